# Optimizing an MI355X kernel written in HIP

```python
import math
import jax, jax.numpy as jnp
from jax import lax
import numpy as np

D_MODEL = 2048
BATCH = 8
SEQ = 4096
DEPTH = 1

D_MIX = D_MODEL
GLA_HEADS = 4
GLA_WIDTH = D_MIX // 2
GLA_DV = GLA_WIDTH // GLA_HEADS
GLA_DK = GLA_DV // 2
GLA_RANK = 16
GLA_TAU = 16.0
GLA_CHUNK = 64
NSA_HEADS = 8
NSA_KV = 2
NSA_REP = NSA_HEADS // NSA_KV
NSA_WIDTH = D_MIX - GLA_WIDTH
NSA_DH = NSA_WIDTH // NSA_HEADS
CMP_LEN = 32
CMP_STRIDE = 16
CMP_HIDDEN = NSA_DH
SEL_BLOCK = 64
SEL_TOPN = 16
SEL_Q_CHUNK = 32
WINDOW = 512
WIN_QBLOCK = 128
N_BUCKETS = 32
MAX_DISTANCE = 128
N_EXPERTS = 32
TOP_K = 4
D_FF = D_MODEL
SWIGLU_ALPHA = 1.702
SWIGLU_LIMIT = 7.0
MOE_BLOCK = 128

RMS_EPS = 1e-5
NEG_INF = -1e30
FORCE_SCORE = 1e4

IN_SIZES = (GLA_HEADS * GLA_DK, GLA_HEADS * GLA_DK, GLA_WIDTH, GLA_WIDTH, GLA_RANK,
            NSA_WIDTH,
            NSA_KV * NSA_DH, NSA_KV * NSA_DH,
            NSA_KV * NSA_DH, NSA_KV * NSA_DH,
            NSA_KV * NSA_DH, NSA_KV * NSA_DH,
            3 * NSA_HEADS)
D_IN = sum(IN_SIZES)

kernel_name = 'hybrid_gla_nsa_moe_block'


def rmsnorm(x, g):
    xf = x.astype(jnp.float32)
    y = xf * lax.rsqrt(jnp.mean(xf * xf, axis=-1, keepdims=True) + RMS_EPS)
    return (y * g.astype(jnp.float32)).astype(x.dtype)


def t5_bucket(dist):
    n = jnp.maximum(dist, 0)
    exact = N_BUCKETS // 2
    scaled = jnp.log(jnp.maximum(n, 1).astype(jnp.float32) / exact) / math.log(MAX_DISTANCE / exact)
    large = exact + (scaled * (N_BUCKETS - exact)).astype(jnp.int32)
    return jnp.where(n < exact, n, jnp.minimum(large, N_BUCKETS - 1)).astype(jnp.int32)


def masked_softmax(logits, mask):
    return jax.nn.softmax(jnp.where(mask, logits.astype(jnp.float32), NEG_INF), axis=-1)


def gla_chunked(q, k, v, log_a):
    B, S, H, DK = q.shape
    DV = v.shape[-1]
    C = GLA_CHUNK
    NC = S // C

    def chunks(t):
        return t.reshape(B, NC, C, H, t.shape[-1]).transpose(1, 0, 3, 2, 4).astype(jnp.float32)

    qc, kc, vc = chunks(q), chunks(k), chunks(v)
    bc = jnp.cumsum(chunks(log_a), axis=3)
    causal = jnp.tril(jnp.ones((C, C), dtype=bool))[:, :, None]

    def step(state, inp):
        q_, k_, v_, b_ = inp
        o_inter = jnp.einsum('bhcd,bhdv->bhcv', q_ * jnp.exp(b_), state)
        diff = b_[:, :, :, None, :] - b_[:, :, None, :, :]
        decay = jnp.exp(jnp.where(causal, diff, -jnp.inf))
        scores = jnp.einsum('bhid,bhjd,bhijd->bhij', q_, k_, decay)
        o_intra = jnp.einsum('bhij,bhjv->bhiv', scores, v_)
        b_last = b_[:, :, -1, :]
        k_dec = k_ * jnp.exp(b_last[:, :, None, :] - b_)
        state = state * jnp.exp(b_last)[..., None] + jnp.einsum('bhjd,bhjv->bhdv', k_dec, v_)
        return state, o_inter + o_intra

    state0 = jnp.zeros((B, H, DK, DV), jnp.float32)
    _, o = lax.scan(step, state0, (qc, kc, vc, bc))
    return o.transpose(1, 0, 3, 2, 4).reshape(B, S, H, DV).astype(v.dtype)


def compress_blocks(t, pe, w1, w2):
    B, G, S, DH = t.shape
    nc = (S - CMP_LEN) // CMP_STRIDE + 1
    idx = jnp.arange(nc)[:, None] * CMP_STRIDE + jnp.arange(CMP_LEN)[None, :]
    blocks = t[:, :, idx] + pe
    flat = blocks.reshape(B, G, nc, CMP_LEN * DH)
    return jax.nn.gelu(flat @ w1) @ w2


def nsa_attention(q, kc, vc, ks, vs, kw, vw, gate_logits, pe_k, wk1, wk2, pe_v, wv1, wv2, rel_bias):
    B, S, _ = q.shape
    G, R, DH = NSA_KV, NSA_REP, NSA_DH
    f32 = jnp.float32
    q = q.reshape(B, S, G, R, DH).transpose(0, 2, 3, 1, 4) * (DH ** -0.5)

    def kv_heads(t):
        return t.reshape(B, S, G, DH).transpose(0, 2, 1, 3)

    kc, vc, ks, vs, kw, vw = (kv_heads(t) for t in (kc, vc, ks, vs, kw, vw))
    pos = jnp.arange(S)

    def head_bias(dist):
        b = rel_bias[t5_bucket(dist)]
        return jnp.moveaxis(b, -1, 0).reshape((G, R) + dist.shape).astype(f32)

    k_cmp = compress_blocks(kc, pe_k, wk1, wk2)
    v_cmp = compress_blocks(vc, pe_v, wv1, wv2)
    nc = k_cmp.shape[2]
    cmp_start = jnp.arange(nc) * CMP_STRIDE
    dist_c = pos[:, None] - (cmp_start + CMP_LEN - 1)[None, :]
    valid_c = dist_c >= 0
    logits_c = jnp.einsum('bgrsd,bgcd->bgrsc', q, k_cmp).astype(f32) + head_bias(dist_c)
    p_c = masked_softmax(logits_c, valid_c) * jnp.any(valid_c, axis=-1, keepdims=True)
    o_cmp = jnp.einsum('bgrsc,bgcd->bgrsd', p_c.astype(v_cmp.dtype), v_cmp)

    ns = S // SEL_BLOCK
    n_sel = min(SEL_TOPN, ns)
    sel_start = jnp.arange(ns) * SEL_BLOCK
    overlap = ((cmp_start[:, None] < sel_start[None, :] + SEL_BLOCK)
               & (cmp_start[:, None] + CMP_LEN > sel_start[None, :])).astype(f32)
    importance = jnp.einsum('bgrsc,cn->bgsn', p_c, overlap)
    blk = jnp.arange(ns)[None, :]
    cur = (pos // SEL_BLOCK)[:, None]
    forced = (blk == 0) | (blk == cur) | (blk == cur - 1)
    score = jnp.where(forced, FORCE_SCORE, jnp.where(blk <= cur, importance, -1.0))
    _, sel_idx = lax.top_k(score, n_sel)

    k_blocks = ks.reshape(B, G, ns, SEL_BLOCK, DH)
    v_blocks = vs.reshape(B, G, ns, SEL_BLOCK, DH)
    gather = jax.vmap(jax.vmap(lambda blocks, ix: blocks[ix]))
    bias_tbl = rel_bias.reshape(N_BUCKETS, G, R)

    def sel_chunk(c):
        s0 = c * SEL_Q_CHUNK
        q_c = lax.dynamic_slice_in_dim(q, s0, SEL_Q_CHUNK, axis=3)
        idx_c = lax.dynamic_slice_in_dim(sel_idx, s0, SEL_Q_CHUNK, axis=2)
        k_g = gather(k_blocks, idx_c)
        v_g = gather(v_blocks, idx_c)
        t_c = s0 + jnp.arange(SEL_Q_CHUNK)
        kpos = idx_c[..., None] * SEL_BLOCK + jnp.arange(SEL_BLOCK)
        dist = t_c[None, None, :, None, None] - kpos
        bias = jax.vmap(lambda tbl, bk: tbl[bk], in_axes=(1, 1), out_axes=1)(bias_tbl, t5_bucket(dist))
        bias = jnp.moveaxis(bias, -1, 2).astype(f32)
        logits = jnp.einsum('bgrqd,bgqnkd->bgrqnk', q_c, k_g).astype(f32) + bias
        mask = (dist >= 0)[:, :, None].reshape(B, G, 1, SEL_Q_CHUNK, -1)
        p = masked_softmax(logits.reshape(B, G, R, SEL_Q_CHUNK, -1), mask).reshape(logits.shape)
        return jnp.einsum('bgrqnk,bgqnkd->bgrqd', p.astype(v_g.dtype), v_g)

    o_sel = lax.map(sel_chunk, jnp.arange(S // SEL_Q_CHUNK))
    o_sel = o_sel.transpose(1, 2, 3, 0, 4, 5).reshape(B, G, R, S, DH)

    nqb = S // WIN_QBLOCK
    pre = WINDOW // WIN_QBLOCK

    def band(t):
        padded = jnp.pad(t, ((0, 0), (0, 0), (pre * WIN_QBLOCK, 0), (0, 0)))
        padded = padded.reshape(B, G, nqb + pre, WIN_QBLOCK, DH)
        return jnp.concatenate([padded[:, :, o:o + nqb] for o in range(pre + 1)], axis=3)

    k_band, v_band = band(kw), band(vw)
    qpos = jnp.arange(nqb)[:, None] * WIN_QBLOCK + jnp.arange(WIN_QBLOCK)[None, :]
    kpos_w = (jnp.arange(nqb)[:, None] - pre) * WIN_QBLOCK + jnp.arange((pre + 1) * WIN_QBLOCK)[None, :]
    dist_w = qpos[:, :, None] - kpos_w[:, None, :]
    valid_w = (dist_w >= 0) & (dist_w < WINDOW) & (kpos_w[:, None, :] >= 0)
    q_w = q.reshape(B, G, R, nqb, WIN_QBLOCK, DH)
    logits_w = jnp.einsum('bgrnqd,bgnkd->bgrnqk', q_w, k_band).astype(f32) + head_bias(dist_w)
    p_w = masked_softmax(logits_w, valid_w)
    o_win = jnp.einsum('bgrnqk,bgnkd->bgrnqd', p_w.astype(v_band.dtype), v_band).reshape(B, G, R, S, DH)

    gates = jax.nn.sigmoid(gate_logits.astype(f32)).reshape(B, S, 3, G, R).transpose(2, 0, 3, 4, 1)[..., None]
    o = gates[0] * o_cmp + gates[1] * o_sel + gates[2] * o_win
    return o.transpose(0, 3, 1, 2, 4).reshape(B, S, NSA_WIDTH).astype(q.dtype)


def hybrid_mixer(xn, w_in, gla_wa2, gla_ba, gla_norm_g, cmp_pe_k, cmp_wk1, cmp_wk2,
                 cmp_pe_v, cmp_wv1, cmp_wv2, nsa_norm_g, rel_bias, w_out):
    B, S, _ = xn.shape
    proj = xn @ w_in
    split_points = [int(p) for p in np.cumsum(IN_SIZES)[:-1]]
    (g_q, g_k, g_v, g_g, g_a, n_q, n_kc, n_vc, n_ks, n_vs, n_kw, n_vw, n_gate) = jnp.split(proj, split_points, axis=-1)

    q = g_q.reshape(B, S, GLA_HEADS, GLA_DK) * (GLA_DK ** -0.5)
    k = g_k.reshape(B, S, GLA_HEADS, GLA_DK)
    v = g_v.reshape(B, S, GLA_HEADS, GLA_DV)
    log_a = jax.nn.log_sigmoid((g_a @ gla_wa2 + gla_ba).astype(jnp.float32)) / GLA_TAU
    o_gla = gla_chunked(q, k, v, log_a.reshape(B, S, GLA_HEADS, GLA_DK))
    o_gla = rmsnorm(o_gla, gla_norm_g) * jax.nn.silu(g_g.reshape(B, S, GLA_HEADS, GLA_DV))
    o_gla = o_gla.reshape(B, S, GLA_WIDTH)

    o_nsa = nsa_attention(n_q, n_kc, n_vc, n_ks, n_vs, n_kw, n_vw, n_gate,
                          cmp_pe_k, cmp_wk1, cmp_wk2, cmp_pe_v, cmp_wv1, cmp_wv2, rel_bias)
    o_nsa = rmsnorm(o_nsa, nsa_norm_g)

    return jnp.concatenate([o_gla, o_nsa], axis=-1) @ w_out


def clamped_swiglu(hu):
    glu, lin = jnp.split(hu, 2, axis=-1)
    glu = jnp.minimum(glu, SWIGLU_LIMIT)
    lin = jnp.clip(lin, -SWIGLU_LIMIT, SWIGLU_LIMIT)
    return glu * jax.nn.sigmoid(SWIGLU_ALPHA * glu) * (lin + 1.0)


def moe_ffn(h, router_w, router_b, w1, b1, w2, b2):
    B, S, D = h.shape
    T = B * S
    xt = h.reshape(T, D)
    logits = (xt @ router_w + router_b).astype(jnp.float32)
    top_val, top_idx = lax.top_k(logits, TOP_K)
    gate = jax.nn.softmax(top_val, axis=-1).astype(h.dtype)

    A = T * TOP_K
    e_flat = top_idx.reshape(A)
    tok_flat = jnp.arange(A, dtype=jnp.int32) // TOP_K
    w_flat = gate.reshape(A)
    order = jnp.argsort(e_flat)
    e_sorted, tok_sorted, w_sorted = e_flat[order], tok_flat[order], w_flat[order]

    counts = jnp.zeros((N_EXPERTS,), jnp.int32).at[e_flat].add(1)
    padded = (counts + MOE_BLOCK - 1) // MOE_BLOCK * MOE_BLOCK
    start = jnp.cumsum(counts) - counts
    pend = jnp.cumsum(padded)
    pstart = pend - padded
    pos = pstart[e_sorted] + (jnp.arange(A, dtype=jnp.int32) - start[e_sorted])

    n_blocks = -(-A // MOE_BLOCK) + N_EXPERTS
    P = n_blocks * MOE_BLOCK
    buf_tok = jnp.full((P,), T, jnp.int32).at[pos].set(tok_sorted)
    buf_w = jnp.zeros((P,), h.dtype).at[pos].set(w_sorted)
    blk_exp = jnp.minimum(jnp.searchsorted(pend, jnp.arange(n_blocks) * MOE_BLOCK, side='right'), N_EXPERTS - 1)
    xt_pad = jnp.concatenate([xt, jnp.zeros((1, D), h.dtype)], axis=0)

    def expert_block(args):
        tok, wgt, e = args
        hu = xt_pad[tok] @ w1[e] + b1[e]
        y = clamped_swiglu(hu) @ w2[e] + b2[e]
        return y * wgt[:, None]

    ys = lax.map(expert_block, (buf_tok.reshape(n_blocks, MOE_BLOCK), buf_w.reshape(n_blocks, MOE_BLOCK), blk_exp))
    out = jax.ops.segment_sum(ys.reshape(P, D), buf_tok, num_segments=T + 1)[:T]
    return out.reshape(B, S, D).astype(h.dtype)


def setup_inputs(seed: int = 0) -> dict:
    key = jax.random.key(seed)
    ks = jax.random.split(key, 24)
    L = DEPTH

    def nrm(k, shape, scale):
        return scale * jax.random.normal(k, shape, jnp.float32)

    return {
        'x': nrm(ks[0], (BATCH, SEQ, D_MODEL), 1.0),
        'norm_mix_g': 1.0 + nrm(ks[1], (L, D_MODEL), 0.02),
        'w_in': nrm(ks[2], (L, D_MODEL, D_IN), D_MODEL ** -0.5),
        'gla_wa2': nrm(ks[3], (L, GLA_RANK, GLA_HEADS * GLA_DK), GLA_RANK ** -0.5),
        'gla_ba': nrm(ks[4], (L, GLA_HEADS * GLA_DK), 0.1),
        'gla_norm_g': 1.0 + nrm(ks[5], (L, GLA_DV), 0.02),
        'cmp_pe_k': nrm(ks[6], (L, CMP_LEN, NSA_DH), 0.02),
        'cmp_wk1': nrm(ks[7], (L, CMP_LEN * NSA_DH, CMP_HIDDEN), (CMP_LEN * NSA_DH) ** -0.5),
        'cmp_wk2': nrm(ks[8], (L, CMP_HIDDEN, NSA_DH), CMP_HIDDEN ** -0.5),
        'cmp_pe_v': nrm(ks[9], (L, CMP_LEN, NSA_DH), 0.02),
        'cmp_wv1': nrm(ks[10], (L, CMP_LEN * NSA_DH, CMP_HIDDEN), (CMP_LEN * NSA_DH) ** -0.5),
        'cmp_wv2': nrm(ks[11], (L, CMP_HIDDEN, NSA_DH), CMP_HIDDEN ** -0.5),
        'nsa_norm_g': 1.0 + nrm(ks[12], (L, NSA_WIDTH), 0.02),
        'rel_bias': nrm(ks[13], (N_BUCKETS, NSA_HEADS), 0.1),
        'w_out': nrm(ks[14], (L, D_MIX, D_MODEL), D_MIX ** -0.5),
        'norm_ffn_g': 1.0 + nrm(ks[15], (L, D_MODEL), 0.02),
        'router_w': nrm(ks[16], (L, D_MODEL, N_EXPERTS), D_MODEL ** -0.5),
        'router_b': nrm(ks[17], (L, N_EXPERTS), 0.01),
        'exp_w1': nrm(ks[18], (L, N_EXPERTS, D_MODEL, 2 * D_FF), D_MODEL ** -0.5),
        'exp_b1': nrm(ks[19], (L, N_EXPERTS, 2 * D_FF), 0.01),
        'exp_w2': nrm(ks[20], (L, N_EXPERTS, D_FF, D_MODEL), D_FF ** -0.5),
        'exp_b2': nrm(ks[21], (L, N_EXPERTS, D_MODEL), 0.01),
        'norm_final_g': 1.0 + nrm(ks[22], (D_MODEL,), 0.02),
    }


def reference(x, norm_mix_g, w_in, gla_wa2, gla_ba, gla_norm_g, cmp_pe_k, cmp_wk1, cmp_wk2,
              cmp_pe_v, cmp_wv1, cmp_wv2, nsa_norm_g, rel_bias, w_out, norm_ffn_g,
              router_w, router_b, exp_w1, exp_b1, exp_w2, exp_b2, norm_final_g):
    h = x
    for l in range(DEPTH):
        xn = rmsnorm(h, norm_mix_g[l])
        h = h + hybrid_mixer(xn, w_in[l], gla_wa2[l], gla_ba[l], gla_norm_g[l],
                             cmp_pe_k[l], cmp_wk1[l], cmp_wk2[l], cmp_pe_v[l], cmp_wv1[l], cmp_wv2[l],
                             nsa_norm_g[l], rel_bias, w_out[l])
        hn = rmsnorm(h, norm_ffn_g[l])
        h = h + moe_ffn(hn, router_w[l], router_b[l], exp_w1[l], exp_b1[l], exp_w2[l], exp_b2[l])
    return rmsnorm(h, norm_final_g)
```

```cpp
#include <hip/hip_runtime.h>
#include <cstdio>
#include <cstdint>
namespace pg8 {
#define PG8_LAS __attribute__((address_space(3)))
typedef unsigned short bf16_t;
typedef short bf16x8 __attribute__((ext_vector_type(8)));
typedef float f32x4 __attribute__((ext_vector_type(4)));
typedef unsigned u32x4 __attribute__((ext_vector_type(4)));
constexpr int BM = 256, BK = 64, HALF = 128, HTB = HALF * BK * 2  , STAGE_BYTES = 8 * HTB, NXCD = 8, WGM = 8;

__host__ __device__ __forceinline__ int lds_byte(int r, int c) { const int st = (r >> 4) * 2 + (c >> 5), rr = r & 15, cc = c & 31, ob = rr * 64 + cc * 2; return st * 1024 + (ob ^ (((ob >> 9) & 1) << 5)); }
__host__ __device__ __forceinline__ void stage_rc(int b, int& R, int& C) { const int st = b / 1024, sb = b % 1024, swz = sb ^ (((sb >> 9) & 1) << 5); R = (st >> 1) * 16 + swz / 64; C = (st & 1) * 32 + (swz % 64) / 2; }
__host__ __device__ __forceinline__ int perm32(int rho) { const int n = rho >> 4, i = rho & 15; return 8 * (i >> 2) + 4 * n + (i & 3); }

struct Unit { int pm, pn, kind; };
struct Gemm { const bf16_t* A; const bf16_t* Bt; int M, N, K; };

__host__ __device__ __forceinline__ void tile_of(int wgid, int nM, int nN, int& pm, int& pn) {
    const int nwg = nM * nN;
    { const int q = nwg / NXCD, r = nwg % NXCD, xcd = wgid % NXCD, off = wgid / NXCD; wgid = (xcd < r ? xcd * (q + 1) : r * (q + 1) + (xcd - r) * q) + off; }
    const int nig = WGM * nN, gid = wgid / nig, fm = gid * WGM, gsz = (nM - fm) < WGM ? (nM - fm) : WGM;
    pm = fm + ((wgid % nig) % gsz); pn = (wgid % nig) / gsz;
}
struct StaticOrder {
    int nM, nN, nwg, G, c;
    __host__ __device__ void init(int M, int N, int G_, int c_) { nM = M / BM; nN = N / BM; nwg = nM * nN; G = G_; c = c_; }
    __device__ __forceinline__ bool next(int i, Unit& u) const {
        const long L = (long)i * G + c; if (L >= nwg) return false;
        tile_of((int)L, nM, nN, u.pm, u.pn); u.kind = 0; return true;
    }
    __device__ __forceinline__ const char* pa(const Gemm& g, const Unit& u) const { return (const char*)g.A + (size_t)u.pm * ((size_t)BM * g.K * 2); }
    __device__ __forceinline__ const char* pb(const Gemm& g, const Unit& u) const { return (const char*)g.Bt + (size_t)u.pn * ((size_t)BM * g.K * 2); }
    __device__ __forceinline__ void a_ready(const Unit&) const {}
    __device__ __forceinline__ void done(const Unit&) const {}
};
__device__ __forceinline__ unsigned cvt_pk_bf16(float lo, float hi) { unsigned r; asm volatile("v_cvt_pk_bf16_f32 %0, %1, %2" : "=v"(r) : "v"(lo), "v"(hi)); return r; }
template <bool I8> __device__ __forceinline__ f32x4 mma16(bf16x8 a, bf16x8 b, f32x4 c) {
    if constexpr (I8) { typedef int i32x4 __attribute__((ext_vector_type(4)));
        return __builtin_bit_cast(f32x4, __builtin_amdgcn_mfma_i32_16x16x64_i8(__builtin_bit_cast(i32x4, a), __builtin_bit_cast(i32x4, b), __builtin_bit_cast(i32x4, c), 0, 0, 0)); }
    else return __builtin_amdgcn_mfma_f32_16x16x32_bf16(a, b, c, 0, 0, 0);
}
template <class Epi, class Sched, bool ALIGN_EPI = false, bool SP2 = false, bool I8 = false>
__device__ __forceinline__ void gemm_phase(PG8_LAS unsigned char* lds, const Gemm g, const Sched& S, const Epi& E) {
    int tid_l = threadIdx.x; asm volatile("" : "+v"(tid_l));
    const int tid = tid_l, wid = __builtin_amdgcn_readfirstlane(tid >> 6), lane = tid & 63, wr = wid >> 2, wc = wid & 3, fr = lane & 15, fq = lane >> 4;
    const int K = g.K, nt = K / BK;
    unsigned voffA[2], voffB[2];
#pragma unroll
    for (int i = 0; i < 2; ++i) { int R, C; stage_rc(tid * 16 + i * 8192, R, C); const int Rb = Epi::PERM ? ((R & ~31) + perm32(R & 31)) : R;
        voffA[i] = (unsigned)(R * K + C) * 2u; voffB[i] = (unsigned)(Rb * K + C) * 2u; }
    const size_t kstep = (size_t)(BK * 2);
    const size_t hstep = (size_t)HALF * K * 2;
    const unsigned ldsw = (unsigned)wid * 1024u;
    const int aoff = lds_byte(wr * 64 + fr, fq * 8), boff = lds_byte(wc * 32 + fr, fq * 8);
#define PG8_SA(b, h) (((b) * 2 + (h)) * HTB)
#define PG8_SB(b, h) ((4 + (b) * 2 + (h)) * HTB)
#define PG8_STAGE(bufoff, gbase, voff) do { _Pragma("unroll") for (int _i = 0; _i < 2; ++_i) \
        __builtin_amdgcn_global_load_lds((const unsigned*)((const char*)(gbase) + (voff)[_i]), (PG8_LAS unsigned*)(lds + (bufoff) + ldsw + _i * 8192), 16, 0, 0); } while (0)
#define PG8_LDA(dst, b, h) do { _Pragma("unroll") for (int m = 0; m < 4; ++m) _Pragma("unroll") for (int k = 0; k < 2; ++k) dst[m][k] = *(const PG8_LAS bf16x8*)(lds + PG8_SA(b, h) + aoff + m * 2048 + k * 1024); } while (0)
#define PG8_LDB(dst, b, h) do { _Pragma("unroll") for (int n = 0; n < 2; ++n) _Pragma("unroll") for (int k = 0; k < 2; ++k) dst[n][k] = *(const PG8_LAS bf16x8*)(lds + PG8_SB(b, h) + boff + n * 2048 + k * 1024); } while (0)
#define PG8_MMA(ai, bj, At, Bt) do { __builtin_amdgcn_s_setprio(1); _Pragma("unroll") for (int m = 0; m < 4; ++m) _Pragma("unroll") for (int n = 0; n < 2; ++n) _Pragma("unroll") for (int k = 0; k < 2; ++k) \
        acc[ai][bj][m][n] = mma16<I8>(Bt[n][k], At[m][k], acc[ai][bj][m][n]); __builtin_amdgcn_s_setprio(0); } while (0)
#define PG8_WAIT_V(n) asm volatile("s_waitcnt vmcnt(" #n ")" ::: "memory")
#define PG8_WAIT_L(n) asm volatile("s_waitcnt lgkmcnt(" #n ")" ::: "memory")
#define PG8_BAR __builtin_amdgcn_s_barrier()
#define PG8_SCHED __builtin_amdgcn_sched_barrier(0)
    Unit cur, nxt; int ui = 0;
    if (!S.next(0, cur)) return;
    f32x4 acc[2][2][4][2];
#pragma unroll
    for (int a = 0; a < 2; ++a)
#pragma unroll
        for (int b = 0; b < 2; ++b)
#pragma unroll
            for (int m = 0; m < 4; ++m)
#pragma unroll
                for (int n = 0; n < 2; ++n) acc[a][b][m][n] = (f32x4){0.f, 0.f, 0.f, 0.f};
    bf16x8 At[4][2], B0[2][2], B1[2][2];
    const char* cA = S.pa(g, cur); const char* cB = S.pb(g, cur);
    S.a_ready(cur);
    if constexpr (SP2) {
        PG8_STAGE(PG8_SB(0, 0), cB, voffB); PG8_STAGE(PG8_SB(0, 1), cB + hstep, voffB); PG8_STAGE(PG8_SA(0, 0), cA, voffA); PG8_STAGE(PG8_SA(0, 1), cA + hstep, voffA);
        if (wr == 1) PG8_BAR;
        PG8_WAIT_V(2); PG8_BAR;
        PG8_STAGE(PG8_SB(1, 0), cB + kstep, voffB); PG8_STAGE(PG8_SA(1, 0), cA + kstep, voffA); PG8_STAGE(PG8_SB(1, 1), cB + hstep + kstep, voffB);
        PG8_WAIT_V(6); PG8_BAR;
    } else {
        PG8_STAGE(PG8_SB(0, 0), cB, voffB); PG8_STAGE(PG8_SA(0, 0), cA, voffA); PG8_STAGE(PG8_SB(0, 1), cB + hstep, voffB); PG8_STAGE(PG8_SA(0, 1), cA + hstep, voffA);
        if (wr == 1) PG8_BAR;
        PG8_WAIT_V(4); PG8_BAR;
        PG8_STAGE(PG8_SB(1, 0), cB + kstep, voffB); PG8_STAGE(PG8_SA(1, 0), cA + kstep, voffA); PG8_STAGE(PG8_SB(1, 1), cB + hstep + kstep, voffB);
        PG8_WAIT_V(6); PG8_BAR;
    }
    for (;;) {
        const bool has_next = S.next(ui + 1, nxt);
        const char* nA = has_next ? S.pa(g, nxt) : cA; const char* nB = has_next ? S.pb(g, nxt) : cB;
        for (int t = 0; t < nt; t += 2) {
            const bool last = (t == nt - 2);
            const char* a1 = cA + (size_t)(t + 1) * kstep;
            const char* a2 = last ? nA : cA + (size_t)(t + 2) * kstep; const char* b2 = last ? nB : cB + (size_t)(t + 2) * kstep;
            const char* a3 = a2 + kstep; const char* b3 = b2 + kstep;
            if (last && has_next) S.a_ready(nxt);
            if constexpr (SP2) {
            PG8_LDB(B0, 0, 0); PG8_LDB(B1, 0, 1); PG8_SCHED; PG8_LDA(At, 0, 0); PG8_STAGE(PG8_SA(1, 1), a1 + hstep, voffA);
            PG8_WAIT_V(8); PG8_WAIT_L(0); PG8_BAR; PG8_MMA(0, 0, At, B0); PG8_MMA(0, 1, At, B1); PG8_BAR; PG8_SCHED;
            PG8_LDA(At, 0, 1); PG8_STAGE(PG8_SB(0, 0), b2, voffB); PG8_STAGE(PG8_SB(0, 1), b2 + hstep, voffB); PG8_STAGE(PG8_SA(0, 0), a2, voffA);
            PG8_WAIT_V(8); PG8_WAIT_L(0); PG8_BAR; PG8_MMA(1, 0, At, B0); PG8_MMA(1, 1, At, B1); PG8_BAR; PG8_SCHED;
            PG8_LDB(B0, 1, 0); PG8_LDB(B1, 1, 1); PG8_SCHED; PG8_LDA(At, 1, 0); PG8_STAGE(PG8_SA(0, 1), a2 + hstep, voffA);
            PG8_WAIT_V(8); PG8_WAIT_L(0); PG8_BAR; PG8_MMA(0, 0, At, B0); PG8_MMA(0, 1, At, B1); PG8_BAR; PG8_SCHED;
            PG8_LDA(At, 1, 1); PG8_STAGE(PG8_SB(1, 0), b3, voffB); PG8_STAGE(PG8_SB(1, 1), b3 + hstep, voffB); PG8_STAGE(PG8_SA(1, 0), a3, voffA);
            PG8_WAIT_V(8); PG8_WAIT_L(0); PG8_BAR; PG8_MMA(1, 0, At, B0); PG8_MMA(1, 1, At, B1); PG8_BAR; PG8_SCHED;
            } else {
            PG8_LDB(B0, 0, 0); PG8_SCHED; PG8_LDA(At, 0, 0); PG8_STAGE(PG8_SA(1, 1), a1 + hstep, voffA);
            PG8_WAIT_L(8); PG8_BAR; PG8_WAIT_L(0); PG8_MMA(0, 0, At, B0); PG8_BAR; PG8_SCHED;
            PG8_LDB(B1, 0, 1); PG8_STAGE(PG8_SB(0, 0), b2, voffB);
            PG8_BAR; PG8_WAIT_L(0); PG8_MMA(0, 1, At, B1); PG8_BAR;
            PG8_LDA(At, 0, 1); PG8_STAGE(PG8_SA(0, 0), a2, voffA);
            PG8_BAR; PG8_WAIT_L(0); PG8_MMA(1, 0, At, B0); PG8_BAR; PG8_SCHED;
            PG8_STAGE(PG8_SB(0, 1), b2 + hstep, voffB);
            PG8_WAIT_V(6); PG8_BAR; PG8_MMA(1, 1, At, B1); PG8_BAR;
            PG8_LDB(B0, 1, 0); PG8_SCHED; PG8_LDA(At, 1, 0); PG8_STAGE(PG8_SA(0, 1), a2 + hstep, voffA);
            PG8_WAIT_L(8); PG8_BAR; PG8_WAIT_L(0); PG8_MMA(0, 0, At, B0); PG8_BAR; PG8_SCHED;
            PG8_LDB(B1, 1, 1); PG8_STAGE(PG8_SB(1, 0), b3, voffB);
            PG8_BAR; PG8_WAIT_L(0); PG8_MMA(0, 1, At, B1); PG8_BAR;
            PG8_LDA(At, 1, 1); PG8_STAGE(PG8_SA(1, 0), a3, voffA);
            PG8_BAR; PG8_WAIT_L(0); PG8_MMA(1, 0, At, B0); PG8_BAR; PG8_SCHED;
            PG8_STAGE(PG8_SB(1, 1), b3 + hstep, voffB);
            PG8_WAIT_V(6); PG8_BAR; PG8_MMA(1, 1, At, B1); PG8_BAR;
            }
        }
        if constexpr (ALIGN_EPI) { if (wr == 0) PG8_BAR; }
        if constexpr (!Epi::AFTER_DRAIN) { E(acc, cur, wr, wc, fr, fq); S.done(cur); }
        if (!has_next) break;
#pragma unroll
        for (int a = 0; a < 2; ++a)
#pragma unroll
            for (int b = 0; b < 2; ++b)
#pragma unroll
                for (int m = 0; m < 4; ++m)
#pragma unroll
                    for (int n = 0; n < 2; ++n) acc[a][b][m][n] = (f32x4){0.f, 0.f, 0.f, 0.f};
        cur = nxt; cA = nA; cB = nB; ++ui;
        if constexpr (ALIGN_EPI) { if (wr == 1) PG8_BAR; }
    }
    PG8_WAIT_V(0);
    if constexpr (!ALIGN_EPI) { if (wr == 0) PG8_BAR; }
    PG8_BAR;
    if constexpr (Epi::AFTER_DRAIN) { E.fused(acc, cur, wr, wc, fr, fq, lds, wid, lane); S.done(cur); }
#undef PG8_SA
#undef PG8_SB
#undef PG8_STAGE
#undef PG8_LDA
#undef PG8_LDB
#undef PG8_MMA
#undef PG8_WAIT_V
#undef PG8_WAIT_L
#undef PG8_BAR
#undef PG8_SCHED
}
}

#define GAS __attribute__((address_space(1)))
#define LAS __attribute__((address_space(3)))
typedef unsigned short bf16;
typedef unsigned v4u __attribute__((ext_vector_type(4)));
typedef unsigned v2u __attribute__((ext_vector_type(2)));
typedef float f32x4 __attribute__((ext_vector_type(4)));
typedef short bf16x8 __attribute__((ext_vector_type(8)));

constexpr int NB = 8, SEQ = 4096, DM = 2048, T = NB * SEQ;
constexpr int NPT = 23;
constexpr int NE = 32, DFF = 2048;
constexpr int MAXTILES = 544;
constexpr float RMS_EPS = 1e-5f;
constexpr int NVB = 256, TPV = T / NVB;

enum { I_X = 0, I_NMIX, I_WIN, I_WA2, I_BA, I_GLAG, I_PEK, I_WK1, I_WK2, I_PEV, I_WV1, I_WV2, I_NSAG, I_RELB, I_WOUT, I_NFFN, I_RW, I_RB, I_W1, I_B1, I_W2, I_B2, I_NFIN, N_IN };

constexpr size_t MiB = 1u << 20;
constexpr size_t al(size_t x) { return (x + 255) & ~(size_t)255; }
constexpr size_t WS_CTL = 0, CTL_BYTES = 1 * MiB;
constexpr size_t WS_CNT = WS_CTL + CTL_BYTES;
constexpr size_t WS_META = WS_CNT + al(NVB * 32 * 4);
constexpr size_t WS_EIDX = WS_META + al((64 + MAXTILES) * 4);
constexpr size_t WS_LRNK = WS_EIDX + al((size_t)T * 4 * 4);
constexpr size_t WS_GATE = WS_LRNK + al((size_t)T * 4 * 4);
constexpr size_t WS_POS = WS_GATE + al((size_t)T * 4 * 4);
constexpr size_t WS_ROWW = WS_POS + al((size_t)T * 4 * 4);
constexpr size_t WS_WINT = al(WS_ROWW + (size_t)MAXTILES * 256 * 4);
constexpr size_t WS_WOT = WS_WINT + (size_t)NPT * 256 * DM * 2;
constexpr size_t WS_WKCT = WS_WOT + (size_t)DM * DM * 2;
constexpr size_t WS_WVCT = WS_WKCT + (size_t)256 * 2048 * 2;
constexpr size_t WS_W1T = WS_WVCT + (size_t)256 * 2048 * 2;
constexpr size_t WS_W2T = WS_W1T + (size_t)NE * 4096 * DM * 2;
constexpr size_t WS_XN = WS_W2T + (size_t)NE * DM * DFF * 2;
constexpr size_t WS_GQ = WS_XN + (size_t)T * DM * 2;
constexpr size_t WS_GK = WS_GQ + (size_t)T * 512 * 2;
constexpr size_t WS_GV = WS_GK + (size_t)T * 512 * 2;
constexpr size_t WS_GG = WS_GV + (size_t)T * 1024 * 2;
constexpr size_t WS_NQ = WS_GG + (size_t)T * 1024 * 2;
constexpr size_t WS_KC = WS_NQ + (size_t)T * 1024 * 2;
constexpr size_t WS_VC = WS_KC + (size_t)T * 256 * 2;
constexpr size_t WS_KS = WS_VC + (size_t)T * 256 * 2;
constexpr size_t WS_KW = WS_KS + (size_t)T * 256 * 2;
constexpr size_t WS_VST = WS_KW + (size_t)T * 256 * 2;
constexpr size_t WS_VWT = WS_VST + (size_t)T * 256 * 2;
constexpr size_t WS_SM = WS_VWT + (size_t)T * 256 * 2;
constexpr size_t WS_LA = WS_SM + (size_t)T * 64 * 2;
constexpr size_t WS_OG = WS_LA + (size_t)T * 512 * 4;
constexpr size_t WS_ON = WS_OG + (size_t)T * 1024 * 4;
constexpr size_t WS_KCMP = WS_ON + (size_t)T * 1024 * 4;
constexpr size_t WS_VCMPT = WS_KCMP + (size_t)16 * 256 * 128 * 2;
constexpr size_t WS_A2 = WS_VCMPT + (size_t)16 * 256 * 128 * 2;
constexpr size_t WS_HN = WS_A2 + (size_t)T * DM * 2;
constexpr size_t WS_XG = WS_HN + (size_t)T * DM * 2;
constexpr size_t WS_ACT = WS_XG + (size_t)MAXTILES * 256 * DM * 2;
constexpr size_t WS_END = WS_ACT + (size_t)MAXTILES * 256 * DFF * 2;

__device__ __forceinline__ unsigned f2bf(float f) { unsigned u = __builtin_bit_cast(unsigned, f); return (u + 0x7fffu + ((u >> 16) & 1u)) >> 16; }
__device__ __forceinline__ unsigned pk2(float lo, float hi) { return f2bf(lo) | (f2bf(hi) << 16); }
__device__ __forceinline__ float bf2f(unsigned short v) { return __builtin_bit_cast(float, (unsigned)v << 16); }
__device__ __forceinline__ float bflo(unsigned w) { return __builtin_bit_cast(float, w << 16); }
__device__ __forceinline__ float bfhi(unsigned w) { return __builtin_bit_cast(float, w & 0xffff0000u); }
__device__ __forceinline__ float wave_sum(float v) {
#pragma unroll
    for (int o = 1; o < 64; o <<= 1) v += __shfl_xor(v, o);
    return v;
}
__device__ __forceinline__ float wave_max(float v) {
#pragma unroll
    for (int o = 1; o < 64; o <<= 1) v = fmaxf(v, __shfl_xor(v, o));
    return v;
}
#define LDS_WAIT() asm volatile("s_waitcnt lgkmcnt(0)" ::: "memory")

__device__ const unsigned char kBucket[128] = {0, 1, 2, 3, 4, 5, 6, 7, 8, 9, 10, 11, 12, 13, 14, 15, 16, 16, 16, 17, 17, 18, 18, 18, 19, 19, 19, 20, 20, 20, 20, 21, 21, 21, 21, 22, 22, 22, 22, 22, 23, 23, 23, 23, 23, 23, 24, 24, 24, 24, 24, 24, 25, 25, 25, 25, 25, 25, 25, 26, 26, 26, 26, 26, 26, 26, 26, 27, 27, 27, 27, 27, 27, 27, 27, 27, 27, 28, 28, 28, 28, 28, 28, 28, 28, 28, 28, 29, 29, 29, 29, 29, 29, 29, 29, 29, 29, 29, 29, 30, 30, 30, 30, 30, 30, 30, 30, 30, 30, 30, 30, 30, 30, 31, 31, 31, 31, 31, 31, 31, 31, 31, 31, 31, 31, 31, 31, 31};

struct Params {
    const float* in[N_IN];
    float* out;
    unsigned char* ws;
};

template <class F>
__device__ __forceinline__ void transpose_item(const float* W, int ldw, int k0, int n0, int nlim, LAS float* scr, int lane, F dst) {
#pragma unroll 8
    for (int i = 0; i < 32; ++i) { const int kk = 2 * i + (lane >> 5); const int n = n0 + (lane & 31); scr[kk * 33 + (lane & 31)] = n < nlim ? W[(size_t)(k0 + kk) * ldw + n] : 0.f; }
    LDS_WAIT(); asm volatile("" ::: "memory");
    const int c = lane & 7;
#pragma unroll
    for (int j = 0; j < 4; ++j) { const int nn = (lane >> 3) + 8 * j; const int n = n0 + nn; const LAS float* s = scr + (8 * c) * 33 + nn;
        bf16* rowp; float sc;
        if (n < nlim && dst(n, rowp, sc)) {
            v4u o; o.x = pk2(s[0 * 33] * sc, s[1 * 33] * sc); o.y = pk2(s[2 * 33] * sc, s[3 * 33] * sc); o.z = pk2(s[4 * 33] * sc, s[5 * 33] * sc); o.w = pk2(s[6 * 33] * sc, s[7 * 33] * sc);
            *(v4u*)(rowp + 8 * c) = o; } }
    LDS_WAIT(); asm volatile("" ::: "memory");
}
__device__ __forceinline__ int win_row(int n, float& sc) {
    sc = 1.f;
    if (n < 512) { sc = 0.08838834764831845f; return n; }
    if (n < 1024) return n;
    if (n < 2048) return n;
    if (n < 3072) return n;
    if (n < 3088) return 5120 + (n - 3072);
    if (n < 4112) { sc = 0.08838834764831845f; return 3072 + (n - 3088); }
    if (n < 4368) return 4096 + (n - 4112);
    if (n < 4624) return 4352 + (n - 4368);
    if (n < 4880) return 4608 + (n - 4624);
    if (n < 5136) return 5376 + (n - 4880);
    if (n < 5392) return 4864 + (n - 5136);
    if (n < 5648) return 5632 + (n - 5392);
    return 5136 + (n - 5648);
}
constexpr size_t WS_PEVP = WS_W2T;
__device__ __forceinline__ void p0_prologue(const Params& p, LAS unsigned char* lds, int gw, int NGW, int wave, int lane) {
    LAS float* scr = (LAS float*)(lds + wave * 16384);
    bf16* WinT = (bf16*)(p.ws + WS_WINT); bf16* WoT = (bf16*)(p.ws + WS_WOT); bf16* WkcT = (bf16*)(p.ws + WS_WKCT); bf16* WvcT = (bf16*)(p.ws + WS_WVCT);
    bf16* W1T = (bf16*)(p.ws + WS_W1T); bf16* W2T = (bf16*)(p.ws + WS_W2T);
    constexpr int I_IN = 32 * 178, I_O = 32 * 64, I_C = 64 * 4, I_E1 = 32 * 128, I_E2 = 32 * 64;
    constexpr int I_PE = 2 * 64;
    constexpr int NITEMS = I_O + 2 * I_C + I_PE;
    (void)I_IN; (void)WinT;
    for (int it = gw; it < NITEMS; it += NGW) {
        int r = it;
        if (r < I_O) { const int kb = r / 64, nb = r % 64, k0 = kb * 64;
            transpose_item(p.in[I_WOUT], DM, k0, nb * 32, DM, scr, lane, [&](int n, bf16*& rowp, float& sc) { sc = 1.f; rowp = WoT + (size_t)n * DM + k0; return true; }); continue; } r -= I_O;
        if (r >= 2 * I_C) { r -= 2 * I_C; const int which = r >> 6, kq = r & 63; const float* pe = p.in[which ? I_PEV : I_PEK] + kq * 64; const float* w1 = p.in[which ? I_WV1 : I_WK1] + (size_t)kq * 64 * 128 + lane;
            float a0 = 0.f, a1 = 0.f;
#pragma unroll
            for (int k = 0; k < 64; ++k) { const float pv = pe[k]; a0 += pv * w1[k * 128]; a1 += pv * w1[k * 128 + 64]; }
            float* dst = (float*)(p.ws + WS_PEVP) + (size_t)(which * 64 + kq) * 128 + lane; dst[0] = a0; dst[64] = a1; continue; }
        { const int which = r / I_C; r %= I_C; const int kb = r / 4, nb = r % 4, k0 = kb * 64;
            bf16* dstm = which ? WvcT : WkcT;
            transpose_item(p.in[which ? I_WV1 : I_WK1], 128, k0, nb * 32, 128, scr, lane, [&](int n, bf16*& rowp, float& sc) { sc = 1.f; rowp = dstm + (size_t)(n + (k0 >= 2048 ? 128 : 0)) * 2048 + (k0 & 2047); return true; }); }
        (void)I_E1; (void)I_E2; (void)W1T; (void)W2T;
    }
    const float* x = p.in[I_X]; const float* gm = p.in[I_NMIX];
    for (int m = gw; m < T; m += NGW) {
        const f32x4* xr = (const f32x4*)(x + (size_t)m * DM) + lane; f32x4 v[8]; float s = 0.f;
#pragma unroll
        for (int j = 0; j < 8; ++j) { v[j] = xr[64 * j]; s += (v[j].x * v[j].x + v[j].y * v[j].y) + (v[j].z * v[j].z + v[j].w * v[j].w); }
        const float rstd = 1.f / sqrtf(wave_sum(s) * (1.f / DM) + RMS_EPS);
        float mxr = 0.f;
#pragma unroll
        for (int j = 0; j < 8; ++j) { const f32x4 g4 = ((const f32x4*)gm)[lane + 64 * j]; v[j].x *= rstd * g4.x; v[j].y *= rstd * g4.y; v[j].z *= rstd * g4.z; v[j].w *= rstd * g4.w;
            mxr = fmaxf(mxr, fmaxf(fmaxf(fabsf(v[j].x), fabsf(v[j].y)), fmaxf(fabsf(v[j].z), fabsf(v[j].w)))); }
        mxr = wave_max(mxr); const float qs = mxr > 0.f ? mxr * (1.f / 127.f) : 1.f, qi = 1.f / qs;
        unsigned* o4 = (unsigned*)(p.ws + WS_XN + (size_t)m * DM) + lane;
#pragma unroll
        for (int j = 0; j < 8; ++j) { const int q0 = (int)rintf(v[j].x * qi), q1 = (int)rintf(v[j].y * qi), q2 = (int)rintf(v[j].z * qi), q3 = (int)rintf(v[j].w * qi);
            o4[64 * j] = ((unsigned)q0 & 0xffu) | (((unsigned)q1 & 0xffu) << 8) | (((unsigned)q2 & 0xffu) << 16) | (((unsigned)q3 & 0xffu) << 24); }
        if (lane == 0) ((float*)(p.ws + WS_XN + (size_t)T * DM))[m] = qs;
    }
}
#define XB_TMO      128
#define XB_XCNT(j)  (256  + 64 * (j))
#define XB_XSUB(j)  (1280 + 64 * (j))
#define XB_XGEN(j)  (2304 + 64 * (j))
#define XB_TOP      3328
#define XB_TOPGEN   3392
#define XCD_BAR_WORDS 3456
#define XB_SPIN_CAP (1u << 18)

__device__ __forceinline__ unsigned xb_ld(unsigned* p)              { return __hip_atomic_load(p, __ATOMIC_RELAXED, __HIP_MEMORY_SCOPE_AGENT); }
__device__ __forceinline__ unsigned xb_add(unsigned* p, unsigned v) { return __hip_atomic_fetch_add(p, v, __ATOMIC_RELAXED, __HIP_MEMORY_SCOPE_AGENT); }
__device__ __forceinline__ unsigned xb_xcc_id() { return (unsigned)__builtin_amdgcn_s_getreg((3 << 11) | 20) & 0xFu; }
#define XB_SPIN(cond, bar) do { unsigned _sp = 0; while (cond) { __builtin_amdgcn_s_sleep(1); \
    if ((++_sp & 255u) == 0u) { if (xb_ld(&(bar)[XB_TMO])) break; if (_sp > XB_SPIN_CAP) { atomicAdd(&(bar)[XB_TMO], 1u); break; } } } } while (0)

struct XcdBarrier {
    unsigned* bar; unsigned x;
    volatile LAS unsigned* st;
};

__device__ __forceinline__ XcdBarrier xcd_barrier_post(unsigned* bar, volatile LAS unsigned* st) {
    XcdBarrier b; b.bar = bar; b.x = xb_xcc_id(); b.st = st;
    if (threadIdx.x == 0) (void)xb_add(&bar[XB_XCNT(b.x)], 1u);
    return b;
}
__device__ __forceinline__ void xcd_barrier_complete(unsigned* bar, unsigned x, unsigned& nloc, unsigned& nx) {
    const unsigned G = gridDim.x * gridDim.y * gridDim.z;
    unsigned sum, cnt, mine, sp = 0u;
    for (;;) {
        sum = 0u; cnt = 0u; mine = 0u;
#pragma unroll
        for (unsigned j = 0; j < 16; ++j) { const unsigned c = xb_ld(&bar[XB_XCNT(j)]); sum += c; cnt += (c > 0u) ? 1u : 0u; mine = (j == x) ? c : mine; }
        if (sum == G) break;
        __builtin_amdgcn_s_sleep(1);
        if ((++sp & 255u) == 0u) { if (xb_ld(&bar[XB_TMO])) break; if (sp > XB_SPIN_CAP) { atomicAdd(&bar[XB_TMO], 1u); break; } }
    }
    nloc = mine > 0u ? mine : 1u; nx = cnt > 0u ? cnt : 1u;
}

__device__ __forceinline__ void xcd_barrier(const XcdBarrier& b) {
    asm volatile("s_waitcnt vmcnt(0)" ::: "memory");
    __syncthreads();
    if (threadIdx.x == 0) {
        unsigned* bar = b.bar;
        __builtin_amdgcn_s_waitcnt(0);
        unsigned nloc = b.st[0], nx = b.st[1];
        if (nloc == 0u) { xcd_barrier_complete(bar, b.x, nloc, nx); b.st[0] = nloc; b.st[1] = nx; }
        const unsigned old = xb_add(&bar[XB_XSUB(b.x)], 1u);
        const unsigned gen = old / nloc;
        if (old + 1u == (gen + 1u) * nloc) {
            __builtin_amdgcn_fence(__ATOMIC_RELEASE, "agent");
            asm volatile("s_waitcnt vmcnt(0)" ::: "memory");
            const unsigned og = xb_add(&bar[XB_TOP], 1u);
            const unsigned tg = og / nx;
            if (og + 1u == (tg + 1u) * nx) xb_add(&bar[XB_TOPGEN], 1u);
            else XB_SPIN(xb_ld(&bar[XB_TOPGEN]) == tg, bar);
            __builtin_amdgcn_fence(__ATOMIC_ACQUIRE, "agent");
            xb_add(&bar[XB_XGEN(b.x)], 1u);
            asm volatile("s_waitcnt vmcnt(0)" ::: "memory");
        } else {
            XB_SPIN(xb_ld(&bar[XB_XGEN(b.x)]) == gen, bar);
            __builtin_amdgcn_fence(__ATOMIC_ACQUIRE, "agent");
            asm volatile("s_waitcnt vmcnt(0)" ::: "memory");
        }
    }
    __syncthreads();
}

struct ProjOrder : pg8::StaticOrder {
    const bf16* xn; const bf16* wt;
    __device__ __forceinline__ bool next(int i, pg8::Unit& u) const { if (!pg8::StaticOrder::next(i, u)) return false; u.kind = (u.pn >= 21) ? 1 : 0; return true; }
    __device__ __forceinline__ const char* pa(const pg8::Gemm& g, const pg8::Unit& u) const { return u.kind ? (const char*)wt + (size_t)u.pn * ((size_t)256 * g.K * 2) : (const char*)xn + (size_t)u.pm * ((size_t)256 * g.K * 2); }
    __device__ __forceinline__ const char* pb(const pg8::Gemm& g, const pg8::Unit& u) const { return u.kind ? (const char*)xn + (size_t)u.pm * ((size_t)256 * g.K * 2) : (const char*)wt + (size_t)u.pn * ((size_t)256 * g.K * 2); }
};
struct EpiProj {
    static constexpr bool PERM = true, AFTER_DRAIN = false;
    unsigned char* ws;
    __device__ __forceinline__ void operator()(const pg8::f32x4 (&acc)[2][2][4][2], const pg8::Unit& u, int wr, int wc, int fr, int fq) const {
        const int cw = wc * 32 + 8 * fq;
        if (u.kind == 0) {
            const int tn = u.pn; bf16* base; size_t bjs = 128; int ld = 0; bool headmajor = false; bool small = false;
            if (tn < 2) { base = (bf16*)(ws + WS_GQ) + tn * 256; ld = 512; }
            else if (tn < 4) { base = (bf16*)(ws + WS_GK) + (tn - 2) * 256; ld = 512; }
            else if (tn < 8) { base = (bf16*)(ws + WS_GV) + (tn - 4) * 256; ld = 1024; }
            else if (tn < 12) { base = (bf16*)(ws + WS_GG) + (tn - 8) * 256; ld = 1024; }
            else if (tn < 16) { base = (bf16*)(ws + WS_NQ) + (tn - 12) * 256; ld = 1024; }
            else if (tn < 20) { base = (bf16*)(ws + (tn == 16 ? WS_KC : tn == 17 ? WS_VC : tn == 18 ? WS_KS : WS_KW)); headmajor = true; bjs = (size_t)SEQ * 128; }
            else { base = (bf16*)(ws + WS_SM); ld = 64; small = true; }
            if (small && wc >= 2) return;
#pragma unroll
            for (int ai = 0; ai < 2; ++ai)
#pragma unroll
                for (int m = 0; m < 4; ++m) { const int r = u.pm * 256 + ai * 128 + wr * 64 + m * 16 + fr;
                    const size_t rterm = headmajor ? ((size_t)(r >> 12) * 2 * SEQ + (r & (SEQ - 1))) * 128 : (size_t)r * ld;
#pragma unroll
                    for (int bj = 0; bj < 2; ++bj) { if (small && bj) continue;
                        const pg8::f32x4 v0 = acc[ai][bj][m][0], v1 = acc[ai][bj][m][1];
                        pg8::u32x4 w; w.x = pg8::cvt_pk_bf16(v0[0], v0[1]); w.y = pg8::cvt_pk_bf16(v0[2], v0[3]); w.z = pg8::cvt_pk_bf16(v1[0], v1[1]); w.w = pg8::cvt_pk_bf16(v1[2], v1[3]);
                        *(pg8::u32x4*)(base + rterm + bj * bjs + cw) = w; } }
        } else {
            bf16* base = (bf16*)(ws + (u.pn == 21 ? WS_VST : WS_VWT));
#pragma unroll
            for (int ai = 0; ai < 2; ++ai)
#pragma unroll
                for (int m = 0; m < 4; ++m) { const int dh = wr * 64 + m * 16 + fr;
#pragma unroll
                    for (int bj = 0; bj < 2; ++bj) { const int tok = u.pm * 256 + bj * 128 + cw; const int b = tok >> 12, s = tok & (SEQ - 1);
                        const pg8::f32x4 v0 = acc[ai][bj][m][0], v1 = acc[ai][bj][m][1];
                        pg8::u32x4 w; w.x = pg8::cvt_pk_bf16(v0[0], v0[1]); w.y = pg8::cvt_pk_bf16(v0[2], v0[3]); w.z = pg8::cvt_pk_bf16(v1[0], v1[1]); w.w = pg8::cvt_pk_bf16(v1[2], v1[3]);
                        *(pg8::u32x4*)(base + ((size_t)(b * 2 + ai) * 128 + dh) * SEQ + s) = w; } }
        }
    }
};
struct EpiRes {
    static constexpr bool PERM = false, AFTER_DRAIN = false;
    const float* x; float* h;
    __device__ __forceinline__ void operator()(const pg8::f32x4 (&acc)[2][2][4][2], const pg8::Unit& u, int wr, int wc, int fr, int fq) const {
        const int row0 = u.pm * 256 + wr * 64 + fr, col0 = u.pn * 256 + wc * 32 + 4 * fq;
#pragma unroll
        for (int ai = 0; ai < 2; ++ai)
#pragma unroll
            for (int m = 0; m < 4; ++m) { const size_t off = (size_t)(row0 + ai * 128 + m * 16) * DM + col0;
#pragma unroll
                for (int bj = 0; bj < 2; ++bj)
#pragma unroll
                    for (int n = 0; n < 2; ++n) { const pg8::f32x4 xv = *(const pg8::f32x4*)(x + off + bj * 128 + n * 16); *(pg8::f32x4*)(h + off + bj * 128 + n * 16) = xv + acc[ai][bj][m][n]; } }
    }
};
struct MoeOrder {
    int nM, nN, nwg, G, c; const int* tile_exp;
    __device__ __forceinline__ void init(const int* meta, int nN_, int G_, int c_) { nM = meta[0]; nN = nN_; nwg = nM * nN; G = G_; c = c_; tile_exp = meta + 64; }
    __device__ __forceinline__ bool next(int i, pg8::Unit& u) const {
        const long L = (long)i * G + c; if (L >= nwg) return false;
        pg8::tile_of((int)L, nM, nN, u.pm, u.pn); u.kind = tile_exp[u.pm]; return true;
    }
    __device__ __forceinline__ const char* pa(const pg8::Gemm& g, const pg8::Unit& u) const { return (const char*)g.A + (size_t)u.pm * ((size_t)256 * g.K * 2); }
    __device__ __forceinline__ const char* pb(const pg8::Gemm& g, const pg8::Unit& u) const { return (const char*)g.Bt + ((size_t)u.kind * nN + u.pn) * ((size_t)256 * g.K * 2); }
    __device__ __forceinline__ void a_ready(const pg8::Unit&) const {}
    __device__ __forceinline__ void done(const pg8::Unit&) const {}
};

struct MoeOrderSync : MoeOrder {
    unsigned* xl; unsigned x, nloc; int full_rounds; mutable int calls;
    __device__ __forceinline__ void init_sync(unsigned* xl_, unsigned x_, unsigned nloc_) { xl = xl_; x = x_; nloc = nloc_ ? nloc_ : 1u; full_rounds = nwg / G; calls = 0; }
    __device__ __forceinline__ void a_ready(const pg8::Unit&) const {
        if (calls < full_rounds) {
            if (threadIdx.x == 0) { unsigned* sub = xl + 64 * x; unsigned* genw = xl + 1024 + 64 * x;
                const unsigned old = __hip_atomic_fetch_add(sub, 1u, __ATOMIC_RELAXED, __HIP_MEMORY_SCOPE_AGENT), gen = old / nloc;
                if (old + 1u == (gen + 1u) * nloc) __hip_atomic_fetch_add(genw, 1u, __ATOMIC_RELAXED, __HIP_MEMORY_SCOPE_AGENT);
                else { unsigned sp = 0; while (__hip_atomic_load(genw, __ATOMIC_RELAXED, __HIP_MEMORY_SCOPE_AGENT) == gen) { __builtin_amdgcn_s_sleep(1); if (++sp > (1u << 16)) break; } } }
            asm volatile("" ::: "memory"); __builtin_amdgcn_s_barrier(); asm volatile("" ::: "memory"); }
        ++calls;
    }
};
struct EpiSwiglu {
    static constexpr bool PERM = true, AFTER_DRAIN = false;
    const float* b1; bf16* act;
    __device__ __forceinline__ void operator()(const pg8::f32x4 (&acc)[2][2][4][2], const pg8::Unit& u, int wr, int wc, int fr, int fq) const {
        const int e = u.kind; const int col = u.pn * 128 + wc * 32 + 8 * fq; const int row0 = u.pm * 256 + wr * 64 + fr;
        const float* bg = b1 + (size_t)e * 4096 + col; const float* bl = bg + 2048;
        const pg8::f32x4 g0 = *(const pg8::f32x4*)bg, g1 = *(const pg8::f32x4*)(bg + 4), l0 = *(const pg8::f32x4*)bl, l1 = *(const pg8::f32x4*)(bl + 4);
#pragma unroll
        for (int ai = 0; ai < 2; ++ai)
#pragma unroll
            for (int m = 0; m < 4; ++m) { float o[8];
#pragma unroll
                for (int n = 0; n < 2; ++n)
#pragma unroll
                    for (int j = 0; j < 4; ++j) { float gl = acc[ai][0][m][n][j] + (n ? g1[j] : g0[j]); float li = acc[ai][1][m][n][j] + (n ? l1[j] : l0[j]);
                        gl = fminf(gl, 7.f); li = fminf(fmaxf(li, -7.f), 7.f);
                        o[n * 4 + j] = gl * (1.f / (1.f + __expf(-1.702f * gl))) * (li + 1.f); }
                pg8::u32x4 w; w.x = pg8::cvt_pk_bf16(o[0], o[1]); w.y = pg8::cvt_pk_bf16(o[2], o[3]); w.z = pg8::cvt_pk_bf16(o[4], o[5]); w.w = pg8::cvt_pk_bf16(o[6], o[7]);
                *(pg8::u32x4*)(act + (size_t)(row0 + ai * 128 + m * 16) * DFF + col) = w; }
    }
};
struct EpiDown {
    static constexpr bool PERM = true, AFTER_DRAIN = false;
    const float* b2; const float* roww; bf16* y;
    __device__ __forceinline__ void operator()(const pg8::f32x4 (&acc)[2][2][4][2], const pg8::Unit& u, int wr, int wc, int fr, int fq) const {
        const int e = u.kind; const int col0 = u.pn * 256 + wc * 32 + 8 * fq; const int row0 = u.pm * 256 + wr * 64 + fr;
        pg8::f32x4 bv[2][2];
#pragma unroll
        for (int bj = 0; bj < 2; ++bj)
#pragma unroll
            for (int n = 0; n < 2; ++n) bv[bj][n] = *(const pg8::f32x4*)(b2 + (size_t)e * DM + col0 + bj * 128 + 4 * n);
#pragma unroll
        for (int ai = 0; ai < 2; ++ai)
#pragma unroll
            for (int m = 0; m < 4; ++m) { const int r = row0 + ai * 128 + m * 16; const float g = roww[r];
#pragma unroll
                for (int bj = 0; bj < 2; ++bj) { const pg8::f32x4 v0 = (acc[ai][bj][m][0] + bv[bj][0]) * g, v1 = (acc[ai][bj][m][1] + bv[bj][1]) * g;
                    pg8::u32x4 w; w.x = pg8::cvt_pk_bf16(v0[0], v0[1]); w.y = pg8::cvt_pk_bf16(v0[2], v0[3]); w.z = pg8::cvt_pk_bf16(v1[0], v1[1]); w.w = pg8::cvt_pk_bf16(v1[2], v1[3]);
                    *(pg8::u32x4*)(y + (size_t)r * DM + col0 + bj * 128) = w; } }
    }
};

__device__ __forceinline__ void ph_loga(const Params& p, size_t i0, size_t istride) {
    const bf16* SM = (const bf16*)(p.ws + WS_SM); float* LA = (float*)(p.ws + WS_LA); const float* wa2 = p.in[I_WA2]; const float* ba = p.in[I_BA];
    for (size_t i = i0; i < (size_t)T * 512; i += istride) {
        const int t = (int)(i >> 9), c = (int)(i & 511); float z = ba[c];
#pragma unroll
        for (int r = 0; r < 16; ++r) z += bf2f(SM[(size_t)t * 64 + r]) * wa2[r * 512 + c];
        LA[i] = (fminf(z, 0.f) - log1pf(__expf(-fabsf(z)))) * (1.f / 16.f);
    }
}
__device__ __forceinline__ void ph_gla_naive(const Params& p, LAS float* qs, int unit, int lane) {
    LAS float* ks = qs + 128; LAS float* as = qs + 256;
    const int bh = unit >> 2, sl = unit & 3, b = bh >> 2, h = bh & 3, dv = sl * 64 + lane;
    const bf16* GQ = (const bf16*)(p.ws + WS_GQ); const bf16* GK = (const bf16*)(p.ws + WS_GK); const bf16* GV = (const bf16*)(p.ws + WS_GV);
    const float* LA = (const float*)(p.ws + WS_LA); float* OG = (float*)(p.ws + WS_OG);
    float st[128];
#pragma unroll
    for (int i = 0; i < 128; ++i) st[i] = 0.f;
    for (int s = 0; s < SEQ; ++s) { const size_t row = (size_t)b * SEQ + s;
#pragma unroll
        for (int j = 0; j < 2; ++j) { const int dk = lane + 64 * j; qs[dk] = bf2f(GQ[row * 512 + h * 128 + dk]); ks[dk] = bf2f(GK[row * 512 + h * 128 + dk]); as[dk] = __expf(LA[row * 512 + h * 128 + dk]); }
        LDS_WAIT(); __builtin_amdgcn_wave_barrier();
        const float v = bf2f(GV[row * 1024 + h * 256 + dv]); float o = 0.f;
#pragma unroll
        for (int dk = 0; dk < 128; ++dk) { st[dk] = as[dk] * st[dk] + ks[dk] * v; o += qs[dk] * st[dk]; }
        OG[row * 1024 + h * 256 + dv] = o;
        LDS_WAIT(); __builtin_amdgcn_wave_barrier();
    }
}
template <bool DO_NSA> __device__ __forceinline__ void ph_mix_post(const Params& p, int gw, int NGW, int lane) {
    const float* OG = (const float*)(p.ws + WS_OG); const float* ON = (const float*)(p.ws + WS_ON); const bf16* GG = (const bf16*)(p.ws + WS_GG); bf16* A2 = (bf16*)(p.ws + WS_A2);
    const float* gn = p.in[I_GLAG]; const float* ng = p.in[I_NSAG];
    for (int t = gw; t < T; t += NGW) {
#pragma unroll
        for (int h = 0; h < 4; ++h) { const f32x4 o = *((const f32x4*)(OG + (size_t)t * 1024 + h * 256) + lane);
            const float ms = wave_sum(o.x * o.x + o.y * o.y + o.z * o.z + o.w * o.w) * (1.f / 256.f); const float rstd = 1.f / sqrtf(ms + RMS_EPS);
            const f32x4 g4 = ((const f32x4*)gn)[lane]; const v2u gg = *((const v2u*)(GG + (size_t)t * 1024 + h * 256) + lane);
            const float z0 = bflo(gg.x), z1 = bfhi(gg.x), z2 = bflo(gg.y), z3 = bfhi(gg.y);
            v2u w; w.x = pk2(o.x * rstd * g4.x * (z0 / (1.f + __expf(-z0))), o.y * rstd * g4.y * (z1 / (1.f + __expf(-z1))));
            w.y = pk2(o.z * rstd * g4.z * (z2 / (1.f + __expf(-z2))), o.w * rstd * g4.w * (z3 / (1.f + __expf(-z3))));
            *((v2u*)(A2 + (size_t)t * DM + h * 256) + lane) = w; }
        if (!DO_NSA) continue;
        f32x4 v[4]; float s = 0.f;
#pragma unroll
        for (int j = 0; j < 4; ++j) { v[j] = *((const f32x4*)(ON + (size_t)t * 1024) + lane + 64 * j); s += v[j].x * v[j].x + v[j].y * v[j].y + v[j].z * v[j].z + v[j].w * v[j].w; }
        const float rstd = 1.f / sqrtf(wave_sum(s) * (1.f / 1024.f) + RMS_EPS);
#pragma unroll
        for (int j = 0; j < 4; ++j) { const f32x4 g4 = ((const f32x4*)ng)[lane + 64 * j]; v2u w; w.x = pk2(v[j].x * rstd * g4.x, v[j].y * rstd * g4.y); w.y = pk2(v[j].z * rstd * g4.z, v[j].w * rstd * g4.w);
            *((v2u*)(A2 + (size_t)t * DM + 1024) + lane + 64 * j) = w; }
    }
}
__device__ __forceinline__ float gelu_tanh(float x) { const float u = 0.7978845608028654f * (x + 0.044715f * x * x * x); const float e = __expf(2.f * u); return 0.5f * x * (1.f + (1.f - 2.f / (e + 1.f))); }
__device__ __forceinline__ void ph_cmp_naive(const Params& p, LAS float* tl, int id, int n) {
    LAS float* hid = tl + 4096;
    const int which = id / (16 * 255), rem = id % (16 * 255), bg = rem / 255, c = rem % 255;
    const bf16* src = (const bf16*)(p.ws + (which ? WS_VC : WS_KC)) + ((size_t)bg * SEQ + 16 * c) * 128;
    const float* pe = p.in[which ? I_PEV : I_PEK]; const float* w1 = p.in[which ? I_WV1 : I_WK1]; const float* w2 = p.in[which ? I_WV2 : I_WK2];
    for (int i = n; i < 4096; i += 128) tl[i] = bf2f(src[i]) + pe[i];
    __syncthreads();
    float a = 0.f;
    for (int k = 0; k < 4096; ++k) a += tl[k] * w1[(size_t)k * 128 + n];
    hid[n] = gelu_tanh(a);
    __syncthreads();
    float o = 0.f;
    for (int m = 0; m < 128; ++m) o += hid[m] * w2[m * 128 + n];
    if (which == 0) ((bf16*)(p.ws + WS_KCMP))[((size_t)bg * 256 + c) * 128 + n] = (bf16)f2bf(o);
    else ((bf16*)(p.ws + WS_VCMPT))[((size_t)bg * 128 + n) * 256 + c] = (bf16)f2bf(o);
}
__device__ __forceinline__ void ph_cmp_fin_simple(const Params& p, LAS float* tl, int id, int n, const float* LHall, const float* PEVall) {
    LAS float* hid = tl + 4096;
    const int which = id / (16 * 255), rem = id % (16 * 255), bg = rem / 255, c = rem % 255;
    const float* w2 = p.in[which ? I_WV2 : I_WK2];
    const float* LH = LHall + ((size_t)which * 4096 + bg * 256) * 256;
    float pev = 0.f;
#pragma unroll 8
    for (int q = 0; q < 64; ++q) pev += PEVall[(size_t)(which * 64 + q) * 128 + n];
    const float a = LH[(size_t)c * 256 + n] + LH[(size_t)(c + 1) * 256 + 128 + n] + pev;
    hid[n] = gelu_tanh(a);
    __syncthreads();
    float o = 0.f;
    for (int m = 0; m < 128; ++m) o += hid[m] * w2[m * 128 + n];
    if (which == 0) ((bf16*)(p.ws + WS_KCMP))[((size_t)bg * 256 + c) * 128 + n] = (bf16)f2bf(o);
    else ((bf16*)(p.ws + WS_VCMPT))[((size_t)bg * 128 + n) * 256 + c] = (bf16)f2bf(o);
}
__device__ __forceinline__ float dot128(const LAS float* q, const bf16* k) {
    float a = 0.f;
#pragma unroll
    for (int i = 0; i < 16; ++i) { const v4u w = ((const v4u*)k)[i];
        a += q[8 * i] * bflo(w.x) + q[8 * i + 1] * bfhi(w.x) + q[8 * i + 2] * bflo(w.y) + q[8 * i + 3] * bfhi(w.y) + q[8 * i + 4] * bflo(w.z) + q[8 * i + 5] * bfhi(w.z) + q[8 * i + 6] * bflo(w.w) + q[8 * i + 7] * bfhi(w.w); }
    return a;
}
__device__ __forceinline__ void ph_nsa_naive(const Params& p, LAS float* base, int vblk, int r, int lane) {
    LAS float (*qf)[128] = (LAS float (*)[128])base; LAS float (*lg)[1024] = (LAS float (*)[1024])(base + 512); LAS unsigned long long& selm = *(LAS unsigned long long*)(base + 512 + 4096);
    const int s = vblk & (SEQ - 1), bg = vblk >> 12, b = bg >> 1, g = bg & 1, h = g * 4 + r;
    const size_t row = (size_t)b * SEQ + s;
    const bf16* NQ = (const bf16*)(p.ws + WS_NQ); const bf16* SM = (const bf16*)(p.ws + WS_SM);
    const bf16* KCMP = (const bf16*)(p.ws + WS_KCMP) + (size_t)bg * 256 * 128; const bf16* VCMPT = (const bf16*)(p.ws + WS_VCMPT) + (size_t)bg * 128 * 256;
    const bf16* KS = (const bf16*)(p.ws + WS_KS) + (size_t)bg * SEQ * 128; const bf16* KW = (const bf16*)(p.ws + WS_KW) + (size_t)bg * SEQ * 128;
    const bf16* VST = (const bf16*)(p.ws + WS_VST) + (size_t)bg * 128 * SEQ; const bf16* VWT = (const bf16*)(p.ws + WS_VWT) + (size_t)bg * 128 * SEQ;
    const float* relb = p.in[I_RELB]; float* ON = (float*)(p.ws + WS_ON);
    qf[r][lane] = bf2f(NQ[row * 1024 + h * 128 + lane]); qf[r][lane + 64] = bf2f(NQ[row * 1024 + h * 128 + lane + 64]);
    __syncthreads();
    const LAS float* q = qf[r]; LAS float* L = lg[r];
    float ot0 = 0.f, ot1 = 0.f;
    const float gt0 = 1.f / (1.f + __expf(-bf2f(SM[row * 64 + 16 + h]))), gt1 = 1.f / (1.f + __expf(-bf2f(SM[row * 64 + 24 + h]))), gt2 = 1.f / (1.f + __expf(-bf2f(SM[row * 64 + 32 + h])));
#define BIAS(dist) relb[(int)kBucket[(dist) > 127 ? 127 : (dist)] * 8 + h]
    const int ncv = (s >= 31) ? ((s - 31) >> 4) + 1 : 0;
    if (ncv > 0) {
        float mx = -3e38f;
        for (int c = lane; c < ncv; c += 64) { const float l = dot128(q, KCMP + (size_t)c * 128) + BIAS(s - (16 * c + 31)); L[c] = l; mx = fmaxf(mx, l); }
        mx = wave_max(mx); float sum = 0.f;
        for (int c = lane; c < ncv; c += 64) { const float e = __expf(L[c] - mx); L[c] = e; sum += e; }
        sum = wave_sum(sum); const float inv = 1.f / sum;
        for (int c = lane; c < ncv; c += 64) L[c] *= inv;
        LDS_WAIT(); __builtin_amdgcn_wave_barrier();
        float o0 = 0.f, o1 = 0.f;
        for (int c = 0; c < ncv; ++c) { const float pr = L[c]; o0 += pr * bf2f(VCMPT[(size_t)lane * 256 + c]); o1 += pr * bf2f(VCMPT[(size_t)(lane + 64) * 256 + c]); }
        ot0 += gt0 * o0; ot1 += gt0 * o1;
    }
    __syncthreads();
    const int cur = s >> 6;
    if (r == 0) { const int n = lane; float sc;
        if (n == 0 || n == cur || n == cur - 1) sc = 1e4f;
        else if (n <= cur) { float im = 0.f; for (int rr = 0; rr < 4; ++rr) for (int c = 4 * n - 1; c <= 4 * n + 3; ++c) if (c >= 0 && c < ncv) im += lg[rr][c]; sc = im; }
        else sc = -1.f;
        int rank = 0;
        for (int m = 0; m < 64; ++m) { const float sm = __shfl(sc, m); rank += (sm > sc || (sm == sc && m < n)) ? 1 : 0; }
        const unsigned long long mk = __ballot(rank < 16);
        if (lane == 0) selm = mk; }
    __syncthreads();
    { unsigned long long mask = selm & (cur == 63 ? ~0ull : ((1ull << (cur + 1)) - 1ull));
      int cnt = 0; float mx = -3e38f;
      for (unsigned long long mm = mask; mm; mm &= mm - 1) { const int n = __builtin_ctzll(mm); const int kpos = n * 64 + lane; float l = -3e38f;
          if (kpos <= s) l = dot128(q, KS + (size_t)kpos * 128) + BIAS(s - kpos);
          L[cnt * 64 + lane] = l; mx = fmaxf(mx, l); ++cnt; }
      mx = wave_max(mx); float sum = 0.f;
      for (int j = 0; j < cnt; ++j) { const float l = L[j * 64 + lane]; const float e = l > -1e38f ? __expf(l - mx) : 0.f; L[j * 64 + lane] = e; sum += e; }
      sum = wave_sum(sum); const float inv = 1.f / sum;
      LDS_WAIT(); __builtin_amdgcn_wave_barrier();
      float o0 = 0.f, o1 = 0.f; int j = 0;
      for (unsigned long long mm = mask; mm; mm &= mm - 1, ++j) { const int n = __builtin_ctzll(mm);
          for (int kk = 0; kk < 64; ++kk) { const float pr = L[j * 64 + kk]; o0 += pr * bf2f(VST[(size_t)lane * SEQ + n * 64 + kk]); o1 += pr * bf2f(VST[(size_t)(lane + 64) * SEQ + n * 64 + kk]); } }
      ot0 += gt1 * o0 * inv; ot1 += gt1 * o1 * inv; }
    LDS_WAIT(); __builtin_amdgcn_wave_barrier();
    { const int lo = s >= 511 ? s - 511 : 0, nk = s - lo + 1; float mx = -3e38f;
      for (int i = lane; i < nk; i += 64) { const int kpos = lo + i; const float l = dot128(q, KW + (size_t)kpos * 128) + BIAS(s - kpos); L[i] = l; mx = fmaxf(mx, l); }
      mx = wave_max(mx); float sum = 0.f;
      for (int i = lane; i < nk; i += 64) { const float e = __expf(L[i] - mx); L[i] = e; sum += e; }
      sum = wave_sum(sum); const float inv = 1.f / sum;
      LDS_WAIT(); __builtin_amdgcn_wave_barrier();
      float o0 = 0.f, o1 = 0.f;
      for (int i = 0; i < nk; ++i) { const float pr = L[i]; o0 += pr * bf2f(VWT[(size_t)lane * SEQ + lo + i]); o1 += pr * bf2f(VWT[(size_t)(lane + 64) * SEQ + lo + i]); }
      ot0 += gt2 * o0 * inv; ot1 += gt2 * o1 * inv; }
#undef BIAS
    ON[row * 1024 + h * 128 + lane] = ot0; ON[row * 1024 + h * 128 + lane + 64] = ot1;
}

namespace nsa {
constexpr int KB0 = 0, KB1 = 16384, VB0 = 32768, VB1 = 49152, LUT = 65536;
constexpr int QST = LUT + 4096, IMP = QST + 65536, SELM = IMP + 16384, LDS_END = SELM + 512;
constexpr float LOG2E = 1.4426950408889634f;
typedef float f4 __attribute__((ext_vector_type(4)));

typedef unsigned u2v __attribute__((ext_vector_type(2)));
__device__ __forceinline__ float rmax16(float x) { const unsigned u = __float_as_uint(x); const u2v r = __builtin_amdgcn_permlane16_swap(u, u, false, false); return fmaxf(__uint_as_float(r[0]), __uint_as_float(r[1])); }
__device__ __forceinline__ float rmax32(float x) { const unsigned u = __float_as_uint(x); const u2v r = __builtin_amdgcn_permlane32_swap(u, u, false, false); return fmaxf(__uint_as_float(r[0]), __uint_as_float(r[1])); }
__device__ __forceinline__ float radd16(float x) { const unsigned u = __float_as_uint(x); const u2v r = __builtin_amdgcn_permlane16_swap(u, u, false, false); return __uint_as_float(r[0]) + __uint_as_float(r[1]); }
__device__ __forceinline__ float radd32(float x) { const unsigned u = __float_as_uint(x); const u2v r = __builtin_amdgcn_permlane32_swap(u, u, false, false); return __uint_as_float(r[0]) + __uint_as_float(r[1]); }
__device__ __forceinline__ float raddq(float x) { x += __int_as_float(__builtin_amdgcn_update_dpp(0, __float_as_int(x), 0xB1, 0xF, 0xF, true)); x += __int_as_float(__builtin_amdgcn_update_dpp(0, __float_as_int(x), 0x4E, 0xF, 0xF, true)); return x; }
struct Ctx {
    LAS unsigned char* lds; int tid, lane, wave, c, gq, r;
    int s0, cur;
    const LAS unsigned char* qst;
    int pos0;
    const LAS float* lutrow;
    int koff0, voff0;
    unsigned kdo[2], vdoc[2], vdos[2];
};
__device__ __forceinline__ void dma_k(const Ctx& C, const bf16* kt, LAS unsigned char* kb) {
#pragma unroll
    for (int i = 0; i < 2; ++i) __builtin_amdgcn_global_load_lds((const unsigned*)((const char*)kt + C.kdo[i]), (LAS unsigned*)(kb + (2 * C.wave + i) * 1024), 16, 0, 0); }
__device__ __forceinline__ void dma_v(const Ctx& C, const bf16* vt, const unsigned (&vdo)[2], LAS unsigned char* vb) {
#pragma unroll
    for (int i = 0; i < 2; ++i) __builtin_amdgcn_global_load_lds((const unsigned*)((const char*)vt + vdo[i]), (LAS unsigned*)(vb + (2 * C.wave + i) * 1024), 16, 0, 0); }

__device__ __forceinline__ void compute_st(const Ctx& C, const LAS unsigned char* kb, f4 (&s)[2][4]) {
#pragma unroll
    for (int ks = 0; ks < 4; ++ks) { const bf16x8 q0 = *(const LAS bf16x8*)(C.qst + ks * 1024), q1 = *(const LAS bf16x8*)(C.qst + (4 + ks) * 1024);
#pragma unroll
        for (int kt = 0; kt < 4; ++kt) { const bf16x8 a = *(const LAS bf16x8*)(kb + kt * 4096 + (C.koff0 ^ (ks * 64)));
            s[0][kt] = __builtin_amdgcn_mfma_f32_16x16x32_bf16(a, q0, ks == 0 ? (f4){0.f, 0.f, 0.f, 0.f} : s[0][kt], 0, 0, 0);
            s[1][kt] = __builtin_amdgcn_mfma_f32_16x16x32_bf16(a, q1, ks == 0 ? (f4){0.f, 0.f, 0.f, 0.f} : s[1][kt], 0, 0, 0); }
        asm volatile("" ::: "memory"); }
}
__device__ __forceinline__ void compute_pv(const Ctx& C, const LAS unsigned char* vb, const f4 (&p)[2][4], f4 (&o)[2][8]) {
#pragma unroll
    for (int i = 0; i < 2; ++i) { bf16x8 pb[2];
#pragma unroll
        for (int qt = 0; qt < 2; ++qt) { v4u w; w.x = pg8::cvt_pk_bf16(p[qt][2 * i][0], p[qt][2 * i][1]); w.y = pg8::cvt_pk_bf16(p[qt][2 * i][2], p[qt][2 * i][3]);
            w.z = pg8::cvt_pk_bf16(p[qt][2 * i + 1][0], p[qt][2 * i + 1][1]); w.w = pg8::cvt_pk_bf16(p[qt][2 * i + 1][2], p[qt][2 * i + 1][3]); pb[qt] = __builtin_bit_cast(bf16x8, w); }
#pragma unroll
        for (int dt = 0; dt < 8; ++dt) { const v2u lo = *(const LAS v2u*)(vb + dt * 2048 + (C.voff0 ^ (i * 64))), hi = *(const LAS v2u*)(vb + dt * 2048 + (C.voff0 ^ (i * 64 + 32))); const bf16x8 a = __builtin_bit_cast(bf16x8, (v4u){lo.x, lo.y, hi.x, hi.y});
#pragma unroll
            for (int qt = 0; qt < 2; ++qt) o[qt][dt] = __builtin_amdgcn_mfma_f32_16x16x32_bf16(a, pb[qt], o[qt][dt], 0, 0, 0);
            if (dt & 1) asm volatile("" ::: "memory"); } }
}
enum { M_CMP = 0, M_SEL = 1, M_WIN = 2 };
template <int MODE, bool FAR = false>
__device__ __forceinline__ void mask_bias(const Ctx& C, f4 (&s)[2][4], int kb, int n, const LAS unsigned* selw) {
    const float NEG = -__builtin_inff();
#pragma unroll
    for (int qt = 0; qt < 2; ++qt) {
        bool tokok = true;
        if (MODE == M_SEL) tokok = ((selw[(4 * qt + (C.c >> 2)) * 2 + (n >> 5)] >> (n & 31)) & 1u) != 0u;
        if (FAR) { const float be = tokok ? C.lutrow[127] : NEG;
#pragma unroll
            for (int kt = 0; kt < 4; ++kt)
#pragma unroll
                for (int rg = 0; rg < 4; ++rg) s[qt][kt][rg] = __builtin_fmaf(s[qt][kt][rg], LOG2E, be);
            continue; }
        const int dbase = (MODE == M_CMP) ? (C.pos0 + 4 * qt - 31 - 16 * (kb + 4 * C.gq)) : (C.pos0 + 4 * qt - (kb + 4 * C.gq));
#pragma unroll
        for (int kt = 0; kt < 4; ++kt) {
#pragma unroll
            for (int rg = 0; rg < 4; ++rg) { const int d = (MODE == M_CMP) ? dbase - 16 * (16 * kt + rg) : dbase - (16 * kt + rg);
                int di = d < 0 ? 0 : d; di = di > 127 ? 127 : di; const float bias = C.lutrow[di];
                bool ok = tokok && d >= 0; if (MODE == M_WIN) ok = ok && d < 512;
                s[qt][kt][rg] = ok ? __builtin_fmaf(s[qt][kt][rg], LOG2E, bias) : NEG; }
            asm volatile("" ::: "memory"); }
    }
}
__device__ __forceinline__ void softmax_step(f4 (&s)[2][4], float (&m)[2], float (&l)[2], f4 (&o)[2][8], bool rescale_o) {
#pragma unroll
    for (int qt = 0; qt < 2; ++qt) { float mx = s[qt][0][0];
#pragma unroll
        for (int kt = 0; kt < 4; ++kt)
#pragma unroll
            for (int rg = 0; rg < 4; ++rg) mx = fmaxf(mx, s[qt][kt][rg]);
        mx = rmax32(rmax16(mx));
        const float mn = fmaxf(m[qt], mx), alpha = __builtin_amdgcn_exp2f(m[qt] - mn); m[qt] = mn; float ps = 0.f;
#pragma unroll
        for (int kt = 0; kt < 4; ++kt)
#pragma unroll
            for (int rg = 0; rg < 4; ++rg) { const float e = __builtin_amdgcn_exp2f(s[qt][kt][rg] - mn); s[qt][kt][rg] = e; ps += e; }
        l[qt] = l[qt] * alpha + ps;
        if (rescale_o && __any(alpha != 1.f)) {
#pragma unroll
            for (int dt = 0; dt < 8; ++dt) o[qt][dt] = o[qt][dt] * alpha; }
    }
}
}

__device__ __forceinline__ void ph_nsa(const Params& p, LAS unsigned char* lds, int idx0, int idxstride, int tid_in, int wave) {
    using namespace nsa;
    int tid = tid_in; asm volatile("" : "+v"(tid));
    const int lane = tid & 63;
    Ctx C; C.lds = lds; C.tid = tid; C.lane = lane; C.wave = wave; C.c = lane & 15; C.gq = lane >> 4; C.r = lane & 3;
    C.koff0 = C.c * 256 + ((C.gq ^ C.c) * 16);
#pragma unroll
    for (int i = 0; i < 2; ++i) { const int piece = 2 * wave + i;
        { const int row = piece * 4 + (lane >> 4), chunk = (lane & 15) ^ (row & 15); C.kdo[i] = (unsigned)(row * 256 + chunk * 16); }
        { const int row = piece * 8 + (lane >> 3), chunk = (lane & 7) ^ ((row >> 1) & 7); C.vdoc[i] = (unsigned)(row * 256 * 2 + chunk * 16); C.vdos[i] = (unsigned)(row * SEQ * 2 + chunk * 16); } }
    C.voff0 = C.c * 128 + (((C.gq >> 1) ^ ((C.c >> 1) & 7)) * 16) + (C.gq & 1) * 8;
    const bf16* NQ = (const bf16*)(p.ws + WS_NQ); const bf16* SM = (const bf16*)(p.ws + WS_SM); bf16* A2 = (bf16*)(p.ws + WS_A2);
    const float* relb = p.in[I_RELB]; const float* nsag = p.in[I_NSAG];
    LAS float* lut = (LAS float*)(lds + LUT);
    for (int i = tid; i < 8 * 128; i += 512) { const int hh = i >> 7, d = i & 127; lut[i] = relb[(int)kBucket[d] * 8 + hh] * LOG2E; }
    __syncthreads();
    LAS unsigned char* qstw = lds + QST + wave * 8192 + lane * 16; C.qst = qstw;
    LAS float* imp = (LAS float*)(lds + IMP + wave * 2048);
    LAS unsigned long long* selm = (LAS unsigned long long*)(lds + SELM + wave * 64);
#define NSA_SYNC() do { asm volatile("s_waitcnt vmcnt(0)" ::: "memory"); __syncthreads(); } while (0)
    for (int idx = idx0; idx < 512; idx += idxstride) {
        const int rnd = idx >> 8, kq = idx & 255, b = kq & 7, tq = rnd == 0 ? 63 - (kq >> 3) : (kq >> 3);
        C.s0 = tq * 64; C.cur = tq;
        const int tokl0 = 8 * wave + (C.c >> 2);
        C.pos0 = C.s0 + tokl0;
        float ssq[2] = {0.f, 0.f};
        for (int g = 0; g < 2; ++g) {
            const int bg = b * 2 + g, h = g * 4 + C.r;
            C.lutrow = lut + h * 128;
            const bf16* KCMP = (const bf16*)(p.ws + WS_KCMP) + (size_t)bg * 256 * 128; const bf16* VCMPT = (const bf16*)(p.ws + WS_VCMPT) + (size_t)bg * 128 * 256;
#pragma unroll
            for (int qt = 0; qt < 2; ++qt) { const unsigned qo = (unsigned)(((b * SEQ + (C.pos0 + 4 * qt)) * 1024 + h * 128 + 8 * C.gq) * 2);
#pragma unroll
                for (int ks = 0; ks < 4; ++ks) *(LAS bf16x8*)(qstw + (qt * 4 + ks) * 1024) = *(const bf16x8*)((const char*)NQ + qo + ks * 64); }
#pragma unroll
            for (int i = 0; i < 2; ++i) *(LAS f32x4*)((LAS unsigned char*)imp + lane * 16 + i * 1024) = (f32x4){0.f, 0.f, 0.f, 0.f};
#define NSA_OROW(qt) ((char*)A2 + (unsigned)(((b * SEQ + C.pos0 + 4 * (qt)) * DM + 1024 + h * 128 + 4 * C.gq) * 2))
            const int cmaxb = C.s0 + 63 - 31; const int nct = cmaxb >= 0 ? ((cmaxb >> 4) >> 6) + 1 : 0;
            float m[2] = {-1e30f, -1e30f}, l[2] = {0.f, 0.f};
            f4 o[2][8];
            if (nct > 0) {
                dma_k(C, KCMP, lds + KB0); NSA_SYNC();
                for (int ct = 0; ct < nct; ++ct) { const int buf = ct & 1;
                    if (ct + 1 < nct) dma_k(C, KCMP + (ct + 1) * 64 * 128, lds + (buf ? KB0 : KB1));
                    f4 s[2][4]; compute_st(C, lds + (buf ? KB1 : KB0), s); mask_bias<M_CMP>(C, s, 64 * ct, 0, (const LAS unsigned*)selm); softmax_step(s, m, l, o, false);
                    NSA_SYNC(); }
            }
            float inv[2];
#pragma unroll
            for (int qt = 0; qt < 2; ++qt) { const float lt = radd32(radd16(l[qt])); inv[qt] = lt > 0.f ? 1.f / lt : 0.f; }
#pragma unroll
            for (int qt = 0; qt < 2; ++qt)
#pragma unroll
                for (int dt = 0; dt < 8; ++dt) o[qt][dt] = (f4){0.f, 0.f, 0.f, 0.f};
            if (nct > 0) {
                dma_k(C, KCMP, lds + KB0); dma_v(C, VCMPT, C.vdoc, lds + VB0); NSA_SYNC();
                for (int ct = 0; ct < nct; ++ct) { const int buf = ct & 1;
                    if (ct + 1 < nct) { dma_k(C, KCMP + (ct + 1) * 64 * 128, lds + (buf ? KB0 : KB1)); dma_v(C, VCMPT + 64 * (ct + 1), C.vdoc, lds + (buf ? VB0 : VB1)); }
                    f4 s[2][4]; compute_st(C, lds + (buf ? KB1 : KB0), s); mask_bias<M_CMP>(C, s, 64 * ct, 0, (const LAS unsigned*)selm);
#pragma unroll
                    for (int qt = 0; qt < 2; ++qt)
#pragma unroll
                        for (int kt = 0; kt < 4; ++kt) {
#pragma unroll
                            for (int rg = 0; rg < 4; ++rg) s[qt][kt][rg] = __builtin_amdgcn_exp2f(s[qt][kt][rg] - m[qt]) * inv[qt];
                            float po = (s[qt][kt][0] + s[qt][kt][1]) + (s[qt][kt][2] + s[qt][kt][3]), p3 = s[qt][kt][3];
                            po = raddq(po); p3 = raddq(p3);
                            const int nb = 16 * ct + 4 * kt + C.gq, tl = 4 * qt + (C.c >> 2);
                            if (C.r == 0) { __hip_atomic_fetch_add((float*)(imp + tl * 64 + nb), po, __ATOMIC_RELAXED, __HIP_MEMORY_SCOPE_WORKGROUP); if (nb + 1 < 64) __hip_atomic_fetch_add((float*)(imp + tl * 64 + nb + 1), p3, __ATOMIC_RELAXED, __HIP_MEMORY_SCOPE_WORKGROUP); } }
                    compute_pv(C, lds + (buf ? VB1 : VB0), s, o);
                    NSA_SYNC(); }
            }
            LDS_WAIT(); __builtin_amdgcn_wave_barrier();
            for (int tk = 0; tk < 8; ++tk) { const int n = lane; float sc;
                if (n == 0 || n == C.cur || n == C.cur - 1) sc = 1e4f; else if (n <= C.cur) sc = imp[tk * 64 + n]; else sc = -1.f;
                const int key = ((sc < 0.f ? 0 : __float_as_int(sc) + 64) & ~63) | (63 - n);
                int rank = 0;
#pragma unroll
                for (int mm = 0; mm < 64; ++mm) rank += (__builtin_amdgcn_readlane(key, mm) > key) ? 1 : 0;
                const unsigned long long mk = __ballot(rank < 16);
                if (lane == 0) selm[tk] = mk; }
            LDS_WAIT(); __builtin_amdgcn_wave_barrier();
#pragma unroll
            for (int qt = 0; qt < 2; ++qt) { const float gt = 1.f / (1.f + __expf(-bf2f(*(const bf16*)((const char*)SM + (unsigned)(((b * SEQ + (C.pos0 + 4 * qt)) * 64 + 16 + h) * 2)))));
#pragma unroll
                for (int dt = 0; dt < 8; ++dt) { const f4 v = o[qt][dt] * gt; *(v2u*)(NSA_OROW(qt) + 32 * dt) = (v2u){pg8::cvt_pk_bf16(v[0], v[1]), pg8::cvt_pk_bf16(v[2], v[3])}; } }
#pragma unroll
            for (int br = 1; br <= 2; ++br) {
                const bf16* KX = (const bf16*)(p.ws + (br == 1 ? WS_KS : WS_KW)) + bg * SEQ * 128; const bf16* VX = (const bf16*)(p.ws + (br == 1 ? WS_VST : WS_VWT)) + bg * 128 * SEQ;
                const int n0 = br == 1 ? 0 : (C.cur >= 8 ? C.cur - 8 : 0), n1 = C.cur;
                m[0] = m[1] = -1e30f; l[0] = l[1] = 0.f;
#pragma unroll
                for (int qt = 0; qt < 2; ++qt)
#pragma unroll
                    for (int dt = 0; dt < 8; ++dt) o[qt][dt] = (f4){0.f, 0.f, 0.f, 0.f};
                int f0 = n1 + 1, f1 = n0 - 1;
                for (int n = n0; n <= n1; ++n) { const bool fa = (C.s0 - (64 * n + 63) >= 113) && (br == 1 || (C.s0 + 63 - 64 * n) < 512); if (fa) { f0 = n < f0 ? n : f0; f1 = n; } }
                const int cntf = f1 >= f0 ? f1 - f0 + 1 : 0, cnt = n1 - n0 + 1, nlo = cntf ? f0 - n0 : cnt;
#define NSA_TILE(i) ((i) < cntf ? f0 + (i) : (((i) - cntf) < nlo ? n0 + ((i) - cntf) : f1 + 1 + ((i) - cntf - nlo)))
#define NSA_BODY(FARF) { const int n = NSA_TILE(i); const int buf = i & 1; \
                    if (i + 1 < cnt) { const int nn = NSA_TILE(i + 1); dma_k(C, KX + nn * 64 * 128, lds + (buf ? KB0 : KB1)); dma_v(C, VX + 64 * nn, C.vdos, lds + (buf ? VB0 : VB1)); } \
                    bool need = true; \
                    if (br == 1) { const unsigned any = ((const LAS unsigned*)selm)[(lane & 7) * 2 + (n >> 5)] >> (n & 31); need = __any((int)(any & 1u)); } \
                    if (need) { f4 s[2][4]; compute_st(C, lds + (buf ? KB1 : KB0), s); \
                        if (br == 1) mask_bias<M_SEL, FARF>(C, s, 64 * n, n, (const LAS unsigned*)selm); else mask_bias<M_WIN, FARF>(C, s, 64 * n, n, (const LAS unsigned*)selm); \
                        softmax_step(s, m, l, o, true); compute_pv(C, lds + (buf ? VB1 : VB0), s, o); } \
                    NSA_SYNC(); }
                { const int nf = NSA_TILE(0); dma_k(C, KX + nf * 64 * 128, lds + KB0); dma_v(C, VX + 64 * nf, C.vdos, lds + VB0); NSA_SYNC(); }
                int i = 0;
                for (; i < cntf; ++i) NSA_BODY(true)
                for (; i < cnt; ++i) NSA_BODY(false)
#undef NSA_BODY
#undef NSA_TILE
                asm volatile("s_waitcnt vmcnt(0)" ::: "memory");
#pragma unroll
                for (int qt = 0; qt < 2; ++qt) { const float lt = radd32(radd16(l[qt]));
                    const int row = b * SEQ + (C.pos0 + 4 * qt);
                    const float sc = (1.f / (1.f + __expf(-bf2f(*(const bf16*)((const char*)SM + (unsigned)((row * 64 + 16 + 8 * br + h) * 2)))))) / lt;
#pragma unroll
                    for (int dt = 0; dt < 8; ++dt) { const f4 v = o[qt][dt] * sc; v2u* sp = (v2u*)(NSA_OROW(qt) + 32 * dt); const v2u pv = *sp;
                        const float a0 = bflo(pv.x) + v[0], a1 = bfhi(pv.x) + v[1], a2 = bflo(pv.y) + v[2], a3 = bfhi(pv.y) + v[3];
                        if (br == 2) ssq[qt] += (a0 * a0 + a1 * a1) + (a2 * a2 + a3 * a3);
                        *sp = (v2u){pg8::cvt_pk_bf16(a0, a1), pg8::cvt_pk_bf16(a2, a3)}; } }
            }
        }
        float rstd[2];
#pragma unroll
        for (int qt = 0; qt < 2; ++qt) { const float t = radd32(radd16(raddq(ssq[qt]))); rstd[qt] = 1.f / sqrtf(t * (1.f / 1024.f) + RMS_EPS); }
        asm volatile("s_waitcnt vmcnt(0)" ::: "memory");
#pragma unroll
        for (int qt = 0; qt < 2; ++qt) { const int sub = C.r * 4 + C.gq; bf16* orow = (bf16*)((char*)A2 + (unsigned)(((b * SEQ + (C.pos0 + 4 * qt)) * DM + 1024) * 2 + sub * 16)); const int subz = 0;
#pragma unroll
            for (int j = 0; j < 8; ++j) { const int col = (j * 16 + subz) * 8; v4u w = *(const v4u*)((const char*)orow + (unsigned)(col * 2)); const f32x4 g0 = *(const f32x4*)((const char*)nsag + (unsigned)(col * 4 + sub * 32)), g1 = *(const f32x4*)((const char*)nsag + (unsigned)(col * 4 + sub * 32 + 16)); const float rs = rstd[qt];
                w.x = pk2(bflo(w.x) * rs * g0.x, bfhi(w.x) * rs * g0.y); w.y = pk2(bflo(w.y) * rs * g0.z, bfhi(w.y) * rs * g0.w); w.z = pk2(bflo(w.z) * rs * g1.x, bfhi(w.z) * rs * g1.y); w.w = pk2(bflo(w.w) * rs * g1.z, bfhi(w.w) * rs * g1.w);
                *(v4u*)((char*)orow + (unsigned)(col * 2)) = w; } }
        NSA_SYNC();
    }
#undef NSA_SYNC
#undef NSA_OROW
}

constexpr size_t WS_ST = WS_LA;
constexpr size_t WS_DEC = WS_ST + (size_t)2048 * 256 * 128 * 2;
static_assert(WS_DEC + (size_t)2048 * 128 * 4 <= WS_KCMP, "gla scratch overlay");
namespace gla {
typedef float f4 __attribute__((ext_vector_type(4)));
constexpr int L_ST = 0, L_KT = 65536, L_QT = 81920, L_VT = 98304, L_GA = 131072, L_GT = L_GA + 4096, L_RED = L_GT + 2048, L_END = L_RED + 512;
__device__ __forceinline__ void chunk_cumsum(const Params& p, LAS unsigned char* lds, int tid, int t0, int h, float (&P)[16], float& blast) {
    const bf16* SM = (const bf16*)(p.ws + WS_SM); const float* wa2 = p.in[I_WA2]; const float* ba = p.in[I_BA];
    LAS float* ga = (LAS float*)(lds + L_GA); LAS float* gt = (LAS float*)(lds + L_GT);
    if (tid < 128) { const int j = tid >> 1, hf = tid & 1; const v4u w = *(const v4u*)((const char*)SM + (unsigned)(((t0 + j) * 64 + hf * 8) * 2));
        LAS float* d = ga + j * 16 + hf * 8; d[0] = bflo(w.x); d[1] = bfhi(w.x); d[2] = bflo(w.y); d[3] = bfhi(w.y); d[4] = bflo(w.z); d[5] = bfhi(w.z); d[6] = bflo(w.w); d[7] = bfhi(w.w); }
    const int dk = tid & 127, jq = tid >> 7;
    float w[16];
#pragma unroll
    for (int r = 0; r < 16; ++r) w[r] = wa2[r * 512 + h * 128 + dk];
    const float bb = ba[h * 128 + dk];
    __syncthreads();
    float run = 0.f;
#pragma unroll
    for (int jj = 0; jj < 16; ++jj) { const LAS f32x4* gr = (const LAS f32x4*)(ga + (16 * jq + jj) * 16); float z = bb;
#pragma unroll
        for (int r4 = 0; r4 < 4; ++r4) { const f32x4 g4 = gr[r4]; z += g4.x * w[4 * r4] + g4.y * w[4 * r4 + 1] + g4.z * w[4 * r4 + 2] + g4.w * w[4 * r4 + 3]; }
        run += (fminf(z, 0.f) - log1pf(__expf(-fabsf(z)))) * (1.f / 16.f); P[jj] = run; }
    gt[jq * 128 + dk] = run;
    __syncthreads();
    float off = 0.f, tot = 0.f;
#pragma unroll
    for (int q = 0; q < 4; ++q) { const float t = gt[q * 128 + dk]; tot += t; if (q < jq) off += t; }
#pragma unroll
    for (int jj = 0; jj < 16; ++jj) P[jj] += off;
    blast = tot;
}
__device__ __forceinline__ void fill_vt(const Params& p, LAS unsigned char* lds, int tid, int t0, int h) {
    const bf16* GV = (const bf16*)(p.ws + WS_GV); const int dv = tid & 255, jh = tid >> 8;
    const char* src = (const char*)GV + (unsigned)(((t0 + 32 * jh) * 1024 + h * 256 + dv) * 2);
    unsigned short v[32];
#pragma unroll
    for (int jj = 0; jj < 32; ++jj) v[jj] = *(const bf16*)(src + jj * 2048);
    LAS unsigned char* row = lds + L_VT + dv * 128; const int f = (dv >> 1) & 7;
#pragma unroll
    for (int q = 0; q < 4; ++q) { v4u w; w.x = v[8 * q] | ((unsigned)v[8 * q + 1] << 16); w.y = v[8 * q + 2] | ((unsigned)v[8 * q + 3] << 16); w.z = v[8 * q + 4] | ((unsigned)v[8 * q + 5] << 16); w.w = v[8 * q + 6] | ((unsigned)v[8 * q + 7] << 16);
        *(LAS v4u*)(row + (((4 * jh + q) ^ f) * 16)) = w; }
}
}

__device__ __forceinline__ void ph_gla_a(const Params& p, LAS unsigned char* lds, int u0, int ustride, int tid_in, int wave) {
    using namespace gla;
    int tid = tid_in; asm volatile("" : "+v"(tid));
    const int lane = tid & 63, c = lane & 15, gq = lane >> 4;
    const bf16* GK = (const bf16*)(p.ws + WS_GK); bf16* ST = (bf16*)(p.ws + WS_ST); float* DEC = (float*)(p.ws + WS_DEC);
    for (int unit = u0; unit < 2048; unit += ustride) {
        const int bh = unit >> 6, ch = unit & 63, b = bh >> 2, h = bh & 3, t0 = b * SEQ + ch * 64;
        float P[16], blast; chunk_cumsum(p, lds, tid, t0, h, P, blast);
        { const int dk = tid & 127, jq = tid >> 7; const char* src = (const char*)GK + (unsigned)(((t0 + 16 * jq) * 512 + h * 128 + dk) * 2);
          unsigned short kv[16];
#pragma unroll
          for (int jj = 0; jj < 16; ++jj) kv[jj] = *(const bf16*)(src + jj * 1024);
          unsigned pk[8];
#pragma unroll
          for (int q = 0; q < 8; ++q) pk[q] = pk2(bf2f(kv[2 * q]) * __expf(blast - P[2 * q]), bf2f(kv[2 * q + 1]) * __expf(blast - P[2 * q + 1]));
          LAS unsigned char* row = lds + L_KT + dk * 128; const int f = (dk >> 1) & 7;
          *(LAS v4u*)(row + (((2 * jq) ^ f) * 16)) = (v4u){pk[0], pk[1], pk[2], pk[3]}; *(LAS v4u*)(row + (((2 * jq + 1) ^ f) * 16)) = (v4u){pk[4], pk[5], pk[6], pk[7]};
          if (jq == 0) DEC[unit * 128 + dk] = __expf(blast); }
        fill_vt(p, lds, tid, t0, h);
        __syncthreads();
        f4 acc[16];
        const int f = (c >> 1) & 7;
        bf16x8 aF[2];
#pragma unroll
        for (int ks = 0; ks < 2; ++ks) aF[ks] = *(const LAS bf16x8*)(lds + L_KT + (16 * wave + c) * 128 + (((4 * ks + gq) ^ f) * 16));
#pragma unroll
        for (int nt = 0; nt < 16; ++nt) { acc[nt] = (f4){0.f, 0.f, 0.f, 0.f};
#pragma unroll
            for (int ks = 0; ks < 2; ++ks) { const bf16x8 bF = *(const LAS bf16x8*)(lds + L_VT + (16 * nt + c) * 128 + (((4 * ks + gq) ^ f) * 16)); acc[nt] = __builtin_amdgcn_mfma_f32_16x16x32_bf16(aF[ks], bF, acc[nt], 0, 0, 0); } }
        char* dst = (char*)ST + (size_t)unit * (256 * 128 * 2) + (unsigned)((c * 128 + 16 * wave + 4 * gq) * 2);
#pragma unroll
        for (int nt = 0; nt < 16; ++nt) *(v2u*)(dst + nt * 16 * 256) = (v2u){pg8::cvt_pk_bf16(acc[nt][0], acc[nt][1]), pg8::cvt_pk_bf16(acc[nt][2], acc[nt][3])};
        __syncthreads();
    }
}
__device__ __forceinline__ void ph_gla_b(const Params& p, int gid, int gstride) {
    bf16* ST = (bf16*)(p.ws + WS_ST); const float* DEC = (const float*)(p.ws + WS_DEC);
    for (int e = gid; e < 32 * 4096; e += gstride) { const int bh = e >> 12, dv = (e >> 4) & 255, d8 = e & 15;
        float st[8];
#pragma unroll
        for (int i = 0; i < 8; ++i) st[i] = 0.f;
        char* base = (char*)ST + (size_t)bh * 64 * (256 * 128 * 2) + (unsigned)((dv * 128 + d8 * 8) * 2); const float* dbase = DEC + (size_t)bh * 64 * 128 + d8 * 8;
#pragma unroll 4
        for (int ch = 0; ch < 64; ++ch) { v4u* ptr = (v4u*)(base + (size_t)ch * (256 * 128 * 2)); const v4u w = *ptr; const f32x4 d0 = *(const f32x4*)(dbase + ch * 128), d1 = *(const f32x4*)(dbase + ch * 128 + 4);
            v4u o; o.x = pk2(st[0], st[1]); o.y = pk2(st[2], st[3]); o.z = pk2(st[4], st[5]); o.w = pk2(st[6], st[7]); *ptr = o;
            st[0] = st[0] * d0.x + bflo(w.x); st[1] = st[1] * d0.y + bfhi(w.x); st[2] = st[2] * d0.z + bflo(w.y); st[3] = st[3] * d0.w + bfhi(w.y);
            st[4] = st[4] * d1.x + bflo(w.z); st[5] = st[5] * d1.y + bfhi(w.z); st[6] = st[6] * d1.z + bflo(w.w); st[7] = st[7] * d1.w + bfhi(w.w); }
    }
}
__device__ __forceinline__ void ph_gla_c(const Params& p, LAS unsigned char* lds, int u0, int ustride, int tid_in, int wave) {
    using namespace gla;
    int tid = tid_in; asm volatile("" : "+v"(tid));
    const int lane = tid & 63, c = lane & 15, gq = lane >> 4, nt = wave & 3, half = wave >> 2;
    const bf16* GQ = (const bf16*)(p.ws + WS_GQ); const bf16* GK = (const bf16*)(p.ws + WS_GK); const bf16* GG = (const bf16*)(p.ws + WS_GG); const bf16* ST = (const bf16*)(p.ws + WS_ST);
    bf16* A2 = (bf16*)(p.ws + WS_A2); const float* gn = p.in[I_GLAG];
    const int koff0 = c * 256 + ((gq ^ c) * 16), voff0 = c * 128 + (((gq >> 1) ^ ((c >> 1) & 7)) * 16) + (gq & 1) * 8;
    for (int unit = u0; unit < 2048; unit += ustride) {
        const int bh = unit >> 6, ch = unit & 63, b = bh >> 2, h = bh & 3, t0 = b * SEQ + ch * 64;
        { const char* src = (const char*)ST + (size_t)unit * (256 * 128 * 2);
#pragma unroll
          for (int i = 0; i < 8; ++i) { const int piece = 8 * wave + i, row = piece * 4 + (lane >> 4), chunk = (lane & 15) ^ (row & 15);
              __builtin_amdgcn_global_load_lds((const unsigned*)(src + (unsigned)(row * 256 + chunk * 16)), (LAS unsigned*)(lds + L_ST + piece * 1024), 16, 0, 0); } }
        float P[16], blast; chunk_cumsum(p, lds, tid, t0, h, P, blast);
        { const int dk = tid & 127, jq = tid >> 7; const unsigned so = (unsigned)(((t0 + 16 * jq) * 512 + h * 128 + dk) * 2);
#pragma unroll
          for (int jj = 0; jj < 16; ++jj) { const int j = 16 * jq + jj; const float qv = bf2f(*(const bf16*)((const char*)GQ + so + jj * 1024)), kv = bf2f(*(const bf16*)((const char*)GK + so + jj * 1024));
              const int off = j * 256 + (((dk >> 3) ^ (j & 15)) * 16) + (dk & 7) * 2;
              *(LAS bf16*)(lds + L_QT + off) = (bf16)f2bf(qv * __expf(P[jj])); *(LAS bf16*)(lds + L_KT + off) = (bf16)f2bf(kv * __expf(-P[jj])); } }
        fill_vt(p, lds, tid, t0, h);
        asm volatile("s_waitcnt vmcnt(0)" ::: "memory"); __syncthreads();
        bf16x8 qF[4];
#pragma unroll
        for (int ks = 0; ks < 4; ++ks) qF[ks] = *(const LAS bf16x8*)(lds + L_QT + nt * 4096 + (koff0 ^ (ks * 64)));
        f4 sT[4];
#pragma unroll
        for (int jt = 0; jt < 4; ++jt) { sT[jt] = (f4){0.f, 0.f, 0.f, 0.f};
            if (jt <= nt) {
#pragma unroll
                for (int ks = 0; ks < 4; ++ks) { const bf16x8 a = *(const LAS bf16x8*)(lds + L_KT + jt * 4096 + (koff0 ^ (ks * 64))); sT[jt] = __builtin_amdgcn_mfma_f32_16x16x32_bf16(a, qF[ks], sT[jt], 0, 0, 0); }
                if (jt == nt) {
#pragma unroll
                    for (int rg = 0; rg < 4; ++rg) if (4 * gq + rg > c) sT[jt][rg] = 0.f; } } }
        bf16x8 pb[2];
#pragma unroll
        for (int s = 0; s < 2; ++s) { v4u w; w.x = pg8::cvt_pk_bf16(sT[2 * s][0], sT[2 * s][1]); w.y = pg8::cvt_pk_bf16(sT[2 * s][2], sT[2 * s][3]); w.z = pg8::cvt_pk_bf16(sT[2 * s + 1][0], sT[2 * s + 1][1]); w.w = pg8::cvt_pk_bf16(sT[2 * s + 1][2], sT[2 * s + 1][3]); pb[s] = __builtin_bit_cast(bf16x8, w); }
        f4 o[8]; float ss = 0.f;
#pragma unroll
        for (int mt = 0; mt < 8; ++mt) { o[mt] = (f4){0.f, 0.f, 0.f, 0.f}; const int rb = 128 * half + 16 * mt;
#pragma unroll
            for (int ks = 0; ks < 4; ++ks) { const bf16x8 a = *(const LAS bf16x8*)(lds + L_ST + rb * 256 + (koff0 ^ (ks * 64))); o[mt] = __builtin_amdgcn_mfma_f32_16x16x32_bf16(a, qF[ks], o[mt], 0, 0, 0); }
#pragma unroll
            for (int s = 0; s < 2; ++s) if (2 * s <= nt) { const v2u lo = *(const LAS v2u*)(lds + L_VT + rb * 128 + (voff0 ^ (s * 64))), hi = *(const LAS v2u*)(lds + L_VT + rb * 128 + (voff0 ^ (s * 64 + 32)));
                o[mt] = __builtin_amdgcn_mfma_f32_16x16x32_bf16(__builtin_bit_cast(bf16x8, (v4u){lo.x, lo.y, hi.x, hi.y}), pb[s], o[mt], 0, 0, 0); }
            ss += (o[mt][0] * o[mt][0] + o[mt][1] * o[mt][1]) + (o[mt][2] * o[mt][2] + o[mt][3] * o[mt][3]); }
        ss = nsa::radd32(nsa::radd16(ss));
        LAS float* red = (LAS float*)(lds + L_RED);
        if (gq == 0) red[half * 64 + 16 * nt + c] = ss;
        __syncthreads();
        const float rstd = 1.f / sqrtf((red[16 * nt + c] + red[64 + 16 * nt + c]) * (1.f / 256.f) + RMS_EPS);
        const int tok = t0 + 16 * nt + c;
#pragma unroll
        for (int mt = 0; mt < 8; ++mt) { const int dv = 128 * half + 16 * mt + 4 * gq; const f32x4 g4 = *(const f32x4*)((const char*)gn + (unsigned)(dv * 4));
            const v2u gg = *(const v2u*)((const char*)GG + (unsigned)((tok * 1024 + h * 256 + dv) * 2));
            const float z0 = bflo(gg.x), z1 = bfhi(gg.x), z2 = bflo(gg.y), z3 = bfhi(gg.y);
            v2u w; w.x = pg8::cvt_pk_bf16(o[mt][0] * rstd * g4.x * (z0 / (1.f + __expf(-z0))), o[mt][1] * rstd * g4.y * (z1 / (1.f + __expf(-z1))));
            w.y = pg8::cvt_pk_bf16(o[mt][2] * rstd * g4.z * (z2 / (1.f + __expf(-z2))), o[mt][3] * rstd * g4.w * (z3 / (1.f + __expf(-z3))));
            *(v2u*)((char*)A2 + (unsigned)((tok * DM + h * 256 + dv) * 2)) = w; }
        __syncthreads();
    }
}

constexpr size_t WS_LH = WS_DEC + (size_t)2048 * 128 * 4;
constexpr size_t WS_PEV = WS_LH + (size_t)2 * 4096 * 256 * 4;
static_assert(WS_PEV + 1024 <= WS_KCMP, "cmp scratch overlay");
struct CmpOrder {
    int c; const bf16 *kc, *vc, *wk, *wv;
    __device__ __forceinline__ bool next(int i, pg8::Unit& u) const { if (i > 0 || c >= 32) return false; u.pm = c & 15; u.pn = 0; u.kind = c >> 4; return true; }
    __device__ __forceinline__ const char* pa(const pg8::Gemm&, const pg8::Unit& u) const { return (const char*)(u.kind ? vc : kc) + (size_t)u.pm * ((size_t)256 * 2048 * 2); }
    __device__ __forceinline__ const char* pb(const pg8::Gemm&, const pg8::Unit& u) const { return (const char*)(u.kind ? wv : wk); }
    __device__ __forceinline__ void a_ready(const pg8::Unit&) const {}
    __device__ __forceinline__ void done(const pg8::Unit&) const {}
};
struct EpiLH {
    static constexpr bool PERM = false, AFTER_DRAIN = false;
    float* LH;
    __device__ __forceinline__ void operator()(const pg8::f32x4 (&acc)[2][2][4][2], const pg8::Unit& u, int wr, int wc, int fr, int fq) const {
        const int row0 = u.kind * 4096 + u.pm * 256 + wr * 64 + fr, col0 = wc * 32 + 4 * fq;
#pragma unroll
        for (int ai = 0; ai < 2; ++ai)
#pragma unroll
            for (int m = 0; m < 4; ++m) { float* rowp = LH + (size_t)(row0 + ai * 128 + m * 16) * 256 + col0;
#pragma unroll
                for (int bj = 0; bj < 2; ++bj)
#pragma unroll
                    for (int n = 0; n < 2; ++n) *(pg8::f32x4*)(rowp + bj * 128 + n * 16) = acc[ai][bj][m][n]; }
    }
};
__device__ __forceinline__ void cmp_pevec(const Params& p, LAS unsigned char* lds, int which, int tid) {
    const float* pe = p.in[which ? I_PEV : I_PEK]; const float* w1 = p.in[which ? I_WV1 : I_WK1]; LAS float* part = (LAS float*)lds;
    const int m = tid & 127, q = tid >> 7; float a = 0.f;
    __syncthreads();
    for (int k = q * 1024; k < q * 1024 + 1024; ++k) a += pe[k] * w1[(size_t)k * 128 + m];
    part[q * 128 + m] = a; __syncthreads();
    if (tid < 128) ((float*)(p.ws + WS_PEV))[which * 128 + tid] = (part[tid] + part[128 + tid]) + (part[256 + tid] + part[384 + tid]);
    __syncthreads();
}
__device__ __forceinline__ void cmp_finalize(const Params& p, LAS unsigned char* lds, int which, int bg, int tid_in, int wave) {
    int tid = tid_in; asm volatile("" : "+v"(tid));
    const int lane = tid & 63, c15 = lane & 15, gq = lane >> 4;
    constexpr int L_HID = 0, L_W2T = 65536;
    const float* LH = (const float*)(p.ws + WS_LH) + ((size_t)which * 4096 + bg * 256) * 256; const float* pev = (const float*)(p.ws + WS_PEV) + which * 128; const float* w2 = p.in[which ? I_WV2 : I_WK2];
    asm volatile("s_waitcnt vmcnt(0)" ::: "memory"); __syncthreads();
#pragma unroll
    for (int i = 0; i < 8; ++i) { const int id = tid + 512 * i, c = id >> 4, ch = id & 15; v4u w = (v4u){0u, 0u, 0u, 0u};
        if (c < 255) { const float* lp = LH + (size_t)c * 256 + 8 * ch; const float* hp = LH + (size_t)(c + 1) * 256 + 128 + 8 * ch;
            const f32x4 l0 = *(const f32x4*)lp, l1 = *(const f32x4*)(lp + 4), h0 = *(const f32x4*)hp, h1 = *(const f32x4*)(hp + 4), e0 = *(const f32x4*)(pev + 8 * ch), e1 = *(const f32x4*)(pev + 8 * ch + 4);
            w.x = pk2(gelu_tanh(l0.x + h0.x + e0.x), gelu_tanh(l0.y + h0.y + e0.y)); w.y = pk2(gelu_tanh(l0.z + h0.z + e0.z), gelu_tanh(l0.w + h0.w + e0.w));
            w.z = pk2(gelu_tanh(l1.x + h1.x + e1.x), gelu_tanh(l1.y + h1.y + e1.y)); w.w = pk2(gelu_tanh(l1.z + h1.z + e1.z), gelu_tanh(l1.w + h1.w + e1.w)); }
        *(LAS v4u*)(lds + L_HID + c * 256 + ((ch ^ (c & 15)) * 16)) = w; }
#pragma unroll 8
    for (int i = 0; i < 32; ++i) { const int id = tid + 512 * i, m = id >> 7, n = id & 127;
        *(LAS bf16*)(lds + L_W2T + n * 256 + (((m >> 3) ^ (n & 15)) * 16) + (m & 7) * 2) = (bf16)f2bf(w2[id]); }
    __syncthreads();
    const int koff0 = c15 * 256 + ((gq ^ c15) * 16);
    bf16* KCMP = (bf16*)(p.ws + WS_KCMP) + (size_t)bg * 256 * 128; bf16* VCMPT = (bf16*)(p.ws + WS_VCMPT) + (size_t)bg * 128 * 256;
#pragma unroll
    for (int ci = 0; ci < 2; ++ci) { const int ctile = 2 * wave + ci;
        bf16x8 hF[4];
#pragma unroll
        for (int ks = 0; ks < 4; ++ks) hF[ks] = *(const LAS bf16x8*)(lds + L_HID + ctile * 4096 + (koff0 ^ (ks * 64)));
#pragma unroll
        for (int ntile = 0; ntile < 8; ++ntile) { pg8::f32x4 d = (pg8::f32x4){0.f, 0.f, 0.f, 0.f};
#pragma unroll
            for (int ks = 0; ks < 4; ++ks) { const bf16x8 wF = *(const LAS bf16x8*)(lds + L_W2T + ntile * 4096 + (koff0 ^ (ks * 64)));
                d = which ? __builtin_amdgcn_mfma_f32_16x16x32_bf16(hF[ks], wF, d, 0, 0, 0) : __builtin_amdgcn_mfma_f32_16x16x32_bf16(wF, hF[ks], d, 0, 0, 0); }
            const v2u w = (v2u){pg8::cvt_pk_bf16(d[0], d[1]), pg8::cvt_pk_bf16(d[2], d[3])};
            if (which) *(v2u*)(VCMPT + (size_t)(16 * ntile + c15) * 256 + 16 * ctile + 4 * gq) = w;
            else *(v2u*)(KCMP + (size_t)(16 * ctile + c15) * 128 + 16 * ntile + 4 * gq) = w; } }
    __syncthreads();
}

constexpr size_t PROWS = (size_t)MAXTILES * 256;
constexpr size_t WS_W1Q = WS_W1T;
constexpr size_t WS_W2Q = WS_W1Q + (size_t)NE * 4096 * DM;
constexpr size_t WS_HN8 = WS_W2Q + (size_t)NE * DM * DFF;
constexpr size_t WS_AMAXP = WS_HN8 + (size_t)T * DM;
constexpr size_t WS_WSC1 = WS_AMAXP + PROWS * 64 * 4;
constexpr size_t WS_WSC2 = WS_WSC1 + (size_t)NE * 4096 * 4;
constexpr size_t WS_HSC = WS_WSC2 + (size_t)NE * 2048 * 4;
constexpr size_t WS_ROWSC = WS_HSC + (size_t)T * 4;
constexpr size_t WS_ASC = WS_ROWSC + PROWS * 4;
static_assert(WS_ASC + PROWS * 4 <= WS_XN, "int8 buffers fit in the retired bf16 expert-weight region");
constexpr size_t WS_XG8 = WS_XG;
constexpr size_t WS_ACT8 = WS_XG + PROWS * DM;
constexpr size_t WS_Y = WS_ACT;
static_assert(WS_ACT8 + PROWS * DM <= WS_ACT, "int8 row buffers fit in the retired gathered-row region");

__device__ __forceinline__ unsigned q8(float v) { int q = (int)rintf(v); q = q > 127 ? 127 : (q < -127 ? -127 : q); return (unsigned)q & 0xffu; }
__device__ __forceinline__ unsigned q8x4(float a, float b, float c, float d) { return q8(a) | (q8(b) << 8) | (q8(c) << 16) | (q8(d) << 24); }

constexpr size_t WS_WINQ = WS_WINT;
constexpr size_t WS_WISC = WS_WINT + (size_t)NPT * 256 * DM;
constexpr size_t WS_XN8 = WS_XN;
constexpr size_t WS_XSC = WS_XN + (size_t)T * DM;
constexpr size_t WS_PMAX = WS_HN;
constexpr size_t WS_PMAXI = WS_PMAX + (size_t)64 * 8 * 4096 * 4;
__device__ __forceinline__ void p0_absmax(const Params& p, int bid, int G, int tid) {
    float* PMAX = (float*)(p.ws + WS_PMAX);
    for (int it = bid; it < 8; it += G) {
        const float* src = p.in[I_WIN] + (size_t)it * 256 * 5672; float* dst = (float*)(p.ws + WS_PMAXI) + (size_t)it * 5696;
#pragma unroll
        for (int q = 0; q < 3; ++q) { const int c4 = tid + 512 * q; if (c4 < 1418) { f32x4 m0 = (f32x4){0.f, 0.f, 0.f, 0.f};
#pragma unroll 8
            for (int r = 0; r < 256; ++r) { const f32x4 a = *(const f32x4*)(src + (size_t)r * 5672 + c4 * 4); m0.x = fmaxf(m0.x, fabsf(a.x)); m0.y = fmaxf(m0.y, fabsf(a.y)); m0.z = fmaxf(m0.z, fabsf(a.z)); m0.w = fmaxf(m0.w, fabsf(a.w)); }
            *(f32x4*)(dst + c4 * 4) = m0; } } }
    for (int it = bid; it < 64 * 8; it += G) { const int mi = it >> 3, rb = it & 7, e = mi >> 1; const bool isw2 = mi & 1;
        if (!isw2) { const float* src = p.in[I_W1] + (size_t)e * DM * 4096 + (size_t)rb * 256 * 4096 + tid * 8; f32x4 m0 = (f32x4){0.f, 0.f, 0.f, 0.f}, m1 = m0;
#pragma unroll 8
            for (int r = 0; r < 256; ++r) { const f32x4 a = __builtin_nontemporal_load((const f32x4*)(src + (size_t)r * 4096)), b = __builtin_nontemporal_load((const f32x4*)(src + (size_t)r * 4096 + 4));
                m0.x = fmaxf(m0.x, fabsf(a.x)); m0.y = fmaxf(m0.y, fabsf(a.y)); m0.z = fmaxf(m0.z, fabsf(a.z)); m0.w = fmaxf(m0.w, fabsf(a.w));
                m1.x = fmaxf(m1.x, fabsf(b.x)); m1.y = fmaxf(m1.y, fabsf(b.y)); m1.z = fmaxf(m1.z, fabsf(b.z)); m1.w = fmaxf(m1.w, fabsf(b.w)); }
            float* d = PMAX + (size_t)it * 4096 + tid * 8; *(f32x4*)d = m0; *(f32x4*)(d + 4) = m1; }
        else { const float* src = p.in[I_W2] + (size_t)e * DFF * DM + (size_t)rb * 256 * 2048 + tid * 4; f32x4 m0 = (f32x4){0.f, 0.f, 0.f, 0.f};
#pragma unroll 8
            for (int r = 0; r < 256; ++r) { const f32x4 a = __builtin_nontemporal_load((const f32x4*)(src + (size_t)r * 2048));
                m0.x = fmaxf(m0.x, fabsf(a.x)); m0.y = fmaxf(m0.y, fabsf(a.y)); m0.z = fmaxf(m0.z, fabsf(a.z)); m0.w = fmaxf(m0.w, fabsf(a.w)); }
            *(f32x4*)(PMAX + (size_t)it * 4096 + tid * 4) = m0; } }
}
__device__ __forceinline__ void p0_quant(const Params& p, LAS unsigned char* lds, int gw, int NGW, int wave, int lane) {
    LAS float* scr = (LAS float*)(lds + wave * 16896);
    const float* PMAX = (const float*)(p.ws + WS_PMAX);
    signed char* W1Q = (signed char*)(p.ws + WS_W1Q); signed char* W2Q = (signed char*)(p.ws + WS_W2Q); float* WSC1 = (float*)(p.ws + WS_WSC1); float* WSC2 = (float*)(p.ws + WS_WSC2);
    for (int it = gw; it < 16 * 178; it += NGW) {
        const int kb = it / 178, nb = it % 178, n0 = nb * 32, k0 = kb * 128; const int nl = n0 + (lane & 31); const bool okc = nl < 5672;
        const float* W = p.in[I_WIN] + (size_t)k0 * 5672 + (okc ? nl : 0) + (size_t)(lane >> 5) * 5672;
        float w[64];
#pragma unroll
        for (int i = 0; i < 64; ++i) w[i] = W[(size_t)(2 * i) * 5672];
        float mx = 0.f;
#pragma unroll
        for (int q = 0; q < 8; ++q) mx = fmaxf(mx, ((const float*)(p.ws + WS_PMAXI))[(size_t)q * 5696 + (okc ? nl : 0)]);
        const float sc = mx > 0.f ? mx * (1.f / 127.f) : 1.f, ivl = 1.f / sc; float qsc; const int rowl = okc ? win_row(nl, qsc) : -1;
        if (kb == 0 && lane < 32 && okc) ((float*)(p.ws + WS_WISC))[rowl] = sc * qsc;
#pragma unroll
        for (int i = 0; i < 64; ++i) scr[(2 * i + (lane >> 5)) * 33 + (lane & 31)] = w[i];
        LDS_WAIT(); asm volatile("" ::: "memory");
        const int c = lane & 7;
#pragma unroll
        for (int j = 0; j < 4; ++j) { const int nn = (lane >> 3) + 8 * j; const float iv = __shfl(ivl, nn); const int rown = __shfl(rowl, nn); const LAS float* s = scr + (16 * c) * 33 + nn; v4u o;
            o.x = q8x4(s[0] * iv, s[33] * iv, s[66] * iv, s[99] * iv); o.y = q8x4(s[132] * iv, s[165] * iv, s[198] * iv, s[231] * iv);
            o.z = q8x4(s[264] * iv, s[297] * iv, s[330] * iv, s[363] * iv); o.w = q8x4(s[396] * iv, s[429] * iv, s[462] * iv, s[495] * iv);
            if (rown >= 0) *(v4u*)((signed char*)(p.ws + WS_WINQ) + (size_t)rown * 2048 + k0 + 16 * c) = o; }
        LDS_WAIT(); asm volatile("" ::: "memory"); }
    for (int it = gw; it < NE * 3072; it += NGW) { const int e = it / 3072; int r = it % 3072; const bool isw2 = r >= 2048; if (isw2) r -= 2048;
        const int nbs = isw2 ? 64 : 128, kb = r / nbs, nb = r % nbs, N = isw2 ? 2048 : 4096, n0 = nb * 32, k0 = kb * 128, mi = e * 2 + (isw2 ? 1 : 0);
        const float* W = (isw2 ? p.in[I_W2] + (size_t)e * DFF * DM : p.in[I_W1] + (size_t)e * DM * 4096) + (size_t)k0 * N + n0 + (lane & 31) + (size_t)(lane >> 5) * N;
        float w[64];
#pragma unroll
        for (int i = 0; i < 64; ++i) w[i] = __builtin_nontemporal_load(&W[(size_t)(2 * i) * N]);
        float mx = 0.f;
#pragma unroll
        for (int q = 0; q < 8; ++q) mx = fmaxf(mx, PMAX[((size_t)mi * 8 + q) * 4096 + n0 + (lane & 31)]);
        const float sc = mx > 0.f ? mx * (1.f / 127.f) : 1.f, ivl = 1.f / sc;
        const int nl = n0 + (lane & 31), j2l = nl & 2047; const int rowl = isw2 ? nl : (j2l >> 7) * 256 + (nl >= 2048 ? 128 : 0) + (j2l & 127);
        if (kb == 0 && lane < 32) { if (isw2) WSC2[e * 2048 + rowl] = sc; else WSC1[e * 4096 + rowl] = sc; }
#pragma unroll
        for (int i = 0; i < 64; ++i) scr[(2 * i + (lane >> 5)) * 33 + (lane & 31)] = w[i];
        LDS_WAIT(); asm volatile("" ::: "memory");
        const int c = lane & 7;
#pragma unroll
        for (int j = 0; j < 4; ++j) { const int nn = (lane >> 3) + 8 * j; const float iv = __shfl(ivl, nn); const int rown = __shfl(rowl, nn); const LAS float* s = scr + (16 * c) * 33 + nn; v4u o;
            o.x = q8x4(s[0] * iv, s[33] * iv, s[66] * iv, s[99] * iv); o.y = q8x4(s[132] * iv, s[165] * iv, s[198] * iv, s[231] * iv);
            o.z = q8x4(s[264] * iv, s[297] * iv, s[330] * iv, s[363] * iv); o.w = q8x4(s[396] * iv, s[429] * iv, s[462] * iv, s[495] * iv);
            signed char* dst = (isw2 ? W2Q + ((size_t)e * 2048 + rown) * 2048 : W1Q + ((size_t)e * 4096 + rown) * 2048);
            *(v4u*)(dst + k0 + 16 * c) = o; }
        LDS_WAIT(); asm volatile("" ::: "memory"); }
}
struct EpiSwigluI8 {
    static constexpr bool PERM = true, AFTER_DRAIN = false;
    const float* b1; const float* rowsc; const float* wsc1; bf16* act; float* amaxp;
    __device__ __forceinline__ void operator()(const pg8::f32x4 (&acc)[2][2][4][2], const pg8::Unit& u, int wr, int wc, int fr, int fq) const {
        const int e = u.kind; const int cin = wc * 32 + 8 * fq; const int col = u.pn * 128 + cin; const int row0 = u.pm * 256 + wr * 64 + fr;
        const float* bg = b1 + (size_t)e * 4096 + col; const float* bl = bg + 2048; const float* sg = wsc1 + (size_t)e * 4096 + u.pn * 256 + cin; const float* sl = sg + 128;
        float gb[8], lb[8], gs[8], ls[8];
#pragma unroll
        for (int j = 0; j < 8; ++j) { gb[j] = bg[j]; lb[j] = bl[j]; gs[j] = sg[j]; ls[j] = sl[j]; }
#pragma unroll
        for (int ai = 0; ai < 2; ++ai)
#pragma unroll
            for (int m = 0; m < 4; ++m) { const int r = row0 + ai * 128 + m * 16; const float rs = rowsc[r]; float o[8]; float mx = 0.f;
#pragma unroll
                for (int n = 0; n < 2; ++n)
#pragma unroll
                    for (int j = 0; j < 4; ++j) { float gl = (float)__float_as_int(acc[ai][0][m][n][j]) * (rs * gs[n * 4 + j]) + gb[n * 4 + j]; float li = (float)__float_as_int(acc[ai][1][m][n][j]) * (rs * ls[n * 4 + j]) + lb[n * 4 + j];
                        gl = fminf(gl, 7.f); li = fminf(fmaxf(li, -7.f), 7.f);
                        const float v = gl * __builtin_amdgcn_rcpf(1.f + __builtin_amdgcn_exp2f(-2.4554669595930156f * gl)) * (li + 1.f); o[n * 4 + j] = v; mx = fmaxf(mx, fabsf(v)); }
                mx = nsa::rmax32(nsa::rmax16(mx));
                if (fq == 0) amaxp[(size_t)r * 64 + u.pn * 4 + wc] = mx;
                pg8::u32x4 w; w.x = pg8::cvt_pk_bf16(o[0], o[1]); w.y = pg8::cvt_pk_bf16(o[2], o[3]); w.z = pg8::cvt_pk_bf16(o[4], o[5]); w.w = pg8::cvt_pk_bf16(o[6], o[7]);
                *(pg8::u32x4*)(act + (size_t)r * DFF + col) = w; }
    }
};
__device__ __forceinline__ void ph_actq(const Params& p, int gw, int NGW, int lane) {
    const int nrows = ((const int*)(p.ws + WS_META))[0] * 256; const float* amaxp = (const float*)(p.ws + WS_AMAXP); const bf16* act = (const bf16*)(p.ws + WS_ACT);
    signed char* A8 = (signed char*)(p.ws + WS_ACT8); float* ASC = (float*)(p.ws + WS_ASC);
    for (int r = gw; r < nrows; r += NGW) { const float mx = wave_max(amaxp[(size_t)r * 64 + lane]); const float sc = mx > 0.f ? mx * (1.f / 127.f) : 1.f, iv = 1.f / sc;
        const v4u* src = (const v4u*)(act + (size_t)r * DFF) + lane * 4; v4u a[4];
#pragma unroll
        for (int j = 0; j < 4; ++j) a[j] = src[j];
        v4u o[2];
#pragma unroll
        for (int h = 0; h < 2; ++h) { const v4u x = a[2 * h], y = a[2 * h + 1];
            o[h].x = q8x4(bflo(x.x) * iv, bfhi(x.x) * iv, bflo(x.y) * iv, bfhi(x.y) * iv); o[h].y = q8x4(bflo(x.z) * iv, bfhi(x.z) * iv, bflo(x.w) * iv, bfhi(x.w) * iv);
            o[h].z = q8x4(bflo(y.x) * iv, bfhi(y.x) * iv, bflo(y.y) * iv, bfhi(y.y) * iv); o[h].w = q8x4(bflo(y.z) * iv, bfhi(y.z) * iv, bflo(y.w) * iv, bfhi(y.w) * iv); }
        v4u* dst = (v4u*)(A8 + (size_t)r * DFF) + lane * 2; dst[0] = o[0]; dst[1] = o[1];
        if (lane == 0) ASC[r] = sc; }
}
struct EpiDownI8 {
    static constexpr bool PERM = true, AFTER_DRAIN = false;
    const float* b2; const float* roww; const float* asc; const float* wsc2; bf16* y;
    __device__ __forceinline__ void operator()(const pg8::f32x4 (&acc)[2][2][4][2], const pg8::Unit& u, int wr, int wc, int fr, int fq) const {
        const int e = u.kind; const int col0 = u.pn * 256 + wc * 32 + 8 * fq; const int row0 = u.pm * 256 + wr * 64 + fr;
        float bv[2][8], sv[2][8];
#pragma unroll
        for (int bj = 0; bj < 2; ++bj)
#pragma unroll
            for (int j = 0; j < 8; ++j) { bv[bj][j] = b2[(size_t)e * DM + col0 + bj * 128 + j]; sv[bj][j] = wsc2[(size_t)e * DM + col0 + bj * 128 + j]; }
#pragma unroll
        for (int ai = 0; ai < 2; ++ai)
#pragma unroll
            for (int m = 0; m < 4; ++m) { const int r = row0 + ai * 128 + m * 16; const float g = roww[r], as = asc[r];
#pragma unroll
                for (int bj = 0; bj < 2; ++bj) { float o[8];
#pragma unroll
                    for (int n = 0; n < 2; ++n)
#pragma unroll
                        for (int j = 0; j < 4; ++j) o[n * 4 + j] = ((float)__float_as_int(acc[ai][bj][m][n][j]) * (as * sv[bj][n * 4 + j]) + bv[bj][n * 4 + j]) * g;
                    pg8::u32x4 w; w.x = pg8::cvt_pk_bf16(o[0], o[1]); w.y = pg8::cvt_pk_bf16(o[2], o[3]); w.z = pg8::cvt_pk_bf16(o[4], o[5]); w.w = pg8::cvt_pk_bf16(o[6], o[7]);
                    *(pg8::u32x4*)(y + (size_t)r * DM + col0 + bj * 128) = w; } }
    }
};

struct EpiProjI8 {
    static constexpr bool PERM = true, AFTER_DRAIN = false;
    unsigned char* ws;
    __device__ __forceinline__ void operator()(const pg8::f32x4 (&acc)[2][2][4][2], const pg8::Unit& u, int wr, int wc, int fr, int fq) const {
        const int cw = wc * 32 + 8 * fq; const float* XSC = (const float*)(ws + WS_XSC); const float* WISC = (const float*)(ws + WS_WISC);
        if (u.kind == 0) {
            const int tn = u.pn; bf16* base; size_t bjs = 128; int ld = 0; bool headmajor = false; bool small = false;
            if (tn < 2) { base = (bf16*)(ws + WS_GQ) + tn * 256; ld = 512; }
            else if (tn < 4) { base = (bf16*)(ws + WS_GK) + (tn - 2) * 256; ld = 512; }
            else if (tn < 8) { base = (bf16*)(ws + WS_GV) + (tn - 4) * 256; ld = 1024; }
            else if (tn < 12) { base = (bf16*)(ws + WS_GG) + (tn - 8) * 256; ld = 1024; }
            else if (tn < 16) { base = (bf16*)(ws + WS_NQ) + (tn - 12) * 256; ld = 1024; }
            else if (tn < 20) { base = (bf16*)(ws + (tn == 16 ? WS_KC : tn == 17 ? WS_VC : tn == 18 ? WS_KS : WS_KW)); headmajor = true; bjs = (size_t)SEQ * 128; }
            else { base = (bf16*)(ws + WS_SM); ld = 64; small = true; }
            if (small && wc >= 2) return;
            float cs[2][8];
#pragma unroll
            for (int bj = 0; bj < 2; ++bj)
#pragma unroll
                for (int j = 0; j < 8; ++j) cs[bj][j] = WISC[tn * 256 + bj * 128 + cw + j];
#pragma unroll
            for (int ai = 0; ai < 2; ++ai)
#pragma unroll
                for (int m = 0; m < 4; ++m) { const int r = u.pm * 256 + ai * 128 + wr * 64 + m * 16 + fr; const float rs = XSC[r];
                    const size_t rterm = headmajor ? ((size_t)(r >> 12) * 2 * SEQ + (r & (SEQ - 1))) * 128 : (size_t)r * ld;
#pragma unroll
                    for (int bj = 0; bj < 2; ++bj) { if (small && bj) continue; float o[8];
#pragma unroll
                        for (int n = 0; n < 2; ++n)
#pragma unroll
                            for (int j = 0; j < 4; ++j) o[n * 4 + j] = (float)__float_as_int(acc[ai][bj][m][n][j]) * (rs * cs[bj][n * 4 + j]);
                        pg8::u32x4 w; w.x = pg8::cvt_pk_bf16(o[0], o[1]); w.y = pg8::cvt_pk_bf16(o[2], o[3]); w.z = pg8::cvt_pk_bf16(o[4], o[5]); w.w = pg8::cvt_pk_bf16(o[6], o[7]);
                        *(pg8::u32x4*)(base + rterm + bj * bjs + cw) = w; } }
        } else {
            bf16* base = (bf16*)(ws + (u.pn == 21 ? WS_VST : WS_VWT));
#pragma unroll
            for (int ai = 0; ai < 2; ++ai)
#pragma unroll
                for (int m = 0; m < 4; ++m) { const int dh = wr * 64 + m * 16 + fr; const float ws_ = WISC[u.pn * 256 + ai * 128 + dh];
#pragma unroll
                    for (int bj = 0; bj < 2; ++bj) { const int tok = u.pm * 256 + bj * 128 + cw; const int b = tok >> 12, s = tok & (SEQ - 1); float o[8];
                        const pg8::f32x4 x0 = *(const pg8::f32x4*)(XSC + tok), x1 = *(const pg8::f32x4*)(XSC + tok + 4);
#pragma unroll
                        for (int j = 0; j < 4; ++j) { o[j] = (float)__float_as_int(acc[ai][bj][m][0][j]) * (ws_ * x0[j]); o[4 + j] = (float)__float_as_int(acc[ai][bj][m][1][j]) * (ws_ * x1[j]); }
                        pg8::u32x4 w; w.x = pg8::cvt_pk_bf16(o[0], o[1]); w.y = pg8::cvt_pk_bf16(o[2], o[3]); w.z = pg8::cvt_pk_bf16(o[4], o[5]); w.w = pg8::cvt_pk_bf16(o[6], o[7]);
                        *(pg8::u32x4*)(base + ((size_t)(b * 2 + ai) * 128 + dh) * SEQ + s) = w; } }
        }
    }
};

__device__ __forceinline__ void r1_router(const Params& p, LAS unsigned char* lds, int vb, int tid, int wave, int lane) {
    LAS float* rowbuf = (LAS float*)lds;
    LAS float* part = (LAS float*)(lds + 65536);
    LAS int* tk = (LAS int*)(lds + 81920 + wave * 1024);
    LAS int* cntw = (LAS int*)(lds + 90112);
    const float* h = p.out; const float* gf = p.in[I_NFFN]; const float* rw = p.in[I_RW]; const float* rb = p.in[I_RB];
    signed char* HN8 = (signed char*)(p.ws + WS_HN8);
    const int e = lane & 31, eg = tid & 31, dg = tid >> 5; int mycount = 0;
    float rwr[128];
#pragma unroll
    for (int c4 = 0; c4 < 4; ++c4) { unsigned o = (unsigned)((((dg * 128 + c4 * 32) * 32) + eg) * 4); asm volatile("" : "+v"(o));
#pragma unroll
        for (int i = 0; i < 32; ++i) rwr[c4 * 32 + i] = *(const float*)((const char*)rw + o + i * 128); }
    for (int grp = 0; grp < 16; ++grp) { const int t = vb * TPV + grp * 8 + wave;
        { const f32x4* xr = (const f32x4*)(h + (size_t)t * DM) + lane; f32x4 v[8]; float s = 0.f;
#pragma unroll
          for (int j = 0; j < 8; ++j) { v[j] = xr[64 * j]; s += (v[j].x * v[j].x + v[j].y * v[j].y) + (v[j].z * v[j].z + v[j].w * v[j].w); }
          const float rstd = 1.f / sqrtf(wave_sum(s) * (1.f / DM) + RMS_EPS);
          float mxr = 0.f; LAS f32x4* hrow = (LAS f32x4*)(rowbuf + wave * 2048);
#pragma unroll
          for (int j = 0; j < 8; ++j) { const f32x4 g4 = ((const f32x4*)gf)[lane + 64 * j]; f32x4 y; y.x = v[j].x * rstd * g4.x; y.y = v[j].y * rstd * g4.y; y.z = v[j].z * rstd * g4.z; y.w = v[j].w * rstd * g4.w;
              v[j] = y; hrow[lane + 64 * j] = y; mxr = fmaxf(mxr, fmaxf(fmaxf(fabsf(y.x), fabsf(y.y)), fmaxf(fabsf(y.z), fabsf(y.w)))); }
          mxr = wave_max(mxr); const float qs = mxr > 0.f ? mxr * (1.f / 127.f) : 1.f, qi = 1.f / qs;
          unsigned* o4 = (unsigned*)(HN8 + (size_t)t * DM) + lane;
#pragma unroll
          for (int j = 0; j < 8; ++j) o4[64 * j] = q8x4(v[j].x * qi, v[j].y * qi, v[j].z * qi, v[j].w * qi);
          if (lane == 0) ((float*)(p.ws + WS_HSC))[t] = qs; }
        __syncthreads();
        { float acc[8];
#pragma unroll
          for (int tt = 0; tt < 8; ++tt) acc[tt] = 0.f;
#pragma unroll
          for (int i4 = 0; i4 < 32; ++i4) { f32x4 xv[8];
#pragma unroll
              for (int tt = 0; tt < 8; ++tt) xv[tt] = *(const LAS f32x4*)(rowbuf + tt * 2048 + dg * 128 + 4 * i4);
#pragma unroll
              for (int tt = 0; tt < 8; ++tt) acc[tt] += xv[tt].x * rwr[4 * i4] + xv[tt].y * rwr[4 * i4 + 1] + xv[tt].z * rwr[4 * i4 + 2] + xv[tt].w * rwr[4 * i4 + 3];
              if (i4 & 1) asm volatile("" ::: "memory"); }
#pragma unroll
          for (int tt = 0; tt < 8; ++tt) part[(dg * 8 + tt) * 32 + eg] = acc[tt]; }
        __syncthreads();
        { float a = rb[e];
#pragma unroll
          for (int q = 0; q < 16; ++q) a += part[(q * 8 + wave) * 32 + e];
          int rank = 0;
#pragma unroll
          for (int mm = 0; mm < 32; ++mm) { const float lm = __shfl(a, mm); rank += (lm > a || (lm == a && mm < e)) ? 1 : 0; }
          const float mx = wave_max(a); const bool sel = rank < 4;
          const float ex = (sel && lane < 32) ? __expf(a - mx) : 0.f; const float sum = wave_sum(ex);
          if (sel && lane < 32) { LAS int* q = tk + (grp * 4 + rank) * 4; q[0] = e; q[1] = mycount; q[2] = __builtin_bit_cast(int, ex / sum); ++mycount; } }
        __syncthreads();
    }
    if (lane < 32) cntw[wave * 32 + lane] = mycount;
    __syncthreads();
    if (wave == 0 && lane < 32) { int tot = 0; for (int w = 0; w < 8; ++w) tot += cntw[w * 32 + lane]; ((int*)(p.ws + WS_CNT))[vb * 32 + lane] = tot; }
    { const int i = lane >> 2, k = lane & 3; const LAS int* q = tk + (i * 4 + k) * 4; const int ee = q[0]; int base = 0; for (int w = 0; w < wave; ++w) base += cntw[w * 32 + ee];
      const int t = vb * TPV + i * 8 + wave;
      ((int*)(p.ws + WS_EIDX))[t * 4 + k] = ee; ((int*)(p.ws + WS_LRNK))[t * 4 + k] = base + q[1]; ((int*)(p.ws + WS_GATE))[t * 4 + k] = q[2]; }
    __syncthreads();
}
__device__ __forceinline__ void r2_gather(const Params& p, LAS unsigned char* lds, int vb, bool write_meta, int tid, int wave, int lane) {
    LAS int* part_tot = (LAS int*)lds;
    LAS int* part_base = part_tot + 512;
    LAS int* pbase = part_base + 512;
    const int* CNT = (const int*)(p.ws + WS_CNT);
    { const int e = tid & 31, part = tid >> 5; int tot = 0, bs = 0;
      for (int v = part * 16; v < part * 16 + 16; ++v) { const int c = CNT[v * 32 + e]; tot += c; if (v < vb) bs += c; }
      part_tot[part * 32 + e] = tot; part_base[part * 32 + e] = bs; }
    __syncthreads();
    if (tid == 0) { int ps = 0; int* meta = (int*)(p.ws + WS_META); int nt = 0;
        for (int e = 0; e < 32; ++e) { int tot = 0, bs = 0; for (int q = 0; q < 16; ++q) { tot += part_tot[q * 32 + e]; bs += part_base[q * 32 + e]; }
            pbase[e] = ps + bs; const int ntile = (tot + 255) >> 8;
            if (write_meta) for (int q = 0; q < ntile; ++q) meta[64 + nt + q] = e;
            nt += ntile; ps += ntile * 256; }
        if (write_meta) meta[0] = nt; }
    __syncthreads();
    const signed char* HN8 = (const signed char*)(p.ws + WS_HN8); signed char* XG8 = (signed char*)(p.ws + WS_XG8); const float* HSC = (const float*)(p.ws + WS_HSC); float* ROWSC = (float*)(p.ws + WS_ROWSC);
    const int* EIDX = (const int*)(p.ws + WS_EIDX); const int* LRNK = (const int*)(p.ws + WS_LRNK); const float* GATE = (const float*)(p.ws + WS_GATE);
    int* POS = (int*)(p.ws + WS_POS); float* ROWW = (float*)(p.ws + WS_ROWW);
    for (int i0 = 0; i0 < 16; i0 += 4) {
        v4u v0[4], v1[4]; float hs[4]; int ee[4][4], lr[4][4]; float gt[4][4];
#pragma unroll
        for (int u = 0; u < 4; ++u) { const int t = vb * TPV + (i0 + u) * 8 + wave; const v4u* src = (const v4u*)(HN8 + (size_t)t * DM) + lane; v0[u] = src[0]; v1[u] = src[64]; hs[u] = HSC[t];
#pragma unroll
            for (int k = 0; k < 4; ++k) { ee[u][k] = EIDX[t * 4 + k]; lr[u][k] = LRNK[t * 4 + k]; gt[u][k] = GATE[t * 4 + k]; } }
#pragma unroll
        for (int u = 0; u < 4; ++u) { const int t = vb * TPV + (i0 + u) * 8 + wave;
#pragma unroll
            for (int k = 0; k < 4; ++k) { const int pos = pbase[ee[u][k]] + lr[u][k];
                if (lane == 0) { POS[t * 4 + k] = pos; ROWW[pos] = gt[u][k]; ROWSC[pos] = hs[u]; }
                v4u* dst = (v4u*)(XG8 + (size_t)pos * DM) + lane; dst[0] = v0[u]; dst[64] = v1[u]; } } }
    __syncthreads();
}
__device__ __forceinline__ void pf_final(const Params& p, int gw, int NGW, int lane) {
    const bf16* Y = (const bf16*)(p.ws + WS_Y); const int* POS = (const int*)(p.ws + WS_POS); const float* gfin = p.in[I_NFIN];
    for (int t = gw; t < T; t += NGW) {
        f32x4* xr = (f32x4*)(p.out + (size_t)t * DM) + lane; f32x4 v[8];
#pragma unroll
        for (int j = 0; j < 8; ++j) v[j] = xr[64 * j];
#pragma unroll
        for (int k = 0; k < 4; ++k) { const int pos = POS[t * 4 + k]; const v2u* yr = (const v2u*)(Y + (size_t)pos * DM) + lane;
#pragma unroll
            for (int j = 0; j < 8; ++j) { const v2u w = yr[64 * j]; v[j].x += bflo(w.x); v[j].y += bfhi(w.x); v[j].z += bflo(w.y); v[j].w += bfhi(w.y); } }
        float s = 0.f;
#pragma unroll
        for (int j = 0; j < 8; ++j) s += (v[j].x * v[j].x + v[j].y * v[j].y) + (v[j].z * v[j].z + v[j].w * v[j].w);
        const float rstd = 1.f / sqrtf(wave_sum(s) * (1.f / DM) + RMS_EPS);
#pragma unroll
        for (int j = 0; j < 8; ++j) { const f32x4 g4 = ((const f32x4*)gfin)[lane + 64 * j]; f32x4 o; o.x = v[j].x * rstd * g4.x; o.y = v[j].y * rstd * g4.y; o.z = v[j].z * rstd * g4.z; o.w = v[j].w * rstd * g4.w; xr[64 * j] = o; }
    }
}


constexpr int LDS_BYTES = 159744;
constexpr int MISC_OFF = LDS_BYTES - 256;  static_assert(nsa::LDS_END <= MISC_OFF && gla::L_END <= MISC_OFF, "LDS map");
constexpr int CW_BAR = 4096, CW_XL = 16384;
__global__ __launch_bounds__(512, 2) void mega_fwd(Params p) {
    extern __shared__ __attribute__((aligned(16))) unsigned char lds_raw[];
    LAS unsigned char* lds = (LAS unsigned char*)lds_raw;
    const int G = gridDim.x, bid = blockIdx.x, NGW = G * 8;
#define PH_IDS int tid = threadIdx.x; asm volatile("" : "+v"(tid)); const int lane = tid & 63, wave = __builtin_amdgcn_readfirstlane(tid >> 6), gw = bid * 8 + wave; (void)lane; (void)gw;
    for (int u = threadIdx.x; u < 64; u += 512) ((LAS unsigned*)(lds + MISC_OFF))[u] = 0u;
    __syncthreads();
    XcdBarrier bar = xcd_barrier_post((unsigned*)(p.ws + WS_CTL) + CW_BAR, (volatile LAS unsigned*)(lds + MISC_OFF) + 8);
    { PH_IDS; p0_absmax(p, bid, G, tid); p0_prologue(p, lds, gw, NGW, wave, lane); }
    xcd_barrier(bar);
    { PH_IDS; p0_quant(p, lds, gw, NGW, wave, lane); }
    xcd_barrier(bar);
    { pg8::Gemm g{(const bf16*)(p.ws + WS_XN8), (const bf16*)(p.ws + WS_WINQ), T, NPT * 256, DM / 2};
      ProjOrder S; S.init(T, NPT * 256, G, bid); S.xn = g.A; S.wt = g.Bt; EpiProjI8 E{p.ws};
      pg8::gemm_phase<EpiProjI8, ProjOrder, true, true, true>(lds, g, S, E); }
    xcd_barrier(bar);
    if (bid < 32) {
        pg8::Gemm g{(const bf16*)(p.ws + WS_KC), (const bf16*)(p.ws + WS_WKCT), 4096, 256, 2048};
        CmpOrder S{bid, (const bf16*)(p.ws + WS_KC), (const bf16*)(p.ws + WS_VC), (const bf16*)(p.ws + WS_WKCT), (const bf16*)(p.ws + WS_WVCT)}; EpiLH E{(float*)(p.ws + WS_LH)};
        pg8::gemm_phase<EpiLH, CmpOrder, true, true>(lds, g, S, E);
    } else { PH_IDS; ph_gla_a(p, lds, bid - 32, G - 32, tid, wave); }
    xcd_barrier(bar);
    { PH_IDS; ph_gla_b(p, bid * 512 + tid, G * 512);
      for (int i = bid * 512 + tid; i < 16 * 128; i += G * 512) { const int bgz = i >> 7, dz = i & 127; ((bf16*)(p.ws + WS_KCMP))[((size_t)bgz * 256 + 255) * 128 + dz] = 0; ((bf16*)(p.ws + WS_VCMPT))[((size_t)bgz * 128 + dz) * 256 + 255] = 0; }
      const int ngrp = G * 4, total = 2 * 16 * 255, iters = (total + ngrp - 1) / ngrp; const int grp = tid >> 7;
      for (int it = 0; it < iters; ++it) { int id = it * ngrp + bid * 4 + grp; if (id >= total) id = total - 1;
          ph_cmp_fin_simple(p, (LAS float*)lds + grp * 4352, id, tid & 127, (const float*)(p.ws + WS_LH), (const float*)(p.ws + WS_PEVP)); __syncthreads(); } }
    xcd_barrier(bar);
    { PH_IDS; ph_nsa(p, lds, bid, G, tid, wave); }
    xcd_barrier(bar);
    { PH_IDS; ph_gla_c(p, lds, bid, G, tid, wave); }
    xcd_barrier(bar);
    { pg8::Gemm g{(const bf16*)(p.ws + WS_A2), (const bf16*)(p.ws + WS_WOT), T, DM, DM};
      pg8::StaticOrder S; S.init(T, DM, G, bid); EpiRes E{p.in[I_X], p.out};
      pg8::gemm_phase<EpiRes, pg8::StaticOrder, true, true>(lds, g, S, E); }
    xcd_barrier(bar);
    { PH_IDS; for (int vb = bid; vb < NVB; vb += G) r1_router(p, lds, vb, tid, wave, lane); }
    xcd_barrier(bar);
    { PH_IDS; for (int vb = bid; vb < NVB; vb += G) r2_gather(p, lds, vb, vb == 0, tid, wave, lane); }
    xcd_barrier(bar);
    { pg8::Gemm g{(const bf16*)(p.ws + WS_XG8), (const bf16*)(p.ws + WS_W1Q), MAXTILES * 256, 4096, DM / 2};
      MoeOrder S; S.init((const int*)(p.ws + WS_META), 16, G, bid); EpiSwigluI8 E{p.in[I_B1], (const float*)(p.ws + WS_ROWSC), (const float*)(p.ws + WS_WSC1), (bf16*)(p.ws + WS_ACT), (float*)(p.ws + WS_AMAXP)};
      pg8::gemm_phase<EpiSwigluI8, MoeOrder, true, true, true>(lds, g, S, E); }
    xcd_barrier(bar);
    { PH_IDS; ph_actq(p, gw, NGW, lane); }
    xcd_barrier(bar);
    { pg8::Gemm g{(const bf16*)(p.ws + WS_ACT8), (const bf16*)(p.ws + WS_W2Q), MAXTILES * 256, DM, DFF / 2};
      MoeOrder S; S.init((const int*)(p.ws + WS_META), 8, G, bid); EpiDownI8 E{p.in[I_B2], (const float*)(p.ws + WS_ROWW), (const float*)(p.ws + WS_ASC), (const float*)(p.ws + WS_WSC2), (bf16*)(p.ws + WS_Y)};
      pg8::gemm_phase<EpiDownI8, MoeOrder, true, true, true>(lds, g, S, E); }
    xcd_barrier(bar);
    { PH_IDS; pf_final(p, gw, NGW, lane); }
}

extern "C" void kernel_launch(void* const* d_in, const int* in_sizes, int n_in, void* d_out, int out_size, void* d_ws, size_t ws_size, hipStream_t stream) {
    static int grid = 0;
    if (grid == 0) {
        if (n_in != N_IN || out_size != T * DM || ws_size < WS_END) { fprintf(stderr, "kernel_launch: unexpected shapes (n_in %d out %d ws %zu need %zu)\n", n_in, out_size, ws_size, (size_t)WS_END); grid = -1; return; }
        int dev = 0, cus = 0, per_cu = 0;
        if (hipGetDevice(&dev) != hipSuccess || hipDeviceGetAttribute(&cus, hipDeviceAttributeMultiprocessorCount, dev) != hipSuccess) { grid = -1; return; }
        if (hipFuncSetAttribute((const void*)mega_fwd, hipFuncAttributeMaxDynamicSharedMemorySize, LDS_BYTES) != hipSuccess) { fprintf(stderr, "kernel_launch: hipFuncSetAttribute failed\n"); grid = -1; return; }
        if (hipOccupancyMaxActiveBlocksPerMultiprocessor(&per_cu, (const void*)mega_fwd, 512, LDS_BYTES) != hipSuccess || per_cu < 1) { fprintf(stderr, "kernel_launch: occupancy query says %d blocks per CU\n", per_cu); }
        (void)hipGetLastError();
        grid = cus;
    }
    if (grid < 0) return;
    if (hipMemsetAsync((char*)d_ws + WS_CTL, 0, CTL_BYTES, stream) != hipSuccess) return;
    Params p{};
    for (int i = 0; i < N_IN; ++i) p.in[i] = (const float*)d_in[i];
    p.out = (float*)d_out; p.ws = (unsigned char*)d_ws;
    hipLaunchKernelGGL(mega_fwd, dim3(grid), dim3(512), LDS_BYTES, stream, p);
}
```

```cpp
#include <hip/hip_runtime.h>
#include <cstdio>
#include <cstdint>
namespace pg8 {
#define PG8_LAS __attribute__((address_space(3)))
typedef unsigned short bf16_t;
typedef short bf16x8 __attribute__((ext_vector_type(8)));
typedef float f32x4 __attribute__((ext_vector_type(4)));
typedef unsigned u32x4 __attribute__((ext_vector_type(4)));
constexpr int BM = 256, BK = 64, HALF = 128, HTB = HALF * BK * 2  , STAGE_BYTES = 8 * HTB, NXCD = 8, WGM = 8;

__host__ __device__ __forceinline__ int lds_byte(int r, int c) { const int st = (r >> 4) * 2 + (c >> 5), rr = r & 15, cc = c & 31, ob = rr * 64 + cc * 2; return st * 1024 + (ob ^ (((ob >> 9) & 1) << 5)); }
__host__ __device__ __forceinline__ void stage_rc(int b, int& R, int& C) { const int st = b / 1024, sb = b % 1024, swz = sb ^ (((sb >> 9) & 1) << 5); R = (st >> 1) * 16 + swz / 64; C = (st & 1) * 32 + (swz % 64) / 2; }
__host__ __device__ __forceinline__ int perm32(int rho) { const int n = rho >> 4, i = rho & 15; return 8 * (i >> 2) + 4 * n + (i & 3); }

struct Unit { int pm, pn, kind; };
struct Gemm { const bf16_t* A; const bf16_t* Bt; int M, N, K; };

__host__ __device__ __forceinline__ void tile_of(int wgid, int nM, int nN, int& pm, int& pn) {
    const int nwg = nM * nN;
    { const int q = nwg / NXCD, r = nwg % NXCD, xcd = wgid % NXCD, off = wgid / NXCD; wgid = (xcd < r ? xcd * (q + 1) : r * (q + 1) + (xcd - r) * q) + off; }
    const int nig = WGM * nN, gid = wgid / nig, fm = gid * WGM, gsz = (nM - fm) < WGM ? (nM - fm) : WGM;
    pm = fm + ((wgid % nig) % gsz); pn = (wgid % nig) / gsz;
}
struct StaticOrder {
    int nM, nN, nwg, G, c;
    __host__ __device__ void init(int M, int N, int G_, int c_) { nM = M / BM; nN = N / BM; nwg = nM * nN; G = G_; c = c_; }
    __device__ __forceinline__ bool next(int i, Unit& u) const {
        const long L = (long)i * G + c; if (L >= nwg) return false;
        tile_of((int)L, nM, nN, u.pm, u.pn); u.kind = 0; return true;
    }
    __device__ __forceinline__ const char* pa(const Gemm& g, const Unit& u) const { return (const char*)g.A + (size_t)u.pm * ((size_t)BM * g.K * 2); }
    __device__ __forceinline__ const char* pb(const Gemm& g, const Unit& u) const { return (const char*)g.Bt + (size_t)u.pn * ((size_t)BM * g.K * 2); }
    __device__ __forceinline__ void a_ready(const Unit&) const {}
    __device__ __forceinline__ void done(const Unit&) const {}
};
__device__ __forceinline__ unsigned cvt_pk_bf16(float lo, float hi) { unsigned r; asm volatile("v_cvt_pk_bf16_f32 %0, %1, %2" : "=v"(r) : "v"(lo), "v"(hi)); return r; }
template <bool I8> __device__ __forceinline__ f32x4 mma16(bf16x8 a, bf16x8 b, f32x4 c) {
    if constexpr (I8) { typedef int i32x4 __attribute__((ext_vector_type(4)));
        return __builtin_bit_cast(f32x4, __builtin_amdgcn_mfma_i32_16x16x64_i8(__builtin_bit_cast(i32x4, a), __builtin_bit_cast(i32x4, b), __builtin_bit_cast(i32x4, c), 0, 0, 0)); }
    else return __builtin_amdgcn_mfma_f32_16x16x32_bf16(a, b, c, 0, 0, 0);
}
template <class Epi, class Sched, bool ALIGN_EPI = false, bool SP2 = false, bool I8 = false>
__device__ __forceinline__ void gemm_phase(PG8_LAS unsigned char* lds, const Gemm g, const Sched& S, const Epi& E) {
    int tid_l = threadIdx.x; asm volatile("" : "+v"(tid_l));
    const int tid = tid_l, wid = __builtin_amdgcn_readfirstlane(tid >> 6), lane = tid & 63, wr = wid >> 2, wc = wid & 3, fr = lane & 15, fq = lane >> 4;
    const int K = g.K, nt = K / BK;
    unsigned voffA[2], voffB[2];
#pragma unroll
    for (int i = 0; i < 2; ++i) { int R, C; stage_rc(tid * 16 + i * 8192, R, C); const int Rb = Epi::PERM ? ((R & ~31) + perm32(R & 31)) : R;
        voffA[i] = (unsigned)(R * K + C) * 2u; voffB[i] = (unsigned)(Rb * K + C) * 2u; }
    const size_t kstep = (size_t)(BK * 2);
    const size_t hstep = (size_t)HALF * K * 2;
    const unsigned ldsw = (unsigned)wid * 1024u;
    const int aoff = lds_byte(wr * 64 + fr, fq * 8), boff = lds_byte(wc * 32 + fr, fq * 8);
#define PG8_SA(b, h) (((b) * 2 + (h)) * HTB)
#define PG8_SB(b, h) ((4 + (b) * 2 + (h)) * HTB)
#define PG8_STAGE(bufoff, gbase, voff) do { _Pragma("unroll") for (int _i = 0; _i < 2; ++_i) \
        __builtin_amdgcn_global_load_lds((const unsigned*)((const char*)(gbase) + (voff)[_i]), (PG8_LAS unsigned*)(lds + (bufoff) + ldsw + _i * 8192), 16, 0, 0); } while (0)
#define PG8_LDA(dst, b, h) do { _Pragma("unroll") for (int m = 0; m < 4; ++m) _Pragma("unroll") for (int k = 0; k < 2; ++k) dst[m][k] = *(const PG8_LAS bf16x8*)(lds + PG8_SA(b, h) + aoff + m * 2048 + k * 1024); } while (0)
#define PG8_LDB(dst, b, h) do { _Pragma("unroll") for (int n = 0; n < 2; ++n) _Pragma("unroll") for (int k = 0; k < 2; ++k) dst[n][k] = *(const PG8_LAS bf16x8*)(lds + PG8_SB(b, h) + boff + n * 2048 + k * 1024); } while (0)
#define PG8_MMA(ai, bj, At, Bt) do { __builtin_amdgcn_s_setprio(1); _Pragma("unroll") for (int m = 0; m < 4; ++m) _Pragma("unroll") for (int n = 0; n < 2; ++n) _Pragma("unroll") for (int k = 0; k < 2; ++k) \
        acc[ai][bj][m][n] = mma16<I8>(Bt[n][k], At[m][k], acc[ai][bj][m][n]); __builtin_amdgcn_s_setprio(0); } while (0)
#define PG8_WAIT_V(n) asm volatile("s_waitcnt vmcnt(" #n ")" ::: "memory")
#define PG8_WAIT_L(n) asm volatile("s_waitcnt lgkmcnt(" #n ")" ::: "memory")
#define PG8_BAR __builtin_amdgcn_s_barrier()
#define PG8_SCHED __builtin_amdgcn_sched_barrier(0)
    Unit cur, nxt; int ui = 0;
    if (!S.next(0, cur)) return;
    f32x4 acc[2][2][4][2];
#pragma unroll
    for (int a = 0; a < 2; ++a)
#pragma unroll
        for (int b = 0; b < 2; ++b)
#pragma unroll
            for (int m = 0; m < 4; ++m)
#pragma unroll
                for (int n = 0; n < 2; ++n) acc[a][b][m][n] = (f32x4){0.f, 0.f, 0.f, 0.f};
    bf16x8 At[4][2], B0[2][2], B1[2][2];
    const char* cA = S.pa(g, cur); const char* cB = S.pb(g, cur);
    S.a_ready(cur);
    if constexpr (SP2) {
        PG8_STAGE(PG8_SB(0, 0), cB, voffB); PG8_STAGE(PG8_SB(0, 1), cB + hstep, voffB); PG8_STAGE(PG8_SA(0, 0), cA, voffA); PG8_STAGE(PG8_SA(0, 1), cA + hstep, voffA);
        if (wr == 1) PG8_BAR;
        PG8_WAIT_V(2); PG8_BAR;
        PG8_STAGE(PG8_SB(1, 0), cB + kstep, voffB); PG8_STAGE(PG8_SA(1, 0), cA + kstep, voffA); PG8_STAGE(PG8_SB(1, 1), cB + hstep + kstep, voffB);
        PG8_WAIT_V(6); PG8_BAR;
    } else {
        PG8_STAGE(PG8_SB(0, 0), cB, voffB); PG8_STAGE(PG8_SA(0, 0), cA, voffA); PG8_STAGE(PG8_SB(0, 1), cB + hstep, voffB); PG8_STAGE(PG8_SA(0, 1), cA + hstep, voffA);
        if (wr == 1) PG8_BAR;
        PG8_WAIT_V(4); PG8_BAR;
        PG8_STAGE(PG8_SB(1, 0), cB + kstep, voffB); PG8_STAGE(PG8_SA(1, 0), cA + kstep, voffA); PG8_STAGE(PG8_SB(1, 1), cB + hstep + kstep, voffB);
        PG8_WAIT_V(6); PG8_BAR;
    }
    for (;;) {
        const bool has_next = S.next(ui + 1, nxt);
        const char* nA = has_next ? S.pa(g, nxt) : cA; const char* nB = has_next ? S.pb(g, nxt) : cB;
        for (int t = 0; t < nt; t += 2) {
            const bool last = (t == nt - 2);
            const char* a1 = cA + (size_t)(t + 1) * kstep;
            const char* a2 = last ? nA : cA + (size_t)(t + 2) * kstep; const char* b2 = last ? nB : cB + (size_t)(t + 2) * kstep;
            const char* a3 = a2 + kstep; const char* b3 = b2 + kstep;
            if (last && has_next) S.a_ready(nxt);
            if constexpr (SP2) {
            PG8_LDB(B0, 0, 0); PG8_LDB(B1, 0, 1); PG8_SCHED; PG8_LDA(At, 0, 0); PG8_STAGE(PG8_SA(1, 1), a1 + hstep, voffA);
            PG8_WAIT_V(8); PG8_WAIT_L(0); PG8_BAR; PG8_MMA(0, 0, At, B0); PG8_MMA(0, 1, At, B1); PG8_BAR; PG8_SCHED;
            PG8_LDA(At, 0, 1); PG8_STAGE(PG8_SB(0, 0), b2, voffB); PG8_STAGE(PG8_SB(0, 1), b2 + hstep, voffB); PG8_STAGE(PG8_SA(0, 0), a2, voffA);
            PG8_WAIT_V(8); PG8_WAIT_L(0); PG8_BAR; PG8_MMA(1, 0, At, B0); PG8_MMA(1, 1, At, B1); PG8_BAR; PG8_SCHED;
            PG8_LDB(B0, 1, 0); PG8_LDB(B1, 1, 1); PG8_SCHED; PG8_LDA(At, 1, 0); PG8_STAGE(PG8_SA(0, 1), a2 + hstep, voffA);
            PG8_WAIT_V(8); PG8_WAIT_L(0); PG8_BAR; PG8_MMA(0, 0, At, B0); PG8_MMA(0, 1, At, B1); PG8_BAR; PG8_SCHED;
            PG8_LDA(At, 1, 1); PG8_STAGE(PG8_SB(1, 0), b3, voffB); PG8_STAGE(PG8_SB(1, 1), b3 + hstep, voffB); PG8_STAGE(PG8_SA(1, 0), a3, voffA);
            PG8_WAIT_V(8); PG8_WAIT_L(0); PG8_BAR; PG8_MMA(1, 0, At, B0); PG8_MMA(1, 1, At, B1); PG8_BAR; PG8_SCHED;
            } else {
            PG8_LDB(B0, 0, 0); PG8_SCHED; PG8_LDA(At, 0, 0); PG8_STAGE(PG8_SA(1, 1), a1 + hstep, voffA);
            PG8_WAIT_L(8); PG8_BAR; PG8_WAIT_L(0); PG8_MMA(0, 0, At, B0); PG8_BAR; PG8_SCHED;
            PG8_LDB(B1, 0, 1); PG8_STAGE(PG8_SB(0, 0), b2, voffB);
            PG8_BAR; PG8_WAIT_L(0); PG8_MMA(0, 1, At, B1); PG8_BAR;
            PG8_LDA(At, 0, 1); PG8_STAGE(PG8_SA(0, 0), a2, voffA);
            PG8_BAR; PG8_WAIT_L(0); PG8_MMA(1, 0, At, B0); PG8_BAR; PG8_SCHED;
            PG8_STAGE(PG8_SB(0, 1), b2 + hstep, voffB);
            PG8_WAIT_V(6); PG8_BAR; PG8_MMA(1, 1, At, B1); PG8_BAR;
            PG8_LDB(B0, 1, 0); PG8_SCHED; PG8_LDA(At, 1, 0); PG8_STAGE(PG8_SA(0, 1), a2 + hstep, voffA);
            PG8_WAIT_L(8); PG8_BAR; PG8_WAIT_L(0); PG8_MMA(0, 0, At, B0); PG8_BAR; PG8_SCHED;
            PG8_LDB(B1, 1, 1); PG8_STAGE(PG8_SB(1, 0), b3, voffB);
            PG8_BAR; PG8_WAIT_L(0); PG8_MMA(0, 1, At, B1); PG8_BAR;
            PG8_LDA(At, 1, 1); PG8_STAGE(PG8_SA(1, 0), a3, voffA);
            PG8_BAR; PG8_WAIT_L(0); PG8_MMA(1, 0, At, B0); PG8_BAR; PG8_SCHED;
            PG8_STAGE(PG8_SB(1, 1), b3 + hstep, voffB);
            PG8_WAIT_V(6); PG8_BAR; PG8_MMA(1, 1, At, B1); PG8_BAR;
            }
        }
        if constexpr (ALIGN_EPI) { if (wr == 0) PG8_BAR; }
        if constexpr (!Epi::AFTER_DRAIN) { E(acc, cur, wr, wc, fr, fq); S.done(cur); }
        if (!has_next) break;
#pragma unroll
        for (int a = 0; a < 2; ++a)
#pragma unroll
            for (int b = 0; b < 2; ++b)
#pragma unroll
                for (int m = 0; m < 4; ++m)
#pragma unroll
                    for (int n = 0; n < 2; ++n) acc[a][b][m][n] = (f32x4){0.f, 0.f, 0.f, 0.f};
        cur = nxt; cA = nA; cB = nB; ++ui;
        if constexpr (ALIGN_EPI) { if (wr == 1) PG8_BAR; }
    }
    PG8_WAIT_V(0);
    if constexpr (!ALIGN_EPI) { if (wr == 0) PG8_BAR; }
    PG8_BAR;
    if constexpr (Epi::AFTER_DRAIN) { E.fused(acc, cur, wr, wc, fr, fq, lds, wid, lane); S.done(cur); }
#undef PG8_SA
#undef PG8_SB
#undef PG8_STAGE
#undef PG8_LDA
#undef PG8_LDB
#undef PG8_MMA
#undef PG8_WAIT_V
#undef PG8_WAIT_L
#undef PG8_BAR
#undef PG8_SCHED
}
}

#define GAS __attribute__((address_space(1)))
#define LAS __attribute__((address_space(3)))
typedef unsigned short bf16;
typedef unsigned v4u __attribute__((ext_vector_type(4)));
typedef unsigned v2u __attribute__((ext_vector_type(2)));
typedef float f32x4 __attribute__((ext_vector_type(4)));
typedef short bf16x8 __attribute__((ext_vector_type(8)));

constexpr int NB = 8, SEQ = 4096, DM = 2048, T = NB * SEQ;
constexpr int NPT = 23;
constexpr int NE = 32, DFF = 2048;
constexpr int MAXTILES = 544;
constexpr float RMS_EPS = 1e-5f;
constexpr int NVB = 256, TPV = T / NVB;

enum { I_X = 0, I_NMIX, I_WIN, I_WA2, I_BA, I_GLAG, I_PEK, I_WK1, I_WK2, I_PEV, I_WV1, I_WV2, I_NSAG, I_RELB, I_WOUT, I_NFFN, I_RW, I_RB, I_W1, I_B1, I_W2, I_B2, I_NFIN, N_IN };

constexpr size_t MiB = 1u << 20;
constexpr size_t al(size_t x) { return (x + 255) & ~(size_t)255; }
constexpr size_t WS_CTL = 0, CTL_BYTES = 1 * MiB;
constexpr size_t WS_CNT = WS_CTL + CTL_BYTES;
constexpr size_t WS_META = WS_CNT + al(NVB * 32 * 4);
constexpr size_t WS_EIDX = WS_META + al((64 + MAXTILES) * 4);
constexpr size_t WS_LRNK = WS_EIDX + al((size_t)T * 4 * 4);
constexpr size_t WS_GATE = WS_LRNK + al((size_t)T * 4 * 4);
constexpr size_t WS_POS = WS_GATE + al((size_t)T * 4 * 4);
constexpr size_t WS_ROWW = WS_POS + al((size_t)T * 4 * 4);
constexpr size_t WS_WINT = al(WS_ROWW + (size_t)MAXTILES * 256 * 4);
constexpr size_t WS_WOT = WS_WINT + (size_t)NPT * 256 * DM * 2;
constexpr size_t WS_WKCT = WS_WOT + (size_t)DM * DM * 2;
constexpr size_t WS_WVCT = WS_WKCT + (size_t)256 * 2048 * 2;
constexpr size_t WS_W1T = WS_WVCT + (size_t)256 * 2048 * 2;
constexpr size_t WS_W2T = WS_W1T + (size_t)NE * 4096 * DM * 2;
constexpr size_t WS_XN = WS_W2T + (size_t)NE * DM * DFF * 2;
constexpr size_t WS_GQ = WS_XN + (size_t)T * DM * 2;
constexpr size_t WS_GK = WS_GQ + (size_t)T * 512 * 2;
constexpr size_t WS_GV = WS_GK + (size_t)T * 512 * 2;
constexpr size_t WS_GG = WS_GV + (size_t)T * 1024 * 2;
constexpr size_t WS_NQ = WS_GG + (size_t)T * 1024 * 2;
constexpr size_t WS_KC = WS_NQ + (size_t)T * 1024 * 2;
constexpr size_t WS_VC = WS_KC + (size_t)T * 256 * 2;
constexpr size_t WS_KS = WS_VC + (size_t)T * 256 * 2;
constexpr size_t WS_KW = WS_KS + (size_t)T * 256 * 2;
constexpr size_t WS_VST = WS_KW + (size_t)T * 256 * 2;
constexpr size_t WS_VWT = WS_VST + (size_t)T * 256 * 2;
constexpr size_t WS_SM = WS_VWT + (size_t)T * 256 * 2;
constexpr size_t WS_LA = WS_SM + (size_t)T * 64 * 2;
constexpr size_t WS_OG = WS_LA + (size_t)T * 512 * 4;
constexpr size_t WS_ON = WS_OG + (size_t)T * 1024 * 4;
constexpr size_t WS_KCMP = WS_ON + (size_t)T * 1024 * 4;
constexpr size_t WS_VCMPT = WS_KCMP + (size_t)16 * 256 * 128 * 2;
constexpr size_t WS_A2 = WS_VCMPT + (size_t)16 * 256 * 128 * 2;
constexpr size_t WS_HN = WS_A2 + (size_t)T * DM * 2;
constexpr size_t WS_XG = WS_HN + (size_t)T * DM * 2;
constexpr size_t WS_ACT = WS_XG + (size_t)MAXTILES * 256 * DM * 2;
constexpr size_t WS_END = WS_ACT + (size_t)MAXTILES * 256 * DFF * 2;

__device__ __forceinline__ unsigned f2bf(float f) { unsigned u = __builtin_bit_cast(unsigned, f); return (u + 0x7fffu + ((u >> 16) & 1u)) >> 16; }
__device__ __forceinline__ unsigned pk2(float lo, float hi) { return f2bf(lo) | (f2bf(hi) << 16); }
__device__ __forceinline__ float bf2f(unsigned short v) { return __builtin_bit_cast(float, (unsigned)v << 16); }
__device__ __forceinline__ float bflo(unsigned w) { return __builtin_bit_cast(float, w << 16); }
__device__ __forceinline__ float bfhi(unsigned w) { return __builtin_bit_cast(float, w & 0xffff0000u); }
__device__ __forceinline__ float wave_sum(float v) {
#pragma unroll
    for (int o = 1; o < 64; o <<= 1) v += __shfl_xor(v, o);
    return v;
}
__device__ __forceinline__ float wave_max(float v) {
#pragma unroll
    for (int o = 1; o < 64; o <<= 1) v = fmaxf(v, __shfl_xor(v, o));
    return v;
}
#define LDS_WAIT() asm volatile("s_waitcnt lgkmcnt(0)" ::: "memory")

__device__ const unsigned char kBucket[128] = {0, 1, 2, 3, 4, 5, 6, 7, 8, 9, 10, 11, 12, 13, 14, 15, 16, 16, 16, 17, 17, 18, 18, 18, 19, 19, 19, 20, 20, 20, 20, 21, 21, 21, 21, 22, 22, 22, 22, 22, 23, 23, 23, 23, 23, 23, 24, 24, 24, 24, 24, 24, 25, 25, 25, 25, 25, 25, 25, 26, 26, 26, 26, 26, 26, 26, 26, 27, 27, 27, 27, 27, 27, 27, 27, 27, 27, 28, 28, 28, 28, 28, 28, 28, 28, 28, 28, 29, 29, 29, 29, 29, 29, 29, 29, 29, 29, 29, 29, 30, 30, 30, 30, 30, 30, 30, 30, 30, 30, 30, 30, 30, 30, 31, 31, 31, 31, 31, 31, 31, 31, 31, 31, 31, 31, 31, 31, 31};

struct Params {
    const float* in[N_IN];
    float* out;
    unsigned char* ws;
};

template <class F>
__device__ __forceinline__ void transpose_item(const float* W, int ldw, int k0, int n0, int nlim, LAS float* scr, int lane, F dst) {
#pragma unroll 8
    for (int i = 0; i < 32; ++i) { const int kk = 2 * i + (lane >> 5); const int n = n0 + (lane & 31); scr[kk * 33 + (lane & 31)] = n < nlim ? W[(size_t)(k0 + kk) * ldw + n] : 0.f; }
    LDS_WAIT(); asm volatile("" ::: "memory");
    const int c = lane & 7;
#pragma unroll
    for (int j = 0; j < 4; ++j) { const int nn = (lane >> 3) + 8 * j; const int n = n0 + nn; const LAS float* s = scr + (8 * c) * 33 + nn;
        bf16* rowp; float sc;
        if (n < nlim && dst(n, rowp, sc)) {
            v4u o; o.x = pk2(s[0 * 33] * sc, s[1 * 33] * sc); o.y = pk2(s[2 * 33] * sc, s[3 * 33] * sc); o.z = pk2(s[4 * 33] * sc, s[5 * 33] * sc); o.w = pk2(s[6 * 33] * sc, s[7 * 33] * sc);
            *(v4u*)(rowp + 8 * c) = o; } }
    LDS_WAIT(); asm volatile("" ::: "memory");
}
__device__ __forceinline__ int win_row(int n, float& sc) {
    sc = 1.f;
    if (n < 512) { sc = 0.08838834764831845f; return n; }
    if (n < 1024) return n;
    if (n < 2048) return n;
    if (n < 3072) return n;
    if (n < 3088) return 5120 + (n - 3072);
    if (n < 4112) { sc = 0.08838834764831845f; return 3072 + (n - 3088); }
    if (n < 4368) return 4096 + (n - 4112);
    if (n < 4624) return 4352 + (n - 4368);
    if (n < 4880) return 4608 + (n - 4624);
    if (n < 5136) return 5376 + (n - 4880);
    if (n < 5392) return 4864 + (n - 5136);
    if (n < 5648) return 5632 + (n - 5392);
    return 5136 + (n - 5648);
}
constexpr size_t WS_PEVP = WS_W2T;
__device__ __forceinline__ void p0_prologue(const Params& p, LAS unsigned char* lds, int gw, int NGW, int wave, int lane) {
    LAS float* scr = (LAS float*)(lds + wave * 16384);
    bf16* WinT = (bf16*)(p.ws + WS_WINT); bf16* WoT = (bf16*)(p.ws + WS_WOT); bf16* WkcT = (bf16*)(p.ws + WS_WKCT); bf16* WvcT = (bf16*)(p.ws + WS_WVCT);
    bf16* W1T = (bf16*)(p.ws + WS_W1T); bf16* W2T = (bf16*)(p.ws + WS_W2T);
    constexpr int I_IN = 32 * 178, I_O = 32 * 64, I_C = 64 * 4, I_E1 = 32 * 128, I_E2 = 32 * 64;
    constexpr int I_PE = 2 * 64;
    constexpr int NITEMS = I_O + 2 * I_C + I_PE;
    (void)I_IN; (void)WinT;
    for (int it = gw; it < NITEMS; it += NGW) {
        int r = it;
        if (r < I_O) { const int kb = r / 64, nb = r % 64, k0 = kb * 64;
            transpose_item(p.in[I_WOUT], DM, k0, nb * 32, DM, scr, lane, [&](int n, bf16*& rowp, float& sc) { sc = 1.f; rowp = WoT + (size_t)n * DM + k0; return true; }); continue; } r -= I_O;
        if (r >= 2 * I_C) { r -= 2 * I_C; const int which = r >> 6, kq = r & 63; const float* pe = p.in[which ? I_PEV : I_PEK] + kq * 64; const float* w1 = p.in[which ? I_WV1 : I_WK1] + (size_t)kq * 64 * 128 + lane;
            float a0 = 0.f, a1 = 0.f;
#pragma unroll
            for (int k = 0; k < 64; ++k) { const float pv = pe[k]; a0 += pv * w1[k * 128]; a1 += pv * w1[k * 128 + 64]; }
            float* dst = (float*)(p.ws + WS_PEVP) + (size_t)(which * 64 + kq) * 128 + lane; dst[0] = a0; dst[64] = a1; continue; }
        { const int which = r / I_C; r %= I_C; const int kb = r / 4, nb = r % 4, k0 = kb * 64;
            bf16* dstm = which ? WvcT : WkcT;
            transpose_item(p.in[which ? I_WV1 : I_WK1], 128, k0, nb * 32, 128, scr, lane, [&](int n, bf16*& rowp, float& sc) { sc = 1.f; rowp = dstm + (size_t)(n + (k0 >= 2048 ? 128 : 0)) * 2048 + (k0 & 2047); return true; }); }
        (void)I_E1; (void)I_E2; (void)W1T; (void)W2T;
    }
    const float* x = p.in[I_X]; const float* gm = p.in[I_NMIX];
    for (int m = gw; m < T; m += NGW) {
        const f32x4* xr = (const f32x4*)(x + (size_t)m * DM) + lane; f32x4 v[8]; float s = 0.f;
#pragma unroll
        for (int j = 0; j < 8; ++j) { v[j] = xr[64 * j]; s += (v[j].x * v[j].x + v[j].y * v[j].y) + (v[j].z * v[j].z + v[j].w * v[j].w); }
        const float rstd = 1.f / sqrtf(wave_sum(s) * (1.f / DM) + RMS_EPS);
        float mxr = 0.f;
#pragma unroll
        for (int j = 0; j < 8; ++j) { const f32x4 g4 = ((const f32x4*)gm)[lane + 64 * j]; v[j].x *= rstd * g4.x; v[j].y *= rstd * g4.y; v[j].z *= rstd * g4.z; v[j].w *= rstd * g4.w;
            mxr = fmaxf(mxr, fmaxf(fmaxf(fabsf(v[j].x), fabsf(v[j].y)), fmaxf(fabsf(v[j].z), fabsf(v[j].w)))); }
        mxr = wave_max(mxr); const float qs = mxr > 0.f ? mxr * (1.f / 127.f) : 1.f, qi = 1.f / qs;
        unsigned* o4 = (unsigned*)(p.ws + WS_XN + (size_t)m * DM) + lane;
#pragma unroll
        for (int j = 0; j < 8; ++j) { const int q0 = (int)rintf(v[j].x * qi), q1 = (int)rintf(v[j].y * qi), q2 = (int)rintf(v[j].z * qi), q3 = (int)rintf(v[j].w * qi);
            o4[64 * j] = ((unsigned)q0 & 0xffu) | (((unsigned)q1 & 0xffu) << 8) | (((unsigned)q2 & 0xffu) << 16) | (((unsigned)q3 & 0xffu) << 24); }
        if (lane == 0) ((float*)(p.ws + WS_XN + (size_t)T * DM))[m] = qs;
    }
}
#define XB_TMO      128
#define XB_XCNT(j)  (256  + 64 * (j))
#define XB_XSUB(j)  (1280 + 64 * (j))
#define XB_XGEN(j)  (2304 + 64 * (j))
#define XB_TOP      3328
#define XB_TOPGEN   3392
#define XCD_BAR_WORDS 3456
#define XB_SPIN_CAP (1u << 18)

__device__ __forceinline__ unsigned xb_ld(unsigned* p)              { return __hip_atomic_load(p, __ATOMIC_RELAXED, __HIP_MEMORY_SCOPE_AGENT); }
__device__ __forceinline__ unsigned xb_add(unsigned* p, unsigned v) { return __hip_atomic_fetch_add(p, v, __ATOMIC_RELAXED, __HIP_MEMORY_SCOPE_AGENT); }
__device__ __forceinline__ unsigned xb_xcc_id() { return (unsigned)__builtin_amdgcn_s_getreg((3 << 11) | 20) & 0xFu; }
#define XB_SPIN(cond, bar) do { unsigned _sp = 0; while (cond) { __builtin_amdgcn_s_sleep(1); \
    if ((++_sp & 255u) == 0u) { if (xb_ld(&(bar)[XB_TMO])) break; if (_sp > XB_SPIN_CAP) { atomicAdd(&(bar)[XB_TMO], 1u); break; } } } } while (0)

struct XcdBarrier {
    unsigned* bar; unsigned x;
    volatile LAS unsigned* st;
};

__device__ __forceinline__ XcdBarrier xcd_barrier_post(unsigned* bar, volatile LAS unsigned* st) {
    XcdBarrier b; b.bar = bar; b.x = xb_xcc_id(); b.st = st;
    if (threadIdx.x == 0) (void)xb_add(&bar[XB_XCNT(b.x)], 1u);
    return b;
}
__device__ __forceinline__ void xcd_barrier_complete(unsigned* bar, unsigned x, unsigned& nloc, unsigned& nx) {
    const unsigned G = gridDim.x * gridDim.y * gridDim.z;
    unsigned sum, cnt, mine, sp = 0u;
    for (;;) {
        sum = 0u; cnt = 0u; mine = 0u;
#pragma unroll
        for (unsigned j = 0; j < 16; ++j) { const unsigned c = xb_ld(&bar[XB_XCNT(j)]); sum += c; cnt += (c > 0u) ? 1u : 0u; mine = (j == x) ? c : mine; }
        if (sum == G) break;
        __builtin_amdgcn_s_sleep(1);
        if ((++sp & 255u) == 0u) { if (xb_ld(&bar[XB_TMO])) break; if (sp > XB_SPIN_CAP) { atomicAdd(&bar[XB_TMO], 1u); break; } }
    }
    nloc = mine > 0u ? mine : 1u; nx = cnt > 0u ? cnt : 1u;
}

__device__ __forceinline__ void xcd_barrier(const XcdBarrier& b) {
    asm volatile("s_waitcnt vmcnt(0)" ::: "memory");
    __syncthreads();
    if (threadIdx.x == 0) {
        unsigned* bar = b.bar;
        __builtin_amdgcn_s_waitcnt(0);
        unsigned nloc = b.st[0], nx = b.st[1];
        if (nloc == 0u) { xcd_barrier_complete(bar, b.x, nloc, nx); b.st[0] = nloc; b.st[1] = nx; }
        const unsigned old = xb_add(&bar[XB_XSUB(b.x)], 1u);
        const unsigned gen = old / nloc;
        if (old + 1u == (gen + 1u) * nloc) {
            __builtin_amdgcn_fence(__ATOMIC_RELEASE, "agent");
            asm volatile("s_waitcnt vmcnt(0)" ::: "memory");
            const unsigned og = xb_add(&bar[XB_TOP], 1u);
            const unsigned tg = og / nx;
            if (og + 1u == (tg + 1u) * nx) xb_add(&bar[XB_TOPGEN], 1u);
            else XB_SPIN(xb_ld(&bar[XB_TOPGEN]) == tg, bar);
            __builtin_amdgcn_fence(__ATOMIC_ACQUIRE, "agent");
            xb_add(&bar[XB_XGEN(b.x)], 1u);
            asm volatile("s_waitcnt vmcnt(0)" ::: "memory");
        } else {
            XB_SPIN(xb_ld(&bar[XB_XGEN(b.x)]) == gen, bar);
            __builtin_amdgcn_fence(__ATOMIC_ACQUIRE, "agent");
            asm volatile("s_waitcnt vmcnt(0)" ::: "memory");
        }
    }
    __syncthreads();
}

struct ProjOrder : pg8::StaticOrder {
    const bf16* xn; const bf16* wt;
    __device__ __forceinline__ bool next(int i, pg8::Unit& u) const { if (!pg8::StaticOrder::next(i, u)) return false; u.kind = (u.pn >= 21) ? 1 : 0; return true; }
    __device__ __forceinline__ const char* pa(const pg8::Gemm& g, const pg8::Unit& u) const { return u.kind ? (const char*)wt + (size_t)u.pn * ((size_t)256 * g.K * 2) : (const char*)xn + (size_t)u.pm * ((size_t)256 * g.K * 2); }
    __device__ __forceinline__ const char* pb(const pg8::Gemm& g, const pg8::Unit& u) const { return u.kind ? (const char*)xn + (size_t)u.pm * ((size_t)256 * g.K * 2) : (const char*)wt + (size_t)u.pn * ((size_t)256 * g.K * 2); }
};
struct EpiProj {
    static constexpr bool PERM = true, AFTER_DRAIN = false;
    unsigned char* ws;
    __device__ __forceinline__ void operator()(const pg8::f32x4 (&acc)[2][2][4][2], const pg8::Unit& u, int wr, int wc, int fr, int fq) const {
        const int cw = wc * 32 + 8 * fq;
        if (u.kind == 0) {
            const int tn = u.pn; bf16* base; size_t bjs = 128; int ld = 0; bool headmajor = false; bool small = false;
            if (tn < 2) { base = (bf16*)(ws + WS_GQ) + tn * 256; ld = 512; }
            else if (tn < 4) { base = (bf16*)(ws + WS_GK) + (tn - 2) * 256; ld = 512; }
            else if (tn < 8) { base = (bf16*)(ws + WS_GV) + (tn - 4) * 256; ld = 1024; }
            else if (tn < 12) { base = (bf16*)(ws + WS_GG) + (tn - 8) * 256; ld = 1024; }
            else if (tn < 16) { base = (bf16*)(ws + WS_NQ) + (tn - 12) * 256; ld = 1024; }
            else if (tn < 20) { base = (bf16*)(ws + (tn == 16 ? WS_KC : tn == 17 ? WS_VC : tn == 18 ? WS_KS : WS_KW)); headmajor = true; bjs = (size_t)SEQ * 128; }
            else { base = (bf16*)(ws + WS_SM); ld = 64; small = true; }
            if (small && wc >= 2) return;
#pragma unroll
            for (int ai = 0; ai < 2; ++ai)
#pragma unroll
                for (int m = 0; m < 4; ++m) { const int r = u.pm * 256 + ai * 128 + wr * 64 + m * 16 + fr;
                    const size_t rterm = headmajor ? ((size_t)(r >> 12) * 2 * SEQ + (r & (SEQ - 1))) * 128 : (size_t)r * ld;
#pragma unroll
                    for (int bj = 0; bj < 2; ++bj) { if (small && bj) continue;
                        const pg8::f32x4 v0 = acc[ai][bj][m][0], v1 = acc[ai][bj][m][1];
                        pg8::u32x4 w; w.x = pg8::cvt_pk_bf16(v0[0], v0[1]); w.y = pg8::cvt_pk_bf16(v0[2], v0[3]); w.z = pg8::cvt_pk_bf16(v1[0], v1[1]); w.w = pg8::cvt_pk_bf16(v1[2], v1[3]);
                        *(pg8::u32x4*)(base + rterm + bj * bjs + cw) = w; } }
        } else {
            bf16* base = (bf16*)(ws + (u.pn == 21 ? WS_VST : WS_VWT));
#pragma unroll
            for (int ai = 0; ai < 2; ++ai)
#pragma unroll
                for (int m = 0; m < 4; ++m) { const int dh = wr * 64 + m * 16 + fr;
#pragma unroll
                    for (int bj = 0; bj < 2; ++bj) { const int tok = u.pm * 256 + bj * 128 + cw; const int b = tok >> 12, s = tok & (SEQ - 1);
                        const pg8::f32x4 v0 = acc[ai][bj][m][0], v1 = acc[ai][bj][m][1];
                        pg8::u32x4 w; w.x = pg8::cvt_pk_bf16(v0[0], v0[1]); w.y = pg8::cvt_pk_bf16(v0[2], v0[3]); w.z = pg8::cvt_pk_bf16(v1[0], v1[1]); w.w = pg8::cvt_pk_bf16(v1[2], v1[3]);
                        *(pg8::u32x4*)(base + ((size_t)(b * 2 + ai) * 128 + dh) * SEQ + s) = w; } }
        }
    }
};
struct EpiRes {
    static constexpr bool PERM = false, AFTER_DRAIN = false;
    const float* x; float* h;
    __device__ __forceinline__ void operator()(const pg8::f32x4 (&acc)[2][2][4][2], const pg8::Unit& u, int wr, int wc, int fr, int fq) const {
        const int row0 = u.pm * 256 + wr * 64 + fr, col0 = u.pn * 256 + wc * 32 + 4 * fq;
#pragma unroll
        for (int ai = 0; ai < 2; ++ai)
#pragma unroll
            for (int m = 0; m < 4; ++m) { const size_t off = (size_t)(row0 + ai * 128 + m * 16) * DM + col0;
#pragma unroll
                for (int bj = 0; bj < 2; ++bj)
#pragma unroll
                    for (int n = 0; n < 2; ++n) { const pg8::f32x4 xv = *(const pg8::f32x4*)(x + off + bj * 128 + n * 16); *(pg8::f32x4*)(h + off + bj * 128 + n * 16) = xv + acc[ai][bj][m][n]; } }
    }
};
struct MoeOrder {
    int nM, nN, nwg, G, c; const int* tile_exp;
    __device__ __forceinline__ void init(const int* meta, int nN_, int G_, int c_) { nM = meta[0]; nN = nN_; nwg = nM * nN; G = G_; c = c_; tile_exp = meta + 64; }
    __device__ __forceinline__ bool next(int i, pg8::Unit& u) const {
        const long L = (long)i * G + c; if (L >= nwg) return false;
        pg8::tile_of((int)L, nM, nN, u.pm, u.pn); u.kind = tile_exp[u.pm]; return true;
    }
    __device__ __forceinline__ const char* pa(const pg8::Gemm& g, const pg8::Unit& u) const { return (const char*)g.A + (size_t)u.pm * ((size_t)256 * g.K * 2); }
    __device__ __forceinline__ const char* pb(const pg8::Gemm& g, const pg8::Unit& u) const { return (const char*)g.Bt + ((size_t)u.kind * nN + u.pn) * ((size_t)256 * g.K * 2); }
    __device__ __forceinline__ void a_ready(const pg8::Unit&) const {}
    __device__ __forceinline__ void done(const pg8::Unit&) const {}
};

struct MoeOrderSync : MoeOrder {
    unsigned* xl; unsigned x, nloc; int full_rounds; mutable int calls;
    __device__ __forceinline__ void init_sync(unsigned* xl_, unsigned x_, unsigned nloc_) { xl = xl_; x = x_; nloc = nloc_ ? nloc_ : 1u; full_rounds = nwg / G; calls = 0; }
    __device__ __forceinline__ void a_ready(const pg8::Unit&) const {
        if (calls < full_rounds) {
            if (threadIdx.x == 0) { unsigned* sub = xl + 64 * x; unsigned* genw = xl + 1024 + 64 * x;
                const unsigned old = __hip_atomic_fetch_add(sub, 1u, __ATOMIC_RELAXED, __HIP_MEMORY_SCOPE_AGENT), gen = old / nloc;
                if (old + 1u == (gen + 1u) * nloc) __hip_atomic_fetch_add(genw, 1u, __ATOMIC_RELAXED, __HIP_MEMORY_SCOPE_AGENT);
                else { unsigned sp = 0; while (__hip_atomic_load(genw, __ATOMIC_RELAXED, __HIP_MEMORY_SCOPE_AGENT) == gen) { __builtin_amdgcn_s_sleep(1); if (++sp > (1u << 16)) break; } } }
            asm volatile("" ::: "memory"); __builtin_amdgcn_s_barrier(); asm volatile("" ::: "memory"); }
        ++calls;
    }
};
struct EpiSwiglu {
    static constexpr bool PERM = true, AFTER_DRAIN = false;
    const float* b1; bf16* act;
    __device__ __forceinline__ void operator()(const pg8::f32x4 (&acc)[2][2][4][2], const pg8::Unit& u, int wr, int wc, int fr, int fq) const {
        const int e = u.kind; const int col = u.pn * 128 + wc * 32 + 8 * fq; const int row0 = u.pm * 256 + wr * 64 + fr;
        const float* bg = b1 + (size_t)e * 4096 + col; const float* bl = bg + 2048;
        const pg8::f32x4 g0 = *(const pg8::f32x4*)bg, g1 = *(const pg8::f32x4*)(bg + 4), l0 = *(const pg8::f32x4*)bl, l1 = *(const pg8::f32x4*)(bl + 4);
#pragma unroll
        for (int ai = 0; ai < 2; ++ai)
#pragma unroll
            for (int m = 0; m < 4; ++m) { float o[8];
#pragma unroll
                for (int n = 0; n < 2; ++n)
#pragma unroll
                    for (int j = 0; j < 4; ++j) { float gl = acc[ai][0][m][n][j] + (n ? g1[j] : g0[j]); float li = acc[ai][1][m][n][j] + (n ? l1[j] : l0[j]);
                        gl = fminf(gl, 7.f); li = fminf(fmaxf(li, -7.f), 7.f);
                        o[n * 4 + j] = gl * (1.f / (1.f + __expf(-1.702f * gl))) * (li + 1.f); }
                pg8::u32x4 w; w.x = pg8::cvt_pk_bf16(o[0], o[1]); w.y = pg8::cvt_pk_bf16(o[2], o[3]); w.z = pg8::cvt_pk_bf16(o[4], o[5]); w.w = pg8::cvt_pk_bf16(o[6], o[7]);
                *(pg8::u32x4*)(act + (size_t)(row0 + ai * 128 + m * 16) * DFF + col) = w; }
    }
};
struct EpiDown {
    static constexpr bool PERM = true, AFTER_DRAIN = false;
    const float* b2; const float* roww; bf16* y;
    __device__ __forceinline__ void operator()(const pg8::f32x4 (&acc)[2][2][4][2], const pg8::Unit& u, int wr, int wc, int fr, int fq) const {
        const int e = u.kind; const int col0 = u.pn * 256 + wc * 32 + 8 * fq; const int row0 = u.pm * 256 + wr * 64 + fr;
        pg8::f32x4 bv[2][2];
#pragma unroll
        for (int bj = 0; bj < 2; ++bj)
#pragma unroll
            for (int n = 0; n < 2; ++n) bv[bj][n] = *(const pg8::f32x4*)(b2 + (size_t)e * DM + col0 + bj * 128 + 4 * n);
#pragma unroll
        for (int ai = 0; ai < 2; ++ai)
#pragma unroll
            for (int m = 0; m < 4; ++m) { const int r = row0 + ai * 128 + m * 16; const float g = roww[r];
#pragma unroll
                for (int bj = 0; bj < 2; ++bj) { const pg8::f32x4 v0 = (acc[ai][bj][m][0] + bv[bj][0]) * g, v1 = (acc[ai][bj][m][1] + bv[bj][1]) * g;
                    pg8::u32x4 w; w.x = pg8::cvt_pk_bf16(v0[0], v0[1]); w.y = pg8::cvt_pk_bf16(v0[2], v0[3]); w.z = pg8::cvt_pk_bf16(v1[0], v1[1]); w.w = pg8::cvt_pk_bf16(v1[2], v1[3]);
                    *(pg8::u32x4*)(y + (size_t)r * DM + col0 + bj * 128) = w; } }
    }
};

__device__ __forceinline__ void ph_loga(const Params& p, size_t i0, size_t istride) {
    const bf16* SM = (const bf16*)(p.ws + WS_SM); float* LA = (float*)(p.ws + WS_LA); const float* wa2 = p.in[I_WA2]; const float* ba = p.in[I_BA];
    for (size_t i = i0; i < (size_t)T * 512; i += istride) {
        const int t = (int)(i >> 9), c = (int)(i & 511); float z = ba[c];
#pragma unroll
        for (int r = 0; r < 16; ++r) z += bf2f(SM[(size_t)t * 64 + r]) * wa2[r * 512 + c];
        LA[i] = (fminf(z, 0.f) - log1pf(__expf(-fabsf(z)))) * (1.f / 16.f);
    }
}
__device__ __forceinline__ void ph_gla_naive(const Params& p, LAS float* qs, int unit, int lane) {
    LAS float* ks = qs + 128; LAS float* as = qs + 256;
    const int bh = unit >> 2, sl = unit & 3, b = bh >> 2, h = bh & 3, dv = sl * 64 + lane;
    const bf16* GQ = (const bf16*)(p.ws + WS_GQ); const bf16* GK = (const bf16*)(p.ws + WS_GK); const bf16* GV = (const bf16*)(p.ws + WS_GV);
    const float* LA = (const float*)(p.ws + WS_LA); float* OG = (float*)(p.ws + WS_OG);
    float st[128];
#pragma unroll
    for (int i = 0; i < 128; ++i) st[i] = 0.f;
    for (int s = 0; s < SEQ; ++s) { const size_t row = (size_t)b * SEQ + s;
#pragma unroll
        for (int j = 0; j < 2; ++j) { const int dk = lane + 64 * j; qs[dk] = bf2f(GQ[row * 512 + h * 128 + dk]); ks[dk] = bf2f(GK[row * 512 + h * 128 + dk]); as[dk] = __expf(LA[row * 512 + h * 128 + dk]); }
        LDS_WAIT(); __builtin_amdgcn_wave_barrier();
        const float v = bf2f(GV[row * 1024 + h * 256 + dv]); float o = 0.f;
#pragma unroll
        for (int dk = 0; dk < 128; ++dk) { st[dk] = as[dk] * st[dk] + ks[dk] * v; o += qs[dk] * st[dk]; }
        OG[row * 1024 + h * 256 + dv] = o;
        LDS_WAIT(); __builtin_amdgcn_wave_barrier();
    }
}
template <bool DO_NSA> __device__ __forceinline__ void ph_mix_post(const Params& p, int gw, int NGW, int lane) {
    const float* OG = (const float*)(p.ws + WS_OG); const float* ON = (const float*)(p.ws + WS_ON); const bf16* GG = (const bf16*)(p.ws + WS_GG); bf16* A2 = (bf16*)(p.ws + WS_A2);
    const float* gn = p.in[I_GLAG]; const float* ng = p.in[I_NSAG];
    for (int t = gw; t < T; t += NGW) {
#pragma unroll
        for (int h = 0; h < 4; ++h) { const f32x4 o = *((const f32x4*)(OG + (size_t)t * 1024 + h * 256) + lane);
            const float ms = wave_sum(o.x * o.x + o.y * o.y + o.z * o.z + o.w * o.w) * (1.f / 256.f); const float rstd = 1.f / sqrtf(ms + RMS_EPS);
            const f32x4 g4 = ((const f32x4*)gn)[lane]; const v2u gg = *((const v2u*)(GG + (size_t)t * 1024 + h * 256) + lane);
            const float z0 = bflo(gg.x), z1 = bfhi(gg.x), z2 = bflo(gg.y), z3 = bfhi(gg.y);
            v2u w; w.x = pk2(o.x * rstd * g4.x * (z0 / (1.f + __expf(-z0))), o.y * rstd * g4.y * (z1 / (1.f + __expf(-z1))));
            w.y = pk2(o.z * rstd * g4.z * (z2 / (1.f + __expf(-z2))), o.w * rstd * g4.w * (z3 / (1.f + __expf(-z3))));
            *((v2u*)(A2 + (size_t)t * DM + h * 256) + lane) = w; }
        if (!DO_NSA) continue;
        f32x4 v[4]; float s = 0.f;
#pragma unroll
        for (int j = 0; j < 4; ++j) { v[j] = *((const f32x4*)(ON + (size_t)t * 1024) + lane + 64 * j); s += v[j].x * v[j].x + v[j].y * v[j].y + v[j].z * v[j].z + v[j].w * v[j].w; }
        const float rstd = 1.f / sqrtf(wave_sum(s) * (1.f / 1024.f) + RMS_EPS);
#pragma unroll
        for (int j = 0; j < 4; ++j) { const f32x4 g4 = ((const f32x4*)ng)[lane + 64 * j]; v2u w; w.x = pk2(v[j].x * rstd * g4.x, v[j].y * rstd * g4.y); w.y = pk2(v[j].z * rstd * g4.z, v[j].w * rstd * g4.w);
            *((v2u*)(A2 + (size_t)t * DM + 1024) + lane + 64 * j) = w; }
    }
}
__device__ __forceinline__ float gelu_tanh(float x) { const float u = 0.7978845608028654f * (x + 0.044715f * x * x * x); const float e = __expf(2.f * u); return 0.5f * x * (1.f + (1.f - 2.f / (e + 1.f))); }
__device__ __forceinline__ void ph_cmp_naive(const Params& p, LAS float* tl, int id, int n) {
    LAS float* hid = tl + 4096;
    const int which = id / (16 * 255), rem = id % (16 * 255), bg = rem / 255, c = rem % 255;
    const bf16* src = (const bf16*)(p.ws + (which ? WS_VC : WS_KC)) + ((size_t)bg * SEQ + 16 * c) * 128;
    const float* pe = p.in[which ? I_PEV : I_PEK]; const float* w1 = p.in[which ? I_WV1 : I_WK1]; const float* w2 = p.in[which ? I_WV2 : I_WK2];
    for (int i = n; i < 4096; i += 128) tl[i] = bf2f(src[i]) + pe[i];
    __syncthreads();
    float a = 0.f;
    for (int k = 0; k < 4096; ++k) a += tl[k] * w1[(size_t)k * 128 + n];
    hid[n] = gelu_tanh(a);
    __syncthreads();
    float o = 0.f;
    for (int m = 0; m < 128; ++m) o += hid[m] * w2[m * 128 + n];
    if (which == 0) ((bf16*)(p.ws + WS_KCMP))[((size_t)bg * 256 + c) * 128 + n] = (bf16)f2bf(o);
    else ((bf16*)(p.ws + WS_VCMPT))[((size_t)bg * 128 + n) * 256 + c] = (bf16)f2bf(o);
}
__device__ __forceinline__ void ph_cmp_fin_simple(const Params& p, LAS float* tl, int id, int n, const float* LHall, const float* PEVall) {
    LAS float* hid = tl + 4096;
    const int which = id / (16 * 255), rem = id % (16 * 255), bg = rem / 255, c = rem % 255;
    const float* w2 = p.in[which ? I_WV2 : I_WK2];
    const float* LH = LHall + ((size_t)which * 4096 + bg * 256) * 256;
    float pev = 0.f;
#pragma unroll 8
    for (int q = 0; q < 64; ++q) pev += PEVall[(size_t)(which * 64 + q) * 128 + n];
    const float a = LH[(size_t)c * 256 + n] + LH[(size_t)(c + 1) * 256 + 128 + n] + pev;
    hid[n] = gelu_tanh(a);
    __syncthreads();
    float o = 0.f;
    for (int m = 0; m < 128; ++m) o += hid[m] * w2[m * 128 + n];
    if (which == 0) ((bf16*)(p.ws + WS_KCMP))[((size_t)bg * 256 + c) * 128 + n] = (bf16)f2bf(o);
    else ((bf16*)(p.ws + WS_VCMPT))[((size_t)bg * 128 + n) * 256 + c] = (bf16)f2bf(o);
}
__device__ __forceinline__ float dot128(const LAS float* q, const bf16* k) {
    float a = 0.f;
#pragma unroll
    for (int i = 0; i < 16; ++i) { const v4u w = ((const v4u*)k)[i];
        a += q[8 * i] * bflo(w.x) + q[8 * i + 1] * bfhi(w.x) + q[8 * i + 2] * bflo(w.y) + q[8 * i + 3] * bfhi(w.y) + q[8 * i + 4] * bflo(w.z) + q[8 * i + 5] * bfhi(w.z) + q[8 * i + 6] * bflo(w.w) + q[8 * i + 7] * bfhi(w.w); }
    return a;
}
__device__ __forceinline__ void ph_nsa_naive(const Params& p, LAS float* base, int vblk, int r, int lane) {
    LAS float (*qf)[128] = (LAS float (*)[128])base; LAS float (*lg)[1024] = (LAS float (*)[1024])(base + 512); LAS unsigned long long& selm = *(LAS unsigned long long*)(base + 512 + 4096);
    const int s = vblk & (SEQ - 1), bg = vblk >> 12, b = bg >> 1, g = bg & 1, h = g * 4 + r;
    const size_t row = (size_t)b * SEQ + s;
    const bf16* NQ = (const bf16*)(p.ws + WS_NQ); const bf16* SM = (const bf16*)(p.ws + WS_SM);
    const bf16* KCMP = (const bf16*)(p.ws + WS_KCMP) + (size_t)bg * 256 * 128; const bf16* VCMPT = (const bf16*)(p.ws + WS_VCMPT) + (size_t)bg * 128 * 256;
    const bf16* KS = (const bf16*)(p.ws + WS_KS) + (size_t)bg * SEQ * 128; const bf16* KW = (const bf16*)(p.ws + WS_KW) + (size_t)bg * SEQ * 128;
    const bf16* VST = (const bf16*)(p.ws + WS_VST) + (size_t)bg * 128 * SEQ; const bf16* VWT = (const bf16*)(p.ws + WS_VWT) + (size_t)bg * 128 * SEQ;
    const float* relb = p.in[I_RELB]; float* ON = (float*)(p.ws + WS_ON);
    qf[r][lane] = bf2f(NQ[row * 1024 + h * 128 + lane]); qf[r][lane + 64] = bf2f(NQ[row * 1024 + h * 128 + lane + 64]);
    __syncthreads();
    const LAS float* q = qf[r]; LAS float* L = lg[r];
    float ot0 = 0.f, ot1 = 0.f;
    const float gt0 = 1.f / (1.f + __expf(-bf2f(SM[row * 64 + 16 + h]))), gt1 = 1.f / (1.f + __expf(-bf2f(SM[row * 64 + 24 + h]))), gt2 = 1.f / (1.f + __expf(-bf2f(SM[row * 64 + 32 + h])));
#define BIAS(dist) relb[(int)kBucket[(dist) > 127 ? 127 : (dist)] * 8 + h]
    const int ncv = (s >= 31) ? ((s - 31) >> 4) + 1 : 0;
    if (ncv > 0) {
        float mx = -3e38f;
        for (int c = lane; c < ncv; c += 64) { const float l = dot128(q, KCMP + (size_t)c * 128) + BIAS(s - (16 * c + 31)); L[c] = l; mx = fmaxf(mx, l); }
        mx = wave_max(mx); float sum = 0.f;
        for (int c = lane; c < ncv; c += 64) { const float e = __expf(L[c] - mx); L[c] = e; sum += e; }
        sum = wave_sum(sum); const float inv = 1.f / sum;
        for (int c = lane; c < ncv; c += 64) L[c] *= inv;
        LDS_WAIT(); __builtin_amdgcn_wave_barrier();
        float o0 = 0.f, o1 = 0.f;
        for (int c = 0; c < ncv; ++c) { const float pr = L[c]; o0 += pr * bf2f(VCMPT[(size_t)lane * 256 + c]); o1 += pr * bf2f(VCMPT[(size_t)(lane + 64) * 256 + c]); }
        ot0 += gt0 * o0; ot1 += gt0 * o1;
    }
    __syncthreads();
    const int cur = s >> 6;
    if (r == 0) { const int n = lane; float sc;
        if (n == 0 || n == cur || n == cur - 1) sc = 1e4f;
        else if (n <= cur) { float im = 0.f; for (int rr = 0; rr < 4; ++rr) for (int c = 4 * n - 1; c <= 4 * n + 3; ++c) if (c >= 0 && c < ncv) im += lg[rr][c]; sc = im; }
        else sc = -1.f;
        int rank = 0;
        for (int m = 0; m < 64; ++m) { const float sm = __shfl(sc, m); rank += (sm > sc || (sm == sc && m < n)) ? 1 : 0; }
        const unsigned long long mk = __ballot(rank < 16);
        if (lane == 0) selm = mk; }
    __syncthreads();
    { unsigned long long mask = selm & (cur == 63 ? ~0ull : ((1ull << (cur + 1)) - 1ull));
      int cnt = 0; float mx = -3e38f;
      for (unsigned long long mm = mask; mm; mm &= mm - 1) { const int n = __builtin_ctzll(mm); const int kpos = n * 64 + lane; float l = -3e38f;
          if (kpos <= s) l = dot128(q, KS + (size_t)kpos * 128) + BIAS(s - kpos);
          L[cnt * 64 + lane] = l; mx = fmaxf(mx, l); ++cnt; }
      mx = wave_max(mx); float sum = 0.f;
      for (int j = 0; j < cnt; ++j) { const float l = L[j * 64 + lane]; const float e = l > -1e38f ? __expf(l - mx) : 0.f; L[j * 64 + lane] = e; sum += e; }
      sum = wave_sum(sum); const float inv = 1.f / sum;
      LDS_WAIT(); __builtin_amdgcn_wave_barrier();
      float o0 = 0.f, o1 = 0.f; int j = 0;
      for (unsigned long long mm = mask; mm; mm &= mm - 1, ++j) { const int n = __builtin_ctzll(mm);
          for (int kk = 0; kk < 64; ++kk) { const float pr = L[j * 64 + kk]; o0 += pr * bf2f(VST[(size_t)lane * SEQ + n * 64 + kk]); o1 += pr * bf2f(VST[(size_t)(lane + 64) * SEQ + n * 64 + kk]); } }
      ot0 += gt1 * o0 * inv; ot1 += gt1 * o1 * inv; }
    LDS_WAIT(); __builtin_amdgcn_wave_barrier();
    { const int lo = s >= 511 ? s - 511 : 0, nk = s - lo + 1; float mx = -3e38f;
      for (int i = lane; i < nk; i += 64) { const int kpos = lo + i; const float l = dot128(q, KW + (size_t)kpos * 128) + BIAS(s - kpos); L[i] = l; mx = fmaxf(mx, l); }
      mx = wave_max(mx); float sum = 0.f;
      for (int i = lane; i < nk; i += 64) { const float e = __expf(L[i] - mx); L[i] = e; sum += e; }
      sum = wave_sum(sum); const float inv = 1.f / sum;
      LDS_WAIT(); __builtin_amdgcn_wave_barrier();
      float o0 = 0.f, o1 = 0.f;
      for (int i = 0; i < nk; ++i) { const float pr = L[i]; o0 += pr * bf2f(VWT[(size_t)lane * SEQ + lo + i]); o1 += pr * bf2f(VWT[(size_t)(lane + 64) * SEQ + lo + i]); }
      ot0 += gt2 * o0 * inv; ot1 += gt2 * o1 * inv; }
#undef BIAS
    ON[row * 1024 + h * 128 + lane] = ot0; ON[row * 1024 + h * 128 + lane + 64] = ot1;
}

namespace nsa {
constexpr int KB0 = 0, KB1 = 16384, VB0 = 32768, VB1 = 49152, LUT = 65536;
constexpr int QST = LUT + 4096, IMP = QST + 65536, SELM = IMP + 16384, LDS_END = SELM + 512;
constexpr float LOG2E = 1.4426950408889634f;
typedef float f4 __attribute__((ext_vector_type(4)));

typedef unsigned u2v __attribute__((ext_vector_type(2)));
__device__ __forceinline__ float rmax16(float x) { const unsigned u = __float_as_uint(x); const u2v r = __builtin_amdgcn_permlane16_swap(u, u, false, false); return fmaxf(__uint_as_float(r[0]), __uint_as_float(r[1])); }
__device__ __forceinline__ float rmax32(float x) { const unsigned u = __float_as_uint(x); const u2v r = __builtin_amdgcn_permlane32_swap(u, u, false, false); return fmaxf(__uint_as_float(r[0]), __uint_as_float(r[1])); }
__device__ __forceinline__ float radd16(float x) { const unsigned u = __float_as_uint(x); const u2v r = __builtin_amdgcn_permlane16_swap(u, u, false, false); return __uint_as_float(r[0]) + __uint_as_float(r[1]); }
__device__ __forceinline__ float radd32(float x) { const unsigned u = __float_as_uint(x); const u2v r = __builtin_amdgcn_permlane32_swap(u, u, false, false); return __uint_as_float(r[0]) + __uint_as_float(r[1]); }
__device__ __forceinline__ float raddq(float x) { x += __int_as_float(__builtin_amdgcn_update_dpp(0, __float_as_int(x), 0xB1, 0xF, 0xF, true)); x += __int_as_float(__builtin_amdgcn_update_dpp(0, __float_as_int(x), 0x4E, 0xF, 0xF, true)); return x; }
struct Ctx {
    LAS unsigned char* lds; int tid, lane, wave, c, gq, r;
    int s0, cur;
    const LAS unsigned char* qst;
    int pos0;
    const LAS float* lutrow;
    int koff0, voff0;
    unsigned kdo[2], vdoc[2], vdos[2];
};
__device__ __forceinline__ void dma_k(const Ctx& C, const bf16* kt, LAS unsigned char* kb) {
#pragma unroll
    for (int i = 0; i < 2; ++i) __builtin_amdgcn_global_load_lds((const unsigned*)((const char*)kt + C.kdo[i]), (LAS unsigned*)(kb + (2 * C.wave + i) * 1024), 16, 0, 0); }
__device__ __forceinline__ void dma_v(const Ctx& C, const bf16* vt, const unsigned (&vdo)[2], LAS unsigned char* vb) {
#pragma unroll
    for (int i = 0; i < 2; ++i) __builtin_amdgcn_global_load_lds((const unsigned*)((const char*)vt + vdo[i]), (LAS unsigned*)(vb + (2 * C.wave + i) * 1024), 16, 0, 0); }

__device__ __forceinline__ void compute_st(const Ctx& C, const LAS unsigned char* kb, f4 (&s)[2][4]) {
#pragma unroll
    for (int ks = 0; ks < 4; ++ks) { const bf16x8 q0 = *(const LAS bf16x8*)(C.qst + ks * 1024), q1 = *(const LAS bf16x8*)(C.qst + (4 + ks) * 1024);
#pragma unroll
        for (int kt = 0; kt < 4; ++kt) { const bf16x8 a = *(const LAS bf16x8*)(kb + kt * 4096 + (C.koff0 ^ (ks * 64)));
            s[0][kt] = __builtin_amdgcn_mfma_f32_16x16x32_bf16(a, q0, ks == 0 ? (f4){0.f, 0.f, 0.f, 0.f} : s[0][kt], 0, 0, 0);
            s[1][kt] = __builtin_amdgcn_mfma_f32_16x16x32_bf16(a, q1, ks == 0 ? (f4){0.f, 0.f, 0.f, 0.f} : s[1][kt], 0, 0, 0); }
        asm volatile("" ::: "memory"); }
}
__device__ __forceinline__ void compute_pv(const Ctx& C, const LAS unsigned char* vb, const f4 (&p)[2][4], f4 (&o)[2][8]) {
#pragma unroll
    for (int i = 0; i < 2; ++i) { bf16x8 pb[2];
#pragma unroll
        for (int qt = 0; qt < 2; ++qt) { v4u w; w.x = pg8::cvt_pk_bf16(p[qt][2 * i][0], p[qt][2 * i][1]); w.y = pg8::cvt_pk_bf16(p[qt][2 * i][2], p[qt][2 * i][3]);
            w.z = pg8::cvt_pk_bf16(p[qt][2 * i + 1][0], p[qt][2 * i + 1][1]); w.w = pg8::cvt_pk_bf16(p[qt][2 * i + 1][2], p[qt][2 * i + 1][3]); pb[qt] = __builtin_bit_cast(bf16x8, w); }
#pragma unroll
        for (int dt = 0; dt < 8; ++dt) { const v2u lo = *(const LAS v2u*)(vb + dt * 2048 + (C.voff0 ^ (i * 64))), hi = *(const LAS v2u*)(vb + dt * 2048 + (C.voff0 ^ (i * 64 + 32))); const bf16x8 a = __builtin_bit_cast(bf16x8, (v4u){lo.x, lo.y, hi.x, hi.y});
#pragma unroll
            for (int qt = 0; qt < 2; ++qt) o[qt][dt] = __builtin_amdgcn_mfma_f32_16x16x32_bf16(a, pb[qt], o[qt][dt], 0, 0, 0);
            if (dt & 1) asm volatile("" ::: "memory"); } }
}
enum { M_CMP = 0, M_SEL = 1, M_WIN = 2 };
template <int MODE, bool FAR = false>
__device__ __forceinline__ void mask_bias(const Ctx& C, f4 (&s)[2][4], int kb, int n, const LAS unsigned* selw) {
    const float NEG = -__builtin_inff();
#pragma unroll
    for (int qt = 0; qt < 2; ++qt) {
        bool tokok = true;
        if (MODE == M_SEL) tokok = ((selw[(4 * qt + (C.c >> 2)) * 2 + (n >> 5)] >> (n & 31)) & 1u) != 0u;
        if (FAR) { const float be = tokok ? C.lutrow[127] : NEG;
#pragma unroll
            for (int kt = 0; kt < 4; ++kt)
#pragma unroll
                for (int rg = 0; rg < 4; ++rg) s[qt][kt][rg] = __builtin_fmaf(s[qt][kt][rg], LOG2E, be);
            continue; }
        const int dbase = (MODE == M_CMP) ? (C.pos0 + 4 * qt - 31 - 16 * (kb + 4 * C.gq)) : (C.pos0 + 4 * qt - (kb + 4 * C.gq));
#pragma unroll
        for (int kt = 0; kt < 4; ++kt) {
#pragma unroll
            for (int rg = 0; rg < 4; ++rg) { const int d = (MODE == M_CMP) ? dbase - 16 * (16 * kt + rg) : dbase - (16 * kt + rg);
                int di = d < 0 ? 0 : d; di = di > 127 ? 127 : di; const float bias = C.lutrow[di];
                bool ok = tokok && d >= 0; if (MODE == M_WIN) ok = ok && d < 512;
                s[qt][kt][rg] = ok ? __builtin_fmaf(s[qt][kt][rg], LOG2E, bias) : NEG; }
            asm volatile("" ::: "memory"); }
    }
}
__device__ __forceinline__ void softmax_step(f4 (&s)[2][4], float (&m)[2], float (&l)[2], f4 (&o)[2][8], bool rescale_o) {
#pragma unroll
    for (int qt = 0; qt < 2; ++qt) { float mx = s[qt][0][0];
#pragma unroll
        for (int kt = 0; kt < 4; ++kt)
#pragma unroll
            for (int rg = 0; rg < 4; ++rg) mx = fmaxf(mx, s[qt][kt][rg]);
        mx = rmax32(rmax16(mx));
        const float mn = fmaxf(m[qt], mx), alpha = __builtin_amdgcn_exp2f(m[qt] - mn); m[qt] = mn; float ps = 0.f;
#pragma unroll
        for (int kt = 0; kt < 4; ++kt)
#pragma unroll
            for (int rg = 0; rg < 4; ++rg) { const float e = __builtin_amdgcn_exp2f(s[qt][kt][rg] - mn); s[qt][kt][rg] = e; ps += e; }
        l[qt] = l[qt] * alpha + ps;
        if (rescale_o && __any(alpha != 1.f)) {
#pragma unroll
            for (int dt = 0; dt < 8; ++dt) o[qt][dt] = o[qt][dt] * alpha; }
    }
}
}

__device__ __forceinline__ void ph_nsa(const Params& p, LAS unsigned char* lds, int idx0, int idxstride, int tid_in, int wave) {
    using namespace nsa;
    int tid = tid_in; asm volatile("" : "+v"(tid));
    const int lane = tid & 63;
    Ctx C; C.lds = lds; C.tid = tid; C.lane = lane; C.wave = wave; C.c = lane & 15; C.gq = lane >> 4; C.r = lane & 3;
    C.koff0 = C.c * 256 + ((C.gq ^ C.c) * 16);
#pragma unroll
    for (int i = 0; i < 2; ++i) { const int piece = 2 * wave + i;
        { const int row = piece * 4 + (lane >> 4), chunk = (lane & 15) ^ (row & 15); C.kdo[i] = (unsigned)(row * 256 + chunk * 16); }
        { const int row = piece * 8 + (lane >> 3), chunk = (lane & 7) ^ ((row >> 1) & 7); C.vdoc[i] = (unsigned)(row * 256 * 2 + chunk * 16); C.vdos[i] = (unsigned)(row * SEQ * 2 + chunk * 16); } }
    C.voff0 = C.c * 128 + (((C.gq >> 1) ^ ((C.c >> 1) & 7)) * 16) + (C.gq & 1) * 8;
    const bf16* NQ = (const bf16*)(p.ws + WS_NQ); const bf16* SM = (const bf16*)(p.ws + WS_SM); bf16* A2 = (bf16*)(p.ws + WS_A2);
    const float* relb = p.in[I_RELB]; const float* nsag = p.in[I_NSAG];
    LAS float* lut = (LAS float*)(lds + LUT);
    for (int i = tid; i < 8 * 128; i += 512) { const int hh = i >> 7, d = i & 127; lut[i] = relb[(int)kBucket[d] * 8 + hh] * LOG2E; }
    __syncthreads();
    LAS unsigned char* qstw = lds + QST + wave * 8192 + lane * 16; C.qst = qstw;
    LAS float* imp = (LAS float*)(lds + IMP + wave * 2048);
    LAS unsigned long long* selm = (LAS unsigned long long*)(lds + SELM + wave * 64);
#define NSA_SYNC() do { asm volatile("s_waitcnt vmcnt(0)" ::: "memory"); __syncthreads(); } while (0)
    for (int idx = idx0; idx < 512; idx += idxstride) {
        const int rnd = idx >> 8, kq = idx & 255, b = kq & 7, tq = rnd == 0 ? 63 - (kq >> 3) : (kq >> 3);
        C.s0 = tq * 64; C.cur = tq;
        const int tokl0 = 8 * wave + (C.c >> 2);
        C.pos0 = C.s0 + tokl0;
        float ssq[2] = {0.f, 0.f};
        for (int g = 0; g < 2; ++g) {
            const int bg = b * 2 + g, h = g * 4 + C.r;
            C.lutrow = lut + h * 128;
            const bf16* KCMP = (const bf16*)(p.ws + WS_KCMP) + (size_t)bg * 256 * 128; const bf16* VCMPT = (const bf16*)(p.ws + WS_VCMPT) + (size_t)bg * 128 * 256;
#pragma unroll
            for (int qt = 0; qt < 2; ++qt) { const unsigned qo = (unsigned)(((b * SEQ + (C.pos0 + 4 * qt)) * 1024 + h * 128 + 8 * C.gq) * 2);
#pragma unroll
                for (int ks = 0; ks < 4; ++ks) *(LAS bf16x8*)(qstw + (qt * 4 + ks) * 1024) = *(const bf16x8*)((const char*)NQ + qo + ks * 64); }
#pragma unroll
            for (int i = 0; i < 2; ++i) *(LAS f32x4*)((LAS unsigned char*)imp + lane * 16 + i * 1024) = (f32x4){0.f, 0.f, 0.f, 0.f};
#define NSA_OROW(qt) ((char*)A2 + (unsigned)(((b * SEQ + C.pos0 + 4 * (qt)) * DM + 1024 + h * 128 + 4 * C.gq) * 2))
            const int cmaxb = C.s0 + 63 - 31; const int nct = cmaxb >= 0 ? ((cmaxb >> 4) >> 6) + 1 : 0;
            float m[2] = {-1e30f, -1e30f}, l[2] = {0.f, 0.f};
            f4 o[2][8];
            if (nct > 0) {
                dma_k(C, KCMP, lds + KB0); NSA_SYNC();
                for (int ct = 0; ct < nct; ++ct) { const int buf = ct & 1;
                    if (ct + 1 < nct) dma_k(C, KCMP + (ct + 1) * 64 * 128, lds + (buf ? KB0 : KB1));
                    f4 s[2][4]; compute_st(C, lds + (buf ? KB1 : KB0), s); mask_bias<M_CMP>(C, s, 64 * ct, 0, (const LAS unsigned*)selm); softmax_step(s, m, l, o, false);
                    NSA_SYNC(); }
            }
            float inv[2];
#pragma unroll
            for (int qt = 0; qt < 2; ++qt) { const float lt = radd32(radd16(l[qt])); inv[qt] = lt > 0.f ? 1.f / lt : 0.f; }
#pragma unroll
            for (int qt = 0; qt < 2; ++qt)
#pragma unroll
                for (int dt = 0; dt < 8; ++dt) o[qt][dt] = (f4){0.f, 0.f, 0.f, 0.f};
            if (nct > 0) {
                dma_k(C, KCMP, lds + KB0); dma_v(C, VCMPT, C.vdoc, lds + VB0); NSA_SYNC();
                for (int ct = 0; ct < nct; ++ct) { const int buf = ct & 1;
                    if (ct + 1 < nct) { dma_k(C, KCMP + (ct + 1) * 64 * 128, lds + (buf ? KB0 : KB1)); dma_v(C, VCMPT + 64 * (ct + 1), C.vdoc, lds + (buf ? VB0 : VB1)); }
                    f4 s[2][4]; compute_st(C, lds + (buf ? KB1 : KB0), s); mask_bias<M_CMP>(C, s, 64 * ct, 0, (const LAS unsigned*)selm);
#pragma unroll
                    for (int qt = 0; qt < 2; ++qt)
#pragma unroll
                        for (int kt = 0; kt < 4; ++kt) {
#pragma unroll
                            for (int rg = 0; rg < 4; ++rg) s[qt][kt][rg] = __builtin_amdgcn_exp2f(s[qt][kt][rg] - m[qt]) * inv[qt];
                            float po = (s[qt][kt][0] + s[qt][kt][1]) + (s[qt][kt][2] + s[qt][kt][3]), p3 = s[qt][kt][3];
                            po = raddq(po); p3 = raddq(p3);
                            const int nb = 16 * ct + 4 * kt + C.gq, tl = 4 * qt + (C.c >> 2);
                            if (C.r == 0) { __hip_atomic_fetch_add((float*)(imp + tl * 64 + nb), po, __ATOMIC_RELAXED, __HIP_MEMORY_SCOPE_WORKGROUP); if (nb + 1 < 64) __hip_atomic_fetch_add((float*)(imp + tl * 64 + nb + 1), p3, __ATOMIC_RELAXED, __HIP_MEMORY_SCOPE_WORKGROUP); } }
                    compute_pv(C, lds + (buf ? VB1 : VB0), s, o);
                    NSA_SYNC(); }
            }
            LDS_WAIT(); __builtin_amdgcn_wave_barrier();
            for (int tk = 0; tk < 8; ++tk) { const int n = lane; float sc;
                if (n == 0 || n == C.cur || n == C.cur - 1) sc = 1e4f; else if (n <= C.cur) sc = imp[tk * 64 + n]; else sc = -1.f;
                const int key = ((sc < 0.f ? 0 : __float_as_int(sc) + 64) & ~63) | (63 - n);
                int rank = 0;
#pragma unroll
                for (int mm = 0; mm < 64; ++mm) rank += (__builtin_amdgcn_readlane(key, mm) > key) ? 1 : 0;
                const unsigned long long mk = __ballot(rank < 16);
                if (lane == 0) selm[tk] = mk; }
            LDS_WAIT(); __builtin_amdgcn_wave_barrier();
#pragma unroll
            for (int qt = 0; qt < 2; ++qt) { const float gt = 1.f / (1.f + __expf(-bf2f(*(const bf16*)((const char*)SM + (unsigned)(((b * SEQ + (C.pos0 + 4 * qt)) * 64 + 16 + h) * 2)))));
#pragma unroll
                for (int dt = 0; dt < 8; ++dt) { const f4 v = o[qt][dt] * gt; *(v2u*)(NSA_OROW(qt) + 32 * dt) = (v2u){pg8::cvt_pk_bf16(v[0], v[1]), pg8::cvt_pk_bf16(v[2], v[3])}; } }
#pragma unroll
            for (int br = 1; br <= 2; ++br) {
                const bf16* KX = (const bf16*)(p.ws + (br == 1 ? WS_KS : WS_KW)) + bg * SEQ * 128; const bf16* VX = (const bf16*)(p.ws + (br == 1 ? WS_VST : WS_VWT)) + bg * 128 * SEQ;
                const int n0 = br == 1 ? 0 : (C.cur >= 8 ? C.cur - 8 : 0), n1 = C.cur;
                m[0] = m[1] = -1e30f; l[0] = l[1] = 0.f;
#pragma unroll
                for (int qt = 0; qt < 2; ++qt)
#pragma unroll
                    for (int dt = 0; dt < 8; ++dt) o[qt][dt] = (f4){0.f, 0.f, 0.f, 0.f};
                int f0 = n1 + 1, f1 = n0 - 1;
                for (int n = n0; n <= n1; ++n) { const bool fa = (C.s0 - (64 * n + 63) >= 113) && (br == 1 || (C.s0 + 63 - 64 * n) < 512); if (fa) { f0 = n < f0 ? n : f0; f1 = n; } }
                const int cntf = f1 >= f0 ? f1 - f0 + 1 : 0, cnt = n1 - n0 + 1, nlo = cntf ? f0 - n0 : cnt;
#define NSA_TILE(i) ((i) < cntf ? f0 + (i) : (((i) - cntf) < nlo ? n0 + ((i) - cntf) : f1 + 1 + ((i) - cntf - nlo)))
#define NSA_BODY(FARF) { const int n = NSA_TILE(i); const int buf = i & 1; \
                    if (i + 1 < cnt) { const int nn = NSA_TILE(i + 1); dma_k(C, KX + nn * 64 * 128, lds + (buf ? KB0 : KB1)); dma_v(C, VX + 64 * nn, C.vdos, lds + (buf ? VB0 : VB1)); } \
                    bool need = true; \
                    if (br == 1) { const unsigned any = ((const LAS unsigned*)selm)[(lane & 7) * 2 + (n >> 5)] >> (n & 31); need = __any((int)(any & 1u)); } \
                    if (need) { f4 s[2][4]; compute_st(C, lds + (buf ? KB1 : KB0), s); \
                        if (br == 1) mask_bias<M_SEL, FARF>(C, s, 64 * n, n, (const LAS unsigned*)selm); else mask_bias<M_WIN, FARF>(C, s, 64 * n, n, (const LAS unsigned*)selm); \
                        softmax_step(s, m, l, o, true); compute_pv(C, lds + (buf ? VB1 : VB0), s, o); } \
                    NSA_SYNC(); }
                { const int nf = NSA_TILE(0); dma_k(C, KX + nf * 64 * 128, lds + KB0); dma_v(C, VX + 64 * nf, C.vdos, lds + VB0); NSA_SYNC(); }
                int i = 0;
                for (; i < cntf; ++i) NSA_BODY(true)
                for (; i < cnt; ++i) NSA_BODY(false)
#undef NSA_BODY
#undef NSA_TILE
                asm volatile("s_waitcnt vmcnt(0)" ::: "memory");
#pragma unroll
                for (int qt = 0; qt < 2; ++qt) { const float lt = radd32(radd16(l[qt]));
                    const int row = b * SEQ + (C.pos0 + 4 * qt);
                    const float sc = (1.f / (1.f + __expf(-bf2f(*(const bf16*)((const char*)SM + (unsigned)((row * 64 + 16 + 8 * br + h) * 2)))))) / lt;
#pragma unroll
                    for (int dt = 0; dt < 8; ++dt) { const f4 v = o[qt][dt] * sc; v2u* sp = (v2u*)(NSA_OROW(qt) + 32 * dt); const v2u pv = *sp;
                        const float a0 = bflo(pv.x) + v[0], a1 = bfhi(pv.x) + v[1], a2 = bflo(pv.y) + v[2], a3 = bfhi(pv.y) + v[3];
                        if (br == 2) ssq[qt] += (a0 * a0 + a1 * a1) + (a2 * a2 + a3 * a3);
                        *sp = (v2u){pg8::cvt_pk_bf16(a0, a1), pg8::cvt_pk_bf16(a2, a3)}; } }
            }
        }
        float rstd[2];
#pragma unroll
        for (int qt = 0; qt < 2; ++qt) { const float t = radd32(radd16(raddq(ssq[qt]))); rstd[qt] = 1.f / sqrtf(t * (1.f / 1024.f) + RMS_EPS); }
        asm volatile("s_waitcnt vmcnt(0)" ::: "memory");
#pragma unroll
        for (int qt = 0; qt < 2; ++qt) { const int sub = C.r * 4 + C.gq; bf16* orow = (bf16*)((char*)A2 + (unsigned)(((b * SEQ + (C.pos0 + 4 * qt)) * DM + 1024) * 2 + sub * 16)); const int subz = 0;
#pragma unroll
            for (int j = 0; j < 8; ++j) { const int col = (j * 16 + subz) * 8; v4u w = *(const v4u*)((const char*)orow + (unsigned)(col * 2)); const f32x4 g0 = *(const f32x4*)((const char*)nsag + (unsigned)(col * 4 + sub * 32)), g1 = *(const f32x4*)((const char*)nsag + (unsigned)(col * 4 + sub * 32 + 16)); const float rs = rstd[qt];
                w.x = pk2(bflo(w.x) * rs * g0.x, bfhi(w.x) * rs * g0.y); w.y = pk2(bflo(w.y) * rs * g0.z, bfhi(w.y) * rs * g0.w); w.z = pk2(bflo(w.z) * rs * g1.x, bfhi(w.z) * rs * g1.y); w.w = pk2(bflo(w.w) * rs * g1.z, bfhi(w.w) * rs * g1.w);
                *(v4u*)((char*)orow + (unsigned)(col * 2)) = w; } }
        NSA_SYNC();
    }
#undef NSA_SYNC
#undef NSA_OROW
}

constexpr size_t WS_ST = WS_LA;
constexpr size_t WS_DEC = WS_ST + (size_t)2048 * 256 * 128 * 2;
static_assert(WS_DEC + (size_t)2048 * 128 * 4 <= WS_KCMP, "gla scratch overlay");
namespace gla {
typedef float f4 __attribute__((ext_vector_type(4)));
constexpr int L_ST = 0, L_KT = 65536, L_QT = 81920, L_VT = 98304, L_GA = 131072, L_GT = L_GA + 4096, L_RED = L_GT + 2048, L_END = L_RED + 512;
__device__ __forceinline__ void chunk_cumsum(const Params& p, LAS unsigned char* lds, int tid, int t0, int h, float (&P)[16], float& blast) {
    const bf16* SM = (const bf16*)(p.ws + WS_SM); const float* wa2 = p.in[I_WA2]; const float* ba = p.in[I_BA];
    LAS float* ga = (LAS float*)(lds + L_GA); LAS float* gt = (LAS float*)(lds + L_GT);
    if (tid < 128) { const int j = tid >> 1, hf = tid & 1; const v4u w = *(const v4u*)((const char*)SM + (unsigned)(((t0 + j) * 64 + hf * 8) * 2));
        LAS float* d = ga + j * 16 + hf * 8; d[0] = bflo(w.x); d[1] = bfhi(w.x); d[2] = bflo(w.y); d[3] = bfhi(w.y); d[4] = bflo(w.z); d[5] = bfhi(w.z); d[6] = bflo(w.w); d[7] = bfhi(w.w); }
    const int dk = tid & 127, jq = tid >> 7;
    float w[16];
#pragma unroll
    for (int r = 0; r < 16; ++r) w[r] = wa2[r * 512 + h * 128 + dk];
    const float bb = ba[h * 128 + dk];
    __syncthreads();
    float run = 0.f;
#pragma unroll
    for (int jj = 0; jj < 16; ++jj) { const LAS f32x4* gr = (const LAS f32x4*)(ga + (16 * jq + jj) * 16); float z = bb;
#pragma unroll
        for (int r4 = 0; r4 < 4; ++r4) { const f32x4 g4 = gr[r4]; z += g4.x * w[4 * r4] + g4.y * w[4 * r4 + 1] + g4.z * w[4 * r4 + 2] + g4.w * w[4 * r4 + 3]; }
        run += (fminf(z, 0.f) - log1pf(__expf(-fabsf(z)))) * (1.f / 16.f); P[jj] = run; }
    gt[jq * 128 + dk] = run;
    __syncthreads();
    float off = 0.f, tot = 0.f;
#pragma unroll
    for (int q = 0; q < 4; ++q) { const float t = gt[q * 128 + dk]; tot += t; if (q < jq) off += t; }
#pragma unroll
    for (int jj = 0; jj < 16; ++jj) P[jj] += off;
    blast = tot;
}
__device__ __forceinline__ void stage_raw_k(const bf16* src  , LAS unsigned char* dst, int tid, int t0, int h) {
#pragma unroll
    for (int q = 0; q < 2; ++q) { const int id = tid + 512 * q, j = id >> 4, c16 = id & 15; *(LAS v4u*)(dst + j * 256 + c16 * 16) = *(const v4u*)((const char*)src + (unsigned)(((t0 + j) * 512 + h * 128 + c16 * 8) * 2)); }
}
__device__ __forceinline__ void stage_raw_v(const Params& p, LAS unsigned char* dst, int tid, int t0, int h) {
    const bf16* GV = (const bf16*)(p.ws + WS_GV);
#pragma unroll
    for (int q = 0; q < 4; ++q) { const int id = tid + 512 * q, j = id >> 5, c = id & 31; *(LAS v4u*)(dst + j * 512 + c * 16) = *(const v4u*)((const char*)GV + (unsigned)(((t0 + j) * 1024 + h * 256 + c * 8) * 2)); }
}
__device__ __forceinline__ void fill_vt(LAS unsigned char* lds, const LAS unsigned char* rv, int tid) {
    const int dv = tid & 255, jh = tid >> 8;
    unsigned short v[32];
#pragma unroll
    for (int jj = 0; jj < 32; ++jj) v[jj] = *(const LAS bf16*)(rv + (32 * jh + jj) * 512 + dv * 2);
    LAS unsigned char* row = lds + L_VT + dv * 128; const int f = (dv >> 1) & 7;
#pragma unroll
    for (int q = 0; q < 4; ++q) { v4u w; w.x = v[8 * q] | ((unsigned)v[8 * q + 1] << 16); w.y = v[8 * q + 2] | ((unsigned)v[8 * q + 3] << 16); w.z = v[8 * q + 4] | ((unsigned)v[8 * q + 5] << 16); w.w = v[8 * q + 6] | ((unsigned)v[8 * q + 7] << 16);
        *(LAS v4u*)(row + (((4 * jh + q) ^ f) * 16)) = w; }
}
}

__device__ __forceinline__ void ph_gla_a(const Params& p, LAS unsigned char* lds, int u0, int ustride, int tid_in, int wave) {
    using namespace gla;
    int tid = tid_in; asm volatile("" : "+v"(tid));
    const int lane = tid & 63, c = lane & 15, gq = lane >> 4;
    const bf16* GK = (const bf16*)(p.ws + WS_GK); bf16* ST = (bf16*)(p.ws + WS_ST); float* DEC = (float*)(p.ws + WS_DEC);
    for (int unit = u0; unit < 2048; unit += ustride) {
        const int bh = unit >> 6, ch = unit & 63, b = bh >> 2, h = bh & 3, t0 = b * SEQ + ch * 64;
        stage_raw_k(GK, lds + 0, tid, t0, h); stage_raw_v(p, lds + 16384, tid, t0, h);
        float P[16], blast; chunk_cumsum(p, lds, tid, t0, h, P, blast);
        { const int dk = tid & 127, jq = tid >> 7;
          unsigned short kv[16];
#pragma unroll
          for (int jj = 0; jj < 16; ++jj) kv[jj] = *(const LAS bf16*)(lds + (16 * jq + jj) * 256 + dk * 2);
          unsigned pk[8];
#pragma unroll
          for (int q = 0; q < 8; ++q) pk[q] = pk2(bf2f(kv[2 * q]) * __expf(blast - P[2 * q]), bf2f(kv[2 * q + 1]) * __expf(blast - P[2 * q + 1]));
          LAS unsigned char* row = lds + L_KT + dk * 128; const int f = (dk >> 1) & 7;
          *(LAS v4u*)(row + (((2 * jq) ^ f) * 16)) = (v4u){pk[0], pk[1], pk[2], pk[3]}; *(LAS v4u*)(row + (((2 * jq + 1) ^ f) * 16)) = (v4u){pk[4], pk[5], pk[6], pk[7]};
          if (jq == 0) DEC[unit * 128 + dk] = __expf(blast); }
        fill_vt(lds, lds + 16384, tid);
        __syncthreads();
        f4 acc[16];
        const int f = (c >> 1) & 7;
        bf16x8 aF[2];
#pragma unroll
        for (int ks = 0; ks < 2; ++ks) aF[ks] = *(const LAS bf16x8*)(lds + L_KT + (16 * wave + c) * 128 + (((4 * ks + gq) ^ f) * 16));
#pragma unroll
        for (int nt = 0; nt < 16; ++nt) { acc[nt] = (f4){0.f, 0.f, 0.f, 0.f};
#pragma unroll
            for (int ks = 0; ks < 2; ++ks) { const bf16x8 bF = *(const LAS bf16x8*)(lds + L_VT + (16 * nt + c) * 128 + (((4 * ks + gq) ^ f) * 16)); acc[nt] = __builtin_amdgcn_mfma_f32_16x16x32_bf16(aF[ks], bF, acc[nt], 0, 0, 0); } }
        char* dst = (char*)ST + (size_t)unit * (256 * 128 * 2) + (unsigned)((c * 128 + 16 * wave + 4 * gq) * 2);
#pragma unroll
        for (int nt = 0; nt < 16; ++nt) *(v2u*)(dst + nt * 16 * 256) = (v2u){pg8::cvt_pk_bf16(acc[nt][0], acc[nt][1]), pg8::cvt_pk_bf16(acc[nt][2], acc[nt][3])};
        __syncthreads();
    }
}
__device__ __forceinline__ void ph_gla_b(const Params& p, int gid, int gstride) {
    bf16* ST = (bf16*)(p.ws + WS_ST); const float* DEC = (const float*)(p.ws + WS_DEC);
    for (int e = gid; e < 32 * 4096; e += gstride) { const int bh = e >> 12, dv = (e >> 4) & 255, d8 = e & 15;
        float st[8];
#pragma unroll
        for (int i = 0; i < 8; ++i) st[i] = 0.f;
        char* base = (char*)ST + (size_t)bh * 64 * (256 * 128 * 2) + (unsigned)((dv * 128 + d8 * 8) * 2); const float* dbase = DEC + (size_t)bh * 64 * 128 + d8 * 8;
#pragma unroll 4
        for (int ch = 0; ch < 64; ++ch) { v4u* ptr = (v4u*)(base + (size_t)ch * (256 * 128 * 2)); const v4u w = *ptr; const f32x4 d0 = *(const f32x4*)(dbase + ch * 128), d1 = *(const f32x4*)(dbase + ch * 128 + 4);
            v4u o; o.x = pk2(st[0], st[1]); o.y = pk2(st[2], st[3]); o.z = pk2(st[4], st[5]); o.w = pk2(st[6], st[7]); *ptr = o;
            st[0] = st[0] * d0.x + bflo(w.x); st[1] = st[1] * d0.y + bfhi(w.x); st[2] = st[2] * d0.z + bflo(w.y); st[3] = st[3] * d0.w + bfhi(w.y);
            st[4] = st[4] * d1.x + bflo(w.z); st[5] = st[5] * d1.y + bfhi(w.z); st[6] = st[6] * d1.z + bflo(w.w); st[7] = st[7] * d1.w + bfhi(w.w); }
    }
}
__device__ __forceinline__ void ph_gla_c(const Params& p, LAS unsigned char* lds, int u0, int ustride, int tid_in, int wave) {
    using namespace gla;
    int tid = tid_in; asm volatile("" : "+v"(tid));
    const int lane = tid & 63, c = lane & 15, gq = lane >> 4, nt = wave & 3, half = wave >> 2;
    const bf16* GQ = (const bf16*)(p.ws + WS_GQ); const bf16* GK = (const bf16*)(p.ws + WS_GK); const bf16* GG = (const bf16*)(p.ws + WS_GG); const bf16* ST = (const bf16*)(p.ws + WS_ST);
    bf16* A2 = (bf16*)(p.ws + WS_A2); const float* gn = p.in[I_GLAG];
    const int koff0 = c * 256 + ((gq ^ c) * 16), voff0 = c * 128 + (((gq >> 1) ^ ((c >> 1) & 7)) * 16) + (gq & 1) * 8;
    for (int unit = u0; unit < 2048; unit += ustride) {
        const int bh = unit >> 6, ch = unit & 63, b = bh >> 2, h = bh & 3, t0 = b * SEQ + ch * 64;
        stage_raw_k(GQ, lds + 0, tid, t0, h); stage_raw_k(GK, lds + 16384, tid, t0, h); stage_raw_v(p, lds + 32768, tid, t0, h);
        float P[16], blast; chunk_cumsum(p, lds, tid, t0, h, P, blast);
        { const int dk = tid & 127, jq = tid >> 7;
#pragma unroll
          for (int jj = 0; jj < 16; ++jj) { const int j = 16 * jq + jj; const float qv = bf2f(*(const LAS bf16*)(lds + j * 256 + dk * 2)), kv = bf2f(*(const LAS bf16*)(lds + 16384 + j * 256 + dk * 2));
              const int off = j * 256 + (((dk >> 3) ^ (j & 15)) * 16) + (dk & 7) * 2;
              *(LAS bf16*)(lds + L_QT + off) = (bf16)f2bf(qv * __expf(P[jj])); *(LAS bf16*)(lds + L_KT + off) = (bf16)f2bf(kv * __expf(-P[jj])); } }
        fill_vt(lds, lds + 32768, tid);
        __syncthreads();
        { const char* src = (const char*)ST + (size_t)unit * (256 * 128 * 2);
#pragma unroll
          for (int i = 0; i < 8; ++i) { const int piece = 8 * wave + i, row = piece * 4 + (lane >> 4), chunk = (lane & 15) ^ (row & 15);
              __builtin_amdgcn_global_load_lds((const unsigned*)(src + (unsigned)(row * 256 + chunk * 16)), (LAS unsigned*)(lds + L_ST + piece * 1024), 16, 0, 0); } }
        asm volatile("s_waitcnt vmcnt(0)" ::: "memory"); __syncthreads();
        bf16x8 qF[4];
#pragma unroll
        for (int ks = 0; ks < 4; ++ks) qF[ks] = *(const LAS bf16x8*)(lds + L_QT + nt * 4096 + (koff0 ^ (ks * 64)));
        f4 sT[4];
#pragma unroll
        for (int jt = 0; jt < 4; ++jt) { sT[jt] = (f4){0.f, 0.f, 0.f, 0.f};
            if (jt <= nt) {
#pragma unroll
                for (int ks = 0; ks < 4; ++ks) { const bf16x8 a = *(const LAS bf16x8*)(lds + L_KT + jt * 4096 + (koff0 ^ (ks * 64))); sT[jt] = __builtin_amdgcn_mfma_f32_16x16x32_bf16(a, qF[ks], sT[jt], 0, 0, 0); }
                if (jt == nt) {
#pragma unroll
                    for (int rg = 0; rg < 4; ++rg) if (4 * gq + rg > c) sT[jt][rg] = 0.f; } } }
        bf16x8 pb[2];
#pragma unroll
        for (int s = 0; s < 2; ++s) { v4u w; w.x = pg8::cvt_pk_bf16(sT[2 * s][0], sT[2 * s][1]); w.y = pg8::cvt_pk_bf16(sT[2 * s][2], sT[2 * s][3]); w.z = pg8::cvt_pk_bf16(sT[2 * s + 1][0], sT[2 * s + 1][1]); w.w = pg8::cvt_pk_bf16(sT[2 * s + 1][2], sT[2 * s + 1][3]); pb[s] = __builtin_bit_cast(bf16x8, w); }
        f4 o[8]; float ss = 0.f;
#pragma unroll
        for (int mt = 0; mt < 8; ++mt) { o[mt] = (f4){0.f, 0.f, 0.f, 0.f}; const int rb = 128 * half + 16 * mt;
#pragma unroll
            for (int ks = 0; ks < 4; ++ks) { const bf16x8 a = *(const LAS bf16x8*)(lds + L_ST + rb * 256 + (koff0 ^ (ks * 64))); o[mt] = __builtin_amdgcn_mfma_f32_16x16x32_bf16(a, qF[ks], o[mt], 0, 0, 0); }
#pragma unroll
            for (int s = 0; s < 2; ++s) if (2 * s <= nt) { const v2u lo = *(const LAS v2u*)(lds + L_VT + rb * 128 + (voff0 ^ (s * 64))), hi = *(const LAS v2u*)(lds + L_VT + rb * 128 + (voff0 ^ (s * 64 + 32)));
                o[mt] = __builtin_amdgcn_mfma_f32_16x16x32_bf16(__builtin_bit_cast(bf16x8, (v4u){lo.x, lo.y, hi.x, hi.y}), pb[s], o[mt], 0, 0, 0); }
            ss += (o[mt][0] * o[mt][0] + o[mt][1] * o[mt][1]) + (o[mt][2] * o[mt][2] + o[mt][3] * o[mt][3]); }
        ss = nsa::radd32(nsa::radd16(ss));
        LAS float* red = (LAS float*)(lds + L_RED);
        if (gq == 0) red[half * 64 + 16 * nt + c] = ss;
        __syncthreads();
        const float rstd = 1.f / sqrtf((red[16 * nt + c] + red[64 + 16 * nt + c]) * (1.f / 256.f) + RMS_EPS);
        const int tok = t0 + 16 * nt + c;
#pragma unroll
        for (int mt = 0; mt < 8; ++mt) { const int dv = 128 * half + 16 * mt + 4 * gq; const f32x4 g4 = *(const f32x4*)((const char*)gn + (unsigned)(dv * 4));
            const v2u gg = *(const v2u*)((const char*)GG + (unsigned)((tok * 1024 + h * 256 + dv) * 2));
            const float z0 = bflo(gg.x), z1 = bfhi(gg.x), z2 = bflo(gg.y), z3 = bfhi(gg.y);
            v2u w; w.x = pg8::cvt_pk_bf16(o[mt][0] * rstd * g4.x * (z0 / (1.f + __expf(-z0))), o[mt][1] * rstd * g4.y * (z1 / (1.f + __expf(-z1))));
            w.y = pg8::cvt_pk_bf16(o[mt][2] * rstd * g4.z * (z2 / (1.f + __expf(-z2))), o[mt][3] * rstd * g4.w * (z3 / (1.f + __expf(-z3))));
            *(v2u*)((char*)A2 + (unsigned)((tok * DM + h * 256 + dv) * 2)) = w; }
        __syncthreads();
    }
}

constexpr size_t WS_LH = WS_DEC + (size_t)2048 * 128 * 4;
constexpr size_t WS_PEV = WS_LH + (size_t)2 * 4096 * 256 * 4;
static_assert(WS_PEV + 1024 <= WS_KCMP, "cmp scratch overlay");
struct CmpOrder {
    int c; const bf16 *kc, *vc, *wk, *wv;
    __device__ __forceinline__ bool next(int i, pg8::Unit& u) const { if (i > 0 || c >= 32) return false; u.pm = c & 15; u.pn = 0; u.kind = c >> 4; return true; }
    __device__ __forceinline__ const char* pa(const pg8::Gemm&, const pg8::Unit& u) const { return (const char*)(u.kind ? vc : kc) + (size_t)u.pm * ((size_t)256 * 2048 * 2); }
    __device__ __forceinline__ const char* pb(const pg8::Gemm&, const pg8::Unit& u) const { return (const char*)(u.kind ? wv : wk); }
    __device__ __forceinline__ void a_ready(const pg8::Unit&) const {}
    __device__ __forceinline__ void done(const pg8::Unit&) const {}
};
struct EpiLH {
    static constexpr bool PERM = false, AFTER_DRAIN = false;
    float* LH;
    __device__ __forceinline__ void operator()(const pg8::f32x4 (&acc)[2][2][4][2], const pg8::Unit& u, int wr, int wc, int fr, int fq) const {
        const int row0 = u.kind * 4096 + u.pm * 256 + wr * 64 + fr, col0 = wc * 32 + 4 * fq;
#pragma unroll
        for (int ai = 0; ai < 2; ++ai)
#pragma unroll
            for (int m = 0; m < 4; ++m) { float* rowp = LH + (size_t)(row0 + ai * 128 + m * 16) * 256 + col0;
#pragma unroll
                for (int bj = 0; bj < 2; ++bj)
#pragma unroll
                    for (int n = 0; n < 2; ++n) *(pg8::f32x4*)(rowp + bj * 128 + n * 16) = acc[ai][bj][m][n]; }
    }
};
__device__ __forceinline__ void cmp_pevec(const Params& p, LAS unsigned char* lds, int which, int tid) {
    const float* pe = p.in[which ? I_PEV : I_PEK]; const float* w1 = p.in[which ? I_WV1 : I_WK1]; LAS float* part = (LAS float*)lds;
    const int m = tid & 127, q = tid >> 7; float a = 0.f;
    __syncthreads();
    for (int k = q * 1024; k < q * 1024 + 1024; ++k) a += pe[k] * w1[(size_t)k * 128 + m];
    part[q * 128 + m] = a; __syncthreads();
    if (tid < 128) ((float*)(p.ws + WS_PEV))[which * 128 + tid] = (part[tid] + part[128 + tid]) + (part[256 + tid] + part[384 + tid]);
    __syncthreads();
}
__device__ __forceinline__ void cmp_finalize(const Params& p, LAS unsigned char* lds, int which, int bg, int tid_in, int wave) {
    int tid = tid_in; asm volatile("" : "+v"(tid));
    const int lane = tid & 63, c15 = lane & 15, gq = lane >> 4;
    constexpr int L_HID = 0, L_W2T = 65536;
    const float* LH = (const float*)(p.ws + WS_LH) + ((size_t)which * 4096 + bg * 256) * 256; const float* pev = (const float*)(p.ws + WS_PEV) + which * 128; const float* w2 = p.in[which ? I_WV2 : I_WK2];
    asm volatile("s_waitcnt vmcnt(0)" ::: "memory"); __syncthreads();
#pragma unroll
    for (int i = 0; i < 8; ++i) { const int id = tid + 512 * i, c = id >> 4, ch = id & 15; v4u w = (v4u){0u, 0u, 0u, 0u};
        if (c < 255) { const float* lp = LH + (size_t)c * 256 + 8 * ch; const float* hp = LH + (size_t)(c + 1) * 256 + 128 + 8 * ch;
            const f32x4 l0 = *(const f32x4*)lp, l1 = *(const f32x4*)(lp + 4), h0 = *(const f32x4*)hp, h1 = *(const f32x4*)(hp + 4), e0 = *(const f32x4*)(pev + 8 * ch), e1 = *(const f32x4*)(pev + 8 * ch + 4);
            w.x = pk2(gelu_tanh(l0.x + h0.x + e0.x), gelu_tanh(l0.y + h0.y + e0.y)); w.y = pk2(gelu_tanh(l0.z + h0.z + e0.z), gelu_tanh(l0.w + h0.w + e0.w));
            w.z = pk2(gelu_tanh(l1.x + h1.x + e1.x), gelu_tanh(l1.y + h1.y + e1.y)); w.w = pk2(gelu_tanh(l1.z + h1.z + e1.z), gelu_tanh(l1.w + h1.w + e1.w)); }
        *(LAS v4u*)(lds + L_HID + c * 256 + ((ch ^ (c & 15)) * 16)) = w; }
#pragma unroll 8
    for (int i = 0; i < 32; ++i) { const int id = tid + 512 * i, m = id >> 7, n = id & 127;
        *(LAS bf16*)(lds + L_W2T + n * 256 + (((m >> 3) ^ (n & 15)) * 16) + (m & 7) * 2) = (bf16)f2bf(w2[id]); }
    __syncthreads();
    const int koff0 = c15 * 256 + ((gq ^ c15) * 16);
    bf16* KCMP = (bf16*)(p.ws + WS_KCMP) + (size_t)bg * 256 * 128; bf16* VCMPT = (bf16*)(p.ws + WS_VCMPT) + (size_t)bg * 128 * 256;
#pragma unroll
    for (int ci = 0; ci < 2; ++ci) { const int ctile = 2 * wave + ci;
        bf16x8 hF[4];
#pragma unroll
        for (int ks = 0; ks < 4; ++ks) hF[ks] = *(const LAS bf16x8*)(lds + L_HID + ctile * 4096 + (koff0 ^ (ks * 64)));
#pragma unroll
        for (int ntile = 0; ntile < 8; ++ntile) { pg8::f32x4 d = (pg8::f32x4){0.f, 0.f, 0.f, 0.f};
#pragma unroll
            for (int ks = 0; ks < 4; ++ks) { const bf16x8 wF = *(const LAS bf16x8*)(lds + L_W2T + ntile * 4096 + (koff0 ^ (ks * 64)));
                d = which ? __builtin_amdgcn_mfma_f32_16x16x32_bf16(hF[ks], wF, d, 0, 0, 0) : __builtin_amdgcn_mfma_f32_16x16x32_bf16(wF, hF[ks], d, 0, 0, 0); }
            const v2u w = (v2u){pg8::cvt_pk_bf16(d[0], d[1]), pg8::cvt_pk_bf16(d[2], d[3])};
            if (which) *(v2u*)(VCMPT + (size_t)(16 * ntile + c15) * 256 + 16 * ctile + 4 * gq) = w;
            else *(v2u*)(KCMP + (size_t)(16 * ctile + c15) * 128 + 16 * ntile + 4 * gq) = w; } }
    __syncthreads();
}

constexpr size_t PROWS = (size_t)MAXTILES * 256;
constexpr size_t WS_W1Q = WS_W1T;
constexpr size_t WS_W2Q = WS_W1Q + (size_t)NE * 4096 * DM;
constexpr size_t WS_HN8 = WS_W2Q + (size_t)NE * DM * DFF;
constexpr size_t WS_AMAXP = WS_HN8 + (size_t)T * DM;
constexpr size_t WS_WSC1 = WS_AMAXP + PROWS * 64 * 4;
constexpr size_t WS_WSC2 = WS_WSC1 + (size_t)NE * 4096 * 4;
constexpr size_t WS_HSC = WS_WSC2 + (size_t)NE * 2048 * 4;
constexpr size_t WS_ROWSC = WS_HSC + (size_t)T * 4;
constexpr size_t WS_ASC = WS_ROWSC + PROWS * 4;
static_assert(WS_ASC + PROWS * 4 <= WS_XN, "int8 buffers fit in the retired bf16 expert-weight region");
constexpr size_t WS_XG8 = WS_XG;
constexpr size_t WS_ACT8 = WS_XG + PROWS * DM;
constexpr size_t WS_Y = WS_ACT;
static_assert(WS_ACT8 + PROWS * DM <= WS_ACT, "int8 row buffers fit in the retired gathered-row region");

__device__ __forceinline__ unsigned q8(float v) { int q = (int)rintf(v); q = q > 127 ? 127 : (q < -127 ? -127 : q); return (unsigned)q & 0xffu; }
__device__ __forceinline__ unsigned q8x4(float a, float b, float c, float d) { return q8(a) | (q8(b) << 8) | (q8(c) << 16) | (q8(d) << 24); }

constexpr size_t WS_WINQ = WS_WINT;
constexpr size_t WS_WISC = WS_WINT + (size_t)NPT * 256 * DM;
constexpr size_t WS_XN8 = WS_XN;
constexpr size_t WS_XSC = WS_XN + (size_t)T * DM;
constexpr size_t WS_PMAX = WS_HN;
constexpr size_t WS_PMAXI = WS_PMAX + (size_t)64 * 8 * 4096 * 4;
__device__ __forceinline__ void p0_absmax(const Params& p, int bid, int G, int tid) {
    float* PMAX = (float*)(p.ws + WS_PMAX);
    for (int it = bid; it < 8; it += G) {
        const float* src = p.in[I_WIN] + (size_t)it * 256 * 5672; float* dst = (float*)(p.ws + WS_PMAXI) + (size_t)it * 5696;
#pragma unroll
        for (int q = 0; q < 3; ++q) { const int c4 = tid + 512 * q; if (c4 < 1418) { f32x4 m0 = (f32x4){0.f, 0.f, 0.f, 0.f};
#pragma unroll 8
            for (int r = 0; r < 256; ++r) { const f32x4 a = *(const f32x4*)(src + (size_t)r * 5672 + c4 * 4); m0.x = fmaxf(m0.x, fabsf(a.x)); m0.y = fmaxf(m0.y, fabsf(a.y)); m0.z = fmaxf(m0.z, fabsf(a.z)); m0.w = fmaxf(m0.w, fabsf(a.w)); }
            *(f32x4*)(dst + c4 * 4) = m0; } } }
    for (int it = bid; it < 64 * 8; it += G) { const int mi = it >> 3, rb = it & 7, e = mi >> 1; const bool isw2 = mi & 1;
        if (!isw2) { const float* src = p.in[I_W1] + (size_t)e * DM * 4096 + (size_t)rb * 256 * 4096 + tid * 8; f32x4 m0 = (f32x4){0.f, 0.f, 0.f, 0.f}, m1 = m0;
#pragma unroll 8
            for (int r = 0; r < 256; ++r) { const f32x4 a = __builtin_nontemporal_load((const f32x4*)(src + (size_t)r * 4096)), b = __builtin_nontemporal_load((const f32x4*)(src + (size_t)r * 4096 + 4));
                m0.x = fmaxf(m0.x, fabsf(a.x)); m0.y = fmaxf(m0.y, fabsf(a.y)); m0.z = fmaxf(m0.z, fabsf(a.z)); m0.w = fmaxf(m0.w, fabsf(a.w));
                m1.x = fmaxf(m1.x, fabsf(b.x)); m1.y = fmaxf(m1.y, fabsf(b.y)); m1.z = fmaxf(m1.z, fabsf(b.z)); m1.w = fmaxf(m1.w, fabsf(b.w)); }
            float* d = PMAX + (size_t)it * 4096 + tid * 8; *(f32x4*)d = m0; *(f32x4*)(d + 4) = m1; }
        else { const float* src = p.in[I_W2] + (size_t)e * DFF * DM + (size_t)rb * 256 * 2048 + tid * 4; f32x4 m0 = (f32x4){0.f, 0.f, 0.f, 0.f};
#pragma unroll 8
            for (int r = 0; r < 256; ++r) { const f32x4 a = __builtin_nontemporal_load((const f32x4*)(src + (size_t)r * 2048));
                m0.x = fmaxf(m0.x, fabsf(a.x)); m0.y = fmaxf(m0.y, fabsf(a.y)); m0.z = fmaxf(m0.z, fabsf(a.z)); m0.w = fmaxf(m0.w, fabsf(a.w)); }
            *(f32x4*)(PMAX + (size_t)it * 4096 + tid * 4) = m0; } }
}
__device__ __forceinline__ void p0_quant(const Params& p, LAS unsigned char* lds, int gw, int NGW, int wave, int lane) {
    LAS float* scr = (LAS float*)(lds + wave * 16896);
    const float* PMAX = (const float*)(p.ws + WS_PMAX);
    signed char* W1Q = (signed char*)(p.ws + WS_W1Q); signed char* W2Q = (signed char*)(p.ws + WS_W2Q); float* WSC1 = (float*)(p.ws + WS_WSC1); float* WSC2 = (float*)(p.ws + WS_WSC2);
    for (int it = gw; it < 16 * 178; it += NGW) {
        const int kb = it / 178, nb = it % 178, n0 = nb * 32, k0 = kb * 128; const int nl = n0 + (lane & 31); const bool okc = nl < 5672;
        const float* W = p.in[I_WIN] + (size_t)k0 * 5672 + (okc ? nl : 0) + (size_t)(lane >> 5) * 5672;
        float w[64];
#pragma unroll
        for (int i = 0; i < 64; ++i) w[i] = W[(size_t)(2 * i) * 5672];
        float mx = 0.f;
#pragma unroll
        for (int q = 0; q < 8; ++q) mx = fmaxf(mx, ((const float*)(p.ws + WS_PMAXI))[(size_t)q * 5696 + (okc ? nl : 0)]);
        const float sc = mx > 0.f ? mx * (1.f / 127.f) : 1.f, ivl = 1.f / sc; float qsc; const int rowl = okc ? win_row(nl, qsc) : -1;
        if (kb == 0 && lane < 32 && okc) ((float*)(p.ws + WS_WISC))[rowl] = sc * qsc;
#pragma unroll
        for (int i = 0; i < 64; ++i) scr[(2 * i + (lane >> 5)) * 33 + (lane & 31)] = w[i];
        LDS_WAIT(); asm volatile("" ::: "memory");
        const int c = lane & 7;
#pragma unroll
        for (int j = 0; j < 4; ++j) { const int nn = (lane >> 3) + 8 * j; const float iv = __shfl(ivl, nn); const int rown = __shfl(rowl, nn); const LAS float* s = scr + (16 * c) * 33 + nn; v4u o;
            o.x = q8x4(s[0] * iv, s[33] * iv, s[66] * iv, s[99] * iv); o.y = q8x4(s[132] * iv, s[165] * iv, s[198] * iv, s[231] * iv);
            o.z = q8x4(s[264] * iv, s[297] * iv, s[330] * iv, s[363] * iv); o.w = q8x4(s[396] * iv, s[429] * iv, s[462] * iv, s[495] * iv);
            if (rown >= 0) *(v4u*)((signed char*)(p.ws + WS_WINQ) + (size_t)rown * 2048 + k0 + 16 * c) = o; }
        LDS_WAIT(); asm volatile("" ::: "memory"); }
    for (int it = gw; it < NE * 3072; it += NGW) { const int e = it / 3072; int r = it % 3072; const bool isw2 = r >= 2048; if (isw2) r -= 2048;
        const int nbs = isw2 ? 64 : 128, kb = r / nbs, nb = r % nbs, N = isw2 ? 2048 : 4096, n0 = nb * 32, k0 = kb * 128, mi = e * 2 + (isw2 ? 1 : 0);
        const float* W = (isw2 ? p.in[I_W2] + (size_t)e * DFF * DM : p.in[I_W1] + (size_t)e * DM * 4096) + (size_t)k0 * N + n0 + (lane & 31) + (size_t)(lane >> 5) * N;
        float w[64];
#pragma unroll
        for (int i = 0; i < 64; ++i) w[i] = __builtin_nontemporal_load(&W[(size_t)(2 * i) * N]);
        float mx = 0.f;
#pragma unroll
        for (int q = 0; q < 8; ++q) mx = fmaxf(mx, PMAX[((size_t)mi * 8 + q) * 4096 + n0 + (lane & 31)]);
        const float sc = mx > 0.f ? mx * (1.f / 127.f) : 1.f, ivl = 1.f / sc;
        const int nl = n0 + (lane & 31), j2l = nl & 2047; const int rowl = isw2 ? nl : (j2l >> 7) * 256 + (nl >= 2048 ? 128 : 0) + (j2l & 127);
        if (kb == 0 && lane < 32) { if (isw2) WSC2[e * 2048 + rowl] = sc; else WSC1[e * 4096 + rowl] = sc; }
#pragma unroll
        for (int i = 0; i < 64; ++i) scr[(2 * i + (lane >> 5)) * 33 + (lane & 31)] = w[i];
        LDS_WAIT(); asm volatile("" ::: "memory");
        const int c = lane & 7;
#pragma unroll
        for (int j = 0; j < 4; ++j) { const int nn = (lane >> 3) + 8 * j; const float iv = __shfl(ivl, nn); const int rown = __shfl(rowl, nn); const LAS float* s = scr + (16 * c) * 33 + nn; v4u o;
            o.x = q8x4(s[0] * iv, s[33] * iv, s[66] * iv, s[99] * iv); o.y = q8x4(s[132] * iv, s[165] * iv, s[198] * iv, s[231] * iv);
            o.z = q8x4(s[264] * iv, s[297] * iv, s[330] * iv, s[363] * iv); o.w = q8x4(s[396] * iv, s[429] * iv, s[462] * iv, s[495] * iv);
            signed char* dst = (isw2 ? W2Q + ((size_t)e * 2048 + rown) * 2048 : W1Q + ((size_t)e * 4096 + rown) * 2048);
            *(v4u*)(dst + k0 + 16 * c) = o; }
        LDS_WAIT(); asm volatile("" ::: "memory"); }
}
struct EpiSwigluI8 {
    static constexpr bool PERM = true, AFTER_DRAIN = false;
    const float* b1; const float* rowsc; const float* wsc1; bf16* act; float* amaxp;
    __device__ __forceinline__ void operator()(const pg8::f32x4 (&acc)[2][2][4][2], const pg8::Unit& u, int wr, int wc, int fr, int fq) const {
        const int e = u.kind; const int cin = wc * 32 + 8 * fq; const int col = u.pn * 128 + cin; const int row0 = u.pm * 256 + wr * 64 + fr;
        const float* bg = b1 + (size_t)e * 4096 + col; const float* bl = bg + 2048; const float* sg = wsc1 + (size_t)e * 4096 + u.pn * 256 + cin; const float* sl = sg + 128;
        float gb[8], lb[8], gs[8], ls[8];
#pragma unroll
        for (int j = 0; j < 8; ++j) { gb[j] = bg[j]; lb[j] = bl[j]; gs[j] = sg[j]; ls[j] = sl[j]; }
#pragma unroll
        for (int ai = 0; ai < 2; ++ai)
#pragma unroll
            for (int m = 0; m < 4; ++m) { const int r = row0 + ai * 128 + m * 16; const float rs = rowsc[r]; float o[8]; float mx = 0.f;
#pragma unroll
                for (int n = 0; n < 2; ++n)
#pragma unroll
                    for (int j = 0; j < 4; ++j) { float gl = (float)__float_as_int(acc[ai][0][m][n][j]) * (rs * gs[n * 4 + j]) + gb[n * 4 + j]; float li = (float)__float_as_int(acc[ai][1][m][n][j]) * (rs * ls[n * 4 + j]) + lb[n * 4 + j];
                        gl = fminf(gl, 7.f); li = fminf(fmaxf(li, -7.f), 7.f);
                        const float v = gl * __builtin_amdgcn_rcpf(1.f + __builtin_amdgcn_exp2f(-2.4554669595930156f * gl)) * (li + 1.f); o[n * 4 + j] = v; mx = fmaxf(mx, fabsf(v)); }
                mx = nsa::rmax32(nsa::rmax16(mx));
                if (fq == 0) amaxp[(size_t)r * 64 + u.pn * 4 + wc] = mx;
                pg8::u32x4 w; w.x = pg8::cvt_pk_bf16(o[0], o[1]); w.y = pg8::cvt_pk_bf16(o[2], o[3]); w.z = pg8::cvt_pk_bf16(o[4], o[5]); w.w = pg8::cvt_pk_bf16(o[6], o[7]);
                *(pg8::u32x4*)(act + (size_t)r * DFF + col) = w; }
    }
};
__device__ __forceinline__ void ph_actq(const Params& p, int gw, int NGW, int lane) {
    const int nrows = ((const int*)(p.ws + WS_META))[0] * 256; const float* amaxp = (const float*)(p.ws + WS_AMAXP); const bf16* act = (const bf16*)(p.ws + WS_ACT);
    signed char* A8 = (signed char*)(p.ws + WS_ACT8); float* ASC = (float*)(p.ws + WS_ASC);
    for (int r = gw; r < nrows; r += NGW) { const float mx = wave_max(amaxp[(size_t)r * 64 + lane]); const float sc = mx > 0.f ? mx * (1.f / 127.f) : 1.f, iv = 1.f / sc;
        const v4u* src = (const v4u*)(act + (size_t)r * DFF) + lane * 4; v4u a[4];
#pragma unroll
        for (int j = 0; j < 4; ++j) a[j] = src[j];
        v4u o[2];
#pragma unroll
        for (int h = 0; h < 2; ++h) { const v4u x = a[2 * h], y = a[2 * h + 1];
            o[h].x = q8x4(bflo(x.x) * iv, bfhi(x.x) * iv, bflo(x.y) * iv, bfhi(x.y) * iv); o[h].y = q8x4(bflo(x.z) * iv, bfhi(x.z) * iv, bflo(x.w) * iv, bfhi(x.w) * iv);
            o[h].z = q8x4(bflo(y.x) * iv, bfhi(y.x) * iv, bflo(y.y) * iv, bfhi(y.y) * iv); o[h].w = q8x4(bflo(y.z) * iv, bfhi(y.z) * iv, bflo(y.w) * iv, bfhi(y.w) * iv); }
        v4u* dst = (v4u*)(A8 + (size_t)r * DFF) + lane * 2; dst[0] = o[0]; dst[1] = o[1];
        if (lane == 0) ASC[r] = sc; }
}
struct EpiDownI8 {
    static constexpr bool PERM = true, AFTER_DRAIN = false;
    const float* b2; const float* roww; const float* asc; const float* wsc2; bf16* y;
    __device__ __forceinline__ void operator()(const pg8::f32x4 (&acc)[2][2][4][2], const pg8::Unit& u, int wr, int wc, int fr, int fq) const {
        const int e = u.kind; const int col0 = u.pn * 256 + wc * 32 + 8 * fq; const int row0 = u.pm * 256 + wr * 64 + fr;
        float bv[2][8], sv[2][8];
#pragma unroll
        for (int bj = 0; bj < 2; ++bj)
#pragma unroll
            for (int j = 0; j < 8; ++j) { bv[bj][j] = b2[(size_t)e * DM + col0 + bj * 128 + j]; sv[bj][j] = wsc2[(size_t)e * DM + col0 + bj * 128 + j]; }
#pragma unroll
        for (int ai = 0; ai < 2; ++ai)
#pragma unroll
            for (int m = 0; m < 4; ++m) { const int r = row0 + ai * 128 + m * 16; const float g = roww[r], as = asc[r];
#pragma unroll
                for (int bj = 0; bj < 2; ++bj) { float o[8];
#pragma unroll
                    for (int n = 0; n < 2; ++n)
#pragma unroll
                        for (int j = 0; j < 4; ++j) o[n * 4 + j] = ((float)__float_as_int(acc[ai][bj][m][n][j]) * (as * sv[bj][n * 4 + j]) + bv[bj][n * 4 + j]) * g;
                    pg8::u32x4 w; w.x = pg8::cvt_pk_bf16(o[0], o[1]); w.y = pg8::cvt_pk_bf16(o[2], o[3]); w.z = pg8::cvt_pk_bf16(o[4], o[5]); w.w = pg8::cvt_pk_bf16(o[6], o[7]);
                    *(pg8::u32x4*)(y + (size_t)r * DM + col0 + bj * 128) = w; } }
    }
};

struct EpiProjI8 {
    static constexpr bool PERM = true, AFTER_DRAIN = false;
    unsigned char* ws;
    __device__ __forceinline__ void operator()(const pg8::f32x4 (&acc)[2][2][4][2], const pg8::Unit& u, int wr, int wc, int fr, int fq) const {
        const int cw = wc * 32 + 8 * fq; const float* XSC = (const float*)(ws + WS_XSC); const float* WISC = (const float*)(ws + WS_WISC);
        if (u.kind == 0) {
            const int tn = u.pn; bf16* base; size_t bjs = 128; int ld = 0; bool headmajor = false; bool small = false;
            if (tn < 2) { base = (bf16*)(ws + WS_GQ) + tn * 256; ld = 512; }
            else if (tn < 4) { base = (bf16*)(ws + WS_GK) + (tn - 2) * 256; ld = 512; }
            else if (tn < 8) { base = (bf16*)(ws + WS_GV) + (tn - 4) * 256; ld = 1024; }
            else if (tn < 12) { base = (bf16*)(ws + WS_GG) + (tn - 8) * 256; ld = 1024; }
            else if (tn < 16) { base = (bf16*)(ws + WS_NQ) + (tn - 12) * 256; ld = 1024; }
            else if (tn < 20) { base = (bf16*)(ws + (tn == 16 ? WS_KC : tn == 17 ? WS_VC : tn == 18 ? WS_KS : WS_KW)); headmajor = true; bjs = (size_t)SEQ * 128; }
            else { base = (bf16*)(ws + WS_SM); ld = 64; small = true; }
            if (small && wc >= 2) return;
            float cs[2][8];
#pragma unroll
            for (int bj = 0; bj < 2; ++bj)
#pragma unroll
                for (int j = 0; j < 8; ++j) cs[bj][j] = WISC[tn * 256 + bj * 128 + cw + j];
#pragma unroll
            for (int ai = 0; ai < 2; ++ai)
#pragma unroll
                for (int m = 0; m < 4; ++m) { const int r = u.pm * 256 + ai * 128 + wr * 64 + m * 16 + fr; const float rs = XSC[r];
                    const size_t rterm = headmajor ? ((size_t)(r >> 12) * 2 * SEQ + (r & (SEQ - 1))) * 128 : (size_t)r * ld;
#pragma unroll
                    for (int bj = 0; bj < 2; ++bj) { if (small && bj) continue; float o[8];
#pragma unroll
                        for (int n = 0; n < 2; ++n)
#pragma unroll
                            for (int j = 0; j < 4; ++j) o[n * 4 + j] = (float)__float_as_int(acc[ai][bj][m][n][j]) * (rs * cs[bj][n * 4 + j]);
                        pg8::u32x4 w; w.x = pg8::cvt_pk_bf16(o[0], o[1]); w.y = pg8::cvt_pk_bf16(o[2], o[3]); w.z = pg8::cvt_pk_bf16(o[4], o[5]); w.w = pg8::cvt_pk_bf16(o[6], o[7]);
                        *(pg8::u32x4*)(base + rterm + bj * bjs + cw) = w; } }
        } else {
            bf16* base = (bf16*)(ws + (u.pn == 21 ? WS_VST : WS_VWT));
#pragma unroll
            for (int ai = 0; ai < 2; ++ai)
#pragma unroll
                for (int m = 0; m < 4; ++m) { const int dh = wr * 64 + m * 16 + fr; const float ws_ = WISC[u.pn * 256 + ai * 128 + dh];
#pragma unroll
                    for (int bj = 0; bj < 2; ++bj) { const int tok = u.pm * 256 + bj * 128 + cw; const int b = tok >> 12, s = tok & (SEQ - 1); float o[8];
                        const pg8::f32x4 x0 = *(const pg8::f32x4*)(XSC + tok), x1 = *(const pg8::f32x4*)(XSC + tok + 4);
#pragma unroll
                        for (int j = 0; j < 4; ++j) { o[j] = (float)__float_as_int(acc[ai][bj][m][0][j]) * (ws_ * x0[j]); o[4 + j] = (float)__float_as_int(acc[ai][bj][m][1][j]) * (ws_ * x1[j]); }
                        pg8::u32x4 w; w.x = pg8::cvt_pk_bf16(o[0], o[1]); w.y = pg8::cvt_pk_bf16(o[2], o[3]); w.z = pg8::cvt_pk_bf16(o[4], o[5]); w.w = pg8::cvt_pk_bf16(o[6], o[7]);
                        *(pg8::u32x4*)(base + ((size_t)(b * 2 + ai) * 128 + dh) * SEQ + s) = w; } }
        }
    }
};

__device__ __forceinline__ void r1_router(const Params& p, LAS unsigned char* lds, int vb, int tid, int wave, int lane) {
    LAS float* rowbuf = (LAS float*)lds;
    LAS float* part = (LAS float*)(lds + 65536);
    LAS int* tk = (LAS int*)(lds + 81920 + wave * 1024);
    LAS int* cntw = (LAS int*)(lds + 90112);
    const float* h = p.out; const float* gf = p.in[I_NFFN]; const float* rw = p.in[I_RW]; const float* rb = p.in[I_RB];
    signed char* HN8 = (signed char*)(p.ws + WS_HN8);
    const int e = lane & 31, eg = tid & 31, dg = tid >> 5; int mycount = 0;
    float rwr[128];
#pragma unroll
    for (int c4 = 0; c4 < 4; ++c4) { unsigned o = (unsigned)((((dg * 128 + c4 * 32) * 32) + eg) * 4); asm volatile("" : "+v"(o));
#pragma unroll
        for (int i = 0; i < 32; ++i) rwr[c4 * 32 + i] = *(const float*)((const char*)rw + o + i * 128); }
    for (int grp = 0; grp < 16; ++grp) { const int t = vb * TPV + grp * 8 + wave;
        { const f32x4* xr = (const f32x4*)(h + (size_t)t * DM) + lane; f32x4 v[8]; float s = 0.f;
#pragma unroll
          for (int j = 0; j < 8; ++j) { v[j] = xr[64 * j]; s += (v[j].x * v[j].x + v[j].y * v[j].y) + (v[j].z * v[j].z + v[j].w * v[j].w); }
          const float rstd = 1.f / sqrtf(wave_sum(s) * (1.f / DM) + RMS_EPS);
          float mxr = 0.f; LAS f32x4* hrow = (LAS f32x4*)(rowbuf + wave * 2048);
#pragma unroll
          for (int j = 0; j < 8; ++j) { const f32x4 g4 = ((const f32x4*)gf)[lane + 64 * j]; f32x4 y; y.x = v[j].x * rstd * g4.x; y.y = v[j].y * rstd * g4.y; y.z = v[j].z * rstd * g4.z; y.w = v[j].w * rstd * g4.w;
              v[j] = y; hrow[lane + 64 * j] = y; mxr = fmaxf(mxr, fmaxf(fmaxf(fabsf(y.x), fabsf(y.y)), fmaxf(fabsf(y.z), fabsf(y.w)))); }
          mxr = wave_max(mxr); const float qs = mxr > 0.f ? mxr * (1.f / 127.f) : 1.f, qi = 1.f / qs;
          unsigned* o4 = (unsigned*)(HN8 + (size_t)t * DM) + lane;
#pragma unroll
          for (int j = 0; j < 8; ++j) o4[64 * j] = q8x4(v[j].x * qi, v[j].y * qi, v[j].z * qi, v[j].w * qi);
          if (lane == 0) ((float*)(p.ws + WS_HSC))[t] = qs; }
        __syncthreads();
        { float acc[8];
#pragma unroll
          for (int tt = 0; tt < 8; ++tt) acc[tt] = 0.f;
#pragma unroll
          for (int i4 = 0; i4 < 32; ++i4) { f32x4 xv[8];
#pragma unroll
              for (int tt = 0; tt < 8; ++tt) xv[tt] = *(const LAS f32x4*)(rowbuf + tt * 2048 + dg * 128 + 4 * i4);
#pragma unroll
              for (int tt = 0; tt < 8; ++tt) acc[tt] += xv[tt].x * rwr[4 * i4] + xv[tt].y * rwr[4 * i4 + 1] + xv[tt].z * rwr[4 * i4 + 2] + xv[tt].w * rwr[4 * i4 + 3];
              if (i4 & 1) asm volatile("" ::: "memory"); }
#pragma unroll
          for (int tt = 0; tt < 8; ++tt) part[(dg * 8 + tt) * 32 + eg] = acc[tt]; }
        __syncthreads();
        { float a = rb[e];
#pragma unroll
          for (int q = 0; q < 16; ++q) a += part[(q * 8 + wave) * 32 + e];
          int rank = 0;
#pragma unroll
          for (int mm = 0; mm < 32; ++mm) { const float lm = __shfl(a, mm); rank += (lm > a || (lm == a && mm < e)) ? 1 : 0; }
          const float mx = wave_max(a); const bool sel = rank < 4;
          const float ex = (sel && lane < 32) ? __expf(a - mx) : 0.f; const float sum = wave_sum(ex);
          if (sel && lane < 32) { LAS int* q = tk + (grp * 4 + rank) * 4; q[0] = e; q[1] = mycount; q[2] = __builtin_bit_cast(int, ex / sum); ++mycount; } }
        __syncthreads();
    }
    if (lane < 32) cntw[wave * 32 + lane] = mycount;
    __syncthreads();
    if (wave == 0 && lane < 32) { int tot = 0; for (int w = 0; w < 8; ++w) tot += cntw[w * 32 + lane]; ((int*)(p.ws + WS_CNT))[vb * 32 + lane] = tot; }
    { const int i = lane >> 2, k = lane & 3; const LAS int* q = tk + (i * 4 + k) * 4; const int ee = q[0]; int base = 0; for (int w = 0; w < wave; ++w) base += cntw[w * 32 + ee];
      const int t = vb * TPV + i * 8 + wave;
      ((int*)(p.ws + WS_EIDX))[t * 4 + k] = ee; ((int*)(p.ws + WS_LRNK))[t * 4 + k] = base + q[1]; ((int*)(p.ws + WS_GATE))[t * 4 + k] = q[2]; }
    __syncthreads();
}
__device__ __forceinline__ void r2_gather(const Params& p, LAS unsigned char* lds, int vb, bool write_meta, int tid, int wave, int lane) {
    LAS int* part_tot = (LAS int*)lds;
    LAS int* part_base = part_tot + 512;
    LAS int* pbase = part_base + 512;
    const int* CNT = (const int*)(p.ws + WS_CNT);
    { const int e = tid & 31, part = tid >> 5; int tot = 0, bs = 0;
      for (int v = part * 16; v < part * 16 + 16; ++v) { const int c = CNT[v * 32 + e]; tot += c; if (v < vb) bs += c; }
      part_tot[part * 32 + e] = tot; part_base[part * 32 + e] = bs; }
    __syncthreads();
    if (tid == 0) { int ps = 0; int* meta = (int*)(p.ws + WS_META); int nt = 0;
        for (int e = 0; e < 32; ++e) { int tot = 0, bs = 0; for (int q = 0; q < 16; ++q) { tot += part_tot[q * 32 + e]; bs += part_base[q * 32 + e]; }
            pbase[e] = ps + bs; const int ntile = (tot + 255) >> 8;
            if (write_meta) for (int q = 0; q < ntile; ++q) meta[64 + nt + q] = e;
            nt += ntile; ps += ntile * 256; }
        if (write_meta) meta[0] = nt; }
    __syncthreads();
    const signed char* HN8 = (const signed char*)(p.ws + WS_HN8); signed char* XG8 = (signed char*)(p.ws + WS_XG8); const float* HSC = (const float*)(p.ws + WS_HSC); float* ROWSC = (float*)(p.ws + WS_ROWSC);
    const int* EIDX = (const int*)(p.ws + WS_EIDX); const int* LRNK = (const int*)(p.ws + WS_LRNK); const float* GATE = (const float*)(p.ws + WS_GATE);
    int* POS = (int*)(p.ws + WS_POS); float* ROWW = (float*)(p.ws + WS_ROWW);
    for (int i0 = 0; i0 < 16; i0 += 4) {
        v4u v0[4], v1[4]; float hs[4]; int ee[4][4], lr[4][4]; float gt[4][4];
#pragma unroll
        for (int u = 0; u < 4; ++u) { const int t = vb * TPV + (i0 + u) * 8 + wave; const v4u* src = (const v4u*)(HN8 + (size_t)t * DM) + lane; v0[u] = src[0]; v1[u] = src[64]; hs[u] = HSC[t];
#pragma unroll
            for (int k = 0; k < 4; ++k) { ee[u][k] = EIDX[t * 4 + k]; lr[u][k] = LRNK[t * 4 + k]; gt[u][k] = GATE[t * 4 + k]; } }
#pragma unroll
        for (int u = 0; u < 4; ++u) { const int t = vb * TPV + (i0 + u) * 8 + wave;
#pragma unroll
            for (int k = 0; k < 4; ++k) { const int pos = pbase[ee[u][k]] + lr[u][k];
                if (lane == 0) { POS[t * 4 + k] = pos; ROWW[pos] = gt[u][k]; ROWSC[pos] = hs[u]; }
                v4u* dst = (v4u*)(XG8 + (size_t)pos * DM) + lane; dst[0] = v0[u]; dst[64] = v1[u]; } } }
    __syncthreads();
}
__device__ __forceinline__ void pf_final(const Params& p, int gw, int NGW, int lane) {
    const bf16* Y = (const bf16*)(p.ws + WS_Y); const int* POS = (const int*)(p.ws + WS_POS); const float* gfin = p.in[I_NFIN];
    for (int t = gw; t < T; t += NGW) {
        f32x4* xr = (f32x4*)(p.out + (size_t)t * DM) + lane; f32x4 v[8];
#pragma unroll
        for (int j = 0; j < 8; ++j) v[j] = xr[64 * j];
#pragma unroll
        for (int k = 0; k < 4; ++k) { const int pos = POS[t * 4 + k]; const v2u* yr = (const v2u*)(Y + (size_t)pos * DM) + lane;
#pragma unroll
            for (int j = 0; j < 8; ++j) { const v2u w = yr[64 * j]; v[j].x += bflo(w.x); v[j].y += bfhi(w.x); v[j].z += bflo(w.y); v[j].w += bfhi(w.y); } }
        float s = 0.f;
#pragma unroll
        for (int j = 0; j < 8; ++j) s += (v[j].x * v[j].x + v[j].y * v[j].y) + (v[j].z * v[j].z + v[j].w * v[j].w);
        const float rstd = 1.f / sqrtf(wave_sum(s) * (1.f / DM) + RMS_EPS);
#pragma unroll
        for (int j = 0; j < 8; ++j) { const f32x4 g4 = ((const f32x4*)gfin)[lane + 64 * j]; f32x4 o; o.x = v[j].x * rstd * g4.x; o.y = v[j].y * rstd * g4.y; o.z = v[j].z * rstd * g4.z; o.w = v[j].w * rstd * g4.w; xr[64 * j] = o; }
    }
}


constexpr int LDS_BYTES = 159744;
constexpr int MISC_OFF = LDS_BYTES - 256;  static_assert(nsa::LDS_END <= MISC_OFF && gla::L_END <= MISC_OFF, "LDS map");
constexpr int CW_BAR = 4096, CW_XL = 16384;
__global__ __launch_bounds__(512, 2) void mega_fwd(Params p) {
    extern __shared__ __attribute__((aligned(16))) unsigned char lds_raw[];
    LAS unsigned char* lds = (LAS unsigned char*)lds_raw;
    const int G = gridDim.x, bid = blockIdx.x, NGW = G * 8;
#define PH_IDS int tid = threadIdx.x; asm volatile("" : "+v"(tid)); const int lane = tid & 63, wave = __builtin_amdgcn_readfirstlane(tid >> 6), gw = bid * 8 + wave; (void)lane; (void)gw;
    for (int u = threadIdx.x; u < 64; u += 512) ((LAS unsigned*)(lds + MISC_OFF))[u] = 0u;
    __syncthreads();
    XcdBarrier bar = xcd_barrier_post((unsigned*)(p.ws + WS_CTL) + CW_BAR, (volatile LAS unsigned*)(lds + MISC_OFF) + 8);
    { PH_IDS; p0_absmax(p, bid, G, tid); p0_prologue(p, lds, gw, NGW, wave, lane); }
    xcd_barrier(bar);
    { PH_IDS; p0_quant(p, lds, gw, NGW, wave, lane); }
    xcd_barrier(bar);
    { pg8::Gemm g{(const bf16*)(p.ws + WS_XN8), (const bf16*)(p.ws + WS_WINQ), T, NPT * 256, DM / 2};
      ProjOrder S; S.init(T, NPT * 256, G, bid); S.xn = g.A; S.wt = g.Bt; EpiProjI8 E{p.ws};
      pg8::gemm_phase<EpiProjI8, ProjOrder, true, true, true>(lds, g, S, E); }
    xcd_barrier(bar);
    if (bid < 32) {
        pg8::Gemm g{(const bf16*)(p.ws + WS_KC), (const bf16*)(p.ws + WS_WKCT), 4096, 256, 2048};
        CmpOrder S{bid, (const bf16*)(p.ws + WS_KC), (const bf16*)(p.ws + WS_VC), (const bf16*)(p.ws + WS_WKCT), (const bf16*)(p.ws + WS_WVCT)}; EpiLH E{(float*)(p.ws + WS_LH)};
        pg8::gemm_phase<EpiLH, CmpOrder, true, true>(lds, g, S, E);
    } else { PH_IDS; ph_gla_a(p, lds, bid - 32, G - 32, tid, wave); }
    xcd_barrier(bar);
    { PH_IDS; ph_gla_b(p, bid * 512 + tid, G * 512);
      for (int i = bid * 512 + tid; i < 16 * 128; i += G * 512) { const int bgz = i >> 7, dz = i & 127; ((bf16*)(p.ws + WS_KCMP))[((size_t)bgz * 256 + 255) * 128 + dz] = 0; ((bf16*)(p.ws + WS_VCMPT))[((size_t)bgz * 128 + dz) * 256 + 255] = 0; }
      const int ngrp = G * 4, total = 2 * 16 * 255, iters = (total + ngrp - 1) / ngrp; const int grp = tid >> 7;
      for (int it = 0; it < iters; ++it) { int id = it * ngrp + bid * 4 + grp; if (id >= total) id = total - 1;
          ph_cmp_fin_simple(p, (LAS float*)lds + grp * 4352, id, tid & 127, (const float*)(p.ws + WS_LH), (const float*)(p.ws + WS_PEVP)); __syncthreads(); } }
    xcd_barrier(bar);
    { PH_IDS; ph_nsa(p, lds, bid, G, tid, wave); }
    { PH_IDS; __syncthreads(); ph_gla_c(p, lds, bid, G, tid, wave); }
    xcd_barrier(bar);
    { pg8::Gemm g{(const bf16*)(p.ws + WS_A2), (const bf16*)(p.ws + WS_WOT), T, DM, DM};
      pg8::StaticOrder S; S.init(T, DM, G, bid); EpiRes E{p.in[I_X], p.out};
      pg8::gemm_phase<EpiRes, pg8::StaticOrder, true, true>(lds, g, S, E); }
    xcd_barrier(bar);
    { PH_IDS; for (int vb = bid; vb < NVB; vb += G) r1_router(p, lds, vb, tid, wave, lane); }
    xcd_barrier(bar);
    { PH_IDS; for (int vb = bid; vb < NVB; vb += G) r2_gather(p, lds, vb, vb == 0, tid, wave, lane); }
    xcd_barrier(bar);
    { pg8::Gemm g{(const bf16*)(p.ws + WS_XG8), (const bf16*)(p.ws + WS_W1Q), MAXTILES * 256, 4096, DM / 2};
      MoeOrder S; S.init((const int*)(p.ws + WS_META), 16, G, bid); EpiSwigluI8 E{p.in[I_B1], (const float*)(p.ws + WS_ROWSC), (const float*)(p.ws + WS_WSC1), (bf16*)(p.ws + WS_ACT), (float*)(p.ws + WS_AMAXP)};
      pg8::gemm_phase<EpiSwigluI8, MoeOrder, true, true, true>(lds, g, S, E); }
    xcd_barrier(bar);
    { PH_IDS; ph_actq(p, gw, NGW, lane); }
    xcd_barrier(bar);
    { pg8::Gemm g{(const bf16*)(p.ws + WS_ACT8), (const bf16*)(p.ws + WS_W2Q), MAXTILES * 256, DM, DFF / 2};
      MoeOrder S; S.init((const int*)(p.ws + WS_META), 8, G, bid); EpiDownI8 E{p.in[I_B2], (const float*)(p.ws + WS_ROWW), (const float*)(p.ws + WS_ASC), (const float*)(p.ws + WS_WSC2), (bf16*)(p.ws + WS_Y)};
      pg8::gemm_phase<EpiDownI8, MoeOrder, true, true, true>(lds, g, S, E); }
    xcd_barrier(bar);
    { PH_IDS; pf_final(p, gw, NGW, lane); }
}

extern "C" void kernel_launch(void* const* d_in, const int* in_sizes, int n_in, void* d_out, int out_size, void* d_ws, size_t ws_size, hipStream_t stream) {
    static int grid = 0;
    if (grid == 0) {
        if (n_in != N_IN || out_size != T * DM || ws_size < WS_END) { fprintf(stderr, "kernel_launch: unexpected shapes (n_in %d out %d ws %zu need %zu)\n", n_in, out_size, ws_size, (size_t)WS_END); grid = -1; return; }
        int dev = 0, cus = 0, per_cu = 0;
        if (hipGetDevice(&dev) != hipSuccess || hipDeviceGetAttribute(&cus, hipDeviceAttributeMultiprocessorCount, dev) != hipSuccess) { grid = -1; return; }
        if (hipFuncSetAttribute((const void*)mega_fwd, hipFuncAttributeMaxDynamicSharedMemorySize, LDS_BYTES) != hipSuccess) { fprintf(stderr, "kernel_launch: hipFuncSetAttribute failed\n"); grid = -1; return; }
        if (hipOccupancyMaxActiveBlocksPerMultiprocessor(&per_cu, (const void*)mega_fwd, 512, LDS_BYTES) != hipSuccess || per_cu < 1) { fprintf(stderr, "kernel_launch: occupancy query says %d blocks per CU\n", per_cu); }
        (void)hipGetLastError();
        grid = cus;
    }
    if (grid < 0) return;
    if (hipMemsetAsync((char*)d_ws + WS_CTL, 0, CTL_BYTES, stream) != hipSuccess) return;
    Params p{};
    for (int i = 0; i < N_IN; ++i) p.in[i] = (const float*)d_in[i];
    p.out = (float*)d_out; p.ws = (unsigned char*)d_ws;
    hipLaunchKernelGGL(mega_fwd, dim3(grid), dim3(512), LDS_BYTES, stream, p);
}
```

```cpp
#include <hip/hip_runtime.h>
#include <cstdio>
#include <cstdint>
namespace pg8 {
#define PG8_LAS __attribute__((address_space(3)))
typedef unsigned short bf16_t;
typedef short bf16x8 __attribute__((ext_vector_type(8)));
typedef float f32x4 __attribute__((ext_vector_type(4)));
typedef unsigned u32x4 __attribute__((ext_vector_type(4)));
constexpr int BM = 256, BK = 64, HALF = 128, HTB = HALF * BK * 2  , STAGE_BYTES = 8 * HTB, NXCD = 8, WGM = 8;

__host__ __device__ __forceinline__ int lds_byte(int r, int c) { const int st = (r >> 4) * 2 + (c >> 5), rr = r & 15, cc = c & 31, ob = rr * 64 + cc * 2; return st * 1024 + (ob ^ (((ob >> 9) & 1) << 5)); }
__host__ __device__ __forceinline__ void stage_rc(int b, int& R, int& C) { const int st = b / 1024, sb = b % 1024, swz = sb ^ (((sb >> 9) & 1) << 5); R = (st >> 1) * 16 + swz / 64; C = (st & 1) * 32 + (swz % 64) / 2; }
__host__ __device__ __forceinline__ int perm32(int rho) { const int n = rho >> 4, i = rho & 15; return 8 * (i >> 2) + 4 * n + (i & 3); }

struct Unit { int pm, pn, kind; };
struct Gemm { const bf16_t* A; const bf16_t* Bt; int M, N, K; };

__host__ __device__ __forceinline__ void tile_of(int wgid, int nM, int nN, int& pm, int& pn) {
    const int nwg = nM * nN;
    { const int q = nwg / NXCD, r = nwg % NXCD, xcd = wgid % NXCD, off = wgid / NXCD; wgid = (xcd < r ? xcd * (q + 1) : r * (q + 1) + (xcd - r) * q) + off; }
    const int nig = WGM * nN, gid = wgid / nig, fm = gid * WGM, gsz = (nM - fm) < WGM ? (nM - fm) : WGM;
    pm = fm + ((wgid % nig) % gsz); pn = (wgid % nig) / gsz;
}
struct StaticOrder {
    int nM, nN, nwg, G, c;
    __host__ __device__ void init(int M, int N, int G_, int c_) { nM = M / BM; nN = N / BM; nwg = nM * nN; G = G_; c = c_; }
    __device__ __forceinline__ bool next(int i, Unit& u) const {
        const long L = (long)i * G + c; if (L >= nwg) return false;
        tile_of((int)L, nM, nN, u.pm, u.pn); u.kind = 0; return true;
    }
    __device__ __forceinline__ const char* pa(const Gemm& g, const Unit& u) const { return (const char*)g.A + (size_t)u.pm * ((size_t)BM * g.K * 2); }
    __device__ __forceinline__ const char* pb(const Gemm& g, const Unit& u) const { return (const char*)g.Bt + (size_t)u.pn * ((size_t)BM * g.K * 2); }
    __device__ __forceinline__ void a_ready(const Unit&) const {}
    __device__ __forceinline__ void done(const Unit&) const {}
};
__device__ __forceinline__ unsigned cvt_pk_bf16(float lo, float hi) { unsigned r; asm volatile("v_cvt_pk_bf16_f32 %0, %1, %2" : "=v"(r) : "v"(lo), "v"(hi)); return r; }
template <bool I8> __device__ __forceinline__ f32x4 mma16(bf16x8 a, bf16x8 b, f32x4 c) {
    if constexpr (I8) { typedef int i32x4 __attribute__((ext_vector_type(4)));
        return __builtin_bit_cast(f32x4, __builtin_amdgcn_mfma_i32_16x16x64_i8(__builtin_bit_cast(i32x4, a), __builtin_bit_cast(i32x4, b), __builtin_bit_cast(i32x4, c), 0, 0, 0)); }
    else return __builtin_amdgcn_mfma_f32_16x16x32_bf16(a, b, c, 0, 0, 0);
}
template <class Epi, class Sched, bool ALIGN_EPI = false, bool SP2 = false, bool I8 = false>
__device__ __forceinline__ void gemm_phase(PG8_LAS unsigned char* lds, const Gemm g, const Sched& S, const Epi& E) {
    int tid_l = threadIdx.x; asm volatile("" : "+v"(tid_l));
    const int tid = tid_l, wid = __builtin_amdgcn_readfirstlane(tid >> 6), lane = tid & 63, wr = wid >> 2, wc = wid & 3, fr = lane & 15, fq = lane >> 4;
    const int K = g.K, nt = K / BK;
    unsigned voffA[2], voffB[2];
#pragma unroll
    for (int i = 0; i < 2; ++i) { int R, C; stage_rc(tid * 16 + i * 8192, R, C); const int Rb = Epi::PERM ? ((R & ~31) + perm32(R & 31)) : R;
        voffA[i] = (unsigned)(R * K + C) * 2u; voffB[i] = (unsigned)(Rb * K + C) * 2u; }
    const size_t kstep = (size_t)(BK * 2);
    const size_t hstep = (size_t)HALF * K * 2;
    const unsigned ldsw = (unsigned)wid * 1024u;
    const int aoff = lds_byte(wr * 64 + fr, fq * 8), boff = lds_byte(wc * 32 + fr, fq * 8);
#define PG8_SA(b, h) (((b) * 2 + (h)) * HTB)
#define PG8_SB(b, h) ((4 + (b) * 2 + (h)) * HTB)
#define PG8_STAGE(bufoff, gbase, voff) do { _Pragma("unroll") for (int _i = 0; _i < 2; ++_i) \
        __builtin_amdgcn_global_load_lds((const unsigned*)((const char*)(gbase) + (voff)[_i]), (PG8_LAS unsigned*)(lds + (bufoff) + ldsw + _i * 8192), 16, 0, 0); } while (0)
#define PG8_LDA(dst, b, h) do { _Pragma("unroll") for (int m = 0; m < 4; ++m) _Pragma("unroll") for (int k = 0; k < 2; ++k) dst[m][k] = *(const PG8_LAS bf16x8*)(lds + PG8_SA(b, h) + aoff + m * 2048 + k * 1024); } while (0)
#define PG8_LDB(dst, b, h) do { _Pragma("unroll") for (int n = 0; n < 2; ++n) _Pragma("unroll") for (int k = 0; k < 2; ++k) dst[n][k] = *(const PG8_LAS bf16x8*)(lds + PG8_SB(b, h) + boff + n * 2048 + k * 1024); } while (0)
#define PG8_MMA(ai, bj, At, Bt) do { __builtin_amdgcn_s_setprio(1); _Pragma("unroll") for (int m = 0; m < 4; ++m) _Pragma("unroll") for (int n = 0; n < 2; ++n) _Pragma("unroll") for (int k = 0; k < 2; ++k) \
        acc[ai][bj][m][n] = mma16<I8>(Bt[n][k], At[m][k], acc[ai][bj][m][n]); __builtin_amdgcn_s_setprio(0); } while (0)
#define PG8_WAIT_V(n) asm volatile("s_waitcnt vmcnt(" #n ")" ::: "memory")
#define PG8_WAIT_L(n) asm volatile("s_waitcnt lgkmcnt(" #n ")" ::: "memory")
#define PG8_BAR __builtin_amdgcn_s_barrier()
#define PG8_SCHED __builtin_amdgcn_sched_barrier(0)
    Unit cur, nxt; int ui = 0;
    if (!S.next(0, cur)) return;
    f32x4 acc[2][2][4][2];
#pragma unroll
    for (int a = 0; a < 2; ++a)
#pragma unroll
        for (int b = 0; b < 2; ++b)
#pragma unroll
            for (int m = 0; m < 4; ++m)
#pragma unroll
                for (int n = 0; n < 2; ++n) acc[a][b][m][n] = (f32x4){0.f, 0.f, 0.f, 0.f};
    bf16x8 At[4][2], B0[2][2], B1[2][2];
    const char* cA = S.pa(g, cur); const char* cB = S.pb(g, cur);
    S.a_ready(cur);
    if constexpr (SP2) {
        PG8_STAGE(PG8_SB(0, 0), cB, voffB); PG8_STAGE(PG8_SB(0, 1), cB + hstep, voffB); PG8_STAGE(PG8_SA(0, 0), cA, voffA); PG8_STAGE(PG8_SA(0, 1), cA + hstep, voffA);
        if (wr == 1) PG8_BAR;
        PG8_WAIT_V(2); PG8_BAR;
        PG8_STAGE(PG8_SB(1, 0), cB + kstep, voffB); PG8_STAGE(PG8_SA(1, 0), cA + kstep, voffA); PG8_STAGE(PG8_SB(1, 1), cB + hstep + kstep, voffB);
        PG8_WAIT_V(6); PG8_BAR;
    } else {
        PG8_STAGE(PG8_SB(0, 0), cB, voffB); PG8_STAGE(PG8_SA(0, 0), cA, voffA); PG8_STAGE(PG8_SB(0, 1), cB + hstep, voffB); PG8_STAGE(PG8_SA(0, 1), cA + hstep, voffA);
        if (wr == 1) PG8_BAR;
        PG8_WAIT_V(4); PG8_BAR;
        PG8_STAGE(PG8_SB(1, 0), cB + kstep, voffB); PG8_STAGE(PG8_SA(1, 0), cA + kstep, voffA); PG8_STAGE(PG8_SB(1, 1), cB + hstep + kstep, voffB);
        PG8_WAIT_V(6); PG8_BAR;
    }
    for (;;) {
        const bool has_next = S.next(ui + 1, nxt);
        const char* nA = has_next ? S.pa(g, nxt) : cA; const char* nB = has_next ? S.pb(g, nxt) : cB;
        for (int t = 0; t < nt; t += 2) {
            const bool last = (t == nt - 2);
            const char* a1 = cA + (size_t)(t + 1) * kstep;
            const char* a2 = last ? nA : cA + (size_t)(t + 2) * kstep; const char* b2 = last ? nB : cB + (size_t)(t + 2) * kstep;
            const char* a3 = a2 + kstep; const char* b3 = b2 + kstep;
            if (last && has_next) S.a_ready(nxt);
            if constexpr (SP2) {
            PG8_LDB(B0, 0, 0); PG8_LDB(B1, 0, 1); PG8_SCHED; PG8_LDA(At, 0, 0); PG8_STAGE(PG8_SA(1, 1), a1 + hstep, voffA);
            PG8_WAIT_V(8); PG8_WAIT_L(0); PG8_BAR; PG8_MMA(0, 0, At, B0); PG8_MMA(0, 1, At, B1); PG8_BAR; PG8_SCHED;
            PG8_LDA(At, 0, 1); PG8_STAGE(PG8_SB(0, 0), b2, voffB); PG8_STAGE(PG8_SB(0, 1), b2 + hstep, voffB); PG8_STAGE(PG8_SA(0, 0), a2, voffA);
            PG8_WAIT_V(8); PG8_WAIT_L(0); PG8_BAR; PG8_MMA(1, 0, At, B0); PG8_MMA(1, 1, At, B1); PG8_BAR; PG8_SCHED;
            PG8_LDB(B0, 1, 0); PG8_LDB(B1, 1, 1); PG8_SCHED; PG8_LDA(At, 1, 0); PG8_STAGE(PG8_SA(0, 1), a2 + hstep, voffA);
            PG8_WAIT_V(8); PG8_WAIT_L(0); PG8_BAR; PG8_MMA(0, 0, At, B0); PG8_MMA(0, 1, At, B1); PG8_BAR; PG8_SCHED;
            PG8_LDA(At, 1, 1); PG8_STAGE(PG8_SB(1, 0), b3, voffB); PG8_STAGE(PG8_SB(1, 1), b3 + hstep, voffB); PG8_STAGE(PG8_SA(1, 0), a3, voffA);
            PG8_WAIT_V(8); PG8_WAIT_L(0); PG8_BAR; PG8_MMA(1, 0, At, B0); PG8_MMA(1, 1, At, B1); PG8_BAR; PG8_SCHED;
            } else {
            PG8_LDB(B0, 0, 0); PG8_SCHED; PG8_LDA(At, 0, 0); PG8_STAGE(PG8_SA(1, 1), a1 + hstep, voffA);
            PG8_WAIT_L(8); PG8_BAR; PG8_WAIT_L(0); PG8_MMA(0, 0, At, B0); PG8_BAR; PG8_SCHED;
            PG8_LDB(B1, 0, 1); PG8_STAGE(PG8_SB(0, 0), b2, voffB);
            PG8_BAR; PG8_WAIT_L(0); PG8_MMA(0, 1, At, B1); PG8_BAR;
            PG8_LDA(At, 0, 1); PG8_STAGE(PG8_SA(0, 0), a2, voffA);
            PG8_BAR; PG8_WAIT_L(0); PG8_MMA(1, 0, At, B0); PG8_BAR; PG8_SCHED;
            PG8_STAGE(PG8_SB(0, 1), b2 + hstep, voffB);
            PG8_WAIT_V(6); PG8_BAR; PG8_MMA(1, 1, At, B1); PG8_BAR;
            PG8_LDB(B0, 1, 0); PG8_SCHED; PG8_LDA(At, 1, 0); PG8_STAGE(PG8_SA(0, 1), a2 + hstep, voffA);
            PG8_WAIT_L(8); PG8_BAR; PG8_WAIT_L(0); PG8_MMA(0, 0, At, B0); PG8_BAR; PG8_SCHED;
            PG8_LDB(B1, 1, 1); PG8_STAGE(PG8_SB(1, 0), b3, voffB);
            PG8_BAR; PG8_WAIT_L(0); PG8_MMA(0, 1, At, B1); PG8_BAR;
            PG8_LDA(At, 1, 1); PG8_STAGE(PG8_SA(1, 0), a3, voffA);
            PG8_BAR; PG8_WAIT_L(0); PG8_MMA(1, 0, At, B0); PG8_BAR; PG8_SCHED;
            PG8_STAGE(PG8_SB(1, 1), b3 + hstep, voffB);
            PG8_WAIT_V(6); PG8_BAR; PG8_MMA(1, 1, At, B1); PG8_BAR;
            }
        }
        if constexpr (ALIGN_EPI) { if (wr == 0) PG8_BAR; }
        if constexpr (!Epi::AFTER_DRAIN) { E(acc, cur, wr, wc, fr, fq); S.done(cur); }
        if (!has_next) break;
#pragma unroll
        for (int a = 0; a < 2; ++a)
#pragma unroll
            for (int b = 0; b < 2; ++b)
#pragma unroll
                for (int m = 0; m < 4; ++m)
#pragma unroll
                    for (int n = 0; n < 2; ++n) acc[a][b][m][n] = (f32x4){0.f, 0.f, 0.f, 0.f};
        cur = nxt; cA = nA; cB = nB; ++ui;
        if constexpr (ALIGN_EPI) { if (wr == 1) PG8_BAR; }
    }
    PG8_WAIT_V(0);
    if constexpr (!ALIGN_EPI) { if (wr == 0) PG8_BAR; }
    PG8_BAR;
    if constexpr (Epi::AFTER_DRAIN) { E.fused(acc, cur, wr, wc, fr, fq, lds, wid, lane); S.done(cur); }
#undef PG8_SA
#undef PG8_SB
#undef PG8_STAGE
#undef PG8_LDA
#undef PG8_LDB
#undef PG8_MMA
#undef PG8_WAIT_V
#undef PG8_WAIT_L
#undef PG8_BAR
#undef PG8_SCHED
}
}

#define GAS __attribute__((address_space(1)))
#define LAS __attribute__((address_space(3)))
typedef unsigned short bf16;
typedef unsigned v4u __attribute__((ext_vector_type(4)));
typedef unsigned v2u __attribute__((ext_vector_type(2)));
typedef float f32x4 __attribute__((ext_vector_type(4)));
typedef short bf16x8 __attribute__((ext_vector_type(8)));

constexpr int NB = 8, SEQ = 4096, DM = 2048, T = NB * SEQ;
constexpr int NPT = 23;
constexpr int NE = 32, DFF = 2048;
constexpr int MAXTILES = 544;
constexpr float RMS_EPS = 1e-5f;
constexpr int NVB = 256, TPV = T / NVB;

enum { I_X = 0, I_NMIX, I_WIN, I_WA2, I_BA, I_GLAG, I_PEK, I_WK1, I_WK2, I_PEV, I_WV1, I_WV2, I_NSAG, I_RELB, I_WOUT, I_NFFN, I_RW, I_RB, I_W1, I_B1, I_W2, I_B2, I_NFIN, N_IN };

constexpr size_t MiB = 1u << 20;
constexpr size_t al(size_t x) { return (x + 255) & ~(size_t)255; }
constexpr size_t WS_CTL = 0, CTL_BYTES = 1 * MiB;
constexpr size_t WS_CNT = WS_CTL + CTL_BYTES;
constexpr size_t WS_META = WS_CNT + al(NVB * 32 * 4);
constexpr size_t WS_EIDX = WS_META + al((64 + MAXTILES) * 4);
constexpr size_t WS_LRNK = WS_EIDX + al((size_t)T * 4 * 4);
constexpr size_t WS_GATE = WS_LRNK + al((size_t)T * 4 * 4);
constexpr size_t WS_POS = WS_GATE + al((size_t)T * 4 * 4);
constexpr size_t WS_ROWW = WS_POS + al((size_t)T * 4 * 4);
constexpr size_t WS_WINT = al(WS_ROWW + (size_t)MAXTILES * 256 * 4);
constexpr size_t WS_WOT = WS_WINT + (size_t)NPT * 256 * DM * 2;
constexpr size_t WS_WKCT = WS_WOT + (size_t)DM * DM * 2;
constexpr size_t WS_WVCT = WS_WKCT + (size_t)256 * 2048 * 2;
constexpr size_t WS_W1T = WS_WVCT + (size_t)256 * 2048 * 2;
constexpr size_t WS_W2T = WS_W1T + (size_t)NE * 4096 * DM * 2;
constexpr size_t WS_XN = WS_W2T + (size_t)NE * DM * DFF * 2;
constexpr size_t WS_GQ = WS_XN + (size_t)T * DM * 2;
constexpr size_t WS_GK = WS_GQ + (size_t)T * 512 * 2;
constexpr size_t WS_GV = WS_GK + (size_t)T * 512 * 2;
constexpr size_t WS_GG = WS_GV + (size_t)T * 1024 * 2;
constexpr size_t WS_NQ = WS_GG + (size_t)T * 1024 * 2;
constexpr size_t WS_KC = WS_NQ + (size_t)T * 1024 * 2;
constexpr size_t WS_VC = WS_KC + (size_t)T * 256 * 2;
constexpr size_t WS_KS = WS_VC + (size_t)T * 256 * 2;
constexpr size_t WS_KW = WS_KS + (size_t)T * 256 * 2;
constexpr size_t WS_VST = WS_KW + (size_t)T * 256 * 2;
constexpr size_t WS_VWT = WS_VST + (size_t)T * 256 * 2;
constexpr size_t WS_SM = WS_VWT + (size_t)T * 256 * 2;
constexpr size_t WS_LA = WS_SM + (size_t)T * 64 * 2;
constexpr size_t WS_OG = WS_LA + (size_t)T * 512 * 4;
constexpr size_t WS_ON = WS_OG + (size_t)T * 1024 * 4;
constexpr size_t WS_KCMP = WS_ON + (size_t)T * 1024 * 4;
constexpr size_t WS_VCMPT = WS_KCMP + (size_t)16 * 256 * 128 * 2;
constexpr size_t WS_A2 = WS_VCMPT + (size_t)16 * 256 * 128 * 2;
constexpr size_t WS_HN = WS_A2 + (size_t)T * DM * 2;
constexpr size_t WS_XG = WS_HN + (size_t)T * DM * 2;
constexpr size_t WS_ACT = WS_XG + (size_t)MAXTILES * 256 * DM * 2;
constexpr size_t WS_END = WS_ACT + (size_t)MAXTILES * 256 * DFF * 2;

__device__ __forceinline__ unsigned f2bf(float f) { unsigned u = __builtin_bit_cast(unsigned, f); return (u + 0x7fffu + ((u >> 16) & 1u)) >> 16; }
__device__ __forceinline__ unsigned pk2(float lo, float hi) { return f2bf(lo) | (f2bf(hi) << 16); }
__device__ __forceinline__ float bf2f(unsigned short v) { return __builtin_bit_cast(float, (unsigned)v << 16); }
__device__ __forceinline__ float bflo(unsigned w) { return __builtin_bit_cast(float, w << 16); }
__device__ __forceinline__ float bfhi(unsigned w) { return __builtin_bit_cast(float, w & 0xffff0000u); }
__device__ __forceinline__ float wave_sum(float v) {
#pragma unroll
    for (int o = 1; o < 64; o <<= 1) v += __shfl_xor(v, o);
    return v;
}
__device__ __forceinline__ float wave_max(float v) {
#pragma unroll
    for (int o = 1; o < 64; o <<= 1) v = fmaxf(v, __shfl_xor(v, o));
    return v;
}
#define LDS_WAIT() asm volatile("s_waitcnt lgkmcnt(0)" ::: "memory")

__device__ const unsigned char kBucket[128] = {0, 1, 2, 3, 4, 5, 6, 7, 8, 9, 10, 11, 12, 13, 14, 15, 16, 16, 16, 17, 17, 18, 18, 18, 19, 19, 19, 20, 20, 20, 20, 21, 21, 21, 21, 22, 22, 22, 22, 22, 23, 23, 23, 23, 23, 23, 24, 24, 24, 24, 24, 24, 25, 25, 25, 25, 25, 25, 25, 26, 26, 26, 26, 26, 26, 26, 26, 27, 27, 27, 27, 27, 27, 27, 27, 27, 27, 28, 28, 28, 28, 28, 28, 28, 28, 28, 28, 29, 29, 29, 29, 29, 29, 29, 29, 29, 29, 29, 29, 30, 30, 30, 30, 30, 30, 30, 30, 30, 30, 30, 30, 30, 30, 31, 31, 31, 31, 31, 31, 31, 31, 31, 31, 31, 31, 31, 31, 31};

struct Params {
    const float* in[N_IN];
    float* out;
    unsigned char* ws;
};

template <class F>
__device__ __forceinline__ void transpose_item(const float* W, int ldw, int k0, int n0, int nlim, LAS float* scr, int lane, F dst) {
#pragma unroll 8
    for (int i = 0; i < 32; ++i) { const int kk = 2 * i + (lane >> 5); const int n = n0 + (lane & 31); scr[kk * 33 + (lane & 31)] = n < nlim ? W[(size_t)(k0 + kk) * ldw + n] : 0.f; }
    LDS_WAIT(); asm volatile("" ::: "memory");
    const int c = lane & 7;
#pragma unroll
    for (int j = 0; j < 4; ++j) { const int nn = (lane >> 3) + 8 * j; const int n = n0 + nn; const LAS float* s = scr + (8 * c) * 33 + nn;
        bf16* rowp; float sc;
        if (n < nlim && dst(n, rowp, sc)) {
            v4u o; o.x = pk2(s[0 * 33] * sc, s[1 * 33] * sc); o.y = pk2(s[2 * 33] * sc, s[3 * 33] * sc); o.z = pk2(s[4 * 33] * sc, s[5 * 33] * sc); o.w = pk2(s[6 * 33] * sc, s[7 * 33] * sc);
            *(v4u*)(rowp + 8 * c) = o; } }
    LDS_WAIT(); asm volatile("" ::: "memory");
}
__device__ __forceinline__ int win_row(int n, float& sc) {
    sc = 1.f;
    if (n < 512) { sc = 0.08838834764831845f; return n; }
    if (n < 1024) return n;
    if (n < 2048) return n;
    if (n < 3072) return n;
    if (n < 3088) return 5120 + (n - 3072);
    if (n < 4112) { sc = 0.08838834764831845f; return 3072 + (n - 3088); }
    if (n < 4368) return 4096 + (n - 4112);
    if (n < 4624) return 4352 + (n - 4368);
    if (n < 4880) return 4608 + (n - 4624);
    if (n < 5136) return 5376 + (n - 4880);
    if (n < 5392) return 4864 + (n - 5136);
    if (n < 5648) return 5632 + (n - 5392);
    return 5136 + (n - 5648);
}
constexpr size_t WS_PEVP = WS_W2T;
__device__ __forceinline__ void p0_prologue(const Params& p, LAS unsigned char* lds, int gw, int NGW, int wave, int lane) {
    LAS float* scr = (LAS float*)(lds + wave * 16384);
    bf16* WinT = (bf16*)(p.ws + WS_WINT); bf16* WoT = (bf16*)(p.ws + WS_WOT); bf16* WkcT = (bf16*)(p.ws + WS_WKCT); bf16* WvcT = (bf16*)(p.ws + WS_WVCT);
    bf16* W1T = (bf16*)(p.ws + WS_W1T); bf16* W2T = (bf16*)(p.ws + WS_W2T);
    constexpr int I_IN = 32 * 178, I_O = 32 * 64, I_C = 64 * 4, I_E1 = 32 * 128, I_E2 = 32 * 64;
    constexpr int I_PE = 2 * 64;
    constexpr int NITEMS = I_O + 2 * I_C + I_PE;
    (void)I_IN; (void)WinT;
    for (int it = gw; it < NITEMS; it += NGW) {
        int r = it;
        if (r < I_O) { const int kb = r / 64, nb = r % 64, k0 = kb * 64;
            transpose_item(p.in[I_WOUT], DM, k0, nb * 32, DM, scr, lane, [&](int n, bf16*& rowp, float& sc) { sc = 1.f; rowp = WoT + (size_t)n * DM + k0; return true; }); continue; } r -= I_O;
        if (r >= 2 * I_C) { r -= 2 * I_C; const int which = r >> 6, kq = r & 63; const float* pe = p.in[which ? I_PEV : I_PEK] + kq * 64; const float* w1 = p.in[which ? I_WV1 : I_WK1] + (size_t)kq * 64 * 128 + lane;
            float a0 = 0.f, a1 = 0.f;
#pragma unroll
            for (int k = 0; k < 64; ++k) { const float pv = pe[k]; a0 += pv * w1[k * 128]; a1 += pv * w1[k * 128 + 64]; }
            float* dst = (float*)(p.ws + WS_PEVP) + (size_t)(which * 64 + kq) * 128 + lane; dst[0] = a0; dst[64] = a1; continue; }
        { const int which = r / I_C; r %= I_C; const int kb = r / 4, nb = r % 4, k0 = kb * 64;
            bf16* dstm = which ? WvcT : WkcT;
            transpose_item(p.in[which ? I_WV1 : I_WK1], 128, k0, nb * 32, 128, scr, lane, [&](int n, bf16*& rowp, float& sc) { sc = 1.f; rowp = dstm + (size_t)(n + (k0 >= 2048 ? 128 : 0)) * 2048 + (k0 & 2047); return true; }); }
        (void)I_E1; (void)I_E2; (void)W1T; (void)W2T;
    }
    const float* x = p.in[I_X]; const float* gm = p.in[I_NMIX];
    for (int m = gw; m < T; m += NGW) {
        const f32x4* xr = (const f32x4*)(x + (size_t)m * DM) + lane; f32x4 v[8]; float s = 0.f;
#pragma unroll
        for (int j = 0; j < 8; ++j) { v[j] = xr[64 * j]; s += (v[j].x * v[j].x + v[j].y * v[j].y) + (v[j].z * v[j].z + v[j].w * v[j].w); }
        const float rstd = 1.f / sqrtf(wave_sum(s) * (1.f / DM) + RMS_EPS);
        float mxr = 0.f;
#pragma unroll
        for (int j = 0; j < 8; ++j) { const f32x4 g4 = ((const f32x4*)gm)[lane + 64 * j]; v[j].x *= rstd * g4.x; v[j].y *= rstd * g4.y; v[j].z *= rstd * g4.z; v[j].w *= rstd * g4.w;
            mxr = fmaxf(mxr, fmaxf(fmaxf(fabsf(v[j].x), fabsf(v[j].y)), fmaxf(fabsf(v[j].z), fabsf(v[j].w)))); }
        mxr = wave_max(mxr); const float qs = mxr > 0.f ? mxr * (1.f / 127.f) : 1.f, qi = 1.f / qs;
        unsigned* o4 = (unsigned*)(p.ws + WS_XN + (size_t)m * DM) + lane;
#pragma unroll
        for (int j = 0; j < 8; ++j) { const int q0 = (int)rintf(v[j].x * qi), q1 = (int)rintf(v[j].y * qi), q2 = (int)rintf(v[j].z * qi), q3 = (int)rintf(v[j].w * qi);
            o4[64 * j] = ((unsigned)q0 & 0xffu) | (((unsigned)q1 & 0xffu) << 8) | (((unsigned)q2 & 0xffu) << 16) | (((unsigned)q3 & 0xffu) << 24); }
        if (lane == 0) ((float*)(p.ws + WS_XN + (size_t)T * DM))[m] = qs;
    }
}
#define XB_TMO      128
#define XB_XCNT(j)  (256  + 64 * (j))
#define XB_XSUB(j)  (1280 + 64 * (j))
#define XB_XGEN(j)  (2304 + 64 * (j))
#define XB_TOP      3328
#define XB_TOPGEN   3392
#define XCD_BAR_WORDS 3456
#define XB_SPIN_CAP (1u << 18)

__device__ __forceinline__ unsigned xb_ld(unsigned* p)              { return __hip_atomic_load(p, __ATOMIC_RELAXED, __HIP_MEMORY_SCOPE_AGENT); }
__device__ __forceinline__ unsigned xb_add(unsigned* p, unsigned v) { return __hip_atomic_fetch_add(p, v, __ATOMIC_RELAXED, __HIP_MEMORY_SCOPE_AGENT); }
__device__ __forceinline__ unsigned xb_xcc_id() { return (unsigned)__builtin_amdgcn_s_getreg((3 << 11) | 20) & 0xFu; }
#define XB_SPIN(cond, bar) do { unsigned _sp = 0; while (cond) { __builtin_amdgcn_s_sleep(1); \
    if ((++_sp & 255u) == 0u) { if (xb_ld(&(bar)[XB_TMO])) break; if (_sp > XB_SPIN_CAP) { atomicAdd(&(bar)[XB_TMO], 1u); break; } } } } while (0)

struct XcdBarrier {
    unsigned* bar; unsigned x;
    volatile LAS unsigned* st;
};

__device__ __forceinline__ XcdBarrier xcd_barrier_post(unsigned* bar, volatile LAS unsigned* st) {
    XcdBarrier b; b.bar = bar; b.x = xb_xcc_id(); b.st = st;
    if (threadIdx.x == 0) (void)xb_add(&bar[XB_XCNT(b.x)], 1u);
    return b;
}
__device__ __forceinline__ void xcd_barrier_complete(unsigned* bar, unsigned x, unsigned& nloc, unsigned& nx) {
    const unsigned G = gridDim.x * gridDim.y * gridDim.z;
    unsigned sum, cnt, mine, sp = 0u;
    for (;;) {
        sum = 0u; cnt = 0u; mine = 0u;
#pragma unroll
        for (unsigned j = 0; j < 16; ++j) { const unsigned c = xb_ld(&bar[XB_XCNT(j)]); sum += c; cnt += (c > 0u) ? 1u : 0u; mine = (j == x) ? c : mine; }
        if (sum == G) break;
        __builtin_amdgcn_s_sleep(1);
        if ((++sp & 255u) == 0u) { if (xb_ld(&bar[XB_TMO])) break; if (sp > XB_SPIN_CAP) { atomicAdd(&bar[XB_TMO], 1u); break; } }
    }
    nloc = mine > 0u ? mine : 1u; nx = cnt > 0u ? cnt : 1u;
}

__device__ __forceinline__ void xcd_barrier(const XcdBarrier& b) {
    asm volatile("s_waitcnt vmcnt(0)" ::: "memory");
    __syncthreads();
    if (threadIdx.x == 0) {
        unsigned* bar = b.bar;
        __builtin_amdgcn_s_waitcnt(0);
        unsigned nloc = b.st[0], nx = b.st[1];
        if (nloc == 0u) { xcd_barrier_complete(bar, b.x, nloc, nx); b.st[0] = nloc; b.st[1] = nx; }
        const unsigned old = xb_add(&bar[XB_XSUB(b.x)], 1u);
        const unsigned gen = old / nloc;
        if (old + 1u == (gen + 1u) * nloc) {
            __builtin_amdgcn_fence(__ATOMIC_RELEASE, "agent");
            asm volatile("s_waitcnt vmcnt(0)" ::: "memory");
            const unsigned og = xb_add(&bar[XB_TOP], 1u);
            const unsigned tg = og / nx;
            if (og + 1u == (tg + 1u) * nx) xb_add(&bar[XB_TOPGEN], 1u);
            else XB_SPIN(xb_ld(&bar[XB_TOPGEN]) == tg, bar);
            __builtin_amdgcn_fence(__ATOMIC_ACQUIRE, "agent");
            xb_add(&bar[XB_XGEN(b.x)], 1u);
            asm volatile("s_waitcnt vmcnt(0)" ::: "memory");
        } else {
            XB_SPIN(xb_ld(&bar[XB_XGEN(b.x)]) == gen, bar);
            __builtin_amdgcn_fence(__ATOMIC_ACQUIRE, "agent");
            asm volatile("s_waitcnt vmcnt(0)" ::: "memory");
        }
    }
    __syncthreads();
}

struct ProjOrder : pg8::StaticOrder {
    const bf16* xn; const bf16* wt;
    __device__ __forceinline__ bool next(int i, pg8::Unit& u) const { if (!pg8::StaticOrder::next(i, u)) return false; u.kind = (u.pn >= 21) ? 1 : 0; return true; }
    __device__ __forceinline__ const char* pa(const pg8::Gemm& g, const pg8::Unit& u) const { return u.kind ? (const char*)wt + (size_t)u.pn * ((size_t)256 * g.K * 2) : (const char*)xn + (size_t)u.pm * ((size_t)256 * g.K * 2); }
    __device__ __forceinline__ const char* pb(const pg8::Gemm& g, const pg8::Unit& u) const { return u.kind ? (const char*)xn + (size_t)u.pm * ((size_t)256 * g.K * 2) : (const char*)wt + (size_t)u.pn * ((size_t)256 * g.K * 2); }
};
struct EpiProj {
    static constexpr bool PERM = true, AFTER_DRAIN = false;
    unsigned char* ws;
    __device__ __forceinline__ void operator()(const pg8::f32x4 (&acc)[2][2][4][2], const pg8::Unit& u, int wr, int wc, int fr, int fq) const {
        const int cw = wc * 32 + 8 * fq;
        if (u.kind == 0) {
            const int tn = u.pn; bf16* base; size_t bjs = 128; int ld = 0; bool headmajor = false; bool small = false;
            if (tn < 2) { base = (bf16*)(ws + WS_GQ) + tn * 256; ld = 512; }
            else if (tn < 4) { base = (bf16*)(ws + WS_GK) + (tn - 2) * 256; ld = 512; }
            else if (tn < 8) { base = (bf16*)(ws + WS_GV) + (tn - 4) * 256; ld = 1024; }
            else if (tn < 12) { base = (bf16*)(ws + WS_GG) + (tn - 8) * 256; ld = 1024; }
            else if (tn < 16) { base = (bf16*)(ws + WS_NQ) + (tn - 12) * 256; ld = 1024; }
            else if (tn < 20) { base = (bf16*)(ws + (tn == 16 ? WS_KC : tn == 17 ? WS_VC : tn == 18 ? WS_KS : WS_KW)); headmajor = true; bjs = (size_t)SEQ * 128; }
            else { base = (bf16*)(ws + WS_SM); ld = 64; small = true; }
            if (small && wc >= 2) return;
#pragma unroll
            for (int ai = 0; ai < 2; ++ai)
#pragma unroll
                for (int m = 0; m < 4; ++m) { const int r = u.pm * 256 + ai * 128 + wr * 64 + m * 16 + fr;
                    const size_t rterm = headmajor ? ((size_t)(r >> 12) * 2 * SEQ + (r & (SEQ - 1))) * 128 : (size_t)r * ld;
#pragma unroll
                    for (int bj = 0; bj < 2; ++bj) { if (small && bj) continue;
                        const pg8::f32x4 v0 = acc[ai][bj][m][0], v1 = acc[ai][bj][m][1];
                        pg8::u32x4 w; w.x = pg8::cvt_pk_bf16(v0[0], v0[1]); w.y = pg8::cvt_pk_bf16(v0[2], v0[3]); w.z = pg8::cvt_pk_bf16(v1[0], v1[1]); w.w = pg8::cvt_pk_bf16(v1[2], v1[3]);
                        *(pg8::u32x4*)(base + rterm + bj * bjs + cw) = w; } }
        } else {
            bf16* base = (bf16*)(ws + (u.pn == 21 ? WS_VST : WS_VWT));
#pragma unroll
            for (int ai = 0; ai < 2; ++ai)
#pragma unroll
                for (int m = 0; m < 4; ++m) { const int dh = wr * 64 + m * 16 + fr;
#pragma unroll
                    for (int bj = 0; bj < 2; ++bj) { const int tok = u.pm * 256 + bj * 128 + cw; const int b = tok >> 12, s = tok & (SEQ - 1);
                        const pg8::f32x4 v0 = acc[ai][bj][m][0], v1 = acc[ai][bj][m][1];
                        pg8::u32x4 w; w.x = pg8::cvt_pk_bf16(v0[0], v0[1]); w.y = pg8::cvt_pk_bf16(v0[2], v0[3]); w.z = pg8::cvt_pk_bf16(v1[0], v1[1]); w.w = pg8::cvt_pk_bf16(v1[2], v1[3]);
                        *(pg8::u32x4*)(base + ((size_t)(b * 2 + ai) * 128 + dh) * SEQ + s) = w; } }
        }
    }
};
struct EpiRes {
    static constexpr bool PERM = false, AFTER_DRAIN = false;
    const float* x; float* h;
    __device__ __forceinline__ void operator()(const pg8::f32x4 (&acc)[2][2][4][2], const pg8::Unit& u, int wr, int wc, int fr, int fq) const {
        const int row0 = u.pm * 256 + wr * 64 + fr, col0 = u.pn * 256 + wc * 32 + 4 * fq;
#pragma unroll
        for (int ai = 0; ai < 2; ++ai)
#pragma unroll
            for (int m = 0; m < 4; ++m) { const size_t off = (size_t)(row0 + ai * 128 + m * 16) * DM + col0;
#pragma unroll
                for (int bj = 0; bj < 2; ++bj)
#pragma unroll
                    for (int n = 0; n < 2; ++n) { const pg8::f32x4 xv = *(const pg8::f32x4*)(x + off + bj * 128 + n * 16); *(pg8::f32x4*)(h + off + bj * 128 + n * 16) = xv + acc[ai][bj][m][n]; } }
    }
};
struct MoeOrder {
    int nM, nN, nwg, G, c; const int* tile_exp;
    __device__ __forceinline__ void init(const int* meta, int nN_, int G_, int c_) { nM = meta[0]; nN = nN_; nwg = nM * nN; G = G_; c = c_; tile_exp = meta + 64; }
    __device__ __forceinline__ bool next(int i, pg8::Unit& u) const {
        const long L = (long)i * G + c; if (L >= nwg) return false;
        pg8::tile_of((int)L, nM, nN, u.pm, u.pn); u.kind = tile_exp[u.pm]; return true;
    }
    __device__ __forceinline__ const char* pa(const pg8::Gemm& g, const pg8::Unit& u) const { return (const char*)g.A + (size_t)u.pm * ((size_t)256 * g.K * 2); }
    __device__ __forceinline__ const char* pb(const pg8::Gemm& g, const pg8::Unit& u) const { return (const char*)g.Bt + ((size_t)u.kind * nN + u.pn) * ((size_t)256 * g.K * 2); }
    __device__ __forceinline__ void a_ready(const pg8::Unit&) const {}
    __device__ __forceinline__ void done(const pg8::Unit&) const {}
};

struct MoeOrderSync : MoeOrder {
    unsigned* xl; unsigned x, nloc; int full_rounds; mutable int calls;
    __device__ __forceinline__ void init_sync(unsigned* xl_, unsigned x_, unsigned nloc_) { xl = xl_; x = x_; nloc = nloc_ ? nloc_ : 1u; full_rounds = nwg / G; calls = 0; }
    __device__ __forceinline__ void a_ready(const pg8::Unit&) const {
        if (calls < full_rounds) {
            if (threadIdx.x == 0) { unsigned* sub = xl + 64 * x; unsigned* genw = xl + 1024 + 64 * x;
                const unsigned old = __hip_atomic_fetch_add(sub, 1u, __ATOMIC_RELAXED, __HIP_MEMORY_SCOPE_AGENT), gen = old / nloc;
                if (old + 1u == (gen + 1u) * nloc) __hip_atomic_fetch_add(genw, 1u, __ATOMIC_RELAXED, __HIP_MEMORY_SCOPE_AGENT);
                else { unsigned sp = 0; while (__hip_atomic_load(genw, __ATOMIC_RELAXED, __HIP_MEMORY_SCOPE_AGENT) == gen) { __builtin_amdgcn_s_sleep(1); if (++sp > (1u << 16)) break; } } }
            asm volatile("" ::: "memory"); __builtin_amdgcn_s_barrier(); asm volatile("" ::: "memory"); }
        ++calls;
    }
};
struct EpiSwiglu {
    static constexpr bool PERM = true, AFTER_DRAIN = false;
    const float* b1; bf16* act;
    __device__ __forceinline__ void operator()(const pg8::f32x4 (&acc)[2][2][4][2], const pg8::Unit& u, int wr, int wc, int fr, int fq) const {
        const int e = u.kind; const int col = u.pn * 128 + wc * 32 + 8 * fq; const int row0 = u.pm * 256 + wr * 64 + fr;
        const float* bg = b1 + (size_t)e * 4096 + col; const float* bl = bg + 2048;
        const pg8::f32x4 g0 = *(const pg8::f32x4*)bg, g1 = *(const pg8::f32x4*)(bg + 4), l0 = *(const pg8::f32x4*)bl, l1 = *(const pg8::f32x4*)(bl + 4);
#pragma unroll
        for (int ai = 0; ai < 2; ++ai)
#pragma unroll
            for (int m = 0; m < 4; ++m) { float o[8];
#pragma unroll
                for (int n = 0; n < 2; ++n)
#pragma unroll
                    for (int j = 0; j < 4; ++j) { float gl = acc[ai][0][m][n][j] + (n ? g1[j] : g0[j]); float li = acc[ai][1][m][n][j] + (n ? l1[j] : l0[j]);
                        gl = fminf(gl, 7.f); li = fminf(fmaxf(li, -7.f), 7.f);
                        o[n * 4 + j] = gl * (1.f / (1.f + __expf(-1.702f * gl))) * (li + 1.f); }
                pg8::u32x4 w; w.x = pg8::cvt_pk_bf16(o[0], o[1]); w.y = pg8::cvt_pk_bf16(o[2], o[3]); w.z = pg8::cvt_pk_bf16(o[4], o[5]); w.w = pg8::cvt_pk_bf16(o[6], o[7]);
                *(pg8::u32x4*)(act + (size_t)(row0 + ai * 128 + m * 16) * DFF + col) = w; }
    }
};
struct EpiDown {
    static constexpr bool PERM = true, AFTER_DRAIN = false;
    const float* b2; const float* roww; bf16* y;
    __device__ __forceinline__ void operator()(const pg8::f32x4 (&acc)[2][2][4][2], const pg8::Unit& u, int wr, int wc, int fr, int fq) const {
        const int e = u.kind; const int col0 = u.pn * 256 + wc * 32 + 8 * fq; const int row0 = u.pm * 256 + wr * 64 + fr;
        pg8::f32x4 bv[2][2];
#pragma unroll
        for (int bj = 0; bj < 2; ++bj)
#pragma unroll
            for (int n = 0; n < 2; ++n) bv[bj][n] = *(const pg8::f32x4*)(b2 + (size_t)e * DM + col0 + bj * 128 + 4 * n);
#pragma unroll
        for (int ai = 0; ai < 2; ++ai)
#pragma unroll
            for (int m = 0; m < 4; ++m) { const int r = row0 + ai * 128 + m * 16; const float g = roww[r];
#pragma unroll
                for (int bj = 0; bj < 2; ++bj) { const pg8::f32x4 v0 = (acc[ai][bj][m][0] + bv[bj][0]) * g, v1 = (acc[ai][bj][m][1] + bv[bj][1]) * g;
                    pg8::u32x4 w; w.x = pg8::cvt_pk_bf16(v0[0], v0[1]); w.y = pg8::cvt_pk_bf16(v0[2], v0[3]); w.z = pg8::cvt_pk_bf16(v1[0], v1[1]); w.w = pg8::cvt_pk_bf16(v1[2], v1[3]);
                    *(pg8::u32x4*)(y + (size_t)r * DM + col0 + bj * 128) = w; } }
    }
};

__device__ __forceinline__ void ph_loga(const Params& p, size_t i0, size_t istride) {
    const bf16* SM = (const bf16*)(p.ws + WS_SM); float* LA = (float*)(p.ws + WS_LA); const float* wa2 = p.in[I_WA2]; const float* ba = p.in[I_BA];
    for (size_t i = i0; i < (size_t)T * 512; i += istride) {
        const int t = (int)(i >> 9), c = (int)(i & 511); float z = ba[c];
#pragma unroll
        for (int r = 0; r < 16; ++r) z += bf2f(SM[(size_t)t * 64 + r]) * wa2[r * 512 + c];
        LA[i] = (fminf(z, 0.f) - log1pf(__expf(-fabsf(z)))) * (1.f / 16.f);
    }
}
__device__ __forceinline__ void ph_gla_naive(const Params& p, LAS float* qs, int unit, int lane) {
    LAS float* ks = qs + 128; LAS float* as = qs + 256;
    const int bh = unit >> 2, sl = unit & 3, b = bh >> 2, h = bh & 3, dv = sl * 64 + lane;
    const bf16* GQ = (const bf16*)(p.ws + WS_GQ); const bf16* GK = (const bf16*)(p.ws + WS_GK); const bf16* GV = (const bf16*)(p.ws + WS_GV);
    const float* LA = (const float*)(p.ws + WS_LA); float* OG = (float*)(p.ws + WS_OG);
    float st[128];
#pragma unroll
    for (int i = 0; i < 128; ++i) st[i] = 0.f;
    for (int s = 0; s < SEQ; ++s) { const size_t row = (size_t)b * SEQ + s;
#pragma unroll
        for (int j = 0; j < 2; ++j) { const int dk = lane + 64 * j; qs[dk] = bf2f(GQ[row * 512 + h * 128 + dk]); ks[dk] = bf2f(GK[row * 512 + h * 128 + dk]); as[dk] = __expf(LA[row * 512 + h * 128 + dk]); }
        LDS_WAIT(); __builtin_amdgcn_wave_barrier();
        const float v = bf2f(GV[row * 1024 + h * 256 + dv]); float o = 0.f;
#pragma unroll
        for (int dk = 0; dk < 128; ++dk) { st[dk] = as[dk] * st[dk] + ks[dk] * v; o += qs[dk] * st[dk]; }
        OG[row * 1024 + h * 256 + dv] = o;
        LDS_WAIT(); __builtin_amdgcn_wave_barrier();
    }
}
template <bool DO_NSA> __device__ __forceinline__ void ph_mix_post(const Params& p, int gw, int NGW, int lane) {
    const float* OG = (const float*)(p.ws + WS_OG); const float* ON = (const float*)(p.ws + WS_ON); const bf16* GG = (const bf16*)(p.ws + WS_GG); bf16* A2 = (bf16*)(p.ws + WS_A2);
    const float* gn = p.in[I_GLAG]; const float* ng = p.in[I_NSAG];
    for (int t = gw; t < T; t += NGW) {
#pragma unroll
        for (int h = 0; h < 4; ++h) { const f32x4 o = *((const f32x4*)(OG + (size_t)t * 1024 + h * 256) + lane);
            const float ms = wave_sum(o.x * o.x + o.y * o.y + o.z * o.z + o.w * o.w) * (1.f / 256.f); const float rstd = 1.f / sqrtf(ms + RMS_EPS);
            const f32x4 g4 = ((const f32x4*)gn)[lane]; const v2u gg = *((const v2u*)(GG + (size_t)t * 1024 + h * 256) + lane);
            const float z0 = bflo(gg.x), z1 = bfhi(gg.x), z2 = bflo(gg.y), z3 = bfhi(gg.y);
            v2u w; w.x = pk2(o.x * rstd * g4.x * (z0 / (1.f + __expf(-z0))), o.y * rstd * g4.y * (z1 / (1.f + __expf(-z1))));
            w.y = pk2(o.z * rstd * g4.z * (z2 / (1.f + __expf(-z2))), o.w * rstd * g4.w * (z3 / (1.f + __expf(-z3))));
            *((v2u*)(A2 + (size_t)t * DM + h * 256) + lane) = w; }
        if (!DO_NSA) continue;
        f32x4 v[4]; float s = 0.f;
#pragma unroll
        for (int j = 0; j < 4; ++j) { v[j] = *((const f32x4*)(ON + (size_t)t * 1024) + lane + 64 * j); s += v[j].x * v[j].x + v[j].y * v[j].y + v[j].z * v[j].z + v[j].w * v[j].w; }
        const float rstd = 1.f / sqrtf(wave_sum(s) * (1.f / 1024.f) + RMS_EPS);
#pragma unroll
        for (int j = 0; j < 4; ++j) { const f32x4 g4 = ((const f32x4*)ng)[lane + 64 * j]; v2u w; w.x = pk2(v[j].x * rstd * g4.x, v[j].y * rstd * g4.y); w.y = pk2(v[j].z * rstd * g4.z, v[j].w * rstd * g4.w);
            *((v2u*)(A2 + (size_t)t * DM + 1024) + lane + 64 * j) = w; }
    }
}
__device__ __forceinline__ float gelu_tanh(float x) { const float u = 0.7978845608028654f * (x + 0.044715f * x * x * x); const float e = __expf(2.f * u); return 0.5f * x * (1.f + (1.f - 2.f / (e + 1.f))); }
__device__ __forceinline__ void ph_cmp_naive(const Params& p, LAS float* tl, int id, int n) {
    LAS float* hid = tl + 4096;
    const int which = id / (16 * 255), rem = id % (16 * 255), bg = rem / 255, c = rem % 255;
    const bf16* src = (const bf16*)(p.ws + (which ? WS_VC : WS_KC)) + ((size_t)bg * SEQ + 16 * c) * 128;
    const float* pe = p.in[which ? I_PEV : I_PEK]; const float* w1 = p.in[which ? I_WV1 : I_WK1]; const float* w2 = p.in[which ? I_WV2 : I_WK2];
    for (int i = n; i < 4096; i += 128) tl[i] = bf2f(src[i]) + pe[i];
    __syncthreads();
    float a = 0.f;
    for (int k = 0; k < 4096; ++k) a += tl[k] * w1[(size_t)k * 128 + n];
    hid[n] = gelu_tanh(a);
    __syncthreads();
    float o = 0.f;
    for (int m = 0; m < 128; ++m) o += hid[m] * w2[m * 128 + n];
    if (which == 0) ((bf16*)(p.ws + WS_KCMP))[((size_t)bg * 256 + c) * 128 + n] = (bf16)f2bf(o);
    else ((bf16*)(p.ws + WS_VCMPT))[((size_t)bg * 128 + n) * 256 + c] = (bf16)f2bf(o);
}
__device__ __forceinline__ void ph_cmp_fin_simple(const Params& p, LAS float* tl, int id, int n, const float* LHall, const float* PEVall) {
    LAS float* hid = tl + 4096;
    const int which = id / (16 * 255), rem = id % (16 * 255), bg = rem / 255, c = rem % 255;
    const float* w2 = p.in[which ? I_WV2 : I_WK2];
    const float* LH = LHall + ((size_t)which * 4096 + bg * 256) * 256;
    float pev = 0.f;
#pragma unroll 8
    for (int q = 0; q < 64; ++q) pev += PEVall[(size_t)(which * 64 + q) * 128 + n];
    const float a = LH[(size_t)c * 256 + n] + LH[(size_t)(c + 1) * 256 + 128 + n] + pev;
    hid[n] = gelu_tanh(a);
    __syncthreads();
    float o = 0.f;
    for (int m = 0; m < 128; ++m) o += hid[m] * w2[m * 128 + n];
    if (which == 0) ((bf16*)(p.ws + WS_KCMP))[((size_t)bg * 256 + c) * 128 + n] = (bf16)f2bf(o);
    else ((bf16*)(p.ws + WS_VCMPT))[((size_t)bg * 128 + n) * 256 + c] = (bf16)f2bf(o);
}
__device__ __forceinline__ float dot128(const LAS float* q, const bf16* k) {
    float a = 0.f;
#pragma unroll
    for (int i = 0; i < 16; ++i) { const v4u w = ((const v4u*)k)[i];
        a += q[8 * i] * bflo(w.x) + q[8 * i + 1] * bfhi(w.x) + q[8 * i + 2] * bflo(w.y) + q[8 * i + 3] * bfhi(w.y) + q[8 * i + 4] * bflo(w.z) + q[8 * i + 5] * bfhi(w.z) + q[8 * i + 6] * bflo(w.w) + q[8 * i + 7] * bfhi(w.w); }
    return a;
}
__device__ __forceinline__ void ph_nsa_naive(const Params& p, LAS float* base, int vblk, int r, int lane) {
    LAS float (*qf)[128] = (LAS float (*)[128])base; LAS float (*lg)[1024] = (LAS float (*)[1024])(base + 512); LAS unsigned long long& selm = *(LAS unsigned long long*)(base + 512 + 4096);
    const int s = vblk & (SEQ - 1), bg = vblk >> 12, b = bg >> 1, g = bg & 1, h = g * 4 + r;
    const size_t row = (size_t)b * SEQ + s;
    const bf16* NQ = (const bf16*)(p.ws + WS_NQ); const bf16* SM = (const bf16*)(p.ws + WS_SM);
    const bf16* KCMP = (const bf16*)(p.ws + WS_KCMP) + (size_t)bg * 256 * 128; const bf16* VCMPT = (const bf16*)(p.ws + WS_VCMPT) + (size_t)bg * 128 * 256;
    const bf16* KS = (const bf16*)(p.ws + WS_KS) + (size_t)bg * SEQ * 128; const bf16* KW = (const bf16*)(p.ws + WS_KW) + (size_t)bg * SEQ * 128;
    const bf16* VST = (const bf16*)(p.ws + WS_VST) + (size_t)bg * 128 * SEQ; const bf16* VWT = (const bf16*)(p.ws + WS_VWT) + (size_t)bg * 128 * SEQ;
    const float* relb = p.in[I_RELB]; float* ON = (float*)(p.ws + WS_ON);
    qf[r][lane] = bf2f(NQ[row * 1024 + h * 128 + lane]); qf[r][lane + 64] = bf2f(NQ[row * 1024 + h * 128 + lane + 64]);
    __syncthreads();
    const LAS float* q = qf[r]; LAS float* L = lg[r];
    float ot0 = 0.f, ot1 = 0.f;
    const float gt0 = 1.f / (1.f + __expf(-bf2f(SM[row * 64 + 16 + h]))), gt1 = 1.f / (1.f + __expf(-bf2f(SM[row * 64 + 24 + h]))), gt2 = 1.f / (1.f + __expf(-bf2f(SM[row * 64 + 32 + h])));
#define BIAS(dist) relb[(int)kBucket[(dist) > 127 ? 127 : (dist)] * 8 + h]
    const int ncv = (s >= 31) ? ((s - 31) >> 4) + 1 : 0;
    if (ncv > 0) {
        float mx = -3e38f;
        for (int c = lane; c < ncv; c += 64) { const float l = dot128(q, KCMP + (size_t)c * 128) + BIAS(s - (16 * c + 31)); L[c] = l; mx = fmaxf(mx, l); }
        mx = wave_max(mx); float sum = 0.f;
        for (int c = lane; c < ncv; c += 64) { const float e = __expf(L[c] - mx); L[c] = e; sum += e; }
        sum = wave_sum(sum); const float inv = 1.f / sum;
        for (int c = lane; c < ncv; c += 64) L[c] *= inv;
        LDS_WAIT(); __builtin_amdgcn_wave_barrier();
        float o0 = 0.f, o1 = 0.f;
        for (int c = 0; c < ncv; ++c) { const float pr = L[c]; o0 += pr * bf2f(VCMPT[(size_t)lane * 256 + c]); o1 += pr * bf2f(VCMPT[(size_t)(lane + 64) * 256 + c]); }
        ot0 += gt0 * o0; ot1 += gt0 * o1;
    }
    __syncthreads();
    const int cur = s >> 6;
    if (r == 0) { const int n = lane; float sc;
        if (n == 0 || n == cur || n == cur - 1) sc = 1e4f;
        else if (n <= cur) { float im = 0.f; for (int rr = 0; rr < 4; ++rr) for (int c = 4 * n - 1; c <= 4 * n + 3; ++c) if (c >= 0 && c < ncv) im += lg[rr][c]; sc = im; }
        else sc = -1.f;
        int rank = 0;
        for (int m = 0; m < 64; ++m) { const float sm = __shfl(sc, m); rank += (sm > sc || (sm == sc && m < n)) ? 1 : 0; }
        const unsigned long long mk = __ballot(rank < 16);
        if (lane == 0) selm = mk; }
    __syncthreads();
    { unsigned long long mask = selm & (cur == 63 ? ~0ull : ((1ull << (cur + 1)) - 1ull));
      int cnt = 0; float mx = -3e38f;
      for (unsigned long long mm = mask; mm; mm &= mm - 1) { const int n = __builtin_ctzll(mm); const int kpos = n * 64 + lane; float l = -3e38f;
          if (kpos <= s) l = dot128(q, KS + (size_t)kpos * 128) + BIAS(s - kpos);
          L[cnt * 64 + lane] = l; mx = fmaxf(mx, l); ++cnt; }
      mx = wave_max(mx); float sum = 0.f;
      for (int j = 0; j < cnt; ++j) { const float l = L[j * 64 + lane]; const float e = l > -1e38f ? __expf(l - mx) : 0.f; L[j * 64 + lane] = e; sum += e; }
      sum = wave_sum(sum); const float inv = 1.f / sum;
      LDS_WAIT(); __builtin_amdgcn_wave_barrier();
      float o0 = 0.f, o1 = 0.f; int j = 0;
      for (unsigned long long mm = mask; mm; mm &= mm - 1, ++j) { const int n = __builtin_ctzll(mm);
          for (int kk = 0; kk < 64; ++kk) { const float pr = L[j * 64 + kk]; o0 += pr * bf2f(VST[(size_t)lane * SEQ + n * 64 + kk]); o1 += pr * bf2f(VST[(size_t)(lane + 64) * SEQ + n * 64 + kk]); } }
      ot0 += gt1 * o0 * inv; ot1 += gt1 * o1 * inv; }
    LDS_WAIT(); __builtin_amdgcn_wave_barrier();
    { const int lo = s >= 511 ? s - 511 : 0, nk = s - lo + 1; float mx = -3e38f;
      for (int i = lane; i < nk; i += 64) { const int kpos = lo + i; const float l = dot128(q, KW + (size_t)kpos * 128) + BIAS(s - kpos); L[i] = l; mx = fmaxf(mx, l); }
      mx = wave_max(mx); float sum = 0.f;
      for (int i = lane; i < nk; i += 64) { const float e = __expf(L[i] - mx); L[i] = e; sum += e; }
      sum = wave_sum(sum); const float inv = 1.f / sum;
      LDS_WAIT(); __builtin_amdgcn_wave_barrier();
      float o0 = 0.f, o1 = 0.f;
      for (int i = 0; i < nk; ++i) { const float pr = L[i]; o0 += pr * bf2f(VWT[(size_t)lane * SEQ + lo + i]); o1 += pr * bf2f(VWT[(size_t)(lane + 64) * SEQ + lo + i]); }
      ot0 += gt2 * o0 * inv; ot1 += gt2 * o1 * inv; }
#undef BIAS
    ON[row * 1024 + h * 128 + lane] = ot0; ON[row * 1024 + h * 128 + lane + 64] = ot1;
}

namespace nsa {
constexpr int KB0 = 0, KB1 = 16384, VB0 = 32768, VB1 = 49152, LUT = 65536;
constexpr int QST = LUT + 4096, IMP = QST + 65536, SELM = IMP + 16384, LDS_END = SELM + 512;
constexpr float LOG2E = 1.4426950408889634f;
typedef float f4 __attribute__((ext_vector_type(4)));

typedef unsigned u2v __attribute__((ext_vector_type(2)));
__device__ __forceinline__ float rmax16(float x) { const unsigned u = __float_as_uint(x); const u2v r = __builtin_amdgcn_permlane16_swap(u, u, false, false); return fmaxf(__uint_as_float(r[0]), __uint_as_float(r[1])); }
__device__ __forceinline__ float rmax32(float x) { const unsigned u = __float_as_uint(x); const u2v r = __builtin_amdgcn_permlane32_swap(u, u, false, false); return fmaxf(__uint_as_float(r[0]), __uint_as_float(r[1])); }
__device__ __forceinline__ float radd16(float x) { const unsigned u = __float_as_uint(x); const u2v r = __builtin_amdgcn_permlane16_swap(u, u, false, false); return __uint_as_float(r[0]) + __uint_as_float(r[1]); }
__device__ __forceinline__ float radd32(float x) { const unsigned u = __float_as_uint(x); const u2v r = __builtin_amdgcn_permlane32_swap(u, u, false, false); return __uint_as_float(r[0]) + __uint_as_float(r[1]); }
__device__ __forceinline__ float raddq(float x) { x += __int_as_float(__builtin_amdgcn_update_dpp(0, __float_as_int(x), 0xB1, 0xF, 0xF, true)); x += __int_as_float(__builtin_amdgcn_update_dpp(0, __float_as_int(x), 0x4E, 0xF, 0xF, true)); return x; }
struct Ctx {
    LAS unsigned char* lds; int tid, lane, wave, c, gq, r;
    int s0, cur;
    const LAS unsigned char* qst;
    int pos0;
    const LAS float* lutrow;
    int koff0, voff0;
    unsigned kdo[2], vdoc[2], vdos[2];
};
__device__ __forceinline__ void dma_k(const Ctx& C, const bf16* kt, LAS unsigned char* kb) {
#pragma unroll
    for (int i = 0; i < 2; ++i) __builtin_amdgcn_global_load_lds((const unsigned*)((const char*)kt + C.kdo[i]), (LAS unsigned*)(kb + (2 * C.wave + i) * 1024), 16, 0, 0); }
__device__ __forceinline__ void dma_v(const Ctx& C, const bf16* vt, const unsigned (&vdo)[2], LAS unsigned char* vb) {
#pragma unroll
    for (int i = 0; i < 2; ++i) __builtin_amdgcn_global_load_lds((const unsigned*)((const char*)vt + vdo[i]), (LAS unsigned*)(vb + (2 * C.wave + i) * 1024), 16, 0, 0); }

__device__ __forceinline__ void compute_st(const Ctx& C, const LAS unsigned char* kb, f4 (&s)[2][4]) {
#pragma unroll
    for (int ks = 0; ks < 4; ++ks) { const bf16x8 q0 = *(const LAS bf16x8*)(C.qst + ks * 1024), q1 = *(const LAS bf16x8*)(C.qst + (4 + ks) * 1024);
#pragma unroll
        for (int kt = 0; kt < 4; ++kt) { const bf16x8 a = *(const LAS bf16x8*)(kb + kt * 4096 + (C.koff0 ^ (ks * 64)));
            s[0][kt] = __builtin_amdgcn_mfma_f32_16x16x32_bf16(a, q0, ks == 0 ? (f4){0.f, 0.f, 0.f, 0.f} : s[0][kt], 0, 0, 0);
            s[1][kt] = __builtin_amdgcn_mfma_f32_16x16x32_bf16(a, q1, ks == 0 ? (f4){0.f, 0.f, 0.f, 0.f} : s[1][kt], 0, 0, 0); }
        asm volatile("" ::: "memory"); }
}
__device__ __forceinline__ void compute_pv(const Ctx& C, const LAS unsigned char* vb, const f4 (&p)[2][4], f4 (&o)[2][8]) {
#pragma unroll
    for (int i = 0; i < 2; ++i) { bf16x8 pb[2];
#pragma unroll
        for (int qt = 0; qt < 2; ++qt) { v4u w; w.x = pg8::cvt_pk_bf16(p[qt][2 * i][0], p[qt][2 * i][1]); w.y = pg8::cvt_pk_bf16(p[qt][2 * i][2], p[qt][2 * i][3]);
            w.z = pg8::cvt_pk_bf16(p[qt][2 * i + 1][0], p[qt][2 * i + 1][1]); w.w = pg8::cvt_pk_bf16(p[qt][2 * i + 1][2], p[qt][2 * i + 1][3]); pb[qt] = __builtin_bit_cast(bf16x8, w); }
#pragma unroll
        for (int dt = 0; dt < 8; ++dt) { const v2u lo = *(const LAS v2u*)(vb + dt * 2048 + (C.voff0 ^ (i * 64))), hi = *(const LAS v2u*)(vb + dt * 2048 + (C.voff0 ^ (i * 64 + 32))); const bf16x8 a = __builtin_bit_cast(bf16x8, (v4u){lo.x, lo.y, hi.x, hi.y});
#pragma unroll
            for (int qt = 0; qt < 2; ++qt) o[qt][dt] = __builtin_amdgcn_mfma_f32_16x16x32_bf16(a, pb[qt], o[qt][dt], 0, 0, 0);
            if (dt & 1) asm volatile("" ::: "memory"); } }
}
enum { M_CMP = 0, M_SEL = 1, M_WIN = 2 };
template <int MODE, bool FAR = false>
__device__ __forceinline__ void mask_bias(const Ctx& C, f4 (&s)[2][4], int kb, int n, const LAS unsigned* selw) {
    const float NEG = -__builtin_inff();
#pragma unroll
    for (int qt = 0; qt < 2; ++qt) {
        bool tokok = true;
        if (MODE == M_SEL) tokok = ((selw[(4 * qt + (C.c >> 2)) * 2 + (n >> 5)] >> (n & 31)) & 1u) != 0u;
        if (FAR) { const float be = tokok ? C.lutrow[127] : NEG;
#pragma unroll
            for (int kt = 0; kt < 4; ++kt)
#pragma unroll
                for (int rg = 0; rg < 4; ++rg) s[qt][kt][rg] = __builtin_fmaf(s[qt][kt][rg], LOG2E, be);
            continue; }
        const int dbase = (MODE == M_CMP) ? (C.pos0 + 4 * qt - 31 - 16 * (kb + 4 * C.gq)) : (C.pos0 + 4 * qt - (kb + 4 * C.gq));
#pragma unroll
        for (int kt = 0; kt < 4; ++kt) {
#pragma unroll
            for (int rg = 0; rg < 4; ++rg) { const int d = (MODE == M_CMP) ? dbase - 16 * (16 * kt + rg) : dbase - (16 * kt + rg);
                int di = d < 0 ? 0 : d; di = di > 127 ? 127 : di; const float bias = C.lutrow[di];
                bool ok = tokok && d >= 0; if (MODE == M_WIN) ok = ok && d < 512;
                s[qt][kt][rg] = ok ? __builtin_fmaf(s[qt][kt][rg], LOG2E, bias) : NEG; }
            asm volatile("" ::: "memory"); }
    }
}
__device__ __forceinline__ void softmax_step(f4 (&s)[2][4], float (&m)[2], float (&l)[2], f4 (&o)[2][8], bool rescale_o) {
#pragma unroll
    for (int qt = 0; qt < 2; ++qt) { float mx = s[qt][0][0];
#pragma unroll
        for (int kt = 0; kt < 4; ++kt)
#pragma unroll
            for (int rg = 0; rg < 4; ++rg) mx = fmaxf(mx, s[qt][kt][rg]);
        mx = rmax32(rmax16(mx));
        const float mn = fmaxf(m[qt], mx), alpha = __builtin_amdgcn_exp2f(m[qt] - mn); m[qt] = mn; float ps = 0.f;
#pragma unroll
        for (int kt = 0; kt < 4; ++kt)
#pragma unroll
            for (int rg = 0; rg < 4; ++rg) { const float e = __builtin_amdgcn_exp2f(s[qt][kt][rg] - mn); s[qt][kt][rg] = e; ps += e; }
        l[qt] = l[qt] * alpha + ps;
        if (rescale_o && __any(alpha != 1.f)) {
#pragma unroll
            for (int dt = 0; dt < 8; ++dt) o[qt][dt] = o[qt][dt] * alpha; }
    }
}
}

__device__ __forceinline__ void ph_nsa(const Params& p, LAS unsigned char* lds, int idx0, int idxstride, int tid_in, int wave) {
    using namespace nsa;
    int tid = tid_in; asm volatile("" : "+v"(tid));
    const int lane = tid & 63;
    Ctx C; C.lds = lds; C.tid = tid; C.lane = lane; C.wave = wave; C.c = lane & 15; C.gq = lane >> 4; C.r = lane & 3;
    C.koff0 = C.c * 256 + ((C.gq ^ C.c) * 16);
#pragma unroll
    for (int i = 0; i < 2; ++i) { const int piece = 2 * wave + i;
        { const int row = piece * 4 + (lane >> 4), chunk = (lane & 15) ^ (row & 15); C.kdo[i] = (unsigned)(row * 256 + chunk * 16); }
        { const int row = piece * 8 + (lane >> 3), chunk = (lane & 7) ^ ((row >> 1) & 7); C.vdoc[i] = (unsigned)(row * 256 * 2 + chunk * 16); C.vdos[i] = (unsigned)(row * SEQ * 2 + chunk * 16); } }
    C.voff0 = C.c * 128 + (((C.gq >> 1) ^ ((C.c >> 1) & 7)) * 16) + (C.gq & 1) * 8;
    const bf16* NQ = (const bf16*)(p.ws + WS_NQ); const bf16* SM = (const bf16*)(p.ws + WS_SM); bf16* A2 = (bf16*)(p.ws + WS_A2);
    const float* relb = p.in[I_RELB]; const float* nsag = p.in[I_NSAG];
    LAS float* lut = (LAS float*)(lds + LUT);
    for (int i = tid; i < 8 * 128; i += 512) { const int hh = i >> 7, d = i & 127; lut[i] = relb[(int)kBucket[d] * 8 + hh] * LOG2E; }
    __syncthreads();
    LAS unsigned char* qstw = lds + QST + wave * 8192 + lane * 16; C.qst = qstw;
    LAS float* imp = (LAS float*)(lds + IMP + wave * 2048);
    LAS unsigned long long* selm = (LAS unsigned long long*)(lds + SELM + wave * 64);
#define NSA_SYNC() do { asm volatile("s_waitcnt vmcnt(0)" ::: "memory"); __syncthreads(); } while (0)
    for (int idx = idx0; idx < 512; idx += idxstride) {
        const int rnd = idx >> 8, kq = idx & 255, b = kq & 7, tq = rnd == 0 ? 63 - (kq >> 3) : (kq >> 3);
        C.s0 = tq * 64; C.cur = tq;
        const int tokl0 = 8 * wave + (C.c >> 2);
        C.pos0 = C.s0 + tokl0;
        float ssq[2] = {0.f, 0.f};
        for (int g = 0; g < 2; ++g) {
            const int bg = b * 2 + g, h = g * 4 + C.r;
            C.lutrow = lut + h * 128;
            const bf16* KCMP = (const bf16*)(p.ws + WS_KCMP) + (size_t)bg * 256 * 128; const bf16* VCMPT = (const bf16*)(p.ws + WS_VCMPT) + (size_t)bg * 128 * 256;
#pragma unroll
            for (int qt = 0; qt < 2; ++qt) { const unsigned qo = (unsigned)(((b * SEQ + (C.pos0 + 4 * qt)) * 1024 + h * 128 + 8 * C.gq) * 2);
#pragma unroll
                for (int ks = 0; ks < 4; ++ks) *(LAS bf16x8*)(qstw + (qt * 4 + ks) * 1024) = *(const bf16x8*)((const char*)NQ + qo + ks * 64); }
#pragma unroll
            for (int i = 0; i < 2; ++i) *(LAS f32x4*)((LAS unsigned char*)imp + lane * 16 + i * 1024) = (f32x4){0.f, 0.f, 0.f, 0.f};
#define NSA_OROW(qt) ((char*)A2 + (unsigned)(((b * SEQ + C.pos0 + 4 * (qt)) * DM + 1024 + h * 128 + 4 * C.gq) * 2))
            const int cmaxb = C.s0 + 63 - 31; const int nct = cmaxb >= 0 ? ((cmaxb >> 4) >> 6) + 1 : 0;
            float m[2] = {-1e30f, -1e30f}, l[2] = {0.f, 0.f};
            f4 o[2][8];
            if (nct > 0) {
                dma_k(C, KCMP, lds + KB0); NSA_SYNC();
                for (int ct = 0; ct < nct; ++ct) { const int buf = ct & 1;
                    if (ct + 1 < nct) dma_k(C, KCMP + (ct + 1) * 64 * 128, lds + (buf ? KB0 : KB1));
                    f4 s[2][4]; compute_st(C, lds + (buf ? KB1 : KB0), s); mask_bias<M_CMP>(C, s, 64 * ct, 0, (const LAS unsigned*)selm); softmax_step(s, m, l, o, false);
                    NSA_SYNC(); }
            }
            float inv[2];
#pragma unroll
            for (int qt = 0; qt < 2; ++qt) { const float lt = radd32(radd16(l[qt])); inv[qt] = lt > 0.f ? 1.f / lt : 0.f; }
#pragma unroll
            for (int qt = 0; qt < 2; ++qt)
#pragma unroll
                for (int dt = 0; dt < 8; ++dt) o[qt][dt] = (f4){0.f, 0.f, 0.f, 0.f};
            if (nct > 0) {
                dma_k(C, KCMP, lds + KB0); dma_v(C, VCMPT, C.vdoc, lds + VB0); NSA_SYNC();
                for (int ct = 0; ct < nct; ++ct) { const int buf = ct & 1;
                    if (ct + 1 < nct) { dma_k(C, KCMP + (ct + 1) * 64 * 128, lds + (buf ? KB0 : KB1)); dma_v(C, VCMPT + 64 * (ct + 1), C.vdoc, lds + (buf ? VB0 : VB1)); }
                    f4 s[2][4]; compute_st(C, lds + (buf ? KB1 : KB0), s); mask_bias<M_CMP>(C, s, 64 * ct, 0, (const LAS unsigned*)selm);
#pragma unroll
                    for (int qt = 0; qt < 2; ++qt)
#pragma unroll
                        for (int kt = 0; kt < 4; ++kt) {
#pragma unroll
                            for (int rg = 0; rg < 4; ++rg) s[qt][kt][rg] = __builtin_amdgcn_exp2f(s[qt][kt][rg] - m[qt]) * inv[qt];
                            float po = (s[qt][kt][0] + s[qt][kt][1]) + (s[qt][kt][2] + s[qt][kt][3]), p3 = s[qt][kt][3];
                            po = raddq(po); p3 = raddq(p3);
                            const int nb = 16 * ct + 4 * kt + C.gq, tl = 4 * qt + (C.c >> 2);
                            if (C.r == 0) { __hip_atomic_fetch_add((float*)(imp + tl * 64 + nb), po, __ATOMIC_RELAXED, __HIP_MEMORY_SCOPE_WORKGROUP); if (nb + 1 < 64) __hip_atomic_fetch_add((float*)(imp + tl * 64 + nb + 1), p3, __ATOMIC_RELAXED, __HIP_MEMORY_SCOPE_WORKGROUP); } }
                    compute_pv(C, lds + (buf ? VB1 : VB0), s, o);
                    NSA_SYNC(); }
            }
            LDS_WAIT(); __builtin_amdgcn_wave_barrier();
            for (int tk = 0; tk < 8; ++tk) { const int n = lane; float sc;
                if (n == 0 || n == C.cur || n == C.cur - 1) sc = 1e4f; else if (n <= C.cur) sc = imp[tk * 64 + n]; else sc = -1.f;
                const int key = ((sc < 0.f ? 0 : __float_as_int(sc) + 64) & ~63) | (63 - n);
                int rank = 0;
#pragma unroll
                for (int mm = 0; mm < 64; ++mm) rank += (__builtin_amdgcn_readlane(key, mm) > key) ? 1 : 0;
                const unsigned long long mk = __ballot(rank < 16);
                if (lane == 0) selm[tk] = mk; }
            LDS_WAIT(); __builtin_amdgcn_wave_barrier();
#pragma unroll
            for (int qt = 0; qt < 2; ++qt) { const float gt = 1.f / (1.f + __expf(-bf2f(*(const bf16*)((const char*)SM + (unsigned)(((b * SEQ + (C.pos0 + 4 * qt)) * 64 + 16 + h) * 2)))));
#pragma unroll
                for (int dt = 0; dt < 8; ++dt) { const f4 v = o[qt][dt] * gt; *(v2u*)(NSA_OROW(qt) + 32 * dt) = (v2u){pg8::cvt_pk_bf16(v[0], v[1]), pg8::cvt_pk_bf16(v[2], v[3])}; } }
#pragma unroll
            for (int br = 1; br <= 2; ++br) {
                const bf16* KX = (const bf16*)(p.ws + (br == 1 ? WS_KS : WS_KW)) + bg * SEQ * 128; const bf16* VX = (const bf16*)(p.ws + (br == 1 ? WS_VST : WS_VWT)) + bg * 128 * SEQ;
                const int n0 = br == 1 ? 0 : (C.cur >= 8 ? C.cur - 8 : 0), n1 = C.cur;
                m[0] = m[1] = -1e30f; l[0] = l[1] = 0.f;
#pragma unroll
                for (int qt = 0; qt < 2; ++qt)
#pragma unroll
                    for (int dt = 0; dt < 8; ++dt) o[qt][dt] = (f4){0.f, 0.f, 0.f, 0.f};
                int f0 = n1 + 1, f1 = n0 - 1;
                for (int n = n0; n <= n1; ++n) { const bool fa = (C.s0 - (64 * n + 63) >= 113) && (br == 1 || (C.s0 + 63 - 64 * n) < 512); if (fa) { f0 = n < f0 ? n : f0; f1 = n; } }
                const int cntf = f1 >= f0 ? f1 - f0 + 1 : 0, cnt = n1 - n0 + 1, nlo = cntf ? f0 - n0 : cnt;
#define NSA_TILE(i) ((i) < cntf ? f0 + (i) : (((i) - cntf) < nlo ? n0 + ((i) - cntf) : f1 + 1 + ((i) - cntf - nlo)))
#define NSA_BODY(FARF) { const int n = NSA_TILE(i); const int buf = i & 1; \
                    if (i + 1 < cnt) { const int nn = NSA_TILE(i + 1); dma_k(C, KX + nn * 64 * 128, lds + (buf ? KB0 : KB1)); dma_v(C, VX + 64 * nn, C.vdos, lds + (buf ? VB0 : VB1)); } \
                    bool need = true; \
                    if (br == 1) { const unsigned any = ((const LAS unsigned*)selm)[(lane & 7) * 2 + (n >> 5)] >> (n & 31); need = __any((int)(any & 1u)); } \
                    if (need) { f4 s[2][4]; compute_st(C, lds + (buf ? KB1 : KB0), s); \
                        if (br == 1) mask_bias<M_SEL, FARF>(C, s, 64 * n, n, (const LAS unsigned*)selm); else mask_bias<M_WIN, FARF>(C, s, 64 * n, n, (const LAS unsigned*)selm); \
                        softmax_step(s, m, l, o, true); compute_pv(C, lds + (buf ? VB1 : VB0), s, o); } \
                    NSA_SYNC(); }
                { const int nf = NSA_TILE(0); dma_k(C, KX + nf * 64 * 128, lds + KB0); dma_v(C, VX + 64 * nf, C.vdos, lds + VB0); NSA_SYNC(); }
                int i = 0;
                for (; i < cntf; ++i) NSA_BODY(true)
                for (; i < cnt; ++i) NSA_BODY(false)
#undef NSA_BODY
#undef NSA_TILE
                asm volatile("s_waitcnt vmcnt(0)" ::: "memory");
#pragma unroll
                for (int qt = 0; qt < 2; ++qt) { const float lt = radd32(radd16(l[qt]));
                    const int row = b * SEQ + (C.pos0 + 4 * qt);
                    const float sc = (1.f / (1.f + __expf(-bf2f(*(const bf16*)((const char*)SM + (unsigned)((row * 64 + 16 + 8 * br + h) * 2)))))) / lt;
#pragma unroll
                    for (int dt = 0; dt < 8; ++dt) { const f4 v = o[qt][dt] * sc; v2u* sp = (v2u*)(NSA_OROW(qt) + 32 * dt); const v2u pv = *sp;
                        const float a0 = bflo(pv.x) + v[0], a1 = bfhi(pv.x) + v[1], a2 = bflo(pv.y) + v[2], a3 = bfhi(pv.y) + v[3];
                        if (br == 2) ssq[qt] += (a0 * a0 + a1 * a1) + (a2 * a2 + a3 * a3);
                        *sp = (v2u){pg8::cvt_pk_bf16(a0, a1), pg8::cvt_pk_bf16(a2, a3)}; } }
            }
        }
        float rstd[2];
#pragma unroll
        for (int qt = 0; qt < 2; ++qt) { const float t = radd32(radd16(raddq(ssq[qt]))); rstd[qt] = 1.f / sqrtf(t * (1.f / 1024.f) + RMS_EPS); }
        asm volatile("s_waitcnt vmcnt(0)" ::: "memory");
#pragma unroll
        for (int qt = 0; qt < 2; ++qt) { const int sub = C.r * 4 + C.gq; bf16* orow = (bf16*)((char*)A2 + (unsigned)(((b * SEQ + (C.pos0 + 4 * qt)) * DM + 1024) * 2 + sub * 16)); const int subz = 0;
#pragma unroll
            for (int j = 0; j < 8; ++j) { const int col = (j * 16 + subz) * 8; v4u w = *(const v4u*)((const char*)orow + (unsigned)(col * 2)); const f32x4 g0 = *(const f32x4*)((const char*)nsag + (unsigned)(col * 4 + sub * 32)), g1 = *(const f32x4*)((const char*)nsag + (unsigned)(col * 4 + sub * 32 + 16)); const float rs = rstd[qt];
                w.x = pk2(bflo(w.x) * rs * g0.x, bfhi(w.x) * rs * g0.y); w.y = pk2(bflo(w.y) * rs * g0.z, bfhi(w.y) * rs * g0.w); w.z = pk2(bflo(w.z) * rs * g1.x, bfhi(w.z) * rs * g1.y); w.w = pk2(bflo(w.w) * rs * g1.z, bfhi(w.w) * rs * g1.w);
                *(v4u*)((char*)orow + (unsigned)(col * 2)) = w; } }
        NSA_SYNC();
    }
#undef NSA_SYNC
#undef NSA_OROW
}

constexpr size_t WS_ST = WS_LA;
constexpr size_t WS_DEC = WS_ST + (size_t)2048 * 256 * 128 * 2;
static_assert(WS_DEC + (size_t)2048 * 128 * 4 <= WS_KCMP, "gla scratch overlay");
namespace gla {
typedef float f4 __attribute__((ext_vector_type(4)));
constexpr int L_ST = 0, L_KT = 65536, L_QT = 81920, L_VT = 98304, L_GA = 131072, L_GT = L_GA + 4096, L_RED = L_GT + 2048, L_END = L_RED + 512;
__device__ __forceinline__ void chunk_cumsum(const Params& p, LAS unsigned char* lds, int tid, int t0, int h, float (&P)[16], float& blast) {
    const bf16* SM = (const bf16*)(p.ws + WS_SM); const float* wa2 = p.in[I_WA2]; const float* ba = p.in[I_BA];
    LAS float* ga = (LAS float*)(lds + L_GA); LAS float* gt = (LAS float*)(lds + L_GT);
    if (tid < 128) { const int j = tid >> 1, hf = tid & 1; const v4u w = *(const v4u*)((const char*)SM + (unsigned)(((t0 + j) * 64 + hf * 8) * 2));
        LAS float* d = ga + j * 16 + hf * 8; d[0] = bflo(w.x); d[1] = bfhi(w.x); d[2] = bflo(w.y); d[3] = bfhi(w.y); d[4] = bflo(w.z); d[5] = bfhi(w.z); d[6] = bflo(w.w); d[7] = bfhi(w.w); }
    const int dk = tid & 127, jq = tid >> 7;
    float w[16];
#pragma unroll
    for (int r = 0; r < 16; ++r) w[r] = wa2[r * 512 + h * 128 + dk];
    const float bb = ba[h * 128 + dk];
    __syncthreads();
    float run = 0.f;
#pragma unroll
    for (int jj = 0; jj < 16; ++jj) { const LAS f32x4* gr = (const LAS f32x4*)(ga + (16 * jq + jj) * 16); float z = bb;
#pragma unroll
        for (int r4 = 0; r4 < 4; ++r4) { const f32x4 g4 = gr[r4]; z += g4.x * w[4 * r4] + g4.y * w[4 * r4 + 1] + g4.z * w[4 * r4 + 2] + g4.w * w[4 * r4 + 3]; }
        run += (fminf(z, 0.f) - log1pf(__expf(-fabsf(z)))) * (1.f / 16.f); P[jj] = run; }
    gt[jq * 128 + dk] = run;
    __syncthreads();
    float off = 0.f, tot = 0.f;
#pragma unroll
    for (int q = 0; q < 4; ++q) { const float t = gt[q * 128 + dk]; tot += t; if (q < jq) off += t; }
#pragma unroll
    for (int jj = 0; jj < 16; ++jj) P[jj] += off;
    blast = tot;
}
__device__ __forceinline__ void stage_raw_k(const bf16* src  , LAS unsigned char* dst, int tid, int t0, int h) {
#pragma unroll
    for (int q = 0; q < 2; ++q) { const int id = tid + 512 * q, j = id >> 4, c16 = id & 15; *(LAS v4u*)(dst + j * 256 + c16 * 16) = *(const v4u*)((const char*)src + (unsigned)(((t0 + j) * 512 + h * 128 + c16 * 8) * 2)); }
}
__device__ __forceinline__ void stage_raw_v(const Params& p, LAS unsigned char* dst, int tid, int t0, int h) {
    const bf16* GV = (const bf16*)(p.ws + WS_GV);
#pragma unroll
    for (int q = 0; q < 4; ++q) { const int id = tid + 512 * q, j = id >> 5, c = id & 31; *(LAS v4u*)(dst + j * 512 + c * 16) = *(const v4u*)((const char*)GV + (unsigned)(((t0 + j) * 1024 + h * 256 + c * 8) * 2)); }
}
__device__ __forceinline__ void fill_vt(LAS unsigned char* lds, const LAS unsigned char* rv, int tid) {
    const int dv = tid & 255, jh = tid >> 8;
    unsigned short v[32];
#pragma unroll
    for (int jj = 0; jj < 32; ++jj) v[jj] = *(const LAS bf16*)(rv + (32 * jh + jj) * 512 + dv * 2);
    LAS unsigned char* row = lds + L_VT + dv * 128; const int f = (dv >> 1) & 7;
#pragma unroll
    for (int q = 0; q < 4; ++q) { v4u w; w.x = v[8 * q] | ((unsigned)v[8 * q + 1] << 16); w.y = v[8 * q + 2] | ((unsigned)v[8 * q + 3] << 16); w.z = v[8 * q + 4] | ((unsigned)v[8 * q + 5] << 16); w.w = v[8 * q + 6] | ((unsigned)v[8 * q + 7] << 16);
        *(LAS v4u*)(row + (((4 * jh + q) ^ f) * 16)) = w; }
}
}

__device__ __forceinline__ void ph_gla_a(const Params& p, LAS unsigned char* lds, int u0, int ustride, int tid_in, int wave) {
    using namespace gla;
    int tid = tid_in; asm volatile("" : "+v"(tid));
    const int lane = tid & 63, c = lane & 15, gq = lane >> 4;
    const bf16* GK = (const bf16*)(p.ws + WS_GK); bf16* ST = (bf16*)(p.ws + WS_ST); float* DEC = (float*)(p.ws + WS_DEC);
    for (int unit = u0; unit < 2048; unit += ustride) {
        const int bh = unit >> 6, ch = unit & 63, b = bh >> 2, h = bh & 3, t0 = b * SEQ + ch * 64;
        stage_raw_k(GK, lds + 0, tid, t0, h); stage_raw_v(p, lds + 16384, tid, t0, h);
        float P[16], blast; chunk_cumsum(p, lds, tid, t0, h, P, blast);
        { const int dk = tid & 127, jq = tid >> 7;
          unsigned short kv[16];
#pragma unroll
          for (int jj = 0; jj < 16; ++jj) kv[jj] = *(const LAS bf16*)(lds + (16 * jq + jj) * 256 + dk * 2);
          unsigned pk[8];
#pragma unroll
          for (int q = 0; q < 8; ++q) pk[q] = pk2(bf2f(kv[2 * q]) * __expf(blast - P[2 * q]), bf2f(kv[2 * q + 1]) * __expf(blast - P[2 * q + 1]));
          LAS unsigned char* row = lds + L_KT + dk * 128; const int f = (dk >> 1) & 7;
          *(LAS v4u*)(row + (((2 * jq) ^ f) * 16)) = (v4u){pk[0], pk[1], pk[2], pk[3]}; *(LAS v4u*)(row + (((2 * jq + 1) ^ f) * 16)) = (v4u){pk[4], pk[5], pk[6], pk[7]};
          if (jq == 0) DEC[unit * 128 + dk] = __expf(blast); }
        fill_vt(lds, lds + 16384, tid);
        __syncthreads();
        f4 acc[16];
        const int f = (c >> 1) & 7;
        bf16x8 aF[2];
#pragma unroll
        for (int ks = 0; ks < 2; ++ks) aF[ks] = *(const LAS bf16x8*)(lds + L_KT + (16 * wave + c) * 128 + (((4 * ks + gq) ^ f) * 16));
#pragma unroll
        for (int nt = 0; nt < 16; ++nt) { acc[nt] = (f4){0.f, 0.f, 0.f, 0.f};
#pragma unroll
            for (int ks = 0; ks < 2; ++ks) { const bf16x8 bF = *(const LAS bf16x8*)(lds + L_VT + (16 * nt + c) * 128 + (((4 * ks + gq) ^ f) * 16)); acc[nt] = __builtin_amdgcn_mfma_f32_16x16x32_bf16(aF[ks], bF, acc[nt], 0, 0, 0); } }
        char* dst = (char*)ST + (size_t)unit * (256 * 128 * 2) + (unsigned)((c * 128 + 16 * wave + 4 * gq) * 2);
#pragma unroll
        for (int nt = 0; nt < 16; ++nt) *(v2u*)(dst + nt * 16 * 256) = (v2u){pg8::cvt_pk_bf16(acc[nt][0], acc[nt][1]), pg8::cvt_pk_bf16(acc[nt][2], acc[nt][3])};
        __syncthreads();
    }
}
__device__ __forceinline__ void ph_gla_b(const Params& p, int gid, int gstride) {
    bf16* ST = (bf16*)(p.ws + WS_ST); const float* DEC = (const float*)(p.ws + WS_DEC);
    for (int e = gid; e < 32 * 4096; e += gstride) { const int bh = e >> 12, dv = (e >> 4) & 255, d8 = e & 15;
        float st[8];
#pragma unroll
        for (int i = 0; i < 8; ++i) st[i] = 0.f;
        char* base = (char*)ST + (size_t)bh * 64 * (256 * 128 * 2) + (unsigned)((dv * 128 + d8 * 8) * 2); const float* dbase = DEC + (size_t)bh * 64 * 128 + d8 * 8;
#pragma unroll 4
        for (int ch = 0; ch < 64; ++ch) { v4u* ptr = (v4u*)(base + (size_t)ch * (256 * 128 * 2)); const v4u w = *ptr; const f32x4 d0 = *(const f32x4*)(dbase + ch * 128), d1 = *(const f32x4*)(dbase + ch * 128 + 4);
            v4u o; o.x = pk2(st[0], st[1]); o.y = pk2(st[2], st[3]); o.z = pk2(st[4], st[5]); o.w = pk2(st[6], st[7]); *ptr = o;
            st[0] = st[0] * d0.x + bflo(w.x); st[1] = st[1] * d0.y + bfhi(w.x); st[2] = st[2] * d0.z + bflo(w.y); st[3] = st[3] * d0.w + bfhi(w.y);
            st[4] = st[4] * d1.x + bflo(w.z); st[5] = st[5] * d1.y + bfhi(w.z); st[6] = st[6] * d1.z + bflo(w.w); st[7] = st[7] * d1.w + bfhi(w.w); }
    }
}
__device__ __forceinline__ void ph_gla_c(const Params& p, LAS unsigned char* lds, int u0, int ustride, int tid_in, int wave) {
    using namespace gla;
    int tid = tid_in; asm volatile("" : "+v"(tid));
    const int lane = tid & 63, c = lane & 15, gq = lane >> 4, nt = wave & 3, half = wave >> 2;
    const bf16* GQ = (const bf16*)(p.ws + WS_GQ); const bf16* GK = (const bf16*)(p.ws + WS_GK); const bf16* GG = (const bf16*)(p.ws + WS_GG); const bf16* ST = (const bf16*)(p.ws + WS_ST);
    bf16* A2 = (bf16*)(p.ws + WS_A2); const float* gn = p.in[I_GLAG];
    const int koff0 = c * 256 + ((gq ^ c) * 16), voff0 = c * 128 + (((gq >> 1) ^ ((c >> 1) & 7)) * 16) + (gq & 1) * 8;
    for (int unit = u0; unit < 2048; unit += ustride) {
        const int bh = unit >> 6, ch = unit & 63, b = bh >> 2, h = bh & 3, t0 = b * SEQ + ch * 64;
        stage_raw_k(GQ, lds + 0, tid, t0, h); stage_raw_k(GK, lds + 16384, tid, t0, h); stage_raw_v(p, lds + 32768, tid, t0, h);
        float P[16], blast; chunk_cumsum(p, lds, tid, t0, h, P, blast);
        { const int dk = tid & 127, jq = tid >> 7;
#pragma unroll
          for (int jj = 0; jj < 16; ++jj) { const int j = 16 * jq + jj; const float qv = bf2f(*(const LAS bf16*)(lds + j * 256 + dk * 2)), kv = bf2f(*(const LAS bf16*)(lds + 16384 + j * 256 + dk * 2));
              const int off = j * 256 + (((dk >> 3) ^ (j & 15)) * 16) + (dk & 7) * 2;
              *(LAS bf16*)(lds + L_QT + off) = (bf16)f2bf(qv * __expf(P[jj])); *(LAS bf16*)(lds + L_KT + off) = (bf16)f2bf(kv * __expf(-P[jj])); } }
        fill_vt(lds, lds + 32768, tid);
        __syncthreads();
        { const char* src = (const char*)ST + (size_t)unit * (256 * 128 * 2);
#pragma unroll
          for (int i = 0; i < 8; ++i) { const int piece = 8 * wave + i, row = piece * 4 + (lane >> 4), chunk = (lane & 15) ^ (row & 15);
              __builtin_amdgcn_global_load_lds((const unsigned*)(src + (unsigned)(row * 256 + chunk * 16)), (LAS unsigned*)(lds + L_ST + piece * 1024), 16, 0, 0); } }
        asm volatile("s_waitcnt vmcnt(0)" ::: "memory"); __syncthreads();
        bf16x8 qF[4];
#pragma unroll
        for (int ks = 0; ks < 4; ++ks) qF[ks] = *(const LAS bf16x8*)(lds + L_QT + nt * 4096 + (koff0 ^ (ks * 64)));
        f4 sT[4];
#pragma unroll
        for (int jt = 0; jt < 4; ++jt) { sT[jt] = (f4){0.f, 0.f, 0.f, 0.f};
            if (jt <= nt) {
#pragma unroll
                for (int ks = 0; ks < 4; ++ks) { const bf16x8 a = *(const LAS bf16x8*)(lds + L_KT + jt * 4096 + (koff0 ^ (ks * 64))); sT[jt] = __builtin_amdgcn_mfma_f32_16x16x32_bf16(a, qF[ks], sT[jt], 0, 0, 0); }
                if (jt == nt) {
#pragma unroll
                    for (int rg = 0; rg < 4; ++rg) if (4 * gq + rg > c) sT[jt][rg] = 0.f; } } }
        bf16x8 pb[2];
#pragma unroll
        for (int s = 0; s < 2; ++s) { v4u w; w.x = pg8::cvt_pk_bf16(sT[2 * s][0], sT[2 * s][1]); w.y = pg8::cvt_pk_bf16(sT[2 * s][2], sT[2 * s][3]); w.z = pg8::cvt_pk_bf16(sT[2 * s + 1][0], sT[2 * s + 1][1]); w.w = pg8::cvt_pk_bf16(sT[2 * s + 1][2], sT[2 * s + 1][3]); pb[s] = __builtin_bit_cast(bf16x8, w); }
        f4 o[8]; float ss = 0.f;
#pragma unroll
        for (int mt = 0; mt < 8; ++mt) { o[mt] = (f4){0.f, 0.f, 0.f, 0.f}; const int rb = 128 * half + 16 * mt;
#pragma unroll
            for (int ks = 0; ks < 4; ++ks) { const bf16x8 a = *(const LAS bf16x8*)(lds + L_ST + rb * 256 + (koff0 ^ (ks * 64))); o[mt] = __builtin_amdgcn_mfma_f32_16x16x32_bf16(a, qF[ks], o[mt], 0, 0, 0); }
#pragma unroll
            for (int s = 0; s < 2; ++s) if (2 * s <= nt) { const v2u lo = *(const LAS v2u*)(lds + L_VT + rb * 128 + (voff0 ^ (s * 64))), hi = *(const LAS v2u*)(lds + L_VT + rb * 128 + (voff0 ^ (s * 64 + 32)));
                o[mt] = __builtin_amdgcn_mfma_f32_16x16x32_bf16(__builtin_bit_cast(bf16x8, (v4u){lo.x, lo.y, hi.x, hi.y}), pb[s], o[mt], 0, 0, 0); }
            ss += (o[mt][0] * o[mt][0] + o[mt][1] * o[mt][1]) + (o[mt][2] * o[mt][2] + o[mt][3] * o[mt][3]); }
        ss = nsa::radd32(nsa::radd16(ss));
        LAS float* red = (LAS float*)(lds + L_RED);
        if (gq == 0) red[half * 64 + 16 * nt + c] = ss;
        __syncthreads();
        const float rstd = 1.f / sqrtf((red[16 * nt + c] + red[64 + 16 * nt + c]) * (1.f / 256.f) + RMS_EPS);
        const int tok = t0 + 16 * nt + c;
#pragma unroll
        for (int mt = 0; mt < 8; ++mt) { const int dv = 128 * half + 16 * mt + 4 * gq; const f32x4 g4 = *(const f32x4*)((const char*)gn + (unsigned)(dv * 4));
            const v2u gg = *(const v2u*)((const char*)GG + (unsigned)((tok * 1024 + h * 256 + dv) * 2));
            const float z0 = bflo(gg.x), z1 = bfhi(gg.x), z2 = bflo(gg.y), z3 = bfhi(gg.y);
            v2u w; w.x = pg8::cvt_pk_bf16(o[mt][0] * rstd * g4.x * (z0 / (1.f + __expf(-z0))), o[mt][1] * rstd * g4.y * (z1 / (1.f + __expf(-z1))));
            w.y = pg8::cvt_pk_bf16(o[mt][2] * rstd * g4.z * (z2 / (1.f + __expf(-z2))), o[mt][3] * rstd * g4.w * (z3 / (1.f + __expf(-z3))));
            *(v2u*)((char*)A2 + (unsigned)((tok * DM + h * 256 + dv) * 2)) = w; }
        __syncthreads();
    }
}

constexpr size_t WS_LH = WS_DEC + (size_t)2048 * 128 * 4;
constexpr size_t WS_PEV = WS_LH + (size_t)2 * 4096 * 256 * 4;
static_assert(WS_PEV + 1024 <= WS_KCMP, "cmp scratch overlay");
struct CmpOrder {
    int c; const bf16 *kc, *vc, *wk, *wv;
    __device__ __forceinline__ bool next(int i, pg8::Unit& u) const { if (i > 0 || c >= 32) return false; u.pm = c & 15; u.pn = 0; u.kind = c >> 4; return true; }
    __device__ __forceinline__ const char* pa(const pg8::Gemm&, const pg8::Unit& u) const { return (const char*)(u.kind ? vc : kc) + (size_t)u.pm * ((size_t)256 * 2048 * 2); }
    __device__ __forceinline__ const char* pb(const pg8::Gemm&, const pg8::Unit& u) const { return (const char*)(u.kind ? wv : wk); }
    __device__ __forceinline__ void a_ready(const pg8::Unit&) const {}
    __device__ __forceinline__ void done(const pg8::Unit&) const {}
};
struct EpiLH {
    static constexpr bool PERM = false, AFTER_DRAIN = false;
    float* LH;
    __device__ __forceinline__ void operator()(const pg8::f32x4 (&acc)[2][2][4][2], const pg8::Unit& u, int wr, int wc, int fr, int fq) const {
        const int row0 = u.kind * 4096 + u.pm * 256 + wr * 64 + fr, col0 = wc * 32 + 4 * fq;
#pragma unroll
        for (int ai = 0; ai < 2; ++ai)
#pragma unroll
            for (int m = 0; m < 4; ++m) { float* rowp = LH + (size_t)(row0 + ai * 128 + m * 16) * 256 + col0;
#pragma unroll
                for (int bj = 0; bj < 2; ++bj)
#pragma unroll
                    for (int n = 0; n < 2; ++n) *(pg8::f32x4*)(rowp + bj * 128 + n * 16) = acc[ai][bj][m][n]; }
    }
};
__device__ __forceinline__ void cmp_pevec(const Params& p, LAS unsigned char* lds, int which, int tid) {
    const float* pe = p.in[which ? I_PEV : I_PEK]; const float* w1 = p.in[which ? I_WV1 : I_WK1]; LAS float* part = (LAS float*)lds;
    const int m = tid & 127, q = tid >> 7; float a = 0.f;
    __syncthreads();
    for (int k = q * 1024; k < q * 1024 + 1024; ++k) a += pe[k] * w1[(size_t)k * 128 + m];
    part[q * 128 + m] = a; __syncthreads();
    if (tid < 128) ((float*)(p.ws + WS_PEV))[which * 128 + tid] = (part[tid] + part[128 + tid]) + (part[256 + tid] + part[384 + tid]);
    __syncthreads();
}
__device__ __forceinline__ void cmp_finalize(const Params& p, LAS unsigned char* lds, int which, int bg, int tid_in, int wave) {
    int tid = tid_in; asm volatile("" : "+v"(tid));
    const int lane = tid & 63, c15 = lane & 15, gq = lane >> 4;
    constexpr int L_HID = 0, L_W2T = 65536;
    const float* LH = (const float*)(p.ws + WS_LH) + ((size_t)which * 4096 + bg * 256) * 256; const float* pev = (const float*)(p.ws + WS_PEV) + which * 128; const float* w2 = p.in[which ? I_WV2 : I_WK2];
    asm volatile("s_waitcnt vmcnt(0)" ::: "memory"); __syncthreads();
#pragma unroll
    for (int i = 0; i < 8; ++i) { const int id = tid + 512 * i, c = id >> 4, ch = id & 15; v4u w = (v4u){0u, 0u, 0u, 0u};
        if (c < 255) { const float* lp = LH + (size_t)c * 256 + 8 * ch; const float* hp = LH + (size_t)(c + 1) * 256 + 128 + 8 * ch;
            const f32x4 l0 = *(const f32x4*)lp, l1 = *(const f32x4*)(lp + 4), h0 = *(const f32x4*)hp, h1 = *(const f32x4*)(hp + 4), e0 = *(const f32x4*)(pev + 8 * ch), e1 = *(const f32x4*)(pev + 8 * ch + 4);
            w.x = pk2(gelu_tanh(l0.x + h0.x + e0.x), gelu_tanh(l0.y + h0.y + e0.y)); w.y = pk2(gelu_tanh(l0.z + h0.z + e0.z), gelu_tanh(l0.w + h0.w + e0.w));
            w.z = pk2(gelu_tanh(l1.x + h1.x + e1.x), gelu_tanh(l1.y + h1.y + e1.y)); w.w = pk2(gelu_tanh(l1.z + h1.z + e1.z), gelu_tanh(l1.w + h1.w + e1.w)); }
        *(LAS v4u*)(lds + L_HID + c * 256 + ((ch ^ (c & 15)) * 16)) = w; }
#pragma unroll 8
    for (int i = 0; i < 32; ++i) { const int id = tid + 512 * i, m = id >> 7, n = id & 127;
        *(LAS bf16*)(lds + L_W2T + n * 256 + (((m >> 3) ^ (n & 15)) * 16) + (m & 7) * 2) = (bf16)f2bf(w2[id]); }
    __syncthreads();
    const int koff0 = c15 * 256 + ((gq ^ c15) * 16);
    bf16* KCMP = (bf16*)(p.ws + WS_KCMP) + (size_t)bg * 256 * 128; bf16* VCMPT = (bf16*)(p.ws + WS_VCMPT) + (size_t)bg * 128 * 256;
#pragma unroll
    for (int ci = 0; ci < 2; ++ci) { const int ctile = 2 * wave + ci;
        bf16x8 hF[4];
#pragma unroll
        for (int ks = 0; ks < 4; ++ks) hF[ks] = *(const LAS bf16x8*)(lds + L_HID + ctile * 4096 + (koff0 ^ (ks * 64)));
#pragma unroll
        for (int ntile = 0; ntile < 8; ++ntile) { pg8::f32x4 d = (pg8::f32x4){0.f, 0.f, 0.f, 0.f};
#pragma unroll
            for (int ks = 0; ks < 4; ++ks) { const bf16x8 wF = *(const LAS bf16x8*)(lds + L_W2T + ntile * 4096 + (koff0 ^ (ks * 64)));
                d = which ? __builtin_amdgcn_mfma_f32_16x16x32_bf16(hF[ks], wF, d, 0, 0, 0) : __builtin_amdgcn_mfma_f32_16x16x32_bf16(wF, hF[ks], d, 0, 0, 0); }
            const v2u w = (v2u){pg8::cvt_pk_bf16(d[0], d[1]), pg8::cvt_pk_bf16(d[2], d[3])};
            if (which) *(v2u*)(VCMPT + (size_t)(16 * ntile + c15) * 256 + 16 * ctile + 4 * gq) = w;
            else *(v2u*)(KCMP + (size_t)(16 * ctile + c15) * 128 + 16 * ntile + 4 * gq) = w; } }
    __syncthreads();
}

constexpr size_t PROWS = (size_t)MAXTILES * 256;
constexpr size_t WS_W1Q = WS_W1T;
constexpr size_t WS_W2Q = WS_W1Q + (size_t)NE * 4096 * DM;
constexpr size_t WS_HN8 = WS_W2Q + (size_t)NE * DM * DFF;
constexpr size_t WS_AMAXP = WS_HN8 + (size_t)T * DM;
constexpr size_t WS_WSC1 = WS_AMAXP + PROWS * 64 * 4;
constexpr size_t WS_WSC2 = WS_WSC1 + (size_t)NE * 4096 * 4;
constexpr size_t WS_HSC = WS_WSC2 + (size_t)NE * 2048 * 4;
constexpr size_t WS_ROWSC = WS_HSC + (size_t)T * 4;
constexpr size_t WS_ASC = WS_ROWSC + PROWS * 4;
static_assert(WS_ASC + PROWS * 4 <= WS_XN, "int8 buffers fit in the retired bf16 expert-weight region");
constexpr size_t WS_XG8 = WS_XG;
constexpr size_t WS_ACT8 = WS_XG + PROWS * DM;
constexpr size_t WS_Y = WS_ACT;
static_assert(WS_ACT8 + PROWS * DM <= WS_ACT, "int8 row buffers fit in the retired gathered-row region");

__device__ __forceinline__ unsigned q8(float v) { int q = (int)rintf(v); q = q > 127 ? 127 : (q < -127 ? -127 : q); return (unsigned)q & 0xffu; }
__device__ __forceinline__ unsigned q8x4(float a, float b, float c, float d) { return q8(a) | (q8(b) << 8) | (q8(c) << 16) | (q8(d) << 24); }

constexpr size_t WS_WINQ = WS_WINT;
constexpr size_t WS_WISC = WS_WINT + (size_t)NPT * 256 * DM;
constexpr size_t WS_XN8 = WS_XN;
constexpr size_t WS_XSC = WS_XN + (size_t)T * DM;
constexpr size_t WS_PMAX = WS_HN;
constexpr size_t WS_PMAXI = WS_PMAX + (size_t)64 * 8 * 4096 * 4;
__device__ __forceinline__ void p0_absmax(const Params& p, int bid, int G, int tid) {
    float* PMAX = (float*)(p.ws + WS_PMAX);
    for (int it = bid; it < 8; it += G) {
        const float* src = p.in[I_WIN] + (size_t)it * 256 * 5672; float* dst = (float*)(p.ws + WS_PMAXI) + (size_t)it * 5696;
#pragma unroll
        for (int q = 0; q < 3; ++q) { const int c4 = tid + 512 * q; if (c4 < 1418) { f32x4 m0 = (f32x4){0.f, 0.f, 0.f, 0.f};
#pragma unroll 8
            for (int r = 0; r < 256; ++r) { const f32x4 a = *(const f32x4*)(src + (size_t)r * 5672 + c4 * 4); m0.x = fmaxf(m0.x, fabsf(a.x)); m0.y = fmaxf(m0.y, fabsf(a.y)); m0.z = fmaxf(m0.z, fabsf(a.z)); m0.w = fmaxf(m0.w, fabsf(a.w)); }
            *(f32x4*)(dst + c4 * 4) = m0; } } }
}
__device__ __forceinline__ void p0_quant(const Params& p, LAS unsigned char* lds, int gw, int NGW, int wave, int lane) {
    LAS float* scr = (LAS float*)(lds + wave * 16896);
    const float* PMAX = (const float*)(p.ws + WS_PMAX);
    signed char* W1Q = (signed char*)(p.ws + WS_W1Q); signed char* W2Q = (signed char*)(p.ws + WS_W2Q); float* WSC1 = (float*)(p.ws + WS_WSC1); float* WSC2 = (float*)(p.ws + WS_WSC2);
    for (int it = gw; it < 16 * 178; it += NGW) {
        const int kb = it / 178, nb = it % 178, n0 = nb * 32, k0 = kb * 128; const int nl = n0 + (lane & 31); const bool okc = nl < 5672;
        const float* W = p.in[I_WIN] + (size_t)k0 * 5672 + (okc ? nl : 0) + (size_t)(lane >> 5) * 5672;
        float w[64];
#pragma unroll
        for (int i = 0; i < 64; ++i) w[i] = W[(size_t)(2 * i) * 5672];
        float mx = 0.f;
#pragma unroll
        for (int q = 0; q < 8; ++q) mx = fmaxf(mx, ((const float*)(p.ws + WS_PMAXI))[(size_t)q * 5696 + (okc ? nl : 0)]);
        const float sc = mx > 0.f ? mx * (1.f / 127.f) : 1.f, ivl = 1.f / sc; float qsc; const int rowl = okc ? win_row(nl, qsc) : -1;
        if (kb == 0 && lane < 32 && okc) ((float*)(p.ws + WS_WISC))[rowl] = sc * qsc;
#pragma unroll
        for (int i = 0; i < 64; ++i) scr[(2 * i + (lane >> 5)) * 33 + (lane & 31)] = w[i];
        LDS_WAIT(); asm volatile("" ::: "memory");
        const int c = lane & 7;
#pragma unroll
        for (int j = 0; j < 4; ++j) { const int nn = (lane >> 3) + 8 * j; const float iv = __shfl(ivl, nn); const int rown = __shfl(rowl, nn); const LAS float* s = scr + (16 * c) * 33 + nn; v4u o;
            o.x = q8x4(s[0] * iv, s[33] * iv, s[66] * iv, s[99] * iv); o.y = q8x4(s[132] * iv, s[165] * iv, s[198] * iv, s[231] * iv);
            o.z = q8x4(s[264] * iv, s[297] * iv, s[330] * iv, s[363] * iv); o.w = q8x4(s[396] * iv, s[429] * iv, s[462] * iv, s[495] * iv);
            if (rown >= 0) *(v4u*)((signed char*)(p.ws + WS_WINQ) + (size_t)rown * 2048 + k0 + 16 * c) = o; }
        LDS_WAIT(); asm volatile("" ::: "memory"); }
}

__device__ __forceinline__ void p0_slab_quant(const Params& p, LAS unsigned char* lds, int bid, int G, int tid) {
    constexpr int RS = 4104;
    LAS unsigned char* TT = lds; LAS float* part = (LAS float*)(lds + 32 * RS); LAS float* inv = part + 64 * 32; LAS int* drow = (LAS int*)(inv + 32);
    signed char* W1Q = (signed char*)(p.ws + WS_W1Q); signed char* W2Q = (signed char*)(p.ws + WS_W2Q); float* WSC1 = (float*)(p.ws + WS_WSC1); float* WSC2 = (float*)(p.ws + WS_WSC2);
    const int n4 = tid & 7, r0 = tid >> 3;
    for (int slab = bid; slab < NE * 192; slab += G) {
        const int e = slab / 192, r = slab % 192; const bool isw2 = r >= 128; const int nb = isw2 ? r - 128 : r, N = isw2 ? 2048 : 4096, n0 = nb * 32;
        const float* W = (isw2 ? p.in[I_W2] + (size_t)e * DFF * DM : p.in[I_W1] + (size_t)e * DM * 4096) + (size_t)r0 * N + n0 + 4 * n4;
        f32x4 mx = (f32x4){0.f, 0.f, 0.f, 0.f};
#pragma unroll
        for (int ib = 0; ib < 4; ++ib) { f32x4 v[8];
#pragma unroll
            for (int u = 0; u < 8; ++u) v[u] = __builtin_nontemporal_load((const f32x4*)(W + (size_t)(64 * (8 * ib + u)) * N));
#pragma unroll
            for (int u = 0; u < 8; ++u) { const int k = r0 + 64 * (8 * ib + u);
                mx.x = fmaxf(mx.x, fabsf(v[u].x)); mx.y = fmaxf(mx.y, fabsf(v[u].y)); mx.z = fmaxf(mx.z, fabsf(v[u].z)); mx.w = fmaxf(mx.w, fabsf(v[u].w));
                LAS unsigned char* d = TT + (4 * n4) * RS + k * 2;
                *(LAS bf16*)d = (bf16)f2bf(v[u].x); *(LAS bf16*)(d + RS) = (bf16)f2bf(v[u].y); *(LAS bf16*)(d + 2 * RS) = (bf16)f2bf(v[u].z); *(LAS bf16*)(d + 3 * RS) = (bf16)f2bf(v[u].w); } }
        *(LAS f32x4*)(part + r0 * 32 + 4 * n4) = mx;
        __syncthreads();
        if (tid < 32) { float m = 0.f;
#pragma unroll 8
            for (int q = 0; q < 64; ++q) m = fmaxf(m, part[q * 32 + tid]);
            const float sc = m > 0.f ? m * (1.f / 127.f) : 1.f; inv[tid] = 1.f / sc; const int n = n0 + tid;
            if (isw2) { drow[tid] = e * 2048 + n; WSC2[e * 2048 + n] = sc; }
            else { const int j2 = n & 2047, row = (j2 >> 7) * 256 + (n >= 2048 ? 128 : 0) + (j2 & 127); drow[tid] = e * 4096 + row; WSC1[e * 4096 + row] = sc; } }
        __syncthreads();
        { const int kc = tid & 7, n = (tid >> 3) & 31, hf = tid >> 8; const float iv = inv[n]; signed char* dst = (isw2 ? W2Q : W1Q) + (size_t)drow[n] * 2048; const LAS unsigned char* src = TT + n * RS;
#pragma unroll
          for (int m8 = 0; m8 < 8; ++m8) { const int k0 = 16 * (kc + 8 * (hf + 2 * m8)); const LAS v2u* sp = (const LAS v2u*)(src + k0 * 2); const v2u a = sp[0], b = sp[1], c = sp[2], d = sp[3]; v4u o;
              o.x = q8x4(bflo(a.x) * iv, bfhi(a.x) * iv, bflo(a.y) * iv, bfhi(a.y) * iv); o.y = q8x4(bflo(b.x) * iv, bfhi(b.x) * iv, bflo(b.y) * iv, bfhi(b.y) * iv);
              o.z = q8x4(bflo(c.x) * iv, bfhi(c.x) * iv, bflo(c.y) * iv, bfhi(c.y) * iv); o.w = q8x4(bflo(d.x) * iv, bfhi(d.x) * iv, bflo(d.y) * iv, bfhi(d.y) * iv);
              *(v4u*)(dst + k0) = o; } }
        __syncthreads();
    }
}
struct EpiSwigluI8 {
    static constexpr bool PERM = true, AFTER_DRAIN = false;
    const float* b1; const float* rowsc; const float* wsc1; bf16* act; float* amaxp;
    __device__ __forceinline__ void operator()(const pg8::f32x4 (&acc)[2][2][4][2], const pg8::Unit& u, int wr, int wc, int fr, int fq) const {
        const int e = u.kind; const int cin = wc * 32 + 8 * fq; const int col = u.pn * 128 + cin; const int row0 = u.pm * 256 + wr * 64 + fr;
        const float* bg = b1 + (size_t)e * 4096 + col; const float* bl = bg + 2048; const float* sg = wsc1 + (size_t)e * 4096 + u.pn * 256 + cin; const float* sl = sg + 128;
        float gb[8], lb[8], gs[8], ls[8];
#pragma unroll
        for (int j = 0; j < 8; ++j) { gb[j] = bg[j]; lb[j] = bl[j]; gs[j] = sg[j]; ls[j] = sl[j]; }
#pragma unroll
        for (int ai = 0; ai < 2; ++ai)
#pragma unroll
            for (int m = 0; m < 4; ++m) { const int r = row0 + ai * 128 + m * 16; const float rs = rowsc[r]; float o[8]; float mx = 0.f;
#pragma unroll
                for (int n = 0; n < 2; ++n)
#pragma unroll
                    for (int j = 0; j < 4; ++j) { float gl = (float)__float_as_int(acc[ai][0][m][n][j]) * (rs * gs[n * 4 + j]) + gb[n * 4 + j]; float li = (float)__float_as_int(acc[ai][1][m][n][j]) * (rs * ls[n * 4 + j]) + lb[n * 4 + j];
                        gl = fminf(gl, 7.f); li = fminf(fmaxf(li, -7.f), 7.f);
                        const float v = gl * __builtin_amdgcn_rcpf(1.f + __builtin_amdgcn_exp2f(-2.4554669595930156f * gl)) * (li + 1.f); o[n * 4 + j] = v; mx = fmaxf(mx, fabsf(v)); }
                mx = nsa::rmax32(nsa::rmax16(mx));
                if (fq == 0) amaxp[(size_t)r * 64 + u.pn * 4 + wc] = mx;
                pg8::u32x4 w; w.x = pg8::cvt_pk_bf16(o[0], o[1]); w.y = pg8::cvt_pk_bf16(o[2], o[3]); w.z = pg8::cvt_pk_bf16(o[4], o[5]); w.w = pg8::cvt_pk_bf16(o[6], o[7]);
                *(pg8::u32x4*)(act + (size_t)r * DFF + col) = w; }
    }
};
__device__ __forceinline__ void ph_actq(const Params& p, int gw, int NGW, int lane) {
    const int nrows = ((const int*)(p.ws + WS_META))[0] * 256; const float* amaxp = (const float*)(p.ws + WS_AMAXP); const bf16* act = (const bf16*)(p.ws + WS_ACT);
    signed char* A8 = (signed char*)(p.ws + WS_ACT8); float* ASC = (float*)(p.ws + WS_ASC);
    for (int r = gw; r < nrows; r += NGW) { const float mx = wave_max(amaxp[(size_t)r * 64 + lane]); const float sc = mx > 0.f ? mx * (1.f / 127.f) : 1.f, iv = 1.f / sc;
        const v4u* src = (const v4u*)(act + (size_t)r * DFF) + lane * 4; v4u a[4];
#pragma unroll
        for (int j = 0; j < 4; ++j) a[j] = src[j];
        v4u o[2];
#pragma unroll
        for (int h = 0; h < 2; ++h) { const v4u x = a[2 * h], y = a[2 * h + 1];
            o[h].x = q8x4(bflo(x.x) * iv, bfhi(x.x) * iv, bflo(x.y) * iv, bfhi(x.y) * iv); o[h].y = q8x4(bflo(x.z) * iv, bfhi(x.z) * iv, bflo(x.w) * iv, bfhi(x.w) * iv);
            o[h].z = q8x4(bflo(y.x) * iv, bfhi(y.x) * iv, bflo(y.y) * iv, bfhi(y.y) * iv); o[h].w = q8x4(bflo(y.z) * iv, bfhi(y.z) * iv, bflo(y.w) * iv, bfhi(y.w) * iv); }
        v4u* dst = (v4u*)(A8 + (size_t)r * DFF) + lane * 2; dst[0] = o[0]; dst[1] = o[1];
        if (lane == 0) ASC[r] = sc; }
}
struct EpiDownI8 {
    static constexpr bool PERM = true, AFTER_DRAIN = false;
    const float* b2; const float* roww; const float* asc; const float* wsc2; bf16* y;
    __device__ __forceinline__ void operator()(const pg8::f32x4 (&acc)[2][2][4][2], const pg8::Unit& u, int wr, int wc, int fr, int fq) const {
        const int e = u.kind; const int col0 = u.pn * 256 + wc * 32 + 8 * fq; const int row0 = u.pm * 256 + wr * 64 + fr;
        float bv[2][8], sv[2][8];
#pragma unroll
        for (int bj = 0; bj < 2; ++bj)
#pragma unroll
            for (int j = 0; j < 8; ++j) { bv[bj][j] = b2[(size_t)e * DM + col0 + bj * 128 + j]; sv[bj][j] = wsc2[(size_t)e * DM + col0 + bj * 128 + j]; }
#pragma unroll
        for (int ai = 0; ai < 2; ++ai)
#pragma unroll
            for (int m = 0; m < 4; ++m) { const int r = row0 + ai * 128 + m * 16; const float g = roww[r], as = asc[r];
#pragma unroll
                for (int bj = 0; bj < 2; ++bj) { float o[8];
#pragma unroll
                    for (int n = 0; n < 2; ++n)
#pragma unroll
                        for (int j = 0; j < 4; ++j) o[n * 4 + j] = ((float)__float_as_int(acc[ai][bj][m][n][j]) * (as * sv[bj][n * 4 + j]) + bv[bj][n * 4 + j]) * g;
                    pg8::u32x4 w; w.x = pg8::cvt_pk_bf16(o[0], o[1]); w.y = pg8::cvt_pk_bf16(o[2], o[3]); w.z = pg8::cvt_pk_bf16(o[4], o[5]); w.w = pg8::cvt_pk_bf16(o[6], o[7]);
                    *(pg8::u32x4*)(y + (size_t)r * DM + col0 + bj * 128) = w; } }
    }
};

struct EpiProjI8 {
    static constexpr bool PERM = true, AFTER_DRAIN = false;
    unsigned char* ws;
    __device__ __forceinline__ void operator()(const pg8::f32x4 (&acc)[2][2][4][2], const pg8::Unit& u, int wr, int wc, int fr, int fq) const {
        const int cw = wc * 32 + 8 * fq; const float* XSC = (const float*)(ws + WS_XSC); const float* WISC = (const float*)(ws + WS_WISC);
        if (u.kind == 0) {
            const int tn = u.pn; bf16* base; size_t bjs = 128; int ld = 0; bool headmajor = false; bool small = false;
            if (tn < 2) { base = (bf16*)(ws + WS_GQ) + tn * 256; ld = 512; }
            else if (tn < 4) { base = (bf16*)(ws + WS_GK) + (tn - 2) * 256; ld = 512; }
            else if (tn < 8) { base = (bf16*)(ws + WS_GV) + (tn - 4) * 256; ld = 1024; }
            else if (tn < 12) { base = (bf16*)(ws + WS_GG) + (tn - 8) * 256; ld = 1024; }
            else if (tn < 16) { base = (bf16*)(ws + WS_NQ) + (tn - 12) * 256; ld = 1024; }
            else if (tn < 20) { base = (bf16*)(ws + (tn == 16 ? WS_KC : tn == 17 ? WS_VC : tn == 18 ? WS_KS : WS_KW)); headmajor = true; bjs = (size_t)SEQ * 128; }
            else { base = (bf16*)(ws + WS_SM); ld = 64; small = true; }
            if (small && wc >= 2) return;
            float cs[2][8];
#pragma unroll
            for (int bj = 0; bj < 2; ++bj)
#pragma unroll
                for (int j = 0; j < 8; ++j) cs[bj][j] = WISC[tn * 256 + bj * 128 + cw + j];
#pragma unroll
            for (int ai = 0; ai < 2; ++ai)
#pragma unroll
                for (int m = 0; m < 4; ++m) { const int r = u.pm * 256 + ai * 128 + wr * 64 + m * 16 + fr; const float rs = XSC[r];
                    const size_t rterm = headmajor ? ((size_t)(r >> 12) * 2 * SEQ + (r & (SEQ - 1))) * 128 : (size_t)r * ld;
#pragma unroll
                    for (int bj = 0; bj < 2; ++bj) { if (small && bj) continue; float o[8];
#pragma unroll
                        for (int n = 0; n < 2; ++n)
#pragma unroll
                            for (int j = 0; j < 4; ++j) o[n * 4 + j] = (float)__float_as_int(acc[ai][bj][m][n][j]) * (rs * cs[bj][n * 4 + j]);
                        pg8::u32x4 w; w.x = pg8::cvt_pk_bf16(o[0], o[1]); w.y = pg8::cvt_pk_bf16(o[2], o[3]); w.z = pg8::cvt_pk_bf16(o[4], o[5]); w.w = pg8::cvt_pk_bf16(o[6], o[7]);
                        *(pg8::u32x4*)(base + rterm + bj * bjs + cw) = w; } }
        } else {
            bf16* base = (bf16*)(ws + (u.pn == 21 ? WS_VST : WS_VWT));
#pragma unroll
            for (int ai = 0; ai < 2; ++ai)
#pragma unroll
                for (int m = 0; m < 4; ++m) { const int dh = wr * 64 + m * 16 + fr; const float ws_ = WISC[u.pn * 256 + ai * 128 + dh];
#pragma unroll
                    for (int bj = 0; bj < 2; ++bj) { const int tok = u.pm * 256 + bj * 128 + cw; const int b = tok >> 12, s = tok & (SEQ - 1); float o[8];
                        const pg8::f32x4 x0 = *(const pg8::f32x4*)(XSC + tok), x1 = *(const pg8::f32x4*)(XSC + tok + 4);
#pragma unroll
                        for (int j = 0; j < 4; ++j) { o[j] = (float)__float_as_int(acc[ai][bj][m][0][j]) * (ws_ * x0[j]); o[4 + j] = (float)__float_as_int(acc[ai][bj][m][1][j]) * (ws_ * x1[j]); }
                        pg8::u32x4 w; w.x = pg8::cvt_pk_bf16(o[0], o[1]); w.y = pg8::cvt_pk_bf16(o[2], o[3]); w.z = pg8::cvt_pk_bf16(o[4], o[5]); w.w = pg8::cvt_pk_bf16(o[6], o[7]);
                        *(pg8::u32x4*)(base + ((size_t)(b * 2 + ai) * 128 + dh) * SEQ + s) = w; } }
        }
    }
};

__device__ __forceinline__ void r1_router(const Params& p, LAS unsigned char* lds, int vb, int tid, int wave, int lane) {
    LAS float* rowbuf = (LAS float*)lds;
    LAS float* part = (LAS float*)(lds + 65536);
    LAS int* tk = (LAS int*)(lds + 81920 + wave * 1024);
    LAS int* cntw = (LAS int*)(lds + 90112);
    const float* h = p.out; const float* gf = p.in[I_NFFN]; const float* rw = p.in[I_RW]; const float* rb = p.in[I_RB];
    signed char* HN8 = (signed char*)(p.ws + WS_HN8);
    const int e = lane & 31, eg = tid & 31, dg = tid >> 5; int mycount = 0;
    float rwr[128];
#pragma unroll
    for (int c4 = 0; c4 < 4; ++c4) { unsigned o = (unsigned)((((dg * 128 + c4 * 32) * 32) + eg) * 4); asm volatile("" : "+v"(o));
#pragma unroll
        for (int i = 0; i < 32; ++i) rwr[c4 * 32 + i] = *(const float*)((const char*)rw + o + i * 128); }
    for (int grp = 0; grp < 16; ++grp) { const int t = vb * TPV + grp * 8 + wave;
        { const f32x4* xr = (const f32x4*)(h + (size_t)t * DM) + lane; f32x4 v[8]; float s = 0.f;
#pragma unroll
          for (int j = 0; j < 8; ++j) { v[j] = xr[64 * j]; s += (v[j].x * v[j].x + v[j].y * v[j].y) + (v[j].z * v[j].z + v[j].w * v[j].w); }
          const float rstd = 1.f / sqrtf(wave_sum(s) * (1.f / DM) + RMS_EPS);
          float mxr = 0.f; LAS f32x4* hrow = (LAS f32x4*)(rowbuf + wave * 2048);
#pragma unroll
          for (int j = 0; j < 8; ++j) { const f32x4 g4 = ((const f32x4*)gf)[lane + 64 * j]; f32x4 y; y.x = v[j].x * rstd * g4.x; y.y = v[j].y * rstd * g4.y; y.z = v[j].z * rstd * g4.z; y.w = v[j].w * rstd * g4.w;
              v[j] = y; hrow[lane + 64 * j] = y; mxr = fmaxf(mxr, fmaxf(fmaxf(fabsf(y.x), fabsf(y.y)), fmaxf(fabsf(y.z), fabsf(y.w)))); }
          mxr = wave_max(mxr); const float qs = mxr > 0.f ? mxr * (1.f / 127.f) : 1.f, qi = 1.f / qs;
          unsigned* o4 = (unsigned*)(HN8 + (size_t)t * DM) + lane;
#pragma unroll
          for (int j = 0; j < 8; ++j) o4[64 * j] = q8x4(v[j].x * qi, v[j].y * qi, v[j].z * qi, v[j].w * qi);
          if (lane == 0) ((float*)(p.ws + WS_HSC))[t] = qs; }
        __syncthreads();
        { float acc[8];
#pragma unroll
          for (int tt = 0; tt < 8; ++tt) acc[tt] = 0.f;
#pragma unroll
          for (int i4 = 0; i4 < 32; ++i4) { f32x4 xv[8];
#pragma unroll
              for (int tt = 0; tt < 8; ++tt) xv[tt] = *(const LAS f32x4*)(rowbuf + tt * 2048 + dg * 128 + 4 * i4);
#pragma unroll
              for (int tt = 0; tt < 8; ++tt) acc[tt] += xv[tt].x * rwr[4 * i4] + xv[tt].y * rwr[4 * i4 + 1] + xv[tt].z * rwr[4 * i4 + 2] + xv[tt].w * rwr[4 * i4 + 3];
              if (i4 & 1) asm volatile("" ::: "memory"); }
#pragma unroll
          for (int tt = 0; tt < 8; ++tt) part[(dg * 8 + tt) * 32 + eg] = acc[tt]; }
        __syncthreads();
        { float a = rb[e];
#pragma unroll
          for (int q = 0; q < 16; ++q) a += part[(q * 8 + wave) * 32 + e];
          int rank = 0;
#pragma unroll
          for (int mm = 0; mm < 32; ++mm) { const float lm = __shfl(a, mm); rank += (lm > a || (lm == a && mm < e)) ? 1 : 0; }
          const float mx = wave_max(a); const bool sel = rank < 4;
          const float ex = (sel && lane < 32) ? __expf(a - mx) : 0.f; const float sum = wave_sum(ex);
          if (sel && lane < 32) { LAS int* q = tk + (grp * 4 + rank) * 4; q[0] = e; q[1] = mycount; q[2] = __builtin_bit_cast(int, ex / sum); ++mycount; } }
        __syncthreads();
    }
    if (lane < 32) cntw[wave * 32 + lane] = mycount;
    __syncthreads();
    if (wave == 0 && lane < 32) { int tot = 0; for (int w = 0; w < 8; ++w) tot += cntw[w * 32 + lane]; ((int*)(p.ws + WS_CNT))[vb * 32 + lane] = tot; }
    { const int i = lane >> 2, k = lane & 3; const LAS int* q = tk + (i * 4 + k) * 4; const int ee = q[0]; int base = 0; for (int w = 0; w < wave; ++w) base += cntw[w * 32 + ee];
      const int t = vb * TPV + i * 8 + wave;
      ((int*)(p.ws + WS_EIDX))[t * 4 + k] = ee; ((int*)(p.ws + WS_LRNK))[t * 4 + k] = base + q[1]; ((int*)(p.ws + WS_GATE))[t * 4 + k] = q[2]; }
    __syncthreads();
}
__device__ __forceinline__ void r2_gather(const Params& p, LAS unsigned char* lds, int vb, bool write_meta, int tid, int wave, int lane) {
    LAS int* part_tot = (LAS int*)lds;
    LAS int* part_base = part_tot + 512;
    LAS int* pbase = part_base + 512;
    const int* CNT = (const int*)(p.ws + WS_CNT);
    { const int e = tid & 31, part = tid >> 5; int tot = 0, bs = 0;
      for (int v = part * 16; v < part * 16 + 16; ++v) { const int c = CNT[v * 32 + e]; tot += c; if (v < vb) bs += c; }
      part_tot[part * 32 + e] = tot; part_base[part * 32 + e] = bs; }
    __syncthreads();
    if (tid == 0) { int ps = 0; int* meta = (int*)(p.ws + WS_META); int nt = 0;
        for (int e = 0; e < 32; ++e) { int tot = 0, bs = 0; for (int q = 0; q < 16; ++q) { tot += part_tot[q * 32 + e]; bs += part_base[q * 32 + e]; }
            pbase[e] = ps + bs; const int ntile = (tot + 255) >> 8;
            if (write_meta) for (int q = 0; q < ntile; ++q) meta[64 + nt + q] = e;
            nt += ntile; ps += ntile * 256; }
        if (write_meta) meta[0] = nt; }
    __syncthreads();
    const signed char* HN8 = (const signed char*)(p.ws + WS_HN8); signed char* XG8 = (signed char*)(p.ws + WS_XG8); const float* HSC = (const float*)(p.ws + WS_HSC); float* ROWSC = (float*)(p.ws + WS_ROWSC);
    const int* EIDX = (const int*)(p.ws + WS_EIDX); const int* LRNK = (const int*)(p.ws + WS_LRNK); const float* GATE = (const float*)(p.ws + WS_GATE);
    int* POS = (int*)(p.ws + WS_POS); float* ROWW = (float*)(p.ws + WS_ROWW);
    for (int i0 = 0; i0 < 16; i0 += 4) {
        v4u v0[4], v1[4]; float hs[4]; int ee[4][4], lr[4][4]; float gt[4][4];
#pragma unroll
        for (int u = 0; u < 4; ++u) { const int t = vb * TPV + (i0 + u) * 8 + wave; const v4u* src = (const v4u*)(HN8 + (size_t)t * DM) + lane; v0[u] = src[0]; v1[u] = src[64]; hs[u] = HSC[t];
#pragma unroll
            for (int k = 0; k < 4; ++k) { ee[u][k] = EIDX[t * 4 + k]; lr[u][k] = LRNK[t * 4 + k]; gt[u][k] = GATE[t * 4 + k]; } }
#pragma unroll
        for (int u = 0; u < 4; ++u) { const int t = vb * TPV + (i0 + u) * 8 + wave;
#pragma unroll
            for (int k = 0; k < 4; ++k) { const int pos = pbase[ee[u][k]] + lr[u][k];
                if (lane == 0) { POS[t * 4 + k] = pos; ROWW[pos] = gt[u][k]; ROWSC[pos] = hs[u]; }
                v4u* dst = (v4u*)(XG8 + (size_t)pos * DM) + lane; dst[0] = v0[u]; dst[64] = v1[u]; } } }
    __syncthreads();
}
__device__ __forceinline__ void pf_final(const Params& p, int gw, int NGW, int lane) {
    const bf16* Y = (const bf16*)(p.ws + WS_Y); const int* POS = (const int*)(p.ws + WS_POS); const float* gfin = p.in[I_NFIN];
    for (int t = gw; t < T; t += NGW) {
        f32x4* xr = (f32x4*)(p.out + (size_t)t * DM) + lane; f32x4 v[8];
#pragma unroll
        for (int j = 0; j < 8; ++j) v[j] = xr[64 * j];
#pragma unroll
        for (int k = 0; k < 4; ++k) { const int pos = POS[t * 4 + k]; const v2u* yr = (const v2u*)(Y + (size_t)pos * DM) + lane;
#pragma unroll
            for (int j = 0; j < 8; ++j) { const v2u w = yr[64 * j]; v[j].x += bflo(w.x); v[j].y += bfhi(w.x); v[j].z += bflo(w.y); v[j].w += bfhi(w.y); } }
        float s = 0.f;
#pragma unroll
        for (int j = 0; j < 8; ++j) s += (v[j].x * v[j].x + v[j].y * v[j].y) + (v[j].z * v[j].z + v[j].w * v[j].w);
        const float rstd = 1.f / sqrtf(wave_sum(s) * (1.f / DM) + RMS_EPS);
#pragma unroll
        for (int j = 0; j < 8; ++j) { const f32x4 g4 = ((const f32x4*)gfin)[lane + 64 * j]; f32x4 o; o.x = v[j].x * rstd * g4.x; o.y = v[j].y * rstd * g4.y; o.z = v[j].z * rstd * g4.z; o.w = v[j].w * rstd * g4.w; xr[64 * j] = o; }
    }
}


constexpr int LDS_BYTES = 159744;
constexpr int MISC_OFF = LDS_BYTES - 256;  static_assert(nsa::LDS_END <= MISC_OFF && gla::L_END <= MISC_OFF, "LDS map");
constexpr int CW_BAR = 4096, CW_XL = 16384;
__global__ __launch_bounds__(512, 2) void mega_fwd(Params p) {
    extern __shared__ __attribute__((aligned(16))) unsigned char lds_raw[];
    LAS unsigned char* lds = (LAS unsigned char*)lds_raw;
    const int G = gridDim.x, bid = blockIdx.x, NGW = G * 8;
#define PH_IDS int tid = threadIdx.x; asm volatile("" : "+v"(tid)); const int lane = tid & 63, wave = __builtin_amdgcn_readfirstlane(tid >> 6), gw = bid * 8 + wave; (void)lane; (void)gw;
    for (int u = threadIdx.x; u < 64; u += 512) ((LAS unsigned*)(lds + MISC_OFF))[u] = 0u;
    __syncthreads();
    XcdBarrier bar = xcd_barrier_post((unsigned*)(p.ws + WS_CTL) + CW_BAR, (volatile LAS unsigned*)(lds + MISC_OFF) + 8);
    { PH_IDS; p0_absmax(p, bid, G, tid); p0_prologue(p, lds, gw, NGW, wave, lane); __syncthreads(); p0_slab_quant(p, lds, bid, G, tid); }
    xcd_barrier(bar);
    { PH_IDS; p0_quant(p, lds, gw, NGW, wave, lane); }
    xcd_barrier(bar);
    { pg8::Gemm g{(const bf16*)(p.ws + WS_XN8), (const bf16*)(p.ws + WS_WINQ), T, NPT * 256, DM / 2};
      ProjOrder S; S.init(T, NPT * 256, G, bid); S.xn = g.A; S.wt = g.Bt; EpiProjI8 E{p.ws};
      pg8::gemm_phase<EpiProjI8, ProjOrder, true, true, true>(lds, g, S, E); }
    xcd_barrier(bar);
    if (bid < 32) {
        pg8::Gemm g{(const bf16*)(p.ws + WS_KC), (const bf16*)(p.ws + WS_WKCT), 4096, 256, 2048};
        CmpOrder S{bid, (const bf16*)(p.ws + WS_KC), (const bf16*)(p.ws + WS_VC), (const bf16*)(p.ws + WS_WKCT), (const bf16*)(p.ws + WS_WVCT)}; EpiLH E{(float*)(p.ws + WS_LH)};
        pg8::gemm_phase<EpiLH, CmpOrder, true, true>(lds, g, S, E);
    } else { PH_IDS; ph_gla_a(p, lds, bid - 32, G - 32, tid, wave); }
    xcd_barrier(bar);
    { PH_IDS; ph_gla_b(p, bid * 512 + tid, G * 512);
      for (int i = bid * 512 + tid; i < 16 * 128; i += G * 512) { const int bgz = i >> 7, dz = i & 127; ((bf16*)(p.ws + WS_KCMP))[((size_t)bgz * 256 + 255) * 128 + dz] = 0; ((bf16*)(p.ws + WS_VCMPT))[((size_t)bgz * 128 + dz) * 256 + 255] = 0; }
      const int ngrp = G * 4, total = 2 * 16 * 255, iters = (total + ngrp - 1) / ngrp; const int grp = tid >> 7;
      for (int it = 0; it < iters; ++it) { int id = it * ngrp + bid * 4 + grp; if (id >= total) id = total - 1;
          ph_cmp_fin_simple(p, (LAS float*)lds + grp * 4352, id, tid & 127, (const float*)(p.ws + WS_LH), (const float*)(p.ws + WS_PEVP)); __syncthreads(); } }
    xcd_barrier(bar);
    { PH_IDS; ph_nsa(p, lds, bid, G, tid, wave); }
    { PH_IDS; __syncthreads(); ph_gla_c(p, lds, bid, G, tid, wave); }
    xcd_barrier(bar);
    { pg8::Gemm g{(const bf16*)(p.ws + WS_A2), (const bf16*)(p.ws + WS_WOT), T, DM, DM};
      pg8::StaticOrder S; S.init(T, DM, G, bid); EpiRes E{p.in[I_X], p.out};
      pg8::gemm_phase<EpiRes, pg8::StaticOrder, true, true>(lds, g, S, E); }
    xcd_barrier(bar);
    { PH_IDS; for (int vb = bid; vb < NVB; vb += G) r1_router(p, lds, vb, tid, wave, lane); }
    xcd_barrier(bar);
    { PH_IDS; for (int vb = bid; vb < NVB; vb += G) r2_gather(p, lds, vb, vb == 0, tid, wave, lane); }
    xcd_barrier(bar);
    { pg8::Gemm g{(const bf16*)(p.ws + WS_XG8), (const bf16*)(p.ws + WS_W1Q), MAXTILES * 256, 4096, DM / 2};
      MoeOrder S; S.init((const int*)(p.ws + WS_META), 16, G, bid); EpiSwigluI8 E{p.in[I_B1], (const float*)(p.ws + WS_ROWSC), (const float*)(p.ws + WS_WSC1), (bf16*)(p.ws + WS_ACT), (float*)(p.ws + WS_AMAXP)};
      pg8::gemm_phase<EpiSwigluI8, MoeOrder, true, true, true>(lds, g, S, E); }
    xcd_barrier(bar);
    { PH_IDS; ph_actq(p, gw, NGW, lane); }
    xcd_barrier(bar);
    { pg8::Gemm g{(const bf16*)(p.ws + WS_ACT8), (const bf16*)(p.ws + WS_W2Q), MAXTILES * 256, DM, DFF / 2};
      MoeOrder S; S.init((const int*)(p.ws + WS_META), 8, G, bid); EpiDownI8 E{p.in[I_B2], (const float*)(p.ws + WS_ROWW), (const float*)(p.ws + WS_ASC), (const float*)(p.ws + WS_WSC2), (bf16*)(p.ws + WS_Y)};
      pg8::gemm_phase<EpiDownI8, MoeOrder, true, true, true>(lds, g, S, E); }
    xcd_barrier(bar);
    { PH_IDS; pf_final(p, gw, NGW, lane); }
}

extern "C" void kernel_launch(void* const* d_in, const int* in_sizes, int n_in, void* d_out, int out_size, void* d_ws, size_t ws_size, hipStream_t stream) {
    static int grid = 0;
    if (grid == 0) {
        if (n_in != N_IN || out_size != T * DM || ws_size < WS_END) { fprintf(stderr, "kernel_launch: unexpected shapes (n_in %d out %d ws %zu need %zu)\n", n_in, out_size, ws_size, (size_t)WS_END); grid = -1; return; }
        int dev = 0, cus = 0, per_cu = 0;
        if (hipGetDevice(&dev) != hipSuccess || hipDeviceGetAttribute(&cus, hipDeviceAttributeMultiprocessorCount, dev) != hipSuccess) { grid = -1; return; }
        if (hipFuncSetAttribute((const void*)mega_fwd, hipFuncAttributeMaxDynamicSharedMemorySize, LDS_BYTES) != hipSuccess) { fprintf(stderr, "kernel_launch: hipFuncSetAttribute failed\n"); grid = -1; return; }
        if (hipOccupancyMaxActiveBlocksPerMultiprocessor(&per_cu, (const void*)mega_fwd, 512, LDS_BYTES) != hipSuccess || per_cu < 1) { fprintf(stderr, "kernel_launch: occupancy query says %d blocks per CU\n", per_cu); }
        (void)hipGetLastError();
        grid = cus;
    }
    if (grid < 0) return;
    if (hipMemsetAsync((char*)d_ws + WS_CTL, 0, CTL_BYTES, stream) != hipSuccess) return;
    Params p{};
    for (int i = 0; i < N_IN; ++i) p.in[i] = (const float*)d_in[i];
    p.out = (float*)d_out; p.ws = (unsigned char*)d_ws;
    hipLaunchKernelGGL(mega_fwd, dim3(grid), dim3(512), LDS_BYTES, stream, p);
}
```

```cpp
#include <hip/hip_runtime.h>
#include <cstdio>
#include <cstdint>
namespace pg8 {
#define PG8_LAS __attribute__((address_space(3)))
typedef unsigned short bf16_t;
typedef short bf16x8 __attribute__((ext_vector_type(8)));
typedef float f32x4 __attribute__((ext_vector_type(4)));
typedef unsigned u32x4 __attribute__((ext_vector_type(4)));
constexpr int BM = 256, BK = 64, HALF = 128, HTB = HALF * BK * 2  , STAGE_BYTES = 8 * HTB, NXCD = 8, WGM = 8;

__host__ __device__ __forceinline__ int lds_byte(int r, int c) { const int st = (r >> 4) * 2 + (c >> 5), rr = r & 15, cc = c & 31, ob = rr * 64 + cc * 2; return st * 1024 + (ob ^ (((ob >> 9) & 1) << 5)); }
__host__ __device__ __forceinline__ void stage_rc(int b, int& R, int& C) { const int st = b / 1024, sb = b % 1024, swz = sb ^ (((sb >> 9) & 1) << 5); R = (st >> 1) * 16 + swz / 64; C = (st & 1) * 32 + (swz % 64) / 2; }
__host__ __device__ __forceinline__ int perm32(int rho) { const int n = rho >> 4, i = rho & 15; return 8 * (i >> 2) + 4 * n + (i & 3); }

struct Unit { int pm, pn, kind; };
struct Gemm { const bf16_t* A; const bf16_t* Bt; int M, N, K; };

__host__ __device__ __forceinline__ void tile_of(int wgid, int nM, int nN, int& pm, int& pn) {
    const int nwg = nM * nN;
    { const int q = nwg / NXCD, r = nwg % NXCD, xcd = wgid % NXCD, off = wgid / NXCD; wgid = (xcd < r ? xcd * (q + 1) : r * (q + 1) + (xcd - r) * q) + off; }
    const int nig = WGM * nN, gid = wgid / nig, fm = gid * WGM, gsz = (nM - fm) < WGM ? (nM - fm) : WGM;
    pm = fm + ((wgid % nig) % gsz); pn = (wgid % nig) / gsz;
}
struct StaticOrder {
    int nM, nN, nwg, G, c;
    __host__ __device__ void init(int M, int N, int G_, int c_) { nM = M / BM; nN = N / BM; nwg = nM * nN; G = G_; c = c_; }
    __device__ __forceinline__ bool next(int i, Unit& u) const {
        const long L = (long)i * G + c; if (L >= nwg) return false;
        tile_of((int)L, nM, nN, u.pm, u.pn); u.kind = 0; return true;
    }
    __device__ __forceinline__ const char* pa(const Gemm& g, const Unit& u) const { return (const char*)g.A + (size_t)u.pm * ((size_t)BM * g.K * 2); }
    __device__ __forceinline__ const char* pb(const Gemm& g, const Unit& u) const { return (const char*)g.Bt + (size_t)u.pn * ((size_t)BM * g.K * 2); }
    __device__ __forceinline__ void a_ready(const Unit&) const {}
    __device__ __forceinline__ void done(const Unit&) const {}
};
__device__ __forceinline__ unsigned cvt_pk_bf16(float lo, float hi) { unsigned r; asm volatile("v_cvt_pk_bf16_f32 %0, %1, %2" : "=v"(r) : "v"(lo), "v"(hi)); return r; }
template <bool I8> __device__ __forceinline__ f32x4 mma16(bf16x8 a, bf16x8 b, f32x4 c) {
    if constexpr (I8) { typedef int i32x4 __attribute__((ext_vector_type(4)));
        return __builtin_bit_cast(f32x4, __builtin_amdgcn_mfma_i32_16x16x64_i8(__builtin_bit_cast(i32x4, a), __builtin_bit_cast(i32x4, b), __builtin_bit_cast(i32x4, c), 0, 0, 0)); }
    else return __builtin_amdgcn_mfma_f32_16x16x32_bf16(a, b, c, 0, 0, 0);
}
template <class Epi, class Sched, bool ALIGN_EPI = false, bool SP2 = false, bool I8 = false>
__device__ __forceinline__ void gemm_phase(PG8_LAS unsigned char* lds, const Gemm g, const Sched& S, const Epi& E) {
    int tid_l = threadIdx.x; asm volatile("" : "+v"(tid_l));
    const int tid = tid_l, wid = __builtin_amdgcn_readfirstlane(tid >> 6), lane = tid & 63, wr = wid >> 2, wc = wid & 3, fr = lane & 15, fq = lane >> 4;
    const int K = g.K, nt = K / BK;
    unsigned voffA[2], voffB[2];
#pragma unroll
    for (int i = 0; i < 2; ++i) { int R, C; stage_rc(tid * 16 + i * 8192, R, C); const int Rb = Epi::PERM ? ((R & ~31) + perm32(R & 31)) : R;
        voffA[i] = (unsigned)(R * K + C) * 2u; voffB[i] = (unsigned)(Rb * K + C) * 2u; }
    const size_t kstep = (size_t)(BK * 2);
    const size_t hstep = (size_t)HALF * K * 2;
    const unsigned ldsw = (unsigned)wid * 1024u;
    const int aoff = lds_byte(wr * 64 + fr, fq * 8), boff = lds_byte(wc * 32 + fr, fq * 8);
#define PG8_SA(b, h) (((b) * 2 + (h)) * HTB)
#define PG8_SB(b, h) ((4 + (b) * 2 + (h)) * HTB)
#define PG8_STAGE(bufoff, gbase, voff) do { _Pragma("unroll") for (int _i = 0; _i < 2; ++_i) \
        __builtin_amdgcn_global_load_lds((const unsigned*)((const char*)(gbase) + (voff)[_i]), (PG8_LAS unsigned*)(lds + (bufoff) + ldsw + _i * 8192), 16, 0, 0); } while (0)
#define PG8_LDA(dst, b, h) do { _Pragma("unroll") for (int m = 0; m < 4; ++m) _Pragma("unroll") for (int k = 0; k < 2; ++k) dst[m][k] = *(const PG8_LAS bf16x8*)(lds + PG8_SA(b, h) + aoff + m * 2048 + k * 1024); } while (0)
#define PG8_LDB(dst, b, h) do { _Pragma("unroll") for (int n = 0; n < 2; ++n) _Pragma("unroll") for (int k = 0; k < 2; ++k) dst[n][k] = *(const PG8_LAS bf16x8*)(lds + PG8_SB(b, h) + boff + n * 2048 + k * 1024); } while (0)
#define PG8_MMA(ai, bj, At, Bt) do { __builtin_amdgcn_s_setprio(1); _Pragma("unroll") for (int m = 0; m < 4; ++m) _Pragma("unroll") for (int n = 0; n < 2; ++n) _Pragma("unroll") for (int k = 0; k < 2; ++k) \
        acc[ai][bj][m][n] = mma16<I8>(Bt[n][k], At[m][k], acc[ai][bj][m][n]); __builtin_amdgcn_s_setprio(0); } while (0)
#define PG8_WAIT_V(n) asm volatile("s_waitcnt vmcnt(" #n ")" ::: "memory")
#define PG8_WAIT_L(n) asm volatile("s_waitcnt lgkmcnt(" #n ")" ::: "memory")
#define PG8_BAR __builtin_amdgcn_s_barrier()
#define PG8_SCHED __builtin_amdgcn_sched_barrier(0)
    Unit cur, nxt; int ui = 0;
    if (!S.next(0, cur)) return;
    f32x4 acc[2][2][4][2];
#pragma unroll
    for (int a = 0; a < 2; ++a)
#pragma unroll
        for (int b = 0; b < 2; ++b)
#pragma unroll
            for (int m = 0; m < 4; ++m)
#pragma unroll
                for (int n = 0; n < 2; ++n) acc[a][b][m][n] = (f32x4){0.f, 0.f, 0.f, 0.f};
    bf16x8 At[4][2], B0[2][2], B1[2][2];
    const char* cA = S.pa(g, cur); const char* cB = S.pb(g, cur);
    S.a_ready(cur);
    if constexpr (SP2) {
        PG8_STAGE(PG8_SB(0, 0), cB, voffB); PG8_STAGE(PG8_SB(0, 1), cB + hstep, voffB); PG8_STAGE(PG8_SA(0, 0), cA, voffA); PG8_STAGE(PG8_SA(0, 1), cA + hstep, voffA);
        if (wr == 1) PG8_BAR;
        PG8_WAIT_V(2); PG8_BAR;
        PG8_STAGE(PG8_SB(1, 0), cB + kstep, voffB); PG8_STAGE(PG8_SA(1, 0), cA + kstep, voffA); PG8_STAGE(PG8_SB(1, 1), cB + hstep + kstep, voffB);
        PG8_WAIT_V(6); PG8_BAR;
    } else {
        PG8_STAGE(PG8_SB(0, 0), cB, voffB); PG8_STAGE(PG8_SA(0, 0), cA, voffA); PG8_STAGE(PG8_SB(0, 1), cB + hstep, voffB); PG8_STAGE(PG8_SA(0, 1), cA + hstep, voffA);
        if (wr == 1) PG8_BAR;
        PG8_WAIT_V(4); PG8_BAR;
        PG8_STAGE(PG8_SB(1, 0), cB + kstep, voffB); PG8_STAGE(PG8_SA(1, 0), cA + kstep, voffA); PG8_STAGE(PG8_SB(1, 1), cB + hstep + kstep, voffB);
        PG8_WAIT_V(6); PG8_BAR;
    }
    for (;;) {
        const bool has_next = S.next(ui + 1, nxt);
        const char* nA = has_next ? S.pa(g, nxt) : cA; const char* nB = has_next ? S.pb(g, nxt) : cB;
        for (int t = 0; t < nt; t += 2) {
            const bool last = (t == nt - 2);
            const char* a1 = cA + (size_t)(t + 1) * kstep;
            const char* a2 = last ? nA : cA + (size_t)(t + 2) * kstep; const char* b2 = last ? nB : cB + (size_t)(t + 2) * kstep;
            const char* a3 = a2 + kstep; const char* b3 = b2 + kstep;
            if (last && has_next) S.a_ready(nxt);
            if constexpr (SP2) {
            PG8_LDB(B0, 0, 0); PG8_LDB(B1, 0, 1); PG8_SCHED; PG8_LDA(At, 0, 0); PG8_STAGE(PG8_SA(1, 1), a1 + hstep, voffA);
            PG8_WAIT_V(8); PG8_WAIT_L(0); PG8_BAR; PG8_MMA(0, 0, At, B0); PG8_MMA(0, 1, At, B1); PG8_BAR; PG8_SCHED;
            PG8_LDA(At, 0, 1); PG8_STAGE(PG8_SB(0, 0), b2, voffB); PG8_STAGE(PG8_SB(0, 1), b2 + hstep, voffB); PG8_STAGE(PG8_SA(0, 0), a2, voffA);
            PG8_WAIT_V(8); PG8_WAIT_L(0); PG8_BAR; PG8_MMA(1, 0, At, B0); PG8_MMA(1, 1, At, B1); PG8_BAR; PG8_SCHED;
            PG8_LDB(B0, 1, 0); PG8_LDB(B1, 1, 1); PG8_SCHED; PG8_LDA(At, 1, 0); PG8_STAGE(PG8_SA(0, 1), a2 + hstep, voffA);
            PG8_WAIT_V(8); PG8_WAIT_L(0); PG8_BAR; PG8_MMA(0, 0, At, B0); PG8_MMA(0, 1, At, B1); PG8_BAR; PG8_SCHED;
            PG8_LDA(At, 1, 1); PG8_STAGE(PG8_SB(1, 0), b3, voffB); PG8_STAGE(PG8_SB(1, 1), b3 + hstep, voffB); PG8_STAGE(PG8_SA(1, 0), a3, voffA);
            PG8_WAIT_V(8); PG8_WAIT_L(0); PG8_BAR; PG8_MMA(1, 0, At, B0); PG8_MMA(1, 1, At, B1); PG8_BAR; PG8_SCHED;
            } else {
            PG8_LDB(B0, 0, 0); PG8_SCHED; PG8_LDA(At, 0, 0); PG8_STAGE(PG8_SA(1, 1), a1 + hstep, voffA);
            PG8_WAIT_L(8); PG8_BAR; PG8_WAIT_L(0); PG8_MMA(0, 0, At, B0); PG8_BAR; PG8_SCHED;
            PG8_LDB(B1, 0, 1); PG8_STAGE(PG8_SB(0, 0), b2, voffB);
            PG8_BAR; PG8_WAIT_L(0); PG8_MMA(0, 1, At, B1); PG8_BAR;
            PG8_LDA(At, 0, 1); PG8_STAGE(PG8_SA(0, 0), a2, voffA);
            PG8_BAR; PG8_WAIT_L(0); PG8_MMA(1, 0, At, B0); PG8_BAR; PG8_SCHED;
            PG8_STAGE(PG8_SB(0, 1), b2 + hstep, voffB);
            PG8_WAIT_V(6); PG8_BAR; PG8_MMA(1, 1, At, B1); PG8_BAR;
            PG8_LDB(B0, 1, 0); PG8_SCHED; PG8_LDA(At, 1, 0); PG8_STAGE(PG8_SA(0, 1), a2 + hstep, voffA);
            PG8_WAIT_L(8); PG8_BAR; PG8_WAIT_L(0); PG8_MMA(0, 0, At, B0); PG8_BAR; PG8_SCHED;
            PG8_LDB(B1, 1, 1); PG8_STAGE(PG8_SB(1, 0), b3, voffB);
            PG8_BAR; PG8_WAIT_L(0); PG8_MMA(0, 1, At, B1); PG8_BAR;
            PG8_LDA(At, 1, 1); PG8_STAGE(PG8_SA(1, 0), a3, voffA);
            PG8_BAR; PG8_WAIT_L(0); PG8_MMA(1, 0, At, B0); PG8_BAR; PG8_SCHED;
            PG8_STAGE(PG8_SB(1, 1), b3 + hstep, voffB);
            PG8_WAIT_V(6); PG8_BAR; PG8_MMA(1, 1, At, B1); PG8_BAR;
            }
        }
        if constexpr (ALIGN_EPI) { if (wr == 0) PG8_BAR; }
        if constexpr (!Epi::AFTER_DRAIN) { E(acc, cur, wr, wc, fr, fq); S.done(cur); }
        if (!has_next) break;
#pragma unroll
        for (int a = 0; a < 2; ++a)
#pragma unroll
            for (int b = 0; b < 2; ++b)
#pragma unroll
                for (int m = 0; m < 4; ++m)
#pragma unroll
                    for (int n = 0; n < 2; ++n) acc[a][b][m][n] = (f32x4){0.f, 0.f, 0.f, 0.f};
        cur = nxt; cA = nA; cB = nB; ++ui;
        if constexpr (ALIGN_EPI) { if (wr == 1) PG8_BAR; }
    }
    PG8_WAIT_V(0);
    if constexpr (!ALIGN_EPI) { if (wr == 0) PG8_BAR; }
    PG8_BAR;
    if constexpr (Epi::AFTER_DRAIN) { E.fused(acc, cur, wr, wc, fr, fq, lds, wid, lane); S.done(cur); }
#undef PG8_SA
#undef PG8_SB
#undef PG8_STAGE
#undef PG8_LDA
#undef PG8_LDB
#undef PG8_MMA
#undef PG8_WAIT_V
#undef PG8_WAIT_L
#undef PG8_BAR
#undef PG8_SCHED
}
}

#define GAS __attribute__((address_space(1)))
#define LAS __attribute__((address_space(3)))
typedef unsigned short bf16;
typedef unsigned v4u __attribute__((ext_vector_type(4)));
typedef unsigned v2u __attribute__((ext_vector_type(2)));
typedef float f32x4 __attribute__((ext_vector_type(4)));
typedef short bf16x8 __attribute__((ext_vector_type(8)));

constexpr int NB = 8, SEQ = 4096, DM = 2048, T = NB * SEQ;
constexpr int NPT = 23;
constexpr int NE = 32, DFF = 2048;
constexpr int MAXTILES = 544;
constexpr float RMS_EPS = 1e-5f;
constexpr int NVB = 256, TPV = T / NVB;

enum { I_X = 0, I_NMIX, I_WIN, I_WA2, I_BA, I_GLAG, I_PEK, I_WK1, I_WK2, I_PEV, I_WV1, I_WV2, I_NSAG, I_RELB, I_WOUT, I_NFFN, I_RW, I_RB, I_W1, I_B1, I_W2, I_B2, I_NFIN, N_IN };

constexpr size_t MiB = 1u << 20;
constexpr size_t al(size_t x) { return (x + 255) & ~(size_t)255; }
constexpr size_t WS_CTL = 0, CTL_BYTES = 1 * MiB;
constexpr size_t WS_CNT = WS_CTL + CTL_BYTES;
constexpr size_t WS_META = WS_CNT + al(NVB * 32 * 4);
constexpr size_t WS_EIDX = WS_META + al((64 + MAXTILES) * 4);
constexpr size_t WS_LRNK = WS_EIDX + al((size_t)T * 4 * 4);
constexpr size_t WS_GATE = WS_LRNK + al((size_t)T * 4 * 4);
constexpr size_t WS_POS = WS_GATE + al((size_t)T * 4 * 4);
constexpr size_t WS_ROWW = WS_POS + al((size_t)T * 4 * 4);
constexpr size_t WS_WINT = al(WS_ROWW + (size_t)MAXTILES * 256 * 4);
constexpr size_t WS_WOT = WS_WINT + (size_t)NPT * 256 * DM * 2;
constexpr size_t WS_WKCT = WS_WOT + (size_t)DM * DM * 2;
constexpr size_t WS_WVCT = WS_WKCT + (size_t)256 * 2048 * 2;
constexpr size_t WS_W1T = WS_WVCT + (size_t)256 * 2048 * 2;
constexpr size_t WS_W2T = WS_W1T + (size_t)NE * 4096 * DM * 2;
constexpr size_t WS_XN = WS_W2T + (size_t)NE * DM * DFF * 2;
constexpr size_t WS_GQ = WS_XN + (size_t)T * DM * 2;
constexpr size_t WS_GK = WS_GQ + (size_t)T * 512 * 2;
constexpr size_t WS_GV = WS_GK + (size_t)T * 512 * 2;
constexpr size_t WS_GG = WS_GV + (size_t)T * 1024 * 2;
constexpr size_t WS_NQ = WS_GG + (size_t)T * 1024 * 2;
constexpr size_t WS_KC = WS_NQ + (size_t)T * 1024 * 2;
constexpr size_t WS_VC = WS_KC + (size_t)T * 256 * 2;
constexpr size_t WS_KS = WS_VC + (size_t)T * 256 * 2;
constexpr size_t WS_KW = WS_KS + (size_t)T * 256 * 2;
constexpr size_t WS_VST = WS_KW + (size_t)T * 256 * 2;
constexpr size_t WS_VWT = WS_VST + (size_t)T * 256 * 2;
constexpr size_t WS_SM = WS_VWT + (size_t)T * 256 * 2;
constexpr size_t WS_LA = WS_SM + (size_t)T * 64 * 2;
constexpr size_t WS_OG = WS_LA + (size_t)T * 512 * 4;
constexpr size_t WS_ON = WS_OG + (size_t)T * 1024 * 4;
constexpr size_t WS_KCMP = WS_ON + (size_t)T * 1024 * 4;
constexpr size_t WS_VCMPT = WS_KCMP + (size_t)16 * 256 * 128 * 2;
constexpr size_t WS_A2 = WS_VCMPT + (size_t)16 * 256 * 128 * 2;
constexpr size_t WS_HN = WS_A2 + (size_t)T * DM * 2;
constexpr size_t WS_XG = WS_HN + (size_t)T * DM * 2;
constexpr size_t WS_ACT = WS_XG + (size_t)MAXTILES * 256 * DM * 2;
constexpr size_t WS_END = WS_ACT + (size_t)MAXTILES * 256 * DFF * 2;

__device__ __forceinline__ unsigned f2bf(float f) { unsigned u = __builtin_bit_cast(unsigned, f); return (u + 0x7fffu + ((u >> 16) & 1u)) >> 16; }
__device__ __forceinline__ unsigned pk2(float lo, float hi) { return f2bf(lo) | (f2bf(hi) << 16); }
__device__ __forceinline__ float bf2f(unsigned short v) { return __builtin_bit_cast(float, (unsigned)v << 16); }
__device__ __forceinline__ float bflo(unsigned w) { return __builtin_bit_cast(float, w << 16); }
__device__ __forceinline__ float bfhi(unsigned w) { return __builtin_bit_cast(float, w & 0xffff0000u); }
__device__ __forceinline__ float wave_sum(float v) {
#pragma unroll
    for (int o = 1; o < 64; o <<= 1) v += __shfl_xor(v, o);
    return v;
}
__device__ __forceinline__ float wave_max(float v) {
#pragma unroll
    for (int o = 1; o < 64; o <<= 1) v = fmaxf(v, __shfl_xor(v, o));
    return v;
}
#define LDS_WAIT() asm volatile("s_waitcnt lgkmcnt(0)" ::: "memory")

__device__ const unsigned char kBucket[128] = {0, 1, 2, 3, 4, 5, 6, 7, 8, 9, 10, 11, 12, 13, 14, 15, 16, 16, 16, 17, 17, 18, 18, 18, 19, 19, 19, 20, 20, 20, 20, 21, 21, 21, 21, 22, 22, 22, 22, 22, 23, 23, 23, 23, 23, 23, 24, 24, 24, 24, 24, 24, 25, 25, 25, 25, 25, 25, 25, 26, 26, 26, 26, 26, 26, 26, 26, 27, 27, 27, 27, 27, 27, 27, 27, 27, 27, 28, 28, 28, 28, 28, 28, 28, 28, 28, 28, 29, 29, 29, 29, 29, 29, 29, 29, 29, 29, 29, 29, 30, 30, 30, 30, 30, 30, 30, 30, 30, 30, 30, 30, 30, 30, 31, 31, 31, 31, 31, 31, 31, 31, 31, 31, 31, 31, 31, 31, 31};

struct Params {
    const float* in[N_IN];
    float* out;
    unsigned char* ws;
};

template <class F>
__device__ __forceinline__ void transpose_item(const float* W, int ldw, int k0, int n0, int nlim, LAS float* scr, int lane, F dst) {
#pragma unroll 8
    for (int i = 0; i < 32; ++i) { const int kk = 2 * i + (lane >> 5); const int n = n0 + (lane & 31); scr[kk * 33 + (lane & 31)] = n < nlim ? W[(size_t)(k0 + kk) * ldw + n] : 0.f; }
    LDS_WAIT(); asm volatile("" ::: "memory");
    const int c = lane & 7;
#pragma unroll
    for (int j = 0; j < 4; ++j) { const int nn = (lane >> 3) + 8 * j; const int n = n0 + nn; const LAS float* s = scr + (8 * c) * 33 + nn;
        bf16* rowp; float sc;
        if (n < nlim && dst(n, rowp, sc)) {
            v4u o; o.x = pk2(s[0 * 33] * sc, s[1 * 33] * sc); o.y = pk2(s[2 * 33] * sc, s[3 * 33] * sc); o.z = pk2(s[4 * 33] * sc, s[5 * 33] * sc); o.w = pk2(s[6 * 33] * sc, s[7 * 33] * sc);
            *(v4u*)(rowp + 8 * c) = o; } }
    LDS_WAIT(); asm volatile("" ::: "memory");
}
__device__ __forceinline__ int win_row(int n, float& sc) {
    sc = 1.f;
    if (n < 512) { sc = 0.08838834764831845f; return n; }
    if (n < 1024) return n;
    if (n < 2048) return n;
    if (n < 3072) return n;
    if (n < 3088) return 5120 + (n - 3072);
    if (n < 4112) { sc = 0.08838834764831845f; return 3072 + (n - 3088); }
    if (n < 4368) return 4096 + (n - 4112);
    if (n < 4624) return 4352 + (n - 4368);
    if (n < 4880) return 4608 + (n - 4624);
    if (n < 5136) return 5376 + (n - 4880);
    if (n < 5392) return 4864 + (n - 5136);
    if (n < 5648) return 5632 + (n - 5392);
    return 5136 + (n - 5648);
}
constexpr size_t WS_PEVP = WS_W2T;
__device__ __forceinline__ void p0_prologue(const Params& p, LAS unsigned char* lds, int gw, int NGW, int wave, int lane) {
    LAS float* scr = (LAS float*)(lds + wave * 16384);
    bf16* WinT = (bf16*)(p.ws + WS_WINT); bf16* WoT = (bf16*)(p.ws + WS_WOT); bf16* WkcT = (bf16*)(p.ws + WS_WKCT); bf16* WvcT = (bf16*)(p.ws + WS_WVCT);
    bf16* W1T = (bf16*)(p.ws + WS_W1T); bf16* W2T = (bf16*)(p.ws + WS_W2T);
    constexpr int I_IN = 32 * 178, I_O = 32 * 64, I_C = 64 * 4, I_E1 = 32 * 128, I_E2 = 32 * 64;
    constexpr int I_PE = 2 * 64;
    constexpr int NITEMS = I_O + 2 * I_C + I_PE;
    (void)I_IN; (void)WinT;
    for (int it = gw; it < NITEMS; it += NGW) {
        int r = it;
        if (r < I_O) { const int kb = r / 64, nb = r % 64, k0 = kb * 64;
            transpose_item(p.in[I_WOUT], DM, k0, nb * 32, DM, scr, lane, [&](int n, bf16*& rowp, float& sc) { sc = 1.f; rowp = WoT + (size_t)n * DM + k0; return true; }); continue; } r -= I_O;
        if (r >= 2 * I_C) { r -= 2 * I_C; const int which = r >> 6, kq = r & 63; const float* pe = p.in[which ? I_PEV : I_PEK] + kq * 64; const float* w1 = p.in[which ? I_WV1 : I_WK1] + (size_t)kq * 64 * 128 + lane;
            float a0 = 0.f, a1 = 0.f;
#pragma unroll
            for (int k = 0; k < 64; ++k) { const float pv = pe[k]; a0 += pv * w1[k * 128]; a1 += pv * w1[k * 128 + 64]; }
            float* dst = (float*)(p.ws + WS_PEVP) + (size_t)(which * 64 + kq) * 128 + lane; dst[0] = a0; dst[64] = a1; continue; }
        { const int which = r / I_C; r %= I_C; const int kb = r / 4, nb = r % 4, k0 = kb * 64;
            bf16* dstm = which ? WvcT : WkcT;
            transpose_item(p.in[which ? I_WV1 : I_WK1], 128, k0, nb * 32, 128, scr, lane, [&](int n, bf16*& rowp, float& sc) { sc = 1.f; rowp = dstm + (size_t)(n + (k0 >= 2048 ? 128 : 0)) * 2048 + (k0 & 2047); return true; }); }
        (void)I_E1; (void)I_E2; (void)W1T; (void)W2T;
    }
    const float* x = p.in[I_X]; const float* gm = p.in[I_NMIX];
    for (int m = gw; m < T; m += NGW) {
        const f32x4* xr = (const f32x4*)(x + (size_t)m * DM) + lane; f32x4 v[8]; float s = 0.f;
#pragma unroll
        for (int j = 0; j < 8; ++j) { v[j] = xr[64 * j]; s += (v[j].x * v[j].x + v[j].y * v[j].y) + (v[j].z * v[j].z + v[j].w * v[j].w); }
        const float rstd = 1.f / sqrtf(wave_sum(s) * (1.f / DM) + RMS_EPS);
        float mxr = 0.f;
#pragma unroll
        for (int j = 0; j < 8; ++j) { const f32x4 g4 = ((const f32x4*)gm)[lane + 64 * j]; v[j].x *= rstd * g4.x; v[j].y *= rstd * g4.y; v[j].z *= rstd * g4.z; v[j].w *= rstd * g4.w;
            mxr = fmaxf(mxr, fmaxf(fmaxf(fabsf(v[j].x), fabsf(v[j].y)), fmaxf(fabsf(v[j].z), fabsf(v[j].w)))); }
        mxr = wave_max(mxr); const float qs = mxr > 0.f ? mxr * (1.f / 127.f) : 1.f, qi = 1.f / qs;
        unsigned* o4 = (unsigned*)(p.ws + WS_XN + (size_t)m * DM) + lane;
#pragma unroll
        for (int j = 0; j < 8; ++j) { const int q0 = (int)rintf(v[j].x * qi), q1 = (int)rintf(v[j].y * qi), q2 = (int)rintf(v[j].z * qi), q3 = (int)rintf(v[j].w * qi);
            o4[64 * j] = ((unsigned)q0 & 0xffu) | (((unsigned)q1 & 0xffu) << 8) | (((unsigned)q2 & 0xffu) << 16) | (((unsigned)q3 & 0xffu) << 24); }
        if (lane == 0) ((float*)(p.ws + WS_XN + (size_t)T * DM))[m] = qs;
    }
}
#define XB_TMO      128
#define XB_XCNT(j)  (256  + 64 * (j))
#define XB_XSUB(j)  (1280 + 64 * (j))
#define XB_XGEN(j)  (2304 + 64 * (j))
#define XB_TOP      3328
#define XB_TOPGEN   3392
#define XCD_BAR_WORDS 3456
#define XB_SPIN_CAP (1u << 18)

__device__ __forceinline__ unsigned xb_ld(unsigned* p)              { return __hip_atomic_load(p, __ATOMIC_RELAXED, __HIP_MEMORY_SCOPE_AGENT); }
__device__ __forceinline__ unsigned xb_add(unsigned* p, unsigned v) { return __hip_atomic_fetch_add(p, v, __ATOMIC_RELAXED, __HIP_MEMORY_SCOPE_AGENT); }
__device__ __forceinline__ unsigned xb_xcc_id() { return (unsigned)__builtin_amdgcn_s_getreg((3 << 11) | 20) & 0xFu; }
#define XB_SPIN(cond, bar) do { unsigned _sp = 0; while (cond) { __builtin_amdgcn_s_sleep(1); \
    if ((++_sp & 255u) == 0u) { if (xb_ld(&(bar)[XB_TMO])) break; if (_sp > XB_SPIN_CAP) { atomicAdd(&(bar)[XB_TMO], 1u); break; } } } } while (0)

struct XcdBarrier {
    unsigned* bar; unsigned x;
    volatile LAS unsigned* st;
};

__device__ __forceinline__ XcdBarrier xcd_barrier_post(unsigned* bar, volatile LAS unsigned* st) {
    XcdBarrier b; b.bar = bar; b.x = xb_xcc_id(); b.st = st;
    if (threadIdx.x == 0) (void)xb_add(&bar[XB_XCNT(b.x)], 1u);
    return b;
}
__device__ __forceinline__ void xcd_barrier_complete(unsigned* bar, unsigned x, unsigned& nloc, unsigned& nx) {
    const unsigned G = gridDim.x * gridDim.y * gridDim.z;
    unsigned sum, cnt, mine, sp = 0u;
    for (;;) {
        sum = 0u; cnt = 0u; mine = 0u;
#pragma unroll
        for (unsigned j = 0; j < 16; ++j) { const unsigned c = xb_ld(&bar[XB_XCNT(j)]); sum += c; cnt += (c > 0u) ? 1u : 0u; mine = (j == x) ? c : mine; }
        if (sum == G) break;
        __builtin_amdgcn_s_sleep(1);
        if ((++sp & 255u) == 0u) { if (xb_ld(&bar[XB_TMO])) break; if (sp > XB_SPIN_CAP) { atomicAdd(&bar[XB_TMO], 1u); break; } }
    }
    nloc = mine > 0u ? mine : 1u; nx = cnt > 0u ? cnt : 1u;
}

__device__ __forceinline__ void xcd_barrier(const XcdBarrier& b) {
    asm volatile("s_waitcnt vmcnt(0)" ::: "memory");
    __syncthreads();
    if (threadIdx.x == 0) {
        unsigned* bar = b.bar;
        __builtin_amdgcn_s_waitcnt(0);
        unsigned nloc = b.st[0], nx = b.st[1];
        if (nloc == 0u) { xcd_barrier_complete(bar, b.x, nloc, nx); b.st[0] = nloc; b.st[1] = nx; }
        const unsigned old = xb_add(&bar[XB_XSUB(b.x)], 1u);
        const unsigned gen = old / nloc;
        if (old + 1u == (gen + 1u) * nloc) {
            __builtin_amdgcn_fence(__ATOMIC_RELEASE, "agent");
            asm volatile("s_waitcnt vmcnt(0)" ::: "memory");
            const unsigned og = xb_add(&bar[XB_TOP], 1u);
            const unsigned tg = og / nx;
            if (og + 1u == (tg + 1u) * nx) xb_add(&bar[XB_TOPGEN], 1u);
            else XB_SPIN(xb_ld(&bar[XB_TOPGEN]) == tg, bar);
            __builtin_amdgcn_fence(__ATOMIC_ACQUIRE, "agent");
            xb_add(&bar[XB_XGEN(b.x)], 1u);
            asm volatile("s_waitcnt vmcnt(0)" ::: "memory");
        } else {
            XB_SPIN(xb_ld(&bar[XB_XGEN(b.x)]) == gen, bar);
            __builtin_amdgcn_fence(__ATOMIC_ACQUIRE, "agent");
            asm volatile("s_waitcnt vmcnt(0)" ::: "memory");
        }
    }
    __syncthreads();
}

struct ProjOrder : pg8::StaticOrder {
    const bf16* xn; const bf16* wt;
    __device__ __forceinline__ bool next(int i, pg8::Unit& u) const { if (!pg8::StaticOrder::next(i, u)) return false; u.kind = (u.pn >= 21) ? 1 : 0; return true; }
    __device__ __forceinline__ const char* pa(const pg8::Gemm& g, const pg8::Unit& u) const { return u.kind ? (const char*)wt + (size_t)u.pn * ((size_t)256 * g.K * 2) : (const char*)xn + (size_t)u.pm * ((size_t)256 * g.K * 2); }
    __device__ __forceinline__ const char* pb(const pg8::Gemm& g, const pg8::Unit& u) const { return u.kind ? (const char*)xn + (size_t)u.pm * ((size_t)256 * g.K * 2) : (const char*)wt + (size_t)u.pn * ((size_t)256 * g.K * 2); }
};
struct EpiProj {
    static constexpr bool PERM = true, AFTER_DRAIN = false;
    unsigned char* ws;
    __device__ __forceinline__ void operator()(const pg8::f32x4 (&acc)[2][2][4][2], const pg8::Unit& u, int wr, int wc, int fr, int fq) const {
        const int cw = wc * 32 + 8 * fq;
        if (u.kind == 0) {
            const int tn = u.pn; bf16* base; size_t bjs = 128; int ld = 0; bool headmajor = false; bool small = false;
            if (tn < 2) { base = (bf16*)(ws + WS_GQ) + tn * 256; ld = 512; }
            else if (tn < 4) { base = (bf16*)(ws + WS_GK) + (tn - 2) * 256; ld = 512; }
            else if (tn < 8) { base = (bf16*)(ws + WS_GV) + (tn - 4) * 256; ld = 1024; }
            else if (tn < 12) { base = (bf16*)(ws + WS_GG) + (tn - 8) * 256; ld = 1024; }
            else if (tn < 16) { base = (bf16*)(ws + WS_NQ) + (tn - 12) * 256; ld = 1024; }
            else if (tn < 20) { base = (bf16*)(ws + (tn == 16 ? WS_KC : tn == 17 ? WS_VC : tn == 18 ? WS_KS : WS_KW)); headmajor = true; bjs = (size_t)SEQ * 128; }
            else { base = (bf16*)(ws + WS_SM); ld = 64; small = true; }
            if (small && wc >= 2) return;
#pragma unroll
            for (int ai = 0; ai < 2; ++ai)
#pragma unroll
                for (int m = 0; m < 4; ++m) { const int r = u.pm * 256 + ai * 128 + wr * 64 + m * 16 + fr;
                    const size_t rterm = headmajor ? ((size_t)(r >> 12) * 2 * SEQ + (r & (SEQ - 1))) * 128 : (size_t)r * ld;
#pragma unroll
                    for (int bj = 0; bj < 2; ++bj) { if (small && bj) continue;
                        const pg8::f32x4 v0 = acc[ai][bj][m][0], v1 = acc[ai][bj][m][1];
                        pg8::u32x4 w; w.x = pg8::cvt_pk_bf16(v0[0], v0[1]); w.y = pg8::cvt_pk_bf16(v0[2], v0[3]); w.z = pg8::cvt_pk_bf16(v1[0], v1[1]); w.w = pg8::cvt_pk_bf16(v1[2], v1[3]);
                        *(pg8::u32x4*)(base + rterm + bj * bjs + cw) = w; } }
        } else {
            bf16* base = (bf16*)(ws + (u.pn == 21 ? WS_VST : WS_VWT));
#pragma unroll
            for (int ai = 0; ai < 2; ++ai)
#pragma unroll
                for (int m = 0; m < 4; ++m) { const int dh = wr * 64 + m * 16 + fr;
#pragma unroll
                    for (int bj = 0; bj < 2; ++bj) { const int tok = u.pm * 256 + bj * 128 + cw; const int b = tok >> 12, s = tok & (SEQ - 1);
                        const pg8::f32x4 v0 = acc[ai][bj][m][0], v1 = acc[ai][bj][m][1];
                        pg8::u32x4 w; w.x = pg8::cvt_pk_bf16(v0[0], v0[1]); w.y = pg8::cvt_pk_bf16(v0[2], v0[3]); w.z = pg8::cvt_pk_bf16(v1[0], v1[1]); w.w = pg8::cvt_pk_bf16(v1[2], v1[3]);
                        *(pg8::u32x4*)(base + ((size_t)(b * 2 + ai) * 128 + dh) * SEQ + s) = w; } }
        }
    }
};
struct EpiRes {
    static constexpr bool PERM = false, AFTER_DRAIN = false;
    const float* x; float* h;
    __device__ __forceinline__ void operator()(const pg8::f32x4 (&acc)[2][2][4][2], const pg8::Unit& u, int wr, int wc, int fr, int fq) const {
        const int row0 = u.pm * 256 + wr * 64 + fr, col0 = u.pn * 256 + wc * 32 + 4 * fq;
#pragma unroll
        for (int ai = 0; ai < 2; ++ai)
#pragma unroll
            for (int m = 0; m < 4; ++m) { const size_t off = (size_t)(row0 + ai * 128 + m * 16) * DM + col0;
#pragma unroll
                for (int bj = 0; bj < 2; ++bj)
#pragma unroll
                    for (int n = 0; n < 2; ++n) { const pg8::f32x4 xv = *(const pg8::f32x4*)(x + off + bj * 128 + n * 16); *(pg8::f32x4*)(h + off + bj * 128 + n * 16) = xv + acc[ai][bj][m][n]; } }
    }
};
struct MoeOrder {
    int nM, nN, nwg, G, c; const int* tile_exp;
    __device__ __forceinline__ void init(const int* meta, int nN_, int G_, int c_) { nM = meta[0]; nN = nN_; nwg = nM * nN; G = G_; c = c_; tile_exp = meta + 64; }
    __device__ __forceinline__ bool next(int i, pg8::Unit& u) const {
        const long L = (long)i * G + c; if (L >= nwg) return false;
        pg8::tile_of((int)L, nM, nN, u.pm, u.pn); u.kind = tile_exp[u.pm]; return true;
    }
    __device__ __forceinline__ const char* pa(const pg8::Gemm& g, const pg8::Unit& u) const { return (const char*)g.A + (size_t)u.pm * ((size_t)256 * g.K * 2); }
    __device__ __forceinline__ const char* pb(const pg8::Gemm& g, const pg8::Unit& u) const { return (const char*)g.Bt + ((size_t)u.kind * nN + u.pn) * ((size_t)256 * g.K * 2); }
    __device__ __forceinline__ void a_ready(const pg8::Unit&) const {}
    __device__ __forceinline__ void done(const pg8::Unit&) const {}
};

struct MoeOrderSync : MoeOrder {
    unsigned* xl; unsigned x, nloc; int full_rounds; mutable int calls;
    __device__ __forceinline__ void init_sync(unsigned* xl_, unsigned x_, unsigned nloc_) { xl = xl_; x = x_; nloc = nloc_ ? nloc_ : 1u; full_rounds = nwg / G; calls = 0; }
    __device__ __forceinline__ void a_ready(const pg8::Unit&) const {
        if (calls < full_rounds) {
            if (threadIdx.x == 0) { unsigned* sub = xl + 64 * x; unsigned* genw = xl + 1024 + 64 * x;
                const unsigned old = __hip_atomic_fetch_add(sub, 1u, __ATOMIC_RELAXED, __HIP_MEMORY_SCOPE_AGENT), gen = old / nloc;
                if (old + 1u == (gen + 1u) * nloc) __hip_atomic_fetch_add(genw, 1u, __ATOMIC_RELAXED, __HIP_MEMORY_SCOPE_AGENT);
                else { unsigned sp = 0; while (__hip_atomic_load(genw, __ATOMIC_RELAXED, __HIP_MEMORY_SCOPE_AGENT) == gen) { __builtin_amdgcn_s_sleep(1); if (++sp > (1u << 16)) break; } } }
            asm volatile("" ::: "memory"); __builtin_amdgcn_s_barrier(); asm volatile("" ::: "memory"); }
        ++calls;
    }
};
struct EpiSwiglu {
    static constexpr bool PERM = true, AFTER_DRAIN = false;
    const float* b1; bf16* act;
    __device__ __forceinline__ void operator()(const pg8::f32x4 (&acc)[2][2][4][2], const pg8::Unit& u, int wr, int wc, int fr, int fq) const {
        const int e = u.kind; const int col = u.pn * 128 + wc * 32 + 8 * fq; const int row0 = u.pm * 256 + wr * 64 + fr;
        const float* bg = b1 + (size_t)e * 4096 + col; const float* bl = bg + 2048;
        const pg8::f32x4 g0 = *(const pg8::f32x4*)bg, g1 = *(const pg8::f32x4*)(bg + 4), l0 = *(const pg8::f32x4*)bl, l1 = *(const pg8::f32x4*)(bl + 4);
#pragma unroll
        for (int ai = 0; ai < 2; ++ai)
#pragma unroll
            for (int m = 0; m < 4; ++m) { float o[8];
#pragma unroll
                for (int n = 0; n < 2; ++n)
#pragma unroll
                    for (int j = 0; j < 4; ++j) { float gl = acc[ai][0][m][n][j] + (n ? g1[j] : g0[j]); float li = acc[ai][1][m][n][j] + (n ? l1[j] : l0[j]);
                        gl = fminf(gl, 7.f); li = fminf(fmaxf(li, -7.f), 7.f);
                        o[n * 4 + j] = gl * (1.f / (1.f + __expf(-1.702f * gl))) * (li + 1.f); }
                pg8::u32x4 w; w.x = pg8::cvt_pk_bf16(o[0], o[1]); w.y = pg8::cvt_pk_bf16(o[2], o[3]); w.z = pg8::cvt_pk_bf16(o[4], o[5]); w.w = pg8::cvt_pk_bf16(o[6], o[7]);
                *(pg8::u32x4*)(act + (size_t)(row0 + ai * 128 + m * 16) * DFF + col) = w; }
    }
};
struct EpiDown {
    static constexpr bool PERM = true, AFTER_DRAIN = false;
    const float* b2; const float* roww; bf16* y;
    __device__ __forceinline__ void operator()(const pg8::f32x4 (&acc)[2][2][4][2], const pg8::Unit& u, int wr, int wc, int fr, int fq) const {
        const int e = u.kind; const int col0 = u.pn * 256 + wc * 32 + 8 * fq; const int row0 = u.pm * 256 + wr * 64 + fr;
        pg8::f32x4 bv[2][2];
#pragma unroll
        for (int bj = 0; bj < 2; ++bj)
#pragma unroll
            for (int n = 0; n < 2; ++n) bv[bj][n] = *(const pg8::f32x4*)(b2 + (size_t)e * DM + col0 + bj * 128 + 4 * n);
#pragma unroll
        for (int ai = 0; ai < 2; ++ai)
#pragma unroll
            for (int m = 0; m < 4; ++m) { const int r = row0 + ai * 128 + m * 16; const float g = roww[r];
#pragma unroll
                for (int bj = 0; bj < 2; ++bj) { const pg8::f32x4 v0 = (acc[ai][bj][m][0] + bv[bj][0]) * g, v1 = (acc[ai][bj][m][1] + bv[bj][1]) * g;
                    pg8::u32x4 w; w.x = pg8::cvt_pk_bf16(v0[0], v0[1]); w.y = pg8::cvt_pk_bf16(v0[2], v0[3]); w.z = pg8::cvt_pk_bf16(v1[0], v1[1]); w.w = pg8::cvt_pk_bf16(v1[2], v1[3]);
                    *(pg8::u32x4*)(y + (size_t)r * DM + col0 + bj * 128) = w; } }
    }
};

__device__ __forceinline__ void ph_loga(const Params& p, size_t i0, size_t istride) {
    const bf16* SM = (const bf16*)(p.ws + WS_SM); float* LA = (float*)(p.ws + WS_LA); const float* wa2 = p.in[I_WA2]; const float* ba = p.in[I_BA];
    for (size_t i = i0; i < (size_t)T * 512; i += istride) {
        const int t = (int)(i >> 9), c = (int)(i & 511); float z = ba[c];
#pragma unroll
        for (int r = 0; r < 16; ++r) z += bf2f(SM[(size_t)t * 64 + r]) * wa2[r * 512 + c];
        LA[i] = (fminf(z, 0.f) - log1pf(__expf(-fabsf(z)))) * (1.f / 16.f);
    }
}
__device__ __forceinline__ void ph_gla_naive(const Params& p, LAS float* qs, int unit, int lane) {
    LAS float* ks = qs + 128; LAS float* as = qs + 256;
    const int bh = unit >> 2, sl = unit & 3, b = bh >> 2, h = bh & 3, dv = sl * 64 + lane;
    const bf16* GQ = (const bf16*)(p.ws + WS_GQ); const bf16* GK = (const bf16*)(p.ws + WS_GK); const bf16* GV = (const bf16*)(p.ws + WS_GV);
    const float* LA = (const float*)(p.ws + WS_LA); float* OG = (float*)(p.ws + WS_OG);
    float st[128];
#pragma unroll
    for (int i = 0; i < 128; ++i) st[i] = 0.f;
    for (int s = 0; s < SEQ; ++s) { const size_t row = (size_t)b * SEQ + s;
#pragma unroll
        for (int j = 0; j < 2; ++j) { const int dk = lane + 64 * j; qs[dk] = bf2f(GQ[row * 512 + h * 128 + dk]); ks[dk] = bf2f(GK[row * 512 + h * 128 + dk]); as[dk] = __expf(LA[row * 512 + h * 128 + dk]); }
        LDS_WAIT(); __builtin_amdgcn_wave_barrier();
        const float v = bf2f(GV[row * 1024 + h * 256 + dv]); float o = 0.f;
#pragma unroll
        for (int dk = 0; dk < 128; ++dk) { st[dk] = as[dk] * st[dk] + ks[dk] * v; o += qs[dk] * st[dk]; }
        OG[row * 1024 + h * 256 + dv] = o;
        LDS_WAIT(); __builtin_amdgcn_wave_barrier();
    }
}
template <bool DO_NSA> __device__ __forceinline__ void ph_mix_post(const Params& p, int gw, int NGW, int lane) {
    const float* OG = (const float*)(p.ws + WS_OG); const float* ON = (const float*)(p.ws + WS_ON); const bf16* GG = (const bf16*)(p.ws + WS_GG); bf16* A2 = (bf16*)(p.ws + WS_A2);
    const float* gn = p.in[I_GLAG]; const float* ng = p.in[I_NSAG];
    for (int t = gw; t < T; t += NGW) {
#pragma unroll
        for (int h = 0; h < 4; ++h) { const f32x4 o = *((const f32x4*)(OG + (size_t)t * 1024 + h * 256) + lane);
            const float ms = wave_sum(o.x * o.x + o.y * o.y + o.z * o.z + o.w * o.w) * (1.f / 256.f); const float rstd = 1.f / sqrtf(ms + RMS_EPS);
            const f32x4 g4 = ((const f32x4*)gn)[lane]; const v2u gg = *((const v2u*)(GG + (size_t)t * 1024 + h * 256) + lane);
            const float z0 = bflo(gg.x), z1 = bfhi(gg.x), z2 = bflo(gg.y), z3 = bfhi(gg.y);
            v2u w; w.x = pk2(o.x * rstd * g4.x * (z0 / (1.f + __expf(-z0))), o.y * rstd * g4.y * (z1 / (1.f + __expf(-z1))));
            w.y = pk2(o.z * rstd * g4.z * (z2 / (1.f + __expf(-z2))), o.w * rstd * g4.w * (z3 / (1.f + __expf(-z3))));
            *((v2u*)(A2 + (size_t)t * DM + h * 256) + lane) = w; }
        if (!DO_NSA) continue;
        f32x4 v[4]; float s = 0.f;
#pragma unroll
        for (int j = 0; j < 4; ++j) { v[j] = *((const f32x4*)(ON + (size_t)t * 1024) + lane + 64 * j); s += v[j].x * v[j].x + v[j].y * v[j].y + v[j].z * v[j].z + v[j].w * v[j].w; }
        const float rstd = 1.f / sqrtf(wave_sum(s) * (1.f / 1024.f) + RMS_EPS);
#pragma unroll
        for (int j = 0; j < 4; ++j) { const f32x4 g4 = ((const f32x4*)ng)[lane + 64 * j]; v2u w; w.x = pk2(v[j].x * rstd * g4.x, v[j].y * rstd * g4.y); w.y = pk2(v[j].z * rstd * g4.z, v[j].w * rstd * g4.w);
            *((v2u*)(A2 + (size_t)t * DM + 1024) + lane + 64 * j) = w; }
    }
}
__device__ __forceinline__ float gelu_tanh(float x) { const float u = 0.7978845608028654f * (x + 0.044715f * x * x * x); const float e = __expf(2.f * u); return 0.5f * x * (1.f + (1.f - 2.f / (e + 1.f))); }
__device__ __forceinline__ void ph_cmp_naive(const Params& p, LAS float* tl, int id, int n) {
    LAS float* hid = tl + 4096;
    const int which = id / (16 * 255), rem = id % (16 * 255), bg = rem / 255, c = rem % 255;
    const bf16* src = (const bf16*)(p.ws + (which ? WS_VC : WS_KC)) + ((size_t)bg * SEQ + 16 * c) * 128;
    const float* pe = p.in[which ? I_PEV : I_PEK]; const float* w1 = p.in[which ? I_WV1 : I_WK1]; const float* w2 = p.in[which ? I_WV2 : I_WK2];
    for (int i = n; i < 4096; i += 128) tl[i] = bf2f(src[i]) + pe[i];
    __syncthreads();
    float a = 0.f;
    for (int k = 0; k < 4096; ++k) a += tl[k] * w1[(size_t)k * 128 + n];
    hid[n] = gelu_tanh(a);
    __syncthreads();
    float o = 0.f;
    for (int m = 0; m < 128; ++m) o += hid[m] * w2[m * 128 + n];
    if (which == 0) ((bf16*)(p.ws + WS_KCMP))[((size_t)bg * 256 + c) * 128 + n] = (bf16)f2bf(o);
    else ((bf16*)(p.ws + WS_VCMPT))[((size_t)bg * 128 + n) * 256 + c] = (bf16)f2bf(o);
}
__device__ __forceinline__ void ph_cmp_fin_simple(const Params& p, LAS float* tl, int id, int n, const float* LHall, const float* PEVall) {
    LAS float* hid = tl + 4096;
    const int which = id / (16 * 255), rem = id % (16 * 255), bg = rem / 255, c = rem % 255;
    const float* w2 = p.in[which ? I_WV2 : I_WK2];
    const float* LH = LHall + ((size_t)which * 4096 + bg * 256) * 256;
    float pev = 0.f;
#pragma unroll 8
    for (int q = 0; q < 64; ++q) pev += PEVall[(size_t)(which * 64 + q) * 128 + n];
    const float a = LH[(size_t)c * 256 + n] + LH[(size_t)(c + 1) * 256 + 128 + n] + pev;
    hid[n] = gelu_tanh(a);
    __syncthreads();
    float o = 0.f;
    for (int m = 0; m < 128; ++m) o += hid[m] * w2[m * 128 + n];
    if (which == 0) ((bf16*)(p.ws + WS_KCMP))[((size_t)bg * 256 + c) * 128 + n] = (bf16)f2bf(o);
    else ((bf16*)(p.ws + WS_VCMPT))[((size_t)bg * 128 + n) * 256 + c] = (bf16)f2bf(o);
}
__device__ __forceinline__ float dot128(const LAS float* q, const bf16* k) {
    float a = 0.f;
#pragma unroll
    for (int i = 0; i < 16; ++i) { const v4u w = ((const v4u*)k)[i];
        a += q[8 * i] * bflo(w.x) + q[8 * i + 1] * bfhi(w.x) + q[8 * i + 2] * bflo(w.y) + q[8 * i + 3] * bfhi(w.y) + q[8 * i + 4] * bflo(w.z) + q[8 * i + 5] * bfhi(w.z) + q[8 * i + 6] * bflo(w.w) + q[8 * i + 7] * bfhi(w.w); }
    return a;
}
__device__ __forceinline__ void ph_nsa_naive(const Params& p, LAS float* base, int vblk, int r, int lane) {
    LAS float (*qf)[128] = (LAS float (*)[128])base; LAS float (*lg)[1024] = (LAS float (*)[1024])(base + 512); LAS unsigned long long& selm = *(LAS unsigned long long*)(base + 512 + 4096);
    const int s = vblk & (SEQ - 1), bg = vblk >> 12, b = bg >> 1, g = bg & 1, h = g * 4 + r;
    const size_t row = (size_t)b * SEQ + s;
    const bf16* NQ = (const bf16*)(p.ws + WS_NQ); const bf16* SM = (const bf16*)(p.ws + WS_SM);
    const bf16* KCMP = (const bf16*)(p.ws + WS_KCMP) + (size_t)bg * 256 * 128; const bf16* VCMPT = (const bf16*)(p.ws + WS_VCMPT) + (size_t)bg * 128 * 256;
    const bf16* KS = (const bf16*)(p.ws + WS_KS) + (size_t)bg * SEQ * 128; const bf16* KW = (const bf16*)(p.ws + WS_KW) + (size_t)bg * SEQ * 128;
    const bf16* VST = (const bf16*)(p.ws + WS_VST) + (size_t)bg * 128 * SEQ; const bf16* VWT = (const bf16*)(p.ws + WS_VWT) + (size_t)bg * 128 * SEQ;
    const float* relb = p.in[I_RELB]; float* ON = (float*)(p.ws + WS_ON);
    qf[r][lane] = bf2f(NQ[row * 1024 + h * 128 + lane]); qf[r][lane + 64] = bf2f(NQ[row * 1024 + h * 128 + lane + 64]);
    __syncthreads();
    const LAS float* q = qf[r]; LAS float* L = lg[r];
    float ot0 = 0.f, ot1 = 0.f;
    const float gt0 = 1.f / (1.f + __expf(-bf2f(SM[row * 64 + 16 + h]))), gt1 = 1.f / (1.f + __expf(-bf2f(SM[row * 64 + 24 + h]))), gt2 = 1.f / (1.f + __expf(-bf2f(SM[row * 64 + 32 + h])));
#define BIAS(dist) relb[(int)kBucket[(dist) > 127 ? 127 : (dist)] * 8 + h]
    const int ncv = (s >= 31) ? ((s - 31) >> 4) + 1 : 0;
    if (ncv > 0) {
        float mx = -3e38f;
        for (int c = lane; c < ncv; c += 64) { const float l = dot128(q, KCMP + (size_t)c * 128) + BIAS(s - (16 * c + 31)); L[c] = l; mx = fmaxf(mx, l); }
        mx = wave_max(mx); float sum = 0.f;
        for (int c = lane; c < ncv; c += 64) { const float e = __expf(L[c] - mx); L[c] = e; sum += e; }
        sum = wave_sum(sum); const float inv = 1.f / sum;
        for (int c = lane; c < ncv; c += 64) L[c] *= inv;
        LDS_WAIT(); __builtin_amdgcn_wave_barrier();
        float o0 = 0.f, o1 = 0.f;
        for (int c = 0; c < ncv; ++c) { const float pr = L[c]; o0 += pr * bf2f(VCMPT[(size_t)lane * 256 + c]); o1 += pr * bf2f(VCMPT[(size_t)(lane + 64) * 256 + c]); }
        ot0 += gt0 * o0; ot1 += gt0 * o1;
    }
    __syncthreads();
    const int cur = s >> 6;
    if (r == 0) { const int n = lane; float sc;
        if (n == 0 || n == cur || n == cur - 1) sc = 1e4f;
        else if (n <= cur) { float im = 0.f; for (int rr = 0; rr < 4; ++rr) for (int c = 4 * n - 1; c <= 4 * n + 3; ++c) if (c >= 0 && c < ncv) im += lg[rr][c]; sc = im; }
        else sc = -1.f;
        int rank = 0;
        for (int m = 0; m < 64; ++m) { const float sm = __shfl(sc, m); rank += (sm > sc || (sm == sc && m < n)) ? 1 : 0; }
        const unsigned long long mk = __ballot(rank < 16);
        if (lane == 0) selm = mk; }
    __syncthreads();
    { unsigned long long mask = selm & (cur == 63 ? ~0ull : ((1ull << (cur + 1)) - 1ull));
      int cnt = 0; float mx = -3e38f;
      for (unsigned long long mm = mask; mm; mm &= mm - 1) { const int n = __builtin_ctzll(mm); const int kpos = n * 64 + lane; float l = -3e38f;
          if (kpos <= s) l = dot128(q, KS + (size_t)kpos * 128) + BIAS(s - kpos);
          L[cnt * 64 + lane] = l; mx = fmaxf(mx, l); ++cnt; }
      mx = wave_max(mx); float sum = 0.f;
      for (int j = 0; j < cnt; ++j) { const float l = L[j * 64 + lane]; const float e = l > -1e38f ? __expf(l - mx) : 0.f; L[j * 64 + lane] = e; sum += e; }
      sum = wave_sum(sum); const float inv = 1.f / sum;
      LDS_WAIT(); __builtin_amdgcn_wave_barrier();
      float o0 = 0.f, o1 = 0.f; int j = 0;
      for (unsigned long long mm = mask; mm; mm &= mm - 1, ++j) { const int n = __builtin_ctzll(mm);
          for (int kk = 0; kk < 64; ++kk) { const float pr = L[j * 64 + kk]; o0 += pr * bf2f(VST[(size_t)lane * SEQ + n * 64 + kk]); o1 += pr * bf2f(VST[(size_t)(lane + 64) * SEQ + n * 64 + kk]); } }
      ot0 += gt1 * o0 * inv; ot1 += gt1 * o1 * inv; }
    LDS_WAIT(); __builtin_amdgcn_wave_barrier();
    { const int lo = s >= 511 ? s - 511 : 0, nk = s - lo + 1; float mx = -3e38f;
      for (int i = lane; i < nk; i += 64) { const int kpos = lo + i; const float l = dot128(q, KW + (size_t)kpos * 128) + BIAS(s - kpos); L[i] = l; mx = fmaxf(mx, l); }
      mx = wave_max(mx); float sum = 0.f;
      for (int i = lane; i < nk; i += 64) { const float e = __expf(L[i] - mx); L[i] = e; sum += e; }
      sum = wave_sum(sum); const float inv = 1.f / sum;
      LDS_WAIT(); __builtin_amdgcn_wave_barrier();
      float o0 = 0.f, o1 = 0.f;
      for (int i = 0; i < nk; ++i) { const float pr = L[i]; o0 += pr * bf2f(VWT[(size_t)lane * SEQ + lo + i]); o1 += pr * bf2f(VWT[(size_t)(lane + 64) * SEQ + lo + i]); }
      ot0 += gt2 * o0 * inv; ot1 += gt2 * o1 * inv; }
#undef BIAS
    ON[row * 1024 + h * 128 + lane] = ot0; ON[row * 1024 + h * 128 + lane + 64] = ot1;
}

namespace nsa {
constexpr int KB0 = 0, KB1 = 16384, VB0 = 32768, VB1 = 49152, LUT = 65536;
constexpr int QST = LUT + 4096, IMP = QST + 65536, SELM = IMP + 16384, LDS_END = SELM + 512;
constexpr float LOG2E = 1.4426950408889634f;
typedef float f4 __attribute__((ext_vector_type(4)));

typedef unsigned u2v __attribute__((ext_vector_type(2)));
__device__ __forceinline__ float rmax16(float x) { const unsigned u = __float_as_uint(x); const u2v r = __builtin_amdgcn_permlane16_swap(u, u, false, false); return fmaxf(__uint_as_float(r[0]), __uint_as_float(r[1])); }
__device__ __forceinline__ float rmax32(float x) { const unsigned u = __float_as_uint(x); const u2v r = __builtin_amdgcn_permlane32_swap(u, u, false, false); return fmaxf(__uint_as_float(r[0]), __uint_as_float(r[1])); }
__device__ __forceinline__ float radd16(float x) { const unsigned u = __float_as_uint(x); const u2v r = __builtin_amdgcn_permlane16_swap(u, u, false, false); return __uint_as_float(r[0]) + __uint_as_float(r[1]); }
__device__ __forceinline__ float radd32(float x) { const unsigned u = __float_as_uint(x); const u2v r = __builtin_amdgcn_permlane32_swap(u, u, false, false); return __uint_as_float(r[0]) + __uint_as_float(r[1]); }
__device__ __forceinline__ float raddq(float x) { x += __int_as_float(__builtin_amdgcn_update_dpp(0, __float_as_int(x), 0xB1, 0xF, 0xF, true)); x += __int_as_float(__builtin_amdgcn_update_dpp(0, __float_as_int(x), 0x4E, 0xF, 0xF, true)); return x; }
struct Ctx {
    LAS unsigned char* lds; int tid, lane, wave, c, gq, r;
    int s0, cur;
    const LAS unsigned char* qst;
    int pos0;
    const LAS float* lutrow;
    int koff0, voff0;
    unsigned kdo[2], vdoc[2], vdos[2];
};
__device__ __forceinline__ void dma_k(const Ctx& C, const bf16* kt, LAS unsigned char* kb) {
#pragma unroll
    for (int i = 0; i < 2; ++i) __builtin_amdgcn_global_load_lds((const unsigned*)((const char*)kt + C.kdo[i]), (LAS unsigned*)(kb + (2 * C.wave + i) * 1024), 16, 0, 0); }
__device__ __forceinline__ void dma_v(const Ctx& C, const bf16* vt, const unsigned (&vdo)[2], LAS unsigned char* vb) {
#pragma unroll
    for (int i = 0; i < 2; ++i) __builtin_amdgcn_global_load_lds((const unsigned*)((const char*)vt + vdo[i]), (LAS unsigned*)(vb + (2 * C.wave + i) * 1024), 16, 0, 0); }

__device__ __forceinline__ void compute_st(const Ctx& C, const LAS unsigned char* kb, f4 (&s)[2][4]) {
#pragma unroll
    for (int ks = 0; ks < 4; ++ks) { const bf16x8 q0 = *(const LAS bf16x8*)(C.qst + ks * 1024), q1 = *(const LAS bf16x8*)(C.qst + (4 + ks) * 1024);
#pragma unroll
        for (int kt = 0; kt < 4; ++kt) { const bf16x8 a = *(const LAS bf16x8*)(kb + kt * 4096 + (C.koff0 ^ (ks * 64)));
            s[0][kt] = __builtin_amdgcn_mfma_f32_16x16x32_bf16(a, q0, ks == 0 ? (f4){0.f, 0.f, 0.f, 0.f} : s[0][kt], 0, 0, 0);
            s[1][kt] = __builtin_amdgcn_mfma_f32_16x16x32_bf16(a, q1, ks == 0 ? (f4){0.f, 0.f, 0.f, 0.f} : s[1][kt], 0, 0, 0); }
        asm volatile("" ::: "memory"); }
}
__device__ __forceinline__ void compute_pv(const Ctx& C, const LAS unsigned char* vb, const f4 (&p)[2][4], f4 (&o)[2][8]) {
#pragma unroll
    for (int i = 0; i < 2; ++i) { bf16x8 pb[2];
#pragma unroll
        for (int qt = 0; qt < 2; ++qt) { v4u w; w.x = pg8::cvt_pk_bf16(p[qt][2 * i][0], p[qt][2 * i][1]); w.y = pg8::cvt_pk_bf16(p[qt][2 * i][2], p[qt][2 * i][3]);
            w.z = pg8::cvt_pk_bf16(p[qt][2 * i + 1][0], p[qt][2 * i + 1][1]); w.w = pg8::cvt_pk_bf16(p[qt][2 * i + 1][2], p[qt][2 * i + 1][3]); pb[qt] = __builtin_bit_cast(bf16x8, w); }
#pragma unroll
        for (int dt = 0; dt < 8; ++dt) { const v2u lo = *(const LAS v2u*)(vb + dt * 2048 + (C.voff0 ^ (i * 64))), hi = *(const LAS v2u*)(vb + dt * 2048 + (C.voff0 ^ (i * 64 + 32))); const bf16x8 a = __builtin_bit_cast(bf16x8, (v4u){lo.x, lo.y, hi.x, hi.y});
#pragma unroll
            for (int qt = 0; qt < 2; ++qt) o[qt][dt] = __builtin_amdgcn_mfma_f32_16x16x32_bf16(a, pb[qt], o[qt][dt], 0, 0, 0);
            if (dt & 1) asm volatile("" ::: "memory"); } }
}
enum { M_CMP = 0, M_SEL = 1, M_WIN = 2 };
template <int MODE, bool FAR = false>
__device__ __forceinline__ void mask_bias(const Ctx& C, f4 (&s)[2][4], int kb, int n, const LAS unsigned* selw) {
    const float NEG = -__builtin_inff();
#pragma unroll
    for (int qt = 0; qt < 2; ++qt) {
        bool tokok = true;
        if (MODE == M_SEL) tokok = ((selw[(4 * qt + (C.c >> 2)) * 2 + (n >> 5)] >> (n & 31)) & 1u) != 0u;
        if (FAR) { const float be = tokok ? C.lutrow[127] : NEG;
#pragma unroll
            for (int kt = 0; kt < 4; ++kt)
#pragma unroll
                for (int rg = 0; rg < 4; ++rg) s[qt][kt][rg] = __builtin_fmaf(s[qt][kt][rg], LOG2E, be);
            continue; }
        const int dbase = (MODE == M_CMP) ? (C.pos0 + 4 * qt - 31 - 16 * (kb + 4 * C.gq)) : (C.pos0 + 4 * qt - (kb + 4 * C.gq));
#pragma unroll
        for (int kt = 0; kt < 4; ++kt) {
#pragma unroll
            for (int rg = 0; rg < 4; ++rg) { const int d = (MODE == M_CMP) ? dbase - 16 * (16 * kt + rg) : dbase - (16 * kt + rg);
                int di = d < 0 ? 0 : d; di = di > 127 ? 127 : di; const float bias = C.lutrow[di];
                bool ok = tokok && d >= 0; if (MODE == M_WIN) ok = ok && d < 512;
                s[qt][kt][rg] = ok ? __builtin_fmaf(s[qt][kt][rg], LOG2E, bias) : NEG; }
            asm volatile("" ::: "memory"); }
    }
}
__device__ __forceinline__ void softmax_step(f4 (&s)[2][4], float (&m)[2], float (&l)[2], f4 (&o)[2][8], bool rescale_o) {
#pragma unroll
    for (int qt = 0; qt < 2; ++qt) { float mx = s[qt][0][0];
#pragma unroll
        for (int kt = 0; kt < 4; ++kt)
#pragma unroll
            for (int rg = 0; rg < 4; ++rg) mx = fmaxf(mx, s[qt][kt][rg]);
        mx = rmax32(rmax16(mx));
        const float mn = fmaxf(m[qt], mx), alpha = __builtin_amdgcn_exp2f(m[qt] - mn); m[qt] = mn; float ps = 0.f;
#pragma unroll
        for (int kt = 0; kt < 4; ++kt)
#pragma unroll
            for (int rg = 0; rg < 4; ++rg) { const float e = __builtin_amdgcn_exp2f(s[qt][kt][rg] - mn); s[qt][kt][rg] = e; ps += e; }
        l[qt] = l[qt] * alpha + ps;
        if (rescale_o && __any(alpha != 1.f)) {
#pragma unroll
            for (int dt = 0; dt < 8; ++dt) o[qt][dt] = o[qt][dt] * alpha; }
    }
}
}

__device__ __forceinline__ void ph_nsa(const Params& p, LAS unsigned char* lds, int idx0, int idxstride, int tid_in, int wave) {
    using namespace nsa;
    int tid = tid_in; asm volatile("" : "+v"(tid));
    const int lane = tid & 63;
    Ctx C; C.lds = lds; C.tid = tid; C.lane = lane; C.wave = wave; C.c = lane & 15; C.gq = lane >> 4; C.r = lane & 3;
    C.koff0 = C.c * 256 + ((C.gq ^ C.c) * 16);
#pragma unroll
    for (int i = 0; i < 2; ++i) { const int piece = 2 * wave + i;
        { const int row = piece * 4 + (lane >> 4), chunk = (lane & 15) ^ (row & 15); C.kdo[i] = (unsigned)(row * 256 + chunk * 16); }
        { const int row = piece * 8 + (lane >> 3), chunk = (lane & 7) ^ ((row >> 1) & 7); C.vdoc[i] = (unsigned)(row * 256 * 2 + chunk * 16); C.vdos[i] = (unsigned)(row * SEQ * 2 + chunk * 16); } }
    C.voff0 = C.c * 128 + (((C.gq >> 1) ^ ((C.c >> 1) & 7)) * 16) + (C.gq & 1) * 8;
    const bf16* NQ = (const bf16*)(p.ws + WS_NQ); const bf16* SM = (const bf16*)(p.ws + WS_SM); bf16* A2 = (bf16*)(p.ws + WS_A2);
    const float* relb = p.in[I_RELB]; const float* nsag = p.in[I_NSAG];
    LAS float* lut = (LAS float*)(lds + LUT);
    for (int i = tid; i < 8 * 128; i += 512) { const int hh = i >> 7, d = i & 127; lut[i] = relb[(int)kBucket[d] * 8 + hh] * LOG2E; }
    __syncthreads();
    LAS unsigned char* qstw = lds + QST + wave * 8192 + lane * 16; C.qst = qstw;
    LAS float* imp = (LAS float*)(lds + IMP + wave * 2048);
    LAS unsigned long long* selm = (LAS unsigned long long*)(lds + SELM + wave * 64);
#define NSA_SYNC() do { asm volatile("s_waitcnt vmcnt(0)" ::: "memory"); __syncthreads(); } while (0)
    for (int idx = idx0; idx < 512; idx += idxstride) {
        const int rnd = idx >> 8, kq = idx & 255, b = kq & 7, tq = rnd == 0 ? 63 - (kq >> 3) : (kq >> 3);
        C.s0 = tq * 64; C.cur = tq;
        const int tokl0 = 8 * wave + (C.c >> 2);
        C.pos0 = C.s0 + tokl0;
        float ssq[2] = {0.f, 0.f};
        for (int g = 0; g < 2; ++g) {
            const int bg = b * 2 + g, h = g * 4 + C.r;
            C.lutrow = lut + h * 128;
            const bf16* KCMP = (const bf16*)(p.ws + WS_KCMP) + (size_t)bg * 256 * 128; const bf16* VCMPT = (const bf16*)(p.ws + WS_VCMPT) + (size_t)bg * 128 * 256;
#pragma unroll
            for (int qt = 0; qt < 2; ++qt) { const unsigned qo = (unsigned)(((b * SEQ + (C.pos0 + 4 * qt)) * 1024 + h * 128 + 8 * C.gq) * 2);
#pragma unroll
                for (int ks = 0; ks < 4; ++ks) *(LAS bf16x8*)(qstw + (qt * 4 + ks) * 1024) = *(const bf16x8*)((const char*)NQ + qo + ks * 64); }
#pragma unroll
            for (int i = 0; i < 2; ++i) *(LAS f32x4*)((LAS unsigned char*)imp + lane * 16 + i * 1024) = (f32x4){0.f, 0.f, 0.f, 0.f};
#define NSA_OROW(qt) ((char*)A2 + (unsigned)(((b * SEQ + C.pos0 + 4 * (qt)) * DM + 1024 + h * 128 + 4 * C.gq) * 2))
            const int cmaxb = C.s0 + 63 - 31; const int nct = cmaxb >= 0 ? ((cmaxb >> 4) >> 6) + 1 : 0;
            float m[2] = {-1e30f, -1e30f}, l[2] = {0.f, 0.f};
            f4 o[2][8];
            if (nct > 0) {
                dma_k(C, KCMP, lds + KB0); NSA_SYNC();
                for (int ct = 0; ct < nct; ++ct) { const int buf = ct & 1;
                    if (ct + 1 < nct) dma_k(C, KCMP + (ct + 1) * 64 * 128, lds + (buf ? KB0 : KB1));
                    f4 s[2][4]; compute_st(C, lds + (buf ? KB1 : KB0), s); mask_bias<M_CMP>(C, s, 64 * ct, 0, (const LAS unsigned*)selm); softmax_step(s, m, l, o, false);
                    NSA_SYNC(); }
            }
            float inv[2];
#pragma unroll
            for (int qt = 0; qt < 2; ++qt) { const float lt = radd32(radd16(l[qt])); inv[qt] = lt > 0.f ? 1.f / lt : 0.f; }
#pragma unroll
            for (int qt = 0; qt < 2; ++qt)
#pragma unroll
                for (int dt = 0; dt < 8; ++dt) o[qt][dt] = (f4){0.f, 0.f, 0.f, 0.f};
            if (nct > 0) {
                dma_k(C, KCMP, lds + KB0); dma_v(C, VCMPT, C.vdoc, lds + VB0); NSA_SYNC();
                for (int ct = 0; ct < nct; ++ct) { const int buf = ct & 1;
                    if (ct + 1 < nct) { dma_k(C, KCMP + (ct + 1) * 64 * 128, lds + (buf ? KB0 : KB1)); dma_v(C, VCMPT + 64 * (ct + 1), C.vdoc, lds + (buf ? VB0 : VB1)); }
                    f4 s[2][4]; compute_st(C, lds + (buf ? KB1 : KB0), s); mask_bias<M_CMP>(C, s, 64 * ct, 0, (const LAS unsigned*)selm);
#pragma unroll
                    for (int qt = 0; qt < 2; ++qt)
#pragma unroll
                        for (int kt = 0; kt < 4; ++kt) {
#pragma unroll
                            for (int rg = 0; rg < 4; ++rg) s[qt][kt][rg] = __builtin_amdgcn_exp2f(s[qt][kt][rg] - m[qt]) * inv[qt];
                            float po = (s[qt][kt][0] + s[qt][kt][1]) + (s[qt][kt][2] + s[qt][kt][3]), p3 = s[qt][kt][3];
                            po = raddq(po); p3 = raddq(p3);
                            const int nb = 16 * ct + 4 * kt + C.gq, tl = 4 * qt + (C.c >> 2);
                            if (C.r == 0) { __hip_atomic_fetch_add((float*)(imp + tl * 64 + nb), po, __ATOMIC_RELAXED, __HIP_MEMORY_SCOPE_WORKGROUP); if (nb + 1 < 64) __hip_atomic_fetch_add((float*)(imp + tl * 64 + nb + 1), p3, __ATOMIC_RELAXED, __HIP_MEMORY_SCOPE_WORKGROUP); } }
                    compute_pv(C, lds + (buf ? VB1 : VB0), s, o);
                    NSA_SYNC(); }
            }
            LDS_WAIT(); __builtin_amdgcn_wave_barrier();
            for (int tk = 0; tk < 8; ++tk) { const int n = lane; float sc;
                if (n == 0 || n == C.cur || n == C.cur - 1) sc = 1e4f; else if (n <= C.cur) sc = imp[tk * 64 + n]; else sc = -1.f;
                const int key = ((sc < 0.f ? 0 : __float_as_int(sc) + 64) & ~63) | (63 - n);
                int rank = 0;
#pragma unroll
                for (int mm = 0; mm < 64; ++mm) rank += (__builtin_amdgcn_readlane(key, mm) > key) ? 1 : 0;
                const unsigned long long mk = __ballot(rank < 16);
                if (lane == 0) selm[tk] = mk; }
            LDS_WAIT(); __builtin_amdgcn_wave_barrier();
#pragma unroll
            for (int qt = 0; qt < 2; ++qt) { const float gt = 1.f / (1.f + __expf(-bf2f(*(const bf16*)((const char*)SM + (unsigned)(((b * SEQ + (C.pos0 + 4 * qt)) * 64 + 16 + h) * 2)))));
#pragma unroll
                for (int dt = 0; dt < 8; ++dt) { const f4 v = o[qt][dt] * gt; *(v2u*)(NSA_OROW(qt) + 32 * dt) = (v2u){pg8::cvt_pk_bf16(v[0], v[1]), pg8::cvt_pk_bf16(v[2], v[3])}; } }
#pragma unroll
            for (int br = 1; br <= 2; ++br) {
                const bf16* KX = (const bf16*)(p.ws + (br == 1 ? WS_KS : WS_KW)) + bg * SEQ * 128; const bf16* VX = (const bf16*)(p.ws + (br == 1 ? WS_VST : WS_VWT)) + bg * 128 * SEQ;
                const int n0 = br == 1 ? 0 : (C.cur >= 8 ? C.cur - 8 : 0), n1 = C.cur;
                m[0] = m[1] = -1e30f; l[0] = l[1] = 0.f;
#pragma unroll
                for (int qt = 0; qt < 2; ++qt)
#pragma unroll
                    for (int dt = 0; dt < 8; ++dt) o[qt][dt] = (f4){0.f, 0.f, 0.f, 0.f};
                int f0 = n1 + 1, f1 = n0 - 1;
                for (int n = n0; n <= n1; ++n) { const bool fa = (C.s0 - (64 * n + 63) >= 113) && (br == 1 || (C.s0 + 63 - 64 * n) < 512); if (fa) { f0 = n < f0 ? n : f0; f1 = n; } }
                const int cntf = f1 >= f0 ? f1 - f0 + 1 : 0, cnt = n1 - n0 + 1, nlo = cntf ? f0 - n0 : cnt;
#define NSA_TILE(i) ((i) < cntf ? f0 + (i) : (((i) - cntf) < nlo ? n0 + ((i) - cntf) : f1 + 1 + ((i) - cntf - nlo)))
#define NSA_BODY(FARF) { const int n = NSA_TILE(i); const int buf = i & 1; \
                    if (i + 1 < cnt) { const int nn = NSA_TILE(i + 1); dma_k(C, KX + nn * 64 * 128, lds + (buf ? KB0 : KB1)); dma_v(C, VX + 64 * nn, C.vdos, lds + (buf ? VB0 : VB1)); } \
                    bool need = true; \
                    if (br == 1) { const unsigned any = ((const LAS unsigned*)selm)[(lane & 7) * 2 + (n >> 5)] >> (n & 31); need = __any((int)(any & 1u)); } \
                    if (need) { f4 s[2][4]; compute_st(C, lds + (buf ? KB1 : KB0), s); \
                        if (br == 1) mask_bias<M_SEL, FARF>(C, s, 64 * n, n, (const LAS unsigned*)selm); else mask_bias<M_WIN, FARF>(C, s, 64 * n, n, (const LAS unsigned*)selm); \
                        softmax_step(s, m, l, o, true); compute_pv(C, lds + (buf ? VB1 : VB0), s, o); } \
                    NSA_SYNC(); }
                { const int nf = NSA_TILE(0); dma_k(C, KX + nf * 64 * 128, lds + KB0); dma_v(C, VX + 64 * nf, C.vdos, lds + VB0); NSA_SYNC(); }
                int i = 0;
                for (; i < cntf; ++i) NSA_BODY(true)
                for (; i < cnt; ++i) NSA_BODY(false)
#undef NSA_BODY
#undef NSA_TILE
                asm volatile("s_waitcnt vmcnt(0)" ::: "memory");
#pragma unroll
                for (int qt = 0; qt < 2; ++qt) { const float lt = radd32(radd16(l[qt]));
                    const int row = b * SEQ + (C.pos0 + 4 * qt);
                    const float sc = (1.f / (1.f + __expf(-bf2f(*(const bf16*)((const char*)SM + (unsigned)((row * 64 + 16 + 8 * br + h) * 2)))))) / lt;
#pragma unroll
                    for (int dt = 0; dt < 8; ++dt) { const f4 v = o[qt][dt] * sc; v2u* sp = (v2u*)(NSA_OROW(qt) + 32 * dt); const v2u pv = *sp;
                        const float a0 = bflo(pv.x) + v[0], a1 = bfhi(pv.x) + v[1], a2 = bflo(pv.y) + v[2], a3 = bfhi(pv.y) + v[3];
                        if (br == 2) ssq[qt] += (a0 * a0 + a1 * a1) + (a2 * a2 + a3 * a3);
                        *sp = (v2u){pg8::cvt_pk_bf16(a0, a1), pg8::cvt_pk_bf16(a2, a3)}; } }
            }
        }
        float rstd[2];
#pragma unroll
        for (int qt = 0; qt < 2; ++qt) { const float t = radd32(radd16(raddq(ssq[qt]))); rstd[qt] = 1.f / sqrtf(t * (1.f / 1024.f) + RMS_EPS); }
        asm volatile("s_waitcnt vmcnt(0)" ::: "memory");
#pragma unroll
        for (int qt = 0; qt < 2; ++qt) { const int sub = C.r * 4 + C.gq; bf16* orow = (bf16*)((char*)A2 + (unsigned)(((b * SEQ + (C.pos0 + 4 * qt)) * DM + 1024) * 2 + sub * 16)); const int subz = 0;
#pragma unroll
            for (int j = 0; j < 8; ++j) { const int col = (j * 16 + subz) * 8; v4u w = *(const v4u*)((const char*)orow + (unsigned)(col * 2)); const f32x4 g0 = *(const f32x4*)((const char*)nsag + (unsigned)(col * 4 + sub * 32)), g1 = *(const f32x4*)((const char*)nsag + (unsigned)(col * 4 + sub * 32 + 16)); const float rs = rstd[qt];
                w.x = pk2(bflo(w.x) * rs * g0.x, bfhi(w.x) * rs * g0.y); w.y = pk2(bflo(w.y) * rs * g0.z, bfhi(w.y) * rs * g0.w); w.z = pk2(bflo(w.z) * rs * g1.x, bfhi(w.z) * rs * g1.y); w.w = pk2(bflo(w.w) * rs * g1.z, bfhi(w.w) * rs * g1.w);
                *(v4u*)((char*)orow + (unsigned)(col * 2)) = w; } }
        NSA_SYNC();
    }
#undef NSA_SYNC
#undef NSA_OROW
}

constexpr size_t WS_ST = WS_LA;
constexpr size_t WS_DEC = WS_ST + (size_t)2048 * 256 * 128 * 2;
static_assert(WS_DEC + (size_t)2048 * 128 * 4 <= WS_KCMP, "gla scratch overlay");
namespace gla {
typedef float f4 __attribute__((ext_vector_type(4)));
constexpr int L_ST = 0, L_KT = 65536, L_QT = 81920, L_VT = 98304, L_GA = 131072, L_GT = L_GA + 4096, L_RED = L_GT + 2048, L_END = L_RED + 512;
__device__ __forceinline__ void chunk_cumsum(const Params& p, LAS unsigned char* lds, int tid, int t0, int h, float (&P)[16], float& blast) {
    const bf16* SM = (const bf16*)(p.ws + WS_SM); const float* wa2 = p.in[I_WA2]; const float* ba = p.in[I_BA];
    LAS float* ga = (LAS float*)(lds + L_GA); LAS float* gt = (LAS float*)(lds + L_GT);
    if (tid < 128) { const int j = tid >> 1, hf = tid & 1; const v4u w = *(const v4u*)((const char*)SM + (unsigned)(((t0 + j) * 64 + hf * 8) * 2));
        LAS float* d = ga + j * 16 + hf * 8; d[0] = bflo(w.x); d[1] = bfhi(w.x); d[2] = bflo(w.y); d[3] = bfhi(w.y); d[4] = bflo(w.z); d[5] = bfhi(w.z); d[6] = bflo(w.w); d[7] = bfhi(w.w); }
    const int dk = tid & 127, jq = tid >> 7;
    float w[16];
#pragma unroll
    for (int r = 0; r < 16; ++r) w[r] = wa2[r * 512 + h * 128 + dk];
    const float bb = ba[h * 128 + dk];
    __syncthreads();
    float run = 0.f;
#pragma unroll
    for (int jj = 0; jj < 16; ++jj) { const LAS f32x4* gr = (const LAS f32x4*)(ga + (16 * jq + jj) * 16); float z = bb;
#pragma unroll
        for (int r4 = 0; r4 < 4; ++r4) { const f32x4 g4 = gr[r4]; z += g4.x * w[4 * r4] + g4.y * w[4 * r4 + 1] + g4.z * w[4 * r4 + 2] + g4.w * w[4 * r4 + 3]; }
        run += (fminf(z, 0.f) - log1pf(__expf(-fabsf(z)))) * (1.f / 16.f); P[jj] = run; }
    gt[jq * 128 + dk] = run;
    __syncthreads();
    float off = 0.f, tot = 0.f;
#pragma unroll
    for (int q = 0; q < 4; ++q) { const float t = gt[q * 128 + dk]; tot += t; if (q < jq) off += t; }
#pragma unroll
    for (int jj = 0; jj < 16; ++jj) P[jj] += off;
    blast = tot;
}
__device__ __forceinline__ void stage_raw_k(const bf16* src  , LAS unsigned char* dst, int tid, int t0, int h) {
#pragma unroll
    for (int q = 0; q < 2; ++q) { const int id = tid + 512 * q, j = id >> 4, c16 = id & 15; *(LAS v4u*)(dst + j * 256 + c16 * 16) = *(const v4u*)((const char*)src + (unsigned)(((t0 + j) * 512 + h * 128 + c16 * 8) * 2)); }
}
__device__ __forceinline__ void stage_raw_v(const Params& p, LAS unsigned char* dst, int tid, int t0, int h) {
    const bf16* GV = (const bf16*)(p.ws + WS_GV);
#pragma unroll
    for (int q = 0; q < 4; ++q) { const int id = tid + 512 * q, j = id >> 5, c = id & 31; *(LAS v4u*)(dst + j * 512 + c * 16) = *(const v4u*)((const char*)GV + (unsigned)(((t0 + j) * 1024 + h * 256 + c * 8) * 2)); }
}
__device__ __forceinline__ void fill_vt(LAS unsigned char* lds, const LAS unsigned char* rv, int tid) {
    const int dv = tid & 255, jh = tid >> 8;
    unsigned short v[32];
#pragma unroll
    for (int jj = 0; jj < 32; ++jj) v[jj] = *(const LAS bf16*)(rv + (32 * jh + jj) * 512 + dv * 2);
    LAS unsigned char* row = lds + L_VT + dv * 128; const int f = (dv >> 1) & 7;
#pragma unroll
    for (int q = 0; q < 4; ++q) { v4u w; w.x = v[8 * q] | ((unsigned)v[8 * q + 1] << 16); w.y = v[8 * q + 2] | ((unsigned)v[8 * q + 3] << 16); w.z = v[8 * q + 4] | ((unsigned)v[8 * q + 5] << 16); w.w = v[8 * q + 6] | ((unsigned)v[8 * q + 7] << 16);
        *(LAS v4u*)(row + (((4 * jh + q) ^ f) * 16)) = w; }
}
}

__device__ __forceinline__ void ph_gla_a(const Params& p, LAS unsigned char* lds, int u0, int ustride, int tid_in, int wave) {
    using namespace gla;
    int tid = tid_in; asm volatile("" : "+v"(tid));
    const int lane = tid & 63, c = lane & 15, gq = lane >> 4;
    const bf16* GK = (const bf16*)(p.ws + WS_GK); bf16* ST = (bf16*)(p.ws + WS_ST); float* DEC = (float*)(p.ws + WS_DEC);
    for (int unit = u0; unit < 2048; unit += ustride) {
        const int bh = unit >> 6, ch = unit & 63, b = bh >> 2, h = bh & 3, t0 = b * SEQ + ch * 64;
        stage_raw_k(GK, lds + 0, tid, t0, h); stage_raw_v(p, lds + 16384, tid, t0, h);
        float P[16], blast; chunk_cumsum(p, lds, tid, t0, h, P, blast);
        { const int dk = tid & 127, jq = tid >> 7;
          unsigned short kv[16];
#pragma unroll
          for (int jj = 0; jj < 16; ++jj) kv[jj] = *(const LAS bf16*)(lds + (16 * jq + jj) * 256 + dk * 2);
          unsigned pk[8];
#pragma unroll
          for (int q = 0; q < 8; ++q) pk[q] = pk2(bf2f(kv[2 * q]) * __expf(blast - P[2 * q]), bf2f(kv[2 * q + 1]) * __expf(blast - P[2 * q + 1]));
          LAS unsigned char* row = lds + L_KT + dk * 128; const int f = (dk >> 1) & 7;
          *(LAS v4u*)(row + (((2 * jq) ^ f) * 16)) = (v4u){pk[0], pk[1], pk[2], pk[3]}; *(LAS v4u*)(row + (((2 * jq + 1) ^ f) * 16)) = (v4u){pk[4], pk[5], pk[6], pk[7]};
          if (jq == 0) DEC[unit * 128 + dk] = __expf(blast); }
        fill_vt(lds, lds + 16384, tid);
        __syncthreads();
        f4 acc[16];
        const int f = (c >> 1) & 7;
        bf16x8 aF[2];
#pragma unroll
        for (int ks = 0; ks < 2; ++ks) aF[ks] = *(const LAS bf16x8*)(lds + L_KT + (16 * wave + c) * 128 + (((4 * ks + gq) ^ f) * 16));
#pragma unroll
        for (int nt = 0; nt < 16; ++nt) { acc[nt] = (f4){0.f, 0.f, 0.f, 0.f};
#pragma unroll
            for (int ks = 0; ks < 2; ++ks) { const bf16x8 bF = *(const LAS bf16x8*)(lds + L_VT + (16 * nt + c) * 128 + (((4 * ks + gq) ^ f) * 16)); acc[nt] = __builtin_amdgcn_mfma_f32_16x16x32_bf16(aF[ks], bF, acc[nt], 0, 0, 0); } }
        char* dst = (char*)ST + (size_t)unit * (256 * 128 * 2) + (unsigned)((c * 128 + 16 * wave + 4 * gq) * 2);
#pragma unroll
        for (int nt = 0; nt < 16; ++nt) *(v2u*)(dst + nt * 16 * 256) = (v2u){pg8::cvt_pk_bf16(acc[nt][0], acc[nt][1]), pg8::cvt_pk_bf16(acc[nt][2], acc[nt][3])};
        __syncthreads();
    }
}
__device__ __forceinline__ void ph_gla_b(const Params& p, int gid, int gstride) {
    bf16* ST = (bf16*)(p.ws + WS_ST); const float* DEC = (const float*)(p.ws + WS_DEC);
    for (int e = gid; e < 32 * 4096; e += gstride) { const int bh = e >> 12, dv = (e >> 4) & 255, d8 = e & 15;
        float st[8];
#pragma unroll
        for (int i = 0; i < 8; ++i) st[i] = 0.f;
        char* base = (char*)ST + (size_t)bh * 64 * (256 * 128 * 2) + (unsigned)((dv * 128 + d8 * 8) * 2); const float* dbase = DEC + (size_t)bh * 64 * 128 + d8 * 8;
#pragma unroll 4
        for (int ch = 0; ch < 64; ++ch) { v4u* ptr = (v4u*)(base + (size_t)ch * (256 * 128 * 2)); const v4u w = *ptr; const f32x4 d0 = *(const f32x4*)(dbase + ch * 128), d1 = *(const f32x4*)(dbase + ch * 128 + 4);
            v4u o; o.x = pk2(st[0], st[1]); o.y = pk2(st[2], st[3]); o.z = pk2(st[4], st[5]); o.w = pk2(st[6], st[7]); *ptr = o;
            st[0] = st[0] * d0.x + bflo(w.x); st[1] = st[1] * d0.y + bfhi(w.x); st[2] = st[2] * d0.z + bflo(w.y); st[3] = st[3] * d0.w + bfhi(w.y);
            st[4] = st[4] * d1.x + bflo(w.z); st[5] = st[5] * d1.y + bfhi(w.z); st[6] = st[6] * d1.z + bflo(w.w); st[7] = st[7] * d1.w + bfhi(w.w); }
    }
}
__device__ __forceinline__ void ph_gla_c(const Params& p, LAS unsigned char* lds, int u0, int ustride, int tid_in, int wave) {
    using namespace gla;
    int tid = tid_in; asm volatile("" : "+v"(tid));
    const int lane = tid & 63, c = lane & 15, gq = lane >> 4, nt = wave & 3, half = wave >> 2;
    const bf16* GQ = (const bf16*)(p.ws + WS_GQ); const bf16* GK = (const bf16*)(p.ws + WS_GK); const bf16* GG = (const bf16*)(p.ws + WS_GG); const bf16* ST = (const bf16*)(p.ws + WS_ST);
    bf16* A2 = (bf16*)(p.ws + WS_A2); const float* gn = p.in[I_GLAG];
    const int koff0 = c * 256 + ((gq ^ c) * 16), voff0 = c * 128 + (((gq >> 1) ^ ((c >> 1) & 7)) * 16) + (gq & 1) * 8;
    for (int unit = u0; unit < 2048; unit += ustride) {
        const int bh = unit >> 6, ch = unit & 63, b = bh >> 2, h = bh & 3, t0 = b * SEQ + ch * 64;
        stage_raw_k(GQ, lds + 0, tid, t0, h); stage_raw_k(GK, lds + 16384, tid, t0, h); stage_raw_v(p, lds + 32768, tid, t0, h);
        float P[16], blast; chunk_cumsum(p, lds, tid, t0, h, P, blast);
        { const int dk = tid & 127, jq = tid >> 7;
#pragma unroll
          for (int jj = 0; jj < 16; ++jj) { const int j = 16 * jq + jj; const float qv = bf2f(*(const LAS bf16*)(lds + j * 256 + dk * 2)), kv = bf2f(*(const LAS bf16*)(lds + 16384 + j * 256 + dk * 2));
              const int off = j * 256 + (((dk >> 3) ^ (j & 15)) * 16) + (dk & 7) * 2;
              *(LAS bf16*)(lds + L_QT + off) = (bf16)f2bf(qv * __expf(P[jj])); *(LAS bf16*)(lds + L_KT + off) = (bf16)f2bf(kv * __expf(-P[jj])); } }
        fill_vt(lds, lds + 32768, tid);
        __syncthreads();
        { const char* src = (const char*)ST + (size_t)unit * (256 * 128 * 2);
#pragma unroll
          for (int i = 0; i < 8; ++i) { const int piece = 8 * wave + i, row = piece * 4 + (lane >> 4), chunk = (lane & 15) ^ (row & 15);
              __builtin_amdgcn_global_load_lds((const unsigned*)(src + (unsigned)(row * 256 + chunk * 16)), (LAS unsigned*)(lds + L_ST + piece * 1024), 16, 0, 0); } }
        asm volatile("s_waitcnt vmcnt(0)" ::: "memory"); __syncthreads();
        bf16x8 qF[4];
#pragma unroll
        for (int ks = 0; ks < 4; ++ks) qF[ks] = *(const LAS bf16x8*)(lds + L_QT + nt * 4096 + (koff0 ^ (ks * 64)));
        f4 sT[4];
#pragma unroll
        for (int jt = 0; jt < 4; ++jt) { sT[jt] = (f4){0.f, 0.f, 0.f, 0.f};
            if (jt <= nt) {
#pragma unroll
                for (int ks = 0; ks < 4; ++ks) { const bf16x8 a = *(const LAS bf16x8*)(lds + L_KT + jt * 4096 + (koff0 ^ (ks * 64))); sT[jt] = __builtin_amdgcn_mfma_f32_16x16x32_bf16(a, qF[ks], sT[jt], 0, 0, 0); }
                if (jt == nt) {
#pragma unroll
                    for (int rg = 0; rg < 4; ++rg) if (4 * gq + rg > c) sT[jt][rg] = 0.f; } } }
        bf16x8 pb[2];
#pragma unroll
        for (int s = 0; s < 2; ++s) { v4u w; w.x = pg8::cvt_pk_bf16(sT[2 * s][0], sT[2 * s][1]); w.y = pg8::cvt_pk_bf16(sT[2 * s][2], sT[2 * s][3]); w.z = pg8::cvt_pk_bf16(sT[2 * s + 1][0], sT[2 * s + 1][1]); w.w = pg8::cvt_pk_bf16(sT[2 * s + 1][2], sT[2 * s + 1][3]); pb[s] = __builtin_bit_cast(bf16x8, w); }
        f4 o[8]; float ss = 0.f;
#pragma unroll
        for (int mt = 0; mt < 8; ++mt) { o[mt] = (f4){0.f, 0.f, 0.f, 0.f}; const int rb = 128 * half + 16 * mt;
#pragma unroll
            for (int ks = 0; ks < 4; ++ks) { const bf16x8 a = *(const LAS bf16x8*)(lds + L_ST + rb * 256 + (koff0 ^ (ks * 64))); o[mt] = __builtin_amdgcn_mfma_f32_16x16x32_bf16(a, qF[ks], o[mt], 0, 0, 0); }
#pragma unroll
            for (int s = 0; s < 2; ++s) if (2 * s <= nt) { const v2u lo = *(const LAS v2u*)(lds + L_VT + rb * 128 + (voff0 ^ (s * 64))), hi = *(const LAS v2u*)(lds + L_VT + rb * 128 + (voff0 ^ (s * 64 + 32)));
                o[mt] = __builtin_amdgcn_mfma_f32_16x16x32_bf16(__builtin_bit_cast(bf16x8, (v4u){lo.x, lo.y, hi.x, hi.y}), pb[s], o[mt], 0, 0, 0); }
            ss += (o[mt][0] * o[mt][0] + o[mt][1] * o[mt][1]) + (o[mt][2] * o[mt][2] + o[mt][3] * o[mt][3]); }
        ss = nsa::radd32(nsa::radd16(ss));
        LAS float* red = (LAS float*)(lds + L_RED);
        if (gq == 0) red[half * 64 + 16 * nt + c] = ss;
        __syncthreads();
        const float rstd = 1.f / sqrtf((red[16 * nt + c] + red[64 + 16 * nt + c]) * (1.f / 256.f) + RMS_EPS);
        const int tok = t0 + 16 * nt + c;
#pragma unroll
        for (int mt = 0; mt < 8; ++mt) { const int dv = 128 * half + 16 * mt + 4 * gq; const f32x4 g4 = *(const f32x4*)((const char*)gn + (unsigned)(dv * 4));
            const v2u gg = *(const v2u*)((const char*)GG + (unsigned)((tok * 1024 + h * 256 + dv) * 2));
            const float z0 = bflo(gg.x), z1 = bfhi(gg.x), z2 = bflo(gg.y), z3 = bfhi(gg.y);
            v2u w; w.x = pg8::cvt_pk_bf16(o[mt][0] * rstd * g4.x * (z0 / (1.f + __expf(-z0))), o[mt][1] * rstd * g4.y * (z1 / (1.f + __expf(-z1))));
            w.y = pg8::cvt_pk_bf16(o[mt][2] * rstd * g4.z * (z2 / (1.f + __expf(-z2))), o[mt][3] * rstd * g4.w * (z3 / (1.f + __expf(-z3))));
            *(v2u*)((char*)A2 + (unsigned)((tok * DM + h * 256 + dv) * 2)) = w; }
        __syncthreads();
    }
}

constexpr size_t WS_LH = WS_DEC + (size_t)2048 * 128 * 4;
constexpr size_t WS_PEV = WS_LH + (size_t)2 * 4096 * 256 * 4;
static_assert(WS_PEV + 1024 <= WS_KCMP, "cmp scratch overlay");
struct CmpOrder {
    int c; const bf16 *kc, *vc, *wk, *wv;
    __device__ __forceinline__ bool next(int i, pg8::Unit& u) const { if (i > 0 || c >= 32) return false; u.pm = c & 15; u.pn = 0; u.kind = c >> 4; return true; }
    __device__ __forceinline__ const char* pa(const pg8::Gemm&, const pg8::Unit& u) const { return (const char*)(u.kind ? vc : kc) + (size_t)u.pm * ((size_t)256 * 2048 * 2); }
    __device__ __forceinline__ const char* pb(const pg8::Gemm&, const pg8::Unit& u) const { return (const char*)(u.kind ? wv : wk); }
    __device__ __forceinline__ void a_ready(const pg8::Unit&) const {}
    __device__ __forceinline__ void done(const pg8::Unit&) const {}
};
struct EpiLH {
    static constexpr bool PERM = false, AFTER_DRAIN = false;
    float* LH;
    __device__ __forceinline__ void operator()(const pg8::f32x4 (&acc)[2][2][4][2], const pg8::Unit& u, int wr, int wc, int fr, int fq) const {
        const int row0 = u.kind * 4096 + u.pm * 256 + wr * 64 + fr, col0 = wc * 32 + 4 * fq;
#pragma unroll
        for (int ai = 0; ai < 2; ++ai)
#pragma unroll
            for (int m = 0; m < 4; ++m) { float* rowp = LH + (size_t)(row0 + ai * 128 + m * 16) * 256 + col0;
#pragma unroll
                for (int bj = 0; bj < 2; ++bj)
#pragma unroll
                    for (int n = 0; n < 2; ++n) *(pg8::f32x4*)(rowp + bj * 128 + n * 16) = acc[ai][bj][m][n]; }
    }
};
__device__ __forceinline__ void cmp_pevec(const Params& p, LAS unsigned char* lds, int which, int tid) {
    const float* pe = p.in[which ? I_PEV : I_PEK]; const float* w1 = p.in[which ? I_WV1 : I_WK1]; LAS float* part = (LAS float*)lds;
    const int m = tid & 127, q = tid >> 7; float a = 0.f;
    __syncthreads();
    for (int k = q * 1024; k < q * 1024 + 1024; ++k) a += pe[k] * w1[(size_t)k * 128 + m];
    part[q * 128 + m] = a; __syncthreads();
    if (tid < 128) ((float*)(p.ws + WS_PEV))[which * 128 + tid] = (part[tid] + part[128 + tid]) + (part[256 + tid] + part[384 + tid]);
    __syncthreads();
}
__device__ __forceinline__ void cmp_finalize(const Params& p, LAS unsigned char* lds, int which, int bg, int tid_in, int wave) {
    int tid = tid_in; asm volatile("" : "+v"(tid));
    const int lane = tid & 63, c15 = lane & 15, gq = lane >> 4;
    constexpr int L_HID = 0, L_W2T = 65536;
    const float* LH = (const float*)(p.ws + WS_LH) + ((size_t)which * 4096 + bg * 256) * 256; const float* pev = (const float*)(p.ws + WS_PEV) + which * 128; const float* w2 = p.in[which ? I_WV2 : I_WK2];
    asm volatile("s_waitcnt vmcnt(0)" ::: "memory"); __syncthreads();
#pragma unroll
    for (int i = 0; i < 8; ++i) { const int id = tid + 512 * i, c = id >> 4, ch = id & 15; v4u w = (v4u){0u, 0u, 0u, 0u};
        if (c < 255) { const float* lp = LH + (size_t)c * 256 + 8 * ch; const float* hp = LH + (size_t)(c + 1) * 256 + 128 + 8 * ch;
            const f32x4 l0 = *(const f32x4*)lp, l1 = *(const f32x4*)(lp + 4), h0 = *(const f32x4*)hp, h1 = *(const f32x4*)(hp + 4), e0 = *(const f32x4*)(pev + 8 * ch), e1 = *(const f32x4*)(pev + 8 * ch + 4);
            w.x = pk2(gelu_tanh(l0.x + h0.x + e0.x), gelu_tanh(l0.y + h0.y + e0.y)); w.y = pk2(gelu_tanh(l0.z + h0.z + e0.z), gelu_tanh(l0.w + h0.w + e0.w));
            w.z = pk2(gelu_tanh(l1.x + h1.x + e1.x), gelu_tanh(l1.y + h1.y + e1.y)); w.w = pk2(gelu_tanh(l1.z + h1.z + e1.z), gelu_tanh(l1.w + h1.w + e1.w)); }
        *(LAS v4u*)(lds + L_HID + c * 256 + ((ch ^ (c & 15)) * 16)) = w; }
#pragma unroll 8
    for (int i = 0; i < 32; ++i) { const int id = tid + 512 * i, m = id >> 7, n = id & 127;
        *(LAS bf16*)(lds + L_W2T + n * 256 + (((m >> 3) ^ (n & 15)) * 16) + (m & 7) * 2) = (bf16)f2bf(w2[id]); }
    __syncthreads();
    const int koff0 = c15 * 256 + ((gq ^ c15) * 16);
    bf16* KCMP = (bf16*)(p.ws + WS_KCMP) + (size_t)bg * 256 * 128; bf16* VCMPT = (bf16*)(p.ws + WS_VCMPT) + (size_t)bg * 128 * 256;
#pragma unroll
    for (int ci = 0; ci < 2; ++ci) { const int ctile = 2 * wave + ci;
        bf16x8 hF[4];
#pragma unroll
        for (int ks = 0; ks < 4; ++ks) hF[ks] = *(const LAS bf16x8*)(lds + L_HID + ctile * 4096 + (koff0 ^ (ks * 64)));
#pragma unroll
        for (int ntile = 0; ntile < 8; ++ntile) { pg8::f32x4 d = (pg8::f32x4){0.f, 0.f, 0.f, 0.f};
#pragma unroll
            for (int ks = 0; ks < 4; ++ks) { const bf16x8 wF = *(const LAS bf16x8*)(lds + L_W2T + ntile * 4096 + (koff0 ^ (ks * 64)));
                d = which ? __builtin_amdgcn_mfma_f32_16x16x32_bf16(hF[ks], wF, d, 0, 0, 0) : __builtin_amdgcn_mfma_f32_16x16x32_bf16(wF, hF[ks], d, 0, 0, 0); }
            const v2u w = (v2u){pg8::cvt_pk_bf16(d[0], d[1]), pg8::cvt_pk_bf16(d[2], d[3])};
            if (which) *(v2u*)(VCMPT + (size_t)(16 * ntile + c15) * 256 + 16 * ctile + 4 * gq) = w;
            else *(v2u*)(KCMP + (size_t)(16 * ctile + c15) * 128 + 16 * ntile + 4 * gq) = w; } }
    __syncthreads();
}

constexpr size_t PROWS = (size_t)MAXTILES * 256;
constexpr size_t WS_W1Q = WS_W1T;
constexpr size_t WS_W2Q = WS_W1Q + (size_t)NE * 4096 * DM;
constexpr size_t WS_HN8 = WS_W2Q + (size_t)NE * DM * DFF;
constexpr size_t WS_AMAXP = WS_HN8 + (size_t)T * DM;
constexpr size_t WS_WSC1 = WS_AMAXP + PROWS * 64 * 4;
constexpr size_t WS_WSC2 = WS_WSC1 + (size_t)NE * 4096 * 4;
constexpr size_t WS_HSC = WS_WSC2 + (size_t)NE * 2048 * 4;
constexpr size_t WS_ROWSC = WS_HSC + (size_t)T * 4;
constexpr size_t WS_ASC = WS_ROWSC + PROWS * 4;
static_assert(WS_ASC + PROWS * 4 <= WS_XN, "int8 buffers fit in the retired bf16 expert-weight region");
constexpr size_t WS_XG8 = WS_XG;
constexpr size_t WS_ACT8 = WS_XG + PROWS * DM;
constexpr size_t WS_Y = WS_ACT;
static_assert(WS_ACT8 + PROWS * DM <= WS_ACT, "int8 row buffers fit in the retired gathered-row region");

__device__ __forceinline__ unsigned q8(float v) { int q = (int)rintf(v); q = q > 127 ? 127 : (q < -127 ? -127 : q); return (unsigned)q & 0xffu; }
__device__ __forceinline__ unsigned q8x4(float a, float b, float c, float d) { return q8(a) | (q8(b) << 8) | (q8(c) << 16) | (q8(d) << 24); }

constexpr size_t WS_WINQ = WS_WINT;
constexpr size_t WS_WISC = WS_WINT + (size_t)NPT * 256 * DM;
constexpr size_t WS_XN8 = WS_XN;
constexpr size_t WS_XSC = WS_XN + (size_t)T * DM;
constexpr size_t WS_PMAX = WS_HN;
constexpr size_t WS_PMAXI = WS_PMAX + (size_t)64 * 8 * 4096 * 4;
__device__ __forceinline__ void p0_absmax(const Params& p, int bid, int G, int tid) {
    float* PMAX = (float*)(p.ws + WS_PMAX);
    for (int it = bid; it < 8; it += G) {
        const float* src = p.in[I_WIN] + (size_t)it * 256 * 5672; float* dst = (float*)(p.ws + WS_PMAXI) + (size_t)it * 5696;
#pragma unroll
        for (int q = 0; q < 3; ++q) { const int c4 = tid + 512 * q; if (c4 < 1418) { f32x4 m0 = (f32x4){0.f, 0.f, 0.f, 0.f};
#pragma unroll 8
            for (int r = 0; r < 256; ++r) { const f32x4 a = *(const f32x4*)(src + (size_t)r * 5672 + c4 * 4); m0.x = fmaxf(m0.x, fabsf(a.x)); m0.y = fmaxf(m0.y, fabsf(a.y)); m0.z = fmaxf(m0.z, fabsf(a.z)); m0.w = fmaxf(m0.w, fabsf(a.w)); }
            *(f32x4*)(dst + c4 * 4) = m0; } } }
}
__device__ __forceinline__ void p0_quant(const Params& p, LAS unsigned char* lds, int gw, int NGW, int wave, int lane) {
    LAS float* scr = (LAS float*)(lds + wave * 16896);
    const float* PMAX = (const float*)(p.ws + WS_PMAX);
    signed char* W1Q = (signed char*)(p.ws + WS_W1Q); signed char* W2Q = (signed char*)(p.ws + WS_W2Q); float* WSC1 = (float*)(p.ws + WS_WSC1); float* WSC2 = (float*)(p.ws + WS_WSC2);
    for (int it = gw; it < 16 * 178; it += NGW) {
        const int kb = it / 178, nb = it % 178, n0 = nb * 32, k0 = kb * 128; const int nl = n0 + (lane & 31); const bool okc = nl < 5672;
        const float* W = p.in[I_WIN] + (size_t)k0 * 5672 + (okc ? nl : 0) + (size_t)(lane >> 5) * 5672;
        float w[64];
#pragma unroll
        for (int i = 0; i < 64; ++i) w[i] = W[(size_t)(2 * i) * 5672];
        float mx = 0.f;
#pragma unroll
        for (int q = 0; q < 8; ++q) mx = fmaxf(mx, ((const float*)(p.ws + WS_PMAXI))[(size_t)q * 5696 + (okc ? nl : 0)]);
        const float sc = mx > 0.f ? mx * (1.f / 127.f) : 1.f, ivl = 1.f / sc; float qsc; const int rowl = okc ? win_row(nl, qsc) : -1;
        if (kb == 0 && lane < 32 && okc) ((float*)(p.ws + WS_WISC))[rowl] = sc * qsc;
#pragma unroll
        for (int i = 0; i < 64; ++i) scr[(2 * i + (lane >> 5)) * 33 + (lane & 31)] = w[i];
        LDS_WAIT(); asm volatile("" ::: "memory");
        const int c = lane & 7;
#pragma unroll
        for (int j = 0; j < 4; ++j) { const int nn = (lane >> 3) + 8 * j; const float iv = __shfl(ivl, nn); const int rown = __shfl(rowl, nn); const LAS float* s = scr + (16 * c) * 33 + nn; v4u o;
            o.x = q8x4(s[0] * iv, s[33] * iv, s[66] * iv, s[99] * iv); o.y = q8x4(s[132] * iv, s[165] * iv, s[198] * iv, s[231] * iv);
            o.z = q8x4(s[264] * iv, s[297] * iv, s[330] * iv, s[363] * iv); o.w = q8x4(s[396] * iv, s[429] * iv, s[462] * iv, s[495] * iv);
            if (rown >= 0) *(v4u*)((signed char*)(p.ws + WS_WINQ) + (size_t)rown * 2048 + k0 + 16 * c) = o; }
        LDS_WAIT(); asm volatile("" ::: "memory"); }
}

constexpr int NSLAB_E = NE * 192, NSLAB = NSLAB_E + 178;
struct SlabSrc { const float* W; int N; bool ok; };
__device__ __forceinline__ SlabSrc slab_src(const Params& p, int sl, int r0, int n4) {
    SlabSrc s;
    if (sl < NSLAB_E) { const int e = sl / 192, r = sl % 192; const bool isw2 = r >= 128; const int nb = isw2 ? r - 128 : r; s.N = isw2 ? 2048 : 4096;
        s.W = (isw2 ? p.in[I_W2] + (size_t)e * DFF * DM : p.in[I_W1] + (size_t)e * DM * 4096) + (size_t)r0 * s.N + nb * 32 + 4 * n4; s.ok = true; }
    else { const int nb = sl - NSLAB_E; s.N = 5672; s.ok = nb * 32 + 4 * n4 < 5672; s.W = p.in[I_WIN] + (size_t)r0 * 5672 + (s.ok ? nb * 32 + 4 * n4 : 0); }
    return s;
}
__device__ __forceinline__ void p0_slab_quant(const Params& p, LAS unsigned char* lds, int bid, int G, int tid) {
    constexpr int RS = 4104;
    LAS unsigned char* TT = lds; LAS float* part = (LAS float*)(lds + 32 * RS); LAS float* inv = part + 64 * 32; LAS int* drow = (LAS int*)(inv + 32);
    signed char* W1Q = (signed char*)(p.ws + WS_W1Q); signed char* W2Q = (signed char*)(p.ws + WS_W2Q); signed char* WIQ = (signed char*)(p.ws + WS_WINQ);
    float* WSC1 = (float*)(p.ws + WS_WSC1); float* WSC2 = (float*)(p.ws + WS_WSC2); float* WISC = (float*)(p.ws + WS_WISC);
    const int n4 = tid & 7, r0 = tid >> 3;
    f32x4 vn[8];
    if (bid < NSLAB) { const SlabSrc s0 = slab_src(p, bid, r0, n4);
#pragma unroll
        for (int u = 0; u < 8; ++u) vn[u] = __builtin_nontemporal_load((const f32x4*)(s0.W + (size_t)(64 * u) * s0.N)); }
    for (int slab = bid; slab < NSLAB; slab += G) {
        const SlabSrc sc_ = slab_src(p, slab, r0, n4);
        f32x4 mx = (f32x4){0.f, 0.f, 0.f, 0.f};
#pragma unroll
        for (int ib = 0; ib < 4; ++ib) { f32x4 v[8];
#pragma unroll
            for (int u = 0; u < 8; ++u) v[u] = sc_.ok ? vn[u] : (f32x4){0.f, 0.f, 0.f, 0.f};
            if (ib < 3) {
#pragma unroll
                for (int u = 0; u < 8; ++u) vn[u] = __builtin_nontemporal_load((const f32x4*)(sc_.W + (size_t)(64 * (8 * (ib + 1) + u)) * sc_.N)); }
            else if (slab + G < NSLAB) { const SlabSrc sn = slab_src(p, slab + G, r0, n4);
#pragma unroll
                for (int u = 0; u < 8; ++u) vn[u] = __builtin_nontemporal_load((const f32x4*)(sn.W + (size_t)(64 * u) * sn.N)); }
#pragma unroll
            for (int u = 0; u < 8; ++u) { const int k = r0 + 64 * (8 * ib + u);
                mx.x = fmaxf(mx.x, fabsf(v[u].x)); mx.y = fmaxf(mx.y, fabsf(v[u].y)); mx.z = fmaxf(mx.z, fabsf(v[u].z)); mx.w = fmaxf(mx.w, fabsf(v[u].w));
                LAS unsigned char* d = TT + (4 * n4) * RS + k * 2;
                *(LAS bf16*)d = (bf16)f2bf(v[u].x); *(LAS bf16*)(d + RS) = (bf16)f2bf(v[u].y); *(LAS bf16*)(d + 2 * RS) = (bf16)f2bf(v[u].z); *(LAS bf16*)(d + 3 * RS) = (bf16)f2bf(v[u].w); } }
        *(LAS f32x4*)(part + r0 * 32 + 4 * n4) = mx;
        __syncthreads();
        if (tid < 32) { float m = 0.f;
#pragma unroll 8
            for (int q = 0; q < 64; ++q) m = fmaxf(m, part[q * 32 + tid]);
            const float sc = m > 0.f ? m * (1.f / 127.f) : 1.f; inv[tid] = 1.f / sc;
            if (slab < NSLAB_E) { const int e = slab / 192, r = slab % 192; const bool isw2 = r >= 128; const int n = (isw2 ? r - 128 : r) * 32 + tid;
                if (isw2) { drow[tid] = e * 2048 + n; WSC2[e * 2048 + n] = sc; }
                else { const int j2 = n & 2047, row = (j2 >> 7) * 256 + (n >= 2048 ? 128 : 0) + (j2 & 127); drow[tid] = e * 4096 + row; WSC1[e * 4096 + row] = sc; } }
            else { const int n = (slab - NSLAB_E) * 32 + tid; if (n < 5672) { float qsc; const int row = win_row(n, qsc); drow[tid] = row; WISC[row] = sc * qsc; } else drow[tid] = -1; } }
        __syncthreads();
        { const int kc = tid & 7, n = (tid >> 3) & 31, hf = tid >> 8; const float iv = inv[n]; const int dr = drow[n];
          signed char* dst = (slab < NSLAB_E ? ((slab % 192) >= 128 ? W2Q : W1Q) : WIQ) + (size_t)(dr < 0 ? 0 : dr) * 2048; const LAS unsigned char* src = TT + n * RS;
          if (dr >= 0) {
#pragma unroll
          for (int m8 = 0; m8 < 8; ++m8) { const int k0 = 16 * (kc + 8 * (hf + 2 * m8)); const LAS v2u* sp = (const LAS v2u*)(src + k0 * 2); const v2u a = sp[0], b = sp[1], c = sp[2], d = sp[3]; v4u o;
              o.x = q8x4(bflo(a.x) * iv, bfhi(a.x) * iv, bflo(a.y) * iv, bfhi(a.y) * iv); o.y = q8x4(bflo(b.x) * iv, bfhi(b.x) * iv, bflo(b.y) * iv, bfhi(b.y) * iv);
              o.z = q8x4(bflo(c.x) * iv, bfhi(c.x) * iv, bflo(c.y) * iv, bfhi(c.y) * iv); o.w = q8x4(bflo(d.x) * iv, bfhi(d.x) * iv, bflo(d.y) * iv, bfhi(d.y) * iv);
              *(v4u*)(dst + k0) = o; } } }
        __syncthreads();
    }
}
struct EpiSwigluI8 {
    static constexpr bool PERM = true, AFTER_DRAIN = false;
    const float* b1; const float* rowsc; const float* wsc1; bf16* act; float* amaxp;
    __device__ __forceinline__ void operator()(const pg8::f32x4 (&acc)[2][2][4][2], const pg8::Unit& u, int wr, int wc, int fr, int fq) const {
        const int e = u.kind; const int cin = wc * 32 + 8 * fq; const int col = u.pn * 128 + cin; const int row0 = u.pm * 256 + wr * 64 + fr;
        const float* bg = b1 + (size_t)e * 4096 + col; const float* bl = bg + 2048; const float* sg = wsc1 + (size_t)e * 4096 + u.pn * 256 + cin; const float* sl = sg + 128;
        float gb[8], lb[8], gs[8], ls[8];
#pragma unroll
        for (int j = 0; j < 8; ++j) { gb[j] = bg[j]; lb[j] = bl[j]; gs[j] = sg[j]; ls[j] = sl[j]; }
#pragma unroll
        for (int ai = 0; ai < 2; ++ai)
#pragma unroll
            for (int m = 0; m < 4; ++m) { const int r = row0 + ai * 128 + m * 16; const float rs = rowsc[r]; float o[8]; float mx = 0.f;
#pragma unroll
                for (int n = 0; n < 2; ++n)
#pragma unroll
                    for (int j = 0; j < 4; ++j) { float gl = (float)__float_as_int(acc[ai][0][m][n][j]) * (rs * gs[n * 4 + j]) + gb[n * 4 + j]; float li = (float)__float_as_int(acc[ai][1][m][n][j]) * (rs * ls[n * 4 + j]) + lb[n * 4 + j];
                        gl = fminf(gl, 7.f); li = fminf(fmaxf(li, -7.f), 7.f);
                        const float v = gl * __builtin_amdgcn_rcpf(1.f + __builtin_amdgcn_exp2f(-2.4554669595930156f * gl)) * (li + 1.f); o[n * 4 + j] = v; mx = fmaxf(mx, fabsf(v)); }
                mx = nsa::rmax32(nsa::rmax16(mx));
                if (fq == 0) amaxp[(size_t)r * 64 + u.pn * 4 + wc] = mx;
                pg8::u32x4 w; w.x = pg8::cvt_pk_bf16(o[0], o[1]); w.y = pg8::cvt_pk_bf16(o[2], o[3]); w.z = pg8::cvt_pk_bf16(o[4], o[5]); w.w = pg8::cvt_pk_bf16(o[6], o[7]);
                *(pg8::u32x4*)(act + (size_t)r * DFF + col) = w; }
    }
};
__device__ __forceinline__ void ph_actq(const Params& p, int gw, int NGW, int lane) {
    const int nrows = ((const int*)(p.ws + WS_META))[0] * 256; const float* amaxp = (const float*)(p.ws + WS_AMAXP); const bf16* act = (const bf16*)(p.ws + WS_ACT);
    signed char* A8 = (signed char*)(p.ws + WS_ACT8); float* ASC = (float*)(p.ws + WS_ASC);
    for (int r = gw; r < nrows; r += NGW) { const float mx = wave_max(amaxp[(size_t)r * 64 + lane]); const float sc = mx > 0.f ? mx * (1.f / 127.f) : 1.f, iv = 1.f / sc;
        const v4u* src = (const v4u*)(act + (size_t)r * DFF) + lane * 4; v4u a[4];
#pragma unroll
        for (int j = 0; j < 4; ++j) a[j] = src[j];
        v4u o[2];
#pragma unroll
        for (int h = 0; h < 2; ++h) { const v4u x = a[2 * h], y = a[2 * h + 1];
            o[h].x = q8x4(bflo(x.x) * iv, bfhi(x.x) * iv, bflo(x.y) * iv, bfhi(x.y) * iv); o[h].y = q8x4(bflo(x.z) * iv, bfhi(x.z) * iv, bflo(x.w) * iv, bfhi(x.w) * iv);
            o[h].z = q8x4(bflo(y.x) * iv, bfhi(y.x) * iv, bflo(y.y) * iv, bfhi(y.y) * iv); o[h].w = q8x4(bflo(y.z) * iv, bfhi(y.z) * iv, bflo(y.w) * iv, bfhi(y.w) * iv); }
        v4u* dst = (v4u*)(A8 + (size_t)r * DFF) + lane * 2; dst[0] = o[0]; dst[1] = o[1];
        if (lane == 0) ASC[r] = sc; }
}
struct EpiDownI8 {
    static constexpr bool PERM = true, AFTER_DRAIN = false;
    const float* b2; const float* roww; const float* asc; const float* wsc2; bf16* y;
    __device__ __forceinline__ void operator()(const pg8::f32x4 (&acc)[2][2][4][2], const pg8::Unit& u, int wr, int wc, int fr, int fq) const {
        const int e = u.kind; const int col0 = u.pn * 256 + wc * 32 + 8 * fq; const int row0 = u.pm * 256 + wr * 64 + fr;
        float bv[2][8], sv[2][8];
#pragma unroll
        for (int bj = 0; bj < 2; ++bj)
#pragma unroll
            for (int j = 0; j < 8; ++j) { bv[bj][j] = b2[(size_t)e * DM + col0 + bj * 128 + j]; sv[bj][j] = wsc2[(size_t)e * DM + col0 + bj * 128 + j]; }
#pragma unroll
        for (int ai = 0; ai < 2; ++ai)
#pragma unroll
            for (int m = 0; m < 4; ++m) { const int r = row0 + ai * 128 + m * 16; const float g = roww[r], as = asc[r];
#pragma unroll
                for (int bj = 0; bj < 2; ++bj) { float o[8];
#pragma unroll
                    for (int n = 0; n < 2; ++n)
#pragma unroll
                        for (int j = 0; j < 4; ++j) o[n * 4 + j] = ((float)__float_as_int(acc[ai][bj][m][n][j]) * (as * sv[bj][n * 4 + j]) + bv[bj][n * 4 + j]) * g;
                    pg8::u32x4 w; w.x = pg8::cvt_pk_bf16(o[0], o[1]); w.y = pg8::cvt_pk_bf16(o[2], o[3]); w.z = pg8::cvt_pk_bf16(o[4], o[5]); w.w = pg8::cvt_pk_bf16(o[6], o[7]);
                    *(pg8::u32x4*)(y + (size_t)r * DM + col0 + bj * 128) = w; } }
    }
};

struct EpiProjI8 {
    static constexpr bool PERM = true, AFTER_DRAIN = false;
    unsigned char* ws;
    __device__ __forceinline__ void operator()(const pg8::f32x4 (&acc)[2][2][4][2], const pg8::Unit& u, int wr, int wc, int fr, int fq) const {
        const int cw = wc * 32 + 8 * fq; const float* XSC = (const float*)(ws + WS_XSC); const float* WISC = (const float*)(ws + WS_WISC);
        if (u.kind == 0) {
            const int tn = u.pn; bf16* base; size_t bjs = 128; int ld = 0; bool headmajor = false; bool small = false;
            if (tn < 2) { base = (bf16*)(ws + WS_GQ) + tn * 256; ld = 512; }
            else if (tn < 4) { base = (bf16*)(ws + WS_GK) + (tn - 2) * 256; ld = 512; }
            else if (tn < 8) { base = (bf16*)(ws + WS_GV) + (tn - 4) * 256; ld = 1024; }
            else if (tn < 12) { base = (bf16*)(ws + WS_GG) + (tn - 8) * 256; ld = 1024; }
            else if (tn < 16) { base = (bf16*)(ws + WS_NQ) + (tn - 12) * 256; ld = 1024; }
            else if (tn < 20) { base = (bf16*)(ws + (tn == 16 ? WS_KC : tn == 17 ? WS_VC : tn == 18 ? WS_KS : WS_KW)); headmajor = true; bjs = (size_t)SEQ * 128; }
            else { base = (bf16*)(ws + WS_SM); ld = 64; small = true; }
            if (small && wc >= 2) return;
            float cs[2][8];
#pragma unroll
            for (int bj = 0; bj < 2; ++bj)
#pragma unroll
                for (int j = 0; j < 8; ++j) cs[bj][j] = WISC[tn * 256 + bj * 128 + cw + j];
#pragma unroll
            for (int ai = 0; ai < 2; ++ai)
#pragma unroll
                for (int m = 0; m < 4; ++m) { const int r = u.pm * 256 + ai * 128 + wr * 64 + m * 16 + fr; const float rs = XSC[r];
                    const size_t rterm = headmajor ? ((size_t)(r >> 12) * 2 * SEQ + (r & (SEQ - 1))) * 128 : (size_t)r * ld;
#pragma unroll
                    for (int bj = 0; bj < 2; ++bj) { if (small && bj) continue; float o[8];
#pragma unroll
                        for (int n = 0; n < 2; ++n)
#pragma unroll
                            for (int j = 0; j < 4; ++j) o[n * 4 + j] = (float)__float_as_int(acc[ai][bj][m][n][j]) * (rs * cs[bj][n * 4 + j]);
                        pg8::u32x4 w; w.x = pg8::cvt_pk_bf16(o[0], o[1]); w.y = pg8::cvt_pk_bf16(o[2], o[3]); w.z = pg8::cvt_pk_bf16(o[4], o[5]); w.w = pg8::cvt_pk_bf16(o[6], o[7]);
                        *(pg8::u32x4*)(base + rterm + bj * bjs + cw) = w; } }
        } else {
            bf16* base = (bf16*)(ws + (u.pn == 21 ? WS_VST : WS_VWT));
#pragma unroll
            for (int ai = 0; ai < 2; ++ai)
#pragma unroll
                for (int m = 0; m < 4; ++m) { const int dh = wr * 64 + m * 16 + fr; const float ws_ = WISC[u.pn * 256 + ai * 128 + dh];
#pragma unroll
                    for (int bj = 0; bj < 2; ++bj) { const int tok = u.pm * 256 + bj * 128 + cw; const int b = tok >> 12, s = tok & (SEQ - 1); float o[8];
                        const pg8::f32x4 x0 = *(const pg8::f32x4*)(XSC + tok), x1 = *(const pg8::f32x4*)(XSC + tok + 4);
#pragma unroll
                        for (int j = 0; j < 4; ++j) { o[j] = (float)__float_as_int(acc[ai][bj][m][0][j]) * (ws_ * x0[j]); o[4 + j] = (float)__float_as_int(acc[ai][bj][m][1][j]) * (ws_ * x1[j]); }
                        pg8::u32x4 w; w.x = pg8::cvt_pk_bf16(o[0], o[1]); w.y = pg8::cvt_pk_bf16(o[2], o[3]); w.z = pg8::cvt_pk_bf16(o[4], o[5]); w.w = pg8::cvt_pk_bf16(o[6], o[7]);
                        *(pg8::u32x4*)(base + ((size_t)(b * 2 + ai) * 128 + dh) * SEQ + s) = w; } }
        }
    }
};

__device__ __forceinline__ void r1_router(const Params& p, LAS unsigned char* lds, int vb, int tid, int wave, int lane) {
    LAS float* rowbuf = (LAS float*)lds;
    LAS float* part = (LAS float*)(lds + 65536);
    LAS int* tk = (LAS int*)(lds + 81920 + wave * 1024);
    LAS int* cntw = (LAS int*)(lds + 90112);
    const float* h = p.out; const float* gf = p.in[I_NFFN]; const float* rw = p.in[I_RW]; const float* rb = p.in[I_RB];
    signed char* HN8 = (signed char*)(p.ws + WS_HN8);
    const int e = lane & 31, eg = tid & 31, dg = tid >> 5; int mycount = 0;
    float rwr[128];
#pragma unroll
    for (int c4 = 0; c4 < 4; ++c4) { unsigned o = (unsigned)((((dg * 128 + c4 * 32) * 32) + eg) * 4); asm volatile("" : "+v"(o));
#pragma unroll
        for (int i = 0; i < 32; ++i) rwr[c4 * 32 + i] = *(const float*)((const char*)rw + o + i * 128); }
    for (int grp = 0; grp < 16; ++grp) { const int t = vb * TPV + grp * 8 + wave;
        { const f32x4* xr = (const f32x4*)(h + (size_t)t * DM) + lane; f32x4 v[8]; float s = 0.f;
#pragma unroll
          for (int j = 0; j < 8; ++j) { v[j] = xr[64 * j]; s += (v[j].x * v[j].x + v[j].y * v[j].y) + (v[j].z * v[j].z + v[j].w * v[j].w); }
          const float rstd = 1.f / sqrtf(wave_sum(s) * (1.f / DM) + RMS_EPS);
          float mxr = 0.f; LAS f32x4* hrow = (LAS f32x4*)(rowbuf + wave * 2048);
#pragma unroll
          for (int j = 0; j < 8; ++j) { const f32x4 g4 = ((const f32x4*)gf)[lane + 64 * j]; f32x4 y; y.x = v[j].x * rstd * g4.x; y.y = v[j].y * rstd * g4.y; y.z = v[j].z * rstd * g4.z; y.w = v[j].w * rstd * g4.w;
              v[j] = y; hrow[lane + 64 * j] = y; mxr = fmaxf(mxr, fmaxf(fmaxf(fabsf(y.x), fabsf(y.y)), fmaxf(fabsf(y.z), fabsf(y.w)))); }
          mxr = wave_max(mxr); const float qs = mxr > 0.f ? mxr * (1.f / 127.f) : 1.f, qi = 1.f / qs;
          unsigned* o4 = (unsigned*)(HN8 + (size_t)t * DM) + lane;
#pragma unroll
          for (int j = 0; j < 8; ++j) o4[64 * j] = q8x4(v[j].x * qi, v[j].y * qi, v[j].z * qi, v[j].w * qi);
          if (lane == 0) ((float*)(p.ws + WS_HSC))[t] = qs; }
        __syncthreads();
        { float acc[8];
#pragma unroll
          for (int tt = 0; tt < 8; ++tt) acc[tt] = 0.f;
#pragma unroll
          for (int i4 = 0; i4 < 32; ++i4) { f32x4 xv[8];
#pragma unroll
              for (int tt = 0; tt < 8; ++tt) xv[tt] = *(const LAS f32x4*)(rowbuf + tt * 2048 + dg * 128 + 4 * i4);
#pragma unroll
              for (int tt = 0; tt < 8; ++tt) acc[tt] += xv[tt].x * rwr[4 * i4] + xv[tt].y * rwr[4 * i4 + 1] + xv[tt].z * rwr[4 * i4 + 2] + xv[tt].w * rwr[4 * i4 + 3];
              if (i4 & 1) asm volatile("" ::: "memory"); }
#pragma unroll
          for (int tt = 0; tt < 8; ++tt) part[(dg * 8 + tt) * 32 + eg] = acc[tt]; }
        __syncthreads();
        { float a = rb[e];
#pragma unroll
          for (int q = 0; q < 16; ++q) a += part[(q * 8 + wave) * 32 + e];
          int rank = 0;
#pragma unroll
          for (int mm = 0; mm < 32; ++mm) { const float lm = __shfl(a, mm); rank += (lm > a || (lm == a && mm < e)) ? 1 : 0; }
          const float mx = wave_max(a); const bool sel = rank < 4;
          const float ex = (sel && lane < 32) ? __expf(a - mx) : 0.f; const float sum = wave_sum(ex);
          if (sel && lane < 32) { LAS int* q = tk + (grp * 4 + rank) * 4; q[0] = e; q[1] = mycount; q[2] = __builtin_bit_cast(int, ex / sum); ++mycount; } }
        __syncthreads();
    }
    if (lane < 32) cntw[wave * 32 + lane] = mycount;
    __syncthreads();
    if (wave == 0 && lane < 32) { int tot = 0; for (int w = 0; w < 8; ++w) tot += cntw[w * 32 + lane]; ((int*)(p.ws + WS_CNT))[vb * 32 + lane] = tot; }
    { const int i = lane >> 2, k = lane & 3; const LAS int* q = tk + (i * 4 + k) * 4; const int ee = q[0]; int base = 0; for (int w = 0; w < wave; ++w) base += cntw[w * 32 + ee];
      const int t = vb * TPV + i * 8 + wave;
      ((int*)(p.ws + WS_EIDX))[t * 4 + k] = ee; ((int*)(p.ws + WS_LRNK))[t * 4 + k] = base + q[1]; ((int*)(p.ws + WS_GATE))[t * 4 + k] = q[2]; }
    __syncthreads();
}
__device__ __forceinline__ void r2_gather(const Params& p, LAS unsigned char* lds, int vb, bool write_meta, int tid, int wave, int lane) {
    LAS int* part_tot = (LAS int*)lds;
    LAS int* part_base = part_tot + 512;
    LAS int* pbase = part_base + 512;
    const int* CNT = (const int*)(p.ws + WS_CNT);
    { const int e = tid & 31, part = tid >> 5; int tot = 0, bs = 0;
      for (int v = part * 16; v < part * 16 + 16; ++v) { const int c = CNT[v * 32 + e]; tot += c; if (v < vb) bs += c; }
      part_tot[part * 32 + e] = tot; part_base[part * 32 + e] = bs; }
    __syncthreads();
    if (tid == 0) { int ps = 0; int* meta = (int*)(p.ws + WS_META); int nt = 0;
        for (int e = 0; e < 32; ++e) { int tot = 0, bs = 0; for (int q = 0; q < 16; ++q) { tot += part_tot[q * 32 + e]; bs += part_base[q * 32 + e]; }
            pbase[e] = ps + bs; const int ntile = (tot + 255) >> 8;
            if (write_meta) for (int q = 0; q < ntile; ++q) meta[64 + nt + q] = e;
            nt += ntile; ps += ntile * 256; }
        if (write_meta) meta[0] = nt; }
    __syncthreads();
    const signed char* HN8 = (const signed char*)(p.ws + WS_HN8); signed char* XG8 = (signed char*)(p.ws + WS_XG8); const float* HSC = (const float*)(p.ws + WS_HSC); float* ROWSC = (float*)(p.ws + WS_ROWSC);
    const int* EIDX = (const int*)(p.ws + WS_EIDX); const int* LRNK = (const int*)(p.ws + WS_LRNK); const float* GATE = (const float*)(p.ws + WS_GATE);
    int* POS = (int*)(p.ws + WS_POS); float* ROWW = (float*)(p.ws + WS_ROWW);
    for (int i0 = 0; i0 < 16; i0 += 4) {
        v4u v0[4], v1[4]; float hs[4]; int ee[4][4], lr[4][4]; float gt[4][4];
#pragma unroll
        for (int u = 0; u < 4; ++u) { const int t = vb * TPV + (i0 + u) * 8 + wave; const v4u* src = (const v4u*)(HN8 + (size_t)t * DM) + lane; v0[u] = src[0]; v1[u] = src[64]; hs[u] = HSC[t];
#pragma unroll
            for (int k = 0; k < 4; ++k) { ee[u][k] = EIDX[t * 4 + k]; lr[u][k] = LRNK[t * 4 + k]; gt[u][k] = GATE[t * 4 + k]; } }
#pragma unroll
        for (int u = 0; u < 4; ++u) { const int t = vb * TPV + (i0 + u) * 8 + wave;
#pragma unroll
            for (int k = 0; k < 4; ++k) { const int pos = pbase[ee[u][k]] + lr[u][k];
                if (lane == 0) { POS[t * 4 + k] = pos; ROWW[pos] = gt[u][k]; ROWSC[pos] = hs[u]; }
                v4u* dst = (v4u*)(XG8 + (size_t)pos * DM) + lane; dst[0] = v0[u]; dst[64] = v1[u]; } } }
    __syncthreads();
}
__device__ __forceinline__ void pf_final(const Params& p, int gw, int NGW, int lane) {
    const bf16* Y = (const bf16*)(p.ws + WS_Y); const int* POS = (const int*)(p.ws + WS_POS); const float* gfin = p.in[I_NFIN];
    for (int t = gw; t < T; t += NGW) {
        f32x4* xr = (f32x4*)(p.out + (size_t)t * DM) + lane; f32x4 v[8];
#pragma unroll
        for (int j = 0; j < 8; ++j) v[j] = xr[64 * j];
#pragma unroll
        for (int k = 0; k < 4; ++k) { const int pos = POS[t * 4 + k]; const v2u* yr = (const v2u*)(Y + (size_t)pos * DM) + lane;
#pragma unroll
            for (int j = 0; j < 8; ++j) { const v2u w = yr[64 * j]; v[j].x += bflo(w.x); v[j].y += bfhi(w.x); v[j].z += bflo(w.y); v[j].w += bfhi(w.y); } }
        float s = 0.f;
#pragma unroll
        for (int j = 0; j < 8; ++j) s += (v[j].x * v[j].x + v[j].y * v[j].y) + (v[j].z * v[j].z + v[j].w * v[j].w);
        const float rstd = 1.f / sqrtf(wave_sum(s) * (1.f / DM) + RMS_EPS);
#pragma unroll
        for (int j = 0; j < 8; ++j) { const f32x4 g4 = ((const f32x4*)gfin)[lane + 64 * j]; f32x4 o; o.x = v[j].x * rstd * g4.x; o.y = v[j].y * rstd * g4.y; o.z = v[j].z * rstd * g4.z; o.w = v[j].w * rstd * g4.w; xr[64 * j] = o; }
    }
}


constexpr int LDS_BYTES = 159744;
constexpr int MISC_OFF = LDS_BYTES - 256;  static_assert(nsa::LDS_END <= MISC_OFF && gla::L_END <= MISC_OFF, "LDS map");
constexpr int CW_BAR = 4096, CW_XL = 16384;
__global__ __launch_bounds__(512, 2) void mega_fwd(Params p) {
    extern __shared__ __attribute__((aligned(16))) unsigned char lds_raw[];
    LAS unsigned char* lds = (LAS unsigned char*)lds_raw;
    const int G = gridDim.x, bid = blockIdx.x, NGW = G * 8;
#define PH_IDS int tid = threadIdx.x; asm volatile("" : "+v"(tid)); const int lane = tid & 63, wave = __builtin_amdgcn_readfirstlane(tid >> 6), gw = bid * 8 + wave; (void)lane; (void)gw;
    for (int u = threadIdx.x; u < 64; u += 512) ((LAS unsigned*)(lds + MISC_OFF))[u] = 0u;
    __syncthreads();
    XcdBarrier bar = xcd_barrier_post((unsigned*)(p.ws + WS_CTL) + CW_BAR, (volatile LAS unsigned*)(lds + MISC_OFF) + 8);
    { PH_IDS; p0_prologue(p, lds, gw, NGW, wave, lane); __syncthreads(); p0_slab_quant(p, lds, bid, G, tid); }
    xcd_barrier(bar);
    { pg8::Gemm g{(const bf16*)(p.ws + WS_XN8), (const bf16*)(p.ws + WS_WINQ), T, NPT * 256, DM / 2};
      ProjOrder S; S.init(T, NPT * 256, G, bid); S.xn = g.A; S.wt = g.Bt; EpiProjI8 E{p.ws};
      pg8::gemm_phase<EpiProjI8, ProjOrder, true, true, true>(lds, g, S, E); }
    xcd_barrier(bar);
    if (bid < 32) {
        pg8::Gemm g{(const bf16*)(p.ws + WS_KC), (const bf16*)(p.ws + WS_WKCT), 4096, 256, 2048};
        CmpOrder S{bid, (const bf16*)(p.ws + WS_KC), (const bf16*)(p.ws + WS_VC), (const bf16*)(p.ws + WS_WKCT), (const bf16*)(p.ws + WS_WVCT)}; EpiLH E{(float*)(p.ws + WS_LH)};
        pg8::gemm_phase<EpiLH, CmpOrder, true, true>(lds, g, S, E);
    } else { PH_IDS; ph_gla_a(p, lds, bid - 32, G - 32, tid, wave); }
    xcd_barrier(bar);
    { PH_IDS; ph_gla_b(p, bid * 512 + tid, G * 512);
      for (int i = bid * 512 + tid; i < 16 * 128; i += G * 512) { const int bgz = i >> 7, dz = i & 127; ((bf16*)(p.ws + WS_KCMP))[((size_t)bgz * 256 + 255) * 128 + dz] = 0; ((bf16*)(p.ws + WS_VCMPT))[((size_t)bgz * 128 + dz) * 256 + 255] = 0; }
      const int ngrp = G * 4, total = 2 * 16 * 255, iters = (total + ngrp - 1) / ngrp; const int grp = tid >> 7;
      for (int it = 0; it < iters; ++it) { int id = it * ngrp + bid * 4 + grp; if (id >= total) id = total - 1;
          ph_cmp_fin_simple(p, (LAS float*)lds + grp * 4352, id, tid & 127, (const float*)(p.ws + WS_LH), (const float*)(p.ws + WS_PEVP)); __syncthreads(); } }
    xcd_barrier(bar);
    { PH_IDS; ph_nsa(p, lds, bid, G, tid, wave); }
    { PH_IDS; __syncthreads(); ph_gla_c(p, lds, bid, G, tid, wave); }
    xcd_barrier(bar);
    { pg8::Gemm g{(const bf16*)(p.ws + WS_A2), (const bf16*)(p.ws + WS_WOT), T, DM, DM};
      pg8::StaticOrder S; S.init(T, DM, G, bid); EpiRes E{p.in[I_X], p.out};
      pg8::gemm_phase<EpiRes, pg8::StaticOrder, true, true>(lds, g, S, E); }
    xcd_barrier(bar);
    { PH_IDS; for (int vb = bid; vb < NVB; vb += G) r1_router(p, lds, vb, tid, wave, lane); }
    xcd_barrier(bar);
    { PH_IDS; for (int vb = bid; vb < NVB; vb += G) r2_gather(p, lds, vb, vb == 0, tid, wave, lane); }
    xcd_barrier(bar);
    { pg8::Gemm g{(const bf16*)(p.ws + WS_XG8), (const bf16*)(p.ws + WS_W1Q), MAXTILES * 256, 4096, DM / 2};
      MoeOrder S; S.init((const int*)(p.ws + WS_META), 16, G, bid); EpiSwigluI8 E{p.in[I_B1], (const float*)(p.ws + WS_ROWSC), (const float*)(p.ws + WS_WSC1), (bf16*)(p.ws + WS_ACT), (float*)(p.ws + WS_AMAXP)};
      pg8::gemm_phase<EpiSwigluI8, MoeOrder, true, true, true>(lds, g, S, E); }
    xcd_barrier(bar);
    { PH_IDS; ph_actq(p, gw, NGW, lane); }
    xcd_barrier(bar);
    { pg8::Gemm g{(const bf16*)(p.ws + WS_ACT8), (const bf16*)(p.ws + WS_W2Q), MAXTILES * 256, DM, DFF / 2};
      MoeOrder S; S.init((const int*)(p.ws + WS_META), 8, G, bid); EpiDownI8 E{p.in[I_B2], (const float*)(p.ws + WS_ROWW), (const float*)(p.ws + WS_ASC), (const float*)(p.ws + WS_WSC2), (bf16*)(p.ws + WS_Y)};
      pg8::gemm_phase<EpiDownI8, MoeOrder, true, true, true>(lds, g, S, E); }
    xcd_barrier(bar);
    { PH_IDS; pf_final(p, gw, NGW, lane); }
}

extern "C" void kernel_launch(void* const* d_in, const int* in_sizes, int n_in, void* d_out, int out_size, void* d_ws, size_t ws_size, hipStream_t stream) {
    static int grid = 0;
    if (grid == 0) {
        if (n_in != N_IN || out_size != T * DM || ws_size < WS_END) { fprintf(stderr, "kernel_launch: unexpected shapes (n_in %d out %d ws %zu need %zu)\n", n_in, out_size, ws_size, (size_t)WS_END); grid = -1; return; }
        int dev = 0, cus = 0, per_cu = 0;
        if (hipGetDevice(&dev) != hipSuccess || hipDeviceGetAttribute(&cus, hipDeviceAttributeMultiprocessorCount, dev) != hipSuccess) { grid = -1; return; }
        if (hipFuncSetAttribute((const void*)mega_fwd, hipFuncAttributeMaxDynamicSharedMemorySize, LDS_BYTES) != hipSuccess) { fprintf(stderr, "kernel_launch: hipFuncSetAttribute failed\n"); grid = -1; return; }
        if (hipOccupancyMaxActiveBlocksPerMultiprocessor(&per_cu, (const void*)mega_fwd, 512, LDS_BYTES) != hipSuccess || per_cu < 1) { fprintf(stderr, "kernel_launch: occupancy query says %d blocks per CU\n", per_cu); }
        (void)hipGetLastError();
        grid = cus;
    }
    if (grid < 0) return;
    if (hipMemsetAsync((char*)d_ws + WS_CTL, 0, CTL_BYTES, stream) != hipSuccess) return;
    Params p{};
    for (int i = 0; i < N_IN; ++i) p.in[i] = (const float*)d_in[i];
    p.out = (float*)d_out; p.ws = (unsigned char*)d_ws;
    hipLaunchKernelGGL(mega_fwd, dim3(grid), dim3(512), LDS_BYTES, stream, p);
}
```

```cpp
#include <hip/hip_runtime.h>
#include <cstdio>
#include <cstdint>
namespace pg8 {
#define PG8_LAS __attribute__((address_space(3)))
typedef unsigned short bf16_t;
typedef short bf16x8 __attribute__((ext_vector_type(8)));
typedef float f32x4 __attribute__((ext_vector_type(4)));
typedef unsigned u32x4 __attribute__((ext_vector_type(4)));
constexpr int BM = 256, BK = 64, HALF = 128, HTB = HALF * BK * 2  , STAGE_BYTES = 8 * HTB, NXCD = 8, WGM = 8;

__host__ __device__ __forceinline__ int lds_byte(int r, int c) { const int st = (r >> 4) * 2 + (c >> 5), rr = r & 15, cc = c & 31, ob = rr * 64 + cc * 2; return st * 1024 + (ob ^ (((ob >> 9) & 1) << 5)); }
__host__ __device__ __forceinline__ void stage_rc(int b, int& R, int& C) { const int st = b / 1024, sb = b % 1024, swz = sb ^ (((sb >> 9) & 1) << 5); R = (st >> 1) * 16 + swz / 64; C = (st & 1) * 32 + (swz % 64) / 2; }
__host__ __device__ __forceinline__ int perm32(int rho) { const int n = rho >> 4, i = rho & 15; return 8 * (i >> 2) + 4 * n + (i & 3); }

struct Unit { int pm, pn, kind; };
struct Gemm { const bf16_t* A; const bf16_t* Bt; int M, N, K; };

template <int WG = WGM> __host__ __device__ __forceinline__ void tile_of(int wgid, int nM, int nN, int& pm, int& pn) {
    const int nwg = nM * nN;
    { const int q = nwg / NXCD, r = nwg % NXCD, xcd = wgid % NXCD, off = wgid / NXCD; wgid = (xcd < r ? xcd * (q + 1) : r * (q + 1) + (xcd - r) * q) + off; }
    const int nig = WG * nN, gid = wgid / nig, fm = gid * WG, gsz = (nM - fm) < WG ? (nM - fm) : WG;
    pm = fm + ((wgid % nig) % gsz); pn = (wgid % nig) / gsz;
}
struct StaticOrder {
    int nM, nN, nwg, G, c;
    __host__ __device__ void init(int M, int N, int G_, int c_) { nM = M / BM; nN = N / BM; nwg = nM * nN; G = G_; c = c_; }
    __device__ __forceinline__ bool next(int i, Unit& u) const {
        const long L = (long)i * G + c; if (L >= nwg) return false;
        tile_of((int)L, nM, nN, u.pm, u.pn); u.kind = 0; return true;
    }
    __device__ __forceinline__ const char* pa(const Gemm& g, const Unit& u) const { return (const char*)g.A + (size_t)u.pm * ((size_t)BM * g.K * 2); }
    __device__ __forceinline__ const char* pb(const Gemm& g, const Unit& u) const { return (const char*)g.Bt + (size_t)u.pn * ((size_t)BM * g.K * 2); }
    __device__ __forceinline__ void a_ready(const Unit&) const {}
    __device__ __forceinline__ void done(const Unit&) const {}
};
__device__ __forceinline__ unsigned cvt_pk_bf16(float lo, float hi) { unsigned r; asm volatile("v_cvt_pk_bf16_f32 %0, %1, %2" : "=v"(r) : "v"(lo), "v"(hi)); return r; }
template <bool I8> __device__ __forceinline__ f32x4 mma16(bf16x8 a, bf16x8 b, f32x4 c) {
    if constexpr (I8) { typedef int i32x4 __attribute__((ext_vector_type(4)));
        return __builtin_bit_cast(f32x4, __builtin_amdgcn_mfma_i32_16x16x64_i8(__builtin_bit_cast(i32x4, a), __builtin_bit_cast(i32x4, b), __builtin_bit_cast(i32x4, c), 0, 0, 0)); }
    else return __builtin_amdgcn_mfma_f32_16x16x32_bf16(a, b, c, 0, 0, 0);
}
template <class Epi, class Sched, bool ALIGN_EPI = false, bool SP2 = false, bool I8 = false>
__device__ __forceinline__ void gemm_phase(PG8_LAS unsigned char* lds, const Gemm g, const Sched& S, const Epi& E) {
    int tid_l = threadIdx.x; asm volatile("" : "+v"(tid_l));
    const int tid = tid_l, wid = __builtin_amdgcn_readfirstlane(tid >> 6), lane = tid & 63, wr = wid >> 2, wc = wid & 3, fr = lane & 15, fq = lane >> 4;
    const int K = g.K, nt = K / BK;
    unsigned voffA[2], voffB[2];
#pragma unroll
    for (int i = 0; i < 2; ++i) { int R, C; stage_rc(tid * 16 + i * 8192, R, C); const int Rb = Epi::PERM ? ((R & ~31) + perm32(R & 31)) : R;
        voffA[i] = (unsigned)(R * K + C) * 2u; voffB[i] = (unsigned)(Rb * K + C) * 2u; }
    const size_t kstep = (size_t)(BK * 2);
    const size_t hstep = (size_t)HALF * K * 2;
    const unsigned ldsw = (unsigned)wid * 1024u;
    const int aoff = lds_byte(wr * 64 + fr, fq * 8), boff = lds_byte(wc * 32 + fr, fq * 8);
#define PG8_SA(b, h) (((b) * 2 + (h)) * HTB)
#define PG8_SB(b, h) ((4 + (b) * 2 + (h)) * HTB)
#define PG8_STAGE(bufoff, gbase, voff) do { _Pragma("unroll") for (int _i = 0; _i < 2; ++_i) \
        __builtin_amdgcn_global_load_lds((const unsigned*)((const char*)(gbase) + (voff)[_i]), (PG8_LAS unsigned*)(lds + (bufoff) + ldsw + _i * 8192), 16, 0, 0); } while (0)
#define PG8_LDA(dst, b, h) do { _Pragma("unroll") for (int m = 0; m < 4; ++m) _Pragma("unroll") for (int k = 0; k < 2; ++k) dst[m][k] = *(const PG8_LAS bf16x8*)(lds + PG8_SA(b, h) + aoff + m * 2048 + k * 1024); } while (0)
#define PG8_LDB(dst, b, h) do { _Pragma("unroll") for (int n = 0; n < 2; ++n) _Pragma("unroll") for (int k = 0; k < 2; ++k) dst[n][k] = *(const PG8_LAS bf16x8*)(lds + PG8_SB(b, h) + boff + n * 2048 + k * 1024); } while (0)
#define PG8_MMA(ai, bj, At, Bt) do { __builtin_amdgcn_s_setprio(1); _Pragma("unroll") for (int m = 0; m < 4; ++m) _Pragma("unroll") for (int n = 0; n < 2; ++n) _Pragma("unroll") for (int k = 0; k < 2; ++k) \
        acc[ai][bj][m][n] = mma16<I8>(Bt[n][k], At[m][k], acc[ai][bj][m][n]); __builtin_amdgcn_s_setprio(0); } while (0)
#define PG8_WAIT_V(n) asm volatile("s_waitcnt vmcnt(" #n ")" ::: "memory")
#define PG8_WAIT_L(n) asm volatile("s_waitcnt lgkmcnt(" #n ")" ::: "memory")
#define PG8_BAR __builtin_amdgcn_s_barrier()
#define PG8_SCHED __builtin_amdgcn_sched_barrier(0)
    Unit cur, nxt; int ui = 0;
    if (!S.next(0, cur)) return;
    f32x4 acc[2][2][4][2];
#pragma unroll
    for (int a = 0; a < 2; ++a)
#pragma unroll
        for (int b = 0; b < 2; ++b)
#pragma unroll
            for (int m = 0; m < 4; ++m)
#pragma unroll
                for (int n = 0; n < 2; ++n) acc[a][b][m][n] = (f32x4){0.f, 0.f, 0.f, 0.f};
    bf16x8 At[4][2], B0[2][2], B1[2][2];
    const char* cA = S.pa(g, cur); const char* cB = S.pb(g, cur);
    S.a_ready(cur);
    if constexpr (SP2) {
        PG8_STAGE(PG8_SB(0, 0), cB, voffB); PG8_STAGE(PG8_SB(0, 1), cB + hstep, voffB); PG8_STAGE(PG8_SA(0, 0), cA, voffA); PG8_STAGE(PG8_SA(0, 1), cA + hstep, voffA);
        if (wr == 1) PG8_BAR;
        PG8_WAIT_V(2); PG8_BAR;
        PG8_STAGE(PG8_SB(1, 0), cB + kstep, voffB); PG8_STAGE(PG8_SA(1, 0), cA + kstep, voffA); PG8_STAGE(PG8_SB(1, 1), cB + hstep + kstep, voffB);
        PG8_WAIT_V(6); PG8_BAR;
    } else {
        PG8_STAGE(PG8_SB(0, 0), cB, voffB); PG8_STAGE(PG8_SA(0, 0), cA, voffA); PG8_STAGE(PG8_SB(0, 1), cB + hstep, voffB); PG8_STAGE(PG8_SA(0, 1), cA + hstep, voffA);
        if (wr == 1) PG8_BAR;
        PG8_WAIT_V(4); PG8_BAR;
        PG8_STAGE(PG8_SB(1, 0), cB + kstep, voffB); PG8_STAGE(PG8_SA(1, 0), cA + kstep, voffA); PG8_STAGE(PG8_SB(1, 1), cB + hstep + kstep, voffB);
        PG8_WAIT_V(6); PG8_BAR;
    }
    for (;;) {
        const bool has_next = S.next(ui + 1, nxt);
        const char* nA = has_next ? S.pa(g, nxt) : cA; const char* nB = has_next ? S.pb(g, nxt) : cB;
        for (int t = 0; t < nt; t += 2) {
            const bool last = (t == nt - 2);
            const char* a1 = cA + (size_t)(t + 1) * kstep;
            const char* a2 = last ? nA : cA + (size_t)(t + 2) * kstep; const char* b2 = last ? nB : cB + (size_t)(t + 2) * kstep;
            const char* a3 = a2 + kstep; const char* b3 = b2 + kstep;
            if (last && has_next) S.a_ready(nxt);
            if constexpr (SP2) {
            PG8_LDB(B0, 0, 0); PG8_LDB(B1, 0, 1); PG8_SCHED; PG8_LDA(At, 0, 0); PG8_STAGE(PG8_SA(1, 1), a1 + hstep, voffA);
            PG8_WAIT_V(8); PG8_WAIT_L(0); PG8_BAR; PG8_MMA(0, 0, At, B0); PG8_MMA(0, 1, At, B1); PG8_BAR; PG8_SCHED;
            PG8_LDA(At, 0, 1); PG8_STAGE(PG8_SB(0, 0), b2, voffB); PG8_STAGE(PG8_SB(0, 1), b2 + hstep, voffB); PG8_STAGE(PG8_SA(0, 0), a2, voffA);
            PG8_WAIT_V(8); PG8_WAIT_L(0); PG8_BAR; PG8_MMA(1, 0, At, B0); PG8_MMA(1, 1, At, B1); PG8_BAR; PG8_SCHED;
            PG8_LDB(B0, 1, 0); PG8_LDB(B1, 1, 1); PG8_SCHED; PG8_LDA(At, 1, 0); PG8_STAGE(PG8_SA(0, 1), a2 + hstep, voffA);
            PG8_WAIT_V(8); PG8_WAIT_L(0); PG8_BAR; PG8_MMA(0, 0, At, B0); PG8_MMA(0, 1, At, B1); PG8_BAR; PG8_SCHED;
            PG8_LDA(At, 1, 1); PG8_STAGE(PG8_SB(1, 0), b3, voffB); PG8_STAGE(PG8_SB(1, 1), b3 + hstep, voffB); PG8_STAGE(PG8_SA(1, 0), a3, voffA);
            PG8_WAIT_V(8); PG8_WAIT_L(0); PG8_BAR; PG8_MMA(1, 0, At, B0); PG8_MMA(1, 1, At, B1); PG8_BAR; PG8_SCHED;
            } else {
            PG8_LDB(B0, 0, 0); PG8_SCHED; PG8_LDA(At, 0, 0); PG8_STAGE(PG8_SA(1, 1), a1 + hstep, voffA);
            PG8_WAIT_L(8); PG8_BAR; PG8_WAIT_L(0); PG8_MMA(0, 0, At, B0); PG8_BAR; PG8_SCHED;
            PG8_LDB(B1, 0, 1); PG8_STAGE(PG8_SB(0, 0), b2, voffB);
            PG8_BAR; PG8_WAIT_L(0); PG8_MMA(0, 1, At, B1); PG8_BAR;
            PG8_LDA(At, 0, 1); PG8_STAGE(PG8_SA(0, 0), a2, voffA);
            PG8_BAR; PG8_WAIT_L(0); PG8_MMA(1, 0, At, B0); PG8_BAR; PG8_SCHED;
            PG8_STAGE(PG8_SB(0, 1), b2 + hstep, voffB);
            PG8_WAIT_V(6); PG8_BAR; PG8_MMA(1, 1, At, B1); PG8_BAR;
            PG8_LDB(B0, 1, 0); PG8_SCHED; PG8_LDA(At, 1, 0); PG8_STAGE(PG8_SA(0, 1), a2 + hstep, voffA);
            PG8_WAIT_L(8); PG8_BAR; PG8_WAIT_L(0); PG8_MMA(0, 0, At, B0); PG8_BAR; PG8_SCHED;
            PG8_LDB(B1, 1, 1); PG8_STAGE(PG8_SB(1, 0), b3, voffB);
            PG8_BAR; PG8_WAIT_L(0); PG8_MMA(0, 1, At, B1); PG8_BAR;
            PG8_LDA(At, 1, 1); PG8_STAGE(PG8_SA(1, 0), a3, voffA);
            PG8_BAR; PG8_WAIT_L(0); PG8_MMA(1, 0, At, B0); PG8_BAR; PG8_SCHED;
            PG8_STAGE(PG8_SB(1, 1), b3 + hstep, voffB);
            PG8_WAIT_V(6); PG8_BAR; PG8_MMA(1, 1, At, B1); PG8_BAR;
            }
        }
        if constexpr (ALIGN_EPI) { if (wr == 0) PG8_BAR; }
        if constexpr (!Epi::AFTER_DRAIN) { E(acc, cur, wr, wc, fr, fq); S.done(cur); }
        if (!has_next) break;
#pragma unroll
        for (int a = 0; a < 2; ++a)
#pragma unroll
            for (int b = 0; b < 2; ++b)
#pragma unroll
                for (int m = 0; m < 4; ++m)
#pragma unroll
                    for (int n = 0; n < 2; ++n) acc[a][b][m][n] = (f32x4){0.f, 0.f, 0.f, 0.f};
        cur = nxt; cA = nA; cB = nB; ++ui;
        if constexpr (ALIGN_EPI) { if (wr == 1) PG8_BAR; }
    }
    PG8_WAIT_V(0);
    if constexpr (!ALIGN_EPI) { if (wr == 0) PG8_BAR; }
    PG8_BAR;
    if constexpr (Epi::AFTER_DRAIN) { E.fused(acc, cur, wr, wc, fr, fq, lds, wid, lane); S.done(cur); }
#undef PG8_SA
#undef PG8_SB
#undef PG8_STAGE
#undef PG8_LDA
#undef PG8_LDB
#undef PG8_MMA
#undef PG8_WAIT_V
#undef PG8_WAIT_L
#undef PG8_BAR
#undef PG8_SCHED
}
}

#define GAS __attribute__((address_space(1)))
#define LAS __attribute__((address_space(3)))
typedef unsigned short bf16;
typedef unsigned v4u __attribute__((ext_vector_type(4)));
typedef unsigned v2u __attribute__((ext_vector_type(2)));
typedef float f32x4 __attribute__((ext_vector_type(4)));
typedef short bf16x8 __attribute__((ext_vector_type(8)));

constexpr int NB = 8, SEQ = 4096, DM = 2048, T = NB * SEQ;
constexpr int NPT = 23;
constexpr int NE = 32, DFF = 2048;
constexpr int MAXTILES = 544;
constexpr float RMS_EPS = 1e-5f;
constexpr int NVB = 256, TPV = T / NVB;

enum { I_X = 0, I_NMIX, I_WIN, I_WA2, I_BA, I_GLAG, I_PEK, I_WK1, I_WK2, I_PEV, I_WV1, I_WV2, I_NSAG, I_RELB, I_WOUT, I_NFFN, I_RW, I_RB, I_W1, I_B1, I_W2, I_B2, I_NFIN, N_IN };

constexpr size_t MiB = 1u << 20;
constexpr size_t al(size_t x) { return (x + 255) & ~(size_t)255; }
constexpr size_t WS_CTL = 0, CTL_BYTES = 1 * MiB;
constexpr size_t WS_CNT = WS_CTL + CTL_BYTES;
constexpr size_t WS_META = WS_CNT + al(NVB * 32 * 4);
constexpr size_t WS_EIDX = WS_META + al((64 + MAXTILES) * 4);
constexpr size_t WS_LRNK = WS_EIDX + al((size_t)T * 4 * 4);
constexpr size_t WS_GATE = WS_LRNK + al((size_t)T * 4 * 4);
constexpr size_t WS_POS = WS_GATE + al((size_t)T * 4 * 4);
constexpr size_t WS_ROWW = WS_POS + al((size_t)T * 4 * 4);
constexpr size_t WS_WINT = al(WS_ROWW + (size_t)MAXTILES * 256 * 4);
constexpr size_t WS_WOT = WS_WINT + (size_t)NPT * 256 * DM * 2;
constexpr size_t WS_WKCT = WS_WOT + (size_t)DM * DM * 2;
constexpr size_t WS_WVCT = WS_WKCT + (size_t)256 * 2048 * 2;
constexpr size_t WS_W1T = WS_WVCT + (size_t)256 * 2048 * 2;
constexpr size_t WS_W2T = WS_W1T + (size_t)NE * 4096 * DM * 2;
constexpr size_t WS_XN = WS_W2T + (size_t)NE * DM * DFF * 2;
constexpr size_t WS_GQ = WS_XN + (size_t)T * DM * 2;
constexpr size_t WS_GK = WS_GQ + (size_t)T * 512 * 2;
constexpr size_t WS_GV = WS_GK + (size_t)T * 512 * 2;
constexpr size_t WS_GG = WS_GV + (size_t)T * 1024 * 2;
constexpr size_t WS_NQ = WS_GG + (size_t)T * 1024 * 2;
constexpr size_t WS_KC = WS_NQ + (size_t)T * 1024 * 2;
constexpr size_t WS_VC = WS_KC + (size_t)T * 256 * 2;
constexpr size_t WS_KS = WS_VC + (size_t)T * 256 * 2;
constexpr size_t WS_KW = WS_KS + (size_t)T * 256 * 2;
constexpr size_t WS_VST = WS_KW + (size_t)T * 256 * 2;
constexpr size_t WS_VWT = WS_VST + (size_t)T * 256 * 2;
constexpr size_t WS_SM = WS_VWT + (size_t)T * 256 * 2;
constexpr size_t WS_LA = WS_SM + (size_t)T * 64 * 2;
constexpr size_t WS_OG = WS_LA + (size_t)T * 512 * 4;
constexpr size_t WS_ON = WS_OG + (size_t)T * 1024 * 4;
constexpr size_t WS_KCMP = WS_ON + (size_t)T * 1024 * 4;
constexpr size_t WS_VCMPT = WS_KCMP + (size_t)16 * 256 * 128 * 2;
constexpr size_t WS_A2 = WS_VCMPT + (size_t)16 * 256 * 128 * 2;
constexpr size_t WS_HN = WS_A2 + (size_t)T * DM * 2;
constexpr size_t WS_XG = WS_HN + (size_t)T * DM * 2;
constexpr size_t WS_ACT = WS_XG + (size_t)MAXTILES * 256 * DM * 2;
constexpr size_t WS_END = WS_ACT + (size_t)MAXTILES * 256 * DFF * 2;

__device__ __forceinline__ unsigned f2bf(float f) { unsigned u = __builtin_bit_cast(unsigned, f); return (u + 0x7fffu + ((u >> 16) & 1u)) >> 16; }
__device__ __forceinline__ unsigned pk2(float lo, float hi) { return f2bf(lo) | (f2bf(hi) << 16); }
__device__ __forceinline__ float bf2f(unsigned short v) { return __builtin_bit_cast(float, (unsigned)v << 16); }
__device__ __forceinline__ float bflo(unsigned w) { return __builtin_bit_cast(float, w << 16); }
__device__ __forceinline__ float bfhi(unsigned w) { return __builtin_bit_cast(float, w & 0xffff0000u); }
__device__ __forceinline__ float wave_sum(float v) {
#pragma unroll
    for (int o = 1; o < 64; o <<= 1) v += __shfl_xor(v, o);
    return v;
}
__device__ __forceinline__ float wave_max(float v) {
#pragma unroll
    for (int o = 1; o < 64; o <<= 1) v = fmaxf(v, __shfl_xor(v, o));
    return v;
}
#define LDS_WAIT() asm volatile("s_waitcnt lgkmcnt(0)" ::: "memory")

__device__ const unsigned char kBucket[128] = {0, 1, 2, 3, 4, 5, 6, 7, 8, 9, 10, 11, 12, 13, 14, 15, 16, 16, 16, 17, 17, 18, 18, 18, 19, 19, 19, 20, 20, 20, 20, 21, 21, 21, 21, 22, 22, 22, 22, 22, 23, 23, 23, 23, 23, 23, 24, 24, 24, 24, 24, 24, 25, 25, 25, 25, 25, 25, 25, 26, 26, 26, 26, 26, 26, 26, 26, 27, 27, 27, 27, 27, 27, 27, 27, 27, 27, 28, 28, 28, 28, 28, 28, 28, 28, 28, 28, 29, 29, 29, 29, 29, 29, 29, 29, 29, 29, 29, 29, 30, 30, 30, 30, 30, 30, 30, 30, 30, 30, 30, 30, 30, 30, 31, 31, 31, 31, 31, 31, 31, 31, 31, 31, 31, 31, 31, 31, 31};

struct Params {
    const float* in[N_IN];
    float* out;
    unsigned char* ws;
};

template <class F>
__device__ __forceinline__ void transpose_item(const float* W, int ldw, int k0, int n0, int nlim, LAS float* scr, int lane, F dst) {
#pragma unroll 8
    for (int i = 0; i < 32; ++i) { const int kk = 2 * i + (lane >> 5); const int n = n0 + (lane & 31); scr[kk * 33 + (lane & 31)] = n < nlim ? W[(size_t)(k0 + kk) * ldw + n] : 0.f; }
    LDS_WAIT(); asm volatile("" ::: "memory");
    const int c = lane & 7;
#pragma unroll
    for (int j = 0; j < 4; ++j) { const int nn = (lane >> 3) + 8 * j; const int n = n0 + nn; const LAS float* s = scr + (8 * c) * 33 + nn;
        bf16* rowp; float sc;
        if (n < nlim && dst(n, rowp, sc)) {
            v4u o; o.x = pk2(s[0 * 33] * sc, s[1 * 33] * sc); o.y = pk2(s[2 * 33] * sc, s[3 * 33] * sc); o.z = pk2(s[4 * 33] * sc, s[5 * 33] * sc); o.w = pk2(s[6 * 33] * sc, s[7 * 33] * sc);
            *(v4u*)(rowp + 8 * c) = o; } }
    LDS_WAIT(); asm volatile("" ::: "memory");
}
__device__ __forceinline__ int win_row(int n, float& sc) {
    sc = 1.f;
    if (n < 512) { sc = 0.08838834764831845f; return n; }
    if (n < 1024) return n;
    if (n < 2048) return n;
    if (n < 3072) return n;
    if (n < 3088) return 5120 + (n - 3072);
    if (n < 4112) { sc = 0.08838834764831845f; return 3072 + (n - 3088); }
    if (n < 4368) return 4096 + (n - 4112);
    if (n < 4624) return 4352 + (n - 4368);
    if (n < 4880) return 4608 + (n - 4624);
    if (n < 5136) return 5376 + (n - 4880);
    if (n < 5392) return 4864 + (n - 5136);
    if (n < 5648) return 5632 + (n - 5392);
    return 5136 + (n - 5648);
}
constexpr size_t WS_PEVP = WS_W2T;
__device__ __forceinline__ void p0_prologue(const Params& p, LAS unsigned char* lds, int gw, int NGW, int wave, int lane) {
    LAS float* scr = (LAS float*)(lds + wave * 16384);
    bf16* WinT = (bf16*)(p.ws + WS_WINT); bf16* WoT = (bf16*)(p.ws + WS_WOT); bf16* WkcT = (bf16*)(p.ws + WS_WKCT); bf16* WvcT = (bf16*)(p.ws + WS_WVCT);
    bf16* W1T = (bf16*)(p.ws + WS_W1T); bf16* W2T = (bf16*)(p.ws + WS_W2T);
    constexpr int I_IN = 32 * 178, I_O = 32 * 64, I_C = 64 * 4, I_E1 = 32 * 128, I_E2 = 32 * 64;
    constexpr int I_PE = 2 * 64;
    constexpr int NITEMS = I_O + 2 * I_C + I_PE;
    (void)I_IN; (void)WinT;
    for (int it = gw; it < NITEMS; it += NGW) {
        int r = it;
        if (r < I_O) { const int kb = r / 64, nb = r % 64, k0 = kb * 64;
            transpose_item(p.in[I_WOUT], DM, k0, nb * 32, DM, scr, lane, [&](int n, bf16*& rowp, float& sc) { sc = 1.f; rowp = WoT + (size_t)n * DM + k0; return true; }); continue; } r -= I_O;
        if (r >= 2 * I_C) { r -= 2 * I_C; const int which = r >> 6, kq = r & 63; const float* pe = p.in[which ? I_PEV : I_PEK] + kq * 64; const float* w1 = p.in[which ? I_WV1 : I_WK1] + (size_t)kq * 64 * 128 + lane;
            float a0 = 0.f, a1 = 0.f;
#pragma unroll
            for (int k = 0; k < 64; ++k) { const float pv = pe[k]; a0 += pv * w1[k * 128]; a1 += pv * w1[k * 128 + 64]; }
            float* dst = (float*)(p.ws + WS_PEVP) + (size_t)(which * 64 + kq) * 128 + lane; dst[0] = a0; dst[64] = a1; continue; }
        { const int which = r / I_C; r %= I_C; const int kb = r / 4, nb = r % 4, k0 = kb * 64;
            bf16* dstm = which ? WvcT : WkcT;
            transpose_item(p.in[which ? I_WV1 : I_WK1], 128, k0, nb * 32, 128, scr, lane, [&](int n, bf16*& rowp, float& sc) { sc = 1.f; rowp = dstm + (size_t)(n + (k0 >= 2048 ? 128 : 0)) * 2048 + (k0 & 2047); return true; }); }
        (void)I_E1; (void)I_E2; (void)W1T; (void)W2T;
    }
    const float* x = p.in[I_X]; const float* gm = p.in[I_NMIX];
    for (int m = gw; m < T; m += NGW) {
        const f32x4* xr = (const f32x4*)(x + (size_t)m * DM) + lane; f32x4 v[8]; float s = 0.f;
#pragma unroll
        for (int j = 0; j < 8; ++j) { v[j] = xr[64 * j]; s += (v[j].x * v[j].x + v[j].y * v[j].y) + (v[j].z * v[j].z + v[j].w * v[j].w); }
        const float rstd = 1.f / sqrtf(wave_sum(s) * (1.f / DM) + RMS_EPS);
        float mxr = 0.f;
#pragma unroll
        for (int j = 0; j < 8; ++j) { const f32x4 g4 = ((const f32x4*)gm)[lane + 64 * j]; v[j].x *= rstd * g4.x; v[j].y *= rstd * g4.y; v[j].z *= rstd * g4.z; v[j].w *= rstd * g4.w;
            mxr = fmaxf(mxr, fmaxf(fmaxf(fabsf(v[j].x), fabsf(v[j].y)), fmaxf(fabsf(v[j].z), fabsf(v[j].w)))); }
        mxr = wave_max(mxr); const float qs = mxr > 0.f ? mxr * (1.f / 127.f) : 1.f, qi = 1.f / qs;
        unsigned* o4 = (unsigned*)(p.ws + WS_XN + (size_t)m * DM) + lane;
#pragma unroll
        for (int j = 0; j < 8; ++j) { const int q0 = (int)rintf(v[j].x * qi), q1 = (int)rintf(v[j].y * qi), q2 = (int)rintf(v[j].z * qi), q3 = (int)rintf(v[j].w * qi);
            o4[64 * j] = ((unsigned)q0 & 0xffu) | (((unsigned)q1 & 0xffu) << 8) | (((unsigned)q2 & 0xffu) << 16) | (((unsigned)q3 & 0xffu) << 24); }
        if (lane == 0) ((float*)(p.ws + WS_XN + (size_t)T * DM))[m] = qs;
    }
}
#define XB_TMO      128
#define XB_XCNT(j)  (256  + 64 * (j))
#define XB_XSUB(j)  (1280 + 64 * (j))
#define XB_XGEN(j)  (2304 + 64 * (j))
#define XB_TOP      3328
#define XB_TOPGEN   3392
#define XCD_BAR_WORDS 3456
#define XB_SPIN_CAP (1u << 18)

__device__ __forceinline__ unsigned xb_ld(unsigned* p)              { return __hip_atomic_load(p, __ATOMIC_RELAXED, __HIP_MEMORY_SCOPE_AGENT); }
__device__ __forceinline__ unsigned xb_add(unsigned* p, unsigned v) { return __hip_atomic_fetch_add(p, v, __ATOMIC_RELAXED, __HIP_MEMORY_SCOPE_AGENT); }
__device__ __forceinline__ unsigned xb_xcc_id() { return (unsigned)__builtin_amdgcn_s_getreg((3 << 11) | 20) & 0xFu; }
#define XB_SPIN(cond, bar) do { unsigned _sp = 0; while (cond) { __builtin_amdgcn_s_sleep(1); \
    if ((++_sp & 255u) == 0u) { if (xb_ld(&(bar)[XB_TMO])) break; if (_sp > XB_SPIN_CAP) { atomicAdd(&(bar)[XB_TMO], 1u); break; } } } } while (0)

struct XcdBarrier {
    unsigned* bar; unsigned x;
    volatile LAS unsigned* st;
};

__device__ __forceinline__ XcdBarrier xcd_barrier_post(unsigned* bar, volatile LAS unsigned* st) {
    XcdBarrier b; b.bar = bar; b.x = xb_xcc_id(); b.st = st;
    if (threadIdx.x == 0) (void)xb_add(&bar[XB_XCNT(b.x)], 1u);
    return b;
}
__device__ __forceinline__ void xcd_barrier_complete(unsigned* bar, unsigned x, unsigned& nloc, unsigned& nx) {
    const unsigned G = gridDim.x * gridDim.y * gridDim.z;
    unsigned sum, cnt, mine, sp = 0u;
    for (;;) {
        sum = 0u; cnt = 0u; mine = 0u;
#pragma unroll
        for (unsigned j = 0; j < 16; ++j) { const unsigned c = xb_ld(&bar[XB_XCNT(j)]); sum += c; cnt += (c > 0u) ? 1u : 0u; mine = (j == x) ? c : mine; }
        if (sum == G) break;
        __builtin_amdgcn_s_sleep(1);
        if ((++sp & 255u) == 0u) { if (xb_ld(&bar[XB_TMO])) break; if (sp > XB_SPIN_CAP) { atomicAdd(&bar[XB_TMO], 1u); break; } }
    }
    nloc = mine > 0u ? mine : 1u; nx = cnt > 0u ? cnt : 1u;
}

__device__ __forceinline__ void xcd_barrier(const XcdBarrier& b) {
    asm volatile("s_waitcnt vmcnt(0)" ::: "memory");
    __syncthreads();
    if (threadIdx.x == 0) {
        unsigned* bar = b.bar;
        __builtin_amdgcn_s_waitcnt(0);
        unsigned nloc = b.st[0], nx = b.st[1];
        if (nloc == 0u) { xcd_barrier_complete(bar, b.x, nloc, nx); b.st[0] = nloc; b.st[1] = nx; }
        const unsigned old = xb_add(&bar[XB_XSUB(b.x)], 1u);
        const unsigned gen = old / nloc;
        if (old + 1u == (gen + 1u) * nloc) {
            __builtin_amdgcn_fence(__ATOMIC_RELEASE, "agent");
            asm volatile("s_waitcnt vmcnt(0)" ::: "memory");
            const unsigned og = xb_add(&bar[XB_TOP], 1u);
            const unsigned tg = og / nx;
            if (og + 1u == (tg + 1u) * nx) xb_add(&bar[XB_TOPGEN], 1u);
            else XB_SPIN(xb_ld(&bar[XB_TOPGEN]) == tg, bar);
            __builtin_amdgcn_fence(__ATOMIC_ACQUIRE, "agent");
            xb_add(&bar[XB_XGEN(b.x)], 1u);
            asm volatile("s_waitcnt vmcnt(0)" ::: "memory");
        } else {
            XB_SPIN(xb_ld(&bar[XB_XGEN(b.x)]) == gen, bar);
            __builtin_amdgcn_fence(__ATOMIC_ACQUIRE, "agent");
            asm volatile("s_waitcnt vmcnt(0)" ::: "memory");
        }
    }
    __syncthreads();
}

struct ProjOrder : pg8::StaticOrder {
    const bf16* xn; const bf16* wt;
    __device__ __forceinline__ bool next(int i, pg8::Unit& u) const { if (!pg8::StaticOrder::next(i, u)) return false; u.kind = (u.pn >= 21) ? 1 : 0; return true; }
    __device__ __forceinline__ const char* pa(const pg8::Gemm& g, const pg8::Unit& u) const { return u.kind ? (const char*)wt + (size_t)u.pn * ((size_t)256 * g.K * 2) : (const char*)xn + (size_t)u.pm * ((size_t)256 * g.K * 2); }
    __device__ __forceinline__ const char* pb(const pg8::Gemm& g, const pg8::Unit& u) const { return u.kind ? (const char*)xn + (size_t)u.pm * ((size_t)256 * g.K * 2) : (const char*)wt + (size_t)u.pn * ((size_t)256 * g.K * 2); }
};
struct EpiProj {
    static constexpr bool PERM = true, AFTER_DRAIN = false;
    unsigned char* ws;
    __device__ __forceinline__ void operator()(const pg8::f32x4 (&acc)[2][2][4][2], const pg8::Unit& u, int wr, int wc, int fr, int fq) const {
        const int cw = wc * 32 + 8 * fq;
        if (u.kind == 0) {
            const int tn = u.pn; bf16* base; size_t bjs = 128; int ld = 0; bool headmajor = false; bool small = false;
            if (tn < 2) { base = (bf16*)(ws + WS_GQ) + tn * 256; ld = 512; }
            else if (tn < 4) { base = (bf16*)(ws + WS_GK) + (tn - 2) * 256; ld = 512; }
            else if (tn < 8) { base = (bf16*)(ws + WS_GV) + (tn - 4) * 256; ld = 1024; }
            else if (tn < 12) { base = (bf16*)(ws + WS_GG) + (tn - 8) * 256; ld = 1024; }
            else if (tn < 16) { base = (bf16*)(ws + WS_NQ) + (tn - 12) * 256; ld = 1024; }
            else if (tn < 20) { base = (bf16*)(ws + (tn == 16 ? WS_KC : tn == 17 ? WS_VC : tn == 18 ? WS_KS : WS_KW)); headmajor = true; bjs = (size_t)SEQ * 128; }
            else { base = (bf16*)(ws + WS_SM); ld = 64; small = true; }
            if (small && wc >= 2) return;
#pragma unroll
            for (int ai = 0; ai < 2; ++ai)
#pragma unroll
                for (int m = 0; m < 4; ++m) { const int r = u.pm * 256 + ai * 128 + wr * 64 + m * 16 + fr;
                    const size_t rterm = headmajor ? ((size_t)(r >> 12) * 2 * SEQ + (r & (SEQ - 1))) * 128 : (size_t)r * ld;
#pragma unroll
                    for (int bj = 0; bj < 2; ++bj) { if (small && bj) continue;
                        const pg8::f32x4 v0 = acc[ai][bj][m][0], v1 = acc[ai][bj][m][1];
                        pg8::u32x4 w; w.x = pg8::cvt_pk_bf16(v0[0], v0[1]); w.y = pg8::cvt_pk_bf16(v0[2], v0[3]); w.z = pg8::cvt_pk_bf16(v1[0], v1[1]); w.w = pg8::cvt_pk_bf16(v1[2], v1[3]);
                        *(pg8::u32x4*)(base + rterm + bj * bjs + cw) = w; } }
        } else {
            bf16* base = (bf16*)(ws + (u.pn == 21 ? WS_VST : WS_VWT));
#pragma unroll
            for (int ai = 0; ai < 2; ++ai)
#pragma unroll
                for (int m = 0; m < 4; ++m) { const int dh = wr * 64 + m * 16 + fr;
#pragma unroll
                    for (int bj = 0; bj < 2; ++bj) { const int tok = u.pm * 256 + bj * 128 + cw; const int b = tok >> 12, s = tok & (SEQ - 1);
                        const pg8::f32x4 v0 = acc[ai][bj][m][0], v1 = acc[ai][bj][m][1];
                        pg8::u32x4 w; w.x = pg8::cvt_pk_bf16(v0[0], v0[1]); w.y = pg8::cvt_pk_bf16(v0[2], v0[3]); w.z = pg8::cvt_pk_bf16(v1[0], v1[1]); w.w = pg8::cvt_pk_bf16(v1[2], v1[3]);
                        *(pg8::u32x4*)(base + ((size_t)(b * 2 + ai) * 128 + dh) * SEQ + s) = w; } }
        }
    }
};
struct EpiRes {
    static constexpr bool PERM = false, AFTER_DRAIN = false;
    const float* x; float* h;
    __device__ __forceinline__ void operator()(const pg8::f32x4 (&acc)[2][2][4][2], const pg8::Unit& u, int wr, int wc, int fr, int fq) const {
        const int row0 = u.pm * 256 + wr * 64 + fr, col0 = u.pn * 256 + wc * 32 + 4 * fq;
#pragma unroll
        for (int ai = 0; ai < 2; ++ai)
#pragma unroll
            for (int m = 0; m < 4; ++m) { const size_t off = (size_t)(row0 + ai * 128 + m * 16) * DM + col0;
#pragma unroll
                for (int bj = 0; bj < 2; ++bj)
#pragma unroll
                    for (int n = 0; n < 2; ++n) { const pg8::f32x4 xv = *(const pg8::f32x4*)(x + off + bj * 128 + n * 16); *(pg8::f32x4*)(h + off + bj * 128 + n * 16) = xv + acc[ai][bj][m][n]; } }
    }
};
struct MoeOrder {
    int nM, nN, nwg, G, c; const int* tile_exp;
    __device__ __forceinline__ void init(const int* meta, int nN_, int G_, int c_) { nM = meta[0]; nN = nN_; nwg = nM * nN; G = G_; c = c_; tile_exp = meta + 64; }
    __device__ __forceinline__ bool next(int i, pg8::Unit& u) const {
        const long L = (long)i * G + c; if (L >= nwg) return false;
        pg8::tile_of<8>((int)L, nM, nN, u.pm, u.pn); u.kind = tile_exp[u.pm]; return true;
    }
    __device__ __forceinline__ const char* pa(const pg8::Gemm& g, const pg8::Unit& u) const { return (const char*)g.A + (size_t)u.pm * ((size_t)256 * g.K * 2); }
    __device__ __forceinline__ const char* pb(const pg8::Gemm& g, const pg8::Unit& u) const { return (const char*)g.Bt + ((size_t)u.kind * nN + u.pn) * ((size_t)256 * g.K * 2); }
    __device__ __forceinline__ void a_ready(const pg8::Unit&) const {}
    __device__ __forceinline__ void done(const pg8::Unit&) const {}
};

struct MoeOrderSync : MoeOrder {
    unsigned* xl; unsigned x, nloc; int full_rounds; mutable int calls;
    __device__ __forceinline__ void init_sync(unsigned* xl_, unsigned x_, unsigned nloc_) { xl = xl_; x = x_; nloc = nloc_ ? nloc_ : 1u; full_rounds = nwg / G; calls = 0; }
    __device__ __forceinline__ void a_ready(const pg8::Unit&) const {
        if (calls < full_rounds) {
            if (threadIdx.x == 0) { unsigned* sub = xl + 64 * x; unsigned* genw = xl + 1024 + 64 * x;
                const unsigned old = __hip_atomic_fetch_add(sub, 1u, __ATOMIC_RELAXED, __HIP_MEMORY_SCOPE_AGENT), gen = old / nloc;
                if (old + 1u == (gen + 1u) * nloc) __hip_atomic_fetch_add(genw, 1u, __ATOMIC_RELAXED, __HIP_MEMORY_SCOPE_AGENT);
                else { unsigned sp = 0; while (__hip_atomic_load(genw, __ATOMIC_RELAXED, __HIP_MEMORY_SCOPE_AGENT) == gen) { __builtin_amdgcn_s_sleep(1); if (++sp > (1u << 16)) break; } } }
            asm volatile("" ::: "memory"); __builtin_amdgcn_s_barrier(); asm volatile("" ::: "memory"); }
        ++calls;
    }
};
struct EpiSwiglu {
    static constexpr bool PERM = true, AFTER_DRAIN = false;
    const float* b1; bf16* act;
    __device__ __forceinline__ void operator()(const pg8::f32x4 (&acc)[2][2][4][2], const pg8::Unit& u, int wr, int wc, int fr, int fq) const {
        const int e = u.kind; const int col = u.pn * 128 + wc * 32 + 8 * fq; const int row0 = u.pm * 256 + wr * 64 + fr;
        const float* bg = b1 + (size_t)e * 4096 + col; const float* bl = bg + 2048;
        const pg8::f32x4 g0 = *(const pg8::f32x4*)bg, g1 = *(const pg8::f32x4*)(bg + 4), l0 = *(const pg8::f32x4*)bl, l1 = *(const pg8::f32x4*)(bl + 4);
#pragma unroll
        for (int ai = 0; ai < 2; ++ai)
#pragma unroll
            for (int m = 0; m < 4; ++m) { float o[8];
#pragma unroll
                for (int n = 0; n < 2; ++n)
#pragma unroll
                    for (int j = 0; j < 4; ++j) { float gl = acc[ai][0][m][n][j] + (n ? g1[j] : g0[j]); float li = acc[ai][1][m][n][j] + (n ? l1[j] : l0[j]);
                        gl = fminf(gl, 7.f); li = fminf(fmaxf(li, -7.f), 7.f);
                        o[n * 4 + j] = gl * (1.f / (1.f + __expf(-1.702f * gl))) * (li + 1.f); }
                pg8::u32x4 w; w.x = pg8::cvt_pk_bf16(o[0], o[1]); w.y = pg8::cvt_pk_bf16(o[2], o[3]); w.z = pg8::cvt_pk_bf16(o[4], o[5]); w.w = pg8::cvt_pk_bf16(o[6], o[7]);
                *(pg8::u32x4*)(act + (size_t)(row0 + ai * 128 + m * 16) * DFF + col) = w; }
    }
};
struct EpiDown {
    static constexpr bool PERM = true, AFTER_DRAIN = false;
    const float* b2; const float* roww; bf16* y;
    __device__ __forceinline__ void operator()(const pg8::f32x4 (&acc)[2][2][4][2], const pg8::Unit& u, int wr, int wc, int fr, int fq) const {
        const int e = u.kind; const int col0 = u.pn * 256 + wc * 32 + 8 * fq; const int row0 = u.pm * 256 + wr * 64 + fr;
        pg8::f32x4 bv[2][2];
#pragma unroll
        for (int bj = 0; bj < 2; ++bj)
#pragma unroll
            for (int n = 0; n < 2; ++n) bv[bj][n] = *(const pg8::f32x4*)(b2 + (size_t)e * DM + col0 + bj * 128 + 4 * n);
#pragma unroll
        for (int ai = 0; ai < 2; ++ai)
#pragma unroll
            for (int m = 0; m < 4; ++m) { const int r = row0 + ai * 128 + m * 16; const float g = roww[r];
#pragma unroll
                for (int bj = 0; bj < 2; ++bj) { const pg8::f32x4 v0 = (acc[ai][bj][m][0] + bv[bj][0]) * g, v1 = (acc[ai][bj][m][1] + bv[bj][1]) * g;
                    pg8::u32x4 w; w.x = pg8::cvt_pk_bf16(v0[0], v0[1]); w.y = pg8::cvt_pk_bf16(v0[2], v0[3]); w.z = pg8::cvt_pk_bf16(v1[0], v1[1]); w.w = pg8::cvt_pk_bf16(v1[2], v1[3]);
                    *(pg8::u32x4*)(y + (size_t)r * DM + col0 + bj * 128) = w; } }
    }
};

__device__ __forceinline__ void ph_loga(const Params& p, size_t i0, size_t istride) {
    const bf16* SM = (const bf16*)(p.ws + WS_SM); float* LA = (float*)(p.ws + WS_LA); const float* wa2 = p.in[I_WA2]; const float* ba = p.in[I_BA];
    for (size_t i = i0; i < (size_t)T * 512; i += istride) {
        const int t = (int)(i >> 9), c = (int)(i & 511); float z = ba[c];
#pragma unroll
        for (int r = 0; r < 16; ++r) z += bf2f(SM[(size_t)t * 64 + r]) * wa2[r * 512 + c];
        LA[i] = (fminf(z, 0.f) - log1pf(__expf(-fabsf(z)))) * (1.f / 16.f);
    }
}
__device__ __forceinline__ void ph_gla_naive(const Params& p, LAS float* qs, int unit, int lane) {
    LAS float* ks = qs + 128; LAS float* as = qs + 256;
    const int bh = unit >> 2, sl = unit & 3, b = bh >> 2, h = bh & 3, dv = sl * 64 + lane;
    const bf16* GQ = (const bf16*)(p.ws + WS_GQ); const bf16* GK = (const bf16*)(p.ws + WS_GK); const bf16* GV = (const bf16*)(p.ws + WS_GV);
    const float* LA = (const float*)(p.ws + WS_LA); float* OG = (float*)(p.ws + WS_OG);
    float st[128];
#pragma unroll
    for (int i = 0; i < 128; ++i) st[i] = 0.f;
    for (int s = 0; s < SEQ; ++s) { const size_t row = (size_t)b * SEQ + s;
#pragma unroll
        for (int j = 0; j < 2; ++j) { const int dk = lane + 64 * j; qs[dk] = bf2f(GQ[row * 512 + h * 128 + dk]); ks[dk] = bf2f(GK[row * 512 + h * 128 + dk]); as[dk] = __expf(LA[row * 512 + h * 128 + dk]); }
        LDS_WAIT(); __builtin_amdgcn_wave_barrier();
        const float v = bf2f(GV[row * 1024 + h * 256 + dv]); float o = 0.f;
#pragma unroll
        for (int dk = 0; dk < 128; ++dk) { st[dk] = as[dk] * st[dk] + ks[dk] * v; o += qs[dk] * st[dk]; }
        OG[row * 1024 + h * 256 + dv] = o;
        LDS_WAIT(); __builtin_amdgcn_wave_barrier();
    }
}
template <bool DO_NSA> __device__ __forceinline__ void ph_mix_post(const Params& p, int gw, int NGW, int lane) {
    const float* OG = (const float*)(p.ws + WS_OG); const float* ON = (const float*)(p.ws + WS_ON); const bf16* GG = (const bf16*)(p.ws + WS_GG); bf16* A2 = (bf16*)(p.ws + WS_A2);
    const float* gn = p.in[I_GLAG]; const float* ng = p.in[I_NSAG];
    for (int t = gw; t < T; t += NGW) {
#pragma unroll
        for (int h = 0; h < 4; ++h) { const f32x4 o = *((const f32x4*)(OG + (size_t)t * 1024 + h * 256) + lane);
            const float ms = wave_sum(o.x * o.x + o.y * o.y + o.z * o.z + o.w * o.w) * (1.f / 256.f); const float rstd = 1.f / sqrtf(ms + RMS_EPS);
            const f32x4 g4 = ((const f32x4*)gn)[lane]; const v2u gg = *((const v2u*)(GG + (size_t)t * 1024 + h * 256) + lane);
            const float z0 = bflo(gg.x), z1 = bfhi(gg.x), z2 = bflo(gg.y), z3 = bfhi(gg.y);
            v2u w; w.x = pk2(o.x * rstd * g4.x * (z0 / (1.f + __expf(-z0))), o.y * rstd * g4.y * (z1 / (1.f + __expf(-z1))));
            w.y = pk2(o.z * rstd * g4.z * (z2 / (1.f + __expf(-z2))), o.w * rstd * g4.w * (z3 / (1.f + __expf(-z3))));
            *((v2u*)(A2 + (size_t)t * DM + h * 256) + lane) = w; }
        if (!DO_NSA) continue;
        f32x4 v[4]; float s = 0.f;
#pragma unroll
        for (int j = 0; j < 4; ++j) { v[j] = *((const f32x4*)(ON + (size_t)t * 1024) + lane + 64 * j); s += v[j].x * v[j].x + v[j].y * v[j].y + v[j].z * v[j].z + v[j].w * v[j].w; }
        const float rstd = 1.f / sqrtf(wave_sum(s) * (1.f / 1024.f) + RMS_EPS);
#pragma unroll
        for (int j = 0; j < 4; ++j) { const f32x4 g4 = ((const f32x4*)ng)[lane + 64 * j]; v2u w; w.x = pk2(v[j].x * rstd * g4.x, v[j].y * rstd * g4.y); w.y = pk2(v[j].z * rstd * g4.z, v[j].w * rstd * g4.w);
            *((v2u*)(A2 + (size_t)t * DM + 1024) + lane + 64 * j) = w; }
    }
}
__device__ __forceinline__ float gelu_tanh(float x) { const float u = 0.7978845608028654f * (x + 0.044715f * x * x * x); const float e = __expf(2.f * u); return 0.5f * x * (1.f + (1.f - 2.f / (e + 1.f))); }
__device__ __forceinline__ void ph_cmp_naive(const Params& p, LAS float* tl, int id, int n) {
    LAS float* hid = tl + 4096;
    const int which = id / (16 * 255), rem = id % (16 * 255), bg = rem / 255, c = rem % 255;
    const bf16* src = (const bf16*)(p.ws + (which ? WS_VC : WS_KC)) + ((size_t)bg * SEQ + 16 * c) * 128;
    const float* pe = p.in[which ? I_PEV : I_PEK]; const float* w1 = p.in[which ? I_WV1 : I_WK1]; const float* w2 = p.in[which ? I_WV2 : I_WK2];
    for (int i = n; i < 4096; i += 128) tl[i] = bf2f(src[i]) + pe[i];
    __syncthreads();
    float a = 0.f;
    for (int k = 0; k < 4096; ++k) a += tl[k] * w1[(size_t)k * 128 + n];
    hid[n] = gelu_tanh(a);
    __syncthreads();
    float o = 0.f;
    for (int m = 0; m < 128; ++m) o += hid[m] * w2[m * 128 + n];
    if (which == 0) ((bf16*)(p.ws + WS_KCMP))[((size_t)bg * 256 + c) * 128 + n] = (bf16)f2bf(o);
    else ((bf16*)(p.ws + WS_VCMPT))[((size_t)bg * 128 + n) * 256 + c] = (bf16)f2bf(o);
}
__device__ __forceinline__ void ph_cmp_fin_simple(const Params& p, LAS float* tl, int id, int n, const float* LHall, const float* PEVall) {
    LAS float* hid = tl + 4096;
    const int which = id / (16 * 255), rem = id % (16 * 255), bg = rem / 255, c = rem % 255;
    const float* w2 = p.in[which ? I_WV2 : I_WK2];
    const float* LH = LHall + ((size_t)which * 4096 + bg * 256) * 256;
    float pev = 0.f;
#pragma unroll 8
    for (int q = 0; q < 64; ++q) pev += PEVall[(size_t)(which * 64 + q) * 128 + n];
    const float a = LH[(size_t)c * 256 + n] + LH[(size_t)(c + 1) * 256 + 128 + n] + pev;
    hid[n] = gelu_tanh(a);
    __syncthreads();
    float o = 0.f;
    for (int m = 0; m < 128; ++m) o += hid[m] * w2[m * 128 + n];
    if (which == 0) ((bf16*)(p.ws + WS_KCMP))[((size_t)bg * 256 + c) * 128 + n] = (bf16)f2bf(o);
    else ((bf16*)(p.ws + WS_VCMPT))[((size_t)bg * 128 + n) * 256 + c] = (bf16)f2bf(o);
}
__device__ __forceinline__ float dot128(const LAS float* q, const bf16* k) {
    float a = 0.f;
#pragma unroll
    for (int i = 0; i < 16; ++i) { const v4u w = ((const v4u*)k)[i];
        a += q[8 * i] * bflo(w.x) + q[8 * i + 1] * bfhi(w.x) + q[8 * i + 2] * bflo(w.y) + q[8 * i + 3] * bfhi(w.y) + q[8 * i + 4] * bflo(w.z) + q[8 * i + 5] * bfhi(w.z) + q[8 * i + 6] * bflo(w.w) + q[8 * i + 7] * bfhi(w.w); }
    return a;
}
__device__ __forceinline__ void ph_nsa_naive(const Params& p, LAS float* base, int vblk, int r, int lane) {
    LAS float (*qf)[128] = (LAS float (*)[128])base; LAS float (*lg)[1024] = (LAS float (*)[1024])(base + 512); LAS unsigned long long& selm = *(LAS unsigned long long*)(base + 512 + 4096);
    const int s = vblk & (SEQ - 1), bg = vblk >> 12, b = bg >> 1, g = bg & 1, h = g * 4 + r;
    const size_t row = (size_t)b * SEQ + s;
    const bf16* NQ = (const bf16*)(p.ws + WS_NQ); const bf16* SM = (const bf16*)(p.ws + WS_SM);
    const bf16* KCMP = (const bf16*)(p.ws + WS_KCMP) + (size_t)bg * 256 * 128; const bf16* VCMPT = (const bf16*)(p.ws + WS_VCMPT) + (size_t)bg * 128 * 256;
    const bf16* KS = (const bf16*)(p.ws + WS_KS) + (size_t)bg * SEQ * 128; const bf16* KW = (const bf16*)(p.ws + WS_KW) + (size_t)bg * SEQ * 128;
    const bf16* VST = (const bf16*)(p.ws + WS_VST) + (size_t)bg * 128 * SEQ; const bf16* VWT = (const bf16*)(p.ws + WS_VWT) + (size_t)bg * 128 * SEQ;
    const float* relb = p.in[I_RELB]; float* ON = (float*)(p.ws + WS_ON);
    qf[r][lane] = bf2f(NQ[row * 1024 + h * 128 + lane]); qf[r][lane + 64] = bf2f(NQ[row * 1024 + h * 128 + lane + 64]);
    __syncthreads();
    const LAS float* q = qf[r]; LAS float* L = lg[r];
    float ot0 = 0.f, ot1 = 0.f;
    const float gt0 = 1.f / (1.f + __expf(-bf2f(SM[row * 64 + 16 + h]))), gt1 = 1.f / (1.f + __expf(-bf2f(SM[row * 64 + 24 + h]))), gt2 = 1.f / (1.f + __expf(-bf2f(SM[row * 64 + 32 + h])));
#define BIAS(dist) relb[(int)kBucket[(dist) > 127 ? 127 : (dist)] * 8 + h]
    const int ncv = (s >= 31) ? ((s - 31) >> 4) + 1 : 0;
    if (ncv > 0) {
        float mx = -3e38f;
        for (int c = lane; c < ncv; c += 64) { const float l = dot128(q, KCMP + (size_t)c * 128) + BIAS(s - (16 * c + 31)); L[c] = l; mx = fmaxf(mx, l); }
        mx = wave_max(mx); float sum = 0.f;
        for (int c = lane; c < ncv; c += 64) { const float e = __expf(L[c] - mx); L[c] = e; sum += e; }
        sum = wave_sum(sum); const float inv = 1.f / sum;
        for (int c = lane; c < ncv; c += 64) L[c] *= inv;
        LDS_WAIT(); __builtin_amdgcn_wave_barrier();
        float o0 = 0.f, o1 = 0.f;
        for (int c = 0; c < ncv; ++c) { const float pr = L[c]; o0 += pr * bf2f(VCMPT[(size_t)lane * 256 + c]); o1 += pr * bf2f(VCMPT[(size_t)(lane + 64) * 256 + c]); }
        ot0 += gt0 * o0; ot1 += gt0 * o1;
    }
    __syncthreads();
    const int cur = s >> 6;
    if (r == 0) { const int n = lane; float sc;
        if (n == 0 || n == cur || n == cur - 1) sc = 1e4f;
        else if (n <= cur) { float im = 0.f; for (int rr = 0; rr < 4; ++rr) for (int c = 4 * n - 1; c <= 4 * n + 3; ++c) if (c >= 0 && c < ncv) im += lg[rr][c]; sc = im; }
        else sc = -1.f;
        int rank = 0;
        for (int m = 0; m < 64; ++m) { const float sm = __shfl(sc, m); rank += (sm > sc || (sm == sc && m < n)) ? 1 : 0; }
        const unsigned long long mk = __ballot(rank < 16);
        if (lane == 0) selm = mk; }
    __syncthreads();
    { unsigned long long mask = selm & (cur == 63 ? ~0ull : ((1ull << (cur + 1)) - 1ull));
      int cnt = 0; float mx = -3e38f;
      for (unsigned long long mm = mask; mm; mm &= mm - 1) { const int n = __builtin_ctzll(mm); const int kpos = n * 64 + lane; float l = -3e38f;
          if (kpos <= s) l = dot128(q, KS + (size_t)kpos * 128) + BIAS(s - kpos);
          L[cnt * 64 + lane] = l; mx = fmaxf(mx, l); ++cnt; }
      mx = wave_max(mx); float sum = 0.f;
      for (int j = 0; j < cnt; ++j) { const float l = L[j * 64 + lane]; const float e = l > -1e38f ? __expf(l - mx) : 0.f; L[j * 64 + lane] = e; sum += e; }
      sum = wave_sum(sum); const float inv = 1.f / sum;
      LDS_WAIT(); __builtin_amdgcn_wave_barrier();
      float o0 = 0.f, o1 = 0.f; int j = 0;
      for (unsigned long long mm = mask; mm; mm &= mm - 1, ++j) { const int n = __builtin_ctzll(mm);
          for (int kk = 0; kk < 64; ++kk) { const float pr = L[j * 64 + kk]; o0 += pr * bf2f(VST[(size_t)lane * SEQ + n * 64 + kk]); o1 += pr * bf2f(VST[(size_t)(lane + 64) * SEQ + n * 64 + kk]); } }
      ot0 += gt1 * o0 * inv; ot1 += gt1 * o1 * inv; }
    LDS_WAIT(); __builtin_amdgcn_wave_barrier();
    { const int lo = s >= 511 ? s - 511 : 0, nk = s - lo + 1; float mx = -3e38f;
      for (int i = lane; i < nk; i += 64) { const int kpos = lo + i; const float l = dot128(q, KW + (size_t)kpos * 128) + BIAS(s - kpos); L[i] = l; mx = fmaxf(mx, l); }
      mx = wave_max(mx); float sum = 0.f;
      for (int i = lane; i < nk; i += 64) { const float e = __expf(L[i] - mx); L[i] = e; sum += e; }
      sum = wave_sum(sum); const float inv = 1.f / sum;
      LDS_WAIT(); __builtin_amdgcn_wave_barrier();
      float o0 = 0.f, o1 = 0.f;
      for (int i = 0; i < nk; ++i) { const float pr = L[i]; o0 += pr * bf2f(VWT[(size_t)lane * SEQ + lo + i]); o1 += pr * bf2f(VWT[(size_t)(lane + 64) * SEQ + lo + i]); }
      ot0 += gt2 * o0 * inv; ot1 += gt2 * o1 * inv; }
#undef BIAS
    ON[row * 1024 + h * 128 + lane] = ot0; ON[row * 1024 + h * 128 + lane + 64] = ot1;
}

namespace nsa {
constexpr int KB0 = 0, KB1 = 16384, VB0 = 32768, VB1 = 49152, LUT = 65536;
constexpr int QST = LUT + 4096, IMP = QST + 65536, SELM = IMP + 16384, LDS_END = SELM + 512;
constexpr float LOG2E = 1.4426950408889634f;
typedef float f4 __attribute__((ext_vector_type(4)));

typedef unsigned u2v __attribute__((ext_vector_type(2)));
__device__ __forceinline__ float rmax16(float x) { const unsigned u = __float_as_uint(x); const u2v r = __builtin_amdgcn_permlane16_swap(u, u, false, false); return fmaxf(__uint_as_float(r[0]), __uint_as_float(r[1])); }
__device__ __forceinline__ float rmax32(float x) { const unsigned u = __float_as_uint(x); const u2v r = __builtin_amdgcn_permlane32_swap(u, u, false, false); return fmaxf(__uint_as_float(r[0]), __uint_as_float(r[1])); }
__device__ __forceinline__ float radd16(float x) { const unsigned u = __float_as_uint(x); const u2v r = __builtin_amdgcn_permlane16_swap(u, u, false, false); return __uint_as_float(r[0]) + __uint_as_float(r[1]); }
__device__ __forceinline__ float radd32(float x) { const unsigned u = __float_as_uint(x); const u2v r = __builtin_amdgcn_permlane32_swap(u, u, false, false); return __uint_as_float(r[0]) + __uint_as_float(r[1]); }
__device__ __forceinline__ float raddq(float x) { x += __int_as_float(__builtin_amdgcn_update_dpp(0, __float_as_int(x), 0xB1, 0xF, 0xF, true)); x += __int_as_float(__builtin_amdgcn_update_dpp(0, __float_as_int(x), 0x4E, 0xF, 0xF, true)); return x; }
struct Ctx {
    LAS unsigned char* lds; int tid, lane, wave, c, gq, r;
    int s0, cur;
    const LAS unsigned char* qst;
    int pos0;
    const LAS float* lutrow;
    int koff0, voff0;
    unsigned kdo[2], vdoc[2], vdos[2];
};
__device__ __forceinline__ void dma_k(const Ctx& C, const bf16* kt, LAS unsigned char* kb) {
#pragma unroll
    for (int i = 0; i < 2; ++i) __builtin_amdgcn_global_load_lds((const unsigned*)((const char*)kt + C.kdo[i]), (LAS unsigned*)(kb + (2 * C.wave + i) * 1024), 16, 0, 0); }
__device__ __forceinline__ void dma_v(const Ctx& C, const bf16* vt, const unsigned (&vdo)[2], LAS unsigned char* vb) {
#pragma unroll
    for (int i = 0; i < 2; ++i) __builtin_amdgcn_global_load_lds((const unsigned*)((const char*)vt + vdo[i]), (LAS unsigned*)(vb + (2 * C.wave + i) * 1024), 16, 0, 0); }

__device__ __forceinline__ void compute_st(const Ctx& C, const LAS unsigned char* kb, f4 (&s)[2][4]) {
#pragma unroll
    for (int ks = 0; ks < 4; ++ks) { const bf16x8 q0 = *(const LAS bf16x8*)(C.qst + ks * 1024), q1 = *(const LAS bf16x8*)(C.qst + (4 + ks) * 1024);
#pragma unroll
        for (int kt = 0; kt < 4; ++kt) { const bf16x8 a = *(const LAS bf16x8*)(kb + kt * 4096 + (C.koff0 ^ (ks * 64)));
            s[0][kt] = __builtin_amdgcn_mfma_f32_16x16x32_bf16(a, q0, ks == 0 ? (f4){0.f, 0.f, 0.f, 0.f} : s[0][kt], 0, 0, 0);
            s[1][kt] = __builtin_amdgcn_mfma_f32_16x16x32_bf16(a, q1, ks == 0 ? (f4){0.f, 0.f, 0.f, 0.f} : s[1][kt], 0, 0, 0); }
        asm volatile("" ::: "memory"); }
}
__device__ __forceinline__ void compute_pv(const Ctx& C, const LAS unsigned char* vb, const f4 (&p)[2][4], f4 (&o)[2][8]) {
#pragma unroll
    for (int i = 0; i < 2; ++i) { bf16x8 pb[2];
#pragma unroll
        for (int qt = 0; qt < 2; ++qt) { v4u w; w.x = pg8::cvt_pk_bf16(p[qt][2 * i][0], p[qt][2 * i][1]); w.y = pg8::cvt_pk_bf16(p[qt][2 * i][2], p[qt][2 * i][3]);
            w.z = pg8::cvt_pk_bf16(p[qt][2 * i + 1][0], p[qt][2 * i + 1][1]); w.w = pg8::cvt_pk_bf16(p[qt][2 * i + 1][2], p[qt][2 * i + 1][3]); pb[qt] = __builtin_bit_cast(bf16x8, w); }
#pragma unroll
        for (int dt = 0; dt < 8; ++dt) { const v2u lo = *(const LAS v2u*)(vb + dt * 2048 + (C.voff0 ^ (i * 64))), hi = *(const LAS v2u*)(vb + dt * 2048 + (C.voff0 ^ (i * 64 + 32))); const bf16x8 a = __builtin_bit_cast(bf16x8, (v4u){lo.x, lo.y, hi.x, hi.y});
#pragma unroll
            for (int qt = 0; qt < 2; ++qt) o[qt][dt] = __builtin_amdgcn_mfma_f32_16x16x32_bf16(a, pb[qt], o[qt][dt], 0, 0, 0);
            if (dt & 1) asm volatile("" ::: "memory"); } }
}
enum { M_CMP = 0, M_SEL = 1, M_WIN = 2 };
template <int MODE, bool FAR = false>
__device__ __forceinline__ void mask_bias(const Ctx& C, f4 (&s)[2][4], int kb, int n, const LAS unsigned* selw) {
    const float NEG = -__builtin_inff();
#pragma unroll
    for (int qt = 0; qt < 2; ++qt) {
        bool tokok = true;
        if (MODE == M_SEL) tokok = ((selw[(4 * qt + (C.c >> 2)) * 2 + (n >> 5)] >> (n & 31)) & 1u) != 0u;
        if (FAR) { const float be = tokok ? C.lutrow[127] : NEG;
#pragma unroll
            for (int kt = 0; kt < 4; ++kt)
#pragma unroll
                for (int rg = 0; rg < 4; ++rg) s[qt][kt][rg] = __builtin_fmaf(s[qt][kt][rg], LOG2E, be);
            continue; }
        const int dbase = (MODE == M_CMP) ? (C.pos0 + 4 * qt - 31 - 16 * (kb + 4 * C.gq)) : (C.pos0 + 4 * qt - (kb + 4 * C.gq));
#pragma unroll
        for (int kt = 0; kt < 4; ++kt) {
#pragma unroll
            for (int rg = 0; rg < 4; ++rg) { const int d = (MODE == M_CMP) ? dbase - 16 * (16 * kt + rg) : dbase - (16 * kt + rg);
                int di = d < 0 ? 0 : d; di = di > 127 ? 127 : di; const float bias = C.lutrow[di];
                bool ok = tokok && d >= 0; if (MODE == M_WIN) ok = ok && d < 512;
                s[qt][kt][rg] = ok ? __builtin_fmaf(s[qt][kt][rg], LOG2E, bias) : NEG; }
            asm volatile("" ::: "memory"); }
    }
}
__device__ __forceinline__ void softmax_step(f4 (&s)[2][4], float (&m)[2], float (&l)[2], f4 (&o)[2][8], bool rescale_o) {
#pragma unroll
    for (int qt = 0; qt < 2; ++qt) { float mx = s[qt][0][0];
#pragma unroll
        for (int kt = 0; kt < 4; ++kt)
#pragma unroll
            for (int rg = 0; rg < 4; ++rg) mx = fmaxf(mx, s[qt][kt][rg]);
        mx = rmax32(rmax16(mx));
        const float mn = fmaxf(m[qt], mx), alpha = __builtin_amdgcn_exp2f(m[qt] - mn); m[qt] = mn; float ps = 0.f;
#pragma unroll
        for (int kt = 0; kt < 4; ++kt)
#pragma unroll
            for (int rg = 0; rg < 4; ++rg) { const float e = __builtin_amdgcn_exp2f(s[qt][kt][rg] - mn); s[qt][kt][rg] = e; ps += e; }
        l[qt] = l[qt] * alpha + ps;
        if (rescale_o && __any(alpha != 1.f)) {
#pragma unroll
            for (int dt = 0; dt < 8; ++dt) o[qt][dt] = o[qt][dt] * alpha; }
    }
}
template <int MODE>
__device__ __forceinline__ void softmax_far(const Ctx& C, f4 (&s)[2][4], int n, const LAS unsigned* selw, float (&m)[2], float (&l)[2], f4 (&o)[2][8]) {
    const float b31 = C.lutrow[127];
#pragma unroll
    for (int qt = 0; qt < 2; ++qt) {
        float be = b31;
        if (MODE == M_SEL) { const bool tokok = ((selw[(4 * qt + (C.c >> 2)) * 2 + (n >> 5)] >> (n & 31)) & 1u) != 0u; be = tokok ? b31 : -__builtin_inff(); }
        float mx = fmaxf(fmaxf(s[qt][0][0], s[qt][0][1]), fmaxf(s[qt][0][2], s[qt][0][3]));
#pragma unroll
        for (int kt = 1; kt < 4; ++kt) mx = fmaxf(mx, fmaxf(fmaxf(s[qt][kt][0], s[qt][kt][1]), fmaxf(s[qt][kt][2], s[qt][kt][3])));
        mx = rmax32(rmax16(mx));
        const float mt = __builtin_fmaf(mx, LOG2E, be), mn = fmaxf(m[qt], mt), alpha = __builtin_amdgcn_exp2f(m[qt] - mn), c0 = be - mn; m[qt] = mn; float ps = 0.f;
#pragma unroll
        for (int kt = 0; kt < 4; ++kt)
#pragma unroll
            for (int rg = 0; rg < 4; ++rg) { const float e = __builtin_amdgcn_exp2f(__builtin_fmaf(s[qt][kt][rg], LOG2E, c0)); s[qt][kt][rg] = e; ps += e; }
        l[qt] = l[qt] * alpha + ps;
        if (__any(alpha != 1.f)) {
#pragma unroll
            for (int dt = 0; dt < 8; ++dt) o[qt][dt] = o[qt][dt] * alpha; }
    }
}
}

__device__ __forceinline__ void ph_nsa(const Params& p, LAS unsigned char* lds, int idx0, int idxstride, int tid_in, int wave) {
    using namespace nsa;
    int tid = tid_in; asm volatile("" : "+v"(tid));
    const int lane = tid & 63;
    Ctx C; C.lds = lds; C.tid = tid; C.lane = lane; C.wave = wave; C.c = lane & 15; C.gq = lane >> 4; C.r = lane & 3;
    C.koff0 = C.c * 256 + ((C.gq ^ C.c) * 16);
#pragma unroll
    for (int i = 0; i < 2; ++i) { const int piece = 2 * wave + i;
        { const int row = piece * 4 + (lane >> 4), chunk = (lane & 15) ^ (row & 15); C.kdo[i] = (unsigned)(row * 256 + chunk * 16); }
        { const int row = piece * 8 + (lane >> 3), chunk = (lane & 7) ^ ((row >> 1) & 7); C.vdoc[i] = (unsigned)(row * 256 * 2 + chunk * 16); C.vdos[i] = (unsigned)(row * SEQ * 2 + chunk * 16); } }
    C.voff0 = C.c * 128 + (((C.gq >> 1) ^ ((C.c >> 1) & 7)) * 16) + (C.gq & 1) * 8;
    const bf16* NQ = (const bf16*)(p.ws + WS_NQ); const bf16* SM = (const bf16*)(p.ws + WS_SM); bf16* A2 = (bf16*)(p.ws + WS_A2);
    const float* relb = p.in[I_RELB]; const float* nsag = p.in[I_NSAG];
    LAS float* lut = (LAS float*)(lds + LUT);
    for (int i = tid; i < 8 * 128; i += 512) { const int hh = i >> 7, d = i & 127; lut[i] = relb[(int)kBucket[d] * 8 + hh] * LOG2E; }
    __syncthreads();
    LAS unsigned char* qstw = lds + QST + wave * 8192 + lane * 16; C.qst = qstw;
    LAS float* imp = (LAS float*)(lds + IMP + wave * 2048);
    LAS unsigned long long* selm = (LAS unsigned long long*)(lds + SELM + wave * 64);
#define NSA_SYNC() do { asm volatile("s_waitcnt vmcnt(0)" ::: "memory"); __syncthreads(); } while (0)
    for (int idx = idx0; idx < 512; idx += idxstride) {
        const int rnd = idx >> 8, kq = idx & 255, b = kq & 7, tq = rnd == 0 ? 63 - (kq >> 3) : (kq >> 3);
        C.s0 = tq * 64; C.cur = tq;
        const int tokl0 = 8 * wave + (C.c >> 2);
        C.pos0 = C.s0 + tokl0;
        float ssq[2] = {0.f, 0.f};
        for (int g = 0; g < 2; ++g) {
            const int bg = b * 2 + g, h = g * 4 + C.r;
            C.lutrow = lut + h * 128;
            const bf16* KCMP = (const bf16*)(p.ws + WS_KCMP) + (size_t)bg * 256 * 128; const bf16* VCMPT = (const bf16*)(p.ws + WS_VCMPT) + (size_t)bg * 128 * 256;
#pragma unroll
            for (int qt = 0; qt < 2; ++qt) { const unsigned qo = (unsigned)(((b * SEQ + (C.pos0 + 4 * qt)) * 1024 + h * 128 + 8 * C.gq) * 2);
#pragma unroll
                for (int ks = 0; ks < 4; ++ks) *(LAS bf16x8*)(qstw + (qt * 4 + ks) * 1024) = *(const bf16x8*)((const char*)NQ + qo + ks * 64); }
#pragma unroll
            for (int i = 0; i < 2; ++i) *(LAS f32x4*)((LAS unsigned char*)imp + lane * 16 + i * 1024) = (f32x4){0.f, 0.f, 0.f, 0.f};
#define NSA_OROW(qt) ((char*)A2 + (unsigned)(((b * SEQ + C.pos0 + 4 * (qt)) * DM + 1024 + h * 128 + 4 * C.gq) * 2))
            const int cmaxb = C.s0 + 63 - 31; const int nct = cmaxb >= 0 ? ((cmaxb >> 4) >> 6) + 1 : 0;
            float m[2] = {-1e30f, -1e30f}, l[2] = {0.f, 0.f};
            f4 o[2][8];
            if (nct > 0) {
                dma_k(C, KCMP, lds + KB0); NSA_SYNC();
                for (int ct = 0; ct < nct; ++ct) { const int buf = ct & 1;
                    if (ct + 1 < nct) dma_k(C, KCMP + (ct + 1) * 64 * 128, lds + (buf ? KB0 : KB1));
                    f4 s[2][4]; compute_st(C, lds + (buf ? KB1 : KB0), s); mask_bias<M_CMP>(C, s, 64 * ct, 0, (const LAS unsigned*)selm); softmax_step(s, m, l, o, false);
                    NSA_SYNC(); }
            }
            float inv[2];
#pragma unroll
            for (int qt = 0; qt < 2; ++qt) { const float lt = radd32(radd16(l[qt])); inv[qt] = lt > 0.f ? 1.f / lt : 0.f; }
#pragma unroll
            for (int qt = 0; qt < 2; ++qt)
#pragma unroll
                for (int dt = 0; dt < 8; ++dt) o[qt][dt] = (f4){0.f, 0.f, 0.f, 0.f};
            if (nct > 0) {
                dma_k(C, KCMP, lds + KB0); dma_v(C, VCMPT, C.vdoc, lds + VB0); NSA_SYNC();
                for (int ct = 0; ct < nct; ++ct) { const int buf = ct & 1;
                    if (ct + 1 < nct) { dma_k(C, KCMP + (ct + 1) * 64 * 128, lds + (buf ? KB0 : KB1)); dma_v(C, VCMPT + 64 * (ct + 1), C.vdoc, lds + (buf ? VB0 : VB1)); }
                    f4 s[2][4]; compute_st(C, lds + (buf ? KB1 : KB0), s); mask_bias<M_CMP>(C, s, 64 * ct, 0, (const LAS unsigned*)selm);
#pragma unroll
                    for (int qt = 0; qt < 2; ++qt)
#pragma unroll
                        for (int kt = 0; kt < 4; ++kt) {
#pragma unroll
                            for (int rg = 0; rg < 4; ++rg) s[qt][kt][rg] = __builtin_amdgcn_exp2f(s[qt][kt][rg] - m[qt]) * inv[qt];
                            float po = (s[qt][kt][0] + s[qt][kt][1]) + (s[qt][kt][2] + s[qt][kt][3]), p3 = s[qt][kt][3];
                            po = raddq(po); p3 = raddq(p3);
                            const int nb = 16 * ct + 4 * kt + C.gq, tl = 4 * qt + (C.c >> 2);
                            if (C.r == 0) { __hip_atomic_fetch_add((float*)(imp + tl * 64 + nb), po, __ATOMIC_RELAXED, __HIP_MEMORY_SCOPE_WORKGROUP); if (nb + 1 < 64) __hip_atomic_fetch_add((float*)(imp + tl * 64 + nb + 1), p3, __ATOMIC_RELAXED, __HIP_MEMORY_SCOPE_WORKGROUP); } }
                    compute_pv(C, lds + (buf ? VB1 : VB0), s, o);
                    NSA_SYNC(); }
            }
            LDS_WAIT(); __builtin_amdgcn_wave_barrier();
            for (int tk = 0; tk < 8; ++tk) { const int n = lane; float sc;
                if (n == 0 || n == C.cur || n == C.cur - 1) sc = 1e4f; else if (n <= C.cur) sc = imp[tk * 64 + n]; else sc = -1.f;
                const int key = ((sc < 0.f ? 0 : __float_as_int(sc) + 64) & ~63) | (63 - n);
                int rank = 0;
#pragma unroll
                for (int mm = 0; mm < 64; ++mm) rank += (__builtin_amdgcn_readlane(key, mm) > key) ? 1 : 0;
                const unsigned long long mk = __ballot(rank < 16);
                if (lane == 0) selm[tk] = mk; }
            LDS_WAIT(); __builtin_amdgcn_wave_barrier();
#pragma unroll
            for (int qt = 0; qt < 2; ++qt) { const float gt = 1.f / (1.f + __expf(-bf2f(*(const bf16*)((const char*)SM + (unsigned)(((b * SEQ + (C.pos0 + 4 * qt)) * 64 + 16 + h) * 2)))));
#pragma unroll
                for (int dt = 0; dt < 8; ++dt) { const f4 v = o[qt][dt] * gt; *(v2u*)(NSA_OROW(qt) + 32 * dt) = (v2u){pg8::cvt_pk_bf16(v[0], v[1]), pg8::cvt_pk_bf16(v[2], v[3])}; } }
#pragma unroll
            for (int br = 1; br <= 2; ++br) {
                const bf16* KX = (const bf16*)(p.ws + (br == 1 ? WS_KS : WS_KW)) + bg * SEQ * 128; const bf16* VX = (const bf16*)(p.ws + (br == 1 ? WS_VST : WS_VWT)) + bg * 128 * SEQ;
                const int n0 = br == 1 ? 0 : (C.cur >= 8 ? C.cur - 8 : 0), n1 = C.cur;
                m[0] = m[1] = -1e30f; l[0] = l[1] = 0.f;
#pragma unroll
                for (int qt = 0; qt < 2; ++qt)
#pragma unroll
                    for (int dt = 0; dt < 8; ++dt) o[qt][dt] = (f4){0.f, 0.f, 0.f, 0.f};
                int f0 = n1 + 1, f1 = n0 - 1;
                for (int n = n0; n <= n1; ++n) { const bool fa = (C.s0 - (64 * n + 63) >= 113) && (br == 1 || (C.s0 + 63 - 64 * n) < 512); if (fa) { f0 = n < f0 ? n : f0; f1 = n; } }
                const int cntf = f1 >= f0 ? f1 - f0 + 1 : 0, cnt = n1 - n0 + 1, nlo = cntf ? f0 - n0 : cnt;
#define NSA_TILE(i) ((i) < cntf ? f0 + (i) : (((i) - cntf) < nlo ? n0 + ((i) - cntf) : f1 + 1 + ((i) - cntf - nlo)))
#define NSA_BODY(FARF) { const int n = NSA_TILE(i); const int buf = i & 1; \
                    if (i + 1 < cnt) { const int nn = NSA_TILE(i + 1); dma_k(C, KX + nn * 64 * 128, lds + (buf ? KB0 : KB1)); dma_v(C, VX + 64 * nn, C.vdos, lds + (buf ? VB0 : VB1)); } \
                    bool need = true; \
                    if (br == 1) { const unsigned any = ((const LAS unsigned*)selm)[(lane & 7) * 2 + (n >> 5)] >> (n & 31); need = __any((int)(any & 1u)); } \
                    if (need) { f4 s[2][4]; compute_st(C, lds + (buf ? KB1 : KB0), s); \
                        if (FARF) { if (br == 1) softmax_far<M_SEL>(C, s, n, (const LAS unsigned*)selm, m, l, o); else softmax_far<M_WIN>(C, s, n, (const LAS unsigned*)selm, m, l, o); } \
                        else { if (br == 1) mask_bias<M_SEL, false>(C, s, 64 * n, n, (const LAS unsigned*)selm); else mask_bias<M_WIN, false>(C, s, 64 * n, n, (const LAS unsigned*)selm); \
                            softmax_step(s, m, l, o, true); } \
                        compute_pv(C, lds + (buf ? VB1 : VB0), s, o); } \
                    NSA_SYNC(); }
                { const int nf = NSA_TILE(0); dma_k(C, KX + nf * 64 * 128, lds + KB0); dma_v(C, VX + 64 * nf, C.vdos, lds + VB0); NSA_SYNC(); }
                int i = 0;
                for (; i < cntf; ++i) NSA_BODY(true)
                for (; i < cnt; ++i) NSA_BODY(false)
#undef NSA_BODY
#undef NSA_TILE
                asm volatile("s_waitcnt vmcnt(0)" ::: "memory");
#pragma unroll
                for (int qt = 0; qt < 2; ++qt) { const float lt = radd32(radd16(l[qt]));
                    const int row = b * SEQ + (C.pos0 + 4 * qt);
                    const float sc = (1.f / (1.f + __expf(-bf2f(*(const bf16*)((const char*)SM + (unsigned)((row * 64 + 16 + 8 * br + h) * 2)))))) / lt;
#pragma unroll
                    for (int dt = 0; dt < 8; ++dt) { const f4 v = o[qt][dt] * sc; v2u* sp = (v2u*)(NSA_OROW(qt) + 32 * dt); const v2u pv = *sp;
                        const float a0 = bflo(pv.x) + v[0], a1 = bfhi(pv.x) + v[1], a2 = bflo(pv.y) + v[2], a3 = bfhi(pv.y) + v[3];
                        if (br == 2) ssq[qt] += (a0 * a0 + a1 * a1) + (a2 * a2 + a3 * a3);
                        *sp = (v2u){pg8::cvt_pk_bf16(a0, a1), pg8::cvt_pk_bf16(a2, a3)}; } }
            }
        }
        float rstd[2];
#pragma unroll
        for (int qt = 0; qt < 2; ++qt) { const float t = radd32(radd16(raddq(ssq[qt]))); rstd[qt] = 1.f / sqrtf(t * (1.f / 1024.f) + RMS_EPS); }
        asm volatile("s_waitcnt vmcnt(0)" ::: "memory");
#pragma unroll
        for (int qt = 0; qt < 2; ++qt) { const int sub = C.r * 4 + C.gq; bf16* orow = (bf16*)((char*)A2 + (unsigned)(((b * SEQ + (C.pos0 + 4 * qt)) * DM + 1024) * 2 + sub * 16)); const int subz = 0;
#pragma unroll
            for (int j = 0; j < 8; ++j) { const int col = (j * 16 + subz) * 8; v4u w = *(const v4u*)((const char*)orow + (unsigned)(col * 2)); const f32x4 g0 = *(const f32x4*)((const char*)nsag + (unsigned)(col * 4 + sub * 32)), g1 = *(const f32x4*)((const char*)nsag + (unsigned)(col * 4 + sub * 32 + 16)); const float rs = rstd[qt];
                w.x = pk2(bflo(w.x) * rs * g0.x, bfhi(w.x) * rs * g0.y); w.y = pk2(bflo(w.y) * rs * g0.z, bfhi(w.y) * rs * g0.w); w.z = pk2(bflo(w.z) * rs * g1.x, bfhi(w.z) * rs * g1.y); w.w = pk2(bflo(w.w) * rs * g1.z, bfhi(w.w) * rs * g1.w);
                *(v4u*)((char*)orow + (unsigned)(col * 2)) = w; } }
        NSA_SYNC();
    }
#undef NSA_SYNC
#undef NSA_OROW
}

constexpr size_t WS_ST = WS_LA;
constexpr size_t WS_DEC = WS_ST + (size_t)2048 * 256 * 128 * 2;
static_assert(WS_DEC + (size_t)2048 * 128 * 4 <= WS_KCMP, "gla scratch overlay");
namespace gla {
typedef float f4 __attribute__((ext_vector_type(4)));
constexpr int L_ST = 0, L_KT = 65536, L_QT = 81920, L_VT = 98304, L_GA = 131072, L_GT = L_GA + 4096, L_RED = L_GT + 2048, L_END = L_RED + 512;
__device__ __forceinline__ void chunk_cumsum(const Params& p, LAS unsigned char* lds, int tid, int t0, int h, float (&P)[16], float& blast) {
    const bf16* SM = (const bf16*)(p.ws + WS_SM); const float* wa2 = p.in[I_WA2]; const float* ba = p.in[I_BA];
    LAS float* ga = (LAS float*)(lds + L_GA); LAS float* gt = (LAS float*)(lds + L_GT);
    if (tid < 128) { const int j = tid >> 1, hf = tid & 1; const v4u w = *(const v4u*)((const char*)SM + (unsigned)(((t0 + j) * 64 + hf * 8) * 2));
        LAS float* d = ga + j * 16 + hf * 8; d[0] = bflo(w.x); d[1] = bfhi(w.x); d[2] = bflo(w.y); d[3] = bfhi(w.y); d[4] = bflo(w.z); d[5] = bfhi(w.z); d[6] = bflo(w.w); d[7] = bfhi(w.w); }
    const int dk = tid & 127, jq = tid >> 7;
    float w[16];
#pragma unroll
    for (int r = 0; r < 16; ++r) w[r] = wa2[r * 512 + h * 128 + dk];
    const float bb = ba[h * 128 + dk];
    __syncthreads();
    float run = 0.f;
#pragma unroll
    for (int jj = 0; jj < 16; ++jj) { const LAS f32x4* gr = (const LAS f32x4*)(ga + (16 * jq + jj) * 16); float z = bb;
#pragma unroll
        for (int r4 = 0; r4 < 4; ++r4) { const f32x4 g4 = gr[r4]; z += g4.x * w[4 * r4] + g4.y * w[4 * r4 + 1] + g4.z * w[4 * r4 + 2] + g4.w * w[4 * r4 + 3]; }
        run += (fminf(z, 0.f) - log1pf(__expf(-fabsf(z)))) * (1.f / 16.f); P[jj] = run; }
    gt[jq * 128 + dk] = run;
    __syncthreads();
    float off = 0.f, tot = 0.f;
#pragma unroll
    for (int q = 0; q < 4; ++q) { const float t = gt[q * 128 + dk]; tot += t; if (q < jq) off += t; }
#pragma unroll
    for (int jj = 0; jj < 16; ++jj) P[jj] += off;
    blast = tot;
}
__device__ __forceinline__ void stage_raw_k(const bf16* src  , LAS unsigned char* dst, int tid, int t0, int h) {
#pragma unroll
    for (int q = 0; q < 2; ++q) { const int id = tid + 512 * q, j = id >> 4, c16 = id & 15; *(LAS v4u*)(dst + j * 256 + c16 * 16) = *(const v4u*)((const char*)src + (unsigned)(((t0 + j) * 512 + h * 128 + c16 * 8) * 2)); }
}
__device__ __forceinline__ void stage_raw_v(const Params& p, LAS unsigned char* dst, int tid, int t0, int h) {
    const bf16* GV = (const bf16*)(p.ws + WS_GV);
#pragma unroll
    for (int q = 0; q < 4; ++q) { const int id = tid + 512 * q, j = id >> 5, c = id & 31; *(LAS v4u*)(dst + j * 512 + c * 16) = *(const v4u*)((const char*)GV + (unsigned)(((t0 + j) * 1024 + h * 256 + c * 8) * 2)); }
}
__device__ __forceinline__ void fill_vt(LAS unsigned char* lds, const LAS unsigned char* rv, int tid) {
    const int dv = tid & 255, jh = tid >> 8;
    unsigned short v[32];
#pragma unroll
    for (int jj = 0; jj < 32; ++jj) v[jj] = *(const LAS bf16*)(rv + (32 * jh + jj) * 512 + dv * 2);
    LAS unsigned char* row = lds + L_VT + dv * 128; const int f = (dv >> 1) & 7;
#pragma unroll
    for (int q = 0; q < 4; ++q) { v4u w; w.x = v[8 * q] | ((unsigned)v[8 * q + 1] << 16); w.y = v[8 * q + 2] | ((unsigned)v[8 * q + 3] << 16); w.z = v[8 * q + 4] | ((unsigned)v[8 * q + 5] << 16); w.w = v[8 * q + 6] | ((unsigned)v[8 * q + 7] << 16);
        *(LAS v4u*)(row + (((4 * jh + q) ^ f) * 16)) = w; }
}
}

__device__ __forceinline__ void ph_gla_a(const Params& p, LAS unsigned char* lds, int u0, int ustride, int tid_in, int wave) {
    using namespace gla;
    int tid = tid_in; asm volatile("" : "+v"(tid));
    const int lane = tid & 63, c = lane & 15, gq = lane >> 4;
    const bf16* GK = (const bf16*)(p.ws + WS_GK); bf16* ST = (bf16*)(p.ws + WS_ST); float* DEC = (float*)(p.ws + WS_DEC);
    for (int unit = u0; unit < 2048; unit += ustride) {
        const int bh = unit >> 6, ch = unit & 63, b = bh >> 2, h = bh & 3, t0 = b * SEQ + ch * 64;
        stage_raw_k(GK, lds + 0, tid, t0, h); stage_raw_v(p, lds + 16384, tid, t0, h);
        float P[16], blast; chunk_cumsum(p, lds, tid, t0, h, P, blast);
        { const int dk = tid & 127, jq = tid >> 7;
          unsigned short kv[16];
#pragma unroll
          for (int jj = 0; jj < 16; ++jj) kv[jj] = *(const LAS bf16*)(lds + (16 * jq + jj) * 256 + dk * 2);
          unsigned pk[8];
#pragma unroll
          for (int q = 0; q < 8; ++q) pk[q] = pk2(bf2f(kv[2 * q]) * __expf(blast - P[2 * q]), bf2f(kv[2 * q + 1]) * __expf(blast - P[2 * q + 1]));
          LAS unsigned char* row = lds + L_KT + dk * 128; const int f = (dk >> 1) & 7;
          *(LAS v4u*)(row + (((2 * jq) ^ f) * 16)) = (v4u){pk[0], pk[1], pk[2], pk[3]}; *(LAS v4u*)(row + (((2 * jq + 1) ^ f) * 16)) = (v4u){pk[4], pk[5], pk[6], pk[7]};
          if (jq == 0) DEC[unit * 128 + dk] = __expf(blast); }
        fill_vt(lds, lds + 16384, tid);
        __syncthreads();
        f4 acc[16];
        const int f = (c >> 1) & 7;
        bf16x8 aF[2];
#pragma unroll
        for (int ks = 0; ks < 2; ++ks) aF[ks] = *(const LAS bf16x8*)(lds + L_KT + (16 * wave + c) * 128 + (((4 * ks + gq) ^ f) * 16));
#pragma unroll
        for (int nt = 0; nt < 16; ++nt) { acc[nt] = (f4){0.f, 0.f, 0.f, 0.f};
#pragma unroll
            for (int ks = 0; ks < 2; ++ks) { const bf16x8 bF = *(const LAS bf16x8*)(lds + L_VT + (16 * nt + c) * 128 + (((4 * ks + gq) ^ f) * 16)); acc[nt] = __builtin_amdgcn_mfma_f32_16x16x32_bf16(aF[ks], bF, acc[nt], 0, 0, 0); } }
        char* dst = (char*)ST + (size_t)unit * (256 * 128 * 2) + (unsigned)((c * 128 + 16 * wave + 4 * gq) * 2);
#pragma unroll
        for (int nt = 0; nt < 16; ++nt) *(v2u*)(dst + nt * 16 * 256) = (v2u){pg8::cvt_pk_bf16(acc[nt][0], acc[nt][1]), pg8::cvt_pk_bf16(acc[nt][2], acc[nt][3])};
        __syncthreads();
    }
}
__device__ __forceinline__ void ph_gla_b(const Params& p, int gid, int gstride) {
    bf16* ST = (bf16*)(p.ws + WS_ST); const float* DEC = (const float*)(p.ws + WS_DEC);
    for (int e = gid; e < 32 * 4096; e += gstride) { const int bh = e >> 12, dv = (e >> 4) & 255, d8 = e & 15;
        float st[8];
#pragma unroll
        for (int i = 0; i < 8; ++i) st[i] = 0.f;
        char* base = (char*)ST + (size_t)bh * 64 * (256 * 128 * 2) + (unsigned)((dv * 128 + d8 * 8) * 2); const float* dbase = DEC + (size_t)bh * 64 * 128 + d8 * 8;
#pragma unroll 4
        for (int ch = 0; ch < 64; ++ch) { v4u* ptr = (v4u*)(base + (size_t)ch * (256 * 128 * 2)); const v4u w = *ptr; const f32x4 d0 = *(const f32x4*)(dbase + ch * 128), d1 = *(const f32x4*)(dbase + ch * 128 + 4);
            v4u o; o.x = pk2(st[0], st[1]); o.y = pk2(st[2], st[3]); o.z = pk2(st[4], st[5]); o.w = pk2(st[6], st[7]); *ptr = o;
            st[0] = st[0] * d0.x + bflo(w.x); st[1] = st[1] * d0.y + bfhi(w.x); st[2] = st[2] * d0.z + bflo(w.y); st[3] = st[3] * d0.w + bfhi(w.y);
            st[4] = st[4] * d1.x + bflo(w.z); st[5] = st[5] * d1.y + bfhi(w.z); st[6] = st[6] * d1.z + bflo(w.w); st[7] = st[7] * d1.w + bfhi(w.w); }
    }
}
__device__ __forceinline__ void ph_gla_c(const Params& p, LAS unsigned char* lds, int u0, int ustride, int tid_in, int wave) {
    using namespace gla;
    int tid = tid_in; asm volatile("" : "+v"(tid));
    const int lane = tid & 63, c = lane & 15, gq = lane >> 4, nt = wave & 3, half = wave >> 2;
    const bf16* GQ = (const bf16*)(p.ws + WS_GQ); const bf16* GK = (const bf16*)(p.ws + WS_GK); const bf16* GG = (const bf16*)(p.ws + WS_GG); const bf16* ST = (const bf16*)(p.ws + WS_ST);
    bf16* A2 = (bf16*)(p.ws + WS_A2); const float* gn = p.in[I_GLAG];
    const int koff0 = c * 256 + ((gq ^ c) * 16), voff0 = c * 128 + (((gq >> 1) ^ ((c >> 1) & 7)) * 16) + (gq & 1) * 8;
    for (int unit = u0; unit < 2048; unit += ustride) {
        const int bh = unit >> 6, ch = unit & 63, b = bh >> 2, h = bh & 3, t0 = b * SEQ + ch * 64;
        stage_raw_k(GQ, lds + 0, tid, t0, h); stage_raw_k(GK, lds + 16384, tid, t0, h); stage_raw_v(p, lds + 32768, tid, t0, h);
        float P[16], blast; chunk_cumsum(p, lds, tid, t0, h, P, blast);
        { const int dk = tid & 127, jq = tid >> 7;
#pragma unroll
          for (int jj = 0; jj < 16; ++jj) { const int j = 16 * jq + jj; const float qv = bf2f(*(const LAS bf16*)(lds + j * 256 + dk * 2)), kv = bf2f(*(const LAS bf16*)(lds + 16384 + j * 256 + dk * 2));
              const int off = j * 256 + (((dk >> 3) ^ (j & 15)) * 16) + (dk & 7) * 2;
              *(LAS bf16*)(lds + L_QT + off) = (bf16)f2bf(qv * __expf(P[jj])); *(LAS bf16*)(lds + L_KT + off) = (bf16)f2bf(kv * __expf(-P[jj])); } }
        fill_vt(lds, lds + 32768, tid);
        __syncthreads();
        { const char* src = (const char*)ST + (size_t)unit * (256 * 128 * 2);
#pragma unroll
          for (int i = 0; i < 8; ++i) { const int piece = 8 * wave + i, row = piece * 4 + (lane >> 4), chunk = (lane & 15) ^ (row & 15);
              __builtin_amdgcn_global_load_lds((const unsigned*)(src + (unsigned)(row * 256 + chunk * 16)), (LAS unsigned*)(lds + L_ST + piece * 1024), 16, 0, 0); } }
        asm volatile("s_waitcnt vmcnt(0)" ::: "memory"); __syncthreads();
        bf16x8 qF[4];
#pragma unroll
        for (int ks = 0; ks < 4; ++ks) qF[ks] = *(const LAS bf16x8*)(lds + L_QT + nt * 4096 + (koff0 ^ (ks * 64)));
        f4 sT[4];
#pragma unroll
        for (int jt = 0; jt < 4; ++jt) { sT[jt] = (f4){0.f, 0.f, 0.f, 0.f};
            if (jt <= nt) {
#pragma unroll
                for (int ks = 0; ks < 4; ++ks) { const bf16x8 a = *(const LAS bf16x8*)(lds + L_KT + jt * 4096 + (koff0 ^ (ks * 64))); sT[jt] = __builtin_amdgcn_mfma_f32_16x16x32_bf16(a, qF[ks], sT[jt], 0, 0, 0); }
                if (jt == nt) {
#pragma unroll
                    for (int rg = 0; rg < 4; ++rg) if (4 * gq + rg > c) sT[jt][rg] = 0.f; } } }
        bf16x8 pb[2];
#pragma unroll
        for (int s = 0; s < 2; ++s) { v4u w; w.x = pg8::cvt_pk_bf16(sT[2 * s][0], sT[2 * s][1]); w.y = pg8::cvt_pk_bf16(sT[2 * s][2], sT[2 * s][3]); w.z = pg8::cvt_pk_bf16(sT[2 * s + 1][0], sT[2 * s + 1][1]); w.w = pg8::cvt_pk_bf16(sT[2 * s + 1][2], sT[2 * s + 1][3]); pb[s] = __builtin_bit_cast(bf16x8, w); }
        f4 o[8]; float ss = 0.f;
#pragma unroll
        for (int mt = 0; mt < 8; ++mt) { o[mt] = (f4){0.f, 0.f, 0.f, 0.f}; const int rb = 128 * half + 16 * mt;
#pragma unroll
            for (int ks = 0; ks < 4; ++ks) { const bf16x8 a = *(const LAS bf16x8*)(lds + L_ST + rb * 256 + (koff0 ^ (ks * 64))); o[mt] = __builtin_amdgcn_mfma_f32_16x16x32_bf16(a, qF[ks], o[mt], 0, 0, 0); }
#pragma unroll
            for (int s = 0; s < 2; ++s) if (2 * s <= nt) { const v2u lo = *(const LAS v2u*)(lds + L_VT + rb * 128 + (voff0 ^ (s * 64))), hi = *(const LAS v2u*)(lds + L_VT + rb * 128 + (voff0 ^ (s * 64 + 32)));
                o[mt] = __builtin_amdgcn_mfma_f32_16x16x32_bf16(__builtin_bit_cast(bf16x8, (v4u){lo.x, lo.y, hi.x, hi.y}), pb[s], o[mt], 0, 0, 0); }
            ss += (o[mt][0] * o[mt][0] + o[mt][1] * o[mt][1]) + (o[mt][2] * o[mt][2] + o[mt][3] * o[mt][3]); }
        ss = nsa::radd32(nsa::radd16(ss));
        LAS float* red = (LAS float*)(lds + L_RED);
        if (gq == 0) red[half * 64 + 16 * nt + c] = ss;
        __syncthreads();
        const float rstd = 1.f / sqrtf((red[16 * nt + c] + red[64 + 16 * nt + c]) * (1.f / 256.f) + RMS_EPS);
        const int tok = t0 + 16 * nt + c;
#pragma unroll
        for (int mt = 0; mt < 8; ++mt) { const int dv = 128 * half + 16 * mt + 4 * gq; const f32x4 g4 = *(const f32x4*)((const char*)gn + (unsigned)(dv * 4));
            const v2u gg = *(const v2u*)((const char*)GG + (unsigned)((tok * 1024 + h * 256 + dv) * 2));
            const float z0 = bflo(gg.x), z1 = bfhi(gg.x), z2 = bflo(gg.y), z3 = bfhi(gg.y);
            v2u w; w.x = pg8::cvt_pk_bf16(o[mt][0] * rstd * g4.x * (z0 / (1.f + __expf(-z0))), o[mt][1] * rstd * g4.y * (z1 / (1.f + __expf(-z1))));
            w.y = pg8::cvt_pk_bf16(o[mt][2] * rstd * g4.z * (z2 / (1.f + __expf(-z2))), o[mt][3] * rstd * g4.w * (z3 / (1.f + __expf(-z3))));
            *(v2u*)((char*)A2 + (unsigned)((tok * DM + h * 256 + dv) * 2)) = w; }
        __syncthreads();
    }
}

constexpr size_t WS_LH = WS_DEC + (size_t)2048 * 128 * 4;
constexpr size_t WS_PEV = WS_LH + (size_t)2 * 4096 * 256 * 4;
static_assert(WS_PEV + 1024 <= WS_KCMP, "cmp scratch overlay");
struct CmpOrder {
    int c; const bf16 *kc, *vc, *wk, *wv;
    __device__ __forceinline__ bool next(int i, pg8::Unit& u) const { if (i > 0 || c >= 32) return false; u.pm = c & 15; u.pn = 0; u.kind = c >> 4; return true; }
    __device__ __forceinline__ const char* pa(const pg8::Gemm&, const pg8::Unit& u) const { return (const char*)(u.kind ? vc : kc) + (size_t)u.pm * ((size_t)256 * 2048 * 2); }
    __device__ __forceinline__ const char* pb(const pg8::Gemm&, const pg8::Unit& u) const { return (const char*)(u.kind ? wv : wk); }
    __device__ __forceinline__ void a_ready(const pg8::Unit&) const {}
    __device__ __forceinline__ void done(const pg8::Unit&) const {}
};
struct EpiLH {
    static constexpr bool PERM = false, AFTER_DRAIN = false;
    float* LH;
    __device__ __forceinline__ void operator()(const pg8::f32x4 (&acc)[2][2][4][2], const pg8::Unit& u, int wr, int wc, int fr, int fq) const {
        const int row0 = u.kind * 4096 + u.pm * 256 + wr * 64 + fr, col0 = wc * 32 + 4 * fq;
#pragma unroll
        for (int ai = 0; ai < 2; ++ai)
#pragma unroll
            for (int m = 0; m < 4; ++m) { float* rowp = LH + (size_t)(row0 + ai * 128 + m * 16) * 256 + col0;
#pragma unroll
                for (int bj = 0; bj < 2; ++bj)
#pragma unroll
                    for (int n = 0; n < 2; ++n) *(pg8::f32x4*)(rowp + bj * 128 + n * 16) = acc[ai][bj][m][n]; }
    }
};
__device__ __forceinline__ void cmp_pevec(const Params& p, LAS unsigned char* lds, int which, int tid) {
    const float* pe = p.in[which ? I_PEV : I_PEK]; const float* w1 = p.in[which ? I_WV1 : I_WK1]; LAS float* part = (LAS float*)lds;
    const int m = tid & 127, q = tid >> 7; float a = 0.f;
    __syncthreads();
    for (int k = q * 1024; k < q * 1024 + 1024; ++k) a += pe[k] * w1[(size_t)k * 128 + m];
    part[q * 128 + m] = a; __syncthreads();
    if (tid < 128) ((float*)(p.ws + WS_PEV))[which * 128 + tid] = (part[tid] + part[128 + tid]) + (part[256 + tid] + part[384 + tid]);
    __syncthreads();
}
__device__ __forceinline__ void cmp_finalize(const Params& p, LAS unsigned char* lds, int which, int bg, int tid_in, int wave) {
    int tid = tid_in; asm volatile("" : "+v"(tid));
    const int lane = tid & 63, c15 = lane & 15, gq = lane >> 4;
    constexpr int L_HID = 0, L_W2T = 65536;
    const float* LH = (const float*)(p.ws + WS_LH) + ((size_t)which * 4096 + bg * 256) * 256; const float* pev = (const float*)(p.ws + WS_PEV) + which * 128; const float* w2 = p.in[which ? I_WV2 : I_WK2];
    asm volatile("s_waitcnt vmcnt(0)" ::: "memory"); __syncthreads();
#pragma unroll
    for (int i = 0; i < 8; ++i) { const int id = tid + 512 * i, c = id >> 4, ch = id & 15; v4u w = (v4u){0u, 0u, 0u, 0u};
        if (c < 255) { const float* lp = LH + (size_t)c * 256 + 8 * ch; const float* hp = LH + (size_t)(c + 1) * 256 + 128 + 8 * ch;
            const f32x4 l0 = *(const f32x4*)lp, l1 = *(const f32x4*)(lp + 4), h0 = *(const f32x4*)hp, h1 = *(const f32x4*)(hp + 4), e0 = *(const f32x4*)(pev + 8 * ch), e1 = *(const f32x4*)(pev + 8 * ch + 4);
            w.x = pk2(gelu_tanh(l0.x + h0.x + e0.x), gelu_tanh(l0.y + h0.y + e0.y)); w.y = pk2(gelu_tanh(l0.z + h0.z + e0.z), gelu_tanh(l0.w + h0.w + e0.w));
            w.z = pk2(gelu_tanh(l1.x + h1.x + e1.x), gelu_tanh(l1.y + h1.y + e1.y)); w.w = pk2(gelu_tanh(l1.z + h1.z + e1.z), gelu_tanh(l1.w + h1.w + e1.w)); }
        *(LAS v4u*)(lds + L_HID + c * 256 + ((ch ^ (c & 15)) * 16)) = w; }
#pragma unroll 8
    for (int i = 0; i < 32; ++i) { const int id = tid + 512 * i, m = id >> 7, n = id & 127;
        *(LAS bf16*)(lds + L_W2T + n * 256 + (((m >> 3) ^ (n & 15)) * 16) + (m & 7) * 2) = (bf16)f2bf(w2[id]); }
    __syncthreads();
    const int koff0 = c15 * 256 + ((gq ^ c15) * 16);
    bf16* KCMP = (bf16*)(p.ws + WS_KCMP) + (size_t)bg * 256 * 128; bf16* VCMPT = (bf16*)(p.ws + WS_VCMPT) + (size_t)bg * 128 * 256;
#pragma unroll
    for (int ci = 0; ci < 2; ++ci) { const int ctile = 2 * wave + ci;
        bf16x8 hF[4];
#pragma unroll
        for (int ks = 0; ks < 4; ++ks) hF[ks] = *(const LAS bf16x8*)(lds + L_HID + ctile * 4096 + (koff0 ^ (ks * 64)));
#pragma unroll
        for (int ntile = 0; ntile < 8; ++ntile) { pg8::f32x4 d = (pg8::f32x4){0.f, 0.f, 0.f, 0.f};
#pragma unroll
            for (int ks = 0; ks < 4; ++ks) { const bf16x8 wF = *(const LAS bf16x8*)(lds + L_W2T + ntile * 4096 + (koff0 ^ (ks * 64)));
                d = which ? __builtin_amdgcn_mfma_f32_16x16x32_bf16(hF[ks], wF, d, 0, 0, 0) : __builtin_amdgcn_mfma_f32_16x16x32_bf16(wF, hF[ks], d, 0, 0, 0); }
            const v2u w = (v2u){pg8::cvt_pk_bf16(d[0], d[1]), pg8::cvt_pk_bf16(d[2], d[3])};
            if (which) *(v2u*)(VCMPT + (size_t)(16 * ntile + c15) * 256 + 16 * ctile + 4 * gq) = w;
            else *(v2u*)(KCMP + (size_t)(16 * ctile + c15) * 128 + 16 * ntile + 4 * gq) = w; } }
    __syncthreads();
}

constexpr size_t PROWS = (size_t)MAXTILES * 256;
constexpr size_t WS_W1Q = WS_W1T;
constexpr size_t WS_W2Q = WS_W1Q + (size_t)NE * 4096 * DM;
constexpr size_t WS_HN8 = WS_W2Q + (size_t)NE * DM * DFF;
constexpr size_t WS_AMAXP = WS_HN8 + (size_t)T * DM;
constexpr size_t WS_WSC1 = WS_AMAXP + PROWS * 64 * 4;
constexpr size_t WS_WSC2 = WS_WSC1 + (size_t)NE * 4096 * 4;
constexpr size_t WS_HSC = WS_WSC2 + (size_t)NE * 2048 * 4;
constexpr size_t WS_ROWSC = WS_HSC + (size_t)T * 4;
constexpr size_t WS_ASC = WS_ROWSC + PROWS * 4;
static_assert(WS_ASC + PROWS * 4 <= WS_XN, "int8 buffers fit in the retired bf16 expert-weight region");
constexpr size_t WS_XG8 = WS_XG;
constexpr size_t WS_ACT8 = WS_XG + PROWS * DM;
constexpr size_t WS_Y = WS_ACT;
static_assert(WS_ACT8 + PROWS * DM <= WS_ACT, "int8 row buffers fit in the retired gathered-row region");

__device__ __forceinline__ unsigned q8(float v) { int q = (int)rintf(v); q = q > 127 ? 127 : (q < -127 ? -127 : q); return (unsigned)q & 0xffu; }
__device__ __forceinline__ unsigned q8x4(float a, float b, float c, float d) { return q8(a) | (q8(b) << 8) | (q8(c) << 16) | (q8(d) << 24); }

constexpr size_t WS_WINQ = WS_WINT;
constexpr size_t WS_WISC = WS_WINT + (size_t)NPT * 256 * DM;
constexpr size_t WS_XN8 = WS_XN;
constexpr size_t WS_XSC = WS_XN + (size_t)T * DM;
constexpr size_t WS_PMAX = WS_HN;
constexpr size_t WS_PMAXI = WS_PMAX + (size_t)64 * 8 * 4096 * 4;
__device__ __forceinline__ void p0_absmax(const Params& p, int bid, int G, int tid) {
    float* PMAX = (float*)(p.ws + WS_PMAX);
    for (int it = bid; it < 8; it += G) {
        const float* src = p.in[I_WIN] + (size_t)it * 256 * 5672; float* dst = (float*)(p.ws + WS_PMAXI) + (size_t)it * 5696;
#pragma unroll
        for (int q = 0; q < 3; ++q) { const int c4 = tid + 512 * q; if (c4 < 1418) { f32x4 m0 = (f32x4){0.f, 0.f, 0.f, 0.f};
#pragma unroll 8
            for (int r = 0; r < 256; ++r) { const f32x4 a = *(const f32x4*)(src + (size_t)r * 5672 + c4 * 4); m0.x = fmaxf(m0.x, fabsf(a.x)); m0.y = fmaxf(m0.y, fabsf(a.y)); m0.z = fmaxf(m0.z, fabsf(a.z)); m0.w = fmaxf(m0.w, fabsf(a.w)); }
            *(f32x4*)(dst + c4 * 4) = m0; } } }
}
__device__ __forceinline__ void p0_quant(const Params& p, LAS unsigned char* lds, int gw, int NGW, int wave, int lane) {
    LAS float* scr = (LAS float*)(lds + wave * 16896);
    const float* PMAX = (const float*)(p.ws + WS_PMAX);
    signed char* W1Q = (signed char*)(p.ws + WS_W1Q); signed char* W2Q = (signed char*)(p.ws + WS_W2Q); float* WSC1 = (float*)(p.ws + WS_WSC1); float* WSC2 = (float*)(p.ws + WS_WSC2);
    for (int it = gw; it < 16 * 178; it += NGW) {
        const int kb = it / 178, nb = it % 178, n0 = nb * 32, k0 = kb * 128; const int nl = n0 + (lane & 31); const bool okc = nl < 5672;
        const float* W = p.in[I_WIN] + (size_t)k0 * 5672 + (okc ? nl : 0) + (size_t)(lane >> 5) * 5672;
        float w[64];
#pragma unroll
        for (int i = 0; i < 64; ++i) w[i] = W[(size_t)(2 * i) * 5672];
        float mx = 0.f;
#pragma unroll
        for (int q = 0; q < 8; ++q) mx = fmaxf(mx, ((const float*)(p.ws + WS_PMAXI))[(size_t)q * 5696 + (okc ? nl : 0)]);
        const float sc = mx > 0.f ? mx * (1.f / 127.f) : 1.f, ivl = 1.f / sc; float qsc; const int rowl = okc ? win_row(nl, qsc) : -1;
        if (kb == 0 && lane < 32 && okc) ((float*)(p.ws + WS_WISC))[rowl] = sc * qsc;
#pragma unroll
        for (int i = 0; i < 64; ++i) scr[(2 * i + (lane >> 5)) * 33 + (lane & 31)] = w[i];
        LDS_WAIT(); asm volatile("" ::: "memory");
        const int c = lane & 7;
#pragma unroll
        for (int j = 0; j < 4; ++j) { const int nn = (lane >> 3) + 8 * j; const float iv = __shfl(ivl, nn); const int rown = __shfl(rowl, nn); const LAS float* s = scr + (16 * c) * 33 + nn; v4u o;
            o.x = q8x4(s[0] * iv, s[33] * iv, s[66] * iv, s[99] * iv); o.y = q8x4(s[132] * iv, s[165] * iv, s[198] * iv, s[231] * iv);
            o.z = q8x4(s[264] * iv, s[297] * iv, s[330] * iv, s[363] * iv); o.w = q8x4(s[396] * iv, s[429] * iv, s[462] * iv, s[495] * iv);
            if (rown >= 0) *(v4u*)((signed char*)(p.ws + WS_WINQ) + (size_t)rown * 2048 + k0 + 16 * c) = o; }
        LDS_WAIT(); asm volatile("" ::: "memory"); }
}

constexpr int NSLAB_E = NE * 192, NSLAB = NSLAB_E + 178;
struct SlabSrc { const float* W; int N; bool ok; };
__device__ __forceinline__ SlabSrc slab_src(const Params& p, int sl, int r0, int n4) {
    SlabSrc s;
    if (sl < NSLAB_E) { const int e = sl / 192, r = sl % 192; const bool isw2 = r >= 128; const int nb = isw2 ? r - 128 : r; s.N = isw2 ? 2048 : 4096;
        s.W = (isw2 ? p.in[I_W2] + (size_t)e * DFF * DM : p.in[I_W1] + (size_t)e * DM * 4096) + (size_t)r0 * s.N + nb * 32 + 4 * n4; s.ok = true; }
    else { const int nb = sl - NSLAB_E; s.N = 5672; s.ok = nb * 32 + 4 * n4 < 5672; s.W = p.in[I_WIN] + (size_t)r0 * 5672 + (s.ok ? nb * 32 + 4 * n4 : 0); }
    return s;
}
__device__ __forceinline__ void p0_slab_quant(const Params& p, LAS unsigned char* lds, int bid, int G, int tid) {
    constexpr int RS = 4104;
    LAS unsigned char* TT = lds; LAS float* part = (LAS float*)(lds + 32 * RS); LAS float* inv = part + 64 * 32; LAS int* drow = (LAS int*)(inv + 32);
    signed char* W1Q = (signed char*)(p.ws + WS_W1Q); signed char* W2Q = (signed char*)(p.ws + WS_W2Q); signed char* WIQ = (signed char*)(p.ws + WS_WINQ);
    float* WSC1 = (float*)(p.ws + WS_WSC1); float* WSC2 = (float*)(p.ws + WS_WSC2); float* WISC = (float*)(p.ws + WS_WISC);
    const int n4 = tid & 7, r0 = tid >> 3;
    f32x4 va[8], vb[8];
#define SLAB_ISSUE(dst, sl, j) do { if ((sl) < NSLAB) { const SlabSrc ss_ = slab_src(p, (sl), r0, n4); _Pragma("unroll") for (int u = 0; u < 8; ++u) dst[u] = __builtin_nontemporal_load((const f32x4*)(ss_.W + (size_t)(64 * (8 * (j) + u)) * ss_.N)); } } while (0)
#define SLAB_USE(src, j) do { _Pragma("unroll") for (int u = 0; u < 8; ++u) { const f32x4 x = sc_.ok ? src[u] : (f32x4){0.f, 0.f, 0.f, 0.f}; const int k = r0 + 64 * (8 * (j) + u); \
            mx.x = fmaxf(mx.x, fabsf(x.x)); mx.y = fmaxf(mx.y, fabsf(x.y)); mx.z = fmaxf(mx.z, fabsf(x.z)); mx.w = fmaxf(mx.w, fabsf(x.w)); \
            LAS unsigned char* d = TT + (4 * n4) * RS + k * 2; \
            *(LAS bf16*)d = (bf16)f2bf(x.x); *(LAS bf16*)(d + RS) = (bf16)f2bf(x.y); *(LAS bf16*)(d + 2 * RS) = (bf16)f2bf(x.z); *(LAS bf16*)(d + 3 * RS) = (bf16)f2bf(x.w); } } while (0)
    SLAB_ISSUE(va, bid, 0); SLAB_ISSUE(vb, bid, 1);
    for (int slab = bid; slab < NSLAB; slab += G) {
        const SlabSrc sc_ = slab_src(p, slab, r0, n4);
        f32x4 mx = (f32x4){0.f, 0.f, 0.f, 0.f};
        SLAB_USE(va, 0); SLAB_ISSUE(va, slab, 2);
        SLAB_USE(vb, 1); SLAB_ISSUE(vb, slab, 3);
        SLAB_USE(va, 2); SLAB_ISSUE(va, slab + G, 0);
        SLAB_USE(vb, 3); SLAB_ISSUE(vb, slab + G, 1);
        { f32x4 t = mx;
#pragma unroll
          for (int o = 8; o < 64; o <<= 1) { t.x = fmaxf(t.x, __shfl_xor(t.x, o)); t.y = fmaxf(t.y, __shfl_xor(t.y, o)); t.z = fmaxf(t.z, __shfl_xor(t.z, o)); t.w = fmaxf(t.w, __shfl_xor(t.w, o)); }
          if ((tid & 63) < 8) *(LAS f32x4*)(part + (tid >> 6) * 32 + 4 * n4) = t; }
        __syncthreads();
        if (tid < 32) { float m = 0.f;
#pragma unroll
            for (int q = 0; q < 8; ++q) m = fmaxf(m, part[q * 32 + tid]);
            const float sc = m > 0.f ? m * (1.f / 127.f) : 1.f; inv[tid] = 1.f / sc;
            if (slab < NSLAB_E) { const int e = slab / 192, r = slab % 192; const bool isw2 = r >= 128; const int n = (isw2 ? r - 128 : r) * 32 + tid;
                if (isw2) { drow[tid] = e * 2048 + n; WSC2[e * 2048 + n] = sc; }
                else { const int j2 = n & 2047, row = (j2 >> 7) * 256 + (n >= 2048 ? 128 : 0) + (j2 & 127); drow[tid] = e * 4096 + row; WSC1[e * 4096 + row] = sc; } }
            else { const int n = (slab - NSLAB_E) * 32 + tid; if (n < 5672) { float qsc; const int row = win_row(n, qsc); drow[tid] = row; WISC[row] = sc * qsc; } else drow[tid] = -1; } }
        __syncthreads();
        { const int kc = tid & 7, n = (tid >> 3) & 31, hf = tid >> 8; const float iv = inv[n]; const int dr = drow[n];
          signed char* dst = (slab < NSLAB_E ? ((slab % 192) >= 128 ? W2Q : W1Q) : WIQ) + (size_t)(dr < 0 ? 0 : dr) * 2048; const LAS unsigned char* src = TT + n * RS;
          if (dr >= 0) {
#pragma unroll
          for (int m8 = 0; m8 < 8; ++m8) { const int k0 = 16 * (kc + 8 * (hf + 2 * m8)); const LAS v2u* sp = (const LAS v2u*)(src + k0 * 2); const v2u a = sp[0], b = sp[1], c = sp[2], d = sp[3]; v4u o;
              o.x = q8x4(bflo(a.x) * iv, bfhi(a.x) * iv, bflo(a.y) * iv, bfhi(a.y) * iv); o.y = q8x4(bflo(b.x) * iv, bfhi(b.x) * iv, bflo(b.y) * iv, bfhi(b.y) * iv);
              o.z = q8x4(bflo(c.x) * iv, bfhi(c.x) * iv, bflo(c.y) * iv, bfhi(c.y) * iv); o.w = q8x4(bflo(d.x) * iv, bfhi(d.x) * iv, bflo(d.y) * iv, bfhi(d.y) * iv);
              *(v4u*)(dst + k0) = o; } } }
        __syncthreads();
    }
#undef SLAB_ISSUE
#undef SLAB_USE
}
struct EpiSwigluI8 {
    static constexpr bool PERM = true, AFTER_DRAIN = false;
    const float* b1; const float* rowsc; const float* wsc1; bf16* act; float* amaxp;
    __device__ __forceinline__ void operator()(const pg8::f32x4 (&acc)[2][2][4][2], const pg8::Unit& u, int wr, int wc, int fr, int fq) const {
        const int e = u.kind; const int cin = wc * 32 + 8 * fq; const int col = u.pn * 128 + cin; const int row0 = u.pm * 256 + wr * 64 + fr;
        const float* bg = b1 + (size_t)e * 4096 + col; const float* bl = bg + 2048; const float* sg = wsc1 + (size_t)e * 4096 + u.pn * 256 + cin; const float* sl = sg + 128;
        float gb[8], lb[8], gs[8], ls[8];
#pragma unroll
        for (int j = 0; j < 8; ++j) { gb[j] = bg[j]; lb[j] = bl[j]; gs[j] = sg[j]; ls[j] = sl[j]; }
#pragma unroll
        for (int ai = 0; ai < 2; ++ai)
#pragma unroll
            for (int m = 0; m < 4; ++m) { const int r = row0 + ai * 128 + m * 16; const float rs = rowsc[r]; float o[8]; float mx = 0.f;
#pragma unroll
                for (int n = 0; n < 2; ++n)
#pragma unroll
                    for (int j = 0; j < 4; ++j) { float gl = (float)__float_as_int(acc[ai][0][m][n][j]) * (rs * gs[n * 4 + j]) + gb[n * 4 + j]; float li = (float)__float_as_int(acc[ai][1][m][n][j]) * (rs * ls[n * 4 + j]) + lb[n * 4 + j];
                        gl = fminf(gl, 7.f); li = fminf(fmaxf(li, -7.f), 7.f);
                        const float v = gl * __builtin_amdgcn_rcpf(1.f + __builtin_amdgcn_exp2f(-2.4554669595930156f * gl)) * (li + 1.f); o[n * 4 + j] = v; mx = fmaxf(mx, fabsf(v)); }
                mx = nsa::rmax32(nsa::rmax16(mx));
                if (fq == 0) amaxp[(size_t)r * 64 + u.pn * 4 + wc] = mx;
                pg8::u32x4 w; w.x = pg8::cvt_pk_bf16(o[0], o[1]); w.y = pg8::cvt_pk_bf16(o[2], o[3]); w.z = pg8::cvt_pk_bf16(o[4], o[5]); w.w = pg8::cvt_pk_bf16(o[6], o[7]);
                *(pg8::u32x4*)(act + (size_t)r * DFF + col) = w; }
    }
};
__device__ __forceinline__ void ph_actq(const Params& p, int gw, int NGW, int lane) {
    const int nrows = ((const int*)(p.ws + WS_META))[0] * 256; const float* amaxp = (const float*)(p.ws + WS_AMAXP); const bf16* act = (const bf16*)(p.ws + WS_ACT);
    signed char* A8 = (signed char*)(p.ws + WS_ACT8); float* ASC = (float*)(p.ws + WS_ASC);
    for (int r = gw; r < nrows; r += NGW) { const float mx = wave_max(amaxp[(size_t)r * 64 + lane]); const float sc = mx > 0.f ? mx * (1.f / 127.f) : 1.f, iv = 1.f / sc;
        const v4u* src = (const v4u*)(act + (size_t)r * DFF) + lane * 4; v4u a[4];
#pragma unroll
        for (int j = 0; j < 4; ++j) a[j] = src[j];
        v4u o[2];
#pragma unroll
        for (int h = 0; h < 2; ++h) { const v4u x = a[2 * h], y = a[2 * h + 1];
            o[h].x = q8x4(bflo(x.x) * iv, bfhi(x.x) * iv, bflo(x.y) * iv, bfhi(x.y) * iv); o[h].y = q8x4(bflo(x.z) * iv, bfhi(x.z) * iv, bflo(x.w) * iv, bfhi(x.w) * iv);
            o[h].z = q8x4(bflo(y.x) * iv, bfhi(y.x) * iv, bflo(y.y) * iv, bfhi(y.y) * iv); o[h].w = q8x4(bflo(y.z) * iv, bfhi(y.z) * iv, bflo(y.w) * iv, bfhi(y.w) * iv); }
        v4u* dst = (v4u*)(A8 + (size_t)r * DFF) + lane * 2; dst[0] = o[0]; dst[1] = o[1];
        if (lane == 0) ASC[r] = sc; }
}
struct EpiDownI8 {
    static constexpr bool PERM = true, AFTER_DRAIN = false;
    const float* b2; const float* roww; const float* asc; const float* wsc2; bf16* y;
    __device__ __forceinline__ void operator()(const pg8::f32x4 (&acc)[2][2][4][2], const pg8::Unit& u, int wr, int wc, int fr, int fq) const {
        const int e = u.kind; const int col0 = u.pn * 256 + wc * 32 + 8 * fq; const int row0 = u.pm * 256 + wr * 64 + fr;
        float bv[2][8], sv[2][8];
#pragma unroll
        for (int bj = 0; bj < 2; ++bj)
#pragma unroll
            for (int j = 0; j < 8; ++j) { bv[bj][j] = b2[(size_t)e * DM + col0 + bj * 128 + j]; sv[bj][j] = wsc2[(size_t)e * DM + col0 + bj * 128 + j]; }
#pragma unroll
        for (int ai = 0; ai < 2; ++ai)
#pragma unroll
            for (int m = 0; m < 4; ++m) { const int r = row0 + ai * 128 + m * 16; const float g = roww[r], as = asc[r];
#pragma unroll
                for (int bj = 0; bj < 2; ++bj) { float o[8];
#pragma unroll
                    for (int n = 0; n < 2; ++n)
#pragma unroll
                        for (int j = 0; j < 4; ++j) o[n * 4 + j] = ((float)__float_as_int(acc[ai][bj][m][n][j]) * (as * sv[bj][n * 4 + j]) + bv[bj][n * 4 + j]) * g;
                    pg8::u32x4 w; w.x = pg8::cvt_pk_bf16(o[0], o[1]); w.y = pg8::cvt_pk_bf16(o[2], o[3]); w.z = pg8::cvt_pk_bf16(o[4], o[5]); w.w = pg8::cvt_pk_bf16(o[6], o[7]);
                    *(pg8::u32x4*)(y + (size_t)r * DM + col0 + bj * 128) = w; } }
    }
};

struct EpiProjI8 {
    static constexpr bool PERM = true, AFTER_DRAIN = false;
    unsigned char* ws;
    __device__ __forceinline__ void operator()(const pg8::f32x4 (&acc)[2][2][4][2], const pg8::Unit& u, int wr, int wc, int fr, int fq) const {
        const int cw = wc * 32 + 8 * fq; const float* XSC = (const float*)(ws + WS_XSC); const float* WISC = (const float*)(ws + WS_WISC);
        if (u.kind == 0) {
            const int tn = u.pn; bf16* base; size_t bjs = 128; int ld = 0; bool headmajor = false; bool small = false;
            if (tn < 2) { base = (bf16*)(ws + WS_GQ) + tn * 256; ld = 512; }
            else if (tn < 4) { base = (bf16*)(ws + WS_GK) + (tn - 2) * 256; ld = 512; }
            else if (tn < 8) { base = (bf16*)(ws + WS_GV) + (tn - 4) * 256; ld = 1024; }
            else if (tn < 12) { base = (bf16*)(ws + WS_GG) + (tn - 8) * 256; ld = 1024; }
            else if (tn < 16) { base = (bf16*)(ws + WS_NQ) + (tn - 12) * 256; ld = 1024; }
            else if (tn < 20) { base = (bf16*)(ws + (tn == 16 ? WS_KC : tn == 17 ? WS_VC : tn == 18 ? WS_KS : WS_KW)); headmajor = true; bjs = (size_t)SEQ * 128; }
            else { base = (bf16*)(ws + WS_SM); ld = 64; small = true; }
            if (small && wc >= 2) return;
            float cs[2][8];
#pragma unroll
            for (int bj = 0; bj < 2; ++bj)
#pragma unroll
                for (int j = 0; j < 8; ++j) cs[bj][j] = WISC[tn * 256 + bj * 128 + cw + j];
#pragma unroll
            for (int ai = 0; ai < 2; ++ai)
#pragma unroll
                for (int m = 0; m < 4; ++m) { const int r = u.pm * 256 + ai * 128 + wr * 64 + m * 16 + fr; const float rs = XSC[r];
                    const size_t rterm = headmajor ? ((size_t)(r >> 12) * 2 * SEQ + (r & (SEQ - 1))) * 128 : (size_t)r * ld;
#pragma unroll
                    for (int bj = 0; bj < 2; ++bj) { if (small && bj) continue; float o[8];
#pragma unroll
                        for (int n = 0; n < 2; ++n)
#pragma unroll
                            for (int j = 0; j < 4; ++j) o[n * 4 + j] = (float)__float_as_int(acc[ai][bj][m][n][j]) * (rs * cs[bj][n * 4 + j]);
                        pg8::u32x4 w; w.x = pg8::cvt_pk_bf16(o[0], o[1]); w.y = pg8::cvt_pk_bf16(o[2], o[3]); w.z = pg8::cvt_pk_bf16(o[4], o[5]); w.w = pg8::cvt_pk_bf16(o[6], o[7]);
                        *(pg8::u32x4*)(base + rterm + bj * bjs + cw) = w; } }
        } else {
            bf16* base = (bf16*)(ws + (u.pn == 21 ? WS_VST : WS_VWT));
#pragma unroll
            for (int ai = 0; ai < 2; ++ai)
#pragma unroll
                for (int m = 0; m < 4; ++m) { const int dh = wr * 64 + m * 16 + fr; const float ws_ = WISC[u.pn * 256 + ai * 128 + dh];
#pragma unroll
                    for (int bj = 0; bj < 2; ++bj) { const int tok = u.pm * 256 + bj * 128 + cw; const int b = tok >> 12, s = tok & (SEQ - 1); float o[8];
                        const pg8::f32x4 x0 = *(const pg8::f32x4*)(XSC + tok), x1 = *(const pg8::f32x4*)(XSC + tok + 4);
#pragma unroll
                        for (int j = 0; j < 4; ++j) { o[j] = (float)__float_as_int(acc[ai][bj][m][0][j]) * (ws_ * x0[j]); o[4 + j] = (float)__float_as_int(acc[ai][bj][m][1][j]) * (ws_ * x1[j]); }
                        pg8::u32x4 w; w.x = pg8::cvt_pk_bf16(o[0], o[1]); w.y = pg8::cvt_pk_bf16(o[2], o[3]); w.z = pg8::cvt_pk_bf16(o[4], o[5]); w.w = pg8::cvt_pk_bf16(o[6], o[7]);
                        *(pg8::u32x4*)(base + ((size_t)(b * 2 + ai) * 128 + dh) * SEQ + s) = w; } }
        }
    }
};

__device__ __forceinline__ void r1_router(const Params& p, LAS unsigned char* lds, int vb, int tid, int wave, int lane) {
    LAS float* rowbuf = (LAS float*)lds;
    LAS float* part = (LAS float*)(lds + 65536);
    LAS int* tk = (LAS int*)(lds + 81920 + wave * 1024);
    LAS int* cntw = (LAS int*)(lds + 90112);
    const float* h = p.out; const float* gf = p.in[I_NFFN]; const float* rw = p.in[I_RW]; const float* rb = p.in[I_RB];
    signed char* HN8 = (signed char*)(p.ws + WS_HN8);
    const int e = lane & 31, eg = tid & 31, dg = tid >> 5; int mycount = 0;
    float rwr[128];
#pragma unroll
    for (int c4 = 0; c4 < 4; ++c4) { unsigned o = (unsigned)((((dg * 128 + c4 * 32) * 32) + eg) * 4); asm volatile("" : "+v"(o));
#pragma unroll
        for (int i = 0; i < 32; ++i) rwr[c4 * 32 + i] = *(const float*)((const char*)rw + o + i * 128); }
    for (int grp = 0; grp < 16; ++grp) { const int t = vb * TPV + grp * 8 + wave;
        { const f32x4* xr = (const f32x4*)(h + (size_t)t * DM) + lane; f32x4 v[8]; float s = 0.f;
#pragma unroll
          for (int j = 0; j < 8; ++j) { v[j] = xr[64 * j]; s += (v[j].x * v[j].x + v[j].y * v[j].y) + (v[j].z * v[j].z + v[j].w * v[j].w); }
          const float rstd = 1.f / sqrtf(wave_sum(s) * (1.f / DM) + RMS_EPS);
          float mxr = 0.f; LAS f32x4* hrow = (LAS f32x4*)(rowbuf + wave * 2048);
#pragma unroll
          for (int j = 0; j < 8; ++j) { const f32x4 g4 = ((const f32x4*)gf)[lane + 64 * j]; f32x4 y; y.x = v[j].x * rstd * g4.x; y.y = v[j].y * rstd * g4.y; y.z = v[j].z * rstd * g4.z; y.w = v[j].w * rstd * g4.w;
              v[j] = y; hrow[lane + 64 * j] = y; mxr = fmaxf(mxr, fmaxf(fmaxf(fabsf(y.x), fabsf(y.y)), fmaxf(fabsf(y.z), fabsf(y.w)))); }
          mxr = wave_max(mxr); const float qs = mxr > 0.f ? mxr * (1.f / 127.f) : 1.f, qi = 1.f / qs;
          unsigned* o4 = (unsigned*)(HN8 + (size_t)t * DM) + lane;
#pragma unroll
          for (int j = 0; j < 8; ++j) o4[64 * j] = q8x4(v[j].x * qi, v[j].y * qi, v[j].z * qi, v[j].w * qi);
          if (lane == 0) ((float*)(p.ws + WS_HSC))[t] = qs; }
        __syncthreads();
        { float acc[8];
#pragma unroll
          for (int tt = 0; tt < 8; ++tt) acc[tt] = 0.f;
#pragma unroll
          for (int i4 = 0; i4 < 32; ++i4) { f32x4 xv[8];
#pragma unroll
              for (int tt = 0; tt < 8; ++tt) xv[tt] = *(const LAS f32x4*)(rowbuf + tt * 2048 + dg * 128 + 4 * i4);
#pragma unroll
              for (int tt = 0; tt < 8; ++tt) acc[tt] += xv[tt].x * rwr[4 * i4] + xv[tt].y * rwr[4 * i4 + 1] + xv[tt].z * rwr[4 * i4 + 2] + xv[tt].w * rwr[4 * i4 + 3];
              if (i4 & 1) asm volatile("" ::: "memory"); }
#pragma unroll
          for (int tt = 0; tt < 8; ++tt) part[(dg * 8 + tt) * 32 + eg] = acc[tt]; }
        __syncthreads();
        { float a = rb[e];
#pragma unroll
          for (int q = 0; q < 16; ++q) a += part[(q * 8 + wave) * 32 + e];
          int rank = 0;
#pragma unroll
          for (int mm = 0; mm < 32; ++mm) { const float lm = __shfl(a, mm); rank += (lm > a || (lm == a && mm < e)) ? 1 : 0; }
          const float mx = wave_max(a); const bool sel = rank < 4;
          const float ex = (sel && lane < 32) ? __expf(a - mx) : 0.f; const float sum = wave_sum(ex);
          if (sel && lane < 32) { LAS int* q = tk + (grp * 4 + rank) * 4; q[0] = e; q[1] = mycount; q[2] = __builtin_bit_cast(int, ex / sum); ++mycount; } }
        __syncthreads();
    }
    if (lane < 32) cntw[wave * 32 + lane] = mycount;
    __syncthreads();
    if (wave == 0 && lane < 32) { int tot = 0; for (int w = 0; w < 8; ++w) tot += cntw[w * 32 + lane]; ((int*)(p.ws + WS_CNT))[vb * 32 + lane] = tot; }
    { const int i = lane >> 2, k = lane & 3; const LAS int* q = tk + (i * 4 + k) * 4; const int ee = q[0]; int base = 0; for (int w = 0; w < wave; ++w) base += cntw[w * 32 + ee];
      const int t = vb * TPV + i * 8 + wave;
      ((int*)(p.ws + WS_EIDX))[t * 4 + k] = ee; ((int*)(p.ws + WS_LRNK))[t * 4 + k] = base + q[1]; ((int*)(p.ws + WS_GATE))[t * 4 + k] = q[2]; }
    __syncthreads();
}
__device__ __forceinline__ void r2_gather(const Params& p, LAS unsigned char* lds, int vb, bool write_meta, int tid, int wave, int lane) {
    LAS int* part_tot = (LAS int*)lds;
    LAS int* part_base = part_tot + 512;
    LAS int* pbase = part_base + 512;
    const int* CNT = (const int*)(p.ws + WS_CNT);
    { const int e = tid & 31, part = tid >> 5; int tot = 0, bs = 0;
      for (int v = part * 16; v < part * 16 + 16; ++v) { const int c = CNT[v * 32 + e]; tot += c; if (v < vb) bs += c; }
      part_tot[part * 32 + e] = tot; part_base[part * 32 + e] = bs; }
    __syncthreads();
    if (tid == 0) { int ps = 0; int* meta = (int*)(p.ws + WS_META); int nt = 0;
        for (int e = 0; e < 32; ++e) { int tot = 0, bs = 0; for (int q = 0; q < 16; ++q) { tot += part_tot[q * 32 + e]; bs += part_base[q * 32 + e]; }
            pbase[e] = ps + bs; const int ntile = (tot + 255) >> 8;
            if (write_meta) for (int q = 0; q < ntile; ++q) meta[64 + nt + q] = e;
            nt += ntile; ps += ntile * 256; }
        if (write_meta) meta[0] = nt; }
    __syncthreads();
    const signed char* HN8 = (const signed char*)(p.ws + WS_HN8); signed char* XG8 = (signed char*)(p.ws + WS_XG8); const float* HSC = (const float*)(p.ws + WS_HSC); float* ROWSC = (float*)(p.ws + WS_ROWSC);
    const int* EIDX = (const int*)(p.ws + WS_EIDX); const int* LRNK = (const int*)(p.ws + WS_LRNK); const float* GATE = (const float*)(p.ws + WS_GATE);
    int* POS = (int*)(p.ws + WS_POS); float* ROWW = (float*)(p.ws + WS_ROWW);
    for (int i0 = 0; i0 < 16; i0 += 4) {
        v4u v0[4], v1[4]; float hs[4]; int ee[4][4], lr[4][4]; float gt[4][4];
#pragma unroll
        for (int u = 0; u < 4; ++u) { const int t = vb * TPV + (i0 + u) * 8 + wave; const v4u* src = (const v4u*)(HN8 + (size_t)t * DM) + lane; v0[u] = src[0]; v1[u] = src[64]; hs[u] = HSC[t];
#pragma unroll
            for (int k = 0; k < 4; ++k) { ee[u][k] = EIDX[t * 4 + k]; lr[u][k] = LRNK[t * 4 + k]; gt[u][k] = GATE[t * 4 + k]; } }
#pragma unroll
        for (int u = 0; u < 4; ++u) { const int t = vb * TPV + (i0 + u) * 8 + wave;
#pragma unroll
            for (int k = 0; k < 4; ++k) { const int pos = pbase[ee[u][k]] + lr[u][k];
                if (lane == 0) { POS[t * 4 + k] = pos; ROWW[pos] = gt[u][k]; ROWSC[pos] = hs[u]; }
                v4u* dst = (v4u*)(XG8 + (size_t)pos * DM) + lane; dst[0] = v0[u]; dst[64] = v1[u]; } } }
    __syncthreads();
}
__device__ __forceinline__ void pf_final(const Params& p, int gw, int NGW, int lane) {
    const bf16* Y = (const bf16*)(p.ws + WS_Y); const int* POS = (const int*)(p.ws + WS_POS); const float* gfin = p.in[I_NFIN];
    for (int t = gw; t < T; t += NGW) {
        f32x4* xr = (f32x4*)(p.out + (size_t)t * DM) + lane; f32x4 v[8];
#pragma unroll
        for (int j = 0; j < 8; ++j) v[j] = xr[64 * j];
#pragma unroll
        for (int k = 0; k < 4; ++k) { const int pos = POS[t * 4 + k]; const v2u* yr = (const v2u*)(Y + (size_t)pos * DM) + lane;
#pragma unroll
            for (int j = 0; j < 8; ++j) { const v2u w = yr[64 * j]; v[j].x += bflo(w.x); v[j].y += bfhi(w.x); v[j].z += bflo(w.y); v[j].w += bfhi(w.y); } }
        float s = 0.f;
#pragma unroll
        for (int j = 0; j < 8; ++j) s += (v[j].x * v[j].x + v[j].y * v[j].y) + (v[j].z * v[j].z + v[j].w * v[j].w);
        const float rstd = 1.f / sqrtf(wave_sum(s) * (1.f / DM) + RMS_EPS);
#pragma unroll
        for (int j = 0; j < 8; ++j) { const f32x4 g4 = ((const f32x4*)gfin)[lane + 64 * j]; f32x4 o; o.x = v[j].x * rstd * g4.x; o.y = v[j].y * rstd * g4.y; o.z = v[j].z * rstd * g4.z; o.w = v[j].w * rstd * g4.w; xr[64 * j] = o; }
    }
}


constexpr int LDS_BYTES = 159744;
constexpr int MISC_OFF = LDS_BYTES - 256;  static_assert(nsa::LDS_END <= MISC_OFF && gla::L_END <= MISC_OFF, "LDS map");
constexpr int CW_BAR = 4096, CW_XL = 16384;
__global__ __launch_bounds__(512, 2) void mega_fwd(Params p) {
    extern __shared__ __attribute__((aligned(16))) unsigned char lds_raw[];
    LAS unsigned char* lds = (LAS unsigned char*)lds_raw;
    const int G = gridDim.x, bid = blockIdx.x, NGW = G * 8;
#define PH_IDS int tid = threadIdx.x; asm volatile("" : "+v"(tid)); const int lane = tid & 63, wave = __builtin_amdgcn_readfirstlane(tid >> 6), gw = bid * 8 + wave; (void)lane; (void)gw;
    for (int u = threadIdx.x; u < 64; u += 512) ((LAS unsigned*)(lds + MISC_OFF))[u] = 0u;
    __syncthreads();
    XcdBarrier bar = xcd_barrier_post((unsigned*)(p.ws + WS_CTL) + CW_BAR, (volatile LAS unsigned*)(lds + MISC_OFF) + 8);
    { PH_IDS; p0_prologue(p, lds, gw, NGW, wave, lane); __syncthreads(); p0_slab_quant(p, lds, bid, G, tid); }
    xcd_barrier(bar);
    { pg8::Gemm g{(const bf16*)(p.ws + WS_XN8), (const bf16*)(p.ws + WS_WINQ), T, NPT * 256, DM / 2};
      ProjOrder S; S.init(T, NPT * 256, G, bid); S.xn = g.A; S.wt = g.Bt; EpiProjI8 E{p.ws};
      pg8::gemm_phase<EpiProjI8, ProjOrder, true, true, true>(lds, g, S, E); }
    xcd_barrier(bar);
    if (bid < 32) {
        pg8::Gemm g{(const bf16*)(p.ws + WS_KC), (const bf16*)(p.ws + WS_WKCT), 4096, 256, 2048};
        CmpOrder S{bid, (const bf16*)(p.ws + WS_KC), (const bf16*)(p.ws + WS_VC), (const bf16*)(p.ws + WS_WKCT), (const bf16*)(p.ws + WS_WVCT)}; EpiLH E{(float*)(p.ws + WS_LH)};
        pg8::gemm_phase<EpiLH, CmpOrder, true, true>(lds, g, S, E);
    } else { PH_IDS; ph_gla_a(p, lds, bid - 32, G - 32, tid, wave); }
    xcd_barrier(bar);
    { PH_IDS; ph_gla_b(p, bid * 512 + tid, G * 512);
      for (int i = bid * 512 + tid; i < 16 * 128; i += G * 512) { const int bgz = i >> 7, dz = i & 127; ((bf16*)(p.ws + WS_KCMP))[((size_t)bgz * 256 + 255) * 128 + dz] = 0; ((bf16*)(p.ws + WS_VCMPT))[((size_t)bgz * 128 + dz) * 256 + 255] = 0; }
      const int ngrp = G * 4, total = 2 * 16 * 255, iters = (total + ngrp - 1) / ngrp; const int grp = tid >> 7;
      for (int it = 0; it < iters; ++it) { int id = it * ngrp + bid * 4 + grp; if (id >= total) id = total - 1;
          ph_cmp_fin_simple(p, (LAS float*)lds + grp * 4352, id, tid & 127, (const float*)(p.ws + WS_LH), (const float*)(p.ws + WS_PEVP)); __syncthreads(); } }
    xcd_barrier(bar);
    { PH_IDS; ph_nsa(p, lds, bid, G, tid, wave); }
    { PH_IDS; __syncthreads(); ph_gla_c(p, lds, bid, G, tid, wave); }
    xcd_barrier(bar);
    { pg8::Gemm g{(const bf16*)(p.ws + WS_A2), (const bf16*)(p.ws + WS_WOT), T, DM, DM};
      pg8::StaticOrder S; S.init(T, DM, G, bid); EpiRes E{p.in[I_X], p.out};
      pg8::gemm_phase<EpiRes, pg8::StaticOrder, true, true>(lds, g, S, E); }
    xcd_barrier(bar);
    { PH_IDS; for (int vb = bid; vb < NVB; vb += G) r1_router(p, lds, vb, tid, wave, lane); }
    xcd_barrier(bar);
    { PH_IDS; for (int vb = bid; vb < NVB; vb += G) r2_gather(p, lds, vb, vb == 0, tid, wave, lane); }
    xcd_barrier(bar);
    { pg8::Gemm g{(const bf16*)(p.ws + WS_XG8), (const bf16*)(p.ws + WS_W1Q), MAXTILES * 256, 4096, DM / 2};
      MoeOrder S; S.init((const int*)(p.ws + WS_META), 16, G, bid); EpiSwigluI8 E{p.in[I_B1], (const float*)(p.ws + WS_ROWSC), (const float*)(p.ws + WS_WSC1), (bf16*)(p.ws + WS_ACT), (float*)(p.ws + WS_AMAXP)};
      pg8::gemm_phase<EpiSwigluI8, MoeOrder, true, true, true>(lds, g, S, E); }
    xcd_barrier(bar);
    { PH_IDS; ph_actq(p, gw, NGW, lane); }
    xcd_barrier(bar);
    { pg8::Gemm g{(const bf16*)(p.ws + WS_ACT8), (const bf16*)(p.ws + WS_W2Q), MAXTILES * 256, DM, DFF / 2};
      MoeOrder S; S.init((const int*)(p.ws + WS_META), 8, G, bid); EpiDownI8 E{p.in[I_B2], (const float*)(p.ws + WS_ROWW), (const float*)(p.ws + WS_ASC), (const float*)(p.ws + WS_WSC2), (bf16*)(p.ws + WS_Y)};
      pg8::gemm_phase<EpiDownI8, MoeOrder, true, true, true>(lds, g, S, E); }
    xcd_barrier(bar);
    { PH_IDS; pf_final(p, gw, NGW, lane); }
}

extern "C" void kernel_launch(void* const* d_in, const int* in_sizes, int n_in, void* d_out, int out_size, void* d_ws, size_t ws_size, hipStream_t stream) {
    static int grid = 0;
    if (grid == 0) {
        if (n_in != N_IN || out_size != T * DM || ws_size < WS_END) { fprintf(stderr, "kernel_launch: unexpected shapes (n_in %d out %d ws %zu need %zu)\n", n_in, out_size, ws_size, (size_t)WS_END); grid = -1; return; }
        int dev = 0, cus = 0, per_cu = 0;
        if (hipGetDevice(&dev) != hipSuccess || hipDeviceGetAttribute(&cus, hipDeviceAttributeMultiprocessorCount, dev) != hipSuccess) { grid = -1; return; }
        if (hipFuncSetAttribute((const void*)mega_fwd, hipFuncAttributeMaxDynamicSharedMemorySize, LDS_BYTES) != hipSuccess) { fprintf(stderr, "kernel_launch: hipFuncSetAttribute failed\n"); grid = -1; return; }
        if (hipOccupancyMaxActiveBlocksPerMultiprocessor(&per_cu, (const void*)mega_fwd, 512, LDS_BYTES) != hipSuccess || per_cu < 1) { fprintf(stderr, "kernel_launch: occupancy query says %d blocks per CU\n", per_cu); }
        (void)hipGetLastError();
        grid = cus;
    }
    if (grid < 0) return;
    if (hipMemsetAsync((char*)d_ws + WS_CTL, 0, CTL_BYTES, stream) != hipSuccess) return;
    Params p{};
    for (int i = 0; i < N_IN; ++i) p.in[i] = (const float*)d_in[i];
    p.out = (float*)d_out; p.ws = (unsigned char*)d_ws;
    hipLaunchKernelGGL(mega_fwd, dim3(grid), dim3(512), LDS_BYTES, stream, p);
}
```

```cpp
#include <hip/hip_runtime.h>
#include <cstdio>
#include <cstdint>
namespace pg8 {
#define PG8_LAS __attribute__((address_space(3)))
typedef unsigned short bf16_t;
typedef short bf16x8 __attribute__((ext_vector_type(8)));
typedef float f32x4 __attribute__((ext_vector_type(4)));
typedef unsigned u32x4 __attribute__((ext_vector_type(4)));
constexpr int BM = 256, BK = 64, HALF = 128, HTB = HALF * BK * 2  , STAGE_BYTES = 8 * HTB, NXCD = 8, WGM = 8;

__host__ __device__ __forceinline__ int lds_byte(int r, int c) { const int st = (r >> 4) * 2 + (c >> 5), rr = r & 15, cc = c & 31, ob = rr * 64 + cc * 2; return st * 1024 + (ob ^ (((ob >> 9) & 1) << 5)); }
__host__ __device__ __forceinline__ void stage_rc(int b, int& R, int& C) { const int st = b / 1024, sb = b % 1024, swz = sb ^ (((sb >> 9) & 1) << 5); R = (st >> 1) * 16 + swz / 64; C = (st & 1) * 32 + (swz % 64) / 2; }
__host__ __device__ __forceinline__ int perm32(int rho) { const int n = rho >> 4, i = rho & 15; return 8 * (i >> 2) + 4 * n + (i & 3); }

struct Unit { int pm, pn, kind; };
struct Gemm { const bf16_t* A; const bf16_t* Bt; int M, N, K; };

template <int WG = WGM> __host__ __device__ __forceinline__ void tile_of(int wgid, int nM, int nN, int& pm, int& pn) {
    const int nwg = nM * nN;
    { const int q = nwg / NXCD, r = nwg % NXCD, xcd = wgid % NXCD, off = wgid / NXCD; wgid = (xcd < r ? xcd * (q + 1) : r * (q + 1) + (xcd - r) * q) + off; }
    const int nig = WG * nN, gid = wgid / nig, fm = gid * WG, gsz = (nM - fm) < WG ? (nM - fm) : WG;
    pm = fm + ((wgid % nig) % gsz); pn = (wgid % nig) / gsz;
}
struct StaticOrder {
    int nM, nN, nwg, G, c;
    __host__ __device__ void init(int M, int N, int G_, int c_) { nM = M / BM; nN = N / BM; nwg = nM * nN; G = G_; c = c_; }
    __device__ __forceinline__ bool next(int i, Unit& u) const {
        const long L = (long)i * G + c; if (L >= nwg) return false;
        tile_of((int)L, nM, nN, u.pm, u.pn); u.kind = 0; return true;
    }
    __device__ __forceinline__ const char* pa(const Gemm& g, const Unit& u) const { return (const char*)g.A + (size_t)u.pm * ((size_t)BM * g.K * 2); }
    __device__ __forceinline__ const char* pb(const Gemm& g, const Unit& u) const { return (const char*)g.Bt + (size_t)u.pn * ((size_t)BM * g.K * 2); }
    __device__ __forceinline__ void a_ready(const Unit&) const {}
    __device__ __forceinline__ void done(const Unit&) const {}
};
__device__ __forceinline__ unsigned cvt_pk_bf16(float lo, float hi) { unsigned r; asm volatile("v_cvt_pk_bf16_f32 %0, %1, %2" : "=v"(r) : "v"(lo), "v"(hi)); return r; }
template <bool I8> __device__ __forceinline__ f32x4 mma16(bf16x8 a, bf16x8 b, f32x4 c) {
    if constexpr (I8) { typedef int i32x4 __attribute__((ext_vector_type(4)));
        return __builtin_bit_cast(f32x4, __builtin_amdgcn_mfma_i32_16x16x64_i8(__builtin_bit_cast(i32x4, a), __builtin_bit_cast(i32x4, b), __builtin_bit_cast(i32x4, c), 0, 0, 0)); }
    else return __builtin_amdgcn_mfma_f32_16x16x32_bf16(a, b, c, 0, 0, 0);
}
template <class Epi, class Sched, bool ALIGN_EPI = false, bool SP2 = false, bool I8 = false>
__device__ __forceinline__ void gemm_phase(PG8_LAS unsigned char* lds, const Gemm g, const Sched& S, const Epi& E) {
    int tid_l = threadIdx.x; asm volatile("" : "+v"(tid_l));
    const int tid = tid_l, wid = __builtin_amdgcn_readfirstlane(tid >> 6), lane = tid & 63, wr = wid >> 2, wc = wid & 3, fr = lane & 15, fq = lane >> 4;
    const int K = g.K, nt = K / BK;
    unsigned voffA[2], voffB[2];
#pragma unroll
    for (int i = 0; i < 2; ++i) { int R, C; stage_rc(tid * 16 + i * 8192, R, C); const int Rb = Epi::PERM ? ((R & ~31) + perm32(R & 31)) : R;
        voffA[i] = (unsigned)(R * K + C) * 2u; voffB[i] = (unsigned)(Rb * K + C) * 2u; }
    const size_t kstep = (size_t)(BK * 2);
    const size_t hstep = (size_t)HALF * K * 2;
    const unsigned ldsw = (unsigned)wid * 1024u;
    const int aoff = lds_byte(wr * 64 + fr, fq * 8), boff = lds_byte(wc * 32 + fr, fq * 8);
#define PG8_SA(b, h) (((b) * 2 + (h)) * HTB)
#define PG8_SB(b, h) ((4 + (b) * 2 + (h)) * HTB)
#define PG8_STAGE(bufoff, gbase, voff) do { _Pragma("unroll") for (int _i = 0; _i < 2; ++_i) \
        __builtin_amdgcn_global_load_lds((const unsigned*)((const char*)(gbase) + (voff)[_i]), (PG8_LAS unsigned*)(lds + (bufoff) + ldsw + _i * 8192), 16, 0, 0); } while (0)
#define PG8_LDA(dst, b, h) do { _Pragma("unroll") for (int m = 0; m < 4; ++m) _Pragma("unroll") for (int k = 0; k < 2; ++k) dst[m][k] = *(const PG8_LAS bf16x8*)(lds + PG8_SA(b, h) + aoff + m * 2048 + k * 1024); } while (0)
#define PG8_LDB(dst, b, h) do { _Pragma("unroll") for (int n = 0; n < 2; ++n) _Pragma("unroll") for (int k = 0; k < 2; ++k) dst[n][k] = *(const PG8_LAS bf16x8*)(lds + PG8_SB(b, h) + boff + n * 2048 + k * 1024); } while (0)
#define PG8_MMA(ai, bj, At, Bt) do { __builtin_amdgcn_s_setprio(1); _Pragma("unroll") for (int m = 0; m < 4; ++m) _Pragma("unroll") for (int n = 0; n < 2; ++n) _Pragma("unroll") for (int k = 0; k < 2; ++k) \
        acc[ai][bj][m][n] = mma16<I8>(Bt[n][k], At[m][k], acc[ai][bj][m][n]); __builtin_amdgcn_s_setprio(0); } while (0)
#define PG8_WAIT_V(n) asm volatile("s_waitcnt vmcnt(" #n ")" ::: "memory")
#define PG8_WAIT_L(n) asm volatile("s_waitcnt lgkmcnt(" #n ")" ::: "memory")
#define PG8_BAR __builtin_amdgcn_s_barrier()
#define PG8_SCHED __builtin_amdgcn_sched_barrier(0)
    Unit cur, nxt; int ui = 0;
    if (!S.next(0, cur)) return;
    f32x4 acc[2][2][4][2];
#pragma unroll
    for (int a = 0; a < 2; ++a)
#pragma unroll
        for (int b = 0; b < 2; ++b)
#pragma unroll
            for (int m = 0; m < 4; ++m)
#pragma unroll
                for (int n = 0; n < 2; ++n) acc[a][b][m][n] = (f32x4){0.f, 0.f, 0.f, 0.f};
    bf16x8 At[4][2], B0[2][2], B1[2][2];
    const char* cA = S.pa(g, cur); const char* cB = S.pb(g, cur);
    S.a_ready(cur);
    if constexpr (SP2) {
        PG8_STAGE(PG8_SB(0, 0), cB, voffB); PG8_STAGE(PG8_SB(0, 1), cB + hstep, voffB); PG8_STAGE(PG8_SA(0, 0), cA, voffA); PG8_STAGE(PG8_SA(0, 1), cA + hstep, voffA);
        if (wr == 1) PG8_BAR;
        PG8_WAIT_V(2); PG8_BAR;
        PG8_STAGE(PG8_SB(1, 0), cB + kstep, voffB); PG8_STAGE(PG8_SA(1, 0), cA + kstep, voffA); PG8_STAGE(PG8_SB(1, 1), cB + hstep + kstep, voffB);
        PG8_WAIT_V(6); PG8_BAR;
    } else {
        PG8_STAGE(PG8_SB(0, 0), cB, voffB); PG8_STAGE(PG8_SA(0, 0), cA, voffA); PG8_STAGE(PG8_SB(0, 1), cB + hstep, voffB); PG8_STAGE(PG8_SA(0, 1), cA + hstep, voffA);
        if (wr == 1) PG8_BAR;
        PG8_WAIT_V(4); PG8_BAR;
        PG8_STAGE(PG8_SB(1, 0), cB + kstep, voffB); PG8_STAGE(PG8_SA(1, 0), cA + kstep, voffA); PG8_STAGE(PG8_SB(1, 1), cB + hstep + kstep, voffB);
        PG8_WAIT_V(6); PG8_BAR;
    }
    for (;;) {
        const bool has_next = S.next(ui + 1, nxt);
        const char* nA = has_next ? S.pa(g, nxt) : cA; const char* nB = has_next ? S.pb(g, nxt) : cB;
        for (int t = 0; t < nt; t += 2) {
            const bool last = (t == nt - 2);
            const char* a1 = cA + (size_t)(t + 1) * kstep;
            const char* a2 = last ? nA : cA + (size_t)(t + 2) * kstep; const char* b2 = last ? nB : cB + (size_t)(t + 2) * kstep;
            const char* a3 = a2 + kstep; const char* b3 = b2 + kstep;
            if (last && has_next) S.a_ready(nxt);
            if constexpr (SP2) {
            PG8_LDB(B0, 0, 0); PG8_LDB(B1, 0, 1); PG8_SCHED; PG8_LDA(At, 0, 0); PG8_STAGE(PG8_SA(1, 1), a1 + hstep, voffA);
            PG8_WAIT_V(8); PG8_WAIT_L(0); PG8_BAR; PG8_MMA(0, 0, At, B0); PG8_MMA(0, 1, At, B1); PG8_BAR; PG8_SCHED;
            PG8_LDA(At, 0, 1); PG8_STAGE(PG8_SB(0, 0), b2, voffB); PG8_STAGE(PG8_SB(0, 1), b2 + hstep, voffB); PG8_STAGE(PG8_SA(0, 0), a2, voffA);
            PG8_WAIT_V(8); PG8_WAIT_L(0); PG8_BAR; PG8_MMA(1, 0, At, B0); PG8_MMA(1, 1, At, B1); PG8_BAR; PG8_SCHED;
            PG8_LDB(B0, 1, 0); PG8_LDB(B1, 1, 1); PG8_SCHED; PG8_LDA(At, 1, 0); PG8_STAGE(PG8_SA(0, 1), a2 + hstep, voffA);
            PG8_WAIT_V(8); PG8_WAIT_L(0); PG8_BAR; PG8_MMA(0, 0, At, B0); PG8_MMA(0, 1, At, B1); PG8_BAR; PG8_SCHED;
            PG8_LDA(At, 1, 1); PG8_STAGE(PG8_SB(1, 0), b3, voffB); PG8_STAGE(PG8_SB(1, 1), b3 + hstep, voffB); PG8_STAGE(PG8_SA(1, 0), a3, voffA);
            PG8_WAIT_V(8); PG8_WAIT_L(0); PG8_BAR; PG8_MMA(1, 0, At, B0); PG8_MMA(1, 1, At, B1); PG8_BAR; PG8_SCHED;
            } else {
            PG8_LDB(B0, 0, 0); PG8_SCHED; PG8_LDA(At, 0, 0); PG8_STAGE(PG8_SA(1, 1), a1 + hstep, voffA);
            PG8_WAIT_L(8); PG8_BAR; PG8_WAIT_L(0); PG8_MMA(0, 0, At, B0); PG8_BAR; PG8_SCHED;
            PG8_LDB(B1, 0, 1); PG8_STAGE(PG8_SB(0, 0), b2, voffB);
            PG8_BAR; PG8_WAIT_L(0); PG8_MMA(0, 1, At, B1); PG8_BAR;
            PG8_LDA(At, 0, 1); PG8_STAGE(PG8_SA(0, 0), a2, voffA);
            PG8_BAR; PG8_WAIT_L(0); PG8_MMA(1, 0, At, B0); PG8_BAR; PG8_SCHED;
            PG8_STAGE(PG8_SB(0, 1), b2 + hstep, voffB);
            PG8_WAIT_V(6); PG8_BAR; PG8_MMA(1, 1, At, B1); PG8_BAR;
            PG8_LDB(B0, 1, 0); PG8_SCHED; PG8_LDA(At, 1, 0); PG8_STAGE(PG8_SA(0, 1), a2 + hstep, voffA);
            PG8_WAIT_L(8); PG8_BAR; PG8_WAIT_L(0); PG8_MMA(0, 0, At, B0); PG8_BAR; PG8_SCHED;
            PG8_LDB(B1, 1, 1); PG8_STAGE(PG8_SB(1, 0), b3, voffB);
            PG8_BAR; PG8_WAIT_L(0); PG8_MMA(0, 1, At, B1); PG8_BAR;
            PG8_LDA(At, 1, 1); PG8_STAGE(PG8_SA(1, 0), a3, voffA);
            PG8_BAR; PG8_WAIT_L(0); PG8_MMA(1, 0, At, B0); PG8_BAR; PG8_SCHED;
            PG8_STAGE(PG8_SB(1, 1), b3 + hstep, voffB);
            PG8_WAIT_V(6); PG8_BAR; PG8_MMA(1, 1, At, B1); PG8_BAR;
            }
        }
        if constexpr (ALIGN_EPI) { if (wr == 0) PG8_BAR; }
        if constexpr (!Epi::AFTER_DRAIN) { E(acc, cur, wr, wc, fr, fq); S.done(cur); }
        if (!has_next) break;
#pragma unroll
        for (int a = 0; a < 2; ++a)
#pragma unroll
            for (int b = 0; b < 2; ++b)
#pragma unroll
                for (int m = 0; m < 4; ++m)
#pragma unroll
                    for (int n = 0; n < 2; ++n) acc[a][b][m][n] = (f32x4){0.f, 0.f, 0.f, 0.f};
        cur = nxt; cA = nA; cB = nB; ++ui;
        if constexpr (ALIGN_EPI) { if (wr == 1) PG8_BAR; }
    }
    PG8_WAIT_V(0);
    if constexpr (!ALIGN_EPI) { if (wr == 0) PG8_BAR; }
    PG8_BAR;
    if constexpr (Epi::AFTER_DRAIN) { E.fused(acc, cur, wr, wc, fr, fq, lds, wid, lane); S.done(cur); }
#undef PG8_SA
#undef PG8_SB
#undef PG8_STAGE
#undef PG8_LDA
#undef PG8_LDB
#undef PG8_MMA
#undef PG8_WAIT_V
#undef PG8_WAIT_L
#undef PG8_BAR
#undef PG8_SCHED
}
}

#define GAS __attribute__((address_space(1)))
#define LAS __attribute__((address_space(3)))
typedef unsigned short bf16;
typedef unsigned v4u __attribute__((ext_vector_type(4)));
typedef unsigned v2u __attribute__((ext_vector_type(2)));
typedef float f32x4 __attribute__((ext_vector_type(4)));
typedef short bf16x8 __attribute__((ext_vector_type(8)));

constexpr int NB = 8, SEQ = 4096, DM = 2048, T = NB * SEQ;
constexpr int NPT = 23;
constexpr int NE = 32, DFF = 2048;
constexpr int MAXTILES = 544;
constexpr float RMS_EPS = 1e-5f;
constexpr int NVB = 256, TPV = T / NVB;

enum { I_X = 0, I_NMIX, I_WIN, I_WA2, I_BA, I_GLAG, I_PEK, I_WK1, I_WK2, I_PEV, I_WV1, I_WV2, I_NSAG, I_RELB, I_WOUT, I_NFFN, I_RW, I_RB, I_W1, I_B1, I_W2, I_B2, I_NFIN, N_IN };

constexpr size_t MiB = 1u << 20;
constexpr size_t al(size_t x) { return (x + 255) & ~(size_t)255; }
constexpr size_t WS_CTL = 0, CTL_BYTES = 1 * MiB;
constexpr size_t WS_CNT = WS_CTL + CTL_BYTES;
constexpr size_t WS_META = WS_CNT + al(NVB * 32 * 4);
constexpr size_t WS_EIDX = WS_META + al((64 + MAXTILES) * 4);
constexpr size_t WS_LRNK = WS_EIDX + al((size_t)T * 4 * 4);
constexpr size_t WS_GATE = WS_LRNK + al((size_t)T * 4 * 4);
constexpr size_t WS_POS = WS_GATE + al((size_t)T * 4 * 4);
constexpr size_t WS_ROWW = WS_POS + al((size_t)T * 4 * 4);
constexpr size_t WS_WINT = al(WS_ROWW + (size_t)MAXTILES * 256 * 4);
constexpr size_t WS_WOT = WS_WINT + (size_t)NPT * 256 * DM * 2;
constexpr size_t WS_WKCT = WS_WOT + (size_t)DM * DM * 2;
constexpr size_t WS_WVCT = WS_WKCT + (size_t)256 * 2048 * 2;
constexpr size_t WS_W1T = WS_WVCT + (size_t)256 * 2048 * 2;
constexpr size_t WS_W2T = WS_W1T + (size_t)NE * 4096 * DM * 2;
constexpr size_t WS_XN = WS_W2T + (size_t)NE * DM * DFF * 2;
constexpr size_t WS_GQ = WS_XN + (size_t)T * DM * 2;
constexpr size_t WS_GK = WS_GQ + (size_t)T * 512 * 2;
constexpr size_t WS_GV = WS_GK + (size_t)T * 512 * 2;
constexpr size_t WS_GG = WS_GV + (size_t)T * 1024 * 2;
constexpr size_t WS_NQ = WS_GG + (size_t)T * 1024 * 2;
constexpr size_t WS_KC = WS_NQ + (size_t)T * 1024 * 2;
constexpr size_t WS_VC = WS_KC + (size_t)T * 256 * 2;
constexpr size_t WS_KS = WS_VC + (size_t)T * 256 * 2;
constexpr size_t WS_KW = WS_KS + (size_t)T * 256 * 2;
constexpr size_t WS_VST = WS_KW + (size_t)T * 256 * 2;
constexpr size_t WS_VWT = WS_VST + (size_t)T * 256 * 2;
constexpr size_t WS_SM = WS_VWT + (size_t)T * 256 * 2;
constexpr size_t WS_LA = WS_SM + (size_t)T * 64 * 2;
constexpr size_t WS_OG = WS_LA + (size_t)T * 512 * 4;
constexpr size_t WS_ON = WS_OG + (size_t)T * 1024 * 4;
constexpr size_t WS_KCMP = WS_ON + (size_t)T * 1024 * 4;
constexpr size_t WS_VCMPT = WS_KCMP + (size_t)16 * 256 * 128 * 2;
constexpr size_t WS_A2 = WS_VCMPT + (size_t)16 * 256 * 128 * 2;
constexpr size_t WS_HN = WS_A2 + (size_t)T * DM * 2;
constexpr size_t WS_XG = WS_HN + (size_t)T * DM * 2;
constexpr size_t WS_ACT = WS_XG + (size_t)MAXTILES * 256 * DM * 2;
constexpr size_t WS_END = WS_ACT + (size_t)MAXTILES * 256 * DFF * 2;

__device__ __forceinline__ unsigned f2bf(float f) { unsigned u = __builtin_bit_cast(unsigned, f); return (u + 0x7fffu + ((u >> 16) & 1u)) >> 16; }
__device__ __forceinline__ unsigned pk2(float lo, float hi) { return f2bf(lo) | (f2bf(hi) << 16); }
__device__ __forceinline__ float bf2f(unsigned short v) { return __builtin_bit_cast(float, (unsigned)v << 16); }
__device__ __forceinline__ float bflo(unsigned w) { return __builtin_bit_cast(float, w << 16); }
__device__ __forceinline__ float bfhi(unsigned w) { return __builtin_bit_cast(float, w & 0xffff0000u); }
__device__ __forceinline__ float wave_sum(float v) {
#pragma unroll
    for (int o = 1; o < 64; o <<= 1) v += __shfl_xor(v, o);
    return v;
}
__device__ __forceinline__ float wave_max(float v) {
#pragma unroll
    for (int o = 1; o < 64; o <<= 1) v = fmaxf(v, __shfl_xor(v, o));
    return v;
}
#define LDS_WAIT() asm volatile("s_waitcnt lgkmcnt(0)" ::: "memory")

__device__ const unsigned char kBucket[128] = {0, 1, 2, 3, 4, 5, 6, 7, 8, 9, 10, 11, 12, 13, 14, 15, 16, 16, 16, 17, 17, 18, 18, 18, 19, 19, 19, 20, 20, 20, 20, 21, 21, 21, 21, 22, 22, 22, 22, 22, 23, 23, 23, 23, 23, 23, 24, 24, 24, 24, 24, 24, 25, 25, 25, 25, 25, 25, 25, 26, 26, 26, 26, 26, 26, 26, 26, 27, 27, 27, 27, 27, 27, 27, 27, 27, 27, 28, 28, 28, 28, 28, 28, 28, 28, 28, 28, 29, 29, 29, 29, 29, 29, 29, 29, 29, 29, 29, 29, 30, 30, 30, 30, 30, 30, 30, 30, 30, 30, 30, 30, 30, 30, 31, 31, 31, 31, 31, 31, 31, 31, 31, 31, 31, 31, 31, 31, 31};

struct Params {
    const float* in[N_IN];
    float* out;
    unsigned char* ws;
};

template <class F>
__device__ __forceinline__ void transpose_item(const float* W, int ldw, int k0, int n0, int nlim, LAS float* scr, int lane, F dst) {
#pragma unroll 8
    for (int i = 0; i < 32; ++i) { const int kk = 2 * i + (lane >> 5); const int n = n0 + (lane & 31); scr[kk * 33 + (lane & 31)] = n < nlim ? W[(size_t)(k0 + kk) * ldw + n] : 0.f; }
    LDS_WAIT(); asm volatile("" ::: "memory");
    const int c = lane & 7;
#pragma unroll
    for (int j = 0; j < 4; ++j) { const int nn = (lane >> 3) + 8 * j; const int n = n0 + nn; const LAS float* s = scr + (8 * c) * 33 + nn;
        bf16* rowp; float sc;
        if (n < nlim && dst(n, rowp, sc)) {
            v4u o; o.x = pk2(s[0 * 33] * sc, s[1 * 33] * sc); o.y = pk2(s[2 * 33] * sc, s[3 * 33] * sc); o.z = pk2(s[4 * 33] * sc, s[5 * 33] * sc); o.w = pk2(s[6 * 33] * sc, s[7 * 33] * sc);
            *(v4u*)(rowp + 8 * c) = o; } }
    LDS_WAIT(); asm volatile("" ::: "memory");
}
__device__ __forceinline__ int win_row(int n, float& sc) {
    sc = 1.f;
    if (n < 512) { sc = 0.08838834764831845f; return n; }
    if (n < 1024) return n;
    if (n < 2048) return n;
    if (n < 3072) return n;
    if (n < 3088) return 5120 + (n - 3072);
    if (n < 4112) { sc = 0.08838834764831845f; return 3072 + (n - 3088); }
    if (n < 4368) return 4096 + (n - 4112);
    if (n < 4624) return 4352 + (n - 4368);
    if (n < 4880) return 4608 + (n - 4624);
    if (n < 5136) return 5376 + (n - 4880);
    if (n < 5392) return 4864 + (n - 5136);
    if (n < 5648) return 5632 + (n - 5392);
    return 5136 + (n - 5648);
}
constexpr size_t WS_PEVP = WS_W2T;
__device__ __forceinline__ void p0_prologue(const Params& p, LAS unsigned char* lds, int gw, int NGW, int wave, int lane) {
    LAS float* scr = (LAS float*)(lds + wave * 16384);
    bf16* WinT = (bf16*)(p.ws + WS_WINT); bf16* WoT = (bf16*)(p.ws + WS_WOT); bf16* WkcT = (bf16*)(p.ws + WS_WKCT); bf16* WvcT = (bf16*)(p.ws + WS_WVCT);
    bf16* W1T = (bf16*)(p.ws + WS_W1T); bf16* W2T = (bf16*)(p.ws + WS_W2T);
    constexpr int I_IN = 32 * 178, I_O = 32 * 64, I_C = 64 * 4, I_E1 = 32 * 128, I_E2 = 32 * 64;
    constexpr int I_PE = 2 * 64;
    constexpr int NITEMS = I_O + 2 * I_C + I_PE;
    (void)I_IN; (void)WinT;
    for (int it = gw; it < NITEMS; it += NGW) {
        int r = it;
        if (r < I_O) { const int kb = r / 64, nb = r % 64, k0 = kb * 64;
            transpose_item(p.in[I_WOUT], DM, k0, nb * 32, DM, scr, lane, [&](int n, bf16*& rowp, float& sc) { sc = 1.f; rowp = WoT + (size_t)n * DM + k0; return true; }); continue; } r -= I_O;
        if (r >= 2 * I_C) { r -= 2 * I_C; const int which = r >> 6, kq = r & 63; const float* pe = p.in[which ? I_PEV : I_PEK] + kq * 64; const float* w1 = p.in[which ? I_WV1 : I_WK1] + (size_t)kq * 64 * 128 + lane;
            float a0 = 0.f, a1 = 0.f;
#pragma unroll
            for (int k = 0; k < 64; ++k) { const float pv = pe[k]; a0 += pv * w1[k * 128]; a1 += pv * w1[k * 128 + 64]; }
            float* dst = (float*)(p.ws + WS_PEVP) + (size_t)(which * 64 + kq) * 128 + lane; dst[0] = a0; dst[64] = a1; continue; }
        { const int which = r / I_C; r %= I_C; const int kb = r / 4, nb = r % 4, k0 = kb * 64;
            bf16* dstm = which ? WvcT : WkcT;
            transpose_item(p.in[which ? I_WV1 : I_WK1], 128, k0, nb * 32, 128, scr, lane, [&](int n, bf16*& rowp, float& sc) { sc = 1.f; rowp = dstm + (size_t)(n + (k0 >= 2048 ? 128 : 0)) * 2048 + (k0 & 2047); return true; }); }
        (void)I_E1; (void)I_E2; (void)W1T; (void)W2T;
    }
    const float* x = p.in[I_X]; const float* gm = p.in[I_NMIX];
    for (int m = gw; m < T; m += NGW) {
        const f32x4* xr = (const f32x4*)(x + (size_t)m * DM) + lane; f32x4 v[8]; float s = 0.f;
#pragma unroll
        for (int j = 0; j < 8; ++j) { v[j] = xr[64 * j]; s += (v[j].x * v[j].x + v[j].y * v[j].y) + (v[j].z * v[j].z + v[j].w * v[j].w); }
        const float rstd = 1.f / sqrtf(wave_sum(s) * (1.f / DM) + RMS_EPS);
        float mxr = 0.f;
#pragma unroll
        for (int j = 0; j < 8; ++j) { const f32x4 g4 = ((const f32x4*)gm)[lane + 64 * j]; v[j].x *= rstd * g4.x; v[j].y *= rstd * g4.y; v[j].z *= rstd * g4.z; v[j].w *= rstd * g4.w;
            mxr = fmaxf(mxr, fmaxf(fmaxf(fabsf(v[j].x), fabsf(v[j].y)), fmaxf(fabsf(v[j].z), fabsf(v[j].w)))); }
        mxr = wave_max(mxr); const float qs = mxr > 0.f ? mxr * (1.f / 127.f) : 1.f, qi = 1.f / qs;
        unsigned* o4 = (unsigned*)(p.ws + WS_XN + (size_t)m * DM) + lane;
#pragma unroll
        for (int j = 0; j < 8; ++j) { const int q0 = (int)rintf(v[j].x * qi), q1 = (int)rintf(v[j].y * qi), q2 = (int)rintf(v[j].z * qi), q3 = (int)rintf(v[j].w * qi);
            o4[64 * j] = ((unsigned)q0 & 0xffu) | (((unsigned)q1 & 0xffu) << 8) | (((unsigned)q2 & 0xffu) << 16) | (((unsigned)q3 & 0xffu) << 24); }
        if (lane == 0) ((float*)(p.ws + WS_XN + (size_t)T * DM))[m] = qs;
    }
}
#define XB_TMO      128
#define XB_XCNT(j)  (256  + 64 * (j))
#define XB_XSUB(j)  (1280 + 64 * (j))
#define XB_XGEN(j)  (2304 + 64 * (j))
#define XB_TOP      3328
#define XB_TOPGEN   3392
#define XCD_BAR_WORDS 3456
#define XB_SPIN_CAP (1u << 18)

__device__ __forceinline__ unsigned xb_ld(unsigned* p)              { return __hip_atomic_load(p, __ATOMIC_RELAXED, __HIP_MEMORY_SCOPE_AGENT); }
__device__ __forceinline__ unsigned xb_add(unsigned* p, unsigned v) { return __hip_atomic_fetch_add(p, v, __ATOMIC_RELAXED, __HIP_MEMORY_SCOPE_AGENT); }
__device__ __forceinline__ unsigned xb_xcc_id() { return (unsigned)__builtin_amdgcn_s_getreg((3 << 11) | 20) & 0xFu; }
#define XB_SPIN(cond, bar) do { unsigned _sp = 0; while (cond) { __builtin_amdgcn_s_sleep(1); \
    if ((++_sp & 255u) == 0u) { if (xb_ld(&(bar)[XB_TMO])) break; if (_sp > XB_SPIN_CAP) { atomicAdd(&(bar)[XB_TMO], 1u); break; } } } } while (0)

struct XcdBarrier {
    unsigned* bar; unsigned x;
    volatile LAS unsigned* st;
};

__device__ __forceinline__ XcdBarrier xcd_barrier_post(unsigned* bar, volatile LAS unsigned* st) {
    XcdBarrier b; b.bar = bar; b.x = xb_xcc_id(); b.st = st;
    if (threadIdx.x == 0) (void)xb_add(&bar[XB_XCNT(b.x)], 1u);
    return b;
}
__device__ __forceinline__ void xcd_barrier_complete(unsigned* bar, unsigned x, unsigned& nloc, unsigned& nx) {
    const unsigned G = gridDim.x * gridDim.y * gridDim.z;
    unsigned sum, cnt, mine, sp = 0u;
    for (;;) {
        sum = 0u; cnt = 0u; mine = 0u;
#pragma unroll
        for (unsigned j = 0; j < 16; ++j) { const unsigned c = xb_ld(&bar[XB_XCNT(j)]); sum += c; cnt += (c > 0u) ? 1u : 0u; mine = (j == x) ? c : mine; }
        if (sum == G) break;
        __builtin_amdgcn_s_sleep(1);
        if ((++sp & 255u) == 0u) { if (xb_ld(&bar[XB_TMO])) break; if (sp > XB_SPIN_CAP) { atomicAdd(&bar[XB_TMO], 1u); break; } }
    }
    nloc = mine > 0u ? mine : 1u; nx = cnt > 0u ? cnt : 1u;
}

__device__ __forceinline__ void xcd_barrier(const XcdBarrier& b) {
    asm volatile("s_waitcnt vmcnt(0)" ::: "memory");
    __syncthreads();
    if (threadIdx.x == 0) {
        unsigned* bar = b.bar;
        __builtin_amdgcn_s_waitcnt(0);
        unsigned nloc = b.st[0], nx = b.st[1];
        if (nloc == 0u) { xcd_barrier_complete(bar, b.x, nloc, nx); b.st[0] = nloc; b.st[1] = nx; }
        const unsigned old = xb_add(&bar[XB_XSUB(b.x)], 1u);
        const unsigned gen = old / nloc;
        if (old + 1u == (gen + 1u) * nloc) {
            __builtin_amdgcn_fence(__ATOMIC_RELEASE, "agent");
            asm volatile("s_waitcnt vmcnt(0)" ::: "memory");
            const unsigned og = xb_add(&bar[XB_TOP], 1u);
            const unsigned tg = og / nx;
            if (og + 1u == (tg + 1u) * nx) xb_add(&bar[XB_TOPGEN], 1u);
            else XB_SPIN(xb_ld(&bar[XB_TOPGEN]) == tg, bar);
            __builtin_amdgcn_fence(__ATOMIC_ACQUIRE, "agent");
            xb_add(&bar[XB_XGEN(b.x)], 1u);
            asm volatile("s_waitcnt vmcnt(0)" ::: "memory");
        } else {
            XB_SPIN(xb_ld(&bar[XB_XGEN(b.x)]) == gen, bar);
            __builtin_amdgcn_fence(__ATOMIC_ACQUIRE, "agent");
            asm volatile("s_waitcnt vmcnt(0)" ::: "memory");
        }
    }
    __syncthreads();
}

struct ProjOrder : pg8::StaticOrder {
    const bf16* xn; const bf16* wt;
    __device__ __forceinline__ bool next(int i, pg8::Unit& u) const { if (!pg8::StaticOrder::next(i, u)) return false; u.kind = (u.pn >= 21) ? 1 : 0; return true; }
    __device__ __forceinline__ const char* pa(const pg8::Gemm& g, const pg8::Unit& u) const { return u.kind ? (const char*)wt + (size_t)u.pn * ((size_t)256 * g.K * 2) : (const char*)xn + (size_t)u.pm * ((size_t)256 * g.K * 2); }
    __device__ __forceinline__ const char* pb(const pg8::Gemm& g, const pg8::Unit& u) const { return u.kind ? (const char*)xn + (size_t)u.pm * ((size_t)256 * g.K * 2) : (const char*)wt + (size_t)u.pn * ((size_t)256 * g.K * 2); }
};
struct EpiRes {
    static constexpr bool PERM = false, AFTER_DRAIN = false;
    const float* x; float* h;
    __device__ __forceinline__ void operator()(const pg8::f32x4 (&acc)[2][2][4][2], const pg8::Unit& u, int wr, int wc, int fr, int fq) const {
        const int row0 = u.pm * 256 + wr * 64 + fr, col0 = u.pn * 256 + wc * 32 + 4 * fq;
#pragma unroll
        for (int ai = 0; ai < 2; ++ai)
#pragma unroll
            for (int m = 0; m < 4; ++m) { const size_t off = (size_t)(row0 + ai * 128 + m * 16) * DM + col0;
#pragma unroll
                for (int bj = 0; bj < 2; ++bj)
#pragma unroll
                    for (int n = 0; n < 2; ++n) { const pg8::f32x4 xv = *(const pg8::f32x4*)(x + off + bj * 128 + n * 16); *(pg8::f32x4*)(h + off + bj * 128 + n * 16) = xv + acc[ai][bj][m][n]; } }
    }
};
struct MoeOrder {
    int nM, nN, nwg, G, c; const int* tile_exp;
    __device__ __forceinline__ void init(const int* meta, int nN_, int G_, int c_) { nM = meta[0]; nN = nN_; nwg = nM * nN; G = G_; c = c_; tile_exp = meta + 64; }
    __device__ __forceinline__ bool next(int i, pg8::Unit& u) const {
        const long L = (long)i * G + c; if (L >= nwg) return false;
        pg8::tile_of<8>((int)L, nM, nN, u.pm, u.pn); u.kind = tile_exp[u.pm]; return true;
    }
    __device__ __forceinline__ const char* pa(const pg8::Gemm& g, const pg8::Unit& u) const { return (const char*)g.A + (size_t)u.pm * ((size_t)256 * g.K * 2); }
    __device__ __forceinline__ const char* pb(const pg8::Gemm& g, const pg8::Unit& u) const { return (const char*)g.Bt + ((size_t)u.kind * nN + u.pn) * ((size_t)256 * g.K * 2); }
    __device__ __forceinline__ void a_ready(const pg8::Unit&) const {}
    __device__ __forceinline__ void done(const pg8::Unit&) const {}
};


__device__ __forceinline__ float gelu_tanh(float x) { const float u = 0.7978845608028654f * (x + 0.044715f * x * x * x); const float e = __expf(2.f * u); return 0.5f * x * (1.f + (1.f - 2.f / (e + 1.f))); }
__device__ __forceinline__ void ph_cmp_fin_simple(const Params& p, LAS float* tl, int id, int n, const float* LHall, const float* PEVall) {
    LAS float* hid = tl + 4096;
    const int which = id / (16 * 255), rem = id % (16 * 255), bg = rem / 255, c = rem % 255;
    const float* w2 = p.in[which ? I_WV2 : I_WK2];
    const float* LH = LHall + ((size_t)which * 4096 + bg * 256) * 256;
    float pev = 0.f;
#pragma unroll 8
    for (int q = 0; q < 64; ++q) pev += PEVall[(size_t)(which * 64 + q) * 128 + n];
    const float a = LH[(size_t)c * 256 + n] + LH[(size_t)(c + 1) * 256 + 128 + n] + pev;
    hid[n] = gelu_tanh(a);
    __syncthreads();
    float o = 0.f;
    for (int m = 0; m < 128; ++m) o += hid[m] * w2[m * 128 + n];
    if (which == 0) ((bf16*)(p.ws + WS_KCMP))[((size_t)bg * 256 + c) * 128 + n] = (bf16)f2bf(o);
    else ((bf16*)(p.ws + WS_VCMPT))[((size_t)bg * 128 + n) * 256 + c] = (bf16)f2bf(o);
}

namespace nsa {
constexpr int KB0 = 0, KB1 = 16384, VB0 = 32768, VB1 = 49152, LUT = 65536;
constexpr int QST = LUT + 4096, IMP = QST + 65536, SELM = IMP + 16384, LDS_END = SELM + 512;
constexpr float LOG2E = 1.4426950408889634f;
typedef float f4 __attribute__((ext_vector_type(4)));

typedef unsigned u2v __attribute__((ext_vector_type(2)));
__device__ __forceinline__ float rmax16(float x) { const unsigned u = __float_as_uint(x); const u2v r = __builtin_amdgcn_permlane16_swap(u, u, false, false); return fmaxf(__uint_as_float(r[0]), __uint_as_float(r[1])); }
__device__ __forceinline__ float rmax32(float x) { const unsigned u = __float_as_uint(x); const u2v r = __builtin_amdgcn_permlane32_swap(u, u, false, false); return fmaxf(__uint_as_float(r[0]), __uint_as_float(r[1])); }
__device__ __forceinline__ float radd16(float x) { const unsigned u = __float_as_uint(x); const u2v r = __builtin_amdgcn_permlane16_swap(u, u, false, false); return __uint_as_float(r[0]) + __uint_as_float(r[1]); }
__device__ __forceinline__ float radd32(float x) { const unsigned u = __float_as_uint(x); const u2v r = __builtin_amdgcn_permlane32_swap(u, u, false, false); return __uint_as_float(r[0]) + __uint_as_float(r[1]); }
__device__ __forceinline__ float raddq(float x) { x += __int_as_float(__builtin_amdgcn_update_dpp(0, __float_as_int(x), 0xB1, 0xF, 0xF, true)); x += __int_as_float(__builtin_amdgcn_update_dpp(0, __float_as_int(x), 0x4E, 0xF, 0xF, true)); return x; }
struct Ctx {
    LAS unsigned char* lds; int tid, lane, wave, c, gq, r;
    int s0, cur;
    const LAS unsigned char* qst;
    int pos0;
    const LAS float* lutrow;
    int koff0, voff0;
    unsigned kdo[2], vdoc[2], vdos[2];
};
__device__ __forceinline__ void dma_k(const Ctx& C, const bf16* kt, LAS unsigned char* kb) {
#pragma unroll
    for (int i = 0; i < 2; ++i) __builtin_amdgcn_global_load_lds((const unsigned*)((const char*)kt + C.kdo[i]), (LAS unsigned*)(kb + (2 * C.wave + i) * 1024), 16, 0, 0); }
__device__ __forceinline__ void dma_v(const Ctx& C, const bf16* vt, const unsigned (&vdo)[2], LAS unsigned char* vb) {
#pragma unroll
    for (int i = 0; i < 2; ++i) __builtin_amdgcn_global_load_lds((const unsigned*)((const char*)vt + vdo[i]), (LAS unsigned*)(vb + (2 * C.wave + i) * 1024), 16, 0, 0); }

__device__ __forceinline__ void compute_st(const Ctx& C, const LAS unsigned char* kb, f4 (&s)[2][4]) {
#pragma unroll
    for (int ks = 0; ks < 4; ++ks) { const bf16x8 q0 = *(const LAS bf16x8*)(C.qst + ks * 1024), q1 = *(const LAS bf16x8*)(C.qst + (4 + ks) * 1024);
#pragma unroll
        for (int kt = 0; kt < 4; ++kt) { const bf16x8 a = *(const LAS bf16x8*)(kb + kt * 4096 + (C.koff0 ^ (ks * 64)));
            s[0][kt] = __builtin_amdgcn_mfma_f32_16x16x32_bf16(a, q0, ks == 0 ? (f4){0.f, 0.f, 0.f, 0.f} : s[0][kt], 0, 0, 0);
            s[1][kt] = __builtin_amdgcn_mfma_f32_16x16x32_bf16(a, q1, ks == 0 ? (f4){0.f, 0.f, 0.f, 0.f} : s[1][kt], 0, 0, 0); }
        asm volatile("" ::: "memory"); }
}
__device__ __forceinline__ void compute_pv(const Ctx& C, const LAS unsigned char* vb, const f4 (&p)[2][4], f4 (&o)[2][8]) {
#pragma unroll
    for (int i = 0; i < 2; ++i) { bf16x8 pb[2];
#pragma unroll
        for (int qt = 0; qt < 2; ++qt) { v4u w; w.x = pg8::cvt_pk_bf16(p[qt][2 * i][0], p[qt][2 * i][1]); w.y = pg8::cvt_pk_bf16(p[qt][2 * i][2], p[qt][2 * i][3]);
            w.z = pg8::cvt_pk_bf16(p[qt][2 * i + 1][0], p[qt][2 * i + 1][1]); w.w = pg8::cvt_pk_bf16(p[qt][2 * i + 1][2], p[qt][2 * i + 1][3]); pb[qt] = __builtin_bit_cast(bf16x8, w); }
#pragma unroll
        for (int dt = 0; dt < 8; ++dt) { const v2u lo = *(const LAS v2u*)(vb + dt * 2048 + (C.voff0 ^ (i * 64))), hi = *(const LAS v2u*)(vb + dt * 2048 + (C.voff0 ^ (i * 64 + 32))); const bf16x8 a = __builtin_bit_cast(bf16x8, (v4u){lo.x, lo.y, hi.x, hi.y});
#pragma unroll
            for (int qt = 0; qt < 2; ++qt) o[qt][dt] = __builtin_amdgcn_mfma_f32_16x16x32_bf16(a, pb[qt], o[qt][dt], 0, 0, 0);
            if (dt & 1) asm volatile("" ::: "memory"); } }
}
enum { M_CMP = 0, M_SEL = 1, M_WIN = 2 };
template <int MODE, bool FAR = false>
__device__ __forceinline__ void mask_bias(const Ctx& C, f4 (&s)[2][4], int kb, int n, const LAS unsigned* selw) {
    const float NEG = -__builtin_inff();
#pragma unroll
    for (int qt = 0; qt < 2; ++qt) {
        bool tokok = true;
        if (MODE == M_SEL) tokok = ((selw[(4 * qt + (C.c >> 2)) * 2 + (n >> 5)] >> (n & 31)) & 1u) != 0u;
        if (FAR) { const float be = tokok ? C.lutrow[127] : NEG;
#pragma unroll
            for (int kt = 0; kt < 4; ++kt)
#pragma unroll
                for (int rg = 0; rg < 4; ++rg) s[qt][kt][rg] = __builtin_fmaf(s[qt][kt][rg], LOG2E, be);
            continue; }
        const int dbase = (MODE == M_CMP) ? (C.pos0 + 4 * qt - 31 - 16 * (kb + 4 * C.gq)) : (C.pos0 + 4 * qt - (kb + 4 * C.gq));
#pragma unroll
        for (int kt = 0; kt < 4; ++kt) {
#pragma unroll
            for (int rg = 0; rg < 4; ++rg) { const int d = (MODE == M_CMP) ? dbase - 16 * (16 * kt + rg) : dbase - (16 * kt + rg);
                int di = d < 0 ? 0 : d; di = di > 127 ? 127 : di; const float bias = C.lutrow[di];
                bool ok = tokok && d >= 0; if (MODE == M_WIN) ok = ok && d < 512;
                s[qt][kt][rg] = ok ? __builtin_fmaf(s[qt][kt][rg], LOG2E, bias) : NEG; }
            asm volatile("" ::: "memory"); }
    }
}
__device__ __forceinline__ void softmax_step(f4 (&s)[2][4], float (&m)[2], float (&l)[2], f4 (&o)[2][8], bool rescale_o) {
#pragma unroll
    for (int qt = 0; qt < 2; ++qt) { float mx = s[qt][0][0];
#pragma unroll
        for (int kt = 0; kt < 4; ++kt)
#pragma unroll
            for (int rg = 0; rg < 4; ++rg) mx = fmaxf(mx, s[qt][kt][rg]);
        mx = rmax32(rmax16(mx));
        const float mn = fmaxf(m[qt], mx), alpha = __builtin_amdgcn_exp2f(m[qt] - mn); m[qt] = mn; float ps = 0.f;
#pragma unroll
        for (int kt = 0; kt < 4; ++kt)
#pragma unroll
            for (int rg = 0; rg < 4; ++rg) { const float e = __builtin_amdgcn_exp2f(s[qt][kt][rg] - mn); s[qt][kt][rg] = e; ps += e; }
        l[qt] = l[qt] * alpha + ps;
        if (rescale_o && __any(alpha != 1.f)) {
#pragma unroll
            for (int dt = 0; dt < 8; ++dt) o[qt][dt] = o[qt][dt] * alpha; }
    }
}
template <int MODE>
__device__ __forceinline__ void softmax_far(const Ctx& C, f4 (&s)[2][4], int n, const LAS unsigned* selw, float (&m)[2], float (&l)[2], f4 (&o)[2][8]) {
    const float b31 = C.lutrow[127];
#pragma unroll
    for (int qt = 0; qt < 2; ++qt) {
        float be = b31;
        if (MODE == M_SEL) { const bool tokok = ((selw[(4 * qt + (C.c >> 2)) * 2 + (n >> 5)] >> (n & 31)) & 1u) != 0u; be = tokok ? b31 : -__builtin_inff(); }
        float mx = fmaxf(fmaxf(s[qt][0][0], s[qt][0][1]), fmaxf(s[qt][0][2], s[qt][0][3]));
#pragma unroll
        for (int kt = 1; kt < 4; ++kt) mx = fmaxf(mx, fmaxf(fmaxf(s[qt][kt][0], s[qt][kt][1]), fmaxf(s[qt][kt][2], s[qt][kt][3])));
        mx = rmax32(rmax16(mx));
        const float mt = __builtin_fmaf(mx, LOG2E, be), mn = fmaxf(m[qt], mt), alpha = __builtin_amdgcn_exp2f(m[qt] - mn), c0 = be - mn; m[qt] = mn; float ps = 0.f;
#pragma unroll
        for (int kt = 0; kt < 4; ++kt)
#pragma unroll
            for (int rg = 0; rg < 4; ++rg) { const float e = __builtin_amdgcn_exp2f(__builtin_fmaf(s[qt][kt][rg], LOG2E, c0)); s[qt][kt][rg] = e; ps += e; }
        l[qt] = l[qt] * alpha + ps;
        if (__any(alpha != 1.f)) {
#pragma unroll
            for (int dt = 0; dt < 8; ++dt) o[qt][dt] = o[qt][dt] * alpha; }
    }
}
}

__device__ __forceinline__ void ph_nsa(const Params& p, LAS unsigned char* lds, int idx0, int idxstride, int tid_in, int wave) {
    using namespace nsa;
    int tid = tid_in; asm volatile("" : "+v"(tid));
    const int lane = tid & 63;
    Ctx C; C.lds = lds; C.tid = tid; C.lane = lane; C.wave = wave; C.c = lane & 15; C.gq = lane >> 4; C.r = lane & 3;
    C.koff0 = C.c * 256 + ((C.gq ^ C.c) * 16);
#pragma unroll
    for (int i = 0; i < 2; ++i) { const int piece = 2 * wave + i;
        { const int row = piece * 4 + (lane >> 4), chunk = (lane & 15) ^ (row & 15); C.kdo[i] = (unsigned)(row * 256 + chunk * 16); }
        { const int row = piece * 8 + (lane >> 3), chunk = (lane & 7) ^ ((row >> 1) & 7); C.vdoc[i] = (unsigned)(row * 256 * 2 + chunk * 16); C.vdos[i] = (unsigned)(row * SEQ * 2 + chunk * 16); } }
    C.voff0 = C.c * 128 + (((C.gq >> 1) ^ ((C.c >> 1) & 7)) * 16) + (C.gq & 1) * 8;
    const bf16* NQ = (const bf16*)(p.ws + WS_NQ); const bf16* SM = (const bf16*)(p.ws + WS_SM); bf16* A2 = (bf16*)(p.ws + WS_A2);
    const float* relb = p.in[I_RELB]; const float* nsag = p.in[I_NSAG];
    LAS float* lut = (LAS float*)(lds + LUT);
    for (int i = tid; i < 8 * 128; i += 512) { const int hh = i >> 7, d = i & 127; lut[i] = relb[(int)kBucket[d] * 8 + hh] * LOG2E; }
    __syncthreads();
    LAS unsigned char* qstw = lds + QST + wave * 8192 + lane * 16; C.qst = qstw;
    LAS float* imp = (LAS float*)(lds + IMP + wave * 2048);
    LAS unsigned long long* selm = (LAS unsigned long long*)(lds + SELM + wave * 64);
#define NSA_SYNC() do { asm volatile("s_waitcnt vmcnt(0)" ::: "memory"); __syncthreads(); } while (0)
    for (int idx = idx0; idx < 512; idx += idxstride) {
        const int rnd = idx >> 8, kq = idx & 255, b = kq & 7, tq = rnd == 0 ? 63 - (kq >> 3) : (kq >> 3);
        C.s0 = tq * 64; C.cur = tq;
        const int tokl0 = 8 * wave + (C.c >> 2);
        C.pos0 = C.s0 + tokl0;
        float ssq[2] = {0.f, 0.f};
        for (int g = 0; g < 2; ++g) {
            const int bg = b * 2 + g, h = g * 4 + C.r;
            C.lutrow = lut + h * 128;
            const bf16* KCMP = (const bf16*)(p.ws + WS_KCMP) + (size_t)bg * 256 * 128; const bf16* VCMPT = (const bf16*)(p.ws + WS_VCMPT) + (size_t)bg * 128 * 256;
#pragma unroll
            for (int qt = 0; qt < 2; ++qt) { const unsigned qo = (unsigned)(((b * SEQ + (C.pos0 + 4 * qt)) * 1024 + h * 128 + 8 * C.gq) * 2);
#pragma unroll
                for (int ks = 0; ks < 4; ++ks) *(LAS bf16x8*)(qstw + (qt * 4 + ks) * 1024) = *(const bf16x8*)((const char*)NQ + qo + ks * 64); }
#pragma unroll
            for (int i = 0; i < 2; ++i) *(LAS f32x4*)((LAS unsigned char*)imp + lane * 16 + i * 1024) = (f32x4){0.f, 0.f, 0.f, 0.f};
#define NSA_OROW(qt) ((char*)A2 + (unsigned)(((b * SEQ + C.pos0 + 4 * (qt)) * DM + 1024 + h * 128 + 4 * C.gq) * 2))
            const int cmaxb = C.s0 + 63 - 31; const int nct = cmaxb >= 0 ? ((cmaxb >> 4) >> 6) + 1 : 0;
            float m[2] = {-1e30f, -1e30f}, l[2] = {0.f, 0.f};
            f4 o[2][8];
            if (nct > 0) {
                dma_k(C, KCMP, lds + KB0); NSA_SYNC();
                for (int ct = 0; ct < nct; ++ct) { const int buf = ct & 1;
                    if (ct + 1 < nct) dma_k(C, KCMP + (ct + 1) * 64 * 128, lds + (buf ? KB0 : KB1));
                    f4 s[2][4]; compute_st(C, lds + (buf ? KB1 : KB0), s); mask_bias<M_CMP>(C, s, 64 * ct, 0, (const LAS unsigned*)selm); softmax_step(s, m, l, o, false);
                    NSA_SYNC(); }
            }
            float inv[2];
#pragma unroll
            for (int qt = 0; qt < 2; ++qt) { const float lt = radd32(radd16(l[qt])); inv[qt] = lt > 0.f ? 1.f / lt : 0.f; }
#pragma unroll
            for (int qt = 0; qt < 2; ++qt)
#pragma unroll
                for (int dt = 0; dt < 8; ++dt) o[qt][dt] = (f4){0.f, 0.f, 0.f, 0.f};
            if (nct > 0) {
                dma_k(C, KCMP, lds + KB0); dma_v(C, VCMPT, C.vdoc, lds + VB0); NSA_SYNC();
                for (int ct = 0; ct < nct; ++ct) { const int buf = ct & 1;
                    if (ct + 1 < nct) { dma_k(C, KCMP + (ct + 1) * 64 * 128, lds + (buf ? KB0 : KB1)); dma_v(C, VCMPT + 64 * (ct + 1), C.vdoc, lds + (buf ? VB0 : VB1)); }
                    f4 s[2][4]; compute_st(C, lds + (buf ? KB1 : KB0), s); mask_bias<M_CMP>(C, s, 64 * ct, 0, (const LAS unsigned*)selm);
#pragma unroll
                    for (int qt = 0; qt < 2; ++qt)
#pragma unroll
                        for (int kt = 0; kt < 4; ++kt) {
#pragma unroll
                            for (int rg = 0; rg < 4; ++rg) s[qt][kt][rg] = __builtin_amdgcn_exp2f(s[qt][kt][rg] - m[qt]) * inv[qt];
                            float po = (s[qt][kt][0] + s[qt][kt][1]) + (s[qt][kt][2] + s[qt][kt][3]), p3 = s[qt][kt][3];
                            po = raddq(po); p3 = raddq(p3);
                            const int nb = 16 * ct + 4 * kt + C.gq, tl = 4 * qt + (C.c >> 2);
                            if (C.r == 0) { __hip_atomic_fetch_add((float*)(imp + tl * 64 + nb), po, __ATOMIC_RELAXED, __HIP_MEMORY_SCOPE_WORKGROUP); if (nb + 1 < 64) __hip_atomic_fetch_add((float*)(imp + tl * 64 + nb + 1), p3, __ATOMIC_RELAXED, __HIP_MEMORY_SCOPE_WORKGROUP); } }
                    compute_pv(C, lds + (buf ? VB1 : VB0), s, o);
                    NSA_SYNC(); }
            }
            LDS_WAIT(); __builtin_amdgcn_wave_barrier();
            for (int tk = 0; tk < 8; ++tk) { const int n = lane; float sc;
                if (n == 0 || n == C.cur || n == C.cur - 1) sc = 1e4f; else if (n <= C.cur) sc = imp[tk * 64 + n]; else sc = -1.f;
                const int key = ((sc < 0.f ? 0 : __float_as_int(sc) + 64) & ~63) | (63 - n);
                int rank = 0;
#pragma unroll
                for (int mm = 0; mm < 64; ++mm) rank += (__builtin_amdgcn_readlane(key, mm) > key) ? 1 : 0;
                const unsigned long long mk = __ballot(rank < 16);
                if (lane == 0) selm[tk] = mk; }
            LDS_WAIT(); __builtin_amdgcn_wave_barrier();
#pragma unroll
            for (int qt = 0; qt < 2; ++qt) { const float gt = 1.f / (1.f + __expf(-bf2f(*(const bf16*)((const char*)SM + (unsigned)(((b * SEQ + (C.pos0 + 4 * qt)) * 64 + 16 + h) * 2)))));
#pragma unroll
                for (int dt = 0; dt < 8; ++dt) { const f4 v = o[qt][dt] * gt; *(v2u*)(NSA_OROW(qt) + 32 * dt) = (v2u){pg8::cvt_pk_bf16(v[0], v[1]), pg8::cvt_pk_bf16(v[2], v[3])}; } }
#pragma unroll
            for (int br = 1; br <= 2; ++br) {
                const bf16* KX = (const bf16*)(p.ws + (br == 1 ? WS_KS : WS_KW)) + bg * SEQ * 128; const bf16* VX = (const bf16*)(p.ws + (br == 1 ? WS_VST : WS_VWT)) + bg * 128 * SEQ;
                const int n0 = br == 1 ? 0 : (C.cur >= 8 ? C.cur - 8 : 0), n1 = C.cur;
                m[0] = m[1] = -1e30f; l[0] = l[1] = 0.f;
#pragma unroll
                for (int qt = 0; qt < 2; ++qt)
#pragma unroll
                    for (int dt = 0; dt < 8; ++dt) o[qt][dt] = (f4){0.f, 0.f, 0.f, 0.f};
                int f0 = n1 + 1, f1 = n0 - 1;
                for (int n = n0; n <= n1; ++n) { const bool fa = (C.s0 - (64 * n + 63) >= 113) && (br == 1 || (C.s0 + 63 - 64 * n) < 512); if (fa) { f0 = n < f0 ? n : f0; f1 = n; } }
                const int cntf = f1 >= f0 ? f1 - f0 + 1 : 0, cnt = n1 - n0 + 1, nlo = cntf ? f0 - n0 : cnt;
#define NSA_TILE(i) ((i) < cntf ? f0 + (i) : (((i) - cntf) < nlo ? n0 + ((i) - cntf) : f1 + 1 + ((i) - cntf - nlo)))
#define NSA_BODY(FARF) { const int n = NSA_TILE(i); const int buf = i & 1; \
                    if (i + 1 < cnt) { const int nn = NSA_TILE(i + 1); dma_k(C, KX + nn * 64 * 128, lds + (buf ? KB0 : KB1)); dma_v(C, VX + 64 * nn, C.vdos, lds + (buf ? VB0 : VB1)); } \
                    bool need = true; \
                    if (br == 1) { const unsigned any = ((const LAS unsigned*)selm)[(lane & 7) * 2 + (n >> 5)] >> (n & 31); need = __any((int)(any & 1u)); } \
                    if (need) { f4 s[2][4]; compute_st(C, lds + (buf ? KB1 : KB0), s); \
                        if (FARF) { if (br == 1) softmax_far<M_SEL>(C, s, n, (const LAS unsigned*)selm, m, l, o); else softmax_far<M_WIN>(C, s, n, (const LAS unsigned*)selm, m, l, o); } \
                        else { if (br == 1) mask_bias<M_SEL, false>(C, s, 64 * n, n, (const LAS unsigned*)selm); else mask_bias<M_WIN, false>(C, s, 64 * n, n, (const LAS unsigned*)selm); \
                            softmax_step(s, m, l, o, true); } \
                        compute_pv(C, lds + (buf ? VB1 : VB0), s, o); } \
                    NSA_SYNC(); }
                { const int nf = NSA_TILE(0); dma_k(C, KX + nf * 64 * 128, lds + KB0); dma_v(C, VX + 64 * nf, C.vdos, lds + VB0); NSA_SYNC(); }
                int i = 0;
                for (; i < cntf; ++i) NSA_BODY(true)
                for (; i < cnt; ++i) NSA_BODY(false)
#undef NSA_BODY
#undef NSA_TILE
                asm volatile("s_waitcnt vmcnt(0)" ::: "memory");
#pragma unroll
                for (int qt = 0; qt < 2; ++qt) { const float lt = radd32(radd16(l[qt]));
                    const int row = b * SEQ + (C.pos0 + 4 * qt);
                    const float sc = (1.f / (1.f + __expf(-bf2f(*(const bf16*)((const char*)SM + (unsigned)((row * 64 + 16 + 8 * br + h) * 2)))))) / lt;
#pragma unroll
                    for (int dt = 0; dt < 8; ++dt) { const f4 v = o[qt][dt] * sc; v2u* sp = (v2u*)(NSA_OROW(qt) + 32 * dt); const v2u pv = *sp;
                        const float a0 = bflo(pv.x) + v[0], a1 = bfhi(pv.x) + v[1], a2 = bflo(pv.y) + v[2], a3 = bfhi(pv.y) + v[3];
                        if (br == 2) ssq[qt] += (a0 * a0 + a1 * a1) + (a2 * a2 + a3 * a3);
                        *sp = (v2u){pg8::cvt_pk_bf16(a0, a1), pg8::cvt_pk_bf16(a2, a3)}; } }
            }
        }
        float rstd[2];
#pragma unroll
        for (int qt = 0; qt < 2; ++qt) { const float t = radd32(radd16(raddq(ssq[qt]))); rstd[qt] = 1.f / sqrtf(t * (1.f / 1024.f) + RMS_EPS); }
        asm volatile("s_waitcnt vmcnt(0)" ::: "memory");
#pragma unroll
        for (int qt = 0; qt < 2; ++qt) { const int sub = C.r * 4 + C.gq; bf16* orow = (bf16*)((char*)A2 + (unsigned)(((b * SEQ + (C.pos0 + 4 * qt)) * DM + 1024) * 2 + sub * 16)); const int subz = 0;
#pragma unroll
            for (int j = 0; j < 8; ++j) { const int col = (j * 16 + subz) * 8; v4u w = *(const v4u*)((const char*)orow + (unsigned)(col * 2)); const f32x4 g0 = *(const f32x4*)((const char*)nsag + (unsigned)(col * 4 + sub * 32)), g1 = *(const f32x4*)((const char*)nsag + (unsigned)(col * 4 + sub * 32 + 16)); const float rs = rstd[qt];
                w.x = pk2(bflo(w.x) * rs * g0.x, bfhi(w.x) * rs * g0.y); w.y = pk2(bflo(w.y) * rs * g0.z, bfhi(w.y) * rs * g0.w); w.z = pk2(bflo(w.z) * rs * g1.x, bfhi(w.z) * rs * g1.y); w.w = pk2(bflo(w.w) * rs * g1.z, bfhi(w.w) * rs * g1.w);
                *(v4u*)((char*)orow + (unsigned)(col * 2)) = w; } }
        NSA_SYNC();
    }
#undef NSA_SYNC
#undef NSA_OROW
}

constexpr size_t WS_ST = WS_LA;
constexpr size_t WS_DEC = WS_ST + (size_t)2048 * 256 * 128 * 2;
static_assert(WS_DEC + (size_t)2048 * 128 * 4 <= WS_KCMP, "gla scratch overlay");
namespace gla {
typedef float f4 __attribute__((ext_vector_type(4)));
constexpr int L_ST = 0, L_KT = 65536, L_QT = 81920, L_VT = 98304, L_GA = 131072, L_GT = L_GA + 4096, L_RED = L_GT + 2048, L_END = L_RED + 512;
__device__ __forceinline__ void chunk_cumsum(const Params& p, LAS unsigned char* lds, int tid, int t0, int h, float (&P)[16], float& blast) {
    const bf16* SM = (const bf16*)(p.ws + WS_SM); const float* wa2 = p.in[I_WA2]; const float* ba = p.in[I_BA];
    LAS float* ga = (LAS float*)(lds + L_GA); LAS float* gt = (LAS float*)(lds + L_GT);
    if (tid < 128) { const int j = tid >> 1, hf = tid & 1; const v4u w = *(const v4u*)((const char*)SM + (unsigned)(((t0 + j) * 64 + hf * 8) * 2));
        LAS float* d = ga + j * 16 + hf * 8; d[0] = bflo(w.x); d[1] = bfhi(w.x); d[2] = bflo(w.y); d[3] = bfhi(w.y); d[4] = bflo(w.z); d[5] = bfhi(w.z); d[6] = bflo(w.w); d[7] = bfhi(w.w); }
    const int dk = tid & 127, jq = tid >> 7;
    float w[16];
#pragma unroll
    for (int r = 0; r < 16; ++r) w[r] = wa2[r * 512 + h * 128 + dk];
    const float bb = ba[h * 128 + dk];
    __syncthreads();
    float run = 0.f;
#pragma unroll
    for (int jj = 0; jj < 16; ++jj) { const LAS f32x4* gr = (const LAS f32x4*)(ga + (16 * jq + jj) * 16); float z = bb;
#pragma unroll
        for (int r4 = 0; r4 < 4; ++r4) { const f32x4 g4 = gr[r4]; z += g4.x * w[4 * r4] + g4.y * w[4 * r4 + 1] + g4.z * w[4 * r4 + 2] + g4.w * w[4 * r4 + 3]; }
        run += (fminf(z, 0.f) - log1pf(__expf(-fabsf(z)))) * (1.f / 16.f); P[jj] = run; }
    gt[jq * 128 + dk] = run;
    __syncthreads();
    float off = 0.f, tot = 0.f;
#pragma unroll
    for (int q = 0; q < 4; ++q) { const float t = gt[q * 128 + dk]; tot += t; if (q < jq) off += t; }
#pragma unroll
    for (int jj = 0; jj < 16; ++jj) P[jj] += off;
    blast = tot;
}
__device__ __forceinline__ void stage_raw_k(const bf16* src  , LAS unsigned char* dst, int tid, int t0, int h) {
#pragma unroll
    for (int q = 0; q < 2; ++q) { const int id = tid + 512 * q, j = id >> 4, c16 = id & 15; *(LAS v4u*)(dst + j * 256 + c16 * 16) = *(const v4u*)((const char*)src + (unsigned)(((t0 + j) * 512 + h * 128 + c16 * 8) * 2)); }
}
__device__ __forceinline__ void stage_raw_v(const Params& p, LAS unsigned char* dst, int tid, int t0, int h) {
    const bf16* GV = (const bf16*)(p.ws + WS_GV);
#pragma unroll
    for (int q = 0; q < 4; ++q) { const int id = tid + 512 * q, j = id >> 5, c = id & 31; *(LAS v4u*)(dst + j * 512 + c * 16) = *(const v4u*)((const char*)GV + (unsigned)(((t0 + j) * 1024 + h * 256 + c * 8) * 2)); }
}
__device__ __forceinline__ void fill_vt(LAS unsigned char* lds, const LAS unsigned char* rv, int tid) {
    const int dv = tid & 255, jh = tid >> 8;
    unsigned short v[32];
#pragma unroll
    for (int jj = 0; jj < 32; ++jj) v[jj] = *(const LAS bf16*)(rv + (32 * jh + jj) * 512 + dv * 2);
    LAS unsigned char* row = lds + L_VT + dv * 128; const int f = (dv >> 1) & 7;
#pragma unroll
    for (int q = 0; q < 4; ++q) { v4u w; w.x = v[8 * q] | ((unsigned)v[8 * q + 1] << 16); w.y = v[8 * q + 2] | ((unsigned)v[8 * q + 3] << 16); w.z = v[8 * q + 4] | ((unsigned)v[8 * q + 5] << 16); w.w = v[8 * q + 6] | ((unsigned)v[8 * q + 7] << 16);
        *(LAS v4u*)(row + (((4 * jh + q) ^ f) * 16)) = w; }
}
}

__device__ __forceinline__ void ph_gla_a(const Params& p, LAS unsigned char* lds, int u0, int ustride, int tid_in, int wave) {
    using namespace gla;
    int tid = tid_in; asm volatile("" : "+v"(tid));
    const int lane = tid & 63, c = lane & 15, gq = lane >> 4;
    const bf16* GK = (const bf16*)(p.ws + WS_GK); bf16* ST = (bf16*)(p.ws + WS_ST); float* DEC = (float*)(p.ws + WS_DEC);
    for (int unit = u0; unit < 2048; unit += ustride) {
        const int bh = unit >> 6, ch = unit & 63, b = bh >> 2, h = bh & 3, t0 = b * SEQ + ch * 64;
        stage_raw_k(GK, lds + 0, tid, t0, h); stage_raw_v(p, lds + 16384, tid, t0, h);
        float P[16], blast; chunk_cumsum(p, lds, tid, t0, h, P, blast);
        { const int dk = tid & 127, jq = tid >> 7;
          unsigned short kv[16];
#pragma unroll
          for (int jj = 0; jj < 16; ++jj) kv[jj] = *(const LAS bf16*)(lds + (16 * jq + jj) * 256 + dk * 2);
          unsigned pk[8];
#pragma unroll
          for (int q = 0; q < 8; ++q) pk[q] = pk2(bf2f(kv[2 * q]) * __expf(blast - P[2 * q]), bf2f(kv[2 * q + 1]) * __expf(blast - P[2 * q + 1]));
          LAS unsigned char* row = lds + L_KT + dk * 128; const int f = (dk >> 1) & 7;
          *(LAS v4u*)(row + (((2 * jq) ^ f) * 16)) = (v4u){pk[0], pk[1], pk[2], pk[3]}; *(LAS v4u*)(row + (((2 * jq + 1) ^ f) * 16)) = (v4u){pk[4], pk[5], pk[6], pk[7]};
          if (jq == 0) DEC[unit * 128 + dk] = __expf(blast); }
        fill_vt(lds, lds + 16384, tid);
        __syncthreads();
        f4 acc[16];
        const int f = (c >> 1) & 7;
        bf16x8 aF[2];
#pragma unroll
        for (int ks = 0; ks < 2; ++ks) aF[ks] = *(const LAS bf16x8*)(lds + L_KT + (16 * wave + c) * 128 + (((4 * ks + gq) ^ f) * 16));
#pragma unroll
        for (int nt = 0; nt < 16; ++nt) { acc[nt] = (f4){0.f, 0.f, 0.f, 0.f};
#pragma unroll
            for (int ks = 0; ks < 2; ++ks) { const bf16x8 bF = *(const LAS bf16x8*)(lds + L_VT + (16 * nt + c) * 128 + (((4 * ks + gq) ^ f) * 16)); acc[nt] = __builtin_amdgcn_mfma_f32_16x16x32_bf16(aF[ks], bF, acc[nt], 0, 0, 0); } }
        char* dst = (char*)ST + (size_t)unit * (256 * 128 * 2) + (unsigned)((c * 128 + 16 * wave + 4 * gq) * 2);
#pragma unroll
        for (int nt = 0; nt < 16; ++nt) *(v2u*)(dst + nt * 16 * 256) = (v2u){pg8::cvt_pk_bf16(acc[nt][0], acc[nt][1]), pg8::cvt_pk_bf16(acc[nt][2], acc[nt][3])};
        __syncthreads();
    }
}
__device__ __forceinline__ void ph_gla_b(const Params& p, int gid, int gstride) {
    bf16* ST = (bf16*)(p.ws + WS_ST); const float* DEC = (const float*)(p.ws + WS_DEC);
    for (int e = gid; e < 32 * 4096; e += gstride) { const int bh = e >> 12, dv = (e >> 4) & 255, d8 = e & 15;
        float st[8];
#pragma unroll
        for (int i = 0; i < 8; ++i) st[i] = 0.f;
        char* base = (char*)ST + (size_t)bh * 64 * (256 * 128 * 2) + (unsigned)((dv * 128 + d8 * 8) * 2); const float* dbase = DEC + (size_t)bh * 64 * 128 + d8 * 8;
#pragma unroll 4
        for (int ch = 0; ch < 64; ++ch) { v4u* ptr = (v4u*)(base + (size_t)ch * (256 * 128 * 2)); const v4u w = *ptr; const f32x4 d0 = *(const f32x4*)(dbase + ch * 128), d1 = *(const f32x4*)(dbase + ch * 128 + 4);
            v4u o; o.x = pk2(st[0], st[1]); o.y = pk2(st[2], st[3]); o.z = pk2(st[4], st[5]); o.w = pk2(st[6], st[7]); *ptr = o;
            st[0] = st[0] * d0.x + bflo(w.x); st[1] = st[1] * d0.y + bfhi(w.x); st[2] = st[2] * d0.z + bflo(w.y); st[3] = st[3] * d0.w + bfhi(w.y);
            st[4] = st[4] * d1.x + bflo(w.z); st[5] = st[5] * d1.y + bfhi(w.z); st[6] = st[6] * d1.z + bflo(w.w); st[7] = st[7] * d1.w + bfhi(w.w); }
    }
}
__device__ __forceinline__ void ph_gla_c(const Params& p, LAS unsigned char* lds, int u0, int ustride, int tid_in, int wave) {
    using namespace gla;
    int tid = tid_in; asm volatile("" : "+v"(tid));
    const int lane = tid & 63, c = lane & 15, gq = lane >> 4, nt = wave & 3, half = wave >> 2;
    const bf16* GQ = (const bf16*)(p.ws + WS_GQ); const bf16* GK = (const bf16*)(p.ws + WS_GK); const bf16* GG = (const bf16*)(p.ws + WS_GG); const bf16* ST = (const bf16*)(p.ws + WS_ST);
    bf16* A2 = (bf16*)(p.ws + WS_A2); const float* gn = p.in[I_GLAG];
    const int koff0 = c * 256 + ((gq ^ c) * 16), voff0 = c * 128 + (((gq >> 1) ^ ((c >> 1) & 7)) * 16) + (gq & 1) * 8;
    for (int unit = u0; unit < 2048; unit += ustride) {
        const int bh = unit >> 6, ch = unit & 63, b = bh >> 2, h = bh & 3, t0 = b * SEQ + ch * 64;
        stage_raw_k(GQ, lds + 0, tid, t0, h); stage_raw_k(GK, lds + 16384, tid, t0, h); stage_raw_v(p, lds + 32768, tid, t0, h);
        float P[16], blast; chunk_cumsum(p, lds, tid, t0, h, P, blast);
        { const int dk = tid & 127, jq = tid >> 7;
#pragma unroll
          for (int jj = 0; jj < 16; ++jj) { const int j = 16 * jq + jj; const float qv = bf2f(*(const LAS bf16*)(lds + j * 256 + dk * 2)), kv = bf2f(*(const LAS bf16*)(lds + 16384 + j * 256 + dk * 2));
              const int off = j * 256 + (((dk >> 3) ^ (j & 15)) * 16) + (dk & 7) * 2;
              *(LAS bf16*)(lds + L_QT + off) = (bf16)f2bf(qv * __expf(P[jj])); *(LAS bf16*)(lds + L_KT + off) = (bf16)f2bf(kv * __expf(-P[jj])); } }
        fill_vt(lds, lds + 32768, tid);
        __syncthreads();
        { const char* src = (const char*)ST + (size_t)unit * (256 * 128 * 2);
#pragma unroll
          for (int i = 0; i < 8; ++i) { const int piece = 8 * wave + i, row = piece * 4 + (lane >> 4), chunk = (lane & 15) ^ (row & 15);
              __builtin_amdgcn_global_load_lds((const unsigned*)(src + (unsigned)(row * 256 + chunk * 16)), (LAS unsigned*)(lds + L_ST + piece * 1024), 16, 0, 0); } }
        asm volatile("s_waitcnt vmcnt(0)" ::: "memory"); __syncthreads();
        bf16x8 qF[4];
#pragma unroll
        for (int ks = 0; ks < 4; ++ks) qF[ks] = *(const LAS bf16x8*)(lds + L_QT + nt * 4096 + (koff0 ^ (ks * 64)));
        f4 sT[4];
#pragma unroll
        for (int jt = 0; jt < 4; ++jt) { sT[jt] = (f4){0.f, 0.f, 0.f, 0.f};
            if (jt <= nt) {
#pragma unroll
                for (int ks = 0; ks < 4; ++ks) { const bf16x8 a = *(const LAS bf16x8*)(lds + L_KT + jt * 4096 + (koff0 ^ (ks * 64))); sT[jt] = __builtin_amdgcn_mfma_f32_16x16x32_bf16(a, qF[ks], sT[jt], 0, 0, 0); }
                if (jt == nt) {
#pragma unroll
                    for (int rg = 0; rg < 4; ++rg) if (4 * gq + rg > c) sT[jt][rg] = 0.f; } } }
        bf16x8 pb[2];
#pragma unroll
        for (int s = 0; s < 2; ++s) { v4u w; w.x = pg8::cvt_pk_bf16(sT[2 * s][0], sT[2 * s][1]); w.y = pg8::cvt_pk_bf16(sT[2 * s][2], sT[2 * s][3]); w.z = pg8::cvt_pk_bf16(sT[2 * s + 1][0], sT[2 * s + 1][1]); w.w = pg8::cvt_pk_bf16(sT[2 * s + 1][2], sT[2 * s + 1][3]); pb[s] = __builtin_bit_cast(bf16x8, w); }
        f4 o[8]; float ss = 0.f;
#pragma unroll
        for (int mt = 0; mt < 8; ++mt) { o[mt] = (f4){0.f, 0.f, 0.f, 0.f}; const int rb = 128 * half + 16 * mt;
#pragma unroll
            for (int ks = 0; ks < 4; ++ks) { const bf16x8 a = *(const LAS bf16x8*)(lds + L_ST + rb * 256 + (koff0 ^ (ks * 64))); o[mt] = __builtin_amdgcn_mfma_f32_16x16x32_bf16(a, qF[ks], o[mt], 0, 0, 0); }
#pragma unroll
            for (int s = 0; s < 2; ++s) if (2 * s <= nt) { const v2u lo = *(const LAS v2u*)(lds + L_VT + rb * 128 + (voff0 ^ (s * 64))), hi = *(const LAS v2u*)(lds + L_VT + rb * 128 + (voff0 ^ (s * 64 + 32)));
                o[mt] = __builtin_amdgcn_mfma_f32_16x16x32_bf16(__builtin_bit_cast(bf16x8, (v4u){lo.x, lo.y, hi.x, hi.y}), pb[s], o[mt], 0, 0, 0); }
            ss += (o[mt][0] * o[mt][0] + o[mt][1] * o[mt][1]) + (o[mt][2] * o[mt][2] + o[mt][3] * o[mt][3]); }
        ss = nsa::radd32(nsa::radd16(ss));
        LAS float* red = (LAS float*)(lds + L_RED);
        if (gq == 0) red[half * 64 + 16 * nt + c] = ss;
        __syncthreads();
        const float rstd = 1.f / sqrtf((red[16 * nt + c] + red[64 + 16 * nt + c]) * (1.f / 256.f) + RMS_EPS);
        const int tok = t0 + 16 * nt + c;
#pragma unroll
        for (int mt = 0; mt < 8; ++mt) { const int dv = 128 * half + 16 * mt + 4 * gq; const f32x4 g4 = *(const f32x4*)((const char*)gn + (unsigned)(dv * 4));
            const v2u gg = *(const v2u*)((const char*)GG + (unsigned)((tok * 1024 + h * 256 + dv) * 2));
            const float z0 = bflo(gg.x), z1 = bfhi(gg.x), z2 = bflo(gg.y), z3 = bfhi(gg.y);
            v2u w; w.x = pg8::cvt_pk_bf16(o[mt][0] * rstd * g4.x * (z0 / (1.f + __expf(-z0))), o[mt][1] * rstd * g4.y * (z1 / (1.f + __expf(-z1))));
            w.y = pg8::cvt_pk_bf16(o[mt][2] * rstd * g4.z * (z2 / (1.f + __expf(-z2))), o[mt][3] * rstd * g4.w * (z3 / (1.f + __expf(-z3))));
            *(v2u*)((char*)A2 + (unsigned)((tok * DM + h * 256 + dv) * 2)) = w; }
        __syncthreads();
    }
}

constexpr size_t WS_LH = WS_DEC + (size_t)2048 * 128 * 4;
constexpr size_t WS_PEV = WS_LH + (size_t)2 * 4096 * 256 * 4;
static_assert(WS_PEV + 1024 <= WS_KCMP, "cmp scratch overlay");
struct CmpOrder {
    int c; const bf16 *kc, *vc, *wk, *wv;
    __device__ __forceinline__ bool next(int i, pg8::Unit& u) const { if (i > 0 || c >= 32) return false; u.pm = c & 15; u.pn = 0; u.kind = c >> 4; return true; }
    __device__ __forceinline__ const char* pa(const pg8::Gemm&, const pg8::Unit& u) const { return (const char*)(u.kind ? vc : kc) + (size_t)u.pm * ((size_t)256 * 2048 * 2); }
    __device__ __forceinline__ const char* pb(const pg8::Gemm&, const pg8::Unit& u) const { return (const char*)(u.kind ? wv : wk); }
    __device__ __forceinline__ void a_ready(const pg8::Unit&) const {}
    __device__ __forceinline__ void done(const pg8::Unit&) const {}
};
struct EpiLH {
    static constexpr bool PERM = false, AFTER_DRAIN = false;
    float* LH;
    __device__ __forceinline__ void operator()(const pg8::f32x4 (&acc)[2][2][4][2], const pg8::Unit& u, int wr, int wc, int fr, int fq) const {
        const int row0 = u.kind * 4096 + u.pm * 256 + wr * 64 + fr, col0 = wc * 32 + 4 * fq;
#pragma unroll
        for (int ai = 0; ai < 2; ++ai)
#pragma unroll
            for (int m = 0; m < 4; ++m) { float* rowp = LH + (size_t)(row0 + ai * 128 + m * 16) * 256 + col0;
#pragma unroll
                for (int bj = 0; bj < 2; ++bj)
#pragma unroll
                    for (int n = 0; n < 2; ++n) *(pg8::f32x4*)(rowp + bj * 128 + n * 16) = acc[ai][bj][m][n]; }
    }
};

constexpr size_t PROWS = (size_t)MAXTILES * 256;
constexpr size_t WS_W1Q = WS_W1T;
constexpr size_t WS_W2Q = WS_W1Q + (size_t)NE * 4096 * DM;
constexpr size_t WS_HN8 = WS_W2Q + (size_t)NE * DM * DFF;
constexpr size_t WS_AMAXP = WS_HN8 + (size_t)T * DM;
constexpr size_t WS_WSC1 = WS_AMAXP + PROWS * 64 * 4;
constexpr size_t WS_WSC2 = WS_WSC1 + (size_t)NE * 4096 * 4;
constexpr size_t WS_HSC = WS_WSC2 + (size_t)NE * 2048 * 4;
constexpr size_t WS_ROWSC = WS_HSC + (size_t)T * 4;
constexpr size_t WS_ASC = WS_ROWSC + PROWS * 4;
static_assert(WS_ASC + PROWS * 4 <= WS_XN, "int8 buffers fit in the retired bf16 expert-weight region");
constexpr size_t WS_XG8 = WS_XG;
constexpr size_t WS_ACT8 = WS_XG + PROWS * DM;
constexpr size_t WS_Y = WS_ACT;
static_assert(WS_ACT8 + PROWS * DM <= WS_ACT, "int8 row buffers fit in the retired gathered-row region");

__device__ __forceinline__ unsigned q8(float v) { int q = (int)rintf(v); q = q > 127 ? 127 : (q < -127 ? -127 : q); return (unsigned)q & 0xffu; }
__device__ __forceinline__ unsigned q8x4(float a, float b, float c, float d) { return q8(a) | (q8(b) << 8) | (q8(c) << 16) | (q8(d) << 24); }

constexpr size_t WS_WINQ = WS_WINT;
constexpr size_t WS_WISC = WS_WINT + (size_t)NPT * 256 * DM;
constexpr size_t WS_XN8 = WS_XN;
constexpr size_t WS_XSC = WS_XN + (size_t)T * DM;
constexpr size_t WS_PMAX = WS_HN;
constexpr size_t WS_PMAXI = WS_PMAX + (size_t)64 * 8 * 4096 * 4;

constexpr int NSLAB_E = NE * 192, NSLAB = NSLAB_E + 178;
struct SlabSrc { const float* W; int N; bool ok; };
__device__ __forceinline__ SlabSrc slab_src(const Params& p, int sl, int r0, int n4) {
    SlabSrc s;
    if (sl < NSLAB_E) { const int e = sl / 192, r = sl % 192; const bool isw2 = r >= 128; const int nb = isw2 ? r - 128 : r; s.N = isw2 ? 2048 : 4096;
        s.W = (isw2 ? p.in[I_W2] + (size_t)e * DFF * DM : p.in[I_W1] + (size_t)e * DM * 4096) + (size_t)r0 * s.N + nb * 32 + 4 * n4; s.ok = true; }
    else { const int nb = sl - NSLAB_E; s.N = 5672; s.ok = nb * 32 + 4 * n4 < 5672; s.W = p.in[I_WIN] + (size_t)r0 * 5672 + (s.ok ? nb * 32 + 4 * n4 : 0); }
    return s;
}
__device__ __forceinline__ void p0_slab_quant(const Params& p, LAS unsigned char* lds, int bid, int G, int tid) {
    constexpr int RS = 4104;
    LAS unsigned char* TT = lds; LAS float* part = (LAS float*)(lds + 32 * RS); LAS float* inv = part + 64 * 32; LAS int* drow = (LAS int*)(inv + 32);
    signed char* W1Q = (signed char*)(p.ws + WS_W1Q); signed char* W2Q = (signed char*)(p.ws + WS_W2Q); signed char* WIQ = (signed char*)(p.ws + WS_WINQ);
    float* WSC1 = (float*)(p.ws + WS_WSC1); float* WSC2 = (float*)(p.ws + WS_WSC2); float* WISC = (float*)(p.ws + WS_WISC);
    const int n4 = tid & 7, r0 = tid >> 3;
    f32x4 va[8], vb[8];
#define SLAB_ISSUE(dst, sl, j) do { if ((sl) < NSLAB) { const SlabSrc ss_ = slab_src(p, (sl), r0, n4); _Pragma("unroll") for (int u = 0; u < 8; ++u) dst[u] = __builtin_nontemporal_load((const f32x4*)(ss_.W + (size_t)(64 * (8 * (j) + u)) * ss_.N)); } } while (0)
#define SLAB_USE(src, j) do { _Pragma("unroll") for (int u = 0; u < 8; ++u) { const f32x4 x = sc_.ok ? src[u] : (f32x4){0.f, 0.f, 0.f, 0.f}; const int k = r0 + 64 * (8 * (j) + u); \
            mx.x = fmaxf(mx.x, fabsf(x.x)); mx.y = fmaxf(mx.y, fabsf(x.y)); mx.z = fmaxf(mx.z, fabsf(x.z)); mx.w = fmaxf(mx.w, fabsf(x.w)); \
            LAS unsigned char* d = TT + (4 * n4) * RS + k * 2; \
            *(LAS bf16*)d = (bf16)f2bf(x.x); *(LAS bf16*)(d + RS) = (bf16)f2bf(x.y); *(LAS bf16*)(d + 2 * RS) = (bf16)f2bf(x.z); *(LAS bf16*)(d + 3 * RS) = (bf16)f2bf(x.w); } } while (0)
    SLAB_ISSUE(va, bid, 0); SLAB_ISSUE(vb, bid, 1);
    for (int slab = bid; slab < NSLAB; slab += G) {
        const SlabSrc sc_ = slab_src(p, slab, r0, n4);
        f32x4 mx = (f32x4){0.f, 0.f, 0.f, 0.f};
        SLAB_USE(va, 0); SLAB_ISSUE(va, slab, 2);
        SLAB_USE(vb, 1); SLAB_ISSUE(vb, slab, 3);
        SLAB_USE(va, 2); SLAB_ISSUE(va, slab + G, 0);
        SLAB_USE(vb, 3); SLAB_ISSUE(vb, slab + G, 1);
        { f32x4 t = mx;
#pragma unroll
          for (int o = 8; o < 64; o <<= 1) { t.x = fmaxf(t.x, __shfl_xor(t.x, o)); t.y = fmaxf(t.y, __shfl_xor(t.y, o)); t.z = fmaxf(t.z, __shfl_xor(t.z, o)); t.w = fmaxf(t.w, __shfl_xor(t.w, o)); }
          if ((tid & 63) < 8) *(LAS f32x4*)(part + (tid >> 6) * 32 + 4 * n4) = t; }
        __syncthreads();
        if (tid < 32) { float m = 0.f;
#pragma unroll
            for (int q = 0; q < 8; ++q) m = fmaxf(m, part[q * 32 + tid]);
            const float sc = m > 0.f ? m * (1.f / 127.f) : 1.f; inv[tid] = 1.f / sc;
            if (slab < NSLAB_E) { const int e = slab / 192, r = slab % 192; const bool isw2 = r >= 128; const int n = (isw2 ? r - 128 : r) * 32 + tid;
                if (isw2) { drow[tid] = e * 2048 + n; WSC2[e * 2048 + n] = sc; }
                else { const int j2 = n & 2047, row = (j2 >> 7) * 256 + (n >= 2048 ? 128 : 0) + (j2 & 127); drow[tid] = e * 4096 + row; WSC1[e * 4096 + row] = sc; } }
            else { const int n = (slab - NSLAB_E) * 32 + tid; if (n < 5672) { float qsc; const int row = win_row(n, qsc); drow[tid] = row; WISC[row] = sc * qsc; } else drow[tid] = -1; } }
        __syncthreads();
        { const int kc = tid & 7, n = (tid >> 3) & 31, hf = tid >> 8; const float iv = inv[n]; const int dr = drow[n];
          signed char* dst = (slab < NSLAB_E ? ((slab % 192) >= 128 ? W2Q : W1Q) : WIQ) + (size_t)(dr < 0 ? 0 : dr) * 2048; const LAS unsigned char* src = TT + n * RS;
          if (dr >= 0) {
#pragma unroll
          for (int m8 = 0; m8 < 8; ++m8) { const int k0 = 16 * (kc + 8 * (hf + 2 * m8)); const LAS v2u* sp = (const LAS v2u*)(src + k0 * 2); const v2u a = sp[0], b = sp[1], c = sp[2], d = sp[3]; v4u o;
              o.x = q8x4(bflo(a.x) * iv, bfhi(a.x) * iv, bflo(a.y) * iv, bfhi(a.y) * iv); o.y = q8x4(bflo(b.x) * iv, bfhi(b.x) * iv, bflo(b.y) * iv, bfhi(b.y) * iv);
              o.z = q8x4(bflo(c.x) * iv, bfhi(c.x) * iv, bflo(c.y) * iv, bfhi(c.y) * iv); o.w = q8x4(bflo(d.x) * iv, bfhi(d.x) * iv, bflo(d.y) * iv, bfhi(d.y) * iv);
              *(v4u*)(dst + k0) = o; } } }
        __syncthreads();
    }
#undef SLAB_ISSUE
#undef SLAB_USE
}
struct EpiSwigluI8 {
    static constexpr bool PERM = true, AFTER_DRAIN = false;
    const float* b1; const float* rowsc; const float* wsc1; bf16* act; float* amaxp;
    __device__ __forceinline__ void operator()(const pg8::f32x4 (&acc)[2][2][4][2], const pg8::Unit& u, int wr, int wc, int fr, int fq) const {
        const int e = u.kind; const int cin = wc * 32 + 8 * fq; const int col = u.pn * 128 + cin; const int row0 = u.pm * 256 + wr * 64 + fr;
        const float* bg = b1 + (size_t)e * 4096 + col; const float* bl = bg + 2048; const float* sg = wsc1 + (size_t)e * 4096 + u.pn * 256 + cin; const float* sl = sg + 128;
        float gb[8], lb[8], gs[8], ls[8];
#pragma unroll
        for (int j = 0; j < 8; ++j) { gb[j] = bg[j]; lb[j] = bl[j]; gs[j] = sg[j]; ls[j] = sl[j]; }
#pragma unroll
        for (int ai = 0; ai < 2; ++ai)
#pragma unroll
            for (int m = 0; m < 4; ++m) { const int r = row0 + ai * 128 + m * 16; const float rs = rowsc[r]; float o[8]; float mx = 0.f;
#pragma unroll
                for (int n = 0; n < 2; ++n)
#pragma unroll
                    for (int j = 0; j < 4; ++j) { float gl = (float)__float_as_int(acc[ai][0][m][n][j]) * (rs * gs[n * 4 + j]) + gb[n * 4 + j]; float li = (float)__float_as_int(acc[ai][1][m][n][j]) * (rs * ls[n * 4 + j]) + lb[n * 4 + j];
                        gl = fminf(gl, 7.f); li = fminf(fmaxf(li, -7.f), 7.f);
                        const float v = gl * __builtin_amdgcn_rcpf(1.f + __builtin_amdgcn_exp2f(-2.4554669595930156f * gl)) * (li + 1.f); o[n * 4 + j] = v; mx = fmaxf(mx, fabsf(v)); }
                mx = nsa::rmax32(nsa::rmax16(mx));
                if (fq == 0) amaxp[(size_t)r * 64 + u.pn * 4 + wc] = mx;
                pg8::u32x4 w; w.x = pg8::cvt_pk_bf16(o[0], o[1]); w.y = pg8::cvt_pk_bf16(o[2], o[3]); w.z = pg8::cvt_pk_bf16(o[4], o[5]); w.w = pg8::cvt_pk_bf16(o[6], o[7]);
                *(pg8::u32x4*)(act + (size_t)r * DFF + col) = w; }
    }
};
__device__ __forceinline__ void ph_actq(const Params& p, int gw, int NGW, int lane) {
    const int nrows = ((const int*)(p.ws + WS_META))[0] * 256; const float* amaxp = (const float*)(p.ws + WS_AMAXP); const bf16* act = (const bf16*)(p.ws + WS_ACT);
    signed char* A8 = (signed char*)(p.ws + WS_ACT8); float* ASC = (float*)(p.ws + WS_ASC);
    for (int r = gw; r < nrows; r += NGW) { const float mx = wave_max(amaxp[(size_t)r * 64 + lane]); const float sc = mx > 0.f ? mx * (1.f / 127.f) : 1.f, iv = 1.f / sc;
        const v4u* src = (const v4u*)(act + (size_t)r * DFF) + lane * 4; v4u a[4];
#pragma unroll
        for (int j = 0; j < 4; ++j) a[j] = src[j];
        v4u o[2];
#pragma unroll
        for (int h = 0; h < 2; ++h) { const v4u x = a[2 * h], y = a[2 * h + 1];
            o[h].x = q8x4(bflo(x.x) * iv, bfhi(x.x) * iv, bflo(x.y) * iv, bfhi(x.y) * iv); o[h].y = q8x4(bflo(x.z) * iv, bfhi(x.z) * iv, bflo(x.w) * iv, bfhi(x.w) * iv);
            o[h].z = q8x4(bflo(y.x) * iv, bfhi(y.x) * iv, bflo(y.y) * iv, bfhi(y.y) * iv); o[h].w = q8x4(bflo(y.z) * iv, bfhi(y.z) * iv, bflo(y.w) * iv, bfhi(y.w) * iv); }
        v4u* dst = (v4u*)(A8 + (size_t)r * DFF) + lane * 2; dst[0] = o[0]; dst[1] = o[1];
        if (lane == 0) ASC[r] = sc; }
}
struct EpiDownI8 {
    static constexpr bool PERM = true, AFTER_DRAIN = false;
    const float* b2; const float* roww; const float* asc; const float* wsc2; bf16* y;
    __device__ __forceinline__ void operator()(const pg8::f32x4 (&acc)[2][2][4][2], const pg8::Unit& u, int wr, int wc, int fr, int fq) const {
        const int e = u.kind; const int col0 = u.pn * 256 + wc * 32 + 8 * fq; const int row0 = u.pm * 256 + wr * 64 + fr;
        float bv[2][8], sv[2][8];
#pragma unroll
        for (int bj = 0; bj < 2; ++bj)
#pragma unroll
            for (int j = 0; j < 8; ++j) { bv[bj][j] = b2[(size_t)e * DM + col0 + bj * 128 + j]; sv[bj][j] = wsc2[(size_t)e * DM + col0 + bj * 128 + j]; }
#pragma unroll
        for (int ai = 0; ai < 2; ++ai)
#pragma unroll
            for (int m = 0; m < 4; ++m) { const int r = row0 + ai * 128 + m * 16; const float g = roww[r], as = asc[r];
#pragma unroll
                for (int bj = 0; bj < 2; ++bj) { float o[8];
#pragma unroll
                    for (int n = 0; n < 2; ++n)
#pragma unroll
                        for (int j = 0; j < 4; ++j) o[n * 4 + j] = ((float)__float_as_int(acc[ai][bj][m][n][j]) * (as * sv[bj][n * 4 + j]) + bv[bj][n * 4 + j]) * g;
                    pg8::u32x4 w; w.x = pg8::cvt_pk_bf16(o[0], o[1]); w.y = pg8::cvt_pk_bf16(o[2], o[3]); w.z = pg8::cvt_pk_bf16(o[4], o[5]); w.w = pg8::cvt_pk_bf16(o[6], o[7]);
                    *(pg8::u32x4*)(y + (size_t)r * DM + col0 + bj * 128) = w; } }
    }
};

struct EpiProjI8 {
    static constexpr bool PERM = true, AFTER_DRAIN = false;
    unsigned char* ws;
    __device__ __forceinline__ void operator()(const pg8::f32x4 (&acc)[2][2][4][2], const pg8::Unit& u, int wr, int wc, int fr, int fq) const {
        const int cw = wc * 32 + 8 * fq; const float* XSC = (const float*)(ws + WS_XSC); const float* WISC = (const float*)(ws + WS_WISC);
        if (u.kind == 0) {
            const int tn = u.pn; bf16* base; size_t bjs = 128; int ld = 0; bool headmajor = false; bool small = false;
            if (tn < 2) { base = (bf16*)(ws + WS_GQ) + tn * 256; ld = 512; }
            else if (tn < 4) { base = (bf16*)(ws + WS_GK) + (tn - 2) * 256; ld = 512; }
            else if (tn < 8) { base = (bf16*)(ws + WS_GV) + (tn - 4) * 256; ld = 1024; }
            else if (tn < 12) { base = (bf16*)(ws + WS_GG) + (tn - 8) * 256; ld = 1024; }
            else if (tn < 16) { base = (bf16*)(ws + WS_NQ) + (tn - 12) * 256; ld = 1024; }
            else if (tn < 20) { base = (bf16*)(ws + (tn == 16 ? WS_KC : tn == 17 ? WS_VC : tn == 18 ? WS_KS : WS_KW)); headmajor = true; bjs = (size_t)SEQ * 128; }
            else { base = (bf16*)(ws + WS_SM); ld = 64; small = true; }
            if (small && wc >= 2) return;
            float cs[2][8];
#pragma unroll
            for (int bj = 0; bj < 2; ++bj)
#pragma unroll
                for (int j = 0; j < 8; ++j) cs[bj][j] = WISC[tn * 256 + bj * 128 + cw + j];
#pragma unroll
            for (int ai = 0; ai < 2; ++ai)
#pragma unroll
                for (int m = 0; m < 4; ++m) { const int r = u.pm * 256 + ai * 128 + wr * 64 + m * 16 + fr; const float rs = XSC[r];
                    const size_t rterm = headmajor ? ((size_t)(r >> 12) * 2 * SEQ + (r & (SEQ - 1))) * 128 : (size_t)r * ld;
#pragma unroll
                    for (int bj = 0; bj < 2; ++bj) { if (small && bj) continue; float o[8];
#pragma unroll
                        for (int n = 0; n < 2; ++n)
#pragma unroll
                            for (int j = 0; j < 4; ++j) o[n * 4 + j] = (float)__float_as_int(acc[ai][bj][m][n][j]) * (rs * cs[bj][n * 4 + j]);
                        pg8::u32x4 w; w.x = pg8::cvt_pk_bf16(o[0], o[1]); w.y = pg8::cvt_pk_bf16(o[2], o[3]); w.z = pg8::cvt_pk_bf16(o[4], o[5]); w.w = pg8::cvt_pk_bf16(o[6], o[7]);
                        *(pg8::u32x4*)(base + rterm + bj * bjs + cw) = w; } }
        } else {
            bf16* base = (bf16*)(ws + (u.pn == 21 ? WS_VST : WS_VWT));
#pragma unroll
            for (int ai = 0; ai < 2; ++ai)
#pragma unroll
                for (int m = 0; m < 4; ++m) { const int dh = wr * 64 + m * 16 + fr; const float ws_ = WISC[u.pn * 256 + ai * 128 + dh];
#pragma unroll
                    for (int bj = 0; bj < 2; ++bj) { const int tok = u.pm * 256 + bj * 128 + cw; const int b = tok >> 12, s = tok & (SEQ - 1); float o[8];
                        const pg8::f32x4 x0 = *(const pg8::f32x4*)(XSC + tok), x1 = *(const pg8::f32x4*)(XSC + tok + 4);
#pragma unroll
                        for (int j = 0; j < 4; ++j) { o[j] = (float)__float_as_int(acc[ai][bj][m][0][j]) * (ws_ * x0[j]); o[4 + j] = (float)__float_as_int(acc[ai][bj][m][1][j]) * (ws_ * x1[j]); }
                        pg8::u32x4 w; w.x = pg8::cvt_pk_bf16(o[0], o[1]); w.y = pg8::cvt_pk_bf16(o[2], o[3]); w.z = pg8::cvt_pk_bf16(o[4], o[5]); w.w = pg8::cvt_pk_bf16(o[6], o[7]);
                        *(pg8::u32x4*)(base + ((size_t)(b * 2 + ai) * 128 + dh) * SEQ + s) = w; } }
        }
    }
};

__device__ __forceinline__ void r1_router(const Params& p, LAS unsigned char* lds, int vb, int tid, int wave, int lane) {
    LAS float* rowbuf = (LAS float*)lds;
    LAS float* part = (LAS float*)(lds + 65536);
    LAS int* tk = (LAS int*)(lds + 81920 + wave * 1024);
    LAS int* cntw = (LAS int*)(lds + 90112);
    const float* h = p.out; const float* gf = p.in[I_NFFN]; const float* rw = p.in[I_RW]; const float* rb = p.in[I_RB];
    signed char* HN8 = (signed char*)(p.ws + WS_HN8);
    const int e = lane & 31, eg = tid & 31, dg = tid >> 5; int mycount = 0;
    float rwr[128];
#pragma unroll
    for (int c4 = 0; c4 < 4; ++c4) { unsigned o = (unsigned)((((dg * 128 + c4 * 32) * 32) + eg) * 4); asm volatile("" : "+v"(o));
#pragma unroll
        for (int i = 0; i < 32; ++i) rwr[c4 * 32 + i] = *(const float*)((const char*)rw + o + i * 128); }
    for (int grp = 0; grp < 16; ++grp) { const int t = vb * TPV + grp * 8 + wave;
        { const f32x4* xr = (const f32x4*)(h + (size_t)t * DM) + lane; f32x4 v[8]; float s = 0.f;
#pragma unroll
          for (int j = 0; j < 8; ++j) { v[j] = xr[64 * j]; s += (v[j].x * v[j].x + v[j].y * v[j].y) + (v[j].z * v[j].z + v[j].w * v[j].w); }
          const float rstd = 1.f / sqrtf(wave_sum(s) * (1.f / DM) + RMS_EPS);
          float mxr = 0.f; LAS f32x4* hrow = (LAS f32x4*)(rowbuf + wave * 2048);
#pragma unroll
          for (int j = 0; j < 8; ++j) { const f32x4 g4 = ((const f32x4*)gf)[lane + 64 * j]; f32x4 y; y.x = v[j].x * rstd * g4.x; y.y = v[j].y * rstd * g4.y; y.z = v[j].z * rstd * g4.z; y.w = v[j].w * rstd * g4.w;
              v[j] = y; hrow[lane + 64 * j] = y; mxr = fmaxf(mxr, fmaxf(fmaxf(fabsf(y.x), fabsf(y.y)), fmaxf(fabsf(y.z), fabsf(y.w)))); }
          mxr = wave_max(mxr); const float qs = mxr > 0.f ? mxr * (1.f / 127.f) : 1.f, qi = 1.f / qs;
          unsigned* o4 = (unsigned*)(HN8 + (size_t)t * DM) + lane;
#pragma unroll
          for (int j = 0; j < 8; ++j) o4[64 * j] = q8x4(v[j].x * qi, v[j].y * qi, v[j].z * qi, v[j].w * qi);
          if (lane == 0) ((float*)(p.ws + WS_HSC))[t] = qs; }
        __syncthreads();
        { float acc[8];
#pragma unroll
          for (int tt = 0; tt < 8; ++tt) acc[tt] = 0.f;
#pragma unroll
          for (int i4 = 0; i4 < 32; ++i4) { f32x4 xv[8];
#pragma unroll
              for (int tt = 0; tt < 8; ++tt) xv[tt] = *(const LAS f32x4*)(rowbuf + tt * 2048 + dg * 128 + 4 * i4);
#pragma unroll
              for (int tt = 0; tt < 8; ++tt) acc[tt] += xv[tt].x * rwr[4 * i4] + xv[tt].y * rwr[4 * i4 + 1] + xv[tt].z * rwr[4 * i4 + 2] + xv[tt].w * rwr[4 * i4 + 3];
              if (i4 & 1) asm volatile("" ::: "memory"); }
#pragma unroll
          for (int tt = 0; tt < 8; ++tt) part[(dg * 8 + tt) * 32 + eg] = acc[tt]; }
        __syncthreads();
        { float a = rb[e];
#pragma unroll
          for (int q = 0; q < 16; ++q) a += part[(q * 8 + wave) * 32 + e];
          int rank = 0;
#pragma unroll
          for (int mm = 0; mm < 32; ++mm) { const float lm = __shfl(a, mm); rank += (lm > a || (lm == a && mm < e)) ? 1 : 0; }
          const float mx = wave_max(a); const bool sel = rank < 4;
          const float ex = (sel && lane < 32) ? __expf(a - mx) : 0.f; const float sum = wave_sum(ex);
          if (sel && lane < 32) { LAS int* q = tk + (grp * 4 + rank) * 4; q[0] = e; q[1] = mycount; q[2] = __builtin_bit_cast(int, ex / sum); ++mycount; } }
        __syncthreads();
    }
    if (lane < 32) cntw[wave * 32 + lane] = mycount;
    __syncthreads();
    if (wave == 0 && lane < 32) { int tot = 0; for (int w = 0; w < 8; ++w) tot += cntw[w * 32 + lane]; ((int*)(p.ws + WS_CNT))[vb * 32 + lane] = tot; }
    { const int i = lane >> 2, k = lane & 3; const LAS int* q = tk + (i * 4 + k) * 4; const int ee = q[0]; int base = 0; for (int w = 0; w < wave; ++w) base += cntw[w * 32 + ee];
      const int t = vb * TPV + i * 8 + wave;
      ((int*)(p.ws + WS_EIDX))[t * 4 + k] = ee; ((int*)(p.ws + WS_LRNK))[t * 4 + k] = base + q[1]; ((int*)(p.ws + WS_GATE))[t * 4 + k] = q[2]; }
    __syncthreads();
}
__device__ __forceinline__ void r2_gather(const Params& p, LAS unsigned char* lds, int vb, bool write_meta, int tid, int wave, int lane) {
    LAS int* part_tot = (LAS int*)lds;
    LAS int* part_base = part_tot + 512;
    LAS int* pbase = part_base + 512;
    const int* CNT = (const int*)(p.ws + WS_CNT);
    { const int e = tid & 31, part = tid >> 5; int tot = 0, bs = 0;
      for (int v = part * 16; v < part * 16 + 16; ++v) { const int c = CNT[v * 32 + e]; tot += c; if (v < vb) bs += c; }
      part_tot[part * 32 + e] = tot; part_base[part * 32 + e] = bs; }
    __syncthreads();
    if (tid == 0) { int ps = 0; int* meta = (int*)(p.ws + WS_META); int nt = 0;
        for (int e = 0; e < 32; ++e) { int tot = 0, bs = 0; for (int q = 0; q < 16; ++q) { tot += part_tot[q * 32 + e]; bs += part_base[q * 32 + e]; }
            pbase[e] = ps + bs; const int ntile = (tot + 255) >> 8;
            if (write_meta) for (int q = 0; q < ntile; ++q) meta[64 + nt + q] = e;
            nt += ntile; ps += ntile * 256; }
        if (write_meta) meta[0] = nt; }
    __syncthreads();
    const signed char* HN8 = (const signed char*)(p.ws + WS_HN8); signed char* XG8 = (signed char*)(p.ws + WS_XG8); const float* HSC = (const float*)(p.ws + WS_HSC); float* ROWSC = (float*)(p.ws + WS_ROWSC);
    const int* EIDX = (const int*)(p.ws + WS_EIDX); const int* LRNK = (const int*)(p.ws + WS_LRNK); const float* GATE = (const float*)(p.ws + WS_GATE);
    int* POS = (int*)(p.ws + WS_POS); float* ROWW = (float*)(p.ws + WS_ROWW);
    for (int i0 = 0; i0 < 16; i0 += 4) {
        v4u v0[4], v1[4]; float hs[4]; int ee[4][4], lr[4][4]; float gt[4][4];
#pragma unroll
        for (int u = 0; u < 4; ++u) { const int t = vb * TPV + (i0 + u) * 8 + wave; const v4u* src = (const v4u*)(HN8 + (size_t)t * DM) + lane; v0[u] = src[0]; v1[u] = src[64]; hs[u] = HSC[t];
#pragma unroll
            for (int k = 0; k < 4; ++k) { ee[u][k] = EIDX[t * 4 + k]; lr[u][k] = LRNK[t * 4 + k]; gt[u][k] = GATE[t * 4 + k]; } }
#pragma unroll
        for (int u = 0; u < 4; ++u) { const int t = vb * TPV + (i0 + u) * 8 + wave;
#pragma unroll
            for (int k = 0; k < 4; ++k) { const int pos = pbase[ee[u][k]] + lr[u][k];
                if (lane == 0) { POS[t * 4 + k] = pos; ROWW[pos] = gt[u][k]; ROWSC[pos] = hs[u]; }
                v4u* dst = (v4u*)(XG8 + (size_t)pos * DM) + lane; dst[0] = v0[u]; dst[64] = v1[u]; } } }
    __syncthreads();
}
__device__ __forceinline__ void pf_final(const Params& p, int gw, int NGW, int lane) {
    const bf16* Y = (const bf16*)(p.ws + WS_Y); const int* POS = (const int*)(p.ws + WS_POS); const float* gfin = p.in[I_NFIN];
    for (int t = gw; t < T; t += NGW) {
        f32x4* xr = (f32x4*)(p.out + (size_t)t * DM) + lane; f32x4 v[8];
#pragma unroll
        for (int j = 0; j < 8; ++j) v[j] = xr[64 * j];
#pragma unroll
        for (int k = 0; k < 4; ++k) { const int pos = POS[t * 4 + k]; const v2u* yr = (const v2u*)(Y + (size_t)pos * DM) + lane;
#pragma unroll
            for (int j = 0; j < 8; ++j) { const v2u w = yr[64 * j]; v[j].x += bflo(w.x); v[j].y += bfhi(w.x); v[j].z += bflo(w.y); v[j].w += bfhi(w.y); } }
        float s = 0.f;
#pragma unroll
        for (int j = 0; j < 8; ++j) s += (v[j].x * v[j].x + v[j].y * v[j].y) + (v[j].z * v[j].z + v[j].w * v[j].w);
        const float rstd = 1.f / sqrtf(wave_sum(s) * (1.f / DM) + RMS_EPS);
#pragma unroll
        for (int j = 0; j < 8; ++j) { const f32x4 g4 = ((const f32x4*)gfin)[lane + 64 * j]; f32x4 o; o.x = v[j].x * rstd * g4.x; o.y = v[j].y * rstd * g4.y; o.z = v[j].z * rstd * g4.z; o.w = v[j].w * rstd * g4.w; xr[64 * j] = o; }
    }
}


constexpr int LDS_BYTES = 159744;
constexpr int MISC_OFF = LDS_BYTES - 256;  static_assert(nsa::LDS_END <= MISC_OFF && gla::L_END <= MISC_OFF, "LDS map");
constexpr int CW_BAR = 4096, CW_XL = 16384;
__global__ __launch_bounds__(512, 2) void mega_fwd(Params p) {
    extern __shared__ __attribute__((aligned(16))) unsigned char lds_raw[];
    LAS unsigned char* lds = (LAS unsigned char*)lds_raw;
    const int G = gridDim.x, bid = blockIdx.x, NGW = G * 8;
#define PH_IDS int tid = threadIdx.x; asm volatile("" : "+v"(tid)); const int lane = tid & 63, wave = __builtin_amdgcn_readfirstlane(tid >> 6), gw = bid * 8 + wave; (void)lane; (void)gw;
    for (int u = threadIdx.x; u < 64; u += 512) ((LAS unsigned*)(lds + MISC_OFF))[u] = 0u;
    __syncthreads();
    XcdBarrier bar = xcd_barrier_post((unsigned*)(p.ws + WS_CTL) + CW_BAR, (volatile LAS unsigned*)(lds + MISC_OFF) + 8);
    { PH_IDS; p0_prologue(p, lds, gw, NGW, wave, lane); __syncthreads(); p0_slab_quant(p, lds, bid, G, tid); }
    xcd_barrier(bar);
    { pg8::Gemm g{(const bf16*)(p.ws + WS_XN8), (const bf16*)(p.ws + WS_WINQ), T, NPT * 256, DM / 2};
      ProjOrder S; S.init(T, NPT * 256, G, bid); S.xn = g.A; S.wt = g.Bt; EpiProjI8 E{p.ws};
      pg8::gemm_phase<EpiProjI8, ProjOrder, true, true, true>(lds, g, S, E); }
    xcd_barrier(bar);
    if (bid < 32) {
        pg8::Gemm g{(const bf16*)(p.ws + WS_KC), (const bf16*)(p.ws + WS_WKCT), 4096, 256, 2048};
        CmpOrder S{bid, (const bf16*)(p.ws + WS_KC), (const bf16*)(p.ws + WS_VC), (const bf16*)(p.ws + WS_WKCT), (const bf16*)(p.ws + WS_WVCT)}; EpiLH E{(float*)(p.ws + WS_LH)};
        pg8::gemm_phase<EpiLH, CmpOrder, true, true>(lds, g, S, E);
    } else { PH_IDS; ph_gla_a(p, lds, bid - 32, G - 32, tid, wave); }
    xcd_barrier(bar);
    { PH_IDS; ph_gla_b(p, bid * 512 + tid, G * 512);
      for (int i = bid * 512 + tid; i < 16 * 128; i += G * 512) { const int bgz = i >> 7, dz = i & 127; ((bf16*)(p.ws + WS_KCMP))[((size_t)bgz * 256 + 255) * 128 + dz] = 0; ((bf16*)(p.ws + WS_VCMPT))[((size_t)bgz * 128 + dz) * 256 + 255] = 0; }
      const int ngrp = G * 4, total = 2 * 16 * 255, iters = (total + ngrp - 1) / ngrp; const int grp = tid >> 7;
      for (int it = 0; it < iters; ++it) { int id = it * ngrp + bid * 4 + grp; if (id >= total) id = total - 1;
          ph_cmp_fin_simple(p, (LAS float*)lds + grp * 4352, id, tid & 127, (const float*)(p.ws + WS_LH), (const float*)(p.ws + WS_PEVP)); __syncthreads(); } }
    xcd_barrier(bar);
    { PH_IDS; ph_nsa(p, lds, bid, G, tid, wave); }
    { PH_IDS; __syncthreads(); ph_gla_c(p, lds, bid, G, tid, wave); }
    xcd_barrier(bar);
    { pg8::Gemm g{(const bf16*)(p.ws + WS_A2), (const bf16*)(p.ws + WS_WOT), T, DM, DM};
      pg8::StaticOrder S; S.init(T, DM, G, bid); EpiRes E{p.in[I_X], p.out};
      pg8::gemm_phase<EpiRes, pg8::StaticOrder, true, true>(lds, g, S, E); }
    xcd_barrier(bar);
    { PH_IDS; for (int vb = bid; vb < NVB; vb += G) r1_router(p, lds, vb, tid, wave, lane); }
    xcd_barrier(bar);
    { PH_IDS; for (int vb = bid; vb < NVB; vb += G) r2_gather(p, lds, vb, vb == 0, tid, wave, lane); }
    xcd_barrier(bar);
    { pg8::Gemm g{(const bf16*)(p.ws + WS_XG8), (const bf16*)(p.ws + WS_W1Q), MAXTILES * 256, 4096, DM / 2};
      MoeOrder S; S.init((const int*)(p.ws + WS_META), 16, G, bid); EpiSwigluI8 E{p.in[I_B1], (const float*)(p.ws + WS_ROWSC), (const float*)(p.ws + WS_WSC1), (bf16*)(p.ws + WS_ACT), (float*)(p.ws + WS_AMAXP)};
      pg8::gemm_phase<EpiSwigluI8, MoeOrder, true, true, true>(lds, g, S, E); }
    xcd_barrier(bar);
    { PH_IDS; ph_actq(p, gw, NGW, lane); }
    xcd_barrier(bar);
    { pg8::Gemm g{(const bf16*)(p.ws + WS_ACT8), (const bf16*)(p.ws + WS_W2Q), MAXTILES * 256, DM, DFF / 2};
      MoeOrder S; S.init((const int*)(p.ws + WS_META), 8, G, bid); EpiDownI8 E{p.in[I_B2], (const float*)(p.ws + WS_ROWW), (const float*)(p.ws + WS_ASC), (const float*)(p.ws + WS_WSC2), (bf16*)(p.ws + WS_Y)};
      pg8::gemm_phase<EpiDownI8, MoeOrder, true, true, true>(lds, g, S, E); }
    xcd_barrier(bar);
    { PH_IDS; pf_final(p, gw, NGW, lane); }
}

extern "C" void kernel_launch(void* const* d_in, const int* in_sizes, int n_in, void* d_out, int out_size, void* d_ws, size_t ws_size, hipStream_t stream) {
    static int grid = 0;
    if (grid == 0) {
        if (n_in != N_IN || out_size != T * DM || ws_size < WS_END) { fprintf(stderr, "kernel_launch: unexpected shapes (n_in %d out %d ws %zu need %zu)\n", n_in, out_size, ws_size, (size_t)WS_END); grid = -1; return; }
        int dev = 0, cus = 0, per_cu = 0;
        if (hipGetDevice(&dev) != hipSuccess || hipDeviceGetAttribute(&cus, hipDeviceAttributeMultiprocessorCount, dev) != hipSuccess) { grid = -1; return; }
        if (hipFuncSetAttribute((const void*)mega_fwd, hipFuncAttributeMaxDynamicSharedMemorySize, LDS_BYTES) != hipSuccess) { fprintf(stderr, "kernel_launch: hipFuncSetAttribute failed\n"); grid = -1; return; }
        if (hipOccupancyMaxActiveBlocksPerMultiprocessor(&per_cu, (const void*)mega_fwd, 512, LDS_BYTES) != hipSuccess || per_cu < 1) { fprintf(stderr, "kernel_launch: occupancy query says %d blocks per CU\n", per_cu); }
        (void)hipGetLastError();
        grid = cus;
    }
    if (grid < 0) return;
    if (hipMemsetAsync((char*)d_ws + WS_CTL, 0, CTL_BYTES, stream) != hipSuccess) return;
    Params p{};
    for (int i = 0; i < N_IN; ++i) p.in[i] = (const float*)d_in[i];
    p.out = (float*)d_out; p.ws = (unsigned char*)d_ws;
    hipLaunchKernelGGL(mega_fwd, dim3(grid), dim3(512), LDS_BYTES, stream, p);
}
```

```cpp
#include <hip/hip_runtime.h>
#include <cstdio>
#include <cstdint>
namespace pg8 {
#define PG8_LAS __attribute__((address_space(3)))
typedef unsigned short bf16_t;
typedef short bf16x8 __attribute__((ext_vector_type(8)));
typedef float f32x4 __attribute__((ext_vector_type(4)));
typedef unsigned u32x4 __attribute__((ext_vector_type(4)));
constexpr int BM = 256, BK = 64, HALF = 128, HTB = HALF * BK * 2  , STAGE_BYTES = 8 * HTB, NXCD = 8, WGM = 8;

__host__ __device__ __forceinline__ int lds_byte(int r, int c) { const int st = (r >> 4) * 2 + (c >> 5), rr = r & 15, cc = c & 31, ob = rr * 64 + cc * 2; return st * 1024 + (ob ^ (((ob >> 9) & 1) << 5)); }
__host__ __device__ __forceinline__ void stage_rc(int b, int& R, int& C) { const int st = b / 1024, sb = b % 1024, swz = sb ^ (((sb >> 9) & 1) << 5); R = (st >> 1) * 16 + swz / 64; C = (st & 1) * 32 + (swz % 64) / 2; }
__host__ __device__ __forceinline__ int perm32(int rho) { const int n = rho >> 4, i = rho & 15; return 8 * (i >> 2) + 4 * n + (i & 3); }

struct Unit { int pm, pn, kind; };
struct Gemm { const bf16_t* A; const bf16_t* Bt; int M, N, K; };

template <int WG = WGM> __host__ __device__ __forceinline__ void tile_of(int wgid, int nM, int nN, int& pm, int& pn) {
    const int nwg = nM * nN;
    { const int q = nwg / NXCD, r = nwg % NXCD, xcd = wgid % NXCD, off = wgid / NXCD; wgid = (xcd < r ? xcd * (q + 1) : r * (q + 1) + (xcd - r) * q) + off; }
    const int nig = WG * nN, gid = wgid / nig, fm = gid * WG, gsz = (nM - fm) < WG ? (nM - fm) : WG;
    pm = fm + ((wgid % nig) % gsz); pn = (wgid % nig) / gsz;
}
struct StaticOrder {
    int nM, nN, nwg, G, c;
    __host__ __device__ void init(int M, int N, int G_, int c_) { nM = M / BM; nN = N / BM; nwg = nM * nN; G = G_; c = c_; }
    __device__ __forceinline__ bool next(int i, Unit& u) const {
        const long L = (long)i * G + c; if (L >= nwg) return false;
        tile_of((int)L, nM, nN, u.pm, u.pn); u.kind = 0; return true;
    }
    __device__ __forceinline__ const char* pa(const Gemm& g, const Unit& u) const { return (const char*)g.A + (size_t)u.pm * ((size_t)BM * g.K * 2); }
    __device__ __forceinline__ const char* pb(const Gemm& g, const Unit& u) const { return (const char*)g.Bt + (size_t)u.pn * ((size_t)BM * g.K * 2); }
    __device__ __forceinline__ void a_ready(const Unit&) const {}
    __device__ __forceinline__ void done(const Unit&) const {}
};
__device__ __forceinline__ unsigned cvt_pk_bf16(float lo, float hi) { unsigned r; asm volatile("v_cvt_pk_bf16_f32 %0, %1, %2" : "=v"(r) : "v"(lo), "v"(hi)); return r; }
template <bool I8> __device__ __forceinline__ f32x4 mma16(bf16x8 a, bf16x8 b, f32x4 c) {
    if constexpr (I8) { typedef int i32x4 __attribute__((ext_vector_type(4)));
        return __builtin_bit_cast(f32x4, __builtin_amdgcn_mfma_i32_16x16x64_i8(__builtin_bit_cast(i32x4, a), __builtin_bit_cast(i32x4, b), __builtin_bit_cast(i32x4, c), 0, 0, 0)); }
    else return __builtin_amdgcn_mfma_f32_16x16x32_bf16(a, b, c, 0, 0, 0);
}
template <class Epi, class Sched, bool ALIGN_EPI = false, bool SP2 = false, bool I8 = false>
__device__ __forceinline__ void gemm_phase(PG8_LAS unsigned char* lds, const Gemm g, const Sched& S, const Epi& E) {
    int tid_l = threadIdx.x; asm volatile("" : "+v"(tid_l));
    const int tid = tid_l, wid = __builtin_amdgcn_readfirstlane(tid >> 6), lane = tid & 63, wr = wid >> 2, wc = wid & 3, fr = lane & 15, fq = lane >> 4;
    const int K = g.K, nt = K / BK;
    unsigned voffA[2], voffB[2];
#pragma unroll
    for (int i = 0; i < 2; ++i) { int R, C; stage_rc(tid * 16 + i * 8192, R, C); const int Rb = Epi::PERM ? ((R & ~31) + perm32(R & 31)) : R;
        voffA[i] = (unsigned)(R * K + C) * 2u; voffB[i] = (unsigned)(Rb * K + C) * 2u; }
    const size_t kstep = (size_t)(BK * 2);
    const size_t hstep = (size_t)HALF * K * 2;
    const unsigned ldsw = (unsigned)wid * 1024u;
    const int aoff = lds_byte(wr * 64 + fr, fq * 8), boff = lds_byte(wc * 32 + fr, fq * 8);
#define PG8_SA(b, h) (((b) * 2 + (h)) * HTB)
#define PG8_SB(b, h) ((4 + (b) * 2 + (h)) * HTB)
#define PG8_STAGE(bufoff, gbase, voff) do { _Pragma("unroll") for (int _i = 0; _i < 2; ++_i) \
        __builtin_amdgcn_global_load_lds((const unsigned*)((const char*)(gbase) + (voff)[_i]), (PG8_LAS unsigned*)(lds + (bufoff) + ldsw + _i * 8192), 16, 0, 0); } while (0)
#define PG8_LDA(dst, b, h) do { _Pragma("unroll") for (int m = 0; m < 4; ++m) _Pragma("unroll") for (int k = 0; k < 2; ++k) dst[m][k] = *(const PG8_LAS bf16x8*)(lds + PG8_SA(b, h) + aoff + m * 2048 + k * 1024); } while (0)
#define PG8_LDB(dst, b, h) do { _Pragma("unroll") for (int n = 0; n < 2; ++n) _Pragma("unroll") for (int k = 0; k < 2; ++k) dst[n][k] = *(const PG8_LAS bf16x8*)(lds + PG8_SB(b, h) + boff + n * 2048 + k * 1024); } while (0)
#define PG8_MMA(ai, bj, At, Bt) do { __builtin_amdgcn_s_setprio(1); _Pragma("unroll") for (int m = 0; m < 4; ++m) _Pragma("unroll") for (int n = 0; n < 2; ++n) _Pragma("unroll") for (int k = 0; k < 2; ++k) \
        acc[ai][bj][m][n] = mma16<I8>(Bt[n][k], At[m][k], acc[ai][bj][m][n]); __builtin_amdgcn_s_setprio(0); } while (0)
#define PG8_WAIT_V(n) asm volatile("s_waitcnt vmcnt(" #n ")" ::: "memory")
#define PG8_WAIT_L(n) asm volatile("s_waitcnt lgkmcnt(" #n ")" ::: "memory")
#define PG8_BAR __builtin_amdgcn_s_barrier()
#define PG8_SCHED __builtin_amdgcn_sched_barrier(0)
    Unit cur, nxt; int ui = 0;
    if (!S.next(0, cur)) return;
    f32x4 acc[2][2][4][2];
#pragma unroll
    for (int a = 0; a < 2; ++a)
#pragma unroll
        for (int b = 0; b < 2; ++b)
#pragma unroll
            for (int m = 0; m < 4; ++m)
#pragma unroll
                for (int n = 0; n < 2; ++n) acc[a][b][m][n] = (f32x4){0.f, 0.f, 0.f, 0.f};
    bf16x8 At[4][2], B0[2][2], B1[2][2];
    const char* cA = S.pa(g, cur); const char* cB = S.pb(g, cur);
    S.a_ready(cur);
    if constexpr (SP2) {
        PG8_STAGE(PG8_SB(0, 0), cB, voffB); PG8_STAGE(PG8_SB(0, 1), cB + hstep, voffB); PG8_STAGE(PG8_SA(0, 0), cA, voffA); PG8_STAGE(PG8_SA(0, 1), cA + hstep, voffA);
        if (wr == 1) PG8_BAR;
        PG8_WAIT_V(2); PG8_BAR;
        PG8_STAGE(PG8_SB(1, 0), cB + kstep, voffB); PG8_STAGE(PG8_SA(1, 0), cA + kstep, voffA); PG8_STAGE(PG8_SB(1, 1), cB + hstep + kstep, voffB);
        PG8_WAIT_V(6); PG8_BAR;
    } else {
        PG8_STAGE(PG8_SB(0, 0), cB, voffB); PG8_STAGE(PG8_SA(0, 0), cA, voffA); PG8_STAGE(PG8_SB(0, 1), cB + hstep, voffB); PG8_STAGE(PG8_SA(0, 1), cA + hstep, voffA);
        if (wr == 1) PG8_BAR;
        PG8_WAIT_V(4); PG8_BAR;
        PG8_STAGE(PG8_SB(1, 0), cB + kstep, voffB); PG8_STAGE(PG8_SA(1, 0), cA + kstep, voffA); PG8_STAGE(PG8_SB(1, 1), cB + hstep + kstep, voffB);
        PG8_WAIT_V(6); PG8_BAR;
    }
    for (;;) {
        const bool has_next = S.next(ui + 1, nxt);
        const char* nA = has_next ? S.pa(g, nxt) : cA; const char* nB = has_next ? S.pb(g, nxt) : cB;
        for (int t = 0; t < nt; t += 2) {
            const bool last = (t == nt - 2);
            const char* a1 = cA + (size_t)(t + 1) * kstep;
            const char* a2 = last ? nA : cA + (size_t)(t + 2) * kstep; const char* b2 = last ? nB : cB + (size_t)(t + 2) * kstep;
            const char* a3 = a2 + kstep; const char* b3 = b2 + kstep;
            if (last && has_next) S.a_ready(nxt);
            if constexpr (SP2) {
            PG8_LDB(B0, 0, 0); PG8_LDB(B1, 0, 1); PG8_SCHED; PG8_LDA(At, 0, 0); PG8_STAGE(PG8_SA(1, 1), a1 + hstep, voffA);
            PG8_WAIT_V(8); PG8_WAIT_L(0); PG8_BAR; PG8_MMA(0, 0, At, B0); PG8_MMA(0, 1, At, B1); PG8_BAR; PG8_SCHED;
            PG8_LDA(At, 0, 1); PG8_STAGE(PG8_SB(0, 0), b2, voffB); PG8_STAGE(PG8_SB(0, 1), b2 + hstep, voffB); PG8_STAGE(PG8_SA(0, 0), a2, voffA);
            PG8_WAIT_V(8); PG8_WAIT_L(0); PG8_BAR; PG8_MMA(1, 0, At, B0); PG8_MMA(1, 1, At, B1); PG8_BAR; PG8_SCHED;
            PG8_LDB(B0, 1, 0); PG8_LDB(B1, 1, 1); PG8_SCHED; PG8_LDA(At, 1, 0); PG8_STAGE(PG8_SA(0, 1), a2 + hstep, voffA);
            PG8_WAIT_V(8); PG8_WAIT_L(0); PG8_BAR; PG8_MMA(0, 0, At, B0); PG8_MMA(0, 1, At, B1); PG8_BAR; PG8_SCHED;
            PG8_LDA(At, 1, 1); PG8_STAGE(PG8_SB(1, 0), b3, voffB); PG8_STAGE(PG8_SB(1, 1), b3 + hstep, voffB); PG8_STAGE(PG8_SA(1, 0), a3, voffA);
            PG8_WAIT_V(8); PG8_WAIT_L(0); PG8_BAR; PG8_MMA(1, 0, At, B0); PG8_MMA(1, 1, At, B1); PG8_BAR; PG8_SCHED;
            } else {
            PG8_LDB(B0, 0, 0); PG8_SCHED; PG8_LDA(At, 0, 0); PG8_STAGE(PG8_SA(1, 1), a1 + hstep, voffA);
            PG8_WAIT_L(8); PG8_BAR; PG8_WAIT_L(0); PG8_MMA(0, 0, At, B0); PG8_BAR; PG8_SCHED;
            PG8_LDB(B1, 0, 1); PG8_STAGE(PG8_SB(0, 0), b2, voffB);
            PG8_BAR; PG8_WAIT_L(0); PG8_MMA(0, 1, At, B1); PG8_BAR;
            PG8_LDA(At, 0, 1); PG8_STAGE(PG8_SA(0, 0), a2, voffA);
            PG8_BAR; PG8_WAIT_L(0); PG8_MMA(1, 0, At, B0); PG8_BAR; PG8_SCHED;
            PG8_STAGE(PG8_SB(0, 1), b2 + hstep, voffB);
            PG8_WAIT_V(6); PG8_BAR; PG8_MMA(1, 1, At, B1); PG8_BAR;
            PG8_LDB(B0, 1, 0); PG8_SCHED; PG8_LDA(At, 1, 0); PG8_STAGE(PG8_SA(0, 1), a2 + hstep, voffA);
            PG8_WAIT_L(8); PG8_BAR; PG8_WAIT_L(0); PG8_MMA(0, 0, At, B0); PG8_BAR; PG8_SCHED;
            PG8_LDB(B1, 1, 1); PG8_STAGE(PG8_SB(1, 0), b3, voffB);
            PG8_BAR; PG8_WAIT_L(0); PG8_MMA(0, 1, At, B1); PG8_BAR;
            PG8_LDA(At, 1, 1); PG8_STAGE(PG8_SA(1, 0), a3, voffA);
            PG8_BAR; PG8_WAIT_L(0); PG8_MMA(1, 0, At, B0); PG8_BAR; PG8_SCHED;
            PG8_STAGE(PG8_SB(1, 1), b3 + hstep, voffB);
            PG8_WAIT_V(6); PG8_BAR; PG8_MMA(1, 1, At, B1); PG8_BAR;
            }
        }
        if constexpr (ALIGN_EPI) { if (wr == 0) PG8_BAR; }
        if constexpr (!Epi::AFTER_DRAIN) { E(acc, cur, wr, wc, fr, fq); S.done(cur); }
        if (!has_next) break;
#pragma unroll
        for (int a = 0; a < 2; ++a)
#pragma unroll
            for (int b = 0; b < 2; ++b)
#pragma unroll
                for (int m = 0; m < 4; ++m)
#pragma unroll
                    for (int n = 0; n < 2; ++n) acc[a][b][m][n] = (f32x4){0.f, 0.f, 0.f, 0.f};
        cur = nxt; cA = nA; cB = nB; ++ui;
        if constexpr (ALIGN_EPI) { if (wr == 1) PG8_BAR; }
    }
    PG8_WAIT_V(0);
    if constexpr (!ALIGN_EPI) { if (wr == 0) PG8_BAR; }
    PG8_BAR;
    if constexpr (Epi::AFTER_DRAIN) { E.fused(acc, cur, wr, wc, fr, fq, lds, wid, lane); S.done(cur); }
#undef PG8_SA
#undef PG8_SB
#undef PG8_STAGE
#undef PG8_LDA
#undef PG8_LDB
#undef PG8_MMA
#undef PG8_WAIT_V
#undef PG8_WAIT_L
#undef PG8_BAR
#undef PG8_SCHED
}
}

#define GAS __attribute__((address_space(1)))
#define LAS __attribute__((address_space(3)))
typedef unsigned short bf16;
typedef unsigned v4u __attribute__((ext_vector_type(4)));
typedef unsigned v2u __attribute__((ext_vector_type(2)));
typedef float f32x4 __attribute__((ext_vector_type(4)));
typedef short bf16x8 __attribute__((ext_vector_type(8)));

constexpr int NB = 8, SEQ = 4096, DM = 2048, T = NB * SEQ;
constexpr int NPT = 23;
constexpr int NE = 32, DFF = 2048;
constexpr int MAXTILES = 544;
constexpr float RMS_EPS = 1e-5f;
constexpr int NVB = 256, TPV = T / NVB;

enum { I_X = 0, I_NMIX, I_WIN, I_WA2, I_BA, I_GLAG, I_PEK, I_WK1, I_WK2, I_PEV, I_WV1, I_WV2, I_NSAG, I_RELB, I_WOUT, I_NFFN, I_RW, I_RB, I_W1, I_B1, I_W2, I_B2, I_NFIN, N_IN };

constexpr size_t MiB = 1u << 20;
constexpr size_t al(size_t x) { return (x + 255) & ~(size_t)255; }
constexpr size_t WS_CTL = 0, CTL_BYTES = 1 * MiB;
constexpr size_t WS_CNT = WS_CTL + CTL_BYTES;
constexpr size_t WS_META = WS_CNT + al(NVB * 32 * 4);
constexpr size_t WS_EIDX = WS_META + al((64 + MAXTILES) * 4);
constexpr size_t WS_LRNK = WS_EIDX + al((size_t)T * 4 * 4);
constexpr size_t WS_GATE = WS_LRNK + al((size_t)T * 4 * 4);
constexpr size_t WS_POS = WS_GATE + al((size_t)T * 4 * 4);
constexpr size_t WS_ROWW = WS_POS + al((size_t)T * 4 * 4);
constexpr size_t WS_WINT = al(WS_ROWW + (size_t)MAXTILES * 256 * 4);
constexpr size_t WS_WOT = WS_WINT + (size_t)NPT * 256 * DM * 2;
constexpr size_t WS_WKCT = WS_WOT + (size_t)DM * DM * 2;
constexpr size_t WS_WVCT = WS_WKCT + (size_t)256 * 2048 * 2;
constexpr size_t WS_W1T = WS_WVCT + (size_t)256 * 2048 * 2;
constexpr size_t WS_W2T = WS_W1T + (size_t)NE * 4096 * DM * 2;
constexpr size_t WS_XN = WS_W2T + (size_t)NE * DM * DFF * 2;
constexpr size_t WS_GQ = WS_XN + (size_t)T * DM * 2;
constexpr size_t WS_GK = WS_GQ + (size_t)T * 512 * 2;
constexpr size_t WS_GV = WS_GK + (size_t)T * 512 * 2;
constexpr size_t WS_GG = WS_GV + (size_t)T * 1024 * 2;
constexpr size_t WS_NQ = WS_GG + (size_t)T * 1024 * 2;
constexpr size_t WS_KC = WS_NQ + (size_t)T * 1024 * 2;
constexpr size_t WS_VC = WS_KC + (size_t)T * 256 * 2;
constexpr size_t WS_KS = WS_VC + (size_t)T * 256 * 2;
constexpr size_t WS_KW = WS_KS + (size_t)T * 256 * 2;
constexpr size_t WS_VST = WS_KW + (size_t)T * 256 * 2;
constexpr size_t WS_VWT = WS_VST + (size_t)T * 256 * 2;
constexpr size_t WS_SM = WS_VWT + (size_t)T * 256 * 2;
constexpr size_t WS_LA = WS_SM + (size_t)T * 64 * 2;
constexpr size_t WS_OG = WS_LA + (size_t)T * 512 * 4;
constexpr size_t WS_ON = WS_OG + (size_t)T * 1024 * 4;
constexpr size_t WS_KCMP = WS_ON + (size_t)T * 1024 * 4;
constexpr size_t WS_VCMPT = WS_KCMP + (size_t)16 * 256 * 128 * 2;
constexpr size_t WS_A2 = WS_VCMPT + (size_t)16 * 256 * 128 * 2;
constexpr size_t WS_HN = WS_A2 + (size_t)T * DM * 2;
constexpr size_t WS_XG = WS_HN + (size_t)T * DM * 2;
constexpr size_t WS_ACT = WS_XG + (size_t)MAXTILES * 256 * DM * 2;
constexpr size_t WS_END = WS_ACT + (size_t)MAXTILES * 256 * DFF * 2;

__device__ __forceinline__ unsigned f2bf(float f) { unsigned u = __builtin_bit_cast(unsigned, f); return (u + 0x7fffu + ((u >> 16) & 1u)) >> 16; }
__device__ __forceinline__ unsigned pk2(float lo, float hi) { return f2bf(lo) | (f2bf(hi) << 16); }
__device__ __forceinline__ float bf2f(unsigned short v) { return __builtin_bit_cast(float, (unsigned)v << 16); }
__device__ __forceinline__ float bflo(unsigned w) { return __builtin_bit_cast(float, w << 16); }
__device__ __forceinline__ float bfhi(unsigned w) { return __builtin_bit_cast(float, w & 0xffff0000u); }
__device__ __forceinline__ float wave_sum(float v) {
#pragma unroll
    for (int o = 1; o < 64; o <<= 1) v += __shfl_xor(v, o);
    return v;
}
__device__ __forceinline__ float wave_max(float v) {
#pragma unroll
    for (int o = 1; o < 64; o <<= 1) v = fmaxf(v, __shfl_xor(v, o));
    return v;
}
#define LDS_WAIT() asm volatile("s_waitcnt lgkmcnt(0)" ::: "memory")

__device__ const unsigned char kBucket[128] = {0, 1, 2, 3, 4, 5, 6, 7, 8, 9, 10, 11, 12, 13, 14, 15, 16, 16, 16, 17, 17, 18, 18, 18, 19, 19, 19, 20, 20, 20, 20, 21, 21, 21, 21, 22, 22, 22, 22, 22, 23, 23, 23, 23, 23, 23, 24, 24, 24, 24, 24, 24, 25, 25, 25, 25, 25, 25, 25, 26, 26, 26, 26, 26, 26, 26, 26, 27, 27, 27, 27, 27, 27, 27, 27, 27, 27, 28, 28, 28, 28, 28, 28, 28, 28, 28, 28, 29, 29, 29, 29, 29, 29, 29, 29, 29, 29, 29, 29, 30, 30, 30, 30, 30, 30, 30, 30, 30, 30, 30, 30, 30, 30, 31, 31, 31, 31, 31, 31, 31, 31, 31, 31, 31, 31, 31, 31, 31};

struct Params {
    const float* in[N_IN];
    float* out;
    unsigned char* ws;
};

template <class F>
__device__ __forceinline__ void transpose_item(const float* W, int ldw, int k0, int n0, int nlim, LAS float* scr, int lane, F dst) {
#pragma unroll 8
    for (int i = 0; i < 32; ++i) { const int kk = 2 * i + (lane >> 5); const int n = n0 + (lane & 31); scr[kk * 33 + (lane & 31)] = n < nlim ? W[(size_t)(k0 + kk) * ldw + n] : 0.f; }
    LDS_WAIT(); asm volatile("" ::: "memory");
    const int c = lane & 7;
#pragma unroll
    for (int j = 0; j < 4; ++j) { const int nn = (lane >> 3) + 8 * j; const int n = n0 + nn; const LAS float* s = scr + (8 * c) * 33 + nn;
        bf16* rowp; float sc;
        if (n < nlim && dst(n, rowp, sc)) {
            v4u o; o.x = pk2(s[0 * 33] * sc, s[1 * 33] * sc); o.y = pk2(s[2 * 33] * sc, s[3 * 33] * sc); o.z = pk2(s[4 * 33] * sc, s[5 * 33] * sc); o.w = pk2(s[6 * 33] * sc, s[7 * 33] * sc);
            *(v4u*)(rowp + 8 * c) = o; } }
    LDS_WAIT(); asm volatile("" ::: "memory");
}
__device__ __forceinline__ int win_row(int n, float& sc) {
    sc = 1.f;
    if (n < 512) { sc = 0.08838834764831845f; return n; }
    if (n < 1024) return n;
    if (n < 2048) return n;
    if (n < 3072) return n;
    if (n < 3088) return 5120 + (n - 3072);
    if (n < 4112) { sc = 0.08838834764831845f; return 3072 + (n - 3088); }
    if (n < 4368) return 4096 + (n - 4112);
    if (n < 4624) return 4352 + (n - 4368);
    if (n < 4880) return 4608 + (n - 4624);
    if (n < 5136) return 5376 + (n - 4880);
    if (n < 5392) return 4864 + (n - 5136);
    if (n < 5648) return 5632 + (n - 5392);
    return 5136 + (n - 5648);
}
constexpr size_t WS_PEVP = WS_W2T;
__device__ __forceinline__ void p0_prologue(const Params& p, LAS unsigned char* lds, int gw, int NGW, int wave, int lane) {
    LAS float* scr = (LAS float*)(lds + wave * 16384);
    bf16* WinT = (bf16*)(p.ws + WS_WINT); bf16* WoT = (bf16*)(p.ws + WS_WOT); bf16* WkcT = (bf16*)(p.ws + WS_WKCT); bf16* WvcT = (bf16*)(p.ws + WS_WVCT);
    bf16* W1T = (bf16*)(p.ws + WS_W1T); bf16* W2T = (bf16*)(p.ws + WS_W2T);
    constexpr int I_IN = 32 * 178, I_O = 32 * 64, I_C = 64 * 4, I_E1 = 32 * 128, I_E2 = 32 * 64;
    constexpr int I_PE = 2 * 64;
    constexpr int NITEMS = I_O + 2 * I_C + I_PE;
    (void)I_IN; (void)WinT;
    for (int it = gw; it < NITEMS; it += NGW) {
        int r = it;
        if (r < I_O) { const int kb = r / 64, nb = r % 64, k0 = kb * 64;
            transpose_item(p.in[I_WOUT], DM, k0, nb * 32, DM, scr, lane, [&](int n, bf16*& rowp, float& sc) { sc = 1.f; rowp = WoT + (size_t)n * DM + k0; return true; }); continue; } r -= I_O;
        if (r >= 2 * I_C) { r -= 2 * I_C; const int which = r >> 6, kq = r & 63; const float* pe = p.in[which ? I_PEV : I_PEK] + kq * 64; const float* w1 = p.in[which ? I_WV1 : I_WK1] + (size_t)kq * 64 * 128 + lane;
            float a0 = 0.f, a1 = 0.f;
#pragma unroll
            for (int k = 0; k < 64; ++k) { const float pv = pe[k]; a0 += pv * w1[k * 128]; a1 += pv * w1[k * 128 + 64]; }
            float* dst = (float*)(p.ws + WS_PEVP) + (size_t)(which * 64 + kq) * 128 + lane; dst[0] = a0; dst[64] = a1; continue; }
        { const int which = r / I_C; r %= I_C; const int kb = r / 4, nb = r % 4, k0 = kb * 64;
            bf16* dstm = which ? WvcT : WkcT;
            transpose_item(p.in[which ? I_WV1 : I_WK1], 128, k0, nb * 32, 128, scr, lane, [&](int n, bf16*& rowp, float& sc) { sc = 1.f; rowp = dstm + (size_t)(n + (k0 >= 2048 ? 128 : 0)) * 2048 + (k0 & 2047); return true; }); }
        (void)I_E1; (void)I_E2; (void)W1T; (void)W2T;
    }
    const float* x = p.in[I_X]; const float* gm = p.in[I_NMIX];
    for (int m = gw; m < T; m += NGW) {
        const f32x4* xr = (const f32x4*)(x + (size_t)m * DM) + lane; f32x4 v[8]; float s = 0.f;
#pragma unroll
        for (int j = 0; j < 8; ++j) { v[j] = xr[64 * j]; s += (v[j].x * v[j].x + v[j].y * v[j].y) + (v[j].z * v[j].z + v[j].w * v[j].w); }
        const float rstd = 1.f / sqrtf(wave_sum(s) * (1.f / DM) + RMS_EPS);
        float mxr = 0.f;
#pragma unroll
        for (int j = 0; j < 8; ++j) { const f32x4 g4 = ((const f32x4*)gm)[lane + 64 * j]; v[j].x *= rstd * g4.x; v[j].y *= rstd * g4.y; v[j].z *= rstd * g4.z; v[j].w *= rstd * g4.w;
            mxr = fmaxf(mxr, fmaxf(fmaxf(fabsf(v[j].x), fabsf(v[j].y)), fmaxf(fabsf(v[j].z), fabsf(v[j].w)))); }
        mxr = wave_max(mxr); const float qs = mxr > 0.f ? mxr * (1.f / 127.f) : 1.f, qi = 1.f / qs;
        unsigned* o4 = (unsigned*)(p.ws + WS_XN + (size_t)m * DM) + lane;
#pragma unroll
        for (int j = 0; j < 8; ++j) { const int q0 = (int)rintf(v[j].x * qi), q1 = (int)rintf(v[j].y * qi), q2 = (int)rintf(v[j].z * qi), q3 = (int)rintf(v[j].w * qi);
            o4[64 * j] = ((unsigned)q0 & 0xffu) | (((unsigned)q1 & 0xffu) << 8) | (((unsigned)q2 & 0xffu) << 16) | (((unsigned)q3 & 0xffu) << 24); }
        if (lane == 0) ((float*)(p.ws + WS_XN + (size_t)T * DM))[m] = qs;
    }
}
#define XB_TMO      128
#define XB_XCNT(j)  (256  + 64 * (j))
#define XB_XSUB(j)  (1280 + 64 * (j))
#define XB_XGEN(j)  (2304 + 64 * (j))
#define XB_TOP      3328
#define XB_TOPGEN   3392
#define XCD_BAR_WORDS 3456
#define XB_SPIN_CAP (1u << 18)

__device__ __forceinline__ unsigned xb_ld(unsigned* p)              { return __hip_atomic_load(p, __ATOMIC_RELAXED, __HIP_MEMORY_SCOPE_AGENT); }
__device__ __forceinline__ unsigned xb_add(unsigned* p, unsigned v) { return __hip_atomic_fetch_add(p, v, __ATOMIC_RELAXED, __HIP_MEMORY_SCOPE_AGENT); }
__device__ __forceinline__ unsigned xb_xcc_id() { return (unsigned)__builtin_amdgcn_s_getreg((3 << 11) | 20) & 0xFu; }
#define XB_SPIN(cond, bar) do { unsigned _sp = 0; while (cond) { __builtin_amdgcn_s_sleep(1); \
    if ((++_sp & 255u) == 0u) { if (xb_ld(&(bar)[XB_TMO])) break; if (_sp > XB_SPIN_CAP) { atomicAdd(&(bar)[XB_TMO], 1u); break; } } } } while (0)

struct XcdBarrier {
    unsigned* bar; unsigned x;
    volatile LAS unsigned* st;
};

__device__ __forceinline__ XcdBarrier xcd_barrier_post(unsigned* bar, volatile LAS unsigned* st) {
    XcdBarrier b; b.bar = bar; b.x = xb_xcc_id(); b.st = st;
    if (threadIdx.x == 0) (void)xb_add(&bar[XB_XCNT(b.x)], 1u);
    return b;
}
__device__ __forceinline__ void xcd_barrier_complete(unsigned* bar, unsigned x, unsigned& nloc, unsigned& nx) {
    const unsigned G = gridDim.x * gridDim.y * gridDim.z;
    unsigned sum, cnt, mine, sp = 0u;
    for (;;) {
        sum = 0u; cnt = 0u; mine = 0u;
#pragma unroll
        for (unsigned j = 0; j < 16; ++j) { const unsigned c = xb_ld(&bar[XB_XCNT(j)]); sum += c; cnt += (c > 0u) ? 1u : 0u; mine = (j == x) ? c : mine; }
        if (sum == G) break;
        __builtin_amdgcn_s_sleep(1);
        if ((++sp & 255u) == 0u) { if (xb_ld(&bar[XB_TMO])) break; if (sp > XB_SPIN_CAP) { atomicAdd(&bar[XB_TMO], 1u); break; } }
    }
    nloc = mine > 0u ? mine : 1u; nx = cnt > 0u ? cnt : 1u;
}

__device__ __forceinline__ void xcd_barrier(const XcdBarrier& b) {
    asm volatile("s_waitcnt vmcnt(0)" ::: "memory");
    __syncthreads();
    if (threadIdx.x == 0) {
        unsigned* bar = b.bar;
        __builtin_amdgcn_s_waitcnt(0);
        unsigned nloc = b.st[0], nx = b.st[1];
        if (nloc == 0u) { xcd_barrier_complete(bar, b.x, nloc, nx); b.st[0] = nloc; b.st[1] = nx; }
        const unsigned old = xb_add(&bar[XB_XSUB(b.x)], 1u);
        const unsigned gen = old / nloc;
        if (old + 1u == (gen + 1u) * nloc) {
            __builtin_amdgcn_fence(__ATOMIC_RELEASE, "agent");
            asm volatile("s_waitcnt vmcnt(0)" ::: "memory");
            const unsigned og = xb_add(&bar[XB_TOP], 1u);
            const unsigned tg = og / nx;
            if (og + 1u == (tg + 1u) * nx) xb_add(&bar[XB_TOPGEN], 1u);
            else XB_SPIN(xb_ld(&bar[XB_TOPGEN]) == tg, bar);
            __builtin_amdgcn_fence(__ATOMIC_ACQUIRE, "agent");
            xb_add(&bar[XB_XGEN(b.x)], 1u);
            asm volatile("s_waitcnt vmcnt(0)" ::: "memory");
        } else {
            XB_SPIN(xb_ld(&bar[XB_XGEN(b.x)]) == gen, bar);
            __builtin_amdgcn_fence(__ATOMIC_ACQUIRE, "agent");
            asm volatile("s_waitcnt vmcnt(0)" ::: "memory");
        }
    }
    __syncthreads();
}

struct ProjOrder : pg8::StaticOrder {
    const bf16* xn; const bf16* wt;
    __device__ __forceinline__ bool next(int i, pg8::Unit& u) const { if (!pg8::StaticOrder::next(i, u)) return false; u.kind = (u.pn >= 21) ? 1 : 0; return true; }
    __device__ __forceinline__ const char* pa(const pg8::Gemm& g, const pg8::Unit& u) const { return u.kind ? (const char*)wt + (size_t)u.pn * ((size_t)256 * g.K * 2) : (const char*)xn + (size_t)u.pm * ((size_t)256 * g.K * 2); }
    __device__ __forceinline__ const char* pb(const pg8::Gemm& g, const pg8::Unit& u) const { return u.kind ? (const char*)xn + (size_t)u.pm * ((size_t)256 * g.K * 2) : (const char*)wt + (size_t)u.pn * ((size_t)256 * g.K * 2); }
};
struct EpiRes {
    static constexpr bool PERM = false, AFTER_DRAIN = false;
    const float* x; float* h;
    __device__ __forceinline__ void operator()(const pg8::f32x4 (&acc)[2][2][4][2], const pg8::Unit& u, int wr, int wc, int fr, int fq) const {
        const int row0 = u.pm * 256 + wr * 64 + fr, col0 = u.pn * 256 + wc * 32 + 4 * fq;
#pragma unroll
        for (int ai = 0; ai < 2; ++ai)
#pragma unroll
            for (int m = 0; m < 4; ++m) { const size_t off = (size_t)(row0 + ai * 128 + m * 16) * DM + col0;
#pragma unroll
                for (int bj = 0; bj < 2; ++bj)
#pragma unroll
                    for (int n = 0; n < 2; ++n) { const pg8::f32x4 xv = *(const pg8::f32x4*)(x + off + bj * 128 + n * 16); *(pg8::f32x4*)(h + off + bj * 128 + n * 16) = xv + acc[ai][bj][m][n]; } }
    }
};
struct MoeOrder {
    int nM, nN, nwg, G, c; const int* tile_exp;
    __device__ __forceinline__ void init(const int* meta, int nN_, int G_, int c_) { nM = meta[0]; nN = nN_; nwg = nM * nN; G = G_; c = c_; tile_exp = meta + 64; }
    __device__ __forceinline__ bool next(int i, pg8::Unit& u) const {
        const long L = (long)i * G + c; if (L >= nwg) return false;
        pg8::tile_of<8>((int)L, nM, nN, u.pm, u.pn); u.kind = tile_exp[u.pm]; return true;
    }
    __device__ __forceinline__ const char* pa(const pg8::Gemm& g, const pg8::Unit& u) const { return (const char*)g.A + (size_t)u.pm * ((size_t)256 * g.K * 2); }
    __device__ __forceinline__ const char* pb(const pg8::Gemm& g, const pg8::Unit& u) const { return (const char*)g.Bt + ((size_t)u.kind * nN + u.pn) * ((size_t)256 * g.K * 2); }
    __device__ __forceinline__ void a_ready(const pg8::Unit&) const {}
    __device__ __forceinline__ void done(const pg8::Unit&) const {}
};


__device__ __forceinline__ float gelu_tanh(float x) { const float u = 0.7978845608028654f * (x + 0.044715f * x * x * x); const float e = __expf(2.f * u); return 0.5f * x * (1.f + (1.f - 2.f / (e + 1.f))); }
__device__ __forceinline__ void ph_cmp_fin_simple(const Params& p, LAS float* tl, int id, int n, const float* LHall, const float* PEVall) {
    LAS float* hid = tl + 4096;
    const int which = id / (16 * 255), rem = id % (16 * 255), bg = rem / 255, c = rem % 255;
    const float* w2 = p.in[which ? I_WV2 : I_WK2];
    const float* LH = LHall + ((size_t)which * 4096 + bg * 256) * 256;
    float pev = 0.f;
#pragma unroll 8
    for (int q = 0; q < 64; ++q) pev += PEVall[(size_t)(which * 64 + q) * 128 + n];
    const float a = LH[(size_t)c * 256 + n] + LH[(size_t)(c + 1) * 256 + 128 + n] + pev;
    hid[n] = gelu_tanh(a);
    __syncthreads();
    float o = 0.f;
    for (int m = 0; m < 128; ++m) o += hid[m] * w2[m * 128 + n];
    if (which == 0) ((bf16*)(p.ws + WS_KCMP))[((size_t)bg * 256 + c) * 128 + n] = (bf16)f2bf(o);
    else ((bf16*)(p.ws + WS_VCMPT))[((size_t)bg * 128 + n) * 256 + c] = (bf16)f2bf(o);
}

namespace nsa {
constexpr int KB0 = 0, KB1 = 16384, VB0 = 32768, VB1 = 49152, LUT = 65536;
constexpr int QST = LUT + 4096, IMP = QST + 65536, SELM = IMP + 16384, LDS_END = SELM + 512;
constexpr float LOG2E = 1.4426950408889634f;
typedef float f4 __attribute__((ext_vector_type(4)));

typedef unsigned u2v __attribute__((ext_vector_type(2)));
__device__ __forceinline__ float rmax16(float x) { const unsigned u = __float_as_uint(x); const u2v r = __builtin_amdgcn_permlane16_swap(u, u, false, false); return fmaxf(__uint_as_float(r[0]), __uint_as_float(r[1])); }
__device__ __forceinline__ float rmax32(float x) { const unsigned u = __float_as_uint(x); const u2v r = __builtin_amdgcn_permlane32_swap(u, u, false, false); return fmaxf(__uint_as_float(r[0]), __uint_as_float(r[1])); }
__device__ __forceinline__ float radd16(float x) { const unsigned u = __float_as_uint(x); const u2v r = __builtin_amdgcn_permlane16_swap(u, u, false, false); return __uint_as_float(r[0]) + __uint_as_float(r[1]); }
__device__ __forceinline__ float radd32(float x) { const unsigned u = __float_as_uint(x); const u2v r = __builtin_amdgcn_permlane32_swap(u, u, false, false); return __uint_as_float(r[0]) + __uint_as_float(r[1]); }
__device__ __forceinline__ float raddq(float x) { x += __int_as_float(__builtin_amdgcn_update_dpp(0, __float_as_int(x), 0xB1, 0xF, 0xF, true)); x += __int_as_float(__builtin_amdgcn_update_dpp(0, __float_as_int(x), 0x4E, 0xF, 0xF, true)); return x; }
struct Ctx {
    LAS unsigned char* lds; int tid, lane, wave, c, gq, r;
    int s0, cur;
    const LAS unsigned char* qst;
    int pos0;
    const LAS float* lutrow;
    int koff0, voff0;
    unsigned kdo[2], vdoc[2], vdos[2];
};
__device__ __forceinline__ void dma_k(const Ctx& C, const bf16* kt, LAS unsigned char* kb) {
#pragma unroll
    for (int i = 0; i < 2; ++i) __builtin_amdgcn_global_load_lds((const unsigned*)((const char*)kt + C.kdo[i]), (LAS unsigned*)(kb + (2 * C.wave + i) * 1024), 16, 0, 0); }
__device__ __forceinline__ void dma_v(const Ctx& C, const bf16* vt, const unsigned (&vdo)[2], LAS unsigned char* vb) {
#pragma unroll
    for (int i = 0; i < 2; ++i) __builtin_amdgcn_global_load_lds((const unsigned*)((const char*)vt + vdo[i]), (LAS unsigned*)(vb + (2 * C.wave + i) * 1024), 16, 0, 0); }

__device__ __forceinline__ void compute_st(const Ctx& C, const LAS unsigned char* kb, f4 (&s)[2][4]) {
#pragma unroll
    for (int ks = 0; ks < 4; ++ks) { const bf16x8 q0 = *(const LAS bf16x8*)(C.qst + ks * 1024), q1 = *(const LAS bf16x8*)(C.qst + (4 + ks) * 1024);
#pragma unroll
        for (int kt = 0; kt < 4; ++kt) { const bf16x8 a = *(const LAS bf16x8*)(kb + kt * 4096 + (C.koff0 ^ (ks * 64)));
            s[0][kt] = __builtin_amdgcn_mfma_f32_16x16x32_bf16(a, q0, ks == 0 ? (f4){0.f, 0.f, 0.f, 0.f} : s[0][kt], 0, 0, 0);
            s[1][kt] = __builtin_amdgcn_mfma_f32_16x16x32_bf16(a, q1, ks == 0 ? (f4){0.f, 0.f, 0.f, 0.f} : s[1][kt], 0, 0, 0); }
        asm volatile("" ::: "memory"); }
}
__device__ __forceinline__ void compute_pv(const Ctx& C, const LAS unsigned char* vb, const f4 (&p)[2][4], f4 (&o)[2][8]) {
#pragma unroll
    for (int i = 0; i < 2; ++i) { bf16x8 pb[2];
#pragma unroll
        for (int qt = 0; qt < 2; ++qt) { v4u w; w.x = pg8::cvt_pk_bf16(p[qt][2 * i][0], p[qt][2 * i][1]); w.y = pg8::cvt_pk_bf16(p[qt][2 * i][2], p[qt][2 * i][3]);
            w.z = pg8::cvt_pk_bf16(p[qt][2 * i + 1][0], p[qt][2 * i + 1][1]); w.w = pg8::cvt_pk_bf16(p[qt][2 * i + 1][2], p[qt][2 * i + 1][3]); pb[qt] = __builtin_bit_cast(bf16x8, w); }
#pragma unroll
        for (int dt = 0; dt < 8; ++dt) { const v2u lo = *(const LAS v2u*)(vb + dt * 2048 + (C.voff0 ^ (i * 64))), hi = *(const LAS v2u*)(vb + dt * 2048 + (C.voff0 ^ (i * 64 + 32))); const bf16x8 a = __builtin_bit_cast(bf16x8, (v4u){lo.x, lo.y, hi.x, hi.y});
#pragma unroll
            for (int qt = 0; qt < 2; ++qt) o[qt][dt] = __builtin_amdgcn_mfma_f32_16x16x32_bf16(a, pb[qt], o[qt][dt], 0, 0, 0);
            if (dt & 1) asm volatile("" ::: "memory"); } }
}
enum { M_CMP = 0, M_SEL = 1, M_WIN = 2 };
template <int MODE, bool FAR = false>
__device__ __forceinline__ void mask_bias(const Ctx& C, f4 (&s)[2][4], int kb, int n, const LAS unsigned* selw) {
    const float NEG = -__builtin_inff();
#pragma unroll
    for (int qt = 0; qt < 2; ++qt) {
        bool tokok = true;
        if (MODE == M_SEL) tokok = ((selw[(4 * qt + (C.c >> 2)) * 2 + (n >> 5)] >> (n & 31)) & 1u) != 0u;
        if (FAR) { const float be = tokok ? C.lutrow[127] : NEG;
#pragma unroll
            for (int kt = 0; kt < 4; ++kt)
#pragma unroll
                for (int rg = 0; rg < 4; ++rg) s[qt][kt][rg] = __builtin_fmaf(s[qt][kt][rg], LOG2E, be);
            continue; }
        const int dbase = (MODE == M_CMP) ? (C.pos0 + 4 * qt - 31 - 16 * (kb + 4 * C.gq)) : (C.pos0 + 4 * qt - (kb + 4 * C.gq));
#pragma unroll
        for (int kt = 0; kt < 4; ++kt) {
#pragma unroll
            for (int rg = 0; rg < 4; ++rg) { const int d = (MODE == M_CMP) ? dbase - 16 * (16 * kt + rg) : dbase - (16 * kt + rg);
                int di = d < 0 ? 0 : d; di = di > 127 ? 127 : di; const float bias = C.lutrow[di];
                bool ok = tokok && d >= 0; if (MODE == M_WIN) ok = ok && d < 512;
                s[qt][kt][rg] = ok ? __builtin_fmaf(s[qt][kt][rg], LOG2E, bias) : NEG; }
            asm volatile("" ::: "memory"); }
    }
}
__device__ __forceinline__ void softmax_step(f4 (&s)[2][4], float (&m)[2], float (&l)[2], f4 (&o)[2][8], bool rescale_o) {
#pragma unroll
    for (int qt = 0; qt < 2; ++qt) { float mx = s[qt][0][0];
#pragma unroll
        for (int kt = 0; kt < 4; ++kt)
#pragma unroll
            for (int rg = 0; rg < 4; ++rg) mx = fmaxf(mx, s[qt][kt][rg]);
        mx = rmax32(rmax16(mx));
        const float mn = fmaxf(m[qt], mx), alpha = __builtin_amdgcn_exp2f(m[qt] - mn); m[qt] = mn; float ps = 0.f;
#pragma unroll
        for (int kt = 0; kt < 4; ++kt)
#pragma unroll
            for (int rg = 0; rg < 4; ++rg) { const float e = __builtin_amdgcn_exp2f(s[qt][kt][rg] - mn); s[qt][kt][rg] = e; ps += e; }
        l[qt] = l[qt] * alpha + ps;
        if (rescale_o && __any(alpha != 1.f)) {
#pragma unroll
            for (int dt = 0; dt < 8; ++dt) o[qt][dt] = o[qt][dt] * alpha; }
    }
}
template <int MODE>
__device__ __forceinline__ void softmax_far(const Ctx& C, f4 (&s)[2][4], int n, const LAS unsigned* selw, float (&m)[2], float (&l)[2], f4 (&o)[2][8]) {
    const float b31 = C.lutrow[127];
#pragma unroll
    for (int qt = 0; qt < 2; ++qt) {
        float be = b31;
        if (MODE == M_SEL) { const bool tokok = ((selw[(4 * qt + (C.c >> 2)) * 2 + (n >> 5)] >> (n & 31)) & 1u) != 0u; be = tokok ? b31 : -__builtin_inff(); }
        float mx = fmaxf(fmaxf(s[qt][0][0], s[qt][0][1]), fmaxf(s[qt][0][2], s[qt][0][3]));
#pragma unroll
        for (int kt = 1; kt < 4; ++kt) mx = fmaxf(mx, fmaxf(fmaxf(s[qt][kt][0], s[qt][kt][1]), fmaxf(s[qt][kt][2], s[qt][kt][3])));
        mx = rmax32(rmax16(mx));
        const float mt = __builtin_fmaf(mx, LOG2E, be), mn = fmaxf(m[qt], mt), alpha = __builtin_amdgcn_exp2f(m[qt] - mn), c0 = be - mn; m[qt] = mn; float ps = 0.f;
#pragma unroll
        for (int kt = 0; kt < 4; ++kt)
#pragma unroll
            for (int rg = 0; rg < 4; ++rg) { const float e = __builtin_amdgcn_exp2f(__builtin_fmaf(s[qt][kt][rg], LOG2E, c0)); s[qt][kt][rg] = e; ps += e; }
        l[qt] = l[qt] * alpha + ps;
        if (__any(alpha != 1.f)) {
#pragma unroll
            for (int dt = 0; dt < 8; ++dt) o[qt][dt] = o[qt][dt] * alpha; }
    }
}
}

__device__ __forceinline__ void ph_nsa(const Params& p, LAS unsigned char* lds, int idx0, int idxstride, int tid_in, int wave) {
    using namespace nsa;
    int tid = tid_in; asm volatile("" : "+v"(tid));
    const int lane = tid & 63;
    Ctx C; C.lds = lds; C.tid = tid; C.lane = lane; C.wave = wave; C.c = lane & 15; C.gq = lane >> 4; C.r = lane & 3;
    C.koff0 = C.c * 256 + ((C.gq ^ C.c) * 16);
#pragma unroll
    for (int i = 0; i < 2; ++i) { const int piece = 2 * wave + i;
        { const int row = piece * 4 + (lane >> 4), chunk = (lane & 15) ^ (row & 15); C.kdo[i] = (unsigned)(row * 256 + chunk * 16); }
        { const int row = piece * 8 + (lane >> 3), chunk = (lane & 7) ^ ((row >> 1) & 7); C.vdoc[i] = (unsigned)(row * 256 * 2 + chunk * 16); C.vdos[i] = (unsigned)(row * SEQ * 2 + chunk * 16); } }
    C.voff0 = C.c * 128 + (((C.gq >> 1) ^ ((C.c >> 1) & 7)) * 16) + (C.gq & 1) * 8;
    const bf16* NQ = (const bf16*)(p.ws + WS_NQ); const bf16* SM = (const bf16*)(p.ws + WS_SM); bf16* A2 = (bf16*)(p.ws + WS_A2);
    const float* relb = p.in[I_RELB]; const float* nsag = p.in[I_NSAG];
    LAS float* lut = (LAS float*)(lds + LUT);
    for (int i = tid; i < 8 * 128; i += 512) { const int hh = i >> 7, d = i & 127; lut[i] = relb[(int)kBucket[d] * 8 + hh] * LOG2E; }
    __syncthreads();
    LAS unsigned char* qstw = lds + QST + wave * 8192 + lane * 16; C.qst = qstw;
    LAS float* imp = (LAS float*)(lds + IMP + wave * 2048);
    LAS unsigned long long* selm = (LAS unsigned long long*)(lds + SELM + wave * 64);
#define NSA_SYNC() do { asm volatile("s_waitcnt vmcnt(0)" ::: "memory"); __syncthreads(); } while (0)
    for (int idx = idx0; idx < 512; idx += idxstride) {
        const int rnd = idx >> 8, kq = idx & 255, b = kq & 7, tq = rnd == 0 ? 63 - (kq >> 3) : (kq >> 3);
        C.s0 = tq * 64; C.cur = tq;
        const int tokl0 = 8 * wave + (C.c >> 2);
        C.pos0 = C.s0 + tokl0;
        float ssq[2] = {0.f, 0.f};
        for (int g = 0; g < 2; ++g) {
            const int bg = b * 2 + g, h = g * 4 + C.r;
            C.lutrow = lut + h * 128;
            const bf16* KCMP = (const bf16*)(p.ws + WS_KCMP) + (size_t)bg * 256 * 128; const bf16* VCMPT = (const bf16*)(p.ws + WS_VCMPT) + (size_t)bg * 128 * 256;
#pragma unroll
            for (int qt = 0; qt < 2; ++qt) { const unsigned qo = (unsigned)(((b * SEQ + (C.pos0 + 4 * qt)) * 1024 + h * 128 + 8 * C.gq) * 2);
#pragma unroll
                for (int ks = 0; ks < 4; ++ks) *(LAS bf16x8*)(qstw + (qt * 4 + ks) * 1024) = *(const bf16x8*)((const char*)NQ + qo + ks * 64); }
#pragma unroll
            for (int i = 0; i < 2; ++i) *(LAS f32x4*)((LAS unsigned char*)imp + lane * 16 + i * 1024) = (f32x4){0.f, 0.f, 0.f, 0.f};
#define NSA_OROW(qt) ((char*)A2 + (unsigned)(((b * SEQ + C.pos0 + 4 * (qt)) * DM + 1024 + h * 128 + 4 * C.gq) * 2))
            const int cmaxb = C.s0 + 63 - 31; const int nct = cmaxb >= 0 ? ((cmaxb >> 4) >> 6) + 1 : 0;
            float m[2] = {-1e30f, -1e30f}, l[2] = {0.f, 0.f};
            f4 o[2][8];
            if (nct > 0) {
                dma_k(C, KCMP, lds + KB0); NSA_SYNC();
                for (int ct = 0; ct < nct; ++ct) { const int buf = ct & 1;
                    if (ct + 1 < nct) dma_k(C, KCMP + (ct + 1) * 64 * 128, lds + (buf ? KB0 : KB1));
                    f4 s[2][4]; compute_st(C, lds + (buf ? KB1 : KB0), s); mask_bias<M_CMP>(C, s, 64 * ct, 0, (const LAS unsigned*)selm); softmax_step(s, m, l, o, false);
                    NSA_SYNC(); }
            }
            float inv[2];
#pragma unroll
            for (int qt = 0; qt < 2; ++qt) { const float lt = radd32(radd16(l[qt])); inv[qt] = lt > 0.f ? 1.f / lt : 0.f; }
#pragma unroll
            for (int qt = 0; qt < 2; ++qt)
#pragma unroll
                for (int dt = 0; dt < 8; ++dt) o[qt][dt] = (f4){0.f, 0.f, 0.f, 0.f};
            if (nct > 0) {
                dma_k(C, KCMP, lds + KB0); dma_v(C, VCMPT, C.vdoc, lds + VB0); NSA_SYNC();
                for (int ct = 0; ct < nct; ++ct) { const int buf = ct & 1;
                    if (ct + 1 < nct) { dma_k(C, KCMP + (ct + 1) * 64 * 128, lds + (buf ? KB0 : KB1)); dma_v(C, VCMPT + 64 * (ct + 1), C.vdoc, lds + (buf ? VB0 : VB1)); }
                    f4 s[2][4]; compute_st(C, lds + (buf ? KB1 : KB0), s); mask_bias<M_CMP>(C, s, 64 * ct, 0, (const LAS unsigned*)selm);
#pragma unroll
                    for (int qt = 0; qt < 2; ++qt)
#pragma unroll
                        for (int kt = 0; kt < 4; ++kt) {
#pragma unroll
                            for (int rg = 0; rg < 4; ++rg) s[qt][kt][rg] = __builtin_amdgcn_exp2f(s[qt][kt][rg] - m[qt]) * inv[qt];
                            float po = (s[qt][kt][0] + s[qt][kt][1]) + (s[qt][kt][2] + s[qt][kt][3]), p3 = s[qt][kt][3];
                            po = raddq(po); p3 = raddq(p3);
                            const int nb = 16 * ct + 4 * kt + C.gq, tl = 4 * qt + (C.c >> 2);
                            if (C.r == 0) { __hip_atomic_fetch_add((float*)(imp + tl * 64 + nb), po, __ATOMIC_RELAXED, __HIP_MEMORY_SCOPE_WORKGROUP); if (nb + 1 < 64) __hip_atomic_fetch_add((float*)(imp + tl * 64 + nb + 1), p3, __ATOMIC_RELAXED, __HIP_MEMORY_SCOPE_WORKGROUP); } }
                    compute_pv(C, lds + (buf ? VB1 : VB0), s, o);
                    NSA_SYNC(); }
            }
            LDS_WAIT(); __builtin_amdgcn_wave_barrier();
            for (int tk = 0; tk < 8; ++tk) { const int n = lane; float sc;
                if (n == 0 || n == C.cur || n == C.cur - 1) sc = 1e4f; else if (n <= C.cur) sc = imp[tk * 64 + n]; else sc = -1.f;
                const int key = ((sc < 0.f ? 0 : __float_as_int(sc) + 64) & ~63) | (63 - n);
                int rank = 0;
#pragma unroll
                for (int mm = 0; mm < 64; ++mm) rank += (__builtin_amdgcn_readlane(key, mm) > key) ? 1 : 0;
                const unsigned long long mk = __ballot(rank < 16);
                if (lane == 0) selm[tk] = mk; }
            LDS_WAIT(); __builtin_amdgcn_wave_barrier();
#pragma unroll
            for (int qt = 0; qt < 2; ++qt) { const float gt = 1.f / (1.f + __expf(-bf2f(*(const bf16*)((const char*)SM + (unsigned)(((b * SEQ + (C.pos0 + 4 * qt)) * 64 + 16 + h) * 2)))));
#pragma unroll
                for (int dt = 0; dt < 8; ++dt) { const f4 v = o[qt][dt] * gt; *(v2u*)(NSA_OROW(qt) + 32 * dt) = (v2u){pg8::cvt_pk_bf16(v[0], v[1]), pg8::cvt_pk_bf16(v[2], v[3])}; } }
#pragma unroll
            for (int br = 1; br <= 2; ++br) {
                const bf16* KX = (const bf16*)(p.ws + (br == 1 ? WS_KS : WS_KW)) + bg * SEQ * 128; const bf16* VX = (const bf16*)(p.ws + (br == 1 ? WS_VST : WS_VWT)) + bg * 128 * SEQ;
                const int n0 = br == 1 ? 0 : (C.cur >= 8 ? C.cur - 8 : 0), n1 = C.cur;
                m[0] = m[1] = -1e30f; l[0] = l[1] = 0.f;
#pragma unroll
                for (int qt = 0; qt < 2; ++qt)
#pragma unroll
                    for (int dt = 0; dt < 8; ++dt) o[qt][dt] = (f4){0.f, 0.f, 0.f, 0.f};
                int f0 = n1 + 1, f1 = n0 - 1;
                for (int n = n0; n <= n1; ++n) { const bool fa = (C.s0 - (64 * n + 63) >= 113) && (br == 1 || (C.s0 + 63 - 64 * n) < 512); if (fa) { f0 = n < f0 ? n : f0; f1 = n; } }
                const int cntf = f1 >= f0 ? f1 - f0 + 1 : 0, cnt = n1 - n0 + 1, nlo = cntf ? f0 - n0 : cnt;
#define NSA_TILE(i) ((i) < cntf ? f0 + (i) : (((i) - cntf) < nlo ? n0 + ((i) - cntf) : f1 + 1 + ((i) - cntf - nlo)))
#define NSA_BODY(FARF) { const int n = NSA_TILE(i); const int buf = i & 1; \
                    if (i + 1 < cnt) { const int nn = NSA_TILE(i + 1); dma_k(C, KX + nn * 64 * 128, lds + (buf ? KB0 : KB1)); dma_v(C, VX + 64 * nn, C.vdos, lds + (buf ? VB0 : VB1)); } \
                    bool need = true; \
                    if (br == 1) { const unsigned any = ((const LAS unsigned*)selm)[(lane & 7) * 2 + (n >> 5)] >> (n & 31); need = __any((int)(any & 1u)); } \
                    if (need) { f4 s[2][4]; compute_st(C, lds + (buf ? KB1 : KB0), s); \
                        if (FARF) { if (br == 1) softmax_far<M_SEL>(C, s, n, (const LAS unsigned*)selm, m, l, o); else softmax_far<M_WIN>(C, s, n, (const LAS unsigned*)selm, m, l, o); } \
                        else { if (br == 1) mask_bias<M_SEL, false>(C, s, 64 * n, n, (const LAS unsigned*)selm); else mask_bias<M_WIN, false>(C, s, 64 * n, n, (const LAS unsigned*)selm); \
                            softmax_step(s, m, l, o, true); } \
                        compute_pv(C, lds + (buf ? VB1 : VB0), s, o); } \
                    NSA_SYNC(); }
                { const int nf = NSA_TILE(0); dma_k(C, KX + nf * 64 * 128, lds + KB0); dma_v(C, VX + 64 * nf, C.vdos, lds + VB0); NSA_SYNC(); }
                int i = 0;
                for (; i < cntf; ++i) NSA_BODY(true)
                for (; i < cnt; ++i) NSA_BODY(false)
#undef NSA_BODY
#undef NSA_TILE
                asm volatile("s_waitcnt vmcnt(0)" ::: "memory");
#pragma unroll
                for (int qt = 0; qt < 2; ++qt) { const float lt = radd32(radd16(l[qt]));
                    const int row = b * SEQ + (C.pos0 + 4 * qt);
                    const float sc = (1.f / (1.f + __expf(-bf2f(*(const bf16*)((const char*)SM + (unsigned)((row * 64 + 16 + 8 * br + h) * 2)))))) / lt;
#pragma unroll
                    for (int dt = 0; dt < 8; ++dt) { const f4 v = o[qt][dt] * sc; v2u* sp = (v2u*)(NSA_OROW(qt) + 32 * dt); const v2u pv = *sp;
                        const float a0 = bflo(pv.x) + v[0], a1 = bfhi(pv.x) + v[1], a2 = bflo(pv.y) + v[2], a3 = bfhi(pv.y) + v[3];
                        if (br == 2) ssq[qt] += (a0 * a0 + a1 * a1) + (a2 * a2 + a3 * a3);
                        *sp = (v2u){pg8::cvt_pk_bf16(a0, a1), pg8::cvt_pk_bf16(a2, a3)}; } }
            }
        }
        float rstd[2];
#pragma unroll
        for (int qt = 0; qt < 2; ++qt) { const float t = radd32(radd16(raddq(ssq[qt]))); rstd[qt] = 1.f / sqrtf(t * (1.f / 1024.f) + RMS_EPS); }
        asm volatile("s_waitcnt vmcnt(0)" ::: "memory");
#pragma unroll
        for (int qt = 0; qt < 2; ++qt) { const int sub = C.r * 4 + C.gq; bf16* orow = (bf16*)((char*)A2 + (unsigned)(((b * SEQ + (C.pos0 + 4 * qt)) * DM + 1024) * 2 + sub * 16)); const int subz = 0;
#pragma unroll
            for (int j = 0; j < 8; ++j) { const int col = (j * 16 + subz) * 8; v4u w = *(const v4u*)((const char*)orow + (unsigned)(col * 2)); const f32x4 g0 = *(const f32x4*)((const char*)nsag + (unsigned)(col * 4 + sub * 32)), g1 = *(const f32x4*)((const char*)nsag + (unsigned)(col * 4 + sub * 32 + 16)); const float rs = rstd[qt];
                w.x = pk2(bflo(w.x) * rs * g0.x, bfhi(w.x) * rs * g0.y); w.y = pk2(bflo(w.y) * rs * g0.z, bfhi(w.y) * rs * g0.w); w.z = pk2(bflo(w.z) * rs * g1.x, bfhi(w.z) * rs * g1.y); w.w = pk2(bflo(w.w) * rs * g1.z, bfhi(w.w) * rs * g1.w);
                *(v4u*)((char*)orow + (unsigned)(col * 2)) = w; } }
        NSA_SYNC();
    }
#undef NSA_SYNC
#undef NSA_OROW
}

constexpr size_t WS_ST = WS_LA;
constexpr size_t WS_DEC = WS_ST + (size_t)2048 * 256 * 128 * 2;
static_assert(WS_DEC + (size_t)2048 * 128 * 4 <= WS_KCMP, "gla scratch overlay");
namespace gla {
typedef float f4 __attribute__((ext_vector_type(4)));
constexpr int L_ST = 0, L_KT = 65536, L_QT = 81920, L_VT = 98304, L_GA = 131072, L_GT = L_GA + 4096, L_RED = L_GT + 2048, L_END = L_RED + 512;
__device__ __forceinline__ void chunk_cumsum(const Params& p, LAS unsigned char* lds, int tid, int t0, int h, float (&P)[16], float& blast) {
    const bf16* SM = (const bf16*)(p.ws + WS_SM); const float* wa2 = p.in[I_WA2]; const float* ba = p.in[I_BA];
    LAS float* ga = (LAS float*)(lds + L_GA); LAS float* gt = (LAS float*)(lds + L_GT);
    if (tid < 128) { const int j = tid >> 1, hf = tid & 1; const v4u w = *(const v4u*)((const char*)SM + (unsigned)(((t0 + j) * 64 + hf * 8) * 2));
        LAS float* d = ga + j * 16 + hf * 8; d[0] = bflo(w.x); d[1] = bfhi(w.x); d[2] = bflo(w.y); d[3] = bfhi(w.y); d[4] = bflo(w.z); d[5] = bfhi(w.z); d[6] = bflo(w.w); d[7] = bfhi(w.w); }
    const int dk = tid & 127, jq = tid >> 7;
    float w[16];
#pragma unroll
    for (int r = 0; r < 16; ++r) w[r] = wa2[r * 512 + h * 128 + dk];
    const float bb = ba[h * 128 + dk];
    __syncthreads();
    float run = 0.f;
#pragma unroll
    for (int jj = 0; jj < 16; ++jj) { const LAS f32x4* gr = (const LAS f32x4*)(ga + (16 * jq + jj) * 16); float z = bb;
#pragma unroll
        for (int r4 = 0; r4 < 4; ++r4) { const f32x4 g4 = gr[r4]; z += g4.x * w[4 * r4] + g4.y * w[4 * r4 + 1] + g4.z * w[4 * r4 + 2] + g4.w * w[4 * r4 + 3]; }
        run += (fminf(z, 0.f) - log1pf(__expf(-fabsf(z)))) * (1.f / 16.f); P[jj] = run; }
    gt[jq * 128 + dk] = run;
    __syncthreads();
    float off = 0.f, tot = 0.f;
#pragma unroll
    for (int q = 0; q < 4; ++q) { const float t = gt[q * 128 + dk]; tot += t; if (q < jq) off += t; }
#pragma unroll
    for (int jj = 0; jj < 16; ++jj) P[jj] += off;
    blast = tot;
}
__device__ __forceinline__ void stage_raw_k(const bf16* src  , LAS unsigned char* dst, int tid, int t0, int h) {
#pragma unroll
    for (int q = 0; q < 2; ++q) { const int id = tid + 512 * q, j = id >> 4, c16 = id & 15; *(LAS v4u*)(dst + j * 256 + c16 * 16) = *(const v4u*)((const char*)src + (unsigned)(((t0 + j) * 512 + h * 128 + c16 * 8) * 2)); }
}
__device__ __forceinline__ void stage_raw_v(const Params& p, LAS unsigned char* dst, int tid, int t0, int h) {
    const bf16* GV = (const bf16*)(p.ws + WS_GV);
#pragma unroll
    for (int q = 0; q < 4; ++q) { const int id = tid + 512 * q, j = id >> 5, c = id & 31; *(LAS v4u*)(dst + j * 512 + c * 16) = *(const v4u*)((const char*)GV + (unsigned)(((t0 + j) * 1024 + h * 256 + c * 8) * 2)); }
}
__device__ __forceinline__ void fill_vt(LAS unsigned char* lds, const LAS unsigned char* rv, int tid) {
    const int dv = tid & 255, jh = tid >> 8;
    unsigned short v[32];
#pragma unroll
    for (int jj = 0; jj < 32; ++jj) v[jj] = *(const LAS bf16*)(rv + (32 * jh + jj) * 512 + dv * 2);
    LAS unsigned char* row = lds + L_VT + dv * 128; const int f = (dv >> 1) & 7;
#pragma unroll
    for (int q = 0; q < 4; ++q) { v4u w; w.x = v[8 * q] | ((unsigned)v[8 * q + 1] << 16); w.y = v[8 * q + 2] | ((unsigned)v[8 * q + 3] << 16); w.z = v[8 * q + 4] | ((unsigned)v[8 * q + 5] << 16); w.w = v[8 * q + 6] | ((unsigned)v[8 * q + 7] << 16);
        *(LAS v4u*)(row + (((4 * jh + q) ^ f) * 16)) = w; }
}
}

__device__ __forceinline__ void ph_gla_a(const Params& p, LAS unsigned char* lds, int u0, int ustride, int tid_in, int wave) {
    using namespace gla;
    int tid = tid_in; asm volatile("" : "+v"(tid));
    const int lane = tid & 63, c = lane & 15, gq = lane >> 4;
    const bf16* GK = (const bf16*)(p.ws + WS_GK); bf16* ST = (bf16*)(p.ws + WS_ST); float* DEC = (float*)(p.ws + WS_DEC);
    for (int unit = u0; unit < 2048; unit += ustride) {
        const int bh = unit >> 6, ch = unit & 63, b = bh >> 2, h = bh & 3, t0 = b * SEQ + ch * 64;
        stage_raw_k(GK, lds + 0, tid, t0, h); stage_raw_v(p, lds + 16384, tid, t0, h);
        float P[16], blast; chunk_cumsum(p, lds, tid, t0, h, P, blast);
        { const int dk = tid & 127, jq = tid >> 7;
          unsigned short kv[16];
#pragma unroll
          for (int jj = 0; jj < 16; ++jj) kv[jj] = *(const LAS bf16*)(lds + (16 * jq + jj) * 256 + dk * 2);
          unsigned pk[8];
#pragma unroll
          for (int q = 0; q < 8; ++q) pk[q] = pk2(bf2f(kv[2 * q]) * __expf(blast - P[2 * q]), bf2f(kv[2 * q + 1]) * __expf(blast - P[2 * q + 1]));
          LAS unsigned char* row = lds + L_KT + dk * 128; const int f = (dk >> 1) & 7;
          *(LAS v4u*)(row + (((2 * jq) ^ f) * 16)) = (v4u){pk[0], pk[1], pk[2], pk[3]}; *(LAS v4u*)(row + (((2 * jq + 1) ^ f) * 16)) = (v4u){pk[4], pk[5], pk[6], pk[7]};
          if (jq == 0) DEC[unit * 128 + dk] = __expf(blast); }
        fill_vt(lds, lds + 16384, tid);
        __syncthreads();
        f4 acc[16];
        const int f = (c >> 1) & 7;
        bf16x8 aF[2];
#pragma unroll
        for (int ks = 0; ks < 2; ++ks) aF[ks] = *(const LAS bf16x8*)(lds + L_KT + (16 * wave + c) * 128 + (((4 * ks + gq) ^ f) * 16));
#pragma unroll
        for (int nt = 0; nt < 16; ++nt) { acc[nt] = (f4){0.f, 0.f, 0.f, 0.f};
#pragma unroll
            for (int ks = 0; ks < 2; ++ks) { const bf16x8 bF = *(const LAS bf16x8*)(lds + L_VT + (16 * nt + c) * 128 + (((4 * ks + gq) ^ f) * 16)); acc[nt] = __builtin_amdgcn_mfma_f32_16x16x32_bf16(aF[ks], bF, acc[nt], 0, 0, 0); } }
        char* dst = (char*)ST + (size_t)unit * (256 * 128 * 2) + (unsigned)((c * 128 + 16 * wave + 4 * gq) * 2);
#pragma unroll
        for (int nt = 0; nt < 16; ++nt) *(v2u*)(dst + nt * 16 * 256) = (v2u){pg8::cvt_pk_bf16(acc[nt][0], acc[nt][1]), pg8::cvt_pk_bf16(acc[nt][2], acc[nt][3])};
        __syncthreads();
    }
}
__device__ __forceinline__ void ph_gla_b(const Params& p, int gid, int gstride) {
    bf16* ST = (bf16*)(p.ws + WS_ST); const float* DEC = (const float*)(p.ws + WS_DEC);
    for (int e = gid; e < 32 * 4096; e += gstride) { const int bh = e >> 12, dv = (e >> 4) & 255, d8 = e & 15;
        float st[8];
#pragma unroll
        for (int i = 0; i < 8; ++i) st[i] = 0.f;
        char* base = (char*)ST + (size_t)bh * 64 * (256 * 128 * 2) + (unsigned)((dv * 128 + d8 * 8) * 2); const float* dbase = DEC + (size_t)bh * 64 * 128 + d8 * 8;
#pragma unroll 4
        for (int ch = 0; ch < 64; ++ch) { v4u* ptr = (v4u*)(base + (size_t)ch * (256 * 128 * 2)); const v4u w = *ptr; const f32x4 d0 = *(const f32x4*)(dbase + ch * 128), d1 = *(const f32x4*)(dbase + ch * 128 + 4);
            v4u o; o.x = pk2(st[0], st[1]); o.y = pk2(st[2], st[3]); o.z = pk2(st[4], st[5]); o.w = pk2(st[6], st[7]); *ptr = o;
            st[0] = st[0] * d0.x + bflo(w.x); st[1] = st[1] * d0.y + bfhi(w.x); st[2] = st[2] * d0.z + bflo(w.y); st[3] = st[3] * d0.w + bfhi(w.y);
            st[4] = st[4] * d1.x + bflo(w.z); st[5] = st[5] * d1.y + bfhi(w.z); st[6] = st[6] * d1.z + bflo(w.w); st[7] = st[7] * d1.w + bfhi(w.w); }
    }
}
__device__ __forceinline__ void ph_gla_c(const Params& p, LAS unsigned char* lds, int u0, int ustride, int tid_in, int wave) {
    using namespace gla;
    int tid = tid_in; asm volatile("" : "+v"(tid));
    const int lane = tid & 63, c = lane & 15, gq = lane >> 4, nt = wave & 3, half = wave >> 2;
    const bf16* GQ = (const bf16*)(p.ws + WS_GQ); const bf16* GK = (const bf16*)(p.ws + WS_GK); const bf16* GG = (const bf16*)(p.ws + WS_GG); const bf16* ST = (const bf16*)(p.ws + WS_ST);
    bf16* A2 = (bf16*)(p.ws + WS_A2); const float* gn = p.in[I_GLAG];
    const int koff0 = c * 256 + ((gq ^ c) * 16), voff0 = c * 128 + (((gq >> 1) ^ ((c >> 1) & 7)) * 16) + (gq & 1) * 8;
    for (int unit = u0; unit < 2048; unit += ustride) {
        const int bh = unit >> 6, ch = unit & 63, b = bh >> 2, h = bh & 3, t0 = b * SEQ + ch * 64;
        stage_raw_k(GQ, lds + 0, tid, t0, h); stage_raw_k(GK, lds + 16384, tid, t0, h); stage_raw_v(p, lds + 32768, tid, t0, h);
        float P[16], blast; chunk_cumsum(p, lds, tid, t0, h, P, blast);
        { const int dk = tid & 127, jq = tid >> 7;
#pragma unroll
          for (int jj = 0; jj < 16; ++jj) { const int j = 16 * jq + jj; const float qv = bf2f(*(const LAS bf16*)(lds + j * 256 + dk * 2)), kv = bf2f(*(const LAS bf16*)(lds + 16384 + j * 256 + dk * 2));
              const int off = j * 256 + (((dk >> 3) ^ (j & 15)) * 16) + (dk & 7) * 2;
              *(LAS bf16*)(lds + L_QT + off) = (bf16)f2bf(qv * __expf(P[jj])); *(LAS bf16*)(lds + L_KT + off) = (bf16)f2bf(kv * __expf(-P[jj])); } }
        fill_vt(lds, lds + 32768, tid);
        __syncthreads();
        { const char* src = (const char*)ST + (size_t)unit * (256 * 128 * 2);
#pragma unroll
          for (int i = 0; i < 8; ++i) { const int piece = 8 * wave + i, row = piece * 4 + (lane >> 4), chunk = (lane & 15) ^ (row & 15);
              __builtin_amdgcn_global_load_lds((const unsigned*)(src + (unsigned)(row * 256 + chunk * 16)), (LAS unsigned*)(lds + L_ST + piece * 1024), 16, 0, 0); } }
        asm volatile("s_waitcnt vmcnt(0)" ::: "memory"); __syncthreads();
        bf16x8 qF[4];
#pragma unroll
        for (int ks = 0; ks < 4; ++ks) qF[ks] = *(const LAS bf16x8*)(lds + L_QT + nt * 4096 + (koff0 ^ (ks * 64)));
        f4 sT[4];
#pragma unroll
        for (int jt = 0; jt < 4; ++jt) { sT[jt] = (f4){0.f, 0.f, 0.f, 0.f};
            if (jt <= nt) {
#pragma unroll
                for (int ks = 0; ks < 4; ++ks) { const bf16x8 a = *(const LAS bf16x8*)(lds + L_KT + jt * 4096 + (koff0 ^ (ks * 64))); sT[jt] = __builtin_amdgcn_mfma_f32_16x16x32_bf16(a, qF[ks], sT[jt], 0, 0, 0); }
                if (jt == nt) {
#pragma unroll
                    for (int rg = 0; rg < 4; ++rg) if (4 * gq + rg > c) sT[jt][rg] = 0.f; } } }
        bf16x8 pb[2];
#pragma unroll
        for (int s = 0; s < 2; ++s) { v4u w; w.x = pg8::cvt_pk_bf16(sT[2 * s][0], sT[2 * s][1]); w.y = pg8::cvt_pk_bf16(sT[2 * s][2], sT[2 * s][3]); w.z = pg8::cvt_pk_bf16(sT[2 * s + 1][0], sT[2 * s + 1][1]); w.w = pg8::cvt_pk_bf16(sT[2 * s + 1][2], sT[2 * s + 1][3]); pb[s] = __builtin_bit_cast(bf16x8, w); }
        f4 o[8]; float ss = 0.f;
#pragma unroll
        for (int mt = 0; mt < 8; ++mt) { o[mt] = (f4){0.f, 0.f, 0.f, 0.f}; const int rb = 128 * half + 16 * mt;
#pragma unroll
            for (int ks = 0; ks < 4; ++ks) { const bf16x8 a = *(const LAS bf16x8*)(lds + L_ST + rb * 256 + (koff0 ^ (ks * 64))); o[mt] = __builtin_amdgcn_mfma_f32_16x16x32_bf16(a, qF[ks], o[mt], 0, 0, 0); }
#pragma unroll
            for (int s = 0; s < 2; ++s) if (2 * s <= nt) { const v2u lo = *(const LAS v2u*)(lds + L_VT + rb * 128 + (voff0 ^ (s * 64))), hi = *(const LAS v2u*)(lds + L_VT + rb * 128 + (voff0 ^ (s * 64 + 32)));
                o[mt] = __builtin_amdgcn_mfma_f32_16x16x32_bf16(__builtin_bit_cast(bf16x8, (v4u){lo.x, lo.y, hi.x, hi.y}), pb[s], o[mt], 0, 0, 0); }
            ss += (o[mt][0] * o[mt][0] + o[mt][1] * o[mt][1]) + (o[mt][2] * o[mt][2] + o[mt][3] * o[mt][3]); }
        ss = nsa::radd32(nsa::radd16(ss));
        LAS float* red = (LAS float*)(lds + L_RED);
        if (gq == 0) red[half * 64 + 16 * nt + c] = ss;
        __syncthreads();
        const float rstd = 1.f / sqrtf((red[16 * nt + c] + red[64 + 16 * nt + c]) * (1.f / 256.f) + RMS_EPS);
        const int tok = t0 + 16 * nt + c;
#pragma unroll
        for (int mt = 0; mt < 8; ++mt) { const int dv = 128 * half + 16 * mt + 4 * gq; const f32x4 g4 = *(const f32x4*)((const char*)gn + (unsigned)(dv * 4));
            const v2u gg = *(const v2u*)((const char*)GG + (unsigned)((tok * 1024 + h * 256 + dv) * 2));
            const float z0 = bflo(gg.x), z1 = bfhi(gg.x), z2 = bflo(gg.y), z3 = bfhi(gg.y);
            v2u w; w.x = pg8::cvt_pk_bf16(o[mt][0] * rstd * g4.x * (z0 / (1.f + __expf(-z0))), o[mt][1] * rstd * g4.y * (z1 / (1.f + __expf(-z1))));
            w.y = pg8::cvt_pk_bf16(o[mt][2] * rstd * g4.z * (z2 / (1.f + __expf(-z2))), o[mt][3] * rstd * g4.w * (z3 / (1.f + __expf(-z3))));
            *(v2u*)((char*)A2 + (unsigned)((tok * DM + h * 256 + dv) * 2)) = w; }
        __syncthreads();
    }
}

constexpr size_t WS_LH = WS_DEC + (size_t)2048 * 128 * 4;
constexpr size_t WS_PEV = WS_LH + (size_t)2 * 4096 * 256 * 4;
static_assert(WS_PEV + 1024 <= WS_KCMP, "cmp scratch overlay");
struct CmpOrder {
    int c; const bf16 *kc, *vc, *wk, *wv;
    __device__ __forceinline__ bool next(int i, pg8::Unit& u) const { if (i > 0 || c >= 32) return false; u.pm = c & 15; u.pn = 0; u.kind = c >> 4; return true; }
    __device__ __forceinline__ const char* pa(const pg8::Gemm&, const pg8::Unit& u) const { return (const char*)(u.kind ? vc : kc) + (size_t)u.pm * ((size_t)256 * 2048 * 2); }
    __device__ __forceinline__ const char* pb(const pg8::Gemm&, const pg8::Unit& u) const { return (const char*)(u.kind ? wv : wk); }
    __device__ __forceinline__ void a_ready(const pg8::Unit&) const {}
    __device__ __forceinline__ void done(const pg8::Unit&) const {}
};
struct EpiLH {
    static constexpr bool PERM = false, AFTER_DRAIN = false;
    float* LH;
    __device__ __forceinline__ void operator()(const pg8::f32x4 (&acc)[2][2][4][2], const pg8::Unit& u, int wr, int wc, int fr, int fq) const {
        const int row0 = u.kind * 4096 + u.pm * 256 + wr * 64 + fr, col0 = wc * 32 + 4 * fq;
#pragma unroll
        for (int ai = 0; ai < 2; ++ai)
#pragma unroll
            for (int m = 0; m < 4; ++m) { float* rowp = LH + (size_t)(row0 + ai * 128 + m * 16) * 256 + col0;
#pragma unroll
                for (int bj = 0; bj < 2; ++bj)
#pragma unroll
                    for (int n = 0; n < 2; ++n) *(pg8::f32x4*)(rowp + bj * 128 + n * 16) = acc[ai][bj][m][n]; }
    }
};

constexpr size_t PROWS = (size_t)MAXTILES * 256;
constexpr size_t WS_W1Q = WS_W1T;
constexpr size_t WS_W2Q = WS_W1Q + (size_t)NE * 4096 * DM;
constexpr size_t WS_HN8 = WS_W2Q + (size_t)NE * DM * DFF;
constexpr size_t WS_AMAXP = WS_HN8 + (size_t)T * DM;
constexpr size_t WS_WSC1 = WS_AMAXP + PROWS * 64 * 4;
constexpr size_t WS_WSC2 = WS_WSC1 + (size_t)NE * 4096 * 4;
constexpr size_t WS_HSC = WS_WSC2 + (size_t)NE * 2048 * 4;
constexpr size_t WS_ROWSC = WS_HSC + (size_t)T * 4;
constexpr size_t WS_ASC = WS_ROWSC + PROWS * 4;
static_assert(WS_ASC + PROWS * 4 <= WS_XN, "int8 buffers fit in the retired bf16 expert-weight region");
constexpr size_t WS_XG8 = WS_XG;
constexpr size_t WS_ACT8 = WS_XG + PROWS * DM;
constexpr size_t WS_Y = WS_ACT;
static_assert(WS_ACT8 + PROWS * DM <= WS_ACT, "int8 row buffers fit in the retired gathered-row region");

__device__ __forceinline__ unsigned q8(float v) { int q = (int)rintf(v); q = q > 127 ? 127 : (q < -127 ? -127 : q); return (unsigned)q & 0xffu; }
__device__ __forceinline__ unsigned q8x4(float a, float b, float c, float d) { return q8(a) | (q8(b) << 8) | (q8(c) << 16) | (q8(d) << 24); }

constexpr size_t WS_WINQ = WS_WINT;
constexpr size_t WS_WISC = WS_WINT + (size_t)NPT * 256 * DM;
constexpr size_t WS_XN8 = WS_XN;
constexpr size_t WS_XSC = WS_XN + (size_t)T * DM;
constexpr size_t WS_PMAX = WS_HN;
constexpr size_t WS_PMAXI = WS_PMAX + (size_t)64 * 8 * 4096 * 4;

constexpr int NSLAB_E = NE * 192, NSLAB = NSLAB_E + 178;
struct SlabSrc { const float* W; int N; bool ok; };
__device__ __forceinline__ SlabSrc slab_src(const Params& p, int sl, int r0, int n4) {
    SlabSrc s;
    if (sl < NSLAB_E) { const int e = sl / 192, r = sl % 192; const bool isw2 = r >= 128; const int nb = isw2 ? r - 128 : r; s.N = isw2 ? 2048 : 4096;
        s.W = (isw2 ? p.in[I_W2] + (size_t)e * DFF * DM : p.in[I_W1] + (size_t)e * DM * 4096) + (size_t)r0 * s.N + nb * 32 + 4 * n4; s.ok = true; }
    else { const int nb = sl - NSLAB_E; s.N = 5672; s.ok = nb * 32 + 4 * n4 < 5672; s.W = p.in[I_WIN] + (size_t)r0 * 5672 + (s.ok ? nb * 32 + 4 * n4 : 0); }
    return s;
}
__device__ __forceinline__ void p0_slab_quant(const Params& p, LAS unsigned char* lds, int bid, int G, int tid) {
    constexpr int RS = 4104;
    LAS unsigned char* TT = lds; LAS float* part = (LAS float*)(lds + 32 * RS); LAS float* inv = part + 64 * 32; LAS int* drow = (LAS int*)(inv + 32);
    signed char* W1Q = (signed char*)(p.ws + WS_W1Q); signed char* W2Q = (signed char*)(p.ws + WS_W2Q); signed char* WIQ = (signed char*)(p.ws + WS_WINQ);
    float* WSC1 = (float*)(p.ws + WS_WSC1); float* WSC2 = (float*)(p.ws + WS_WSC2); float* WISC = (float*)(p.ws + WS_WISC);
    const int n4 = tid & 7, r0 = tid >> 3;
    f32x4 va[8], vb[8];
#define SLAB_ISSUE(dst, sl, j) do { if ((sl) < NSLAB) { const SlabSrc ss_ = slab_src(p, (sl), r0, n4); _Pragma("unroll") for (int u = 0; u < 8; ++u) dst[u] = __builtin_nontemporal_load((const f32x4*)(ss_.W + (size_t)(64 * (8 * (j) + u)) * ss_.N)); } } while (0)
#define SLAB_USE(src, j) do { _Pragma("unroll") for (int u = 0; u < 8; ++u) { const f32x4 x = sc_.ok ? src[u] : (f32x4){0.f, 0.f, 0.f, 0.f}; const int k = r0 + 64 * (8 * (j) + u); \
            mx.x = fmaxf(mx.x, fabsf(x.x)); mx.y = fmaxf(mx.y, fabsf(x.y)); mx.z = fmaxf(mx.z, fabsf(x.z)); mx.w = fmaxf(mx.w, fabsf(x.w)); \
            LAS unsigned char* d = TT + (4 * n4) * RS + k * 2; \
            *(LAS bf16*)d = (bf16)f2bf(x.x); *(LAS bf16*)(d + RS) = (bf16)f2bf(x.y); *(LAS bf16*)(d + 2 * RS) = (bf16)f2bf(x.z); *(LAS bf16*)(d + 3 * RS) = (bf16)f2bf(x.w); } } while (0)
    SLAB_ISSUE(va, bid, 0); SLAB_ISSUE(vb, bid, 1);
    for (int slab = bid; slab < NSLAB; slab += G) {
        const SlabSrc sc_ = slab_src(p, slab, r0, n4);
        f32x4 mx = (f32x4){0.f, 0.f, 0.f, 0.f};
        SLAB_USE(va, 0); SLAB_ISSUE(va, slab, 2);
        SLAB_USE(vb, 1); SLAB_ISSUE(vb, slab, 3);
        SLAB_USE(va, 2); SLAB_ISSUE(va, slab + G, 0);
        SLAB_USE(vb, 3); SLAB_ISSUE(vb, slab + G, 1);
        { f32x4 t = mx;
#pragma unroll
          for (int o = 8; o < 64; o <<= 1) { t.x = fmaxf(t.x, __shfl_xor(t.x, o)); t.y = fmaxf(t.y, __shfl_xor(t.y, o)); t.z = fmaxf(t.z, __shfl_xor(t.z, o)); t.w = fmaxf(t.w, __shfl_xor(t.w, o)); }
          if ((tid & 63) < 8) *(LAS f32x4*)(part + (tid >> 6) * 32 + 4 * n4) = t; }
        __syncthreads();
        if (tid < 32) { float m = 0.f;
#pragma unroll
            for (int q = 0; q < 8; ++q) m = fmaxf(m, part[q * 32 + tid]);
            const float sc = m > 0.f ? m * (1.f / 127.f) : 1.f; inv[tid] = 1.f / sc;
            if (slab < NSLAB_E) { const int e = slab / 192, r = slab % 192; const bool isw2 = r >= 128; const int n = (isw2 ? r - 128 : r) * 32 + tid;
                if (isw2) { drow[tid] = e * 2048 + n; WSC2[e * 2048 + n] = sc; }
                else { const int j2 = n & 2047, row = (j2 >> 7) * 256 + (n >= 2048 ? 128 : 0) + (j2 & 127); drow[tid] = e * 4096 + row; WSC1[e * 4096 + row] = sc; } }
            else { const int n = (slab - NSLAB_E) * 32 + tid; if (n < 5672) { float qsc; const int row = win_row(n, qsc); drow[tid] = row; WISC[row] = sc * qsc; } else drow[tid] = -1; } }
        __syncthreads();
        { const int kc = tid & 7, n = (tid >> 3) & 31, hf = tid >> 8; const float iv = inv[n]; const int dr = drow[n];
          signed char* dst = (slab < NSLAB_E ? ((slab % 192) >= 128 ? W2Q : W1Q) : WIQ) + (size_t)(dr < 0 ? 0 : dr) * 2048; const LAS unsigned char* src = TT + n * RS;
          if (dr >= 0) {
#pragma unroll
          for (int m8 = 0; m8 < 8; ++m8) { const int k0 = 16 * (kc + 8 * (hf + 2 * m8)); const LAS v2u* sp = (const LAS v2u*)(src + k0 * 2); const v2u a = sp[0], b = sp[1], c = sp[2], d = sp[3]; v4u o;
              o.x = q8x4(bflo(a.x) * iv, bfhi(a.x) * iv, bflo(a.y) * iv, bfhi(a.y) * iv); o.y = q8x4(bflo(b.x) * iv, bfhi(b.x) * iv, bflo(b.y) * iv, bfhi(b.y) * iv);
              o.z = q8x4(bflo(c.x) * iv, bfhi(c.x) * iv, bflo(c.y) * iv, bfhi(c.y) * iv); o.w = q8x4(bflo(d.x) * iv, bfhi(d.x) * iv, bflo(d.y) * iv, bfhi(d.y) * iv);
              *(v4u*)(dst + k0) = o; } } }
        __syncthreads();
    }
#undef SLAB_ISSUE
#undef SLAB_USE
}
struct EpiSwigluI8 {
    static constexpr bool PERM = true, AFTER_DRAIN = false;
    const float* b1; const float* rowsc; const float* wsc1; bf16* act; float* amaxp;
    __device__ __forceinline__ void operator()(const pg8::f32x4 (&acc)[2][2][4][2], const pg8::Unit& u, int wr, int wc, int fr, int fq) const {
        const int e = u.kind; const int cin = wc * 32 + 8 * fq; const int col = u.pn * 128 + cin; const int row0 = u.pm * 256 + wr * 64 + fr;
        const float* bg = b1 + (size_t)e * 4096 + col; const float* bl = bg + 2048; const float* sg = wsc1 + (size_t)e * 4096 + u.pn * 256 + cin; const float* sl = sg + 128;
        float gb[8], lb[8], gs[8], ls[8];
#pragma unroll
        for (int j = 0; j < 8; ++j) { gb[j] = bg[j]; lb[j] = bl[j]; gs[j] = sg[j]; ls[j] = sl[j]; }
#pragma unroll
        for (int ai = 0; ai < 2; ++ai)
#pragma unroll
            for (int m = 0; m < 4; ++m) { const int r = row0 + ai * 128 + m * 16; const float rs = rowsc[r]; float o[8]; float mx = 0.f;
#pragma unroll
                for (int n = 0; n < 2; ++n)
#pragma unroll
                    for (int j = 0; j < 4; ++j) { float gl = (float)__float_as_int(acc[ai][0][m][n][j]) * (rs * gs[n * 4 + j]) + gb[n * 4 + j]; float li = (float)__float_as_int(acc[ai][1][m][n][j]) * (rs * ls[n * 4 + j]) + lb[n * 4 + j];
                        gl = fminf(gl, 7.f); li = fminf(fmaxf(li, -7.f), 7.f);
                        const float v = gl * __builtin_amdgcn_rcpf(1.f + __builtin_amdgcn_exp2f(-2.4554669595930156f * gl)) * (li + 1.f); o[n * 4 + j] = v; mx = fmaxf(mx, fabsf(v)); }
                mx = nsa::rmax32(nsa::rmax16(mx));
                if (fq == 0) amaxp[(size_t)r * 64 + u.pn * 4 + wc] = mx;
                pg8::u32x4 w; w.x = pg8::cvt_pk_bf16(o[0], o[1]); w.y = pg8::cvt_pk_bf16(o[2], o[3]); w.z = pg8::cvt_pk_bf16(o[4], o[5]); w.w = pg8::cvt_pk_bf16(o[6], o[7]);
                *(pg8::u32x4*)(act + (size_t)r * DFF + col) = w; }
    }
};
__device__ __forceinline__ void ph_actq(const Params& p, int gw, int NGW, int lane) {
    const int nrows = ((const int*)(p.ws + WS_META))[0] * 256; const float* amaxp = (const float*)(p.ws + WS_AMAXP); const bf16* act = (const bf16*)(p.ws + WS_ACT);
    signed char* A8 = (signed char*)(p.ws + WS_ACT8); float* ASC = (float*)(p.ws + WS_ASC);
    for (int rb = gw; rb < nrows; rb += 2 * NGW) {
        const int r0 = rb, r1 = rb + NGW; const bool h1 = r1 < nrows; const int r1c = h1 ? r1 : r0;
        float m0 = amaxp[(size_t)r0 * 64 + lane], m1 = amaxp[(size_t)r1c * 64 + lane];
        const v4u* s0 = (const v4u*)(act + (size_t)r0 * DFF) + lane * 4; const v4u* s1 = (const v4u*)(act + (size_t)r1c * DFF) + lane * 4; v4u a[2][4];
#pragma unroll
        for (int j = 0; j < 4; ++j) { a[0][j] = s0[j]; a[1][j] = s1[j]; }
        m0 = wave_max(m0); m1 = wave_max(m1);
#pragma unroll
        for (int q = 0; q < 2; ++q) { const int r = q ? r1 : r0; if (q && !h1) break; const float mx = q ? m1 : m0; const float sc = mx > 0.f ? mx * (1.f / 127.f) : 1.f, iv = 1.f / sc; v4u o[2];
#pragma unroll
            for (int h = 0; h < 2; ++h) { const v4u x = a[q][2 * h], y = a[q][2 * h + 1];
                o[h].x = q8x4(bflo(x.x) * iv, bfhi(x.x) * iv, bflo(x.y) * iv, bfhi(x.y) * iv); o[h].y = q8x4(bflo(x.z) * iv, bfhi(x.z) * iv, bflo(x.w) * iv, bfhi(x.w) * iv);
                o[h].z = q8x4(bflo(y.x) * iv, bfhi(y.x) * iv, bflo(y.y) * iv, bfhi(y.y) * iv); o[h].w = q8x4(bflo(y.z) * iv, bfhi(y.z) * iv, bflo(y.w) * iv, bfhi(y.w) * iv); }
            v4u* dst = (v4u*)(A8 + (size_t)r * DFF) + lane * 2; dst[0] = o[0]; dst[1] = o[1];
            if (lane == 0) ASC[r] = sc; } }
}
struct EpiDownI8 {
    static constexpr bool PERM = true, AFTER_DRAIN = false;
    const float* b2; const float* roww; const float* asc; const float* wsc2; bf16* y;
    __device__ __forceinline__ void operator()(const pg8::f32x4 (&acc)[2][2][4][2], const pg8::Unit& u, int wr, int wc, int fr, int fq) const {
        const int e = u.kind; const int col0 = u.pn * 256 + wc * 32 + 8 * fq; const int row0 = u.pm * 256 + wr * 64 + fr;
        float bv[2][8], sv[2][8];
#pragma unroll
        for (int bj = 0; bj < 2; ++bj)
#pragma unroll
            for (int j = 0; j < 8; ++j) { bv[bj][j] = b2[(size_t)e * DM + col0 + bj * 128 + j]; sv[bj][j] = wsc2[(size_t)e * DM + col0 + bj * 128 + j]; }
#pragma unroll
        for (int ai = 0; ai < 2; ++ai)
#pragma unroll
            for (int m = 0; m < 4; ++m) { const int r = row0 + ai * 128 + m * 16; const float g = roww[r], as = asc[r];
#pragma unroll
                for (int bj = 0; bj < 2; ++bj) { float o[8];
#pragma unroll
                    for (int n = 0; n < 2; ++n)
#pragma unroll
                        for (int j = 0; j < 4; ++j) o[n * 4 + j] = ((float)__float_as_int(acc[ai][bj][m][n][j]) * (as * sv[bj][n * 4 + j]) + bv[bj][n * 4 + j]) * g;
                    pg8::u32x4 w; w.x = pg8::cvt_pk_bf16(o[0], o[1]); w.y = pg8::cvt_pk_bf16(o[2], o[3]); w.z = pg8::cvt_pk_bf16(o[4], o[5]); w.w = pg8::cvt_pk_bf16(o[6], o[7]);
                    *(pg8::u32x4*)(y + (size_t)r * DM + col0 + bj * 128) = w; } }
    }
};

struct EpiProjI8 {
    static constexpr bool PERM = true, AFTER_DRAIN = false;
    unsigned char* ws;
    __device__ __forceinline__ void operator()(const pg8::f32x4 (&acc)[2][2][4][2], const pg8::Unit& u, int wr, int wc, int fr, int fq) const {
        const int cw = wc * 32 + 8 * fq; const float* XSC = (const float*)(ws + WS_XSC); const float* WISC = (const float*)(ws + WS_WISC);
        if (u.kind == 0) {
            const int tn = u.pn; bf16* base; size_t bjs = 128; int ld = 0; bool headmajor = false; bool small = false;
            if (tn < 2) { base = (bf16*)(ws + WS_GQ) + tn * 256; ld = 512; }
            else if (tn < 4) { base = (bf16*)(ws + WS_GK) + (tn - 2) * 256; ld = 512; }
            else if (tn < 8) { base = (bf16*)(ws + WS_GV) + (tn - 4) * 256; ld = 1024; }
            else if (tn < 12) { base = (bf16*)(ws + WS_GG) + (tn - 8) * 256; ld = 1024; }
            else if (tn < 16) { base = (bf16*)(ws + WS_NQ) + (tn - 12) * 256; ld = 1024; }
            else if (tn < 20) { base = (bf16*)(ws + (tn == 16 ? WS_KC : tn == 17 ? WS_VC : tn == 18 ? WS_KS : WS_KW)); headmajor = true; bjs = (size_t)SEQ * 128; }
            else { base = (bf16*)(ws + WS_SM); ld = 64; small = true; }
            if (small && wc >= 2) return;
            float cs[2][8];
#pragma unroll
            for (int bj = 0; bj < 2; ++bj)
#pragma unroll
                for (int j = 0; j < 8; ++j) cs[bj][j] = WISC[tn * 256 + bj * 128 + cw + j];
#pragma unroll
            for (int ai = 0; ai < 2; ++ai)
#pragma unroll
                for (int m = 0; m < 4; ++m) { const int r = u.pm * 256 + ai * 128 + wr * 64 + m * 16 + fr; const float rs = XSC[r];
                    const size_t rterm = headmajor ? ((size_t)(r >> 12) * 2 * SEQ + (r & (SEQ - 1))) * 128 : (size_t)r * ld;
#pragma unroll
                    for (int bj = 0; bj < 2; ++bj) { if (small && bj) continue; float o[8];
#pragma unroll
                        for (int n = 0; n < 2; ++n)
#pragma unroll
                            for (int j = 0; j < 4; ++j) o[n * 4 + j] = (float)__float_as_int(acc[ai][bj][m][n][j]) * (rs * cs[bj][n * 4 + j]);
                        pg8::u32x4 w; w.x = pg8::cvt_pk_bf16(o[0], o[1]); w.y = pg8::cvt_pk_bf16(o[2], o[3]); w.z = pg8::cvt_pk_bf16(o[4], o[5]); w.w = pg8::cvt_pk_bf16(o[6], o[7]);
                        *(pg8::u32x4*)(base + rterm + bj * bjs + cw) = w; } }
        } else {
            bf16* base = (bf16*)(ws + (u.pn == 21 ? WS_VST : WS_VWT));
#pragma unroll
            for (int ai = 0; ai < 2; ++ai)
#pragma unroll
                for (int m = 0; m < 4; ++m) { const int dh = wr * 64 + m * 16 + fr; const float ws_ = WISC[u.pn * 256 + ai * 128 + dh];
#pragma unroll
                    for (int bj = 0; bj < 2; ++bj) { const int tok = u.pm * 256 + bj * 128 + cw; const int b = tok >> 12, s = tok & (SEQ - 1); float o[8];
                        const pg8::f32x4 x0 = *(const pg8::f32x4*)(XSC + tok), x1 = *(const pg8::f32x4*)(XSC + tok + 4);
#pragma unroll
                        for (int j = 0; j < 4; ++j) { o[j] = (float)__float_as_int(acc[ai][bj][m][0][j]) * (ws_ * x0[j]); o[4 + j] = (float)__float_as_int(acc[ai][bj][m][1][j]) * (ws_ * x1[j]); }
                        pg8::u32x4 w; w.x = pg8::cvt_pk_bf16(o[0], o[1]); w.y = pg8::cvt_pk_bf16(o[2], o[3]); w.z = pg8::cvt_pk_bf16(o[4], o[5]); w.w = pg8::cvt_pk_bf16(o[6], o[7]);
                        *(pg8::u32x4*)(base + ((size_t)(b * 2 + ai) * 128 + dh) * SEQ + s) = w; } }
        }
    }
};

__device__ __forceinline__ void r1_router(const Params& p, LAS unsigned char* lds, int vb, int tid, int wave, int lane) {
    LAS float* rowbuf = (LAS float*)lds;
    LAS float* part = (LAS float*)(lds + 65536);
    LAS int* tk = (LAS int*)(lds + 81920 + wave * 1024);
    LAS int* cntw = (LAS int*)(lds + 90112);
    const float* h = p.out; const float* gf = p.in[I_NFFN]; const float* rw = p.in[I_RW]; const float* rb = p.in[I_RB];
    signed char* HN8 = (signed char*)(p.ws + WS_HN8);
    const int e = lane & 31, eg = tid & 31, dg = tid >> 5; int mycount = 0;
    float rwr[128];
#pragma unroll
    for (int c4 = 0; c4 < 4; ++c4) { unsigned o = (unsigned)((((dg * 128 + c4 * 32) * 32) + eg) * 4); asm volatile("" : "+v"(o));
#pragma unroll
        for (int i = 0; i < 32; ++i) rwr[c4 * 32 + i] = *(const float*)((const char*)rw + o + i * 128); }
    for (int grp = 0; grp < 16; ++grp) { const int t = vb * TPV + grp * 8 + wave;
        { const f32x4* xr = (const f32x4*)(h + (size_t)t * DM) + lane; f32x4 v[8]; float s = 0.f;
#pragma unroll
          for (int j = 0; j < 8; ++j) { v[j] = xr[64 * j]; s += (v[j].x * v[j].x + v[j].y * v[j].y) + (v[j].z * v[j].z + v[j].w * v[j].w); }
          const float rstd = 1.f / sqrtf(wave_sum(s) * (1.f / DM) + RMS_EPS);
          float mxr = 0.f; LAS f32x4* hrow = (LAS f32x4*)(rowbuf + wave * 2048);
#pragma unroll
          for (int j = 0; j < 8; ++j) { const f32x4 g4 = ((const f32x4*)gf)[lane + 64 * j]; f32x4 y; y.x = v[j].x * rstd * g4.x; y.y = v[j].y * rstd * g4.y; y.z = v[j].z * rstd * g4.z; y.w = v[j].w * rstd * g4.w;
              v[j] = y; hrow[lane + 64 * j] = y; mxr = fmaxf(mxr, fmaxf(fmaxf(fabsf(y.x), fabsf(y.y)), fmaxf(fabsf(y.z), fabsf(y.w)))); }
          mxr = wave_max(mxr); const float qs = mxr > 0.f ? mxr * (1.f / 127.f) : 1.f, qi = 1.f / qs;
          unsigned* o4 = (unsigned*)(HN8 + (size_t)t * DM) + lane;
#pragma unroll
          for (int j = 0; j < 8; ++j) o4[64 * j] = q8x4(v[j].x * qi, v[j].y * qi, v[j].z * qi, v[j].w * qi);
          if (lane == 0) ((float*)(p.ws + WS_HSC))[t] = qs; }
        __syncthreads();
        { float acc[8];
#pragma unroll
          for (int tt = 0; tt < 8; ++tt) acc[tt] = 0.f;
#pragma unroll
          for (int i4 = 0; i4 < 32; ++i4) { f32x4 xv[8];
#pragma unroll
              for (int tt = 0; tt < 8; ++tt) xv[tt] = *(const LAS f32x4*)(rowbuf + tt * 2048 + dg * 128 + 4 * i4);
#pragma unroll
              for (int tt = 0; tt < 8; ++tt) acc[tt] += xv[tt].x * rwr[4 * i4] + xv[tt].y * rwr[4 * i4 + 1] + xv[tt].z * rwr[4 * i4 + 2] + xv[tt].w * rwr[4 * i4 + 3];
              if (i4 & 1) asm volatile("" ::: "memory"); }
#pragma unroll
          for (int tt = 0; tt < 8; ++tt) part[(dg * 8 + tt) * 32 + eg] = acc[tt]; }
        __syncthreads();
        { float a = rb[e];
#pragma unroll
          for (int q = 0; q < 16; ++q) a += part[(q * 8 + wave) * 32 + e];
          int rank = 0;
#pragma unroll
          for (int mm = 0; mm < 32; ++mm) { const float lm = __shfl(a, mm); rank += (lm > a || (lm == a && mm < e)) ? 1 : 0; }
          const float mx = wave_max(a); const bool sel = rank < 4;
          const float ex = (sel && lane < 32) ? __expf(a - mx) : 0.f; const float sum = wave_sum(ex);
          if (sel && lane < 32) { LAS int* q = tk + (grp * 4 + rank) * 4; q[0] = e; q[1] = mycount; q[2] = __builtin_bit_cast(int, ex / sum); ++mycount; } }
        __syncthreads();
    }
    if (lane < 32) cntw[wave * 32 + lane] = mycount;
    __syncthreads();
    if (wave == 0 && lane < 32) { int tot = 0; for (int w = 0; w < 8; ++w) tot += cntw[w * 32 + lane]; ((int*)(p.ws + WS_CNT))[vb * 32 + lane] = tot; }
    { const int i = lane >> 2, k = lane & 3; const LAS int* q = tk + (i * 4 + k) * 4; const int ee = q[0]; int base = 0; for (int w = 0; w < wave; ++w) base += cntw[w * 32 + ee];
      const int t = vb * TPV + i * 8 + wave;
      ((int*)(p.ws + WS_EIDX))[t * 4 + k] = ee; ((int*)(p.ws + WS_LRNK))[t * 4 + k] = base + q[1]; ((int*)(p.ws + WS_GATE))[t * 4 + k] = q[2]; }
    __syncthreads();
}
__device__ __forceinline__ void r2_gather(const Params& p, LAS unsigned char* lds, int vb, bool write_meta, int tid, int wave, int lane) {
    LAS int* part_tot = (LAS int*)lds;
    LAS int* part_base = part_tot + 512;
    LAS int* pbase = part_base + 512;
    const int* CNT = (const int*)(p.ws + WS_CNT);
    { const int e = tid & 31, part = tid >> 5; int tot = 0, bs = 0;
      for (int v = part * 16; v < part * 16 + 16; ++v) { const int c = CNT[v * 32 + e]; tot += c; if (v < vb) bs += c; }
      part_tot[part * 32 + e] = tot; part_base[part * 32 + e] = bs; }
    __syncthreads();
    if (tid == 0) { int ps = 0; int* meta = (int*)(p.ws + WS_META); int nt = 0;
        for (int e = 0; e < 32; ++e) { int tot = 0, bs = 0; for (int q = 0; q < 16; ++q) { tot += part_tot[q * 32 + e]; bs += part_base[q * 32 + e]; }
            pbase[e] = ps + bs; const int ntile = (tot + 255) >> 8;
            if (write_meta) for (int q = 0; q < ntile; ++q) meta[64 + nt + q] = e;
            nt += ntile; ps += ntile * 256; }
        if (write_meta) meta[0] = nt; }
    __syncthreads();
    const signed char* HN8 = (const signed char*)(p.ws + WS_HN8); signed char* XG8 = (signed char*)(p.ws + WS_XG8); const float* HSC = (const float*)(p.ws + WS_HSC); float* ROWSC = (float*)(p.ws + WS_ROWSC);
    const int* EIDX = (const int*)(p.ws + WS_EIDX); const int* LRNK = (const int*)(p.ws + WS_LRNK); const float* GATE = (const float*)(p.ws + WS_GATE);
    int* POS = (int*)(p.ws + WS_POS); float* ROWW = (float*)(p.ws + WS_ROWW);
    for (int i0 = 0; i0 < 16; i0 += 4) {
        v4u v0[4], v1[4]; float hs[4]; int ee[4][4], lr[4][4]; float gt[4][4];
#pragma unroll
        for (int u = 0; u < 4; ++u) { const int t = vb * TPV + (i0 + u) * 8 + wave; const v4u* src = (const v4u*)(HN8 + (size_t)t * DM) + lane; v0[u] = src[0]; v1[u] = src[64]; hs[u] = HSC[t];
#pragma unroll
            for (int k = 0; k < 4; ++k) { ee[u][k] = EIDX[t * 4 + k]; lr[u][k] = LRNK[t * 4 + k]; gt[u][k] = GATE[t * 4 + k]; } }
#pragma unroll
        for (int u = 0; u < 4; ++u) { const int t = vb * TPV + (i0 + u) * 8 + wave;
#pragma unroll
            for (int k = 0; k < 4; ++k) { const int pos = pbase[ee[u][k]] + lr[u][k];
                if (lane == 0) { POS[t * 4 + k] = pos; ROWW[pos] = gt[u][k]; ROWSC[pos] = hs[u]; }
                v4u* dst = (v4u*)(XG8 + (size_t)pos * DM) + lane; dst[0] = v0[u]; dst[64] = v1[u]; } } }
    __syncthreads();
}
__device__ __forceinline__ void pf_final(const Params& p, int gw, int NGW, int lane) {
    const bf16* Y = (const bf16*)(p.ws + WS_Y); const int* POS = (const int*)(p.ws + WS_POS); const float* gfin = p.in[I_NFIN];
    for (int t = gw; t < T; t += NGW) {
        f32x4* xr = (f32x4*)(p.out + (size_t)t * DM) + lane; f32x4 v[8];
#pragma unroll
        for (int j = 0; j < 8; ++j) v[j] = xr[64 * j];
#pragma unroll
        for (int k = 0; k < 4; ++k) { const int pos = POS[t * 4 + k]; const v2u* yr = (const v2u*)(Y + (size_t)pos * DM) + lane;
#pragma unroll
            for (int j = 0; j < 8; ++j) { const v2u w = yr[64 * j]; v[j].x += bflo(w.x); v[j].y += bfhi(w.x); v[j].z += bflo(w.y); v[j].w += bfhi(w.y); } }
        float s = 0.f;
#pragma unroll
        for (int j = 0; j < 8; ++j) s += (v[j].x * v[j].x + v[j].y * v[j].y) + (v[j].z * v[j].z + v[j].w * v[j].w);
        const float rstd = 1.f / sqrtf(wave_sum(s) * (1.f / DM) + RMS_EPS);
#pragma unroll
        for (int j = 0; j < 8; ++j) { const f32x4 g4 = ((const f32x4*)gfin)[lane + 64 * j]; f32x4 o; o.x = v[j].x * rstd * g4.x; o.y = v[j].y * rstd * g4.y; o.z = v[j].z * rstd * g4.z; o.w = v[j].w * rstd * g4.w; xr[64 * j] = o; }
    }
}


constexpr int LDS_BYTES = 159744;
constexpr int MISC_OFF = LDS_BYTES - 256;  static_assert(nsa::LDS_END <= MISC_OFF && gla::L_END <= MISC_OFF, "LDS map");
constexpr int CW_BAR = 4096, CW_XL = 16384;
__global__ __launch_bounds__(512, 2) void mega_fwd(Params p) {
    extern __shared__ __attribute__((aligned(16))) unsigned char lds_raw[];
    LAS unsigned char* lds = (LAS unsigned char*)lds_raw;
    const int G = gridDim.x, bid = blockIdx.x, NGW = G * 8;
#define PH_IDS int tid = threadIdx.x; asm volatile("" : "+v"(tid)); const int lane = tid & 63, wave = __builtin_amdgcn_readfirstlane(tid >> 6), gw = bid * 8 + wave; (void)lane; (void)gw;
    for (int u = threadIdx.x; u < 64; u += 512) ((LAS unsigned*)(lds + MISC_OFF))[u] = 0u;
    __syncthreads();
    XcdBarrier bar = xcd_barrier_post((unsigned*)(p.ws + WS_CTL) + CW_BAR, (volatile LAS unsigned*)(lds + MISC_OFF) + 8);
    { PH_IDS; p0_prologue(p, lds, gw, NGW, wave, lane); __syncthreads(); p0_slab_quant(p, lds, bid, G, tid); }
    xcd_barrier(bar);
    { pg8::Gemm g{(const bf16*)(p.ws + WS_XN8), (const bf16*)(p.ws + WS_WINQ), T, NPT * 256, DM / 2};
      ProjOrder S; S.init(T, NPT * 256, G, bid); S.xn = g.A; S.wt = g.Bt; EpiProjI8 E{p.ws};
      pg8::gemm_phase<EpiProjI8, ProjOrder, true, true, true>(lds, g, S, E); }
    xcd_barrier(bar);
    if (bid < 32) {
        pg8::Gemm g{(const bf16*)(p.ws + WS_KC), (const bf16*)(p.ws + WS_WKCT), 4096, 256, 2048};
        CmpOrder S{bid, (const bf16*)(p.ws + WS_KC), (const bf16*)(p.ws + WS_VC), (const bf16*)(p.ws + WS_WKCT), (const bf16*)(p.ws + WS_WVCT)}; EpiLH E{(float*)(p.ws + WS_LH)};
        pg8::gemm_phase<EpiLH, CmpOrder, true, true>(lds, g, S, E);
    } else { PH_IDS; ph_gla_a(p, lds, bid - 32, G - 32, tid, wave); }
    xcd_barrier(bar);
    { PH_IDS; ph_gla_b(p, bid * 512 + tid, G * 512);
      for (int i = bid * 512 + tid; i < 16 * 128; i += G * 512) { const int bgz = i >> 7, dz = i & 127; ((bf16*)(p.ws + WS_KCMP))[((size_t)bgz * 256 + 255) * 128 + dz] = 0; ((bf16*)(p.ws + WS_VCMPT))[((size_t)bgz * 128 + dz) * 256 + 255] = 0; }
      const int ngrp = G * 4, total = 2 * 16 * 255, iters = (total + ngrp - 1) / ngrp; const int grp = tid >> 7;
      for (int it = 0; it < iters; ++it) { int id = it * ngrp + bid * 4 + grp; if (id >= total) id = total - 1;
          ph_cmp_fin_simple(p, (LAS float*)lds + grp * 4352, id, tid & 127, (const float*)(p.ws + WS_LH), (const float*)(p.ws + WS_PEVP)); __syncthreads(); } }
    xcd_barrier(bar);
    { PH_IDS; ph_nsa(p, lds, bid, G, tid, wave); }
    { PH_IDS; __syncthreads(); ph_gla_c(p, lds, bid, G, tid, wave); }
    xcd_barrier(bar);
    { pg8::Gemm g{(const bf16*)(p.ws + WS_A2), (const bf16*)(p.ws + WS_WOT), T, DM, DM};
      pg8::StaticOrder S; S.init(T, DM, G, bid); EpiRes E{p.in[I_X], p.out};
      pg8::gemm_phase<EpiRes, pg8::StaticOrder, true, true>(lds, g, S, E); }
    xcd_barrier(bar);
    { PH_IDS; for (int vb = bid; vb < NVB; vb += G) r1_router(p, lds, vb, tid, wave, lane); }
    xcd_barrier(bar);
    { PH_IDS; for (int vb = bid; vb < NVB; vb += G) r2_gather(p, lds, vb, vb == 0, tid, wave, lane); }
    xcd_barrier(bar);
    { pg8::Gemm g{(const bf16*)(p.ws + WS_XG8), (const bf16*)(p.ws + WS_W1Q), MAXTILES * 256, 4096, DM / 2};
      MoeOrder S; S.init((const int*)(p.ws + WS_META), 16, G, bid); EpiSwigluI8 E{p.in[I_B1], (const float*)(p.ws + WS_ROWSC), (const float*)(p.ws + WS_WSC1), (bf16*)(p.ws + WS_ACT), (float*)(p.ws + WS_AMAXP)};
      pg8::gemm_phase<EpiSwigluI8, MoeOrder, true, true, true>(lds, g, S, E); }
    xcd_barrier(bar);
    { PH_IDS; ph_actq(p, gw, NGW, lane); }
    xcd_barrier(bar);
    { pg8::Gemm g{(const bf16*)(p.ws + WS_ACT8), (const bf16*)(p.ws + WS_W2Q), MAXTILES * 256, DM, DFF / 2};
      MoeOrder S; S.init((const int*)(p.ws + WS_META), 8, G, bid); EpiDownI8 E{p.in[I_B2], (const float*)(p.ws + WS_ROWW), (const float*)(p.ws + WS_ASC), (const float*)(p.ws + WS_WSC2), (bf16*)(p.ws + WS_Y)};
      pg8::gemm_phase<EpiDownI8, MoeOrder, true, true, true>(lds, g, S, E); }
    xcd_barrier(bar);
    { PH_IDS; pf_final(p, gw, NGW, lane); }
}

extern "C" void kernel_launch(void* const* d_in, const int* in_sizes, int n_in, void* d_out, int out_size, void* d_ws, size_t ws_size, hipStream_t stream) {
    static int grid = 0;
    if (grid == 0) {
        if (n_in != N_IN || out_size != T * DM || ws_size < WS_END) { fprintf(stderr, "kernel_launch: unexpected shapes (n_in %d out %d ws %zu need %zu)\n", n_in, out_size, ws_size, (size_t)WS_END); grid = -1; return; }
        int dev = 0, cus = 0, per_cu = 0;
        if (hipGetDevice(&dev) != hipSuccess || hipDeviceGetAttribute(&cus, hipDeviceAttributeMultiprocessorCount, dev) != hipSuccess) { grid = -1; return; }
        if (hipFuncSetAttribute((const void*)mega_fwd, hipFuncAttributeMaxDynamicSharedMemorySize, LDS_BYTES) != hipSuccess) { fprintf(stderr, "kernel_launch: hipFuncSetAttribute failed\n"); grid = -1; return; }
        if (hipOccupancyMaxActiveBlocksPerMultiprocessor(&per_cu, (const void*)mega_fwd, 512, LDS_BYTES) != hipSuccess || per_cu < 1) { fprintf(stderr, "kernel_launch: occupancy query says %d blocks per CU\n", per_cu); }
        (void)hipGetLastError();
        grid = cus;
    }
    if (grid < 0) return;
    if (hipMemsetAsync((char*)d_ws + WS_CTL, 0, CTL_BYTES, stream) != hipSuccess) return;
    Params p{};
    for (int i = 0; i < N_IN; ++i) p.in[i] = (const float*)d_in[i];
    p.out = (float*)d_out; p.ws = (unsigned char*)d_ws;
    hipLaunchKernelGGL(mega_fwd, dim3(grid), dim3(512), LDS_BYTES, stream, p);
}
```

```cpp
#include <hip/hip_runtime.h>
#include <cstdio>
#include <cstdint>
namespace pg8 {
#define PG8_LAS __attribute__((address_space(3)))
typedef unsigned short bf16_t;
typedef short bf16x8 __attribute__((ext_vector_type(8)));
typedef float f32x4 __attribute__((ext_vector_type(4)));
typedef unsigned u32x4 __attribute__((ext_vector_type(4)));
typedef unsigned v2u_t __attribute__((ext_vector_type(2)));
constexpr int BM = 256, BK = 64, HALF = 128, HTB = HALF * BK * 2  , STAGE_BYTES = 8 * HTB, NXCD = 8, WGM = 8;

__host__ __device__ __forceinline__ int lds_byte(int r, int c) { const int st = (r >> 4) * 2 + (c >> 5), rr = r & 15, cc = c & 31, ob = rr * 64 + cc * 2; return st * 1024 + (ob ^ (((ob >> 9) & 1) << 5)); }
__host__ __device__ __forceinline__ void stage_rc(int b, int& R, int& C) { const int st = b / 1024, sb = b % 1024, swz = sb ^ (((sb >> 9) & 1) << 5); R = (st >> 1) * 16 + swz / 64; C = (st & 1) * 32 + (swz % 64) / 2; }
__host__ __device__ __forceinline__ int perm32(int rho) { const int n = rho >> 4, i = rho & 15; return 8 * (i >> 2) + 4 * n + (i & 3); }

struct Unit { int pm, pn, kind; };
struct Gemm { const bf16_t* A; const bf16_t* Bt; int M, N, K; };

template <int WG = WGM> __host__ __device__ __forceinline__ void tile_of(int wgid, int nM, int nN, int& pm, int& pn) {
    const int nwg = nM * nN;
    { const int q = nwg / NXCD, r = nwg % NXCD, xcd = wgid % NXCD, off = wgid / NXCD; wgid = (xcd < r ? xcd * (q + 1) : r * (q + 1) + (xcd - r) * q) + off; }
    const int nig = WG * nN, gid = wgid / nig, fm = gid * WG, gsz = (nM - fm) < WG ? (nM - fm) : WG;
    pm = fm + ((wgid % nig) % gsz); pn = (wgid % nig) / gsz;
}
struct StaticOrder {
    int nM, nN, nwg, G, c;
    __host__ __device__ void init(int M, int N, int G_, int c_) { nM = M / BM; nN = N / BM; nwg = nM * nN; G = G_; c = c_; }
    __device__ __forceinline__ bool next(int i, Unit& u) const {
        const long L = (long)i * G + c; if (L >= nwg) return false;
        tile_of((int)L, nM, nN, u.pm, u.pn); u.kind = 0; return true;
    }
    __device__ __forceinline__ const char* pa(const Gemm& g, const Unit& u) const { return (const char*)g.A + (size_t)u.pm * ((size_t)BM * g.K * 2); }
    __device__ __forceinline__ const char* pb(const Gemm& g, const Unit& u) const { return (const char*)g.Bt + (size_t)u.pn * ((size_t)BM * g.K * 2); }
    __device__ __forceinline__ void a_ready(const Unit&) const {}
    __device__ __forceinline__ void done(const Unit&) const {}
};
__device__ __forceinline__ unsigned cvt_pk_bf16(float lo, float hi) { unsigned r; asm volatile("v_cvt_pk_bf16_f32 %0, %1, %2" : "=v"(r) : "v"(lo), "v"(hi)); return r; }
template <bool I8> __device__ __forceinline__ f32x4 mma16(bf16x8 a, bf16x8 b, f32x4 c) {
    if constexpr (I8) { typedef int i32x4 __attribute__((ext_vector_type(4)));
        return __builtin_bit_cast(f32x4, __builtin_amdgcn_mfma_i32_16x16x64_i8(__builtin_bit_cast(i32x4, a), __builtin_bit_cast(i32x4, b), __builtin_bit_cast(i32x4, c), 0, 0, 0)); }
    else return __builtin_amdgcn_mfma_f32_16x16x32_bf16(a, b, c, 0, 0, 0);
}
template <class Epi, class Sched, bool ALIGN_EPI = false, bool SP2 = false, bool I8 = false, bool GATHER = false>
__device__ __forceinline__ void gemm_phase(PG8_LAS unsigned char* lds, const Gemm g, const Sched& S, const Epi& E) {
    int tid_l = threadIdx.x; asm volatile("" : "+v"(tid_l));
    const int tid = tid_l, wid = __builtin_amdgcn_readfirstlane(tid >> 6), lane = tid & 63, wr = wid >> 2, wc = wid & 3, fr = lane & 15, fq = lane >> 4;
    const int K = g.K, nt = K / BK;
    unsigned voffA[2], voffB[2];
#pragma unroll
    for (int i = 0; i < 2; ++i) { int R, C; stage_rc(tid * 16 + i * 8192, R, C); const int Rb = Epi::PERM ? ((R & ~31) + perm32(R & 31)) : R;
        voffA[i] = (unsigned)(R * K + C) * 2u; voffB[i] = (unsigned)(Rb * K + C) * 2u; }
    const size_t kstep = (size_t)(BK * 2);
    const size_t hstep = (size_t)HALF * K * 2;
    const unsigned ldsw = (unsigned)wid * 1024u;
    const int aoff = lds_byte(wr * 64 + fr, fq * 8), boff = lds_byte(wc * 32 + fr, fq * 8);
#define PG8_SA(b, h) (((b) * 2 + (h)) * HTB)
#define PG8_SB(b, h) ((4 + (b) * 2 + (h)) * HTB)
#define PG8_STAGE(bufoff, gbase, voff) do { _Pragma("unroll") for (int _i = 0; _i < 2; ++_i) \
        __builtin_amdgcn_global_load_lds((const unsigned*)((const char*)(gbase) + (voff)[_i]), (PG8_LAS unsigned*)(lds + (bufoff) + ldsw + _i * 8192), 16, 0, 0); } while (0)
#define PG8_STAGE_A(bufoff, ptr, h) do { if constexpr (GATHER) PG8_STAGE(bufoff, ptr, cuo + 2 * (h)); else PG8_STAGE(bufoff, (ptr) + (h) * hstep, voffA); } while (0)
#define PG8_LDA(dst, b, h) do { _Pragma("unroll") for (int m = 0; m < 4; ++m) _Pragma("unroll") for (int k = 0; k < 2; ++k) dst[m][k] = *(const PG8_LAS bf16x8*)(lds + PG8_SA(b, h) + aoff + m * 2048 + k * 1024); } while (0)
#define PG8_LDB(dst, b, h) do { _Pragma("unroll") for (int n = 0; n < 2; ++n) _Pragma("unroll") for (int k = 0; k < 2; ++k) dst[n][k] = *(const PG8_LAS bf16x8*)(lds + PG8_SB(b, h) + boff + n * 2048 + k * 1024); } while (0)
#define PG8_MMA(ai, bj, At, Bt) do { __builtin_amdgcn_s_setprio(1); _Pragma("unroll") for (int m = 0; m < 4; ++m) _Pragma("unroll") for (int n = 0; n < 2; ++n) _Pragma("unroll") for (int k = 0; k < 2; ++k) \
        acc[ai][bj][m][n] = mma16<I8>(Bt[n][k], At[m][k], acc[ai][bj][m][n]); __builtin_amdgcn_s_setprio(0); } while (0)
#define PG8_WAIT_V(n) asm volatile("s_waitcnt vmcnt(" #n ")" ::: "memory")
#define PG8_WAIT_L(n) asm volatile("s_waitcnt lgkmcnt(" #n ")" ::: "memory")
#define PG8_BAR __builtin_amdgcn_s_barrier()
#define PG8_SCHED __builtin_amdgcn_sched_barrier(0)
    Unit cur, nxt; int ui = 0;
    if (!S.next(0, cur)) return;
    unsigned cuo[4] = {0u, 0u, 0u, 0u}, cb0 = 0u; v2u_t raw = {0u, 0u};
    if constexpr (GATHER) { int R0, C0; stage_rc(tid * 16, R0, C0); cb0 = (unsigned)C0 * 2u; unsigned ro = (unsigned)R0 * 8u; asm volatile("" : "+v"(ro));
        Unit u1; const bool h1 = S.next(1, u1); const v2u_t r0 = *(const v2u_t*)((const char*)S.rowtab + (size_t)cur.pm * 512 + ro); raw = *(const v2u_t*)((const char*)S.rowtab + (size_t)(h1 ? u1.pm : cur.pm) * 512 + ro);
        cuo[0] = ((r0.x & 0xffffu) << 11) + cb0; cuo[1] = ((r0.x >> 16) << 11) + cb0; cuo[2] = ((r0.y & 0xffffu) << 11) + cb0; cuo[3] = ((r0.y >> 16) << 11) + cb0; }
    f32x4 acc[2][2][4][2];
#pragma unroll
    for (int a = 0; a < 2; ++a)
#pragma unroll
        for (int b = 0; b < 2; ++b)
#pragma unroll
            for (int m = 0; m < 4; ++m)
#pragma unroll
                for (int n = 0; n < 2; ++n) acc[a][b][m][n] = (f32x4){0.f, 0.f, 0.f, 0.f};
    bf16x8 At[4][2], B0[2][2], B1[2][2];
    const char* cA = S.pa(g, cur); const char* cB = S.pb(g, cur);
    S.a_ready(cur);
    if constexpr (SP2) {
        PG8_STAGE(PG8_SB(0, 0), cB, voffB); PG8_STAGE(PG8_SB(0, 1), cB + hstep, voffB); PG8_STAGE_A(PG8_SA(0, 0), cA, 0); PG8_STAGE_A(PG8_SA(0, 1), cA, 1);
        if (wr == 1) PG8_BAR;
        PG8_WAIT_V(2); PG8_BAR;
        PG8_STAGE(PG8_SB(1, 0), cB + kstep, voffB); PG8_STAGE_A(PG8_SA(1, 0), cA + kstep, 0); PG8_STAGE(PG8_SB(1, 1), cB + hstep + kstep, voffB);
        PG8_WAIT_V(6); PG8_BAR;
    } else {
        PG8_STAGE(PG8_SB(0, 0), cB, voffB); PG8_STAGE(PG8_SA(0, 0), cA, voffA); PG8_STAGE(PG8_SB(0, 1), cB + hstep, voffB); PG8_STAGE(PG8_SA(0, 1), cA + hstep, voffA);
        if (wr == 1) PG8_BAR;
        PG8_WAIT_V(4); PG8_BAR;
        PG8_STAGE(PG8_SB(1, 0), cB + kstep, voffB); PG8_STAGE(PG8_SA(1, 0), cA + kstep, voffA); PG8_STAGE(PG8_SB(1, 1), cB + hstep + kstep, voffB);
        PG8_WAIT_V(6); PG8_BAR;
    }
    for (;;) {
        const bool has_next = S.next(ui + 1, nxt);
        const char* nA = has_next ? S.pa(g, nxt) : cA; const char* nB = has_next ? S.pb(g, nxt) : cB;
        for (int t = 0; t < nt; t += 2) {
            const bool last = (t == nt - 2);
            const char* a1 = cA + (size_t)(t + 1) * kstep;
            const char* a2 = last ? nA : cA + (size_t)(t + 2) * kstep; const char* b2 = last ? nB : cB + (size_t)(t + 2) * kstep;
            const char* a3 = a2 + kstep; const char* b3 = b2 + kstep;
            if (last && has_next) S.a_ready(nxt);
            if constexpr (SP2) {
            PG8_LDB(B0, 0, 0); PG8_LDB(B1, 0, 1); PG8_SCHED; PG8_LDA(At, 0, 0); PG8_STAGE_A(PG8_SA(1, 1), a1, 1);
            if constexpr (GATHER) { unsigned rx = raw.x, ry = raw.y; asm volatile("" : "+v"(rx), "+v"(ry));
                const unsigned n0 = ((rx & 0xffffu) << 11) + cb0, n1 = ((rx >> 16) << 11) + cb0, n2 = ((ry & 0xffffu) << 11) + cb0, n3 = ((ry >> 16) << 11) + cb0;
                cuo[0] = last ? n0 : cuo[0]; cuo[1] = last ? n1 : cuo[1]; cuo[2] = last ? n2 : cuo[2]; cuo[3] = last ? n3 : cuo[3]; }
            PG8_WAIT_V(8); PG8_WAIT_L(0); PG8_BAR; PG8_MMA(0, 0, At, B0); PG8_MMA(0, 1, At, B1); PG8_BAR; PG8_SCHED;
            PG8_LDA(At, 0, 1); PG8_STAGE(PG8_SB(0, 0), b2, voffB); PG8_STAGE(PG8_SB(0, 1), b2 + hstep, voffB); PG8_STAGE_A(PG8_SA(0, 0), a2, 0);
            PG8_WAIT_V(8); PG8_WAIT_L(0); PG8_BAR; PG8_MMA(1, 0, At, B0); PG8_MMA(1, 1, At, B1); PG8_BAR; PG8_SCHED;
            PG8_LDB(B0, 1, 0); PG8_LDB(B1, 1, 1); PG8_SCHED; PG8_LDA(At, 1, 0); PG8_STAGE_A(PG8_SA(0, 1), a2, 1);
            PG8_WAIT_V(8); PG8_WAIT_L(0); PG8_BAR; PG8_MMA(0, 0, At, B0); PG8_MMA(0, 1, At, B1); PG8_BAR; PG8_SCHED;
            PG8_LDA(At, 1, 1); PG8_STAGE(PG8_SB(1, 0), b3, voffB); PG8_STAGE(PG8_SB(1, 1), b3 + hstep, voffB); PG8_STAGE_A(PG8_SA(1, 0), a3, 0);
            PG8_WAIT_V(8); PG8_WAIT_L(0); PG8_BAR; PG8_MMA(1, 0, At, B0); PG8_MMA(1, 1, At, B1); PG8_BAR; PG8_SCHED;
            } else {
            PG8_LDB(B0, 0, 0); PG8_SCHED; PG8_LDA(At, 0, 0); PG8_STAGE(PG8_SA(1, 1), a1 + hstep, voffA);
            PG8_WAIT_L(8); PG8_BAR; PG8_WAIT_L(0); PG8_MMA(0, 0, At, B0); PG8_BAR; PG8_SCHED;
            PG8_LDB(B1, 0, 1); PG8_STAGE(PG8_SB(0, 0), b2, voffB);
            PG8_BAR; PG8_WAIT_L(0); PG8_MMA(0, 1, At, B1); PG8_BAR;
            PG8_LDA(At, 0, 1); PG8_STAGE(PG8_SA(0, 0), a2, voffA);
            PG8_BAR; PG8_WAIT_L(0); PG8_MMA(1, 0, At, B0); PG8_BAR; PG8_SCHED;
            PG8_STAGE(PG8_SB(0, 1), b2 + hstep, voffB);
            PG8_WAIT_V(6); PG8_BAR; PG8_MMA(1, 1, At, B1); PG8_BAR;
            PG8_LDB(B0, 1, 0); PG8_SCHED; PG8_LDA(At, 1, 0); PG8_STAGE(PG8_SA(0, 1), a2 + hstep, voffA);
            PG8_WAIT_L(8); PG8_BAR; PG8_WAIT_L(0); PG8_MMA(0, 0, At, B0); PG8_BAR; PG8_SCHED;
            PG8_LDB(B1, 1, 1); PG8_STAGE(PG8_SB(1, 0), b3, voffB);
            PG8_BAR; PG8_WAIT_L(0); PG8_MMA(0, 1, At, B1); PG8_BAR;
            PG8_LDA(At, 1, 1); PG8_STAGE(PG8_SA(1, 0), a3, voffA);
            PG8_BAR; PG8_WAIT_L(0); PG8_MMA(1, 0, At, B0); PG8_BAR; PG8_SCHED;
            PG8_STAGE(PG8_SB(1, 1), b3 + hstep, voffB);
            PG8_WAIT_V(6); PG8_BAR; PG8_MMA(1, 1, At, B1); PG8_BAR;
            }
        }
        if constexpr (ALIGN_EPI) { if (wr == 0) PG8_BAR; }
        if constexpr (GATHER) { static_assert(SP2 && !Epi::AFTER_DRAIN, "GATHER is written for the SP2 loop"); int R0, C0; stage_rc(tid * 16, R0, C0); Unit u2; const bool h2 = S.next(ui + 2, u2);
            unsigned ro = (unsigned)R0 * 8u; asm volatile("" : "+v"(ro)); raw = *(const v2u_t*)((const char*)S.rowtab + (size_t)(h2 ? u2.pm : cur.pm) * 512 + ro); PG8_SCHED; }
        if constexpr (!Epi::AFTER_DRAIN) { E(acc, cur, wr, wc, fr, fq); S.done(cur); }
        if (!has_next) break;
#pragma unroll
        for (int a = 0; a < 2; ++a)
#pragma unroll
            for (int b = 0; b < 2; ++b)
#pragma unroll
                for (int m = 0; m < 4; ++m)
#pragma unroll
                    for (int n = 0; n < 2; ++n) acc[a][b][m][n] = (f32x4){0.f, 0.f, 0.f, 0.f};
        cur = nxt; cA = nA; cB = nB; ++ui;
        if constexpr (ALIGN_EPI) { if (wr == 1) PG8_BAR; }
    }
    PG8_WAIT_V(0);
    if constexpr (!ALIGN_EPI) { if (wr == 0) PG8_BAR; }
    PG8_BAR;
    if constexpr (Epi::AFTER_DRAIN) { E.fused(acc, cur, wr, wc, fr, fq, lds, wid, lane); S.done(cur); }
#undef PG8_SA
#undef PG8_SB
#undef PG8_STAGE
#undef PG8_STAGE_A
#undef PG8_LDA
#undef PG8_LDB
#undef PG8_MMA
#undef PG8_WAIT_V
#undef PG8_WAIT_L
#undef PG8_BAR
#undef PG8_SCHED
}
}

#define GAS __attribute__((address_space(1)))
#define LAS __attribute__((address_space(3)))
typedef unsigned short bf16;
typedef unsigned v4u __attribute__((ext_vector_type(4)));
typedef unsigned v2u __attribute__((ext_vector_type(2)));
typedef float f32x4 __attribute__((ext_vector_type(4)));
typedef short bf16x8 __attribute__((ext_vector_type(8)));

constexpr int NB = 8, SEQ = 4096, DM = 2048, T = NB * SEQ;
constexpr int NPT = 23;
constexpr int NE = 32, DFF = 2048;
constexpr int MAXTILES = 544;
constexpr float RMS_EPS = 1e-5f;
constexpr int NVB = 256, TPV = T / NVB;

enum { I_X = 0, I_NMIX, I_WIN, I_WA2, I_BA, I_GLAG, I_PEK, I_WK1, I_WK2, I_PEV, I_WV1, I_WV2, I_NSAG, I_RELB, I_WOUT, I_NFFN, I_RW, I_RB, I_W1, I_B1, I_W2, I_B2, I_NFIN, N_IN };

constexpr size_t MiB = 1u << 20;
constexpr size_t al(size_t x) { return (x + 255) & ~(size_t)255; }
constexpr size_t WS_CTL = 0, CTL_BYTES = 1 * MiB;
constexpr size_t WS_CNT = WS_CTL + CTL_BYTES;
constexpr size_t WS_META = WS_CNT + al(NVB * 32 * 4);
constexpr size_t WS_EIDX = WS_META + al((64 + MAXTILES) * 4);
constexpr size_t WS_LRNK = WS_EIDX + al((size_t)T * 4 * 4);
constexpr size_t WS_GATE = WS_LRNK + al((size_t)T * 4 * 4);
constexpr size_t WS_POS = WS_GATE + al((size_t)T * 4 * 4);
constexpr size_t WS_ROWW = WS_POS + al((size_t)T * 4 * 4);
constexpr size_t WS_WINT = al(WS_ROWW + (size_t)MAXTILES * 256 * 4);
constexpr size_t WS_WOT = WS_WINT + (size_t)NPT * 256 * DM * 2;
constexpr size_t WS_WKCT = WS_WOT + (size_t)DM * DM * 2;
constexpr size_t WS_WVCT = WS_WKCT + (size_t)256 * 2048 * 2;
constexpr size_t WS_W1T = WS_WVCT + (size_t)256 * 2048 * 2;
constexpr size_t WS_W2T = WS_W1T + (size_t)NE * 4096 * DM * 2;
constexpr size_t WS_XN = WS_W2T + (size_t)NE * DM * DFF * 2;
constexpr size_t WS_GQ = WS_XN + (size_t)T * DM * 2;
constexpr size_t WS_GK = WS_GQ + (size_t)T * 512 * 2;
constexpr size_t WS_GV = WS_GK + (size_t)T * 512 * 2;
constexpr size_t WS_GG = WS_GV + (size_t)T * 1024 * 2;
constexpr size_t WS_NQ = WS_GG + (size_t)T * 1024 * 2;
constexpr size_t WS_KC = WS_NQ + (size_t)T * 1024 * 2;
constexpr size_t WS_VC = WS_KC + (size_t)T * 256 * 2;
constexpr size_t WS_KS = WS_VC + (size_t)T * 256 * 2;
constexpr size_t WS_KW = WS_KS + (size_t)T * 256 * 2;
constexpr size_t WS_VST = WS_KW + (size_t)T * 256 * 2;
constexpr size_t WS_VWT = WS_VST + (size_t)T * 256 * 2;
constexpr size_t WS_SM = WS_VWT + (size_t)T * 256 * 2;
constexpr size_t WS_LA = WS_SM + (size_t)T * 64 * 2;
constexpr size_t WS_OG = WS_LA + (size_t)T * 512 * 4;
constexpr size_t WS_ON = WS_OG + (size_t)T * 1024 * 4;
constexpr size_t WS_KCMP = WS_ON + (size_t)T * 1024 * 4;
constexpr size_t WS_VCMPT = WS_KCMP + (size_t)16 * 256 * 128 * 2;
constexpr size_t WS_A2 = WS_VCMPT + (size_t)16 * 256 * 128 * 2;
constexpr size_t WS_HN = WS_A2 + (size_t)T * DM * 2;
constexpr size_t WS_XG = WS_HN + (size_t)T * DM * 2;
constexpr size_t WS_ACT = WS_XG + (size_t)MAXTILES * 256 * DM * 2;
constexpr size_t WS_END = WS_ACT + (size_t)MAXTILES * 256 * DFF * 2;

__device__ __forceinline__ unsigned f2bf(float f) { unsigned u = __builtin_bit_cast(unsigned, f); return (u + 0x7fffu + ((u >> 16) & 1u)) >> 16; }
__device__ __forceinline__ unsigned pk2(float lo, float hi) { return f2bf(lo) | (f2bf(hi) << 16); }
__device__ __forceinline__ float bf2f(unsigned short v) { return __builtin_bit_cast(float, (unsigned)v << 16); }
__device__ __forceinline__ float bflo(unsigned w) { return __builtin_bit_cast(float, w << 16); }
__device__ __forceinline__ float bfhi(unsigned w) { return __builtin_bit_cast(float, w & 0xffff0000u); }
__device__ __forceinline__ float wave_sum(float v) {
#pragma unroll
    for (int o = 1; o < 64; o <<= 1) v += __shfl_xor(v, o);
    return v;
}
__device__ __forceinline__ float wave_max(float v) {
#pragma unroll
    for (int o = 1; o < 64; o <<= 1) v = fmaxf(v, __shfl_xor(v, o));
    return v;
}
#define LDS_WAIT() asm volatile("s_waitcnt lgkmcnt(0)" ::: "memory")

__device__ const unsigned char kBucket[128] = {0, 1, 2, 3, 4, 5, 6, 7, 8, 9, 10, 11, 12, 13, 14, 15, 16, 16, 16, 17, 17, 18, 18, 18, 19, 19, 19, 20, 20, 20, 20, 21, 21, 21, 21, 22, 22, 22, 22, 22, 23, 23, 23, 23, 23, 23, 24, 24, 24, 24, 24, 24, 25, 25, 25, 25, 25, 25, 25, 26, 26, 26, 26, 26, 26, 26, 26, 27, 27, 27, 27, 27, 27, 27, 27, 27, 27, 28, 28, 28, 28, 28, 28, 28, 28, 28, 28, 29, 29, 29, 29, 29, 29, 29, 29, 29, 29, 29, 29, 30, 30, 30, 30, 30, 30, 30, 30, 30, 30, 30, 30, 30, 30, 31, 31, 31, 31, 31, 31, 31, 31, 31, 31, 31, 31, 31, 31, 31};

struct Params {
    const float* in[N_IN];
    float* out;
    unsigned char* ws;
};

template <class F>
__device__ __forceinline__ void transpose_item(const float* W, int ldw, int k0, int n0, int nlim, LAS float* scr, int lane, F dst) {
#pragma unroll 8
    for (int i = 0; i < 32; ++i) { const int kk = 2 * i + (lane >> 5); const int n = n0 + (lane & 31); scr[kk * 33 + (lane & 31)] = n < nlim ? W[(size_t)(k0 + kk) * ldw + n] : 0.f; }
    LDS_WAIT(); asm volatile("" ::: "memory");
    const int c = lane & 7;
#pragma unroll
    for (int j = 0; j < 4; ++j) { const int nn = (lane >> 3) + 8 * j; const int n = n0 + nn; const LAS float* s = scr + (8 * c) * 33 + nn;
        bf16* rowp; float sc;
        if (n < nlim && dst(n, rowp, sc)) {
            v4u o; o.x = pk2(s[0 * 33] * sc, s[1 * 33] * sc); o.y = pk2(s[2 * 33] * sc, s[3 * 33] * sc); o.z = pk2(s[4 * 33] * sc, s[5 * 33] * sc); o.w = pk2(s[6 * 33] * sc, s[7 * 33] * sc);
            *(v4u*)(rowp + 8 * c) = o; } }
    LDS_WAIT(); asm volatile("" ::: "memory");
}
__device__ __forceinline__ int win_row(int n, float& sc) {
    sc = 1.f;
    if (n < 512) { sc = 0.08838834764831845f; return n; }
    if (n < 1024) return n;
    if (n < 2048) return n;
    if (n < 3072) return n;
    if (n < 3088) return 5120 + (n - 3072);
    if (n < 4112) { sc = 0.08838834764831845f; return 3072 + (n - 3088); }
    if (n < 4368) return 4096 + (n - 4112);
    if (n < 4624) return 4352 + (n - 4368);
    if (n < 4880) return 4608 + (n - 4624);
    if (n < 5136) return 5376 + (n - 4880);
    if (n < 5392) return 4864 + (n - 5136);
    if (n < 5648) return 5632 + (n - 5392);
    return 5136 + (n - 5648);
}
constexpr size_t WS_PEVP = WS_W2T;
__device__ __forceinline__ void p0_prologue(const Params& p, LAS unsigned char* lds, int gw, int NGW, int wave, int lane) {
    LAS float* scr = (LAS float*)(lds + wave * 16384);
    bf16* WinT = (bf16*)(p.ws + WS_WINT); bf16* WoT = (bf16*)(p.ws + WS_WOT); bf16* WkcT = (bf16*)(p.ws + WS_WKCT); bf16* WvcT = (bf16*)(p.ws + WS_WVCT);
    bf16* W1T = (bf16*)(p.ws + WS_W1T); bf16* W2T = (bf16*)(p.ws + WS_W2T);
    constexpr int I_IN = 32 * 178, I_O = 32 * 64, I_C = 64 * 4, I_E1 = 32 * 128, I_E2 = 32 * 64;
    constexpr int I_PE = 2 * 64;
    constexpr int NITEMS = I_O + 2 * I_C + I_PE;
    (void)I_IN; (void)WinT;
    for (int it = gw; it < NITEMS; it += NGW) {
        int r = it;
        if (r < I_O) { const int kb = r / 64, nb = r % 64, k0 = kb * 64;
            transpose_item(p.in[I_WOUT], DM, k0, nb * 32, DM, scr, lane, [&](int n, bf16*& rowp, float& sc) { sc = 1.f; rowp = WoT + (size_t)n * DM + k0; return true; }); continue; } r -= I_O;
        if (r >= 2 * I_C) { r -= 2 * I_C; const int which = r >> 6, kq = r & 63; const float* pe = p.in[which ? I_PEV : I_PEK] + kq * 64; const float* w1 = p.in[which ? I_WV1 : I_WK1] + (size_t)kq * 64 * 128 + lane;
            float a0 = 0.f, a1 = 0.f;
#pragma unroll
            for (int k = 0; k < 64; ++k) { const float pv = pe[k]; a0 += pv * w1[k * 128]; a1 += pv * w1[k * 128 + 64]; }
            float* dst = (float*)(p.ws + WS_PEVP) + (size_t)(which * 64 + kq) * 128 + lane; dst[0] = a0; dst[64] = a1; continue; }
        { const int which = r / I_C; r %= I_C; const int kb = r / 4, nb = r % 4, k0 = kb * 64;
            bf16* dstm = which ? WvcT : WkcT;
            transpose_item(p.in[which ? I_WV1 : I_WK1], 128, k0, nb * 32, 128, scr, lane, [&](int n, bf16*& rowp, float& sc) { sc = 1.f; rowp = dstm + (size_t)(n + (k0 >= 2048 ? 128 : 0)) * 2048 + (k0 & 2047); return true; }); }
        (void)I_E1; (void)I_E2; (void)W1T; (void)W2T;
    }
    const float* x = p.in[I_X]; const float* gm = p.in[I_NMIX];
    for (int m = gw; m < T; m += NGW) {
        const f32x4* xr = (const f32x4*)(x + (size_t)m * DM) + lane; f32x4 v[8]; float s = 0.f;
#pragma unroll
        for (int j = 0; j < 8; ++j) { v[j] = xr[64 * j]; s += (v[j].x * v[j].x + v[j].y * v[j].y) + (v[j].z * v[j].z + v[j].w * v[j].w); }
        const float rstd = 1.f / sqrtf(wave_sum(s) * (1.f / DM) + RMS_EPS);
        float mxr = 0.f;
#pragma unroll
        for (int j = 0; j < 8; ++j) { const f32x4 g4 = ((const f32x4*)gm)[lane + 64 * j]; v[j].x *= rstd * g4.x; v[j].y *= rstd * g4.y; v[j].z *= rstd * g4.z; v[j].w *= rstd * g4.w;
            mxr = fmaxf(mxr, fmaxf(fmaxf(fabsf(v[j].x), fabsf(v[j].y)), fmaxf(fabsf(v[j].z), fabsf(v[j].w)))); }
        mxr = wave_max(mxr); const float qs = mxr > 0.f ? mxr * (1.f / 127.f) : 1.f, qi = 1.f / qs;
        unsigned* o4 = (unsigned*)(p.ws + WS_XN + (size_t)m * DM) + lane;
#pragma unroll
        for (int j = 0; j < 8; ++j) { const int q0 = (int)rintf(v[j].x * qi), q1 = (int)rintf(v[j].y * qi), q2 = (int)rintf(v[j].z * qi), q3 = (int)rintf(v[j].w * qi);
            o4[64 * j] = ((unsigned)q0 & 0xffu) | (((unsigned)q1 & 0xffu) << 8) | (((unsigned)q2 & 0xffu) << 16) | (((unsigned)q3 & 0xffu) << 24); }
        if (lane == 0) ((float*)(p.ws + WS_XN + (size_t)T * DM))[m] = qs;
    }
}
#define XB_TMO      128
#define XB_XCNT(j)  (256  + 64 * (j))
#define XB_XSUB(j)  (1280 + 64 * (j))
#define XB_XGEN(j)  (2304 + 64 * (j))
#define XB_TOP      3328
#define XB_TOPGEN   3392
#define XCD_BAR_WORDS 3456
#define XB_SPIN_CAP (1u << 18)

__device__ __forceinline__ unsigned xb_ld(unsigned* p)              { return __hip_atomic_load(p, __ATOMIC_RELAXED, __HIP_MEMORY_SCOPE_AGENT); }
__device__ __forceinline__ unsigned xb_add(unsigned* p, unsigned v) { return __hip_atomic_fetch_add(p, v, __ATOMIC_RELAXED, __HIP_MEMORY_SCOPE_AGENT); }
__device__ __forceinline__ unsigned xb_xcc_id() { return (unsigned)__builtin_amdgcn_s_getreg((3 << 11) | 20) & 0xFu; }
#define XB_SPIN(cond, bar) do { unsigned _sp = 0; while (cond) { __builtin_amdgcn_s_sleep(1); \
    if ((++_sp & 255u) == 0u) { if (xb_ld(&(bar)[XB_TMO])) break; if (_sp > XB_SPIN_CAP) { atomicAdd(&(bar)[XB_TMO], 1u); break; } } } } while (0)

struct XcdBarrier {
    unsigned* bar; unsigned x;
    volatile LAS unsigned* st;
};

__device__ __forceinline__ XcdBarrier xcd_barrier_post(unsigned* bar, volatile LAS unsigned* st) {
    XcdBarrier b; b.bar = bar; b.x = xb_xcc_id(); b.st = st;
    if (threadIdx.x == 0) (void)xb_add(&bar[XB_XCNT(b.x)], 1u);
    return b;
}
__device__ __forceinline__ void xcd_barrier_complete(unsigned* bar, unsigned x, unsigned& nloc, unsigned& nx) {
    const unsigned G = gridDim.x * gridDim.y * gridDim.z;
    unsigned sum, cnt, mine, sp = 0u;
    for (;;) {
        sum = 0u; cnt = 0u; mine = 0u;
#pragma unroll
        for (unsigned j = 0; j < 16; ++j) { const unsigned c = xb_ld(&bar[XB_XCNT(j)]); sum += c; cnt += (c > 0u) ? 1u : 0u; mine = (j == x) ? c : mine; }
        if (sum == G) break;
        __builtin_amdgcn_s_sleep(1);
        if ((++sp & 255u) == 0u) { if (xb_ld(&bar[XB_TMO])) break; if (sp > XB_SPIN_CAP) { atomicAdd(&bar[XB_TMO], 1u); break; } }
    }
    nloc = mine > 0u ? mine : 1u; nx = cnt > 0u ? cnt : 1u;
}

__device__ __forceinline__ void xcd_barrier(const XcdBarrier& b) {
    asm volatile("s_waitcnt vmcnt(0)" ::: "memory");
    __syncthreads();
    if (threadIdx.x == 0) {
        unsigned* bar = b.bar;
        __builtin_amdgcn_s_waitcnt(0);
        unsigned nloc = b.st[0], nx = b.st[1];
        if (nloc == 0u) { xcd_barrier_complete(bar, b.x, nloc, nx); b.st[0] = nloc; b.st[1] = nx; }
        const unsigned old = xb_add(&bar[XB_XSUB(b.x)], 1u);
        const unsigned gen = old / nloc;
        if (old + 1u == (gen + 1u) * nloc) {
            __builtin_amdgcn_fence(__ATOMIC_RELEASE, "agent");
            asm volatile("s_waitcnt vmcnt(0)" ::: "memory");
            const unsigned og = xb_add(&bar[XB_TOP], 1u);
            const unsigned tg = og / nx;
            if (og + 1u == (tg + 1u) * nx) xb_add(&bar[XB_TOPGEN], 1u);
            else XB_SPIN(xb_ld(&bar[XB_TOPGEN]) == tg, bar);
            __builtin_amdgcn_fence(__ATOMIC_ACQUIRE, "agent");
            xb_add(&bar[XB_XGEN(b.x)], 1u);
            asm volatile("s_waitcnt vmcnt(0)" ::: "memory");
        } else {
            XB_SPIN(xb_ld(&bar[XB_XGEN(b.x)]) == gen, bar);
            __builtin_amdgcn_fence(__ATOMIC_ACQUIRE, "agent");
            asm volatile("s_waitcnt vmcnt(0)" ::: "memory");
        }
    }
    __syncthreads();
}

struct ProjOrder : pg8::StaticOrder {
    const bf16* xn; const bf16* wt;
    __device__ __forceinline__ bool next(int i, pg8::Unit& u) const { if (!pg8::StaticOrder::next(i, u)) return false; u.kind = (u.pn >= 21) ? 1 : 0; return true; }
    __device__ __forceinline__ const char* pa(const pg8::Gemm& g, const pg8::Unit& u) const { return u.kind ? (const char*)wt + (size_t)u.pn * ((size_t)256 * g.K * 2) : (const char*)xn + (size_t)u.pm * ((size_t)256 * g.K * 2); }
    __device__ __forceinline__ const char* pb(const pg8::Gemm& g, const pg8::Unit& u) const { return u.kind ? (const char*)xn + (size_t)u.pm * ((size_t)256 * g.K * 2) : (const char*)wt + (size_t)u.pn * ((size_t)256 * g.K * 2); }
};
struct EpiRes {
    static constexpr bool PERM = false, AFTER_DRAIN = false;
    const float* x; float* h;
    __device__ __forceinline__ void operator()(const pg8::f32x4 (&acc)[2][2][4][2], const pg8::Unit& u, int wr, int wc, int fr, int fq) const {
        const int row0 = u.pm * 256 + wr * 64 + fr, col0 = u.pn * 256 + wc * 32 + 4 * fq;
#pragma unroll
        for (int ai = 0; ai < 2; ++ai)
#pragma unroll
            for (int m = 0; m < 4; ++m) { const size_t off = (size_t)(row0 + ai * 128 + m * 16) * DM + col0;
#pragma unroll
                for (int bj = 0; bj < 2; ++bj)
#pragma unroll
                    for (int n = 0; n < 2; ++n) { const pg8::f32x4 xv = *(const pg8::f32x4*)(x + off + bj * 128 + n * 16); *(pg8::f32x4*)(h + off + bj * 128 + n * 16) = xv + acc[ai][bj][m][n]; } }
    }
};
struct MoeOrder {
    int nM, nN, nwg, G, c; const int* tile_exp;
    __device__ __forceinline__ void init(const int* meta, int nN_, int G_, int c_) { nM = meta[0]; nN = nN_; nwg = nM * nN; G = G_; c = c_; tile_exp = meta + 64; }
    __device__ __forceinline__ bool next(int i, pg8::Unit& u) const {
        const long L = (long)i * G + c; if (L >= nwg) return false;
        pg8::tile_of<8>((int)L, nM, nN, u.pm, u.pn); u.kind = tile_exp[u.pm]; return true;
    }
    __device__ __forceinline__ const char* pa(const pg8::Gemm& g, const pg8::Unit& u) const { return (const char*)g.A + (size_t)u.pm * ((size_t)256 * g.K * 2); }
    __device__ __forceinline__ const char* pb(const pg8::Gemm& g, const pg8::Unit& u) const { return (const char*)g.Bt + ((size_t)u.kind * nN + u.pn) * ((size_t)256 * g.K * 2); }
    __device__ __forceinline__ void a_ready(const pg8::Unit&) const {}
    __device__ __forceinline__ void done(const pg8::Unit&) const {}
};

struct MoeOrderG : MoeOrder { const unsigned short* rowtab;
    __device__ __forceinline__ const char* pa(const pg8::Gemm& g, const pg8::Unit&) const { return (const char*)g.A; } };

__device__ __forceinline__ float gelu_tanh(float x) { const float u = 0.7978845608028654f * (x + 0.044715f * x * x * x); const float e = __expf(2.f * u); return 0.5f * x * (1.f + (1.f - 2.f / (e + 1.f))); }
__device__ __forceinline__ void ph_cmp_fin_simple(const Params& p, LAS float* tl, int id, int n, const float* LHall, const float* PEVall) {
    LAS float* hid = tl + 4096;
    const int which = id / (16 * 255), rem = id % (16 * 255), bg = rem / 255, c = rem % 255;
    const float* w2 = p.in[which ? I_WV2 : I_WK2];
    const float* LH = LHall + ((size_t)which * 4096 + bg * 256) * 256;
    float pev = 0.f;
#pragma unroll 8
    for (int q = 0; q < 64; ++q) pev += PEVall[(size_t)(which * 64 + q) * 128 + n];
    const float a = LH[(size_t)c * 256 + n] + LH[(size_t)(c + 1) * 256 + 128 + n] + pev;
    hid[n] = gelu_tanh(a);
    __syncthreads();
    float o = 0.f;
    for (int m = 0; m < 128; ++m) o += hid[m] * w2[m * 128 + n];
    if (which == 0) ((bf16*)(p.ws + WS_KCMP))[((size_t)bg * 256 + c) * 128 + n] = (bf16)f2bf(o);
    else ((bf16*)(p.ws + WS_VCMPT))[((size_t)bg * 128 + n) * 256 + c] = (bf16)f2bf(o);
}

namespace nsa {
constexpr int KB0 = 0, KB1 = 16384, VB0 = 32768, VB1 = 49152, LUT = 65536;
constexpr int QST = LUT + 4096, IMP = QST + 65536, SELM = IMP + 16384, LDS_END = SELM + 512;
constexpr float LOG2E = 1.4426950408889634f;
typedef float f4 __attribute__((ext_vector_type(4)));

typedef unsigned u2v __attribute__((ext_vector_type(2)));
__device__ __forceinline__ float rmax16(float x) { const unsigned u = __float_as_uint(x); const u2v r = __builtin_amdgcn_permlane16_swap(u, u, false, false); return fmaxf(__uint_as_float(r[0]), __uint_as_float(r[1])); }
__device__ __forceinline__ float rmax32(float x) { const unsigned u = __float_as_uint(x); const u2v r = __builtin_amdgcn_permlane32_swap(u, u, false, false); return fmaxf(__uint_as_float(r[0]), __uint_as_float(r[1])); }
__device__ __forceinline__ float radd16(float x) { const unsigned u = __float_as_uint(x); const u2v r = __builtin_amdgcn_permlane16_swap(u, u, false, false); return __uint_as_float(r[0]) + __uint_as_float(r[1]); }
__device__ __forceinline__ float radd32(float x) { const unsigned u = __float_as_uint(x); const u2v r = __builtin_amdgcn_permlane32_swap(u, u, false, false); return __uint_as_float(r[0]) + __uint_as_float(r[1]); }
__device__ __forceinline__ float raddq(float x) { x += __int_as_float(__builtin_amdgcn_update_dpp(0, __float_as_int(x), 0xB1, 0xF, 0xF, true)); x += __int_as_float(__builtin_amdgcn_update_dpp(0, __float_as_int(x), 0x4E, 0xF, 0xF, true)); return x; }
struct Ctx {
    LAS unsigned char* lds; int tid, lane, wave, c, gq, r;
    int s0, cur;
    const LAS unsigned char* qst;
    int pos0;
    const LAS float* lutrow;
    int koff0, voff0;
    unsigned kdo[2], vdoc[2], vdos[2];
};
__device__ __forceinline__ void dma_k(const Ctx& C, const bf16* kt, LAS unsigned char* kb) {
#pragma unroll
    for (int i = 0; i < 2; ++i) __builtin_amdgcn_global_load_lds((const unsigned*)((const char*)kt + C.kdo[i]), (LAS unsigned*)(kb + (2 * C.wave + i) * 1024), 16, 0, 0); }
__device__ __forceinline__ void dma_v(const Ctx& C, const bf16* vt, const unsigned (&vdo)[2], LAS unsigned char* vb) {
#pragma unroll
    for (int i = 0; i < 2; ++i) __builtin_amdgcn_global_load_lds((const unsigned*)((const char*)vt + vdo[i]), (LAS unsigned*)(vb + (2 * C.wave + i) * 1024), 16, 0, 0); }

__device__ __forceinline__ void compute_st(const Ctx& C, const LAS unsigned char* kb, f4 (&s)[2][4]) {
#pragma unroll
    for (int ks = 0; ks < 4; ++ks) { const bf16x8 q0 = *(const LAS bf16x8*)(C.qst + ks * 1024), q1 = *(const LAS bf16x8*)(C.qst + (4 + ks) * 1024);
#pragma unroll
        for (int kt = 0; kt < 4; ++kt) { const bf16x8 a = *(const LAS bf16x8*)(kb + kt * 4096 + (C.koff0 ^ (ks * 64)));
            s[0][kt] = __builtin_amdgcn_mfma_f32_16x16x32_bf16(a, q0, ks == 0 ? (f4){0.f, 0.f, 0.f, 0.f} : s[0][kt], 0, 0, 0);
            s[1][kt] = __builtin_amdgcn_mfma_f32_16x16x32_bf16(a, q1, ks == 0 ? (f4){0.f, 0.f, 0.f, 0.f} : s[1][kt], 0, 0, 0); }
        asm volatile("" ::: "memory"); }
}
__device__ __forceinline__ void compute_pv(const Ctx& C, const LAS unsigned char* vb, const f4 (&p)[2][4], f4 (&o)[2][8]) {
#pragma unroll
    for (int i = 0; i < 2; ++i) { bf16x8 pb[2];
#pragma unroll
        for (int qt = 0; qt < 2; ++qt) { v4u w; w.x = pg8::cvt_pk_bf16(p[qt][2 * i][0], p[qt][2 * i][1]); w.y = pg8::cvt_pk_bf16(p[qt][2 * i][2], p[qt][2 * i][3]);
            w.z = pg8::cvt_pk_bf16(p[qt][2 * i + 1][0], p[qt][2 * i + 1][1]); w.w = pg8::cvt_pk_bf16(p[qt][2 * i + 1][2], p[qt][2 * i + 1][3]); pb[qt] = __builtin_bit_cast(bf16x8, w); }
#pragma unroll
        for (int dt = 0; dt < 8; ++dt) { const v2u lo = *(const LAS v2u*)(vb + dt * 2048 + (C.voff0 ^ (i * 64))), hi = *(const LAS v2u*)(vb + dt * 2048 + (C.voff0 ^ (i * 64 + 32))); const bf16x8 a = __builtin_bit_cast(bf16x8, (v4u){lo.x, lo.y, hi.x, hi.y});
#pragma unroll
            for (int qt = 0; qt < 2; ++qt) o[qt][dt] = __builtin_amdgcn_mfma_f32_16x16x32_bf16(a, pb[qt], o[qt][dt], 0, 0, 0);
            if (dt & 1) asm volatile("" ::: "memory"); } }
}
enum { M_CMP = 0, M_SEL = 1, M_WIN = 2 };
template <int MODE, bool FAR = false>
__device__ __forceinline__ void mask_bias(const Ctx& C, f4 (&s)[2][4], int kb, int n, const LAS unsigned* selw) {
    const float NEG = -__builtin_inff();
#pragma unroll
    for (int qt = 0; qt < 2; ++qt) {
        bool tokok = true;
        if (MODE == M_SEL) tokok = ((selw[(4 * qt + (C.c >> 2)) * 2 + (n >> 5)] >> (n & 31)) & 1u) != 0u;
        if (FAR) { const float be = tokok ? C.lutrow[127] : NEG;
#pragma unroll
            for (int kt = 0; kt < 4; ++kt)
#pragma unroll
                for (int rg = 0; rg < 4; ++rg) s[qt][kt][rg] = __builtin_fmaf(s[qt][kt][rg], LOG2E, be);
            continue; }
        const int dbase = (MODE == M_CMP) ? (C.pos0 + 4 * qt - 31 - 16 * (kb + 4 * C.gq)) : (C.pos0 + 4 * qt - (kb + 4 * C.gq));
#pragma unroll
        for (int kt = 0; kt < 4; ++kt) {
#pragma unroll
            for (int rg = 0; rg < 4; ++rg) { const int d = (MODE == M_CMP) ? dbase - 16 * (16 * kt + rg) : dbase - (16 * kt + rg);
                int di = d < 0 ? 0 : d; di = di > 127 ? 127 : di; const float bias = C.lutrow[di];
                bool ok = tokok && d >= 0; if (MODE == M_WIN) ok = ok && d < 512;
                s[qt][kt][rg] = ok ? __builtin_fmaf(s[qt][kt][rg], LOG2E, bias) : NEG; }
            asm volatile("" ::: "memory"); }
    }
}
__device__ __forceinline__ void softmax_step(f4 (&s)[2][4], float (&m)[2], float (&l)[2], f4 (&o)[2][8], bool rescale_o) {
#pragma unroll
    for (int qt = 0; qt < 2; ++qt) { float mx = s[qt][0][0];
#pragma unroll
        for (int kt = 0; kt < 4; ++kt)
#pragma unroll
            for (int rg = 0; rg < 4; ++rg) mx = fmaxf(mx, s[qt][kt][rg]);
        mx = rmax32(rmax16(mx));
        const float mn = fmaxf(m[qt], mx), alpha = __builtin_amdgcn_exp2f(m[qt] - mn); m[qt] = mn; float ps = 0.f;
#pragma unroll
        for (int kt = 0; kt < 4; ++kt)
#pragma unroll
            for (int rg = 0; rg < 4; ++rg) { const float e = __builtin_amdgcn_exp2f(s[qt][kt][rg] - mn); s[qt][kt][rg] = e; ps += e; }
        l[qt] = l[qt] * alpha + ps;
        if (rescale_o && __any(alpha != 1.f)) {
#pragma unroll
            for (int dt = 0; dt < 8; ++dt) o[qt][dt] = o[qt][dt] * alpha; }
    }
}
template <int MODE>
__device__ __forceinline__ void softmax_far(const Ctx& C, f4 (&s)[2][4], int n, const LAS unsigned* selw, float (&m)[2], float (&l)[2], f4 (&o)[2][8]) {
    const float b31 = C.lutrow[127];
#pragma unroll
    for (int qt = 0; qt < 2; ++qt) {
        float be = b31;
        if (MODE == M_SEL) { const bool tokok = ((selw[(4 * qt + (C.c >> 2)) * 2 + (n >> 5)] >> (n & 31)) & 1u) != 0u; be = tokok ? b31 : -__builtin_inff(); }
        float mx = fmaxf(fmaxf(s[qt][0][0], s[qt][0][1]), fmaxf(s[qt][0][2], s[qt][0][3]));
#pragma unroll
        for (int kt = 1; kt < 4; ++kt) mx = fmaxf(mx, fmaxf(fmaxf(s[qt][kt][0], s[qt][kt][1]), fmaxf(s[qt][kt][2], s[qt][kt][3])));
        mx = rmax32(rmax16(mx));
        const float mt = __builtin_fmaf(mx, LOG2E, be), mn = fmaxf(m[qt], mt), alpha = __builtin_amdgcn_exp2f(m[qt] - mn), c0 = be - mn; m[qt] = mn; float ps = 0.f;
#pragma unroll
        for (int kt = 0; kt < 4; ++kt)
#pragma unroll
            for (int rg = 0; rg < 4; ++rg) { const float e = __builtin_amdgcn_exp2f(__builtin_fmaf(s[qt][kt][rg], LOG2E, c0)); s[qt][kt][rg] = e; ps += e; }
        l[qt] = l[qt] * alpha + ps;
        if (__any(alpha != 1.f)) {
#pragma unroll
            for (int dt = 0; dt < 8; ++dt) o[qt][dt] = o[qt][dt] * alpha; }
    }
}
}

__device__ __forceinline__ void ph_nsa(const Params& p, LAS unsigned char* lds, int idx0, int idxstride, int tid_in, int wave) {
    using namespace nsa;
    int tid = tid_in; asm volatile("" : "+v"(tid));
    const int lane = tid & 63;
    Ctx C; C.lds = lds; C.tid = tid; C.lane = lane; C.wave = wave; C.c = lane & 15; C.gq = lane >> 4; C.r = lane & 3;
    C.koff0 = C.c * 256 + ((C.gq ^ C.c) * 16);
#pragma unroll
    for (int i = 0; i < 2; ++i) { const int piece = 2 * wave + i;
        { const int row = piece * 4 + (lane >> 4), chunk = (lane & 15) ^ (row & 15); C.kdo[i] = (unsigned)(row * 256 + chunk * 16); }
        { const int row = piece * 8 + (lane >> 3), chunk = (lane & 7) ^ ((row >> 1) & 7); C.vdoc[i] = (unsigned)(row * 256 * 2 + chunk * 16); C.vdos[i] = (unsigned)(row * SEQ * 2 + chunk * 16); } }
    C.voff0 = C.c * 128 + (((C.gq >> 1) ^ ((C.c >> 1) & 7)) * 16) + (C.gq & 1) * 8;
    const bf16* NQ = (const bf16*)(p.ws + WS_NQ); const bf16* SM = (const bf16*)(p.ws + WS_SM); bf16* A2 = (bf16*)(p.ws + WS_A2);
    const float* relb = p.in[I_RELB]; const float* nsag = p.in[I_NSAG];
    LAS float* lut = (LAS float*)(lds + LUT);
    for (int i = tid; i < 8 * 128; i += 512) { const int hh = i >> 7, d = i & 127; lut[i] = relb[(int)kBucket[d] * 8 + hh] * LOG2E; }
    __syncthreads();
    LAS unsigned char* qstw = lds + QST + wave * 8192 + lane * 16; C.qst = qstw;
    LAS float* imp = (LAS float*)(lds + IMP + wave * 2048);
    LAS unsigned long long* selm = (LAS unsigned long long*)(lds + SELM + wave * 64);
#define NSA_SYNC() do { asm volatile("s_waitcnt vmcnt(0)" ::: "memory"); __syncthreads(); } while (0)
    for (int idx = idx0; idx < 512; idx += idxstride) {
        const int rnd = idx >> 8, kq = idx & 255, b = kq & 7, tq = rnd == 0 ? 63 - (kq >> 3) : (kq >> 3);
        C.s0 = tq * 64; C.cur = tq;
        const int tokl0 = 8 * wave + (C.c >> 2);
        C.pos0 = C.s0 + tokl0;
        float ssq[2] = {0.f, 0.f};
        for (int g = 0; g < 2; ++g) {
            const int bg = b * 2 + g, h = g * 4 + C.r;
            C.lutrow = lut + h * 128;
            const bf16* KCMP = (const bf16*)(p.ws + WS_KCMP) + (size_t)bg * 256 * 128; const bf16* VCMPT = (const bf16*)(p.ws + WS_VCMPT) + (size_t)bg * 128 * 256;
#pragma unroll
            for (int qt = 0; qt < 2; ++qt) { const unsigned qo = (unsigned)(((b * SEQ + (C.pos0 + 4 * qt)) * 1024 + h * 128 + 8 * C.gq) * 2);
#pragma unroll
                for (int ks = 0; ks < 4; ++ks) *(LAS bf16x8*)(qstw + (qt * 4 + ks) * 1024) = *(const bf16x8*)((const char*)NQ + qo + ks * 64); }
#pragma unroll
            for (int i = 0; i < 2; ++i) *(LAS f32x4*)((LAS unsigned char*)imp + lane * 16 + i * 1024) = (f32x4){0.f, 0.f, 0.f, 0.f};
#define NSA_OROW(qt) ((char*)A2 + (unsigned)(((b * SEQ + C.pos0 + 4 * (qt)) * DM + 1024 + h * 128 + 4 * C.gq) * 2))
            const int cmaxb = C.s0 + 63 - 31; const int nct = cmaxb >= 0 ? ((cmaxb >> 4) >> 6) + 1 : 0;
            float m[2] = {-1e30f, -1e30f}, l[2] = {0.f, 0.f};
            f4 o[2][8];
            if (nct > 0) {
                dma_k(C, KCMP, lds + KB0); NSA_SYNC();
                for (int ct = 0; ct < nct; ++ct) { const int buf = ct & 1;
                    if (ct + 1 < nct) dma_k(C, KCMP + (ct + 1) * 64 * 128, lds + (buf ? KB0 : KB1));
                    f4 s[2][4]; compute_st(C, lds + (buf ? KB1 : KB0), s); mask_bias<M_CMP>(C, s, 64 * ct, 0, (const LAS unsigned*)selm); softmax_step(s, m, l, o, false);
                    NSA_SYNC(); }
            }
            float inv[2];
#pragma unroll
            for (int qt = 0; qt < 2; ++qt) { const float lt = radd32(radd16(l[qt])); inv[qt] = lt > 0.f ? 1.f / lt : 0.f; }
#pragma unroll
            for (int qt = 0; qt < 2; ++qt)
#pragma unroll
                for (int dt = 0; dt < 8; ++dt) o[qt][dt] = (f4){0.f, 0.f, 0.f, 0.f};
            if (nct > 0) {
                dma_k(C, KCMP, lds + KB0); dma_v(C, VCMPT, C.vdoc, lds + VB0); NSA_SYNC();
                for (int ct = 0; ct < nct; ++ct) { const int buf = ct & 1;
                    if (ct + 1 < nct) { dma_k(C, KCMP + (ct + 1) * 64 * 128, lds + (buf ? KB0 : KB1)); dma_v(C, VCMPT + 64 * (ct + 1), C.vdoc, lds + (buf ? VB0 : VB1)); }
                    f4 s[2][4]; compute_st(C, lds + (buf ? KB1 : KB0), s); mask_bias<M_CMP>(C, s, 64 * ct, 0, (const LAS unsigned*)selm);
#pragma unroll
                    for (int qt = 0; qt < 2; ++qt)
#pragma unroll
                        for (int kt = 0; kt < 4; ++kt) {
#pragma unroll
                            for (int rg = 0; rg < 4; ++rg) s[qt][kt][rg] = __builtin_amdgcn_exp2f(s[qt][kt][rg] - m[qt]) * inv[qt];
                            float po = (s[qt][kt][0] + s[qt][kt][1]) + (s[qt][kt][2] + s[qt][kt][3]), p3 = s[qt][kt][3];
                            po = raddq(po); p3 = raddq(p3);
                            const int nb = 16 * ct + 4 * kt + C.gq, tl = 4 * qt + (C.c >> 2);
                            if (C.r == 0) { __hip_atomic_fetch_add((float*)(imp + tl * 64 + nb), po, __ATOMIC_RELAXED, __HIP_MEMORY_SCOPE_WORKGROUP); if (nb + 1 < 64) __hip_atomic_fetch_add((float*)(imp + tl * 64 + nb + 1), p3, __ATOMIC_RELAXED, __HIP_MEMORY_SCOPE_WORKGROUP); } }
                    compute_pv(C, lds + (buf ? VB1 : VB0), s, o);
                    NSA_SYNC(); }
            }
            LDS_WAIT(); __builtin_amdgcn_wave_barrier();
            for (int tk = 0; tk < 8; ++tk) { const int n = lane; float sc;
                if (n == 0 || n == C.cur || n == C.cur - 1) sc = 1e4f; else if (n <= C.cur) sc = imp[tk * 64 + n]; else sc = -1.f;
                const int key = ((sc < 0.f ? 0 : __float_as_int(sc) + 64) & ~63) | (63 - n);
                int rank = 0;
#pragma unroll
                for (int mm = 0; mm < 64; ++mm) rank += (__builtin_amdgcn_readlane(key, mm) > key) ? 1 : 0;
                const unsigned long long mk = __ballot(rank < 16);
                if (lane == 0) selm[tk] = mk; }
            LDS_WAIT(); __builtin_amdgcn_wave_barrier();
#pragma unroll
            for (int qt = 0; qt < 2; ++qt) { const float gt = 1.f / (1.f + __expf(-bf2f(*(const bf16*)((const char*)SM + (unsigned)(((b * SEQ + (C.pos0 + 4 * qt)) * 64 + 16 + h) * 2)))));
#pragma unroll
                for (int dt = 0; dt < 8; ++dt) { const f4 v = o[qt][dt] * gt; *(v2u*)(NSA_OROW(qt) + 32 * dt) = (v2u){pg8::cvt_pk_bf16(v[0], v[1]), pg8::cvt_pk_bf16(v[2], v[3])}; } }
#pragma unroll
            for (int br = 1; br <= 2; ++br) {
                const bf16* KX = (const bf16*)(p.ws + (br == 1 ? WS_KS : WS_KW)) + bg * SEQ * 128; const bf16* VX = (const bf16*)(p.ws + (br == 1 ? WS_VST : WS_VWT)) + bg * 128 * SEQ;
                const int n0 = br == 1 ? 0 : (C.cur >= 8 ? C.cur - 8 : 0), n1 = C.cur;
                m[0] = m[1] = -1e30f; l[0] = l[1] = 0.f;
#pragma unroll
                for (int qt = 0; qt < 2; ++qt)
#pragma unroll
                    for (int dt = 0; dt < 8; ++dt) o[qt][dt] = (f4){0.f, 0.f, 0.f, 0.f};
                int f0 = n1 + 1, f1 = n0 - 1;
                for (int n = n0; n <= n1; ++n) { const bool fa = (C.s0 - (64 * n + 63) >= 113) && (br == 1 || (C.s0 + 63 - 64 * n) < 512); if (fa) { f0 = n < f0 ? n : f0; f1 = n; } }
                const int cntf = f1 >= f0 ? f1 - f0 + 1 : 0, cnt = n1 - n0 + 1, nlo = cntf ? f0 - n0 : cnt;
#define NSA_TILE(i) ((i) < cntf ? f0 + (i) : (((i) - cntf) < nlo ? n0 + ((i) - cntf) : f1 + 1 + ((i) - cntf - nlo)))
#define NSA_BODY(FARF) { const int n = NSA_TILE(i); const int buf = i & 1; \
                    if (i + 1 < cnt) { const int nn = NSA_TILE(i + 1); dma_k(C, KX + nn * 64 * 128, lds + (buf ? KB0 : KB1)); dma_v(C, VX + 64 * nn, C.vdos, lds + (buf ? VB0 : VB1)); } \
                    bool need = true; \
                    if (br == 1) { const unsigned any = ((const LAS unsigned*)selm)[(lane & 7) * 2 + (n >> 5)] >> (n & 31); need = __any((int)(any & 1u)); } \
                    if (need) { f4 s[2][4]; compute_st(C, lds + (buf ? KB1 : KB0), s); \
                        if (FARF) { if (br == 1) softmax_far<M_SEL>(C, s, n, (const LAS unsigned*)selm, m, l, o); else softmax_far<M_WIN>(C, s, n, (const LAS unsigned*)selm, m, l, o); } \
                        else { if (br == 1) mask_bias<M_SEL, false>(C, s, 64 * n, n, (const LAS unsigned*)selm); else mask_bias<M_WIN, false>(C, s, 64 * n, n, (const LAS unsigned*)selm); \
                            softmax_step(s, m, l, o, true); } \
                        compute_pv(C, lds + (buf ? VB1 : VB0), s, o); } \
                    NSA_SYNC(); }
                { const int nf = NSA_TILE(0); dma_k(C, KX + nf * 64 * 128, lds + KB0); dma_v(C, VX + 64 * nf, C.vdos, lds + VB0); NSA_SYNC(); }
                int i = 0;
                for (; i < cntf; ++i) NSA_BODY(true)
                for (; i < cnt; ++i) NSA_BODY(false)
#undef NSA_BODY
#undef NSA_TILE
                asm volatile("s_waitcnt vmcnt(0)" ::: "memory");
#pragma unroll
                for (int qt = 0; qt < 2; ++qt) { const float lt = radd32(radd16(l[qt]));
                    const int row = b * SEQ + (C.pos0 + 4 * qt);
                    const float sc = (1.f / (1.f + __expf(-bf2f(*(const bf16*)((const char*)SM + (unsigned)((row * 64 + 16 + 8 * br + h) * 2)))))) / lt;
#pragma unroll
                    for (int dt = 0; dt < 8; ++dt) { const f4 v = o[qt][dt] * sc; v2u* sp = (v2u*)(NSA_OROW(qt) + 32 * dt); const v2u pv = *sp;
                        const float a0 = bflo(pv.x) + v[0], a1 = bfhi(pv.x) + v[1], a2 = bflo(pv.y) + v[2], a3 = bfhi(pv.y) + v[3];
                        if (br == 2) ssq[qt] += (a0 * a0 + a1 * a1) + (a2 * a2 + a3 * a3);
                        *sp = (v2u){pg8::cvt_pk_bf16(a0, a1), pg8::cvt_pk_bf16(a2, a3)}; } }
            }
        }
        float rstd[2];
#pragma unroll
        for (int qt = 0; qt < 2; ++qt) { const float t = radd32(radd16(raddq(ssq[qt]))); rstd[qt] = 1.f / sqrtf(t * (1.f / 1024.f) + RMS_EPS); }
        asm volatile("s_waitcnt vmcnt(0)" ::: "memory");
#pragma unroll
        for (int qt = 0; qt < 2; ++qt) { const int sub = C.r * 4 + C.gq; bf16* orow = (bf16*)((char*)A2 + (unsigned)(((b * SEQ + (C.pos0 + 4 * qt)) * DM + 1024) * 2 + sub * 16)); const int subz = 0;
#pragma unroll
            for (int j = 0; j < 8; ++j) { const int col = (j * 16 + subz) * 8; v4u w = *(const v4u*)((const char*)orow + (unsigned)(col * 2)); const f32x4 g0 = *(const f32x4*)((const char*)nsag + (unsigned)(col * 4 + sub * 32)), g1 = *(const f32x4*)((const char*)nsag + (unsigned)(col * 4 + sub * 32 + 16)); const float rs = rstd[qt];
                w.x = pk2(bflo(w.x) * rs * g0.x, bfhi(w.x) * rs * g0.y); w.y = pk2(bflo(w.y) * rs * g0.z, bfhi(w.y) * rs * g0.w); w.z = pk2(bflo(w.z) * rs * g1.x, bfhi(w.z) * rs * g1.y); w.w = pk2(bflo(w.w) * rs * g1.z, bfhi(w.w) * rs * g1.w);
                *(v4u*)((char*)orow + (unsigned)(col * 2)) = w; } }
        NSA_SYNC();
    }
#undef NSA_SYNC
#undef NSA_OROW
}

constexpr size_t WS_ST = WS_LA;
constexpr size_t WS_DEC = WS_ST + (size_t)2048 * 256 * 128 * 2;
static_assert(WS_DEC + (size_t)2048 * 128 * 4 <= WS_KCMP, "gla scratch overlay");
namespace gla {
typedef float f4 __attribute__((ext_vector_type(4)));
constexpr int L_ST = 0, L_KT = 65536, L_QT = 81920, L_VT = 98304, L_GA = 131072, L_GT = L_GA + 4096, L_RED = L_GT + 2048, L_END = L_RED + 512;
__device__ __forceinline__ void chunk_cumsum(const Params& p, LAS unsigned char* lds, int tid, int t0, int h, float (&P)[16], float& blast) {
    const bf16* SM = (const bf16*)(p.ws + WS_SM); const float* wa2 = p.in[I_WA2]; const float* ba = p.in[I_BA];
    LAS float* ga = (LAS float*)(lds + L_GA); LAS float* gt = (LAS float*)(lds + L_GT);
    if (tid < 128) { const int j = tid >> 1, hf = tid & 1; const v4u w = *(const v4u*)((const char*)SM + (unsigned)(((t0 + j) * 64 + hf * 8) * 2));
        LAS float* d = ga + j * 16 + hf * 8; d[0] = bflo(w.x); d[1] = bfhi(w.x); d[2] = bflo(w.y); d[3] = bfhi(w.y); d[4] = bflo(w.z); d[5] = bfhi(w.z); d[6] = bflo(w.w); d[7] = bfhi(w.w); }
    const int dk = tid & 127, jq = tid >> 7;
    float w[16];
#pragma unroll
    for (int r = 0; r < 16; ++r) w[r] = wa2[r * 512 + h * 128 + dk];
    const float bb = ba[h * 128 + dk];
    __syncthreads();
    float run = 0.f;
#pragma unroll
    for (int jj = 0; jj < 16; ++jj) { const LAS f32x4* gr = (const LAS f32x4*)(ga + (16 * jq + jj) * 16); float z = bb;
#pragma unroll
        for (int r4 = 0; r4 < 4; ++r4) { const f32x4 g4 = gr[r4]; z += g4.x * w[4 * r4] + g4.y * w[4 * r4 + 1] + g4.z * w[4 * r4 + 2] + g4.w * w[4 * r4 + 3]; }
        run += (fminf(z, 0.f) - log1pf(__expf(-fabsf(z)))) * (1.f / 16.f); P[jj] = run; }
    gt[jq * 128 + dk] = run;
    __syncthreads();
    float off = 0.f, tot = 0.f;
#pragma unroll
    for (int q = 0; q < 4; ++q) { const float t = gt[q * 128 + dk]; tot += t; if (q < jq) off += t; }
#pragma unroll
    for (int jj = 0; jj < 16; ++jj) P[jj] += off;
    blast = tot;
}
__device__ __forceinline__ void stage_raw_k(const bf16* src  , LAS unsigned char* dst, int tid, int t0, int h) {
#pragma unroll
    for (int q = 0; q < 2; ++q) { const int id = tid + 512 * q, j = id >> 4, c16 = id & 15; *(LAS v4u*)(dst + j * 256 + c16 * 16) = *(const v4u*)((const char*)src + (unsigned)(((t0 + j) * 512 + h * 128 + c16 * 8) * 2)); }
}
__device__ __forceinline__ void stage_raw_v(const Params& p, LAS unsigned char* dst, int tid, int t0, int h) {
    const bf16* GV = (const bf16*)(p.ws + WS_GV);
#pragma unroll
    for (int q = 0; q < 4; ++q) { const int id = tid + 512 * q, j = id >> 5, c = id & 31; *(LAS v4u*)(dst + j * 512 + c * 16) = *(const v4u*)((const char*)GV + (unsigned)(((t0 + j) * 1024 + h * 256 + c * 8) * 2)); }
}
__device__ __forceinline__ void fill_vt(LAS unsigned char* lds, const LAS unsigned char* rv, int tid) {
    const int dv = tid & 255, jh = tid >> 8;
    unsigned short v[32];
#pragma unroll
    for (int jj = 0; jj < 32; ++jj) v[jj] = *(const LAS bf16*)(rv + (32 * jh + jj) * 512 + dv * 2);
    LAS unsigned char* row = lds + L_VT + dv * 128; const int f = (dv >> 1) & 7;
#pragma unroll
    for (int q = 0; q < 4; ++q) { v4u w; w.x = v[8 * q] | ((unsigned)v[8 * q + 1] << 16); w.y = v[8 * q + 2] | ((unsigned)v[8 * q + 3] << 16); w.z = v[8 * q + 4] | ((unsigned)v[8 * q + 5] << 16); w.w = v[8 * q + 6] | ((unsigned)v[8 * q + 7] << 16);
        *(LAS v4u*)(row + (((4 * jh + q) ^ f) * 16)) = w; }
}
}

__device__ __forceinline__ void ph_gla_a(const Params& p, LAS unsigned char* lds, int u0, int ustride, int tid_in, int wave) {
    using namespace gla;
    int tid = tid_in; asm volatile("" : "+v"(tid));
    const int lane = tid & 63, c = lane & 15, gq = lane >> 4;
    const bf16* GK = (const bf16*)(p.ws + WS_GK); bf16* ST = (bf16*)(p.ws + WS_ST); float* DEC = (float*)(p.ws + WS_DEC);
    for (int unit = u0; unit < 2048; unit += ustride) {
        const int bh = unit >> 6, ch = unit & 63, b = bh >> 2, h = bh & 3, t0 = b * SEQ + ch * 64;
        stage_raw_k(GK, lds + 0, tid, t0, h); stage_raw_v(p, lds + 16384, tid, t0, h);
        float P[16], blast; chunk_cumsum(p, lds, tid, t0, h, P, blast);
        { const int dk = tid & 127, jq = tid >> 7;
          unsigned short kv[16];
#pragma unroll
          for (int jj = 0; jj < 16; ++jj) kv[jj] = *(const LAS bf16*)(lds + (16 * jq + jj) * 256 + dk * 2);
          unsigned pk[8];
#pragma unroll
          for (int q = 0; q < 8; ++q) pk[q] = pk2(bf2f(kv[2 * q]) * __expf(blast - P[2 * q]), bf2f(kv[2 * q + 1]) * __expf(blast - P[2 * q + 1]));
          LAS unsigned char* row = lds + L_KT + dk * 128; const int f = (dk >> 1) & 7;
          *(LAS v4u*)(row + (((2 * jq) ^ f) * 16)) = (v4u){pk[0], pk[1], pk[2], pk[3]}; *(LAS v4u*)(row + (((2 * jq + 1) ^ f) * 16)) = (v4u){pk[4], pk[5], pk[6], pk[7]};
          if (jq == 0) DEC[unit * 128 + dk] = __expf(blast); }
        fill_vt(lds, lds + 16384, tid);
        __syncthreads();
        f4 acc[16];
        const int f = (c >> 1) & 7;
        bf16x8 aF[2];
#pragma unroll
        for (int ks = 0; ks < 2; ++ks) aF[ks] = *(const LAS bf16x8*)(lds + L_KT + (16 * wave + c) * 128 + (((4 * ks + gq) ^ f) * 16));
#pragma unroll
        for (int nt = 0; nt < 16; ++nt) { acc[nt] = (f4){0.f, 0.f, 0.f, 0.f};
#pragma unroll
            for (int ks = 0; ks < 2; ++ks) { const bf16x8 bF = *(const LAS bf16x8*)(lds + L_VT + (16 * nt + c) * 128 + (((4 * ks + gq) ^ f) * 16)); acc[nt] = __builtin_amdgcn_mfma_f32_16x16x32_bf16(aF[ks], bF, acc[nt], 0, 0, 0); } }
        char* dst = (char*)ST + (size_t)unit * (256 * 128 * 2) + (unsigned)((c * 128 + 16 * wave + 4 * gq) * 2);
#pragma unroll
        for (int nt = 0; nt < 16; ++nt) *(v2u*)(dst + nt * 16 * 256) = (v2u){pg8::cvt_pk_bf16(acc[nt][0], acc[nt][1]), pg8::cvt_pk_bf16(acc[nt][2], acc[nt][3])};
        __syncthreads();
    }
}
__device__ __forceinline__ void ph_gla_b(const Params& p, int gid, int gstride) {
    bf16* ST = (bf16*)(p.ws + WS_ST); const float* DEC = (const float*)(p.ws + WS_DEC);
    for (int e = gid; e < 32 * 4096; e += gstride) { const int bh = e >> 12, dv = (e >> 4) & 255, d8 = e & 15;
        float st[8];
#pragma unroll
        for (int i = 0; i < 8; ++i) st[i] = 0.f;
        char* base = (char*)ST + (size_t)bh * 64 * (256 * 128 * 2) + (unsigned)((dv * 128 + d8 * 8) * 2); const float* dbase = DEC + (size_t)bh * 64 * 128 + d8 * 8;
#pragma unroll 4
        for (int ch = 0; ch < 64; ++ch) { v4u* ptr = (v4u*)(base + (size_t)ch * (256 * 128 * 2)); const v4u w = *ptr; const f32x4 d0 = *(const f32x4*)(dbase + ch * 128), d1 = *(const f32x4*)(dbase + ch * 128 + 4);
            v4u o; o.x = pk2(st[0], st[1]); o.y = pk2(st[2], st[3]); o.z = pk2(st[4], st[5]); o.w = pk2(st[6], st[7]); *ptr = o;
            st[0] = st[0] * d0.x + bflo(w.x); st[1] = st[1] * d0.y + bfhi(w.x); st[2] = st[2] * d0.z + bflo(w.y); st[3] = st[3] * d0.w + bfhi(w.y);
            st[4] = st[4] * d1.x + bflo(w.z); st[5] = st[5] * d1.y + bfhi(w.z); st[6] = st[6] * d1.z + bflo(w.w); st[7] = st[7] * d1.w + bfhi(w.w); }
    }
}
__device__ __forceinline__ void ph_gla_c(const Params& p, LAS unsigned char* lds, int u0, int ustride, int tid_in, int wave) {
    using namespace gla;
    int tid = tid_in; asm volatile("" : "+v"(tid));
    const int lane = tid & 63, c = lane & 15, gq = lane >> 4, nt = wave & 3, half = wave >> 2;
    const bf16* GQ = (const bf16*)(p.ws + WS_GQ); const bf16* GK = (const bf16*)(p.ws + WS_GK); const bf16* GG = (const bf16*)(p.ws + WS_GG); const bf16* ST = (const bf16*)(p.ws + WS_ST);
    bf16* A2 = (bf16*)(p.ws + WS_A2); const float* gn = p.in[I_GLAG];
    const int koff0 = c * 256 + ((gq ^ c) * 16), voff0 = c * 128 + (((gq >> 1) ^ ((c >> 1) & 7)) * 16) + (gq & 1) * 8;
    for (int unit = u0; unit < 2048; unit += ustride) {
        const int bh = unit >> 6, ch = unit & 63, b = bh >> 2, h = bh & 3, t0 = b * SEQ + ch * 64;
        stage_raw_k(GQ, lds + 0, tid, t0, h); stage_raw_k(GK, lds + 16384, tid, t0, h); stage_raw_v(p, lds + 32768, tid, t0, h);
        float P[16], blast; chunk_cumsum(p, lds, tid, t0, h, P, blast);
        { const int dk = tid & 127, jq = tid >> 7;
#pragma unroll
          for (int jj = 0; jj < 16; ++jj) { const int j = 16 * jq + jj; const float qv = bf2f(*(const LAS bf16*)(lds + j * 256 + dk * 2)), kv = bf2f(*(const LAS bf16*)(lds + 16384 + j * 256 + dk * 2));
              const int off = j * 256 + (((dk >> 3) ^ (j & 15)) * 16) + (dk & 7) * 2;
              *(LAS bf16*)(lds + L_QT + off) = (bf16)f2bf(qv * __expf(P[jj])); *(LAS bf16*)(lds + L_KT + off) = (bf16)f2bf(kv * __expf(-P[jj])); } }
        fill_vt(lds, lds + 32768, tid);
        __syncthreads();
        { const char* src = (const char*)ST + (size_t)unit * (256 * 128 * 2);
#pragma unroll
          for (int i = 0; i < 8; ++i) { const int piece = 8 * wave + i, row = piece * 4 + (lane >> 4), chunk = (lane & 15) ^ (row & 15);
              __builtin_amdgcn_global_load_lds((const unsigned*)(src + (unsigned)(row * 256 + chunk * 16)), (LAS unsigned*)(lds + L_ST + piece * 1024), 16, 0, 0); } }
        asm volatile("s_waitcnt vmcnt(0)" ::: "memory"); __syncthreads();
        bf16x8 qF[4];
#pragma unroll
        for (int ks = 0; ks < 4; ++ks) qF[ks] = *(const LAS bf16x8*)(lds + L_QT + nt * 4096 + (koff0 ^ (ks * 64)));
        f4 sT[4];
#pragma unroll
        for (int jt = 0; jt < 4; ++jt) { sT[jt] = (f4){0.f, 0.f, 0.f, 0.f};
            if (jt <= nt) {
#pragma unroll
                for (int ks = 0; ks < 4; ++ks) { const bf16x8 a = *(const LAS bf16x8*)(lds + L_KT + jt * 4096 + (koff0 ^ (ks * 64))); sT[jt] = __builtin_amdgcn_mfma_f32_16x16x32_bf16(a, qF[ks], sT[jt], 0, 0, 0); }
                if (jt == nt) {
#pragma unroll
                    for (int rg = 0; rg < 4; ++rg) if (4 * gq + rg > c) sT[jt][rg] = 0.f; } } }
        bf16x8 pb[2];
#pragma unroll
        for (int s = 0; s < 2; ++s) { v4u w; w.x = pg8::cvt_pk_bf16(sT[2 * s][0], sT[2 * s][1]); w.y = pg8::cvt_pk_bf16(sT[2 * s][2], sT[2 * s][3]); w.z = pg8::cvt_pk_bf16(sT[2 * s + 1][0], sT[2 * s + 1][1]); w.w = pg8::cvt_pk_bf16(sT[2 * s + 1][2], sT[2 * s + 1][3]); pb[s] = __builtin_bit_cast(bf16x8, w); }
        f4 o[8]; float ss = 0.f;
#pragma unroll
        for (int mt = 0; mt < 8; ++mt) { o[mt] = (f4){0.f, 0.f, 0.f, 0.f}; const int rb = 128 * half + 16 * mt;
#pragma unroll
            for (int ks = 0; ks < 4; ++ks) { const bf16x8 a = *(const LAS bf16x8*)(lds + L_ST + rb * 256 + (koff0 ^ (ks * 64))); o[mt] = __builtin_amdgcn_mfma_f32_16x16x32_bf16(a, qF[ks], o[mt], 0, 0, 0); }
#pragma unroll
            for (int s = 0; s < 2; ++s) if (2 * s <= nt) { const v2u lo = *(const LAS v2u*)(lds + L_VT + rb * 128 + (voff0 ^ (s * 64))), hi = *(const LAS v2u*)(lds + L_VT + rb * 128 + (voff0 ^ (s * 64 + 32)));
                o[mt] = __builtin_amdgcn_mfma_f32_16x16x32_bf16(__builtin_bit_cast(bf16x8, (v4u){lo.x, lo.y, hi.x, hi.y}), pb[s], o[mt], 0, 0, 0); }
            ss += (o[mt][0] * o[mt][0] + o[mt][1] * o[mt][1]) + (o[mt][2] * o[mt][2] + o[mt][3] * o[mt][3]); }
        ss = nsa::radd32(nsa::radd16(ss));
        LAS float* red = (LAS float*)(lds + L_RED);
        if (gq == 0) red[half * 64 + 16 * nt + c] = ss;
        __syncthreads();
        const float rstd = 1.f / sqrtf((red[16 * nt + c] + red[64 + 16 * nt + c]) * (1.f / 256.f) + RMS_EPS);
        const int tok = t0 + 16 * nt + c;
#pragma unroll
        for (int mt = 0; mt < 8; ++mt) { const int dv = 128 * half + 16 * mt + 4 * gq; const f32x4 g4 = *(const f32x4*)((const char*)gn + (unsigned)(dv * 4));
            const v2u gg = *(const v2u*)((const char*)GG + (unsigned)((tok * 1024 + h * 256 + dv) * 2));
            const float z0 = bflo(gg.x), z1 = bfhi(gg.x), z2 = bflo(gg.y), z3 = bfhi(gg.y);
            v2u w; w.x = pg8::cvt_pk_bf16(o[mt][0] * rstd * g4.x * (z0 / (1.f + __expf(-z0))), o[mt][1] * rstd * g4.y * (z1 / (1.f + __expf(-z1))));
            w.y = pg8::cvt_pk_bf16(o[mt][2] * rstd * g4.z * (z2 / (1.f + __expf(-z2))), o[mt][3] * rstd * g4.w * (z3 / (1.f + __expf(-z3))));
            *(v2u*)((char*)A2 + (unsigned)((tok * DM + h * 256 + dv) * 2)) = w; }
        __syncthreads();
    }
}

constexpr size_t WS_LH = WS_DEC + (size_t)2048 * 128 * 4;
constexpr size_t WS_PEV = WS_LH + (size_t)2 * 4096 * 256 * 4;
static_assert(WS_PEV + 1024 <= WS_KCMP, "cmp scratch overlay");
struct CmpOrder {
    int c; const bf16 *kc, *vc, *wk, *wv;
    __device__ __forceinline__ bool next(int i, pg8::Unit& u) const { if (i > 0 || c >= 32) return false; u.pm = c & 15; u.pn = 0; u.kind = c >> 4; return true; }
    __device__ __forceinline__ const char* pa(const pg8::Gemm&, const pg8::Unit& u) const { return (const char*)(u.kind ? vc : kc) + (size_t)u.pm * ((size_t)256 * 2048 * 2); }
    __device__ __forceinline__ const char* pb(const pg8::Gemm&, const pg8::Unit& u) const { return (const char*)(u.kind ? wv : wk); }
    __device__ __forceinline__ void a_ready(const pg8::Unit&) const {}
    __device__ __forceinline__ void done(const pg8::Unit&) const {}
};
struct EpiLH {
    static constexpr bool PERM = false, AFTER_DRAIN = false;
    float* LH;
    __device__ __forceinline__ void operator()(const pg8::f32x4 (&acc)[2][2][4][2], const pg8::Unit& u, int wr, int wc, int fr, int fq) const {
        const int row0 = u.kind * 4096 + u.pm * 256 + wr * 64 + fr, col0 = wc * 32 + 4 * fq;
#pragma unroll
        for (int ai = 0; ai < 2; ++ai)
#pragma unroll
            for (int m = 0; m < 4; ++m) { float* rowp = LH + (size_t)(row0 + ai * 128 + m * 16) * 256 + col0;
#pragma unroll
                for (int bj = 0; bj < 2; ++bj)
#pragma unroll
                    for (int n = 0; n < 2; ++n) *(pg8::f32x4*)(rowp + bj * 128 + n * 16) = acc[ai][bj][m][n]; }
    }
};

constexpr size_t PROWS = (size_t)MAXTILES * 256;
constexpr size_t WS_W1Q = WS_W1T;
constexpr size_t WS_W2Q = WS_W1Q + (size_t)NE * 4096 * DM;
constexpr size_t WS_HN8 = WS_W2Q + (size_t)NE * DM * DFF;
constexpr size_t WS_AMAXP = WS_HN8 + (size_t)T * DM;
constexpr size_t WS_WSC1 = WS_AMAXP + PROWS * 64 * 4;
constexpr size_t WS_WSC2 = WS_WSC1 + (size_t)NE * 4096 * 4;
constexpr size_t WS_HSC = WS_WSC2 + (size_t)NE * 2048 * 4;
constexpr size_t WS_ROWSC = WS_HSC + (size_t)T * 4;
constexpr size_t WS_ASC = WS_ROWSC + PROWS * 4;
static_assert(WS_ASC + PROWS * 4 <= WS_XN, "int8 buffers fit in the retired bf16 expert-weight region");
constexpr size_t WS_ROWTOK = WS_CTL + 512 * 1024;
static_assert(PROWS * 2 <= 512 * 1024 && DM == 2048, "row table fits; gathered rows are 2048 bytes");
constexpr size_t WS_XG8 = WS_XG;
constexpr size_t WS_ACT8 = WS_XG + PROWS * DM;
constexpr size_t WS_Y = WS_ACT;
static_assert(WS_ACT8 + PROWS * DM <= WS_ACT, "int8 row buffers fit in the retired gathered-row region");

__device__ __forceinline__ unsigned q8(float v) { int q = (int)rintf(v); q = q > 127 ? 127 : (q < -127 ? -127 : q); return (unsigned)q & 0xffu; }
__device__ __forceinline__ unsigned q8x4(float a, float b, float c, float d) { return q8(a) | (q8(b) << 8) | (q8(c) << 16) | (q8(d) << 24); }

constexpr size_t WS_WINQ = WS_WINT;
constexpr size_t WS_WISC = WS_WINT + (size_t)NPT * 256 * DM;
constexpr size_t WS_XN8 = WS_XN;
constexpr size_t WS_XSC = WS_XN + (size_t)T * DM;
constexpr size_t WS_PMAX = WS_HN;
constexpr size_t WS_PMAXI = WS_PMAX + (size_t)64 * 8 * 4096 * 4;

constexpr int NSLAB_E = NE * 192, NSLAB = NSLAB_E + 178;
struct SlabSrc { const float* W; int N; bool ok; };
__device__ __forceinline__ SlabSrc slab_src(const Params& p, int sl, int r0, int n4) {
    SlabSrc s;
    if (sl < NSLAB_E) { const int e = sl / 192, r = sl % 192; const bool isw2 = r >= 128; const int nb = isw2 ? r - 128 : r; s.N = isw2 ? 2048 : 4096;
        s.W = (isw2 ? p.in[I_W2] + (size_t)e * DFF * DM : p.in[I_W1] + (size_t)e * DM * 4096) + (size_t)r0 * s.N + nb * 32 + 4 * n4; s.ok = true; }
    else { const int nb = sl - NSLAB_E; s.N = 5672; s.ok = nb * 32 + 4 * n4 < 5672; s.W = p.in[I_WIN] + (size_t)r0 * 5672 + (s.ok ? nb * 32 + 4 * n4 : 0); }
    return s;
}
__device__ __forceinline__ void p0_slab_quant(const Params& p, LAS unsigned char* lds, int bid, int G, int tid) {
    constexpr int RS = 4104;
    LAS unsigned char* TT = lds; LAS float* part = (LAS float*)(lds + 32 * RS); LAS float* inv = part + 64 * 32; LAS int* drow = (LAS int*)(inv + 32);
    signed char* W1Q = (signed char*)(p.ws + WS_W1Q); signed char* W2Q = (signed char*)(p.ws + WS_W2Q); signed char* WIQ = (signed char*)(p.ws + WS_WINQ);
    float* WSC1 = (float*)(p.ws + WS_WSC1); float* WSC2 = (float*)(p.ws + WS_WSC2); float* WISC = (float*)(p.ws + WS_WISC);
    const int n4 = tid & 7, r0 = tid >> 3;
    f32x4 va[8], vb[8];
#define SLAB_ISSUE(dst, sl, j) do { if ((sl) < NSLAB) { const SlabSrc ss_ = slab_src(p, (sl), r0, n4); _Pragma("unroll") for (int u = 0; u < 8; ++u) dst[u] = __builtin_nontemporal_load((const f32x4*)(ss_.W + (size_t)(64 * (8 * (j) + u)) * ss_.N)); } } while (0)
#define SLAB_USE(src, j) do { _Pragma("unroll") for (int u = 0; u < 8; ++u) { const f32x4 x = sc_.ok ? src[u] : (f32x4){0.f, 0.f, 0.f, 0.f}; const int k = r0 + 64 * (8 * (j) + u); \
            mx.x = fmaxf(mx.x, fabsf(x.x)); mx.y = fmaxf(mx.y, fabsf(x.y)); mx.z = fmaxf(mx.z, fabsf(x.z)); mx.w = fmaxf(mx.w, fabsf(x.w)); \
            LAS unsigned char* d = TT + (4 * n4) * RS + k * 2; \
            *(LAS bf16*)d = (bf16)f2bf(x.x); *(LAS bf16*)(d + RS) = (bf16)f2bf(x.y); *(LAS bf16*)(d + 2 * RS) = (bf16)f2bf(x.z); *(LAS bf16*)(d + 3 * RS) = (bf16)f2bf(x.w); } } while (0)
    SLAB_ISSUE(va, bid, 0); SLAB_ISSUE(vb, bid, 1);
    for (int slab = bid; slab < NSLAB; slab += G) {
        const SlabSrc sc_ = slab_src(p, slab, r0, n4);
        f32x4 mx = (f32x4){0.f, 0.f, 0.f, 0.f};
        SLAB_USE(va, 0); SLAB_ISSUE(va, slab, 2);
        SLAB_USE(vb, 1); SLAB_ISSUE(vb, slab, 3);
        SLAB_USE(va, 2); SLAB_ISSUE(va, slab + G, 0);
        SLAB_USE(vb, 3); SLAB_ISSUE(vb, slab + G, 1);
        { f32x4 t = mx;
#pragma unroll
          for (int o = 8; o < 64; o <<= 1) { t.x = fmaxf(t.x, __shfl_xor(t.x, o)); t.y = fmaxf(t.y, __shfl_xor(t.y, o)); t.z = fmaxf(t.z, __shfl_xor(t.z, o)); t.w = fmaxf(t.w, __shfl_xor(t.w, o)); }
          if ((tid & 63) < 8) *(LAS f32x4*)(part + (tid >> 6) * 32 + 4 * n4) = t; }
        __syncthreads();
        if (tid < 32) { float m = 0.f;
#pragma unroll
            for (int q = 0; q < 8; ++q) m = fmaxf(m, part[q * 32 + tid]);
            const float sc = m > 0.f ? m * (1.f / 127.f) : 1.f; inv[tid] = 1.f / sc;
            if (slab < NSLAB_E) { const int e = slab / 192, r = slab % 192; const bool isw2 = r >= 128; const int n = (isw2 ? r - 128 : r) * 32 + tid;
                if (isw2) { drow[tid] = e * 2048 + n; WSC2[e * 2048 + n] = sc; }
                else { const int j2 = n & 2047, row = (j2 >> 7) * 256 + (n >= 2048 ? 128 : 0) + (j2 & 127); drow[tid] = e * 4096 + row; WSC1[e * 4096 + row] = sc; } }
            else { const int n = (slab - NSLAB_E) * 32 + tid; if (n < 5672) { float qsc; const int row = win_row(n, qsc); drow[tid] = row; WISC[row] = sc * qsc; } else drow[tid] = -1; } }
        __syncthreads();
        { const int kc = tid & 7, n = (tid >> 3) & 31, hf = tid >> 8; const float iv = inv[n]; const int dr = drow[n];
          signed char* dst = (slab < NSLAB_E ? ((slab % 192) >= 128 ? W2Q : W1Q) : WIQ) + (size_t)(dr < 0 ? 0 : dr) * 2048; const LAS unsigned char* src = TT + n * RS;
          if (dr >= 0) {
#pragma unroll
          for (int m8 = 0; m8 < 8; ++m8) { const int k0 = 16 * (kc + 8 * (hf + 2 * m8)); const LAS v2u* sp = (const LAS v2u*)(src + k0 * 2); const v2u a = sp[0], b = sp[1], c = sp[2], d = sp[3]; v4u o;
              o.x = q8x4(bflo(a.x) * iv, bfhi(a.x) * iv, bflo(a.y) * iv, bfhi(a.y) * iv); o.y = q8x4(bflo(b.x) * iv, bfhi(b.x) * iv, bflo(b.y) * iv, bfhi(b.y) * iv);
              o.z = q8x4(bflo(c.x) * iv, bfhi(c.x) * iv, bflo(c.y) * iv, bfhi(c.y) * iv); o.w = q8x4(bflo(d.x) * iv, bfhi(d.x) * iv, bflo(d.y) * iv, bfhi(d.y) * iv);
              *(v4u*)(dst + k0) = o; } } }
        __syncthreads();
    }
#undef SLAB_ISSUE
#undef SLAB_USE
}
struct EpiSwigluI8 {
    static constexpr bool PERM = true, AFTER_DRAIN = false;
    const float* b1; const float* rowsc; const float* wsc1; bf16* act; float* amaxp;
    __device__ __forceinline__ void operator()(const pg8::f32x4 (&acc)[2][2][4][2], const pg8::Unit& u, int wr, int wc, int fr, int fq) const {
        const int e = u.kind; const int cin = wc * 32 + 8 * fq; const int col = u.pn * 128 + cin; const int row0 = u.pm * 256 + wr * 64 + fr;
        const float* bg = b1 + (size_t)e * 4096 + col; const float* bl = bg + 2048; const float* sg = wsc1 + (size_t)e * 4096 + u.pn * 256 + cin; const float* sl = sg + 128;
        float gb[8], lb[8], gs[8], ls[8];
#pragma unroll
        for (int j = 0; j < 8; ++j) { gb[j] = bg[j]; lb[j] = bl[j]; gs[j] = sg[j]; ls[j] = sl[j]; }
#pragma unroll
        for (int ai = 0; ai < 2; ++ai)
#pragma unroll
            for (int m = 0; m < 4; ++m) { const int r = row0 + ai * 128 + m * 16; const float rs = rowsc[r]; float o[8]; float mx = 0.f;
#pragma unroll
                for (int n = 0; n < 2; ++n)
#pragma unroll
                    for (int j = 0; j < 4; ++j) { float gl = (float)__float_as_int(acc[ai][0][m][n][j]) * (rs * gs[n * 4 + j]) + gb[n * 4 + j]; float li = (float)__float_as_int(acc[ai][1][m][n][j]) * (rs * ls[n * 4 + j]) + lb[n * 4 + j];
                        gl = fminf(gl, 7.f); li = fminf(fmaxf(li, -7.f), 7.f);
                        const float v = gl * __builtin_amdgcn_rcpf(1.f + __builtin_amdgcn_exp2f(-2.4554669595930156f * gl)) * (li + 1.f); o[n * 4 + j] = v; mx = fmaxf(mx, fabsf(v)); }
                mx = nsa::rmax32(nsa::rmax16(mx));
                if (fq == 0) amaxp[(size_t)r * 64 + u.pn * 4 + wc] = mx;
                pg8::u32x4 w; w.x = pg8::cvt_pk_bf16(o[0], o[1]); w.y = pg8::cvt_pk_bf16(o[2], o[3]); w.z = pg8::cvt_pk_bf16(o[4], o[5]); w.w = pg8::cvt_pk_bf16(o[6], o[7]);
                *(pg8::u32x4*)(act + (size_t)r * DFF + col) = w; }
    }
};
__device__ __forceinline__ void ph_actq(const Params& p, int gw, int NGW, int lane) {
    const int nrows = ((const int*)(p.ws + WS_META))[0] * 256; const float* amaxp = (const float*)(p.ws + WS_AMAXP); const bf16* act = (const bf16*)(p.ws + WS_ACT);
    signed char* A8 = (signed char*)(p.ws + WS_ACT8); float* ASC = (float*)(p.ws + WS_ASC);
    for (int rb = gw; rb < nrows; rb += 2 * NGW) {
        const int r0 = rb, r1 = rb + NGW; const bool h1 = r1 < nrows; const int r1c = h1 ? r1 : r0;
        float m0 = amaxp[(size_t)r0 * 64 + lane], m1 = amaxp[(size_t)r1c * 64 + lane];
        const v4u* s0 = (const v4u*)(act + (size_t)r0 * DFF) + lane * 4; const v4u* s1 = (const v4u*)(act + (size_t)r1c * DFF) + lane * 4; v4u a[2][4];
#pragma unroll
        for (int j = 0; j < 4; ++j) { a[0][j] = s0[j]; a[1][j] = s1[j]; }
        m0 = wave_max(m0); m1 = wave_max(m1);
#pragma unroll
        for (int q = 0; q < 2; ++q) { const int r = q ? r1 : r0; if (q && !h1) break; const float mx = q ? m1 : m0; const float sc = mx > 0.f ? mx * (1.f / 127.f) : 1.f, iv = 1.f / sc; v4u o[2];
#pragma unroll
            for (int h = 0; h < 2; ++h) { const v4u x = a[q][2 * h], y = a[q][2 * h + 1];
                o[h].x = q8x4(bflo(x.x) * iv, bfhi(x.x) * iv, bflo(x.y) * iv, bfhi(x.y) * iv); o[h].y = q8x4(bflo(x.z) * iv, bfhi(x.z) * iv, bflo(x.w) * iv, bfhi(x.w) * iv);
                o[h].z = q8x4(bflo(y.x) * iv, bfhi(y.x) * iv, bflo(y.y) * iv, bfhi(y.y) * iv); o[h].w = q8x4(bflo(y.z) * iv, bfhi(y.z) * iv, bflo(y.w) * iv, bfhi(y.w) * iv); }
            v4u* dst = (v4u*)(A8 + (size_t)r * DFF) + lane * 2; dst[0] = o[0]; dst[1] = o[1];
            if (lane == 0) ASC[r] = sc; } }
}
struct EpiDownI8 {
    static constexpr bool PERM = true, AFTER_DRAIN = false;
    const float* b2; const float* roww; const float* asc; const float* wsc2; bf16* y;
    __device__ __forceinline__ void operator()(const pg8::f32x4 (&acc)[2][2][4][2], const pg8::Unit& u, int wr, int wc, int fr, int fq) const {
        const int e = u.kind; const int col0 = u.pn * 256 + wc * 32 + 8 * fq; const int row0 = u.pm * 256 + wr * 64 + fr;
        float bv[2][8], sv[2][8];
#pragma unroll
        for (int bj = 0; bj < 2; ++bj)
#pragma unroll
            for (int j = 0; j < 8; ++j) { bv[bj][j] = b2[(size_t)e * DM + col0 + bj * 128 + j]; sv[bj][j] = wsc2[(size_t)e * DM + col0 + bj * 128 + j]; }
#pragma unroll
        for (int ai = 0; ai < 2; ++ai)
#pragma unroll
            for (int m = 0; m < 4; ++m) { const int r = row0 + ai * 128 + m * 16; const float g = roww[r], as = asc[r];
#pragma unroll
                for (int bj = 0; bj < 2; ++bj) { float o[8];
#pragma unroll
                    for (int n = 0; n < 2; ++n)
#pragma unroll
                        for (int j = 0; j < 4; ++j) o[n * 4 + j] = ((float)__float_as_int(acc[ai][bj][m][n][j]) * (as * sv[bj][n * 4 + j]) + bv[bj][n * 4 + j]) * g;
                    pg8::u32x4 w; w.x = pg8::cvt_pk_bf16(o[0], o[1]); w.y = pg8::cvt_pk_bf16(o[2], o[3]); w.z = pg8::cvt_pk_bf16(o[4], o[5]); w.w = pg8::cvt_pk_bf16(o[6], o[7]);
                    *(pg8::u32x4*)(y + (size_t)r * DM + col0 + bj * 128) = w; } }
    }
};

struct EpiProjI8 {
    static constexpr bool PERM = true, AFTER_DRAIN = false;
    unsigned char* ws;
    __device__ __forceinline__ void operator()(const pg8::f32x4 (&acc)[2][2][4][2], const pg8::Unit& u, int wr, int wc, int fr, int fq) const {
        const int cw = wc * 32 + 8 * fq; const float* XSC = (const float*)(ws + WS_XSC); const float* WISC = (const float*)(ws + WS_WISC);
        if (u.kind == 0) {
            const int tn = u.pn; bf16* base; size_t bjs = 128; int ld = 0; bool headmajor = false; bool small = false;
            if (tn < 2) { base = (bf16*)(ws + WS_GQ) + tn * 256; ld = 512; }
            else if (tn < 4) { base = (bf16*)(ws + WS_GK) + (tn - 2) * 256; ld = 512; }
            else if (tn < 8) { base = (bf16*)(ws + WS_GV) + (tn - 4) * 256; ld = 1024; }
            else if (tn < 12) { base = (bf16*)(ws + WS_GG) + (tn - 8) * 256; ld = 1024; }
            else if (tn < 16) { base = (bf16*)(ws + WS_NQ) + (tn - 12) * 256; ld = 1024; }
            else if (tn < 20) { base = (bf16*)(ws + (tn == 16 ? WS_KC : tn == 17 ? WS_VC : tn == 18 ? WS_KS : WS_KW)); headmajor = true; bjs = (size_t)SEQ * 128; }
            else { base = (bf16*)(ws + WS_SM); ld = 64; small = true; }
            if (small && wc >= 2) return;
            float cs[2][8];
#pragma unroll
            for (int bj = 0; bj < 2; ++bj)
#pragma unroll
                for (int j = 0; j < 8; ++j) cs[bj][j] = WISC[tn * 256 + bj * 128 + cw + j];
#pragma unroll
            for (int ai = 0; ai < 2; ++ai)
#pragma unroll
                for (int m = 0; m < 4; ++m) { const int r = u.pm * 256 + ai * 128 + wr * 64 + m * 16 + fr; const float rs = XSC[r];
                    const size_t rterm = headmajor ? ((size_t)(r >> 12) * 2 * SEQ + (r & (SEQ - 1))) * 128 : (size_t)r * ld;
#pragma unroll
                    for (int bj = 0; bj < 2; ++bj) { if (small && bj) continue; float o[8];
#pragma unroll
                        for (int n = 0; n < 2; ++n)
#pragma unroll
                            for (int j = 0; j < 4; ++j) o[n * 4 + j] = (float)__float_as_int(acc[ai][bj][m][n][j]) * (rs * cs[bj][n * 4 + j]);
                        pg8::u32x4 w; w.x = pg8::cvt_pk_bf16(o[0], o[1]); w.y = pg8::cvt_pk_bf16(o[2], o[3]); w.z = pg8::cvt_pk_bf16(o[4], o[5]); w.w = pg8::cvt_pk_bf16(o[6], o[7]);
                        *(pg8::u32x4*)(base + rterm + bj * bjs + cw) = w; } }
        } else {
            bf16* base = (bf16*)(ws + (u.pn == 21 ? WS_VST : WS_VWT));
#pragma unroll
            for (int ai = 0; ai < 2; ++ai)
#pragma unroll
                for (int m = 0; m < 4; ++m) { const int dh = wr * 64 + m * 16 + fr; const float ws_ = WISC[u.pn * 256 + ai * 128 + dh];
#pragma unroll
                    for (int bj = 0; bj < 2; ++bj) { const int tok = u.pm * 256 + bj * 128 + cw; const int b = tok >> 12, s = tok & (SEQ - 1); float o[8];
                        const pg8::f32x4 x0 = *(const pg8::f32x4*)(XSC + tok), x1 = *(const pg8::f32x4*)(XSC + tok + 4);
#pragma unroll
                        for (int j = 0; j < 4; ++j) { o[j] = (float)__float_as_int(acc[ai][bj][m][0][j]) * (ws_ * x0[j]); o[4 + j] = (float)__float_as_int(acc[ai][bj][m][1][j]) * (ws_ * x1[j]); }
                        pg8::u32x4 w; w.x = pg8::cvt_pk_bf16(o[0], o[1]); w.y = pg8::cvt_pk_bf16(o[2], o[3]); w.z = pg8::cvt_pk_bf16(o[4], o[5]); w.w = pg8::cvt_pk_bf16(o[6], o[7]);
                        *(pg8::u32x4*)(base + ((size_t)(b * 2 + ai) * 128 + dh) * SEQ + s) = w; } }
        }
    }
};

__device__ __forceinline__ void r1_router(const Params& p, LAS unsigned char* lds, int vb, int tid, int wave, int lane) {
    LAS float* rowbuf = (LAS float*)lds;
    LAS float* part = (LAS float*)(lds + 65536);
    LAS int* tk = (LAS int*)(lds + 81920 + wave * 1024);
    LAS int* cntw = (LAS int*)(lds + 90112);
    const float* h = p.out; const float* gf = p.in[I_NFFN]; const float* rw = p.in[I_RW]; const float* rb = p.in[I_RB];
    signed char* HN8 = (signed char*)(p.ws + WS_HN8);
    const int e = lane & 31, eg = tid & 31, dg = tid >> 5; int mycount = 0;
    float rwr[128];
#pragma unroll
    for (int c4 = 0; c4 < 4; ++c4) { unsigned o = (unsigned)((((dg * 128 + c4 * 32) * 32) + eg) * 4); asm volatile("" : "+v"(o));
#pragma unroll
        for (int i = 0; i < 32; ++i) rwr[c4 * 32 + i] = *(const float*)((const char*)rw + o + i * 128); }
    for (int grp = 0; grp < 16; ++grp) { const int t = vb * TPV + grp * 8 + wave;
        { const f32x4* xr = (const f32x4*)(h + (size_t)t * DM) + lane; f32x4 v[8]; float s = 0.f;
#pragma unroll
          for (int j = 0; j < 8; ++j) { v[j] = xr[64 * j]; s += (v[j].x * v[j].x + v[j].y * v[j].y) + (v[j].z * v[j].z + v[j].w * v[j].w); }
          const float rstd = 1.f / sqrtf(wave_sum(s) * (1.f / DM) + RMS_EPS);
          float mxr = 0.f; LAS f32x4* hrow = (LAS f32x4*)(rowbuf + wave * 2048);
#pragma unroll
          for (int j = 0; j < 8; ++j) { const f32x4 g4 = ((const f32x4*)gf)[lane + 64 * j]; f32x4 y; y.x = v[j].x * rstd * g4.x; y.y = v[j].y * rstd * g4.y; y.z = v[j].z * rstd * g4.z; y.w = v[j].w * rstd * g4.w;
              v[j] = y; hrow[lane + 64 * j] = y; mxr = fmaxf(mxr, fmaxf(fmaxf(fabsf(y.x), fabsf(y.y)), fmaxf(fabsf(y.z), fabsf(y.w)))); }
          mxr = wave_max(mxr); const float qs = mxr > 0.f ? mxr * (1.f / 127.f) : 1.f, qi = 1.f / qs;
          unsigned* o4 = (unsigned*)(HN8 + (size_t)t * DM) + lane;
#pragma unroll
          for (int j = 0; j < 8; ++j) o4[64 * j] = q8x4(v[j].x * qi, v[j].y * qi, v[j].z * qi, v[j].w * qi);
          if (lane == 0) ((float*)(p.ws + WS_HSC))[t] = qs; }
        __syncthreads();
        { float acc[8];
#pragma unroll
          for (int tt = 0; tt < 8; ++tt) acc[tt] = 0.f;
#pragma unroll
          for (int i4 = 0; i4 < 32; ++i4) { f32x4 xv[8];
#pragma unroll
              for (int tt = 0; tt < 8; ++tt) xv[tt] = *(const LAS f32x4*)(rowbuf + tt * 2048 + dg * 128 + 4 * i4);
#pragma unroll
              for (int tt = 0; tt < 8; ++tt) acc[tt] += xv[tt].x * rwr[4 * i4] + xv[tt].y * rwr[4 * i4 + 1] + xv[tt].z * rwr[4 * i4 + 2] + xv[tt].w * rwr[4 * i4 + 3];
              if (i4 & 1) asm volatile("" ::: "memory"); }
#pragma unroll
          for (int tt = 0; tt < 8; ++tt) part[(dg * 8 + tt) * 32 + eg] = acc[tt]; }
        __syncthreads();
        { float a = rb[e];
#pragma unroll
          for (int q = 0; q < 16; ++q) a += part[(q * 8 + wave) * 32 + e];
          int rank = 0;
#pragma unroll
          for (int mm = 0; mm < 32; ++mm) { const float lm = __shfl(a, mm); rank += (lm > a || (lm == a && mm < e)) ? 1 : 0; }
          const float mx = wave_max(a); const bool sel = rank < 4;
          const float ex = (sel && lane < 32) ? __expf(a - mx) : 0.f; const float sum = wave_sum(ex);
          if (sel && lane < 32) { LAS int* q = tk + (grp * 4 + rank) * 4; q[0] = e; q[1] = mycount; q[2] = __builtin_bit_cast(int, ex / sum); ++mycount; } }
        __syncthreads();
    }
    if (lane < 32) cntw[wave * 32 + lane] = mycount;
    __syncthreads();
    if (wave == 0 && lane < 32) { int tot = 0; for (int w = 0; w < 8; ++w) tot += cntw[w * 32 + lane]; ((int*)(p.ws + WS_CNT))[vb * 32 + lane] = tot; }
    { const int i = lane >> 2, k = lane & 3; const LAS int* q = tk + (i * 4 + k) * 4; const int ee = q[0]; int base = 0; for (int w = 0; w < wave; ++w) base += cntw[w * 32 + ee];
      const int t = vb * TPV + i * 8 + wave;
      ((int*)(p.ws + WS_EIDX))[t * 4 + k] = ee; ((int*)(p.ws + WS_LRNK))[t * 4 + k] = base + q[1]; ((int*)(p.ws + WS_GATE))[t * 4 + k] = q[2]; }
    __syncthreads();
}
__device__ __forceinline__ void r2_gather(const Params& p, LAS unsigned char* lds, int vb, bool write_meta, int tid, int wave, int lane) {
    LAS int* part_tot = (LAS int*)lds;
    LAS int* part_base = part_tot + 512;
    LAS int* pbase = part_base + 512;
    const int* CNT = (const int*)(p.ws + WS_CNT);
    { const int e = tid & 31, part = tid >> 5; int tot = 0, bs = 0;
      for (int v = part * 16; v < part * 16 + 16; ++v) { const int c = CNT[v * 32 + e]; tot += c; if (v < vb) bs += c; }
      part_tot[part * 32 + e] = tot; part_base[part * 32 + e] = bs; }
    __syncthreads();
    if (tid == 0) { int ps = 0; int* meta = (int*)(p.ws + WS_META); int nt = 0;
        for (int e = 0; e < 32; ++e) { int tot = 0, bs = 0; for (int q = 0; q < 16; ++q) { tot += part_tot[q * 32 + e]; bs += part_base[q * 32 + e]; }
            pbase[e] = ps + bs; const int ntile = (tot + 255) >> 8;
            if (write_meta) for (int q = 0; q < ntile; ++q) meta[64 + nt + q] = e;
            nt += ntile; ps += ntile * 256; }
        if (write_meta) meta[0] = nt; }
    __syncthreads();
    const float* HSC = (const float*)(p.ws + WS_HSC); float* ROWSC = (float*)(p.ws + WS_ROWSC);
    const int* EIDX = (const int*)(p.ws + WS_EIDX); const int* LRNK = (const int*)(p.ws + WS_LRNK); const float* GATE = (const float*)(p.ws + WS_GATE);
    int* POS = (int*)(p.ws + WS_POS); float* ROWW = (float*)(p.ws + WS_ROWW);
    unsigned short* RT = (unsigned short*)(p.ws + WS_ROWTOK);
    { const int t = vb * TPV + (tid >> 2), k = tid & 3;
      const int pos = pbase[EIDX[t * 4 + k]] + LRNK[t * 4 + k];
      POS[t * 4 + k] = pos; ROWW[pos] = GATE[t * 4 + k]; ROWSC[pos] = HSC[t]; RT[(pos & ~255) + (pos & 63) * 4 + ((pos >> 6) & 3)] = (unsigned short)t; }
    __syncthreads();
}
__device__ __forceinline__ void pf_final(const Params& p, int gw, int NGW, int lane) {
    const bf16* Y = (const bf16*)(p.ws + WS_Y); const int* POS = (const int*)(p.ws + WS_POS); const float* gfin = p.in[I_NFIN];
    for (int t = gw; t < T; t += NGW) {
        f32x4* xr = (f32x4*)(p.out + (size_t)t * DM) + lane; f32x4 v[8];
#pragma unroll
        for (int j = 0; j < 8; ++j) v[j] = xr[64 * j];
#pragma unroll
        for (int k = 0; k < 4; ++k) { const int pos = POS[t * 4 + k]; const v2u* yr = (const v2u*)(Y + (size_t)pos * DM) + lane;
#pragma unroll
            for (int j = 0; j < 8; ++j) { const v2u w = yr[64 * j]; v[j].x += bflo(w.x); v[j].y += bfhi(w.x); v[j].z += bflo(w.y); v[j].w += bfhi(w.y); } }
        float s = 0.f;
#pragma unroll
        for (int j = 0; j < 8; ++j) s += (v[j].x * v[j].x + v[j].y * v[j].y) + (v[j].z * v[j].z + v[j].w * v[j].w);
        const float rstd = 1.f / sqrtf(wave_sum(s) * (1.f / DM) + RMS_EPS);
#pragma unroll
        for (int j = 0; j < 8; ++j) { const f32x4 g4 = ((const f32x4*)gfin)[lane + 64 * j]; f32x4 o; o.x = v[j].x * rstd * g4.x; o.y = v[j].y * rstd * g4.y; o.z = v[j].z * rstd * g4.z; o.w = v[j].w * rstd * g4.w; xr[64 * j] = o; }
    }
}


constexpr int LDS_BYTES = 159744;
constexpr int MISC_OFF = LDS_BYTES - 256;  static_assert(nsa::LDS_END <= MISC_OFF && gla::L_END <= MISC_OFF, "LDS map");
constexpr int CW_BAR = 4096, CW_XL = 16384;
__global__ __launch_bounds__(512, 2) void mega_fwd(Params p) {
    extern __shared__ __attribute__((aligned(16))) unsigned char lds_raw[];
    LAS unsigned char* lds = (LAS unsigned char*)lds_raw;
    const int G = gridDim.x, bid = blockIdx.x, NGW = G * 8;
#define PH_IDS int tid = threadIdx.x; asm volatile("" : "+v"(tid)); const int lane = tid & 63, wave = __builtin_amdgcn_readfirstlane(tid >> 6), gw = bid * 8 + wave; (void)lane; (void)gw;
    for (int u = threadIdx.x; u < 64; u += 512) ((LAS unsigned*)(lds + MISC_OFF))[u] = 0u;
    __syncthreads();
    XcdBarrier bar = xcd_barrier_post((unsigned*)(p.ws + WS_CTL) + CW_BAR, (volatile LAS unsigned*)(lds + MISC_OFF) + 8);
    { PH_IDS; p0_prologue(p, lds, gw, NGW, wave, lane); __syncthreads(); p0_slab_quant(p, lds, bid, G, tid); }
    xcd_barrier(bar);
    { pg8::Gemm g{(const bf16*)(p.ws + WS_XN8), (const bf16*)(p.ws + WS_WINQ), T, NPT * 256, DM / 2};
      ProjOrder S; S.init(T, NPT * 256, G, bid); S.xn = g.A; S.wt = g.Bt; EpiProjI8 E{p.ws};
      pg8::gemm_phase<EpiProjI8, ProjOrder, true, true, true>(lds, g, S, E); }
    xcd_barrier(bar);
    if (bid < 32) {
        pg8::Gemm g{(const bf16*)(p.ws + WS_KC), (const bf16*)(p.ws + WS_WKCT), 4096, 256, 2048};
        CmpOrder S{bid, (const bf16*)(p.ws + WS_KC), (const bf16*)(p.ws + WS_VC), (const bf16*)(p.ws + WS_WKCT), (const bf16*)(p.ws + WS_WVCT)}; EpiLH E{(float*)(p.ws + WS_LH)};
        pg8::gemm_phase<EpiLH, CmpOrder, true, true>(lds, g, S, E);
    } else { PH_IDS; ph_gla_a(p, lds, bid - 32, G - 32, tid, wave); }
    xcd_barrier(bar);
    { PH_IDS; ph_gla_b(p, bid * 512 + tid, G * 512);
      for (int i = bid * 512 + tid; i < 16 * 128; i += G * 512) { const int bgz = i >> 7, dz = i & 127; ((bf16*)(p.ws + WS_KCMP))[((size_t)bgz * 256 + 255) * 128 + dz] = 0; ((bf16*)(p.ws + WS_VCMPT))[((size_t)bgz * 128 + dz) * 256 + 255] = 0; }
      const int ngrp = G * 4, total = 2 * 16 * 255, iters = (total + ngrp - 1) / ngrp; const int grp = tid >> 7;
      for (int it = 0; it < iters; ++it) { int id = it * ngrp + bid * 4 + grp; if (id >= total) id = total - 1;
          ph_cmp_fin_simple(p, (LAS float*)lds + grp * 4352, id, tid & 127, (const float*)(p.ws + WS_LH), (const float*)(p.ws + WS_PEVP)); __syncthreads(); } }
    xcd_barrier(bar);
    { PH_IDS; ph_nsa(p, lds, bid, G, tid, wave); }
    { PH_IDS; __syncthreads(); ph_gla_c(p, lds, bid, G, tid, wave); }
    xcd_barrier(bar);
    { pg8::Gemm g{(const bf16*)(p.ws + WS_A2), (const bf16*)(p.ws + WS_WOT), T, DM, DM};
      pg8::StaticOrder S; S.init(T, DM, G, bid); EpiRes E{p.in[I_X], p.out};
      pg8::gemm_phase<EpiRes, pg8::StaticOrder, true, true>(lds, g, S, E); }
    xcd_barrier(bar);
    { PH_IDS; for (int vb = bid; vb < NVB; vb += G) r1_router(p, lds, vb, tid, wave, lane); }
    xcd_barrier(bar);
    { PH_IDS; for (int vb = bid; vb < NVB; vb += G) r2_gather(p, lds, vb, vb == 0, tid, wave, lane); }
    xcd_barrier(bar);
    { pg8::Gemm g{(const bf16*)(p.ws + WS_HN8), (const bf16*)(p.ws + WS_W1Q), MAXTILES * 256, 4096, DM / 2};
      MoeOrderG S; S.init((const int*)(p.ws + WS_META), 16, G, bid); S.rowtab = (const unsigned short*)(p.ws + WS_ROWTOK); EpiSwigluI8 E{p.in[I_B1], (const float*)(p.ws + WS_ROWSC), (const float*)(p.ws + WS_WSC1), (bf16*)(p.ws + WS_ACT), (float*)(p.ws + WS_AMAXP)};
      pg8::gemm_phase<EpiSwigluI8, MoeOrderG, true, true, true, true>(lds, g, S, E); }
    xcd_barrier(bar);
    { PH_IDS; ph_actq(p, gw, NGW, lane); }
    xcd_barrier(bar);
    { pg8::Gemm g{(const bf16*)(p.ws + WS_ACT8), (const bf16*)(p.ws + WS_W2Q), MAXTILES * 256, DM, DFF / 2};
      MoeOrder S; S.init((const int*)(p.ws + WS_META), 8, G, bid); EpiDownI8 E{p.in[I_B2], (const float*)(p.ws + WS_ROWW), (const float*)(p.ws + WS_ASC), (const float*)(p.ws + WS_WSC2), (bf16*)(p.ws + WS_Y)};
      pg8::gemm_phase<EpiDownI8, MoeOrder, true, true, true>(lds, g, S, E); }
    xcd_barrier(bar);
    { PH_IDS; pf_final(p, gw, NGW, lane); }
}

extern "C" void kernel_launch(void* const* d_in, const int* in_sizes, int n_in, void* d_out, int out_size, void* d_ws, size_t ws_size, hipStream_t stream) {
    static int grid = 0;
    if (grid == 0) {
        if (n_in != N_IN || out_size != T * DM || ws_size < WS_END) { fprintf(stderr, "kernel_launch: unexpected shapes (n_in %d out %d ws %zu need %zu)\n", n_in, out_size, ws_size, (size_t)WS_END); grid = -1; return; }
        int dev = 0, cus = 0, per_cu = 0;
        if (hipGetDevice(&dev) != hipSuccess || hipDeviceGetAttribute(&cus, hipDeviceAttributeMultiprocessorCount, dev) != hipSuccess) { grid = -1; return; }
        if (hipFuncSetAttribute((const void*)mega_fwd, hipFuncAttributeMaxDynamicSharedMemorySize, LDS_BYTES) != hipSuccess) { fprintf(stderr, "kernel_launch: hipFuncSetAttribute failed\n"); grid = -1; return; }
        if (hipOccupancyMaxActiveBlocksPerMultiprocessor(&per_cu, (const void*)mega_fwd, 512, LDS_BYTES) != hipSuccess || per_cu < 1) { fprintf(stderr, "kernel_launch: occupancy query says %d blocks per CU\n", per_cu); }
        (void)hipGetLastError();
        grid = cus;
    }
    if (grid < 0) return;
    if (hipMemsetAsync((char*)d_ws + WS_CTL, 0, CTL_BYTES, stream) != hipSuccess) return;
    Params p{};
    for (int i = 0; i < N_IN; ++i) p.in[i] = (const float*)d_in[i];
    p.out = (float*)d_out; p.ws = (unsigned char*)d_ws;
    hipLaunchKernelGGL(mega_fwd, dim3(grid), dim3(512), LDS_BYTES, stream, p);
}
```

```cpp
#include <hip/hip_runtime.h>
#include <cstdio>
#include <cstdint>
namespace pg8 {
#define PG8_LAS __attribute__((address_space(3)))
typedef unsigned short bf16_t;
typedef short bf16x8 __attribute__((ext_vector_type(8)));
typedef float f32x4 __attribute__((ext_vector_type(4)));
typedef unsigned u32x4 __attribute__((ext_vector_type(4)));
typedef unsigned v2u_t __attribute__((ext_vector_type(2)));
constexpr int BM = 256, BK = 64, HALF = 128, HTB = HALF * BK * 2  , STAGE_BYTES = 8 * HTB, NXCD = 8, WGM = 8;

__host__ __device__ __forceinline__ int lds_byte(int r, int c) { const int st = (r >> 4) * 2 + (c >> 5), rr = r & 15, cc = c & 31, ob = rr * 64 + cc * 2; return st * 1024 + (ob ^ (((ob >> 9) & 1) << 5)); }
__host__ __device__ __forceinline__ void stage_rc(int b, int& R, int& C) { const int st = b / 1024, sb = b % 1024, swz = sb ^ (((sb >> 9) & 1) << 5); R = (st >> 1) * 16 + swz / 64; C = (st & 1) * 32 + (swz % 64) / 2; }
__host__ __device__ __forceinline__ int perm32(int rho) { const int n = rho >> 4, i = rho & 15; return 8 * (i >> 2) + 4 * n + (i & 3); }

struct Unit { int pm, pn, kind; };
struct Gemm { const bf16_t* A; const bf16_t* Bt; int M, N, K; };

template <int WG = WGM> __host__ __device__ __forceinline__ void tile_of(int wgid, int nM, int nN, int& pm, int& pn) {
    const int nwg = nM * nN;
    { const int q = nwg / NXCD, r = nwg % NXCD, xcd = wgid % NXCD, off = wgid / NXCD; wgid = (xcd < r ? xcd * (q + 1) : r * (q + 1) + (xcd - r) * q) + off; }
    const int nig = WG * nN, gid = wgid / nig, fm = gid * WG, gsz = (nM - fm) < WG ? (nM - fm) : WG;
    pm = fm + ((wgid % nig) % gsz); pn = (wgid % nig) / gsz;
}
struct StaticOrder {
    int nM, nN, nwg, G, c;
    __host__ __device__ void init(int M, int N, int G_, int c_) { nM = M / BM; nN = N / BM; nwg = nM * nN; G = G_; c = c_; }
    __device__ __forceinline__ bool next(int i, Unit& u) const {
        const long L = (long)i * G + c; if (L >= nwg) return false;
        tile_of((int)L, nM, nN, u.pm, u.pn); u.kind = 0; return true;
    }
    __device__ __forceinline__ const char* pa(const Gemm& g, const Unit& u) const { return (const char*)g.A + (size_t)u.pm * ((size_t)BM * g.K * 2); }
    __device__ __forceinline__ const char* pb(const Gemm& g, const Unit& u) const { return (const char*)g.Bt + (size_t)u.pn * ((size_t)BM * g.K * 2); }
    __device__ __forceinline__ void a_ready(const Unit&) const {}
    __device__ __forceinline__ void done(const Unit&) const {}
};
__device__ __forceinline__ unsigned cvt_pk_bf16(float lo, float hi) { unsigned r; asm volatile("v_cvt_pk_bf16_f32 %0, %1, %2" : "=v"(r) : "v"(lo), "v"(hi)); return r; }
template <bool I8> __device__ __forceinline__ f32x4 mma16(bf16x8 a, bf16x8 b, f32x4 c) {
    if constexpr (I8) { typedef int i32x4 __attribute__((ext_vector_type(4)));
        return __builtin_bit_cast(f32x4, __builtin_amdgcn_mfma_i32_16x16x64_i8(__builtin_bit_cast(i32x4, a), __builtin_bit_cast(i32x4, b), __builtin_bit_cast(i32x4, c), 0, 0, 0)); }
    else return __builtin_amdgcn_mfma_f32_16x16x32_bf16(a, b, c, 0, 0, 0);
}
template <class Epi, class Sched, bool ALIGN_EPI = false, bool SP2 = false, bool I8 = false, bool GATHER = false>
__device__ __forceinline__ void gemm_phase(PG8_LAS unsigned char* lds, const Gemm g, const Sched& S, const Epi& E) {
    int tid_l = threadIdx.x; asm volatile("" : "+v"(tid_l));
    const int tid = tid_l, wid = __builtin_amdgcn_readfirstlane(tid >> 6), lane = tid & 63, wr = wid >> 2, wc = wid & 3, fr = lane & 15, fq = lane >> 4;
    const int K = g.K, nt = K / BK;
    unsigned voffA[2], voffB[2];
#pragma unroll
    for (int i = 0; i < 2; ++i) { int R, C; stage_rc(tid * 16 + i * 8192, R, C); const int Rb = Epi::PERM ? ((R & ~31) + perm32(R & 31)) : R;
        voffA[i] = (unsigned)(R * K + C) * 2u; voffB[i] = (unsigned)(Rb * K + C) * 2u; }
    const size_t kstep = (size_t)(BK * 2);
    const size_t hstep = (size_t)HALF * K * 2;
    const unsigned ldsw = (unsigned)wid * 1024u;
    const int aoff = lds_byte(wr * 64 + fr, fq * 8), boff = lds_byte(wc * 32 + fr, fq * 8);
#define PG8_SA(b, h) (((b) * 2 + (h)) * HTB)
#define PG8_SB(b, h) ((4 + (b) * 2 + (h)) * HTB)
#define PG8_STAGE(bufoff, gbase, voff) do { _Pragma("unroll") for (int _i = 0; _i < 2; ++_i) \
        __builtin_amdgcn_global_load_lds((const unsigned*)((const char*)(gbase) + (voff)[_i]), (PG8_LAS unsigned*)(lds + (bufoff) + ldsw + _i * 8192), 16, 0, 0); } while (0)
#define PG8_STAGE_A(bufoff, ptr, h) do { if constexpr (GATHER) PG8_STAGE(bufoff, ptr, cuo + 2 * (h)); else PG8_STAGE(bufoff, (ptr) + (h) * hstep, voffA); } while (0)
#define PG8_LDA(dst, b, h) do { _Pragma("unroll") for (int m = 0; m < 4; ++m) _Pragma("unroll") for (int k = 0; k < 2; ++k) dst[m][k] = *(const PG8_LAS bf16x8*)(lds + PG8_SA(b, h) + aoff + m * 2048 + k * 1024); } while (0)
#define PG8_LDB(dst, b, h) do { _Pragma("unroll") for (int n = 0; n < 2; ++n) _Pragma("unroll") for (int k = 0; k < 2; ++k) dst[n][k] = *(const PG8_LAS bf16x8*)(lds + PG8_SB(b, h) + boff + n * 2048 + k * 1024); } while (0)
#define PG8_MMA(ai, bj, At, Bt) do { __builtin_amdgcn_s_setprio(1); _Pragma("unroll") for (int m = 0; m < 4; ++m) _Pragma("unroll") for (int n = 0; n < 2; ++n) _Pragma("unroll") for (int k = 0; k < 2; ++k) \
        acc[ai][bj][m][n] = mma16<I8>(Bt[n][k], At[m][k], acc[ai][bj][m][n]); __builtin_amdgcn_s_setprio(0); } while (0)
#define PG8_WAIT_V(n) asm volatile("s_waitcnt vmcnt(" #n ")" ::: "memory")
#define PG8_WAIT_L(n) asm volatile("s_waitcnt lgkmcnt(" #n ")" ::: "memory")
#define PG8_BAR __builtin_amdgcn_s_barrier()
#define PG8_SCHED __builtin_amdgcn_sched_barrier(0)
    Unit cur, nxt; int ui = 0;
    if (!S.next(0, cur)) return;
    unsigned cuo[4] = {0u, 0u, 0u, 0u}, cb0 = 0u; v2u_t raw = {0u, 0u};
    if constexpr (GATHER) { int R0, C0; stage_rc(tid * 16, R0, C0); cb0 = (unsigned)C0 * 2u; unsigned ro = (unsigned)R0 * 8u; asm volatile("" : "+v"(ro));
        Unit u1; const bool h1 = S.next(1, u1); const v2u_t r0 = *(const v2u_t*)((const char*)S.rowtab + (size_t)cur.pm * 512 + ro); raw = *(const v2u_t*)((const char*)S.rowtab + (size_t)(h1 ? u1.pm : cur.pm) * 512 + ro);
        cuo[0] = ((r0.x & 0xffffu) << 11) + cb0; cuo[1] = ((r0.x >> 16) << 11) + cb0; cuo[2] = ((r0.y & 0xffffu) << 11) + cb0; cuo[3] = ((r0.y >> 16) << 11) + cb0; }
    f32x4 acc[2][2][4][2];
#pragma unroll
    for (int a = 0; a < 2; ++a)
#pragma unroll
        for (int b = 0; b < 2; ++b)
#pragma unroll
            for (int m = 0; m < 4; ++m)
#pragma unroll
                for (int n = 0; n < 2; ++n) acc[a][b][m][n] = (f32x4){0.f, 0.f, 0.f, 0.f};
    bf16x8 At[4][2], B0[2][2], B1[2][2];
    const char* cA = S.pa(g, cur); const char* cB = S.pb(g, cur);
    S.a_ready(cur);
    if constexpr (SP2) {
        PG8_STAGE(PG8_SB(0, 0), cB, voffB); PG8_STAGE(PG8_SB(0, 1), cB + hstep, voffB); PG8_STAGE_A(PG8_SA(0, 0), cA, 0); PG8_STAGE_A(PG8_SA(0, 1), cA, 1);
        if (wr == 1) PG8_BAR;
        PG8_WAIT_V(2); PG8_BAR;
        PG8_STAGE(PG8_SB(1, 0), cB + kstep, voffB); PG8_STAGE_A(PG8_SA(1, 0), cA + kstep, 0); PG8_STAGE(PG8_SB(1, 1), cB + hstep + kstep, voffB);
        PG8_WAIT_V(6); PG8_BAR;
    } else {
        PG8_STAGE(PG8_SB(0, 0), cB, voffB); PG8_STAGE(PG8_SA(0, 0), cA, voffA); PG8_STAGE(PG8_SB(0, 1), cB + hstep, voffB); PG8_STAGE(PG8_SA(0, 1), cA + hstep, voffA);
        if (wr == 1) PG8_BAR;
        PG8_WAIT_V(4); PG8_BAR;
        PG8_STAGE(PG8_SB(1, 0), cB + kstep, voffB); PG8_STAGE(PG8_SA(1, 0), cA + kstep, voffA); PG8_STAGE(PG8_SB(1, 1), cB + hstep + kstep, voffB);
        PG8_WAIT_V(6); PG8_BAR;
    }
    for (;;) {
        const bool has_next = S.next(ui + 1, nxt);
        const char* nA = has_next ? S.pa(g, nxt) : cA; const char* nB = has_next ? S.pb(g, nxt) : cB;
        for (int t = 0; t < nt; t += 2) {
            const bool last = (t == nt - 2);
            const char* a1 = cA + (size_t)(t + 1) * kstep;
            const char* a2 = last ? nA : cA + (size_t)(t + 2) * kstep; const char* b2 = last ? nB : cB + (size_t)(t + 2) * kstep;
            const char* a3 = a2 + kstep; const char* b3 = b2 + kstep;
            if (last && has_next) S.a_ready(nxt);
            if constexpr (SP2) {
            PG8_LDB(B0, 0, 0); PG8_LDB(B1, 0, 1); PG8_SCHED; PG8_LDA(At, 0, 0); PG8_STAGE_A(PG8_SA(1, 1), a1, 1);
            if constexpr (GATHER) { unsigned rx = raw.x, ry = raw.y; asm volatile("" : "+v"(rx), "+v"(ry));
                const unsigned n0 = ((rx & 0xffffu) << 11) + cb0, n1 = ((rx >> 16) << 11) + cb0, n2 = ((ry & 0xffffu) << 11) + cb0, n3 = ((ry >> 16) << 11) + cb0;
                cuo[0] = last ? n0 : cuo[0]; cuo[1] = last ? n1 : cuo[1]; cuo[2] = last ? n2 : cuo[2]; cuo[3] = last ? n3 : cuo[3]; }
            PG8_WAIT_V(8); PG8_WAIT_L(0); PG8_BAR; PG8_MMA(0, 0, At, B0); PG8_MMA(0, 1, At, B1); PG8_BAR; PG8_SCHED;
            PG8_LDA(At, 0, 1); PG8_STAGE(PG8_SB(0, 0), b2, voffB); PG8_STAGE(PG8_SB(0, 1), b2 + hstep, voffB); PG8_STAGE_A(PG8_SA(0, 0), a2, 0);
            PG8_WAIT_V(8); PG8_WAIT_L(0); PG8_BAR; PG8_MMA(1, 0, At, B0); PG8_MMA(1, 1, At, B1); PG8_BAR; PG8_SCHED;
            PG8_LDB(B0, 1, 0); PG8_LDB(B1, 1, 1); PG8_SCHED; PG8_LDA(At, 1, 0); PG8_STAGE_A(PG8_SA(0, 1), a2, 1);
            PG8_WAIT_V(8); PG8_WAIT_L(0); PG8_BAR; PG8_MMA(0, 0, At, B0); PG8_MMA(0, 1, At, B1); PG8_BAR; PG8_SCHED;
            PG8_LDA(At, 1, 1); PG8_STAGE(PG8_SB(1, 0), b3, voffB); PG8_STAGE(PG8_SB(1, 1), b3 + hstep, voffB); PG8_STAGE_A(PG8_SA(1, 0), a3, 0);
            PG8_WAIT_V(8); PG8_WAIT_L(0); PG8_BAR; PG8_MMA(1, 0, At, B0); PG8_MMA(1, 1, At, B1); PG8_BAR; PG8_SCHED;
            } else {
            PG8_LDB(B0, 0, 0); PG8_SCHED; PG8_LDA(At, 0, 0); PG8_STAGE(PG8_SA(1, 1), a1 + hstep, voffA);
            PG8_WAIT_L(8); PG8_BAR; PG8_WAIT_L(0); PG8_MMA(0, 0, At, B0); PG8_BAR; PG8_SCHED;
            PG8_LDB(B1, 0, 1); PG8_STAGE(PG8_SB(0, 0), b2, voffB);
            PG8_BAR; PG8_WAIT_L(0); PG8_MMA(0, 1, At, B1); PG8_BAR;
            PG8_LDA(At, 0, 1); PG8_STAGE(PG8_SA(0, 0), a2, voffA);
            PG8_BAR; PG8_WAIT_L(0); PG8_MMA(1, 0, At, B0); PG8_BAR; PG8_SCHED;
            PG8_STAGE(PG8_SB(0, 1), b2 + hstep, voffB);
            PG8_WAIT_V(6); PG8_BAR; PG8_MMA(1, 1, At, B1); PG8_BAR;
            PG8_LDB(B0, 1, 0); PG8_SCHED; PG8_LDA(At, 1, 0); PG8_STAGE(PG8_SA(0, 1), a2 + hstep, voffA);
            PG8_WAIT_L(8); PG8_BAR; PG8_WAIT_L(0); PG8_MMA(0, 0, At, B0); PG8_BAR; PG8_SCHED;
            PG8_LDB(B1, 1, 1); PG8_STAGE(PG8_SB(1, 0), b3, voffB);
            PG8_BAR; PG8_WAIT_L(0); PG8_MMA(0, 1, At, B1); PG8_BAR;
            PG8_LDA(At, 1, 1); PG8_STAGE(PG8_SA(1, 0), a3, voffA);
            PG8_BAR; PG8_WAIT_L(0); PG8_MMA(1, 0, At, B0); PG8_BAR; PG8_SCHED;
            PG8_STAGE(PG8_SB(1, 1), b3 + hstep, voffB);
            PG8_WAIT_V(6); PG8_BAR; PG8_MMA(1, 1, At, B1); PG8_BAR;
            }
        }
        if constexpr (ALIGN_EPI) { if (wr == 0) PG8_BAR; }
        if constexpr (GATHER) { static_assert(SP2 && !Epi::AFTER_DRAIN, "GATHER is written for the SP2 loop"); int R0, C0; stage_rc(tid * 16, R0, C0); Unit u2; const bool h2 = S.next(ui + 2, u2);
            unsigned ro = (unsigned)R0 * 8u; asm volatile("" : "+v"(ro)); raw = *(const v2u_t*)((const char*)S.rowtab + (size_t)(h2 ? u2.pm : cur.pm) * 512 + ro); PG8_SCHED; }
        if constexpr (!Epi::AFTER_DRAIN) { E(acc, cur, wr, wc, fr, fq); S.done(cur); }
        if (!has_next) break;
#pragma unroll
        for (int a = 0; a < 2; ++a)
#pragma unroll
            for (int b = 0; b < 2; ++b)
#pragma unroll
                for (int m = 0; m < 4; ++m)
#pragma unroll
                    for (int n = 0; n < 2; ++n) acc[a][b][m][n] = (f32x4){0.f, 0.f, 0.f, 0.f};
        cur = nxt; cA = nA; cB = nB; ++ui;
        if constexpr (ALIGN_EPI) { if (wr == 1) PG8_BAR; }
    }
    PG8_WAIT_V(0);
    if constexpr (!ALIGN_EPI) { if (wr == 0) PG8_BAR; }
    PG8_BAR;
    if constexpr (Epi::AFTER_DRAIN) { E.fused(acc, cur, wr, wc, fr, fq, lds, wid, lane); S.done(cur); }
#undef PG8_SA
#undef PG8_SB
#undef PG8_STAGE
#undef PG8_STAGE_A
#undef PG8_LDA
#undef PG8_LDB
#undef PG8_MMA
#undef PG8_WAIT_V
#undef PG8_WAIT_L
#undef PG8_BAR
#undef PG8_SCHED
}
}

#define GAS __attribute__((address_space(1)))
#define LAS __attribute__((address_space(3)))
typedef unsigned short bf16;
typedef unsigned v4u __attribute__((ext_vector_type(4)));
typedef unsigned v2u __attribute__((ext_vector_type(2)));
typedef float f32x4 __attribute__((ext_vector_type(4)));
typedef short bf16x8 __attribute__((ext_vector_type(8)));

constexpr int NB = 8, SEQ = 4096, DM = 2048, T = NB * SEQ;
constexpr int NPT = 23;
constexpr int NE = 32, DFF = 2048;
constexpr int MAXTILES = 544;
constexpr float RMS_EPS = 1e-5f;
constexpr int NVB = 256, TPV = T / NVB;

enum { I_X = 0, I_NMIX, I_WIN, I_WA2, I_BA, I_GLAG, I_PEK, I_WK1, I_WK2, I_PEV, I_WV1, I_WV2, I_NSAG, I_RELB, I_WOUT, I_NFFN, I_RW, I_RB, I_W1, I_B1, I_W2, I_B2, I_NFIN, N_IN };

constexpr size_t MiB = 1u << 20;
constexpr size_t al(size_t x) { return (x + 255) & ~(size_t)255; }
constexpr size_t WS_CTL = 0, CTL_BYTES = 1 * MiB;
constexpr size_t WS_CNT = WS_CTL + CTL_BYTES;
constexpr size_t WS_META = WS_CNT + al(NVB * 32 * 4);
constexpr size_t WS_EIDX = WS_META + al((64 + MAXTILES) * 4);
constexpr size_t WS_LRNK = WS_EIDX + al((size_t)T * 4 * 4);
constexpr size_t WS_GATE = WS_LRNK + al((size_t)T * 4 * 4);
constexpr size_t WS_POS = WS_GATE + al((size_t)T * 4 * 4);
constexpr size_t WS_ROWW = WS_POS + al((size_t)T * 4 * 4);
constexpr size_t WS_WINT = al(WS_ROWW + (size_t)MAXTILES * 256 * 4);
constexpr size_t WS_WOT = WS_WINT + (size_t)NPT * 256 * DM * 2;
constexpr size_t WS_WKCT = WS_WOT + (size_t)DM * DM * 2;
constexpr size_t WS_WVCT = WS_WKCT + (size_t)256 * 2048 * 2;
constexpr size_t WS_W1T = WS_WVCT + (size_t)256 * 2048 * 2;
constexpr size_t WS_W2T = WS_W1T + (size_t)NE * 4096 * DM * 2;
constexpr size_t WS_XN = WS_W2T + (size_t)NE * DM * DFF * 2;
constexpr size_t WS_GQ = WS_XN + (size_t)T * DM * 2;
constexpr size_t WS_GK = WS_GQ + (size_t)T * 512 * 2;
constexpr size_t WS_GV = WS_GK + (size_t)T * 512 * 2;
constexpr size_t WS_GG = WS_GV + (size_t)T * 1024 * 2;
constexpr size_t WS_NQ = WS_GG + (size_t)T * 1024 * 2;
constexpr size_t WS_KC = WS_NQ + (size_t)T * 1024 * 2;
constexpr size_t WS_VC = WS_KC + (size_t)T * 256 * 2;
constexpr size_t WS_KS = WS_VC + (size_t)T * 256 * 2;
constexpr size_t WS_KW = WS_KS + (size_t)T * 256 * 2;
constexpr size_t WS_VST = WS_KW + (size_t)T * 256 * 2;
constexpr size_t WS_VWT = WS_VST + (size_t)T * 256 * 2;
constexpr size_t WS_SM = WS_VWT + (size_t)T * 256 * 2;
constexpr size_t WS_LA = WS_SM + (size_t)T * 64 * 2;
constexpr size_t WS_OG = WS_LA + (size_t)T * 512 * 4;
constexpr size_t WS_ON = WS_OG + (size_t)T * 1024 * 4;
constexpr size_t WS_KCMP = WS_ON + (size_t)T * 1024 * 4;
constexpr size_t WS_VCMPT = WS_KCMP + (size_t)16 * 256 * 128 * 2;
constexpr size_t WS_A2 = WS_VCMPT + (size_t)16 * 256 * 128 * 2;
constexpr size_t WS_HN = WS_A2 + (size_t)T * DM * 2;
constexpr size_t WS_XG = WS_HN + (size_t)T * DM * 2;
constexpr size_t WS_ACT = WS_XG + (size_t)MAXTILES * 256 * DM * 2;
constexpr size_t WS_END = WS_ACT + (size_t)MAXTILES * 256 * DFF * 2;

__device__ __forceinline__ unsigned f2bf(float f) { unsigned u = __builtin_bit_cast(unsigned, f); return (u + 0x7fffu + ((u >> 16) & 1u)) >> 16; }
__device__ __forceinline__ unsigned pk2(float lo, float hi) { return f2bf(lo) | (f2bf(hi) << 16); }
__device__ __forceinline__ float bf2f(unsigned short v) { return __builtin_bit_cast(float, (unsigned)v << 16); }
__device__ __forceinline__ float bflo(unsigned w) { return __builtin_bit_cast(float, w << 16); }
__device__ __forceinline__ float bfhi(unsigned w) { return __builtin_bit_cast(float, w & 0xffff0000u); }
__device__ __forceinline__ float wave_sum(float v) {
#pragma unroll
    for (int o = 1; o < 64; o <<= 1) v += __shfl_xor(v, o);
    return v;
}
__device__ __forceinline__ float wave_max(float v) {
#pragma unroll
    for (int o = 1; o < 64; o <<= 1) v = fmaxf(v, __shfl_xor(v, o));
    return v;
}
#define LDS_WAIT() asm volatile("s_waitcnt lgkmcnt(0)" ::: "memory")

__device__ const unsigned char kBucket[128] = {0, 1, 2, 3, 4, 5, 6, 7, 8, 9, 10, 11, 12, 13, 14, 15, 16, 16, 16, 17, 17, 18, 18, 18, 19, 19, 19, 20, 20, 20, 20, 21, 21, 21, 21, 22, 22, 22, 22, 22, 23, 23, 23, 23, 23, 23, 24, 24, 24, 24, 24, 24, 25, 25, 25, 25, 25, 25, 25, 26, 26, 26, 26, 26, 26, 26, 26, 27, 27, 27, 27, 27, 27, 27, 27, 27, 27, 28, 28, 28, 28, 28, 28, 28, 28, 28, 28, 29, 29, 29, 29, 29, 29, 29, 29, 29, 29, 29, 29, 30, 30, 30, 30, 30, 30, 30, 30, 30, 30, 30, 30, 30, 30, 31, 31, 31, 31, 31, 31, 31, 31, 31, 31, 31, 31, 31, 31, 31};

struct Params {
    const float* in[N_IN];
    float* out;
    unsigned char* ws;
};

template <class F>
__device__ __forceinline__ void transpose_item(const float* W, int ldw, int k0, int n0, int nlim, LAS float* scr, int lane, F dst) {
#pragma unroll 8
    for (int i = 0; i < 32; ++i) { const int kk = 2 * i + (lane >> 5); const int n = n0 + (lane & 31); scr[kk * 33 + (lane & 31)] = n < nlim ? W[(size_t)(k0 + kk) * ldw + n] : 0.f; }
    LDS_WAIT(); asm volatile("" ::: "memory");
    const int c = lane & 7;
#pragma unroll
    for (int j = 0; j < 4; ++j) { const int nn = (lane >> 3) + 8 * j; const int n = n0 + nn; const LAS float* s = scr + (8 * c) * 33 + nn;
        bf16* rowp; float sc;
        if (n < nlim && dst(n, rowp, sc)) {
            v4u o; o.x = pk2(s[0 * 33] * sc, s[1 * 33] * sc); o.y = pk2(s[2 * 33] * sc, s[3 * 33] * sc); o.z = pk2(s[4 * 33] * sc, s[5 * 33] * sc); o.w = pk2(s[6 * 33] * sc, s[7 * 33] * sc);
            *(v4u*)(rowp + 8 * c) = o; } }
    LDS_WAIT(); asm volatile("" ::: "memory");
}
__device__ __forceinline__ int win_row(int n, float& sc) {
    sc = 1.f;
    if (n < 512) { sc = 0.08838834764831845f; return n; }
    if (n < 1024) return n;
    if (n < 2048) return n;
    if (n < 3072) return n;
    if (n < 3088) return 5120 + (n - 3072);
    if (n < 4112) { sc = 0.08838834764831845f; return 3072 + (n - 3088); }
    if (n < 4368) return 4096 + (n - 4112);
    if (n < 4624) return 4352 + (n - 4368);
    if (n < 4880) return 4608 + (n - 4624);
    if (n < 5136) return 5376 + (n - 4880);
    if (n < 5392) return 4864 + (n - 5136);
    if (n < 5648) return 5632 + (n - 5392);
    return 5136 + (n - 5648);
}
constexpr size_t WS_PEVP = WS_W2T;
__device__ __forceinline__ void p0_prologue(const Params& p, LAS unsigned char* lds, int gw, int NGW, int wave, int lane) {
    LAS float* scr = (LAS float*)(lds + wave * 16384);
    bf16* WinT = (bf16*)(p.ws + WS_WINT); bf16* WoT = (bf16*)(p.ws + WS_WOT); bf16* WkcT = (bf16*)(p.ws + WS_WKCT); bf16* WvcT = (bf16*)(p.ws + WS_WVCT);
    bf16* W1T = (bf16*)(p.ws + WS_W1T); bf16* W2T = (bf16*)(p.ws + WS_W2T);
    constexpr int I_IN = 32 * 178, I_O = 32 * 64, I_C = 64 * 4, I_E1 = 32 * 128, I_E2 = 32 * 64;
    constexpr int I_PE = 2 * 64;
    constexpr int NITEMS = I_O + 2 * I_C + I_PE;
    (void)I_IN; (void)WinT;
    for (int it = gw; it < NITEMS; it += NGW) {
        int r = it;
        if (r < I_O) { const int kb = r / 64, nb = r % 64, k0 = kb * 64;
            transpose_item(p.in[I_WOUT], DM, k0, nb * 32, DM, scr, lane, [&](int n, bf16*& rowp, float& sc) { sc = 1.f; rowp = WoT + (size_t)n * DM + k0; return true; }); continue; } r -= I_O;
        if (r >= 2 * I_C) { r -= 2 * I_C; const int which = r >> 6, kq = r & 63; const float* pe = p.in[which ? I_PEV : I_PEK] + kq * 64; const float* w1 = p.in[which ? I_WV1 : I_WK1] + (size_t)kq * 64 * 128 + lane;
            float a0 = 0.f, a1 = 0.f;
#pragma unroll
            for (int k = 0; k < 64; ++k) { const float pv = pe[k]; a0 += pv * w1[k * 128]; a1 += pv * w1[k * 128 + 64]; }
            float* dst = (float*)(p.ws + WS_PEVP) + (size_t)(which * 64 + kq) * 128 + lane; dst[0] = a0; dst[64] = a1; continue; }
        { const int which = r / I_C; r %= I_C; const int kb = r / 4, nb = r % 4, k0 = kb * 64;
            bf16* dstm = which ? WvcT : WkcT;
            transpose_item(p.in[which ? I_WV1 : I_WK1], 128, k0, nb * 32, 128, scr, lane, [&](int n, bf16*& rowp, float& sc) { sc = 1.f; rowp = dstm + (size_t)(n + (k0 >= 2048 ? 128 : 0)) * 2048 + (k0 & 2047); return true; }); }
        (void)I_E1; (void)I_E2; (void)W1T; (void)W2T;
    }
    const float* x = p.in[I_X]; const float* gm = p.in[I_NMIX];
    for (int m = gw; m < T; m += NGW) {
        const f32x4* xr = (const f32x4*)(x + (size_t)m * DM) + lane; f32x4 v[8]; float s = 0.f;
#pragma unroll
        for (int j = 0; j < 8; ++j) { v[j] = xr[64 * j]; s += (v[j].x * v[j].x + v[j].y * v[j].y) + (v[j].z * v[j].z + v[j].w * v[j].w); }
        const float rstd = 1.f / sqrtf(wave_sum(s) * (1.f / DM) + RMS_EPS);
        float mxr = 0.f;
#pragma unroll
        for (int j = 0; j < 8; ++j) { const f32x4 g4 = ((const f32x4*)gm)[lane + 64 * j]; v[j].x *= rstd * g4.x; v[j].y *= rstd * g4.y; v[j].z *= rstd * g4.z; v[j].w *= rstd * g4.w;
            mxr = fmaxf(mxr, fmaxf(fmaxf(fabsf(v[j].x), fabsf(v[j].y)), fmaxf(fabsf(v[j].z), fabsf(v[j].w)))); }
        mxr = wave_max(mxr); const float qs = mxr > 0.f ? mxr * (1.f / 127.f) : 1.f, qi = 1.f / qs;
        unsigned* o4 = (unsigned*)(p.ws + WS_XN + (size_t)m * DM) + lane;
#pragma unroll
        for (int j = 0; j < 8; ++j) { const int q0 = (int)rintf(v[j].x * qi), q1 = (int)rintf(v[j].y * qi), q2 = (int)rintf(v[j].z * qi), q3 = (int)rintf(v[j].w * qi);
            o4[64 * j] = ((unsigned)q0 & 0xffu) | (((unsigned)q1 & 0xffu) << 8) | (((unsigned)q2 & 0xffu) << 16) | (((unsigned)q3 & 0xffu) << 24); }
        if (lane == 0) ((float*)(p.ws + WS_XN + (size_t)T * DM))[m] = qs;
    }
}
#define XB_TMO      128
#define XB_XCNT(j)  (256  + 64 * (j))
#define XB_XSUB(j)  (1280 + 64 * (j))
#define XB_XGEN(j)  (2304 + 64 * (j))
#define XB_TOP      3328
#define XB_TOPGEN   3392
#define XCD_BAR_WORDS 3456
#define XB_SPIN_CAP (1u << 18)

__device__ __forceinline__ unsigned xb_ld(unsigned* p)              { return __hip_atomic_load(p, __ATOMIC_RELAXED, __HIP_MEMORY_SCOPE_AGENT); }
__device__ __forceinline__ unsigned xb_add(unsigned* p, unsigned v) { return __hip_atomic_fetch_add(p, v, __ATOMIC_RELAXED, __HIP_MEMORY_SCOPE_AGENT); }
__device__ __forceinline__ unsigned xb_xcc_id() { return (unsigned)__builtin_amdgcn_s_getreg((3 << 11) | 20) & 0xFu; }
#define XB_SPIN(cond, bar) do { unsigned _sp = 0; while (cond) { __builtin_amdgcn_s_sleep(1); \
    if ((++_sp & 255u) == 0u) { if (xb_ld(&(bar)[XB_TMO])) break; if (_sp > XB_SPIN_CAP) { atomicAdd(&(bar)[XB_TMO], 1u); break; } } } } while (0)

struct XcdBarrier {
    unsigned* bar; unsigned x;
    volatile LAS unsigned* st;
};

__device__ __forceinline__ XcdBarrier xcd_barrier_post(unsigned* bar, volatile LAS unsigned* st) {
    XcdBarrier b; b.bar = bar; b.x = xb_xcc_id(); b.st = st;
    if (threadIdx.x == 0) (void)xb_add(&bar[XB_XCNT(b.x)], 1u);
    return b;
}
__device__ __forceinline__ void xcd_barrier_complete(unsigned* bar, unsigned x, unsigned& nloc, unsigned& nx) {
    const unsigned G = gridDim.x * gridDim.y * gridDim.z;
    unsigned sum, cnt, mine, sp = 0u;
    for (;;) {
        sum = 0u; cnt = 0u; mine = 0u;
#pragma unroll
        for (unsigned j = 0; j < 16; ++j) { const unsigned c = xb_ld(&bar[XB_XCNT(j)]); sum += c; cnt += (c > 0u) ? 1u : 0u; mine = (j == x) ? c : mine; }
        if (sum == G) break;
        __builtin_amdgcn_s_sleep(1);
        if ((++sp & 255u) == 0u) { if (xb_ld(&bar[XB_TMO])) break; if (sp > XB_SPIN_CAP) { atomicAdd(&bar[XB_TMO], 1u); break; } }
    }
    nloc = mine > 0u ? mine : 1u; nx = cnt > 0u ? cnt : 1u;
}

__device__ __forceinline__ void xcd_barrier(const XcdBarrier& b) {
    asm volatile("s_waitcnt vmcnt(0)" ::: "memory");
    __syncthreads();
    if (threadIdx.x == 0) {
        unsigned* bar = b.bar;
        __builtin_amdgcn_s_waitcnt(0);
        unsigned nloc = b.st[0], nx = b.st[1];
        if (nloc == 0u) { xcd_barrier_complete(bar, b.x, nloc, nx); b.st[0] = nloc; b.st[1] = nx; }
        const unsigned old = xb_add(&bar[XB_XSUB(b.x)], 1u);
        const unsigned gen = old / nloc;
        if (old + 1u == (gen + 1u) * nloc) {
            __builtin_amdgcn_fence(__ATOMIC_RELEASE, "agent");
            asm volatile("s_waitcnt vmcnt(0)" ::: "memory");
            const unsigned og = xb_add(&bar[XB_TOP], 1u);
            const unsigned tg = og / nx;
            if (og + 1u == (tg + 1u) * nx) xb_add(&bar[XB_TOPGEN], 1u);
            else XB_SPIN(xb_ld(&bar[XB_TOPGEN]) == tg, bar);
            __builtin_amdgcn_fence(__ATOMIC_ACQUIRE, "agent");
            xb_add(&bar[XB_XGEN(b.x)], 1u);
            asm volatile("s_waitcnt vmcnt(0)" ::: "memory");
        } else {
            XB_SPIN(xb_ld(&bar[XB_XGEN(b.x)]) == gen, bar);
            __builtin_amdgcn_fence(__ATOMIC_ACQUIRE, "agent");
            asm volatile("s_waitcnt vmcnt(0)" ::: "memory");
        }
    }
    __syncthreads();
}

struct ProjOrder : pg8::StaticOrder {
    const bf16* xn; const bf16* wt;
    __device__ __forceinline__ bool next(int i, pg8::Unit& u) const { if (!pg8::StaticOrder::next(i, u)) return false; u.kind = (u.pn >= 21) ? 1 : 0; return true; }
    __device__ __forceinline__ const char* pa(const pg8::Gemm& g, const pg8::Unit& u) const { return u.kind ? (const char*)wt + (size_t)u.pn * ((size_t)256 * g.K * 2) : (const char*)xn + (size_t)u.pm * ((size_t)256 * g.K * 2); }
    __device__ __forceinline__ const char* pb(const pg8::Gemm& g, const pg8::Unit& u) const { return u.kind ? (const char*)xn + (size_t)u.pm * ((size_t)256 * g.K * 2) : (const char*)wt + (size_t)u.pn * ((size_t)256 * g.K * 2); }
};
struct EpiRes {
    static constexpr bool PERM = true, AFTER_DRAIN = false;
    const float* x; bf16* h;
    __device__ __forceinline__ void operator()(const pg8::f32x4 (&acc)[2][2][4][2], const pg8::Unit& u, int wr, int wc, int fr, int fq) const {
        const int row0 = u.pm * 256 + wr * 64 + fr, col0 = u.pn * 256 + wc * 32 + 8 * fq;
#pragma unroll
        for (int ai = 0; ai < 2; ++ai)
#pragma unroll
            for (int m = 0; m < 4; ++m) { const size_t off = (size_t)(row0 + ai * 128 + m * 16) * DM + col0;
#pragma unroll
                for (int bj = 0; bj < 2; ++bj) { const pg8::f32x4 x0 = *(const pg8::f32x4*)(x + off + bj * 128), x1 = *(const pg8::f32x4*)(x + off + bj * 128 + 4);
                    const pg8::f32x4 a0 = x0 + acc[ai][bj][m][0], a1 = x1 + acc[ai][bj][m][1]; pg8::u32x4 w;
                    w.x = pg8::cvt_pk_bf16(a0.x, a0.y); w.y = pg8::cvt_pk_bf16(a0.z, a0.w); w.z = pg8::cvt_pk_bf16(a1.x, a1.y); w.w = pg8::cvt_pk_bf16(a1.z, a1.w);
                    *(pg8::u32x4*)(h + off + bj * 128) = w; } }
    }
};
struct MoeOrder {
    int nM, nN, nwg, G, c; const int* tile_exp;
    __device__ __forceinline__ void init(const int* meta, int nN_, int G_, int c_) { nM = meta[0]; nN = nN_; nwg = nM * nN; G = G_; c = c_; tile_exp = meta + 64; }
    __device__ __forceinline__ bool next(int i, pg8::Unit& u) const {
        const long L = (long)i * G + c; if (L >= nwg) return false;
        pg8::tile_of<8>((int)L, nM, nN, u.pm, u.pn); u.kind = tile_exp[u.pm]; return true;
    }
    __device__ __forceinline__ const char* pa(const pg8::Gemm& g, const pg8::Unit& u) const { return (const char*)g.A + (size_t)u.pm * ((size_t)256 * g.K * 2); }
    __device__ __forceinline__ const char* pb(const pg8::Gemm& g, const pg8::Unit& u) const { return (const char*)g.Bt + ((size_t)u.kind * nN + u.pn) * ((size_t)256 * g.K * 2); }
    __device__ __forceinline__ void a_ready(const pg8::Unit&) const {}
    __device__ __forceinline__ void done(const pg8::Unit&) const {}
};

struct MoeOrderG : MoeOrder { const unsigned short* rowtab;
    __device__ __forceinline__ const char* pa(const pg8::Gemm& g, const pg8::Unit&) const { return (const char*)g.A; } };

__device__ __forceinline__ float gelu_tanh(float x) { const float u = 0.7978845608028654f * (x + 0.044715f * x * x * x); const float e = __expf(2.f * u); return 0.5f * x * (1.f + (1.f - 2.f / (e + 1.f))); }
__device__ __forceinline__ void ph_cmp_fin_simple(const Params& p, LAS float* tl, int id, int n, const float* LHall, const float* PEVall) {
    LAS float* hid = tl + 4096;
    const int which = id / (16 * 255), rem = id % (16 * 255), bg = rem / 255, c = rem % 255;
    const float* w2 = p.in[which ? I_WV2 : I_WK2];
    const float* LH = LHall + ((size_t)which * 4096 + bg * 256) * 256;
    float pev = 0.f;
#pragma unroll 8
    for (int q = 0; q < 64; ++q) pev += PEVall[(size_t)(which * 64 + q) * 128 + n];
    const float a = LH[(size_t)c * 256 + n] + LH[(size_t)(c + 1) * 256 + 128 + n] + pev;
    hid[n] = gelu_tanh(a);
    __syncthreads();
    float o = 0.f;
    for (int m = 0; m < 128; ++m) o += hid[m] * w2[m * 128 + n];
    if (which == 0) ((bf16*)(p.ws + WS_KCMP))[((size_t)bg * 256 + c) * 128 + n] = (bf16)f2bf(o);
    else ((bf16*)(p.ws + WS_VCMPT))[((size_t)bg * 128 + n) * 256 + c] = (bf16)f2bf(o);
}

namespace nsa {
constexpr int KB0 = 0, KB1 = 16384, VB0 = 32768, VB1 = 49152, LUT = 65536;
constexpr int QST = LUT + 4096, IMP = QST + 65536, SELM = IMP + 16384, LDS_END = SELM + 512;
constexpr float LOG2E = 1.4426950408889634f;
typedef float f4 __attribute__((ext_vector_type(4)));

typedef unsigned u2v __attribute__((ext_vector_type(2)));
__device__ __forceinline__ float rmax16(float x) { const unsigned u = __float_as_uint(x); const u2v r = __builtin_amdgcn_permlane16_swap(u, u, false, false); return fmaxf(__uint_as_float(r[0]), __uint_as_float(r[1])); }
__device__ __forceinline__ float rmax32(float x) { const unsigned u = __float_as_uint(x); const u2v r = __builtin_amdgcn_permlane32_swap(u, u, false, false); return fmaxf(__uint_as_float(r[0]), __uint_as_float(r[1])); }
__device__ __forceinline__ float radd16(float x) { const unsigned u = __float_as_uint(x); const u2v r = __builtin_amdgcn_permlane16_swap(u, u, false, false); return __uint_as_float(r[0]) + __uint_as_float(r[1]); }
__device__ __forceinline__ float radd32(float x) { const unsigned u = __float_as_uint(x); const u2v r = __builtin_amdgcn_permlane32_swap(u, u, false, false); return __uint_as_float(r[0]) + __uint_as_float(r[1]); }
__device__ __forceinline__ float raddq(float x) { x += __int_as_float(__builtin_amdgcn_update_dpp(0, __float_as_int(x), 0xB1, 0xF, 0xF, true)); x += __int_as_float(__builtin_amdgcn_update_dpp(0, __float_as_int(x), 0x4E, 0xF, 0xF, true)); return x; }
struct Ctx {
    LAS unsigned char* lds; int tid, lane, wave, c, gq, r;
    int s0, cur;
    const LAS unsigned char* qst;
    int pos0;
    const LAS float* lutrow;
    int koff0, voff0;
    unsigned kdo[2], vdoc[2], vdos[2];
};
__device__ __forceinline__ void dma_k(const Ctx& C, const bf16* kt, LAS unsigned char* kb) {
#pragma unroll
    for (int i = 0; i < 2; ++i) __builtin_amdgcn_global_load_lds((const unsigned*)((const char*)kt + C.kdo[i]), (LAS unsigned*)(kb + (2 * C.wave + i) * 1024), 16, 0, 0); }
__device__ __forceinline__ void dma_v(const Ctx& C, const bf16* vt, const unsigned (&vdo)[2], LAS unsigned char* vb) {
#pragma unroll
    for (int i = 0; i < 2; ++i) __builtin_amdgcn_global_load_lds((const unsigned*)((const char*)vt + vdo[i]), (LAS unsigned*)(vb + (2 * C.wave + i) * 1024), 16, 0, 0); }

__device__ __forceinline__ void compute_st(const Ctx& C, const LAS unsigned char* kb, f4 (&s)[2][4]) {
#pragma unroll
    for (int ks = 0; ks < 4; ++ks) { const bf16x8 q0 = *(const LAS bf16x8*)(C.qst + ks * 1024), q1 = *(const LAS bf16x8*)(C.qst + (4 + ks) * 1024);
#pragma unroll
        for (int kt = 0; kt < 4; ++kt) { const bf16x8 a = *(const LAS bf16x8*)(kb + kt * 4096 + (C.koff0 ^ (ks * 64)));
            s[0][kt] = __builtin_amdgcn_mfma_f32_16x16x32_bf16(a, q0, ks == 0 ? (f4){0.f, 0.f, 0.f, 0.f} : s[0][kt], 0, 0, 0);
            s[1][kt] = __builtin_amdgcn_mfma_f32_16x16x32_bf16(a, q1, ks == 0 ? (f4){0.f, 0.f, 0.f, 0.f} : s[1][kt], 0, 0, 0); }
        asm volatile("" ::: "memory"); }
}
__device__ __forceinline__ void compute_pv(const Ctx& C, const LAS unsigned char* vb, const f4 (&p)[2][4], f4 (&o)[2][8]) {
#pragma unroll
    for (int i = 0; i < 2; ++i) { bf16x8 pb[2];
#pragma unroll
        for (int qt = 0; qt < 2; ++qt) { v4u w; w.x = pg8::cvt_pk_bf16(p[qt][2 * i][0], p[qt][2 * i][1]); w.y = pg8::cvt_pk_bf16(p[qt][2 * i][2], p[qt][2 * i][3]);
            w.z = pg8::cvt_pk_bf16(p[qt][2 * i + 1][0], p[qt][2 * i + 1][1]); w.w = pg8::cvt_pk_bf16(p[qt][2 * i + 1][2], p[qt][2 * i + 1][3]); pb[qt] = __builtin_bit_cast(bf16x8, w); }
#pragma unroll
        for (int dt = 0; dt < 8; ++dt) { const v2u lo = *(const LAS v2u*)(vb + dt * 2048 + (C.voff0 ^ (i * 64))), hi = *(const LAS v2u*)(vb + dt * 2048 + (C.voff0 ^ (i * 64 + 32))); const bf16x8 a = __builtin_bit_cast(bf16x8, (v4u){lo.x, lo.y, hi.x, hi.y});
#pragma unroll
            for (int qt = 0; qt < 2; ++qt) o[qt][dt] = __builtin_amdgcn_mfma_f32_16x16x32_bf16(a, pb[qt], o[qt][dt], 0, 0, 0);
            if (dt & 1) asm volatile("" ::: "memory"); } }
}
enum { M_CMP = 0, M_SEL = 1, M_WIN = 2 };
template <int MODE, bool FAR = false>
__device__ __forceinline__ void mask_bias(const Ctx& C, f4 (&s)[2][4], int kb, int n, const LAS unsigned* selw) {
    const float NEG = -__builtin_inff();
#pragma unroll
    for (int qt = 0; qt < 2; ++qt) {
        bool tokok = true;
        if (MODE == M_SEL) tokok = ((selw[(4 * qt + (C.c >> 2)) * 2 + (n >> 5)] >> (n & 31)) & 1u) != 0u;
        if (FAR) { const float be = tokok ? C.lutrow[127] : NEG;
#pragma unroll
            for (int kt = 0; kt < 4; ++kt)
#pragma unroll
                for (int rg = 0; rg < 4; ++rg) s[qt][kt][rg] = __builtin_fmaf(s[qt][kt][rg], LOG2E, be);
            continue; }
        const int dbase = (MODE == M_CMP) ? (C.pos0 + 4 * qt - 31 - 16 * (kb + 4 * C.gq)) : (C.pos0 + 4 * qt - (kb + 4 * C.gq));
#pragma unroll
        for (int kt = 0; kt < 4; ++kt) {
#pragma unroll
            for (int rg = 0; rg < 4; ++rg) { const int d = (MODE == M_CMP) ? dbase - 16 * (16 * kt + rg) : dbase - (16 * kt + rg);
                int di = d < 0 ? 0 : d; di = di > 127 ? 127 : di; const float bias = C.lutrow[di];
                bool ok = tokok && d >= 0; if (MODE == M_WIN) ok = ok && d < 512;
                s[qt][kt][rg] = ok ? __builtin_fmaf(s[qt][kt][rg], LOG2E, bias) : NEG; }
            asm volatile("" ::: "memory"); }
    }
}
__device__ __forceinline__ void softmax_step(f4 (&s)[2][4], float (&m)[2], float (&l)[2], f4 (&o)[2][8], bool rescale_o) {
#pragma unroll
    for (int qt = 0; qt < 2; ++qt) { float mx = s[qt][0][0];
#pragma unroll
        for (int kt = 0; kt < 4; ++kt)
#pragma unroll
            for (int rg = 0; rg < 4; ++rg) mx = fmaxf(mx, s[qt][kt][rg]);
        mx = rmax32(rmax16(mx));
        const float mn = fmaxf(m[qt], mx), alpha = __builtin_amdgcn_exp2f(m[qt] - mn); m[qt] = mn; float ps = 0.f;
#pragma unroll
        for (int kt = 0; kt < 4; ++kt)
#pragma unroll
            for (int rg = 0; rg < 4; ++rg) { const float e = __builtin_amdgcn_exp2f(s[qt][kt][rg] - mn); s[qt][kt][rg] = e; ps += e; }
        l[qt] = l[qt] * alpha + ps;
        if (rescale_o && __any(alpha != 1.f)) {
#pragma unroll
            for (int dt = 0; dt < 8; ++dt) o[qt][dt] = o[qt][dt] * alpha; }
    }
}
template <int MODE>
__device__ __forceinline__ void softmax_far(const Ctx& C, f4 (&s)[2][4], int n, const LAS unsigned* selw, float (&m)[2], float (&l)[2], f4 (&o)[2][8]) {
    const float b31 = C.lutrow[127];
#pragma unroll
    for (int qt = 0; qt < 2; ++qt) {
        float be = b31;
        if (MODE == M_SEL) { const bool tokok = ((selw[(4 * qt + (C.c >> 2)) * 2 + (n >> 5)] >> (n & 31)) & 1u) != 0u; be = tokok ? b31 : -__builtin_inff(); }
        float mx = fmaxf(fmaxf(s[qt][0][0], s[qt][0][1]), fmaxf(s[qt][0][2], s[qt][0][3]));
#pragma unroll
        for (int kt = 1; kt < 4; ++kt) mx = fmaxf(mx, fmaxf(fmaxf(s[qt][kt][0], s[qt][kt][1]), fmaxf(s[qt][kt][2], s[qt][kt][3])));
        mx = rmax32(rmax16(mx));
        const float mt = __builtin_fmaf(mx, LOG2E, be), mn = fmaxf(m[qt], mt), alpha = __builtin_amdgcn_exp2f(m[qt] - mn), c0 = be - mn; m[qt] = mn; float ps = 0.f;
#pragma unroll
        for (int kt = 0; kt < 4; ++kt)
#pragma unroll
            for (int rg = 0; rg < 4; ++rg) { const float e = __builtin_amdgcn_exp2f(__builtin_fmaf(s[qt][kt][rg], LOG2E, c0)); s[qt][kt][rg] = e; ps += e; }
        l[qt] = l[qt] * alpha + ps;
        if (__any(alpha != 1.f)) {
#pragma unroll
            for (int dt = 0; dt < 8; ++dt) o[qt][dt] = o[qt][dt] * alpha; }
    }
}
}

__device__ __forceinline__ void ph_nsa(const Params& p, LAS unsigned char* lds, int idx0, int idxstride, int tid_in, int wave) {
    using namespace nsa;
    int tid = tid_in; asm volatile("" : "+v"(tid));
    const int lane = tid & 63;
    Ctx C; C.lds = lds; C.tid = tid; C.lane = lane; C.wave = wave; C.c = lane & 15; C.gq = lane >> 4; C.r = lane & 3;
    C.koff0 = C.c * 256 + ((C.gq ^ C.c) * 16);
#pragma unroll
    for (int i = 0; i < 2; ++i) { const int piece = 2 * wave + i;
        { const int row = piece * 4 + (lane >> 4), chunk = (lane & 15) ^ (row & 15); C.kdo[i] = (unsigned)(row * 256 + chunk * 16); }
        { const int row = piece * 8 + (lane >> 3), chunk = (lane & 7) ^ ((row >> 1) & 7); C.vdoc[i] = (unsigned)(row * 256 * 2 + chunk * 16); C.vdos[i] = (unsigned)(row * SEQ * 2 + chunk * 16); } }
    C.voff0 = C.c * 128 + (((C.gq >> 1) ^ ((C.c >> 1) & 7)) * 16) + (C.gq & 1) * 8;
    const bf16* NQ = (const bf16*)(p.ws + WS_NQ); const bf16* SM = (const bf16*)(p.ws + WS_SM); bf16* A2 = (bf16*)(p.ws + WS_A2);
    const float* relb = p.in[I_RELB]; const float* nsag = p.in[I_NSAG];
    LAS float* lut = (LAS float*)(lds + LUT);
    for (int i = tid; i < 8 * 128; i += 512) { const int hh = i >> 7, d = i & 127; lut[i] = relb[(int)kBucket[d] * 8 + hh] * LOG2E; }
    __syncthreads();
    LAS unsigned char* qstw = lds + QST + wave * 8192 + lane * 16; C.qst = qstw;
    LAS float* imp = (LAS float*)(lds + IMP + wave * 2048);
    LAS unsigned long long* selm = (LAS unsigned long long*)(lds + SELM + wave * 64);
#define NSA_SYNC() do { asm volatile("s_waitcnt vmcnt(0)" ::: "memory"); __syncthreads(); } while (0)
    for (int idx = idx0; idx < 512; idx += idxstride) {
        const int rnd = idx >> 8, kq = idx & 255, b = kq & 7, tq = rnd == 0 ? 63 - (kq >> 3) : (kq >> 3);
        C.s0 = tq * 64; C.cur = tq;
        const int tokl0 = 8 * wave + (C.c >> 2);
        C.pos0 = C.s0 + tokl0;
        float ssq[2] = {0.f, 0.f};
        for (int g = 0; g < 2; ++g) {
            const int bg = b * 2 + g, h = g * 4 + C.r;
            C.lutrow = lut + h * 128;
            const bf16* KCMP = (const bf16*)(p.ws + WS_KCMP) + (size_t)bg * 256 * 128; const bf16* VCMPT = (const bf16*)(p.ws + WS_VCMPT) + (size_t)bg * 128 * 256;
#pragma unroll
            for (int qt = 0; qt < 2; ++qt) { const unsigned qo = (unsigned)(((b * SEQ + (C.pos0 + 4 * qt)) * 1024 + h * 128 + 8 * C.gq) * 2);
#pragma unroll
                for (int ks = 0; ks < 4; ++ks) *(LAS bf16x8*)(qstw + (qt * 4 + ks) * 1024) = *(const bf16x8*)((const char*)NQ + qo + ks * 64); }
#pragma unroll
            for (int i = 0; i < 2; ++i) *(LAS f32x4*)((LAS unsigned char*)imp + lane * 16 + i * 1024) = (f32x4){0.f, 0.f, 0.f, 0.f};
#define NSA_OROW(qt) ((char*)A2 + (unsigned)(((b * SEQ + C.pos0 + 4 * (qt)) * DM + 1024 + h * 128 + 4 * C.gq) * 2))
            const int cmaxb = C.s0 + 63 - 31; const int nct = cmaxb >= 0 ? ((cmaxb >> 4) >> 6) + 1 : 0;
            float m[2] = {-1e30f, -1e30f}, l[2] = {0.f, 0.f};
            f4 o[2][8];
            if (nct > 0) {
                dma_k(C, KCMP, lds + KB0); NSA_SYNC();
                for (int ct = 0; ct < nct; ++ct) { const int buf = ct & 1;
                    if (ct + 1 < nct) dma_k(C, KCMP + (ct + 1) * 64 * 128, lds + (buf ? KB0 : KB1));
                    f4 s[2][4]; compute_st(C, lds + (buf ? KB1 : KB0), s); mask_bias<M_CMP>(C, s, 64 * ct, 0, (const LAS unsigned*)selm); softmax_step(s, m, l, o, false);
                    NSA_SYNC(); }
            }
            float inv[2];
#pragma unroll
            for (int qt = 0; qt < 2; ++qt) { const float lt = radd32(radd16(l[qt])); inv[qt] = lt > 0.f ? 1.f / lt : 0.f; }
#pragma unroll
            for (int qt = 0; qt < 2; ++qt)
#pragma unroll
                for (int dt = 0; dt < 8; ++dt) o[qt][dt] = (f4){0.f, 0.f, 0.f, 0.f};
            if (nct > 0) {
                dma_k(C, KCMP, lds + KB0); dma_v(C, VCMPT, C.vdoc, lds + VB0); NSA_SYNC();
                for (int ct = 0; ct < nct; ++ct) { const int buf = ct & 1;
                    if (ct + 1 < nct) { dma_k(C, KCMP + (ct + 1) * 64 * 128, lds + (buf ? KB0 : KB1)); dma_v(C, VCMPT + 64 * (ct + 1), C.vdoc, lds + (buf ? VB0 : VB1)); }
                    f4 s[2][4]; compute_st(C, lds + (buf ? KB1 : KB0), s); mask_bias<M_CMP>(C, s, 64 * ct, 0, (const LAS unsigned*)selm);
#pragma unroll
                    for (int qt = 0; qt < 2; ++qt)
#pragma unroll
                        for (int kt = 0; kt < 4; ++kt) {
#pragma unroll
                            for (int rg = 0; rg < 4; ++rg) s[qt][kt][rg] = __builtin_amdgcn_exp2f(s[qt][kt][rg] - m[qt]) * inv[qt];
                            float po = (s[qt][kt][0] + s[qt][kt][1]) + (s[qt][kt][2] + s[qt][kt][3]), p3 = s[qt][kt][3];
                            po = raddq(po); p3 = raddq(p3);
                            const int nb = 16 * ct + 4 * kt + C.gq, tl = 4 * qt + (C.c >> 2);
                            if (C.r == 0) { __hip_atomic_fetch_add((float*)(imp + tl * 64 + nb), po, __ATOMIC_RELAXED, __HIP_MEMORY_SCOPE_WORKGROUP); if (nb + 1 < 64) __hip_atomic_fetch_add((float*)(imp + tl * 64 + nb + 1), p3, __ATOMIC_RELAXED, __HIP_MEMORY_SCOPE_WORKGROUP); } }
                    compute_pv(C, lds + (buf ? VB1 : VB0), s, o);
                    NSA_SYNC(); }
            }
            LDS_WAIT(); __builtin_amdgcn_wave_barrier();
            for (int tk = 0; tk < 8; ++tk) { const int n = lane; float sc;
                if (n == 0 || n == C.cur || n == C.cur - 1) sc = 1e4f; else if (n <= C.cur) sc = imp[tk * 64 + n]; else sc = -1.f;
                const int key = ((sc < 0.f ? 0 : __float_as_int(sc) + 64) & ~63) | (63 - n);
                int rank = 0;
#pragma unroll
                for (int mm = 0; mm < 64; ++mm) rank += (__builtin_amdgcn_readlane(key, mm) > key) ? 1 : 0;
                const unsigned long long mk = __ballot(rank < 16);
                if (lane == 0) selm[tk] = mk; }
            LDS_WAIT(); __builtin_amdgcn_wave_barrier();
#pragma unroll
            for (int qt = 0; qt < 2; ++qt) { const float gt = 1.f / (1.f + __expf(-bf2f(*(const bf16*)((const char*)SM + (unsigned)(((b * SEQ + (C.pos0 + 4 * qt)) * 64 + 16 + h) * 2)))));
#pragma unroll
                for (int dt = 0; dt < 8; ++dt) { const f4 v = o[qt][dt] * gt; *(v2u*)(NSA_OROW(qt) + 32 * dt) = (v2u){pg8::cvt_pk_bf16(v[0], v[1]), pg8::cvt_pk_bf16(v[2], v[3])}; } }
#pragma unroll
            for (int br = 1; br <= 2; ++br) {
                const bf16* KX = (const bf16*)(p.ws + (br == 1 ? WS_KS : WS_KW)) + bg * SEQ * 128; const bf16* VX = (const bf16*)(p.ws + (br == 1 ? WS_VST : WS_VWT)) + bg * 128 * SEQ;
                const int n0 = br == 1 ? 0 : (C.cur >= 8 ? C.cur - 8 : 0), n1 = C.cur;
                m[0] = m[1] = -1e30f; l[0] = l[1] = 0.f;
#pragma unroll
                for (int qt = 0; qt < 2; ++qt)
#pragma unroll
                    for (int dt = 0; dt < 8; ++dt) o[qt][dt] = (f4){0.f, 0.f, 0.f, 0.f};
                int f0 = n1 + 1, f1 = n0 - 1;
                for (int n = n0; n <= n1; ++n) { const bool fa = (C.s0 - (64 * n + 63) >= 113) && (br == 1 || (C.s0 + 63 - 64 * n) < 512); if (fa) { f0 = n < f0 ? n : f0; f1 = n; } }
                const int cntf = f1 >= f0 ? f1 - f0 + 1 : 0, cnt = n1 - n0 + 1, nlo = cntf ? f0 - n0 : cnt;
#define NSA_TILE(i) ((i) < cntf ? f0 + (i) : (((i) - cntf) < nlo ? n0 + ((i) - cntf) : f1 + 1 + ((i) - cntf - nlo)))
#define NSA_BODY(FARF) { const int n = NSA_TILE(i); const int buf = i & 1; \
                    if (i + 1 < cnt) { const int nn = NSA_TILE(i + 1); dma_k(C, KX + nn * 64 * 128, lds + (buf ? KB0 : KB1)); dma_v(C, VX + 64 * nn, C.vdos, lds + (buf ? VB0 : VB1)); } \
                    bool need = true; \
                    if (br == 1) { const unsigned any = ((const LAS unsigned*)selm)[(lane & 7) * 2 + (n >> 5)] >> (n & 31); need = __any((int)(any & 1u)); } \
                    if (need) { f4 s[2][4]; compute_st(C, lds + (buf ? KB1 : KB0), s); \
                        if (FARF) { if (br == 1) softmax_far<M_SEL>(C, s, n, (const LAS unsigned*)selm, m, l, o); else softmax_far<M_WIN>(C, s, n, (const LAS unsigned*)selm, m, l, o); } \
                        else { if (br == 1) mask_bias<M_SEL, false>(C, s, 64 * n, n, (const LAS unsigned*)selm); else mask_bias<M_WIN, false>(C, s, 64 * n, n, (const LAS unsigned*)selm); \
                            softmax_step(s, m, l, o, true); } \
                        compute_pv(C, lds + (buf ? VB1 : VB0), s, o); } \
                    NSA_SYNC(); }
                { const int nf = NSA_TILE(0); dma_k(C, KX + nf * 64 * 128, lds + KB0); dma_v(C, VX + 64 * nf, C.vdos, lds + VB0); NSA_SYNC(); }
                int i = 0;
                for (; i < cntf; ++i) NSA_BODY(true)
                for (; i < cnt; ++i) NSA_BODY(false)
#undef NSA_BODY
#undef NSA_TILE
                asm volatile("s_waitcnt vmcnt(0)" ::: "memory");
#pragma unroll
                for (int qt = 0; qt < 2; ++qt) { const float lt = radd32(radd16(l[qt]));
                    const int row = b * SEQ + (C.pos0 + 4 * qt);
                    const float sc = (1.f / (1.f + __expf(-bf2f(*(const bf16*)((const char*)SM + (unsigned)((row * 64 + 16 + 8 * br + h) * 2)))))) / lt;
#pragma unroll
                    for (int dt = 0; dt < 8; ++dt) { const f4 v = o[qt][dt] * sc; v2u* sp = (v2u*)(NSA_OROW(qt) + 32 * dt); const v2u pv = *sp;
                        const float a0 = bflo(pv.x) + v[0], a1 = bfhi(pv.x) + v[1], a2 = bflo(pv.y) + v[2], a3 = bfhi(pv.y) + v[3];
                        if (br == 2) ssq[qt] += (a0 * a0 + a1 * a1) + (a2 * a2 + a3 * a3);
                        *sp = (v2u){pg8::cvt_pk_bf16(a0, a1), pg8::cvt_pk_bf16(a2, a3)}; } }
            }
        }
        float rstd[2];
#pragma unroll
        for (int qt = 0; qt < 2; ++qt) { const float t = radd32(radd16(raddq(ssq[qt]))); rstd[qt] = 1.f / sqrtf(t * (1.f / 1024.f) + RMS_EPS); }
        asm volatile("s_waitcnt vmcnt(0)" ::: "memory");
#pragma unroll
        for (int qt = 0; qt < 2; ++qt) { const int sub = C.r * 4 + C.gq; bf16* orow = (bf16*)((char*)A2 + (unsigned)(((b * SEQ + (C.pos0 + 4 * qt)) * DM + 1024) * 2 + sub * 16)); const int subz = 0;
#pragma unroll
            for (int j = 0; j < 8; ++j) { const int col = (j * 16 + subz) * 8; v4u w = *(const v4u*)((const char*)orow + (unsigned)(col * 2)); const f32x4 g0 = *(const f32x4*)((const char*)nsag + (unsigned)(col * 4 + sub * 32)), g1 = *(const f32x4*)((const char*)nsag + (unsigned)(col * 4 + sub * 32 + 16)); const float rs = rstd[qt];
                w.x = pk2(bflo(w.x) * rs * g0.x, bfhi(w.x) * rs * g0.y); w.y = pk2(bflo(w.y) * rs * g0.z, bfhi(w.y) * rs * g0.w); w.z = pk2(bflo(w.z) * rs * g1.x, bfhi(w.z) * rs * g1.y); w.w = pk2(bflo(w.w) * rs * g1.z, bfhi(w.w) * rs * g1.w);
                *(v4u*)((char*)orow + (unsigned)(col * 2)) = w; } }
        NSA_SYNC();
    }
#undef NSA_SYNC
#undef NSA_OROW
}

constexpr size_t WS_ST = WS_LA;
constexpr size_t WS_DEC = WS_ST + (size_t)2048 * 256 * 128 * 2;
static_assert(WS_DEC + (size_t)2048 * 128 * 4 <= WS_KCMP, "gla scratch overlay");
namespace gla {
typedef float f4 __attribute__((ext_vector_type(4)));
constexpr int L_ST = 0, L_KT = 65536, L_QT = 81920, L_VT = 98304, L_GA = 131072, L_GT = L_GA + 4096, L_RED = L_GT + 2048, L_END = L_RED + 512;
__device__ __forceinline__ void chunk_cumsum(const Params& p, LAS unsigned char* lds, int tid, int t0, int h, float (&P)[16], float& blast) {
    const bf16* SM = (const bf16*)(p.ws + WS_SM); const float* wa2 = p.in[I_WA2]; const float* ba = p.in[I_BA];
    LAS float* ga = (LAS float*)(lds + L_GA); LAS float* gt = (LAS float*)(lds + L_GT);
    if (tid < 128) { const int j = tid >> 1, hf = tid & 1; const v4u w = *(const v4u*)((const char*)SM + (unsigned)(((t0 + j) * 64 + hf * 8) * 2));
        LAS float* d = ga + j * 16 + hf * 8; d[0] = bflo(w.x); d[1] = bfhi(w.x); d[2] = bflo(w.y); d[3] = bfhi(w.y); d[4] = bflo(w.z); d[5] = bfhi(w.z); d[6] = bflo(w.w); d[7] = bfhi(w.w); }
    const int dk = tid & 127, jq = tid >> 7;
    float w[16];
#pragma unroll
    for (int r = 0; r < 16; ++r) w[r] = wa2[r * 512 + h * 128 + dk];
    const float bb = ba[h * 128 + dk];
    __syncthreads();
    float run = 0.f;
#pragma unroll
    for (int jj = 0; jj < 16; ++jj) { const LAS f32x4* gr = (const LAS f32x4*)(ga + (16 * jq + jj) * 16); float z = bb;
#pragma unroll
        for (int r4 = 0; r4 < 4; ++r4) { const f32x4 g4 = gr[r4]; z += g4.x * w[4 * r4] + g4.y * w[4 * r4 + 1] + g4.z * w[4 * r4 + 2] + g4.w * w[4 * r4 + 3]; }
        run += (fminf(z, 0.f) - log1pf(__expf(-fabsf(z)))) * (1.f / 16.f); P[jj] = run; }
    gt[jq * 128 + dk] = run;
    __syncthreads();
    float off = 0.f, tot = 0.f;
#pragma unroll
    for (int q = 0; q < 4; ++q) { const float t = gt[q * 128 + dk]; tot += t; if (q < jq) off += t; }
#pragma unroll
    for (int jj = 0; jj < 16; ++jj) P[jj] += off;
    blast = tot;
}
__device__ __forceinline__ void stage_raw_k(const bf16* src  , LAS unsigned char* dst, int tid, int t0, int h) {
#pragma unroll
    for (int q = 0; q < 2; ++q) { const int id = tid + 512 * q, j = id >> 4, c16 = id & 15; *(LAS v4u*)(dst + j * 256 + c16 * 16) = *(const v4u*)((const char*)src + (unsigned)(((t0 + j) * 512 + h * 128 + c16 * 8) * 2)); }
}
__device__ __forceinline__ void stage_raw_v(const Params& p, LAS unsigned char* dst, int tid, int t0, int h) {
    const bf16* GV = (const bf16*)(p.ws + WS_GV);
#pragma unroll
    for (int q = 0; q < 4; ++q) { const int id = tid + 512 * q, j = id >> 5, c = id & 31; *(LAS v4u*)(dst + j * 512 + c * 16) = *(const v4u*)((const char*)GV + (unsigned)(((t0 + j) * 1024 + h * 256 + c * 8) * 2)); }
}
__device__ __forceinline__ void fill_vt(LAS unsigned char* lds, const LAS unsigned char* rv, int tid) {
    const int dv = tid & 255, jh = tid >> 8;
    unsigned short v[32];
#pragma unroll
    for (int jj = 0; jj < 32; ++jj) v[jj] = *(const LAS bf16*)(rv + (32 * jh + jj) * 512 + dv * 2);
    LAS unsigned char* row = lds + L_VT + dv * 128; const int f = (dv >> 1) & 7;
#pragma unroll
    for (int q = 0; q < 4; ++q) { v4u w; w.x = v[8 * q] | ((unsigned)v[8 * q + 1] << 16); w.y = v[8 * q + 2] | ((unsigned)v[8 * q + 3] << 16); w.z = v[8 * q + 4] | ((unsigned)v[8 * q + 5] << 16); w.w = v[8 * q + 6] | ((unsigned)v[8 * q + 7] << 16);
        *(LAS v4u*)(row + (((4 * jh + q) ^ f) * 16)) = w; }
}
}

__device__ __forceinline__ void ph_gla_a(const Params& p, LAS unsigned char* lds, int u0, int ustride, int tid_in, int wave) {
    using namespace gla;
    int tid = tid_in; asm volatile("" : "+v"(tid));
    const int lane = tid & 63, c = lane & 15, gq = lane >> 4;
    const bf16* GK = (const bf16*)(p.ws + WS_GK); bf16* ST = (bf16*)(p.ws + WS_ST); float* DEC = (float*)(p.ws + WS_DEC);
    for (int unit = u0; unit < 2048; unit += ustride) {
        const int bh = unit >> 6, ch = unit & 63, b = bh >> 2, h = bh & 3, t0 = b * SEQ + ch * 64;
        stage_raw_k(GK, lds + 0, tid, t0, h); stage_raw_v(p, lds + 16384, tid, t0, h);
        float P[16], blast; chunk_cumsum(p, lds, tid, t0, h, P, blast);
        { const int dk = tid & 127, jq = tid >> 7;
          unsigned short kv[16];
#pragma unroll
          for (int jj = 0; jj < 16; ++jj) kv[jj] = *(const LAS bf16*)(lds + (16 * jq + jj) * 256 + dk * 2);
          unsigned pk[8];
#pragma unroll
          for (int q = 0; q < 8; ++q) pk[q] = pk2(bf2f(kv[2 * q]) * __expf(blast - P[2 * q]), bf2f(kv[2 * q + 1]) * __expf(blast - P[2 * q + 1]));
          LAS unsigned char* row = lds + L_KT + dk * 128; const int f = (dk >> 1) & 7;
          *(LAS v4u*)(row + (((2 * jq) ^ f) * 16)) = (v4u){pk[0], pk[1], pk[2], pk[3]}; *(LAS v4u*)(row + (((2 * jq + 1) ^ f) * 16)) = (v4u){pk[4], pk[5], pk[6], pk[7]};
          if (jq == 0) DEC[unit * 128 + dk] = __expf(blast); }
        fill_vt(lds, lds + 16384, tid);
        __syncthreads();
        f4 acc[16];
        const int f = (c >> 1) & 7;
        bf16x8 aF[2];
#pragma unroll
        for (int ks = 0; ks < 2; ++ks) aF[ks] = *(const LAS bf16x8*)(lds + L_KT + (16 * wave + c) * 128 + (((4 * ks + gq) ^ f) * 16));
#pragma unroll
        for (int nt = 0; nt < 16; ++nt) { acc[nt] = (f4){0.f, 0.f, 0.f, 0.f};
#pragma unroll
            for (int ks = 0; ks < 2; ++ks) { const bf16x8 bF = *(const LAS bf16x8*)(lds + L_VT + (16 * nt + c) * 128 + (((4 * ks + gq) ^ f) * 16)); acc[nt] = __builtin_amdgcn_mfma_f32_16x16x32_bf16(aF[ks], bF, acc[nt], 0, 0, 0); } }
        char* dst = (char*)ST + (size_t)unit * (256 * 128 * 2) + (unsigned)((c * 128 + 16 * wave + 4 * gq) * 2);
#pragma unroll
        for (int nt = 0; nt < 16; ++nt) *(v2u*)(dst + nt * 16 * 256) = (v2u){pg8::cvt_pk_bf16(acc[nt][0], acc[nt][1]), pg8::cvt_pk_bf16(acc[nt][2], acc[nt][3])};
        __syncthreads();
    }
}
__device__ __forceinline__ void ph_gla_b(const Params& p, int gid, int gstride) {
    bf16* ST = (bf16*)(p.ws + WS_ST); const float* DEC = (const float*)(p.ws + WS_DEC);
    for (int e = gid; e < 32 * 4096; e += gstride) { const int bh = e >> 12, dv = (e >> 4) & 255, d8 = e & 15;
        float st[8];
#pragma unroll
        for (int i = 0; i < 8; ++i) st[i] = 0.f;
        char* base = (char*)ST + (size_t)bh * 64 * (256 * 128 * 2) + (unsigned)((dv * 128 + d8 * 8) * 2); const float* dbase = DEC + (size_t)bh * 64 * 128 + d8 * 8;
#pragma unroll 4
        for (int ch = 0; ch < 64; ++ch) { v4u* ptr = (v4u*)(base + (size_t)ch * (256 * 128 * 2)); const v4u w = *ptr; const f32x4 d0 = *(const f32x4*)(dbase + ch * 128), d1 = *(const f32x4*)(dbase + ch * 128 + 4);
            v4u o; o.x = pk2(st[0], st[1]); o.y = pk2(st[2], st[3]); o.z = pk2(st[4], st[5]); o.w = pk2(st[6], st[7]); *ptr = o;
            st[0] = st[0] * d0.x + bflo(w.x); st[1] = st[1] * d0.y + bfhi(w.x); st[2] = st[2] * d0.z + bflo(w.y); st[3] = st[3] * d0.w + bfhi(w.y);
            st[4] = st[4] * d1.x + bflo(w.z); st[5] = st[5] * d1.y + bfhi(w.z); st[6] = st[6] * d1.z + bflo(w.w); st[7] = st[7] * d1.w + bfhi(w.w); }
    }
}
__device__ __forceinline__ void ph_gla_c(const Params& p, LAS unsigned char* lds, int u0, int ustride, int tid_in, int wave) {
    using namespace gla;
    int tid = tid_in; asm volatile("" : "+v"(tid));
    const int lane = tid & 63, c = lane & 15, gq = lane >> 4, nt = wave & 3, half = wave >> 2;
    const bf16* GQ = (const bf16*)(p.ws + WS_GQ); const bf16* GK = (const bf16*)(p.ws + WS_GK); const bf16* GG = (const bf16*)(p.ws + WS_GG); const bf16* ST = (const bf16*)(p.ws + WS_ST);
    bf16* A2 = (bf16*)(p.ws + WS_A2); const float* gn = p.in[I_GLAG];
    const int koff0 = c * 256 + ((gq ^ c) * 16), voff0 = c * 128 + (((gq >> 1) ^ ((c >> 1) & 7)) * 16) + (gq & 1) * 8;
    for (int unit = u0; unit < 2048; unit += ustride) {
        const int bh = unit >> 6, ch = unit & 63, b = bh >> 2, h = bh & 3, t0 = b * SEQ + ch * 64;
        stage_raw_k(GQ, lds + 0, tid, t0, h); stage_raw_k(GK, lds + 16384, tid, t0, h); stage_raw_v(p, lds + 32768, tid, t0, h);
        float P[16], blast; chunk_cumsum(p, lds, tid, t0, h, P, blast);
        { const int dk = tid & 127, jq = tid >> 7;
#pragma unroll
          for (int jj = 0; jj < 16; ++jj) { const int j = 16 * jq + jj; const float qv = bf2f(*(const LAS bf16*)(lds + j * 256 + dk * 2)), kv = bf2f(*(const LAS bf16*)(lds + 16384 + j * 256 + dk * 2));
              const int off = j * 256 + (((dk >> 3) ^ (j & 15)) * 16) + (dk & 7) * 2;
              *(LAS bf16*)(lds + L_QT + off) = (bf16)f2bf(qv * __expf(P[jj])); *(LAS bf16*)(lds + L_KT + off) = (bf16)f2bf(kv * __expf(-P[jj])); } }
        fill_vt(lds, lds + 32768, tid);
        __syncthreads();
        { const char* src = (const char*)ST + (size_t)unit * (256 * 128 * 2);
#pragma unroll
          for (int i = 0; i < 8; ++i) { const int piece = 8 * wave + i, row = piece * 4 + (lane >> 4), chunk = (lane & 15) ^ (row & 15);
              __builtin_amdgcn_global_load_lds((const unsigned*)(src + (unsigned)(row * 256 + chunk * 16)), (LAS unsigned*)(lds + L_ST + piece * 1024), 16, 0, 0); } }
        asm volatile("s_waitcnt vmcnt(0)" ::: "memory"); __syncthreads();
        bf16x8 qF[4];
#pragma unroll
        for (int ks = 0; ks < 4; ++ks) qF[ks] = *(const LAS bf16x8*)(lds + L_QT + nt * 4096 + (koff0 ^ (ks * 64)));
        f4 sT[4];
#pragma unroll
        for (int jt = 0; jt < 4; ++jt) { sT[jt] = (f4){0.f, 0.f, 0.f, 0.f};
            if (jt <= nt) {
#pragma unroll
                for (int ks = 0; ks < 4; ++ks) { const bf16x8 a = *(const LAS bf16x8*)(lds + L_KT + jt * 4096 + (koff0 ^ (ks * 64))); sT[jt] = __builtin_amdgcn_mfma_f32_16x16x32_bf16(a, qF[ks], sT[jt], 0, 0, 0); }
                if (jt == nt) {
#pragma unroll
                    for (int rg = 0; rg < 4; ++rg) if (4 * gq + rg > c) sT[jt][rg] = 0.f; } } }
        bf16x8 pb[2];
#pragma unroll
        for (int s = 0; s < 2; ++s) { v4u w; w.x = pg8::cvt_pk_bf16(sT[2 * s][0], sT[2 * s][1]); w.y = pg8::cvt_pk_bf16(sT[2 * s][2], sT[2 * s][3]); w.z = pg8::cvt_pk_bf16(sT[2 * s + 1][0], sT[2 * s + 1][1]); w.w = pg8::cvt_pk_bf16(sT[2 * s + 1][2], sT[2 * s + 1][3]); pb[s] = __builtin_bit_cast(bf16x8, w); }
        f4 o[8]; float ss = 0.f;
#pragma unroll
        for (int mt = 0; mt < 8; ++mt) { o[mt] = (f4){0.f, 0.f, 0.f, 0.f}; const int rb = 128 * half + 16 * mt;
#pragma unroll
            for (int ks = 0; ks < 4; ++ks) { const bf16x8 a = *(const LAS bf16x8*)(lds + L_ST + rb * 256 + (koff0 ^ (ks * 64))); o[mt] = __builtin_amdgcn_mfma_f32_16x16x32_bf16(a, qF[ks], o[mt], 0, 0, 0); }
#pragma unroll
            for (int s = 0; s < 2; ++s) if (2 * s <= nt) { const v2u lo = *(const LAS v2u*)(lds + L_VT + rb * 128 + (voff0 ^ (s * 64))), hi = *(const LAS v2u*)(lds + L_VT + rb * 128 + (voff0 ^ (s * 64 + 32)));
                o[mt] = __builtin_amdgcn_mfma_f32_16x16x32_bf16(__builtin_bit_cast(bf16x8, (v4u){lo.x, lo.y, hi.x, hi.y}), pb[s], o[mt], 0, 0, 0); }
            ss += (o[mt][0] * o[mt][0] + o[mt][1] * o[mt][1]) + (o[mt][2] * o[mt][2] + o[mt][3] * o[mt][3]); }
        ss = nsa::radd32(nsa::radd16(ss));
        LAS float* red = (LAS float*)(lds + L_RED);
        if (gq == 0) red[half * 64 + 16 * nt + c] = ss;
        __syncthreads();
        const float rstd = 1.f / sqrtf((red[16 * nt + c] + red[64 + 16 * nt + c]) * (1.f / 256.f) + RMS_EPS);
        const int tok = t0 + 16 * nt + c;
#pragma unroll
        for (int mt = 0; mt < 8; ++mt) { const int dv = 128 * half + 16 * mt + 4 * gq; const f32x4 g4 = *(const f32x4*)((const char*)gn + (unsigned)(dv * 4));
            const v2u gg = *(const v2u*)((const char*)GG + (unsigned)((tok * 1024 + h * 256 + dv) * 2));
            const float z0 = bflo(gg.x), z1 = bfhi(gg.x), z2 = bflo(gg.y), z3 = bfhi(gg.y);
            v2u w; w.x = pg8::cvt_pk_bf16(o[mt][0] * rstd * g4.x * (z0 / (1.f + __expf(-z0))), o[mt][1] * rstd * g4.y * (z1 / (1.f + __expf(-z1))));
            w.y = pg8::cvt_pk_bf16(o[mt][2] * rstd * g4.z * (z2 / (1.f + __expf(-z2))), o[mt][3] * rstd * g4.w * (z3 / (1.f + __expf(-z3))));
            *(v2u*)((char*)A2 + (unsigned)((tok * DM + h * 256 + dv) * 2)) = w; }
        __syncthreads();
    }
}

constexpr size_t WS_LH = WS_DEC + (size_t)2048 * 128 * 4;
constexpr size_t WS_PEV = WS_LH + (size_t)2 * 4096 * 256 * 4;
static_assert(WS_PEV + 1024 <= WS_KCMP, "cmp scratch overlay");
struct CmpOrder {
    int c; const bf16 *kc, *vc, *wk, *wv;
    __device__ __forceinline__ bool next(int i, pg8::Unit& u) const { if (i > 0 || c >= 32) return false; u.pm = c & 15; u.pn = 0; u.kind = c >> 4; return true; }
    __device__ __forceinline__ const char* pa(const pg8::Gemm&, const pg8::Unit& u) const { return (const char*)(u.kind ? vc : kc) + (size_t)u.pm * ((size_t)256 * 2048 * 2); }
    __device__ __forceinline__ const char* pb(const pg8::Gemm&, const pg8::Unit& u) const { return (const char*)(u.kind ? wv : wk); }
    __device__ __forceinline__ void a_ready(const pg8::Unit&) const {}
    __device__ __forceinline__ void done(const pg8::Unit&) const {}
};
struct EpiLH {
    static constexpr bool PERM = false, AFTER_DRAIN = false;
    float* LH;
    __device__ __forceinline__ void operator()(const pg8::f32x4 (&acc)[2][2][4][2], const pg8::Unit& u, int wr, int wc, int fr, int fq) const {
        const int row0 = u.kind * 4096 + u.pm * 256 + wr * 64 + fr, col0 = wc * 32 + 4 * fq;
#pragma unroll
        for (int ai = 0; ai < 2; ++ai)
#pragma unroll
            for (int m = 0; m < 4; ++m) { float* rowp = LH + (size_t)(row0 + ai * 128 + m * 16) * 256 + col0;
#pragma unroll
                for (int bj = 0; bj < 2; ++bj)
#pragma unroll
                    for (int n = 0; n < 2; ++n) *(pg8::f32x4*)(rowp + bj * 128 + n * 16) = acc[ai][bj][m][n]; }
    }
};

constexpr size_t PROWS = (size_t)MAXTILES * 256;
constexpr size_t WS_W1Q = WS_W1T;
constexpr size_t WS_W2Q = WS_W1Q + (size_t)NE * 4096 * DM;
constexpr size_t WS_HN8 = WS_W2Q + (size_t)NE * DM * DFF;
constexpr size_t WS_AMAXP = WS_HN8 + (size_t)T * DM;
constexpr size_t WS_WSC1 = WS_AMAXP + PROWS * 64 * 4;
constexpr size_t WS_WSC2 = WS_WSC1 + (size_t)NE * 4096 * 4;
constexpr size_t WS_HSC = WS_WSC2 + (size_t)NE * 2048 * 4;
constexpr size_t WS_ROWSC = WS_HSC + (size_t)T * 4;
constexpr size_t WS_ASC = WS_ROWSC + PROWS * 4;
static_assert(WS_ASC + PROWS * 4 <= WS_XN, "int8 buffers fit in the retired bf16 expert-weight region");
constexpr size_t WS_ROWTOK = WS_CTL + 512 * 1024;
static_assert(PROWS * 2 <= 512 * 1024 && DM == 2048, "row table fits; gathered rows are 2048 bytes");
constexpr size_t WS_H16 = WS_XG;
static_assert((size_t)T * DM * 2 <= PROWS * DM, "h fits below ACT8");
constexpr size_t WS_XG8 = WS_XG;
constexpr size_t WS_ACT8 = WS_XG + PROWS * DM;
constexpr size_t WS_Y = WS_ACT;
static_assert(WS_ACT8 + PROWS * DM <= WS_ACT, "int8 row buffers fit in the retired gathered-row region");

__device__ __forceinline__ unsigned q8(float v) { int q = (int)rintf(v); q = q > 127 ? 127 : (q < -127 ? -127 : q); return (unsigned)q & 0xffu; }
__device__ __forceinline__ unsigned q8x4(float a, float b, float c, float d) { return q8(a) | (q8(b) << 8) | (q8(c) << 16) | (q8(d) << 24); }

constexpr size_t WS_WINQ = WS_WINT;
constexpr size_t WS_WISC = WS_WINT + (size_t)NPT * 256 * DM;
constexpr size_t WS_XN8 = WS_XN;
constexpr size_t WS_XSC = WS_XN + (size_t)T * DM;
constexpr size_t WS_PMAX = WS_HN;
constexpr size_t WS_PMAXI = WS_PMAX + (size_t)64 * 8 * 4096 * 4;

constexpr int NSLAB_E = NE * 192, NSLAB = NSLAB_E + 178;
struct SlabSrc { const float* W; int N; bool ok; };
__device__ __forceinline__ SlabSrc slab_src(const Params& p, int sl, int r0, int n4) {
    SlabSrc s;
    if (sl < NSLAB_E) { const int e = sl / 192, r = sl % 192; const bool isw2 = r >= 128; const int nb = isw2 ? r - 128 : r; s.N = isw2 ? 2048 : 4096;
        s.W = (isw2 ? p.in[I_W2] + (size_t)e * DFF * DM : p.in[I_W1] + (size_t)e * DM * 4096) + (size_t)r0 * s.N + nb * 32 + 4 * n4; s.ok = true; }
    else { const int nb = sl - NSLAB_E; s.N = 5672; s.ok = nb * 32 + 4 * n4 < 5672; s.W = p.in[I_WIN] + (size_t)r0 * 5672 + (s.ok ? nb * 32 + 4 * n4 : 0); }
    return s;
}
__device__ __forceinline__ void p0_slab_quant(const Params& p, LAS unsigned char* lds, int bid, int G, int tid) {
    constexpr int RS = 4104;
    LAS unsigned char* TT = lds; LAS float* part = (LAS float*)(lds + 32 * RS); LAS float* inv = part + 64 * 32; LAS int* drow = (LAS int*)(inv + 32);
    signed char* W1Q = (signed char*)(p.ws + WS_W1Q); signed char* W2Q = (signed char*)(p.ws + WS_W2Q); signed char* WIQ = (signed char*)(p.ws + WS_WINQ);
    float* WSC1 = (float*)(p.ws + WS_WSC1); float* WSC2 = (float*)(p.ws + WS_WSC2); float* WISC = (float*)(p.ws + WS_WISC);
    const int n4 = tid & 7, r0 = tid >> 3;
    f32x4 va[8], vb[8];
#define SLAB_ISSUE(dst, sl, j) do { if ((sl) < NSLAB) { const SlabSrc ss_ = slab_src(p, (sl), r0, n4); _Pragma("unroll") for (int u = 0; u < 8; ++u) dst[u] = __builtin_nontemporal_load((const f32x4*)(ss_.W + (size_t)(64 * (8 * (j) + u)) * ss_.N)); } } while (0)
#define SLAB_USE(src, j) do { _Pragma("unroll") for (int u = 0; u < 8; ++u) { const f32x4 x = sc_.ok ? src[u] : (f32x4){0.f, 0.f, 0.f, 0.f}; const int k = r0 + 64 * (8 * (j) + u); \
            mx.x = fmaxf(mx.x, fabsf(x.x)); mx.y = fmaxf(mx.y, fabsf(x.y)); mx.z = fmaxf(mx.z, fabsf(x.z)); mx.w = fmaxf(mx.w, fabsf(x.w)); \
            LAS unsigned char* d = TT + (4 * n4) * RS + k * 2; \
            *(LAS bf16*)d = (bf16)f2bf(x.x); *(LAS bf16*)(d + RS) = (bf16)f2bf(x.y); *(LAS bf16*)(d + 2 * RS) = (bf16)f2bf(x.z); *(LAS bf16*)(d + 3 * RS) = (bf16)f2bf(x.w); } } while (0)
    SLAB_ISSUE(va, bid, 0); SLAB_ISSUE(vb, bid, 1);
    for (int slab = bid; slab < NSLAB; slab += G) {
        const SlabSrc sc_ = slab_src(p, slab, r0, n4);
        f32x4 mx = (f32x4){0.f, 0.f, 0.f, 0.f};
        SLAB_USE(va, 0); SLAB_ISSUE(va, slab, 2);
        SLAB_USE(vb, 1); SLAB_ISSUE(vb, slab, 3);
        SLAB_USE(va, 2); SLAB_ISSUE(va, slab + G, 0);
        SLAB_USE(vb, 3); SLAB_ISSUE(vb, slab + G, 1);
        { f32x4 t = mx;
#pragma unroll
          for (int o = 8; o < 64; o <<= 1) { t.x = fmaxf(t.x, __shfl_xor(t.x, o)); t.y = fmaxf(t.y, __shfl_xor(t.y, o)); t.z = fmaxf(t.z, __shfl_xor(t.z, o)); t.w = fmaxf(t.w, __shfl_xor(t.w, o)); }
          if ((tid & 63) < 8) *(LAS f32x4*)(part + (tid >> 6) * 32 + 4 * n4) = t; }
        __syncthreads();
        if (tid < 32) { float m = 0.f;
#pragma unroll
            for (int q = 0; q < 8; ++q) m = fmaxf(m, part[q * 32 + tid]);
            const float sc = m > 0.f ? m * (1.f / 127.f) : 1.f; inv[tid] = 1.f / sc;
            if (slab < NSLAB_E) { const int e = slab / 192, r = slab % 192; const bool isw2 = r >= 128; const int n = (isw2 ? r - 128 : r) * 32 + tid;
                if (isw2) { drow[tid] = e * 2048 + n; WSC2[e * 2048 + n] = sc; }
                else { const int j2 = n & 2047, row = (j2 >> 7) * 256 + (n >= 2048 ? 128 : 0) + (j2 & 127); drow[tid] = e * 4096 + row; WSC1[e * 4096 + row] = sc; } }
            else { const int n = (slab - NSLAB_E) * 32 + tid; if (n < 5672) { float qsc; const int row = win_row(n, qsc); drow[tid] = row; WISC[row] = sc * qsc; } else drow[tid] = -1; } }
        __syncthreads();
        { const int kc = tid & 7, n = (tid >> 3) & 31, hf = tid >> 8; const float iv = inv[n]; const int dr = drow[n];
          signed char* dst = (slab < NSLAB_E ? ((slab % 192) >= 128 ? W2Q : W1Q) : WIQ) + (size_t)(dr < 0 ? 0 : dr) * 2048; const LAS unsigned char* src = TT + n * RS;
          if (dr >= 0) {
#pragma unroll
          for (int m8 = 0; m8 < 8; ++m8) { const int k0 = 16 * (kc + 8 * (hf + 2 * m8)); const LAS v2u* sp = (const LAS v2u*)(src + k0 * 2); const v2u a = sp[0], b = sp[1], c = sp[2], d = sp[3]; v4u o;
              o.x = q8x4(bflo(a.x) * iv, bfhi(a.x) * iv, bflo(a.y) * iv, bfhi(a.y) * iv); o.y = q8x4(bflo(b.x) * iv, bfhi(b.x) * iv, bflo(b.y) * iv, bfhi(b.y) * iv);
              o.z = q8x4(bflo(c.x) * iv, bfhi(c.x) * iv, bflo(c.y) * iv, bfhi(c.y) * iv); o.w = q8x4(bflo(d.x) * iv, bfhi(d.x) * iv, bflo(d.y) * iv, bfhi(d.y) * iv);
              *(v4u*)(dst + k0) = o; } } }
        __syncthreads();
    }
#undef SLAB_ISSUE
#undef SLAB_USE
}
struct EpiSwigluI8 {
    static constexpr bool PERM = true, AFTER_DRAIN = false;
    const float* b1; const float* rowsc; const float* wsc1; bf16* act; float* amaxp;
    __device__ __forceinline__ void operator()(const pg8::f32x4 (&acc)[2][2][4][2], const pg8::Unit& u, int wr, int wc, int fr, int fq) const {
        const int e = u.kind; const int cin = wc * 32 + 8 * fq; const int col = u.pn * 128 + cin; const int row0 = u.pm * 256 + wr * 64 + fr;
        const float* bg = b1 + (size_t)e * 4096 + col; const float* bl = bg + 2048; const float* sg = wsc1 + (size_t)e * 4096 + u.pn * 256 + cin; const float* sl = sg + 128;
        float gb[8], lb[8], gs[8], ls[8];
#pragma unroll
        for (int j = 0; j < 8; ++j) { gb[j] = bg[j]; lb[j] = bl[j]; gs[j] = sg[j]; ls[j] = sl[j]; }
#pragma unroll
        for (int ai = 0; ai < 2; ++ai)
#pragma unroll
            for (int m = 0; m < 4; ++m) { const int r = row0 + ai * 128 + m * 16; const float rs = rowsc[r]; float o[8]; float mx = 0.f;
#pragma unroll
                for (int n = 0; n < 2; ++n)
#pragma unroll
                    for (int j = 0; j < 4; ++j) { float gl = (float)__float_as_int(acc[ai][0][m][n][j]) * (rs * gs[n * 4 + j]) + gb[n * 4 + j]; float li = (float)__float_as_int(acc[ai][1][m][n][j]) * (rs * ls[n * 4 + j]) + lb[n * 4 + j];
                        gl = fminf(gl, 7.f); li = fminf(fmaxf(li, -7.f), 7.f);
                        const float v = gl * __builtin_amdgcn_rcpf(1.f + __builtin_amdgcn_exp2f(-2.4554669595930156f * gl)) * (li + 1.f); o[n * 4 + j] = v; mx = fmaxf(mx, fabsf(v)); }
                mx = nsa::rmax32(nsa::rmax16(mx));
                if (fq == 0) amaxp[(size_t)r * 64 + u.pn * 4 + wc] = mx;
                pg8::u32x4 w; w.x = pg8::cvt_pk_bf16(o[0], o[1]); w.y = pg8::cvt_pk_bf16(o[2], o[3]); w.z = pg8::cvt_pk_bf16(o[4], o[5]); w.w = pg8::cvt_pk_bf16(o[6], o[7]);
                *(pg8::u32x4*)(act + (size_t)r * DFF + col) = w; }
    }
};
__device__ __forceinline__ void ph_actq(const Params& p, int gw, int NGW, int lane) {
    const int nrows = ((const int*)(p.ws + WS_META))[0] * 256; const float* amaxp = (const float*)(p.ws + WS_AMAXP); const bf16* act = (const bf16*)(p.ws + WS_ACT);
    signed char* A8 = (signed char*)(p.ws + WS_ACT8); float* ASC = (float*)(p.ws + WS_ASC);
    for (int rb = gw; rb < nrows; rb += 2 * NGW) {
        const int r0 = rb, r1 = rb + NGW; const bool h1 = r1 < nrows; const int r1c = h1 ? r1 : r0;
        float m0 = amaxp[(size_t)r0 * 64 + lane], m1 = amaxp[(size_t)r1c * 64 + lane];
        const v4u* s0 = (const v4u*)(act + (size_t)r0 * DFF) + lane * 4; const v4u* s1 = (const v4u*)(act + (size_t)r1c * DFF) + lane * 4; v4u a[2][4];
#pragma unroll
        for (int j = 0; j < 4; ++j) { a[0][j] = s0[j]; a[1][j] = s1[j]; }
        m0 = wave_max(m0); m1 = wave_max(m1);
#pragma unroll
        for (int q = 0; q < 2; ++q) { const int r = q ? r1 : r0; if (q && !h1) break; const float mx = q ? m1 : m0; const float sc = mx > 0.f ? mx * (1.f / 127.f) : 1.f, iv = 1.f / sc; v4u o[2];
#pragma unroll
            for (int h = 0; h < 2; ++h) { const v4u x = a[q][2 * h], y = a[q][2 * h + 1];
                o[h].x = q8x4(bflo(x.x) * iv, bfhi(x.x) * iv, bflo(x.y) * iv, bfhi(x.y) * iv); o[h].y = q8x4(bflo(x.z) * iv, bfhi(x.z) * iv, bflo(x.w) * iv, bfhi(x.w) * iv);
                o[h].z = q8x4(bflo(y.x) * iv, bfhi(y.x) * iv, bflo(y.y) * iv, bfhi(y.y) * iv); o[h].w = q8x4(bflo(y.z) * iv, bfhi(y.z) * iv, bflo(y.w) * iv, bfhi(y.w) * iv); }
            v4u* dst = (v4u*)(A8 + (size_t)r * DFF) + lane * 2; dst[0] = o[0]; dst[1] = o[1];
            if (lane == 0) ASC[r] = sc; } }
}
struct EpiDownI8 {
    static constexpr bool PERM = true, AFTER_DRAIN = false;
    const float* b2; const float* roww; const float* asc; const float* wsc2; bf16* y;
    __device__ __forceinline__ void operator()(const pg8::f32x4 (&acc)[2][2][4][2], const pg8::Unit& u, int wr, int wc, int fr, int fq) const {
        const int e = u.kind; const int col0 = u.pn * 256 + wc * 32 + 8 * fq; const int row0 = u.pm * 256 + wr * 64 + fr;
        float bv[2][8], sv[2][8];
#pragma unroll
        for (int bj = 0; bj < 2; ++bj)
#pragma unroll
            for (int j = 0; j < 8; ++j) { bv[bj][j] = b2[(size_t)e * DM + col0 + bj * 128 + j]; sv[bj][j] = wsc2[(size_t)e * DM + col0 + bj * 128 + j]; }
#pragma unroll
        for (int ai = 0; ai < 2; ++ai)
#pragma unroll
            for (int m = 0; m < 4; ++m) { const int r = row0 + ai * 128 + m * 16; const float g = roww[r], as = asc[r];
#pragma unroll
                for (int bj = 0; bj < 2; ++bj) { float o[8];
#pragma unroll
                    for (int n = 0; n < 2; ++n)
#pragma unroll
                        for (int j = 0; j < 4; ++j) o[n * 4 + j] = ((float)__float_as_int(acc[ai][bj][m][n][j]) * (as * sv[bj][n * 4 + j]) + bv[bj][n * 4 + j]) * g;
                    pg8::u32x4 w; w.x = pg8::cvt_pk_bf16(o[0], o[1]); w.y = pg8::cvt_pk_bf16(o[2], o[3]); w.z = pg8::cvt_pk_bf16(o[4], o[5]); w.w = pg8::cvt_pk_bf16(o[6], o[7]);
                    *(pg8::u32x4*)(y + (size_t)r * DM + col0 + bj * 128) = w; } }
    }
};

struct EpiProjI8 {
    static constexpr bool PERM = true, AFTER_DRAIN = false;
    unsigned char* ws;
    __device__ __forceinline__ void operator()(const pg8::f32x4 (&acc)[2][2][4][2], const pg8::Unit& u, int wr, int wc, int fr, int fq) const {
        const int cw = wc * 32 + 8 * fq; const float* XSC = (const float*)(ws + WS_XSC); const float* WISC = (const float*)(ws + WS_WISC);
        if (u.kind == 0) {
            const int tn = u.pn; bf16* base; size_t bjs = 128; int ld = 0; bool headmajor = false; bool small = false;
            if (tn < 2) { base = (bf16*)(ws + WS_GQ) + tn * 256; ld = 512; }
            else if (tn < 4) { base = (bf16*)(ws + WS_GK) + (tn - 2) * 256; ld = 512; }
            else if (tn < 8) { base = (bf16*)(ws + WS_GV) + (tn - 4) * 256; ld = 1024; }
            else if (tn < 12) { base = (bf16*)(ws + WS_GG) + (tn - 8) * 256; ld = 1024; }
            else if (tn < 16) { base = (bf16*)(ws + WS_NQ) + (tn - 12) * 256; ld = 1024; }
            else if (tn < 20) { base = (bf16*)(ws + (tn == 16 ? WS_KC : tn == 17 ? WS_VC : tn == 18 ? WS_KS : WS_KW)); headmajor = true; bjs = (size_t)SEQ * 128; }
            else { base = (bf16*)(ws + WS_SM); ld = 64; small = true; }
            if (small && wc >= 2) return;
            float cs[2][8];
#pragma unroll
            for (int bj = 0; bj < 2; ++bj)
#pragma unroll
                for (int j = 0; j < 8; ++j) cs[bj][j] = WISC[tn * 256 + bj * 128 + cw + j];
#pragma unroll
            for (int ai = 0; ai < 2; ++ai)
#pragma unroll
                for (int m = 0; m < 4; ++m) { const int r = u.pm * 256 + ai * 128 + wr * 64 + m * 16 + fr; const float rs = XSC[r];
                    const size_t rterm = headmajor ? ((size_t)(r >> 12) * 2 * SEQ + (r & (SEQ - 1))) * 128 : (size_t)r * ld;
#pragma unroll
                    for (int bj = 0; bj < 2; ++bj) { if (small && bj) continue; float o[8];
#pragma unroll
                        for (int n = 0; n < 2; ++n)
#pragma unroll
                            for (int j = 0; j < 4; ++j) o[n * 4 + j] = (float)__float_as_int(acc[ai][bj][m][n][j]) * (rs * cs[bj][n * 4 + j]);
                        pg8::u32x4 w; w.x = pg8::cvt_pk_bf16(o[0], o[1]); w.y = pg8::cvt_pk_bf16(o[2], o[3]); w.z = pg8::cvt_pk_bf16(o[4], o[5]); w.w = pg8::cvt_pk_bf16(o[6], o[7]);
                        *(pg8::u32x4*)(base + rterm + bj * bjs + cw) = w; } }
        } else {
            bf16* base = (bf16*)(ws + (u.pn == 21 ? WS_VST : WS_VWT));
#pragma unroll
            for (int ai = 0; ai < 2; ++ai)
#pragma unroll
                for (int m = 0; m < 4; ++m) { const int dh = wr * 64 + m * 16 + fr; const float ws_ = WISC[u.pn * 256 + ai * 128 + dh];
#pragma unroll
                    for (int bj = 0; bj < 2; ++bj) { const int tok = u.pm * 256 + bj * 128 + cw; const int b = tok >> 12, s = tok & (SEQ - 1); float o[8];
                        const pg8::f32x4 x0 = *(const pg8::f32x4*)(XSC + tok), x1 = *(const pg8::f32x4*)(XSC + tok + 4);
#pragma unroll
                        for (int j = 0; j < 4; ++j) { o[j] = (float)__float_as_int(acc[ai][bj][m][0][j]) * (ws_ * x0[j]); o[4 + j] = (float)__float_as_int(acc[ai][bj][m][1][j]) * (ws_ * x1[j]); }
                        pg8::u32x4 w; w.x = pg8::cvt_pk_bf16(o[0], o[1]); w.y = pg8::cvt_pk_bf16(o[2], o[3]); w.z = pg8::cvt_pk_bf16(o[4], o[5]); w.w = pg8::cvt_pk_bf16(o[6], o[7]);
                        *(pg8::u32x4*)(base + ((size_t)(b * 2 + ai) * 128 + dh) * SEQ + s) = w; } }
        }
    }
};

__device__ __forceinline__ void r1_router(const Params& p, LAS unsigned char* lds, int vb, int tid, int wave, int lane) {
    LAS float* rowbuf = (LAS float*)lds;
    LAS float* part = (LAS float*)(lds + 65536);
    LAS int* tk = (LAS int*)(lds + 81920 + wave * 1024);
    LAS int* cntw = (LAS int*)(lds + 90112);
    const bf16* h = (const bf16*)(p.ws + WS_H16); const float* gf = p.in[I_NFFN]; const float* rw = p.in[I_RW]; const float* rb = p.in[I_RB];
    signed char* HN8 = (signed char*)(p.ws + WS_HN8);
    const int e = lane & 31, eg = tid & 31, dg = tid >> 5; int mycount = 0;
    float rwr[128];
#pragma unroll
    for (int c4 = 0; c4 < 4; ++c4) { unsigned o = (unsigned)((((dg * 128 + c4 * 32) * 32) + eg) * 4); asm volatile("" : "+v"(o));
#pragma unroll
        for (int i = 0; i < 32; ++i) rwr[c4 * 32 + i] = *(const float*)((const char*)rw + o + i * 128); }
    for (int grp = 0; grp < 16; ++grp) { const int t = vb * TPV + grp * 8 + wave;
        { const v4u* xr = (const v4u*)(h + (size_t)t * DM) + lane; float s = 0.f; v4u hw[4];
#pragma unroll
          for (int q = 0; q < 4; ++q) hw[q] = xr[64 * q];
#pragma unroll
          for (int q = 0; q < 4; ++q) { const float a0 = bflo(hw[q].x), a1 = bfhi(hw[q].x), a2 = bflo(hw[q].y), a3 = bfhi(hw[q].y), a4 = bflo(hw[q].z), a5 = bfhi(hw[q].z), a6 = bflo(hw[q].w), a7 = bfhi(hw[q].w);
              s += ((a0 * a0 + a1 * a1) + (a2 * a2 + a3 * a3)) + ((a4 * a4 + a5 * a5) + (a6 * a6 + a7 * a7)); }
          const float rstd = 1.f / sqrtf(wave_sum(s) * (1.f / DM) + RMS_EPS);
          float mxr = 0.f; LAS f32x4* hrow = (LAS f32x4*)(rowbuf + wave * 2048);
#pragma unroll
          for (int j = 0; j < 8; ++j) { const int cj = 2 * lane + 128 * (j >> 1) + (j & 1); const f32x4 g4 = ((const f32x4*)gf)[cj]; const unsigned wa = (j & 1) ? hw[j >> 1].z : hw[j >> 1].x, wb = (j & 1) ? hw[j >> 1].w : hw[j >> 1].y;
              f32x4 y; y.x = bflo(wa) * rstd * g4.x; y.y = bfhi(wa) * rstd * g4.y; y.z = bflo(wb) * rstd * g4.z; y.w = bfhi(wb) * rstd * g4.w;
              hrow[cj] = y; mxr = fmaxf(mxr, fmaxf(fmaxf(fabsf(y.x), fabsf(y.y)), fmaxf(fabsf(y.z), fabsf(y.w)))); }
          mxr = wave_max(mxr); const float qs = mxr > 0.f ? mxr * (1.f / 127.f) : 1.f, qi = 1.f / qs;
          v2u* o8 = (v2u*)(HN8 + (size_t)t * DM) + lane;
#pragma unroll
          for (int q = 0; q < 4; ++q) { const f32x4 ya = hrow[2 * lane + 128 * q], yb = hrow[2 * lane + 128 * q + 1]; v2u o;
              o.x = q8x4(ya.x * qi, ya.y * qi, ya.z * qi, ya.w * qi); o.y = q8x4(yb.x * qi, yb.y * qi, yb.z * qi, yb.w * qi); o8[64 * q] = o; }
          if (lane == 0) ((float*)(p.ws + WS_HSC))[t] = qs; }
        __syncthreads();
        { float acc[8];
#pragma unroll
          for (int tt = 0; tt < 8; ++tt) acc[tt] = 0.f;
#pragma unroll
          for (int i4 = 0; i4 < 32; ++i4) { f32x4 xv[8];
#pragma unroll
              for (int tt = 0; tt < 8; ++tt) xv[tt] = *(const LAS f32x4*)(rowbuf + tt * 2048 + dg * 128 + 4 * i4);
#pragma unroll
              for (int tt = 0; tt < 8; ++tt) acc[tt] += xv[tt].x * rwr[4 * i4] + xv[tt].y * rwr[4 * i4 + 1] + xv[tt].z * rwr[4 * i4 + 2] + xv[tt].w * rwr[4 * i4 + 3];
              if (i4 & 1) asm volatile("" ::: "memory"); }
#pragma unroll
          for (int tt = 0; tt < 8; ++tt) part[(dg * 8 + tt) * 32 + eg] = acc[tt]; }
        __syncthreads();
        { float a = rb[e];
#pragma unroll
          for (int q = 0; q < 16; ++q) a += part[(q * 8 + wave) * 32 + e];
          int rank = 0;
#pragma unroll
          for (int mm = 0; mm < 32; ++mm) { const float lm = __shfl(a, mm); rank += (lm > a || (lm == a && mm < e)) ? 1 : 0; }
          const float mx = wave_max(a); const bool sel = rank < 4;
          const float ex = (sel && lane < 32) ? __expf(a - mx) : 0.f; const float sum = wave_sum(ex);
          if (sel && lane < 32) { LAS int* q = tk + (grp * 4 + rank) * 4; q[0] = e; q[1] = mycount; q[2] = __builtin_bit_cast(int, ex / sum); ++mycount; } }
        __syncthreads();
    }
    int ln; asm volatile("v_mbcnt_lo_u32_b32 %0, -1, 0\n\tv_mbcnt_hi_u32_b32 %0, -1, %0" : "=v"(ln));
    if (ln < 32) cntw[wave * 32 + ln] = mycount;
    __syncthreads();
    if (wave == 0 && ln < 32) { int tot = 0; for (int w = 0; w < 8; ++w) tot += cntw[w * 32 + ln]; ((int*)(p.ws + WS_CNT))[vb * 32 + ln] = tot; }
    { const int i = ln >> 2, k = ln & 3; const LAS int* q = tk + (i * 4 + k) * 4; const int ee = q[0]; int base = 0; for (int w = 0; w < wave; ++w) base += cntw[w * 32 + ee];
      const int t = vb * TPV + i * 8 + wave;
      ((int*)(p.ws + WS_EIDX))[t * 4 + k] = ee; ((int*)(p.ws + WS_LRNK))[t * 4 + k] = base + q[1]; ((int*)(p.ws + WS_GATE))[t * 4 + k] = q[2]; }
    __syncthreads();
}
__device__ __forceinline__ void r2_gather(const Params& p, LAS unsigned char* lds, int vb, bool write_meta, int tid, int wave, int lane) {
    LAS int* part_tot = (LAS int*)lds;
    LAS int* part_base = part_tot + 512;
    LAS int* pbase = part_base + 512;
    const int* CNT = (const int*)(p.ws + WS_CNT);
    { const int e = tid & 31, part = tid >> 5; int tot = 0, bs = 0;
      for (int v = part * 16; v < part * 16 + 16; ++v) { const int c = CNT[v * 32 + e]; tot += c; if (v < vb) bs += c; }
      part_tot[part * 32 + e] = tot; part_base[part * 32 + e] = bs; }
    __syncthreads();
    if (tid == 0) { int ps = 0; int* meta = (int*)(p.ws + WS_META); int nt = 0;
        for (int e = 0; e < 32; ++e) { int tot = 0, bs = 0; for (int q = 0; q < 16; ++q) { tot += part_tot[q * 32 + e]; bs += part_base[q * 32 + e]; }
            pbase[e] = ps + bs; const int ntile = (tot + 255) >> 8;
            if (write_meta) for (int q = 0; q < ntile; ++q) meta[64 + nt + q] = e;
            nt += ntile; ps += ntile * 256; }
        if (write_meta) meta[0] = nt; }
    __syncthreads();
    const float* HSC = (const float*)(p.ws + WS_HSC); float* ROWSC = (float*)(p.ws + WS_ROWSC);
    const int* EIDX = (const int*)(p.ws + WS_EIDX); const int* LRNK = (const int*)(p.ws + WS_LRNK); const float* GATE = (const float*)(p.ws + WS_GATE);
    int* POS = (int*)(p.ws + WS_POS); float* ROWW = (float*)(p.ws + WS_ROWW);
    unsigned short* RT = (unsigned short*)(p.ws + WS_ROWTOK);
    { const int t = vb * TPV + (tid >> 2), k = tid & 3;
      const int pos = pbase[EIDX[t * 4 + k]] + LRNK[t * 4 + k];
      POS[t * 4 + k] = pos; ROWW[pos] = GATE[t * 4 + k]; ROWSC[pos] = HSC[t]; RT[(pos & ~255) + (pos & 63) * 4 + ((pos >> 6) & 3)] = (unsigned short)t; }
    __syncthreads();
}
__device__ __forceinline__ void pf_final(const Params& p, int gw, int NGW, int lane) {
    const bf16* Y = (const bf16*)(p.ws + WS_Y); const int* POS = (const int*)(p.ws + WS_POS); const float* gfin = p.in[I_NFIN]; const bf16* H = (const bf16*)(p.ws + WS_H16);
    for (int t = gw; t < T; t += NGW) {
        f32x4 v[8]; const v4u* hr = (const v4u*)(H + (size_t)t * DM) + lane;
#pragma unroll
        for (int q = 0; q < 4; ++q) { const v4u w = hr[64 * q]; v[2 * q] = (f32x4){bflo(w.x), bfhi(w.x), bflo(w.y), bfhi(w.y)}; v[2 * q + 1] = (f32x4){bflo(w.z), bfhi(w.z), bflo(w.w), bfhi(w.w)}; }
#pragma unroll
        for (int k = 0; k < 4; ++k) { const int pos = POS[t * 4 + k]; const v4u* yr = (const v4u*)(Y + (size_t)pos * DM) + lane;
#pragma unroll
            for (int q = 0; q < 4; ++q) { const v4u w = yr[64 * q]; v[2 * q].x += bflo(w.x); v[2 * q].y += bfhi(w.x); v[2 * q].z += bflo(w.y); v[2 * q].w += bfhi(w.y);
                v[2 * q + 1].x += bflo(w.z); v[2 * q + 1].y += bfhi(w.z); v[2 * q + 1].z += bflo(w.w); v[2 * q + 1].w += bfhi(w.w); } }
        float s = 0.f;
#pragma unroll
        for (int j = 0; j < 8; ++j) s += (v[j].x * v[j].x + v[j].y * v[j].y) + (v[j].z * v[j].z + v[j].w * v[j].w);
        const float rstd = 1.f / sqrtf(wave_sum(s) * (1.f / DM) + RMS_EPS); f32x4* xr = (f32x4*)(p.out + (size_t)t * DM);
#pragma unroll
        for (int j = 0; j < 8; ++j) { const int cj = 2 * lane + 128 * (j >> 1) + (j & 1); const f32x4 g4 = ((const f32x4*)gfin)[cj]; f32x4 o; o.x = v[j].x * rstd * g4.x; o.y = v[j].y * rstd * g4.y; o.z = v[j].z * rstd * g4.z; o.w = v[j].w * rstd * g4.w; xr[cj] = o; }
    }
}


constexpr int LDS_BYTES = 159744;
constexpr int MISC_OFF = LDS_BYTES - 256;  static_assert(nsa::LDS_END <= MISC_OFF && gla::L_END <= MISC_OFF, "LDS map");
constexpr int CW_BAR = 4096, CW_XL = 16384;
__global__ __launch_bounds__(512, 2) void mega_fwd(Params p) {
    extern __shared__ __attribute__((aligned(16))) unsigned char lds_raw[];
    LAS unsigned char* lds = (LAS unsigned char*)lds_raw;
    const int G = gridDim.x, bid = blockIdx.x, NGW = G * 8;
#define PH_IDS int tid = threadIdx.x; asm volatile("" : "+v"(tid)); const int lane = tid & 63, wave = __builtin_amdgcn_readfirstlane(tid >> 6), gw = bid * 8 + wave; (void)lane; (void)gw;
    for (int u = threadIdx.x; u < 64; u += 512) ((LAS unsigned*)(lds + MISC_OFF))[u] = 0u;
    __syncthreads();
    XcdBarrier bar = xcd_barrier_post((unsigned*)(p.ws + WS_CTL) + CW_BAR, (volatile LAS unsigned*)(lds + MISC_OFF) + 8);
    { PH_IDS; p0_prologue(p, lds, gw, NGW, wave, lane); __syncthreads(); p0_slab_quant(p, lds, bid, G, tid); }
    xcd_barrier(bar);
    { pg8::Gemm g{(const bf16*)(p.ws + WS_XN8), (const bf16*)(p.ws + WS_WINQ), T, NPT * 256, DM / 2};
      ProjOrder S; S.init(T, NPT * 256, G, bid); S.xn = g.A; S.wt = g.Bt; EpiProjI8 E{p.ws};
      pg8::gemm_phase<EpiProjI8, ProjOrder, true, true, true>(lds, g, S, E); }
    xcd_barrier(bar);
    if (bid < 32) {
        pg8::Gemm g{(const bf16*)(p.ws + WS_KC), (const bf16*)(p.ws + WS_WKCT), 4096, 256, 2048};
        CmpOrder S{bid, (const bf16*)(p.ws + WS_KC), (const bf16*)(p.ws + WS_VC), (const bf16*)(p.ws + WS_WKCT), (const bf16*)(p.ws + WS_WVCT)}; EpiLH E{(float*)(p.ws + WS_LH)};
        pg8::gemm_phase<EpiLH, CmpOrder, true, true>(lds, g, S, E);
    } else { PH_IDS; ph_gla_a(p, lds, bid - 32, G - 32, tid, wave); }
    xcd_barrier(bar);
    { PH_IDS; ph_gla_b(p, bid * 512 + tid, G * 512);
      for (int i = bid * 512 + tid; i < 16 * 128; i += G * 512) { const int bgz = i >> 7, dz = i & 127; ((bf16*)(p.ws + WS_KCMP))[((size_t)bgz * 256 + 255) * 128 + dz] = 0; ((bf16*)(p.ws + WS_VCMPT))[((size_t)bgz * 128 + dz) * 256 + 255] = 0; }
      const int ngrp = G * 4, total = 2 * 16 * 255, iters = (total + ngrp - 1) / ngrp; const int grp = tid >> 7;
      for (int it = 0; it < iters; ++it) { int id = it * ngrp + bid * 4 + grp; if (id >= total) id = total - 1;
          ph_cmp_fin_simple(p, (LAS float*)lds + grp * 4352, id, tid & 127, (const float*)(p.ws + WS_LH), (const float*)(p.ws + WS_PEVP)); __syncthreads(); } }
    xcd_barrier(bar);
    { PH_IDS; ph_nsa(p, lds, bid, G, tid, wave); }
    { PH_IDS; __syncthreads(); ph_gla_c(p, lds, bid, G, tid, wave); }
    xcd_barrier(bar);
    { pg8::Gemm g{(const bf16*)(p.ws + WS_A2), (const bf16*)(p.ws + WS_WOT), T, DM, DM};
      pg8::StaticOrder S; S.init(T, DM, G, bid); EpiRes E{p.in[I_X], (bf16*)(p.ws + WS_H16)};
      pg8::gemm_phase<EpiRes, pg8::StaticOrder, true, true>(lds, g, S, E); }
    xcd_barrier(bar);
    { PH_IDS; for (int vb = bid; vb < NVB; vb += G) r1_router(p, lds, vb, tid, wave, lane); }
    xcd_barrier(bar);
    { PH_IDS; for (int vb = bid; vb < NVB; vb += G) r2_gather(p, lds, vb, vb == 0, tid, wave, lane); }
    xcd_barrier(bar);
    { pg8::Gemm g{(const bf16*)(p.ws + WS_HN8), (const bf16*)(p.ws + WS_W1Q), MAXTILES * 256, 4096, DM / 2};
      MoeOrderG S; S.init((const int*)(p.ws + WS_META), 16, G, bid); S.rowtab = (const unsigned short*)(p.ws + WS_ROWTOK); EpiSwigluI8 E{p.in[I_B1], (const float*)(p.ws + WS_ROWSC), (const float*)(p.ws + WS_WSC1), (bf16*)(p.ws + WS_ACT), (float*)(p.ws + WS_AMAXP)};
      pg8::gemm_phase<EpiSwigluI8, MoeOrderG, true, true, true, true>(lds, g, S, E); }
    xcd_barrier(bar);
    { PH_IDS; ph_actq(p, gw, NGW, lane); }
    xcd_barrier(bar);
    { pg8::Gemm g{(const bf16*)(p.ws + WS_ACT8), (const bf16*)(p.ws + WS_W2Q), MAXTILES * 256, DM, DFF / 2};
      MoeOrder S; S.init((const int*)(p.ws + WS_META), 8, G, bid); EpiDownI8 E{p.in[I_B2], (const float*)(p.ws + WS_ROWW), (const float*)(p.ws + WS_ASC), (const float*)(p.ws + WS_WSC2), (bf16*)(p.ws + WS_Y)};
      pg8::gemm_phase<EpiDownI8, MoeOrder, true, true, true>(lds, g, S, E); }
    xcd_barrier(bar);
    { PH_IDS; pf_final(p, gw, NGW, lane); }
}

extern "C" void kernel_launch(void* const* d_in, const int* in_sizes, int n_in, void* d_out, int out_size, void* d_ws, size_t ws_size, hipStream_t stream) {
    static int grid = 0;
    if (grid == 0) {
        if (n_in != N_IN || out_size != T * DM || ws_size < WS_END) { fprintf(stderr, "kernel_launch: unexpected shapes (n_in %d out %d ws %zu need %zu)\n", n_in, out_size, ws_size, (size_t)WS_END); grid = -1; return; }
        int dev = 0, cus = 0, per_cu = 0;
        if (hipGetDevice(&dev) != hipSuccess || hipDeviceGetAttribute(&cus, hipDeviceAttributeMultiprocessorCount, dev) != hipSuccess) { grid = -1; return; }
        if (hipFuncSetAttribute((const void*)mega_fwd, hipFuncAttributeMaxDynamicSharedMemorySize, LDS_BYTES) != hipSuccess) { fprintf(stderr, "kernel_launch: hipFuncSetAttribute failed\n"); grid = -1; return; }
        if (hipOccupancyMaxActiveBlocksPerMultiprocessor(&per_cu, (const void*)mega_fwd, 512, LDS_BYTES) != hipSuccess || per_cu < 1) { fprintf(stderr, "kernel_launch: occupancy query says %d blocks per CU\n", per_cu); }
        (void)hipGetLastError();
        grid = cus;
    }
    if (grid < 0) return;
    if (hipMemsetAsync((char*)d_ws + WS_CTL, 0, CTL_BYTES, stream) != hipSuccess) return;
    Params p{};
    for (int i = 0; i < N_IN; ++i) p.in[i] = (const float*)d_in[i];
    p.out = (float*)d_out; p.ws = (unsigned char*)d_ws;
    hipLaunchKernelGGL(mega_fwd, dim3(grid), dim3(512), LDS_BYTES, stream, p);
}
```

```cpp
#include <hip/hip_runtime.h>
#include <cstdio>
#include <cstdint>
namespace pg8 {
#define PG8_LAS __attribute__((address_space(3)))
typedef unsigned short bf16_t;
typedef short bf16x8 __attribute__((ext_vector_type(8)));
typedef float f32x4 __attribute__((ext_vector_type(4)));
typedef unsigned u32x4 __attribute__((ext_vector_type(4)));
typedef unsigned v2u_t __attribute__((ext_vector_type(2)));
constexpr int BM = 256, BK = 64, HALF = 128, HTB = HALF * BK * 2  , STAGE_BYTES = 8 * HTB, NXCD = 8, WGM = 8;

__host__ __device__ __forceinline__ int lds_byte(int r, int c) { const int st = (r >> 4) * 2 + (c >> 5), rr = r & 15, cc = c & 31, ob = rr * 64 + cc * 2; return st * 1024 + (ob ^ (((ob >> 9) & 1) << 5)); }
__host__ __device__ __forceinline__ void stage_rc(int b, int& R, int& C) { const int st = b / 1024, sb = b % 1024, swz = sb ^ (((sb >> 9) & 1) << 5); R = (st >> 1) * 16 + swz / 64; C = (st & 1) * 32 + (swz % 64) / 2; }
__host__ __device__ __forceinline__ int perm32(int rho) { const int n = rho >> 4, i = rho & 15; return 8 * (i >> 2) + 4 * n + (i & 3); }

struct Unit { int pm, pn, kind; };
struct Gemm { const bf16_t* A; const bf16_t* Bt; int M, N, K; };

template <int WG = WGM> __host__ __device__ __forceinline__ void tile_of(int wgid, int nM, int nN, int& pm, int& pn) {
    const int nwg = nM * nN;
    { const int q = nwg / NXCD, r = nwg % NXCD, xcd = wgid % NXCD, off = wgid / NXCD; wgid = (xcd < r ? xcd * (q + 1) : r * (q + 1) + (xcd - r) * q) + off; }
    const int nig = WG * nN, gid = wgid / nig, fm = gid * WG, gsz = (nM - fm) < WG ? (nM - fm) : WG;
    pm = fm + ((wgid % nig) % gsz); pn = (wgid % nig) / gsz;
}
struct StaticOrder {
    int nM, nN, nwg, G, c;
    __host__ __device__ void init(int M, int N, int G_, int c_) { nM = M / BM; nN = N / BM; nwg = nM * nN; G = G_; c = c_; }
    __device__ __forceinline__ bool next(int i, Unit& u) const {
        const long L = (long)i * G + c; if (L >= nwg) return false;
        tile_of((int)L, nM, nN, u.pm, u.pn); u.kind = 0; return true;
    }
    __device__ __forceinline__ const char* pa(const Gemm& g, const Unit& u) const { return (const char*)g.A + (size_t)u.pm * ((size_t)BM * g.K * 2); }
    __device__ __forceinline__ const char* pb(const Gemm& g, const Unit& u) const { return (const char*)g.Bt + (size_t)u.pn * ((size_t)BM * g.K * 2); }
    __device__ __forceinline__ void a_ready(const Unit&) const {}
    __device__ __forceinline__ void done(const Unit&) const {}
};
__device__ __forceinline__ unsigned cvt_pk_bf16(float lo, float hi) { unsigned r; asm volatile("v_cvt_pk_bf16_f32 %0, %1, %2" : "=v"(r) : "v"(lo), "v"(hi)); return r; }
template <bool I8> __device__ __forceinline__ f32x4 mma16(bf16x8 a, bf16x8 b, f32x4 c) {
    if constexpr (I8) { typedef int i32x4 __attribute__((ext_vector_type(4)));
        return __builtin_bit_cast(f32x4, __builtin_amdgcn_mfma_i32_16x16x64_i8(__builtin_bit_cast(i32x4, a), __builtin_bit_cast(i32x4, b), __builtin_bit_cast(i32x4, c), 0, 0, 0)); }
    else return __builtin_amdgcn_mfma_f32_16x16x32_bf16(a, b, c, 0, 0, 0);
}
template <class Epi, class Sched, bool ALIGN_EPI = false, bool SP2 = false, bool I8 = false, bool GATHER = false>
__device__ __forceinline__ void gemm_phase(PG8_LAS unsigned char* lds, const Gemm g, const Sched& S, const Epi& E) {
    int tid_l = threadIdx.x; asm volatile("" : "+v"(tid_l));
    const int tid = tid_l, wid = __builtin_amdgcn_readfirstlane(tid >> 6), lane = tid & 63, wr = wid >> 2, wc = wid & 3, fr = lane & 15, fq = lane >> 4;
    const int K = g.K, nt = K / BK;
    unsigned voffA[2], voffB[2];
#pragma unroll
    for (int i = 0; i < 2; ++i) { int R, C; stage_rc(tid * 16 + i * 8192, R, C); const int Rb = Epi::PERM ? ((R & ~31) + perm32(R & 31)) : R;
        voffA[i] = (unsigned)(R * K + C) * 2u; voffB[i] = (unsigned)(Rb * K + C) * 2u; }
    const size_t kstep = (size_t)(BK * 2);
    const size_t hstep = (size_t)HALF * K * 2;
    const unsigned ldsw = (unsigned)wid * 1024u;
    const int aoff = lds_byte(wr * 64 + fr, fq * 8), boff = lds_byte(wc * 32 + fr, fq * 8);
#define PG8_SA(b, h) (((b) * 2 + (h)) * HTB)
#define PG8_SB(b, h) ((4 + (b) * 2 + (h)) * HTB)
#define PG8_STAGE(bufoff, gbase, voff) do { _Pragma("unroll") for (int _i = 0; _i < 2; ++_i) \
        __builtin_amdgcn_global_load_lds((const unsigned*)((const char*)(gbase) + (voff)[_i]), (PG8_LAS unsigned*)(lds + (bufoff) + ldsw + _i * 8192), 16, 0, 0); } while (0)
#define PG8_STAGE_A(bufoff, ptr, h) do { if constexpr (GATHER) PG8_STAGE(bufoff, ptr, cuo + 2 * (h)); else PG8_STAGE(bufoff, (ptr) + (h) * hstep, voffA); } while (0)
#define PG8_LDA(dst, b, h) do { _Pragma("unroll") for (int m = 0; m < 4; ++m) _Pragma("unroll") for (int k = 0; k < 2; ++k) dst[m][k] = *(const PG8_LAS bf16x8*)(lds + PG8_SA(b, h) + aoff + m * 2048 + k * 1024); } while (0)
#define PG8_LDB(dst, b, h) do { _Pragma("unroll") for (int n = 0; n < 2; ++n) _Pragma("unroll") for (int k = 0; k < 2; ++k) dst[n][k] = *(const PG8_LAS bf16x8*)(lds + PG8_SB(b, h) + boff + n * 2048 + k * 1024); } while (0)
#define PG8_MMA(ai, bj, At, Bt) do { __builtin_amdgcn_s_setprio(1); _Pragma("unroll") for (int m = 0; m < 4; ++m) _Pragma("unroll") for (int n = 0; n < 2; ++n) _Pragma("unroll") for (int k = 0; k < 2; ++k) \
        acc[ai][bj][m][n] = mma16<I8>(Bt[n][k], At[m][k], acc[ai][bj][m][n]); __builtin_amdgcn_s_setprio(0); } while (0)
#define PG8_WAIT_V(n) asm volatile("s_waitcnt vmcnt(" #n ")" ::: "memory")
#define PG8_WAIT_L(n) asm volatile("s_waitcnt lgkmcnt(" #n ")" ::: "memory")
#define PG8_BAR __builtin_amdgcn_s_barrier()
#define PG8_SCHED __builtin_amdgcn_sched_barrier(0)
    Unit cur, nxt; int ui = 0;
    if (!S.next(0, cur)) return;
    unsigned cuo[4] = {0u, 0u, 0u, 0u}, cb0 = 0u; v2u_t raw = {0u, 0u};
    if constexpr (GATHER) { int R0, C0; stage_rc(tid * 16, R0, C0); cb0 = (unsigned)C0 * 2u; unsigned ro = (unsigned)R0 * 8u; asm volatile("" : "+v"(ro));
        Unit u1; const bool h1 = S.next(1, u1); const v2u_t r0 = *(const v2u_t*)((const char*)S.rowtab + (size_t)cur.pm * 512 + ro); raw = *(const v2u_t*)((const char*)S.rowtab + (size_t)(h1 ? u1.pm : cur.pm) * 512 + ro);
        cuo[0] = ((r0.x & 0xffffu) << 11) + cb0; cuo[1] = ((r0.x >> 16) << 11) + cb0; cuo[2] = ((r0.y & 0xffffu) << 11) + cb0; cuo[3] = ((r0.y >> 16) << 11) + cb0; }
    f32x4 acc[2][2][4][2];
#pragma unroll
    for (int a = 0; a < 2; ++a)
#pragma unroll
        for (int b = 0; b < 2; ++b)
#pragma unroll
            for (int m = 0; m < 4; ++m)
#pragma unroll
                for (int n = 0; n < 2; ++n) acc[a][b][m][n] = (f32x4){0.f, 0.f, 0.f, 0.f};
    bf16x8 At[4][2], B0[2][2], B1[2][2];
    const char* cA = S.pa(g, cur); const char* cB = S.pb(g, cur);
    S.a_ready(cur);
    if constexpr (SP2) {
        PG8_STAGE(PG8_SB(0, 0), cB, voffB); PG8_STAGE(PG8_SB(0, 1), cB + hstep, voffB); PG8_STAGE_A(PG8_SA(0, 0), cA, 0); PG8_STAGE_A(PG8_SA(0, 1), cA, 1);
        if (wr == 1) PG8_BAR;
        PG8_WAIT_V(2); PG8_BAR;
        PG8_STAGE(PG8_SB(1, 0), cB + kstep, voffB); PG8_STAGE_A(PG8_SA(1, 0), cA + kstep, 0); PG8_STAGE(PG8_SB(1, 1), cB + hstep + kstep, voffB);
        PG8_WAIT_V(6); PG8_BAR;
    } else {
        PG8_STAGE(PG8_SB(0, 0), cB, voffB); PG8_STAGE(PG8_SA(0, 0), cA, voffA); PG8_STAGE(PG8_SB(0, 1), cB + hstep, voffB); PG8_STAGE(PG8_SA(0, 1), cA + hstep, voffA);
        if (wr == 1) PG8_BAR;
        PG8_WAIT_V(4); PG8_BAR;
        PG8_STAGE(PG8_SB(1, 0), cB + kstep, voffB); PG8_STAGE(PG8_SA(1, 0), cA + kstep, voffA); PG8_STAGE(PG8_SB(1, 1), cB + hstep + kstep, voffB);
        PG8_WAIT_V(6); PG8_BAR;
    }
    for (;;) {
        const bool has_next = S.next(ui + 1, nxt);
        const char* nA = has_next ? S.pa(g, nxt) : cA; const char* nB = has_next ? S.pb(g, nxt) : cB;
        for (int t = 0; t < nt; t += 2) {
            const bool last = (t == nt - 2);
            const char* a1 = cA + (size_t)(t + 1) * kstep;
            const char* a2 = last ? nA : cA + (size_t)(t + 2) * kstep; const char* b2 = last ? nB : cB + (size_t)(t + 2) * kstep;
            const char* a3 = a2 + kstep; const char* b3 = b2 + kstep;
            if (last && has_next) S.a_ready(nxt);
            if constexpr (SP2) {
            PG8_LDB(B0, 0, 0); PG8_LDB(B1, 0, 1); PG8_SCHED; PG8_LDA(At, 0, 0); PG8_STAGE_A(PG8_SA(1, 1), a1, 1);
            if constexpr (GATHER) { unsigned rx = raw.x, ry = raw.y; asm volatile("" : "+v"(rx), "+v"(ry));
                const unsigned n0 = ((rx & 0xffffu) << 11) + cb0, n1 = ((rx >> 16) << 11) + cb0, n2 = ((ry & 0xffffu) << 11) + cb0, n3 = ((ry >> 16) << 11) + cb0;
                cuo[0] = last ? n0 : cuo[0]; cuo[1] = last ? n1 : cuo[1]; cuo[2] = last ? n2 : cuo[2]; cuo[3] = last ? n3 : cuo[3]; }
            PG8_WAIT_V(8); PG8_WAIT_L(0); PG8_BAR; PG8_MMA(0, 0, At, B0); PG8_MMA(0, 1, At, B1); PG8_BAR; PG8_SCHED;
            PG8_LDA(At, 0, 1); PG8_STAGE(PG8_SB(0, 0), b2, voffB); PG8_STAGE(PG8_SB(0, 1), b2 + hstep, voffB); PG8_STAGE_A(PG8_SA(0, 0), a2, 0);
            PG8_WAIT_V(8); PG8_WAIT_L(0); PG8_BAR; PG8_MMA(1, 0, At, B0); PG8_MMA(1, 1, At, B1); PG8_BAR; PG8_SCHED;
            PG8_LDB(B0, 1, 0); PG8_LDB(B1, 1, 1); PG8_SCHED; PG8_LDA(At, 1, 0); PG8_STAGE_A(PG8_SA(0, 1), a2, 1);
            PG8_WAIT_V(8); PG8_WAIT_L(0); PG8_BAR; PG8_MMA(0, 0, At, B0); PG8_MMA(0, 1, At, B1); PG8_BAR; PG8_SCHED;
            PG8_LDA(At, 1, 1); PG8_STAGE(PG8_SB(1, 0), b3, voffB); PG8_STAGE(PG8_SB(1, 1), b3 + hstep, voffB); PG8_STAGE_A(PG8_SA(1, 0), a3, 0);
            PG8_WAIT_V(8); PG8_WAIT_L(0); PG8_BAR; PG8_MMA(1, 0, At, B0); PG8_MMA(1, 1, At, B1); PG8_BAR; PG8_SCHED;
            } else {
            PG8_LDB(B0, 0, 0); PG8_SCHED; PG8_LDA(At, 0, 0); PG8_STAGE(PG8_SA(1, 1), a1 + hstep, voffA);
            PG8_WAIT_L(8); PG8_BAR; PG8_WAIT_L(0); PG8_MMA(0, 0, At, B0); PG8_BAR; PG8_SCHED;
            PG8_LDB(B1, 0, 1); PG8_STAGE(PG8_SB(0, 0), b2, voffB);
            PG8_BAR; PG8_WAIT_L(0); PG8_MMA(0, 1, At, B1); PG8_BAR;
            PG8_LDA(At, 0, 1); PG8_STAGE(PG8_SA(0, 0), a2, voffA);
            PG8_BAR; PG8_WAIT_L(0); PG8_MMA(1, 0, At, B0); PG8_BAR; PG8_SCHED;
            PG8_STAGE(PG8_SB(0, 1), b2 + hstep, voffB);
            PG8_WAIT_V(6); PG8_BAR; PG8_MMA(1, 1, At, B1); PG8_BAR;
            PG8_LDB(B0, 1, 0); PG8_SCHED; PG8_LDA(At, 1, 0); PG8_STAGE(PG8_SA(0, 1), a2 + hstep, voffA);
            PG8_WAIT_L(8); PG8_BAR; PG8_WAIT_L(0); PG8_MMA(0, 0, At, B0); PG8_BAR; PG8_SCHED;
            PG8_LDB(B1, 1, 1); PG8_STAGE(PG8_SB(1, 0), b3, voffB);
            PG8_BAR; PG8_WAIT_L(0); PG8_MMA(0, 1, At, B1); PG8_BAR;
            PG8_LDA(At, 1, 1); PG8_STAGE(PG8_SA(1, 0), a3, voffA);
            PG8_BAR; PG8_WAIT_L(0); PG8_MMA(1, 0, At, B0); PG8_BAR; PG8_SCHED;
            PG8_STAGE(PG8_SB(1, 1), b3 + hstep, voffB);
            PG8_WAIT_V(6); PG8_BAR; PG8_MMA(1, 1, At, B1); PG8_BAR;
            }
        }
        if constexpr (ALIGN_EPI) { if (wr == 0) PG8_BAR; }
        if constexpr (GATHER) { static_assert(SP2 && !Epi::AFTER_DRAIN, "GATHER is written for the SP2 loop"); int R0, C0; stage_rc(tid * 16, R0, C0); Unit u2; const bool h2 = S.next(ui + 2, u2);
            unsigned ro = (unsigned)R0 * 8u; asm volatile("" : "+v"(ro)); raw = *(const v2u_t*)((const char*)S.rowtab + (size_t)(h2 ? u2.pm : cur.pm) * 512 + ro); PG8_SCHED; }
        if constexpr (!Epi::AFTER_DRAIN) { E(acc, cur, wr, wc, fr, fq); S.done(cur); }
        if (!has_next) break;
#pragma unroll
        for (int a = 0; a < 2; ++a)
#pragma unroll
            for (int b = 0; b < 2; ++b)
#pragma unroll
                for (int m = 0; m < 4; ++m)
#pragma unroll
                    for (int n = 0; n < 2; ++n) acc[a][b][m][n] = (f32x4){0.f, 0.f, 0.f, 0.f};
        cur = nxt; cA = nA; cB = nB; ++ui;
        if constexpr (ALIGN_EPI) { if (wr == 1) PG8_BAR; }
    }
    PG8_WAIT_V(0);
    if constexpr (!ALIGN_EPI) { if (wr == 0) PG8_BAR; }
    PG8_BAR;
    if constexpr (Epi::AFTER_DRAIN) { E.fused(acc, cur, wr, wc, fr, fq, lds, wid, lane); S.done(cur); }
#undef PG8_SA
#undef PG8_SB
#undef PG8_STAGE
#undef PG8_STAGE_A
#undef PG8_LDA
#undef PG8_LDB
#undef PG8_MMA
#undef PG8_WAIT_V
#undef PG8_WAIT_L
#undef PG8_BAR
#undef PG8_SCHED
}
}

#define GAS __attribute__((address_space(1)))
#define LAS __attribute__((address_space(3)))
typedef unsigned short bf16;
typedef unsigned v4u __attribute__((ext_vector_type(4)));
typedef unsigned v2u __attribute__((ext_vector_type(2)));
typedef float f32x4 __attribute__((ext_vector_type(4)));
typedef short bf16x8 __attribute__((ext_vector_type(8)));

constexpr int NB = 8, SEQ = 4096, DM = 2048, T = NB * SEQ;
constexpr int NPT = 23;
constexpr int NE = 32, DFF = 2048;
constexpr int MAXTILES = 544;
constexpr float RMS_EPS = 1e-5f;
constexpr int NVB = 256, TPV = T / NVB;

enum { I_X = 0, I_NMIX, I_WIN, I_WA2, I_BA, I_GLAG, I_PEK, I_WK1, I_WK2, I_PEV, I_WV1, I_WV2, I_NSAG, I_RELB, I_WOUT, I_NFFN, I_RW, I_RB, I_W1, I_B1, I_W2, I_B2, I_NFIN, N_IN };

constexpr size_t MiB = 1u << 20;
constexpr size_t al(size_t x) { return (x + 255) & ~(size_t)255; }
constexpr size_t WS_CTL = 0, CTL_BYTES = 1 * MiB;
constexpr size_t WS_CNT = WS_CTL + CTL_BYTES;
constexpr size_t WS_META = WS_CNT + al(NVB * 32 * 4);
constexpr size_t WS_EIDX = WS_META + al((64 + MAXTILES) * 4);
constexpr size_t WS_LRNK = WS_EIDX + al((size_t)T * 4 * 4);
constexpr size_t WS_GATE = WS_LRNK + al((size_t)T * 4 * 4);
constexpr size_t WS_POS = WS_GATE + al((size_t)T * 4 * 4);
constexpr size_t WS_ROWW = WS_POS + al((size_t)T * 4 * 4);
constexpr size_t WS_WINT = al(WS_ROWW + (size_t)MAXTILES * 256 * 4);
constexpr size_t WS_WOT = WS_WINT + (size_t)NPT * 256 * DM * 2;
constexpr size_t WS_WKCT = WS_WOT + (size_t)DM * DM * 2;
constexpr size_t WS_WVCT = WS_WKCT + (size_t)256 * 2048 * 2;
constexpr size_t WS_W1T = WS_WVCT + (size_t)256 * 2048 * 2;
constexpr size_t WS_W2T = WS_W1T + (size_t)NE * 4096 * DM * 2;
constexpr size_t WS_XN = WS_W2T + (size_t)NE * DM * DFF * 2;
constexpr size_t WS_GQ = WS_XN + (size_t)T * DM * 2;
constexpr size_t WS_GK = WS_GQ + (size_t)T * 512 * 2;
constexpr size_t WS_GV = WS_GK + (size_t)T * 512 * 2;
constexpr size_t WS_GG = WS_GV + (size_t)T * 1024 * 2;
constexpr size_t WS_NQ = WS_GG + (size_t)T * 1024 * 2;
constexpr size_t WS_KC = WS_NQ + (size_t)T * 1024 * 2;
constexpr size_t WS_VC = WS_KC + (size_t)T * 256 * 2;
constexpr size_t WS_KS = WS_VC + (size_t)T * 256 * 2;
constexpr size_t WS_KW = WS_KS + (size_t)T * 256 * 2;
constexpr size_t WS_VST = WS_KW + (size_t)T * 256 * 2;
constexpr size_t WS_VWT = WS_VST + (size_t)T * 256 * 2;
constexpr size_t WS_SM = WS_VWT + (size_t)T * 256 * 2;
constexpr size_t WS_LA = WS_SM + (size_t)T * 64 * 2;
constexpr size_t WS_OG = WS_LA + (size_t)T * 512 * 4;
constexpr size_t WS_ON = WS_OG + (size_t)T * 1024 * 4;
constexpr size_t WS_KCMP = WS_ON + (size_t)T * 1024 * 4;
constexpr size_t WS_VCMPT = WS_KCMP + (size_t)16 * 256 * 128 * 2;
constexpr size_t WS_A2 = WS_VCMPT + (size_t)16 * 256 * 128 * 2;
constexpr size_t WS_HN = WS_A2 + (size_t)T * DM * 2;
constexpr size_t WS_XG = WS_HN + (size_t)T * DM * 2;
constexpr size_t WS_ACT = WS_XG + (size_t)MAXTILES * 256 * DM * 2;
constexpr size_t WS_END = WS_ACT + (size_t)MAXTILES * 256 * DFF * 2;

typedef unsigned short u16x2 __attribute__((ext_vector_type(2)));
__device__ __forceinline__ unsigned cvt2bf(float lo, float hi) { unsigned r; asm("v_cvt_pk_bf16_f32 %0, %1, %2" : "=v"(r) : "v"(lo), "v"(hi)); return r; }
__device__ __forceinline__ unsigned f2bf(float f) { return cvt2bf(f, f) & 0xffffu; }
__device__ __forceinline__ unsigned pk2(float lo, float hi) { return cvt2bf(lo, hi); }
__device__ __forceinline__ float bf2f(unsigned short v) { return __builtin_bit_cast(float, (unsigned)v << 16); }
__device__ __forceinline__ float bflo(unsigned w) { return __builtin_bit_cast(float, w << 16); }
__device__ __forceinline__ float bfhi(unsigned w) { return __builtin_bit_cast(float, w & 0xffff0000u); }
__device__ __forceinline__ float wave_sum(float v) {
#pragma unroll
    for (int o = 1; o < 64; o <<= 1) v += __shfl_xor(v, o);
    return v;
}
__device__ __forceinline__ float wave_max(float v) {
#pragma unroll
    for (int o = 1; o < 64; o <<= 1) v = fmaxf(v, __shfl_xor(v, o));
    return v;
}
#define LDS_WAIT() asm volatile("s_waitcnt lgkmcnt(0)" ::: "memory")

__device__ const unsigned char kBucket[128] = {0, 1, 2, 3, 4, 5, 6, 7, 8, 9, 10, 11, 12, 13, 14, 15, 16, 16, 16, 17, 17, 18, 18, 18, 19, 19, 19, 20, 20, 20, 20, 21, 21, 21, 21, 22, 22, 22, 22, 22, 23, 23, 23, 23, 23, 23, 24, 24, 24, 24, 24, 24, 25, 25, 25, 25, 25, 25, 25, 26, 26, 26, 26, 26, 26, 26, 26, 27, 27, 27, 27, 27, 27, 27, 27, 27, 27, 28, 28, 28, 28, 28, 28, 28, 28, 28, 28, 29, 29, 29, 29, 29, 29, 29, 29, 29, 29, 29, 29, 30, 30, 30, 30, 30, 30, 30, 30, 30, 30, 30, 30, 30, 30, 31, 31, 31, 31, 31, 31, 31, 31, 31, 31, 31, 31, 31, 31, 31};

struct Params {
    const float* in[N_IN];
    float* out;
    unsigned char* ws;
};

template <class F>
__device__ __forceinline__ void transpose_item(const float* W, int ldw, int k0, int n0, int nlim, LAS float* scr, int lane, F dst) {
#pragma unroll 8
    for (int i = 0; i < 32; ++i) { const int kk = 2 * i + (lane >> 5); const int n = n0 + (lane & 31); scr[kk * 33 + (lane & 31)] = n < nlim ? W[(size_t)(k0 + kk) * ldw + n] : 0.f; }
    LDS_WAIT(); asm volatile("" ::: "memory");
    const int c = lane & 7;
#pragma unroll
    for (int j = 0; j < 4; ++j) { const int nn = (lane >> 3) + 8 * j; const int n = n0 + nn; const LAS float* s = scr + (8 * c) * 33 + nn;
        bf16* rowp; float sc;
        if (n < nlim && dst(n, rowp, sc)) {
            v4u o; o.x = pk2(s[0 * 33] * sc, s[1 * 33] * sc); o.y = pk2(s[2 * 33] * sc, s[3 * 33] * sc); o.z = pk2(s[4 * 33] * sc, s[5 * 33] * sc); o.w = pk2(s[6 * 33] * sc, s[7 * 33] * sc);
            *(v4u*)(rowp + 8 * c) = o; } }
    LDS_WAIT(); asm volatile("" ::: "memory");
}
__device__ __forceinline__ int win_row(int n, float& sc) {
    sc = 1.f;
    if (n < 512) { sc = 0.08838834764831845f; return n; }
    if (n < 1024) return n;
    if (n < 2048) return n;
    if (n < 3072) return n;
    if (n < 3088) return 5120 + (n - 3072);
    if (n < 4112) { sc = 0.08838834764831845f; return 3072 + (n - 3088); }
    if (n < 4368) return 4096 + (n - 4112);
    if (n < 4624) return 4352 + (n - 4368);
    if (n < 4880) return 4608 + (n - 4624);
    if (n < 5136) return 5376 + (n - 4880);
    if (n < 5392) return 4864 + (n - 5136);
    if (n < 5648) return 5632 + (n - 5392);
    return 5136 + (n - 5648);
}
constexpr size_t WS_PEVP = WS_W2T;
__device__ __forceinline__ void p0_prologue(const Params& p, LAS unsigned char* lds, int gw, int NGW, int wave, int lane) {
    LAS float* scr = (LAS float*)(lds + wave * 16384);
    bf16* WinT = (bf16*)(p.ws + WS_WINT); bf16* WoT = (bf16*)(p.ws + WS_WOT); bf16* WkcT = (bf16*)(p.ws + WS_WKCT); bf16* WvcT = (bf16*)(p.ws + WS_WVCT);
    bf16* W1T = (bf16*)(p.ws + WS_W1T); bf16* W2T = (bf16*)(p.ws + WS_W2T);
    constexpr int I_IN = 32 * 178, I_O = 32 * 64, I_C = 64 * 4, I_E1 = 32 * 128, I_E2 = 32 * 64;
    constexpr int I_PE = 2 * 64;
    constexpr int NITEMS = I_O + 2 * I_C + I_PE;
    (void)I_IN; (void)WinT;
    for (int it = gw; it < NITEMS; it += NGW) {
        int r = it;
        if (r < I_O) { const int kb = r / 64, nb = r % 64, k0 = kb * 64;
            transpose_item(p.in[I_WOUT], DM, k0, nb * 32, DM, scr, lane, [&](int n, bf16*& rowp, float& sc) { sc = 1.f; rowp = WoT + (size_t)n * DM + k0; return true; }); continue; } r -= I_O;
        if (r >= 2 * I_C) { r -= 2 * I_C; const int which = r >> 6, kq = r & 63; const float* pe = p.in[which ? I_PEV : I_PEK] + kq * 64; const float* w1 = p.in[which ? I_WV1 : I_WK1] + (size_t)kq * 64 * 128 + lane;
            float a0 = 0.f, a1 = 0.f;
#pragma unroll
            for (int k = 0; k < 64; ++k) { const float pv = pe[k]; a0 += pv * w1[k * 128]; a1 += pv * w1[k * 128 + 64]; }
            float* dst = (float*)(p.ws + WS_PEVP) + (size_t)(which * 64 + kq) * 128 + lane; dst[0] = a0; dst[64] = a1; continue; }
        { const int which = r / I_C; r %= I_C; const int kb = r / 4, nb = r % 4, k0 = kb * 64;
            bf16* dstm = which ? WvcT : WkcT;
            transpose_item(p.in[which ? I_WV1 : I_WK1], 128, k0, nb * 32, 128, scr, lane, [&](int n, bf16*& rowp, float& sc) { sc = 1.f; rowp = dstm + (size_t)(n + (k0 >= 2048 ? 128 : 0)) * 2048 + (k0 & 2047); return true; }); }
        (void)I_E1; (void)I_E2; (void)W1T; (void)W2T;
    }
    const float* x = p.in[I_X]; const float* gm = p.in[I_NMIX];
    for (int m = gw; m < T; m += NGW) {
        const f32x4* xr = (const f32x4*)(x + (size_t)m * DM) + lane; f32x4 v[8]; float s = 0.f;
#pragma unroll
        for (int j = 0; j < 8; ++j) { v[j] = xr[64 * j]; s += (v[j].x * v[j].x + v[j].y * v[j].y) + (v[j].z * v[j].z + v[j].w * v[j].w); }
        const float rstd = 1.f / sqrtf(wave_sum(s) * (1.f / DM) + RMS_EPS);
        float mxr = 0.f;
#pragma unroll
        for (int j = 0; j < 8; ++j) { const f32x4 g4 = ((const f32x4*)gm)[lane + 64 * j]; v[j].x *= rstd * g4.x; v[j].y *= rstd * g4.y; v[j].z *= rstd * g4.z; v[j].w *= rstd * g4.w;
            mxr = fmaxf(mxr, fmaxf(fmaxf(fabsf(v[j].x), fabsf(v[j].y)), fmaxf(fabsf(v[j].z), fabsf(v[j].w)))); }
        mxr = wave_max(mxr); const float qs = mxr > 0.f ? mxr * (1.f / 127.f) : 1.f, qi = 1.f / qs;
        unsigned* o4 = (unsigned*)(p.ws + WS_XN + (size_t)m * DM) + lane;
#pragma unroll
        for (int j = 0; j < 8; ++j) { const float M = 12582912.f;
            const unsigned ua = __builtin_bit_cast(unsigned, v[j].x * qi + M), ub = __builtin_bit_cast(unsigned, v[j].y * qi + M), uc = __builtin_bit_cast(unsigned, v[j].z * qi + M), ud = __builtin_bit_cast(unsigned, v[j].w * qi + M);
            o4[64 * j] = __builtin_amdgcn_perm(ub, ua, 0x0c0c0400u) | (__builtin_amdgcn_perm(ud, uc, 0x0c0c0400u) << 16); }
        if (lane == 0) ((float*)(p.ws + WS_XN + (size_t)T * DM))[m] = qs;
    }
}
#define XB_TMO      128
#define XB_XCNT(j)  (256  + 64 * (j))
#define XB_XSUB(j)  (1280 + 64 * (j))
#define XB_XGEN(j)  (2304 + 64 * (j))
#define XB_TOP      3328
#define XB_TOPGEN   3392
#define XCD_BAR_WORDS 3456
#define XB_SPIN_CAP (1u << 18)

__device__ __forceinline__ unsigned xb_ld(unsigned* p)              { return __hip_atomic_load(p, __ATOMIC_RELAXED, __HIP_MEMORY_SCOPE_AGENT); }
__device__ __forceinline__ unsigned xb_add(unsigned* p, unsigned v) { return __hip_atomic_fetch_add(p, v, __ATOMIC_RELAXED, __HIP_MEMORY_SCOPE_AGENT); }
__device__ __forceinline__ unsigned xb_xcc_id() { return (unsigned)__builtin_amdgcn_s_getreg((3 << 11) | 20) & 0xFu; }
#define XB_SPIN(cond, bar) do { unsigned _sp = 0; while (cond) { __builtin_amdgcn_s_sleep(1); \
    if ((++_sp & 255u) == 0u) { if (xb_ld(&(bar)[XB_TMO])) break; if (_sp > XB_SPIN_CAP) { atomicAdd(&(bar)[XB_TMO], 1u); break; } } } } while (0)

struct XcdBarrier {
    unsigned* bar; unsigned x;
    volatile LAS unsigned* st;
};

__device__ __forceinline__ XcdBarrier xcd_barrier_post(unsigned* bar, volatile LAS unsigned* st) {
    XcdBarrier b; b.bar = bar; b.x = xb_xcc_id(); b.st = st;
    if (threadIdx.x == 0) (void)xb_add(&bar[XB_XCNT(b.x)], 1u);
    return b;
}
__device__ __forceinline__ void xcd_barrier_complete(unsigned* bar, unsigned x, unsigned& nloc, unsigned& nx) {
    const unsigned G = gridDim.x * gridDim.y * gridDim.z;
    unsigned sum, cnt, mine, sp = 0u;
    for (;;) {
        sum = 0u; cnt = 0u; mine = 0u;
#pragma unroll
        for (unsigned j = 0; j < 16; ++j) { const unsigned c = xb_ld(&bar[XB_XCNT(j)]); sum += c; cnt += (c > 0u) ? 1u : 0u; mine = (j == x) ? c : mine; }
        if (sum == G) break;
        __builtin_amdgcn_s_sleep(1);
        if ((++sp & 255u) == 0u) { if (xb_ld(&bar[XB_TMO])) break; if (sp > XB_SPIN_CAP) { atomicAdd(&bar[XB_TMO], 1u); break; } }
    }
    nloc = mine > 0u ? mine : 1u; nx = cnt > 0u ? cnt : 1u;
}

__device__ __forceinline__ void xcd_barrier(const XcdBarrier& b) {
    asm volatile("s_waitcnt vmcnt(0)" ::: "memory");
    __syncthreads();
    if (threadIdx.x == 0) {
        unsigned* bar = b.bar;
        __builtin_amdgcn_s_waitcnt(0);
        unsigned nloc = b.st[0], nx = b.st[1];
        if (nloc == 0u) { xcd_barrier_complete(bar, b.x, nloc, nx); b.st[0] = nloc; b.st[1] = nx; }
        const unsigned old = xb_add(&bar[XB_XSUB(b.x)], 1u);
        const unsigned gen = old / nloc;
        if (old + 1u == (gen + 1u) * nloc) {
            __builtin_amdgcn_fence(__ATOMIC_RELEASE, "agent");
            asm volatile("s_waitcnt vmcnt(0)" ::: "memory");
            const unsigned og = xb_add(&bar[XB_TOP], 1u);
            const unsigned tg = og / nx;
            if (og + 1u == (tg + 1u) * nx) xb_add(&bar[XB_TOPGEN], 1u);
            else XB_SPIN(xb_ld(&bar[XB_TOPGEN]) == tg, bar);
            __builtin_amdgcn_fence(__ATOMIC_ACQUIRE, "agent");
            xb_add(&bar[XB_XGEN(b.x)], 1u);
            asm volatile("s_waitcnt vmcnt(0)" ::: "memory");
        } else {
            XB_SPIN(xb_ld(&bar[XB_XGEN(b.x)]) == gen, bar);
            __builtin_amdgcn_fence(__ATOMIC_ACQUIRE, "agent");
            asm volatile("s_waitcnt vmcnt(0)" ::: "memory");
        }
    }
    __syncthreads();
}

struct ProjOrder : pg8::StaticOrder {
    const bf16* xn; const bf16* wt;
    __device__ __forceinline__ bool next(int i, pg8::Unit& u) const { if (!pg8::StaticOrder::next(i, u)) return false; u.kind = (u.pn >= 21) ? 1 : 0; return true; }
    __device__ __forceinline__ const char* pa(const pg8::Gemm& g, const pg8::Unit& u) const { return u.kind ? (const char*)wt + (size_t)u.pn * ((size_t)256 * g.K * 2) : (const char*)xn + (size_t)u.pm * ((size_t)256 * g.K * 2); }
    __device__ __forceinline__ const char* pb(const pg8::Gemm& g, const pg8::Unit& u) const { return u.kind ? (const char*)xn + (size_t)u.pm * ((size_t)256 * g.K * 2) : (const char*)wt + (size_t)u.pn * ((size_t)256 * g.K * 2); }
};
struct EpiRes {
    static constexpr bool PERM = true, AFTER_DRAIN = false;
    const float* x; bf16* h;
    __device__ __forceinline__ void operator()(const pg8::f32x4 (&acc)[2][2][4][2], const pg8::Unit& u, int wr, int wc, int fr, int fq) const {
        const int row0 = u.pm * 256 + wr * 64 + fr, col0 = u.pn * 256 + wc * 32 + 8 * fq;
#pragma unroll
        for (int ai = 0; ai < 2; ++ai)
#pragma unroll
            for (int m = 0; m < 4; ++m) { const size_t off = (size_t)(row0 + ai * 128 + m * 16) * DM + col0;
#pragma unroll
                for (int bj = 0; bj < 2; ++bj) { const pg8::f32x4 x0 = *(const pg8::f32x4*)(x + off + bj * 128), x1 = *(const pg8::f32x4*)(x + off + bj * 128 + 4);
                    const pg8::f32x4 a0 = x0 + acc[ai][bj][m][0], a1 = x1 + acc[ai][bj][m][1]; pg8::u32x4 w;
                    w.x = pg8::cvt_pk_bf16(a0.x, a0.y); w.y = pg8::cvt_pk_bf16(a0.z, a0.w); w.z = pg8::cvt_pk_bf16(a1.x, a1.y); w.w = pg8::cvt_pk_bf16(a1.z, a1.w);
                    *(pg8::u32x4*)(h + off + bj * 128) = w; } }
    }
};
struct MoeOrder {
    int nM, nN, nwg, G, c; const int* tile_exp;
    __device__ __forceinline__ void init(const int* meta, int nN_, int G_, int c_) { nM = meta[0]; nN = nN_; nwg = nM * nN; G = G_; c = c_; tile_exp = meta + 64; }
    __device__ __forceinline__ bool next(int i, pg8::Unit& u) const {
        const long L = (long)i * G + c; if (L >= nwg) return false;
        pg8::tile_of<8>((int)L, nM, nN, u.pm, u.pn); u.kind = tile_exp[u.pm]; return true;
    }
    __device__ __forceinline__ const char* pa(const pg8::Gemm& g, const pg8::Unit& u) const { return (const char*)g.A + (size_t)u.pm * ((size_t)256 * g.K * 2); }
    __device__ __forceinline__ const char* pb(const pg8::Gemm& g, const pg8::Unit& u) const { return (const char*)g.Bt + ((size_t)u.kind * nN + u.pn) * ((size_t)256 * g.K * 2); }
    __device__ __forceinline__ void a_ready(const pg8::Unit&) const {}
    __device__ __forceinline__ void done(const pg8::Unit&) const {}
};

struct MoeOrderG : MoeOrder { const unsigned short* rowtab;
    __device__ __forceinline__ const char* pa(const pg8::Gemm& g, const pg8::Unit&) const { return (const char*)g.A; } };

__device__ __forceinline__ float gelu_tanh(float x) { const float u = 0.7978845608028654f * (x + 0.044715f * x * x * x); const float e = __expf(2.f * u); return 0.5f * x * (1.f + (1.f - 2.f / (e + 1.f))); }
__device__ __forceinline__ void ph_cmp_fin_simple(const Params& p, LAS float* tl, int id, int n, const float* LHall, const float* PEVall) {
    LAS float* hid = tl + 4096;
    const int which = id / (16 * 255), rem = id % (16 * 255), bg = rem / 255, c = rem % 255;
    const float* w2 = p.in[which ? I_WV2 : I_WK2];
    const float* LH = LHall + ((size_t)which * 4096 + bg * 256) * 256;
    float pev = 0.f;
#pragma unroll 8
    for (int q = 0; q < 64; ++q) pev += PEVall[(size_t)(which * 64 + q) * 128 + n];
    const float a = LH[(size_t)c * 256 + n] + LH[(size_t)(c + 1) * 256 + 128 + n] + pev;
    hid[n] = gelu_tanh(a);
    __syncthreads();
    float o = 0.f;
    for (int m = 0; m < 128; ++m) o += hid[m] * w2[m * 128 + n];
    if (which == 0) ((bf16*)(p.ws + WS_KCMP))[((size_t)bg * 256 + c) * 128 + n] = (bf16)f2bf(o);
    else ((bf16*)(p.ws + WS_VCMPT))[((size_t)bg * 128 + n) * 256 + c] = (bf16)f2bf(o);
}

namespace nsa {
constexpr int KB0 = 0, KB1 = 16384, VB0 = 32768, VB1 = 49152, LUT = 65536;
constexpr int QST = LUT + 4096, IMP = QST + 65536, SELM = IMP + 16384, LDS_END = SELM + 512;
constexpr float LOG2E = 1.4426950408889634f;
typedef float f4 __attribute__((ext_vector_type(4)));

typedef unsigned u2v __attribute__((ext_vector_type(2)));
__device__ __forceinline__ float rmax16(float x) { const unsigned u = __float_as_uint(x); const u2v r = __builtin_amdgcn_permlane16_swap(u, u, false, false); return fmaxf(__uint_as_float(r[0]), __uint_as_float(r[1])); }
__device__ __forceinline__ float rmax32(float x) { const unsigned u = __float_as_uint(x); const u2v r = __builtin_amdgcn_permlane32_swap(u, u, false, false); return fmaxf(__uint_as_float(r[0]), __uint_as_float(r[1])); }
__device__ __forceinline__ float radd16(float x) { const unsigned u = __float_as_uint(x); const u2v r = __builtin_amdgcn_permlane16_swap(u, u, false, false); return __uint_as_float(r[0]) + __uint_as_float(r[1]); }
__device__ __forceinline__ float radd32(float x) { const unsigned u = __float_as_uint(x); const u2v r = __builtin_amdgcn_permlane32_swap(u, u, false, false); return __uint_as_float(r[0]) + __uint_as_float(r[1]); }
__device__ __forceinline__ float raddq(float x) { x += __int_as_float(__builtin_amdgcn_update_dpp(0, __float_as_int(x), 0xB1, 0xF, 0xF, true)); x += __int_as_float(__builtin_amdgcn_update_dpp(0, __float_as_int(x), 0x4E, 0xF, 0xF, true)); return x; }
struct Ctx {
    LAS unsigned char* lds; int tid, lane, wave, c, gq, r;
    int s0, cur;
    const LAS unsigned char* qst;
    int pos0;
    const LAS float* lutrow;
    int koff0, voff0;
    unsigned kdo[2], vdoc[2], vdos[2];
};
__device__ __forceinline__ void dma_k(const Ctx& C, const bf16* kt, LAS unsigned char* kb) {
#pragma unroll
    for (int i = 0; i < 2; ++i) __builtin_amdgcn_global_load_lds((const unsigned*)((const char*)kt + C.kdo[i]), (LAS unsigned*)(kb + (2 * C.wave + i) * 1024), 16, 0, 0); }
__device__ __forceinline__ void dma_v(const Ctx& C, const bf16* vt, const unsigned (&vdo)[2], LAS unsigned char* vb) {
#pragma unroll
    for (int i = 0; i < 2; ++i) __builtin_amdgcn_global_load_lds((const unsigned*)((const char*)vt + vdo[i]), (LAS unsigned*)(vb + (2 * C.wave + i) * 1024), 16, 0, 0); }

__device__ __forceinline__ void compute_st(const Ctx& C, const LAS unsigned char* kb, f4 (&s)[2][4]) {
#pragma unroll
    for (int ks = 0; ks < 4; ++ks) { const bf16x8 q0 = *(const LAS bf16x8*)(C.qst + ks * 1024), q1 = *(const LAS bf16x8*)(C.qst + (4 + ks) * 1024);
#pragma unroll
        for (int kt = 0; kt < 4; ++kt) { const bf16x8 a = *(const LAS bf16x8*)(kb + kt * 4096 + (C.koff0 ^ (ks * 64)));
            s[0][kt] = __builtin_amdgcn_mfma_f32_16x16x32_bf16(a, q0, ks == 0 ? (f4){0.f, 0.f, 0.f, 0.f} : s[0][kt], 0, 0, 0);
            s[1][kt] = __builtin_amdgcn_mfma_f32_16x16x32_bf16(a, q1, ks == 0 ? (f4){0.f, 0.f, 0.f, 0.f} : s[1][kt], 0, 0, 0); }
        asm volatile("" ::: "memory"); }
}
__device__ __forceinline__ void compute_pv(const Ctx& C, const LAS unsigned char* vb, const f4 (&p)[2][4], f4 (&o)[2][8]) {
#pragma unroll
    for (int i = 0; i < 2; ++i) { bf16x8 pb[2];
#pragma unroll
        for (int qt = 0; qt < 2; ++qt) { v4u w; w.x = pg8::cvt_pk_bf16(p[qt][2 * i][0], p[qt][2 * i][1]); w.y = pg8::cvt_pk_bf16(p[qt][2 * i][2], p[qt][2 * i][3]);
            w.z = pg8::cvt_pk_bf16(p[qt][2 * i + 1][0], p[qt][2 * i + 1][1]); w.w = pg8::cvt_pk_bf16(p[qt][2 * i + 1][2], p[qt][2 * i + 1][3]); pb[qt] = __builtin_bit_cast(bf16x8, w); }
#pragma unroll
        for (int dt = 0; dt < 8; ++dt) { const v2u lo = *(const LAS v2u*)(vb + dt * 2048 + (C.voff0 ^ (i * 64))), hi = *(const LAS v2u*)(vb + dt * 2048 + (C.voff0 ^ (i * 64 + 32))); const bf16x8 a = __builtin_bit_cast(bf16x8, (v4u){lo.x, lo.y, hi.x, hi.y});
#pragma unroll
            for (int qt = 0; qt < 2; ++qt) o[qt][dt] = __builtin_amdgcn_mfma_f32_16x16x32_bf16(a, pb[qt], o[qt][dt], 0, 0, 0);
            if (dt & 1) asm volatile("" ::: "memory"); } }
}
enum { M_CMP = 0, M_SEL = 1, M_WIN = 2 };
template <int MODE, bool FAR = false>
__device__ __forceinline__ void mask_bias(const Ctx& C, f4 (&s)[2][4], int kb, int n, const LAS unsigned* selw) {
    const float NEG = -__builtin_inff();
#pragma unroll
    for (int qt = 0; qt < 2; ++qt) {
        bool tokok = true;
        if (MODE == M_SEL) tokok = ((selw[(4 * qt + (C.c >> 2)) * 2 + (n >> 5)] >> (n & 31)) & 1u) != 0u;
        if (FAR) { const float be = tokok ? C.lutrow[127] : NEG;
#pragma unroll
            for (int kt = 0; kt < 4; ++kt)
#pragma unroll
                for (int rg = 0; rg < 4; ++rg) s[qt][kt][rg] = __builtin_fmaf(s[qt][kt][rg], LOG2E, be);
            continue; }
        const int dbase = (MODE == M_CMP) ? (C.pos0 + 4 * qt - 31 - 16 * (kb + 4 * C.gq)) : (C.pos0 + 4 * qt - (kb + 4 * C.gq));
#pragma unroll
        for (int kt = 0; kt < 4; ++kt) {
#pragma unroll
            for (int rg = 0; rg < 4; ++rg) { const int d = (MODE == M_CMP) ? dbase - 16 * (16 * kt + rg) : dbase - (16 * kt + rg);
                int di = d < 0 ? 0 : d; di = di > 127 ? 127 : di; const float bias = C.lutrow[di];
                bool ok = tokok && d >= 0; if (MODE == M_WIN) ok = ok && d < 512;
                s[qt][kt][rg] = ok ? __builtin_fmaf(s[qt][kt][rg], LOG2E, bias) : NEG; }
            asm volatile("" ::: "memory"); }
    }
}
__device__ __forceinline__ void softmax_step(f4 (&s)[2][4], float (&m)[2], float (&l)[2], f4 (&o)[2][8], bool rescale_o) {
#pragma unroll
    for (int qt = 0; qt < 2; ++qt) { float mx = s[qt][0][0];
#pragma unroll
        for (int kt = 0; kt < 4; ++kt)
#pragma unroll
            for (int rg = 0; rg < 4; ++rg) mx = fmaxf(mx, s[qt][kt][rg]);
        mx = rmax32(rmax16(mx));
        const float mn = fmaxf(m[qt], mx), alpha = __builtin_amdgcn_exp2f(m[qt] - mn); m[qt] = mn; float ps = 0.f;
#pragma unroll
        for (int kt = 0; kt < 4; ++kt)
#pragma unroll
            for (int rg = 0; rg < 4; ++rg) { const float e = __builtin_amdgcn_exp2f(s[qt][kt][rg] - mn); s[qt][kt][rg] = e; ps += e; }
        l[qt] = l[qt] * alpha + ps;
        if (rescale_o && __any(alpha != 1.f)) {
#pragma unroll
            for (int dt = 0; dt < 8; ++dt) o[qt][dt] = o[qt][dt] * alpha; }
    }
}
template <int MODE>
__device__ __forceinline__ void softmax_far(const Ctx& C, f4 (&s)[2][4], int n, const LAS unsigned* selw, float (&m)[2], float (&l)[2], f4 (&o)[2][8]) {
    const float b31 = C.lutrow[127];
#pragma unroll
    for (int qt = 0; qt < 2; ++qt) {
        float be = b31;
        if (MODE == M_SEL) { const bool tokok = ((selw[(4 * qt + (C.c >> 2)) * 2 + (n >> 5)] >> (n & 31)) & 1u) != 0u; be = tokok ? b31 : -__builtin_inff(); }
        float mx = fmaxf(fmaxf(s[qt][0][0], s[qt][0][1]), fmaxf(s[qt][0][2], s[qt][0][3]));
#pragma unroll
        for (int kt = 1; kt < 4; ++kt) mx = fmaxf(mx, fmaxf(fmaxf(s[qt][kt][0], s[qt][kt][1]), fmaxf(s[qt][kt][2], s[qt][kt][3])));
        mx = rmax32(rmax16(mx));
        const float mt = __builtin_fmaf(mx, LOG2E, be), mn = fmaxf(m[qt], mt), alpha = __builtin_amdgcn_exp2f(m[qt] - mn), c0 = be - mn; m[qt] = mn; float ps = 0.f;
#pragma unroll
        for (int kt = 0; kt < 4; ++kt)
#pragma unroll
            for (int rg = 0; rg < 4; ++rg) { const float e = __builtin_amdgcn_exp2f(__builtin_fmaf(s[qt][kt][rg], LOG2E, c0)); s[qt][kt][rg] = e; ps += e; }
        l[qt] = l[qt] * alpha + ps;
        if (__any(alpha != 1.f)) {
#pragma unroll
            for (int dt = 0; dt < 8; ++dt) o[qt][dt] = o[qt][dt] * alpha; }
    }
}
}

__device__ __forceinline__ void ph_nsa(const Params& p, LAS unsigned char* lds, int idx0, int idxstride, int tid_in, int wave) {
    using namespace nsa;
    int tid = tid_in; asm volatile("" : "+v"(tid));
    const int lane = tid & 63;
    Ctx C; C.lds = lds; C.tid = tid; C.lane = lane; C.wave = wave; C.c = lane & 15; C.gq = lane >> 4; C.r = lane & 3;
    C.koff0 = C.c * 256 + ((C.gq ^ C.c) * 16);
#pragma unroll
    for (int i = 0; i < 2; ++i) { const int piece = 2 * wave + i;
        { const int row = piece * 4 + (lane >> 4), chunk = (lane & 15) ^ (row & 15); C.kdo[i] = (unsigned)(row * 256 + chunk * 16); }
        { const int row = piece * 8 + (lane >> 3), chunk = (lane & 7) ^ ((row >> 1) & 7); C.vdoc[i] = (unsigned)(row * 256 * 2 + chunk * 16); C.vdos[i] = (unsigned)(row * SEQ * 2 + chunk * 16); } }
    C.voff0 = C.c * 128 + (((C.gq >> 1) ^ ((C.c >> 1) & 7)) * 16) + (C.gq & 1) * 8;
    const bf16* NQ = (const bf16*)(p.ws + WS_NQ); const bf16* SM = (const bf16*)(p.ws + WS_SM); bf16* A2 = (bf16*)(p.ws + WS_A2);
    const float* relb = p.in[I_RELB]; const float* nsag = p.in[I_NSAG];
    LAS float* lut = (LAS float*)(lds + LUT);
    for (int i = tid; i < 8 * 128; i += 512) { const int hh = i >> 7, d = i & 127; lut[i] = relb[(int)kBucket[d] * 8 + hh] * LOG2E; }
    __syncthreads();
    LAS unsigned char* qstw = lds + QST + wave * 8192 + lane * 16; C.qst = qstw;
    LAS float* imp = (LAS float*)(lds + IMP + wave * 2048);
    LAS unsigned long long* selm = (LAS unsigned long long*)(lds + SELM + wave * 64);
#define NSA_SYNC() do { asm volatile("s_waitcnt vmcnt(0)" ::: "memory"); __syncthreads(); } while (0)
    for (int idx = idx0; idx < 512; idx += idxstride) {
        const int rnd = idx >> 8, kq = idx & 255, b = kq & 7, tq = rnd == 0 ? 63 - (kq >> 3) : (kq >> 3);
        C.s0 = tq * 64; C.cur = tq;
        const int tokl0 = 8 * wave + (C.c >> 2);
        C.pos0 = C.s0 + tokl0;
        float ssq[2] = {0.f, 0.f};
        for (int g = 0; g < 2; ++g) {
            const int bg = b * 2 + g, h = g * 4 + C.r;
            C.lutrow = lut + h * 128;
            const bf16* KCMP = (const bf16*)(p.ws + WS_KCMP) + (size_t)bg * 256 * 128; const bf16* VCMPT = (const bf16*)(p.ws + WS_VCMPT) + (size_t)bg * 128 * 256;
#pragma unroll
            for (int qt = 0; qt < 2; ++qt) { const unsigned qo = (unsigned)(((b * SEQ + (C.pos0 + 4 * qt)) * 1024 + h * 128 + 8 * C.gq) * 2);
#pragma unroll
                for (int ks = 0; ks < 4; ++ks) *(LAS bf16x8*)(qstw + (qt * 4 + ks) * 1024) = *(const bf16x8*)((const char*)NQ + qo + ks * 64); }
#pragma unroll
            for (int i = 0; i < 2; ++i) *(LAS f32x4*)((LAS unsigned char*)imp + lane * 16 + i * 1024) = (f32x4){0.f, 0.f, 0.f, 0.f};
#define NSA_OROW(qt) ((char*)A2 + (unsigned)(((b * SEQ + C.pos0 + 4 * (qt)) * DM + 1024 + h * 128 + 4 * C.gq) * 2))
            const int cmaxb = C.s0 + 63 - 31; const int nct = cmaxb >= 0 ? ((cmaxb >> 4) >> 6) + 1 : 0;
            float m[2] = {-1e30f, -1e30f}, l[2] = {0.f, 0.f};
            f4 o[2][8];
            if (nct > 0) {
                dma_k(C, KCMP, lds + KB0); NSA_SYNC();
                for (int ct = 0; ct < nct; ++ct) { const int buf = ct & 1;
                    if (ct + 1 < nct) dma_k(C, KCMP + (ct + 1) * 64 * 128, lds + (buf ? KB0 : KB1));
                    f4 s[2][4]; compute_st(C, lds + (buf ? KB1 : KB0), s); mask_bias<M_CMP>(C, s, 64 * ct, 0, (const LAS unsigned*)selm); softmax_step(s, m, l, o, false);
                    NSA_SYNC(); }
            }
            float inv[2];
#pragma unroll
            for (int qt = 0; qt < 2; ++qt) { const float lt = radd32(radd16(l[qt])); inv[qt] = lt > 0.f ? 1.f / lt : 0.f; }
#pragma unroll
            for (int qt = 0; qt < 2; ++qt)
#pragma unroll
                for (int dt = 0; dt < 8; ++dt) o[qt][dt] = (f4){0.f, 0.f, 0.f, 0.f};
            if (nct > 0) {
                dma_k(C, KCMP, lds + KB0); dma_v(C, VCMPT, C.vdoc, lds + VB0); NSA_SYNC();
                for (int ct = 0; ct < nct; ++ct) { const int buf = ct & 1;
                    if (ct + 1 < nct) { dma_k(C, KCMP + (ct + 1) * 64 * 128, lds + (buf ? KB0 : KB1)); dma_v(C, VCMPT + 64 * (ct + 1), C.vdoc, lds + (buf ? VB0 : VB1)); }
                    f4 s[2][4]; compute_st(C, lds + (buf ? KB1 : KB0), s); mask_bias<M_CMP>(C, s, 64 * ct, 0, (const LAS unsigned*)selm);
#pragma unroll
                    for (int qt = 0; qt < 2; ++qt)
#pragma unroll
                        for (int kt = 0; kt < 4; ++kt) {
#pragma unroll
                            for (int rg = 0; rg < 4; ++rg) s[qt][kt][rg] = __builtin_amdgcn_exp2f(s[qt][kt][rg] - m[qt]) * inv[qt];
                            float po = (s[qt][kt][0] + s[qt][kt][1]) + (s[qt][kt][2] + s[qt][kt][3]), p3 = s[qt][kt][3];
                            po = raddq(po); p3 = raddq(p3);
                            const int nb = 16 * ct + 4 * kt + C.gq, tl = 4 * qt + (C.c >> 2);
                            if (C.r == 0) { __hip_atomic_fetch_add((float*)(imp + tl * 64 + nb), po, __ATOMIC_RELAXED, __HIP_MEMORY_SCOPE_WORKGROUP); if (nb + 1 < 64) __hip_atomic_fetch_add((float*)(imp + tl * 64 + nb + 1), p3, __ATOMIC_RELAXED, __HIP_MEMORY_SCOPE_WORKGROUP); } }
                    compute_pv(C, lds + (buf ? VB1 : VB0), s, o);
                    NSA_SYNC(); }
            }
            LDS_WAIT(); __builtin_amdgcn_wave_barrier();
            for (int tk = 0; tk < 8; ++tk) { const int n = lane; float sc;
                if (n == 0 || n == C.cur || n == C.cur - 1) sc = 1e4f; else if (n <= C.cur) sc = imp[tk * 64 + n]; else sc = -1.f;
                const int key = ((sc < 0.f ? 0 : __float_as_int(sc) + 64) & ~63) | (63 - n);
                int rank = 0;
#pragma unroll
                for (int mm = 0; mm < 64; ++mm) rank += (__builtin_amdgcn_readlane(key, mm) > key) ? 1 : 0;
                const unsigned long long mk = __ballot(rank < 16);
                if (lane == 0) selm[tk] = mk; }
            LDS_WAIT(); __builtin_amdgcn_wave_barrier();
#pragma unroll
            for (int qt = 0; qt < 2; ++qt) { const float gt = 1.f / (1.f + __expf(-bf2f(*(const bf16*)((const char*)SM + (unsigned)(((b * SEQ + (C.pos0 + 4 * qt)) * 64 + 16 + h) * 2)))));
#pragma unroll
                for (int dt = 0; dt < 8; ++dt) { const f4 v = o[qt][dt] * gt; *(v2u*)(NSA_OROW(qt) + 32 * dt) = (v2u){pg8::cvt_pk_bf16(v[0], v[1]), pg8::cvt_pk_bf16(v[2], v[3])}; } }
#pragma unroll
            for (int br = 1; br <= 2; ++br) {
                const bf16* KX = (const bf16*)(p.ws + (br == 1 ? WS_KS : WS_KW)) + bg * SEQ * 128; const bf16* VX = (const bf16*)(p.ws + (br == 1 ? WS_VST : WS_VWT)) + bg * 128 * SEQ;
                const int n0 = br == 1 ? 0 : (C.cur >= 8 ? C.cur - 8 : 0), n1 = C.cur;
                m[0] = m[1] = -1e30f; l[0] = l[1] = 0.f;
#pragma unroll
                for (int qt = 0; qt < 2; ++qt)
#pragma unroll
                    for (int dt = 0; dt < 8; ++dt) o[qt][dt] = (f4){0.f, 0.f, 0.f, 0.f};
                int f0 = n1 + 1, f1 = n0 - 1;
                for (int n = n0; n <= n1; ++n) { const bool fa = (C.s0 - (64 * n + 63) >= 113) && (br == 1 || (C.s0 + 63 - 64 * n) < 512); if (fa) { f0 = n < f0 ? n : f0; f1 = n; } }
                const int cntf = f1 >= f0 ? f1 - f0 + 1 : 0, cnt = n1 - n0 + 1, nlo = cntf ? f0 - n0 : cnt;
#define NSA_TILE(i) ((i) < cntf ? f0 + (i) : (((i) - cntf) < nlo ? n0 + ((i) - cntf) : f1 + 1 + ((i) - cntf - nlo)))
#define NSA_BODY(FARF) { const int n = NSA_TILE(i); const int buf = i & 1; \
                    if (i + 1 < cnt) { const int nn = NSA_TILE(i + 1); dma_k(C, KX + nn * 64 * 128, lds + (buf ? KB0 : KB1)); dma_v(C, VX + 64 * nn, C.vdos, lds + (buf ? VB0 : VB1)); } \
                    bool need = true; \
                    if (br == 1) { const unsigned any = ((const LAS unsigned*)selm)[(lane & 7) * 2 + (n >> 5)] >> (n & 31); need = __any((int)(any & 1u)); } \
                    if (need) { f4 s[2][4]; compute_st(C, lds + (buf ? KB1 : KB0), s); \
                        if (FARF) { if (br == 1) softmax_far<M_SEL>(C, s, n, (const LAS unsigned*)selm, m, l, o); else softmax_far<M_WIN>(C, s, n, (const LAS unsigned*)selm, m, l, o); } \
                        else { if (br == 1) mask_bias<M_SEL, false>(C, s, 64 * n, n, (const LAS unsigned*)selm); else mask_bias<M_WIN, false>(C, s, 64 * n, n, (const LAS unsigned*)selm); \
                            softmax_step(s, m, l, o, true); } \
                        compute_pv(C, lds + (buf ? VB1 : VB0), s, o); } \
                    NSA_SYNC(); }
                { const int nf = NSA_TILE(0); dma_k(C, KX + nf * 64 * 128, lds + KB0); dma_v(C, VX + 64 * nf, C.vdos, lds + VB0); NSA_SYNC(); }
                int i = 0;
                for (; i < cntf; ++i) NSA_BODY(true)
                for (; i < cnt; ++i) NSA_BODY(false)
#undef NSA_BODY
#undef NSA_TILE
                asm volatile("s_waitcnt vmcnt(0)" ::: "memory");
#pragma unroll
                for (int qt = 0; qt < 2; ++qt) { const float lt = radd32(radd16(l[qt]));
                    const int row = b * SEQ + (C.pos0 + 4 * qt);
                    const float sc = (1.f / (1.f + __expf(-bf2f(*(const bf16*)((const char*)SM + (unsigned)((row * 64 + 16 + 8 * br + h) * 2)))))) / lt;
#pragma unroll
                    for (int dt = 0; dt < 8; ++dt) { const f4 v = o[qt][dt] * sc; v2u* sp = (v2u*)(NSA_OROW(qt) + 32 * dt); const v2u pv = *sp;
                        const float a0 = bflo(pv.x) + v[0], a1 = bfhi(pv.x) + v[1], a2 = bflo(pv.y) + v[2], a3 = bfhi(pv.y) + v[3];
                        if (br == 2) ssq[qt] += (a0 * a0 + a1 * a1) + (a2 * a2 + a3 * a3);
                        *sp = (v2u){pg8::cvt_pk_bf16(a0, a1), pg8::cvt_pk_bf16(a2, a3)}; } }
            }
        }
        float rstd[2];
#pragma unroll
        for (int qt = 0; qt < 2; ++qt) { const float t = radd32(radd16(raddq(ssq[qt]))); rstd[qt] = 1.f / sqrtf(t * (1.f / 1024.f) + RMS_EPS); }
        asm volatile("s_waitcnt vmcnt(0)" ::: "memory");
#pragma unroll
        for (int qt = 0; qt < 2; ++qt) { const int sub = C.r * 4 + C.gq; bf16* orow = (bf16*)((char*)A2 + (unsigned)(((b * SEQ + (C.pos0 + 4 * qt)) * DM + 1024) * 2 + sub * 16)); const int subz = 0;
#pragma unroll
            for (int j = 0; j < 8; ++j) { const int col = (j * 16 + subz) * 8; v4u w = *(const v4u*)((const char*)orow + (unsigned)(col * 2)); const f32x4 g0 = *(const f32x4*)((const char*)nsag + (unsigned)(col * 4 + sub * 32)), g1 = *(const f32x4*)((const char*)nsag + (unsigned)(col * 4 + sub * 32 + 16)); const float rs = rstd[qt];
                w.x = pk2(bflo(w.x) * rs * g0.x, bfhi(w.x) * rs * g0.y); w.y = pk2(bflo(w.y) * rs * g0.z, bfhi(w.y) * rs * g0.w); w.z = pk2(bflo(w.z) * rs * g1.x, bfhi(w.z) * rs * g1.y); w.w = pk2(bflo(w.w) * rs * g1.z, bfhi(w.w) * rs * g1.w);
                *(v4u*)((char*)orow + (unsigned)(col * 2)) = w; } }
        NSA_SYNC();
    }
#undef NSA_SYNC
#undef NSA_OROW
}

constexpr size_t WS_ST = WS_LA;
constexpr size_t WS_DEC = WS_ST + (size_t)2048 * 256 * 128 * 2;
static_assert(WS_DEC + (size_t)2048 * 128 * 4 <= WS_KCMP, "gla scratch overlay");
namespace gla {
typedef float f4 __attribute__((ext_vector_type(4)));
constexpr int L_ST = 0, L_KT = 65536, L_QT = 81920, L_VT = 98304, L_GA = 131072, L_GT = L_GA + 4096, L_RED = L_GT + 2048, L_END = L_RED + 512;
__device__ __forceinline__ void chunk_cumsum(const Params& p, LAS unsigned char* lds, int tid, int t0, int h, float (&P)[16], float& blast) {
    const bf16* SM = (const bf16*)(p.ws + WS_SM); const float* wa2 = p.in[I_WA2]; const float* ba = p.in[I_BA];
    LAS float* ga = (LAS float*)(lds + L_GA); LAS float* gt = (LAS float*)(lds + L_GT);
    if (tid < 128) { const int j = tid >> 1, hf = tid & 1; const v4u w = *(const v4u*)((const char*)SM + (unsigned)(((t0 + j) * 64 + hf * 8) * 2));
        LAS float* d = ga + j * 16 + hf * 8; d[0] = bflo(w.x); d[1] = bfhi(w.x); d[2] = bflo(w.y); d[3] = bfhi(w.y); d[4] = bflo(w.z); d[5] = bfhi(w.z); d[6] = bflo(w.w); d[7] = bfhi(w.w); }
    const int dk = tid & 127, jq = tid >> 7;
    float w[16];
#pragma unroll
    for (int r = 0; r < 16; ++r) w[r] = wa2[r * 512 + h * 128 + dk];
    const float bb = ba[h * 128 + dk];
    __syncthreads();
    float run = 0.f;
#pragma unroll
    for (int jj = 0; jj < 16; ++jj) { const LAS f32x4* gr = (const LAS f32x4*)(ga + (16 * jq + jj) * 16); float z = bb;
#pragma unroll
        for (int r4 = 0; r4 < 4; ++r4) { const f32x4 g4 = gr[r4]; z += g4.x * w[4 * r4] + g4.y * w[4 * r4 + 1] + g4.z * w[4 * r4 + 2] + g4.w * w[4 * r4 + 3]; }
        run += (fminf(z, 0.f) - log1pf(__expf(-fabsf(z)))) * (1.f / 16.f); P[jj] = run; }
    gt[jq * 128 + dk] = run;
    __syncthreads();
    float off = 0.f, tot = 0.f;
#pragma unroll
    for (int q = 0; q < 4; ++q) { const float t = gt[q * 128 + dk]; tot += t; if (q < jq) off += t; }
#pragma unroll
    for (int jj = 0; jj < 16; ++jj) P[jj] += off;
    blast = tot;
}
__device__ __forceinline__ void stage_raw_k(const bf16* src  , LAS unsigned char* dst, int tid, int t0, int h) {
#pragma unroll
    for (int q = 0; q < 2; ++q) { const int id = tid + 512 * q, j = id >> 4, c16 = id & 15; *(LAS v4u*)(dst + j * 256 + c16 * 16) = *(const v4u*)((const char*)src + (unsigned)(((t0 + j) * 512 + h * 128 + c16 * 8) * 2)); }
}
__device__ __forceinline__ void stage_raw_v(const Params& p, LAS unsigned char* dst, int tid, int t0, int h) {
    const bf16* GV = (const bf16*)(p.ws + WS_GV);
#pragma unroll
    for (int q = 0; q < 4; ++q) { const int id = tid + 512 * q, j = id >> 5, c = id & 31; *(LAS v4u*)(dst + j * 512 + c * 16) = *(const v4u*)((const char*)GV + (unsigned)(((t0 + j) * 1024 + h * 256 + c * 8) * 2)); }
}
__device__ __forceinline__ void fill_vt(LAS unsigned char* lds, const LAS unsigned char* rv, int tid) {
    const int dv = tid & 255, jh = tid >> 8;
    unsigned short v[32];
#pragma unroll
    for (int jj = 0; jj < 32; ++jj) v[jj] = *(const LAS bf16*)(rv + (32 * jh + jj) * 512 + dv * 2);
    LAS unsigned char* row = lds + L_VT + dv * 128; const int f = (dv >> 1) & 7;
#pragma unroll
    for (int q = 0; q < 4; ++q) { v4u w; w.x = v[8 * q] | ((unsigned)v[8 * q + 1] << 16); w.y = v[8 * q + 2] | ((unsigned)v[8 * q + 3] << 16); w.z = v[8 * q + 4] | ((unsigned)v[8 * q + 5] << 16); w.w = v[8 * q + 6] | ((unsigned)v[8 * q + 7] << 16);
        *(LAS v4u*)(row + (((4 * jh + q) ^ f) * 16)) = w; }
}
}

__device__ __forceinline__ void ph_gla_a(const Params& p, LAS unsigned char* lds, int u0, int ustride, int tid_in, int wave) {
    using namespace gla;
    int tid = tid_in; asm volatile("" : "+v"(tid));
    const int lane = tid & 63, c = lane & 15, gq = lane >> 4;
    const bf16* GK = (const bf16*)(p.ws + WS_GK); bf16* ST = (bf16*)(p.ws + WS_ST); float* DEC = (float*)(p.ws + WS_DEC);
    for (int unit = u0; unit < 2048; unit += ustride) {
        const int bh = unit >> 6, ch = unit & 63, b = bh >> 2, h = bh & 3, t0 = b * SEQ + ch * 64;
        stage_raw_k(GK, lds + 0, tid, t0, h); stage_raw_v(p, lds + 16384, tid, t0, h);
        float P[16], blast; chunk_cumsum(p, lds, tid, t0, h, P, blast);
        { const int dk = tid & 127, jq = tid >> 7;
          unsigned short kv[16];
#pragma unroll
          for (int jj = 0; jj < 16; ++jj) kv[jj] = *(const LAS bf16*)(lds + (16 * jq + jj) * 256 + dk * 2);
          unsigned pk[8];
#pragma unroll
          for (int q = 0; q < 8; ++q) pk[q] = pk2(bf2f(kv[2 * q]) * __expf(blast - P[2 * q]), bf2f(kv[2 * q + 1]) * __expf(blast - P[2 * q + 1]));
          LAS unsigned char* row = lds + L_KT + dk * 128; const int f = (dk >> 1) & 7;
          *(LAS v4u*)(row + (((2 * jq) ^ f) * 16)) = (v4u){pk[0], pk[1], pk[2], pk[3]}; *(LAS v4u*)(row + (((2 * jq + 1) ^ f) * 16)) = (v4u){pk[4], pk[5], pk[6], pk[7]};
          if (jq == 0) DEC[unit * 128 + dk] = __expf(blast); }
        fill_vt(lds, lds + 16384, tid);
        __syncthreads();
        f4 acc[16];
        const int f = (c >> 1) & 7;
        bf16x8 aF[2];
#pragma unroll
        for (int ks = 0; ks < 2; ++ks) aF[ks] = *(const LAS bf16x8*)(lds + L_KT + (16 * wave + c) * 128 + (((4 * ks + gq) ^ f) * 16));
#pragma unroll
        for (int nt = 0; nt < 16; ++nt) { acc[nt] = (f4){0.f, 0.f, 0.f, 0.f};
#pragma unroll
            for (int ks = 0; ks < 2; ++ks) { const bf16x8 bF = *(const LAS bf16x8*)(lds + L_VT + (16 * nt + c) * 128 + (((4 * ks + gq) ^ f) * 16)); acc[nt] = __builtin_amdgcn_mfma_f32_16x16x32_bf16(aF[ks], bF, acc[nt], 0, 0, 0); } }
        char* dst = (char*)ST + (size_t)unit * (256 * 128 * 2) + (unsigned)((c * 128 + 16 * wave + 4 * gq) * 2);
#pragma unroll
        for (int nt = 0; nt < 16; ++nt) *(v2u*)(dst + nt * 16 * 256) = (v2u){pg8::cvt_pk_bf16(acc[nt][0], acc[nt][1]), pg8::cvt_pk_bf16(acc[nt][2], acc[nt][3])};
        __syncthreads();
    }
}
__device__ __forceinline__ void ph_gla_b(const Params& p, int gid, int gstride) {
    bf16* ST = (bf16*)(p.ws + WS_ST); const float* DEC = (const float*)(p.ws + WS_DEC);
    for (int e = gid; e < 32 * 4096; e += gstride) { const int bh = e >> 12, dv = (e >> 4) & 255, d8 = e & 15;
        float st[8];
#pragma unroll
        for (int i = 0; i < 8; ++i) st[i] = 0.f;
        char* base = (char*)ST + (size_t)bh * 64 * (256 * 128 * 2) + (unsigned)((dv * 128 + d8 * 8) * 2); const float* dbase = DEC + (size_t)bh * 64 * 128 + d8 * 8;
#pragma unroll 4
        for (int ch = 0; ch < 64; ++ch) { v4u* ptr = (v4u*)(base + (size_t)ch * (256 * 128 * 2)); const v4u w = *ptr; const f32x4 d0 = *(const f32x4*)(dbase + ch * 128), d1 = *(const f32x4*)(dbase + ch * 128 + 4);
            v4u o; o.x = pk2(st[0], st[1]); o.y = pk2(st[2], st[3]); o.z = pk2(st[4], st[5]); o.w = pk2(st[6], st[7]); *ptr = o;
            st[0] = st[0] * d0.x + bflo(w.x); st[1] = st[1] * d0.y + bfhi(w.x); st[2] = st[2] * d0.z + bflo(w.y); st[3] = st[3] * d0.w + bfhi(w.y);
            st[4] = st[4] * d1.x + bflo(w.z); st[5] = st[5] * d1.y + bfhi(w.z); st[6] = st[6] * d1.z + bflo(w.w); st[7] = st[7] * d1.w + bfhi(w.w); }
    }
}
__device__ __forceinline__ void ph_gla_c(const Params& p, LAS unsigned char* lds, int u0, int ustride, int tid_in, int wave) {
    using namespace gla;
    int tid = tid_in; asm volatile("" : "+v"(tid));
    const int lane = tid & 63, c = lane & 15, gq = lane >> 4, nt = wave & 3, half = wave >> 2;
    const bf16* GQ = (const bf16*)(p.ws + WS_GQ); const bf16* GK = (const bf16*)(p.ws + WS_GK); const bf16* GG = (const bf16*)(p.ws + WS_GG); const bf16* ST = (const bf16*)(p.ws + WS_ST);
    bf16* A2 = (bf16*)(p.ws + WS_A2); const float* gn = p.in[I_GLAG];
    const int koff0 = c * 256 + ((gq ^ c) * 16), voff0 = c * 128 + (((gq >> 1) ^ ((c >> 1) & 7)) * 16) + (gq & 1) * 8;
    for (int unit = u0; unit < 2048; unit += ustride) {
        const int bh = unit >> 6, ch = unit & 63, b = bh >> 2, h = bh & 3, t0 = b * SEQ + ch * 64;
        stage_raw_k(GQ, lds + 0, tid, t0, h); stage_raw_k(GK, lds + 16384, tid, t0, h); stage_raw_v(p, lds + 32768, tid, t0, h);
        float P[16], blast; chunk_cumsum(p, lds, tid, t0, h, P, blast);
        { const int dk = tid & 127, jq = tid >> 7;
#pragma unroll
          for (int jj = 0; jj < 16; ++jj) { const int j = 16 * jq + jj; const float qv = bf2f(*(const LAS bf16*)(lds + j * 256 + dk * 2)), kv = bf2f(*(const LAS bf16*)(lds + 16384 + j * 256 + dk * 2));
              const int off = j * 256 + (((dk >> 3) ^ (j & 15)) * 16) + (dk & 7) * 2;
              *(LAS bf16*)(lds + L_QT + off) = (bf16)f2bf(qv * __expf(P[jj])); *(LAS bf16*)(lds + L_KT + off) = (bf16)f2bf(kv * __expf(-P[jj])); } }
        fill_vt(lds, lds + 32768, tid);
        __syncthreads();
        { const char* src = (const char*)ST + (size_t)unit * (256 * 128 * 2);
#pragma unroll
          for (int i = 0; i < 8; ++i) { const int piece = 8 * wave + i, row = piece * 4 + (lane >> 4), chunk = (lane & 15) ^ (row & 15);
              __builtin_amdgcn_global_load_lds((const unsigned*)(src + (unsigned)(row * 256 + chunk * 16)), (LAS unsigned*)(lds + L_ST + piece * 1024), 16, 0, 0); } }
        asm volatile("s_waitcnt vmcnt(0)" ::: "memory"); __syncthreads();
        bf16x8 qF[4];
#pragma unroll
        for (int ks = 0; ks < 4; ++ks) qF[ks] = *(const LAS bf16x8*)(lds + L_QT + nt * 4096 + (koff0 ^ (ks * 64)));
        f4 sT[4];
#pragma unroll
        for (int jt = 0; jt < 4; ++jt) { sT[jt] = (f4){0.f, 0.f, 0.f, 0.f};
            if (jt <= nt) {
#pragma unroll
                for (int ks = 0; ks < 4; ++ks) { const bf16x8 a = *(const LAS bf16x8*)(lds + L_KT + jt * 4096 + (koff0 ^ (ks * 64))); sT[jt] = __builtin_amdgcn_mfma_f32_16x16x32_bf16(a, qF[ks], sT[jt], 0, 0, 0); }
                if (jt == nt) {
#pragma unroll
                    for (int rg = 0; rg < 4; ++rg) if (4 * gq + rg > c) sT[jt][rg] = 0.f; } } }
        bf16x8 pb[2];
#pragma unroll
        for (int s = 0; s < 2; ++s) { v4u w; w.x = pg8::cvt_pk_bf16(sT[2 * s][0], sT[2 * s][1]); w.y = pg8::cvt_pk_bf16(sT[2 * s][2], sT[2 * s][3]); w.z = pg8::cvt_pk_bf16(sT[2 * s + 1][0], sT[2 * s + 1][1]); w.w = pg8::cvt_pk_bf16(sT[2 * s + 1][2], sT[2 * s + 1][3]); pb[s] = __builtin_bit_cast(bf16x8, w); }
        f4 o[8]; float ss = 0.f;
#pragma unroll
        for (int mt = 0; mt < 8; ++mt) { o[mt] = (f4){0.f, 0.f, 0.f, 0.f}; const int rb = 128 * half + 16 * mt;
#pragma unroll
            for (int ks = 0; ks < 4; ++ks) { const bf16x8 a = *(const LAS bf16x8*)(lds + L_ST + rb * 256 + (koff0 ^ (ks * 64))); o[mt] = __builtin_amdgcn_mfma_f32_16x16x32_bf16(a, qF[ks], o[mt], 0, 0, 0); }
#pragma unroll
            for (int s = 0; s < 2; ++s) if (2 * s <= nt) { const v2u lo = *(const LAS v2u*)(lds + L_VT + rb * 128 + (voff0 ^ (s * 64))), hi = *(const LAS v2u*)(lds + L_VT + rb * 128 + (voff0 ^ (s * 64 + 32)));
                o[mt] = __builtin_amdgcn_mfma_f32_16x16x32_bf16(__builtin_bit_cast(bf16x8, (v4u){lo.x, lo.y, hi.x, hi.y}), pb[s], o[mt], 0, 0, 0); }
            ss += (o[mt][0] * o[mt][0] + o[mt][1] * o[mt][1]) + (o[mt][2] * o[mt][2] + o[mt][3] * o[mt][3]); }
        ss = nsa::radd32(nsa::radd16(ss));
        LAS float* red = (LAS float*)(lds + L_RED);
        if (gq == 0) red[half * 64 + 16 * nt + c] = ss;
        __syncthreads();
        const float rstd = 1.f / sqrtf((red[16 * nt + c] + red[64 + 16 * nt + c]) * (1.f / 256.f) + RMS_EPS);
        const int tok = t0 + 16 * nt + c;
#pragma unroll
        for (int mt = 0; mt < 8; ++mt) { const int dv = 128 * half + 16 * mt + 4 * gq; const f32x4 g4 = *(const f32x4*)((const char*)gn + (unsigned)(dv * 4));
            const v2u gg = *(const v2u*)((const char*)GG + (unsigned)((tok * 1024 + h * 256 + dv) * 2));
            const float z0 = bflo(gg.x), z1 = bfhi(gg.x), z2 = bflo(gg.y), z3 = bfhi(gg.y);
            v2u w; w.x = pg8::cvt_pk_bf16(o[mt][0] * rstd * g4.x * (z0 / (1.f + __expf(-z0))), o[mt][1] * rstd * g4.y * (z1 / (1.f + __expf(-z1))));
            w.y = pg8::cvt_pk_bf16(o[mt][2] * rstd * g4.z * (z2 / (1.f + __expf(-z2))), o[mt][3] * rstd * g4.w * (z3 / (1.f + __expf(-z3))));
            *(v2u*)((char*)A2 + (unsigned)((tok * DM + h * 256 + dv) * 2)) = w; }
        __syncthreads();
    }
}

constexpr size_t WS_LH = WS_DEC + (size_t)2048 * 128 * 4;
constexpr size_t WS_PEV = WS_LH + (size_t)2 * 4096 * 256 * 4;
static_assert(WS_PEV + 1024 <= WS_KCMP, "cmp scratch overlay");
struct CmpOrder {
    int c; const bf16 *kc, *vc, *wk, *wv;
    __device__ __forceinline__ bool next(int i, pg8::Unit& u) const { if (i > 0 || c >= 32) return false; u.pm = c & 15; u.pn = 0; u.kind = c >> 4; return true; }
    __device__ __forceinline__ const char* pa(const pg8::Gemm&, const pg8::Unit& u) const { return (const char*)(u.kind ? vc : kc) + (size_t)u.pm * ((size_t)256 * 2048 * 2); }
    __device__ __forceinline__ const char* pb(const pg8::Gemm&, const pg8::Unit& u) const { return (const char*)(u.kind ? wv : wk); }
    __device__ __forceinline__ void a_ready(const pg8::Unit&) const {}
    __device__ __forceinline__ void done(const pg8::Unit&) const {}
};
struct EpiLH {
    static constexpr bool PERM = false, AFTER_DRAIN = false;
    float* LH;
    __device__ __forceinline__ void operator()(const pg8::f32x4 (&acc)[2][2][4][2], const pg8::Unit& u, int wr, int wc, int fr, int fq) const {
        const int row0 = u.kind * 4096 + u.pm * 256 + wr * 64 + fr, col0 = wc * 32 + 4 * fq;
#pragma unroll
        for (int ai = 0; ai < 2; ++ai)
#pragma unroll
            for (int m = 0; m < 4; ++m) { float* rowp = LH + (size_t)(row0 + ai * 128 + m * 16) * 256 + col0;
#pragma unroll
                for (int bj = 0; bj < 2; ++bj)
#pragma unroll
                    for (int n = 0; n < 2; ++n) *(pg8::f32x4*)(rowp + bj * 128 + n * 16) = acc[ai][bj][m][n]; }
    }
};

constexpr size_t PROWS = (size_t)MAXTILES * 256;
constexpr size_t WS_W1Q = WS_W1T;
constexpr size_t WS_W2Q = WS_W1Q + (size_t)NE * 4096 * DM;
constexpr size_t WS_HN8 = WS_W2Q + (size_t)NE * DM * DFF;
constexpr size_t WS_AMAXP = WS_HN8 + (size_t)T * DM;
constexpr size_t WS_WSC1 = WS_AMAXP + PROWS * 64 * 4;
constexpr size_t WS_WSC2 = WS_WSC1 + (size_t)NE * 4096 * 4;
constexpr size_t WS_HSC = WS_WSC2 + (size_t)NE * 2048 * 4;
constexpr size_t WS_ROWSC = WS_HSC + (size_t)T * 4;
constexpr size_t WS_ASC = WS_ROWSC + PROWS * 4;
static_assert(WS_ASC + PROWS * 4 <= WS_XN, "int8 buffers fit in the retired bf16 expert-weight region");
constexpr size_t WS_ROWTOK = WS_CTL + 512 * 1024;
static_assert(PROWS * 2 <= 512 * 1024 && DM == 2048, "row table fits; gathered rows are 2048 bytes");
constexpr size_t WS_H16 = WS_XG;
static_assert((size_t)T * DM * 2 <= PROWS * DM, "h fits below ACT8");
constexpr size_t WS_XG8 = WS_XG;
constexpr size_t WS_ACT8 = WS_XG + PROWS * DM;
constexpr size_t WS_Y = WS_ACT;
static_assert(WS_ACT8 + PROWS * DM <= WS_ACT, "int8 row buffers fit in the retired gathered-row region");

__device__ __forceinline__ unsigned q8x4(float a, float b, float c, float d) {
    const float M = 12582912.f; const unsigned ua = __builtin_bit_cast(unsigned, a + M), ub = __builtin_bit_cast(unsigned, b + M), uc = __builtin_bit_cast(unsigned, c + M), ud = __builtin_bit_cast(unsigned, d + M);
    return __builtin_amdgcn_perm(ub, ua, 0x0c0c0400u) | (__builtin_amdgcn_perm(ud, uc, 0x0c0c0400u) << 16); }
__device__ __forceinline__ float clamp127(float v) { return __builtin_amdgcn_fmed3f(v, -127.f, 127.f); }
__device__ __forceinline__ unsigned q8x4c(float a, float b, float c, float d) { return q8x4(clamp127(a), clamp127(b), clamp127(c), clamp127(d)); }

constexpr size_t WS_WINQ = WS_WINT;
constexpr size_t WS_WISC = WS_WINT + (size_t)NPT * 256 * DM;
constexpr size_t WS_XN8 = WS_XN;
constexpr size_t WS_XSC = WS_XN + (size_t)T * DM;
constexpr size_t WS_PMAX = WS_HN;
constexpr size_t WS_PMAXI = WS_PMAX + (size_t)64 * 8 * 4096 * 4;

constexpr int NSLAB_E = NE * 192, NSLAB = NSLAB_E + 178;
struct SlabSrc { const float* W; int N; bool ok; };
__device__ __forceinline__ SlabSrc slab_src(const Params& p, int sl, int r0, int n4) {
    SlabSrc s;
    if (sl < NSLAB_E) { const int e = sl / 192, r = sl % 192; const bool isw2 = r >= 128; const int nb = isw2 ? r - 128 : r; s.N = isw2 ? 2048 : 4096;
        s.W = (isw2 ? p.in[I_W2] + (size_t)e * DFF * DM : p.in[I_W1] + (size_t)e * DM * 4096) + (size_t)r0 * s.N + nb * 32 + 4 * n4; s.ok = true; }
    else { const int nb = sl - NSLAB_E; s.N = 5672; s.ok = nb * 32 + 4 * n4 < 5672; s.W = p.in[I_WIN] + (size_t)r0 * 5672 + (s.ok ? nb * 32 + 4 * n4 : 0); }
    return s;
}
__device__ __forceinline__ void p0_slab_quant(const Params& p, LAS unsigned char* lds, int bid, int G, int tid) {
    constexpr int RS = 4104;
    LAS unsigned char* TT = lds; LAS float* part = (LAS float*)(lds + 32 * RS); LAS float* inv = part + 64 * 32; LAS int* drow = (LAS int*)(inv + 32);
    signed char* W1Q = (signed char*)(p.ws + WS_W1Q); signed char* W2Q = (signed char*)(p.ws + WS_W2Q); signed char* WIQ = (signed char*)(p.ws + WS_WINQ);
    float* WSC1 = (float*)(p.ws + WS_WSC1); float* WSC2 = (float*)(p.ws + WS_WSC2); float* WISC = (float*)(p.ws + WS_WISC);
    const int n4 = tid & 7, r0 = tid >> 3;
    f32x4 va[8], vb[8];
#define SLAB_ISSUE(dst, sl, j) do { if ((sl) < NSLAB) { const SlabSrc ss_ = slab_src(p, (sl), r0, n4); _Pragma("unroll") for (int u = 0; u < 8; ++u) dst[u] = __builtin_nontemporal_load((const f32x4*)(ss_.W + (size_t)(64 * (8 * (j) + u)) * ss_.N)); } } while (0)
#define SLAB_USE(src, j) do { _Pragma("unroll") for (int u = 0; u < 8; ++u) { const f32x4 x = sc_.ok ? src[u] : (f32x4){0.f, 0.f, 0.f, 0.f}; const int k = r0 + 64 * (8 * (j) + u); \
            const unsigned w0 = cvt2bf(x.x, x.y), w1 = cvt2bf(x.z, x.w);        \
            mx0 = __builtin_elementwise_max(mx0, __builtin_bit_cast(u16x2, w0 & 0x7fff7fffu)); mx1 = __builtin_elementwise_max(mx1, __builtin_bit_cast(u16x2, w1 & 0x7fff7fffu)); \
            LAS unsigned char* d = TT + (4 * n4) * RS + k * 2; \
            *(LAS bf16*)d = (bf16)w0; *(LAS bf16*)(d + RS) = (bf16)(w0 >> 16); *(LAS bf16*)(d + 2 * RS) = (bf16)w1; *(LAS bf16*)(d + 3 * RS) = (bf16)(w1 >> 16); } } while (0)
    SLAB_ISSUE(va, bid, 0); SLAB_ISSUE(vb, bid, 1);
    for (int slab = bid; slab < NSLAB; slab += G) {
        const SlabSrc sc_ = slab_src(p, slab, r0, n4);
        u16x2 mx0 = (u16x2){0, 0}, mx1 = (u16x2){0, 0};
        SLAB_USE(va, 0); SLAB_ISSUE(va, slab, 2);
        SLAB_USE(vb, 1); SLAB_ISSUE(vb, slab, 3);
        SLAB_USE(va, 2); SLAB_ISSUE(va, slab + G, 0);
        SLAB_USE(vb, 3); SLAB_ISSUE(vb, slab + G, 1);
        { u16x2 t0 = mx0, t1 = mx1;
#pragma unroll
          for (int o = 8; o < 64; o <<= 1) { t0 = __builtin_elementwise_max(t0, __builtin_bit_cast(u16x2, __shfl_xor(__builtin_bit_cast(int, t0), o))); t1 = __builtin_elementwise_max(t1, __builtin_bit_cast(u16x2, __shfl_xor(__builtin_bit_cast(int, t1), o))); }
          const unsigned a0 = __builtin_bit_cast(unsigned, t0), a1 = __builtin_bit_cast(unsigned, t1);
          if ((tid & 63) < 8) *(LAS f32x4*)(part + (tid >> 6) * 32 + 4 * n4) = (f32x4){bflo(a0), bfhi(a0), bflo(a1), bfhi(a1)}; }
        __syncthreads();
        if (tid < 32) { float m = 0.f;
#pragma unroll
            for (int q = 0; q < 8; ++q) m = fmaxf(m, part[q * 32 + tid]);
            const float sc = m > 0.f ? m * (1.f / 127.f) : 1.f; inv[tid] = 1.f / sc;
            if (slab < NSLAB_E) { const int e = slab / 192, r = slab % 192; const bool isw2 = r >= 128; const int n = (isw2 ? r - 128 : r) * 32 + tid;
                if (isw2) { drow[tid] = e * 2048 + n; WSC2[e * 2048 + n] = sc; }
                else { const int j2 = n & 2047, row = (j2 >> 7) * 256 + (n >= 2048 ? 128 : 0) + (j2 & 127); drow[tid] = e * 4096 + row; WSC1[e * 4096 + row] = sc; } }
            else { const int n = (slab - NSLAB_E) * 32 + tid; if (n < 5672) { float qsc; const int row = win_row(n, qsc); drow[tid] = row; WISC[row] = sc * qsc; } else drow[tid] = -1; } }
        __syncthreads();
        { const int kc = tid & 7, n = (tid >> 3) & 31, hf = tid >> 8; const float iv = inv[n]; const int dr = drow[n];
          signed char* dst = (slab < NSLAB_E ? ((slab % 192) >= 128 ? W2Q : W1Q) : WIQ) + (size_t)(dr < 0 ? 0 : dr) * 2048; const LAS unsigned char* src = TT + n * RS;
          if (dr >= 0) {
#pragma unroll
          for (int m8 = 0; m8 < 8; ++m8) { const int k0 = 16 * (kc + 8 * (hf + 2 * m8)); const LAS v2u* sp = (const LAS v2u*)(src + k0 * 2); const v2u a = sp[0], b = sp[1], c = sp[2], d = sp[3]; v4u o;
              o.x = q8x4(bflo(a.x) * iv, bfhi(a.x) * iv, bflo(a.y) * iv, bfhi(a.y) * iv); o.y = q8x4(bflo(b.x) * iv, bfhi(b.x) * iv, bflo(b.y) * iv, bfhi(b.y) * iv);
              o.z = q8x4(bflo(c.x) * iv, bfhi(c.x) * iv, bflo(c.y) * iv, bfhi(c.y) * iv); o.w = q8x4(bflo(d.x) * iv, bfhi(d.x) * iv, bflo(d.y) * iv, bfhi(d.y) * iv);
              *(v4u*)(dst + k0) = o; } } }
        __syncthreads();
    }
#undef SLAB_ISSUE
#undef SLAB_USE
}
struct EpiSwigluI8 {
    static constexpr bool PERM = true, AFTER_DRAIN = false;
    const float* b1; const float* rowsc; const float* wsc1; bf16* act; float* amaxp;
    __device__ __forceinline__ void operator()(const pg8::f32x4 (&acc)[2][2][4][2], const pg8::Unit& u, int wr, int wc, int fr, int fq) const {
        const int e = u.kind; const int cin = wc * 32 + 8 * fq; const int col = u.pn * 128 + cin; const int row0 = u.pm * 256 + wr * 64 + fr;
        const float* bg = b1 + (size_t)e * 4096 + col; const float* bl = bg + 2048; const float* sg = wsc1 + (size_t)e * 4096 + u.pn * 256 + cin; const float* sl = sg + 128;
        float gb[8], lb[8], gs[8], ls[8];
#pragma unroll
        for (int j = 0; j < 8; ++j) { gb[j] = bg[j]; lb[j] = bl[j]; gs[j] = sg[j]; ls[j] = sl[j]; }
#pragma unroll
        for (int ai = 0; ai < 2; ++ai)
#pragma unroll
            for (int m = 0; m < 4; ++m) { const int r = row0 + ai * 128 + m * 16; const float rs = rowsc[r]; float o[8]; float mx = 0.f;
#pragma unroll
                for (int n = 0; n < 2; ++n)
#pragma unroll
                    for (int j = 0; j < 4; ++j) { float gl = (float)__float_as_int(acc[ai][0][m][n][j]) * (rs * gs[n * 4 + j]) + gb[n * 4 + j]; float li = (float)__float_as_int(acc[ai][1][m][n][j]) * (rs * ls[n * 4 + j]) + lb[n * 4 + j];
                        gl = fminf(gl, 7.f); li = fminf(fmaxf(li, -7.f), 7.f);
                        const float v = gl * __builtin_amdgcn_rcpf(1.f + __builtin_amdgcn_exp2f(-2.4554669595930156f * gl)) * (li + 1.f); o[n * 4 + j] = v; mx = fmaxf(mx, fabsf(v)); }
                mx = nsa::rmax32(nsa::rmax16(mx));
                if (fq == 0) amaxp[(size_t)r * 64 + u.pn * 4 + wc] = mx;
                pg8::u32x4 w; w.x = pg8::cvt_pk_bf16(o[0], o[1]); w.y = pg8::cvt_pk_bf16(o[2], o[3]); w.z = pg8::cvt_pk_bf16(o[4], o[5]); w.w = pg8::cvt_pk_bf16(o[6], o[7]);
                *(pg8::u32x4*)(act + (size_t)r * DFF + col) = w; }
    }
};
__device__ __forceinline__ void ph_actq(const Params& p, int gw, int NGW, int lane) {
    const int nrows = ((const int*)(p.ws + WS_META))[0] * 256; const float* amaxp = (const float*)(p.ws + WS_AMAXP); const bf16* act = (const bf16*)(p.ws + WS_ACT);
    signed char* A8 = (signed char*)(p.ws + WS_ACT8); float* ASC = (float*)(p.ws + WS_ASC);
    for (int rb = gw; rb < nrows; rb += 2 * NGW) {
        const int r0 = rb, r1 = rb + NGW; const bool h1 = r1 < nrows; const int r1c = h1 ? r1 : r0;
        float m0 = amaxp[(size_t)r0 * 64 + lane], m1 = amaxp[(size_t)r1c * 64 + lane];
        const v4u* s0 = (const v4u*)(act + (size_t)r0 * DFF) + lane * 4; const v4u* s1 = (const v4u*)(act + (size_t)r1c * DFF) + lane * 4; v4u a[2][4];
#pragma unroll
        for (int j = 0; j < 4; ++j) { a[0][j] = s0[j]; a[1][j] = s1[j]; }
        m0 = wave_max(m0); m1 = wave_max(m1);
#pragma unroll
        for (int q = 0; q < 2; ++q) { const int r = q ? r1 : r0; if (q && !h1) break; const float mx = q ? m1 : m0; const float sc = mx > 0.f ? mx * (1.f / 127.f) : 1.f, iv = 1.f / sc; v4u o[2];
#pragma unroll
            for (int h = 0; h < 2; ++h) { const v4u x = a[q][2 * h], y = a[q][2 * h + 1];
                o[h].x = q8x4c(bflo(x.x) * iv, bfhi(x.x) * iv, bflo(x.y) * iv, bfhi(x.y) * iv); o[h].y = q8x4c(bflo(x.z) * iv, bfhi(x.z) * iv, bflo(x.w) * iv, bfhi(x.w) * iv);
                o[h].z = q8x4c(bflo(y.x) * iv, bfhi(y.x) * iv, bflo(y.y) * iv, bfhi(y.y) * iv); o[h].w = q8x4c(bflo(y.z) * iv, bfhi(y.z) * iv, bflo(y.w) * iv, bfhi(y.w) * iv); }
            v4u* dst = (v4u*)(A8 + (size_t)r * DFF) + lane * 2; dst[0] = o[0]; dst[1] = o[1];
            if (lane == 0) ASC[r] = sc; } }
}
struct EpiDownI8 {
    static constexpr bool PERM = true, AFTER_DRAIN = false;
    const float* b2; const float* roww; const float* asc; const float* wsc2; bf16* y;
    __device__ __forceinline__ void operator()(const pg8::f32x4 (&acc)[2][2][4][2], const pg8::Unit& u, int wr, int wc, int fr, int fq) const {
        const int e = u.kind; const int col0 = u.pn * 256 + wc * 32 + 8 * fq; const int row0 = u.pm * 256 + wr * 64 + fr;
        float bv[2][8], sv[2][8];
#pragma unroll
        for (int bj = 0; bj < 2; ++bj)
#pragma unroll
            for (int j = 0; j < 8; ++j) { bv[bj][j] = b2[(size_t)e * DM + col0 + bj * 128 + j]; sv[bj][j] = wsc2[(size_t)e * DM + col0 + bj * 128 + j]; }
#pragma unroll
        for (int ai = 0; ai < 2; ++ai)
#pragma unroll
            for (int m = 0; m < 4; ++m) { const int r = row0 + ai * 128 + m * 16; const float g = roww[r], as = asc[r];
#pragma unroll
                for (int bj = 0; bj < 2; ++bj) { float o[8];
#pragma unroll
                    for (int n = 0; n < 2; ++n)
#pragma unroll
                        for (int j = 0; j < 4; ++j) o[n * 4 + j] = ((float)__float_as_int(acc[ai][bj][m][n][j]) * (as * sv[bj][n * 4 + j]) + bv[bj][n * 4 + j]) * g;
                    pg8::u32x4 w; w.x = pg8::cvt_pk_bf16(o[0], o[1]); w.y = pg8::cvt_pk_bf16(o[2], o[3]); w.z = pg8::cvt_pk_bf16(o[4], o[5]); w.w = pg8::cvt_pk_bf16(o[6], o[7]);
                    *(pg8::u32x4*)(y + (size_t)r * DM + col0 + bj * 128) = w; } }
    }
};

struct EpiProjI8 {
    static constexpr bool PERM = true, AFTER_DRAIN = false;
    unsigned char* ws;
    __device__ __forceinline__ void operator()(const pg8::f32x4 (&acc)[2][2][4][2], const pg8::Unit& u, int wr, int wc, int fr, int fq) const {
        const int cw = wc * 32 + 8 * fq; const float* XSC = (const float*)(ws + WS_XSC); const float* WISC = (const float*)(ws + WS_WISC);
        if (u.kind == 0) {
            const int tn = u.pn; bf16* base; size_t bjs = 128; int ld = 0; bool headmajor = false; bool small = false;
            if (tn < 2) { base = (bf16*)(ws + WS_GQ) + tn * 256; ld = 512; }
            else if (tn < 4) { base = (bf16*)(ws + WS_GK) + (tn - 2) * 256; ld = 512; }
            else if (tn < 8) { base = (bf16*)(ws + WS_GV) + (tn - 4) * 256; ld = 1024; }
            else if (tn < 12) { base = (bf16*)(ws + WS_GG) + (tn - 8) * 256; ld = 1024; }
            else if (tn < 16) { base = (bf16*)(ws + WS_NQ) + (tn - 12) * 256; ld = 1024; }
            else if (tn < 20) { base = (bf16*)(ws + (tn == 16 ? WS_KC : tn == 17 ? WS_VC : tn == 18 ? WS_KS : WS_KW)); headmajor = true; bjs = (size_t)SEQ * 128; }
            else { base = (bf16*)(ws + WS_SM); ld = 64; small = true; }
            if (small && wc >= 2) return;
            float cs[2][8];
#pragma unroll
            for (int bj = 0; bj < 2; ++bj)
#pragma unroll
                for (int j = 0; j < 8; ++j) cs[bj][j] = WISC[tn * 256 + bj * 128 + cw + j];
#pragma unroll
            for (int ai = 0; ai < 2; ++ai)
#pragma unroll
                for (int m = 0; m < 4; ++m) { const int r = u.pm * 256 + ai * 128 + wr * 64 + m * 16 + fr; const float rs = XSC[r];
                    const size_t rterm = headmajor ? ((size_t)(r >> 12) * 2 * SEQ + (r & (SEQ - 1))) * 128 : (size_t)r * ld;
#pragma unroll
                    for (int bj = 0; bj < 2; ++bj) { if (small && bj) continue; float o[8];
#pragma unroll
                        for (int n = 0; n < 2; ++n)
#pragma unroll
                            for (int j = 0; j < 4; ++j) o[n * 4 + j] = (float)__float_as_int(acc[ai][bj][m][n][j]) * (rs * cs[bj][n * 4 + j]);
                        pg8::u32x4 w; w.x = pg8::cvt_pk_bf16(o[0], o[1]); w.y = pg8::cvt_pk_bf16(o[2], o[3]); w.z = pg8::cvt_pk_bf16(o[4], o[5]); w.w = pg8::cvt_pk_bf16(o[6], o[7]);
                        *(pg8::u32x4*)(base + rterm + bj * bjs + cw) = w; } }
        } else {
            bf16* base = (bf16*)(ws + (u.pn == 21 ? WS_VST : WS_VWT));
#pragma unroll
            for (int ai = 0; ai < 2; ++ai)
#pragma unroll
                for (int m = 0; m < 4; ++m) { const int dh = wr * 64 + m * 16 + fr; const float ws_ = WISC[u.pn * 256 + ai * 128 + dh];
#pragma unroll
                    for (int bj = 0; bj < 2; ++bj) { const int tok = u.pm * 256 + bj * 128 + cw; const int b = tok >> 12, s = tok & (SEQ - 1); float o[8];
                        const pg8::f32x4 x0 = *(const pg8::f32x4*)(XSC + tok), x1 = *(const pg8::f32x4*)(XSC + tok + 4);
#pragma unroll
                        for (int j = 0; j < 4; ++j) { o[j] = (float)__float_as_int(acc[ai][bj][m][0][j]) * (ws_ * x0[j]); o[4 + j] = (float)__float_as_int(acc[ai][bj][m][1][j]) * (ws_ * x1[j]); }
                        pg8::u32x4 w; w.x = pg8::cvt_pk_bf16(o[0], o[1]); w.y = pg8::cvt_pk_bf16(o[2], o[3]); w.z = pg8::cvt_pk_bf16(o[4], o[5]); w.w = pg8::cvt_pk_bf16(o[6], o[7]);
                        *(pg8::u32x4*)(base + ((size_t)(b * 2 + ai) * 128 + dh) * SEQ + s) = w; } }
        }
    }
};

__device__ __forceinline__ void r1_router(const Params& p, LAS unsigned char* lds, int vb, int tid, int wave, int lane) {
    LAS float* rowbuf = (LAS float*)lds;
    LAS float* part = (LAS float*)(lds + 65536);
    LAS int* tk = (LAS int*)(lds + 81920 + wave * 1024);
    LAS int* cntw = (LAS int*)(lds + 90112);
    const bf16* h = (const bf16*)(p.ws + WS_H16); const float* gf = p.in[I_NFFN]; const float* rw = p.in[I_RW]; const float* rb = p.in[I_RB];
    signed char* HN8 = (signed char*)(p.ws + WS_HN8);
    const int e = lane & 31, eg = tid & 31, dg = tid >> 5; int mycount = 0;
    float rwr[128];
#pragma unroll
    for (int c4 = 0; c4 < 4; ++c4) { unsigned o = (unsigned)((((dg * 128 + c4 * 32) * 32) + eg) * 4); asm volatile("" : "+v"(o));
#pragma unroll
        for (int i = 0; i < 32; ++i) rwr[c4 * 32 + i] = *(const float*)((const char*)rw + o + i * 128); }
    for (int grp = 0; grp < 16; ++grp) { const int t = vb * TPV + grp * 8 + wave;
        { const v4u* xr = (const v4u*)(h + (size_t)t * DM) + lane; float s = 0.f; v4u hw[4];
#pragma unroll
          for (int q = 0; q < 4; ++q) hw[q] = xr[64 * q];
#pragma unroll
          for (int q = 0; q < 4; ++q) { const float a0 = bflo(hw[q].x), a1 = bfhi(hw[q].x), a2 = bflo(hw[q].y), a3 = bfhi(hw[q].y), a4 = bflo(hw[q].z), a5 = bfhi(hw[q].z), a6 = bflo(hw[q].w), a7 = bfhi(hw[q].w);
              s += ((a0 * a0 + a1 * a1) + (a2 * a2 + a3 * a3)) + ((a4 * a4 + a5 * a5) + (a6 * a6 + a7 * a7)); }
          const float rstd = 1.f / sqrtf(wave_sum(s) * (1.f / DM) + RMS_EPS);
          float mxr = 0.f; LAS f32x4* hrow = (LAS f32x4*)(rowbuf + wave * 2048);
#pragma unroll
          for (int j = 0; j < 8; ++j) { const int cj = 2 * lane + 128 * (j >> 1) + (j & 1); const f32x4 g4 = ((const f32x4*)gf)[cj]; const unsigned wa = (j & 1) ? hw[j >> 1].z : hw[j >> 1].x, wb = (j & 1) ? hw[j >> 1].w : hw[j >> 1].y;
              f32x4 y; y.x = bflo(wa) * rstd * g4.x; y.y = bfhi(wa) * rstd * g4.y; y.z = bflo(wb) * rstd * g4.z; y.w = bfhi(wb) * rstd * g4.w;
              hrow[cj] = y; mxr = fmaxf(mxr, fmaxf(fmaxf(fabsf(y.x), fabsf(y.y)), fmaxf(fabsf(y.z), fabsf(y.w)))); }
          mxr = wave_max(mxr); const float qs = mxr > 0.f ? mxr * (1.f / 127.f) : 1.f, qi = 1.f / qs;
          v2u* o8 = (v2u*)(HN8 + (size_t)t * DM) + lane;
#pragma unroll
          for (int q = 0; q < 4; ++q) { const f32x4 ya = hrow[2 * lane + 128 * q], yb = hrow[2 * lane + 128 * q + 1]; v2u o;
              o.x = q8x4(ya.x * qi, ya.y * qi, ya.z * qi, ya.w * qi); o.y = q8x4(yb.x * qi, yb.y * qi, yb.z * qi, yb.w * qi); o8[64 * q] = o; }
          if (lane == 0) ((float*)(p.ws + WS_HSC))[t] = qs; }
        __syncthreads();
        { float acc[8];
#pragma unroll
          for (int tt = 0; tt < 8; ++tt) acc[tt] = 0.f;
#pragma unroll
          for (int i4 = 0; i4 < 32; ++i4) { f32x4 xv[8];
#pragma unroll
              for (int tt = 0; tt < 8; ++tt) xv[tt] = *(const LAS f32x4*)(rowbuf + tt * 2048 + dg * 128 + 4 * i4);
#pragma unroll
              for (int tt = 0; tt < 8; ++tt) acc[tt] += xv[tt].x * rwr[4 * i4] + xv[tt].y * rwr[4 * i4 + 1] + xv[tt].z * rwr[4 * i4 + 2] + xv[tt].w * rwr[4 * i4 + 3];
              if (i4 & 1) asm volatile("" ::: "memory"); }
#pragma unroll
          for (int tt = 0; tt < 8; ++tt) part[(dg * 8 + tt) * 32 + eg] = acc[tt]; }
        __syncthreads();
        { float a = rb[e];
#pragma unroll
          for (int q = 0; q < 16; ++q) a += part[(q * 8 + wave) * 32 + e];
          int rank = 0;
#pragma unroll
          for (int mm = 0; mm < 32; ++mm) { const float lm = __shfl(a, mm); rank += (lm > a || (lm == a && mm < e)) ? 1 : 0; }
          const float mx = wave_max(a); const bool sel = rank < 4;
          const float ex = (sel && lane < 32) ? __expf(a - mx) : 0.f; const float sum = wave_sum(ex);
          if (sel && lane < 32) { LAS int* q = tk + (grp * 4 + rank) * 4; q[0] = e; q[1] = mycount; q[2] = __builtin_bit_cast(int, ex / sum); ++mycount; } }
        __syncthreads();
    }
    int ln; asm volatile("v_mbcnt_lo_u32_b32 %0, -1, 0\n\tv_mbcnt_hi_u32_b32 %0, -1, %0" : "=v"(ln));
    if (ln < 32) cntw[wave * 32 + ln] = mycount;
    __syncthreads();
    if (wave == 0 && ln < 32) { int tot = 0; for (int w = 0; w < 8; ++w) tot += cntw[w * 32 + ln]; ((int*)(p.ws + WS_CNT))[vb * 32 + ln] = tot; }
    { const int i = ln >> 2, k = ln & 3; const LAS int* q = tk + (i * 4 + k) * 4; const int ee = q[0]; int base = 0; for (int w = 0; w < wave; ++w) base += cntw[w * 32 + ee];
      const int t = vb * TPV + i * 8 + wave;
      ((int*)(p.ws + WS_EIDX))[t * 4 + k] = ee; ((int*)(p.ws + WS_LRNK))[t * 4 + k] = base + q[1]; ((int*)(p.ws + WS_GATE))[t * 4 + k] = q[2]; }
    __syncthreads();
}
__device__ __forceinline__ void r2_gather(const Params& p, LAS unsigned char* lds, int vb, bool write_meta, int tid, int wave, int lane) {
    LAS int* part_tot = (LAS int*)lds;
    LAS int* part_base = part_tot + 512;
    LAS int* pbase = part_base + 512;
    const int* CNT = (const int*)(p.ws + WS_CNT);
    { const int e = tid & 31, part = tid >> 5; int tot = 0, bs = 0;
      for (int v = part * 16; v < part * 16 + 16; ++v) { const int c = CNT[v * 32 + e]; tot += c; if (v < vb) bs += c; }
      part_tot[part * 32 + e] = tot; part_base[part * 32 + e] = bs; }
    __syncthreads();
    if (tid == 0) { int ps = 0; int* meta = (int*)(p.ws + WS_META); int nt = 0;
        for (int e = 0; e < 32; ++e) { int tot = 0, bs = 0; for (int q = 0; q < 16; ++q) { tot += part_tot[q * 32 + e]; bs += part_base[q * 32 + e]; }
            pbase[e] = ps + bs; const int ntile = (tot + 255) >> 8;
            if (write_meta) for (int q = 0; q < ntile; ++q) meta[64 + nt + q] = e;
            nt += ntile; ps += ntile * 256; }
        if (write_meta) meta[0] = nt; }
    __syncthreads();
    const float* HSC = (const float*)(p.ws + WS_HSC); float* ROWSC = (float*)(p.ws + WS_ROWSC);
    const int* EIDX = (const int*)(p.ws + WS_EIDX); const int* LRNK = (const int*)(p.ws + WS_LRNK); const float* GATE = (const float*)(p.ws + WS_GATE);
    int* POS = (int*)(p.ws + WS_POS); float* ROWW = (float*)(p.ws + WS_ROWW);
    unsigned short* RT = (unsigned short*)(p.ws + WS_ROWTOK);
    { const int t = vb * TPV + (tid >> 2), k = tid & 3;
      const int pos = pbase[EIDX[t * 4 + k]] + LRNK[t * 4 + k];
      POS[t * 4 + k] = pos; ROWW[pos] = GATE[t * 4 + k]; ROWSC[pos] = HSC[t]; RT[(pos & ~255) + (pos & 63) * 4 + ((pos >> 6) & 3)] = (unsigned short)t; }
    __syncthreads();
}
__device__ __forceinline__ void pf_final(const Params& p, int gw, int NGW, int lane) {
    const bf16* Y = (const bf16*)(p.ws + WS_Y); const int* POS = (const int*)(p.ws + WS_POS); const float* gfin = p.in[I_NFIN]; const bf16* H = (const bf16*)(p.ws + WS_H16);
    for (int t = gw; t < T; t += NGW) {
        f32x4 v[8]; const v4u* hr = (const v4u*)(H + (size_t)t * DM) + lane;
#pragma unroll
        for (int q = 0; q < 4; ++q) { const v4u w = hr[64 * q]; v[2 * q] = (f32x4){bflo(w.x), bfhi(w.x), bflo(w.y), bfhi(w.y)}; v[2 * q + 1] = (f32x4){bflo(w.z), bfhi(w.z), bflo(w.w), bfhi(w.w)}; }
#pragma unroll
        for (int k = 0; k < 4; ++k) { const int pos = POS[t * 4 + k]; const v4u* yr = (const v4u*)(Y + (size_t)pos * DM) + lane;
#pragma unroll
            for (int q = 0; q < 4; ++q) { const v4u w = yr[64 * q]; v[2 * q].x += bflo(w.x); v[2 * q].y += bfhi(w.x); v[2 * q].z += bflo(w.y); v[2 * q].w += bfhi(w.y);
                v[2 * q + 1].x += bflo(w.z); v[2 * q + 1].y += bfhi(w.z); v[2 * q + 1].z += bflo(w.w); v[2 * q + 1].w += bfhi(w.w); } }
        float s = 0.f;
#pragma unroll
        for (int j = 0; j < 8; ++j) s += (v[j].x * v[j].x + v[j].y * v[j].y) + (v[j].z * v[j].z + v[j].w * v[j].w);
        const float rstd = 1.f / sqrtf(wave_sum(s) * (1.f / DM) + RMS_EPS); f32x4* xr = (f32x4*)(p.out + (size_t)t * DM);
#pragma unroll
        for (int j = 0; j < 8; ++j) { const int cj = 2 * lane + 128 * (j >> 1) + (j & 1); const f32x4 g4 = ((const f32x4*)gfin)[cj]; f32x4 o; o.x = v[j].x * rstd * g4.x; o.y = v[j].y * rstd * g4.y; o.z = v[j].z * rstd * g4.z; o.w = v[j].w * rstd * g4.w; xr[cj] = o; }
    }
}


constexpr int LDS_BYTES = 159744;
constexpr int MISC_OFF = LDS_BYTES - 256;  static_assert(nsa::LDS_END <= MISC_OFF && gla::L_END <= MISC_OFF, "LDS map");
constexpr int CW_BAR = 4096, CW_XL = 16384;
__global__ __launch_bounds__(512, 2) void mega_fwd(Params p) {
    extern __shared__ __attribute__((aligned(16))) unsigned char lds_raw[];
    LAS unsigned char* lds = (LAS unsigned char*)lds_raw;
    const int G = gridDim.x, bid = blockIdx.x, NGW = G * 8;
#define PH_IDS int tid = threadIdx.x; asm volatile("" : "+v"(tid)); const int lane = tid & 63, wave = __builtin_amdgcn_readfirstlane(tid >> 6), gw = bid * 8 + wave; (void)lane; (void)gw;
    for (int u = threadIdx.x; u < 64; u += 512) ((LAS unsigned*)(lds + MISC_OFF))[u] = 0u;
    __syncthreads();
    XcdBarrier bar = xcd_barrier_post((unsigned*)(p.ws + WS_CTL) + CW_BAR, (volatile LAS unsigned*)(lds + MISC_OFF) + 8);
    { PH_IDS; p0_prologue(p, lds, gw, NGW, wave, lane); __syncthreads(); p0_slab_quant(p, lds, bid, G, tid); }
    xcd_barrier(bar);
    { pg8::Gemm g{(const bf16*)(p.ws + WS_XN8), (const bf16*)(p.ws + WS_WINQ), T, NPT * 256, DM / 2};
      ProjOrder S; S.init(T, NPT * 256, G, bid); S.xn = g.A; S.wt = g.Bt; EpiProjI8 E{p.ws};
      pg8::gemm_phase<EpiProjI8, ProjOrder, true, true, true>(lds, g, S, E); }
    xcd_barrier(bar);
    if (bid < 32) {
        pg8::Gemm g{(const bf16*)(p.ws + WS_KC), (const bf16*)(p.ws + WS_WKCT), 4096, 256, 2048};
        CmpOrder S{bid, (const bf16*)(p.ws + WS_KC), (const bf16*)(p.ws + WS_VC), (const bf16*)(p.ws + WS_WKCT), (const bf16*)(p.ws + WS_WVCT)}; EpiLH E{(float*)(p.ws + WS_LH)};
        pg8::gemm_phase<EpiLH, CmpOrder, true, true>(lds, g, S, E);
    } else { PH_IDS; ph_gla_a(p, lds, bid - 32, G - 32, tid, wave); }
    xcd_barrier(bar);
    { PH_IDS; ph_gla_b(p, bid * 512 + tid, G * 512);
      for (int i = bid * 512 + tid; i < 16 * 128; i += G * 512) { const int bgz = i >> 7, dz = i & 127; ((bf16*)(p.ws + WS_KCMP))[((size_t)bgz * 256 + 255) * 128 + dz] = 0; ((bf16*)(p.ws + WS_VCMPT))[((size_t)bgz * 128 + dz) * 256 + 255] = 0; }
      const int ngrp = G * 4, total = 2 * 16 * 255, iters = (total + ngrp - 1) / ngrp; const int grp = tid >> 7;
      for (int it = 0; it < iters; ++it) { int id = it * ngrp + bid * 4 + grp; if (id >= total) id = total - 1;
          ph_cmp_fin_simple(p, (LAS float*)lds + grp * 4352, id, tid & 127, (const float*)(p.ws + WS_LH), (const float*)(p.ws + WS_PEVP)); __syncthreads(); } }
    xcd_barrier(bar);
    { PH_IDS; ph_nsa(p, lds, bid, G, tid, wave); }
    { PH_IDS; __syncthreads(); ph_gla_c(p, lds, bid, G, tid, wave); }
    xcd_barrier(bar);
    { pg8::Gemm g{(const bf16*)(p.ws + WS_A2), (const bf16*)(p.ws + WS_WOT), T, DM, DM};
      pg8::StaticOrder S; S.init(T, DM, G, bid); EpiRes E{p.in[I_X], (bf16*)(p.ws + WS_H16)};
      pg8::gemm_phase<EpiRes, pg8::StaticOrder, true, true>(lds, g, S, E); }
    xcd_barrier(bar);
    { PH_IDS; for (int vb = bid; vb < NVB; vb += G) r1_router(p, lds, vb, tid, wave, lane); }
    xcd_barrier(bar);
    { PH_IDS; for (int vb = bid; vb < NVB; vb += G) r2_gather(p, lds, vb, vb == 0, tid, wave, lane); }
    xcd_barrier(bar);
    { pg8::Gemm g{(const bf16*)(p.ws + WS_HN8), (const bf16*)(p.ws + WS_W1Q), MAXTILES * 256, 4096, DM / 2};
      MoeOrderG S; S.init((const int*)(p.ws + WS_META), 16, G, bid); S.rowtab = (const unsigned short*)(p.ws + WS_ROWTOK); EpiSwigluI8 E{p.in[I_B1], (const float*)(p.ws + WS_ROWSC), (const float*)(p.ws + WS_WSC1), (bf16*)(p.ws + WS_ACT), (float*)(p.ws + WS_AMAXP)};
      pg8::gemm_phase<EpiSwigluI8, MoeOrderG, true, true, true, true>(lds, g, S, E); }
    xcd_barrier(bar);
    { PH_IDS; ph_actq(p, gw, NGW, lane); }
    xcd_barrier(bar);
    { pg8::Gemm g{(const bf16*)(p.ws + WS_ACT8), (const bf16*)(p.ws + WS_W2Q), MAXTILES * 256, DM, DFF / 2};
      MoeOrder S; S.init((const int*)(p.ws + WS_META), 8, G, bid); EpiDownI8 E{p.in[I_B2], (const float*)(p.ws + WS_ROWW), (const float*)(p.ws + WS_ASC), (const float*)(p.ws + WS_WSC2), (bf16*)(p.ws + WS_Y)};
      pg8::gemm_phase<EpiDownI8, MoeOrder, true, true, true>(lds, g, S, E); }
    xcd_barrier(bar);
    { PH_IDS; pf_final(p, gw, NGW, lane); }
}

extern "C" void kernel_launch(void* const* d_in, const int* in_sizes, int n_in, void* d_out, int out_size, void* d_ws, size_t ws_size, hipStream_t stream) {
    static int grid = 0;
    if (grid == 0) {
        if (n_in != N_IN || out_size != T * DM || ws_size < WS_END) { fprintf(stderr, "kernel_launch: unexpected shapes (n_in %d out %d ws %zu need %zu)\n", n_in, out_size, ws_size, (size_t)WS_END); grid = -1; return; }
        int dev = 0, cus = 0, per_cu = 0;
        if (hipGetDevice(&dev) != hipSuccess || hipDeviceGetAttribute(&cus, hipDeviceAttributeMultiprocessorCount, dev) != hipSuccess) { grid = -1; return; }
        if (hipFuncSetAttribute((const void*)mega_fwd, hipFuncAttributeMaxDynamicSharedMemorySize, LDS_BYTES) != hipSuccess) { fprintf(stderr, "kernel_launch: hipFuncSetAttribute failed\n"); grid = -1; return; }
        if (hipOccupancyMaxActiveBlocksPerMultiprocessor(&per_cu, (const void*)mega_fwd, 512, LDS_BYTES) != hipSuccess || per_cu < 1) { fprintf(stderr, "kernel_launch: occupancy query says %d blocks per CU\n", per_cu); }
        (void)hipGetLastError();
        grid = cus;
    }
    if (grid < 0) return;
    if (hipMemsetAsync((char*)d_ws + WS_CTL, 0, CTL_BYTES, stream) != hipSuccess) return;
    Params p{};
    for (int i = 0; i < N_IN; ++i) p.in[i] = (const float*)d_in[i];
    p.out = (float*)d_out; p.ws = (unsigned char*)d_ws;
    hipLaunchKernelGGL(mega_fwd, dim3(grid), dim3(512), LDS_BYTES, stream, p);
}
```

```cpp
#include <hip/hip_runtime.h>
#include <cstdio>
#include <cstdint>
namespace pg8 {
#define PG8_LAS __attribute__((address_space(3)))
typedef unsigned short bf16_t;
typedef short bf16x8 __attribute__((ext_vector_type(8)));
typedef float f32x4 __attribute__((ext_vector_type(4)));
typedef unsigned u32x4 __attribute__((ext_vector_type(4)));
typedef unsigned v2u_t __attribute__((ext_vector_type(2)));
constexpr int BM = 256, BK = 64, HALF = 128, HTB = HALF * BK * 2  , STAGE_BYTES = 8 * HTB, NXCD = 8, WGM = 8;

__host__ __device__ __forceinline__ int lds_byte(int r, int c) { const int st = (r >> 4) * 2 + (c >> 5), rr = r & 15, cc = c & 31, ob = rr * 64 + cc * 2; return st * 1024 + (ob ^ (((ob >> 9) & 1) << 5)); }
__host__ __device__ __forceinline__ void stage_rc(int b, int& R, int& C) { const int st = b / 1024, sb = b % 1024, swz = sb ^ (((sb >> 9) & 1) << 5); R = (st >> 1) * 16 + swz / 64; C = (st & 1) * 32 + (swz % 64) / 2; }
__host__ __device__ __forceinline__ int perm32(int rho) { const int n = rho >> 4, i = rho & 15; return 8 * (i >> 2) + 4 * n + (i & 3); }

struct Unit { int pm, pn, kind; };
struct Gemm { const bf16_t* A; const bf16_t* Bt; int M, N, K; };

template <int WG = WGM> __host__ __device__ __forceinline__ void tile_of(int wgid, int nM, int nN, int& pm, int& pn) {
    const int nwg = nM * nN;
    { const int q = nwg / NXCD, r = nwg % NXCD, xcd = wgid % NXCD, off = wgid / NXCD; wgid = (xcd < r ? xcd * (q + 1) : r * (q + 1) + (xcd - r) * q) + off; }
    const int nig = WG * nN, gid = wgid / nig, fm = gid * WG, gsz = (nM - fm) < WG ? (nM - fm) : WG;
    pm = fm + ((wgid % nig) % gsz); pn = (wgid % nig) / gsz;
}
struct StaticOrder {
    int nM, nN, nwg, G, c;
    __host__ __device__ void init(int M, int N, int G_, int c_) { nM = M / BM; nN = N / BM; nwg = nM * nN; G = G_; c = c_; }
    __device__ __forceinline__ bool next(int i, Unit& u) const {
        const long L = (long)i * G + c; if (L >= nwg) return false;
        tile_of((int)L, nM, nN, u.pm, u.pn); u.kind = 0; return true;
    }
    __device__ __forceinline__ const char* pa(const Gemm& g, const Unit& u) const { return (const char*)g.A + (size_t)u.pm * ((size_t)BM * g.K * 2); }
    __device__ __forceinline__ const char* pb(const Gemm& g, const Unit& u) const { return (const char*)g.Bt + (size_t)u.pn * ((size_t)BM * g.K * 2); }
    __device__ __forceinline__ void a_ready(const Unit&) const {}
    __device__ __forceinline__ void done(const Unit&) const {}
};
__device__ __forceinline__ unsigned cvt_pk_bf16(float lo, float hi) { unsigned r; asm volatile("v_cvt_pk_bf16_f32 %0, %1, %2" : "=v"(r) : "v"(lo), "v"(hi)); return r; }
template <bool I8> __device__ __forceinline__ f32x4 mma16(bf16x8 a, bf16x8 b, f32x4 c) {
    if constexpr (I8) { typedef int i32x4 __attribute__((ext_vector_type(4)));
        return __builtin_bit_cast(f32x4, __builtin_amdgcn_mfma_i32_16x16x64_i8(__builtin_bit_cast(i32x4, a), __builtin_bit_cast(i32x4, b), __builtin_bit_cast(i32x4, c), 0, 0, 0)); }
    else return __builtin_amdgcn_mfma_f32_16x16x32_bf16(a, b, c, 0, 0, 0);
}
template <class Epi, class Sched, bool ALIGN_EPI = false, bool SP2 = false, bool I8 = false, bool GATHER = false>
__device__ __forceinline__ void gemm_phase(PG8_LAS unsigned char* lds, const Gemm g, const Sched& S, const Epi& E) {
    int tid_l = threadIdx.x; asm volatile("" : "+v"(tid_l));
    const int tid = tid_l, wid = __builtin_amdgcn_readfirstlane(tid >> 6), lane = tid & 63, wr = wid >> 2, wc = wid & 3, fr = lane & 15, fq = lane >> 4;
    const int K = g.K, nt = K / BK;
    unsigned voffA[2], voffB[2];
#pragma unroll
    for (int i = 0; i < 2; ++i) { int R, C; stage_rc(tid * 16 + i * 8192, R, C); const int Rb = Epi::PERM ? ((R & ~31) + perm32(R & 31)) : R;
        voffA[i] = (unsigned)(R * K + C) * 2u; voffB[i] = (unsigned)(Rb * K + C) * 2u; }
    const size_t kstep = (size_t)(BK * 2);
    const size_t hstep = (size_t)HALF * K * 2;
    const unsigned ldsw = (unsigned)wid * 1024u;
    const int aoff = lds_byte(wr * 64 + fr, fq * 8), boff = lds_byte(wc * 32 + fr, fq * 8);
#define PG8_SA(b, h) (((b) * 2 + (h)) * HTB)
#define PG8_SB(b, h) ((4 + (b) * 2 + (h)) * HTB)
#define PG8_STAGE(bufoff, gbase, voff) do { _Pragma("unroll") for (int _i = 0; _i < 2; ++_i) \
        __builtin_amdgcn_global_load_lds((const unsigned*)((const char*)(gbase) + (voff)[_i]), (PG8_LAS unsigned*)(lds + (bufoff) + ldsw + _i * 8192), 16, 0, 0); } while (0)
#define PG8_STAGE_A(bufoff, ptr, h) do { if constexpr (GATHER) PG8_STAGE(bufoff, ptr, cuo + 2 * (h)); else PG8_STAGE(bufoff, (ptr) + (h) * hstep, voffA); } while (0)
#define PG8_LDA(dst, b, h) do { _Pragma("unroll") for (int m = 0; m < 4; ++m) _Pragma("unroll") for (int k = 0; k < 2; ++k) dst[m][k] = *(const PG8_LAS bf16x8*)(lds + PG8_SA(b, h) + aoff + m * 2048 + k * 1024); } while (0)
#define PG8_LDB(dst, b, h) do { _Pragma("unroll") for (int n = 0; n < 2; ++n) _Pragma("unroll") for (int k = 0; k < 2; ++k) dst[n][k] = *(const PG8_LAS bf16x8*)(lds + PG8_SB(b, h) + boff + n * 2048 + k * 1024); } while (0)
#define PG8_MMA(ai, bj, At, Bt) do { __builtin_amdgcn_s_setprio(1); _Pragma("unroll") for (int m = 0; m < 4; ++m) _Pragma("unroll") for (int n = 0; n < 2; ++n) _Pragma("unroll") for (int k = 0; k < 2; ++k) \
        acc[ai][bj][m][n] = mma16<I8>(Bt[n][k], At[m][k], acc[ai][bj][m][n]); __builtin_amdgcn_s_setprio(0); } while (0)
#define PG8_WAIT_V(n) asm volatile("s_waitcnt vmcnt(" #n ")" ::: "memory")
#define PG8_WAIT_L(n) asm volatile("s_waitcnt lgkmcnt(" #n ")" ::: "memory")
#define PG8_BAR __builtin_amdgcn_s_barrier()
#define PG8_SCHED __builtin_amdgcn_sched_barrier(0)
    Unit cur, nxt; int ui = 0;
    if (!S.next(0, cur)) return;
    unsigned cuo[4] = {0u, 0u, 0u, 0u}, cb0 = 0u; v2u_t raw = {0u, 0u};
    if constexpr (GATHER) { int R0, C0; stage_rc(tid * 16, R0, C0); cb0 = (unsigned)C0 * 2u; unsigned ro = (unsigned)R0 * 8u; asm volatile("" : "+v"(ro));
        Unit u1; const bool h1 = S.next(1, u1); const v2u_t r0 = *(const v2u_t*)((const char*)S.rowtab + (size_t)cur.pm * 512 + ro); raw = *(const v2u_t*)((const char*)S.rowtab + (size_t)(h1 ? u1.pm : cur.pm) * 512 + ro);
        cuo[0] = ((r0.x & 0xffffu) << 11) + cb0; cuo[1] = ((r0.x >> 16) << 11) + cb0; cuo[2] = ((r0.y & 0xffffu) << 11) + cb0; cuo[3] = ((r0.y >> 16) << 11) + cb0; }
    f32x4 acc[2][2][4][2];
#pragma unroll
    for (int a = 0; a < 2; ++a)
#pragma unroll
        for (int b = 0; b < 2; ++b)
#pragma unroll
            for (int m = 0; m < 4; ++m)
#pragma unroll
                for (int n = 0; n < 2; ++n) acc[a][b][m][n] = (f32x4){0.f, 0.f, 0.f, 0.f};
    bf16x8 At[4][2], B0[2][2], B1[2][2];
    const char* cA = S.pa(g, cur); const char* cB = S.pb(g, cur);
    S.a_ready(cur);
    if constexpr (SP2) {
        PG8_STAGE(PG8_SB(0, 0), cB, voffB); PG8_STAGE(PG8_SB(0, 1), cB + hstep, voffB); PG8_STAGE_A(PG8_SA(0, 0), cA, 0); PG8_STAGE_A(PG8_SA(0, 1), cA, 1);
        if (wr == 1) PG8_BAR;
        PG8_WAIT_V(2); PG8_BAR;
        PG8_STAGE(PG8_SB(1, 0), cB + kstep, voffB); PG8_STAGE_A(PG8_SA(1, 0), cA + kstep, 0); PG8_STAGE(PG8_SB(1, 1), cB + hstep + kstep, voffB);
        PG8_WAIT_V(6); PG8_BAR;
    } else {
        PG8_STAGE(PG8_SB(0, 0), cB, voffB); PG8_STAGE(PG8_SA(0, 0), cA, voffA); PG8_STAGE(PG8_SB(0, 1), cB + hstep, voffB); PG8_STAGE(PG8_SA(0, 1), cA + hstep, voffA);
        if (wr == 1) PG8_BAR;
        PG8_WAIT_V(4); PG8_BAR;
        PG8_STAGE(PG8_SB(1, 0), cB + kstep, voffB); PG8_STAGE(PG8_SA(1, 0), cA + kstep, voffA); PG8_STAGE(PG8_SB(1, 1), cB + hstep + kstep, voffB);
        PG8_WAIT_V(6); PG8_BAR;
    }
    for (;;) {
        const bool has_next = S.next(ui + 1, nxt);
        const char* nA = has_next ? S.pa(g, nxt) : cA; const char* nB = has_next ? S.pb(g, nxt) : cB;
        for (int t = 0; t < nt; t += 2) {
            const bool last = (t == nt - 2);
            const char* a1 = cA + (size_t)(t + 1) * kstep;
            const char* a2 = last ? nA : cA + (size_t)(t + 2) * kstep; const char* b2 = last ? nB : cB + (size_t)(t + 2) * kstep;
            const char* a3 = a2 + kstep; const char* b3 = b2 + kstep;
            if (last && has_next) S.a_ready(nxt);
            if constexpr (SP2) {
            PG8_LDB(B0, 0, 0); PG8_LDB(B1, 0, 1); PG8_SCHED; PG8_LDA(At, 0, 0); PG8_STAGE_A(PG8_SA(1, 1), a1, 1);
            if constexpr (GATHER) { unsigned rx = raw.x, ry = raw.y; asm volatile("" : "+v"(rx), "+v"(ry));
                const unsigned n0 = ((rx & 0xffffu) << 11) + cb0, n1 = ((rx >> 16) << 11) + cb0, n2 = ((ry & 0xffffu) << 11) + cb0, n3 = ((ry >> 16) << 11) + cb0;
                cuo[0] = last ? n0 : cuo[0]; cuo[1] = last ? n1 : cuo[1]; cuo[2] = last ? n2 : cuo[2]; cuo[3] = last ? n3 : cuo[3]; }
            PG8_WAIT_V(8); PG8_WAIT_L(0); PG8_BAR; PG8_MMA(0, 0, At, B0); PG8_MMA(0, 1, At, B1); PG8_BAR; PG8_SCHED;
            PG8_LDA(At, 0, 1); PG8_STAGE(PG8_SB(0, 0), b2, voffB); PG8_STAGE(PG8_SB(0, 1), b2 + hstep, voffB); PG8_STAGE_A(PG8_SA(0, 0), a2, 0);
            PG8_WAIT_V(8); PG8_WAIT_L(0); PG8_BAR; PG8_MMA(1, 0, At, B0); PG8_MMA(1, 1, At, B1); PG8_BAR; PG8_SCHED;
            PG8_LDB(B0, 1, 0); PG8_LDB(B1, 1, 1); PG8_SCHED; PG8_LDA(At, 1, 0); PG8_STAGE_A(PG8_SA(0, 1), a2, 1);
            PG8_WAIT_V(8); PG8_WAIT_L(0); PG8_BAR; PG8_MMA(0, 0, At, B0); PG8_MMA(0, 1, At, B1); PG8_BAR; PG8_SCHED;
            PG8_LDA(At, 1, 1); PG8_STAGE(PG8_SB(1, 0), b3, voffB); PG8_STAGE(PG8_SB(1, 1), b3 + hstep, voffB); PG8_STAGE_A(PG8_SA(1, 0), a3, 0);
            PG8_WAIT_V(8); PG8_WAIT_L(0); PG8_BAR; PG8_MMA(1, 0, At, B0); PG8_MMA(1, 1, At, B1); PG8_BAR; PG8_SCHED;
            } else {
            PG8_LDB(B0, 0, 0); PG8_SCHED; PG8_LDA(At, 0, 0); PG8_STAGE(PG8_SA(1, 1), a1 + hstep, voffA);
            PG8_WAIT_L(8); PG8_BAR; PG8_WAIT_L(0); PG8_MMA(0, 0, At, B0); PG8_BAR; PG8_SCHED;
            PG8_LDB(B1, 0, 1); PG8_STAGE(PG8_SB(0, 0), b2, voffB);
            PG8_BAR; PG8_WAIT_L(0); PG8_MMA(0, 1, At, B1); PG8_BAR;
            PG8_LDA(At, 0, 1); PG8_STAGE(PG8_SA(0, 0), a2, voffA);
            PG8_BAR; PG8_WAIT_L(0); PG8_MMA(1, 0, At, B0); PG8_BAR; PG8_SCHED;
            PG8_STAGE(PG8_SB(0, 1), b2 + hstep, voffB);
            PG8_WAIT_V(6); PG8_BAR; PG8_MMA(1, 1, At, B1); PG8_BAR;
            PG8_LDB(B0, 1, 0); PG8_SCHED; PG8_LDA(At, 1, 0); PG8_STAGE(PG8_SA(0, 1), a2 + hstep, voffA);
            PG8_WAIT_L(8); PG8_BAR; PG8_WAIT_L(0); PG8_MMA(0, 0, At, B0); PG8_BAR; PG8_SCHED;
            PG8_LDB(B1, 1, 1); PG8_STAGE(PG8_SB(1, 0), b3, voffB);
            PG8_BAR; PG8_WAIT_L(0); PG8_MMA(0, 1, At, B1); PG8_BAR;
            PG8_LDA(At, 1, 1); PG8_STAGE(PG8_SA(1, 0), a3, voffA);
            PG8_BAR; PG8_WAIT_L(0); PG8_MMA(1, 0, At, B0); PG8_BAR; PG8_SCHED;
            PG8_STAGE(PG8_SB(1, 1), b3 + hstep, voffB);
            PG8_WAIT_V(6); PG8_BAR; PG8_MMA(1, 1, At, B1); PG8_BAR;
            }
        }
        if constexpr (ALIGN_EPI) { if (wr == 0) PG8_BAR; }
        if constexpr (GATHER) { static_assert(SP2 && !Epi::AFTER_DRAIN, "GATHER is written for the SP2 loop"); int R0, C0; stage_rc(tid * 16, R0, C0); Unit u2; const bool h2 = S.next(ui + 2, u2);
            unsigned ro = (unsigned)R0 * 8u; asm volatile("" : "+v"(ro)); raw = *(const v2u_t*)((const char*)S.rowtab + (size_t)(h2 ? u2.pm : cur.pm) * 512 + ro); PG8_SCHED; }
        if constexpr (!Epi::AFTER_DRAIN) { E(acc, cur, wr, wc, fr, fq); S.done(cur); }
        if (!has_next) break;
#pragma unroll
        for (int a = 0; a < 2; ++a)
#pragma unroll
            for (int b = 0; b < 2; ++b)
#pragma unroll
                for (int m = 0; m < 4; ++m)
#pragma unroll
                    for (int n = 0; n < 2; ++n) acc[a][b][m][n] = (f32x4){0.f, 0.f, 0.f, 0.f};
        cur = nxt; cA = nA; cB = nB; ++ui;
        if constexpr (ALIGN_EPI) { if (wr == 1) PG8_BAR; }
    }
    PG8_WAIT_V(0);
    if constexpr (!ALIGN_EPI) { if (wr == 0) PG8_BAR; }
    PG8_BAR;
    if constexpr (Epi::AFTER_DRAIN) { E.fused(acc, cur, wr, wc, fr, fq, lds, wid, lane); S.done(cur); }
#undef PG8_SA
#undef PG8_SB
#undef PG8_STAGE
#undef PG8_STAGE_A
#undef PG8_LDA
#undef PG8_LDB
#undef PG8_MMA
#undef PG8_WAIT_V
#undef PG8_WAIT_L
#undef PG8_BAR
#undef PG8_SCHED
}
}

#define GAS __attribute__((address_space(1)))
#define LAS __attribute__((address_space(3)))
typedef unsigned short bf16;
typedef unsigned v4u __attribute__((ext_vector_type(4)));
typedef unsigned v2u __attribute__((ext_vector_type(2)));
typedef float f32x4 __attribute__((ext_vector_type(4)));
typedef short bf16x8 __attribute__((ext_vector_type(8)));

constexpr int NB = 8, SEQ = 4096, DM = 2048, T = NB * SEQ;
constexpr int NPT = 23;
constexpr int NE = 32, DFF = 2048;
constexpr int MAXTILES = 544;
constexpr float RMS_EPS = 1e-5f;
constexpr int NVB = 256, TPV = T / NVB;

enum { I_X = 0, I_NMIX, I_WIN, I_WA2, I_BA, I_GLAG, I_PEK, I_WK1, I_WK2, I_PEV, I_WV1, I_WV2, I_NSAG, I_RELB, I_WOUT, I_NFFN, I_RW, I_RB, I_W1, I_B1, I_W2, I_B2, I_NFIN, N_IN };

constexpr size_t MiB = 1u << 20;
constexpr size_t al(size_t x) { return (x + 255) & ~(size_t)255; }
constexpr size_t WS_CTL = 0, CTL_BYTES = 1 * MiB;
constexpr size_t WS_CNT = WS_CTL + CTL_BYTES;
constexpr size_t WS_META = WS_CNT + al(NVB * 32 * 4);
constexpr size_t WS_EIDX = WS_META + al((64 + MAXTILES) * 4);
constexpr size_t WS_LRNK = WS_EIDX + al((size_t)T * 4 * 4);
constexpr size_t WS_GATE = WS_LRNK + al((size_t)T * 4 * 4);
constexpr size_t WS_POS = WS_GATE + al((size_t)T * 4 * 4);
constexpr size_t WS_ROWW = WS_POS + al((size_t)T * 4 * 4);
constexpr size_t WS_WINT = al(WS_ROWW + (size_t)MAXTILES * 256 * 4);
constexpr size_t WS_WOT = WS_WINT + (size_t)NPT * 256 * DM * 2;
constexpr size_t WS_WKCT = WS_WOT + (size_t)DM * DM * 2;
constexpr size_t WS_WVCT = WS_WKCT + (size_t)256 * 2048 * 2;
constexpr size_t WS_W1T = WS_WVCT + (size_t)256 * 2048 * 2;
constexpr size_t WS_W2T = WS_W1T + (size_t)NE * 4096 * DM * 2;
constexpr size_t WS_XN = WS_W2T + (size_t)NE * DM * DFF * 2;
constexpr size_t WS_GQ = WS_XN + (size_t)T * DM * 2;
constexpr size_t WS_GK = WS_GQ + (size_t)T * 512 * 2;
constexpr size_t WS_GV = WS_GK + (size_t)T * 512 * 2;
constexpr size_t WS_GG = WS_GV + (size_t)T * 1024 * 2;
constexpr size_t WS_NQ = WS_GG + (size_t)T * 1024 * 2;
constexpr size_t WS_KC = WS_NQ + (size_t)T * 1024 * 2;
constexpr size_t WS_VC = WS_KC + (size_t)T * 256 * 2;
constexpr size_t WS_KS = WS_VC + (size_t)T * 256 * 2;
constexpr size_t WS_KW = WS_KS + (size_t)T * 256 * 2;
constexpr size_t WS_VST = WS_KW + (size_t)T * 256 * 2;
constexpr size_t WS_VWT = WS_VST + (size_t)T * 256 * 2;
constexpr size_t WS_SM = WS_VWT + (size_t)T * 256 * 2;
constexpr size_t WS_LA = WS_SM + (size_t)T * 64 * 2;
constexpr size_t WS_OG = WS_LA + (size_t)T * 512 * 4;
constexpr size_t WS_ON = WS_OG + (size_t)T * 1024 * 4;
constexpr size_t WS_KCMP = WS_ON + (size_t)T * 1024 * 4;
constexpr size_t WS_VCMPT = WS_KCMP + (size_t)16 * 256 * 128 * 2;
constexpr size_t WS_A2 = WS_VCMPT + (size_t)16 * 256 * 128 * 2;
constexpr size_t WS_HN = WS_A2 + (size_t)T * DM * 2;
constexpr size_t WS_XG = WS_HN + (size_t)T * DM * 2;
constexpr size_t WS_ACT = WS_XG + (size_t)MAXTILES * 256 * DM * 2;
constexpr size_t WS_END = WS_ACT + (size_t)MAXTILES * 256 * DFF * 2;

typedef unsigned short u16x2 __attribute__((ext_vector_type(2)));
__device__ __forceinline__ unsigned cvt2bf(float lo, float hi) { unsigned r; asm("v_cvt_pk_bf16_f32 %0, %1, %2" : "=v"(r) : "v"(lo), "v"(hi)); return r; }
__device__ __forceinline__ unsigned f2bf(float f) { return cvt2bf(f, f) & 0xffffu; }
__device__ __forceinline__ unsigned pk2(float lo, float hi) { return cvt2bf(lo, hi); }
__device__ __forceinline__ float bf2f(unsigned short v) { return __builtin_bit_cast(float, (unsigned)v << 16); }
__device__ __forceinline__ float bflo(unsigned w) { return __builtin_bit_cast(float, w << 16); }
__device__ __forceinline__ float bfhi(unsigned w) { return __builtin_bit_cast(float, w & 0xffff0000u); }
__device__ __forceinline__ float wave_sum(float v) {
#pragma unroll
    for (int o = 1; o < 64; o <<= 1) v += __shfl_xor(v, o);
    return v;
}
__device__ __forceinline__ float wave_max(float v) {
#pragma unroll
    for (int o = 1; o < 64; o <<= 1) v = fmaxf(v, __shfl_xor(v, o));
    return v;
}
#define LDS_WAIT() asm volatile("s_waitcnt lgkmcnt(0)" ::: "memory")

__device__ const unsigned char kBucket[128] = {0, 1, 2, 3, 4, 5, 6, 7, 8, 9, 10, 11, 12, 13, 14, 15, 16, 16, 16, 17, 17, 18, 18, 18, 19, 19, 19, 20, 20, 20, 20, 21, 21, 21, 21, 22, 22, 22, 22, 22, 23, 23, 23, 23, 23, 23, 24, 24, 24, 24, 24, 24, 25, 25, 25, 25, 25, 25, 25, 26, 26, 26, 26, 26, 26, 26, 26, 27, 27, 27, 27, 27, 27, 27, 27, 27, 27, 28, 28, 28, 28, 28, 28, 28, 28, 28, 28, 29, 29, 29, 29, 29, 29, 29, 29, 29, 29, 29, 29, 30, 30, 30, 30, 30, 30, 30, 30, 30, 30, 30, 30, 30, 30, 31, 31, 31, 31, 31, 31, 31, 31, 31, 31, 31, 31, 31, 31, 31};

struct Params {
    const float* in[N_IN];
    float* out;
    unsigned char* ws;
};

template <class F>
__device__ __forceinline__ void transpose_item(const float* W, int ldw, int k0, int n0, int nlim, LAS float* scr, int lane, F dst) {
#pragma unroll 8
    for (int i = 0; i < 32; ++i) { const int kk = 2 * i + (lane >> 5); const int n = n0 + (lane & 31); scr[kk * 33 + (lane & 31)] = n < nlim ? W[(size_t)(k0 + kk) * ldw + n] : 0.f; }
    LDS_WAIT(); asm volatile("" ::: "memory");
    const int c = lane & 7;
#pragma unroll
    for (int j = 0; j < 4; ++j) { const int nn = (lane >> 3) + 8 * j; const int n = n0 + nn; const LAS float* s = scr + (8 * c) * 33 + nn;
        bf16* rowp; float sc;
        if (n < nlim && dst(n, rowp, sc)) {
            v4u o; o.x = pk2(s[0 * 33] * sc, s[1 * 33] * sc); o.y = pk2(s[2 * 33] * sc, s[3 * 33] * sc); o.z = pk2(s[4 * 33] * sc, s[5 * 33] * sc); o.w = pk2(s[6 * 33] * sc, s[7 * 33] * sc);
            *(v4u*)(rowp + 8 * c) = o; } }
    LDS_WAIT(); asm volatile("" ::: "memory");
}
__device__ __forceinline__ int win_row(int n, float& sc) {
    sc = 1.f;
    if (n < 512) { sc = 0.08838834764831845f; return n; }
    if (n < 1024) return n;
    if (n < 2048) return n;
    if (n < 3072) return n;
    if (n < 3088) return 5120 + (n - 3072);
    if (n < 4112) { sc = 0.08838834764831845f; return 3072 + (n - 3088); }
    if (n < 4368) return 4096 + (n - 4112);
    if (n < 4624) return 4352 + (n - 4368);
    if (n < 4880) return 4608 + (n - 4624);
    if (n < 5136) return 5376 + (n - 4880);
    if (n < 5392) return 4864 + (n - 5136);
    if (n < 5648) return 5632 + (n - 5392);
    return 5136 + (n - 5648);
}
constexpr size_t WS_PEVP = WS_W2T;
__device__ __forceinline__ void p0_prologue(const Params& p, LAS unsigned char* lds, int gw, int NGW, int wave, int lane) {
    LAS float* scr = (LAS float*)(lds + wave * 16384);
    bf16* WinT = (bf16*)(p.ws + WS_WINT); bf16* WoT = (bf16*)(p.ws + WS_WOT); bf16* WkcT = (bf16*)(p.ws + WS_WKCT); bf16* WvcT = (bf16*)(p.ws + WS_WVCT);
    bf16* W1T = (bf16*)(p.ws + WS_W1T); bf16* W2T = (bf16*)(p.ws + WS_W2T);
    constexpr int I_IN = 32 * 178, I_O = 32 * 64, I_C = 64 * 4, I_E1 = 32 * 128, I_E2 = 32 * 64;
    constexpr int I_PE = 2 * 64;
    constexpr int NITEMS = I_O + 2 * I_C + I_PE;
    (void)I_IN; (void)WinT;
    for (int it = gw; it < NITEMS; it += NGW) {
        int r = it;
        if (r < I_O) { const int kb = r / 64, nb = r % 64, k0 = kb * 64;
            transpose_item(p.in[I_WOUT], DM, k0, nb * 32, DM, scr, lane, [&](int n, bf16*& rowp, float& sc) { sc = 1.f; rowp = WoT + (size_t)n * DM + k0; return true; }); continue; } r -= I_O;
        if (r >= 2 * I_C) { r -= 2 * I_C; const int which = r >> 6, kq = r & 63; const float* pe = p.in[which ? I_PEV : I_PEK] + kq * 64; const float* w1 = p.in[which ? I_WV1 : I_WK1] + (size_t)kq * 64 * 128 + lane;
            float a0 = 0.f, a1 = 0.f;
#pragma unroll
            for (int k = 0; k < 64; ++k) { const float pv = pe[k]; a0 += pv * w1[k * 128]; a1 += pv * w1[k * 128 + 64]; }
            float* dst = (float*)(p.ws + WS_PEVP) + (size_t)(which * 64 + kq) * 128 + lane; dst[0] = a0; dst[64] = a1; continue; }
        { const int which = r / I_C; r %= I_C; const int kb = r / 4, nb = r % 4, k0 = kb * 64;
            bf16* dstm = which ? WvcT : WkcT;
            transpose_item(p.in[which ? I_WV1 : I_WK1], 128, k0, nb * 32, 128, scr, lane, [&](int n, bf16*& rowp, float& sc) { sc = 1.f; rowp = dstm + (size_t)(n + (k0 >= 2048 ? 128 : 0)) * 2048 + (k0 & 2047); return true; }); }
        (void)I_E1; (void)I_E2; (void)W1T; (void)W2T;
    }
    const float* x = p.in[I_X]; const float* gm = p.in[I_NMIX];
    for (int m = gw; m < T; m += NGW) {
        const f32x4* xr = (const f32x4*)(x + (size_t)m * DM) + lane; f32x4 v[8]; float s = 0.f;
#pragma unroll
        for (int j = 0; j < 8; ++j) { v[j] = xr[64 * j]; s += (v[j].x * v[j].x + v[j].y * v[j].y) + (v[j].z * v[j].z + v[j].w * v[j].w); }
        const float rstd = 1.f / sqrtf(wave_sum(s) * (1.f / DM) + RMS_EPS);
        float mxr = 0.f;
#pragma unroll
        for (int j = 0; j < 8; ++j) { const f32x4 g4 = ((const f32x4*)gm)[lane + 64 * j]; v[j].x *= rstd * g4.x; v[j].y *= rstd * g4.y; v[j].z *= rstd * g4.z; v[j].w *= rstd * g4.w;
            mxr = fmaxf(mxr, fmaxf(fmaxf(fabsf(v[j].x), fabsf(v[j].y)), fmaxf(fabsf(v[j].z), fabsf(v[j].w)))); }
        mxr = wave_max(mxr); const float qs = mxr > 0.f ? mxr * (1.f / 127.f) : 1.f, qi = 1.f / qs;
        unsigned* o4 = (unsigned*)(p.ws + WS_XN + (size_t)m * DM) + lane;
#pragma unroll
        for (int j = 0; j < 8; ++j) { const float M = 12582912.f;
            const unsigned ua = __builtin_bit_cast(unsigned, v[j].x * qi + M), ub = __builtin_bit_cast(unsigned, v[j].y * qi + M), uc = __builtin_bit_cast(unsigned, v[j].z * qi + M), ud = __builtin_bit_cast(unsigned, v[j].w * qi + M);
            o4[64 * j] = __builtin_amdgcn_perm(ub, ua, 0x0c0c0400u) | (__builtin_amdgcn_perm(ud, uc, 0x0c0c0400u) << 16); }
        if (lane == 0) ((float*)(p.ws + WS_XN + (size_t)T * DM))[m] = qs;
    }
}
#define XB_TMO      128
#define XB_XCNT(j)  (256  + 64 * (j))
#define XB_XSUB(j)  (1280 + 64 * (j))
#define XB_XGEN(j)  (2304 + 64 * (j))
#define XB_TOP      3328
#define XB_TOPGEN   3392
#define XCD_BAR_WORDS 3456
#define XB_SPIN_CAP (1u << 18)

__device__ __forceinline__ unsigned xb_ld(unsigned* p)              { return __hip_atomic_load(p, __ATOMIC_RELAXED, __HIP_MEMORY_SCOPE_AGENT); }
__device__ __forceinline__ unsigned xb_add(unsigned* p, unsigned v) { return __hip_atomic_fetch_add(p, v, __ATOMIC_RELAXED, __HIP_MEMORY_SCOPE_AGENT); }
__device__ __forceinline__ unsigned xb_xcc_id() { return (unsigned)__builtin_amdgcn_s_getreg((3 << 11) | 20) & 0xFu; }
#define XB_SPIN(cond, bar) do { unsigned _sp = 0; while (cond) { __builtin_amdgcn_s_sleep(1); \
    if ((++_sp & 255u) == 0u) { if (xb_ld(&(bar)[XB_TMO])) break; if (_sp > XB_SPIN_CAP) { atomicAdd(&(bar)[XB_TMO], 1u); break; } } } } while (0)

struct XcdBarrier {
    unsigned* bar; unsigned x;
    volatile LAS unsigned* st;
};

__device__ __forceinline__ XcdBarrier xcd_barrier_post(unsigned* bar, volatile LAS unsigned* st) {
    XcdBarrier b; b.bar = bar; b.x = xb_xcc_id(); b.st = st;
    if (threadIdx.x == 0) (void)xb_add(&bar[XB_XCNT(b.x)], 1u);
    return b;
}
__device__ __forceinline__ void xcd_barrier_complete(unsigned* bar, unsigned x, unsigned& nloc, unsigned& nx) {
    const unsigned G = gridDim.x * gridDim.y * gridDim.z;
    unsigned sum, cnt, mine, sp = 0u;
    for (;;) {
        sum = 0u; cnt = 0u; mine = 0u;
#pragma unroll
        for (unsigned j = 0; j < 16; ++j) { const unsigned c = xb_ld(&bar[XB_XCNT(j)]); sum += c; cnt += (c > 0u) ? 1u : 0u; mine = (j == x) ? c : mine; }
        if (sum == G) break;
        __builtin_amdgcn_s_sleep(1);
        if ((++sp & 255u) == 0u) { if (xb_ld(&bar[XB_TMO])) break; if (sp > XB_SPIN_CAP) { atomicAdd(&bar[XB_TMO], 1u); break; } }
    }
    nloc = mine > 0u ? mine : 1u; nx = cnt > 0u ? cnt : 1u;
}

__device__ __forceinline__ void xcd_barrier(const XcdBarrier& b) {
    asm volatile("s_waitcnt vmcnt(0)" ::: "memory");
    __syncthreads();
    if (threadIdx.x == 0) {
        unsigned* bar = b.bar;
        __builtin_amdgcn_s_waitcnt(0);
        unsigned nloc = b.st[0], nx = b.st[1];
        if (nloc == 0u) { xcd_barrier_complete(bar, b.x, nloc, nx); b.st[0] = nloc; b.st[1] = nx; }
        const unsigned old = xb_add(&bar[XB_XSUB(b.x)], 1u);
        const unsigned gen = old / nloc;
        if (old + 1u == (gen + 1u) * nloc) {
            __builtin_amdgcn_fence(__ATOMIC_RELEASE, "agent");
            asm volatile("s_waitcnt vmcnt(0)" ::: "memory");
            const unsigned og = xb_add(&bar[XB_TOP], 1u);
            const unsigned tg = og / nx;
            if (og + 1u == (tg + 1u) * nx) xb_add(&bar[XB_TOPGEN], 1u);
            else XB_SPIN(xb_ld(&bar[XB_TOPGEN]) == tg, bar);
            __builtin_amdgcn_fence(__ATOMIC_ACQUIRE, "agent");
            xb_add(&bar[XB_XGEN(b.x)], 1u);
            asm volatile("s_waitcnt vmcnt(0)" ::: "memory");
        } else {
            XB_SPIN(xb_ld(&bar[XB_XGEN(b.x)]) == gen, bar);
            __builtin_amdgcn_fence(__ATOMIC_ACQUIRE, "agent");
            asm volatile("s_waitcnt vmcnt(0)" ::: "memory");
        }
    }
    __syncthreads();
}

struct ProjOrder : pg8::StaticOrder {
    const bf16* xn; const bf16* wt;
    __device__ __forceinline__ bool next(int i, pg8::Unit& u) const { if (!pg8::StaticOrder::next(i, u)) return false; u.kind = (u.pn >= 21) ? 1 : 0; return true; }
    __device__ __forceinline__ const char* pa(const pg8::Gemm& g, const pg8::Unit& u) const { return u.kind ? (const char*)wt + (size_t)u.pn * ((size_t)256 * g.K * 2) : (const char*)xn + (size_t)u.pm * ((size_t)256 * g.K * 2); }
    __device__ __forceinline__ const char* pb(const pg8::Gemm& g, const pg8::Unit& u) const { return u.kind ? (const char*)xn + (size_t)u.pm * ((size_t)256 * g.K * 2) : (const char*)wt + (size_t)u.pn * ((size_t)256 * g.K * 2); }
};
struct EpiRes {
    static constexpr bool PERM = true, AFTER_DRAIN = false;
    const float* x; bf16* h;
    __device__ __forceinline__ void operator()(const pg8::f32x4 (&acc)[2][2][4][2], const pg8::Unit& u, int wr, int wc, int fr, int fq) const {
        const int row0 = u.pm * 256 + wr * 64 + fr, col0 = u.pn * 256 + wc * 32 + 8 * fq;
#pragma unroll
        for (int ai = 0; ai < 2; ++ai)
#pragma unroll
            for (int m = 0; m < 4; ++m) { const size_t off = (size_t)(row0 + ai * 128 + m * 16) * DM + col0;
#pragma unroll
                for (int bj = 0; bj < 2; ++bj) { const pg8::f32x4 x0 = *(const pg8::f32x4*)(x + off + bj * 128), x1 = *(const pg8::f32x4*)(x + off + bj * 128 + 4);
                    const pg8::f32x4 a0 = x0 + acc[ai][bj][m][0], a1 = x1 + acc[ai][bj][m][1]; pg8::u32x4 w;
                    w.x = pg8::cvt_pk_bf16(a0.x, a0.y); w.y = pg8::cvt_pk_bf16(a0.z, a0.w); w.z = pg8::cvt_pk_bf16(a1.x, a1.y); w.w = pg8::cvt_pk_bf16(a1.z, a1.w);
                    *(pg8::u32x4*)(h + off + bj * 128) = w; } }
    }
};
struct MoeOrder {
    int nM, nN, nwg, G, c; const int* tile_exp;
    __device__ __forceinline__ void init(const int* meta, int nN_, int G_, int c_) { nM = meta[0]; nN = nN_; nwg = nM * nN; G = G_; c = c_; tile_exp = meta + 64; }
    __device__ __forceinline__ bool next(int i, pg8::Unit& u) const {
        const long L = (long)i * G + c; if (L >= nwg) return false;
        pg8::tile_of<8>((int)L, nM, nN, u.pm, u.pn); u.kind = tile_exp[u.pm]; return true;
    }
    __device__ __forceinline__ const char* pa(const pg8::Gemm& g, const pg8::Unit& u) const { return (const char*)g.A + (size_t)u.pm * ((size_t)256 * g.K * 2); }
    __device__ __forceinline__ const char* pb(const pg8::Gemm& g, const pg8::Unit& u) const { return (const char*)g.Bt + ((size_t)u.kind * nN + u.pn) * ((size_t)256 * g.K * 2); }
    __device__ __forceinline__ void a_ready(const pg8::Unit&) const {}
    __device__ __forceinline__ void done(const pg8::Unit&) const {}
};

struct MoeOrderG : MoeOrder { const unsigned short* rowtab;
    __device__ __forceinline__ const char* pa(const pg8::Gemm& g, const pg8::Unit&) const { return (const char*)g.A; } };

__device__ __forceinline__ float gelu_tanh(float x) { const float u = 0.7978845608028654f * (x + 0.044715f * x * x * x); const float e = __expf(2.f * u); return 0.5f * x * (1.f + (1.f - 2.f / (e + 1.f))); }
__device__ __forceinline__ void ph_cmp_fin_simple(const Params& p, LAS float* tl, int id, int n, const float* LHall, const float* PEVall) {
    LAS float* hid = tl + 4096;
    const int which = id / (16 * 255), rem = id % (16 * 255), bg = rem / 255, c = rem % 255;
    const float* w2 = p.in[which ? I_WV2 : I_WK2];
    const float* LH = LHall + ((size_t)which * 4096 + bg * 256) * 256;
    float pev = 0.f;
#pragma unroll 8
    for (int q = 0; q < 64; ++q) pev += PEVall[(size_t)(which * 64 + q) * 128 + n];
    const float a = LH[(size_t)c * 256 + n] + LH[(size_t)(c + 1) * 256 + 128 + n] + pev;
    hid[n] = gelu_tanh(a);
    __syncthreads();
    float o = 0.f;
    for (int m = 0; m < 128; ++m) o += hid[m] * w2[m * 128 + n];
    if (which == 0) ((bf16*)(p.ws + WS_KCMP))[((size_t)bg * 256 + c) * 128 + n] = (bf16)f2bf(o);
    else ((bf16*)(p.ws + WS_VCMPT))[((size_t)bg * 128 + n) * 256 + c] = (bf16)f2bf(o);
}

namespace nsa {
constexpr int KB0 = 0, KB1 = 16384, VB0 = 32768, VB1 = 49152, LUT = 65536;
constexpr int QST = LUT + 4096, IMP = QST + 65536, SELM = IMP + 16384, LDS_END = SELM + 512;
constexpr float LOG2E = 1.4426950408889634f;
typedef float f4 __attribute__((ext_vector_type(4)));

typedef unsigned u2v __attribute__((ext_vector_type(2)));
__device__ __forceinline__ float rmax16(float x) { const unsigned u = __float_as_uint(x); const u2v r = __builtin_amdgcn_permlane16_swap(u, u, false, false); return fmaxf(__uint_as_float(r[0]), __uint_as_float(r[1])); }
__device__ __forceinline__ float rmax32(float x) { const unsigned u = __float_as_uint(x); const u2v r = __builtin_amdgcn_permlane32_swap(u, u, false, false); return fmaxf(__uint_as_float(r[0]), __uint_as_float(r[1])); }
__device__ __forceinline__ float radd16(float x) { const unsigned u = __float_as_uint(x); const u2v r = __builtin_amdgcn_permlane16_swap(u, u, false, false); return __uint_as_float(r[0]) + __uint_as_float(r[1]); }
__device__ __forceinline__ float radd32(float x) { const unsigned u = __float_as_uint(x); const u2v r = __builtin_amdgcn_permlane32_swap(u, u, false, false); return __uint_as_float(r[0]) + __uint_as_float(r[1]); }
__device__ __forceinline__ float raddq(float x) { x += __int_as_float(__builtin_amdgcn_update_dpp(0, __float_as_int(x), 0xB1, 0xF, 0xF, true)); x += __int_as_float(__builtin_amdgcn_update_dpp(0, __float_as_int(x), 0x4E, 0xF, 0xF, true)); return x; }
struct Ctx {
    LAS unsigned char* lds; int tid, lane, wave, c, gq, r;
    int s0, cur;
    const LAS unsigned char* qst;
    int pos0;
    const LAS float* lutrow;
    int koff0, voff0;
    unsigned kdo[2], vdoc[2], vdos[2];
};
__device__ __forceinline__ void dma_k(const Ctx& C, const bf16* kt, LAS unsigned char* kb) {
#pragma unroll
    for (int i = 0; i < 2; ++i) __builtin_amdgcn_global_load_lds((const unsigned*)((const char*)kt + C.kdo[i]), (LAS unsigned*)(kb + (2 * C.wave + i) * 1024), 16, 0, 0); }
__device__ __forceinline__ void dma_v(const Ctx& C, const bf16* vt, const unsigned (&vdo)[2], LAS unsigned char* vb) {
#pragma unroll
    for (int i = 0; i < 2; ++i) __builtin_amdgcn_global_load_lds((const unsigned*)((const char*)vt + vdo[i]), (LAS unsigned*)(vb + (2 * C.wave + i) * 1024), 16, 0, 0); }

__device__ __forceinline__ void compute_st(const Ctx& C, const LAS unsigned char* kb, f4 (&s)[2][4]) {
#pragma unroll
    for (int ks = 0; ks < 4; ++ks) { const bf16x8 q0 = *(const LAS bf16x8*)(C.qst + ks * 1024), q1 = *(const LAS bf16x8*)(C.qst + (4 + ks) * 1024);
#pragma unroll
        for (int kt = 0; kt < 4; ++kt) { const bf16x8 a = *(const LAS bf16x8*)(kb + kt * 4096 + (C.koff0 ^ (ks * 64)));
            s[0][kt] = __builtin_amdgcn_mfma_f32_16x16x32_bf16(a, q0, ks == 0 ? (f4){0.f, 0.f, 0.f, 0.f} : s[0][kt], 0, 0, 0);
            s[1][kt] = __builtin_amdgcn_mfma_f32_16x16x32_bf16(a, q1, ks == 0 ? (f4){0.f, 0.f, 0.f, 0.f} : s[1][kt], 0, 0, 0); }
        asm volatile("" ::: "memory"); }
}
__device__ __forceinline__ void compute_pv(const Ctx& C, const LAS unsigned char* vb, const f4 (&p)[2][4], f4 (&o)[2][8]) {
#pragma unroll
    for (int i = 0; i < 2; ++i) { bf16x8 pb[2];
#pragma unroll
        for (int qt = 0; qt < 2; ++qt) { v4u w; w.x = pg8::cvt_pk_bf16(p[qt][2 * i][0], p[qt][2 * i][1]); w.y = pg8::cvt_pk_bf16(p[qt][2 * i][2], p[qt][2 * i][3]);
            w.z = pg8::cvt_pk_bf16(p[qt][2 * i + 1][0], p[qt][2 * i + 1][1]); w.w = pg8::cvt_pk_bf16(p[qt][2 * i + 1][2], p[qt][2 * i + 1][3]); pb[qt] = __builtin_bit_cast(bf16x8, w); }
#pragma unroll
        for (int dt = 0; dt < 8; ++dt) { const v2u lo = *(const LAS v2u*)(vb + dt * 2048 + (C.voff0 ^ (i * 64))), hi = *(const LAS v2u*)(vb + dt * 2048 + (C.voff0 ^ (i * 64 + 32))); const bf16x8 a = __builtin_bit_cast(bf16x8, (v4u){lo.x, lo.y, hi.x, hi.y});
#pragma unroll
            for (int qt = 0; qt < 2; ++qt) o[qt][dt] = __builtin_amdgcn_mfma_f32_16x16x32_bf16(a, pb[qt], o[qt][dt], 0, 0, 0);
            if (dt & 1) asm volatile("" ::: "memory"); } }
}
enum { M_CMP = 0, M_SEL = 1, M_WIN = 2 };
template <int MODE, bool FAR = false>
__device__ __forceinline__ void mask_bias(const Ctx& C, f4 (&s)[2][4], int kb, int n, const LAS unsigned* selw) {
    const float NEG = -__builtin_inff();
#pragma unroll
    for (int qt = 0; qt < 2; ++qt) {
        bool tokok = true;
        if (MODE == M_SEL) tokok = ((selw[(4 * qt + (C.c >> 2)) * 2 + (n >> 5)] >> (n & 31)) & 1u) != 0u;
        if (FAR) { const float be = tokok ? C.lutrow[127] : NEG;
#pragma unroll
            for (int kt = 0; kt < 4; ++kt)
#pragma unroll
                for (int rg = 0; rg < 4; ++rg) s[qt][kt][rg] = __builtin_fmaf(s[qt][kt][rg], LOG2E, be);
            continue; }
        const int dbase = (MODE == M_CMP) ? (C.pos0 + 4 * qt - 31 - 16 * (kb + 4 * C.gq)) : (C.pos0 + 4 * qt - (kb + 4 * C.gq));
#pragma unroll
        for (int kt = 0; kt < 4; ++kt) {
#pragma unroll
            for (int rg = 0; rg < 4; ++rg) { const int d = (MODE == M_CMP) ? dbase - 16 * (16 * kt + rg) : dbase - (16 * kt + rg);
                int di = d < 0 ? 0 : d; di = di > 127 ? 127 : di; const float bias = C.lutrow[di];
                bool ok = tokok && d >= 0; if (MODE == M_WIN) ok = ok && d < 512;
                s[qt][kt][rg] = ok ? __builtin_fmaf(s[qt][kt][rg], LOG2E, bias) : NEG; }
            asm volatile("" ::: "memory"); }
    }
}
__device__ __forceinline__ void softmax_step(f4 (&s)[2][4], float (&m)[2], float (&l)[2], f4 (&o)[2][8], bool rescale_o) {
#pragma unroll
    for (int qt = 0; qt < 2; ++qt) { float mx = s[qt][0][0];
#pragma unroll
        for (int kt = 0; kt < 4; ++kt)
#pragma unroll
            for (int rg = 0; rg < 4; ++rg) mx = fmaxf(mx, s[qt][kt][rg]);
        mx = rmax32(rmax16(mx));
        const float mn = fmaxf(m[qt], mx), alpha = __builtin_amdgcn_exp2f(m[qt] - mn); m[qt] = mn; float ps = 0.f;
#pragma unroll
        for (int kt = 0; kt < 4; ++kt)
#pragma unroll
            for (int rg = 0; rg < 4; ++rg) { const float e = __builtin_amdgcn_exp2f(s[qt][kt][rg] - mn); s[qt][kt][rg] = e; ps += e; }
        l[qt] = l[qt] * alpha + ps;
        if (rescale_o && __any(alpha != 1.f)) {
#pragma unroll
            for (int dt = 0; dt < 8; ++dt) o[qt][dt] = o[qt][dt] * alpha; }
    }
}
template <int MODE>
__device__ __forceinline__ void softmax_far(const Ctx& C, f4 (&s)[2][4], int n, const LAS unsigned* selw, float (&m)[2], float (&l)[2], f4 (&o)[2][8]) {
    const float b31 = C.lutrow[127];
#pragma unroll
    for (int qt = 0; qt < 2; ++qt) {
        float be = b31;
        if (MODE == M_SEL) { const bool tokok = ((selw[(4 * qt + (C.c >> 2)) * 2 + (n >> 5)] >> (n & 31)) & 1u) != 0u; be = tokok ? b31 : -__builtin_inff(); }
        float mx = fmaxf(fmaxf(s[qt][0][0], s[qt][0][1]), fmaxf(s[qt][0][2], s[qt][0][3]));
#pragma unroll
        for (int kt = 1; kt < 4; ++kt) mx = fmaxf(mx, fmaxf(fmaxf(s[qt][kt][0], s[qt][kt][1]), fmaxf(s[qt][kt][2], s[qt][kt][3])));
        mx = rmax32(rmax16(mx));
        const float mt = __builtin_fmaf(mx, LOG2E, be), mn = fmaxf(m[qt], mt), alpha = __builtin_amdgcn_exp2f(m[qt] - mn), c0 = be - mn; m[qt] = mn; float ps = 0.f;
#pragma unroll
        for (int kt = 0; kt < 4; ++kt)
#pragma unroll
            for (int rg = 0; rg < 4; ++rg) { const float e = __builtin_amdgcn_exp2f(__builtin_fmaf(s[qt][kt][rg], LOG2E, c0)); s[qt][kt][rg] = e; ps += e; }
        l[qt] = l[qt] * alpha + ps;
        if (__any(alpha != 1.f)) {
#pragma unroll
            for (int dt = 0; dt < 8; ++dt) o[qt][dt] = o[qt][dt] * alpha; }
    }
}
}

__device__ __forceinline__ void ph_nsa(const Params& p, LAS unsigned char* lds, int idx0, int idxstride, int tid_in, int wave) {
    using namespace nsa;
    int tid = tid_in; asm volatile("" : "+v"(tid));
    const int lane = tid & 63;
    Ctx C; C.lds = lds; C.tid = tid; C.lane = lane; C.wave = wave; C.c = lane & 15; C.gq = lane >> 4; C.r = lane & 3;
    C.koff0 = C.c * 256 + ((C.gq ^ C.c) * 16);
#pragma unroll
    for (int i = 0; i < 2; ++i) { const int piece = 2 * wave + i;
        { const int row = piece * 4 + (lane >> 4), chunk = (lane & 15) ^ (row & 15); C.kdo[i] = (unsigned)(row * 256 + chunk * 16); }
        { const int row = piece * 8 + (lane >> 3), chunk = (lane & 7) ^ ((row >> 1) & 7); C.vdoc[i] = (unsigned)(row * 256 * 2 + chunk * 16); C.vdos[i] = (unsigned)(row * SEQ * 2 + chunk * 16); } }
    C.voff0 = C.c * 128 + (((C.gq >> 1) ^ ((C.c >> 1) & 7)) * 16) + (C.gq & 1) * 8;
    const bf16* NQ = (const bf16*)(p.ws + WS_NQ); const bf16* SM = (const bf16*)(p.ws + WS_SM); bf16* A2 = (bf16*)(p.ws + WS_A2);
    const float* relb = p.in[I_RELB]; const float* nsag = p.in[I_NSAG];
    LAS float* lut = (LAS float*)(lds + LUT);
    for (int i = tid; i < 8 * 128; i += 512) { const int hh = i >> 7, d = i & 127; lut[i] = relb[(int)kBucket[d] * 8 + hh] * LOG2E; }
    __syncthreads();
    LAS unsigned char* qstw = lds + QST + wave * 8192 + lane * 16; C.qst = qstw;
    LAS float* imp = (LAS float*)(lds + IMP + wave * 2048);
    LAS unsigned long long* selm = (LAS unsigned long long*)(lds + SELM + wave * 64);
#define NSA_SYNC() do { asm volatile("s_waitcnt vmcnt(0)" ::: "memory"); __syncthreads(); } while (0)
    for (int idx = idx0; idx < 512; idx += idxstride) {
        const int rnd = idx >> 8, kq = idx & 255, b = kq & 7, tq = rnd == 0 ? 63 - (kq >> 3) : (kq >> 3);
        C.s0 = tq * 64; C.cur = tq;
        const int tokl0 = 8 * wave + (C.c >> 2);
        C.pos0 = C.s0 + tokl0;
        float ssq[2] = {0.f, 0.f};
        for (int g = 0; g < 2; ++g) {
            const int bg = b * 2 + g, h = g * 4 + C.r;
            C.lutrow = lut + h * 128;
            const bf16* KCMP = (const bf16*)(p.ws + WS_KCMP) + (size_t)bg * 256 * 128; const bf16* VCMPT = (const bf16*)(p.ws + WS_VCMPT) + (size_t)bg * 128 * 256;
#pragma unroll
            for (int qt = 0; qt < 2; ++qt) { const unsigned qo = (unsigned)(((b * SEQ + (C.pos0 + 4 * qt)) * 1024 + h * 128 + 8 * C.gq) * 2);
#pragma unroll
                for (int ks = 0; ks < 4; ++ks) *(LAS bf16x8*)(qstw + (qt * 4 + ks) * 1024) = *(const bf16x8*)((const char*)NQ + qo + ks * 64); }
#pragma unroll
            for (int i = 0; i < 2; ++i) *(LAS f32x4*)((LAS unsigned char*)imp + lane * 16 + i * 1024) = (f32x4){0.f, 0.f, 0.f, 0.f};
#define NSA_OROW(qt) ((char*)A2 + (unsigned)(((b * SEQ + C.pos0 + 4 * (qt)) * DM + 1024 + h * 128 + 4 * C.gq) * 2))
            const int cmaxb = C.s0 + 63 - 31; const int nct = cmaxb >= 0 ? ((cmaxb >> 4) >> 6) + 1 : 0;
            float m[2] = {-1e30f, -1e30f}, l[2] = {0.f, 0.f};
            f4 o[2][8];
            if (nct > 0) {
                dma_k(C, KCMP, lds + KB0); NSA_SYNC();
                for (int ct = 0; ct < nct; ++ct) { const int buf = ct & 1;
                    if (ct + 1 < nct) dma_k(C, KCMP + (ct + 1) * 64 * 128, lds + (buf ? KB0 : KB1));
                    f4 s[2][4]; compute_st(C, lds + (buf ? KB1 : KB0), s); mask_bias<M_CMP>(C, s, 64 * ct, 0, (const LAS unsigned*)selm); softmax_step(s, m, l, o, false);
                    NSA_SYNC(); }
            }
            float inv[2];
#pragma unroll
            for (int qt = 0; qt < 2; ++qt) { const float lt = radd32(radd16(l[qt])); inv[qt] = lt > 0.f ? 1.f / lt : 0.f; }
#pragma unroll
            for (int qt = 0; qt < 2; ++qt)
#pragma unroll
                for (int dt = 0; dt < 8; ++dt) o[qt][dt] = (f4){0.f, 0.f, 0.f, 0.f};
            if (nct > 0) {
                dma_k(C, KCMP, lds + KB0); dma_v(C, VCMPT, C.vdoc, lds + VB0); NSA_SYNC();
                for (int ct = 0; ct < nct; ++ct) { const int buf = ct & 1;
                    if (ct + 1 < nct) { dma_k(C, KCMP + (ct + 1) * 64 * 128, lds + (buf ? KB0 : KB1)); dma_v(C, VCMPT + 64 * (ct + 1), C.vdoc, lds + (buf ? VB0 : VB1)); }
                    f4 s[2][4]; compute_st(C, lds + (buf ? KB1 : KB0), s); mask_bias<M_CMP>(C, s, 64 * ct, 0, (const LAS unsigned*)selm);
#pragma unroll
                    for (int qt = 0; qt < 2; ++qt)
#pragma unroll
                        for (int kt = 0; kt < 4; ++kt) {
#pragma unroll
                            for (int rg = 0; rg < 4; ++rg) s[qt][kt][rg] = __builtin_amdgcn_exp2f(s[qt][kt][rg] - m[qt]) * inv[qt];
                            float po = (s[qt][kt][0] + s[qt][kt][1]) + (s[qt][kt][2] + s[qt][kt][3]), p3 = s[qt][kt][3];
                            po = raddq(po); p3 = raddq(p3);
                            const int nb = 16 * ct + 4 * kt + C.gq, tl = 4 * qt + (C.c >> 2);
                            if (C.r == 0) { __hip_atomic_fetch_add((float*)(imp + tl * 64 + nb), po, __ATOMIC_RELAXED, __HIP_MEMORY_SCOPE_WORKGROUP); if (nb + 1 < 64) __hip_atomic_fetch_add((float*)(imp + tl * 64 + nb + 1), p3, __ATOMIC_RELAXED, __HIP_MEMORY_SCOPE_WORKGROUP); } }
                    compute_pv(C, lds + (buf ? VB1 : VB0), s, o);
                    NSA_SYNC(); }
            }
            LDS_WAIT(); __builtin_amdgcn_wave_barrier();
            for (int tk = 0; tk < 8; ++tk) { const int n = lane; float sc;
                if (n == 0 || n == C.cur || n == C.cur - 1) sc = 1e4f; else if (n <= C.cur) sc = imp[tk * 64 + n]; else sc = -1.f;
                const int key = ((sc < 0.f ? 0 : __float_as_int(sc) + 64) & ~63) | (63 - n);
                int rank = 0;
#pragma unroll
                for (int mm = 0; mm < 64; ++mm) rank += (__builtin_amdgcn_readlane(key, mm) > key) ? 1 : 0;
                const unsigned long long mk = __ballot(rank < 16);
                if (lane == 0) selm[tk] = mk; }
            LDS_WAIT(); __builtin_amdgcn_wave_barrier();
#pragma unroll
            for (int qt = 0; qt < 2; ++qt) { const float gt = 1.f / (1.f + __expf(-bf2f(*(const bf16*)((const char*)SM + (unsigned)(((b * SEQ + (C.pos0 + 4 * qt)) * 64 + 16 + h) * 2)))));
#pragma unroll
                for (int dt = 0; dt < 8; ++dt) { const f4 v = o[qt][dt] * gt; *(v2u*)(NSA_OROW(qt) + 32 * dt) = (v2u){pg8::cvt_pk_bf16(v[0], v[1]), pg8::cvt_pk_bf16(v[2], v[3])}; } }
#pragma unroll
            for (int br = 1; br <= 2; ++br) {
                const bf16* KX = (const bf16*)(p.ws + (br == 1 ? WS_KS : WS_KW)) + bg * SEQ * 128; const bf16* VX = (const bf16*)(p.ws + (br == 1 ? WS_VST : WS_VWT)) + bg * 128 * SEQ;
                const int n0 = br == 1 ? 0 : (C.cur >= 8 ? C.cur - 8 : 0), n1 = C.cur;
                m[0] = m[1] = -1e30f; l[0] = l[1] = 0.f;
#pragma unroll
                for (int qt = 0; qt < 2; ++qt)
#pragma unroll
                    for (int dt = 0; dt < 8; ++dt) o[qt][dt] = (f4){0.f, 0.f, 0.f, 0.f};
                int f0 = n1 + 1, f1 = n0 - 1;
                for (int n = n0; n <= n1; ++n) { const bool fa = (C.s0 - (64 * n + 63) >= 113) && (br == 1 || (C.s0 + 63 - 64 * n) < 512); if (fa) { f0 = n < f0 ? n : f0; f1 = n; } }
                const int cntf = f1 >= f0 ? f1 - f0 + 1 : 0, cnt = n1 - n0 + 1, nlo = cntf ? f0 - n0 : cnt;
#define NSA_TILE(i) ((i) < cntf ? f0 + (i) : (((i) - cntf) < nlo ? n0 + ((i) - cntf) : f1 + 1 + ((i) - cntf - nlo)))
#define NSA_BODY(FARF) { const int n = NSA_TILE(i); const int buf = i & 1; \
                    if (i + 1 < cnt) { const int nn = NSA_TILE(i + 1); dma_k(C, KX + nn * 64 * 128, lds + (buf ? KB0 : KB1)); dma_v(C, VX + 64 * nn, C.vdos, lds + (buf ? VB0 : VB1)); } \
                    bool need = true; \
                    if (br == 1) { const unsigned any = ((const LAS unsigned*)selm)[(lane & 7) * 2 + (n >> 5)] >> (n & 31); need = __any((int)(any & 1u)); } \
                    if (need) { f4 s[2][4]; compute_st(C, lds + (buf ? KB1 : KB0), s); \
                        if (FARF) { if (br == 1) softmax_far<M_SEL>(C, s, n, (const LAS unsigned*)selm, m, l, o); else softmax_far<M_WIN>(C, s, n, (const LAS unsigned*)selm, m, l, o); } \
                        else { if (br == 1) mask_bias<M_SEL, false>(C, s, 64 * n, n, (const LAS unsigned*)selm); else mask_bias<M_WIN, false>(C, s, 64 * n, n, (const LAS unsigned*)selm); \
                            softmax_step(s, m, l, o, true); } \
                        compute_pv(C, lds + (buf ? VB1 : VB0), s, o); } \
                    NSA_SYNC(); }
                { const int nf = NSA_TILE(0); dma_k(C, KX + nf * 64 * 128, lds + KB0); dma_v(C, VX + 64 * nf, C.vdos, lds + VB0); NSA_SYNC(); }
                int i = 0;
                for (; i < cntf; ++i) NSA_BODY(true)
                for (; i < cnt; ++i) NSA_BODY(false)
#undef NSA_BODY
#undef NSA_TILE
                asm volatile("s_waitcnt vmcnt(0)" ::: "memory");
#pragma unroll
                for (int qt = 0; qt < 2; ++qt) { const float lt = radd32(radd16(l[qt]));
                    const int row = b * SEQ + (C.pos0 + 4 * qt);
                    const float sc = (1.f / (1.f + __expf(-bf2f(*(const bf16*)((const char*)SM + (unsigned)((row * 64 + 16 + 8 * br + h) * 2)))))) / lt;
#pragma unroll
                    for (int dt = 0; dt < 8; ++dt) { const f4 v = o[qt][dt] * sc; v2u* sp = (v2u*)(NSA_OROW(qt) + 32 * dt); const v2u pv = *sp;
                        const float a0 = bflo(pv.x) + v[0], a1 = bfhi(pv.x) + v[1], a2 = bflo(pv.y) + v[2], a3 = bfhi(pv.y) + v[3];
                        if (br == 2) ssq[qt] += (a0 * a0 + a1 * a1) + (a2 * a2 + a3 * a3);
                        *sp = (v2u){pg8::cvt_pk_bf16(a0, a1), pg8::cvt_pk_bf16(a2, a3)}; } }
            }
        }
        float rstd[2];
#pragma unroll
        for (int qt = 0; qt < 2; ++qt) { const float t = radd32(radd16(raddq(ssq[qt]))); rstd[qt] = 1.f / sqrtf(t * (1.f / 1024.f) + RMS_EPS); }
        asm volatile("s_waitcnt vmcnt(0)" ::: "memory");
#pragma unroll
        for (int qt = 0; qt < 2; ++qt) { const int sub = C.r * 4 + C.gq; bf16* orow = (bf16*)((char*)A2 + (unsigned)(((b * SEQ + (C.pos0 + 4 * qt)) * DM + 1024) * 2 + sub * 16)); const int subz = 0;
#pragma unroll
            for (int j = 0; j < 8; ++j) { const int col = (j * 16 + subz) * 8; v4u w = *(const v4u*)((const char*)orow + (unsigned)(col * 2)); const f32x4 g0 = *(const f32x4*)((const char*)nsag + (unsigned)(col * 4 + sub * 32)), g1 = *(const f32x4*)((const char*)nsag + (unsigned)(col * 4 + sub * 32 + 16)); const float rs = rstd[qt];
                w.x = pk2(bflo(w.x) * rs * g0.x, bfhi(w.x) * rs * g0.y); w.y = pk2(bflo(w.y) * rs * g0.z, bfhi(w.y) * rs * g0.w); w.z = pk2(bflo(w.z) * rs * g1.x, bfhi(w.z) * rs * g1.y); w.w = pk2(bflo(w.w) * rs * g1.z, bfhi(w.w) * rs * g1.w);
                *(v4u*)((char*)orow + (unsigned)(col * 2)) = w; } }
        NSA_SYNC();
    }
#undef NSA_SYNC
#undef NSA_OROW
}

constexpr size_t WS_ST = WS_LA;
constexpr size_t WS_DEC = WS_ST + (size_t)2048 * 256 * 128 * 2;
static_assert(WS_DEC + (size_t)2048 * 128 * 4 <= WS_KCMP, "gla scratch overlay");
namespace gla {
typedef float f4 __attribute__((ext_vector_type(4)));
constexpr int L_ST = 0, L_KT = 65536, L_QT = 81920, L_VT = 98304, L_GA = 131072, L_GT = L_GA + 4096, L_RED = L_GT + 2048, L_END = L_RED + 512;
__device__ __forceinline__ void chunk_cumsum(const Params& p, LAS unsigned char* lds, int tid, int t0, int h, float (&P)[16], float& blast) {
    const bf16* SM = (const bf16*)(p.ws + WS_SM); const float* wa2 = p.in[I_WA2]; const float* ba = p.in[I_BA];
    LAS float* ga = (LAS float*)(lds + L_GA); LAS float* gt = (LAS float*)(lds + L_GT);
    if (tid < 128) { const int j = tid >> 1, hf = tid & 1; const v4u w = *(const v4u*)((const char*)SM + (unsigned)(((t0 + j) * 64 + hf * 8) * 2));
        LAS float* d = ga + j * 16 + hf * 8; d[0] = bflo(w.x); d[1] = bfhi(w.x); d[2] = bflo(w.y); d[3] = bfhi(w.y); d[4] = bflo(w.z); d[5] = bfhi(w.z); d[6] = bflo(w.w); d[7] = bfhi(w.w); }
    const int dk = tid & 127, jq = tid >> 7;
    float w[16];
#pragma unroll
    for (int r = 0; r < 16; ++r) w[r] = wa2[r * 512 + h * 128 + dk];
    const float bb = ba[h * 128 + dk];
    __syncthreads();
    float run = 0.f;
#pragma unroll
    for (int jj = 0; jj < 16; ++jj) { const LAS f32x4* gr = (const LAS f32x4*)(ga + (16 * jq + jj) * 16); float z = bb;
#pragma unroll
        for (int r4 = 0; r4 < 4; ++r4) { const f32x4 g4 = gr[r4]; z += g4.x * w[4 * r4] + g4.y * w[4 * r4 + 1] + g4.z * w[4 * r4 + 2] + g4.w * w[4 * r4 + 3]; }
        run += (fminf(z, 0.f) - log1pf(__expf(-fabsf(z)))) * (1.f / 16.f); P[jj] = run; }
    gt[jq * 128 + dk] = run;
    __syncthreads();
    float off = 0.f, tot = 0.f;
#pragma unroll
    for (int q = 0; q < 4; ++q) { const float t = gt[q * 128 + dk]; tot += t; if (q < jq) off += t; }
#pragma unroll
    for (int jj = 0; jj < 16; ++jj) P[jj] += off;
    blast = tot;
}
__device__ __forceinline__ void stage_raw_k(const bf16* src  , LAS unsigned char* dst, int tid, int t0, int h) {
#pragma unroll
    for (int q = 0; q < 2; ++q) { const int id = tid + 512 * q, j = id >> 4, c16 = id & 15; *(LAS v4u*)(dst + j * 256 + c16 * 16) = *(const v4u*)((const char*)src + (unsigned)(((t0 + j) * 512 + h * 128 + c16 * 8) * 2)); }
}
__device__ __forceinline__ void stage_raw_v(const Params& p, LAS unsigned char* dst, int tid, int t0, int h) {
    const bf16* GV = (const bf16*)(p.ws + WS_GV);
#pragma unroll
    for (int q = 0; q < 4; ++q) { const int id = tid + 512 * q, j = id >> 5, c = id & 31; *(LAS v4u*)(dst + j * 512 + c * 16) = *(const v4u*)((const char*)GV + (unsigned)(((t0 + j) * 1024 + h * 256 + c * 8) * 2)); }
}
__device__ __forceinline__ void fill_vt(LAS unsigned char* lds, const LAS unsigned char* rv, int tid) {
    const int dv = tid & 255, jh = tid >> 8;
    unsigned short v[32];
#pragma unroll
    for (int jj = 0; jj < 32; ++jj) v[jj] = *(const LAS bf16*)(rv + (32 * jh + jj) * 512 + dv * 2);
    LAS unsigned char* row = lds + L_VT + dv * 128; const int f = (dv >> 1) & 7;
#pragma unroll
    for (int q = 0; q < 4; ++q) { v4u w; w.x = v[8 * q] | ((unsigned)v[8 * q + 1] << 16); w.y = v[8 * q + 2] | ((unsigned)v[8 * q + 3] << 16); w.z = v[8 * q + 4] | ((unsigned)v[8 * q + 5] << 16); w.w = v[8 * q + 6] | ((unsigned)v[8 * q + 7] << 16);
        *(LAS v4u*)(row + (((4 * jh + q) ^ f) * 16)) = w; }
}
}

__device__ __forceinline__ void ph_gla_a(const Params& p, LAS unsigned char* lds, int u0, int ustride, int tid_in, int wave) {
    using namespace gla;
    int tid = tid_in; asm volatile("" : "+v"(tid));
    const int lane = tid & 63, c = lane & 15, gq = lane >> 4;
    const bf16* GK = (const bf16*)(p.ws + WS_GK); bf16* ST = (bf16*)(p.ws + WS_ST); float* DEC = (float*)(p.ws + WS_DEC);
    for (int unit = u0; unit < 2048; unit += ustride) {
        const int bh = unit >> 6, ch = unit & 63, b = bh >> 2, h = bh & 3, t0 = b * SEQ + ch * 64;
        stage_raw_k(GK, lds + 0, tid, t0, h); stage_raw_v(p, lds + 16384, tid, t0, h);
        float P[16], blast; chunk_cumsum(p, lds, tid, t0, h, P, blast);
        { const int dk = tid & 127, jq = tid >> 7;
          unsigned short kv[16];
#pragma unroll
          for (int jj = 0; jj < 16; ++jj) kv[jj] = *(const LAS bf16*)(lds + (16 * jq + jj) * 256 + dk * 2);
          unsigned pk[8];
#pragma unroll
          for (int q = 0; q < 8; ++q) pk[q] = pk2(bf2f(kv[2 * q]) * __expf(blast - P[2 * q]), bf2f(kv[2 * q + 1]) * __expf(blast - P[2 * q + 1]));
          LAS unsigned char* row = lds + L_KT + dk * 128; const int f = (dk >> 1) & 7;
          *(LAS v4u*)(row + (((2 * jq) ^ f) * 16)) = (v4u){pk[0], pk[1], pk[2], pk[3]}; *(LAS v4u*)(row + (((2 * jq + 1) ^ f) * 16)) = (v4u){pk[4], pk[5], pk[6], pk[7]};
          if (jq == 0) DEC[unit * 128 + dk] = __expf(blast); }
        fill_vt(lds, lds + 16384, tid);
        __syncthreads();
        f4 acc[16];
        const int f = (c >> 1) & 7;
        bf16x8 aF[2];
#pragma unroll
        for (int ks = 0; ks < 2; ++ks) aF[ks] = *(const LAS bf16x8*)(lds + L_KT + (16 * wave + c) * 128 + (((4 * ks + gq) ^ f) * 16));
#pragma unroll
        for (int nt = 0; nt < 16; ++nt) { acc[nt] = (f4){0.f, 0.f, 0.f, 0.f};
#pragma unroll
            for (int ks = 0; ks < 2; ++ks) { const bf16x8 bF = *(const LAS bf16x8*)(lds + L_VT + (16 * nt + c) * 128 + (((4 * ks + gq) ^ f) * 16)); acc[nt] = __builtin_amdgcn_mfma_f32_16x16x32_bf16(aF[ks], bF, acc[nt], 0, 0, 0); } }
        char* dst = (char*)ST + (size_t)unit * (256 * 128 * 2) + (unsigned)((c * 128 + 16 * wave + 4 * gq) * 2);
#pragma unroll
        for (int nt = 0; nt < 16; ++nt) *(v2u*)(dst + nt * 16 * 256) = (v2u){pg8::cvt_pk_bf16(acc[nt][0], acc[nt][1]), pg8::cvt_pk_bf16(acc[nt][2], acc[nt][3])};
        __syncthreads();
    }
}
__device__ __forceinline__ void ph_gla_b(const Params& p, int gid, int gstride) {
    bf16* ST = (bf16*)(p.ws + WS_ST); const float* DEC = (const float*)(p.ws + WS_DEC);
    for (int e = gid; e < 32 * 4096; e += gstride) { const int bh = e >> 12, dv = (e >> 4) & 255, d8 = e & 15;
        float st[8];
#pragma unroll
        for (int i = 0; i < 8; ++i) st[i] = 0.f;
        char* base = (char*)ST + (size_t)bh * 64 * (256 * 128 * 2) + (unsigned)((dv * 128 + d8 * 8) * 2); const float* dbase = DEC + (size_t)bh * 64 * 128 + d8 * 8;
#pragma unroll 4
        for (int ch = 0; ch < 64; ++ch) { v4u* ptr = (v4u*)(base + (size_t)ch * (256 * 128 * 2)); const v4u w = *ptr; const f32x4 d0 = *(const f32x4*)(dbase + ch * 128), d1 = *(const f32x4*)(dbase + ch * 128 + 4);
            v4u o; o.x = pk2(st[0], st[1]); o.y = pk2(st[2], st[3]); o.z = pk2(st[4], st[5]); o.w = pk2(st[6], st[7]); *ptr = o;
            st[0] = st[0] * d0.x + bflo(w.x); st[1] = st[1] * d0.y + bfhi(w.x); st[2] = st[2] * d0.z + bflo(w.y); st[3] = st[3] * d0.w + bfhi(w.y);
            st[4] = st[4] * d1.x + bflo(w.z); st[5] = st[5] * d1.y + bfhi(w.z); st[6] = st[6] * d1.z + bflo(w.w); st[7] = st[7] * d1.w + bfhi(w.w); }
    }
}
__device__ __forceinline__ void ph_gla_c(const Params& p, LAS unsigned char* lds, int u0, int ustride, int tid_in, int wave) {
    using namespace gla;
    int tid = tid_in; asm volatile("" : "+v"(tid));
    const int lane = tid & 63, c = lane & 15, gq = lane >> 4, nt = wave & 3, half = wave >> 2;
    const bf16* GQ = (const bf16*)(p.ws + WS_GQ); const bf16* GK = (const bf16*)(p.ws + WS_GK); const bf16* GG = (const bf16*)(p.ws + WS_GG); const bf16* ST = (const bf16*)(p.ws + WS_ST);
    bf16* A2 = (bf16*)(p.ws + WS_A2); const float* gn = p.in[I_GLAG];
    const int koff0 = c * 256 + ((gq ^ c) * 16), voff0 = c * 128 + (((gq >> 1) ^ ((c >> 1) & 7)) * 16) + (gq & 1) * 8;
    for (int unit = u0; unit < 2048; unit += ustride) {
        const int bh = unit >> 6, ch = unit & 63, b = bh >> 2, h = bh & 3, t0 = b * SEQ + ch * 64;
        stage_raw_k(GQ, lds + 0, tid, t0, h); stage_raw_k(GK, lds + 16384, tid, t0, h); stage_raw_v(p, lds + 32768, tid, t0, h);
        float P[16], blast; chunk_cumsum(p, lds, tid, t0, h, P, blast);
        { const int dk = tid & 127, jq = tid >> 7;
#pragma unroll
          for (int jj = 0; jj < 16; ++jj) { const int j = 16 * jq + jj; const float qv = bf2f(*(const LAS bf16*)(lds + j * 256 + dk * 2)), kv = bf2f(*(const LAS bf16*)(lds + 16384 + j * 256 + dk * 2));
              const int off = j * 256 + (((dk >> 3) ^ (j & 15)) * 16) + (dk & 7) * 2;
              *(LAS bf16*)(lds + L_QT + off) = (bf16)f2bf(qv * __expf(P[jj])); *(LAS bf16*)(lds + L_KT + off) = (bf16)f2bf(kv * __expf(-P[jj])); } }
        fill_vt(lds, lds + 32768, tid);
        __syncthreads();
        { const char* src = (const char*)ST + (size_t)unit * (256 * 128 * 2);
#pragma unroll
          for (int i = 0; i < 8; ++i) { const int piece = 8 * wave + i, row = piece * 4 + (lane >> 4), chunk = (lane & 15) ^ (row & 15);
              __builtin_amdgcn_global_load_lds((const unsigned*)(src + (unsigned)(row * 256 + chunk * 16)), (LAS unsigned*)(lds + L_ST + piece * 1024), 16, 0, 0); } }
        asm volatile("s_waitcnt vmcnt(0)" ::: "memory"); __syncthreads();
        bf16x8 qF[4];
#pragma unroll
        for (int ks = 0; ks < 4; ++ks) qF[ks] = *(const LAS bf16x8*)(lds + L_QT + nt * 4096 + (koff0 ^ (ks * 64)));
        f4 sT[4];
#pragma unroll
        for (int jt = 0; jt < 4; ++jt) { sT[jt] = (f4){0.f, 0.f, 0.f, 0.f};
            if (jt <= nt) {
#pragma unroll
                for (int ks = 0; ks < 4; ++ks) { const bf16x8 a = *(const LAS bf16x8*)(lds + L_KT + jt * 4096 + (koff0 ^ (ks * 64))); sT[jt] = __builtin_amdgcn_mfma_f32_16x16x32_bf16(a, qF[ks], sT[jt], 0, 0, 0); }
                if (jt == nt) {
#pragma unroll
                    for (int rg = 0; rg < 4; ++rg) if (4 * gq + rg > c) sT[jt][rg] = 0.f; } } }
        bf16x8 pb[2];
#pragma unroll
        for (int s = 0; s < 2; ++s) { v4u w; w.x = pg8::cvt_pk_bf16(sT[2 * s][0], sT[2 * s][1]); w.y = pg8::cvt_pk_bf16(sT[2 * s][2], sT[2 * s][3]); w.z = pg8::cvt_pk_bf16(sT[2 * s + 1][0], sT[2 * s + 1][1]); w.w = pg8::cvt_pk_bf16(sT[2 * s + 1][2], sT[2 * s + 1][3]); pb[s] = __builtin_bit_cast(bf16x8, w); }
        f4 o[8]; float ss = 0.f;
#pragma unroll
        for (int mt = 0; mt < 8; ++mt) { o[mt] = (f4){0.f, 0.f, 0.f, 0.f}; const int rb = 128 * half + 16 * mt;
#pragma unroll
            for (int ks = 0; ks < 4; ++ks) { const bf16x8 a = *(const LAS bf16x8*)(lds + L_ST + rb * 256 + (koff0 ^ (ks * 64))); o[mt] = __builtin_amdgcn_mfma_f32_16x16x32_bf16(a, qF[ks], o[mt], 0, 0, 0); }
#pragma unroll
            for (int s = 0; s < 2; ++s) if (2 * s <= nt) { const v2u lo = *(const LAS v2u*)(lds + L_VT + rb * 128 + (voff0 ^ (s * 64))), hi = *(const LAS v2u*)(lds + L_VT + rb * 128 + (voff0 ^ (s * 64 + 32)));
                o[mt] = __builtin_amdgcn_mfma_f32_16x16x32_bf16(__builtin_bit_cast(bf16x8, (v4u){lo.x, lo.y, hi.x, hi.y}), pb[s], o[mt], 0, 0, 0); }
            ss += (o[mt][0] * o[mt][0] + o[mt][1] * o[mt][1]) + (o[mt][2] * o[mt][2] + o[mt][3] * o[mt][3]); }
        ss = nsa::radd32(nsa::radd16(ss));
        LAS float* red = (LAS float*)(lds + L_RED);
        if (gq == 0) red[half * 64 + 16 * nt + c] = ss;
        __syncthreads();
        const float rstd = 1.f / sqrtf((red[16 * nt + c] + red[64 + 16 * nt + c]) * (1.f / 256.f) + RMS_EPS);
        const int tok = t0 + 16 * nt + c;
#pragma unroll
        for (int mt = 0; mt < 8; ++mt) { const int dv = 128 * half + 16 * mt + 4 * gq; const f32x4 g4 = *(const f32x4*)((const char*)gn + (unsigned)(dv * 4));
            const v2u gg = *(const v2u*)((const char*)GG + (unsigned)((tok * 1024 + h * 256 + dv) * 2));
            const float z0 = bflo(gg.x), z1 = bfhi(gg.x), z2 = bflo(gg.y), z3 = bfhi(gg.y);
            v2u w; w.x = pg8::cvt_pk_bf16(o[mt][0] * rstd * g4.x * (z0 / (1.f + __expf(-z0))), o[mt][1] * rstd * g4.y * (z1 / (1.f + __expf(-z1))));
            w.y = pg8::cvt_pk_bf16(o[mt][2] * rstd * g4.z * (z2 / (1.f + __expf(-z2))), o[mt][3] * rstd * g4.w * (z3 / (1.f + __expf(-z3))));
            *(v2u*)((char*)A2 + (unsigned)((tok * DM + h * 256 + dv) * 2)) = w; }
        __syncthreads();
    }
}

constexpr size_t WS_LH = WS_DEC + (size_t)2048 * 128 * 4;
constexpr size_t WS_PEV = WS_LH + (size_t)2 * 4096 * 256 * 4;
static_assert(WS_PEV + 1024 <= WS_KCMP, "cmp scratch overlay");
struct CmpOrder {
    int c; const bf16 *kc, *vc, *wk, *wv;
    __device__ __forceinline__ bool next(int i, pg8::Unit& u) const { if (i > 0 || c >= 32) return false; u.pm = c & 15; u.pn = 0; u.kind = c >> 4; return true; }
    __device__ __forceinline__ const char* pa(const pg8::Gemm&, const pg8::Unit& u) const { return (const char*)(u.kind ? vc : kc) + (size_t)u.pm * ((size_t)256 * 2048 * 2); }
    __device__ __forceinline__ const char* pb(const pg8::Gemm&, const pg8::Unit& u) const { return (const char*)(u.kind ? wv : wk); }
    __device__ __forceinline__ void a_ready(const pg8::Unit&) const {}
    __device__ __forceinline__ void done(const pg8::Unit&) const {}
};
struct EpiLH {
    static constexpr bool PERM = false, AFTER_DRAIN = false;
    float* LH;
    __device__ __forceinline__ void operator()(const pg8::f32x4 (&acc)[2][2][4][2], const pg8::Unit& u, int wr, int wc, int fr, int fq) const {
        const int row0 = u.kind * 4096 + u.pm * 256 + wr * 64 + fr, col0 = wc * 32 + 4 * fq;
#pragma unroll
        for (int ai = 0; ai < 2; ++ai)
#pragma unroll
            for (int m = 0; m < 4; ++m) { float* rowp = LH + (size_t)(row0 + ai * 128 + m * 16) * 256 + col0;
#pragma unroll
                for (int bj = 0; bj < 2; ++bj)
#pragma unroll
                    for (int n = 0; n < 2; ++n) *(pg8::f32x4*)(rowp + bj * 128 + n * 16) = acc[ai][bj][m][n]; }
    }
};

constexpr size_t PROWS = (size_t)MAXTILES * 256;
constexpr size_t WS_W1Q = WS_W1T;
constexpr size_t WS_W2Q = WS_W1Q + (size_t)NE * 4096 * DM;
constexpr size_t WS_HN8 = WS_W2Q + (size_t)NE * DM * DFF;
constexpr size_t WS_AMAXP = WS_HN8 + (size_t)T * DM;
constexpr size_t WS_WSC1 = WS_AMAXP + PROWS * 64 * 4;
constexpr size_t WS_WSC2 = WS_WSC1 + (size_t)NE * 4096 * 4;
constexpr size_t WS_HSC = WS_WSC2 + (size_t)NE * 2048 * 4;
constexpr size_t WS_ROWSC = WS_HSC + (size_t)T * 4;
constexpr size_t WS_ASC = WS_ROWSC + PROWS * 4;
static_assert(WS_ASC + PROWS * 4 <= WS_XN, "int8 buffers fit in the retired bf16 expert-weight region");
constexpr size_t WS_ROWTOK = WS_CTL + 512 * 1024;
static_assert(PROWS * 2 <= 512 * 1024 && DM == 2048, "row table fits; gathered rows are 2048 bytes");
constexpr size_t WS_H16 = WS_XG;
static_assert((size_t)T * DM * 2 <= PROWS * DM, "h fits below ACT8");
constexpr size_t WS_XG8 = WS_XG;
constexpr size_t WS_ACT8 = WS_XG + PROWS * DM;
constexpr size_t WS_Y = WS_ACT;
static_assert(WS_ACT8 + PROWS * DM <= WS_ACT, "int8 row buffers fit in the retired gathered-row region");

__device__ __forceinline__ unsigned q8x4(float a, float b, float c, float d) {
    const float M = 12582912.f; const unsigned ua = __builtin_bit_cast(unsigned, a + M), ub = __builtin_bit_cast(unsigned, b + M), uc = __builtin_bit_cast(unsigned, c + M), ud = __builtin_bit_cast(unsigned, d + M);
    return __builtin_amdgcn_perm(ub, ua, 0x0c0c0400u) | (__builtin_amdgcn_perm(ud, uc, 0x0c0c0400u) << 16); }
__device__ __forceinline__ float clamp127(float v) { return __builtin_amdgcn_fmed3f(v, -127.f, 127.f); }
__device__ __forceinline__ unsigned q8x4c(float a, float b, float c, float d) { return q8x4(clamp127(a), clamp127(b), clamp127(c), clamp127(d)); }

constexpr size_t WS_WINQ = WS_WINT;
constexpr size_t WS_WISC = WS_WINT + (size_t)NPT * 256 * DM;
constexpr size_t WS_XN8 = WS_XN;
constexpr size_t WS_XSC = WS_XN + (size_t)T * DM;
constexpr size_t WS_PMAX = WS_HN;
constexpr size_t WS_PMAXI = WS_PMAX + (size_t)64 * 8 * 4096 * 4;

constexpr int NSLAB_E = NE * 192, NSLAB = NSLAB_E + 178;
struct SlabSrc { const float* W; int N; bool ok; };
__device__ __forceinline__ SlabSrc slab_src(const Params& p, int sl, int r0, int n4) {
    SlabSrc s;
    if (sl < NSLAB_E) { const int e = sl / 192, r = sl % 192; const bool isw2 = r >= 128; const int nb = isw2 ? r - 128 : r; s.N = isw2 ? 2048 : 4096;
        s.W = (isw2 ? p.in[I_W2] + (size_t)e * DFF * DM : p.in[I_W1] + (size_t)e * DM * 4096) + (size_t)r0 * s.N + nb * 32 + 4 * n4; s.ok = true; }
    else { const int nb = sl - NSLAB_E; s.N = 5672; s.ok = nb * 32 + 4 * n4 < 5672; s.W = p.in[I_WIN] + (size_t)r0 * 5672 + (s.ok ? nb * 32 + 4 * n4 : 0); }
    return s;
}
__device__ __forceinline__ void p0_slab_quant(const Params& p, LAS unsigned char* lds, int bid, int G, int tid) {
    constexpr int RS = 4104;
    LAS unsigned char* TT = lds; LAS float* part = (LAS float*)(lds + 32 * RS); LAS float* inv = part + 64 * 32; LAS int* drow = (LAS int*)(inv + 32);
    signed char* W1Q = (signed char*)(p.ws + WS_W1Q); signed char* W2Q = (signed char*)(p.ws + WS_W2Q); signed char* WIQ = (signed char*)(p.ws + WS_WINQ);
    float* WSC1 = (float*)(p.ws + WS_WSC1); float* WSC2 = (float*)(p.ws + WS_WSC2); float* WISC = (float*)(p.ws + WS_WISC);
    const int n4 = tid & 7, r0 = tid >> 3;
    f32x4 va[8], vb[8];
#define SLAB_ISSUE(dst, sl, j) do { if ((sl) < NSLAB) { const SlabSrc ss_ = slab_src(p, (sl), 2 * r0, n4); _Pragma("unroll") for (int u = 0; u < 8; ++u) dst[u] = __builtin_nontemporal_load((const f32x4*)(ss_.W + (size_t)(128 * (4 * (j) + (u >> 1)) + (u & 1)) * ss_.N)); } } while (0)
#define SLAB_USE(src, j) do { _Pragma("unroll") for (int u2 = 0; u2 < 4; ++u2) { const f32x4 xa = src[2 * u2], xb = src[2 * u2 + 1]; const int k = 2 * r0 + 128 * (4 * (j) + u2);        \
            const unsigned w0 = cvt2bf(xa.x, xb.x), w1 = cvt2bf(xa.y, xb.y), w2 = cvt2bf(xa.z, xb.z), w3 = cvt2bf(xa.w, xb.w);        \
            mx0 = __builtin_elementwise_max(mx0, __builtin_bit_cast(u16x2, w0 & 0x7fff7fffu)); mx1 = __builtin_elementwise_max(mx1, __builtin_bit_cast(u16x2, w1 & 0x7fff7fffu)); \
            mx2 = __builtin_elementwise_max(mx2, __builtin_bit_cast(u16x2, w2 & 0x7fff7fffu)); mx3 = __builtin_elementwise_max(mx3, __builtin_bit_cast(u16x2, w3 & 0x7fff7fffu)); \
            LAS unsigned char* d = TT + (4 * n4) * RS + k * 2; \
            *(LAS unsigned*)d = w0; *(LAS unsigned*)(d + RS) = w1; *(LAS unsigned*)(d + 2 * RS) = w2; *(LAS unsigned*)(d + 3 * RS) = w3; } } while (0)
    SLAB_ISSUE(va, bid, 0); SLAB_ISSUE(vb, bid, 1);
    for (int slab = bid; slab < NSLAB; slab += G) {
        u16x2 mx0 = (u16x2){0, 0}, mx1 = (u16x2){0, 0}, mx2 = (u16x2){0, 0}, mx3 = (u16x2){0, 0};
        SLAB_USE(va, 0); SLAB_ISSUE(va, slab, 2);
        SLAB_USE(vb, 1); SLAB_ISSUE(vb, slab, 3);
        SLAB_USE(va, 2); SLAB_ISSUE(va, slab + G, 0);
        SLAB_USE(vb, 3); SLAB_ISSUE(vb, slab + G, 1);
        { u16x2 t0, t1; { const unsigned m0 = __builtin_bit_cast(unsigned, mx0), m1 = __builtin_bit_cast(unsigned, mx1), m2 = __builtin_bit_cast(unsigned, mx2), m3 = __builtin_bit_cast(unsigned, mx3);
            t0 = __builtin_elementwise_max(__builtin_bit_cast(u16x2, __builtin_amdgcn_perm(m1, m0, 0x05040100u)), __builtin_bit_cast(u16x2, __builtin_amdgcn_perm(m1, m0, 0x07060302u)));
            t1 = __builtin_elementwise_max(__builtin_bit_cast(u16x2, __builtin_amdgcn_perm(m3, m2, 0x05040100u)), __builtin_bit_cast(u16x2, __builtin_amdgcn_perm(m3, m2, 0x07060302u))); }
#pragma unroll
          for (int o = 8; o < 64; o <<= 1) { t0 = __builtin_elementwise_max(t0, __builtin_bit_cast(u16x2, __shfl_xor(__builtin_bit_cast(int, t0), o))); t1 = __builtin_elementwise_max(t1, __builtin_bit_cast(u16x2, __shfl_xor(__builtin_bit_cast(int, t1), o))); }
          const unsigned a0 = __builtin_bit_cast(unsigned, t0), a1 = __builtin_bit_cast(unsigned, t1);
          if ((tid & 63) < 8) *(LAS f32x4*)(part + (tid >> 6) * 32 + 4 * n4) = (f32x4){bflo(a0), bfhi(a0), bflo(a1), bfhi(a1)}; }
        __syncthreads();
        if (tid < 32) { float m = 0.f;
#pragma unroll
            for (int q = 0; q < 8; ++q) m = fmaxf(m, part[q * 32 + tid]);
            const float sc = m > 0.f ? m * (1.f / 127.f) : 1.f; inv[tid] = 1.f / sc;
            if (slab < NSLAB_E) { const int e = slab / 192, r = slab % 192; const bool isw2 = r >= 128; const int n = (isw2 ? r - 128 : r) * 32 + tid;
                if (isw2) { drow[tid] = e * 2048 + n; WSC2[e * 2048 + n] = sc; }
                else { const int j2 = n & 2047, row = (j2 >> 7) * 256 + (n >= 2048 ? 128 : 0) + (j2 & 127); drow[tid] = e * 4096 + row; WSC1[e * 4096 + row] = sc; } }
            else { const int n = (slab - NSLAB_E) * 32 + tid; if (n < 5672) { float qsc; const int row = win_row(n, qsc); drow[tid] = row; WISC[row] = sc * qsc; } else drow[tid] = -1; } }
        __syncthreads();
        { const int kc = tid & 7, n = (tid >> 3) & 31, hf = tid >> 8; const float iv = inv[n]; const int dr = drow[n];
          signed char* dst = (slab < NSLAB_E ? ((slab % 192) >= 128 ? W2Q : W1Q) : WIQ) + (size_t)(dr < 0 ? 0 : dr) * 2048; const LAS unsigned char* src = TT + n * RS;
          if (dr >= 0) {
#pragma unroll
          for (int m8 = 0; m8 < 8; ++m8) { const int k0 = 16 * (kc + 8 * (hf + 2 * m8)); const LAS v2u* sp = (const LAS v2u*)(src + k0 * 2); const v2u a = sp[0], b = sp[1], c = sp[2], d = sp[3]; v4u o;
              o.x = q8x4(bflo(a.x) * iv, bfhi(a.x) * iv, bflo(a.y) * iv, bfhi(a.y) * iv); o.y = q8x4(bflo(b.x) * iv, bfhi(b.x) * iv, bflo(b.y) * iv, bfhi(b.y) * iv);
              o.z = q8x4(bflo(c.x) * iv, bfhi(c.x) * iv, bflo(c.y) * iv, bfhi(c.y) * iv); o.w = q8x4(bflo(d.x) * iv, bfhi(d.x) * iv, bflo(d.y) * iv, bfhi(d.y) * iv);
              *(v4u*)(dst + k0) = o; } } }
        __syncthreads();
    }
#undef SLAB_ISSUE
#undef SLAB_USE
}
struct EpiSwigluI8 {
    static constexpr bool PERM = true, AFTER_DRAIN = false;
    const float* b1; const float* rowsc; const float* wsc1; bf16* act; float* amaxp;
    __device__ __forceinline__ void operator()(const pg8::f32x4 (&acc)[2][2][4][2], const pg8::Unit& u, int wr, int wc, int fr, int fq) const {
        const int e = u.kind; const int cin = wc * 32 + 8 * fq; const int col = u.pn * 128 + cin; const int row0 = u.pm * 256 + wr * 64 + fr;
        const float* bg = b1 + (size_t)e * 4096 + col; const float* bl = bg + 2048; const float* sg = wsc1 + (size_t)e * 4096 + u.pn * 256 + cin; const float* sl = sg + 128;
        float gb[8], lb[8], gs[8], ls[8];
#pragma unroll
        for (int j = 0; j < 8; ++j) { gb[j] = bg[j]; lb[j] = bl[j]; gs[j] = sg[j]; ls[j] = sl[j]; }
#pragma unroll
        for (int ai = 0; ai < 2; ++ai)
#pragma unroll
            for (int m = 0; m < 4; ++m) { const int r = row0 + ai * 128 + m * 16; const float rs = rowsc[r]; float o[8]; float mx = 0.f;
#pragma unroll
                for (int n = 0; n < 2; ++n)
#pragma unroll
                    for (int j = 0; j < 4; ++j) { float gl = (float)__float_as_int(acc[ai][0][m][n][j]) * (rs * gs[n * 4 + j]) + gb[n * 4 + j]; float li = (float)__float_as_int(acc[ai][1][m][n][j]) * (rs * ls[n * 4 + j]) + lb[n * 4 + j];
                        gl = fminf(gl, 7.f); li = fminf(fmaxf(li, -7.f), 7.f);
                        const float v = gl * __builtin_amdgcn_rcpf(1.f + __builtin_amdgcn_exp2f(-2.4554669595930156f * gl)) * (li + 1.f); o[n * 4 + j] = v; mx = fmaxf(mx, fabsf(v)); }
                mx = nsa::rmax32(nsa::rmax16(mx));
                if (fq == 0) amaxp[(size_t)r * 64 + u.pn * 4 + wc] = mx;
                pg8::u32x4 w; w.x = pg8::cvt_pk_bf16(o[0], o[1]); w.y = pg8::cvt_pk_bf16(o[2], o[3]); w.z = pg8::cvt_pk_bf16(o[4], o[5]); w.w = pg8::cvt_pk_bf16(o[6], o[7]);
                *(pg8::u32x4*)(act + (size_t)r * DFF + col) = w; }
    }
};
__device__ __forceinline__ void ph_actq(const Params& p, int gw, int NGW, int lane) {
    const int nrows = ((const int*)(p.ws + WS_META))[0] * 256; const float* amaxp = (const float*)(p.ws + WS_AMAXP); const bf16* act = (const bf16*)(p.ws + WS_ACT);
    signed char* A8 = (signed char*)(p.ws + WS_ACT8); float* ASC = (float*)(p.ws + WS_ASC);
    for (int rb = gw; rb < nrows; rb += 2 * NGW) {
        const int r0 = rb, r1 = rb + NGW; const bool h1 = r1 < nrows; const int r1c = h1 ? r1 : r0;
        float m0 = amaxp[(size_t)r0 * 64 + lane], m1 = amaxp[(size_t)r1c * 64 + lane];
        const v4u* s0 = (const v4u*)(act + (size_t)r0 * DFF) + lane * 4; const v4u* s1 = (const v4u*)(act + (size_t)r1c * DFF) + lane * 4; v4u a[2][4];
#pragma unroll
        for (int j = 0; j < 4; ++j) { a[0][j] = s0[j]; a[1][j] = s1[j]; }
        m0 = wave_max(m0); m1 = wave_max(m1);
#pragma unroll
        for (int q = 0; q < 2; ++q) { const int r = q ? r1 : r0; if (q && !h1) break; const float mx = q ? m1 : m0; const float sc = mx > 0.f ? mx * (1.f / 127.f) : 1.f, iv = 1.f / sc; v4u o[2];
#pragma unroll
            for (int h = 0; h < 2; ++h) { const v4u x = a[q][2 * h], y = a[q][2 * h + 1];
                o[h].x = q8x4c(bflo(x.x) * iv, bfhi(x.x) * iv, bflo(x.y) * iv, bfhi(x.y) * iv); o[h].y = q8x4c(bflo(x.z) * iv, bfhi(x.z) * iv, bflo(x.w) * iv, bfhi(x.w) * iv);
                o[h].z = q8x4c(bflo(y.x) * iv, bfhi(y.x) * iv, bflo(y.y) * iv, bfhi(y.y) * iv); o[h].w = q8x4c(bflo(y.z) * iv, bfhi(y.z) * iv, bflo(y.w) * iv, bfhi(y.w) * iv); }
            v4u* dst = (v4u*)(A8 + (size_t)r * DFF) + lane * 2; dst[0] = o[0]; dst[1] = o[1];
            if (lane == 0) ASC[r] = sc; } }
}
struct EpiDownI8 {
    static constexpr bool PERM = true, AFTER_DRAIN = false;
    const float* b2; const float* roww; const float* asc; const float* wsc2; bf16* y;
    __device__ __forceinline__ void operator()(const pg8::f32x4 (&acc)[2][2][4][2], const pg8::Unit& u, int wr, int wc, int fr, int fq) const {
        const int e = u.kind; const int col0 = u.pn * 256 + wc * 32 + 8 * fq; const int row0 = u.pm * 256 + wr * 64 + fr;
        float bv[2][8], sv[2][8];
#pragma unroll
        for (int bj = 0; bj < 2; ++bj)
#pragma unroll
            for (int j = 0; j < 8; ++j) { bv[bj][j] = b2[(size_t)e * DM + col0 + bj * 128 + j]; sv[bj][j] = wsc2[(size_t)e * DM + col0 + bj * 128 + j]; }
#pragma unroll
        for (int ai = 0; ai < 2; ++ai)
#pragma unroll
            for (int m = 0; m < 4; ++m) { const int r = row0 + ai * 128 + m * 16; const float g = roww[r], as = asc[r];
#pragma unroll
                for (int bj = 0; bj < 2; ++bj) { float o[8];
#pragma unroll
                    for (int n = 0; n < 2; ++n)
#pragma unroll
                        for (int j = 0; j < 4; ++j) o[n * 4 + j] = ((float)__float_as_int(acc[ai][bj][m][n][j]) * (as * sv[bj][n * 4 + j]) + bv[bj][n * 4 + j]) * g;
                    pg8::u32x4 w; w.x = pg8::cvt_pk_bf16(o[0], o[1]); w.y = pg8::cvt_pk_bf16(o[2], o[3]); w.z = pg8::cvt_pk_bf16(o[4], o[5]); w.w = pg8::cvt_pk_bf16(o[6], o[7]);
                    *(pg8::u32x4*)(y + (size_t)r * DM + col0 + bj * 128) = w; } }
    }
};

struct EpiProjI8 {
    static constexpr bool PERM = true, AFTER_DRAIN = false;
    unsigned char* ws;
    __device__ __forceinline__ void operator()(const pg8::f32x4 (&acc)[2][2][4][2], const pg8::Unit& u, int wr, int wc, int fr, int fq) const {
        const int cw = wc * 32 + 8 * fq; const float* XSC = (const float*)(ws + WS_XSC); const float* WISC = (const float*)(ws + WS_WISC);
        if (u.kind == 0) {
            const int tn = u.pn; bf16* base; size_t bjs = 128; int ld = 0; bool headmajor = false; bool small = false;
            if (tn < 2) { base = (bf16*)(ws + WS_GQ) + tn * 256; ld = 512; }
            else if (tn < 4) { base = (bf16*)(ws + WS_GK) + (tn - 2) * 256; ld = 512; }
            else if (tn < 8) { base = (bf16*)(ws + WS_GV) + (tn - 4) * 256; ld = 1024; }
            else if (tn < 12) { base = (bf16*)(ws + WS_GG) + (tn - 8) * 256; ld = 1024; }
            else if (tn < 16) { base = (bf16*)(ws + WS_NQ) + (tn - 12) * 256; ld = 1024; }
            else if (tn < 20) { base = (bf16*)(ws + (tn == 16 ? WS_KC : tn == 17 ? WS_VC : tn == 18 ? WS_KS : WS_KW)); headmajor = true; bjs = (size_t)SEQ * 128; }
            else { base = (bf16*)(ws + WS_SM); ld = 64; small = true; }
            if (small && wc >= 2) return;
            float cs[2][8];
#pragma unroll
            for (int bj = 0; bj < 2; ++bj)
#pragma unroll
                for (int j = 0; j < 8; ++j) cs[bj][j] = WISC[tn * 256 + bj * 128 + cw + j];
#pragma unroll
            for (int ai = 0; ai < 2; ++ai)
#pragma unroll
                for (int m = 0; m < 4; ++m) { const int r = u.pm * 256 + ai * 128 + wr * 64 + m * 16 + fr; const float rs = XSC[r];
                    const size_t rterm = headmajor ? ((size_t)(r >> 12) * 2 * SEQ + (r & (SEQ - 1))) * 128 : (size_t)r * ld;
#pragma unroll
                    for (int bj = 0; bj < 2; ++bj) { if (small && bj) continue; float o[8];
#pragma unroll
                        for (int n = 0; n < 2; ++n)
#pragma unroll
                            for (int j = 0; j < 4; ++j) o[n * 4 + j] = (float)__float_as_int(acc[ai][bj][m][n][j]) * (rs * cs[bj][n * 4 + j]);
                        pg8::u32x4 w; w.x = pg8::cvt_pk_bf16(o[0], o[1]); w.y = pg8::cvt_pk_bf16(o[2], o[3]); w.z = pg8::cvt_pk_bf16(o[4], o[5]); w.w = pg8::cvt_pk_bf16(o[6], o[7]);
                        *(pg8::u32x4*)(base + rterm + bj * bjs + cw) = w; } }
        } else {
            bf16* base = (bf16*)(ws + (u.pn == 21 ? WS_VST : WS_VWT));
#pragma unroll
            for (int ai = 0; ai < 2; ++ai)
#pragma unroll
                for (int m = 0; m < 4; ++m) { const int dh = wr * 64 + m * 16 + fr; const float ws_ = WISC[u.pn * 256 + ai * 128 + dh];
#pragma unroll
                    for (int bj = 0; bj < 2; ++bj) { const int tok = u.pm * 256 + bj * 128 + cw; const int b = tok >> 12, s = tok & (SEQ - 1); float o[8];
                        const pg8::f32x4 x0 = *(const pg8::f32x4*)(XSC + tok), x1 = *(const pg8::f32x4*)(XSC + tok + 4);
#pragma unroll
                        for (int j = 0; j < 4; ++j) { o[j] = (float)__float_as_int(acc[ai][bj][m][0][j]) * (ws_ * x0[j]); o[4 + j] = (float)__float_as_int(acc[ai][bj][m][1][j]) * (ws_ * x1[j]); }
                        pg8::u32x4 w; w.x = pg8::cvt_pk_bf16(o[0], o[1]); w.y = pg8::cvt_pk_bf16(o[2], o[3]); w.z = pg8::cvt_pk_bf16(o[4], o[5]); w.w = pg8::cvt_pk_bf16(o[6], o[7]);
                        *(pg8::u32x4*)(base + ((size_t)(b * 2 + ai) * 128 + dh) * SEQ + s) = w; } }
        }
    }
};

__device__ __forceinline__ void r1_router(const Params& p, LAS unsigned char* lds, int vb, int tid, int wave, int lane) {
    LAS float* rowbuf = (LAS float*)lds;
    LAS float* part = (LAS float*)(lds + 65536);
    LAS int* tk = (LAS int*)(lds + 81920 + wave * 1024);
    LAS int* cntw = (LAS int*)(lds + 90112);
    const bf16* h = (const bf16*)(p.ws + WS_H16); const float* gf = p.in[I_NFFN]; const float* rw = p.in[I_RW]; const float* rb = p.in[I_RB];
    signed char* HN8 = (signed char*)(p.ws + WS_HN8);
    const int e = lane & 31, eg = tid & 31, dg = tid >> 5; int mycount = 0;
    float rwr[128];
#pragma unroll
    for (int c4 = 0; c4 < 4; ++c4) { unsigned o = (unsigned)((((dg * 128 + c4 * 32) * 32) + eg) * 4); asm volatile("" : "+v"(o));
#pragma unroll
        for (int i = 0; i < 32; ++i) rwr[c4 * 32 + i] = *(const float*)((const char*)rw + o + i * 128); }
    for (int grp = 0; grp < 16; ++grp) { const int t = vb * TPV + grp * 8 + wave;
        { const v4u* xr = (const v4u*)(h + (size_t)t * DM) + lane; float s = 0.f; v4u hw[4];
#pragma unroll
          for (int q = 0; q < 4; ++q) hw[q] = xr[64 * q];
#pragma unroll
          for (int q = 0; q < 4; ++q) { const float a0 = bflo(hw[q].x), a1 = bfhi(hw[q].x), a2 = bflo(hw[q].y), a3 = bfhi(hw[q].y), a4 = bflo(hw[q].z), a5 = bfhi(hw[q].z), a6 = bflo(hw[q].w), a7 = bfhi(hw[q].w);
              s += ((a0 * a0 + a1 * a1) + (a2 * a2 + a3 * a3)) + ((a4 * a4 + a5 * a5) + (a6 * a6 + a7 * a7)); }
          const float rstd = 1.f / sqrtf(wave_sum(s) * (1.f / DM) + RMS_EPS);
          float mxr = 0.f; LAS f32x4* hrow = (LAS f32x4*)(rowbuf + wave * 2048);
#pragma unroll
          for (int j = 0; j < 8; ++j) { const int cj = 2 * lane + 128 * (j >> 1) + (j & 1); const f32x4 g4 = ((const f32x4*)gf)[cj]; const unsigned wa = (j & 1) ? hw[j >> 1].z : hw[j >> 1].x, wb = (j & 1) ? hw[j >> 1].w : hw[j >> 1].y;
              f32x4 y; y.x = bflo(wa) * rstd * g4.x; y.y = bfhi(wa) * rstd * g4.y; y.z = bflo(wb) * rstd * g4.z; y.w = bfhi(wb) * rstd * g4.w;
              hrow[cj] = y; mxr = fmaxf(mxr, fmaxf(fmaxf(fabsf(y.x), fabsf(y.y)), fmaxf(fabsf(y.z), fabsf(y.w)))); }
          mxr = wave_max(mxr); const float qs = mxr > 0.f ? mxr * (1.f / 127.f) : 1.f, qi = 1.f / qs;
          v2u* o8 = (v2u*)(HN8 + (size_t)t * DM) + lane;
#pragma unroll
          for (int q = 0; q < 4; ++q) { const f32x4 ya = hrow[2 * lane + 128 * q], yb = hrow[2 * lane + 128 * q + 1]; v2u o;
              o.x = q8x4(ya.x * qi, ya.y * qi, ya.z * qi, ya.w * qi); o.y = q8x4(yb.x * qi, yb.y * qi, yb.z * qi, yb.w * qi); o8[64 * q] = o; }
          if (lane == 0) ((float*)(p.ws + WS_HSC))[t] = qs; }
        __syncthreads();
        { float acc[8];
#pragma unroll
          for (int tt = 0; tt < 8; ++tt) acc[tt] = 0.f;
#pragma unroll
          for (int i4 = 0; i4 < 32; ++i4) { f32x4 xv[8];
#pragma unroll
              for (int tt = 0; tt < 8; ++tt) xv[tt] = *(const LAS f32x4*)(rowbuf + tt * 2048 + dg * 128 + 4 * i4);
#pragma unroll
              for (int tt = 0; tt < 8; ++tt) acc[tt] += xv[tt].x * rwr[4 * i4] + xv[tt].y * rwr[4 * i4 + 1] + xv[tt].z * rwr[4 * i4 + 2] + xv[tt].w * rwr[4 * i4 + 3];
              if (i4 & 1) asm volatile("" ::: "memory"); }
#pragma unroll
          for (int tt = 0; tt < 8; ++tt) part[(dg * 8 + tt) * 32 + eg] = acc[tt]; }
        __syncthreads();
        { float a = rb[e];
#pragma unroll
          for (int q = 0; q < 16; ++q) a += part[(q * 8 + wave) * 32 + e];
          int rank = 0;
#pragma unroll
          for (int mm = 0; mm < 32; ++mm) { const float lm = __shfl(a, mm); rank += (lm > a || (lm == a && mm < e)) ? 1 : 0; }
          const float mx = wave_max(a); const bool sel = rank < 4;
          const float ex = (sel && lane < 32) ? __expf(a - mx) : 0.f; const float sum = wave_sum(ex);
          if (sel && lane < 32) { LAS int* q = tk + (grp * 4 + rank) * 4; q[0] = e; q[1] = mycount; q[2] = __builtin_bit_cast(int, ex / sum); ++mycount; } }
        __syncthreads();
    }
    int ln; asm volatile("v_mbcnt_lo_u32_b32 %0, -1, 0\n\tv_mbcnt_hi_u32_b32 %0, -1, %0" : "=v"(ln));
    if (ln < 32) cntw[wave * 32 + ln] = mycount;
    __syncthreads();
    if (wave == 0 && ln < 32) { int tot = 0; for (int w = 0; w < 8; ++w) tot += cntw[w * 32 + ln]; ((int*)(p.ws + WS_CNT))[vb * 32 + ln] = tot; }
    { const int i = ln >> 2, k = ln & 3; const LAS int* q = tk + (i * 4 + k) * 4; const int ee = q[0]; int base = 0; for (int w = 0; w < wave; ++w) base += cntw[w * 32 + ee];
      const int t = vb * TPV + i * 8 + wave;
      ((int*)(p.ws + WS_EIDX))[t * 4 + k] = ee; ((int*)(p.ws + WS_LRNK))[t * 4 + k] = base + q[1]; ((int*)(p.ws + WS_GATE))[t * 4 + k] = q[2]; }
    __syncthreads();
}
__device__ __forceinline__ void r2_gather(const Params& p, LAS unsigned char* lds, int vb, bool write_meta, int tid, int wave, int lane) {
    LAS int* part_tot = (LAS int*)lds;
    LAS int* part_base = part_tot + 512;
    LAS int* pbase = part_base + 512;
    const int* CNT = (const int*)(p.ws + WS_CNT);
    { const int e = tid & 31, part = tid >> 5; int tot = 0, bs = 0;
      for (int v = part * 16; v < part * 16 + 16; ++v) { const int c = CNT[v * 32 + e]; tot += c; if (v < vb) bs += c; }
      part_tot[part * 32 + e] = tot; part_base[part * 32 + e] = bs; }
    __syncthreads();
    if (tid == 0) { int ps = 0; int* meta = (int*)(p.ws + WS_META); int nt = 0;
        for (int e = 0; e < 32; ++e) { int tot = 0, bs = 0; for (int q = 0; q < 16; ++q) { tot += part_tot[q * 32 + e]; bs += part_base[q * 32 + e]; }
            pbase[e] = ps + bs; const int ntile = (tot + 255) >> 8;
            if (write_meta) for (int q = 0; q < ntile; ++q) meta[64 + nt + q] = e;
            nt += ntile; ps += ntile * 256; }
        if (write_meta) meta[0] = nt; }
    __syncthreads();
    const float* HSC = (const float*)(p.ws + WS_HSC); float* ROWSC = (float*)(p.ws + WS_ROWSC);
    const int* EIDX = (const int*)(p.ws + WS_EIDX); const int* LRNK = (const int*)(p.ws + WS_LRNK); const float* GATE = (const float*)(p.ws + WS_GATE);
    int* POS = (int*)(p.ws + WS_POS); float* ROWW = (float*)(p.ws + WS_ROWW);
    unsigned short* RT = (unsigned short*)(p.ws + WS_ROWTOK);
    { const int t = vb * TPV + (tid >> 2), k = tid & 3;
      const int pos = pbase[EIDX[t * 4 + k]] + LRNK[t * 4 + k];
      POS[t * 4 + k] = pos; ROWW[pos] = GATE[t * 4 + k]; ROWSC[pos] = HSC[t]; RT[(pos & ~255) + (pos & 63) * 4 + ((pos >> 6) & 3)] = (unsigned short)t; }
    __syncthreads();
}
__device__ __forceinline__ void pf_final(const Params& p, int gw, int NGW, int lane) {
    const bf16* Y = (const bf16*)(p.ws + WS_Y); const int* POS = (const int*)(p.ws + WS_POS); const float* gfin = p.in[I_NFIN]; const bf16* H = (const bf16*)(p.ws + WS_H16);
    for (int t = gw; t < T; t += NGW) {
        f32x4 v[8]; const v4u* hr = (const v4u*)(H + (size_t)t * DM) + lane;
#pragma unroll
        for (int q = 0; q < 4; ++q) { const v4u w = hr[64 * q]; v[2 * q] = (f32x4){bflo(w.x), bfhi(w.x), bflo(w.y), bfhi(w.y)}; v[2 * q + 1] = (f32x4){bflo(w.z), bfhi(w.z), bflo(w.w), bfhi(w.w)}; }
#pragma unroll
        for (int k = 0; k < 4; ++k) { const int pos = POS[t * 4 + k]; const v4u* yr = (const v4u*)(Y + (size_t)pos * DM) + lane;
#pragma unroll
            for (int q = 0; q < 4; ++q) { const v4u w = yr[64 * q]; v[2 * q].x += bflo(w.x); v[2 * q].y += bfhi(w.x); v[2 * q].z += bflo(w.y); v[2 * q].w += bfhi(w.y);
                v[2 * q + 1].x += bflo(w.z); v[2 * q + 1].y += bfhi(w.z); v[2 * q + 1].z += bflo(w.w); v[2 * q + 1].w += bfhi(w.w); } }
        float s = 0.f;
#pragma unroll
        for (int j = 0; j < 8; ++j) s += (v[j].x * v[j].x + v[j].y * v[j].y) + (v[j].z * v[j].z + v[j].w * v[j].w);
        const float rstd = 1.f / sqrtf(wave_sum(s) * (1.f / DM) + RMS_EPS); f32x4* xr = (f32x4*)(p.out + (size_t)t * DM);
#pragma unroll
        for (int j = 0; j < 8; ++j) { const int cj = 2 * lane + 128 * (j >> 1) + (j & 1); const f32x4 g4 = ((const f32x4*)gfin)[cj]; f32x4 o; o.x = v[j].x * rstd * g4.x; o.y = v[j].y * rstd * g4.y; o.z = v[j].z * rstd * g4.z; o.w = v[j].w * rstd * g4.w; xr[cj] = o; }
    }
}


constexpr int LDS_BYTES = 159744;
constexpr int MISC_OFF = LDS_BYTES - 256;  static_assert(nsa::LDS_END <= MISC_OFF && gla::L_END <= MISC_OFF, "LDS map");
constexpr int CW_BAR = 4096, CW_XL = 16384;
__global__ __launch_bounds__(512, 2) void mega_fwd(Params p) {
    extern __shared__ __attribute__((aligned(16))) unsigned char lds_raw[];
    LAS unsigned char* lds = (LAS unsigned char*)lds_raw;
    const int G = gridDim.x, bid = blockIdx.x, NGW = G * 8;
#define PH_IDS int tid = threadIdx.x; asm volatile("" : "+v"(tid)); const int lane = tid & 63, wave = __builtin_amdgcn_readfirstlane(tid >> 6), gw = bid * 8 + wave; (void)lane; (void)gw;
    for (int u = threadIdx.x; u < 64; u += 512) ((LAS unsigned*)(lds + MISC_OFF))[u] = 0u;
    __syncthreads();
    XcdBarrier bar = xcd_barrier_post((unsigned*)(p.ws + WS_CTL) + CW_BAR, (volatile LAS unsigned*)(lds + MISC_OFF) + 8);
    { PH_IDS; p0_prologue(p, lds, gw, NGW, wave, lane); __syncthreads(); p0_slab_quant(p, lds, bid, G, tid); }
    xcd_barrier(bar);
    { pg8::Gemm g{(const bf16*)(p.ws + WS_XN8), (const bf16*)(p.ws + WS_WINQ), T, NPT * 256, DM / 2};
      ProjOrder S; S.init(T, NPT * 256, G, bid); S.xn = g.A; S.wt = g.Bt; EpiProjI8 E{p.ws};
      pg8::gemm_phase<EpiProjI8, ProjOrder, true, true, true>(lds, g, S, E); }
    xcd_barrier(bar);
    if (bid < 32) {
        pg8::Gemm g{(const bf16*)(p.ws + WS_KC), (const bf16*)(p.ws + WS_WKCT), 4096, 256, 2048};
        CmpOrder S{bid, (const bf16*)(p.ws + WS_KC), (const bf16*)(p.ws + WS_VC), (const bf16*)(p.ws + WS_WKCT), (const bf16*)(p.ws + WS_WVCT)}; EpiLH E{(float*)(p.ws + WS_LH)};
        pg8::gemm_phase<EpiLH, CmpOrder, true, true>(lds, g, S, E);
    } else { PH_IDS; ph_gla_a(p, lds, bid - 32, G - 32, tid, wave); }
    xcd_barrier(bar);
    { PH_IDS; ph_gla_b(p, bid * 512 + tid, G * 512);
      for (int i = bid * 512 + tid; i < 16 * 128; i += G * 512) { const int bgz = i >> 7, dz = i & 127; ((bf16*)(p.ws + WS_KCMP))[((size_t)bgz * 256 + 255) * 128 + dz] = 0; ((bf16*)(p.ws + WS_VCMPT))[((size_t)bgz * 128 + dz) * 256 + 255] = 0; }
      const int ngrp = G * 4, total = 2 * 16 * 255, iters = (total + ngrp - 1) / ngrp; const int grp = tid >> 7;
      for (int it = 0; it < iters; ++it) { int id = it * ngrp + bid * 4 + grp; if (id >= total) id = total - 1;
          ph_cmp_fin_simple(p, (LAS float*)lds + grp * 4352, id, tid & 127, (const float*)(p.ws + WS_LH), (const float*)(p.ws + WS_PEVP)); __syncthreads(); } }
    xcd_barrier(bar);
    { PH_IDS; ph_nsa(p, lds, bid, G, tid, wave); }
    { PH_IDS; __syncthreads(); ph_gla_c(p, lds, bid, G, tid, wave); }
    xcd_barrier(bar);
    { pg8::Gemm g{(const bf16*)(p.ws + WS_A2), (const bf16*)(p.ws + WS_WOT), T, DM, DM};
      pg8::StaticOrder S; S.init(T, DM, G, bid); EpiRes E{p.in[I_X], (bf16*)(p.ws + WS_H16)};
      pg8::gemm_phase<EpiRes, pg8::StaticOrder, true, true>(lds, g, S, E); }
    xcd_barrier(bar);
    { PH_IDS; for (int vb = bid; vb < NVB; vb += G) r1_router(p, lds, vb, tid, wave, lane); }
    xcd_barrier(bar);
    { PH_IDS; for (int vb = bid; vb < NVB; vb += G) r2_gather(p, lds, vb, vb == 0, tid, wave, lane); }
    xcd_barrier(bar);
    { pg8::Gemm g{(const bf16*)(p.ws + WS_HN8), (const bf16*)(p.ws + WS_W1Q), MAXTILES * 256, 4096, DM / 2};
      MoeOrderG S; S.init((const int*)(p.ws + WS_META), 16, G, bid); S.rowtab = (const unsigned short*)(p.ws + WS_ROWTOK); EpiSwigluI8 E{p.in[I_B1], (const float*)(p.ws + WS_ROWSC), (const float*)(p.ws + WS_WSC1), (bf16*)(p.ws + WS_ACT), (float*)(p.ws + WS_AMAXP)};
      pg8::gemm_phase<EpiSwigluI8, MoeOrderG, true, true, true, true>(lds, g, S, E); }
    xcd_barrier(bar);
    { PH_IDS; ph_actq(p, gw, NGW, lane); }
    xcd_barrier(bar);
    { pg8::Gemm g{(const bf16*)(p.ws + WS_ACT8), (const bf16*)(p.ws + WS_W2Q), MAXTILES * 256, DM, DFF / 2};
      MoeOrder S; S.init((const int*)(p.ws + WS_META), 8, G, bid); EpiDownI8 E{p.in[I_B2], (const float*)(p.ws + WS_ROWW), (const float*)(p.ws + WS_ASC), (const float*)(p.ws + WS_WSC2), (bf16*)(p.ws + WS_Y)};
      pg8::gemm_phase<EpiDownI8, MoeOrder, true, true, true>(lds, g, S, E); }
    xcd_barrier(bar);
    { PH_IDS; pf_final(p, gw, NGW, lane); }
}

extern "C" void kernel_launch(void* const* d_in, const int* in_sizes, int n_in, void* d_out, int out_size, void* d_ws, size_t ws_size, hipStream_t stream) {
    static int grid = 0;
    if (grid == 0) {
        if (n_in != N_IN || out_size != T * DM || ws_size < WS_END) { fprintf(stderr, "kernel_launch: unexpected shapes (n_in %d out %d ws %zu need %zu)\n", n_in, out_size, ws_size, (size_t)WS_END); grid = -1; return; }
        int dev = 0, cus = 0, per_cu = 0;
        if (hipGetDevice(&dev) != hipSuccess || hipDeviceGetAttribute(&cus, hipDeviceAttributeMultiprocessorCount, dev) != hipSuccess) { grid = -1; return; }
        if (hipFuncSetAttribute((const void*)mega_fwd, hipFuncAttributeMaxDynamicSharedMemorySize, LDS_BYTES) != hipSuccess) { fprintf(stderr, "kernel_launch: hipFuncSetAttribute failed\n"); grid = -1; return; }
        if (hipOccupancyMaxActiveBlocksPerMultiprocessor(&per_cu, (const void*)mega_fwd, 512, LDS_BYTES) != hipSuccess || per_cu < 1) { fprintf(stderr, "kernel_launch: occupancy query says %d blocks per CU\n", per_cu); }
        (void)hipGetLastError();
        grid = cus;
    }
    if (grid < 0) return;
    if (hipMemsetAsync((char*)d_ws + WS_CTL, 0, CTL_BYTES, stream) != hipSuccess) return;
    Params p{};
    for (int i = 0; i < N_IN; ++i) p.in[i] = (const float*)d_in[i];
    p.out = (float*)d_out; p.ws = (unsigned char*)d_ws;
    hipLaunchKernelGGL(mega_fwd, dim3(grid), dim3(512), LDS_BYTES, stream, p);
}
```

```cpp
#include <hip/hip_runtime.h>
#include <cstdio>
#include <cstdint>
namespace pg8 {
#define PG8_LAS __attribute__((address_space(3)))
typedef unsigned short bf16_t;
typedef short bf16x8 __attribute__((ext_vector_type(8)));
typedef float f32x4 __attribute__((ext_vector_type(4)));
typedef unsigned u32x4 __attribute__((ext_vector_type(4)));
typedef unsigned v2u_t __attribute__((ext_vector_type(2)));
constexpr int BM = 256, BK = 64, HALF = 128, HTB = HALF * BK * 2  , STAGE_BYTES = 8 * HTB, NXCD = 8, WGM = 8;

__host__ __device__ __forceinline__ int lds_byte(int r, int c) { const int st = (r >> 4) * 2 + (c >> 5), rr = r & 15, cc = c & 31, ob = rr * 64 + cc * 2; return st * 1024 + (ob ^ (((ob >> 9) & 1) << 5)); }
__host__ __device__ __forceinline__ void stage_rc(int b, int& R, int& C) { const int st = b / 1024, sb = b % 1024, swz = sb ^ (((sb >> 9) & 1) << 5); R = (st >> 1) * 16 + swz / 64; C = (st & 1) * 32 + (swz % 64) / 2; }
__host__ __device__ __forceinline__ int perm32(int rho) { const int n = rho >> 4, i = rho & 15; return 8 * (i >> 2) + 4 * n + (i & 3); }

struct Unit { int pm, pn, kind; };
struct Gemm { const bf16_t* A; const bf16_t* Bt; int M, N, K; };

template <int WG = WGM> __host__ __device__ __forceinline__ void tile_of(int wgid, int nM, int nN, int& pm, int& pn) {
    const int nwg = nM * nN;
    { const int q = nwg / NXCD, r = nwg % NXCD, xcd = wgid % NXCD, off = wgid / NXCD; wgid = (xcd < r ? xcd * (q + 1) : r * (q + 1) + (xcd - r) * q) + off; }
    const int nig = WG * nN, gid = wgid / nig, fm = gid * WG, gsz = (nM - fm) < WG ? (nM - fm) : WG;
    pm = fm + ((wgid % nig) % gsz); pn = (wgid % nig) / gsz;
}
struct StaticOrder {
    int nM, nN, nwg, G, c;
    __host__ __device__ void init(int M, int N, int G_, int c_) { nM = M / BM; nN = N / BM; nwg = nM * nN; G = G_; c = c_; }
    __device__ __forceinline__ bool next(int i, Unit& u) const {
        const long L = (long)i * G + c; if (L >= nwg) return false;
        tile_of((int)L, nM, nN, u.pm, u.pn); u.kind = 0; return true;
    }
    __device__ __forceinline__ const char* pa(const Gemm& g, const Unit& u) const { return (const char*)g.A + (size_t)u.pm * ((size_t)BM * g.K * 2); }
    __device__ __forceinline__ const char* pb(const Gemm& g, const Unit& u) const { return (const char*)g.Bt + (size_t)u.pn * ((size_t)BM * g.K * 2); }
    __device__ __forceinline__ void a_ready(const Unit&) const {}
    __device__ __forceinline__ void done(const Unit&) const {}
};
__device__ __forceinline__ unsigned cvt_pk_bf16(float lo, float hi) { unsigned r; asm volatile("v_cvt_pk_bf16_f32 %0, %1, %2" : "=v"(r) : "v"(lo), "v"(hi)); return r; }
template <bool I8> __device__ __forceinline__ f32x4 mma16(bf16x8 a, bf16x8 b, f32x4 c) {
    if constexpr (I8) { typedef int i32x4 __attribute__((ext_vector_type(4)));
        return __builtin_bit_cast(f32x4, __builtin_amdgcn_mfma_i32_16x16x64_i8(__builtin_bit_cast(i32x4, a), __builtin_bit_cast(i32x4, b), __builtin_bit_cast(i32x4, c), 0, 0, 0)); }
    else return __builtin_amdgcn_mfma_f32_16x16x32_bf16(a, b, c, 0, 0, 0);
}
template <class Epi, class Sched, bool ALIGN_EPI = false, bool SP2 = false, bool I8 = false, bool GATHER = false>
__device__ __forceinline__ void gemm_phase(PG8_LAS unsigned char* lds, const Gemm g, const Sched& S, const Epi& E) {
    int tid_l = threadIdx.x; asm volatile("" : "+v"(tid_l));
    const int tid = tid_l, wid = __builtin_amdgcn_readfirstlane(tid >> 6), lane = tid & 63, wr = wid >> 2, wc = wid & 3, fr = lane & 15, fq = lane >> 4;
    const int K = g.K, nt = K / BK;
    unsigned voffA[2], voffB[2];
#pragma unroll
    for (int i = 0; i < 2; ++i) { int R, C; stage_rc(tid * 16 + i * 8192, R, C); const int Rb = Epi::PERM ? ((R & ~31) + perm32(R & 31)) : R;
        voffA[i] = (unsigned)(R * K + C) * 2u; voffB[i] = (unsigned)(Rb * K + C) * 2u; }
    const size_t kstep = (size_t)(BK * 2);
    const size_t hstep = (size_t)HALF * K * 2;
    const unsigned ldsw = (unsigned)wid * 1024u;
    const int aoff = lds_byte(wr * 64 + fr, fq * 8), boff = lds_byte(wc * 32 + fr, fq * 8);
#define PG8_SA(b, h) (((b) * 2 + (h)) * HTB)
#define PG8_SB(b, h) ((4 + (b) * 2 + (h)) * HTB)
#define PG8_STAGE(bufoff, gbase, voff) do { _Pragma("unroll") for (int _i = 0; _i < 2; ++_i) \
        __builtin_amdgcn_global_load_lds((const unsigned*)((const char*)(gbase) + (voff)[_i]), (PG8_LAS unsigned*)(lds + (bufoff) + ldsw + _i * 8192), 16, 0, 0); } while (0)
#define PG8_STAGE_A(bufoff, ptr, h) do { if constexpr (GATHER) PG8_STAGE(bufoff, ptr, cuo + 2 * (h)); else PG8_STAGE(bufoff, (ptr) + (h) * hstep, voffA); } while (0)
#define PG8_LDA(dst, b, h) do { _Pragma("unroll") for (int m = 0; m < 4; ++m) _Pragma("unroll") for (int k = 0; k < 2; ++k) dst[m][k] = *(const PG8_LAS bf16x8*)(lds + PG8_SA(b, h) + aoff + m * 2048 + k * 1024); } while (0)
#define PG8_LDB(dst, b, h) do { _Pragma("unroll") for (int n = 0; n < 2; ++n) _Pragma("unroll") for (int k = 0; k < 2; ++k) dst[n][k] = *(const PG8_LAS bf16x8*)(lds + PG8_SB(b, h) + boff + n * 2048 + k * 1024); } while (0)
#define PG8_MMA(ai, bj, At, Bt) do { __builtin_amdgcn_s_setprio(1); _Pragma("unroll") for (int m = 0; m < 4; ++m) _Pragma("unroll") for (int n = 0; n < 2; ++n) _Pragma("unroll") for (int k = 0; k < 2; ++k) \
        acc[ai][bj][m][n] = mma16<I8>(Bt[n][k], At[m][k], acc[ai][bj][m][n]); __builtin_amdgcn_s_setprio(0); } while (0)
#define PG8_WAIT_V(n) asm volatile("s_waitcnt vmcnt(" #n ")" ::: "memory")
#define PG8_WAIT_L(n) asm volatile("s_waitcnt lgkmcnt(" #n ")" ::: "memory")
#define PG8_BAR __builtin_amdgcn_s_barrier()
#define PG8_SCHED __builtin_amdgcn_sched_barrier(0)
    Unit cur, nxt; int ui = 0;
    if (!S.next(0, cur)) return;
    unsigned cuo[4] = {0u, 0u, 0u, 0u}, cb0 = 0u; v2u_t raw = {0u, 0u};
    if constexpr (GATHER) { int R0, C0; stage_rc(tid * 16, R0, C0); cb0 = (unsigned)C0 * 2u; unsigned ro = (unsigned)R0 * 8u; asm volatile("" : "+v"(ro));
        Unit u1; const bool h1 = S.next(1, u1); const v2u_t r0 = *(const v2u_t*)((const char*)S.rowtab + (size_t)cur.pm * 512 + ro); raw = *(const v2u_t*)((const char*)S.rowtab + (size_t)(h1 ? u1.pm : cur.pm) * 512 + ro);
        cuo[0] = ((r0.x & 0xffffu) << 11) + cb0; cuo[1] = ((r0.x >> 16) << 11) + cb0; cuo[2] = ((r0.y & 0xffffu) << 11) + cb0; cuo[3] = ((r0.y >> 16) << 11) + cb0; }
    f32x4 acc[2][2][4][2];
#pragma unroll
    for (int a = 0; a < 2; ++a)
#pragma unroll
        for (int b = 0; b < 2; ++b)
#pragma unroll
            for (int m = 0; m < 4; ++m)
#pragma unroll
                for (int n = 0; n < 2; ++n) acc[a][b][m][n] = (f32x4){0.f, 0.f, 0.f, 0.f};
    bf16x8 At[4][2], B0[2][2], B1[2][2];
    const char* cA = S.pa(g, cur); const char* cB = S.pb(g, cur);
    S.a_ready(cur);
    if constexpr (SP2) {
        PG8_STAGE(PG8_SB(0, 0), cB, voffB); PG8_STAGE(PG8_SB(0, 1), cB + hstep, voffB); PG8_STAGE_A(PG8_SA(0, 0), cA, 0); PG8_STAGE_A(PG8_SA(0, 1), cA, 1);
        if (wr == 1) PG8_BAR;
        PG8_WAIT_V(2); PG8_BAR;
        PG8_STAGE(PG8_SB(1, 0), cB + kstep, voffB); PG8_STAGE_A(PG8_SA(1, 0), cA + kstep, 0); PG8_STAGE(PG8_SB(1, 1), cB + hstep + kstep, voffB);
        PG8_WAIT_V(6); PG8_BAR;
    } else {
        PG8_STAGE(PG8_SB(0, 0), cB, voffB); PG8_STAGE(PG8_SA(0, 0), cA, voffA); PG8_STAGE(PG8_SB(0, 1), cB + hstep, voffB); PG8_STAGE(PG8_SA(0, 1), cA + hstep, voffA);
        if (wr == 1) PG8_BAR;
        PG8_WAIT_V(4); PG8_BAR;
        PG8_STAGE(PG8_SB(1, 0), cB + kstep, voffB); PG8_STAGE(PG8_SA(1, 0), cA + kstep, voffA); PG8_STAGE(PG8_SB(1, 1), cB + hstep + kstep, voffB);
        PG8_WAIT_V(6); PG8_BAR;
    }
    for (;;) {
        const bool has_next = S.next(ui + 1, nxt);
        const char* nA = has_next ? S.pa(g, nxt) : cA; const char* nB = has_next ? S.pb(g, nxt) : cB;
        for (int t = 0; t < nt; t += 2) {
            const bool last = (t == nt - 2);
            const char* a1 = cA + (size_t)(t + 1) * kstep;
            const char* a2 = last ? nA : cA + (size_t)(t + 2) * kstep; const char* b2 = last ? nB : cB + (size_t)(t + 2) * kstep;
            const char* a3 = a2 + kstep; const char* b3 = b2 + kstep;
            if (last && has_next) S.a_ready(nxt);
            if constexpr (SP2) {
            PG8_LDB(B0, 0, 0); PG8_LDB(B1, 0, 1); PG8_SCHED; PG8_LDA(At, 0, 0); PG8_STAGE_A(PG8_SA(1, 1), a1, 1);
            if constexpr (GATHER) { unsigned rx = raw.x, ry = raw.y; asm volatile("" : "+v"(rx), "+v"(ry));
                const unsigned n0 = ((rx & 0xffffu) << 11) + cb0, n1 = ((rx >> 16) << 11) + cb0, n2 = ((ry & 0xffffu) << 11) + cb0, n3 = ((ry >> 16) << 11) + cb0;
                cuo[0] = last ? n0 : cuo[0]; cuo[1] = last ? n1 : cuo[1]; cuo[2] = last ? n2 : cuo[2]; cuo[3] = last ? n3 : cuo[3]; }
            PG8_WAIT_V(8); PG8_WAIT_L(0); PG8_BAR; PG8_MMA(0, 0, At, B0); PG8_MMA(0, 1, At, B1); PG8_BAR; PG8_SCHED;
            PG8_LDA(At, 0, 1); PG8_STAGE(PG8_SB(0, 0), b2, voffB); PG8_STAGE(PG8_SB(0, 1), b2 + hstep, voffB); PG8_STAGE_A(PG8_SA(0, 0), a2, 0);
            PG8_WAIT_V(8); PG8_WAIT_L(0); PG8_BAR; PG8_MMA(1, 0, At, B0); PG8_MMA(1, 1, At, B1); PG8_BAR; PG8_SCHED;
            PG8_LDB(B0, 1, 0); PG8_LDB(B1, 1, 1); PG8_SCHED; PG8_LDA(At, 1, 0); PG8_STAGE_A(PG8_SA(0, 1), a2, 1);
            PG8_WAIT_V(8); PG8_WAIT_L(0); PG8_BAR; PG8_MMA(0, 0, At, B0); PG8_MMA(0, 1, At, B1); PG8_BAR; PG8_SCHED;
            PG8_LDA(At, 1, 1); PG8_STAGE(PG8_SB(1, 0), b3, voffB); PG8_STAGE(PG8_SB(1, 1), b3 + hstep, voffB); PG8_STAGE_A(PG8_SA(1, 0), a3, 0);
            PG8_WAIT_V(8); PG8_WAIT_L(0); PG8_BAR; PG8_MMA(1, 0, At, B0); PG8_MMA(1, 1, At, B1); PG8_BAR; PG8_SCHED;
            } else {
            PG8_LDB(B0, 0, 0); PG8_SCHED; PG8_LDA(At, 0, 0); PG8_STAGE(PG8_SA(1, 1), a1 + hstep, voffA);
            PG8_WAIT_L(8); PG8_BAR; PG8_WAIT_L(0); PG8_MMA(0, 0, At, B0); PG8_BAR; PG8_SCHED;
            PG8_LDB(B1, 0, 1); PG8_STAGE(PG8_SB(0, 0), b2, voffB);
            PG8_BAR; PG8_WAIT_L(0); PG8_MMA(0, 1, At, B1); PG8_BAR;
            PG8_LDA(At, 0, 1); PG8_STAGE(PG8_SA(0, 0), a2, voffA);
            PG8_BAR; PG8_WAIT_L(0); PG8_MMA(1, 0, At, B0); PG8_BAR; PG8_SCHED;
            PG8_STAGE(PG8_SB(0, 1), b2 + hstep, voffB);
            PG8_WAIT_V(6); PG8_BAR; PG8_MMA(1, 1, At, B1); PG8_BAR;
            PG8_LDB(B0, 1, 0); PG8_SCHED; PG8_LDA(At, 1, 0); PG8_STAGE(PG8_SA(0, 1), a2 + hstep, voffA);
            PG8_WAIT_L(8); PG8_BAR; PG8_WAIT_L(0); PG8_MMA(0, 0, At, B0); PG8_BAR; PG8_SCHED;
            PG8_LDB(B1, 1, 1); PG8_STAGE(PG8_SB(1, 0), b3, voffB);
            PG8_BAR; PG8_WAIT_L(0); PG8_MMA(0, 1, At, B1); PG8_BAR;
            PG8_LDA(At, 1, 1); PG8_STAGE(PG8_SA(1, 0), a3, voffA);
            PG8_BAR; PG8_WAIT_L(0); PG8_MMA(1, 0, At, B0); PG8_BAR; PG8_SCHED;
            PG8_STAGE(PG8_SB(1, 1), b3 + hstep, voffB);
            PG8_WAIT_V(6); PG8_BAR; PG8_MMA(1, 1, At, B1); PG8_BAR;
            }
        }
        if constexpr (ALIGN_EPI) { if (wr == 0) PG8_BAR; }
        if constexpr (GATHER) { static_assert(SP2 && !Epi::AFTER_DRAIN, "GATHER is written for the SP2 loop"); int R0, C0; stage_rc(tid * 16, R0, C0); Unit u2; const bool h2 = S.next(ui + 2, u2);
            unsigned ro = (unsigned)R0 * 8u; asm volatile("" : "+v"(ro)); raw = *(const v2u_t*)((const char*)S.rowtab + (size_t)(h2 ? u2.pm : cur.pm) * 512 + ro); PG8_SCHED; }
        if constexpr (!Epi::AFTER_DRAIN) { E(acc, cur, wr, wc, fr, fq); S.done(cur); }
        if (!has_next) break;
#pragma unroll
        for (int a = 0; a < 2; ++a)
#pragma unroll
            for (int b = 0; b < 2; ++b)
#pragma unroll
                for (int m = 0; m < 4; ++m)
#pragma unroll
                    for (int n = 0; n < 2; ++n) acc[a][b][m][n] = (f32x4){0.f, 0.f, 0.f, 0.f};
        cur = nxt; cA = nA; cB = nB; ++ui;
        if constexpr (ALIGN_EPI) { if (wr == 1) PG8_BAR; }
    }
    PG8_WAIT_V(0);
    if constexpr (!ALIGN_EPI) { if (wr == 0) PG8_BAR; }
    PG8_BAR;
    if constexpr (Epi::AFTER_DRAIN) { E.fused(acc, cur, wr, wc, fr, fq, lds, wid, lane); S.done(cur); }
#undef PG8_SA
#undef PG8_SB
#undef PG8_STAGE
#undef PG8_STAGE_A
#undef PG8_LDA
#undef PG8_LDB
#undef PG8_MMA
#undef PG8_WAIT_V
#undef PG8_WAIT_L
#undef PG8_BAR
#undef PG8_SCHED
}
}

#define GAS __attribute__((address_space(1)))
#define LAS __attribute__((address_space(3)))
typedef unsigned short bf16;
typedef unsigned v4u __attribute__((ext_vector_type(4)));
typedef unsigned v2u __attribute__((ext_vector_type(2)));
typedef float f32x4 __attribute__((ext_vector_type(4)));
typedef short bf16x8 __attribute__((ext_vector_type(8)));

constexpr int NB = 8, SEQ = 4096, DM = 2048, T = NB * SEQ;
constexpr int NPT = 23;
constexpr int NE = 32, DFF = 2048;
constexpr int MAXTILES = 544;
constexpr float RMS_EPS = 1e-5f;
constexpr int NVB = 256, TPV = T / NVB;

enum { I_X = 0, I_NMIX, I_WIN, I_WA2, I_BA, I_GLAG, I_PEK, I_WK1, I_WK2, I_PEV, I_WV1, I_WV2, I_NSAG, I_RELB, I_WOUT, I_NFFN, I_RW, I_RB, I_W1, I_B1, I_W2, I_B2, I_NFIN, N_IN };

constexpr size_t MiB = 1u << 20;
constexpr size_t al(size_t x) { return (x + 255) & ~(size_t)255; }
constexpr size_t WS_CTL = 0, CTL_BYTES = 1 * MiB;
constexpr size_t WS_CNT = WS_CTL + CTL_BYTES;
constexpr size_t WS_META = WS_CNT + al(NVB * 32 * 4);
constexpr size_t WS_EIDX = WS_META + al((64 + MAXTILES) * 4);
constexpr size_t WS_LRNK = WS_EIDX + al((size_t)T * 4 * 4);
constexpr size_t WS_GATE = WS_LRNK + al((size_t)T * 4 * 4);
constexpr size_t WS_POS = WS_GATE + al((size_t)T * 4 * 4);
constexpr size_t WS_ROWW = WS_POS + al((size_t)T * 4 * 4);
constexpr size_t WS_WINT = al(WS_ROWW + (size_t)MAXTILES * 256 * 4);
constexpr size_t WS_WOT = WS_WINT + (size_t)NPT * 256 * DM * 2;
constexpr size_t WS_WKCT = WS_WOT + (size_t)DM * DM * 2;
constexpr size_t WS_WVCT = WS_WKCT + (size_t)256 * 2048 * 2;
constexpr size_t WS_W1T = WS_WVCT + (size_t)256 * 2048 * 2;
constexpr size_t WS_W2T = WS_W1T + (size_t)NE * 4096 * DM * 2;
constexpr size_t WS_XN = WS_W2T + (size_t)NE * DM * DFF * 2;
constexpr size_t WS_GQ = WS_XN + (size_t)T * DM * 2;
constexpr size_t WS_GK = WS_GQ + (size_t)T * 512 * 2;
constexpr size_t WS_GV = WS_GK + (size_t)T * 512 * 2;
constexpr size_t WS_GG = WS_GV + (size_t)T * 1024 * 2;
constexpr size_t WS_NQ = WS_GG + (size_t)T * 1024 * 2;
constexpr size_t WS_KC = WS_NQ + (size_t)T * 1024 * 2;
constexpr size_t WS_VC = WS_KC + (size_t)T * 256 * 2;
constexpr size_t WS_KS = WS_VC + (size_t)T * 256 * 2;
constexpr size_t WS_KW = WS_KS + (size_t)T * 256 * 2;
constexpr size_t WS_VST = WS_KW + (size_t)T * 256 * 2;
constexpr size_t WS_VWT = WS_VST + (size_t)T * 256 * 2;
constexpr size_t WS_SM = WS_VWT + (size_t)T * 256 * 2;
constexpr size_t WS_LA = WS_SM + (size_t)T * 64 * 2;
constexpr size_t WS_OG = WS_LA + (size_t)T * 512 * 4;
constexpr size_t WS_ON = WS_OG + (size_t)T * 1024 * 4;
constexpr size_t WS_KCMP = WS_ON + (size_t)T * 1024 * 4;
constexpr size_t WS_VCMPT = WS_KCMP + (size_t)16 * 256 * 128 * 2;
constexpr size_t WS_A2 = WS_VCMPT + (size_t)16 * 256 * 128 * 2;
constexpr size_t WS_HN = WS_A2 + (size_t)T * DM * 2;
constexpr size_t WS_XG = WS_HN + (size_t)T * DM * 2;
constexpr size_t WS_ACT = WS_XG + (size_t)MAXTILES * 256 * DM * 2;
constexpr size_t WS_END = WS_ACT + (size_t)MAXTILES * 256 * DFF * 2;

typedef unsigned short u16x2 __attribute__((ext_vector_type(2)));
__device__ __forceinline__ unsigned cvt2bf(float lo, float hi) { unsigned r; asm("v_cvt_pk_bf16_f32 %0, %1, %2" : "=v"(r) : "v"(lo), "v"(hi)); return r; }
__device__ __forceinline__ unsigned f2bf(float f) { return cvt2bf(f, f) & 0xffffu; }
__device__ __forceinline__ unsigned pk2(float lo, float hi) { return cvt2bf(lo, hi); }
__device__ __forceinline__ float bf2f(unsigned short v) { return __builtin_bit_cast(float, (unsigned)v << 16); }
__device__ __forceinline__ float bflo(unsigned w) { return __builtin_bit_cast(float, w << 16); }
__device__ __forceinline__ float bfhi(unsigned w) { return __builtin_bit_cast(float, w & 0xffff0000u); }
__device__ __forceinline__ float wave_sum(float v) {
#pragma unroll
    for (int o = 1; o < 64; o <<= 1) v += __shfl_xor(v, o);
    return v;
}
__device__ __forceinline__ float wave_max(float v) {
#pragma unroll
    for (int o = 1; o < 64; o <<= 1) v = fmaxf(v, __shfl_xor(v, o));
    return v;
}
#define LDS_WAIT() asm volatile("s_waitcnt lgkmcnt(0)" ::: "memory")

__device__ const unsigned char kBucket[128] = {0, 1, 2, 3, 4, 5, 6, 7, 8, 9, 10, 11, 12, 13, 14, 15, 16, 16, 16, 17, 17, 18, 18, 18, 19, 19, 19, 20, 20, 20, 20, 21, 21, 21, 21, 22, 22, 22, 22, 22, 23, 23, 23, 23, 23, 23, 24, 24, 24, 24, 24, 24, 25, 25, 25, 25, 25, 25, 25, 26, 26, 26, 26, 26, 26, 26, 26, 27, 27, 27, 27, 27, 27, 27, 27, 27, 27, 28, 28, 28, 28, 28, 28, 28, 28, 28, 28, 29, 29, 29, 29, 29, 29, 29, 29, 29, 29, 29, 29, 30, 30, 30, 30, 30, 30, 30, 30, 30, 30, 30, 30, 30, 30, 31, 31, 31, 31, 31, 31, 31, 31, 31, 31, 31, 31, 31, 31, 31};

struct Params {
    const float* in[N_IN];
    float* out;
    unsigned char* ws;
};

template <class F>
__device__ __forceinline__ void transpose_item(const float* W, int ldw, int k0, int n0, int nlim, LAS float* scr, int lane, F dst) {
#pragma unroll 8
    for (int i = 0; i < 32; ++i) { const int kk = 2 * i + (lane >> 5); const int n = n0 + (lane & 31); scr[kk * 33 + (lane & 31)] = n < nlim ? W[(size_t)(k0 + kk) * ldw + n] : 0.f; }
    LDS_WAIT(); asm volatile("" ::: "memory");
    const int c = lane & 7;
#pragma unroll
    for (int j = 0; j < 4; ++j) { const int nn = (lane >> 3) + 8 * j; const int n = n0 + nn; const LAS float* s = scr + (8 * c) * 33 + nn;
        bf16* rowp; float sc;
        if (n < nlim && dst(n, rowp, sc)) {
            v4u o; o.x = pk2(s[0 * 33] * sc, s[1 * 33] * sc); o.y = pk2(s[2 * 33] * sc, s[3 * 33] * sc); o.z = pk2(s[4 * 33] * sc, s[5 * 33] * sc); o.w = pk2(s[6 * 33] * sc, s[7 * 33] * sc);
            *(v4u*)(rowp + 8 * c) = o; } }
    LDS_WAIT(); asm volatile("" ::: "memory");
}
__device__ __forceinline__ int win_row(int n, float& sc) {
    sc = 1.f;
    if (n < 512) { sc = 0.08838834764831845f; return n; }
    if (n < 1024) return n;
    if (n < 2048) return n;
    if (n < 3072) return n;
    if (n < 3088) return 5120 + (n - 3072);
    if (n < 4112) { sc = 0.08838834764831845f; return 3072 + (n - 3088); }
    if (n < 4368) return 4096 + (n - 4112);
    if (n < 4624) return 4352 + (n - 4368);
    if (n < 4880) return 4608 + (n - 4624);
    if (n < 5136) return 5376 + (n - 4880);
    if (n < 5392) return 4864 + (n - 5136);
    if (n < 5648) return 5632 + (n - 5392);
    return 5136 + (n - 5648);
}
constexpr size_t WS_PEVP = WS_W2T;
__device__ __forceinline__ void p0_prologue(const Params& p, LAS unsigned char* lds, int gw, int NGW, int wave, int lane) {
    LAS float* scr = (LAS float*)(lds + wave * 16384);
    bf16* WinT = (bf16*)(p.ws + WS_WINT); bf16* WoT = (bf16*)(p.ws + WS_WOT); bf16* WkcT = (bf16*)(p.ws + WS_WKCT); bf16* WvcT = (bf16*)(p.ws + WS_WVCT);
    bf16* W1T = (bf16*)(p.ws + WS_W1T); bf16* W2T = (bf16*)(p.ws + WS_W2T);
    constexpr int I_IN = 32 * 178, I_O = 32 * 64, I_C = 64 * 4, I_E1 = 32 * 128, I_E2 = 32 * 64;
    constexpr int I_PE = 2 * 64;
    constexpr int NITEMS = I_O + 2 * I_C + I_PE;
    (void)I_IN; (void)WinT;
    for (int it = gw; it < NITEMS; it += NGW) {
        int r = it;
        if (r < I_O) { const int kb = r / 64, nb = r % 64, k0 = kb * 64;
            transpose_item(p.in[I_WOUT], DM, k0, nb * 32, DM, scr, lane, [&](int n, bf16*& rowp, float& sc) { sc = 1.f; rowp = WoT + (size_t)n * DM + k0; return true; }); continue; } r -= I_O;
        if (r >= 2 * I_C) { r -= 2 * I_C; const int which = r >> 6, kq = r & 63; const float* pe = p.in[which ? I_PEV : I_PEK] + kq * 64; const float* w1 = p.in[which ? I_WV1 : I_WK1] + (size_t)kq * 64 * 128 + lane;
            float a0 = 0.f, a1 = 0.f;
#pragma unroll
            for (int k = 0; k < 64; ++k) { const float pv = pe[k]; a0 += pv * w1[k * 128]; a1 += pv * w1[k * 128 + 64]; }
            float* dst = (float*)(p.ws + WS_PEVP) + (size_t)(which * 64 + kq) * 128 + lane; dst[0] = a0; dst[64] = a1; continue; }
        { const int which = r / I_C; r %= I_C; const int kb = r / 4, nb = r % 4, k0 = kb * 64;
            bf16* dstm = which ? WvcT : WkcT;
            transpose_item(p.in[which ? I_WV1 : I_WK1], 128, k0, nb * 32, 128, scr, lane, [&](int n, bf16*& rowp, float& sc) { sc = 1.f; rowp = dstm + (size_t)(n + (k0 >= 2048 ? 128 : 0)) * 2048 + (k0 & 2047); return true; }); }
        (void)I_E1; (void)I_E2; (void)W1T; (void)W2T;
    }
    const float* x = p.in[I_X]; const float* gm = p.in[I_NMIX];
    for (int m = gw; m < T; m += NGW) {
        const f32x4* xr = (const f32x4*)(x + (size_t)m * DM) + lane; f32x4 v[8]; float s = 0.f;
#pragma unroll
        for (int j = 0; j < 8; ++j) { v[j] = xr[64 * j]; s += (v[j].x * v[j].x + v[j].y * v[j].y) + (v[j].z * v[j].z + v[j].w * v[j].w); }
        const float rstd = 1.f / sqrtf(wave_sum(s) * (1.f / DM) + RMS_EPS);
        float mxr = 0.f;
#pragma unroll
        for (int j = 0; j < 8; ++j) { const f32x4 g4 = ((const f32x4*)gm)[lane + 64 * j]; v[j].x *= rstd * g4.x; v[j].y *= rstd * g4.y; v[j].z *= rstd * g4.z; v[j].w *= rstd * g4.w;
            mxr = fmaxf(mxr, fmaxf(fmaxf(fabsf(v[j].x), fabsf(v[j].y)), fmaxf(fabsf(v[j].z), fabsf(v[j].w)))); }
        mxr = wave_max(mxr); const float qs = mxr > 0.f ? mxr * (1.f / 127.f) : 1.f, qi = 1.f / qs;
        unsigned* o4 = (unsigned*)(p.ws + WS_XN + (size_t)m * DM) + lane;
#pragma unroll
        for (int j = 0; j < 8; ++j) { const float M = 12582912.f;
            const unsigned ua = __builtin_bit_cast(unsigned, v[j].x * qi + M), ub = __builtin_bit_cast(unsigned, v[j].y * qi + M), uc = __builtin_bit_cast(unsigned, v[j].z * qi + M), ud = __builtin_bit_cast(unsigned, v[j].w * qi + M);
            o4[64 * j] = __builtin_amdgcn_perm(ub, ua, 0x0c0c0400u) | (__builtin_amdgcn_perm(ud, uc, 0x0c0c0400u) << 16); }
        if (lane == 0) ((float*)(p.ws + WS_XN + (size_t)T * DM))[m] = qs;
    }
}
#define XB_TMO      128
#define XB_XCNT(j)  (256  + 64 * (j))
#define XB_XSUB(j)  (1280 + 64 * (j))
#define XB_XGEN(j)  (2304 + 64 * (j))
#define XB_TOP      3328
#define XB_TOPGEN   3392
#define XCD_BAR_WORDS 3456
#define XB_SPIN_CAP (1u << 18)

__device__ __forceinline__ unsigned xb_ld(unsigned* p)              { return __hip_atomic_load(p, __ATOMIC_RELAXED, __HIP_MEMORY_SCOPE_AGENT); }
__device__ __forceinline__ unsigned xb_add(unsigned* p, unsigned v) { return __hip_atomic_fetch_add(p, v, __ATOMIC_RELAXED, __HIP_MEMORY_SCOPE_AGENT); }
__device__ __forceinline__ unsigned xb_xcc_id() { return (unsigned)__builtin_amdgcn_s_getreg((3 << 11) | 20) & 0xFu; }
#define XB_SPIN(cond, bar) do { unsigned _sp = 0; while (cond) { __builtin_amdgcn_s_sleep(1); \
    if ((++_sp & 255u) == 0u) { if (xb_ld(&(bar)[XB_TMO])) break; if (_sp > XB_SPIN_CAP) { atomicAdd(&(bar)[XB_TMO], 1u); break; } } } } while (0)

struct XcdBarrier {
    unsigned* bar; unsigned x;
    volatile LAS unsigned* st;
};

__device__ __forceinline__ XcdBarrier xcd_barrier_post(unsigned* bar, volatile LAS unsigned* st) {
    XcdBarrier b; b.bar = bar; b.x = xb_xcc_id(); b.st = st;
    if (threadIdx.x == 0) (void)xb_add(&bar[XB_XCNT(b.x)], 1u);
    return b;
}
__device__ __forceinline__ void xcd_barrier_complete(unsigned* bar, unsigned x, unsigned& nloc, unsigned& nx) {
    const unsigned G = gridDim.x * gridDim.y * gridDim.z;
    unsigned sum, cnt, mine, sp = 0u;
    for (;;) {
        sum = 0u; cnt = 0u; mine = 0u;
#pragma unroll
        for (unsigned j = 0; j < 16; ++j) { const unsigned c = xb_ld(&bar[XB_XCNT(j)]); sum += c; cnt += (c > 0u) ? 1u : 0u; mine = (j == x) ? c : mine; }
        if (sum == G) break;
        __builtin_amdgcn_s_sleep(1);
        if ((++sp & 255u) == 0u) { if (xb_ld(&bar[XB_TMO])) break; if (sp > XB_SPIN_CAP) { atomicAdd(&bar[XB_TMO], 1u); break; } }
    }
    nloc = mine > 0u ? mine : 1u; nx = cnt > 0u ? cnt : 1u;
}

__device__ __forceinline__ void xcd_barrier(const XcdBarrier& b) {
    asm volatile("s_waitcnt vmcnt(0)" ::: "memory");
    __syncthreads();
    if (threadIdx.x == 0) {
        unsigned* bar = b.bar;
        __builtin_amdgcn_s_waitcnt(0);
        unsigned nloc = b.st[0], nx = b.st[1];
        if (nloc == 0u) { xcd_barrier_complete(bar, b.x, nloc, nx); b.st[0] = nloc; b.st[1] = nx; }
        const unsigned old = xb_add(&bar[XB_XSUB(b.x)], 1u);
        const unsigned gen = old / nloc;
        if (old + 1u == (gen + 1u) * nloc) {
            __builtin_amdgcn_fence(__ATOMIC_RELEASE, "agent");
            asm volatile("s_waitcnt vmcnt(0)" ::: "memory");
            const unsigned og = xb_add(&bar[XB_TOP], 1u);
            const unsigned tg = og / nx;
            if (og + 1u == (tg + 1u) * nx) xb_add(&bar[XB_TOPGEN], 1u);
            else XB_SPIN(xb_ld(&bar[XB_TOPGEN]) == tg, bar);
            __builtin_amdgcn_fence(__ATOMIC_ACQUIRE, "agent");
            xb_add(&bar[XB_XGEN(b.x)], 1u);
            asm volatile("s_waitcnt vmcnt(0)" ::: "memory");
        } else {
            XB_SPIN(xb_ld(&bar[XB_XGEN(b.x)]) == gen, bar);
            __builtin_amdgcn_fence(__ATOMIC_ACQUIRE, "agent");
            asm volatile("s_waitcnt vmcnt(0)" ::: "memory");
        }
    }
    __syncthreads();
}

struct ProjOrder : pg8::StaticOrder {
    const bf16* xn; const bf16* wt;
    __device__ __forceinline__ bool next(int i, pg8::Unit& u) const { if (!pg8::StaticOrder::next(i, u)) return false; u.kind = (u.pn >= 21) ? 1 : 0; return true; }
    __device__ __forceinline__ const char* pa(const pg8::Gemm& g, const pg8::Unit& u) const { return u.kind ? (const char*)wt + (size_t)u.pn * ((size_t)256 * g.K * 2) : (const char*)xn + (size_t)u.pm * ((size_t)256 * g.K * 2); }
    __device__ __forceinline__ const char* pb(const pg8::Gemm& g, const pg8::Unit& u) const { return u.kind ? (const char*)xn + (size_t)u.pm * ((size_t)256 * g.K * 2) : (const char*)wt + (size_t)u.pn * ((size_t)256 * g.K * 2); }
};
struct EpiRes {
    static constexpr bool PERM = true, AFTER_DRAIN = false;
    const float* x; bf16* h;
    __device__ __forceinline__ void operator()(const pg8::f32x4 (&acc)[2][2][4][2], const pg8::Unit& u, int wr, int wc, int fr, int fq) const {
        const int row0 = u.pm * 256 + wr * 64 + fr, col0 = u.pn * 256 + wc * 32 + 8 * fq;
#pragma unroll
        for (int ai = 0; ai < 2; ++ai)
#pragma unroll
            for (int m = 0; m < 4; ++m) { const size_t off = (size_t)(row0 + ai * 128 + m * 16) * DM + col0;
#pragma unroll
                for (int bj = 0; bj < 2; ++bj) { const pg8::f32x4 x0 = *(const pg8::f32x4*)(x + off + bj * 128), x1 = *(const pg8::f32x4*)(x + off + bj * 128 + 4);
                    const pg8::f32x4 a0 = x0 + acc[ai][bj][m][0], a1 = x1 + acc[ai][bj][m][1]; pg8::u32x4 w;
                    w.x = pg8::cvt_pk_bf16(a0.x, a0.y); w.y = pg8::cvt_pk_bf16(a0.z, a0.w); w.z = pg8::cvt_pk_bf16(a1.x, a1.y); w.w = pg8::cvt_pk_bf16(a1.z, a1.w);
                    *(pg8::u32x4*)(h + off + bj * 128) = w; } }
    }
};
struct MoeOrder {
    int nM, nN, nwg, G, c; const int* tile_exp;
    __device__ __forceinline__ void init(const int* meta, int nN_, int G_, int c_) { nM = meta[0]; nN = nN_; nwg = nM * nN; G = G_; c = c_; tile_exp = meta + 64; }
    __device__ __forceinline__ bool next(int i, pg8::Unit& u) const {
        const long L = (long)i * G + c; if (L >= nwg) return false;
        pg8::tile_of<8>((int)L, nM, nN, u.pm, u.pn); u.kind = tile_exp[u.pm]; return true;
    }
    __device__ __forceinline__ const char* pa(const pg8::Gemm& g, const pg8::Unit& u) const { return (const char*)g.A + (size_t)u.pm * ((size_t)256 * g.K * 2); }
    __device__ __forceinline__ const char* pb(const pg8::Gemm& g, const pg8::Unit& u) const { return (const char*)g.Bt + ((size_t)u.kind * nN + u.pn) * ((size_t)256 * g.K * 2); }
    __device__ __forceinline__ void a_ready(const pg8::Unit&) const {}
    __device__ __forceinline__ void done(const pg8::Unit&) const {}
};

struct MoeOrderG : MoeOrder { const unsigned short* rowtab;
    __device__ __forceinline__ const char* pa(const pg8::Gemm& g, const pg8::Unit&) const { return (const char*)g.A; } };

__device__ __forceinline__ float gelu_tanh(float x) { const float u = 0.7978845608028654f * (x + 0.044715f * x * x * x); const float e = __expf(2.f * u); return 0.5f * x * (1.f + (1.f - 2.f / (e + 1.f))); }
__device__ __forceinline__ void ph_cmp_fin_simple(const Params& p, LAS float* tl, int id, int n, const float* LHall, const float* PEVall) {
    LAS float* hid = tl + 4096;
    const int which = id / (16 * 255), rem = id % (16 * 255), bg = rem / 255, c = rem % 255;
    const float* w2 = p.in[which ? I_WV2 : I_WK2];
    const float* LH = LHall + ((size_t)which * 4096 + bg * 256) * 256;
    float pev = 0.f;
#pragma unroll 8
    for (int q = 0; q < 64; ++q) pev += PEVall[(size_t)(which * 64 + q) * 128 + n];
    const float a = LH[(size_t)c * 256 + n] + LH[(size_t)(c + 1) * 256 + 128 + n] + pev;
    hid[n] = gelu_tanh(a);
    __syncthreads();
    float o = 0.f;
    for (int m = 0; m < 128; ++m) o += hid[m] * w2[m * 128 + n];
    if (which == 0) ((bf16*)(p.ws + WS_KCMP))[((size_t)bg * 256 + c) * 128 + n] = (bf16)f2bf(o);
    else ((bf16*)(p.ws + WS_VCMPT))[((size_t)bg * 128 + n) * 256 + c] = (bf16)f2bf(o);
}

namespace nsa {
constexpr int KB0 = 0, KB1 = 16384, VB0 = 32768, VB1 = 49152, LUT = 65536;
constexpr int QST = LUT + 4096, IMP = QST + 65536, SELM = IMP + 16384, LDS_END = SELM + 512;
constexpr float LOG2E = 1.4426950408889634f;
typedef float f4 __attribute__((ext_vector_type(4)));

typedef unsigned u2v __attribute__((ext_vector_type(2)));
__device__ __forceinline__ float rmax16(float x) { const unsigned u = __float_as_uint(x); const u2v r = __builtin_amdgcn_permlane16_swap(u, u, false, false); return fmaxf(__uint_as_float(r[0]), __uint_as_float(r[1])); }
__device__ __forceinline__ float rmax32(float x) { const unsigned u = __float_as_uint(x); const u2v r = __builtin_amdgcn_permlane32_swap(u, u, false, false); return fmaxf(__uint_as_float(r[0]), __uint_as_float(r[1])); }
__device__ __forceinline__ float radd16(float x) { const unsigned u = __float_as_uint(x); const u2v r = __builtin_amdgcn_permlane16_swap(u, u, false, false); return __uint_as_float(r[0]) + __uint_as_float(r[1]); }
__device__ __forceinline__ float radd32(float x) { const unsigned u = __float_as_uint(x); const u2v r = __builtin_amdgcn_permlane32_swap(u, u, false, false); return __uint_as_float(r[0]) + __uint_as_float(r[1]); }
__device__ __forceinline__ float raddq(float x) { x += __int_as_float(__builtin_amdgcn_update_dpp(0, __float_as_int(x), 0xB1, 0xF, 0xF, true)); x += __int_as_float(__builtin_amdgcn_update_dpp(0, __float_as_int(x), 0x4E, 0xF, 0xF, true)); return x; }
struct Ctx {
    LAS unsigned char* lds; int tid, lane, wave, c, gq, r;
    int s0, cur;
    const LAS unsigned char* qst;
    int pos0;
    const LAS float* lutrow;
    int koff0, voff0;
    unsigned kdo[2], vdoc[2], vdos[2];
};
__device__ __forceinline__ void dma_k(const Ctx& C, const bf16* kt, LAS unsigned char* kb) {
#pragma unroll
    for (int i = 0; i < 2; ++i) __builtin_amdgcn_global_load_lds((const unsigned*)((const char*)kt + C.kdo[i]), (LAS unsigned*)(kb + (2 * C.wave + i) * 1024), 16, 0, 0); }
__device__ __forceinline__ void dma_v(const Ctx& C, const bf16* vt, const unsigned (&vdo)[2], LAS unsigned char* vb) {
#pragma unroll
    for (int i = 0; i < 2; ++i) __builtin_amdgcn_global_load_lds((const unsigned*)((const char*)vt + vdo[i]), (LAS unsigned*)(vb + (2 * C.wave + i) * 1024), 16, 0, 0); }

__device__ __forceinline__ void compute_st(const Ctx& C, const LAS unsigned char* kb, f4 (&s)[2][4]) {
#pragma unroll
    for (int ks = 0; ks < 4; ++ks) { const bf16x8 q0 = *(const LAS bf16x8*)(C.qst + ks * 1024), q1 = *(const LAS bf16x8*)(C.qst + (4 + ks) * 1024);
#pragma unroll
        for (int kt = 0; kt < 4; ++kt) { const bf16x8 a = *(const LAS bf16x8*)(kb + kt * 4096 + (C.koff0 ^ (ks * 64)));
            s[0][kt] = __builtin_amdgcn_mfma_f32_16x16x32_bf16(a, q0, ks == 0 ? (f4){0.f, 0.f, 0.f, 0.f} : s[0][kt], 0, 0, 0);
            s[1][kt] = __builtin_amdgcn_mfma_f32_16x16x32_bf16(a, q1, ks == 0 ? (f4){0.f, 0.f, 0.f, 0.f} : s[1][kt], 0, 0, 0); }
        asm volatile("" ::: "memory"); }
}
__device__ __forceinline__ void compute_pv(const Ctx& C, const LAS unsigned char* vb, const f4 (&p)[2][4], f4 (&o)[2][8]) {
#pragma unroll
    for (int i = 0; i < 2; ++i) { bf16x8 pb[2];
#pragma unroll
        for (int qt = 0; qt < 2; ++qt) { v4u w; w.x = pg8::cvt_pk_bf16(p[qt][2 * i][0], p[qt][2 * i][1]); w.y = pg8::cvt_pk_bf16(p[qt][2 * i][2], p[qt][2 * i][3]);
            w.z = pg8::cvt_pk_bf16(p[qt][2 * i + 1][0], p[qt][2 * i + 1][1]); w.w = pg8::cvt_pk_bf16(p[qt][2 * i + 1][2], p[qt][2 * i + 1][3]); pb[qt] = __builtin_bit_cast(bf16x8, w); }
#pragma unroll
        for (int dt = 0; dt < 8; ++dt) { const v2u lo = *(const LAS v2u*)(vb + dt * 2048 + (C.voff0 ^ (i * 64))), hi = *(const LAS v2u*)(vb + dt * 2048 + (C.voff0 ^ (i * 64 + 32))); const bf16x8 a = __builtin_bit_cast(bf16x8, (v4u){lo.x, lo.y, hi.x, hi.y});
#pragma unroll
            for (int qt = 0; qt < 2; ++qt) o[qt][dt] = __builtin_amdgcn_mfma_f32_16x16x32_bf16(a, pb[qt], o[qt][dt], 0, 0, 0);
            if (dt & 1) asm volatile("" ::: "memory"); } }
}
enum { M_CMP = 0, M_SEL = 1, M_WIN = 2 };
template <int MODE, bool FAR = false>
__device__ __forceinline__ void mask_bias(const Ctx& C, f4 (&s)[2][4], int kb, int n, const LAS unsigned* selw) {
    const float NEG = -__builtin_inff();
#pragma unroll
    for (int qt = 0; qt < 2; ++qt) {
        bool tokok = true;
        if (MODE == M_SEL) tokok = ((selw[(4 * qt + (C.c >> 2)) * 2 + (n >> 5)] >> (n & 31)) & 1u) != 0u;
        if (FAR) { const float be = tokok ? C.lutrow[127] : NEG;
#pragma unroll
            for (int kt = 0; kt < 4; ++kt)
#pragma unroll
                for (int rg = 0; rg < 4; ++rg) s[qt][kt][rg] = __builtin_fmaf(s[qt][kt][rg], LOG2E, be);
            continue; }
        const int dbase = (MODE == M_CMP) ? (C.pos0 + 4 * qt - 31 - 16 * (kb + 4 * C.gq)) : (C.pos0 + 4 * qt - (kb + 4 * C.gq));
#pragma unroll
        for (int kt = 0; kt < 4; ++kt) {
#pragma unroll
            for (int rg = 0; rg < 4; ++rg) { const int d = (MODE == M_CMP) ? dbase - 16 * (16 * kt + rg) : dbase - (16 * kt + rg);
                int di = d < 0 ? 0 : d; di = di > 127 ? 127 : di; const float bias = C.lutrow[di];
                bool ok = tokok && d >= 0; if (MODE == M_WIN) ok = ok && d < 512;
                s[qt][kt][rg] = ok ? __builtin_fmaf(s[qt][kt][rg], LOG2E, bias) : NEG; }
            asm volatile("" ::: "memory"); }
    }
}
__device__ __forceinline__ void softmax_step(f4 (&s)[2][4], float (&m)[2], float (&l)[2], f4 (&o)[2][8], bool rescale_o) {
#pragma unroll
    for (int qt = 0; qt < 2; ++qt) { float mx = s[qt][0][0];
#pragma unroll
        for (int kt = 0; kt < 4; ++kt)
#pragma unroll
            for (int rg = 0; rg < 4; ++rg) mx = fmaxf(mx, s[qt][kt][rg]);
        mx = rmax32(rmax16(mx));
        const float mn = fmaxf(m[qt], mx), alpha = __builtin_amdgcn_exp2f(m[qt] - mn); m[qt] = mn; float ps = 0.f;
#pragma unroll
        for (int kt = 0; kt < 4; ++kt)
#pragma unroll
            for (int rg = 0; rg < 4; ++rg) { const float e = __builtin_amdgcn_exp2f(s[qt][kt][rg] - mn); s[qt][kt][rg] = e; ps += e; }
        l[qt] = l[qt] * alpha + ps;
        if (rescale_o && __any(alpha != 1.f)) {
#pragma unroll
            for (int dt = 0; dt < 8; ++dt) o[qt][dt] = o[qt][dt] * alpha; }
    }
}
template <int MODE>
__device__ __forceinline__ void softmax_far(const Ctx& C, f4 (&s)[2][4], int n, const LAS unsigned* selw, float (&m)[2], float (&l)[2], f4 (&o)[2][8]) {
    const float b31 = C.lutrow[127];
#pragma unroll
    for (int qt = 0; qt < 2; ++qt) {
        float be = b31;
        if (MODE == M_SEL) { const bool tokok = ((selw[(4 * qt + (C.c >> 2)) * 2 + (n >> 5)] >> (n & 31)) & 1u) != 0u; be = tokok ? b31 : -__builtin_inff(); }
        float mx = fmaxf(fmaxf(s[qt][0][0], s[qt][0][1]), fmaxf(s[qt][0][2], s[qt][0][3]));
#pragma unroll
        for (int kt = 1; kt < 4; ++kt) mx = fmaxf(mx, fmaxf(fmaxf(s[qt][kt][0], s[qt][kt][1]), fmaxf(s[qt][kt][2], s[qt][kt][3])));
        mx = rmax32(rmax16(mx));
        const float mt = __builtin_fmaf(mx, LOG2E, be), mn = fmaxf(m[qt], mt), alpha = __builtin_amdgcn_exp2f(m[qt] - mn), c0 = be - mn; m[qt] = mn; float ps = 0.f;
#pragma unroll
        for (int kt = 0; kt < 4; ++kt)
#pragma unroll
            for (int rg = 0; rg < 4; ++rg) { const float e = __builtin_amdgcn_exp2f(__builtin_fmaf(s[qt][kt][rg], LOG2E, c0)); s[qt][kt][rg] = e; ps += e; }
        l[qt] = l[qt] * alpha + ps;
        if (__any(alpha != 1.f)) {
#pragma unroll
            for (int dt = 0; dt < 8; ++dt) o[qt][dt] = o[qt][dt] * alpha; }
    }
}
}

__device__ __forceinline__ void ph_nsa(const Params& p, LAS unsigned char* lds, int idx0, int idxstride, int tid_in, int wave) {
    using namespace nsa;
    int tid = tid_in; asm volatile("" : "+v"(tid));
    const int lane = tid & 63;
    Ctx C; C.lds = lds; C.tid = tid; C.lane = lane; C.wave = wave; C.c = lane & 15; C.gq = lane >> 4; C.r = lane & 3;
    C.koff0 = C.c * 256 + ((C.gq ^ C.c) * 16);
#pragma unroll
    for (int i = 0; i < 2; ++i) { const int piece = 2 * wave + i;
        { const int row = piece * 4 + (lane >> 4), chunk = (lane & 15) ^ (row & 15); C.kdo[i] = (unsigned)(row * 256 + chunk * 16); }
        { const int row = piece * 8 + (lane >> 3), chunk = (lane & 7) ^ ((row >> 1) & 7); C.vdoc[i] = (unsigned)(row * 256 * 2 + chunk * 16); C.vdos[i] = (unsigned)(row * SEQ * 2 + chunk * 16); } }
    C.voff0 = C.c * 128 + (((C.gq >> 1) ^ ((C.c >> 1) & 7)) * 16) + (C.gq & 1) * 8;
    const bf16* NQ = (const bf16*)(p.ws + WS_NQ); const bf16* SM = (const bf16*)(p.ws + WS_SM); bf16* A2 = (bf16*)(p.ws + WS_A2);
    const float* relb = p.in[I_RELB]; const float* nsag = p.in[I_NSAG];
    LAS float* lut = (LAS float*)(lds + LUT);
    for (int i = tid; i < 8 * 128; i += 512) { const int hh = i >> 7, d = i & 127; lut[i] = relb[(int)kBucket[d] * 8 + hh] * LOG2E; }
    __syncthreads();
    LAS unsigned char* qstw = lds + QST + wave * 8192 + lane * 16; C.qst = qstw;
    LAS float* imp = (LAS float*)(lds + IMP + wave * 2048);
    LAS unsigned long long* selm = (LAS unsigned long long*)(lds + SELM + wave * 64);
#define NSA_SYNC() do { asm volatile("s_waitcnt vmcnt(0)" ::: "memory"); __syncthreads(); } while (0)
    for (int idx = idx0; idx < 512; idx += idxstride) {
        const int rnd = idx >> 8, kq = idx & 255, b = kq & 7, tq = rnd == 0 ? 63 - (kq >> 3) : (kq >> 3);
        C.s0 = tq * 64; C.cur = tq;
        const int tokl0 = 8 * wave + (C.c >> 2);
        C.pos0 = C.s0 + tokl0;
        float ssq[2] = {0.f, 0.f};
        for (int g = 0; g < 2; ++g) {
            const int bg = b * 2 + g, h = g * 4 + C.r;
            C.lutrow = lut + h * 128;
            const bf16* KCMP = (const bf16*)(p.ws + WS_KCMP) + (size_t)bg * 256 * 128; const bf16* VCMPT = (const bf16*)(p.ws + WS_VCMPT) + (size_t)bg * 128 * 256;
#pragma unroll
            for (int qt = 0; qt < 2; ++qt) { const unsigned qo = (unsigned)(((b * SEQ + (C.pos0 + 4 * qt)) * 1024 + h * 128 + 8 * C.gq) * 2);
#pragma unroll
                for (int ks = 0; ks < 4; ++ks) *(LAS bf16x8*)(qstw + (qt * 4 + ks) * 1024) = *(const bf16x8*)((const char*)NQ + qo + ks * 64); }
#pragma unroll
            for (int i = 0; i < 2; ++i) *(LAS f32x4*)((LAS unsigned char*)imp + lane * 16 + i * 1024) = (f32x4){0.f, 0.f, 0.f, 0.f};
#define NSA_OROW(qt) ((char*)A2 + (unsigned)(((b * SEQ + C.pos0 + 4 * (qt)) * DM + 1024 + h * 128 + 4 * C.gq) * 2))
            const int cmaxb = C.s0 + 63 - 31; const int nct = cmaxb >= 0 ? ((cmaxb >> 4) >> 6) + 1 : 0;
            float m[2] = {-1e30f, -1e30f}, l[2] = {0.f, 0.f};
            f4 o[2][8];
            if (nct > 0) {
                dma_k(C, KCMP, lds + KB0); NSA_SYNC();
                for (int ct = 0; ct < nct; ++ct) { const int buf = ct & 1;
                    if (ct + 1 < nct) dma_k(C, KCMP + (ct + 1) * 64 * 128, lds + (buf ? KB0 : KB1));
                    f4 s[2][4]; compute_st(C, lds + (buf ? KB1 : KB0), s); mask_bias<M_CMP>(C, s, 64 * ct, 0, (const LAS unsigned*)selm); softmax_step(s, m, l, o, false);
                    NSA_SYNC(); }
            }
            float inv[2];
#pragma unroll
            for (int qt = 0; qt < 2; ++qt) { const float lt = radd32(radd16(l[qt])); inv[qt] = lt > 0.f ? 1.f / lt : 0.f; }
#pragma unroll
            for (int qt = 0; qt < 2; ++qt)
#pragma unroll
                for (int dt = 0; dt < 8; ++dt) o[qt][dt] = (f4){0.f, 0.f, 0.f, 0.f};
            if (nct > 0) {
                dma_k(C, KCMP, lds + KB0); dma_v(C, VCMPT, C.vdoc, lds + VB0); NSA_SYNC();
                for (int ct = 0; ct < nct; ++ct) { const int buf = ct & 1;
                    if (ct + 1 < nct) { dma_k(C, KCMP + (ct + 1) * 64 * 128, lds + (buf ? KB0 : KB1)); dma_v(C, VCMPT + 64 * (ct + 1), C.vdoc, lds + (buf ? VB0 : VB1)); }
                    f4 s[2][4]; compute_st(C, lds + (buf ? KB1 : KB0), s); mask_bias<M_CMP>(C, s, 64 * ct, 0, (const LAS unsigned*)selm);
#pragma unroll
                    for (int qt = 0; qt < 2; ++qt)
#pragma unroll
                        for (int kt = 0; kt < 4; ++kt) {
#pragma unroll
                            for (int rg = 0; rg < 4; ++rg) s[qt][kt][rg] = __builtin_amdgcn_exp2f(s[qt][kt][rg] - m[qt]) * inv[qt];
                            float po = (s[qt][kt][0] + s[qt][kt][1]) + (s[qt][kt][2] + s[qt][kt][3]), p3 = s[qt][kt][3];
                            po = raddq(po); p3 = raddq(p3);
                            const int nb = 16 * ct + 4 * kt + C.gq, tl = 4 * qt + (C.c >> 2);
                            if (C.r == 0) { __hip_atomic_fetch_add((float*)(imp + tl * 64 + nb), po, __ATOMIC_RELAXED, __HIP_MEMORY_SCOPE_WORKGROUP); if (nb + 1 < 64) __hip_atomic_fetch_add((float*)(imp + tl * 64 + nb + 1), p3, __ATOMIC_RELAXED, __HIP_MEMORY_SCOPE_WORKGROUP); } }
                    compute_pv(C, lds + (buf ? VB1 : VB0), s, o);
                    NSA_SYNC(); }
            }
            LDS_WAIT(); __builtin_amdgcn_wave_barrier();
            for (int tk = 0; tk < 8; ++tk) { const int n = lane; float sc;
                if (n == 0 || n == C.cur || n == C.cur - 1) sc = 1e4f; else if (n <= C.cur) sc = imp[tk * 64 + n]; else sc = -1.f;
                const int key = ((sc < 0.f ? 0 : __float_as_int(sc) + 64) & ~63) | (63 - n);
                int rank = 0;
#pragma unroll
                for (int mm = 0; mm < 64; ++mm) rank += (__builtin_amdgcn_readlane(key, mm) > key) ? 1 : 0;
                const unsigned long long mk = __ballot(rank < 16);
                if (lane == 0) selm[tk] = mk; }
            LDS_WAIT(); __builtin_amdgcn_wave_barrier();
#pragma unroll
            for (int qt = 0; qt < 2; ++qt) { const float gt = 1.f / (1.f + __expf(-bf2f(*(const bf16*)((const char*)SM + (unsigned)(((b * SEQ + (C.pos0 + 4 * qt)) * 64 + 16 + h) * 2)))));
#pragma unroll
                for (int dt = 0; dt < 8; ++dt) { const f4 v = o[qt][dt] * gt; *(v2u*)(NSA_OROW(qt) + 32 * dt) = (v2u){pg8::cvt_pk_bf16(v[0], v[1]), pg8::cvt_pk_bf16(v[2], v[3])}; } }
#pragma unroll
            for (int br = 1; br <= 2; ++br) {
                const bf16* KX = (const bf16*)(p.ws + (br == 1 ? WS_KS : WS_KW)) + bg * SEQ * 128; const bf16* VX = (const bf16*)(p.ws + (br == 1 ? WS_VST : WS_VWT)) + bg * 128 * SEQ;
                const int n0 = br == 1 ? 0 : (C.cur >= 8 ? C.cur - 8 : 0), n1 = C.cur;
                m[0] = m[1] = -1e30f; l[0] = l[1] = 0.f;
#pragma unroll
                for (int qt = 0; qt < 2; ++qt)
#pragma unroll
                    for (int dt = 0; dt < 8; ++dt) o[qt][dt] = (f4){0.f, 0.f, 0.f, 0.f};
                int f0 = n1 + 1, f1 = n0 - 1;
                for (int n = n0; n <= n1; ++n) { const bool fa = (C.s0 - (64 * n + 63) >= 113) && (br == 1 || (C.s0 + 63 - 64 * n) < 512); if (fa) { f0 = n < f0 ? n : f0; f1 = n; } }
                const int cntf = f1 >= f0 ? f1 - f0 + 1 : 0, cnt = n1 - n0 + 1, nlo = cntf ? f0 - n0 : cnt;
#define NSA_TILE(i) ((i) < cntf ? f0 + (i) : (((i) - cntf) < nlo ? n0 + ((i) - cntf) : f1 + 1 + ((i) - cntf - nlo)))
#define NSA_BODY(FARF) { const int n = NSA_TILE(i); const int buf = i & 1; \
                    if (i + 1 < cnt) { const int nn = NSA_TILE(i + 1); dma_k(C, KX + nn * 64 * 128, lds + (buf ? KB0 : KB1)); dma_v(C, VX + 64 * nn, C.vdos, lds + (buf ? VB0 : VB1)); } \
                    bool need = true; \
                    if (br == 1) { const unsigned any = ((const LAS unsigned*)selm)[(lane & 7) * 2 + (n >> 5)] >> (n & 31); need = __any((int)(any & 1u)); } \
                    if (need) { f4 s[2][4]; compute_st(C, lds + (buf ? KB1 : KB0), s); \
                        if (FARF) { if (br == 1) softmax_far<M_SEL>(C, s, n, (const LAS unsigned*)selm, m, l, o); else softmax_far<M_WIN>(C, s, n, (const LAS unsigned*)selm, m, l, o); } \
                        else { if (br == 1) mask_bias<M_SEL, false>(C, s, 64 * n, n, (const LAS unsigned*)selm); else mask_bias<M_WIN, false>(C, s, 64 * n, n, (const LAS unsigned*)selm); \
                            softmax_step(s, m, l, o, true); } \
                        compute_pv(C, lds + (buf ? VB1 : VB0), s, o); } \
                    NSA_SYNC(); }
                { const int nf = NSA_TILE(0); dma_k(C, KX + nf * 64 * 128, lds + KB0); dma_v(C, VX + 64 * nf, C.vdos, lds + VB0); NSA_SYNC(); }
                int i = 0;
                for (; i < cntf; ++i) NSA_BODY(true)
                for (; i < cnt; ++i) NSA_BODY(false)
#undef NSA_BODY
#undef NSA_TILE
                asm volatile("s_waitcnt vmcnt(0)" ::: "memory");
#pragma unroll
                for (int qt = 0; qt < 2; ++qt) { const float lt = radd32(radd16(l[qt]));
                    const int row = b * SEQ + (C.pos0 + 4 * qt);
                    const float sc = (1.f / (1.f + __expf(-bf2f(*(const bf16*)((const char*)SM + (unsigned)((row * 64 + 16 + 8 * br + h) * 2)))))) / lt;
#pragma unroll
                    for (int dt = 0; dt < 8; ++dt) { const f4 v = o[qt][dt] * sc; v2u* sp = (v2u*)(NSA_OROW(qt) + 32 * dt); const v2u pv = *sp;
                        const float a0 = bflo(pv.x) + v[0], a1 = bfhi(pv.x) + v[1], a2 = bflo(pv.y) + v[2], a3 = bfhi(pv.y) + v[3];
                        if (br == 2) ssq[qt] += (a0 * a0 + a1 * a1) + (a2 * a2 + a3 * a3);
                        *sp = (v2u){pg8::cvt_pk_bf16(a0, a1), pg8::cvt_pk_bf16(a2, a3)}; } }
            }
        }
        float rstd[2];
#pragma unroll
        for (int qt = 0; qt < 2; ++qt) { const float t = radd32(radd16(raddq(ssq[qt]))); rstd[qt] = 1.f / sqrtf(t * (1.f / 1024.f) + RMS_EPS); }
        asm volatile("s_waitcnt vmcnt(0)" ::: "memory");
#pragma unroll
        for (int qt = 0; qt < 2; ++qt) { const int sub = C.r * 4 + C.gq; bf16* orow = (bf16*)((char*)A2 + (unsigned)(((b * SEQ + (C.pos0 + 4 * qt)) * DM + 1024) * 2 + sub * 16)); const int subz = 0;
#pragma unroll
            for (int j = 0; j < 8; ++j) { const int col = (j * 16 + subz) * 8; v4u w = *(const v4u*)((const char*)orow + (unsigned)(col * 2)); const f32x4 g0 = *(const f32x4*)((const char*)nsag + (unsigned)(col * 4 + sub * 32)), g1 = *(const f32x4*)((const char*)nsag + (unsigned)(col * 4 + sub * 32 + 16)); const float rs = rstd[qt];
                w.x = pk2(bflo(w.x) * rs * g0.x, bfhi(w.x) * rs * g0.y); w.y = pk2(bflo(w.y) * rs * g0.z, bfhi(w.y) * rs * g0.w); w.z = pk2(bflo(w.z) * rs * g1.x, bfhi(w.z) * rs * g1.y); w.w = pk2(bflo(w.w) * rs * g1.z, bfhi(w.w) * rs * g1.w);
                *(v4u*)((char*)orow + (unsigned)(col * 2)) = w; } }
        NSA_SYNC();
    }
#undef NSA_SYNC
#undef NSA_OROW
}

constexpr size_t WS_ST = WS_LA;
constexpr size_t WS_DEC = WS_ST + (size_t)2048 * 256 * 128 * 2;
static_assert(WS_DEC + (size_t)2048 * 128 * 4 <= WS_KCMP, "gla scratch overlay");
namespace gla {
typedef float f4 __attribute__((ext_vector_type(4)));
constexpr int L_ST = 0, L_KT = 65536, L_QT = 81920, L_VT = 98304, L_GA = 131072, L_GT = L_GA + 4096, L_RED = L_GT + 2048, L_END = L_RED + 512;
__device__ __forceinline__ void chunk_cumsum(const Params& p, LAS unsigned char* lds, int tid, int t0, int h, float (&P)[16], float& blast) {
    const bf16* SM = (const bf16*)(p.ws + WS_SM); const float* wa2 = p.in[I_WA2]; const float* ba = p.in[I_BA];
    LAS float* ga = (LAS float*)(lds + L_GA); LAS float* gt = (LAS float*)(lds + L_GT);
    if (tid < 128) { const int j = tid >> 1, hf = tid & 1; const v4u w = *(const v4u*)((const char*)SM + (unsigned)(((t0 + j) * 64 + hf * 8) * 2));
        LAS float* d = ga + j * 16 + hf * 8; d[0] = bflo(w.x); d[1] = bfhi(w.x); d[2] = bflo(w.y); d[3] = bfhi(w.y); d[4] = bflo(w.z); d[5] = bfhi(w.z); d[6] = bflo(w.w); d[7] = bfhi(w.w); }
    const int dk = tid & 127, jq = tid >> 7;
    float w[16];
#pragma unroll
    for (int r = 0; r < 16; ++r) w[r] = wa2[r * 512 + h * 128 + dk];
    const float bb = ba[h * 128 + dk];
    __syncthreads();
    float run = 0.f;
#pragma unroll
    for (int jj = 0; jj < 16; ++jj) { const LAS f32x4* gr = (const LAS f32x4*)(ga + (16 * jq + jj) * 16); float z = bb;
#pragma unroll
        for (int r4 = 0; r4 < 4; ++r4) { const f32x4 g4 = gr[r4]; z += g4.x * w[4 * r4] + g4.y * w[4 * r4 + 1] + g4.z * w[4 * r4 + 2] + g4.w * w[4 * r4 + 3]; }
        run += (fminf(z, 0.f) - __logf(1.f + __expf(-fabsf(z)))) * (1.f / 16.f);   P[jj] = run; }
    gt[jq * 128 + dk] = run;
    __syncthreads();
    float off = 0.f, tot = 0.f;
#pragma unroll
    for (int q = 0; q < 4; ++q) { const float t = gt[q * 128 + dk]; tot += t; if (q < jq) off += t; }
#pragma unroll
    for (int jj = 0; jj < 16; ++jj) P[jj] += off;
    blast = tot;
}
__device__ __forceinline__ void stage_raw_k(const bf16* src  , LAS unsigned char* dst, int tid, int t0, int h) {
#pragma unroll
    for (int q = 0; q < 2; ++q) { const int id = tid + 512 * q, j = id >> 4, c16 = id & 15; *(LAS v4u*)(dst + j * 256 + c16 * 16) = *(const v4u*)((const char*)src + (unsigned)(((t0 + j) * 512 + h * 128 + c16 * 8) * 2)); }
}
__device__ __forceinline__ void stage_raw_v(const Params& p, LAS unsigned char* dst, int tid, int t0, int h) {
    const bf16* GV = (const bf16*)(p.ws + WS_GV);
#pragma unroll
    for (int q = 0; q < 4; ++q) { const int id = tid + 512 * q, j = id >> 5, c = id & 31; *(LAS v4u*)(dst + j * 512 + c * 16) = *(const v4u*)((const char*)GV + (unsigned)(((t0 + j) * 1024 + h * 256 + c * 8) * 2)); }
}
__device__ __forceinline__ void fill_vt(LAS unsigned char* lds, const LAS unsigned char* rv, int tid) {
    const int dv = tid & 255, jh = tid >> 8;
    unsigned short v[32];
#pragma unroll
    for (int jj = 0; jj < 32; ++jj) v[jj] = *(const LAS bf16*)(rv + (32 * jh + jj) * 512 + dv * 2);
    LAS unsigned char* row = lds + L_VT + dv * 128; const int f = (dv >> 1) & 7;
#pragma unroll
    for (int q = 0; q < 4; ++q) { v4u w; w.x = v[8 * q] | ((unsigned)v[8 * q + 1] << 16); w.y = v[8 * q + 2] | ((unsigned)v[8 * q + 3] << 16); w.z = v[8 * q + 4] | ((unsigned)v[8 * q + 5] << 16); w.w = v[8 * q + 6] | ((unsigned)v[8 * q + 7] << 16);
        *(LAS v4u*)(row + (((4 * jh + q) ^ f) * 16)) = w; }
}
}

__device__ __forceinline__ void ph_gla_a(const Params& p, LAS unsigned char* lds, int u0, int ustride, int tid_in, int wave) {
    using namespace gla;
    int tid = tid_in; asm volatile("" : "+v"(tid));
    const int lane = tid & 63, c = lane & 15, gq = lane >> 4;
    const bf16* GK = (const bf16*)(p.ws + WS_GK); bf16* ST = (bf16*)(p.ws + WS_ST); float* DEC = (float*)(p.ws + WS_DEC);
    for (int unit = u0; unit < 2048; unit += ustride) {
        const int bh = unit >> 6, ch = unit & 63, b = bh >> 2, h = bh & 3, t0 = b * SEQ + ch * 64;
        stage_raw_k(GK, lds + 0, tid, t0, h); stage_raw_v(p, lds + 16384, tid, t0, h);
        float P[16], blast; chunk_cumsum(p, lds, tid, t0, h, P, blast);
        { const int dk = tid & 127, jq = tid >> 7;
          unsigned short kv[16];
#pragma unroll
          for (int jj = 0; jj < 16; ++jj) kv[jj] = *(const LAS bf16*)(lds + (16 * jq + jj) * 256 + dk * 2);
          unsigned pk[8];
#pragma unroll
          for (int q = 0; q < 8; ++q) pk[q] = pk2(bf2f(kv[2 * q]) * __expf(blast - P[2 * q]), bf2f(kv[2 * q + 1]) * __expf(blast - P[2 * q + 1]));
          LAS unsigned char* row = lds + L_KT + dk * 128; const int f = (dk >> 1) & 7;
          *(LAS v4u*)(row + (((2 * jq) ^ f) * 16)) = (v4u){pk[0], pk[1], pk[2], pk[3]}; *(LAS v4u*)(row + (((2 * jq + 1) ^ f) * 16)) = (v4u){pk[4], pk[5], pk[6], pk[7]};
          if (jq == 0) DEC[unit * 128 + dk] = __expf(blast); }
        fill_vt(lds, lds + 16384, tid);
        __syncthreads();
        f4 acc[16];
        const int f = (c >> 1) & 7;
        bf16x8 aF[2];
#pragma unroll
        for (int ks = 0; ks < 2; ++ks) aF[ks] = *(const LAS bf16x8*)(lds + L_KT + (16 * wave + c) * 128 + (((4 * ks + gq) ^ f) * 16));
#pragma unroll
        for (int nt = 0; nt < 16; ++nt) { acc[nt] = (f4){0.f, 0.f, 0.f, 0.f};
#pragma unroll
            for (int ks = 0; ks < 2; ++ks) { const bf16x8 bF = *(const LAS bf16x8*)(lds + L_VT + (16 * nt + c) * 128 + (((4 * ks + gq) ^ f) * 16)); acc[nt] = __builtin_amdgcn_mfma_f32_16x16x32_bf16(aF[ks], bF, acc[nt], 0, 0, 0); } }
        char* dst = (char*)ST + (size_t)unit * (256 * 128 * 2) + (unsigned)((c * 128 + 16 * wave + 4 * gq) * 2);
#pragma unroll
        for (int nt = 0; nt < 16; ++nt) *(v2u*)(dst + nt * 16 * 256) = (v2u){pg8::cvt_pk_bf16(acc[nt][0], acc[nt][1]), pg8::cvt_pk_bf16(acc[nt][2], acc[nt][3])};
        __syncthreads();
    }
}
__device__ __forceinline__ void ph_gla_b(const Params& p, int gid, int gstride) {
    bf16* ST = (bf16*)(p.ws + WS_ST); const float* DEC = (const float*)(p.ws + WS_DEC);
    for (int e = gid; e < 32 * 4096; e += gstride) { const int bh = e >> 12, dv = (e >> 4) & 255, d8 = e & 15;
        float st[8];
#pragma unroll
        for (int i = 0; i < 8; ++i) st[i] = 0.f;
        char* base = (char*)ST + (size_t)bh * 64 * (256 * 128 * 2) + (unsigned)((dv * 128 + d8 * 8) * 2); const float* dbase = DEC + (size_t)bh * 64 * 128 + d8 * 8;
#pragma unroll 4
        for (int ch = 0; ch < 64; ++ch) { v4u* ptr = (v4u*)(base + (size_t)ch * (256 * 128 * 2)); const v4u w = *ptr; const f32x4 d0 = *(const f32x4*)(dbase + ch * 128), d1 = *(const f32x4*)(dbase + ch * 128 + 4);
            v4u o; o.x = pk2(st[0], st[1]); o.y = pk2(st[2], st[3]); o.z = pk2(st[4], st[5]); o.w = pk2(st[6], st[7]); *ptr = o;
            st[0] = st[0] * d0.x + bflo(w.x); st[1] = st[1] * d0.y + bfhi(w.x); st[2] = st[2] * d0.z + bflo(w.y); st[3] = st[3] * d0.w + bfhi(w.y);
            st[4] = st[4] * d1.x + bflo(w.z); st[5] = st[5] * d1.y + bfhi(w.z); st[6] = st[6] * d1.z + bflo(w.w); st[7] = st[7] * d1.w + bfhi(w.w); }
    }
}
__device__ __forceinline__ void ph_gla_c(const Params& p, LAS unsigned char* lds, int u0, int ustride, int tid_in, int wave) {
    using namespace gla;
    int tid = tid_in; asm volatile("" : "+v"(tid));
    const int lane = tid & 63, c = lane & 15, gq = lane >> 4, nt = wave & 3, half = wave >> 2;
    const bf16* GQ = (const bf16*)(p.ws + WS_GQ); const bf16* GK = (const bf16*)(p.ws + WS_GK); const bf16* GG = (const bf16*)(p.ws + WS_GG); const bf16* ST = (const bf16*)(p.ws + WS_ST);
    bf16* A2 = (bf16*)(p.ws + WS_A2); const float* gn = p.in[I_GLAG];
    const int koff0 = c * 256 + ((gq ^ c) * 16), voff0 = c * 128 + (((gq >> 1) ^ ((c >> 1) & 7)) * 16) + (gq & 1) * 8;
    for (int unit = u0; unit < 2048; unit += ustride) {
        const int bh = unit >> 6, ch = unit & 63, b = bh >> 2, h = bh & 3, t0 = b * SEQ + ch * 64;
        stage_raw_k(GQ, lds + 0, tid, t0, h); stage_raw_k(GK, lds + 16384, tid, t0, h); stage_raw_v(p, lds + 32768, tid, t0, h);
        float P[16], blast; chunk_cumsum(p, lds, tid, t0, h, P, blast);
        { const int dk = tid & 127, jq = tid >> 7;
#pragma unroll
          for (int jj = 0; jj < 16; ++jj) { const int j = 16 * jq + jj; const float qv = bf2f(*(const LAS bf16*)(lds + j * 256 + dk * 2)), kv = bf2f(*(const LAS bf16*)(lds + 16384 + j * 256 + dk * 2));
              const int off = j * 256 + (((dk >> 3) ^ (j & 15)) * 16) + (dk & 7) * 2;
              *(LAS bf16*)(lds + L_QT + off) = (bf16)f2bf(qv * __expf(P[jj])); *(LAS bf16*)(lds + L_KT + off) = (bf16)f2bf(kv * __expf(-P[jj])); } }
        fill_vt(lds, lds + 32768, tid);
        __syncthreads();
        { const char* src = (const char*)ST + (size_t)unit * (256 * 128 * 2);
#pragma unroll
          for (int i = 0; i < 8; ++i) { const int piece = 8 * wave + i, row = piece * 4 + (lane >> 4), chunk = (lane & 15) ^ (row & 15);
              __builtin_amdgcn_global_load_lds((const unsigned*)(src + (unsigned)(row * 256 + chunk * 16)), (LAS unsigned*)(lds + L_ST + piece * 1024), 16, 0, 0); } }
        asm volatile("s_waitcnt vmcnt(0)" ::: "memory"); __syncthreads();
        bf16x8 qF[4];
#pragma unroll
        for (int ks = 0; ks < 4; ++ks) qF[ks] = *(const LAS bf16x8*)(lds + L_QT + nt * 4096 + (koff0 ^ (ks * 64)));
        f4 sT[4];
#pragma unroll
        for (int jt = 0; jt < 4; ++jt) { sT[jt] = (f4){0.f, 0.f, 0.f, 0.f};
            if (jt <= nt) {
#pragma unroll
                for (int ks = 0; ks < 4; ++ks) { const bf16x8 a = *(const LAS bf16x8*)(lds + L_KT + jt * 4096 + (koff0 ^ (ks * 64))); sT[jt] = __builtin_amdgcn_mfma_f32_16x16x32_bf16(a, qF[ks], sT[jt], 0, 0, 0); }
                if (jt == nt) {
#pragma unroll
                    for (int rg = 0; rg < 4; ++rg) if (4 * gq + rg > c) sT[jt][rg] = 0.f; } } }
        bf16x8 pb[2];
#pragma unroll
        for (int s = 0; s < 2; ++s) { v4u w; w.x = pg8::cvt_pk_bf16(sT[2 * s][0], sT[2 * s][1]); w.y = pg8::cvt_pk_bf16(sT[2 * s][2], sT[2 * s][3]); w.z = pg8::cvt_pk_bf16(sT[2 * s + 1][0], sT[2 * s + 1][1]); w.w = pg8::cvt_pk_bf16(sT[2 * s + 1][2], sT[2 * s + 1][3]); pb[s] = __builtin_bit_cast(bf16x8, w); }
        f4 o[8]; float ss = 0.f;
#pragma unroll
        for (int mt = 0; mt < 8; ++mt) { o[mt] = (f4){0.f, 0.f, 0.f, 0.f}; const int rb = 128 * half + 16 * mt;
#pragma unroll
            for (int ks = 0; ks < 4; ++ks) { const bf16x8 a = *(const LAS bf16x8*)(lds + L_ST + rb * 256 + (koff0 ^ (ks * 64))); o[mt] = __builtin_amdgcn_mfma_f32_16x16x32_bf16(a, qF[ks], o[mt], 0, 0, 0); }
#pragma unroll
            for (int s = 0; s < 2; ++s) if (2 * s <= nt) { const v2u lo = *(const LAS v2u*)(lds + L_VT + rb * 128 + (voff0 ^ (s * 64))), hi = *(const LAS v2u*)(lds + L_VT + rb * 128 + (voff0 ^ (s * 64 + 32)));
                o[mt] = __builtin_amdgcn_mfma_f32_16x16x32_bf16(__builtin_bit_cast(bf16x8, (v4u){lo.x, lo.y, hi.x, hi.y}), pb[s], o[mt], 0, 0, 0); }
            ss += (o[mt][0] * o[mt][0] + o[mt][1] * o[mt][1]) + (o[mt][2] * o[mt][2] + o[mt][3] * o[mt][3]); }
        ss = nsa::radd32(nsa::radd16(ss));
        LAS float* red = (LAS float*)(lds + L_RED);
        if (gq == 0) red[half * 64 + 16 * nt + c] = ss;
        __syncthreads();
        const float rstd = 1.f / sqrtf((red[16 * nt + c] + red[64 + 16 * nt + c]) * (1.f / 256.f) + RMS_EPS);
        const int tok = t0 + 16 * nt + c;
#pragma unroll
        for (int mt = 0; mt < 8; ++mt) { const int dv = 128 * half + 16 * mt + 4 * gq; const f32x4 g4 = *(const f32x4*)((const char*)gn + (unsigned)(dv * 4));
            const v2u gg = *(const v2u*)((const char*)GG + (unsigned)((tok * 1024 + h * 256 + dv) * 2));
            const float z0 = bflo(gg.x), z1 = bfhi(gg.x), z2 = bflo(gg.y), z3 = bfhi(gg.y);
            v2u w; w.x = pg8::cvt_pk_bf16(o[mt][0] * rstd * g4.x * (z0 * __builtin_amdgcn_rcpf(1.f + __expf(-z0))), o[mt][1] * rstd * g4.y * (z1 * __builtin_amdgcn_rcpf(1.f + __expf(-z1))));
            w.y = pg8::cvt_pk_bf16(o[mt][2] * rstd * g4.z * (z2 * __builtin_amdgcn_rcpf(1.f + __expf(-z2))), o[mt][3] * rstd * g4.w * (z3 * __builtin_amdgcn_rcpf(1.f + __expf(-z3))));
            *(v2u*)((char*)A2 + (unsigned)((tok * DM + h * 256 + dv) * 2)) = w; }
        __syncthreads();
    }
}

constexpr size_t WS_LH = WS_DEC + (size_t)2048 * 128 * 4;
constexpr size_t WS_PEV = WS_LH + (size_t)2 * 4096 * 256 * 4;
static_assert(WS_PEV + 1024 <= WS_KCMP, "cmp scratch overlay");
struct CmpOrder {
    int c; const bf16 *kc, *vc, *wk, *wv;
    __device__ __forceinline__ bool next(int i, pg8::Unit& u) const { if (i > 0 || c >= 32) return false; u.pm = c & 15; u.pn = 0; u.kind = c >> 4; return true; }
    __device__ __forceinline__ const char* pa(const pg8::Gemm&, const pg8::Unit& u) const { return (const char*)(u.kind ? vc : kc) + (size_t)u.pm * ((size_t)256 * 2048 * 2); }
    __device__ __forceinline__ const char* pb(const pg8::Gemm&, const pg8::Unit& u) const { return (const char*)(u.kind ? wv : wk); }
    __device__ __forceinline__ void a_ready(const pg8::Unit&) const {}
    __device__ __forceinline__ void done(const pg8::Unit&) const {}
};
struct EpiLH {
    static constexpr bool PERM = false, AFTER_DRAIN = false;
    float* LH;
    __device__ __forceinline__ void operator()(const pg8::f32x4 (&acc)[2][2][4][2], const pg8::Unit& u, int wr, int wc, int fr, int fq) const {
        const int row0 = u.kind * 4096 + u.pm * 256 + wr * 64 + fr, col0 = wc * 32 + 4 * fq;
#pragma unroll
        for (int ai = 0; ai < 2; ++ai)
#pragma unroll
            for (int m = 0; m < 4; ++m) { float* rowp = LH + (size_t)(row0 + ai * 128 + m * 16) * 256 + col0;
#pragma unroll
                for (int bj = 0; bj < 2; ++bj)
#pragma unroll
                    for (int n = 0; n < 2; ++n) *(pg8::f32x4*)(rowp + bj * 128 + n * 16) = acc[ai][bj][m][n]; }
    }
};

constexpr size_t PROWS = (size_t)MAXTILES * 256;
constexpr size_t WS_W1Q = WS_W1T;
constexpr size_t WS_W2Q = WS_W1Q + (size_t)NE * 4096 * DM;
constexpr size_t WS_HN8 = WS_W2Q + (size_t)NE * DM * DFF;
constexpr size_t WS_AMAXP = WS_HN8 + (size_t)T * DM;
constexpr size_t WS_WSC1 = WS_AMAXP + PROWS * 64 * 4;
constexpr size_t WS_WSC2 = WS_WSC1 + (size_t)NE * 4096 * 4;
constexpr size_t WS_HSC = WS_WSC2 + (size_t)NE * 2048 * 4;
constexpr size_t WS_ROWSC = WS_HSC + (size_t)T * 4;
constexpr size_t WS_ASC = WS_ROWSC + PROWS * 4;
static_assert(WS_ASC + PROWS * 4 <= WS_XN, "int8 buffers fit in the retired bf16 expert-weight region");
constexpr size_t WS_ROWTOK = WS_CTL + 512 * 1024;
static_assert(PROWS * 2 <= 512 * 1024 && DM == 2048, "row table fits; gathered rows are 2048 bytes");
constexpr size_t WS_H16 = WS_XG;
static_assert((size_t)T * DM * 2 <= PROWS * DM, "h fits below ACT8");
constexpr size_t WS_XG8 = WS_XG;
constexpr size_t WS_ACT8 = WS_XG + PROWS * DM;
constexpr size_t WS_Y = WS_ACT;
static_assert(WS_ACT8 + PROWS * DM <= WS_ACT, "int8 row buffers fit in the retired gathered-row region");

__device__ __forceinline__ unsigned q8x4(float a, float b, float c, float d) {
    const float M = 12582912.f; const unsigned ua = __builtin_bit_cast(unsigned, a + M), ub = __builtin_bit_cast(unsigned, b + M), uc = __builtin_bit_cast(unsigned, c + M), ud = __builtin_bit_cast(unsigned, d + M);
    return __builtin_amdgcn_perm(ub, ua, 0x0c0c0400u) | (__builtin_amdgcn_perm(ud, uc, 0x0c0c0400u) << 16); }
__device__ __forceinline__ float clamp127(float v) { return __builtin_amdgcn_fmed3f(v, -127.f, 127.f); }
__device__ __forceinline__ unsigned q8x4c(float a, float b, float c, float d) { return q8x4(clamp127(a), clamp127(b), clamp127(c), clamp127(d)); }

constexpr size_t WS_WINQ = WS_WINT;
constexpr size_t WS_WISC = WS_WINT + (size_t)NPT * 256 * DM;
constexpr size_t WS_XN8 = WS_XN;
constexpr size_t WS_XSC = WS_XN + (size_t)T * DM;
constexpr size_t WS_PMAX = WS_HN;
constexpr size_t WS_PMAXI = WS_PMAX + (size_t)64 * 8 * 4096 * 4;

constexpr int NSLAB_E = NE * 192, NSLAB = NSLAB_E + 178;
struct SlabSrc { const float* W; int N; bool ok; };
__device__ __forceinline__ SlabSrc slab_src(const Params& p, int sl, int r0, int n4) {
    SlabSrc s;
    if (sl < NSLAB_E) { const int e = sl / 192, r = sl % 192; const bool isw2 = r >= 128; const int nb = isw2 ? r - 128 : r; s.N = isw2 ? 2048 : 4096;
        s.W = (isw2 ? p.in[I_W2] + (size_t)e * DFF * DM : p.in[I_W1] + (size_t)e * DM * 4096) + (size_t)r0 * s.N + nb * 32 + 4 * n4; s.ok = true; }
    else { const int nb = sl - NSLAB_E; s.N = 5672; s.ok = nb * 32 + 4 * n4 < 5672; s.W = p.in[I_WIN] + (size_t)r0 * 5672 + (s.ok ? nb * 32 + 4 * n4 : 0); }
    return s;
}
__device__ __forceinline__ void p0_slab_quant(const Params& p, LAS unsigned char* lds, int bid, int G, int tid) {
    constexpr int RS = 4104;
    LAS unsigned char* TT = lds; LAS float* part = (LAS float*)(lds + 32 * RS); LAS float* inv = part + 64 * 32; LAS int* drow = (LAS int*)(inv + 32);
    signed char* W1Q = (signed char*)(p.ws + WS_W1Q); signed char* W2Q = (signed char*)(p.ws + WS_W2Q); signed char* WIQ = (signed char*)(p.ws + WS_WINQ);
    float* WSC1 = (float*)(p.ws + WS_WSC1); float* WSC2 = (float*)(p.ws + WS_WSC2); float* WISC = (float*)(p.ws + WS_WISC);
    const int n4 = tid & 7, r0 = tid >> 3;
    f32x4 va[8], vb[8];
#define SLAB_ISSUE(dst, sl, j) do { if ((sl) < NSLAB) { const SlabSrc ss_ = slab_src(p, (sl), 2 * r0, n4); _Pragma("unroll") for (int u = 0; u < 8; ++u) dst[u] = __builtin_nontemporal_load((const f32x4*)(ss_.W + (size_t)(128 * (4 * (j) + (u >> 1)) + (u & 1)) * ss_.N)); } } while (0)
#define SLAB_USE(src, j) do { _Pragma("unroll") for (int u2 = 0; u2 < 4; ++u2) { const f32x4 xa = src[2 * u2], xb = src[2 * u2 + 1]; const int k = 2 * r0 + 128 * (4 * (j) + u2);        \
            const unsigned w0 = cvt2bf(xa.x, xb.x), w1 = cvt2bf(xa.y, xb.y), w2 = cvt2bf(xa.z, xb.z), w3 = cvt2bf(xa.w, xb.w);        \
            mx0 = __builtin_elementwise_max(mx0, __builtin_bit_cast(u16x2, w0 & 0x7fff7fffu)); mx1 = __builtin_elementwise_max(mx1, __builtin_bit_cast(u16x2, w1 & 0x7fff7fffu)); \
            mx2 = __builtin_elementwise_max(mx2, __builtin_bit_cast(u16x2, w2 & 0x7fff7fffu)); mx3 = __builtin_elementwise_max(mx3, __builtin_bit_cast(u16x2, w3 & 0x7fff7fffu)); \
            LAS unsigned char* d = TT + (4 * n4) * RS + k * 2; \
            *(LAS unsigned*)d = w0; *(LAS unsigned*)(d + RS) = w1; *(LAS unsigned*)(d + 2 * RS) = w2; *(LAS unsigned*)(d + 3 * RS) = w3; } } while (0)
    SLAB_ISSUE(va, bid, 0); SLAB_ISSUE(vb, bid, 1);
    for (int slab = bid; slab < NSLAB; slab += G) {
        u16x2 mx0 = (u16x2){0, 0}, mx1 = (u16x2){0, 0}, mx2 = (u16x2){0, 0}, mx3 = (u16x2){0, 0};
        SLAB_USE(va, 0); SLAB_ISSUE(va, slab, 2);
        SLAB_USE(vb, 1); SLAB_ISSUE(vb, slab, 3);
        SLAB_USE(va, 2); SLAB_ISSUE(va, slab + G, 0);
        SLAB_USE(vb, 3); SLAB_ISSUE(vb, slab + G, 1);
        { u16x2 t0, t1; { const unsigned m0 = __builtin_bit_cast(unsigned, mx0), m1 = __builtin_bit_cast(unsigned, mx1), m2 = __builtin_bit_cast(unsigned, mx2), m3 = __builtin_bit_cast(unsigned, mx3);
            t0 = __builtin_elementwise_max(__builtin_bit_cast(u16x2, __builtin_amdgcn_perm(m1, m0, 0x05040100u)), __builtin_bit_cast(u16x2, __builtin_amdgcn_perm(m1, m0, 0x07060302u)));
            t1 = __builtin_elementwise_max(__builtin_bit_cast(u16x2, __builtin_amdgcn_perm(m3, m2, 0x05040100u)), __builtin_bit_cast(u16x2, __builtin_amdgcn_perm(m3, m2, 0x07060302u))); }
#pragma unroll
          for (int o = 8; o < 64; o <<= 1) { t0 = __builtin_elementwise_max(t0, __builtin_bit_cast(u16x2, __shfl_xor(__builtin_bit_cast(int, t0), o))); t1 = __builtin_elementwise_max(t1, __builtin_bit_cast(u16x2, __shfl_xor(__builtin_bit_cast(int, t1), o))); }
          const unsigned a0 = __builtin_bit_cast(unsigned, t0), a1 = __builtin_bit_cast(unsigned, t1);
          if ((tid & 63) < 8) *(LAS f32x4*)(part + (tid >> 6) * 32 + 4 * n4) = (f32x4){bflo(a0), bfhi(a0), bflo(a1), bfhi(a1)}; }
        __syncthreads();
        if (tid < 32) { float m = 0.f;
#pragma unroll
            for (int q = 0; q < 8; ++q) m = fmaxf(m, part[q * 32 + tid]);
            const float sc = m > 0.f ? m * (1.f / 127.f) : 1.f; inv[tid] = 1.f / sc;
            if (slab < NSLAB_E) { const int e = slab / 192, r = slab % 192; const bool isw2 = r >= 128; const int n = (isw2 ? r - 128 : r) * 32 + tid;
                if (isw2) { drow[tid] = e * 2048 + n; WSC2[e * 2048 + n] = sc; }
                else { const int j2 = n & 2047, row = (j2 >> 7) * 256 + (n >= 2048 ? 128 : 0) + (j2 & 127); drow[tid] = e * 4096 + row; WSC1[e * 4096 + row] = sc; } }
            else { const int n = (slab - NSLAB_E) * 32 + tid; if (n < 5672) { float qsc; const int row = win_row(n, qsc); drow[tid] = row; WISC[row] = sc * qsc; } else drow[tid] = -1; } }
        __syncthreads();
        { const int kc = tid & 7, n = (tid >> 3) & 31, hf = tid >> 8; const float iv = inv[n]; const int dr = drow[n];
          signed char* dst = (slab < NSLAB_E ? ((slab % 192) >= 128 ? W2Q : W1Q) : WIQ) + (size_t)(dr < 0 ? 0 : dr) * 2048; const LAS unsigned char* src = TT + n * RS;
          if (dr >= 0) {
#pragma unroll
          for (int m8 = 0; m8 < 8; ++m8) { const int k0 = 16 * (kc + 8 * (hf + 2 * m8)); const LAS v2u* sp = (const LAS v2u*)(src + k0 * 2); const v2u a = sp[0], b = sp[1], c = sp[2], d = sp[3]; v4u o;
              o.x = q8x4(bflo(a.x) * iv, bfhi(a.x) * iv, bflo(a.y) * iv, bfhi(a.y) * iv); o.y = q8x4(bflo(b.x) * iv, bfhi(b.x) * iv, bflo(b.y) * iv, bfhi(b.y) * iv);
              o.z = q8x4(bflo(c.x) * iv, bfhi(c.x) * iv, bflo(c.y) * iv, bfhi(c.y) * iv); o.w = q8x4(bflo(d.x) * iv, bfhi(d.x) * iv, bflo(d.y) * iv, bfhi(d.y) * iv);
              *(v4u*)(dst + k0) = o; } } }
        __syncthreads();
    }
#undef SLAB_ISSUE
#undef SLAB_USE
}
struct EpiSwigluI8 {
    static constexpr bool PERM = true, AFTER_DRAIN = false;
    const float* b1; const float* rowsc; const float* wsc1; bf16* act; float* amaxp;
    __device__ __forceinline__ void operator()(const pg8::f32x4 (&acc)[2][2][4][2], const pg8::Unit& u, int wr, int wc, int fr, int fq) const {
        const int e = u.kind; const int cin = wc * 32 + 8 * fq; const int col = u.pn * 128 + cin; const int row0 = u.pm * 256 + wr * 64 + fr;
        const float* bg = b1 + (size_t)e * 4096 + col; const float* bl = bg + 2048; const float* sg = wsc1 + (size_t)e * 4096 + u.pn * 256 + cin; const float* sl = sg + 128;
        float gb[8], lb[8], gs[8], ls[8];
#pragma unroll
        for (int j = 0; j < 8; ++j) { gb[j] = bg[j]; lb[j] = bl[j]; gs[j] = sg[j]; ls[j] = sl[j]; }
#pragma unroll
        for (int ai = 0; ai < 2; ++ai)
#pragma unroll
            for (int m = 0; m < 4; ++m) { const int r = row0 + ai * 128 + m * 16; const float rs = rowsc[r]; float o[8]; float mx = 0.f;
#pragma unroll
                for (int n = 0; n < 2; ++n)
#pragma unroll
                    for (int j = 0; j < 4; ++j) { float gl = (float)__float_as_int(acc[ai][0][m][n][j]) * (rs * gs[n * 4 + j]) + gb[n * 4 + j]; float li = (float)__float_as_int(acc[ai][1][m][n][j]) * (rs * ls[n * 4 + j]) + lb[n * 4 + j];
                        gl = fminf(gl, 7.f); li = fminf(fmaxf(li, -7.f), 7.f);
                        const float v = gl * __builtin_amdgcn_rcpf(1.f + __builtin_amdgcn_exp2f(-2.4554669595930156f * gl)) * (li + 1.f); o[n * 4 + j] = v; mx = fmaxf(mx, fabsf(v)); }
                mx = nsa::rmax32(nsa::rmax16(mx));
                if (fq == 0) amaxp[(size_t)r * 64 + u.pn * 4 + wc] = mx;
                pg8::u32x4 w; w.x = pg8::cvt_pk_bf16(o[0], o[1]); w.y = pg8::cvt_pk_bf16(o[2], o[3]); w.z = pg8::cvt_pk_bf16(o[4], o[5]); w.w = pg8::cvt_pk_bf16(o[6], o[7]);
                *(pg8::u32x4*)(act + (size_t)r * DFF + col) = w; }
    }
};
__device__ __forceinline__ void ph_actq(const Params& p, int gw, int NGW, int lane) {
    const int nrows = ((const int*)(p.ws + WS_META))[0] * 256; const float* amaxp = (const float*)(p.ws + WS_AMAXP); const bf16* act = (const bf16*)(p.ws + WS_ACT);
    signed char* A8 = (signed char*)(p.ws + WS_ACT8); float* ASC = (float*)(p.ws + WS_ASC);
    for (int rb = gw; rb < nrows; rb += 2 * NGW) {
        const int r0 = rb, r1 = rb + NGW; const bool h1 = r1 < nrows; const int r1c = h1 ? r1 : r0;
        float m0 = amaxp[(size_t)r0 * 64 + lane], m1 = amaxp[(size_t)r1c * 64 + lane];
        const v4u* s0 = (const v4u*)(act + (size_t)r0 * DFF) + lane * 4; const v4u* s1 = (const v4u*)(act + (size_t)r1c * DFF) + lane * 4; v4u a[2][4];
#pragma unroll
        for (int j = 0; j < 4; ++j) { a[0][j] = s0[j]; a[1][j] = s1[j]; }
        m0 = wave_max(m0); m1 = wave_max(m1);
#pragma unroll
        for (int q = 0; q < 2; ++q) { const int r = q ? r1 : r0; if (q && !h1) break; const float mx = q ? m1 : m0; const float sc = mx > 0.f ? mx * (1.f / 127.f) : 1.f, iv = 1.f / sc; v4u o[2];
#pragma unroll
            for (int h = 0; h < 2; ++h) { const v4u x = a[q][2 * h], y = a[q][2 * h + 1];
                o[h].x = q8x4c(bflo(x.x) * iv, bfhi(x.x) * iv, bflo(x.y) * iv, bfhi(x.y) * iv); o[h].y = q8x4c(bflo(x.z) * iv, bfhi(x.z) * iv, bflo(x.w) * iv, bfhi(x.w) * iv);
                o[h].z = q8x4c(bflo(y.x) * iv, bfhi(y.x) * iv, bflo(y.y) * iv, bfhi(y.y) * iv); o[h].w = q8x4c(bflo(y.z) * iv, bfhi(y.z) * iv, bflo(y.w) * iv, bfhi(y.w) * iv); }
            v4u* dst = (v4u*)(A8 + (size_t)r * DFF) + lane * 2; dst[0] = o[0]; dst[1] = o[1];
            if (lane == 0) ASC[r] = sc; } }
}
struct EpiDownI8 {
    static constexpr bool PERM = true, AFTER_DRAIN = false;
    const float* b2; const float* roww; const float* asc; const float* wsc2; bf16* y;
    __device__ __forceinline__ void operator()(const pg8::f32x4 (&acc)[2][2][4][2], const pg8::Unit& u, int wr, int wc, int fr, int fq) const {
        const int e = u.kind; const int col0 = u.pn * 256 + wc * 32 + 8 * fq; const int row0 = u.pm * 256 + wr * 64 + fr;
        float bv[2][8], sv[2][8];
#pragma unroll
        for (int bj = 0; bj < 2; ++bj)
#pragma unroll
            for (int j = 0; j < 8; ++j) { bv[bj][j] = b2[(size_t)e * DM + col0 + bj * 128 + j]; sv[bj][j] = wsc2[(size_t)e * DM + col0 + bj * 128 + j]; }
#pragma unroll
        for (int ai = 0; ai < 2; ++ai)
#pragma unroll
            for (int m = 0; m < 4; ++m) { const int r = row0 + ai * 128 + m * 16; const float g = roww[r], as = asc[r];
#pragma unroll
                for (int bj = 0; bj < 2; ++bj) { float o[8];
#pragma unroll
                    for (int n = 0; n < 2; ++n)
#pragma unroll
                        for (int j = 0; j < 4; ++j) o[n * 4 + j] = ((float)__float_as_int(acc[ai][bj][m][n][j]) * (as * sv[bj][n * 4 + j]) + bv[bj][n * 4 + j]) * g;
                    pg8::u32x4 w; w.x = pg8::cvt_pk_bf16(o[0], o[1]); w.y = pg8::cvt_pk_bf16(o[2], o[3]); w.z = pg8::cvt_pk_bf16(o[4], o[5]); w.w = pg8::cvt_pk_bf16(o[6], o[7]);
                    *(pg8::u32x4*)(y + (size_t)r * DM + col0 + bj * 128) = w; } }
    }
};

struct EpiProjI8 {
    static constexpr bool PERM = true, AFTER_DRAIN = false;
    unsigned char* ws;
    __device__ __forceinline__ void operator()(const pg8::f32x4 (&acc)[2][2][4][2], const pg8::Unit& u, int wr, int wc, int fr, int fq) const {
        const int cw = wc * 32 + 8 * fq; const float* XSC = (const float*)(ws + WS_XSC); const float* WISC = (const float*)(ws + WS_WISC);
        if (u.kind == 0) {
            const int tn = u.pn; bf16* base; size_t bjs = 128; int ld = 0; bool headmajor = false; bool small = false;
            if (tn < 2) { base = (bf16*)(ws + WS_GQ) + tn * 256; ld = 512; }
            else if (tn < 4) { base = (bf16*)(ws + WS_GK) + (tn - 2) * 256; ld = 512; }
            else if (tn < 8) { base = (bf16*)(ws + WS_GV) + (tn - 4) * 256; ld = 1024; }
            else if (tn < 12) { base = (bf16*)(ws + WS_GG) + (tn - 8) * 256; ld = 1024; }
            else if (tn < 16) { base = (bf16*)(ws + WS_NQ) + (tn - 12) * 256; ld = 1024; }
            else if (tn < 20) { base = (bf16*)(ws + (tn == 16 ? WS_KC : tn == 17 ? WS_VC : tn == 18 ? WS_KS : WS_KW)); headmajor = true; bjs = (size_t)SEQ * 128; }
            else { base = (bf16*)(ws + WS_SM); ld = 64; small = true; }
            if (small && wc >= 2) return;
            float cs[2][8];
#pragma unroll
            for (int bj = 0; bj < 2; ++bj)
#pragma unroll
                for (int j = 0; j < 8; ++j) cs[bj][j] = WISC[tn * 256 + bj * 128 + cw + j];
#pragma unroll
            for (int ai = 0; ai < 2; ++ai)
#pragma unroll
                for (int m = 0; m < 4; ++m) { const int r = u.pm * 256 + ai * 128 + wr * 64 + m * 16 + fr; const float rs = XSC[r];
                    const size_t rterm = headmajor ? ((size_t)(r >> 12) * 2 * SEQ + (r & (SEQ - 1))) * 128 : (size_t)r * ld;
#pragma unroll
                    for (int bj = 0; bj < 2; ++bj) { if (small && bj) continue; float o[8];
#pragma unroll
                        for (int n = 0; n < 2; ++n)
#pragma unroll
                            for (int j = 0; j < 4; ++j) o[n * 4 + j] = (float)__float_as_int(acc[ai][bj][m][n][j]) * (rs * cs[bj][n * 4 + j]);
                        pg8::u32x4 w; w.x = pg8::cvt_pk_bf16(o[0], o[1]); w.y = pg8::cvt_pk_bf16(o[2], o[3]); w.z = pg8::cvt_pk_bf16(o[4], o[5]); w.w = pg8::cvt_pk_bf16(o[6], o[7]);
                        *(pg8::u32x4*)(base + rterm + bj * bjs + cw) = w; } }
        } else {
            bf16* base = (bf16*)(ws + (u.pn == 21 ? WS_VST : WS_VWT));
#pragma unroll
            for (int ai = 0; ai < 2; ++ai)
#pragma unroll
                for (int m = 0; m < 4; ++m) { const int dh = wr * 64 + m * 16 + fr; const float ws_ = WISC[u.pn * 256 + ai * 128 + dh];
#pragma unroll
                    for (int bj = 0; bj < 2; ++bj) { const int tok = u.pm * 256 + bj * 128 + cw; const int b = tok >> 12, s = tok & (SEQ - 1); float o[8];
                        const pg8::f32x4 x0 = *(const pg8::f32x4*)(XSC + tok), x1 = *(const pg8::f32x4*)(XSC + tok + 4);
#pragma unroll
                        for (int j = 0; j < 4; ++j) { o[j] = (float)__float_as_int(acc[ai][bj][m][0][j]) * (ws_ * x0[j]); o[4 + j] = (float)__float_as_int(acc[ai][bj][m][1][j]) * (ws_ * x1[j]); }
                        pg8::u32x4 w; w.x = pg8::cvt_pk_bf16(o[0], o[1]); w.y = pg8::cvt_pk_bf16(o[2], o[3]); w.z = pg8::cvt_pk_bf16(o[4], o[5]); w.w = pg8::cvt_pk_bf16(o[6], o[7]);
                        *(pg8::u32x4*)(base + ((size_t)(b * 2 + ai) * 128 + dh) * SEQ + s) = w; } }
        }
    }
};

__device__ __forceinline__ void r1_router(const Params& p, LAS unsigned char* lds, int vb, int tid, int wave, int lane) {
    LAS float* rowbuf = (LAS float*)lds;
    LAS float* part = (LAS float*)(lds + 65536);
    LAS int* tk = (LAS int*)(lds + 81920 + wave * 1024);
    LAS int* cntw = (LAS int*)(lds + 90112);
    const bf16* h = (const bf16*)(p.ws + WS_H16); const float* gf = p.in[I_NFFN]; const float* rw = p.in[I_RW]; const float* rb = p.in[I_RB];
    signed char* HN8 = (signed char*)(p.ws + WS_HN8);
    const int e = lane & 31, eg = tid & 31, dg = tid >> 5; int mycount = 0;
    float rwr[128];
#pragma unroll
    for (int c4 = 0; c4 < 4; ++c4) { unsigned o = (unsigned)((((dg * 128 + c4 * 32) * 32) + eg) * 4); asm volatile("" : "+v"(o));
#pragma unroll
        for (int i = 0; i < 32; ++i) rwr[c4 * 32 + i] = *(const float*)((const char*)rw + o + i * 128); }
    v4u hw[4];
    { const v4u* xr = (const v4u*)(h + (size_t)(vb * TPV + wave) * DM) + lane;
#pragma unroll
      for (int q = 0; q < 4; ++q) hw[q] = xr[64 * q]; }
    for (int grp = 0; grp < 16; ++grp) { const int t = vb * TPV + grp * 8 + wave;
        { float s = 0.f;
#pragma unroll
          for (int q = 0; q < 4; ++q) { const float a0 = bflo(hw[q].x), a1 = bfhi(hw[q].x), a2 = bflo(hw[q].y), a3 = bfhi(hw[q].y), a4 = bflo(hw[q].z), a5 = bfhi(hw[q].z), a6 = bflo(hw[q].w), a7 = bfhi(hw[q].w);
              s += ((a0 * a0 + a1 * a1) + (a2 * a2 + a3 * a3)) + ((a4 * a4 + a5 * a5) + (a6 * a6 + a7 * a7)); }
          const float rstd = 1.f / sqrtf(wave_sum(s) * (1.f / DM) + RMS_EPS);
          float mxr = 0.f; LAS f32x4* hrow = (LAS f32x4*)(rowbuf + wave * 2048);
#pragma unroll
          for (int j = 0; j < 8; ++j) { const int cj = 2 * lane + 128 * (j >> 1) + (j & 1); const f32x4 g4 = ((const f32x4*)gf)[cj]; const unsigned wa = (j & 1) ? hw[j >> 1].z : hw[j >> 1].x, wb = (j & 1) ? hw[j >> 1].w : hw[j >> 1].y;
              f32x4 y; y.x = bflo(wa) * rstd * g4.x; y.y = bfhi(wa) * rstd * g4.y; y.z = bflo(wb) * rstd * g4.z; y.w = bfhi(wb) * rstd * g4.w;
              hrow[cj] = y; mxr = fmaxf(mxr, fmaxf(fmaxf(fabsf(y.x), fabsf(y.y)), fmaxf(fabsf(y.z), fabsf(y.w)))); }
          mxr = wave_max(mxr); const float qs = mxr > 0.f ? mxr * (1.f / 127.f) : 1.f, qi = 1.f / qs;
          v2u* o8 = (v2u*)(HN8 + (size_t)t * DM) + lane;
#pragma unroll
          for (int q = 0; q < 4; ++q) { const f32x4 ya = hrow[2 * lane + 128 * q], yb = hrow[2 * lane + 128 * q + 1]; v2u o;
              o.x = q8x4(ya.x * qi, ya.y * qi, ya.z * qi, ya.w * qi); o.y = q8x4(yb.x * qi, yb.y * qi, yb.z * qi, yb.w * qi); o8[64 * q] = o; }
          if (lane == 0) ((float*)(p.ws + WS_HSC))[t] = qs; }
        __syncthreads();
        { const int tn = vb * TPV + (grp < 15 ? grp + 1 : grp) * 8 + wave; const v4u* xr = (const v4u*)(h + (size_t)tn * DM) + lane;
#pragma unroll
          for (int q = 0; q < 4; ++q) hw[q] = xr[64 * q]; }
        { float acc[8];
#pragma unroll
          for (int tt = 0; tt < 8; ++tt) acc[tt] = 0.f;
#pragma unroll
          for (int i4 = 0; i4 < 32; ++i4) { f32x4 xv[8];
#pragma unroll
              for (int tt = 0; tt < 8; ++tt) xv[tt] = *(const LAS f32x4*)(rowbuf + tt * 2048 + dg * 128 + 4 * i4);
#pragma unroll
              for (int tt = 0; tt < 8; ++tt) acc[tt] += xv[tt].x * rwr[4 * i4] + xv[tt].y * rwr[4 * i4 + 1] + xv[tt].z * rwr[4 * i4 + 2] + xv[tt].w * rwr[4 * i4 + 3];
              if (i4 & 1) asm volatile("" ::: "memory"); }
#pragma unroll
          for (int tt = 0; tt < 8; ++tt) part[(dg * 8 + tt) * 32 + eg] = acc[tt]; }
        __syncthreads();
        { float a = rb[e];
#pragma unroll
          for (int q = 0; q < 16; ++q) a += part[(q * 8 + wave) * 32 + e];
          int rank = 0;
#pragma unroll
          for (int mm = 0; mm < 32; ++mm) { const float lm = __shfl(a, mm); rank += (lm > a || (lm == a && mm < e)) ? 1 : 0; }
          const float mx = wave_max(a); const bool sel = rank < 4;
          const float ex = (sel && lane < 32) ? __expf(a - mx) : 0.f; const float sum = wave_sum(ex);
          if (sel && lane < 32) { LAS int* q = tk + (grp * 4 + rank) * 4; q[0] = e; q[1] = mycount; q[2] = __builtin_bit_cast(int, ex / sum); ++mycount; } }
        __syncthreads();
    }
    int ln; asm volatile("v_mbcnt_lo_u32_b32 %0, -1, 0\n\tv_mbcnt_hi_u32_b32 %0, -1, %0" : "=v"(ln));
    if (ln < 32) cntw[wave * 32 + ln] = mycount;
    __syncthreads();
    if (wave == 0 && ln < 32) { int tot = 0; for (int w = 0; w < 8; ++w) tot += cntw[w * 32 + ln]; ((int*)(p.ws + WS_CNT))[vb * 32 + ln] = tot; }
    { const int i = ln >> 2, k = ln & 3; const LAS int* q = tk + (i * 4 + k) * 4; const int ee = q[0]; int base = 0; for (int w = 0; w < wave; ++w) base += cntw[w * 32 + ee];
      const int t = vb * TPV + i * 8 + wave;
      ((int*)(p.ws + WS_EIDX))[t * 4 + k] = ee; ((int*)(p.ws + WS_LRNK))[t * 4 + k] = base + q[1]; ((int*)(p.ws + WS_GATE))[t * 4 + k] = q[2]; }
    __syncthreads();
}
__device__ __forceinline__ void r2_gather(const Params& p, LAS unsigned char* lds, int vb, bool write_meta, int tid, int wave, int lane) {
    LAS int* part_tot = (LAS int*)lds;
    LAS int* part_base = part_tot + 512;
    LAS int* pbase = part_base + 512;
    const int* CNT = (const int*)(p.ws + WS_CNT);
    { const int e = tid & 31, part = tid >> 5; int tot = 0, bs = 0;
      for (int v = part * 16; v < part * 16 + 16; ++v) { const int c = CNT[v * 32 + e]; tot += c; if (v < vb) bs += c; }
      part_tot[part * 32 + e] = tot; part_base[part * 32 + e] = bs; }
    __syncthreads();
    if (tid == 0) { int ps = 0; int* meta = (int*)(p.ws + WS_META); int nt = 0;
        for (int e = 0; e < 32; ++e) { int tot = 0, bs = 0; for (int q = 0; q < 16; ++q) { tot += part_tot[q * 32 + e]; bs += part_base[q * 32 + e]; }
            pbase[e] = ps + bs; const int ntile = (tot + 255) >> 8;
            if (write_meta) for (int q = 0; q < ntile; ++q) meta[64 + nt + q] = e;
            nt += ntile; ps += ntile * 256; }
        if (write_meta) meta[0] = nt; }
    __syncthreads();
    const float* HSC = (const float*)(p.ws + WS_HSC); float* ROWSC = (float*)(p.ws + WS_ROWSC);
    const int* EIDX = (const int*)(p.ws + WS_EIDX); const int* LRNK = (const int*)(p.ws + WS_LRNK); const float* GATE = (const float*)(p.ws + WS_GATE);
    int* POS = (int*)(p.ws + WS_POS); float* ROWW = (float*)(p.ws + WS_ROWW);
    unsigned short* RT = (unsigned short*)(p.ws + WS_ROWTOK);
    { const int t = vb * TPV + (tid >> 2), k = tid & 3;
      const int pos = pbase[EIDX[t * 4 + k]] + LRNK[t * 4 + k];
      POS[t * 4 + k] = pos; ROWW[pos] = GATE[t * 4 + k]; ROWSC[pos] = HSC[t]; RT[(pos & ~255) + (pos & 63) * 4 + ((pos >> 6) & 3)] = (unsigned short)t; }
    __syncthreads();
}
__device__ __forceinline__ void pf_final(const Params& p, int gw, int NGW, int lane) {
    const bf16* Y = (const bf16*)(p.ws + WS_Y); const int* POS = (const int*)(p.ws + WS_POS); const float* gfin = p.in[I_NFIN]; const bf16* H = (const bf16*)(p.ws + WS_H16);
    for (int t = gw; t < T; t += NGW) {
        f32x4 v[8]; const v4u* hr = (const v4u*)(H + (size_t)t * DM) + lane;
#pragma unroll
        for (int q = 0; q < 4; ++q) { const v4u w = hr[64 * q]; v[2 * q] = (f32x4){bflo(w.x), bfhi(w.x), bflo(w.y), bfhi(w.y)}; v[2 * q + 1] = (f32x4){bflo(w.z), bfhi(w.z), bflo(w.w), bfhi(w.w)}; }
#pragma unroll
        for (int k = 0; k < 4; ++k) { const int pos = POS[t * 4 + k]; const v4u* yr = (const v4u*)(Y + (size_t)pos * DM) + lane;
#pragma unroll
            for (int q = 0; q < 4; ++q) { const v4u w = yr[64 * q]; v[2 * q].x += bflo(w.x); v[2 * q].y += bfhi(w.x); v[2 * q].z += bflo(w.y); v[2 * q].w += bfhi(w.y);
                v[2 * q + 1].x += bflo(w.z); v[2 * q + 1].y += bfhi(w.z); v[2 * q + 1].z += bflo(w.w); v[2 * q + 1].w += bfhi(w.w); } }
        float s = 0.f;
#pragma unroll
        for (int j = 0; j < 8; ++j) s += (v[j].x * v[j].x + v[j].y * v[j].y) + (v[j].z * v[j].z + v[j].w * v[j].w);
        const float rstd = 1.f / sqrtf(wave_sum(s) * (1.f / DM) + RMS_EPS); f32x4* xr = (f32x4*)(p.out + (size_t)t * DM);
#pragma unroll
        for (int j = 0; j < 8; ++j) { const int cj = 2 * lane + 128 * (j >> 1) + (j & 1); const f32x4 g4 = ((const f32x4*)gfin)[cj]; f32x4 o; o.x = v[j].x * rstd * g4.x; o.y = v[j].y * rstd * g4.y; o.z = v[j].z * rstd * g4.z; o.w = v[j].w * rstd * g4.w; xr[cj] = o; }
    }
}


constexpr int LDS_BYTES = 159744;
constexpr int MISC_OFF = LDS_BYTES - 256;  static_assert(nsa::LDS_END <= MISC_OFF && gla::L_END <= MISC_OFF, "LDS map");
constexpr int CW_BAR = 4096, CW_XL = 16384;
__global__ __launch_bounds__(512, 2) void mega_fwd(Params p) {
    extern __shared__ __attribute__((aligned(16))) unsigned char lds_raw[];
    LAS unsigned char* lds = (LAS unsigned char*)lds_raw;
    const int G = gridDim.x, bid = blockIdx.x, NGW = G * 8;
#define PH_IDS int tid = threadIdx.x; asm volatile("" : "+v"(tid)); const int lane = tid & 63, wave = __builtin_amdgcn_readfirstlane(tid >> 6), gw = bid * 8 + wave; (void)lane; (void)gw;
    for (int u = threadIdx.x; u < 64; u += 512) ((LAS unsigned*)(lds + MISC_OFF))[u] = 0u;
    __syncthreads();
    XcdBarrier bar = xcd_barrier_post((unsigned*)(p.ws + WS_CTL) + CW_BAR, (volatile LAS unsigned*)(lds + MISC_OFF) + 8);
    { PH_IDS; p0_prologue(p, lds, gw, NGW, wave, lane); __syncthreads(); p0_slab_quant(p, lds, bid, G, tid); }
    xcd_barrier(bar);
    { pg8::Gemm g{(const bf16*)(p.ws + WS_XN8), (const bf16*)(p.ws + WS_WINQ), T, NPT * 256, DM / 2};
      ProjOrder S; S.init(T, NPT * 256, G, bid); S.xn = g.A; S.wt = g.Bt; EpiProjI8 E{p.ws};
      pg8::gemm_phase<EpiProjI8, ProjOrder, true, true, true>(lds, g, S, E); }
    xcd_barrier(bar);
    if (bid < 32) {
        pg8::Gemm g{(const bf16*)(p.ws + WS_KC), (const bf16*)(p.ws + WS_WKCT), 4096, 256, 2048};
        CmpOrder S{bid, (const bf16*)(p.ws + WS_KC), (const bf16*)(p.ws + WS_VC), (const bf16*)(p.ws + WS_WKCT), (const bf16*)(p.ws + WS_WVCT)}; EpiLH E{(float*)(p.ws + WS_LH)};
        pg8::gemm_phase<EpiLH, CmpOrder, true, true>(lds, g, S, E);
    } else { PH_IDS; ph_gla_a(p, lds, bid - 32, G - 32, tid, wave); }
    xcd_barrier(bar);
    { PH_IDS; ph_gla_b(p, bid * 512 + tid, G * 512);
      for (int i = bid * 512 + tid; i < 16 * 128; i += G * 512) { const int bgz = i >> 7, dz = i & 127; ((bf16*)(p.ws + WS_KCMP))[((size_t)bgz * 256 + 255) * 128 + dz] = 0; ((bf16*)(p.ws + WS_VCMPT))[((size_t)bgz * 128 + dz) * 256 + 255] = 0; }
      const int ngrp = G * 4, total = 2 * 16 * 255, iters = (total + ngrp - 1) / ngrp; const int grp = tid >> 7;
      for (int it = 0; it < iters; ++it) { int id = it * ngrp + bid * 4 + grp; if (id >= total) id = total - 1;
          ph_cmp_fin_simple(p, (LAS float*)lds + grp * 4352, id, tid & 127, (const float*)(p.ws + WS_LH), (const float*)(p.ws + WS_PEVP)); __syncthreads(); } }
    xcd_barrier(bar);
    { PH_IDS; ph_nsa(p, lds, bid, G, tid, wave); }
    { PH_IDS; __syncthreads(); ph_gla_c(p, lds, bid, G, tid, wave); }
    xcd_barrier(bar);
    { pg8::Gemm g{(const bf16*)(p.ws + WS_A2), (const bf16*)(p.ws + WS_WOT), T, DM, DM};
      pg8::StaticOrder S; S.init(T, DM, G, bid); EpiRes E{p.in[I_X], (bf16*)(p.ws + WS_H16)};
      pg8::gemm_phase<EpiRes, pg8::StaticOrder, true, true>(lds, g, S, E); }
    xcd_barrier(bar);
    { PH_IDS; for (int vb = bid; vb < NVB; vb += G) r1_router(p, lds, vb, tid, wave, lane); }
    xcd_barrier(bar);
    { PH_IDS; for (int vb = bid; vb < NVB; vb += G) r2_gather(p, lds, vb, vb == 0, tid, wave, lane); }
    xcd_barrier(bar);
    { pg8::Gemm g{(const bf16*)(p.ws + WS_HN8), (const bf16*)(p.ws + WS_W1Q), MAXTILES * 256, 4096, DM / 2};
      MoeOrderG S; S.init((const int*)(p.ws + WS_META), 16, G, bid); S.rowtab = (const unsigned short*)(p.ws + WS_ROWTOK); EpiSwigluI8 E{p.in[I_B1], (const float*)(p.ws + WS_ROWSC), (const float*)(p.ws + WS_WSC1), (bf16*)(p.ws + WS_ACT), (float*)(p.ws + WS_AMAXP)};
      pg8::gemm_phase<EpiSwigluI8, MoeOrderG, true, true, true, true>(lds, g, S, E); }
    xcd_barrier(bar);
    { PH_IDS; ph_actq(p, gw, NGW, lane); }
    xcd_barrier(bar);
    { pg8::Gemm g{(const bf16*)(p.ws + WS_ACT8), (const bf16*)(p.ws + WS_W2Q), MAXTILES * 256, DM, DFF / 2};
      MoeOrder S; S.init((const int*)(p.ws + WS_META), 8, G, bid); EpiDownI8 E{p.in[I_B2], (const float*)(p.ws + WS_ROWW), (const float*)(p.ws + WS_ASC), (const float*)(p.ws + WS_WSC2), (bf16*)(p.ws + WS_Y)};
      pg8::gemm_phase<EpiDownI8, MoeOrder, true, true, true>(lds, g, S, E); }
    xcd_barrier(bar);
    { PH_IDS; pf_final(p, gw, NGW, lane); }
}

extern "C" void kernel_launch(void* const* d_in, const int* in_sizes, int n_in, void* d_out, int out_size, void* d_ws, size_t ws_size, hipStream_t stream) {
    static int grid = 0;
    if (grid == 0) {
        if (n_in != N_IN || out_size != T * DM || ws_size < WS_END) { fprintf(stderr, "kernel_launch: unexpected shapes (n_in %d out %d ws %zu need %zu)\n", n_in, out_size, ws_size, (size_t)WS_END); grid = -1; return; }
        int dev = 0, cus = 0, per_cu = 0;
        if (hipGetDevice(&dev) != hipSuccess || hipDeviceGetAttribute(&cus, hipDeviceAttributeMultiprocessorCount, dev) != hipSuccess) { grid = -1; return; }
        if (hipFuncSetAttribute((const void*)mega_fwd, hipFuncAttributeMaxDynamicSharedMemorySize, LDS_BYTES) != hipSuccess) { fprintf(stderr, "kernel_launch: hipFuncSetAttribute failed\n"); grid = -1; return; }
        if (hipOccupancyMaxActiveBlocksPerMultiprocessor(&per_cu, (const void*)mega_fwd, 512, LDS_BYTES) != hipSuccess || per_cu < 1) { fprintf(stderr, "kernel_launch: occupancy query says %d blocks per CU\n", per_cu); }
        (void)hipGetLastError();
        grid = cus;
    }
    if (grid < 0) return;
    if (hipMemsetAsync((char*)d_ws + WS_CTL, 0, CTL_BYTES, stream) != hipSuccess) return;
    Params p{};
    for (int i = 0; i < N_IN; ++i) p.in[i] = (const float*)d_in[i];
    p.out = (float*)d_out; p.ws = (unsigned char*)d_ws;
    hipLaunchKernelGGL(mega_fwd, dim3(grid), dim3(512), LDS_BYTES, stream, p);
}
```

```cpp
#include <hip/hip_runtime.h>
#include <cstdio>
#include <cstdint>
namespace pg8 {
#define PG8_LAS __attribute__((address_space(3)))
typedef unsigned short bf16_t;
typedef short bf16x8 __attribute__((ext_vector_type(8)));
typedef float f32x4 __attribute__((ext_vector_type(4)));
typedef unsigned u32x4 __attribute__((ext_vector_type(4)));
typedef unsigned v2u_t __attribute__((ext_vector_type(2)));
constexpr int BM = 256, BK = 64, HALF = 128, HTB = HALF * BK * 2  , STAGE_BYTES = 8 * HTB, NXCD = 8, WGM = 8;

__host__ __device__ __forceinline__ int lds_byte(int r, int c) { const int st = (r >> 4) * 2 + (c >> 5), rr = r & 15, cc = c & 31, ob = rr * 64 + cc * 2; return st * 1024 + (ob ^ (((ob >> 9) & 1) << 5)); }
__host__ __device__ __forceinline__ void stage_rc(int b, int& R, int& C) { const int st = b / 1024, sb = b % 1024, swz = sb ^ (((sb >> 9) & 1) << 5); R = (st >> 1) * 16 + swz / 64; C = (st & 1) * 32 + (swz % 64) / 2; }
__host__ __device__ __forceinline__ int perm32(int rho) { const int n = rho >> 4, i = rho & 15; return 8 * (i >> 2) + 4 * n + (i & 3); }

struct Unit { int pm, pn, kind; };
struct Gemm { const bf16_t* A; const bf16_t* Bt; int M, N, K; };

template <int WG = WGM> __host__ __device__ __forceinline__ void tile_of(int wgid, int nM, int nN, int& pm, int& pn) {
    const int nwg = nM * nN;
    { const int q = nwg / NXCD, r = nwg % NXCD, xcd = wgid % NXCD, off = wgid / NXCD; wgid = (xcd < r ? xcd * (q + 1) : r * (q + 1) + (xcd - r) * q) + off; }
    const int nig = WG * nN, gid = wgid / nig, fm = gid * WG, gsz = (nM - fm) < WG ? (nM - fm) : WG;
    pm = fm + ((wgid % nig) % gsz); pn = (wgid % nig) / gsz;
}
struct StaticOrder {
    int nM, nN, nwg, G, c;
    __host__ __device__ void init(int M, int N, int G_, int c_) { nM = M / BM; nN = N / BM; nwg = nM * nN; G = G_; c = c_; }
    __device__ __forceinline__ bool next(int i, Unit& u) const {
        const long L = (long)i * G + c; if (L >= nwg) return false;
        tile_of((int)L, nM, nN, u.pm, u.pn); u.kind = 0; return true;
    }
    __device__ __forceinline__ const char* pa(const Gemm& g, const Unit& u) const { return (const char*)g.A + (size_t)u.pm * ((size_t)BM * g.K * 2); }
    __device__ __forceinline__ const char* pb(const Gemm& g, const Unit& u) const { return (const char*)g.Bt + (size_t)u.pn * ((size_t)BM * g.K * 2); }
    __device__ __forceinline__ void a_ready(const Unit&) const {}
    __device__ __forceinline__ void done(const Unit&) const {}
};
__device__ __forceinline__ unsigned cvt_pk_bf16(float lo, float hi) { unsigned r; asm volatile("v_cvt_pk_bf16_f32 %0, %1, %2" : "=v"(r) : "v"(lo), "v"(hi)); return r; }
template <bool I8> __device__ __forceinline__ f32x4 mma16(bf16x8 a, bf16x8 b, f32x4 c) {
    if constexpr (I8) { typedef int i32x4 __attribute__((ext_vector_type(4)));
        return __builtin_bit_cast(f32x4, __builtin_amdgcn_mfma_i32_16x16x64_i8(__builtin_bit_cast(i32x4, a), __builtin_bit_cast(i32x4, b), __builtin_bit_cast(i32x4, c), 0, 0, 0)); }
    else return __builtin_amdgcn_mfma_f32_16x16x32_bf16(a, b, c, 0, 0, 0);
}
template <class Epi, class Sched, bool ALIGN_EPI = false, bool SP2 = false, bool I8 = false, bool GATHER = false>
__device__ __forceinline__ void gemm_phase(PG8_LAS unsigned char* lds, const Gemm g, const Sched& S, const Epi& E) {
    int tid_l = threadIdx.x; asm volatile("" : "+v"(tid_l));
    const int tid = tid_l, wid = __builtin_amdgcn_readfirstlane(tid >> 6), lane = tid & 63, wr = wid >> 2, wc = wid & 3, fr = lane & 15, fq = lane >> 4;
    const int K = g.K, nt = K / BK;
    unsigned voffA[2], voffB[2];
#pragma unroll
    for (int i = 0; i < 2; ++i) { int R, C; stage_rc(tid * 16 + i * 8192, R, C); const int Rb = Epi::PERM ? ((R & ~31) + perm32(R & 31)) : R;
        voffA[i] = (unsigned)(R * K + C) * 2u; voffB[i] = (unsigned)(Rb * K + C) * 2u; }
    const size_t kstep = (size_t)(BK * 2);
    const size_t hstep = (size_t)HALF * K * 2;
    const unsigned ldsw = (unsigned)wid * 1024u;
    const int aoff = lds_byte(wr * 64 + fr, fq * 8), boff = lds_byte(wc * 32 + fr, fq * 8);
#define PG8_SA(b, h) (((b) * 2 + (h)) * HTB)
#define PG8_SB(b, h) ((4 + (b) * 2 + (h)) * HTB)
#define PG8_STAGE(bufoff, gbase, voff) do { _Pragma("unroll") for (int _i = 0; _i < 2; ++_i) \
        __builtin_amdgcn_global_load_lds((const unsigned*)((const char*)(gbase) + (voff)[_i]), (PG8_LAS unsigned*)(lds + (bufoff) + ldsw + _i * 8192), 16, 0, 0); } while (0)
#define PG8_STAGE_A(bufoff, ptr, h) do { if constexpr (GATHER) PG8_STAGE(bufoff, ptr, cuo + 2 * (h)); else PG8_STAGE(bufoff, (ptr) + (h) * hstep, voffA); } while (0)
#define PG8_LDA(dst, b, h) do { _Pragma("unroll") for (int m = 0; m < 4; ++m) _Pragma("unroll") for (int k = 0; k < 2; ++k) dst[m][k] = *(const PG8_LAS bf16x8*)(lds + PG8_SA(b, h) + aoff + m * 2048 + k * 1024); } while (0)
#define PG8_LDB(dst, b, h) do { _Pragma("unroll") for (int n = 0; n < 2; ++n) _Pragma("unroll") for (int k = 0; k < 2; ++k) dst[n][k] = *(const PG8_LAS bf16x8*)(lds + PG8_SB(b, h) + boff + n * 2048 + k * 1024); } while (0)
#define PG8_MMA(ai, bj, At, Bt) do { __builtin_amdgcn_s_setprio(1); _Pragma("unroll") for (int m = 0; m < 4; ++m) _Pragma("unroll") for (int n = 0; n < 2; ++n) _Pragma("unroll") for (int k = 0; k < 2; ++k) \
        acc[ai][bj][m][n] = mma16<I8>(Bt[n][k], At[m][k], acc[ai][bj][m][n]); __builtin_amdgcn_s_setprio(0); } while (0)
#define PG8_WAIT_V(n) asm volatile("s_waitcnt vmcnt(" #n ")" ::: "memory")
#define PG8_WAIT_L(n) asm volatile("s_waitcnt lgkmcnt(" #n ")" ::: "memory")
#define PG8_BAR __builtin_amdgcn_s_barrier()
#define PG8_SCHED __builtin_amdgcn_sched_barrier(0)
    Unit cur, nxt; int ui = 0;
    if (!S.next(0, cur)) return;
    unsigned cuo[4] = {0u, 0u, 0u, 0u}, cb0 = 0u; v2u_t raw = {0u, 0u};
    if constexpr (GATHER) { int R0, C0; stage_rc(tid * 16, R0, C0); cb0 = (unsigned)C0 * 2u; unsigned ro = (unsigned)R0 * 8u; asm volatile("" : "+v"(ro));
        Unit u1; const bool h1 = S.next(1, u1); const v2u_t r0 = *(const v2u_t*)((const char*)S.rowtab + (size_t)cur.pm * 512 + ro); raw = *(const v2u_t*)((const char*)S.rowtab + (size_t)(h1 ? u1.pm : cur.pm) * 512 + ro);
        cuo[0] = ((r0.x & 0xffffu) << 11) + cb0; cuo[1] = ((r0.x >> 16) << 11) + cb0; cuo[2] = ((r0.y & 0xffffu) << 11) + cb0; cuo[3] = ((r0.y >> 16) << 11) + cb0; }
    f32x4 acc[2][2][4][2];
#pragma unroll
    for (int a = 0; a < 2; ++a)
#pragma unroll
        for (int b = 0; b < 2; ++b)
#pragma unroll
            for (int m = 0; m < 4; ++m)
#pragma unroll
                for (int n = 0; n < 2; ++n) acc[a][b][m][n] = (f32x4){0.f, 0.f, 0.f, 0.f};
    bf16x8 At[4][2], B0[2][2], B1[2][2];
    const char* cA = S.pa(g, cur); const char* cB = S.pb(g, cur);
    S.a_ready(cur);
    if constexpr (SP2) {
        PG8_STAGE(PG8_SB(0, 0), cB, voffB); PG8_STAGE(PG8_SB(0, 1), cB + hstep, voffB); PG8_STAGE_A(PG8_SA(0, 0), cA, 0); PG8_STAGE_A(PG8_SA(0, 1), cA, 1);
        if (wr == 1) PG8_BAR;
        PG8_WAIT_V(2); PG8_BAR;
        PG8_STAGE(PG8_SB(1, 0), cB + kstep, voffB); PG8_STAGE_A(PG8_SA(1, 0), cA + kstep, 0); PG8_STAGE(PG8_SB(1, 1), cB + hstep + kstep, voffB);
        PG8_WAIT_V(6); PG8_BAR;
    } else {
        PG8_STAGE(PG8_SB(0, 0), cB, voffB); PG8_STAGE(PG8_SA(0, 0), cA, voffA); PG8_STAGE(PG8_SB(0, 1), cB + hstep, voffB); PG8_STAGE(PG8_SA(0, 1), cA + hstep, voffA);
        if (wr == 1) PG8_BAR;
        PG8_WAIT_V(4); PG8_BAR;
        PG8_STAGE(PG8_SB(1, 0), cB + kstep, voffB); PG8_STAGE(PG8_SA(1, 0), cA + kstep, voffA); PG8_STAGE(PG8_SB(1, 1), cB + hstep + kstep, voffB);
        PG8_WAIT_V(6); PG8_BAR;
    }
    for (;;) {
        const bool has_next = S.next(ui + 1, nxt);
        const char* nA = has_next ? S.pa(g, nxt) : cA; const char* nB = has_next ? S.pb(g, nxt) : cB;
        for (int t = 0; t < nt; t += 2) {
            const bool last = (t == nt - 2);
            const char* a1 = cA + (size_t)(t + 1) * kstep;
            const char* a2 = last ? nA : cA + (size_t)(t + 2) * kstep; const char* b2 = last ? nB : cB + (size_t)(t + 2) * kstep;
            const char* a3 = a2 + kstep; const char* b3 = b2 + kstep;
            if (last && has_next) S.a_ready(nxt);
            if constexpr (SP2) {
            PG8_LDB(B0, 0, 0); PG8_LDB(B1, 0, 1); PG8_SCHED; PG8_LDA(At, 0, 0); PG8_STAGE_A(PG8_SA(1, 1), a1, 1);
            if constexpr (GATHER) { unsigned rx = raw.x, ry = raw.y; asm volatile("" : "+v"(rx), "+v"(ry));
                const unsigned n0 = ((rx & 0xffffu) << 11) + cb0, n1 = ((rx >> 16) << 11) + cb0, n2 = ((ry & 0xffffu) << 11) + cb0, n3 = ((ry >> 16) << 11) + cb0;
                cuo[0] = last ? n0 : cuo[0]; cuo[1] = last ? n1 : cuo[1]; cuo[2] = last ? n2 : cuo[2]; cuo[3] = last ? n3 : cuo[3]; }
            PG8_WAIT_V(8); PG8_WAIT_L(0); PG8_BAR; PG8_MMA(0, 0, At, B0); PG8_MMA(0, 1, At, B1); PG8_BAR; PG8_SCHED;
            PG8_LDA(At, 0, 1); PG8_STAGE(PG8_SB(0, 0), b2, voffB); PG8_STAGE(PG8_SB(0, 1), b2 + hstep, voffB); PG8_STAGE_A(PG8_SA(0, 0), a2, 0);
            PG8_WAIT_V(8); PG8_WAIT_L(0); PG8_BAR; PG8_MMA(1, 0, At, B0); PG8_MMA(1, 1, At, B1); PG8_BAR; PG8_SCHED;
            PG8_LDB(B0, 1, 0); PG8_LDB(B1, 1, 1); PG8_SCHED; PG8_LDA(At, 1, 0); PG8_STAGE_A(PG8_SA(0, 1), a2, 1);
            PG8_WAIT_V(8); PG8_WAIT_L(0); PG8_BAR; PG8_MMA(0, 0, At, B0); PG8_MMA(0, 1, At, B1); PG8_BAR; PG8_SCHED;
            PG8_LDA(At, 1, 1); PG8_STAGE(PG8_SB(1, 0), b3, voffB); PG8_STAGE(PG8_SB(1, 1), b3 + hstep, voffB); PG8_STAGE_A(PG8_SA(1, 0), a3, 0);
            PG8_WAIT_V(8); PG8_WAIT_L(0); PG8_BAR; PG8_MMA(1, 0, At, B0); PG8_MMA(1, 1, At, B1); PG8_BAR; PG8_SCHED;
            } else {
            PG8_LDB(B0, 0, 0); PG8_SCHED; PG8_LDA(At, 0, 0); PG8_STAGE(PG8_SA(1, 1), a1 + hstep, voffA);
            PG8_WAIT_L(8); PG8_BAR; PG8_WAIT_L(0); PG8_MMA(0, 0, At, B0); PG8_BAR; PG8_SCHED;
            PG8_LDB(B1, 0, 1); PG8_STAGE(PG8_SB(0, 0), b2, voffB);
            PG8_BAR; PG8_WAIT_L(0); PG8_MMA(0, 1, At, B1); PG8_BAR;
            PG8_LDA(At, 0, 1); PG8_STAGE(PG8_SA(0, 0), a2, voffA);
            PG8_BAR; PG8_WAIT_L(0); PG8_MMA(1, 0, At, B0); PG8_BAR; PG8_SCHED;
            PG8_STAGE(PG8_SB(0, 1), b2 + hstep, voffB);
            PG8_WAIT_V(6); PG8_BAR; PG8_MMA(1, 1, At, B1); PG8_BAR;
            PG8_LDB(B0, 1, 0); PG8_SCHED; PG8_LDA(At, 1, 0); PG8_STAGE(PG8_SA(0, 1), a2 + hstep, voffA);
            PG8_WAIT_L(8); PG8_BAR; PG8_WAIT_L(0); PG8_MMA(0, 0, At, B0); PG8_BAR; PG8_SCHED;
            PG8_LDB(B1, 1, 1); PG8_STAGE(PG8_SB(1, 0), b3, voffB);
            PG8_BAR; PG8_WAIT_L(0); PG8_MMA(0, 1, At, B1); PG8_BAR;
            PG8_LDA(At, 1, 1); PG8_STAGE(PG8_SA(1, 0), a3, voffA);
            PG8_BAR; PG8_WAIT_L(0); PG8_MMA(1, 0, At, B0); PG8_BAR; PG8_SCHED;
            PG8_STAGE(PG8_SB(1, 1), b3 + hstep, voffB);
            PG8_WAIT_V(6); PG8_BAR; PG8_MMA(1, 1, At, B1); PG8_BAR;
            }
        }
        if constexpr (ALIGN_EPI) { if (wr == 0) PG8_BAR; }
        if constexpr (GATHER) { static_assert(SP2 && !Epi::AFTER_DRAIN, "GATHER is written for the SP2 loop"); int R0, C0; stage_rc(tid * 16, R0, C0); Unit u2; const bool h2 = S.next(ui + 2, u2);
            unsigned ro = (unsigned)R0 * 8u; asm volatile("" : "+v"(ro)); raw = *(const v2u_t*)((const char*)S.rowtab + (size_t)(h2 ? u2.pm : cur.pm) * 512 + ro); PG8_SCHED; }
        if constexpr (!Epi::AFTER_DRAIN) { E(acc, cur, wr, wc, fr, fq); S.done(cur); }
        if (!has_next) break;
#pragma unroll
        for (int a = 0; a < 2; ++a)
#pragma unroll
            for (int b = 0; b < 2; ++b)
#pragma unroll
                for (int m = 0; m < 4; ++m)
#pragma unroll
                    for (int n = 0; n < 2; ++n) acc[a][b][m][n] = (f32x4){0.f, 0.f, 0.f, 0.f};
        cur = nxt; cA = nA; cB = nB; ++ui;
        if constexpr (ALIGN_EPI) { if (wr == 1) PG8_BAR; }
    }
    PG8_WAIT_V(0);
    if constexpr (!ALIGN_EPI) { if (wr == 0) PG8_BAR; }
    PG8_BAR;
    if constexpr (Epi::AFTER_DRAIN) { E.fused(acc, cur, wr, wc, fr, fq, lds, wid, lane); S.done(cur); }
#undef PG8_SA
#undef PG8_SB
#undef PG8_STAGE
#undef PG8_STAGE_A
#undef PG8_LDA
#undef PG8_LDB
#undef PG8_MMA
#undef PG8_WAIT_V
#undef PG8_WAIT_L
#undef PG8_BAR
#undef PG8_SCHED
}
}

#define GAS __attribute__((address_space(1)))
#define LAS __attribute__((address_space(3)))
typedef unsigned short bf16;
typedef unsigned v4u __attribute__((ext_vector_type(4)));
typedef unsigned v2u __attribute__((ext_vector_type(2)));
typedef float f32x4 __attribute__((ext_vector_type(4)));
typedef short bf16x8 __attribute__((ext_vector_type(8)));

constexpr int NB = 8, SEQ = 4096, DM = 2048, T = NB * SEQ;
constexpr int NPT = 23;
constexpr int NE = 32, DFF = 2048;
constexpr int MAXTILES = 544;
constexpr float RMS_EPS = 1e-5f;
constexpr int NVB = 256, TPV = T / NVB;

enum { I_X = 0, I_NMIX, I_WIN, I_WA2, I_BA, I_GLAG, I_PEK, I_WK1, I_WK2, I_PEV, I_WV1, I_WV2, I_NSAG, I_RELB, I_WOUT, I_NFFN, I_RW, I_RB, I_W1, I_B1, I_W2, I_B2, I_NFIN, N_IN };

constexpr size_t MiB = 1u << 20;
constexpr size_t al(size_t x) { return (x + 255) & ~(size_t)255; }
constexpr size_t WS_CTL = 0, CTL_BYTES = 1 * MiB;
constexpr size_t WS_CNT = WS_CTL + CTL_BYTES;
constexpr size_t WS_META = WS_CNT + al(NVB * 32 * 4);
constexpr size_t WS_EIDX = WS_META + al((64 + MAXTILES) * 4);
constexpr size_t WS_LRNK = WS_EIDX + al((size_t)T * 4 * 4);
constexpr size_t WS_GATE = WS_LRNK + al((size_t)T * 4 * 4);
constexpr size_t WS_POS = WS_GATE + al((size_t)T * 4 * 4);
constexpr size_t WS_ROWW = WS_POS + al((size_t)T * 4 * 4);
constexpr size_t WS_WINT = al(WS_ROWW + (size_t)MAXTILES * 256 * 4);
constexpr size_t WS_WOT = WS_WINT + (size_t)NPT * 256 * DM * 2;
constexpr size_t WS_WKCT = WS_WOT + (size_t)DM * DM * 2;
constexpr size_t WS_WVCT = WS_WKCT + (size_t)256 * 2048 * 2;
constexpr size_t WS_W1T = WS_WVCT + (size_t)256 * 2048 * 2;
constexpr size_t WS_W2T = WS_W1T + (size_t)NE * 4096 * DM * 2;
constexpr size_t WS_XN = WS_W2T + (size_t)NE * DM * DFF * 2;
constexpr size_t WS_GQ = WS_XN + (size_t)T * DM * 2;
constexpr size_t WS_GK = WS_GQ + (size_t)T * 512 * 2;
constexpr size_t WS_GV = WS_GK + (size_t)T * 512 * 2;
constexpr size_t WS_GG = WS_GV + (size_t)T * 1024 * 2;
constexpr size_t WS_NQ = WS_GG + (size_t)T * 1024 * 2;
constexpr size_t WS_KC = WS_NQ + (size_t)T * 1024 * 2;
constexpr size_t WS_VC = WS_KC + (size_t)T * 256 * 2;
constexpr size_t WS_KS = WS_VC + (size_t)T * 256 * 2;
constexpr size_t WS_KW = WS_KS + (size_t)T * 256 * 2;
constexpr size_t WS_VST = WS_KW + (size_t)T * 256 * 2;
constexpr size_t WS_VWT = WS_VST + (size_t)T * 256 * 2;
constexpr size_t WS_SM = WS_VWT + (size_t)T * 256 * 2;
constexpr size_t WS_LA = WS_SM + (size_t)T * 64 * 2;
constexpr size_t WS_OG = WS_LA + (size_t)T * 512 * 4;
constexpr size_t WS_ON = WS_OG + (size_t)T * 1024 * 4;
constexpr size_t WS_KCMP = WS_ON + (size_t)T * 1024 * 4;
constexpr size_t WS_VCMPT = WS_KCMP + (size_t)16 * 256 * 128 * 2;
constexpr size_t WS_A2 = WS_VCMPT + (size_t)16 * 256 * 128 * 2;
constexpr size_t WS_HN = WS_A2 + (size_t)T * DM * 2;
constexpr size_t WS_XG = WS_HN + (size_t)T * DM * 2;
constexpr size_t WS_ACT = WS_XG + (size_t)MAXTILES * 256 * DM * 2;
constexpr size_t WS_END = WS_ACT + (size_t)MAXTILES * 256 * DFF * 2;

typedef unsigned short u16x2 __attribute__((ext_vector_type(2)));
__device__ __forceinline__ unsigned cvt2bf(float lo, float hi) { unsigned r; asm("v_cvt_pk_bf16_f32 %0, %1, %2" : "=v"(r) : "v"(lo), "v"(hi)); return r; }
__device__ __forceinline__ unsigned f2bf(float f) { return cvt2bf(f, f) & 0xffffu; }
__device__ __forceinline__ unsigned pk2(float lo, float hi) { return cvt2bf(lo, hi); }
__device__ __forceinline__ float bf2f(unsigned short v) { return __builtin_bit_cast(float, (unsigned)v << 16); }
__device__ __forceinline__ float bflo(unsigned w) { return __builtin_bit_cast(float, w << 16); }
__device__ __forceinline__ float bfhi(unsigned w) { return __builtin_bit_cast(float, w & 0xffff0000u); }
__device__ __forceinline__ float wave_sum(float v) {
#pragma unroll
    for (int o = 1; o < 64; o <<= 1) v += __shfl_xor(v, o);
    return v;
}
__device__ __forceinline__ float wave_max(float v) {
#pragma unroll
    for (int o = 1; o < 64; o <<= 1) v = fmaxf(v, __shfl_xor(v, o));
    return v;
}
#define LDS_WAIT() asm volatile("s_waitcnt lgkmcnt(0)" ::: "memory")

__device__ const unsigned char kBucket[128] = {0, 1, 2, 3, 4, 5, 6, 7, 8, 9, 10, 11, 12, 13, 14, 15, 16, 16, 16, 17, 17, 18, 18, 18, 19, 19, 19, 20, 20, 20, 20, 21, 21, 21, 21, 22, 22, 22, 22, 22, 23, 23, 23, 23, 23, 23, 24, 24, 24, 24, 24, 24, 25, 25, 25, 25, 25, 25, 25, 26, 26, 26, 26, 26, 26, 26, 26, 27, 27, 27, 27, 27, 27, 27, 27, 27, 27, 28, 28, 28, 28, 28, 28, 28, 28, 28, 28, 29, 29, 29, 29, 29, 29, 29, 29, 29, 29, 29, 29, 30, 30, 30, 30, 30, 30, 30, 30, 30, 30, 30, 30, 30, 30, 31, 31, 31, 31, 31, 31, 31, 31, 31, 31, 31, 31, 31, 31, 31};

struct Params {
    const float* in[N_IN];
    float* out;
    unsigned char* ws;
};

template <class F>
__device__ __forceinline__ void transpose_item(const float* W, int ldw, int k0, int n0, int nlim, LAS float* scr, int lane, F dst) {
#pragma unroll 8
    for (int i = 0; i < 32; ++i) { const int kk = 2 * i + (lane >> 5); const int n = n0 + (lane & 31); scr[kk * 33 + (lane & 31)] = n < nlim ? W[(size_t)(k0 + kk) * ldw + n] : 0.f; }
    LDS_WAIT(); asm volatile("" ::: "memory");
    const int c = lane & 7;
#pragma unroll
    for (int j = 0; j < 4; ++j) { const int nn = (lane >> 3) + 8 * j; const int n = n0 + nn; const LAS float* s = scr + (8 * c) * 33 + nn;
        bf16* rowp; float sc;
        if (n < nlim && dst(n, rowp, sc)) {
            v4u o; o.x = pk2(s[0 * 33] * sc, s[1 * 33] * sc); o.y = pk2(s[2 * 33] * sc, s[3 * 33] * sc); o.z = pk2(s[4 * 33] * sc, s[5 * 33] * sc); o.w = pk2(s[6 * 33] * sc, s[7 * 33] * sc);
            *(v4u*)(rowp + 8 * c) = o; } }
    LDS_WAIT(); asm volatile("" ::: "memory");
}
__device__ __forceinline__ int win_row(int n, float& sc) {
    sc = 1.f;
    if (n < 512) { sc = 0.08838834764831845f; return n; }
    if (n < 1024) return n;
    if (n < 2048) return n;
    if (n < 3072) return n;
    if (n < 3088) return 5120 + (n - 3072);
    if (n < 4112) { sc = 0.08838834764831845f; return 3072 + (n - 3088); }
    if (n < 4368) return 4096 + (n - 4112);
    if (n < 4624) return 4352 + (n - 4368);
    if (n < 4880) return 4608 + (n - 4624);
    if (n < 5136) return 5376 + (n - 4880);
    if (n < 5392) return 4864 + (n - 5136);
    if (n < 5648) return 5632 + (n - 5392);
    return 5136 + (n - 5648);
}
constexpr size_t WS_PEVP = WS_W2T;
__device__ __forceinline__ void p0_prologue(const Params& p, LAS unsigned char* lds, int gw, int NGW, int wave, int lane) {
    LAS float* scr = (LAS float*)(lds + wave * 16384);
    bf16* WinT = (bf16*)(p.ws + WS_WINT); bf16* WoT = (bf16*)(p.ws + WS_WOT); bf16* WkcT = (bf16*)(p.ws + WS_WKCT); bf16* WvcT = (bf16*)(p.ws + WS_WVCT);
    bf16* W1T = (bf16*)(p.ws + WS_W1T); bf16* W2T = (bf16*)(p.ws + WS_W2T);
    constexpr int I_IN = 32 * 178, I_O = 32 * 64, I_C = 64 * 4, I_E1 = 32 * 128, I_E2 = 32 * 64;
    constexpr int I_PE = 2 * 64;
    constexpr int NITEMS = I_O + 2 * I_C + I_PE;
    (void)I_IN; (void)WinT;
    for (int it = gw; it < NITEMS; it += NGW) {
        int r = it;
        if (r < I_O) { const int kb = r / 64, nb = r % 64, k0 = kb * 64;
            transpose_item(p.in[I_WOUT], DM, k0, nb * 32, DM, scr, lane, [&](int n, bf16*& rowp, float& sc) { sc = 1.f; rowp = WoT + (size_t)n * DM + k0; return true; }); continue; } r -= I_O;
        if (r >= 2 * I_C) { r -= 2 * I_C; const int which = r >> 6, kq = r & 63; const float* pe = p.in[which ? I_PEV : I_PEK] + kq * 64; const float* w1 = p.in[which ? I_WV1 : I_WK1] + (size_t)kq * 64 * 128 + lane;
            float a0 = 0.f, a1 = 0.f;
#pragma unroll
            for (int k = 0; k < 64; ++k) { const float pv = pe[k]; a0 += pv * w1[k * 128]; a1 += pv * w1[k * 128 + 64]; }
            float* dst = (float*)(p.ws + WS_PEVP) + (size_t)(which * 64 + kq) * 128 + lane; dst[0] = a0; dst[64] = a1; continue; }
        { const int which = r / I_C; r %= I_C; const int kb = r / 4, nb = r % 4, k0 = kb * 64;
            bf16* dstm = which ? WvcT : WkcT;
            transpose_item(p.in[which ? I_WV1 : I_WK1], 128, k0, nb * 32, 128, scr, lane, [&](int n, bf16*& rowp, float& sc) { sc = 1.f; rowp = dstm + (size_t)(n + (k0 >= 2048 ? 128 : 0)) * 2048 + (k0 & 2047); return true; }); }
        (void)I_E1; (void)I_E2; (void)W1T; (void)W2T;
    }
    const float* x = p.in[I_X]; const float* gm = p.in[I_NMIX];
    for (int m = gw; m < T; m += NGW) {
        const f32x4* xr = (const f32x4*)(x + (size_t)m * DM) + lane; f32x4 v[8]; float s = 0.f;
#pragma unroll
        for (int j = 0; j < 8; ++j) { v[j] = xr[64 * j]; s += (v[j].x * v[j].x + v[j].y * v[j].y) + (v[j].z * v[j].z + v[j].w * v[j].w); }
        const float rstd = 1.f / sqrtf(wave_sum(s) * (1.f / DM) + RMS_EPS);
        float mxr = 0.f;
#pragma unroll
        for (int j = 0; j < 8; ++j) { const f32x4 g4 = ((const f32x4*)gm)[lane + 64 * j]; v[j].x *= rstd * g4.x; v[j].y *= rstd * g4.y; v[j].z *= rstd * g4.z; v[j].w *= rstd * g4.w;
            mxr = fmaxf(mxr, fmaxf(fmaxf(fabsf(v[j].x), fabsf(v[j].y)), fmaxf(fabsf(v[j].z), fabsf(v[j].w)))); }
        mxr = wave_max(mxr); const float qs = mxr > 0.f ? mxr * (1.f / 127.f) : 1.f, qi = 1.f / qs;
        unsigned* o4 = (unsigned*)(p.ws + WS_XN + (size_t)m * DM) + lane;
#pragma unroll
        for (int j = 0; j < 8; ++j) { const float M = 12582912.f;
            const unsigned ua = __builtin_bit_cast(unsigned, v[j].x * qi + M), ub = __builtin_bit_cast(unsigned, v[j].y * qi + M), uc = __builtin_bit_cast(unsigned, v[j].z * qi + M), ud = __builtin_bit_cast(unsigned, v[j].w * qi + M);
            o4[64 * j] = __builtin_amdgcn_perm(ub, ua, 0x0c0c0400u) | (__builtin_amdgcn_perm(ud, uc, 0x0c0c0400u) << 16); }
        if (lane == 0) ((float*)(p.ws + WS_XN + (size_t)T * DM))[m] = qs;
    }
}
#define XB_TMO      128
#define XB_XCNT(j)  (256  + 64 * (j))
#define XB_XSUB(j)  (1280 + 64 * (j))
#define XB_XGEN(j)  (2304 + 64 * (j))
#define XB_TOP      3328
#define XB_TOPGEN   3392
#define XCD_BAR_WORDS 3456
#define XB_SPIN_CAP (1u << 18)

__device__ __forceinline__ unsigned xb_ld(unsigned* p)              { return __hip_atomic_load(p, __ATOMIC_RELAXED, __HIP_MEMORY_SCOPE_AGENT); }
__device__ __forceinline__ unsigned xb_add(unsigned* p, unsigned v) { return __hip_atomic_fetch_add(p, v, __ATOMIC_RELAXED, __HIP_MEMORY_SCOPE_AGENT); }
__device__ __forceinline__ unsigned xb_xcc_id() { return (unsigned)__builtin_amdgcn_s_getreg((3 << 11) | 20) & 0xFu; }
#define XB_SPIN(cond, bar) do { unsigned _sp = 0; while (cond) { __builtin_amdgcn_s_sleep(1); \
    if ((++_sp & 255u) == 0u) { if (xb_ld(&(bar)[XB_TMO])) break; if (_sp > XB_SPIN_CAP) { atomicAdd(&(bar)[XB_TMO], 1u); break; } } } } while (0)

struct XcdBarrier {
    unsigned* bar; unsigned x;
    volatile LAS unsigned* st;
};

__device__ __forceinline__ XcdBarrier xcd_barrier_post(unsigned* bar, volatile LAS unsigned* st) {
    XcdBarrier b; b.bar = bar; b.x = xb_xcc_id(); b.st = st;
    if (threadIdx.x == 0) (void)xb_add(&bar[XB_XCNT(b.x)], 1u);
    return b;
}
__device__ __forceinline__ void xcd_barrier_complete(unsigned* bar, unsigned x, unsigned& nloc, unsigned& nx) {
    const unsigned G = gridDim.x * gridDim.y * gridDim.z;
    unsigned sum, cnt, mine, sp = 0u;
    for (;;) {
        sum = 0u; cnt = 0u; mine = 0u;
#pragma unroll
        for (unsigned j = 0; j < 16; ++j) { const unsigned c = xb_ld(&bar[XB_XCNT(j)]); sum += c; cnt += (c > 0u) ? 1u : 0u; mine = (j == x) ? c : mine; }
        if (sum == G) break;
        __builtin_amdgcn_s_sleep(1);
        if ((++sp & 255u) == 0u) { if (xb_ld(&bar[XB_TMO])) break; if (sp > XB_SPIN_CAP) { atomicAdd(&bar[XB_TMO], 1u); break; } }
    }
    nloc = mine > 0u ? mine : 1u; nx = cnt > 0u ? cnt : 1u;
}

__device__ __forceinline__ void xcd_barrier(const XcdBarrier& b) {
    asm volatile("s_waitcnt vmcnt(0)" ::: "memory");
    __syncthreads();
    if (threadIdx.x == 0) {
        unsigned* bar = b.bar;
        __builtin_amdgcn_s_waitcnt(0);
        unsigned nloc = b.st[0], nx = b.st[1];
        if (nloc == 0u) { xcd_barrier_complete(bar, b.x, nloc, nx); b.st[0] = nloc; b.st[1] = nx; }
        const unsigned old = xb_add(&bar[XB_XSUB(b.x)], 1u);
        const unsigned gen = old / nloc;
        if (old + 1u == (gen + 1u) * nloc) {
            __builtin_amdgcn_fence(__ATOMIC_RELEASE, "agent");
            asm volatile("s_waitcnt vmcnt(0)" ::: "memory");
            const unsigned og = xb_add(&bar[XB_TOP], 1u);
            const unsigned tg = og / nx;
            if (og + 1u == (tg + 1u) * nx) xb_add(&bar[XB_TOPGEN], 1u);
            else XB_SPIN(xb_ld(&bar[XB_TOPGEN]) == tg, bar);
            __builtin_amdgcn_fence(__ATOMIC_ACQUIRE, "agent");
            xb_add(&bar[XB_XGEN(b.x)], 1u);
            asm volatile("s_waitcnt vmcnt(0)" ::: "memory");
        } else {
            XB_SPIN(xb_ld(&bar[XB_XGEN(b.x)]) == gen, bar);
            __builtin_amdgcn_fence(__ATOMIC_ACQUIRE, "agent");
            asm volatile("s_waitcnt vmcnt(0)" ::: "memory");
        }
    }
    __syncthreads();
}

struct ProjOrder : pg8::StaticOrder {
    const bf16* xn; const bf16* wt;
    __device__ __forceinline__ bool next(int i, pg8::Unit& u) const { if (!pg8::StaticOrder::next(i, u)) return false; u.kind = (u.pn >= 21) ? 1 : 0; return true; }
    __device__ __forceinline__ const char* pa(const pg8::Gemm& g, const pg8::Unit& u) const { return u.kind ? (const char*)wt + (size_t)u.pn * ((size_t)256 * g.K * 2) : (const char*)xn + (size_t)u.pm * ((size_t)256 * g.K * 2); }
    __device__ __forceinline__ const char* pb(const pg8::Gemm& g, const pg8::Unit& u) const { return u.kind ? (const char*)xn + (size_t)u.pm * ((size_t)256 * g.K * 2) : (const char*)wt + (size_t)u.pn * ((size_t)256 * g.K * 2); }
};
struct EpiRes {
    static constexpr bool PERM = true, AFTER_DRAIN = false;
    const float* x; bf16* h;
    __device__ __forceinline__ void operator()(const pg8::f32x4 (&acc)[2][2][4][2], const pg8::Unit& u, int wr, int wc, int fr, int fq) const {
        const int row0 = u.pm * 256 + wr * 64 + fr, col0 = u.pn * 256 + wc * 32 + 8 * fq;
#pragma unroll
        for (int ai = 0; ai < 2; ++ai)
#pragma unroll
            for (int m = 0; m < 4; ++m) { const size_t off = (size_t)(row0 + ai * 128 + m * 16) * DM + col0;
#pragma unroll
                for (int bj = 0; bj < 2; ++bj) { const pg8::f32x4 x0 = *(const pg8::f32x4*)(x + off + bj * 128), x1 = *(const pg8::f32x4*)(x + off + bj * 128 + 4);
                    const pg8::f32x4 a0 = x0 + acc[ai][bj][m][0], a1 = x1 + acc[ai][bj][m][1]; pg8::u32x4 w;
                    w.x = pg8::cvt_pk_bf16(a0.x, a0.y); w.y = pg8::cvt_pk_bf16(a0.z, a0.w); w.z = pg8::cvt_pk_bf16(a1.x, a1.y); w.w = pg8::cvt_pk_bf16(a1.z, a1.w);
                    *(pg8::u32x4*)(h + off + bj * 128) = w; } }
    }
};
struct MoeOrder {
    int nM, nN, nwg, G, c; const int* tile_exp;
    __device__ __forceinline__ void init(const int* meta, int nN_, int G_, int c_) { nM = meta[0]; nN = nN_; nwg = nM * nN; G = G_; c = c_; tile_exp = meta + 64; }
    __device__ __forceinline__ bool next(int i, pg8::Unit& u) const {
        const long L = (long)i * G + c; if (L >= nwg) return false;
        pg8::tile_of<8>((int)L, nM, nN, u.pm, u.pn); u.kind = tile_exp[u.pm]; return true;
    }
    __device__ __forceinline__ const char* pa(const pg8::Gemm& g, const pg8::Unit& u) const { return (const char*)g.A + (size_t)u.pm * ((size_t)256 * g.K * 2); }
    __device__ __forceinline__ const char* pb(const pg8::Gemm& g, const pg8::Unit& u) const { return (const char*)g.Bt + ((size_t)u.kind * nN + u.pn) * ((size_t)256 * g.K * 2); }
    __device__ __forceinline__ void a_ready(const pg8::Unit&) const {}
    __device__ __forceinline__ void done(const pg8::Unit&) const {}
};

struct MoeOrderG : MoeOrder { const unsigned short* rowtab;
    __device__ __forceinline__ const char* pa(const pg8::Gemm& g, const pg8::Unit&) const { return (const char*)g.A; } };

__device__ __forceinline__ float gelu_tanh(float x) { const float u = 0.7978845608028654f * (x + 0.044715f * x * x * x); const float e = __expf(2.f * u); return 0.5f * x * (1.f + (1.f - 2.f / (e + 1.f))); }
__device__ __forceinline__ void ph_cmp_fin_simple(const Params& p, LAS float* tl, int id, int n, const float* LHall, const float* PEVall) {
    LAS float* hid = tl + 4096;
    const int which = id / (16 * 255), rem = id % (16 * 255), bg = rem / 255, c = rem % 255;
    const float* w2 = p.in[which ? I_WV2 : I_WK2];
    const float* LH = LHall + ((size_t)which * 4096 + bg * 256) * 256;
    float pev = 0.f;
#pragma unroll 8
    for (int q = 0; q < 64; ++q) pev += PEVall[(size_t)(which * 64 + q) * 128 + n];
    const float a = LH[(size_t)c * 256 + n] + LH[(size_t)(c + 1) * 256 + 128 + n] + pev;
    hid[n] = gelu_tanh(a);
    __syncthreads();
    float o = 0.f;
    for (int m = 0; m < 128; ++m) o += hid[m] * w2[m * 128 + n];
    if (which == 0) ((bf16*)(p.ws + WS_KCMP))[((size_t)bg * 256 + c) * 128 + n] = (bf16)f2bf(o);
    else ((bf16*)(p.ws + WS_VCMPT))[((size_t)bg * 128 + n) * 256 + c] = (bf16)f2bf(o);
}

namespace nsa {
constexpr int KB0 = 0, KB1 = 16384, VB0 = 32768, VB1 = 49152, LUT = 65536;
constexpr int QST = LUT + 4096, IMP = QST + 65536, SELM = IMP + 16384, LDS_END = SELM + 512;
constexpr float LOG2E = 1.4426950408889634f;
typedef float f4 __attribute__((ext_vector_type(4)));

typedef unsigned u2v __attribute__((ext_vector_type(2)));
__device__ __forceinline__ float rmax16(float x) { const unsigned u = __float_as_uint(x); const u2v r = __builtin_amdgcn_permlane16_swap(u, u, false, false); return fmaxf(__uint_as_float(r[0]), __uint_as_float(r[1])); }
__device__ __forceinline__ float rmax32(float x) { const unsigned u = __float_as_uint(x); const u2v r = __builtin_amdgcn_permlane32_swap(u, u, false, false); return fmaxf(__uint_as_float(r[0]), __uint_as_float(r[1])); }
__device__ __forceinline__ float radd16(float x) { const unsigned u = __float_as_uint(x); const u2v r = __builtin_amdgcn_permlane16_swap(u, u, false, false); return __uint_as_float(r[0]) + __uint_as_float(r[1]); }
__device__ __forceinline__ float radd32(float x) { const unsigned u = __float_as_uint(x); const u2v r = __builtin_amdgcn_permlane32_swap(u, u, false, false); return __uint_as_float(r[0]) + __uint_as_float(r[1]); }
__device__ __forceinline__ float raddq(float x) { x += __int_as_float(__builtin_amdgcn_update_dpp(0, __float_as_int(x), 0xB1, 0xF, 0xF, true)); x += __int_as_float(__builtin_amdgcn_update_dpp(0, __float_as_int(x), 0x4E, 0xF, 0xF, true)); return x; }
struct Ctx {
    LAS unsigned char* lds; int tid, lane, wave, c, gq, r;
    int s0, cur;
    const LAS unsigned char* qst;
    int pos0;
    const LAS float* lutrow;
    int koff0, voff0;
    unsigned kdo[2], vdoc[2], vdos[2];
};
__device__ __forceinline__ void dma_k(const Ctx& C, const bf16* kt, LAS unsigned char* kb) {
#pragma unroll
    for (int i = 0; i < 2; ++i) __builtin_amdgcn_global_load_lds((const unsigned*)((const char*)kt + C.kdo[i]), (LAS unsigned*)(kb + (2 * C.wave + i) * 1024), 16, 0, 0); }
__device__ __forceinline__ void dma_v(const Ctx& C, const bf16* vt, const unsigned (&vdo)[2], LAS unsigned char* vb) {
#pragma unroll
    for (int i = 0; i < 2; ++i) __builtin_amdgcn_global_load_lds((const unsigned*)((const char*)vt + vdo[i]), (LAS unsigned*)(vb + (2 * C.wave + i) * 1024), 16, 0, 0); }

__device__ __forceinline__ void compute_st(const Ctx& C, const LAS unsigned char* kb, f4 (&s)[2][4]) {
#pragma unroll
    for (int ks = 0; ks < 4; ++ks) { const bf16x8 q0 = *(const LAS bf16x8*)(C.qst + ks * 1024), q1 = *(const LAS bf16x8*)(C.qst + (4 + ks) * 1024);
#pragma unroll
        for (int kt = 0; kt < 4; ++kt) { const bf16x8 a = *(const LAS bf16x8*)(kb + kt * 4096 + (C.koff0 ^ (ks * 64)));
            s[0][kt] = __builtin_amdgcn_mfma_f32_16x16x32_bf16(a, q0, ks == 0 ? (f4){0.f, 0.f, 0.f, 0.f} : s[0][kt], 0, 0, 0);
            s[1][kt] = __builtin_amdgcn_mfma_f32_16x16x32_bf16(a, q1, ks == 0 ? (f4){0.f, 0.f, 0.f, 0.f} : s[1][kt], 0, 0, 0); }
        asm volatile("" ::: "memory"); }
}
__device__ __forceinline__ void compute_pv(const Ctx& C, const LAS unsigned char* vb, const f4 (&p)[2][4], f4 (&o)[2][8]) {
#pragma unroll
    for (int i = 0; i < 2; ++i) { bf16x8 pb[2];
#pragma unroll
        for (int qt = 0; qt < 2; ++qt) { v4u w; w.x = pg8::cvt_pk_bf16(p[qt][2 * i][0], p[qt][2 * i][1]); w.y = pg8::cvt_pk_bf16(p[qt][2 * i][2], p[qt][2 * i][3]);
            w.z = pg8::cvt_pk_bf16(p[qt][2 * i + 1][0], p[qt][2 * i + 1][1]); w.w = pg8::cvt_pk_bf16(p[qt][2 * i + 1][2], p[qt][2 * i + 1][3]); pb[qt] = __builtin_bit_cast(bf16x8, w); }
#pragma unroll
        for (int dt = 0; dt < 8; ++dt) { const v2u lo = *(const LAS v2u*)(vb + dt * 2048 + (C.voff0 ^ (i * 64))), hi = *(const LAS v2u*)(vb + dt * 2048 + (C.voff0 ^ (i * 64 + 32))); const bf16x8 a = __builtin_bit_cast(bf16x8, (v4u){lo.x, lo.y, hi.x, hi.y});
#pragma unroll
            for (int qt = 0; qt < 2; ++qt) o[qt][dt] = __builtin_amdgcn_mfma_f32_16x16x32_bf16(a, pb[qt], o[qt][dt], 0, 0, 0);
            if (dt & 1) asm volatile("" ::: "memory"); } }
}
enum { M_CMP = 0, M_SEL = 1, M_WIN = 2 };
template <int MODE, bool FAR = false>
__device__ __forceinline__ void mask_bias(const Ctx& C, f4 (&s)[2][4], int kb, int n, const LAS unsigned* selw) {
    const float NEG = -__builtin_inff();
#pragma unroll
    for (int qt = 0; qt < 2; ++qt) {
        bool tokok = true;
        if (MODE == M_SEL) tokok = ((selw[(4 * qt + (C.c >> 2)) * 2 + (n >> 5)] >> (n & 31)) & 1u) != 0u;
        if (FAR) { const float be = tokok ? C.lutrow[127] : NEG;
#pragma unroll
            for (int kt = 0; kt < 4; ++kt)
#pragma unroll
                for (int rg = 0; rg < 4; ++rg) s[qt][kt][rg] = __builtin_fmaf(s[qt][kt][rg], LOG2E, be);
            continue; }
        const int dbase = (MODE == M_CMP) ? (C.pos0 + 4 * qt - 31 - 16 * (kb + 4 * C.gq)) : (C.pos0 + 4 * qt - (kb + 4 * C.gq));
#pragma unroll
        for (int kt = 0; kt < 4; ++kt) {
#pragma unroll
            for (int rg = 0; rg < 4; ++rg) { const int d = (MODE == M_CMP) ? dbase - 16 * (16 * kt + rg) : dbase - (16 * kt + rg);
                int di = d < 0 ? 0 : d; di = di > 127 ? 127 : di; const float bias = C.lutrow[di];
                bool ok = tokok && d >= 0; if (MODE == M_WIN) ok = ok && d < 512;
                s[qt][kt][rg] = ok ? __builtin_fmaf(s[qt][kt][rg], LOG2E, bias) : NEG; }
            asm volatile("" ::: "memory"); }
    }
}
__device__ __forceinline__ void softmax_step(f4 (&s)[2][4], float (&m)[2], float (&l)[2], f4 (&o)[2][8], bool rescale_o) {
#pragma unroll
    for (int qt = 0; qt < 2; ++qt) { float mx = s[qt][0][0];
#pragma unroll
        for (int kt = 0; kt < 4; ++kt)
#pragma unroll
            for (int rg = 0; rg < 4; ++rg) mx = fmaxf(mx, s[qt][kt][rg]);
        mx = rmax32(rmax16(mx));
        const float mn = fmaxf(m[qt], mx), alpha = __builtin_amdgcn_exp2f(m[qt] - mn); m[qt] = mn; float ps = 0.f;
#pragma unroll
        for (int kt = 0; kt < 4; ++kt)
#pragma unroll
            for (int rg = 0; rg < 4; ++rg) { const float e = __builtin_amdgcn_exp2f(s[qt][kt][rg] - mn); s[qt][kt][rg] = e; ps += e; }
        l[qt] = l[qt] * alpha + ps;
        if (rescale_o && __any(alpha != 1.f)) {
#pragma unroll
            for (int dt = 0; dt < 8; ++dt) o[qt][dt] = o[qt][dt] * alpha; }
    }
}
template <int MODE>
__device__ __forceinline__ void softmax_far(const Ctx& C, f4 (&s)[2][4], int n, const LAS unsigned* selw, float (&m)[2], float (&l)[2], f4 (&o)[2][8]) {
    const float b31 = C.lutrow[127];
#pragma unroll
    for (int qt = 0; qt < 2; ++qt) {
        float be = b31;
        if (MODE == M_SEL) { const bool tokok = ((selw[(4 * qt + (C.c >> 2)) * 2 + (n >> 5)] >> (n & 31)) & 1u) != 0u; be = tokok ? b31 : -__builtin_inff(); }
        float mx = fmaxf(fmaxf(s[qt][0][0], s[qt][0][1]), fmaxf(s[qt][0][2], s[qt][0][3]));
#pragma unroll
        for (int kt = 1; kt < 4; ++kt) mx = fmaxf(mx, fmaxf(fmaxf(s[qt][kt][0], s[qt][kt][1]), fmaxf(s[qt][kt][2], s[qt][kt][3])));
        mx = rmax32(rmax16(mx));
        const float mt = __builtin_fmaf(mx, LOG2E, be), mn = fmaxf(m[qt], mt), alpha = __builtin_amdgcn_exp2f(m[qt] - mn), c0 = be - mn; m[qt] = mn; float ps = 0.f;
#pragma unroll
        for (int kt = 0; kt < 4; ++kt)
#pragma unroll
            for (int rg = 0; rg < 4; ++rg) { const float e = __builtin_amdgcn_exp2f(__builtin_fmaf(s[qt][kt][rg], LOG2E, c0)); s[qt][kt][rg] = e; ps += e; }
        l[qt] = l[qt] * alpha + ps;
        if (__any(alpha != 1.f)) {
#pragma unroll
            for (int dt = 0; dt < 8; ++dt) o[qt][dt] = o[qt][dt] * alpha; }
    }
}
}

__device__ __forceinline__ void ph_nsa(const Params& p, LAS unsigned char* lds, int idx0, int idxstride, int tid_in, int wave) {
    using namespace nsa;
    int tid = tid_in; asm volatile("" : "+v"(tid));
    const int lane = tid & 63;
    Ctx C; C.lds = lds; C.tid = tid; C.lane = lane; C.wave = wave; C.c = lane & 15; C.gq = lane >> 4; C.r = lane & 3;
    C.koff0 = C.c * 256 + ((C.gq ^ C.c) * 16);
#pragma unroll
    for (int i = 0; i < 2; ++i) { const int piece = 2 * wave + i;
        { const int row = piece * 4 + (lane >> 4), chunk = (lane & 15) ^ (row & 15); C.kdo[i] = (unsigned)(row * 256 + chunk * 16); }
        { const int row = piece * 8 + (lane >> 3), chunk = (lane & 7) ^ ((row >> 1) & 7); C.vdoc[i] = (unsigned)(row * 256 * 2 + chunk * 16); C.vdos[i] = (unsigned)(row * SEQ * 2 + chunk * 16); } }
    C.voff0 = C.c * 128 + (((C.gq >> 1) ^ ((C.c >> 1) & 7)) * 16) + (C.gq & 1) * 8;
    const bf16* NQ = (const bf16*)(p.ws + WS_NQ); const bf16* SM = (const bf16*)(p.ws + WS_SM); bf16* A2 = (bf16*)(p.ws + WS_A2);
    const float* relb = p.in[I_RELB]; const float* nsag = p.in[I_NSAG];
    LAS float* lut = (LAS float*)(lds + LUT);
    for (int i = tid; i < 8 * 128; i += 512) { const int hh = i >> 7, d = i & 127; lut[i] = relb[(int)kBucket[d] * 8 + hh] * LOG2E; }
    __syncthreads();
    LAS unsigned char* qstw = lds + QST + wave * 8192 + lane * 16; C.qst = qstw;
    LAS float* imp = (LAS float*)(lds + IMP + wave * 2048);
    LAS unsigned long long* selm = (LAS unsigned long long*)(lds + SELM + wave * 64);
#define NSA_SYNC() do { asm volatile("s_waitcnt vmcnt(0)" ::: "memory"); __syncthreads(); } while (0)
    for (int idx = idx0; idx < 512; idx += idxstride) {
        const int rnd = idx >> 8, kq = idx & 255, b = kq & 7, tq = rnd == 0 ? 63 - (kq >> 3) : (kq >> 3);
        C.s0 = tq * 64; C.cur = tq;
        const int tokl0 = 8 * wave + (C.c >> 2);
        C.pos0 = C.s0 + tokl0;
        float ssq[2] = {0.f, 0.f};
        for (int g = 0; g < 2; ++g) {
            const int bg = b * 2 + g, h = g * 4 + C.r;
            C.lutrow = lut + h * 128;
            const bf16* KCMP = (const bf16*)(p.ws + WS_KCMP) + (size_t)bg * 256 * 128; const bf16* VCMPT = (const bf16*)(p.ws + WS_VCMPT) + (size_t)bg * 128 * 256;
#pragma unroll
            for (int qt = 0; qt < 2; ++qt) { const unsigned qo = (unsigned)(((b * SEQ + (C.pos0 + 4 * qt)) * 1024 + h * 128 + 8 * C.gq) * 2);
#pragma unroll
                for (int ks = 0; ks < 4; ++ks) *(LAS bf16x8*)(qstw + (qt * 4 + ks) * 1024) = *(const bf16x8*)((const char*)NQ + qo + ks * 64); }
#pragma unroll
            for (int i = 0; i < 2; ++i) *(LAS f32x4*)((LAS unsigned char*)imp + lane * 16 + i * 1024) = (f32x4){0.f, 0.f, 0.f, 0.f};
#define NSA_OROW(qt) ((char*)A2 + (unsigned)(((b * SEQ + C.pos0 + 4 * (qt)) * DM + 1024 + h * 128 + 4 * C.gq) * 2))
            const int cmaxb = C.s0 + 63 - 31; const int nct = cmaxb >= 0 ? ((cmaxb >> 4) >> 6) + 1 : 0;
            float m[2] = {-1e30f, -1e30f}, l[2] = {0.f, 0.f};
            f4 o[2][8];
            if (nct > 0) {
                dma_k(C, KCMP, lds + KB0); NSA_SYNC();
                for (int ct = 0; ct < nct; ++ct) { const int buf = ct & 1;
                    if (ct + 1 < nct) dma_k(C, KCMP + (ct + 1) * 64 * 128, lds + (buf ? KB0 : KB1));
                    f4 s[2][4]; compute_st(C, lds + (buf ? KB1 : KB0), s); mask_bias<M_CMP>(C, s, 64 * ct, 0, (const LAS unsigned*)selm); softmax_step(s, m, l, o, false);
                    NSA_SYNC(); }
            }
            float inv[2];
#pragma unroll
            for (int qt = 0; qt < 2; ++qt) { const float lt = radd32(radd16(l[qt])); inv[qt] = lt > 0.f ? 1.f / lt : 0.f; }
#pragma unroll
            for (int qt = 0; qt < 2; ++qt)
#pragma unroll
                for (int dt = 0; dt < 8; ++dt) o[qt][dt] = (f4){0.f, 0.f, 0.f, 0.f};
            if (nct > 0) {
                dma_k(C, KCMP, lds + KB0); dma_v(C, VCMPT, C.vdoc, lds + VB0); NSA_SYNC();
                for (int ct = 0; ct < nct; ++ct) { const int buf = ct & 1;
                    if (ct + 1 < nct) { dma_k(C, KCMP + (ct + 1) * 64 * 128, lds + (buf ? KB0 : KB1)); dma_v(C, VCMPT + 64 * (ct + 1), C.vdoc, lds + (buf ? VB0 : VB1)); }
                    f4 s[2][4]; compute_st(C, lds + (buf ? KB1 : KB0), s); mask_bias<M_CMP>(C, s, 64 * ct, 0, (const LAS unsigned*)selm);
#pragma unroll
                    for (int qt = 0; qt < 2; ++qt)
#pragma unroll
                        for (int kt = 0; kt < 4; ++kt) {
#pragma unroll
                            for (int rg = 0; rg < 4; ++rg) s[qt][kt][rg] = __builtin_amdgcn_exp2f(s[qt][kt][rg] - m[qt]) * inv[qt];
                            float po = (s[qt][kt][0] + s[qt][kt][1]) + (s[qt][kt][2] + s[qt][kt][3]), p3 = s[qt][kt][3];
                            po = raddq(po); p3 = raddq(p3);
                            const int nb = 16 * ct + 4 * kt + C.gq, tl = 4 * qt + (C.c >> 2);
                            if (C.r == 0) { __hip_atomic_fetch_add((float*)(imp + tl * 64 + nb), po, __ATOMIC_RELAXED, __HIP_MEMORY_SCOPE_WORKGROUP); if (nb + 1 < 64) __hip_atomic_fetch_add((float*)(imp + tl * 64 + nb + 1), p3, __ATOMIC_RELAXED, __HIP_MEMORY_SCOPE_WORKGROUP); } }
                    compute_pv(C, lds + (buf ? VB1 : VB0), s, o);
                    NSA_SYNC(); }
            }
            LDS_WAIT(); __builtin_amdgcn_wave_barrier();
            for (int tk = 0; tk < 8; ++tk) { const int n = lane; float sc;
                if (n == 0 || n == C.cur || n == C.cur - 1) sc = 1e4f; else if (n <= C.cur) sc = imp[tk * 64 + n]; else sc = -1.f;
                const int key = ((sc < 0.f ? 0 : __float_as_int(sc) + 64) & ~63) | (63 - n);
                int rank = 0;
#pragma unroll
                for (int mm = 0; mm < 64; ++mm) rank += (__builtin_amdgcn_readlane(key, mm) > key) ? 1 : 0;
                const unsigned long long mk = __ballot(rank < 16);
                if (lane == 0) selm[tk] = mk; }
            LDS_WAIT(); __builtin_amdgcn_wave_barrier();
#pragma unroll
            for (int qt = 0; qt < 2; ++qt) { const float gt = 1.f / (1.f + __expf(-bf2f(*(const bf16*)((const char*)SM + (unsigned)(((b * SEQ + (C.pos0 + 4 * qt)) * 64 + 16 + h) * 2)))));
#pragma unroll
                for (int dt = 0; dt < 8; ++dt) { const f4 v = o[qt][dt] * gt; *(v2u*)(NSA_OROW(qt) + 32 * dt) = (v2u){pg8::cvt_pk_bf16(v[0], v[1]), pg8::cvt_pk_bf16(v[2], v[3])}; } }
#pragma unroll
            for (int br = 1; br <= 2; ++br) {
                const bf16* KX = (const bf16*)(p.ws + (br == 1 ? WS_KS : WS_KW)) + bg * SEQ * 128; const bf16* VX = (const bf16*)(p.ws + (br == 1 ? WS_VST : WS_VWT)) + bg * 128 * SEQ;
                const int n0 = br == 1 ? 0 : (C.cur >= 8 ? C.cur - 8 : 0), n1 = C.cur;
                m[0] = m[1] = -1e30f; l[0] = l[1] = 0.f;
#pragma unroll
                for (int qt = 0; qt < 2; ++qt)
#pragma unroll
                    for (int dt = 0; dt < 8; ++dt) o[qt][dt] = (f4){0.f, 0.f, 0.f, 0.f};
                int f0 = n1 + 1, f1 = n0 - 1;
                for (int n = n0; n <= n1; ++n) { const bool fa = (C.s0 - (64 * n + 63) >= 113) && (br == 1 || (C.s0 + 63 - 64 * n) < 512); if (fa) { f0 = n < f0 ? n : f0; f1 = n; } }
                const int cntf = f1 >= f0 ? f1 - f0 + 1 : 0, cnt = n1 - n0 + 1, nlo = cntf ? f0 - n0 : cnt;
#define NSA_TILE(i) ((i) < cntf ? f0 + (i) : (((i) - cntf) < nlo ? n0 + ((i) - cntf) : f1 + 1 + ((i) - cntf - nlo)))
#define NSA_BODY(FARF) { const int n = NSA_TILE(i); const int buf = i & 1; \
                    if (i + 1 < cnt) { const int nn = NSA_TILE(i + 1); dma_k(C, KX + nn * 64 * 128, lds + (buf ? KB0 : KB1)); dma_v(C, VX + 64 * nn, C.vdos, lds + (buf ? VB0 : VB1)); } \
                    bool need = true; \
                    if (br == 1) { const unsigned any = ((const LAS unsigned*)selm)[(lane & 7) * 2 + (n >> 5)] >> (n & 31); need = __any((int)(any & 1u)); } \
                    if (need) { f4 s[2][4]; compute_st(C, lds + (buf ? KB1 : KB0), s); \
                        if (FARF) { if (br == 1) softmax_far<M_SEL>(C, s, n, (const LAS unsigned*)selm, m, l, o); else softmax_far<M_WIN>(C, s, n, (const LAS unsigned*)selm, m, l, o); } \
                        else { if (br == 1) mask_bias<M_SEL, false>(C, s, 64 * n, n, (const LAS unsigned*)selm); else mask_bias<M_WIN, false>(C, s, 64 * n, n, (const LAS unsigned*)selm); \
                            softmax_step(s, m, l, o, true); } \
                        compute_pv(C, lds + (buf ? VB1 : VB0), s, o); } \
                    NSA_SYNC(); }
                { const int nf = NSA_TILE(0); dma_k(C, KX + nf * 64 * 128, lds + KB0); dma_v(C, VX + 64 * nf, C.vdos, lds + VB0); NSA_SYNC(); }
                int i = 0;
                for (; i < cntf; ++i) NSA_BODY(true)
                for (; i < cnt; ++i) NSA_BODY(false)
#undef NSA_BODY
#undef NSA_TILE
                asm volatile("s_waitcnt vmcnt(0)" ::: "memory");
#pragma unroll
                for (int qt = 0; qt < 2; ++qt) { const float lt = radd32(radd16(l[qt]));
                    const int row = b * SEQ + (C.pos0 + 4 * qt);
                    const float sc = (1.f / (1.f + __expf(-bf2f(*(const bf16*)((const char*)SM + (unsigned)((row * 64 + 16 + 8 * br + h) * 2)))))) / lt;
#pragma unroll
                    for (int dt = 0; dt < 8; ++dt) { const f4 v = o[qt][dt] * sc; v2u* sp = (v2u*)(NSA_OROW(qt) + 32 * dt); const v2u pv = *sp;
                        const float a0 = bflo(pv.x) + v[0], a1 = bfhi(pv.x) + v[1], a2 = bflo(pv.y) + v[2], a3 = bfhi(pv.y) + v[3];
                        if (br == 2) ssq[qt] += (a0 * a0 + a1 * a1) + (a2 * a2 + a3 * a3);
                        *sp = (v2u){pg8::cvt_pk_bf16(a0, a1), pg8::cvt_pk_bf16(a2, a3)}; } }
            }
        }
        float rstd[2];
#pragma unroll
        for (int qt = 0; qt < 2; ++qt) { const float t = radd32(radd16(raddq(ssq[qt]))); rstd[qt] = 1.f / sqrtf(t * (1.f / 1024.f) + RMS_EPS); }
        asm volatile("s_waitcnt vmcnt(0)" ::: "memory");
#pragma unroll
        for (int qt = 0; qt < 2; ++qt) { const int sub = C.r * 4 + C.gq; bf16* orow = (bf16*)((char*)A2 + (unsigned)(((b * SEQ + (C.pos0 + 4 * qt)) * DM + 1024) * 2 + sub * 16)); const int subz = 0;
#pragma unroll
            for (int j = 0; j < 8; ++j) { const int col = (j * 16 + subz) * 8; v4u w = *(const v4u*)((const char*)orow + (unsigned)(col * 2)); const f32x4 g0 = *(const f32x4*)((const char*)nsag + (unsigned)(col * 4 + sub * 32)), g1 = *(const f32x4*)((const char*)nsag + (unsigned)(col * 4 + sub * 32 + 16)); const float rs = rstd[qt];
                w.x = pk2(bflo(w.x) * rs * g0.x, bfhi(w.x) * rs * g0.y); w.y = pk2(bflo(w.y) * rs * g0.z, bfhi(w.y) * rs * g0.w); w.z = pk2(bflo(w.z) * rs * g1.x, bfhi(w.z) * rs * g1.y); w.w = pk2(bflo(w.w) * rs * g1.z, bfhi(w.w) * rs * g1.w);
                *(v4u*)((char*)orow + (unsigned)(col * 2)) = w; } }
        NSA_SYNC();
    }
#undef NSA_SYNC
#undef NSA_OROW
}

constexpr size_t WS_ST = WS_LA;
constexpr size_t WS_DEC = WS_ST + (size_t)2048 * 256 * 128 * 2;
static_assert(WS_DEC + (size_t)2048 * 128 * 4 <= WS_KCMP, "gla scratch overlay");
namespace gla {
typedef float f4 __attribute__((ext_vector_type(4)));
constexpr int L_ST = 0, L_KT = 65536, L_QT = 81920, L_VT = 98304, L_GA = 131072, L_GT = L_GA + 4096, L_RED = L_GT + 2048, L_END = L_RED + 512;
struct CumIn { float w[16]; float bb; v4u sm; };
__device__ __forceinline__ CumIn load_cum(const Params& p, int tid, int t0, int h) { CumIn x;
    const bf16* SM = (const bf16*)(p.ws + WS_SM); const float* wa2 = p.in[I_WA2]; const float* ba = p.in[I_BA]; const int dk = tid & 127;
    x.sm = (v4u){0u, 0u, 0u, 0u};
    if (tid < 128) { const int j = tid >> 1, hf = tid & 1; x.sm = *(const v4u*)((const char*)SM + (unsigned)(((t0 + j) * 64 + hf * 8) * 2)); }
#pragma unroll
    for (int r = 0; r < 16; ++r) x.w[r] = wa2[r * 512 + h * 128 + dk];
    x.bb = ba[h * 128 + dk];
    return x; }
__device__ __forceinline__ void chunk_cumsum(const CumIn& in, LAS unsigned char* lds, int tid, float (&P)[16], float& blast) {
    LAS float* ga = (LAS float*)(lds + L_GA); LAS float* gt = (LAS float*)(lds + L_GT);
    if (tid < 128) { const int j = tid >> 1, hf = tid & 1; const v4u w = in.sm;
        LAS float* d = ga + j * 16 + hf * 8; d[0] = bflo(w.x); d[1] = bfhi(w.x); d[2] = bflo(w.y); d[3] = bfhi(w.y); d[4] = bflo(w.z); d[5] = bfhi(w.z); d[6] = bflo(w.w); d[7] = bfhi(w.w); }
    const int dk = tid & 127, jq = tid >> 7;
    const float bb = in.bb;
    __syncthreads();
    float run = 0.f;
#pragma unroll
    for (int jj = 0; jj < 16; ++jj) { const LAS f32x4* gr = (const LAS f32x4*)(ga + (16 * jq + jj) * 16); float z = bb;
#pragma unroll
        for (int r4 = 0; r4 < 4; ++r4) { const f32x4 g4 = gr[r4]; z += g4.x * in.w[4 * r4] + g4.y * in.w[4 * r4 + 1] + g4.z * in.w[4 * r4 + 2] + g4.w * in.w[4 * r4 + 3]; }
        run += (fminf(z, 0.f) - __logf(1.f + __expf(-fabsf(z)))) * (1.f / 16.f);   P[jj] = run; }
    gt[jq * 128 + dk] = run;
    __syncthreads();
    float off = 0.f, tot = 0.f;
#pragma unroll
    for (int q = 0; q < 4; ++q) { const float t = gt[q * 128 + dk]; tot += t; if (q < jq) off += t; }
#pragma unroll
    for (int jj = 0; jj < 16; ++jj) P[jj] += off;
    blast = tot;
}
struct RawK { v4u r[2]; }; struct RawV { v4u r[4]; };
__device__ __forceinline__ RawK load_raw_k(const bf16* src  , int tid, int t0, int h) { RawK x;
#pragma unroll
    for (int q = 0; q < 2; ++q) { const int id = tid + 512 * q, j = id >> 4, c16 = id & 15; x.r[q] = *(const v4u*)((const char*)src + (unsigned)(((t0 + j) * 512 + h * 128 + c16 * 8) * 2)); }
    return x; }
__device__ __forceinline__ void store_raw_k(LAS unsigned char* dst, int tid, const RawK& x) {
#pragma unroll
    for (int q = 0; q < 2; ++q) { const int id = tid + 512 * q, j = id >> 4, c16 = id & 15; *(LAS v4u*)(dst + j * 256 + c16 * 16) = x.r[q]; } }
__device__ __forceinline__ RawV load_raw_v(const Params& p, int tid, int t0, int h) { const bf16* GV = (const bf16*)(p.ws + WS_GV); RawV x;
#pragma unroll
    for (int q = 0; q < 4; ++q) { const int id = tid + 512 * q, j = id >> 5, c = id & 31; x.r[q] = *(const v4u*)((const char*)GV + (unsigned)(((t0 + j) * 1024 + h * 256 + c * 8) * 2)); }
    return x; }
__device__ __forceinline__ void store_raw_v(LAS unsigned char* dst, int tid, const RawV& x) {
#pragma unroll
    for (int q = 0; q < 4; ++q) { const int id = tid + 512 * q, j = id >> 5, c = id & 31; *(LAS v4u*)(dst + j * 512 + c * 16) = x.r[q]; } }
__device__ __forceinline__ void fill_vt(LAS unsigned char* lds, const LAS unsigned char* rv, int tid) {
    const int dv = tid & 255, jh = tid >> 8;
    unsigned short v[32];
#pragma unroll
    for (int jj = 0; jj < 32; ++jj) v[jj] = *(const LAS bf16*)(rv + (32 * jh + jj) * 512 + dv * 2);
    LAS unsigned char* row = lds + L_VT + dv * 128; const int f = (dv >> 1) & 7;
#pragma unroll
    for (int q = 0; q < 4; ++q) { v4u w; w.x = v[8 * q] | ((unsigned)v[8 * q + 1] << 16); w.y = v[8 * q + 2] | ((unsigned)v[8 * q + 3] << 16); w.z = v[8 * q + 4] | ((unsigned)v[8 * q + 5] << 16); w.w = v[8 * q + 6] | ((unsigned)v[8 * q + 7] << 16);
        *(LAS v4u*)(row + (((4 * jh + q) ^ f) * 16)) = w; }
}
}

__device__ __forceinline__ void ph_gla_a(const Params& p, LAS unsigned char* lds, int u0, int ustride, int tid_in, int wave) {
    using namespace gla;
    int tid = tid_in; asm volatile("" : "+v"(tid));
    const int lane = tid & 63, c = lane & 15, gq = lane >> 4;
    const bf16* GK = (const bf16*)(p.ws + WS_GK); bf16* ST = (bf16*)(p.ws + WS_ST); float* DEC = (float*)(p.ws + WS_DEC);
    RawK rk; RawV rv;
    CumIn ci;
    if (u0 < 2048) { const int bh = u0 >> 6, ch = u0 & 63; rk = load_raw_k(GK, tid, (bh >> 2) * SEQ + ch * 64, bh & 3); rv = load_raw_v(p, tid, (bh >> 2) * SEQ + ch * 64, bh & 3); ci = load_cum(p, tid, (bh >> 2) * SEQ + ch * 64, bh & 3); }
    for (int unit = u0; unit < 2048; unit += ustride) {
        const int bh = unit >> 6, ch = unit & 63, b = bh >> 2, h = bh & 3, t0 = b * SEQ + ch * 64;
        store_raw_k(lds + 0, tid, rk); store_raw_v(lds + 16384, tid, rv);
        float P[16], blast; chunk_cumsum(ci, lds, tid, P, blast);
        { const int dk = tid & 127, jq = tid >> 7;
          unsigned short kv[16];
#pragma unroll
          for (int jj = 0; jj < 16; ++jj) kv[jj] = *(const LAS bf16*)(lds + (16 * jq + jj) * 256 + dk * 2);
          unsigned pk[8];
#pragma unroll
          for (int q = 0; q < 8; ++q) pk[q] = pk2(bf2f(kv[2 * q]) * __expf(blast - P[2 * q]), bf2f(kv[2 * q + 1]) * __expf(blast - P[2 * q + 1]));
          LAS unsigned char* row = lds + L_KT + dk * 128; const int f = (dk >> 1) & 7;
          *(LAS v4u*)(row + (((2 * jq) ^ f) * 16)) = (v4u){pk[0], pk[1], pk[2], pk[3]}; *(LAS v4u*)(row + (((2 * jq + 1) ^ f) * 16)) = (v4u){pk[4], pk[5], pk[6], pk[7]};
          if (jq == 0) DEC[unit * 128 + dk] = __expf(blast); }
        fill_vt(lds, lds + 16384, tid);
        __syncthreads();
        { const int un = unit + ustride < 2048 ? unit + ustride : unit, bhn = un >> 6, chn = un & 63; rk = load_raw_k(GK, tid, (bhn >> 2) * SEQ + chn * 64, bhn & 3); rv = load_raw_v(p, tid, (bhn >> 2) * SEQ + chn * 64, bhn & 3); ci = load_cum(p, tid, (bhn >> 2) * SEQ + chn * 64, bhn & 3); }
        f4 acc[16];
        const int f = (c >> 1) & 7;
        bf16x8 aF[2];
#pragma unroll
        for (int ks = 0; ks < 2; ++ks) aF[ks] = *(const LAS bf16x8*)(lds + L_KT + (16 * wave + c) * 128 + (((4 * ks + gq) ^ f) * 16));
#pragma unroll
        for (int nt = 0; nt < 16; ++nt) { acc[nt] = (f4){0.f, 0.f, 0.f, 0.f};
#pragma unroll
            for (int ks = 0; ks < 2; ++ks) { const bf16x8 bF = *(const LAS bf16x8*)(lds + L_VT + (16 * nt + c) * 128 + (((4 * ks + gq) ^ f) * 16)); acc[nt] = __builtin_amdgcn_mfma_f32_16x16x32_bf16(aF[ks], bF, acc[nt], 0, 0, 0); } }
        char* dst = (char*)ST + (size_t)unit * (256 * 128 * 2) + (unsigned)((c * 128 + 16 * wave + 4 * gq) * 2);
#pragma unroll
        for (int nt = 0; nt < 16; ++nt) *(v2u*)(dst + nt * 16 * 256) = (v2u){pg8::cvt_pk_bf16(acc[nt][0], acc[nt][1]), pg8::cvt_pk_bf16(acc[nt][2], acc[nt][3])};
        __syncthreads();
    }
}
__device__ __forceinline__ void ph_gla_b(const Params& p, int gid, int gstride) {
    bf16* ST = (bf16*)(p.ws + WS_ST); const float* DEC = (const float*)(p.ws + WS_DEC);
    for (int e = gid; e < 32 * 4096; e += gstride) { const int bh = e >> 12, dv = (e >> 4) & 255, d8 = e & 15;
        float st[8];
#pragma unroll
        for (int i = 0; i < 8; ++i) st[i] = 0.f;
        char* base = (char*)ST + (size_t)bh * 64 * (256 * 128 * 2) + (unsigned)((dv * 128 + d8 * 8) * 2); const float* dbase = DEC + (size_t)bh * 64 * 128 + d8 * 8;
#pragma unroll 4
        for (int ch = 0; ch < 64; ++ch) { v4u* ptr = (v4u*)(base + (size_t)ch * (256 * 128 * 2)); const v4u w = *ptr; const f32x4 d0 = *(const f32x4*)(dbase + ch * 128), d1 = *(const f32x4*)(dbase + ch * 128 + 4);
            v4u o; o.x = pk2(st[0], st[1]); o.y = pk2(st[2], st[3]); o.z = pk2(st[4], st[5]); o.w = pk2(st[6], st[7]); *ptr = o;
            st[0] = st[0] * d0.x + bflo(w.x); st[1] = st[1] * d0.y + bfhi(w.x); st[2] = st[2] * d0.z + bflo(w.y); st[3] = st[3] * d0.w + bfhi(w.y);
            st[4] = st[4] * d1.x + bflo(w.z); st[5] = st[5] * d1.y + bfhi(w.z); st[6] = st[6] * d1.z + bflo(w.w); st[7] = st[7] * d1.w + bfhi(w.w); }
    }
}
__device__ __forceinline__ void ph_gla_c(const Params& p, LAS unsigned char* lds, int u0, int ustride, int tid_in, int wave) {
    using namespace gla;
    int tid = tid_in; asm volatile("" : "+v"(tid));
    const int lane = tid & 63, c = lane & 15, gq = lane >> 4, nt = wave & 3, half = wave >> 2;
    const bf16* GQ = (const bf16*)(p.ws + WS_GQ); const bf16* GK = (const bf16*)(p.ws + WS_GK); const bf16* GG = (const bf16*)(p.ws + WS_GG); const bf16* ST = (const bf16*)(p.ws + WS_ST);
    bf16* A2 = (bf16*)(p.ws + WS_A2); const float* gn = p.in[I_GLAG];
    const int koff0 = c * 256 + ((gq ^ c) * 16), voff0 = c * 128 + (((gq >> 1) ^ ((c >> 1) & 7)) * 16) + (gq & 1) * 8;
    CumIn ci; RawK rq, rk; RawV rv;
    if (u0 < 2048) { const int bh = u0 >> 6, ch = u0 & 63, t0 = (bh >> 2) * SEQ + ch * 64; rq = load_raw_k(GQ, tid, t0, bh & 3); rk = load_raw_k(GK, tid, t0, bh & 3); rv = load_raw_v(p, tid, t0, bh & 3); ci = load_cum(p, tid, t0, bh & 3); }
    for (int unit = u0; unit < 2048; unit += ustride) {
        const int bh = unit >> 6, ch = unit & 63, b = bh >> 2, h = bh & 3, t0 = b * SEQ + ch * 64;
        store_raw_k(lds + 0, tid, rq); store_raw_k(lds + 16384, tid, rk); store_raw_v(lds + 32768, tid, rv);
        float P[16], blast; chunk_cumsum(ci, lds, tid, P, blast);
        { const int dk = tid & 127, jq = tid >> 7;
#pragma unroll
          for (int jj = 0; jj < 16; ++jj) { const int j = 16 * jq + jj; const float qv = bf2f(*(const LAS bf16*)(lds + j * 256 + dk * 2)), kv = bf2f(*(const LAS bf16*)(lds + 16384 + j * 256 + dk * 2));
              const int off = j * 256 + (((dk >> 3) ^ (j & 15)) * 16) + (dk & 7) * 2;
              *(LAS bf16*)(lds + L_QT + off) = (bf16)f2bf(qv * __expf(P[jj])); *(LAS bf16*)(lds + L_KT + off) = (bf16)f2bf(kv * __expf(-P[jj])); } }
        fill_vt(lds, lds + 32768, tid);
        __syncthreads();
        { const char* src = (const char*)ST + (size_t)unit * (256 * 128 * 2);
#pragma unroll
          for (int i = 0; i < 8; ++i) { const int piece = 8 * wave + i, row = piece * 4 + (lane >> 4), chunk = (lane & 15) ^ (row & 15);
              __builtin_amdgcn_global_load_lds((const unsigned*)(src + (unsigned)(row * 256 + chunk * 16)), (LAS unsigned*)(lds + L_ST + piece * 1024), 16, 0, 0); } }
        v2u ggr[8];
        { const int tokg = t0 + 16 * nt + c;
#pragma unroll
          for (int mt = 0; mt < 8; ++mt) ggr[mt] = *(const v2u*)((const char*)GG + (unsigned)((tokg * 1024 + h * 256 + 128 * half + 16 * mt + 4 * gq) * 2)); }
        asm volatile("s_waitcnt vmcnt(0)" ::: "memory"); __syncthreads();
        { const int un = unit + ustride < 2048 ? unit + ustride : unit, bhn = un >> 6, chn = un & 63, tn = (bhn >> 2) * SEQ + chn * 64; rq = load_raw_k(GQ, tid, tn, bhn & 3); rk = load_raw_k(GK, tid, tn, bhn & 3); rv = load_raw_v(p, tid, tn, bhn & 3); ci = load_cum(p, tid, tn, bhn & 3); }
        bf16x8 qF[4];
#pragma unroll
        for (int ks = 0; ks < 4; ++ks) qF[ks] = *(const LAS bf16x8*)(lds + L_QT + nt * 4096 + (koff0 ^ (ks * 64)));
        f4 sT[4];
#pragma unroll
        for (int jt = 0; jt < 4; ++jt) { sT[jt] = (f4){0.f, 0.f, 0.f, 0.f};
            if (jt <= nt) {
#pragma unroll
                for (int ks = 0; ks < 4; ++ks) { const bf16x8 a = *(const LAS bf16x8*)(lds + L_KT + jt * 4096 + (koff0 ^ (ks * 64))); sT[jt] = __builtin_amdgcn_mfma_f32_16x16x32_bf16(a, qF[ks], sT[jt], 0, 0, 0); }
                if (jt == nt) {
#pragma unroll
                    for (int rg = 0; rg < 4; ++rg) if (4 * gq + rg > c) sT[jt][rg] = 0.f; } } }
        bf16x8 pb[2];
#pragma unroll
        for (int s = 0; s < 2; ++s) { v4u w; w.x = pg8::cvt_pk_bf16(sT[2 * s][0], sT[2 * s][1]); w.y = pg8::cvt_pk_bf16(sT[2 * s][2], sT[2 * s][3]); w.z = pg8::cvt_pk_bf16(sT[2 * s + 1][0], sT[2 * s + 1][1]); w.w = pg8::cvt_pk_bf16(sT[2 * s + 1][2], sT[2 * s + 1][3]); pb[s] = __builtin_bit_cast(bf16x8, w); }
        f4 o[8]; float ss = 0.f;
#pragma unroll
        for (int mt = 0; mt < 8; ++mt) { o[mt] = (f4){0.f, 0.f, 0.f, 0.f}; const int rb = 128 * half + 16 * mt;
#pragma unroll
            for (int ks = 0; ks < 4; ++ks) { const bf16x8 a = *(const LAS bf16x8*)(lds + L_ST + rb * 256 + (koff0 ^ (ks * 64))); o[mt] = __builtin_amdgcn_mfma_f32_16x16x32_bf16(a, qF[ks], o[mt], 0, 0, 0); }
#pragma unroll
            for (int s = 0; s < 2; ++s) if (2 * s <= nt) { const v2u lo = *(const LAS v2u*)(lds + L_VT + rb * 128 + (voff0 ^ (s * 64))), hi = *(const LAS v2u*)(lds + L_VT + rb * 128 + (voff0 ^ (s * 64 + 32)));
                o[mt] = __builtin_amdgcn_mfma_f32_16x16x32_bf16(__builtin_bit_cast(bf16x8, (v4u){lo.x, lo.y, hi.x, hi.y}), pb[s], o[mt], 0, 0, 0); }
            ss += (o[mt][0] * o[mt][0] + o[mt][1] * o[mt][1]) + (o[mt][2] * o[mt][2] + o[mt][3] * o[mt][3]); }
        ss = nsa::radd32(nsa::radd16(ss));
        LAS float* red = (LAS float*)(lds + L_RED);
        if (gq == 0) red[half * 64 + 16 * nt + c] = ss;
        __syncthreads();
        const float rstd = 1.f / sqrtf((red[16 * nt + c] + red[64 + 16 * nt + c]) * (1.f / 256.f) + RMS_EPS);
        const int tok = t0 + 16 * nt + c;
#pragma unroll
        for (int mt = 0; mt < 8; ++mt) { const int dv = 128 * half + 16 * mt + 4 * gq; const f32x4 g4 = *(const f32x4*)((const char*)gn + (unsigned)(dv * 4));
            const v2u gg = ggr[mt];
            const float z0 = bflo(gg.x), z1 = bfhi(gg.x), z2 = bflo(gg.y), z3 = bfhi(gg.y);
            v2u w; w.x = pg8::cvt_pk_bf16(o[mt][0] * rstd * g4.x * (z0 * __builtin_amdgcn_rcpf(1.f + __expf(-z0))), o[mt][1] * rstd * g4.y * (z1 * __builtin_amdgcn_rcpf(1.f + __expf(-z1))));
            w.y = pg8::cvt_pk_bf16(o[mt][2] * rstd * g4.z * (z2 * __builtin_amdgcn_rcpf(1.f + __expf(-z2))), o[mt][3] * rstd * g4.w * (z3 * __builtin_amdgcn_rcpf(1.f + __expf(-z3))));
            *(v2u*)((char*)A2 + (unsigned)((tok * DM + h * 256 + dv) * 2)) = w; }
        __syncthreads();
    }
}

constexpr size_t WS_LH = WS_DEC + (size_t)2048 * 128 * 4;
constexpr size_t WS_PEV = WS_LH + (size_t)2 * 4096 * 256 * 4;
static_assert(WS_PEV + 1024 <= WS_KCMP, "cmp scratch overlay");
struct CmpOrder {
    int c; const bf16 *kc, *vc, *wk, *wv;
    __device__ __forceinline__ bool next(int i, pg8::Unit& u) const { if (i > 0 || c >= 32) return false; u.pm = c & 15; u.pn = 0; u.kind = c >> 4; return true; }
    __device__ __forceinline__ const char* pa(const pg8::Gemm&, const pg8::Unit& u) const { return (const char*)(u.kind ? vc : kc) + (size_t)u.pm * ((size_t)256 * 2048 * 2); }
    __device__ __forceinline__ const char* pb(const pg8::Gemm&, const pg8::Unit& u) const { return (const char*)(u.kind ? wv : wk); }
    __device__ __forceinline__ void a_ready(const pg8::Unit&) const {}
    __device__ __forceinline__ void done(const pg8::Unit&) const {}
};
struct EpiLH {
    static constexpr bool PERM = false, AFTER_DRAIN = false;
    float* LH;
    __device__ __forceinline__ void operator()(const pg8::f32x4 (&acc)[2][2][4][2], const pg8::Unit& u, int wr, int wc, int fr, int fq) const {
        const int row0 = u.kind * 4096 + u.pm * 256 + wr * 64 + fr, col0 = wc * 32 + 4 * fq;
#pragma unroll
        for (int ai = 0; ai < 2; ++ai)
#pragma unroll
            for (int m = 0; m < 4; ++m) { float* rowp = LH + (size_t)(row0 + ai * 128 + m * 16) * 256 + col0;
#pragma unroll
                for (int bj = 0; bj < 2; ++bj)
#pragma unroll
                    for (int n = 0; n < 2; ++n) *(pg8::f32x4*)(rowp + bj * 128 + n * 16) = acc[ai][bj][m][n]; }
    }
};

constexpr size_t PROWS = (size_t)MAXTILES * 256;
constexpr size_t WS_W1Q = WS_W1T;
constexpr size_t WS_W2Q = WS_W1Q + (size_t)NE * 4096 * DM;
constexpr size_t WS_HN8 = WS_W2Q + (size_t)NE * DM * DFF;
constexpr size_t WS_AMAXP = WS_HN8 + (size_t)T * DM;
constexpr size_t WS_WSC1 = WS_AMAXP + PROWS * 64 * 4;
constexpr size_t WS_WSC2 = WS_WSC1 + (size_t)NE * 4096 * 4;
constexpr size_t WS_HSC = WS_WSC2 + (size_t)NE * 2048 * 4;
constexpr size_t WS_ROWSC = WS_HSC + (size_t)T * 4;
constexpr size_t WS_ASC = WS_ROWSC + PROWS * 4;
static_assert(WS_ASC + PROWS * 4 <= WS_XN, "int8 buffers fit in the retired bf16 expert-weight region");
constexpr size_t WS_ROWTOK = WS_CTL + 512 * 1024;
static_assert(PROWS * 2 <= 512 * 1024 && DM == 2048, "row table fits; gathered rows are 2048 bytes");
constexpr size_t WS_H16 = WS_XG;
static_assert((size_t)T * DM * 2 <= PROWS * DM, "h fits below ACT8");
constexpr size_t WS_XG8 = WS_XG;
constexpr size_t WS_ACT8 = WS_XG + PROWS * DM;
constexpr size_t WS_Y = WS_ACT;
static_assert(WS_ACT8 + PROWS * DM <= WS_ACT, "int8 row buffers fit in the retired gathered-row region");

__device__ __forceinline__ unsigned q8x4(float a, float b, float c, float d) {
    const float M = 12582912.f; const unsigned ua = __builtin_bit_cast(unsigned, a + M), ub = __builtin_bit_cast(unsigned, b + M), uc = __builtin_bit_cast(unsigned, c + M), ud = __builtin_bit_cast(unsigned, d + M);
    return __builtin_amdgcn_perm(ub, ua, 0x0c0c0400u) | (__builtin_amdgcn_perm(ud, uc, 0x0c0c0400u) << 16); }
__device__ __forceinline__ float clamp127(float v) { return __builtin_amdgcn_fmed3f(v, -127.f, 127.f); }
__device__ __forceinline__ unsigned q8x4c(float a, float b, float c, float d) { return q8x4(clamp127(a), clamp127(b), clamp127(c), clamp127(d)); }

constexpr size_t WS_WINQ = WS_WINT;
constexpr size_t WS_WISC = WS_WINT + (size_t)NPT * 256 * DM;
constexpr size_t WS_XN8 = WS_XN;
constexpr size_t WS_XSC = WS_XN + (size_t)T * DM;
constexpr size_t WS_PMAX = WS_HN;
constexpr size_t WS_PMAXI = WS_PMAX + (size_t)64 * 8 * 4096 * 4;

constexpr int NSLAB_E = NE * 192, NSLAB = NSLAB_E + 178;
struct SlabSrc { const float* W; int N; bool ok; };
__device__ __forceinline__ SlabSrc slab_src(const Params& p, int sl, int r0, int n4) {
    SlabSrc s;
    if (sl < NSLAB_E) { const int e = sl / 192, r = sl % 192; const bool isw2 = r >= 128; const int nb = isw2 ? r - 128 : r; s.N = isw2 ? 2048 : 4096;
        s.W = (isw2 ? p.in[I_W2] + (size_t)e * DFF * DM : p.in[I_W1] + (size_t)e * DM * 4096) + (size_t)r0 * s.N + nb * 32 + 4 * n4; s.ok = true; }
    else { const int nb = sl - NSLAB_E; s.N = 5672; s.ok = nb * 32 + 4 * n4 < 5672; s.W = p.in[I_WIN] + (size_t)r0 * 5672 + (s.ok ? nb * 32 + 4 * n4 : 0); }
    return s;
}
__device__ __forceinline__ void p0_slab_quant(const Params& p, LAS unsigned char* lds, int bid, int G, int tid) {
    constexpr int RS = 4104;
    LAS unsigned char* TT = lds; LAS float* part = (LAS float*)(lds + 32 * RS); LAS float* inv = part + 64 * 32; LAS int* drow = (LAS int*)(inv + 32);
    signed char* W1Q = (signed char*)(p.ws + WS_W1Q); signed char* W2Q = (signed char*)(p.ws + WS_W2Q); signed char* WIQ = (signed char*)(p.ws + WS_WINQ);
    float* WSC1 = (float*)(p.ws + WS_WSC1); float* WSC2 = (float*)(p.ws + WS_WSC2); float* WISC = (float*)(p.ws + WS_WISC);
    const int n4 = tid & 7, r0 = tid >> 3;
    f32x4 va[8], vb[8];
#define SLAB_ISSUE(dst, sl, j) do { if ((sl) < NSLAB) { const SlabSrc ss_ = slab_src(p, (sl), 2 * r0, n4); _Pragma("unroll") for (int u = 0; u < 8; ++u) dst[u] = __builtin_nontemporal_load((const f32x4*)(ss_.W + (size_t)(128 * (4 * (j) + (u >> 1)) + (u & 1)) * ss_.N)); } } while (0)
#define SLAB_USE(src, j) do { _Pragma("unroll") for (int u2 = 0; u2 < 4; ++u2) { const f32x4 xa = src[2 * u2], xb = src[2 * u2 + 1]; const int k = 2 * r0 + 128 * (4 * (j) + u2);        \
            const unsigned w0 = cvt2bf(xa.x, xb.x), w1 = cvt2bf(xa.y, xb.y), w2 = cvt2bf(xa.z, xb.z), w3 = cvt2bf(xa.w, xb.w);        \
            mx0 = __builtin_elementwise_max(mx0, __builtin_bit_cast(u16x2, w0 & 0x7fff7fffu)); mx1 = __builtin_elementwise_max(mx1, __builtin_bit_cast(u16x2, w1 & 0x7fff7fffu)); \
            mx2 = __builtin_elementwise_max(mx2, __builtin_bit_cast(u16x2, w2 & 0x7fff7fffu)); mx3 = __builtin_elementwise_max(mx3, __builtin_bit_cast(u16x2, w3 & 0x7fff7fffu)); \
            LAS unsigned char* d = TT + (4 * n4) * RS + k * 2; \
            *(LAS unsigned*)d = w0; *(LAS unsigned*)(d + RS) = w1; *(LAS unsigned*)(d + 2 * RS) = w2; *(LAS unsigned*)(d + 3 * RS) = w3; } } while (0)
    SLAB_ISSUE(va, bid, 0); SLAB_ISSUE(vb, bid, 1);
    for (int slab = bid; slab < NSLAB; slab += G) {
        u16x2 mx0 = (u16x2){0, 0}, mx1 = (u16x2){0, 0}, mx2 = (u16x2){0, 0}, mx3 = (u16x2){0, 0};
        SLAB_USE(va, 0); SLAB_ISSUE(va, slab, 2);
        SLAB_USE(vb, 1); SLAB_ISSUE(vb, slab, 3);
        SLAB_USE(va, 2); SLAB_ISSUE(va, slab + G, 0);
        SLAB_USE(vb, 3); SLAB_ISSUE(vb, slab + G, 1);
        { u16x2 t0, t1; { const unsigned m0 = __builtin_bit_cast(unsigned, mx0), m1 = __builtin_bit_cast(unsigned, mx1), m2 = __builtin_bit_cast(unsigned, mx2), m3 = __builtin_bit_cast(unsigned, mx3);
            t0 = __builtin_elementwise_max(__builtin_bit_cast(u16x2, __builtin_amdgcn_perm(m1, m0, 0x05040100u)), __builtin_bit_cast(u16x2, __builtin_amdgcn_perm(m1, m0, 0x07060302u)));
            t1 = __builtin_elementwise_max(__builtin_bit_cast(u16x2, __builtin_amdgcn_perm(m3, m2, 0x05040100u)), __builtin_bit_cast(u16x2, __builtin_amdgcn_perm(m3, m2, 0x07060302u))); }
#pragma unroll
          for (int o = 8; o < 64; o <<= 1) { t0 = __builtin_elementwise_max(t0, __builtin_bit_cast(u16x2, __shfl_xor(__builtin_bit_cast(int, t0), o))); t1 = __builtin_elementwise_max(t1, __builtin_bit_cast(u16x2, __shfl_xor(__builtin_bit_cast(int, t1), o))); }
          const unsigned a0 = __builtin_bit_cast(unsigned, t0), a1 = __builtin_bit_cast(unsigned, t1);
          if ((tid & 63) < 8) *(LAS f32x4*)(part + (tid >> 6) * 32 + 4 * n4) = (f32x4){bflo(a0), bfhi(a0), bflo(a1), bfhi(a1)}; }
        __syncthreads();
        if (tid < 32) { float m = 0.f;
#pragma unroll
            for (int q = 0; q < 8; ++q) m = fmaxf(m, part[q * 32 + tid]);
            const float sc = m > 0.f ? m * (1.f / 127.f) : 1.f; inv[tid] = 1.f / sc;
            if (slab < NSLAB_E) { const int e = slab / 192, r = slab % 192; const bool isw2 = r >= 128; const int n = (isw2 ? r - 128 : r) * 32 + tid;
                if (isw2) { drow[tid] = e * 2048 + n; WSC2[e * 2048 + n] = sc; }
                else { const int j2 = n & 2047, row = (j2 >> 7) * 256 + (n >= 2048 ? 128 : 0) + (j2 & 127); drow[tid] = e * 4096 + row; WSC1[e * 4096 + row] = sc; } }
            else { const int n = (slab - NSLAB_E) * 32 + tid; if (n < 5672) { float qsc; const int row = win_row(n, qsc); drow[tid] = row; WISC[row] = sc * qsc; } else drow[tid] = -1; } }
        __syncthreads();
        { const int kc = tid & 7, n = (tid >> 3) & 31, hf = tid >> 8; const float iv = inv[n]; const int dr = drow[n];
          signed char* dst = (slab < NSLAB_E ? ((slab % 192) >= 128 ? W2Q : W1Q) : WIQ) + (size_t)(dr < 0 ? 0 : dr) * 2048; const LAS unsigned char* src = TT + n * RS;
          if (dr >= 0) {
#pragma unroll
          for (int m8 = 0; m8 < 8; ++m8) { const int k0 = 16 * (kc + 8 * (hf + 2 * m8)); const LAS v2u* sp = (const LAS v2u*)(src + k0 * 2); const v2u a = sp[0], b = sp[1], c = sp[2], d = sp[3]; v4u o;
              o.x = q8x4(bflo(a.x) * iv, bfhi(a.x) * iv, bflo(a.y) * iv, bfhi(a.y) * iv); o.y = q8x4(bflo(b.x) * iv, bfhi(b.x) * iv, bflo(b.y) * iv, bfhi(b.y) * iv);
              o.z = q8x4(bflo(c.x) * iv, bfhi(c.x) * iv, bflo(c.y) * iv, bfhi(c.y) * iv); o.w = q8x4(bflo(d.x) * iv, bfhi(d.x) * iv, bflo(d.y) * iv, bfhi(d.y) * iv);
              *(v4u*)(dst + k0) = o; } } }
        __syncthreads();
    }
#undef SLAB_ISSUE
#undef SLAB_USE
}
struct EpiSwigluI8 {
    static constexpr bool PERM = true, AFTER_DRAIN = false;
    const float* b1; const float* rowsc; const float* wsc1; bf16* act; float* amaxp;
    __device__ __forceinline__ void operator()(const pg8::f32x4 (&acc)[2][2][4][2], const pg8::Unit& u, int wr, int wc, int fr, int fq) const {
        const int e = u.kind; const int cin = wc * 32 + 8 * fq; const int col = u.pn * 128 + cin; const int row0 = u.pm * 256 + wr * 64 + fr;
        const float* bg = b1 + (size_t)e * 4096 + col; const float* bl = bg + 2048; const float* sg = wsc1 + (size_t)e * 4096 + u.pn * 256 + cin; const float* sl = sg + 128;
        float gb[8], lb[8], gs[8], ls[8];
#pragma unroll
        for (int j = 0; j < 8; ++j) { gb[j] = bg[j]; lb[j] = bl[j]; gs[j] = sg[j]; ls[j] = sl[j]; }
#pragma unroll
        for (int ai = 0; ai < 2; ++ai)
#pragma unroll
            for (int m = 0; m < 4; ++m) { const int r = row0 + ai * 128 + m * 16; const float rs = rowsc[r]; float o[8]; float mx = 0.f;
#pragma unroll
                for (int n = 0; n < 2; ++n)
#pragma unroll
                    for (int j = 0; j < 4; ++j) { float gl = (float)__float_as_int(acc[ai][0][m][n][j]) * (rs * gs[n * 4 + j]) + gb[n * 4 + j]; float li = (float)__float_as_int(acc[ai][1][m][n][j]) * (rs * ls[n * 4 + j]) + lb[n * 4 + j];
                        gl = fminf(gl, 7.f); li = fminf(fmaxf(li, -7.f), 7.f);
                        const float v = gl * __builtin_amdgcn_rcpf(1.f + __builtin_amdgcn_exp2f(-2.4554669595930156f * gl)) * (li + 1.f); o[n * 4 + j] = v; mx = fmaxf(mx, fabsf(v)); }
                mx = nsa::rmax32(nsa::rmax16(mx));
                if (fq == 0) amaxp[(size_t)r * 64 + u.pn * 4 + wc] = mx;
                pg8::u32x4 w; w.x = pg8::cvt_pk_bf16(o[0], o[1]); w.y = pg8::cvt_pk_bf16(o[2], o[3]); w.z = pg8::cvt_pk_bf16(o[4], o[5]); w.w = pg8::cvt_pk_bf16(o[6], o[7]);
                *(pg8::u32x4*)(act + (size_t)r * DFF + col) = w; }
    }
};
__device__ __forceinline__ void ph_actq(const Params& p, int gw, int NGW, int lane) {
    const int nrows = ((const int*)(p.ws + WS_META))[0] * 256; const float* amaxp = (const float*)(p.ws + WS_AMAXP); const bf16* act = (const bf16*)(p.ws + WS_ACT);
    signed char* A8 = (signed char*)(p.ws + WS_ACT8); float* ASC = (float*)(p.ws + WS_ASC);
    for (int rb = gw; rb < nrows; rb += 2 * NGW) {
        const int r0 = rb, r1 = rb + NGW; const bool h1 = r1 < nrows; const int r1c = h1 ? r1 : r0;
        float m0 = amaxp[(size_t)r0 * 64 + lane], m1 = amaxp[(size_t)r1c * 64 + lane];
        const v4u* s0 = (const v4u*)(act + (size_t)r0 * DFF) + lane * 4; const v4u* s1 = (const v4u*)(act + (size_t)r1c * DFF) + lane * 4; v4u a[2][4];
#pragma unroll
        for (int j = 0; j < 4; ++j) { a[0][j] = s0[j]; a[1][j] = s1[j]; }
        m0 = wave_max(m0); m1 = wave_max(m1);
#pragma unroll
        for (int q = 0; q < 2; ++q) { const int r = q ? r1 : r0; if (q && !h1) break; const float mx = q ? m1 : m0; const float sc = mx > 0.f ? mx * (1.f / 127.f) : 1.f, iv = 1.f / sc; v4u o[2];
#pragma unroll
            for (int h = 0; h < 2; ++h) { const v4u x = a[q][2 * h], y = a[q][2 * h + 1];
                o[h].x = q8x4c(bflo(x.x) * iv, bfhi(x.x) * iv, bflo(x.y) * iv, bfhi(x.y) * iv); o[h].y = q8x4c(bflo(x.z) * iv, bfhi(x.z) * iv, bflo(x.w) * iv, bfhi(x.w) * iv);
                o[h].z = q8x4c(bflo(y.x) * iv, bfhi(y.x) * iv, bflo(y.y) * iv, bfhi(y.y) * iv); o[h].w = q8x4c(bflo(y.z) * iv, bfhi(y.z) * iv, bflo(y.w) * iv, bfhi(y.w) * iv); }
            v4u* dst = (v4u*)(A8 + (size_t)r * DFF) + lane * 2; dst[0] = o[0]; dst[1] = o[1];
            if (lane == 0) ASC[r] = sc; } }
}
struct EpiDownI8 {
    static constexpr bool PERM = true, AFTER_DRAIN = false;
    const float* b2; const float* roww; const float* asc; const float* wsc2; bf16* y;
    __device__ __forceinline__ void operator()(const pg8::f32x4 (&acc)[2][2][4][2], const pg8::Unit& u, int wr, int wc, int fr, int fq) const {
        const int e = u.kind; const int col0 = u.pn * 256 + wc * 32 + 8 * fq; const int row0 = u.pm * 256 + wr * 64 + fr;
        float bv[2][8], sv[2][8];
#pragma unroll
        for (int bj = 0; bj < 2; ++bj)
#pragma unroll
            for (int j = 0; j < 8; ++j) { bv[bj][j] = b2[(size_t)e * DM + col0 + bj * 128 + j]; sv[bj][j] = wsc2[(size_t)e * DM + col0 + bj * 128 + j]; }
#pragma unroll
        for (int ai = 0; ai < 2; ++ai)
#pragma unroll
            for (int m = 0; m < 4; ++m) { const int r = row0 + ai * 128 + m * 16; const float g = roww[r], as = asc[r];
#pragma unroll
                for (int bj = 0; bj < 2; ++bj) { float o[8];
#pragma unroll
                    for (int n = 0; n < 2; ++n)
#pragma unroll
                        for (int j = 0; j < 4; ++j) o[n * 4 + j] = ((float)__float_as_int(acc[ai][bj][m][n][j]) * (as * sv[bj][n * 4 + j]) + bv[bj][n * 4 + j]) * g;
                    pg8::u32x4 w; w.x = pg8::cvt_pk_bf16(o[0], o[1]); w.y = pg8::cvt_pk_bf16(o[2], o[3]); w.z = pg8::cvt_pk_bf16(o[4], o[5]); w.w = pg8::cvt_pk_bf16(o[6], o[7]);
                    *(pg8::u32x4*)(y + (size_t)r * DM + col0 + bj * 128) = w; } }
    }
};

struct EpiProjI8 {
    static constexpr bool PERM = true, AFTER_DRAIN = false;
    unsigned char* ws;
    __device__ __forceinline__ void operator()(const pg8::f32x4 (&acc)[2][2][4][2], const pg8::Unit& u, int wr, int wc, int fr, int fq) const {
        const int cw = wc * 32 + 8 * fq; const float* XSC = (const float*)(ws + WS_XSC); const float* WISC = (const float*)(ws + WS_WISC);
        if (u.kind == 0) {
            const int tn = u.pn; bf16* base; size_t bjs = 128; int ld = 0; bool headmajor = false; bool small = false;
            if (tn < 2) { base = (bf16*)(ws + WS_GQ) + tn * 256; ld = 512; }
            else if (tn < 4) { base = (bf16*)(ws + WS_GK) + (tn - 2) * 256; ld = 512; }
            else if (tn < 8) { base = (bf16*)(ws + WS_GV) + (tn - 4) * 256; ld = 1024; }
            else if (tn < 12) { base = (bf16*)(ws + WS_GG) + (tn - 8) * 256; ld = 1024; }
            else if (tn < 16) { base = (bf16*)(ws + WS_NQ) + (tn - 12) * 256; ld = 1024; }
            else if (tn < 20) { base = (bf16*)(ws + (tn == 16 ? WS_KC : tn == 17 ? WS_VC : tn == 18 ? WS_KS : WS_KW)); headmajor = true; bjs = (size_t)SEQ * 128; }
            else { base = (bf16*)(ws + WS_SM); ld = 64; small = true; }
            if (small && wc >= 2) return;
            float cs[2][8];
#pragma unroll
            for (int bj = 0; bj < 2; ++bj)
#pragma unroll
                for (int j = 0; j < 8; ++j) cs[bj][j] = WISC[tn * 256 + bj * 128 + cw + j];
#pragma unroll
            for (int ai = 0; ai < 2; ++ai)
#pragma unroll
                for (int m = 0; m < 4; ++m) { const int r = u.pm * 256 + ai * 128 + wr * 64 + m * 16 + fr; const float rs = XSC[r];
                    const size_t rterm = headmajor ? ((size_t)(r >> 12) * 2 * SEQ + (r & (SEQ - 1))) * 128 : (size_t)r * ld;
#pragma unroll
                    for (int bj = 0; bj < 2; ++bj) { if (small && bj) continue; float o[8];
#pragma unroll
                        for (int n = 0; n < 2; ++n)
#pragma unroll
                            for (int j = 0; j < 4; ++j) o[n * 4 + j] = (float)__float_as_int(acc[ai][bj][m][n][j]) * (rs * cs[bj][n * 4 + j]);
                        pg8::u32x4 w; w.x = pg8::cvt_pk_bf16(o[0], o[1]); w.y = pg8::cvt_pk_bf16(o[2], o[3]); w.z = pg8::cvt_pk_bf16(o[4], o[5]); w.w = pg8::cvt_pk_bf16(o[6], o[7]);
                        *(pg8::u32x4*)(base + rterm + bj * bjs + cw) = w; } }
        } else {
            bf16* base = (bf16*)(ws + (u.pn == 21 ? WS_VST : WS_VWT));
#pragma unroll
            for (int ai = 0; ai < 2; ++ai)
#pragma unroll
                for (int m = 0; m < 4; ++m) { const int dh = wr * 64 + m * 16 + fr; const float ws_ = WISC[u.pn * 256 + ai * 128 + dh];
#pragma unroll
                    for (int bj = 0; bj < 2; ++bj) { const int tok = u.pm * 256 + bj * 128 + cw; const int b = tok >> 12, s = tok & (SEQ - 1); float o[8];
                        const pg8::f32x4 x0 = *(const pg8::f32x4*)(XSC + tok), x1 = *(const pg8::f32x4*)(XSC + tok + 4);
#pragma unroll
                        for (int j = 0; j < 4; ++j) { o[j] = (float)__float_as_int(acc[ai][bj][m][0][j]) * (ws_ * x0[j]); o[4 + j] = (float)__float_as_int(acc[ai][bj][m][1][j]) * (ws_ * x1[j]); }
                        pg8::u32x4 w; w.x = pg8::cvt_pk_bf16(o[0], o[1]); w.y = pg8::cvt_pk_bf16(o[2], o[3]); w.z = pg8::cvt_pk_bf16(o[4], o[5]); w.w = pg8::cvt_pk_bf16(o[6], o[7]);
                        *(pg8::u32x4*)(base + ((size_t)(b * 2 + ai) * 128 + dh) * SEQ + s) = w; } }
        }
    }
};

__device__ __forceinline__ void r1_router(const Params& p, LAS unsigned char* lds, int vb, int tid, int wave, int lane) {
    LAS float* rowbuf = (LAS float*)lds;
    LAS float* part = (LAS float*)(lds + 65536);
    LAS int* tk = (LAS int*)(lds + 81920 + wave * 1024);
    LAS int* cntw = (LAS int*)(lds + 90112);
    const bf16* h = (const bf16*)(p.ws + WS_H16); const float* gf = p.in[I_NFFN]; const float* rw = p.in[I_RW]; const float* rb = p.in[I_RB];
    signed char* HN8 = (signed char*)(p.ws + WS_HN8);
    const int e = lane & 31, eg = tid & 31, dg = tid >> 5; int mycount = 0;
    float rwr[128];
#pragma unroll
    for (int c4 = 0; c4 < 4; ++c4) { unsigned o = (unsigned)((((dg * 128 + c4 * 32) * 32) + eg) * 4); asm volatile("" : "+v"(o));
#pragma unroll
        for (int i = 0; i < 32; ++i) rwr[c4 * 32 + i] = *(const float*)((const char*)rw + o + i * 128); }
    v4u hw[4];
    { const v4u* xr = (const v4u*)(h + (size_t)(vb * TPV + wave) * DM) + lane;
#pragma unroll
      for (int q = 0; q < 4; ++q) hw[q] = xr[64 * q]; }
    for (int grp = 0; grp < 16; ++grp) { const int t = vb * TPV + grp * 8 + wave;
        { float s = 0.f;
#pragma unroll
          for (int q = 0; q < 4; ++q) { const float a0 = bflo(hw[q].x), a1 = bfhi(hw[q].x), a2 = bflo(hw[q].y), a3 = bfhi(hw[q].y), a4 = bflo(hw[q].z), a5 = bfhi(hw[q].z), a6 = bflo(hw[q].w), a7 = bfhi(hw[q].w);
              s += ((a0 * a0 + a1 * a1) + (a2 * a2 + a3 * a3)) + ((a4 * a4 + a5 * a5) + (a6 * a6 + a7 * a7)); }
          const float rstd = 1.f / sqrtf(wave_sum(s) * (1.f / DM) + RMS_EPS);
          float mxr = 0.f; LAS f32x4* hrow = (LAS f32x4*)(rowbuf + wave * 2048);
#pragma unroll
          for (int j = 0; j < 8; ++j) { const int cj = 2 * lane + 128 * (j >> 1) + (j & 1); const f32x4 g4 = ((const f32x4*)gf)[cj]; const unsigned wa = (j & 1) ? hw[j >> 1].z : hw[j >> 1].x, wb = (j & 1) ? hw[j >> 1].w : hw[j >> 1].y;
              f32x4 y; y.x = bflo(wa) * rstd * g4.x; y.y = bfhi(wa) * rstd * g4.y; y.z = bflo(wb) * rstd * g4.z; y.w = bfhi(wb) * rstd * g4.w;
              hrow[cj] = y; mxr = fmaxf(mxr, fmaxf(fmaxf(fabsf(y.x), fabsf(y.y)), fmaxf(fabsf(y.z), fabsf(y.w)))); }
          mxr = wave_max(mxr); const float qs = mxr > 0.f ? mxr * (1.f / 127.f) : 1.f, qi = 1.f / qs;
          v2u* o8 = (v2u*)(HN8 + (size_t)t * DM) + lane;
#pragma unroll
          for (int q = 0; q < 4; ++q) { const f32x4 ya = hrow[2 * lane + 128 * q], yb = hrow[2 * lane + 128 * q + 1]; v2u o;
              o.x = q8x4(ya.x * qi, ya.y * qi, ya.z * qi, ya.w * qi); o.y = q8x4(yb.x * qi, yb.y * qi, yb.z * qi, yb.w * qi); o8[64 * q] = o; }
          if (lane == 0) ((float*)(p.ws + WS_HSC))[t] = qs; }
        __syncthreads();
        { const int tn = vb * TPV + (grp < 15 ? grp + 1 : grp) * 8 + wave; const v4u* xr = (const v4u*)(h + (size_t)tn * DM) + lane;
#pragma unroll
          for (int q = 0; q < 4; ++q) hw[q] = xr[64 * q]; }
        { float acc[8];
#pragma unroll
          for (int tt = 0; tt < 8; ++tt) acc[tt] = 0.f;
#pragma unroll
          for (int i4 = 0; i4 < 32; ++i4) { f32x4 xv[8];
#pragma unroll
              for (int tt = 0; tt < 8; ++tt) xv[tt] = *(const LAS f32x4*)(rowbuf + tt * 2048 + dg * 128 + 4 * i4);
#pragma unroll
              for (int tt = 0; tt < 8; ++tt) acc[tt] += xv[tt].x * rwr[4 * i4] + xv[tt].y * rwr[4 * i4 + 1] + xv[tt].z * rwr[4 * i4 + 2] + xv[tt].w * rwr[4 * i4 + 3];
              if (i4 & 1) asm volatile("" ::: "memory"); }
#pragma unroll
          for (int tt = 0; tt < 8; ++tt) part[(dg * 8 + tt) * 32 + eg] = acc[tt]; }
        __syncthreads();
        { float a = rb[e];
#pragma unroll
          for (int q = 0; q < 16; ++q) a += part[(q * 8 + wave) * 32 + e];
          int rank = 0;
#pragma unroll
          for (int mm = 0; mm < 32; ++mm) { const float lm = __shfl(a, mm); rank += (lm > a || (lm == a && mm < e)) ? 1 : 0; }
          const float mx = wave_max(a); const bool sel = rank < 4;
          const float ex = (sel && lane < 32) ? __expf(a - mx) : 0.f; const float sum = wave_sum(ex);
          if (sel && lane < 32) { LAS int* q = tk + (grp * 4 + rank) * 4; q[0] = e; q[1] = mycount; q[2] = __builtin_bit_cast(int, ex / sum); ++mycount; } }
        __syncthreads();
    }
    int ln; asm volatile("v_mbcnt_lo_u32_b32 %0, -1, 0\n\tv_mbcnt_hi_u32_b32 %0, -1, %0" : "=v"(ln));
    if (ln < 32) cntw[wave * 32 + ln] = mycount;
    __syncthreads();
    if (wave == 0 && ln < 32) { int tot = 0; for (int w = 0; w < 8; ++w) tot += cntw[w * 32 + ln]; ((int*)(p.ws + WS_CNT))[vb * 32 + ln] = tot; }
    { const int i = ln >> 2, k = ln & 3; const LAS int* q = tk + (i * 4 + k) * 4; const int ee = q[0]; int base = 0; for (int w = 0; w < wave; ++w) base += cntw[w * 32 + ee];
      const int t = vb * TPV + i * 8 + wave;
      ((int*)(p.ws + WS_EIDX))[t * 4 + k] = ee; ((int*)(p.ws + WS_LRNK))[t * 4 + k] = base + q[1]; ((int*)(p.ws + WS_GATE))[t * 4 + k] = q[2]; }
    __syncthreads();
}
__device__ __forceinline__ void r2_gather(const Params& p, LAS unsigned char* lds, int vb, bool write_meta, int tid, int wave, int lane) {
    LAS int* part_tot = (LAS int*)lds;
    LAS int* part_base = part_tot + 512;
    LAS int* pbase = part_base + 512;
    const int* CNT = (const int*)(p.ws + WS_CNT);
    { const int e = tid & 31, part = tid >> 5; int tot = 0, bs = 0;
      for (int v = part * 16; v < part * 16 + 16; ++v) { const int c = CNT[v * 32 + e]; tot += c; if (v < vb) bs += c; }
      part_tot[part * 32 + e] = tot; part_base[part * 32 + e] = bs; }
    __syncthreads();
    if (tid == 0) { int ps = 0; int* meta = (int*)(p.ws + WS_META); int nt = 0;
        for (int e = 0; e < 32; ++e) { int tot = 0, bs = 0; for (int q = 0; q < 16; ++q) { tot += part_tot[q * 32 + e]; bs += part_base[q * 32 + e]; }
            pbase[e] = ps + bs; const int ntile = (tot + 255) >> 8;
            if (write_meta) for (int q = 0; q < ntile; ++q) meta[64 + nt + q] = e;
            nt += ntile; ps += ntile * 256; }
        if (write_meta) meta[0] = nt; }
    __syncthreads();
    const float* HSC = (const float*)(p.ws + WS_HSC); float* ROWSC = (float*)(p.ws + WS_ROWSC);
    const int* EIDX = (const int*)(p.ws + WS_EIDX); const int* LRNK = (const int*)(p.ws + WS_LRNK); const float* GATE = (const float*)(p.ws + WS_GATE);
    int* POS = (int*)(p.ws + WS_POS); float* ROWW = (float*)(p.ws + WS_ROWW);
    unsigned short* RT = (unsigned short*)(p.ws + WS_ROWTOK);
    { const int t = vb * TPV + (tid >> 2), k = tid & 3;
      const int pos = pbase[EIDX[t * 4 + k]] + LRNK[t * 4 + k];
      POS[t * 4 + k] = pos; ROWW[pos] = GATE[t * 4 + k]; ROWSC[pos] = HSC[t]; RT[(pos & ~255) + (pos & 63) * 4 + ((pos >> 6) & 3)] = (unsigned short)t; }
    __syncthreads();
}
__device__ __forceinline__ void pf_final(const Params& p, int gw, int NGW, int lane) {
    const bf16* Y = (const bf16*)(p.ws + WS_Y); const int* POS = (const int*)(p.ws + WS_POS); const float* gfin = p.in[I_NFIN]; const bf16* H = (const bf16*)(p.ws + WS_H16);
    for (int t = gw; t < T; t += NGW) {
        f32x4 v[8]; const v4u* hr = (const v4u*)(H + (size_t)t * DM) + lane;
#pragma unroll
        for (int q = 0; q < 4; ++q) { const v4u w = hr[64 * q]; v[2 * q] = (f32x4){bflo(w.x), bfhi(w.x), bflo(w.y), bfhi(w.y)}; v[2 * q + 1] = (f32x4){bflo(w.z), bfhi(w.z), bflo(w.w), bfhi(w.w)}; }
#pragma unroll
        for (int k = 0; k < 4; ++k) { const int pos = POS[t * 4 + k]; const v4u* yr = (const v4u*)(Y + (size_t)pos * DM) + lane;
#pragma unroll
            for (int q = 0; q < 4; ++q) { const v4u w = yr[64 * q]; v[2 * q].x += bflo(w.x); v[2 * q].y += bfhi(w.x); v[2 * q].z += bflo(w.y); v[2 * q].w += bfhi(w.y);
                v[2 * q + 1].x += bflo(w.z); v[2 * q + 1].y += bfhi(w.z); v[2 * q + 1].z += bflo(w.w); v[2 * q + 1].w += bfhi(w.w); } }
        float s = 0.f;
#pragma unroll
        for (int j = 0; j < 8; ++j) s += (v[j].x * v[j].x + v[j].y * v[j].y) + (v[j].z * v[j].z + v[j].w * v[j].w);
        const float rstd = 1.f / sqrtf(wave_sum(s) * (1.f / DM) + RMS_EPS); f32x4* xr = (f32x4*)(p.out + (size_t)t * DM);
#pragma unroll
        for (int j = 0; j < 8; ++j) { const int cj = 2 * lane + 128 * (j >> 1) + (j & 1); const f32x4 g4 = ((const f32x4*)gfin)[cj]; f32x4 o; o.x = v[j].x * rstd * g4.x; o.y = v[j].y * rstd * g4.y; o.z = v[j].z * rstd * g4.z; o.w = v[j].w * rstd * g4.w; xr[cj] = o; }
    }
}


constexpr int LDS_BYTES = 159744;
constexpr int MISC_OFF = LDS_BYTES - 256;  static_assert(nsa::LDS_END <= MISC_OFF && gla::L_END <= MISC_OFF, "LDS map");
constexpr int CW_BAR = 4096, CW_XL = 16384;
__global__ __launch_bounds__(512, 2) void mega_fwd(Params p) {
    extern __shared__ __attribute__((aligned(16))) unsigned char lds_raw[];
    LAS unsigned char* lds = (LAS unsigned char*)lds_raw;
    const int G = gridDim.x, bid = blockIdx.x, NGW = G * 8;
#define PH_IDS int tid = threadIdx.x; asm volatile("" : "+v"(tid)); const int lane = tid & 63, wave = __builtin_amdgcn_readfirstlane(tid >> 6), gw = bid * 8 + wave; (void)lane; (void)gw;
    for (int u = threadIdx.x; u < 64; u += 512) ((LAS unsigned*)(lds + MISC_OFF))[u] = 0u;
    __syncthreads();
    XcdBarrier bar = xcd_barrier_post((unsigned*)(p.ws + WS_CTL) + CW_BAR, (volatile LAS unsigned*)(lds + MISC_OFF) + 8);
    { PH_IDS; p0_prologue(p, lds, gw, NGW, wave, lane); __syncthreads(); p0_slab_quant(p, lds, bid, G, tid); }
    xcd_barrier(bar);
    { pg8::Gemm g{(const bf16*)(p.ws + WS_XN8), (const bf16*)(p.ws + WS_WINQ), T, NPT * 256, DM / 2};
      ProjOrder S; S.init(T, NPT * 256, G, bid); S.xn = g.A; S.wt = g.Bt; EpiProjI8 E{p.ws};
      pg8::gemm_phase<EpiProjI8, ProjOrder, true, true, true>(lds, g, S, E); }
    xcd_barrier(bar);
    if (bid < 32) {
        pg8::Gemm g{(const bf16*)(p.ws + WS_KC), (const bf16*)(p.ws + WS_WKCT), 4096, 256, 2048};
        CmpOrder S{bid, (const bf16*)(p.ws + WS_KC), (const bf16*)(p.ws + WS_VC), (const bf16*)(p.ws + WS_WKCT), (const bf16*)(p.ws + WS_WVCT)}; EpiLH E{(float*)(p.ws + WS_LH)};
        pg8::gemm_phase<EpiLH, CmpOrder, true, true>(lds, g, S, E);
    } else { PH_IDS; ph_gla_a(p, lds, bid - 32, G - 32, tid, wave); }
    xcd_barrier(bar);
    { PH_IDS; ph_gla_b(p, bid * 512 + tid, G * 512);
      for (int i = bid * 512 + tid; i < 16 * 128; i += G * 512) { const int bgz = i >> 7, dz = i & 127; ((bf16*)(p.ws + WS_KCMP))[((size_t)bgz * 256 + 255) * 128 + dz] = 0; ((bf16*)(p.ws + WS_VCMPT))[((size_t)bgz * 128 + dz) * 256 + 255] = 0; }
      const int ngrp = G * 4, total = 2 * 16 * 255, iters = (total + ngrp - 1) / ngrp; const int grp = tid >> 7;
      for (int it = 0; it < iters; ++it) { int id = it * ngrp + bid * 4 + grp; if (id >= total) id = total - 1;
          ph_cmp_fin_simple(p, (LAS float*)lds + grp * 4352, id, tid & 127, (const float*)(p.ws + WS_LH), (const float*)(p.ws + WS_PEVP)); __syncthreads(); } }
    xcd_barrier(bar);
    { PH_IDS; ph_nsa(p, lds, bid, G, tid, wave); }
    { PH_IDS; __syncthreads(); ph_gla_c(p, lds, bid, G, tid, wave); }
    xcd_barrier(bar);
    { pg8::Gemm g{(const bf16*)(p.ws + WS_A2), (const bf16*)(p.ws + WS_WOT), T, DM, DM};
      pg8::StaticOrder S; S.init(T, DM, G, bid); EpiRes E{p.in[I_X], (bf16*)(p.ws + WS_H16)};
      pg8::gemm_phase<EpiRes, pg8::StaticOrder, true, true>(lds, g, S, E); }
    xcd_barrier(bar);
    { PH_IDS; for (int vb = bid; vb < NVB; vb += G) r1_router(p, lds, vb, tid, wave, lane); }
    xcd_barrier(bar);
    { PH_IDS; for (int vb = bid; vb < NVB; vb += G) r2_gather(p, lds, vb, vb == 0, tid, wave, lane); }
    xcd_barrier(bar);
    { pg8::Gemm g{(const bf16*)(p.ws + WS_HN8), (const bf16*)(p.ws + WS_W1Q), MAXTILES * 256, 4096, DM / 2};
      MoeOrderG S; S.init((const int*)(p.ws + WS_META), 16, G, bid); S.rowtab = (const unsigned short*)(p.ws + WS_ROWTOK); EpiSwigluI8 E{p.in[I_B1], (const float*)(p.ws + WS_ROWSC), (const float*)(p.ws + WS_WSC1), (bf16*)(p.ws + WS_ACT), (float*)(p.ws + WS_AMAXP)};
      pg8::gemm_phase<EpiSwigluI8, MoeOrderG, true, true, true, true>(lds, g, S, E); }
    xcd_barrier(bar);
    { PH_IDS; ph_actq(p, gw, NGW, lane); }
    xcd_barrier(bar);
    { pg8::Gemm g{(const bf16*)(p.ws + WS_ACT8), (const bf16*)(p.ws + WS_W2Q), MAXTILES * 256, DM, DFF / 2};
      MoeOrder S; S.init((const int*)(p.ws + WS_META), 8, G, bid); EpiDownI8 E{p.in[I_B2], (const float*)(p.ws + WS_ROWW), (const float*)(p.ws + WS_ASC), (const float*)(p.ws + WS_WSC2), (bf16*)(p.ws + WS_Y)};
      pg8::gemm_phase<EpiDownI8, MoeOrder, true, true, true>(lds, g, S, E); }
    xcd_barrier(bar);
    { PH_IDS; pf_final(p, gw, NGW, lane); }
}

extern "C" void kernel_launch(void* const* d_in, const int* in_sizes, int n_in, void* d_out, int out_size, void* d_ws, size_t ws_size, hipStream_t stream) {
    static int grid = 0;
    if (grid == 0) {
        if (n_in != N_IN || out_size != T * DM || ws_size < WS_END) { fprintf(stderr, "kernel_launch: unexpected shapes (n_in %d out %d ws %zu need %zu)\n", n_in, out_size, ws_size, (size_t)WS_END); grid = -1; return; }
        int dev = 0, cus = 0, per_cu = 0;
        if (hipGetDevice(&dev) != hipSuccess || hipDeviceGetAttribute(&cus, hipDeviceAttributeMultiprocessorCount, dev) != hipSuccess) { grid = -1; return; }
        if (hipFuncSetAttribute((const void*)mega_fwd, hipFuncAttributeMaxDynamicSharedMemorySize, LDS_BYTES) != hipSuccess) { fprintf(stderr, "kernel_launch: hipFuncSetAttribute failed\n"); grid = -1; return; }
        if (hipOccupancyMaxActiveBlocksPerMultiprocessor(&per_cu, (const void*)mega_fwd, 512, LDS_BYTES) != hipSuccess || per_cu < 1) { fprintf(stderr, "kernel_launch: occupancy query says %d blocks per CU\n", per_cu); }
        (void)hipGetLastError();
        grid = cus;
    }
    if (grid < 0) return;
    if (hipMemsetAsync((char*)d_ws + WS_CTL, 0, CTL_BYTES, stream) != hipSuccess) return;
    Params p{};
    for (int i = 0; i < N_IN; ++i) p.in[i] = (const float*)d_in[i];
    p.out = (float*)d_out; p.ws = (unsigned char*)d_ws;
    hipLaunchKernelGGL(mega_fwd, dim3(grid), dim3(512), LDS_BYTES, stream, p);
}
```

```cpp
#include <hip/hip_runtime.h>
#include <cstdio>
#include <cstdint>
namespace pg8 {
#define PG8_LAS __attribute__((address_space(3)))
typedef unsigned short bf16_t;
typedef short bf16x8 __attribute__((ext_vector_type(8)));
typedef float f32x4 __attribute__((ext_vector_type(4)));
typedef unsigned u32x4 __attribute__((ext_vector_type(4)));
typedef unsigned v2u_t __attribute__((ext_vector_type(2)));
constexpr int BM = 256, BK = 64, HALF = 128, HTB = HALF * BK * 2  , STAGE_BYTES = 8 * HTB, NXCD = 8, WGM = 8;

__host__ __device__ __forceinline__ int lds_byte(int r, int c) { const int st = (r >> 4) * 2 + (c >> 5), rr = r & 15, cc = c & 31, ob = rr * 64 + cc * 2; return st * 1024 + (ob ^ (((ob >> 9) & 1) << 5)); }
__host__ __device__ __forceinline__ void stage_rc(int b, int& R, int& C) { const int st = b / 1024, sb = b % 1024, swz = sb ^ (((sb >> 9) & 1) << 5); R = (st >> 1) * 16 + swz / 64; C = (st & 1) * 32 + (swz % 64) / 2; }
__host__ __device__ __forceinline__ int perm32(int rho) { const int n = rho >> 4, i = rho & 15; return 8 * (i >> 2) + 4 * n + (i & 3); }

struct Unit { int pm, pn, kind; };
struct Gemm { const bf16_t* A; const bf16_t* Bt; int M, N, K; };

template <int WG = WGM> __host__ __device__ __forceinline__ void tile_of(int wgid, int nM, int nN, int& pm, int& pn) {
    const int nwg = nM * nN;
    { const int q = nwg / NXCD, r = nwg % NXCD, xcd = wgid % NXCD, off = wgid / NXCD; wgid = (xcd < r ? xcd * (q + 1) : r * (q + 1) + (xcd - r) * q) + off; }
    const int nig = WG * nN, gid = wgid / nig, fm = gid * WG, gsz = (nM - fm) < WG ? (nM - fm) : WG;
    pm = fm + ((wgid % nig) % gsz); pn = (wgid % nig) / gsz;
}
struct StaticOrder {
    int nM, nN, nwg, G, c;
    __host__ __device__ void init(int M, int N, int G_, int c_) { nM = M / BM; nN = N / BM; nwg = nM * nN; G = G_; c = c_; }
    __device__ __forceinline__ bool next(int i, Unit& u) const {
        const long L = (long)i * G + c; if (L >= nwg) return false;
        tile_of((int)L, nM, nN, u.pm, u.pn); u.kind = 0; return true;
    }
    __device__ __forceinline__ const char* pa(const Gemm& g, const Unit& u) const { return (const char*)g.A + (size_t)u.pm * ((size_t)BM * g.K * 2); }
    __device__ __forceinline__ const char* pb(const Gemm& g, const Unit& u) const { return (const char*)g.Bt + (size_t)u.pn * ((size_t)BM * g.K * 2); }
    __device__ __forceinline__ void a_ready(const Unit&) const {}
    __device__ __forceinline__ void done(const Unit&) const {}
};
__device__ __forceinline__ unsigned cvt_pk_bf16(float lo, float hi) { unsigned r; asm volatile("v_cvt_pk_bf16_f32 %0, %1, %2" : "=v"(r) : "v"(lo), "v"(hi)); return r; }
template <bool I8> __device__ __forceinline__ f32x4 mma16(bf16x8 a, bf16x8 b, f32x4 c) {
    if constexpr (I8) { typedef int i32x4 __attribute__((ext_vector_type(4)));
        return __builtin_bit_cast(f32x4, __builtin_amdgcn_mfma_i32_16x16x64_i8(__builtin_bit_cast(i32x4, a), __builtin_bit_cast(i32x4, b), __builtin_bit_cast(i32x4, c), 0, 0, 0)); }
    else return __builtin_amdgcn_mfma_f32_16x16x32_bf16(a, b, c, 0, 0, 0);
}
template <class Epi, class Sched, bool ALIGN_EPI = false, bool SP2 = false, bool I8 = false, bool GATHER = false>
__device__ __forceinline__ void gemm_phase(PG8_LAS unsigned char* lds, const Gemm g, const Sched& S, const Epi& E) {
    int tid_l = threadIdx.x; asm volatile("" : "+v"(tid_l));
    const int tid = tid_l, wid = __builtin_amdgcn_readfirstlane(tid >> 6), lane = tid & 63, wr = wid >> 2, wc = wid & 3, fr = lane & 15, fq = lane >> 4;
    const int K = g.K, nt = K / BK;
    unsigned voffA[2], voffB[2];
#pragma unroll
    for (int i = 0; i < 2; ++i) { int R, C; stage_rc(tid * 16 + i * 8192, R, C); const int Rb = Epi::PERM ? ((R & ~31) + perm32(R & 31)) : R;
        voffA[i] = (unsigned)(R * K + C) * 2u; voffB[i] = (unsigned)(Rb * K + C) * 2u; }
    const size_t kstep = (size_t)(BK * 2);
    const size_t hstep = (size_t)HALF * K * 2;
    const unsigned ldsw = (unsigned)wid * 1024u;
    const int aoff = lds_byte(wr * 64 + fr, fq * 8), boff = lds_byte(wc * 32 + fr, fq * 8);
#define PG8_SA(b, h) (((b) * 2 + (h)) * HTB)
#define PG8_SB(b, h) ((4 + (b) * 2 + (h)) * HTB)
#define PG8_STAGE(bufoff, gbase, voff) do { _Pragma("unroll") for (int _i = 0; _i < 2; ++_i) \
        __builtin_amdgcn_global_load_lds((const unsigned*)((const char*)(gbase) + (voff)[_i]), (PG8_LAS unsigned*)(lds + (bufoff) + ldsw + _i * 8192), 16, 0, 0); } while (0)
#define PG8_STAGE_A(bufoff, ptr, h) do { if constexpr (GATHER) PG8_STAGE(bufoff, ptr, cuo + 2 * (h)); else PG8_STAGE(bufoff, (ptr) + (h) * hstep, voffA); } while (0)
#define PG8_LDA(dst, b, h) do { _Pragma("unroll") for (int m = 0; m < 4; ++m) _Pragma("unroll") for (int k = 0; k < 2; ++k) dst[m][k] = *(const PG8_LAS bf16x8*)(lds + PG8_SA(b, h) + aoff + m * 2048 + k * 1024); } while (0)
#define PG8_LDB(dst, b, h) do { _Pragma("unroll") for (int n = 0; n < 2; ++n) _Pragma("unroll") for (int k = 0; k < 2; ++k) dst[n][k] = *(const PG8_LAS bf16x8*)(lds + PG8_SB(b, h) + boff + n * 2048 + k * 1024); } while (0)
#define PG8_MMA(ai, bj, At, Bt) do { __builtin_amdgcn_s_setprio(1); _Pragma("unroll") for (int m = 0; m < 4; ++m) _Pragma("unroll") for (int n = 0; n < 2; ++n) _Pragma("unroll") for (int k = 0; k < 2; ++k) \
        acc[ai][bj][m][n] = mma16<I8>(Bt[n][k], At[m][k], acc[ai][bj][m][n]); __builtin_amdgcn_s_setprio(0); } while (0)
#define PG8_WAIT_V(n) asm volatile("s_waitcnt vmcnt(" #n ")" ::: "memory")
#define PG8_WAIT_L(n) asm volatile("s_waitcnt lgkmcnt(" #n ")" ::: "memory")
#define PG8_BAR __builtin_amdgcn_s_barrier()
#define PG8_SCHED __builtin_amdgcn_sched_barrier(0)
    Unit cur, nxt; int ui = 0;
    if (!S.next(0, cur)) return;
    unsigned cuo[4] = {0u, 0u, 0u, 0u}, cb0 = 0u; v2u_t raw = {0u, 0u};
    if constexpr (GATHER) { int R0, C0; stage_rc(tid * 16, R0, C0); cb0 = (unsigned)C0 * 2u; unsigned ro = (unsigned)R0 * 8u; asm volatile("" : "+v"(ro));
        Unit u1; const bool h1 = S.next(1, u1); const v2u_t r0 = *(const v2u_t*)((const char*)S.rowtab + (size_t)cur.pm * 512 + ro); raw = *(const v2u_t*)((const char*)S.rowtab + (size_t)(h1 ? u1.pm : cur.pm) * 512 + ro);
        cuo[0] = ((r0.x & 0xffffu) << 11) + cb0; cuo[1] = ((r0.x >> 16) << 11) + cb0; cuo[2] = ((r0.y & 0xffffu) << 11) + cb0; cuo[3] = ((r0.y >> 16) << 11) + cb0; }
    f32x4 acc[2][2][4][2];
#pragma unroll
    for (int a = 0; a < 2; ++a)
#pragma unroll
        for (int b = 0; b < 2; ++b)
#pragma unroll
            for (int m = 0; m < 4; ++m)
#pragma unroll
                for (int n = 0; n < 2; ++n) acc[a][b][m][n] = (f32x4){0.f, 0.f, 0.f, 0.f};
    bf16x8 At[4][2], B0[2][2], B1[2][2];
    const char* cA = S.pa(g, cur); const char* cB = S.pb(g, cur);
    S.a_ready(cur);
    if constexpr (SP2) {
        PG8_STAGE(PG8_SB(0, 0), cB, voffB); PG8_STAGE(PG8_SB(0, 1), cB + hstep, voffB); PG8_STAGE_A(PG8_SA(0, 0), cA, 0); PG8_STAGE_A(PG8_SA(0, 1), cA, 1);
        if (wr == 1) PG8_BAR;
        PG8_WAIT_V(2); PG8_BAR;
        PG8_STAGE(PG8_SB(1, 0), cB + kstep, voffB); PG8_STAGE_A(PG8_SA(1, 0), cA + kstep, 0); PG8_STAGE(PG8_SB(1, 1), cB + hstep + kstep, voffB);
        PG8_WAIT_V(6); PG8_BAR;
    } else {
        PG8_STAGE(PG8_SB(0, 0), cB, voffB); PG8_STAGE(PG8_SA(0, 0), cA, voffA); PG8_STAGE(PG8_SB(0, 1), cB + hstep, voffB); PG8_STAGE(PG8_SA(0, 1), cA + hstep, voffA);
        if (wr == 1) PG8_BAR;
        PG8_WAIT_V(4); PG8_BAR;
        PG8_STAGE(PG8_SB(1, 0), cB + kstep, voffB); PG8_STAGE(PG8_SA(1, 0), cA + kstep, voffA); PG8_STAGE(PG8_SB(1, 1), cB + hstep + kstep, voffB);
        PG8_WAIT_V(6); PG8_BAR;
    }
    for (;;) {
        const bool has_next = S.next(ui + 1, nxt);
        const char* nA = has_next ? S.pa(g, nxt) : cA; const char* nB = has_next ? S.pb(g, nxt) : cB;
        for (int t = 0; t < nt; t += 2) {
            const bool last = (t == nt - 2);
            const char* a1 = cA + (size_t)(t + 1) * kstep;
            const char* a2 = last ? nA : cA + (size_t)(t + 2) * kstep; const char* b2 = last ? nB : cB + (size_t)(t + 2) * kstep;
            const char* a3 = a2 + kstep; const char* b3 = b2 + kstep;
            if (last && has_next) S.a_ready(nxt);
            if constexpr (SP2) {
            PG8_LDB(B0, 0, 0); PG8_LDB(B1, 0, 1); PG8_SCHED; PG8_LDA(At, 0, 0); PG8_STAGE_A(PG8_SA(1, 1), a1, 1);
            if constexpr (GATHER) { unsigned rx = raw.x, ry = raw.y; asm volatile("" : "+v"(rx), "+v"(ry));
                const unsigned n0 = ((rx & 0xffffu) << 11) + cb0, n1 = ((rx >> 16) << 11) + cb0, n2 = ((ry & 0xffffu) << 11) + cb0, n3 = ((ry >> 16) << 11) + cb0;
                cuo[0] = last ? n0 : cuo[0]; cuo[1] = last ? n1 : cuo[1]; cuo[2] = last ? n2 : cuo[2]; cuo[3] = last ? n3 : cuo[3]; }
            PG8_WAIT_V(8); PG8_WAIT_L(0); PG8_BAR; PG8_MMA(0, 0, At, B0); PG8_MMA(0, 1, At, B1); PG8_BAR; PG8_SCHED;
            PG8_LDA(At, 0, 1); PG8_STAGE(PG8_SB(0, 0), b2, voffB); PG8_STAGE(PG8_SB(0, 1), b2 + hstep, voffB); PG8_STAGE_A(PG8_SA(0, 0), a2, 0);
            PG8_WAIT_V(8); PG8_WAIT_L(0); PG8_BAR; PG8_MMA(1, 0, At, B0); PG8_MMA(1, 1, At, B1); PG8_BAR; PG8_SCHED;
            PG8_LDB(B0, 1, 0); PG8_LDB(B1, 1, 1); PG8_SCHED; PG8_LDA(At, 1, 0); PG8_STAGE_A(PG8_SA(0, 1), a2, 1);
            PG8_WAIT_V(8); PG8_WAIT_L(0); PG8_BAR; PG8_MMA(0, 0, At, B0); PG8_MMA(0, 1, At, B1); PG8_BAR; PG8_SCHED;
            PG8_LDA(At, 1, 1); PG8_STAGE(PG8_SB(1, 0), b3, voffB); PG8_STAGE(PG8_SB(1, 1), b3 + hstep, voffB); PG8_STAGE_A(PG8_SA(1, 0), a3, 0);
            PG8_WAIT_V(8); PG8_WAIT_L(0); PG8_BAR; PG8_MMA(1, 0, At, B0); PG8_MMA(1, 1, At, B1); PG8_BAR; PG8_SCHED;
            } else {
            PG8_LDB(B0, 0, 0); PG8_SCHED; PG8_LDA(At, 0, 0); PG8_STAGE(PG8_SA(1, 1), a1 + hstep, voffA);
            PG8_WAIT_L(8); PG8_BAR; PG8_WAIT_L(0); PG8_MMA(0, 0, At, B0); PG8_BAR; PG8_SCHED;
            PG8_LDB(B1, 0, 1); PG8_STAGE(PG8_SB(0, 0), b2, voffB);
            PG8_BAR; PG8_WAIT_L(0); PG8_MMA(0, 1, At, B1); PG8_BAR;
            PG8_LDA(At, 0, 1); PG8_STAGE(PG8_SA(0, 0), a2, voffA);
            PG8_BAR; PG8_WAIT_L(0); PG8_MMA(1, 0, At, B0); PG8_BAR; PG8_SCHED;
            PG8_STAGE(PG8_SB(0, 1), b2 + hstep, voffB);
            PG8_WAIT_V(6); PG8_BAR; PG8_MMA(1, 1, At, B1); PG8_BAR;
            PG8_LDB(B0, 1, 0); PG8_SCHED; PG8_LDA(At, 1, 0); PG8_STAGE(PG8_SA(0, 1), a2 + hstep, voffA);
            PG8_WAIT_L(8); PG8_BAR; PG8_WAIT_L(0); PG8_MMA(0, 0, At, B0); PG8_BAR; PG8_SCHED;
            PG8_LDB(B1, 1, 1); PG8_STAGE(PG8_SB(1, 0), b3, voffB);
            PG8_BAR; PG8_WAIT_L(0); PG8_MMA(0, 1, At, B1); PG8_BAR;
            PG8_LDA(At, 1, 1); PG8_STAGE(PG8_SA(1, 0), a3, voffA);
            PG8_BAR; PG8_WAIT_L(0); PG8_MMA(1, 0, At, B0); PG8_BAR; PG8_SCHED;
            PG8_STAGE(PG8_SB(1, 1), b3 + hstep, voffB);
            PG8_WAIT_V(6); PG8_BAR; PG8_MMA(1, 1, At, B1); PG8_BAR;
            }
        }
        if constexpr (ALIGN_EPI) { if (wr == 0) PG8_BAR; }
        if constexpr (GATHER) { static_assert(SP2 && !Epi::AFTER_DRAIN, "GATHER is written for the SP2 loop"); int R0, C0; stage_rc(tid * 16, R0, C0); Unit u2; const bool h2 = S.next(ui + 2, u2);
            unsigned ro = (unsigned)R0 * 8u; asm volatile("" : "+v"(ro)); raw = *(const v2u_t*)((const char*)S.rowtab + (size_t)(h2 ? u2.pm : cur.pm) * 512 + ro); PG8_SCHED; }
        if constexpr (!Epi::AFTER_DRAIN) { E(acc, cur, wr, wc, fr, fq); S.done(cur); }
        if (!has_next) break;
#pragma unroll
        for (int a = 0; a < 2; ++a)
#pragma unroll
            for (int b = 0; b < 2; ++b)
#pragma unroll
                for (int m = 0; m < 4; ++m)
#pragma unroll
                    for (int n = 0; n < 2; ++n) acc[a][b][m][n] = (f32x4){0.f, 0.f, 0.f, 0.f};
        cur = nxt; cA = nA; cB = nB; ++ui;
        if constexpr (ALIGN_EPI) { if (wr == 1) PG8_BAR; }
    }
    PG8_WAIT_V(0);
    if constexpr (!ALIGN_EPI) { if (wr == 0) PG8_BAR; }
    PG8_BAR;
    if constexpr (Epi::AFTER_DRAIN) { E.fused(acc, cur, wr, wc, fr, fq, lds, wid, lane); S.done(cur); }
#undef PG8_SA
#undef PG8_SB
#undef PG8_STAGE
#undef PG8_STAGE_A
#undef PG8_LDA
#undef PG8_LDB
#undef PG8_MMA
#undef PG8_WAIT_V
#undef PG8_WAIT_L
#undef PG8_BAR
#undef PG8_SCHED
}
}

#define GAS __attribute__((address_space(1)))
#define LAS __attribute__((address_space(3)))
typedef unsigned short bf16;
typedef unsigned v4u __attribute__((ext_vector_type(4)));
typedef unsigned v2u __attribute__((ext_vector_type(2)));
typedef float f32x4 __attribute__((ext_vector_type(4)));
typedef short bf16x8 __attribute__((ext_vector_type(8)));

constexpr int NB = 8, SEQ = 4096, DM = 2048, T = NB * SEQ;
constexpr int NPT = 23;
constexpr int NE = 32, DFF = 2048;
constexpr int MAXTILES = 544;
constexpr float RMS_EPS = 1e-5f;
constexpr int NVB = 256, TPV = T / NVB;

enum { I_X = 0, I_NMIX, I_WIN, I_WA2, I_BA, I_GLAG, I_PEK, I_WK1, I_WK2, I_PEV, I_WV1, I_WV2, I_NSAG, I_RELB, I_WOUT, I_NFFN, I_RW, I_RB, I_W1, I_B1, I_W2, I_B2, I_NFIN, N_IN };

constexpr size_t MiB = 1u << 20;
constexpr size_t al(size_t x) { return (x + 255) & ~(size_t)255; }
constexpr size_t WS_CTL = 0, CTL_BYTES = 1 * MiB;
constexpr size_t WS_CNT = WS_CTL + CTL_BYTES;
constexpr size_t WS_META = WS_CNT + al(NVB * 32 * 4);
constexpr size_t WS_EIDX = WS_META + al((64 + MAXTILES) * 4);
constexpr size_t WS_LRNK = WS_EIDX + al((size_t)T * 4 * 4);
constexpr size_t WS_GATE = WS_LRNK + al((size_t)T * 4 * 4);
constexpr size_t WS_POS = WS_GATE + al((size_t)T * 4 * 4);
constexpr size_t WS_ROWW = WS_POS + al((size_t)T * 4 * 4);
constexpr size_t WS_WINT = al(WS_ROWW + (size_t)MAXTILES * 256 * 4);
constexpr size_t WS_WOT = WS_WINT + (size_t)NPT * 256 * DM * 2;
constexpr size_t WS_WKCT = WS_WOT + (size_t)DM * DM * 2;
constexpr size_t WS_WVCT = WS_WKCT + (size_t)256 * 2048 * 2;
constexpr size_t WS_W1T = WS_WVCT + (size_t)256 * 2048 * 2;
constexpr size_t WS_W2T = WS_W1T + (size_t)NE * 4096 * DM * 2;
constexpr size_t WS_XN = WS_W2T + (size_t)NE * DM * DFF * 2;
constexpr size_t WS_GQ = WS_XN + (size_t)T * DM * 2;
constexpr size_t WS_GK = WS_GQ + (size_t)T * 512 * 2;
constexpr size_t WS_GV = WS_GK + (size_t)T * 512 * 2;
constexpr size_t WS_GG = WS_GV + (size_t)T * 1024 * 2;
constexpr size_t WS_NQ = WS_GG + (size_t)T * 1024 * 2;
constexpr size_t WS_KC = WS_NQ + (size_t)T * 1024 * 2;
constexpr size_t WS_VC = WS_KC + (size_t)T * 256 * 2;
constexpr size_t WS_KS = WS_VC + (size_t)T * 256 * 2;
constexpr size_t WS_KW = WS_KS + (size_t)T * 256 * 2;
constexpr size_t WS_VST = WS_KW + (size_t)T * 256 * 2;
constexpr size_t WS_VWT = WS_VST + (size_t)T * 256 * 2;
constexpr size_t WS_SM = WS_VWT + (size_t)T * 256 * 2;
constexpr size_t WS_LA = WS_SM + (size_t)T * 64 * 2;
constexpr size_t WS_OG = WS_LA + (size_t)T * 512 * 4;
constexpr size_t WS_ON = WS_OG + (size_t)T * 1024 * 4;
constexpr size_t WS_KCMP = WS_ON + (size_t)T * 1024 * 4;
constexpr size_t WS_VCMPT = WS_KCMP + (size_t)16 * 256 * 128 * 2;
constexpr size_t WS_A2 = WS_VCMPT + (size_t)16 * 256 * 128 * 2;
constexpr size_t WS_HN = WS_A2 + (size_t)T * DM * 2;
constexpr size_t WS_XG = WS_HN + (size_t)T * DM * 2;
constexpr size_t WS_ACT = WS_XG + (size_t)MAXTILES * 256 * DM * 2;
constexpr size_t WS_END = WS_ACT + (size_t)MAXTILES * 256 * DFF * 2;

typedef unsigned short u16x2 __attribute__((ext_vector_type(2)));
__device__ __forceinline__ unsigned cvt2bf(float lo, float hi) { unsigned r; asm("v_cvt_pk_bf16_f32 %0, %1, %2" : "=v"(r) : "v"(lo), "v"(hi)); return r; }
__device__ __forceinline__ unsigned f2bf(float f) { return cvt2bf(f, f) & 0xffffu; }
__device__ __forceinline__ unsigned pk2(float lo, float hi) { return cvt2bf(lo, hi); }
__device__ __forceinline__ float bf2f(unsigned short v) { return __builtin_bit_cast(float, (unsigned)v << 16); }
__device__ __forceinline__ float bflo(unsigned w) { return __builtin_bit_cast(float, w << 16); }
__device__ __forceinline__ float bfhi(unsigned w) { return __builtin_bit_cast(float, w & 0xffff0000u); }
__device__ __forceinline__ float wave_sum(float v) {
#pragma unroll
    for (int o = 1; o < 64; o <<= 1) v += __shfl_xor(v, o);
    return v;
}
__device__ __forceinline__ float wave_max(float v) {
#pragma unroll
    for (int o = 1; o < 64; o <<= 1) v = fmaxf(v, __shfl_xor(v, o));
    return v;
}
#define LDS_WAIT() asm volatile("s_waitcnt lgkmcnt(0)" ::: "memory")

__device__ const unsigned char kBucket[128] = {0, 1, 2, 3, 4, 5, 6, 7, 8, 9, 10, 11, 12, 13, 14, 15, 16, 16, 16, 17, 17, 18, 18, 18, 19, 19, 19, 20, 20, 20, 20, 21, 21, 21, 21, 22, 22, 22, 22, 22, 23, 23, 23, 23, 23, 23, 24, 24, 24, 24, 24, 24, 25, 25, 25, 25, 25, 25, 25, 26, 26, 26, 26, 26, 26, 26, 26, 27, 27, 27, 27, 27, 27, 27, 27, 27, 27, 28, 28, 28, 28, 28, 28, 28, 28, 28, 28, 29, 29, 29, 29, 29, 29, 29, 29, 29, 29, 29, 29, 30, 30, 30, 30, 30, 30, 30, 30, 30, 30, 30, 30, 30, 30, 31, 31, 31, 31, 31, 31, 31, 31, 31, 31, 31, 31, 31, 31, 31};

struct Params {
    const float* in[N_IN];
    float* out;
    unsigned char* ws;
};

template <class F>
__device__ __forceinline__ void transpose_item(const float* W, int ldw, int k0, int n0, int nlim, LAS float* scr, int lane, F dst) {
#pragma unroll 8
    for (int i = 0; i < 32; ++i) { const int kk = 2 * i + (lane >> 5); const int n = n0 + (lane & 31); scr[kk * 33 + (lane & 31)] = n < nlim ? W[(size_t)(k0 + kk) * ldw + n] : 0.f; }
    LDS_WAIT(); asm volatile("" ::: "memory");
    const int c = lane & 7;
#pragma unroll
    for (int j = 0; j < 4; ++j) { const int nn = (lane >> 3) + 8 * j; const int n = n0 + nn; const LAS float* s = scr + (8 * c) * 33 + nn;
        bf16* rowp; float sc;
        if (n < nlim && dst(n, rowp, sc)) {
            v4u o; o.x = pk2(s[0 * 33] * sc, s[1 * 33] * sc); o.y = pk2(s[2 * 33] * sc, s[3 * 33] * sc); o.z = pk2(s[4 * 33] * sc, s[5 * 33] * sc); o.w = pk2(s[6 * 33] * sc, s[7 * 33] * sc);
            *(v4u*)(rowp + 8 * c) = o; } }
    LDS_WAIT(); asm volatile("" ::: "memory");
}
__device__ __forceinline__ int win_row(int n, float& sc) {
    sc = 1.f;
    if (n < 512) { sc = 0.08838834764831845f; return n; }
    if (n < 1024) return n;
    if (n < 2048) return n;
    if (n < 3072) return n;
    if (n < 3088) return 5120 + (n - 3072);
    if (n < 4112) { sc = 0.08838834764831845f; return 3072 + (n - 3088); }
    if (n < 4368) return 4096 + (n - 4112);
    if (n < 4624) return 4352 + (n - 4368);
    if (n < 4880) return 4608 + (n - 4624);
    if (n < 5136) return 5376 + (n - 4880);
    if (n < 5392) return 4864 + (n - 5136);
    if (n < 5648) return 5632 + (n - 5392);
    return 5136 + (n - 5648);
}
constexpr size_t WS_PEVP = WS_W2T;
__device__ __forceinline__ void p0_prologue(const Params& p, LAS unsigned char* lds, int gw, int NGW, int wave, int lane) {
    LAS float* scr = (LAS float*)(lds + wave * 16384);
    bf16* WinT = (bf16*)(p.ws + WS_WINT); bf16* WoT = (bf16*)(p.ws + WS_WOT); bf16* WkcT = (bf16*)(p.ws + WS_WKCT); bf16* WvcT = (bf16*)(p.ws + WS_WVCT);
    bf16* W1T = (bf16*)(p.ws + WS_W1T); bf16* W2T = (bf16*)(p.ws + WS_W2T);
    constexpr int I_IN = 32 * 178, I_O = 32 * 64, I_C = 64 * 4, I_E1 = 32 * 128, I_E2 = 32 * 64;
    constexpr int I_PE = 2 * 64;
    constexpr int NITEMS = I_O + 2 * I_C + I_PE;
    (void)I_IN; (void)WinT;
    for (int it = gw; it < NITEMS; it += NGW) {
        int r = it;
        if (r < I_O) { const int kb = r / 64, nb = r % 64, k0 = kb * 64;
            transpose_item(p.in[I_WOUT], DM, k0, nb * 32, DM, scr, lane, [&](int n, bf16*& rowp, float& sc) { sc = 1.f; rowp = WoT + (size_t)n * DM + k0; return true; }); continue; } r -= I_O;
        if (r >= 2 * I_C) { r -= 2 * I_C; const int which = r >> 6, kq = r & 63; const float* pe = p.in[which ? I_PEV : I_PEK] + kq * 64; const float* w1 = p.in[which ? I_WV1 : I_WK1] + (size_t)kq * 64 * 128 + lane;
            float a0 = 0.f, a1 = 0.f;
#pragma unroll
            for (int k = 0; k < 64; ++k) { const float pv = pe[k]; a0 += pv * w1[k * 128]; a1 += pv * w1[k * 128 + 64]; }
            float* dst = (float*)(p.ws + WS_PEVP) + (size_t)(which * 64 + kq) * 128 + lane; dst[0] = a0; dst[64] = a1; continue; }
        { const int which = r / I_C; r %= I_C; const int kb = r / 4, nb = r % 4, k0 = kb * 64;
            bf16* dstm = which ? WvcT : WkcT;
            transpose_item(p.in[which ? I_WV1 : I_WK1], 128, k0, nb * 32, 128, scr, lane, [&](int n, bf16*& rowp, float& sc) { sc = 1.f; rowp = dstm + (size_t)(n + (k0 >= 2048 ? 128 : 0)) * 2048 + (k0 & 2047); return true; }); }
        (void)I_E1; (void)I_E2; (void)W1T; (void)W2T;
    }
    const float* x = p.in[I_X]; const float* gm = p.in[I_NMIX];
    for (int m = gw; m < T; m += NGW) {
        const f32x4* xr = (const f32x4*)(x + (size_t)m * DM) + lane; f32x4 v[8]; float s = 0.f;
#pragma unroll
        for (int j = 0; j < 8; ++j) { v[j] = xr[64 * j]; s += (v[j].x * v[j].x + v[j].y * v[j].y) + (v[j].z * v[j].z + v[j].w * v[j].w); }
        const float rstd = 1.f / sqrtf(wave_sum(s) * (1.f / DM) + RMS_EPS);
        float mxr = 0.f;
#pragma unroll
        for (int j = 0; j < 8; ++j) { const f32x4 g4 = ((const f32x4*)gm)[lane + 64 * j]; v[j].x *= rstd * g4.x; v[j].y *= rstd * g4.y; v[j].z *= rstd * g4.z; v[j].w *= rstd * g4.w;
            mxr = fmaxf(mxr, fmaxf(fmaxf(fabsf(v[j].x), fabsf(v[j].y)), fmaxf(fabsf(v[j].z), fabsf(v[j].w)))); }
        mxr = wave_max(mxr); const float qs = mxr > 0.f ? mxr * (1.f / 127.f) : 1.f, qi = 1.f / qs;
        unsigned* o4 = (unsigned*)(p.ws + WS_XN + (size_t)m * DM) + lane;
#pragma unroll
        for (int j = 0; j < 8; ++j) { const float M = 12582912.f;
            const unsigned ua = __builtin_bit_cast(unsigned, v[j].x * qi + M), ub = __builtin_bit_cast(unsigned, v[j].y * qi + M), uc = __builtin_bit_cast(unsigned, v[j].z * qi + M), ud = __builtin_bit_cast(unsigned, v[j].w * qi + M);
            o4[64 * j] = __builtin_amdgcn_perm(ub, ua, 0x0c0c0400u) | (__builtin_amdgcn_perm(ud, uc, 0x0c0c0400u) << 16); }
        if (lane == 0) ((float*)(p.ws + WS_XN + (size_t)T * DM))[m] = qs;
    }
}
#define XB_TMO      128
#define XB_XCNT(j)  (256  + 64 * (j))
#define XB_XSUB(j)  (1280 + 64 * (j))
#define XB_XGEN(j)  (2304 + 64 * (j))
#define XB_TOP      3328
#define XB_TOPGEN   3392
#define XCD_BAR_WORDS 3456
#define XB_SPIN_CAP (1u << 18)

__device__ __forceinline__ unsigned xb_ld(unsigned* p)              { return __hip_atomic_load(p, __ATOMIC_RELAXED, __HIP_MEMORY_SCOPE_AGENT); }
__device__ __forceinline__ unsigned xb_add(unsigned* p, unsigned v) { return __hip_atomic_fetch_add(p, v, __ATOMIC_RELAXED, __HIP_MEMORY_SCOPE_AGENT); }
__device__ __forceinline__ unsigned xb_xcc_id() { return (unsigned)__builtin_amdgcn_s_getreg((3 << 11) | 20) & 0xFu; }
#define XB_SPIN(cond, bar) do { unsigned _sp = 0; while (cond) { __builtin_amdgcn_s_sleep(1); \
    if ((++_sp & 255u) == 0u) { if (xb_ld(&(bar)[XB_TMO])) break; if (_sp > XB_SPIN_CAP) { atomicAdd(&(bar)[XB_TMO], 1u); break; } } } } while (0)

struct XcdBarrier {
    unsigned* bar; unsigned x;
    volatile LAS unsigned* st;
};

__device__ __forceinline__ XcdBarrier xcd_barrier_post(unsigned* bar, volatile LAS unsigned* st) {
    XcdBarrier b; b.bar = bar; b.x = xb_xcc_id(); b.st = st;
    if (threadIdx.x == 0) (void)xb_add(&bar[XB_XCNT(b.x)], 1u);
    return b;
}
__device__ __forceinline__ void xcd_barrier_complete(unsigned* bar, unsigned x, unsigned& nloc, unsigned& nx) {
    const unsigned G = gridDim.x * gridDim.y * gridDim.z;
    unsigned sum, cnt, mine, sp = 0u;
    for (;;) {
        sum = 0u; cnt = 0u; mine = 0u;
#pragma unroll
        for (unsigned j = 0; j < 16; ++j) { const unsigned c = xb_ld(&bar[XB_XCNT(j)]); sum += c; cnt += (c > 0u) ? 1u : 0u; mine = (j == x) ? c : mine; }
        if (sum == G) break;
        __builtin_amdgcn_s_sleep(1);
        if ((++sp & 255u) == 0u) { if (xb_ld(&bar[XB_TMO])) break; if (sp > XB_SPIN_CAP) { atomicAdd(&bar[XB_TMO], 1u); break; } }
    }
    nloc = mine > 0u ? mine : 1u; nx = cnt > 0u ? cnt : 1u;
}

__device__ __forceinline__ void xcd_barrier(const XcdBarrier& b) {
    asm volatile("s_waitcnt vmcnt(0)" ::: "memory");
    __syncthreads();
    if (threadIdx.x == 0) {
        unsigned* bar = b.bar;
        __builtin_amdgcn_s_waitcnt(0);
        unsigned nloc = b.st[0], nx = b.st[1];
        if (nloc == 0u) { xcd_barrier_complete(bar, b.x, nloc, nx); b.st[0] = nloc; b.st[1] = nx; }
        const unsigned old = xb_add(&bar[XB_XSUB(b.x)], 1u);
        const unsigned gen = old / nloc;
        if (old + 1u == (gen + 1u) * nloc) {
            __builtin_amdgcn_fence(__ATOMIC_RELEASE, "agent");
            asm volatile("s_waitcnt vmcnt(0)" ::: "memory");
            const unsigned og = xb_add(&bar[XB_TOP], 1u);
            const unsigned tg = og / nx;
            if (og + 1u == (tg + 1u) * nx) xb_add(&bar[XB_TOPGEN], 1u);
            else XB_SPIN(xb_ld(&bar[XB_TOPGEN]) == tg, bar);
            __builtin_amdgcn_fence(__ATOMIC_ACQUIRE, "agent");
            xb_add(&bar[XB_XGEN(b.x)], 1u);
            asm volatile("s_waitcnt vmcnt(0)" ::: "memory");
        } else {
            XB_SPIN(xb_ld(&bar[XB_XGEN(b.x)]) == gen, bar);
            __builtin_amdgcn_fence(__ATOMIC_ACQUIRE, "agent");
            asm volatile("s_waitcnt vmcnt(0)" ::: "memory");
        }
    }
    __syncthreads();
}

struct ProjOrder : pg8::StaticOrder {
    const bf16* xn; const bf16* wt;
    __device__ __forceinline__ bool next(int i, pg8::Unit& u) const { if (!pg8::StaticOrder::next(i, u)) return false; u.kind = (u.pn >= 21) ? 1 : 0; return true; }
    __device__ __forceinline__ const char* pa(const pg8::Gemm& g, const pg8::Unit& u) const { return u.kind ? (const char*)wt + (size_t)u.pn * ((size_t)256 * g.K * 2) : (const char*)xn + (size_t)u.pm * ((size_t)256 * g.K * 2); }
    __device__ __forceinline__ const char* pb(const pg8::Gemm& g, const pg8::Unit& u) const { return u.kind ? (const char*)xn + (size_t)u.pm * ((size_t)256 * g.K * 2) : (const char*)wt + (size_t)u.pn * ((size_t)256 * g.K * 2); }
};
struct EpiRes {
    static constexpr bool PERM = true, AFTER_DRAIN = false;
    const float* x; bf16* h;
    __device__ __forceinline__ void operator()(const pg8::f32x4 (&acc)[2][2][4][2], const pg8::Unit& u, int wr, int wc, int fr, int fq) const {
        const int row0 = u.pm * 256 + wr * 64 + fr, col0 = u.pn * 256 + wc * 32 + 8 * fq;
#pragma unroll
        for (int ai = 0; ai < 2; ++ai)
#pragma unroll
            for (int m = 0; m < 4; ++m) { const size_t off = (size_t)(row0 + ai * 128 + m * 16) * DM + col0;
#pragma unroll
                for (int bj = 0; bj < 2; ++bj) { const pg8::f32x4 x0 = *(const pg8::f32x4*)(x + off + bj * 128), x1 = *(const pg8::f32x4*)(x + off + bj * 128 + 4);
                    const pg8::f32x4 a0 = x0 + acc[ai][bj][m][0], a1 = x1 + acc[ai][bj][m][1]; pg8::u32x4 w;
                    w.x = pg8::cvt_pk_bf16(a0.x, a0.y); w.y = pg8::cvt_pk_bf16(a0.z, a0.w); w.z = pg8::cvt_pk_bf16(a1.x, a1.y); w.w = pg8::cvt_pk_bf16(a1.z, a1.w);
                    *(pg8::u32x4*)(h + off + bj * 128) = w; } }
    }
};
struct MoeOrder {
    int nM, nN, nwg, G, c; const int* tile_exp;
    __device__ __forceinline__ void init(const int* meta, int nN_, int G_, int c_) { nM = meta[0]; nN = nN_; nwg = nM * nN; G = G_; c = c_; tile_exp = meta + 64; }
    __device__ __forceinline__ bool next(int i, pg8::Unit& u) const {
        const long L = (long)i * G + c; if (L >= nwg) return false;
        pg8::tile_of<8>((int)L, nM, nN, u.pm, u.pn); u.kind = tile_exp[u.pm]; return true;
    }
    __device__ __forceinline__ const char* pa(const pg8::Gemm& g, const pg8::Unit& u) const { return (const char*)g.A + (size_t)u.pm * ((size_t)256 * g.K * 2); }
    __device__ __forceinline__ const char* pb(const pg8::Gemm& g, const pg8::Unit& u) const { return (const char*)g.Bt + ((size_t)u.kind * nN + u.pn) * ((size_t)256 * g.K * 2); }
    __device__ __forceinline__ void a_ready(const pg8::Unit&) const {}
    __device__ __forceinline__ void done(const pg8::Unit&) const {}
};

struct MoeOrderG : MoeOrder { const unsigned short* rowtab;
    __device__ __forceinline__ const char* pa(const pg8::Gemm& g, const pg8::Unit&) const { return (const char*)g.A; } };

__device__ __forceinline__ float gelu_tanh(float x) { const float u = 0.7978845608028654f * (x + 0.044715f * x * x * x); const float e = __expf(2.f * u); return 0.5f * x * (1.f + (1.f - 2.f / (e + 1.f))); }
__device__ __forceinline__ void ph_cmp_fin(const Params& p, LAS unsigned char* lds, int bid, int G, int tid, const float* LHall, const float* PEVall) {
    const int grp = tid >> 7, n = tid & 127, ngrp = G * 4, total = 2 * 16 * 255, iters = (total + ngrp - 1) / ngrp;
    LAS float* hid = (LAS float*)lds + grp * 128;
    float pevs[2];
#pragma unroll
    for (int w = 0; w < 2; ++w) { float s = 0.f;
#pragma unroll 8
        for (int q = 0; q < 64; ++q) s += PEVall[(size_t)(w * 64 + q) * 128 + n];
        pevs[w] = s; }
    float wcol[128]; int wh = -1;
    for (int it = 0; it < iters; ++it) { int id = it * ngrp + bid * 4 + grp; if (id >= total) id = total - 1;
        const int which = id / (16 * 255), rem = id % (16 * 255), bg = rem / 255, c = rem % 255;
        if (which != wh) { const float* w2 = p.in[which ? I_WV2 : I_WK2]; wh = which;
#pragma unroll
            for (int mm = 0; mm < 128; ++mm) wcol[mm] = w2[mm * 128 + n]; }
        const float* LH = LHall + ((size_t)which * 4096 + bg * 256) * 256;
        const float a = LH[(size_t)c * 256 + n] + LH[(size_t)(c + 1) * 256 + 128 + n] + (which ? pevs[1] : pevs[0]);
        hid[n] = gelu_tanh(a);
        __syncthreads();
        float o0 = 0.f, o1 = 0.f, o2 = 0.f, o3 = 0.f;
#pragma unroll
        for (int m4 = 0; m4 < 32; ++m4) { const f32x4 hv = *(const LAS f32x4*)(hid + 4 * m4); o0 += hv.x * wcol[4 * m4]; o1 += hv.y * wcol[4 * m4 + 1]; o2 += hv.z * wcol[4 * m4 + 2]; o3 += hv.w * wcol[4 * m4 + 3]; }
        const float o = (o0 + o1) + (o2 + o3);
        if (which == 0) ((bf16*)(p.ws + WS_KCMP))[((size_t)bg * 256 + c) * 128 + n] = (bf16)f2bf(o);
        else ((bf16*)(p.ws + WS_VCMPT))[((size_t)bg * 128 + n) * 256 + c] = (bf16)f2bf(o);
        __syncthreads(); }
}

namespace nsa {
constexpr int KB0 = 0, KB1 = 16384, VB0 = 32768, VB1 = 49152, LUT = 65536;
constexpr int QST = LUT + 4096, IMP = QST + 65536, SELM = IMP + 16384, LDS_END = SELM + 512;
constexpr float LOG2E = 1.4426950408889634f;
typedef float f4 __attribute__((ext_vector_type(4)));

typedef unsigned u2v __attribute__((ext_vector_type(2)));
__device__ __forceinline__ float rmax16(float x) { const unsigned u = __float_as_uint(x); const u2v r = __builtin_amdgcn_permlane16_swap(u, u, false, false); return fmaxf(__uint_as_float(r[0]), __uint_as_float(r[1])); }
__device__ __forceinline__ float rmax32(float x) { const unsigned u = __float_as_uint(x); const u2v r = __builtin_amdgcn_permlane32_swap(u, u, false, false); return fmaxf(__uint_as_float(r[0]), __uint_as_float(r[1])); }
__device__ __forceinline__ float radd16(float x) { const unsigned u = __float_as_uint(x); const u2v r = __builtin_amdgcn_permlane16_swap(u, u, false, false); return __uint_as_float(r[0]) + __uint_as_float(r[1]); }
__device__ __forceinline__ float radd32(float x) { const unsigned u = __float_as_uint(x); const u2v r = __builtin_amdgcn_permlane32_swap(u, u, false, false); return __uint_as_float(r[0]) + __uint_as_float(r[1]); }
__device__ __forceinline__ float raddq(float x) { x += __int_as_float(__builtin_amdgcn_update_dpp(0, __float_as_int(x), 0xB1, 0xF, 0xF, true)); x += __int_as_float(__builtin_amdgcn_update_dpp(0, __float_as_int(x), 0x4E, 0xF, 0xF, true)); return x; }
struct Ctx {
    LAS unsigned char* lds; int tid, lane, wave, c, gq, r;
    int s0, cur;
    const LAS unsigned char* qst;
    int pos0;
    const LAS float* lutrow;
    int koff0, voff0;
    unsigned kdo[2], vdoc[2], vdos[2];
};
__device__ __forceinline__ void dma_k(const Ctx& C, const bf16* kt, LAS unsigned char* kb) {
#pragma unroll
    for (int i = 0; i < 2; ++i) __builtin_amdgcn_global_load_lds((const unsigned*)((const char*)kt + C.kdo[i]), (LAS unsigned*)(kb + (2 * C.wave + i) * 1024), 16, 0, 0); }
__device__ __forceinline__ void dma_v(const Ctx& C, const bf16* vt, const unsigned (&vdo)[2], LAS unsigned char* vb) {
#pragma unroll
    for (int i = 0; i < 2; ++i) __builtin_amdgcn_global_load_lds((const unsigned*)((const char*)vt + vdo[i]), (LAS unsigned*)(vb + (2 * C.wave + i) * 1024), 16, 0, 0); }

__device__ __forceinline__ void compute_st(const Ctx& C, const LAS unsigned char* kb, f4 (&s)[2][4]) {
#pragma unroll
    for (int ks = 0; ks < 4; ++ks) { const bf16x8 q0 = *(const LAS bf16x8*)(C.qst + ks * 1024), q1 = *(const LAS bf16x8*)(C.qst + (4 + ks) * 1024);
#pragma unroll
        for (int kt = 0; kt < 4; ++kt) { const bf16x8 a = *(const LAS bf16x8*)(kb + kt * 4096 + (C.koff0 ^ (ks * 64)));
            s[0][kt] = __builtin_amdgcn_mfma_f32_16x16x32_bf16(a, q0, ks == 0 ? (f4){0.f, 0.f, 0.f, 0.f} : s[0][kt], 0, 0, 0);
            s[1][kt] = __builtin_amdgcn_mfma_f32_16x16x32_bf16(a, q1, ks == 0 ? (f4){0.f, 0.f, 0.f, 0.f} : s[1][kt], 0, 0, 0); }
        asm volatile("" ::: "memory"); }
}
__device__ __forceinline__ void compute_pv(const Ctx& C, const LAS unsigned char* vb, const f4 (&p)[2][4], f4 (&o)[2][8]) {
#pragma unroll
    for (int i = 0; i < 2; ++i) { bf16x8 pb[2];
#pragma unroll
        for (int qt = 0; qt < 2; ++qt) { v4u w; w.x = pg8::cvt_pk_bf16(p[qt][2 * i][0], p[qt][2 * i][1]); w.y = pg8::cvt_pk_bf16(p[qt][2 * i][2], p[qt][2 * i][3]);
            w.z = pg8::cvt_pk_bf16(p[qt][2 * i + 1][0], p[qt][2 * i + 1][1]); w.w = pg8::cvt_pk_bf16(p[qt][2 * i + 1][2], p[qt][2 * i + 1][3]); pb[qt] = __builtin_bit_cast(bf16x8, w); }
#pragma unroll
        for (int dt = 0; dt < 8; ++dt) { const v2u lo = *(const LAS v2u*)(vb + dt * 2048 + (C.voff0 ^ (i * 64))), hi = *(const LAS v2u*)(vb + dt * 2048 + (C.voff0 ^ (i * 64 + 32))); const bf16x8 a = __builtin_bit_cast(bf16x8, (v4u){lo.x, lo.y, hi.x, hi.y});
#pragma unroll
            for (int qt = 0; qt < 2; ++qt) o[qt][dt] = __builtin_amdgcn_mfma_f32_16x16x32_bf16(a, pb[qt], o[qt][dt], 0, 0, 0);
            if (dt & 1) asm volatile("" ::: "memory"); } }
}
enum { M_CMP = 0, M_SEL = 1, M_WIN = 2 };
template <int MODE, bool FAR = false>
__device__ __forceinline__ void mask_bias(const Ctx& C, f4 (&s)[2][4], int kb, int n, const LAS unsigned* selw) {
    const float NEG = -__builtin_inff();
#pragma unroll
    for (int qt = 0; qt < 2; ++qt) {
        bool tokok = true;
        if (MODE == M_SEL) tokok = ((selw[(4 * qt + (C.c >> 2)) * 2 + (n >> 5)] >> (n & 31)) & 1u) != 0u;
        if (FAR) { const float be = tokok ? C.lutrow[127] : NEG;
#pragma unroll
            for (int kt = 0; kt < 4; ++kt)
#pragma unroll
                for (int rg = 0; rg < 4; ++rg) s[qt][kt][rg] = __builtin_fmaf(s[qt][kt][rg], LOG2E, be);
            continue; }
        const int dbase = (MODE == M_CMP) ? (C.pos0 + 4 * qt - 31 - 16 * (kb + 4 * C.gq)) : (C.pos0 + 4 * qt - (kb + 4 * C.gq));
#pragma unroll
        for (int kt = 0; kt < 4; ++kt) {
#pragma unroll
            for (int rg = 0; rg < 4; ++rg) { const int d = (MODE == M_CMP) ? dbase - 16 * (16 * kt + rg) : dbase - (16 * kt + rg);
                int di = d < 0 ? 0 : d; di = di > 127 ? 127 : di; const float bias = C.lutrow[di];
                bool ok = tokok && d >= 0; if (MODE == M_WIN) ok = ok && d < 512;
                s[qt][kt][rg] = ok ? __builtin_fmaf(s[qt][kt][rg], LOG2E, bias) : NEG; }
            asm volatile("" ::: "memory"); }
    }
}
__device__ __forceinline__ void softmax_step(f4 (&s)[2][4], float (&m)[2], float (&l)[2], f4 (&o)[2][8], bool rescale_o) {
#pragma unroll
    for (int qt = 0; qt < 2; ++qt) { float mx = s[qt][0][0];
#pragma unroll
        for (int kt = 0; kt < 4; ++kt)
#pragma unroll
            for (int rg = 0; rg < 4; ++rg) mx = fmaxf(mx, s[qt][kt][rg]);
        mx = rmax32(rmax16(mx));
        const float mn = fmaxf(m[qt], mx), alpha = __builtin_amdgcn_exp2f(m[qt] - mn); m[qt] = mn; float ps = 0.f;
#pragma unroll
        for (int kt = 0; kt < 4; ++kt)
#pragma unroll
            for (int rg = 0; rg < 4; ++rg) { const float e = __builtin_amdgcn_exp2f(s[qt][kt][rg] - mn); s[qt][kt][rg] = e; ps += e; }
        l[qt] = l[qt] * alpha + ps;
        if (rescale_o && __any(alpha != 1.f)) {
#pragma unroll
            for (int dt = 0; dt < 8; ++dt) o[qt][dt] = o[qt][dt] * alpha; }
    }
}
template <int MODE>
__device__ __forceinline__ void softmax_far(const Ctx& C, f4 (&s)[2][4], int n, const LAS unsigned* selw, float (&m)[2], float (&l)[2], f4 (&o)[2][8]) {
    const float b31 = C.lutrow[127];
#pragma unroll
    for (int qt = 0; qt < 2; ++qt) {
        float be = b31;
        if (MODE == M_SEL) { const bool tokok = ((selw[(4 * qt + (C.c >> 2)) * 2 + (n >> 5)] >> (n & 31)) & 1u) != 0u; be = tokok ? b31 : -__builtin_inff(); }
        float mx = fmaxf(fmaxf(s[qt][0][0], s[qt][0][1]), fmaxf(s[qt][0][2], s[qt][0][3]));
#pragma unroll
        for (int kt = 1; kt < 4; ++kt) mx = fmaxf(mx, fmaxf(fmaxf(s[qt][kt][0], s[qt][kt][1]), fmaxf(s[qt][kt][2], s[qt][kt][3])));
        mx = rmax32(rmax16(mx));
        const float mt = __builtin_fmaf(mx, LOG2E, be), mn = fmaxf(m[qt], mt), alpha = __builtin_amdgcn_exp2f(m[qt] - mn), c0 = be - mn; m[qt] = mn; float ps = 0.f;
#pragma unroll
        for (int kt = 0; kt < 4; ++kt)
#pragma unroll
            for (int rg = 0; rg < 4; ++rg) { const float e = __builtin_amdgcn_exp2f(__builtin_fmaf(s[qt][kt][rg], LOG2E, c0)); s[qt][kt][rg] = e; ps += e; }
        l[qt] = l[qt] * alpha + ps;
        if (__any(alpha != 1.f)) {
#pragma unroll
            for (int dt = 0; dt < 8; ++dt) o[qt][dt] = o[qt][dt] * alpha; }
    }
}
}

__device__ __forceinline__ void ph_nsa(const Params& p, LAS unsigned char* lds, int idx0, int idxstride, int tid_in, int wave) {
    using namespace nsa;
    int tid = tid_in; asm volatile("" : "+v"(tid));
    const int lane = tid & 63;
    Ctx C; C.lds = lds; C.tid = tid; C.lane = lane; C.wave = wave; C.c = lane & 15; C.gq = lane >> 4; C.r = lane & 3;
    C.koff0 = C.c * 256 + ((C.gq ^ C.c) * 16);
#pragma unroll
    for (int i = 0; i < 2; ++i) { const int piece = 2 * wave + i;
        { const int row = piece * 4 + (lane >> 4), chunk = (lane & 15) ^ (row & 15); C.kdo[i] = (unsigned)(row * 256 + chunk * 16); }
        { const int row = piece * 8 + (lane >> 3), chunk = (lane & 7) ^ ((row >> 1) & 7); C.vdoc[i] = (unsigned)(row * 256 * 2 + chunk * 16); C.vdos[i] = (unsigned)(row * SEQ * 2 + chunk * 16); } }
    C.voff0 = C.c * 128 + (((C.gq >> 1) ^ ((C.c >> 1) & 7)) * 16) + (C.gq & 1) * 8;
    const bf16* NQ = (const bf16*)(p.ws + WS_NQ); const bf16* SM = (const bf16*)(p.ws + WS_SM); bf16* A2 = (bf16*)(p.ws + WS_A2);
    const float* relb = p.in[I_RELB]; const float* nsag = p.in[I_NSAG];
    LAS float* lut = (LAS float*)(lds + LUT);
    for (int i = tid; i < 8 * 128; i += 512) { const int hh = i >> 7, d = i & 127; lut[i] = relb[(int)kBucket[d] * 8 + hh] * LOG2E; }
    __syncthreads();
    LAS unsigned char* qstw = lds + QST + wave * 8192 + lane * 16; C.qst = qstw;
    LAS float* imp = (LAS float*)(lds + IMP + wave * 2048);
    LAS unsigned long long* selm = (LAS unsigned long long*)(lds + SELM + wave * 64);
#define NSA_SYNC() do { asm volatile("s_waitcnt vmcnt(0)" ::: "memory"); __syncthreads(); } while (0)
    for (int idx = idx0; idx < 512; idx += idxstride) {
        const int rnd = idx >> 8, kq = idx & 255, b = kq & 7, tq = rnd == 0 ? 63 - (kq >> 3) : (kq >> 3);
        C.s0 = tq * 64; C.cur = tq;
        const int tokl0 = 8 * wave + (C.c >> 2);
        C.pos0 = C.s0 + tokl0;
        float ssq[2] = {0.f, 0.f};
        for (int g = 0; g < 2; ++g) {
            const int bg = b * 2 + g, h = g * 4 + C.r;
            C.lutrow = lut + h * 128;
            const bf16* KCMP = (const bf16*)(p.ws + WS_KCMP) + (size_t)bg * 256 * 128; const bf16* VCMPT = (const bf16*)(p.ws + WS_VCMPT) + (size_t)bg * 128 * 256;
#pragma unroll
            for (int qt = 0; qt < 2; ++qt) { const unsigned qo = (unsigned)(((b * SEQ + (C.pos0 + 4 * qt)) * 1024 + h * 128 + 8 * C.gq) * 2);
#pragma unroll
                for (int ks = 0; ks < 4; ++ks) *(LAS bf16x8*)(qstw + (qt * 4 + ks) * 1024) = *(const bf16x8*)((const char*)NQ + qo + ks * 64); }
#pragma unroll
            for (int i = 0; i < 2; ++i) *(LAS f32x4*)((LAS unsigned char*)imp + lane * 16 + i * 1024) = (f32x4){0.f, 0.f, 0.f, 0.f};
#define NSA_OROW(qt) ((char*)A2 + (unsigned)(((b * SEQ + C.pos0 + 4 * (qt)) * DM + 1024 + h * 128 + 4 * C.gq) * 2))
            const int cmaxb = C.s0 + 63 - 31; const int nct = cmaxb >= 0 ? ((cmaxb >> 4) >> 6) + 1 : 0;
            float m[2] = {-1e30f, -1e30f}, l[2] = {0.f, 0.f};
            f4 o[2][8];
            if (nct > 0) {
                dma_k(C, KCMP, lds + KB0); NSA_SYNC();
                for (int ct = 0; ct < nct; ++ct) { const int buf = ct & 1;
                    if (ct + 1 < nct) dma_k(C, KCMP + (ct + 1) * 64 * 128, lds + (buf ? KB0 : KB1));
                    f4 s[2][4]; compute_st(C, lds + (buf ? KB1 : KB0), s); mask_bias<M_CMP>(C, s, 64 * ct, 0, (const LAS unsigned*)selm); softmax_step(s, m, l, o, false);
                    NSA_SYNC(); }
            }
            float inv[2];
#pragma unroll
            for (int qt = 0; qt < 2; ++qt) { const float lt = radd32(radd16(l[qt])); inv[qt] = lt > 0.f ? 1.f / lt : 0.f; }
#pragma unroll
            for (int qt = 0; qt < 2; ++qt)
#pragma unroll
                for (int dt = 0; dt < 8; ++dt) o[qt][dt] = (f4){0.f, 0.f, 0.f, 0.f};
            if (nct > 0) {
                dma_k(C, KCMP, lds + KB0); dma_v(C, VCMPT, C.vdoc, lds + VB0); NSA_SYNC();
                for (int ct = 0; ct < nct; ++ct) { const int buf = ct & 1;
                    if (ct + 1 < nct) { dma_k(C, KCMP + (ct + 1) * 64 * 128, lds + (buf ? KB0 : KB1)); dma_v(C, VCMPT + 64 * (ct + 1), C.vdoc, lds + (buf ? VB0 : VB1)); }
                    f4 s[2][4]; compute_st(C, lds + (buf ? KB1 : KB0), s); mask_bias<M_CMP>(C, s, 64 * ct, 0, (const LAS unsigned*)selm);
#pragma unroll
                    for (int qt = 0; qt < 2; ++qt)
#pragma unroll
                        for (int kt = 0; kt < 4; ++kt) {
#pragma unroll
                            for (int rg = 0; rg < 4; ++rg) s[qt][kt][rg] = __builtin_amdgcn_exp2f(s[qt][kt][rg] - m[qt]) * inv[qt];
                            float po = (s[qt][kt][0] + s[qt][kt][1]) + (s[qt][kt][2] + s[qt][kt][3]), p3 = s[qt][kt][3];
                            po = raddq(po); p3 = raddq(p3);
                            const int nb = 16 * ct + 4 * kt + C.gq, tl = 4 * qt + (C.c >> 2);
                            if (C.r == 0) { __hip_atomic_fetch_add((float*)(imp + tl * 64 + nb), po, __ATOMIC_RELAXED, __HIP_MEMORY_SCOPE_WORKGROUP); if (nb + 1 < 64) __hip_atomic_fetch_add((float*)(imp + tl * 64 + nb + 1), p3, __ATOMIC_RELAXED, __HIP_MEMORY_SCOPE_WORKGROUP); } }
                    compute_pv(C, lds + (buf ? VB1 : VB0), s, o);
                    NSA_SYNC(); }
            }
            LDS_WAIT(); __builtin_amdgcn_wave_barrier();
            for (int tk = 0; tk < 8; ++tk) { const int n = lane; float sc;
                if (n == 0 || n == C.cur || n == C.cur - 1) sc = 1e4f; else if (n <= C.cur) sc = imp[tk * 64 + n]; else sc = -1.f;
                const int key = ((sc < 0.f ? 0 : __float_as_int(sc) + 64) & ~63) | (63 - n);
                int rank = 0;
#pragma unroll
                for (int mm = 0; mm < 64; ++mm) rank += (__builtin_amdgcn_readlane(key, mm) > key) ? 1 : 0;
                const unsigned long long mk = __ballot(rank < 16);
                if (lane == 0) selm[tk] = mk; }
            LDS_WAIT(); __builtin_amdgcn_wave_barrier();
#pragma unroll
            for (int qt = 0; qt < 2; ++qt) { const float gt = 1.f / (1.f + __expf(-bf2f(*(const bf16*)((const char*)SM + (unsigned)(((b * SEQ + (C.pos0 + 4 * qt)) * 64 + 16 + h) * 2)))));
#pragma unroll
                for (int dt = 0; dt < 8; ++dt) { const f4 v = o[qt][dt] * gt; *(v2u*)(NSA_OROW(qt) + 32 * dt) = (v2u){pg8::cvt_pk_bf16(v[0], v[1]), pg8::cvt_pk_bf16(v[2], v[3])}; } }
#pragma unroll
            for (int br = 1; br <= 2; ++br) {
                const bf16* KX = (const bf16*)(p.ws + (br == 1 ? WS_KS : WS_KW)) + bg * SEQ * 128; const bf16* VX = (const bf16*)(p.ws + (br == 1 ? WS_VST : WS_VWT)) + bg * 128 * SEQ;
                const int n0 = br == 1 ? 0 : (C.cur >= 8 ? C.cur - 8 : 0), n1 = C.cur;
                m[0] = m[1] = -1e30f; l[0] = l[1] = 0.f;
#pragma unroll
                for (int qt = 0; qt < 2; ++qt)
#pragma unroll
                    for (int dt = 0; dt < 8; ++dt) o[qt][dt] = (f4){0.f, 0.f, 0.f, 0.f};
                int f0 = n1 + 1, f1 = n0 - 1;
                for (int n = n0; n <= n1; ++n) { const bool fa = (C.s0 - (64 * n + 63) >= 113) && (br == 1 || (C.s0 + 63 - 64 * n) < 512); if (fa) { f0 = n < f0 ? n : f0; f1 = n; } }
                const int cntf = f1 >= f0 ? f1 - f0 + 1 : 0, cnt = n1 - n0 + 1, nlo = cntf ? f0 - n0 : cnt;
#define NSA_TILE(i) ((i) < cntf ? f0 + (i) : (((i) - cntf) < nlo ? n0 + ((i) - cntf) : f1 + 1 + ((i) - cntf - nlo)))
#define NSA_BODY(FARF) { const int n = NSA_TILE(i); const int buf = i & 1; \
                    if (i + 1 < cnt) { const int nn = NSA_TILE(i + 1); dma_k(C, KX + nn * 64 * 128, lds + (buf ? KB0 : KB1)); dma_v(C, VX + 64 * nn, C.vdos, lds + (buf ? VB0 : VB1)); } \
                    bool need = true; \
                    if (br == 1) { const unsigned any = ((const LAS unsigned*)selm)[(lane & 7) * 2 + (n >> 5)] >> (n & 31); need = __any((int)(any & 1u)); } \
                    if (need) { f4 s[2][4]; compute_st(C, lds + (buf ? KB1 : KB0), s); \
                        if (FARF) { if (br == 1) softmax_far<M_SEL>(C, s, n, (const LAS unsigned*)selm, m, l, o); else softmax_far<M_WIN>(C, s, n, (const LAS unsigned*)selm, m, l, o); } \
                        else { if (br == 1) mask_bias<M_SEL, false>(C, s, 64 * n, n, (const LAS unsigned*)selm); else mask_bias<M_WIN, false>(C, s, 64 * n, n, (const LAS unsigned*)selm); \
                            softmax_step(s, m, l, o, true); } \
                        compute_pv(C, lds + (buf ? VB1 : VB0), s, o); } \
                    NSA_SYNC(); }
                { const int nf = NSA_TILE(0); dma_k(C, KX + nf * 64 * 128, lds + KB0); dma_v(C, VX + 64 * nf, C.vdos, lds + VB0); NSA_SYNC(); }
                int i = 0;
                for (; i < cntf; ++i) NSA_BODY(true)
                for (; i < cnt; ++i) NSA_BODY(false)
#undef NSA_BODY
#undef NSA_TILE
                asm volatile("s_waitcnt vmcnt(0)" ::: "memory");
#pragma unroll
                for (int qt = 0; qt < 2; ++qt) { const float lt = radd32(radd16(l[qt]));
                    const int row = b * SEQ + (C.pos0 + 4 * qt);
                    const float sc = (1.f / (1.f + __expf(-bf2f(*(const bf16*)((const char*)SM + (unsigned)((row * 64 + 16 + 8 * br + h) * 2)))))) / lt;
#pragma unroll
                    for (int dt = 0; dt < 8; ++dt) { const f4 v = o[qt][dt] * sc; v2u* sp = (v2u*)(NSA_OROW(qt) + 32 * dt); const v2u pv = *sp;
                        const float a0 = bflo(pv.x) + v[0], a1 = bfhi(pv.x) + v[1], a2 = bflo(pv.y) + v[2], a3 = bfhi(pv.y) + v[3];
                        if (br == 2) ssq[qt] += (a0 * a0 + a1 * a1) + (a2 * a2 + a3 * a3);
                        *sp = (v2u){pg8::cvt_pk_bf16(a0, a1), pg8::cvt_pk_bf16(a2, a3)}; } }
            }
        }
        float rstd[2];
#pragma unroll
        for (int qt = 0; qt < 2; ++qt) { const float t = radd32(radd16(raddq(ssq[qt]))); rstd[qt] = 1.f / sqrtf(t * (1.f / 1024.f) + RMS_EPS); }
        asm volatile("s_waitcnt vmcnt(0)" ::: "memory");
#pragma unroll
        for (int qt = 0; qt < 2; ++qt) { const int sub = C.r * 4 + C.gq; bf16* orow = (bf16*)((char*)A2 + (unsigned)(((b * SEQ + (C.pos0 + 4 * qt)) * DM + 1024) * 2 + sub * 16)); const int subz = 0;
#pragma unroll
            for (int j = 0; j < 8; ++j) { const int col = (j * 16 + subz) * 8; v4u w = *(const v4u*)((const char*)orow + (unsigned)(col * 2)); const f32x4 g0 = *(const f32x4*)((const char*)nsag + (unsigned)(col * 4 + sub * 32)), g1 = *(const f32x4*)((const char*)nsag + (unsigned)(col * 4 + sub * 32 + 16)); const float rs = rstd[qt];
                w.x = pk2(bflo(w.x) * rs * g0.x, bfhi(w.x) * rs * g0.y); w.y = pk2(bflo(w.y) * rs * g0.z, bfhi(w.y) * rs * g0.w); w.z = pk2(bflo(w.z) * rs * g1.x, bfhi(w.z) * rs * g1.y); w.w = pk2(bflo(w.w) * rs * g1.z, bfhi(w.w) * rs * g1.w);
                *(v4u*)((char*)orow + (unsigned)(col * 2)) = w; } }
        NSA_SYNC();
    }
#undef NSA_SYNC
#undef NSA_OROW
}

constexpr size_t WS_ST = WS_LA;
constexpr size_t WS_DEC = WS_ST + (size_t)2048 * 256 * 128 * 2;
static_assert(WS_DEC + (size_t)2048 * 128 * 4 <= WS_KCMP, "gla scratch overlay");
namespace gla {
typedef float f4 __attribute__((ext_vector_type(4)));
constexpr int L_ST = 0, L_KT = 65536, L_QT = 81920, L_VT = 98304, L_GA = 131072, L_GT = L_GA + 4096, L_RED = L_GT + 2048, L_END = L_RED + 512;
struct CumIn { float w[16]; float bb; v4u sm; };
__device__ __forceinline__ CumIn load_cum(const Params& p, int tid, int t0, int h) { CumIn x;
    const bf16* SM = (const bf16*)(p.ws + WS_SM); const float* wa2 = p.in[I_WA2]; const float* ba = p.in[I_BA]; const int dk = tid & 127;
    x.sm = (v4u){0u, 0u, 0u, 0u};
    if (tid < 128) { const int j = tid >> 1, hf = tid & 1; x.sm = *(const v4u*)((const char*)SM + (unsigned)(((t0 + j) * 64 + hf * 8) * 2)); }
#pragma unroll
    for (int r = 0; r < 16; ++r) x.w[r] = wa2[r * 512 + h * 128 + dk];
    x.bb = ba[h * 128 + dk];
    return x; }
__device__ __forceinline__ void chunk_cumsum(const CumIn& in, LAS unsigned char* lds, int tid, float (&P)[16], float& blast) {
    LAS float* ga = (LAS float*)(lds + L_GA); LAS float* gt = (LAS float*)(lds + L_GT);
    if (tid < 128) { const int j = tid >> 1, hf = tid & 1; const v4u w = in.sm;
        LAS float* d = ga + j * 16 + hf * 8; d[0] = bflo(w.x); d[1] = bfhi(w.x); d[2] = bflo(w.y); d[3] = bfhi(w.y); d[4] = bflo(w.z); d[5] = bfhi(w.z); d[6] = bflo(w.w); d[7] = bfhi(w.w); }
    const int dk = tid & 127, jq = tid >> 7;
    const float bb = in.bb;
    __syncthreads();
    float run = 0.f;
#pragma unroll
    for (int jj = 0; jj < 16; ++jj) { const LAS f32x4* gr = (const LAS f32x4*)(ga + (16 * jq + jj) * 16); float z = bb;
#pragma unroll
        for (int r4 = 0; r4 < 4; ++r4) { const f32x4 g4 = gr[r4]; z += g4.x * in.w[4 * r4] + g4.y * in.w[4 * r4 + 1] + g4.z * in.w[4 * r4 + 2] + g4.w * in.w[4 * r4 + 3]; }
        run += (fminf(z, 0.f) - __logf(1.f + __expf(-fabsf(z)))) * (1.f / 16.f);   P[jj] = run; }
    gt[jq * 128 + dk] = run;
    __syncthreads();
    float off = 0.f, tot = 0.f;
#pragma unroll
    for (int q = 0; q < 4; ++q) { const float t = gt[q * 128 + dk]; tot += t; if (q < jq) off += t; }
#pragma unroll
    for (int jj = 0; jj < 16; ++jj) P[jj] += off;
    blast = tot;
}
struct RawK { v4u r[2]; }; struct RawV { v4u r[4]; };
__device__ __forceinline__ RawK load_raw_k(const bf16* src  , int tid, int t0, int h) { RawK x;
#pragma unroll
    for (int q = 0; q < 2; ++q) { const int id = tid + 512 * q, j = id >> 4, c16 = id & 15; x.r[q] = *(const v4u*)((const char*)src + (unsigned)(((t0 + j) * 512 + h * 128 + c16 * 8) * 2)); }
    return x; }
__device__ __forceinline__ void store_raw_k(LAS unsigned char* dst, int tid, const RawK& x) {
#pragma unroll
    for (int q = 0; q < 2; ++q) { const int id = tid + 512 * q, j = id >> 4, c16 = id & 15; *(LAS v4u*)(dst + j * 256 + c16 * 16) = x.r[q]; } }
__device__ __forceinline__ RawV load_raw_v(const Params& p, int tid, int t0, int h) { const bf16* GV = (const bf16*)(p.ws + WS_GV); RawV x;
#pragma unroll
    for (int q = 0; q < 4; ++q) { const int id = tid + 512 * q, j = id >> 5, c = id & 31; x.r[q] = *(const v4u*)((const char*)GV + (unsigned)(((t0 + j) * 1024 + h * 256 + c * 8) * 2)); }
    return x; }
__device__ __forceinline__ void store_raw_v(LAS unsigned char* dst, int tid, const RawV& x) {
#pragma unroll
    for (int q = 0; q < 4; ++q) { const int id = tid + 512 * q, j = id >> 5, c = id & 31; *(LAS v4u*)(dst + j * 512 + c * 16) = x.r[q]; } }
__device__ __forceinline__ void fill_vt(LAS unsigned char* lds, const LAS unsigned char* rv, int tid) {
    const int dv = tid & 255, jh = tid >> 8;
    unsigned short v[32];
#pragma unroll
    for (int jj = 0; jj < 32; ++jj) v[jj] = *(const LAS bf16*)(rv + (32 * jh + jj) * 512 + dv * 2);
    LAS unsigned char* row = lds + L_VT + dv * 128; const int f = (dv >> 1) & 7;
#pragma unroll
    for (int q = 0; q < 4; ++q) { v4u w; w.x = v[8 * q] | ((unsigned)v[8 * q + 1] << 16); w.y = v[8 * q + 2] | ((unsigned)v[8 * q + 3] << 16); w.z = v[8 * q + 4] | ((unsigned)v[8 * q + 5] << 16); w.w = v[8 * q + 6] | ((unsigned)v[8 * q + 7] << 16);
        *(LAS v4u*)(row + (((4 * jh + q) ^ f) * 16)) = w; }
}
}

__device__ __forceinline__ void ph_gla_a(const Params& p, LAS unsigned char* lds, int u0, int ustride, int tid_in, int wave) {
    using namespace gla;
    int tid = tid_in; asm volatile("" : "+v"(tid));
    const int lane = tid & 63, c = lane & 15, gq = lane >> 4;
    const bf16* GK = (const bf16*)(p.ws + WS_GK); bf16* ST = (bf16*)(p.ws + WS_ST); float* DEC = (float*)(p.ws + WS_DEC);
    RawK rk; RawV rv;
    CumIn ci;
    if (u0 < 2048) { const int bh = u0 >> 6, ch = u0 & 63; rk = load_raw_k(GK, tid, (bh >> 2) * SEQ + ch * 64, bh & 3); rv = load_raw_v(p, tid, (bh >> 2) * SEQ + ch * 64, bh & 3); ci = load_cum(p, tid, (bh >> 2) * SEQ + ch * 64, bh & 3); }
    for (int unit = u0; unit < 2048; unit += ustride) {
        const int bh = unit >> 6, ch = unit & 63, b = bh >> 2, h = bh & 3, t0 = b * SEQ + ch * 64;
        store_raw_k(lds + 0, tid, rk); store_raw_v(lds + 16384, tid, rv);
        float P[16], blast; chunk_cumsum(ci, lds, tid, P, blast);
        { const int dk = tid & 127, jq = tid >> 7;
          unsigned short kv[16];
#pragma unroll
          for (int jj = 0; jj < 16; ++jj) kv[jj] = *(const LAS bf16*)(lds + (16 * jq + jj) * 256 + dk * 2);
          unsigned pk[8];
#pragma unroll
          for (int q = 0; q < 8; ++q) pk[q] = pk2(bf2f(kv[2 * q]) * __expf(blast - P[2 * q]), bf2f(kv[2 * q + 1]) * __expf(blast - P[2 * q + 1]));
          LAS unsigned char* row = lds + L_KT + dk * 128; const int f = (dk >> 1) & 7;
          *(LAS v4u*)(row + (((2 * jq) ^ f) * 16)) = (v4u){pk[0], pk[1], pk[2], pk[3]}; *(LAS v4u*)(row + (((2 * jq + 1) ^ f) * 16)) = (v4u){pk[4], pk[5], pk[6], pk[7]};
          if (jq == 0) DEC[unit * 128 + dk] = __expf(blast); }
        fill_vt(lds, lds + 16384, tid);
        __syncthreads();
        { const int un = unit + ustride < 2048 ? unit + ustride : unit, bhn = un >> 6, chn = un & 63; rk = load_raw_k(GK, tid, (bhn >> 2) * SEQ + chn * 64, bhn & 3); rv = load_raw_v(p, tid, (bhn >> 2) * SEQ + chn * 64, bhn & 3); ci = load_cum(p, tid, (bhn >> 2) * SEQ + chn * 64, bhn & 3); }
        f4 acc[16];
        const int f = (c >> 1) & 7;
        bf16x8 aF[2];
#pragma unroll
        for (int ks = 0; ks < 2; ++ks) aF[ks] = *(const LAS bf16x8*)(lds + L_KT + (16 * wave + c) * 128 + (((4 * ks + gq) ^ f) * 16));
#pragma unroll
        for (int nt = 0; nt < 16; ++nt) { acc[nt] = (f4){0.f, 0.f, 0.f, 0.f};
#pragma unroll
            for (int ks = 0; ks < 2; ++ks) { const bf16x8 bF = *(const LAS bf16x8*)(lds + L_VT + (16 * nt + c) * 128 + (((4 * ks + gq) ^ f) * 16)); acc[nt] = __builtin_amdgcn_mfma_f32_16x16x32_bf16(aF[ks], bF, acc[nt], 0, 0, 0); } }
        char* dst = (char*)ST + (size_t)unit * (256 * 128 * 2) + (unsigned)((c * 128 + 16 * wave + 4 * gq) * 2);
#pragma unroll
        for (int nt = 0; nt < 16; ++nt) *(v2u*)(dst + nt * 16 * 256) = (v2u){pg8::cvt_pk_bf16(acc[nt][0], acc[nt][1]), pg8::cvt_pk_bf16(acc[nt][2], acc[nt][3])};
        __syncthreads();
    }
}
__device__ __forceinline__ void ph_gla_b(const Params& p, int gid, int gstride) {
    bf16* ST = (bf16*)(p.ws + WS_ST); const float* DEC = (const float*)(p.ws + WS_DEC);
    for (int e = gid; e < 32 * 4096; e += gstride) { const int bh = e >> 12, dv = (e >> 4) & 255, d8 = e & 15;
        float st[8];
#pragma unroll
        for (int i = 0; i < 8; ++i) st[i] = 0.f;
        char* base = (char*)ST + (size_t)bh * 64 * (256 * 128 * 2) + (unsigned)((dv * 128 + d8 * 8) * 2); const float* dbase = DEC + (size_t)bh * 64 * 128 + d8 * 8;
#pragma unroll 4
        for (int ch = 0; ch < 64; ++ch) { v4u* ptr = (v4u*)(base + (size_t)ch * (256 * 128 * 2)); const v4u w = *ptr; const f32x4 d0 = *(const f32x4*)(dbase + ch * 128), d1 = *(const f32x4*)(dbase + ch * 128 + 4);
            v4u o; o.x = pk2(st[0], st[1]); o.y = pk2(st[2], st[3]); o.z = pk2(st[4], st[5]); o.w = pk2(st[6], st[7]); *ptr = o;
            st[0] = st[0] * d0.x + bflo(w.x); st[1] = st[1] * d0.y + bfhi(w.x); st[2] = st[2] * d0.z + bflo(w.y); st[3] = st[3] * d0.w + bfhi(w.y);
            st[4] = st[4] * d1.x + bflo(w.z); st[5] = st[5] * d1.y + bfhi(w.z); st[6] = st[6] * d1.z + bflo(w.w); st[7] = st[7] * d1.w + bfhi(w.w); }
    }
}
__device__ __forceinline__ void ph_gla_c(const Params& p, LAS unsigned char* lds, int u0, int ustride, int tid_in, int wave) {
    using namespace gla;
    int tid = tid_in; asm volatile("" : "+v"(tid));
    const int lane = tid & 63, c = lane & 15, gq = lane >> 4, nt = wave & 3, half = wave >> 2;
    const bf16* GQ = (const bf16*)(p.ws + WS_GQ); const bf16* GK = (const bf16*)(p.ws + WS_GK); const bf16* GG = (const bf16*)(p.ws + WS_GG); const bf16* ST = (const bf16*)(p.ws + WS_ST);
    bf16* A2 = (bf16*)(p.ws + WS_A2); const float* gn = p.in[I_GLAG];
    const int koff0 = c * 256 + ((gq ^ c) * 16), voff0 = c * 128 + (((gq >> 1) ^ ((c >> 1) & 7)) * 16) + (gq & 1) * 8;
    CumIn ci; RawK rq, rk; RawV rv;
    if (u0 < 2048) { const int bh = u0 >> 6, ch = u0 & 63, t0 = (bh >> 2) * SEQ + ch * 64; rq = load_raw_k(GQ, tid, t0, bh & 3); rk = load_raw_k(GK, tid, t0, bh & 3); rv = load_raw_v(p, tid, t0, bh & 3); ci = load_cum(p, tid, t0, bh & 3); }
    for (int unit = u0; unit < 2048; unit += ustride) {
        const int bh = unit >> 6, ch = unit & 63, b = bh >> 2, h = bh & 3, t0 = b * SEQ + ch * 64;
        store_raw_k(lds + 0, tid, rq); store_raw_k(lds + 16384, tid, rk); store_raw_v(lds + 32768, tid, rv);
        float P[16], blast; chunk_cumsum(ci, lds, tid, P, blast);
        { const int dk = tid & 127, jq = tid >> 7;
#pragma unroll
          for (int jj = 0; jj < 16; ++jj) { const int j = 16 * jq + jj; const float qv = bf2f(*(const LAS bf16*)(lds + j * 256 + dk * 2)), kv = bf2f(*(const LAS bf16*)(lds + 16384 + j * 256 + dk * 2));
              const int off = j * 256 + (((dk >> 3) ^ (j & 15)) * 16) + (dk & 7) * 2;
              *(LAS bf16*)(lds + L_QT + off) = (bf16)f2bf(qv * __expf(P[jj])); *(LAS bf16*)(lds + L_KT + off) = (bf16)f2bf(kv * __expf(-P[jj])); } }
        fill_vt(lds, lds + 32768, tid);
        __syncthreads();
        { const char* src = (const char*)ST + (size_t)unit * (256 * 128 * 2);
#pragma unroll
          for (int i = 0; i < 8; ++i) { const int piece = 8 * wave + i, row = piece * 4 + (lane >> 4), chunk = (lane & 15) ^ (row & 15);
              __builtin_amdgcn_global_load_lds((const unsigned*)(src + (unsigned)(row * 256 + chunk * 16)), (LAS unsigned*)(lds + L_ST + piece * 1024), 16, 0, 0); } }
        v2u ggr[8];
        { const int tokg = t0 + 16 * nt + c;
#pragma unroll
          for (int mt = 0; mt < 8; ++mt) ggr[mt] = *(const v2u*)((const char*)GG + (unsigned)((tokg * 1024 + h * 256 + 128 * half + 16 * mt + 4 * gq) * 2)); }
        asm volatile("s_waitcnt vmcnt(0)" ::: "memory"); __syncthreads();
        { const int un = unit + ustride < 2048 ? unit + ustride : unit, bhn = un >> 6, chn = un & 63, tn = (bhn >> 2) * SEQ + chn * 64; rq = load_raw_k(GQ, tid, tn, bhn & 3); rk = load_raw_k(GK, tid, tn, bhn & 3); rv = load_raw_v(p, tid, tn, bhn & 3); ci = load_cum(p, tid, tn, bhn & 3); }
        bf16x8 qF[4];
#pragma unroll
        for (int ks = 0; ks < 4; ++ks) qF[ks] = *(const LAS bf16x8*)(lds + L_QT + nt * 4096 + (koff0 ^ (ks * 64)));
        f4 sT[4];
#pragma unroll
        for (int jt = 0; jt < 4; ++jt) { sT[jt] = (f4){0.f, 0.f, 0.f, 0.f};
            if (jt <= nt) {
#pragma unroll
                for (int ks = 0; ks < 4; ++ks) { const bf16x8 a = *(const LAS bf16x8*)(lds + L_KT + jt * 4096 + (koff0 ^ (ks * 64))); sT[jt] = __builtin_amdgcn_mfma_f32_16x16x32_bf16(a, qF[ks], sT[jt], 0, 0, 0); }
                if (jt == nt) {
#pragma unroll
                    for (int rg = 0; rg < 4; ++rg) if (4 * gq + rg > c) sT[jt][rg] = 0.f; } } }
        bf16x8 pb[2];
#pragma unroll
        for (int s = 0; s < 2; ++s) { v4u w; w.x = pg8::cvt_pk_bf16(sT[2 * s][0], sT[2 * s][1]); w.y = pg8::cvt_pk_bf16(sT[2 * s][2], sT[2 * s][3]); w.z = pg8::cvt_pk_bf16(sT[2 * s + 1][0], sT[2 * s + 1][1]); w.w = pg8::cvt_pk_bf16(sT[2 * s + 1][2], sT[2 * s + 1][3]); pb[s] = __builtin_bit_cast(bf16x8, w); }
        f4 o[8]; float ss = 0.f;
#pragma unroll
        for (int mt = 0; mt < 8; ++mt) { o[mt] = (f4){0.f, 0.f, 0.f, 0.f}; const int rb = 128 * half + 16 * mt;
#pragma unroll
            for (int ks = 0; ks < 4; ++ks) { const bf16x8 a = *(const LAS bf16x8*)(lds + L_ST + rb * 256 + (koff0 ^ (ks * 64))); o[mt] = __builtin_amdgcn_mfma_f32_16x16x32_bf16(a, qF[ks], o[mt], 0, 0, 0); }
#pragma unroll
            for (int s = 0; s < 2; ++s) if (2 * s <= nt) { const v2u lo = *(const LAS v2u*)(lds + L_VT + rb * 128 + (voff0 ^ (s * 64))), hi = *(const LAS v2u*)(lds + L_VT + rb * 128 + (voff0 ^ (s * 64 + 32)));
                o[mt] = __builtin_amdgcn_mfma_f32_16x16x32_bf16(__builtin_bit_cast(bf16x8, (v4u){lo.x, lo.y, hi.x, hi.y}), pb[s], o[mt], 0, 0, 0); }
            ss += (o[mt][0] * o[mt][0] + o[mt][1] * o[mt][1]) + (o[mt][2] * o[mt][2] + o[mt][3] * o[mt][3]); }
        ss = nsa::radd32(nsa::radd16(ss));
        LAS float* red = (LAS float*)(lds + L_RED);
        if (gq == 0) red[half * 64 + 16 * nt + c] = ss;
        __syncthreads();
        const float rstd = 1.f / sqrtf((red[16 * nt + c] + red[64 + 16 * nt + c]) * (1.f / 256.f) + RMS_EPS);
        const int tok = t0 + 16 * nt + c;
#pragma unroll
        for (int mt = 0; mt < 8; ++mt) { const int dv = 128 * half + 16 * mt + 4 * gq; const f32x4 g4 = *(const f32x4*)((const char*)gn + (unsigned)(dv * 4));
            const v2u gg = ggr[mt];
            const float z0 = bflo(gg.x), z1 = bfhi(gg.x), z2 = bflo(gg.y), z3 = bfhi(gg.y);
            v2u w; w.x = pg8::cvt_pk_bf16(o[mt][0] * rstd * g4.x * (z0 * __builtin_amdgcn_rcpf(1.f + __expf(-z0))), o[mt][1] * rstd * g4.y * (z1 * __builtin_amdgcn_rcpf(1.f + __expf(-z1))));
            w.y = pg8::cvt_pk_bf16(o[mt][2] * rstd * g4.z * (z2 * __builtin_amdgcn_rcpf(1.f + __expf(-z2))), o[mt][3] * rstd * g4.w * (z3 * __builtin_amdgcn_rcpf(1.f + __expf(-z3))));
            *(v2u*)((char*)A2 + (unsigned)((tok * DM + h * 256 + dv) * 2)) = w; }
        __syncthreads();
    }
}

constexpr size_t WS_LH = WS_DEC + (size_t)2048 * 128 * 4;
constexpr size_t WS_PEV = WS_LH + (size_t)2 * 4096 * 256 * 4;
static_assert(WS_PEV + 1024 <= WS_KCMP, "cmp scratch overlay");
struct CmpOrder {
    int c; const bf16 *kc, *vc, *wk, *wv;
    __device__ __forceinline__ bool next(int i, pg8::Unit& u) const { if (i > 0 || c >= 32) return false; u.pm = c & 15; u.pn = 0; u.kind = c >> 4; return true; }
    __device__ __forceinline__ const char* pa(const pg8::Gemm&, const pg8::Unit& u) const { return (const char*)(u.kind ? vc : kc) + (size_t)u.pm * ((size_t)256 * 2048 * 2); }
    __device__ __forceinline__ const char* pb(const pg8::Gemm&, const pg8::Unit& u) const { return (const char*)(u.kind ? wv : wk); }
    __device__ __forceinline__ void a_ready(const pg8::Unit&) const {}
    __device__ __forceinline__ void done(const pg8::Unit&) const {}
};
struct EpiLH {
    static constexpr bool PERM = false, AFTER_DRAIN = false;
    float* LH;
    __device__ __forceinline__ void operator()(const pg8::f32x4 (&acc)[2][2][4][2], const pg8::Unit& u, int wr, int wc, int fr, int fq) const {
        const int row0 = u.kind * 4096 + u.pm * 256 + wr * 64 + fr, col0 = wc * 32 + 4 * fq;
#pragma unroll
        for (int ai = 0; ai < 2; ++ai)
#pragma unroll
            for (int m = 0; m < 4; ++m) { float* rowp = LH + (size_t)(row0 + ai * 128 + m * 16) * 256 + col0;
#pragma unroll
                for (int bj = 0; bj < 2; ++bj)
#pragma unroll
                    for (int n = 0; n < 2; ++n) *(pg8::f32x4*)(rowp + bj * 128 + n * 16) = acc[ai][bj][m][n]; }
    }
};

constexpr size_t PROWS = (size_t)MAXTILES * 256;
constexpr size_t WS_W1Q = WS_W1T;
constexpr size_t WS_W2Q = WS_W1Q + (size_t)NE * 4096 * DM;
constexpr size_t WS_HN8 = WS_W2Q + (size_t)NE * DM * DFF;
constexpr size_t WS_AMAXP = WS_HN8 + (size_t)T * DM;
constexpr size_t WS_WSC1 = WS_AMAXP + PROWS * 64 * 4;
constexpr size_t WS_WSC2 = WS_WSC1 + (size_t)NE * 4096 * 4;
constexpr size_t WS_HSC = WS_WSC2 + (size_t)NE * 2048 * 4;
constexpr size_t WS_ROWSC = WS_HSC + (size_t)T * 4;
constexpr size_t WS_ASC = WS_ROWSC + PROWS * 4;
static_assert(WS_ASC + PROWS * 4 <= WS_XN, "int8 buffers fit in the retired bf16 expert-weight region");
constexpr size_t WS_ROWTOK = WS_CTL + 512 * 1024;
static_assert(PROWS * 2 <= 512 * 1024 && DM == 2048, "row table fits; gathered rows are 2048 bytes");
constexpr size_t WS_H16 = WS_XG;
static_assert((size_t)T * DM * 2 <= PROWS * DM, "h fits below ACT8");
constexpr size_t WS_XG8 = WS_XG;
constexpr size_t WS_ACT8 = WS_XG + PROWS * DM;
constexpr size_t WS_Y = WS_ACT;
static_assert(WS_ACT8 + PROWS * DM <= WS_ACT, "int8 row buffers fit in the retired gathered-row region");

__device__ __forceinline__ unsigned q8x4(float a, float b, float c, float d) {
    const float M = 12582912.f; const unsigned ua = __builtin_bit_cast(unsigned, a + M), ub = __builtin_bit_cast(unsigned, b + M), uc = __builtin_bit_cast(unsigned, c + M), ud = __builtin_bit_cast(unsigned, d + M);
    return __builtin_amdgcn_perm(ub, ua, 0x0c0c0400u) | (__builtin_amdgcn_perm(ud, uc, 0x0c0c0400u) << 16); }
__device__ __forceinline__ float clamp127(float v) { return __builtin_amdgcn_fmed3f(v, -127.f, 127.f); }
__device__ __forceinline__ unsigned q8x4c(float a, float b, float c, float d) { return q8x4(clamp127(a), clamp127(b), clamp127(c), clamp127(d)); }

constexpr size_t WS_WINQ = WS_WINT;
constexpr size_t WS_WISC = WS_WINT + (size_t)NPT * 256 * DM;
constexpr size_t WS_XN8 = WS_XN;
constexpr size_t WS_XSC = WS_XN + (size_t)T * DM;
constexpr size_t WS_PMAX = WS_HN;
constexpr size_t WS_PMAXI = WS_PMAX + (size_t)64 * 8 * 4096 * 4;

constexpr int NSLAB_E = NE * 192, NSLAB = NSLAB_E + 178;
struct SlabSrc { const float* W; int N; bool ok; };
__device__ __forceinline__ SlabSrc slab_src(const Params& p, int sl, int r0, int n4) {
    SlabSrc s;
    if (sl < NSLAB_E) { const int e = sl / 192, r = sl % 192; const bool isw2 = r >= 128; const int nb = isw2 ? r - 128 : r; s.N = isw2 ? 2048 : 4096;
        s.W = (isw2 ? p.in[I_W2] + (size_t)e * DFF * DM : p.in[I_W1] + (size_t)e * DM * 4096) + (size_t)r0 * s.N + nb * 32 + 4 * n4; s.ok = true; }
    else { const int nb = sl - NSLAB_E; s.N = 5672; s.ok = nb * 32 + 4 * n4 < 5672; s.W = p.in[I_WIN] + (size_t)r0 * 5672 + (s.ok ? nb * 32 + 4 * n4 : 0); }
    return s;
}
__device__ __forceinline__ void p0_slab_quant(const Params& p, LAS unsigned char* lds, int bid, int G, int tid) {
    constexpr int RS = 4104;
    LAS unsigned char* TT = lds; LAS float* part = (LAS float*)(lds + 32 * RS); LAS float* inv = part + 64 * 32; LAS int* drow = (LAS int*)(inv + 32);
    signed char* W1Q = (signed char*)(p.ws + WS_W1Q); signed char* W2Q = (signed char*)(p.ws + WS_W2Q); signed char* WIQ = (signed char*)(p.ws + WS_WINQ);
    float* WSC1 = (float*)(p.ws + WS_WSC1); float* WSC2 = (float*)(p.ws + WS_WSC2); float* WISC = (float*)(p.ws + WS_WISC);
    const int n4 = tid & 7, r0 = tid >> 3;
    f32x4 va[8], vb[8];
#define SLAB_ISSUE(dst, sl, j) do { if ((sl) < NSLAB) { const SlabSrc ss_ = slab_src(p, (sl), 2 * r0, n4); _Pragma("unroll") for (int u = 0; u < 8; ++u) dst[u] = __builtin_nontemporal_load((const f32x4*)(ss_.W + (size_t)(128 * (4 * (j) + (u >> 1)) + (u & 1)) * ss_.N)); } } while (0)
#define SLAB_USE(src, j) do { _Pragma("unroll") for (int u2 = 0; u2 < 4; ++u2) { const f32x4 xa = src[2 * u2], xb = src[2 * u2 + 1]; const int k = 2 * r0 + 128 * (4 * (j) + u2);        \
            const unsigned w0 = cvt2bf(xa.x, xb.x), w1 = cvt2bf(xa.y, xb.y), w2 = cvt2bf(xa.z, xb.z), w3 = cvt2bf(xa.w, xb.w);        \
            mx0 = __builtin_elementwise_max(mx0, __builtin_bit_cast(u16x2, w0 & 0x7fff7fffu)); mx1 = __builtin_elementwise_max(mx1, __builtin_bit_cast(u16x2, w1 & 0x7fff7fffu)); \
            mx2 = __builtin_elementwise_max(mx2, __builtin_bit_cast(u16x2, w2 & 0x7fff7fffu)); mx3 = __builtin_elementwise_max(mx3, __builtin_bit_cast(u16x2, w3 & 0x7fff7fffu)); \
            LAS unsigned char* d = TT + (4 * n4) * RS + k * 2; \
            *(LAS unsigned*)d = w0; *(LAS unsigned*)(d + RS) = w1; *(LAS unsigned*)(d + 2 * RS) = w2; *(LAS unsigned*)(d + 3 * RS) = w3; } } while (0)
    SLAB_ISSUE(va, bid, 0); SLAB_ISSUE(vb, bid, 1);
    for (int slab = bid; slab < NSLAB; slab += G) {
        u16x2 mx0 = (u16x2){0, 0}, mx1 = (u16x2){0, 0}, mx2 = (u16x2){0, 0}, mx3 = (u16x2){0, 0};
        SLAB_USE(va, 0); SLAB_ISSUE(va, slab, 2);
        SLAB_USE(vb, 1); SLAB_ISSUE(vb, slab, 3);
        SLAB_USE(va, 2); SLAB_ISSUE(va, slab + G, 0);
        SLAB_USE(vb, 3); SLAB_ISSUE(vb, slab + G, 1);
        { u16x2 t0, t1; { const unsigned m0 = __builtin_bit_cast(unsigned, mx0), m1 = __builtin_bit_cast(unsigned, mx1), m2 = __builtin_bit_cast(unsigned, mx2), m3 = __builtin_bit_cast(unsigned, mx3);
            t0 = __builtin_elementwise_max(__builtin_bit_cast(u16x2, __builtin_amdgcn_perm(m1, m0, 0x05040100u)), __builtin_bit_cast(u16x2, __builtin_amdgcn_perm(m1, m0, 0x07060302u)));
            t1 = __builtin_elementwise_max(__builtin_bit_cast(u16x2, __builtin_amdgcn_perm(m3, m2, 0x05040100u)), __builtin_bit_cast(u16x2, __builtin_amdgcn_perm(m3, m2, 0x07060302u))); }
#pragma unroll
          for (int o = 8; o < 64; o <<= 1) { t0 = __builtin_elementwise_max(t0, __builtin_bit_cast(u16x2, __shfl_xor(__builtin_bit_cast(int, t0), o))); t1 = __builtin_elementwise_max(t1, __builtin_bit_cast(u16x2, __shfl_xor(__builtin_bit_cast(int, t1), o))); }
          const unsigned a0 = __builtin_bit_cast(unsigned, t0), a1 = __builtin_bit_cast(unsigned, t1);
          if ((tid & 63) < 8) *(LAS f32x4*)(part + (tid >> 6) * 32 + 4 * n4) = (f32x4){bflo(a0), bfhi(a0), bflo(a1), bfhi(a1)}; }
        __syncthreads();
        if (tid < 32) { float m = 0.f;
#pragma unroll
            for (int q = 0; q < 8; ++q) m = fmaxf(m, part[q * 32 + tid]);
            const float sc = m > 0.f ? m * (1.f / 127.f) : 1.f; inv[tid] = 1.f / sc;
            if (slab < NSLAB_E) { const int e = slab / 192, r = slab % 192; const bool isw2 = r >= 128; const int n = (isw2 ? r - 128 : r) * 32 + tid;
                if (isw2) { drow[tid] = e * 2048 + n; WSC2[e * 2048 + n] = sc; }
                else { const int j2 = n & 2047, row = (j2 >> 7) * 256 + (n >= 2048 ? 128 : 0) + (j2 & 127); drow[tid] = e * 4096 + row; WSC1[e * 4096 + row] = sc; } }
            else { const int n = (slab - NSLAB_E) * 32 + tid; if (n < 5672) { float qsc; const int row = win_row(n, qsc); drow[tid] = row; WISC[row] = sc * qsc; } else drow[tid] = -1; } }
        __syncthreads();
        { const int kc = tid & 7, n = (tid >> 3) & 31, hf = tid >> 8; const float iv = inv[n]; const int dr = drow[n];
          signed char* dst = (slab < NSLAB_E ? ((slab % 192) >= 128 ? W2Q : W1Q) : WIQ) + (size_t)(dr < 0 ? 0 : dr) * 2048; const LAS unsigned char* src = TT + n * RS;
          if (dr >= 0) {
#pragma unroll
          for (int m8 = 0; m8 < 8; ++m8) { const int k0 = 16 * (kc + 8 * (hf + 2 * m8)); const LAS v2u* sp = (const LAS v2u*)(src + k0 * 2); const v2u a = sp[0], b = sp[1], c = sp[2], d = sp[3]; v4u o;
              o.x = q8x4(bflo(a.x) * iv, bfhi(a.x) * iv, bflo(a.y) * iv, bfhi(a.y) * iv); o.y = q8x4(bflo(b.x) * iv, bfhi(b.x) * iv, bflo(b.y) * iv, bfhi(b.y) * iv);
              o.z = q8x4(bflo(c.x) * iv, bfhi(c.x) * iv, bflo(c.y) * iv, bfhi(c.y) * iv); o.w = q8x4(bflo(d.x) * iv, bfhi(d.x) * iv, bflo(d.y) * iv, bfhi(d.y) * iv);
              *(v4u*)(dst + k0) = o; } } }
        __syncthreads();
    }
#undef SLAB_ISSUE
#undef SLAB_USE
}
struct EpiSwigluI8 {
    static constexpr bool PERM = true, AFTER_DRAIN = false;
    const float* b1; const float* rowsc; const float* wsc1; bf16* act; float* amaxp;
    __device__ __forceinline__ void operator()(const pg8::f32x4 (&acc)[2][2][4][2], const pg8::Unit& u, int wr, int wc, int fr, int fq) const {
        const int e = u.kind; const int cin = wc * 32 + 8 * fq; const int col = u.pn * 128 + cin; const int row0 = u.pm * 256 + wr * 64 + fr;
        const float* bg = b1 + (size_t)e * 4096 + col; const float* bl = bg + 2048; const float* sg = wsc1 + (size_t)e * 4096 + u.pn * 256 + cin; const float* sl = sg + 128;
        float gb[8], lb[8], gs[8], ls[8];
#pragma unroll
        for (int j = 0; j < 8; ++j) { gb[j] = bg[j]; lb[j] = bl[j]; gs[j] = sg[j]; ls[j] = sl[j]; }
#pragma unroll
        for (int ai = 0; ai < 2; ++ai)
#pragma unroll
            for (int m = 0; m < 4; ++m) { const int r = row0 + ai * 128 + m * 16; const float rs = rowsc[r]; float o[8]; float mx = 0.f;
#pragma unroll
                for (int n = 0; n < 2; ++n)
#pragma unroll
                    for (int j = 0; j < 4; ++j) { float gl = (float)__float_as_int(acc[ai][0][m][n][j]) * (rs * gs[n * 4 + j]) + gb[n * 4 + j]; float li = (float)__float_as_int(acc[ai][1][m][n][j]) * (rs * ls[n * 4 + j]) + lb[n * 4 + j];
                        gl = fminf(gl, 7.f); li = fminf(fmaxf(li, -7.f), 7.f);
                        const float v = gl * __builtin_amdgcn_rcpf(1.f + __builtin_amdgcn_exp2f(-2.4554669595930156f * gl)) * (li + 1.f); o[n * 4 + j] = v; mx = fmaxf(mx, fabsf(v)); }
                mx = nsa::rmax32(nsa::rmax16(mx));
                if (fq == 0) amaxp[(size_t)r * 64 + u.pn * 4 + wc] = mx;
                pg8::u32x4 w; w.x = pg8::cvt_pk_bf16(o[0], o[1]); w.y = pg8::cvt_pk_bf16(o[2], o[3]); w.z = pg8::cvt_pk_bf16(o[4], o[5]); w.w = pg8::cvt_pk_bf16(o[6], o[7]);
                *(pg8::u32x4*)(act + (size_t)r * DFF + col) = w; }
    }
};
__device__ __forceinline__ void ph_actq(const Params& p, int gw, int NGW, int lane) {
    const int nrows = ((const int*)(p.ws + WS_META))[0] * 256; const float* amaxp = (const float*)(p.ws + WS_AMAXP); const bf16* act = (const bf16*)(p.ws + WS_ACT);
    signed char* A8 = (signed char*)(p.ws + WS_ACT8); float* ASC = (float*)(p.ws + WS_ASC);
    for (int rb = gw; rb < nrows; rb += 2 * NGW) {
        const int r0 = rb, r1 = rb + NGW; const bool h1 = r1 < nrows; const int r1c = h1 ? r1 : r0;
        float m0 = amaxp[(size_t)r0 * 64 + lane], m1 = amaxp[(size_t)r1c * 64 + lane];
        const v4u* s0 = (const v4u*)(act + (size_t)r0 * DFF) + lane * 4; const v4u* s1 = (const v4u*)(act + (size_t)r1c * DFF) + lane * 4; v4u a[2][4];
#pragma unroll
        for (int j = 0; j < 4; ++j) { a[0][j] = s0[j]; a[1][j] = s1[j]; }
        m0 = wave_max(m0); m1 = wave_max(m1);
#pragma unroll
        for (int q = 0; q < 2; ++q) { const int r = q ? r1 : r0; if (q && !h1) break; const float mx = q ? m1 : m0; const float sc = mx > 0.f ? mx * (1.f / 127.f) : 1.f, iv = 1.f / sc; v4u o[2];
#pragma unroll
            for (int h = 0; h < 2; ++h) { const v4u x = a[q][2 * h], y = a[q][2 * h + 1];
                o[h].x = q8x4c(bflo(x.x) * iv, bfhi(x.x) * iv, bflo(x.y) * iv, bfhi(x.y) * iv); o[h].y = q8x4c(bflo(x.z) * iv, bfhi(x.z) * iv, bflo(x.w) * iv, bfhi(x.w) * iv);
                o[h].z = q8x4c(bflo(y.x) * iv, bfhi(y.x) * iv, bflo(y.y) * iv, bfhi(y.y) * iv); o[h].w = q8x4c(bflo(y.z) * iv, bfhi(y.z) * iv, bflo(y.w) * iv, bfhi(y.w) * iv); }
            v4u* dst = (v4u*)(A8 + (size_t)r * DFF) + lane * 2; dst[0] = o[0]; dst[1] = o[1];
            if (lane == 0) ASC[r] = sc; } }
}
struct EpiDownI8 {
    static constexpr bool PERM = true, AFTER_DRAIN = false;
    const float* b2; const float* roww; const float* asc; const float* wsc2; bf16* y;
    __device__ __forceinline__ void operator()(const pg8::f32x4 (&acc)[2][2][4][2], const pg8::Unit& u, int wr, int wc, int fr, int fq) const {
        const int e = u.kind; const int col0 = u.pn * 256 + wc * 32 + 8 * fq; const int row0 = u.pm * 256 + wr * 64 + fr;
        float bv[2][8], sv[2][8];
#pragma unroll
        for (int bj = 0; bj < 2; ++bj)
#pragma unroll
            for (int j = 0; j < 8; ++j) { bv[bj][j] = b2[(size_t)e * DM + col0 + bj * 128 + j]; sv[bj][j] = wsc2[(size_t)e * DM + col0 + bj * 128 + j]; }
#pragma unroll
        for (int ai = 0; ai < 2; ++ai)
#pragma unroll
            for (int m = 0; m < 4; ++m) { const int r = row0 + ai * 128 + m * 16; const float g = roww[r], as = asc[r];
#pragma unroll
                for (int bj = 0; bj < 2; ++bj) { float o[8];
#pragma unroll
                    for (int n = 0; n < 2; ++n)
#pragma unroll
                        for (int j = 0; j < 4; ++j) o[n * 4 + j] = ((float)__float_as_int(acc[ai][bj][m][n][j]) * (as * sv[bj][n * 4 + j]) + bv[bj][n * 4 + j]) * g;
                    pg8::u32x4 w; w.x = pg8::cvt_pk_bf16(o[0], o[1]); w.y = pg8::cvt_pk_bf16(o[2], o[3]); w.z = pg8::cvt_pk_bf16(o[4], o[5]); w.w = pg8::cvt_pk_bf16(o[6], o[7]);
                    *(pg8::u32x4*)(y + (size_t)r * DM + col0 + bj * 128) = w; } }
    }
};

struct EpiProjI8 {
    static constexpr bool PERM = true, AFTER_DRAIN = false;
    unsigned char* ws;
    __device__ __forceinline__ void operator()(const pg8::f32x4 (&acc)[2][2][4][2], const pg8::Unit& u, int wr, int wc, int fr, int fq) const {
        const int cw = wc * 32 + 8 * fq; const float* XSC = (const float*)(ws + WS_XSC); const float* WISC = (const float*)(ws + WS_WISC);
        if (u.kind == 0) {
            const int tn = u.pn; bf16* base; size_t bjs = 128; int ld = 0; bool headmajor = false; bool small = false;
            if (tn < 2) { base = (bf16*)(ws + WS_GQ) + tn * 256; ld = 512; }
            else if (tn < 4) { base = (bf16*)(ws + WS_GK) + (tn - 2) * 256; ld = 512; }
            else if (tn < 8) { base = (bf16*)(ws + WS_GV) + (tn - 4) * 256; ld = 1024; }
            else if (tn < 12) { base = (bf16*)(ws + WS_GG) + (tn - 8) * 256; ld = 1024; }
            else if (tn < 16) { base = (bf16*)(ws + WS_NQ) + (tn - 12) * 256; ld = 1024; }
            else if (tn < 20) { base = (bf16*)(ws + (tn == 16 ? WS_KC : tn == 17 ? WS_VC : tn == 18 ? WS_KS : WS_KW)); headmajor = true; bjs = (size_t)SEQ * 128; }
            else { base = (bf16*)(ws + WS_SM); ld = 64; small = true; }
            if (small && wc >= 2) return;
            float cs[2][8];
#pragma unroll
            for (int bj = 0; bj < 2; ++bj)
#pragma unroll
                for (int j = 0; j < 8; ++j) cs[bj][j] = WISC[tn * 256 + bj * 128 + cw + j];
#pragma unroll
            for (int ai = 0; ai < 2; ++ai)
#pragma unroll
                for (int m = 0; m < 4; ++m) { const int r = u.pm * 256 + ai * 128 + wr * 64 + m * 16 + fr; const float rs = XSC[r];
                    const size_t rterm = headmajor ? ((size_t)(r >> 12) * 2 * SEQ + (r & (SEQ - 1))) * 128 : (size_t)r * ld;
#pragma unroll
                    for (int bj = 0; bj < 2; ++bj) { if (small && bj) continue; float o[8];
#pragma unroll
                        for (int n = 0; n < 2; ++n)
#pragma unroll
                            for (int j = 0; j < 4; ++j) o[n * 4 + j] = (float)__float_as_int(acc[ai][bj][m][n][j]) * (rs * cs[bj][n * 4 + j]);
                        pg8::u32x4 w; w.x = pg8::cvt_pk_bf16(o[0], o[1]); w.y = pg8::cvt_pk_bf16(o[2], o[3]); w.z = pg8::cvt_pk_bf16(o[4], o[5]); w.w = pg8::cvt_pk_bf16(o[6], o[7]);
                        *(pg8::u32x4*)(base + rterm + bj * bjs + cw) = w; } }
        } else {
            bf16* base = (bf16*)(ws + (u.pn == 21 ? WS_VST : WS_VWT));
#pragma unroll
            for (int ai = 0; ai < 2; ++ai)
#pragma unroll
                for (int m = 0; m < 4; ++m) { const int dh = wr * 64 + m * 16 + fr; const float ws_ = WISC[u.pn * 256 + ai * 128 + dh];
#pragma unroll
                    for (int bj = 0; bj < 2; ++bj) { const int tok = u.pm * 256 + bj * 128 + cw; const int b = tok >> 12, s = tok & (SEQ - 1); float o[8];
                        const pg8::f32x4 x0 = *(const pg8::f32x4*)(XSC + tok), x1 = *(const pg8::f32x4*)(XSC + tok + 4);
#pragma unroll
                        for (int j = 0; j < 4; ++j) { o[j] = (float)__float_as_int(acc[ai][bj][m][0][j]) * (ws_ * x0[j]); o[4 + j] = (float)__float_as_int(acc[ai][bj][m][1][j]) * (ws_ * x1[j]); }
                        pg8::u32x4 w; w.x = pg8::cvt_pk_bf16(o[0], o[1]); w.y = pg8::cvt_pk_bf16(o[2], o[3]); w.z = pg8::cvt_pk_bf16(o[4], o[5]); w.w = pg8::cvt_pk_bf16(o[6], o[7]);
                        *(pg8::u32x4*)(base + ((size_t)(b * 2 + ai) * 128 + dh) * SEQ + s) = w; } }
        }
    }
};

__device__ __forceinline__ void r1_router(const Params& p, LAS unsigned char* lds, int vb, int tid, int wave, int lane) {
    LAS float* rowbuf = (LAS float*)lds;
    LAS float* part = (LAS float*)(lds + 65536);
    LAS int* tk = (LAS int*)(lds + 81920 + wave * 1024);
    LAS int* cntw = (LAS int*)(lds + 90112);
    const bf16* h = (const bf16*)(p.ws + WS_H16); const float* gf = p.in[I_NFFN]; const float* rw = p.in[I_RW]; const float* rb = p.in[I_RB];
    signed char* HN8 = (signed char*)(p.ws + WS_HN8);
    const int e = lane & 31, eg = tid & 31, dg = tid >> 5; int mycount = 0;
    float rwr[128];
#pragma unroll
    for (int c4 = 0; c4 < 4; ++c4) { unsigned o = (unsigned)((((dg * 128 + c4 * 32) * 32) + eg) * 4); asm volatile("" : "+v"(o));
#pragma unroll
        for (int i = 0; i < 32; ++i) rwr[c4 * 32 + i] = *(const float*)((const char*)rw + o + i * 128); }
    v4u hw[4];
    { const v4u* xr = (const v4u*)(h + (size_t)(vb * TPV + wave) * DM) + lane;
#pragma unroll
      for (int q = 0; q < 4; ++q) hw[q] = xr[64 * q]; }
    for (int grp = 0; grp < 16; ++grp) { const int t = vb * TPV + grp * 8 + wave;
        { float s = 0.f;
#pragma unroll
          for (int q = 0; q < 4; ++q) { const float a0 = bflo(hw[q].x), a1 = bfhi(hw[q].x), a2 = bflo(hw[q].y), a3 = bfhi(hw[q].y), a4 = bflo(hw[q].z), a5 = bfhi(hw[q].z), a6 = bflo(hw[q].w), a7 = bfhi(hw[q].w);
              s += ((a0 * a0 + a1 * a1) + (a2 * a2 + a3 * a3)) + ((a4 * a4 + a5 * a5) + (a6 * a6 + a7 * a7)); }
          const float rstd = 1.f / sqrtf(wave_sum(s) * (1.f / DM) + RMS_EPS);
          float mxr = 0.f; LAS f32x4* hrow = (LAS f32x4*)(rowbuf + wave * 2048);
#pragma unroll
          for (int j = 0; j < 8; ++j) { const int cj = 2 * lane + 128 * (j >> 1) + (j & 1); const f32x4 g4 = ((const f32x4*)gf)[cj]; const unsigned wa = (j & 1) ? hw[j >> 1].z : hw[j >> 1].x, wb = (j & 1) ? hw[j >> 1].w : hw[j >> 1].y;
              f32x4 y; y.x = bflo(wa) * rstd * g4.x; y.y = bfhi(wa) * rstd * g4.y; y.z = bflo(wb) * rstd * g4.z; y.w = bfhi(wb) * rstd * g4.w;
              hrow[cj] = y; mxr = fmaxf(mxr, fmaxf(fmaxf(fabsf(y.x), fabsf(y.y)), fmaxf(fabsf(y.z), fabsf(y.w)))); }
          mxr = wave_max(mxr); const float qs = mxr > 0.f ? mxr * (1.f / 127.f) : 1.f, qi = 1.f / qs;
          v2u* o8 = (v2u*)(HN8 + (size_t)t * DM) + lane;
#pragma unroll
          for (int q = 0; q < 4; ++q) { const f32x4 ya = hrow[2 * lane + 128 * q], yb = hrow[2 * lane + 128 * q + 1]; v2u o;
              o.x = q8x4(ya.x * qi, ya.y * qi, ya.z * qi, ya.w * qi); o.y = q8x4(yb.x * qi, yb.y * qi, yb.z * qi, yb.w * qi); o8[64 * q] = o; }
          if (lane == 0) ((float*)(p.ws + WS_HSC))[t] = qs; }
        __syncthreads();
        { const int tn = vb * TPV + (grp < 15 ? grp + 1 : grp) * 8 + wave; const v4u* xr = (const v4u*)(h + (size_t)tn * DM) + lane;
#pragma unroll
          for (int q = 0; q < 4; ++q) hw[q] = xr[64 * q]; }
        { float acc[8];
#pragma unroll
          for (int tt = 0; tt < 8; ++tt) acc[tt] = 0.f;
#pragma unroll
          for (int i4 = 0; i4 < 32; ++i4) { f32x4 xv[8];
#pragma unroll
              for (int tt = 0; tt < 8; ++tt) xv[tt] = *(const LAS f32x4*)(rowbuf + tt * 2048 + dg * 128 + 4 * i4);
#pragma unroll
              for (int tt = 0; tt < 8; ++tt) acc[tt] += xv[tt].x * rwr[4 * i4] + xv[tt].y * rwr[4 * i4 + 1] + xv[tt].z * rwr[4 * i4 + 2] + xv[tt].w * rwr[4 * i4 + 3];
              if (i4 & 1) asm volatile("" ::: "memory"); }
#pragma unroll
          for (int tt = 0; tt < 8; ++tt) part[(dg * 8 + tt) * 32 + eg] = acc[tt]; }
        __syncthreads();
        { float a = rb[e];
#pragma unroll
          for (int q = 0; q < 16; ++q) a += part[(q * 8 + wave) * 32 + e];
          int rank = 0;
#pragma unroll
          for (int mm = 0; mm < 32; ++mm) { const float lm = __shfl(a, mm); rank += (lm > a || (lm == a && mm < e)) ? 1 : 0; }
          const float mx = wave_max(a); const bool sel = rank < 4;
          const float ex = (sel && lane < 32) ? __expf(a - mx) : 0.f; const float sum = wave_sum(ex);
          if (sel && lane < 32) { LAS int* q = tk + (grp * 4 + rank) * 4; q[0] = e; q[1] = mycount; q[2] = __builtin_bit_cast(int, ex / sum); ++mycount; } }
        __syncthreads();
    }
    int ln; asm volatile("v_mbcnt_lo_u32_b32 %0, -1, 0\n\tv_mbcnt_hi_u32_b32 %0, -1, %0" : "=v"(ln));
    if (ln < 32) cntw[wave * 32 + ln] = mycount;
    __syncthreads();
    if (wave == 0 && ln < 32) { int tot = 0; for (int w = 0; w < 8; ++w) tot += cntw[w * 32 + ln]; ((int*)(p.ws + WS_CNT))[vb * 32 + ln] = tot; }
    { const int i = ln >> 2, k = ln & 3; const LAS int* q = tk + (i * 4 + k) * 4; const int ee = q[0]; int base = 0; for (int w = 0; w < wave; ++w) base += cntw[w * 32 + ee];
      const int t = vb * TPV + i * 8 + wave;
      ((int*)(p.ws + WS_EIDX))[t * 4 + k] = ee; ((int*)(p.ws + WS_LRNK))[t * 4 + k] = base + q[1]; ((int*)(p.ws + WS_GATE))[t * 4 + k] = q[2]; }
    __syncthreads();
}
__device__ __forceinline__ void r2_gather(const Params& p, LAS unsigned char* lds, int vb, bool write_meta, int tid, int wave, int lane) {
    LAS int* part_tot = (LAS int*)lds;
    LAS int* part_base = part_tot + 512;
    LAS int* pbase = part_base + 512;
    const int* CNT = (const int*)(p.ws + WS_CNT);
    { const int e = tid & 31, part = tid >> 5; int tot = 0, bs = 0;
      for (int v = part * 16; v < part * 16 + 16; ++v) { const int c = CNT[v * 32 + e]; tot += c; if (v < vb) bs += c; }
      part_tot[part * 32 + e] = tot; part_base[part * 32 + e] = bs; }
    __syncthreads();
    if (tid == 0) { int ps = 0; int* meta = (int*)(p.ws + WS_META); int nt = 0;
        for (int e = 0; e < 32; ++e) { int tot = 0, bs = 0; for (int q = 0; q < 16; ++q) { tot += part_tot[q * 32 + e]; bs += part_base[q * 32 + e]; }
            pbase[e] = ps + bs; const int ntile = (tot + 255) >> 8;
            if (write_meta) for (int q = 0; q < ntile; ++q) meta[64 + nt + q] = e;
            nt += ntile; ps += ntile * 256; }
        if (write_meta) meta[0] = nt; }
    __syncthreads();
    const float* HSC = (const float*)(p.ws + WS_HSC); float* ROWSC = (float*)(p.ws + WS_ROWSC);
    const int* EIDX = (const int*)(p.ws + WS_EIDX); const int* LRNK = (const int*)(p.ws + WS_LRNK); const float* GATE = (const float*)(p.ws + WS_GATE);
    int* POS = (int*)(p.ws + WS_POS); float* ROWW = (float*)(p.ws + WS_ROWW);
    unsigned short* RT = (unsigned short*)(p.ws + WS_ROWTOK);
    { const int t = vb * TPV + (tid >> 2), k = tid & 3;
      const int pos = pbase[EIDX[t * 4 + k]] + LRNK[t * 4 + k];
      POS[t * 4 + k] = pos; ROWW[pos] = GATE[t * 4 + k]; ROWSC[pos] = HSC[t]; RT[(pos & ~255) + (pos & 63) * 4 + ((pos >> 6) & 3)] = (unsigned short)t; }
    __syncthreads();
}
__device__ __forceinline__ void pf_final(const Params& p, int gw, int NGW, int lane) {
    const bf16* Y = (const bf16*)(p.ws + WS_Y); const int* POS = (const int*)(p.ws + WS_POS); const float* gfin = p.in[I_NFIN]; const bf16* H = (const bf16*)(p.ws + WS_H16);
    for (int t = gw; t < T; t += NGW) {
        f32x4 v[8]; const v4u* hr = (const v4u*)(H + (size_t)t * DM) + lane;
#pragma unroll
        for (int q = 0; q < 4; ++q) { const v4u w = hr[64 * q]; v[2 * q] = (f32x4){bflo(w.x), bfhi(w.x), bflo(w.y), bfhi(w.y)}; v[2 * q + 1] = (f32x4){bflo(w.z), bfhi(w.z), bflo(w.w), bfhi(w.w)}; }
#pragma unroll
        for (int k = 0; k < 4; ++k) { const int pos = POS[t * 4 + k]; const v4u* yr = (const v4u*)(Y + (size_t)pos * DM) + lane;
#pragma unroll
            for (int q = 0; q < 4; ++q) { const v4u w = yr[64 * q]; v[2 * q].x += bflo(w.x); v[2 * q].y += bfhi(w.x); v[2 * q].z += bflo(w.y); v[2 * q].w += bfhi(w.y);
                v[2 * q + 1].x += bflo(w.z); v[2 * q + 1].y += bfhi(w.z); v[2 * q + 1].z += bflo(w.w); v[2 * q + 1].w += bfhi(w.w); } }
        float s = 0.f;
#pragma unroll
        for (int j = 0; j < 8; ++j) s += (v[j].x * v[j].x + v[j].y * v[j].y) + (v[j].z * v[j].z + v[j].w * v[j].w);
        const float rstd = 1.f / sqrtf(wave_sum(s) * (1.f / DM) + RMS_EPS); f32x4* xr = (f32x4*)(p.out + (size_t)t * DM);
#pragma unroll
        for (int j = 0; j < 8; ++j) { const int cj = 2 * lane + 128 * (j >> 1) + (j & 1); const f32x4 g4 = ((const f32x4*)gfin)[cj]; f32x4 o; o.x = v[j].x * rstd * g4.x; o.y = v[j].y * rstd * g4.y; o.z = v[j].z * rstd * g4.z; o.w = v[j].w * rstd * g4.w; xr[cj] = o; }
    }
}


constexpr int LDS_BYTES = 159744;
constexpr int MISC_OFF = LDS_BYTES - 256;  static_assert(nsa::LDS_END <= MISC_OFF && gla::L_END <= MISC_OFF, "LDS map");
constexpr int CW_BAR = 4096, CW_XL = 16384;
__global__ __launch_bounds__(512, 2) void mega_fwd(Params p) {
    extern __shared__ __attribute__((aligned(16))) unsigned char lds_raw[];
    LAS unsigned char* lds = (LAS unsigned char*)lds_raw;
    const int G = gridDim.x, bid = blockIdx.x, NGW = G * 8;
#define PH_IDS int tid = threadIdx.x; asm volatile("" : "+v"(tid)); const int lane = tid & 63, wave = __builtin_amdgcn_readfirstlane(tid >> 6), gw = bid * 8 + wave; (void)lane; (void)gw;
    for (int u = threadIdx.x; u < 64; u += 512) ((LAS unsigned*)(lds + MISC_OFF))[u] = 0u;
    __syncthreads();
    XcdBarrier bar = xcd_barrier_post((unsigned*)(p.ws + WS_CTL) + CW_BAR, (volatile LAS unsigned*)(lds + MISC_OFF) + 8);
    { PH_IDS; p0_prologue(p, lds, gw, NGW, wave, lane); __syncthreads(); p0_slab_quant(p, lds, bid, G, tid); }
    xcd_barrier(bar);
    { pg8::Gemm g{(const bf16*)(p.ws + WS_XN8), (const bf16*)(p.ws + WS_WINQ), T, NPT * 256, DM / 2};
      ProjOrder S; S.init(T, NPT * 256, G, bid); S.xn = g.A; S.wt = g.Bt; EpiProjI8 E{p.ws};
      pg8::gemm_phase<EpiProjI8, ProjOrder, true, true, true>(lds, g, S, E); }
    xcd_barrier(bar);
    if (bid < 32) {
        pg8::Gemm g{(const bf16*)(p.ws + WS_KC), (const bf16*)(p.ws + WS_WKCT), 4096, 256, 2048};
        CmpOrder S{bid, (const bf16*)(p.ws + WS_KC), (const bf16*)(p.ws + WS_VC), (const bf16*)(p.ws + WS_WKCT), (const bf16*)(p.ws + WS_WVCT)}; EpiLH E{(float*)(p.ws + WS_LH)};
        pg8::gemm_phase<EpiLH, CmpOrder, true, true>(lds, g, S, E);
    } else { PH_IDS; ph_gla_a(p, lds, bid - 32, G - 32, tid, wave); }
    xcd_barrier(bar);
    { PH_IDS; ph_gla_b(p, bid * 512 + tid, G * 512);
      for (int i = bid * 512 + tid; i < 16 * 128; i += G * 512) { const int bgz = i >> 7, dz = i & 127; ((bf16*)(p.ws + WS_KCMP))[((size_t)bgz * 256 + 255) * 128 + dz] = 0; ((bf16*)(p.ws + WS_VCMPT))[((size_t)bgz * 128 + dz) * 256 + 255] = 0; }
      ph_cmp_fin(p, lds, bid, G, tid, (const float*)(p.ws + WS_LH), (const float*)(p.ws + WS_PEVP)); }
    xcd_barrier(bar);
    { PH_IDS; ph_nsa(p, lds, bid, G, tid, wave); }
    { PH_IDS; __syncthreads(); ph_gla_c(p, lds, bid, G, tid, wave); }
    xcd_barrier(bar);
    { pg8::Gemm g{(const bf16*)(p.ws + WS_A2), (const bf16*)(p.ws + WS_WOT), T, DM, DM};
      pg8::StaticOrder S; S.init(T, DM, G, bid); EpiRes E{p.in[I_X], (bf16*)(p.ws + WS_H16)};
      pg8::gemm_phase<EpiRes, pg8::StaticOrder, true, true>(lds, g, S, E); }
    xcd_barrier(bar);
    { PH_IDS; for (int vb = bid; vb < NVB; vb += G) r1_router(p, lds, vb, tid, wave, lane); }
    xcd_barrier(bar);
    { PH_IDS; for (int vb = bid; vb < NVB; vb += G) r2_gather(p, lds, vb, vb == 0, tid, wave, lane); }
    xcd_barrier(bar);
    { pg8::Gemm g{(const bf16*)(p.ws + WS_HN8), (const bf16*)(p.ws + WS_W1Q), MAXTILES * 256, 4096, DM / 2};
      MoeOrderG S; S.init((const int*)(p.ws + WS_META), 16, G, bid); S.rowtab = (const unsigned short*)(p.ws + WS_ROWTOK); EpiSwigluI8 E{p.in[I_B1], (const float*)(p.ws + WS_ROWSC), (const float*)(p.ws + WS_WSC1), (bf16*)(p.ws + WS_ACT), (float*)(p.ws + WS_AMAXP)};
      pg8::gemm_phase<EpiSwigluI8, MoeOrderG, true, true, true, true>(lds, g, S, E); }
    xcd_barrier(bar);
    { PH_IDS; ph_actq(p, gw, NGW, lane); }
    xcd_barrier(bar);
    { pg8::Gemm g{(const bf16*)(p.ws + WS_ACT8), (const bf16*)(p.ws + WS_W2Q), MAXTILES * 256, DM, DFF / 2};
      MoeOrder S; S.init((const int*)(p.ws + WS_META), 8, G, bid); EpiDownI8 E{p.in[I_B2], (const float*)(p.ws + WS_ROWW), (const float*)(p.ws + WS_ASC), (const float*)(p.ws + WS_WSC2), (bf16*)(p.ws + WS_Y)};
      pg8::gemm_phase<EpiDownI8, MoeOrder, true, true, true>(lds, g, S, E); }
    xcd_barrier(bar);
    { PH_IDS; pf_final(p, gw, NGW, lane); }
}

extern "C" void kernel_launch(void* const* d_in, const int* in_sizes, int n_in, void* d_out, int out_size, void* d_ws, size_t ws_size, hipStream_t stream) {
    static int grid = 0;
    if (grid == 0) {
        if (n_in != N_IN || out_size != T * DM || ws_size < WS_END) { fprintf(stderr, "kernel_launch: unexpected shapes (n_in %d out %d ws %zu need %zu)\n", n_in, out_size, ws_size, (size_t)WS_END); grid = -1; return; }
        int dev = 0, cus = 0, per_cu = 0;
        if (hipGetDevice(&dev) != hipSuccess || hipDeviceGetAttribute(&cus, hipDeviceAttributeMultiprocessorCount, dev) != hipSuccess) { grid = -1; return; }
        if (hipFuncSetAttribute((const void*)mega_fwd, hipFuncAttributeMaxDynamicSharedMemorySize, LDS_BYTES) != hipSuccess) { fprintf(stderr, "kernel_launch: hipFuncSetAttribute failed\n"); grid = -1; return; }
        if (hipOccupancyMaxActiveBlocksPerMultiprocessor(&per_cu, (const void*)mega_fwd, 512, LDS_BYTES) != hipSuccess || per_cu < 1) { fprintf(stderr, "kernel_launch: occupancy query says %d blocks per CU\n", per_cu); }
        (void)hipGetLastError();
        grid = cus;
    }
    if (grid < 0) return;
    if (hipMemsetAsync((char*)d_ws + WS_CTL, 0, CTL_BYTES, stream) != hipSuccess) return;
    Params p{};
    for (int i = 0; i < N_IN; ++i) p.in[i] = (const float*)d_in[i];
    p.out = (float*)d_out; p.ws = (unsigned char*)d_ws;
    hipLaunchKernelGGL(mega_fwd, dim3(grid), dim3(512), LDS_BYTES, stream, p);
}
```

```cpp
#include <hip/hip_runtime.h>
#include <cstdio>
#include <cstdint>
namespace pg8 {
#define PG8_LAS __attribute__((address_space(3)))
typedef unsigned short bf16_t;
typedef short bf16x8 __attribute__((ext_vector_type(8)));
typedef float f32x4 __attribute__((ext_vector_type(4)));
typedef unsigned u32x4 __attribute__((ext_vector_type(4)));
typedef unsigned v2u_t __attribute__((ext_vector_type(2)));
constexpr int BM = 256, BK = 64, HALF = 128, HTB = HALF * BK * 2  , STAGE_BYTES = 8 * HTB, NXCD = 8, WGM = 8;

__host__ __device__ __forceinline__ int lds_byte(int r, int c) { const int st = (r >> 4) * 2 + (c >> 5), rr = r & 15, cc = c & 31, ob = rr * 64 + cc * 2; return st * 1024 + (ob ^ (((ob >> 9) & 1) << 5)); }
__host__ __device__ __forceinline__ void stage_rc(int b, int& R, int& C) { const int st = b / 1024, sb = b % 1024, swz = sb ^ (((sb >> 9) & 1) << 5); R = (st >> 1) * 16 + swz / 64; C = (st & 1) * 32 + (swz % 64) / 2; }
__host__ __device__ __forceinline__ int perm32(int rho) { const int n = rho >> 4, i = rho & 15; return 8 * (i >> 2) + 4 * n + (i & 3); }

struct Unit { int pm, pn, kind; };
struct Gemm { const bf16_t* A; const bf16_t* Bt; int M, N, K; };

template <int WG = WGM> __host__ __device__ __forceinline__ void tile_of(int wgid, int nM, int nN, int& pm, int& pn) {
    const int nwg = nM * nN;
    { const int q = nwg / NXCD, r = nwg % NXCD, xcd = wgid % NXCD, off = wgid / NXCD; wgid = (xcd < r ? xcd * (q + 1) : r * (q + 1) + (xcd - r) * q) + off; }
    const int nig = WG * nN, gid = wgid / nig, fm = gid * WG, gsz = (nM - fm) < WG ? (nM - fm) : WG;
    pm = fm + ((wgid % nig) % gsz); pn = (wgid % nig) / gsz;
}
struct StaticOrder {
    int nM, nN, nwg, G, c;
    __host__ __device__ void init(int M, int N, int G_, int c_) { nM = M / BM; nN = N / BM; nwg = nM * nN; G = G_; c = c_; }
    __device__ __forceinline__ bool next(int i, Unit& u) const {
        const long L = (long)i * G + c; if (L >= nwg) return false;
        tile_of((int)L, nM, nN, u.pm, u.pn); u.kind = 0; return true;
    }
    __device__ __forceinline__ const char* pa(const Gemm& g, const Unit& u) const { return (const char*)g.A + (size_t)u.pm * ((size_t)BM * g.K * 2); }
    __device__ __forceinline__ const char* pb(const Gemm& g, const Unit& u) const { return (const char*)g.Bt + (size_t)u.pn * ((size_t)BM * g.K * 2); }
    __device__ __forceinline__ void a_ready(const Unit&) const {}
    __device__ __forceinline__ void done(const Unit&) const {}
};
__device__ __forceinline__ unsigned cvt_pk_bf16(float lo, float hi) { unsigned r; asm volatile("v_cvt_pk_bf16_f32 %0, %1, %2" : "=v"(r) : "v"(lo), "v"(hi)); return r; }
template <bool I8> __device__ __forceinline__ f32x4 mma16(bf16x8 a, bf16x8 b, f32x4 c) {
    if constexpr (I8) { typedef int i32x4 __attribute__((ext_vector_type(4)));
        return __builtin_bit_cast(f32x4, __builtin_amdgcn_mfma_i32_16x16x64_i8(__builtin_bit_cast(i32x4, a), __builtin_bit_cast(i32x4, b), __builtin_bit_cast(i32x4, c), 0, 0, 0)); }
    else return __builtin_amdgcn_mfma_f32_16x16x32_bf16(a, b, c, 0, 0, 0);
}
template <class Epi, class Sched, bool ALIGN_EPI = false, bool SP2 = false, bool I8 = false, bool GATHER = false>
__device__ __forceinline__ void gemm_phase(PG8_LAS unsigned char* lds, const Gemm g, const Sched& S, const Epi& E) {
    int tid_l = threadIdx.x; asm volatile("" : "+v"(tid_l));
    const int tid = tid_l, wid = __builtin_amdgcn_readfirstlane(tid >> 6), lane = tid & 63, wr = wid >> 2, wc = wid & 3, fr = lane & 15, fq = lane >> 4;
    const int K = g.K, nt = K / BK;
    unsigned voffA[2], voffB[2];
#pragma unroll
    for (int i = 0; i < 2; ++i) { int R, C; stage_rc(tid * 16 + i * 8192, R, C); const int Rb = Epi::PERM ? ((R & ~31) + perm32(R & 31)) : R;
        voffA[i] = (unsigned)(R * K + C) * 2u; voffB[i] = (unsigned)(Rb * K + C) * 2u; }
    const size_t kstep = (size_t)(BK * 2);
    const size_t hstep = (size_t)HALF * K * 2;
    const unsigned ldsw = (unsigned)wid * 1024u;
    const int aoff = lds_byte(wr * 64 + fr, fq * 8), boff = lds_byte(wc * 32 + fr, fq * 8);
#define PG8_SA(b, h) (((b) * 2 + (h)) * HTB)
#define PG8_SB(b, h) ((4 + (b) * 2 + (h)) * HTB)
#define PG8_STAGE(bufoff, gbase, voff) do { _Pragma("unroll") for (int _i = 0; _i < 2; ++_i) \
        __builtin_amdgcn_global_load_lds((const unsigned*)((const char*)(gbase) + (voff)[_i]), (PG8_LAS unsigned*)(lds + (bufoff) + ldsw + _i * 8192), 16, 0, 0); } while (0)
#define PG8_STAGE_A(bufoff, ptr, h) do { if constexpr (GATHER) PG8_STAGE(bufoff, ptr, cuo + 2 * (h)); else PG8_STAGE(bufoff, (ptr) + (h) * hstep, voffA); } while (0)
#define PG8_LDA(dst, b, h) do { _Pragma("unroll") for (int m = 0; m < 4; ++m) _Pragma("unroll") for (int k = 0; k < 2; ++k) dst[m][k] = *(const PG8_LAS bf16x8*)(lds + PG8_SA(b, h) + aoff + m * 2048 + k * 1024); } while (0)
#define PG8_LDB(dst, b, h) do { _Pragma("unroll") for (int n = 0; n < 2; ++n) _Pragma("unroll") for (int k = 0; k < 2; ++k) dst[n][k] = *(const PG8_LAS bf16x8*)(lds + PG8_SB(b, h) + boff + n * 2048 + k * 1024); } while (0)
#define PG8_MMA(ai, bj, At, Bt) do { __builtin_amdgcn_s_setprio(1); _Pragma("unroll") for (int m = 0; m < 4; ++m) _Pragma("unroll") for (int n = 0; n < 2; ++n) _Pragma("unroll") for (int k = 0; k < 2; ++k) \
        acc[ai][bj][m][n] = mma16<I8>(Bt[n][k], At[m][k], acc[ai][bj][m][n]); __builtin_amdgcn_s_setprio(0); } while (0)
#define PG8_WAIT_V(n) asm volatile("s_waitcnt vmcnt(" #n ")" ::: "memory")
#define PG8_WAIT_L(n) asm volatile("s_waitcnt lgkmcnt(" #n ")" ::: "memory")
#define PG8_BAR __builtin_amdgcn_s_barrier()
#define PG8_SCHED __builtin_amdgcn_sched_barrier(0)
    Unit cur, nxt; int ui = 0;
    if (!S.next(0, cur)) return;
    unsigned cuo[4] = {0u, 0u, 0u, 0u}, cb0 = 0u; v2u_t raw = {0u, 0u};
    if constexpr (GATHER) { int R0, C0; stage_rc(tid * 16, R0, C0); cb0 = (unsigned)C0 * 2u; unsigned ro = (unsigned)R0 * 8u; asm volatile("" : "+v"(ro));
        Unit u1; const bool h1 = S.next(1, u1); const v2u_t r0 = *(const v2u_t*)((const char*)S.rowtab + (size_t)cur.pm * 512 + ro); raw = *(const v2u_t*)((const char*)S.rowtab + (size_t)(h1 ? u1.pm : cur.pm) * 512 + ro);
        cuo[0] = ((r0.x & 0xffffu) << 11) + cb0; cuo[1] = ((r0.x >> 16) << 11) + cb0; cuo[2] = ((r0.y & 0xffffu) << 11) + cb0; cuo[3] = ((r0.y >> 16) << 11) + cb0; }
    f32x4 acc[2][2][4][2];
#pragma unroll
    for (int a = 0; a < 2; ++a)
#pragma unroll
        for (int b = 0; b < 2; ++b)
#pragma unroll
            for (int m = 0; m < 4; ++m)
#pragma unroll
                for (int n = 0; n < 2; ++n) acc[a][b][m][n] = (f32x4){0.f, 0.f, 0.f, 0.f};
    bf16x8 At[4][2], B0[2][2], B1[2][2];
    const char* cA = S.pa(g, cur); const char* cB = S.pb(g, cur);
    S.a_ready(cur);
    if constexpr (SP2) {
        PG8_STAGE(PG8_SB(0, 0), cB, voffB); PG8_STAGE(PG8_SB(0, 1), cB + hstep, voffB); PG8_STAGE_A(PG8_SA(0, 0), cA, 0); PG8_STAGE_A(PG8_SA(0, 1), cA, 1);
        if (wr == 1) PG8_BAR;
        PG8_WAIT_V(2); PG8_BAR;
        PG8_STAGE(PG8_SB(1, 0), cB + kstep, voffB); PG8_STAGE_A(PG8_SA(1, 0), cA + kstep, 0); PG8_STAGE(PG8_SB(1, 1), cB + hstep + kstep, voffB);
        PG8_WAIT_V(6); PG8_BAR;
    } else {
        PG8_STAGE(PG8_SB(0, 0), cB, voffB); PG8_STAGE(PG8_SA(0, 0), cA, voffA); PG8_STAGE(PG8_SB(0, 1), cB + hstep, voffB); PG8_STAGE(PG8_SA(0, 1), cA + hstep, voffA);
        if (wr == 1) PG8_BAR;
        PG8_WAIT_V(4); PG8_BAR;
        PG8_STAGE(PG8_SB(1, 0), cB + kstep, voffB); PG8_STAGE(PG8_SA(1, 0), cA + kstep, voffA); PG8_STAGE(PG8_SB(1, 1), cB + hstep + kstep, voffB);
        PG8_WAIT_V(6); PG8_BAR;
    }
    for (;;) {
        const bool has_next = S.next(ui + 1, nxt);
        const char* nA = has_next ? S.pa(g, nxt) : cA; const char* nB = has_next ? S.pb(g, nxt) : cB;
        for (int t = 0; t < nt; t += 2) {
            const bool last = (t == nt - 2);
            const char* a1 = cA + (size_t)(t + 1) * kstep;
            const char* a2 = last ? nA : cA + (size_t)(t + 2) * kstep; const char* b2 = last ? nB : cB + (size_t)(t + 2) * kstep;
            const char* a3 = a2 + kstep; const char* b3 = b2 + kstep;
            if (last && has_next) S.a_ready(nxt);
            if constexpr (SP2) {
            PG8_LDB(B0, 0, 0); PG8_LDB(B1, 0, 1); PG8_SCHED; PG8_LDA(At, 0, 0); PG8_STAGE_A(PG8_SA(1, 1), a1, 1);
            if constexpr (GATHER) { unsigned rx = raw.x, ry = raw.y; asm volatile("" : "+v"(rx), "+v"(ry));
                const unsigned n0 = ((rx & 0xffffu) << 11) + cb0, n1 = ((rx >> 16) << 11) + cb0, n2 = ((ry & 0xffffu) << 11) + cb0, n3 = ((ry >> 16) << 11) + cb0;
                cuo[0] = last ? n0 : cuo[0]; cuo[1] = last ? n1 : cuo[1]; cuo[2] = last ? n2 : cuo[2]; cuo[3] = last ? n3 : cuo[3]; }
            PG8_WAIT_V(8); PG8_WAIT_L(0); PG8_BAR; PG8_MMA(0, 0, At, B0); PG8_MMA(0, 1, At, B1); PG8_BAR; PG8_SCHED;
            PG8_LDA(At, 0, 1); PG8_STAGE(PG8_SB(0, 0), b2, voffB); PG8_STAGE(PG8_SB(0, 1), b2 + hstep, voffB); PG8_STAGE_A(PG8_SA(0, 0), a2, 0);
            PG8_WAIT_V(8); PG8_WAIT_L(0); PG8_BAR; PG8_MMA(1, 0, At, B0); PG8_MMA(1, 1, At, B1); PG8_BAR; PG8_SCHED;
            PG8_LDB(B0, 1, 0); PG8_LDB(B1, 1, 1); PG8_SCHED; PG8_LDA(At, 1, 0); PG8_STAGE_A(PG8_SA(0, 1), a2, 1);
            PG8_WAIT_V(8); PG8_WAIT_L(0); PG8_BAR; PG8_MMA(0, 0, At, B0); PG8_MMA(0, 1, At, B1); PG8_BAR; PG8_SCHED;
            PG8_LDA(At, 1, 1); PG8_STAGE(PG8_SB(1, 0), b3, voffB); PG8_STAGE(PG8_SB(1, 1), b3 + hstep, voffB); PG8_STAGE_A(PG8_SA(1, 0), a3, 0);
            PG8_WAIT_V(8); PG8_WAIT_L(0); PG8_BAR; PG8_MMA(1, 0, At, B0); PG8_MMA(1, 1, At, B1); PG8_BAR; PG8_SCHED;
            } else {
            PG8_LDB(B0, 0, 0); PG8_SCHED; PG8_LDA(At, 0, 0); PG8_STAGE(PG8_SA(1, 1), a1 + hstep, voffA);
            PG8_WAIT_L(8); PG8_BAR; PG8_WAIT_L(0); PG8_MMA(0, 0, At, B0); PG8_BAR; PG8_SCHED;
            PG8_LDB(B1, 0, 1); PG8_STAGE(PG8_SB(0, 0), b2, voffB);
            PG8_BAR; PG8_WAIT_L(0); PG8_MMA(0, 1, At, B1); PG8_BAR;
            PG8_LDA(At, 0, 1); PG8_STAGE(PG8_SA(0, 0), a2, voffA);
            PG8_BAR; PG8_WAIT_L(0); PG8_MMA(1, 0, At, B0); PG8_BAR; PG8_SCHED;
            PG8_STAGE(PG8_SB(0, 1), b2 + hstep, voffB);
            PG8_WAIT_V(6); PG8_BAR; PG8_MMA(1, 1, At, B1); PG8_BAR;
            PG8_LDB(B0, 1, 0); PG8_SCHED; PG8_LDA(At, 1, 0); PG8_STAGE(PG8_SA(0, 1), a2 + hstep, voffA);
            PG8_WAIT_L(8); PG8_BAR; PG8_WAIT_L(0); PG8_MMA(0, 0, At, B0); PG8_BAR; PG8_SCHED;
            PG8_LDB(B1, 1, 1); PG8_STAGE(PG8_SB(1, 0), b3, voffB);
            PG8_BAR; PG8_WAIT_L(0); PG8_MMA(0, 1, At, B1); PG8_BAR;
            PG8_LDA(At, 1, 1); PG8_STAGE(PG8_SA(1, 0), a3, voffA);
            PG8_BAR; PG8_WAIT_L(0); PG8_MMA(1, 0, At, B0); PG8_BAR; PG8_SCHED;
            PG8_STAGE(PG8_SB(1, 1), b3 + hstep, voffB);
            PG8_WAIT_V(6); PG8_BAR; PG8_MMA(1, 1, At, B1); PG8_BAR;
            }
        }
        if constexpr (ALIGN_EPI) { if (wr == 0) PG8_BAR; }
        if constexpr (GATHER) { static_assert(SP2 && !Epi::AFTER_DRAIN, "GATHER is written for the SP2 loop"); int R0, C0; stage_rc(tid * 16, R0, C0); Unit u2; const bool h2 = S.next(ui + 2, u2);
            unsigned ro = (unsigned)R0 * 8u; asm volatile("" : "+v"(ro)); raw = *(const v2u_t*)((const char*)S.rowtab + (size_t)(h2 ? u2.pm : cur.pm) * 512 + ro); PG8_SCHED; }
        if constexpr (!Epi::AFTER_DRAIN) { E(acc, cur, wr, wc, fr, fq); S.done(cur); }
        if (!has_next) break;
#pragma unroll
        for (int a = 0; a < 2; ++a)
#pragma unroll
            for (int b = 0; b < 2; ++b)
#pragma unroll
                for (int m = 0; m < 4; ++m)
#pragma unroll
                    for (int n = 0; n < 2; ++n) acc[a][b][m][n] = (f32x4){0.f, 0.f, 0.f, 0.f};
        cur = nxt; cA = nA; cB = nB; ++ui;
        if constexpr (ALIGN_EPI) { if (wr == 1) PG8_BAR; }
    }
    PG8_WAIT_V(0);
    if constexpr (!ALIGN_EPI) { if (wr == 0) PG8_BAR; }
    PG8_BAR;
    if constexpr (Epi::AFTER_DRAIN) { E.fused(acc, cur, wr, wc, fr, fq, lds, wid, lane); S.done(cur); }
#undef PG8_SA
#undef PG8_SB
#undef PG8_STAGE
#undef PG8_STAGE_A
#undef PG8_LDA
#undef PG8_LDB
#undef PG8_MMA
#undef PG8_WAIT_V
#undef PG8_WAIT_L
#undef PG8_BAR
#undef PG8_SCHED
}
}

#define GAS __attribute__((address_space(1)))
#define LAS __attribute__((address_space(3)))
typedef unsigned short bf16;
typedef unsigned v4u __attribute__((ext_vector_type(4)));
typedef unsigned v2u __attribute__((ext_vector_type(2)));
typedef float f32x4 __attribute__((ext_vector_type(4)));
typedef short bf16x8 __attribute__((ext_vector_type(8)));

constexpr int NB = 8, SEQ = 4096, DM = 2048, T = NB * SEQ;
constexpr int NPT = 23;
constexpr int NE = 32, DFF = 2048;
constexpr int MAXTILES = 544;
constexpr float RMS_EPS = 1e-5f;
constexpr int NVB = 256, TPV = T / NVB;

enum { I_X = 0, I_NMIX, I_WIN, I_WA2, I_BA, I_GLAG, I_PEK, I_WK1, I_WK2, I_PEV, I_WV1, I_WV2, I_NSAG, I_RELB, I_WOUT, I_NFFN, I_RW, I_RB, I_W1, I_B1, I_W2, I_B2, I_NFIN, N_IN };

constexpr size_t MiB = 1u << 20;
constexpr size_t al(size_t x) { return (x + 255) & ~(size_t)255; }
constexpr size_t WS_CTL = 0, CTL_BYTES = 1 * MiB;
constexpr size_t WS_CNT = WS_CTL + CTL_BYTES;
constexpr size_t WS_META = WS_CNT + al(NVB * 32 * 4);
constexpr size_t WS_EIDX = WS_META + al((64 + MAXTILES) * 4);
constexpr size_t WS_LRNK = WS_EIDX + al((size_t)T * 4 * 4);
constexpr size_t WS_GATE = WS_LRNK + al((size_t)T * 4 * 4);
constexpr size_t WS_POS = WS_GATE + al((size_t)T * 4 * 4);
constexpr size_t WS_ROWW = WS_POS + al((size_t)T * 4 * 4);
constexpr size_t WS_WINT = al(WS_ROWW + (size_t)MAXTILES * 256 * 4);
constexpr size_t WS_WOT = WS_WINT + (size_t)NPT * 256 * DM * 2;
constexpr size_t WS_WKCT = WS_WOT + (size_t)DM * DM * 2;
constexpr size_t WS_WVCT = WS_WKCT + (size_t)256 * 2048 * 2;
constexpr size_t WS_W1T = WS_WVCT + (size_t)256 * 2048 * 2;
constexpr size_t WS_W2T = WS_W1T + (size_t)NE * 4096 * DM * 2;
constexpr size_t WS_XN = WS_W2T + (size_t)NE * DM * DFF * 2;
constexpr size_t WS_GQ = WS_XN + (size_t)T * DM * 2;
constexpr size_t WS_GK = WS_GQ + (size_t)T * 512 * 2;
constexpr size_t WS_GV = WS_GK + (size_t)T * 512 * 2;
constexpr size_t WS_GG = WS_GV + (size_t)T * 1024 * 2;
constexpr size_t WS_NQ = WS_GG + (size_t)T * 1024 * 2;
constexpr size_t WS_KC = WS_NQ + (size_t)T * 1024 * 2;
constexpr size_t WS_VC = WS_KC + (size_t)T * 256 * 2;
constexpr size_t WS_KS = WS_VC + (size_t)T * 256 * 2;
constexpr size_t WS_KW = WS_KS + (size_t)T * 256 * 2;
constexpr size_t WS_VST = WS_KW + (size_t)T * 256 * 2;
constexpr size_t WS_VWT = WS_VST + (size_t)T * 256 * 2;
constexpr size_t WS_SM = WS_VWT + (size_t)T * 256 * 2;
constexpr size_t WS_LA = WS_SM + (size_t)T * 64 * 2;
constexpr size_t WS_OG = WS_LA + (size_t)T * 512 * 4;
constexpr size_t WS_ON = WS_OG + (size_t)T * 1024 * 4;
constexpr size_t WS_KCMP = WS_ON + (size_t)T * 1024 * 4;
constexpr size_t WS_VCMPT = WS_KCMP + (size_t)16 * 256 * 128 * 2;
constexpr size_t WS_A2 = WS_VCMPT + (size_t)16 * 256 * 128 * 2;
constexpr size_t WS_HN = WS_A2 + (size_t)T * DM * 2;
constexpr size_t WS_XG = WS_HN + (size_t)T * DM * 2;
constexpr size_t WS_ACT = WS_XG + (size_t)MAXTILES * 256 * DM * 2;
constexpr size_t WS_END = WS_ACT + (size_t)MAXTILES * 256 * DFF * 2;

typedef unsigned short u16x2 __attribute__((ext_vector_type(2)));
__device__ __forceinline__ unsigned cvt2bf(float lo, float hi) { unsigned r; asm("v_cvt_pk_bf16_f32 %0, %1, %2" : "=v"(r) : "v"(lo), "v"(hi)); return r; }
__device__ __forceinline__ unsigned f2bf(float f) { return cvt2bf(f, f) & 0xffffu; }
__device__ __forceinline__ unsigned pk2(float lo, float hi) { return cvt2bf(lo, hi); }
__device__ __forceinline__ float bf2f(unsigned short v) { return __builtin_bit_cast(float, (unsigned)v << 16); }
__device__ __forceinline__ float bflo(unsigned w) { return __builtin_bit_cast(float, w << 16); }
__device__ __forceinline__ float bfhi(unsigned w) { return __builtin_bit_cast(float, w & 0xffff0000u); }
__device__ __forceinline__ float wave_sum(float v) {
#pragma unroll
    for (int o = 1; o < 64; o <<= 1) v += __shfl_xor(v, o);
    return v;
}
__device__ __forceinline__ float wave_max(float v) {
#pragma unroll
    for (int o = 1; o < 64; o <<= 1) v = fmaxf(v, __shfl_xor(v, o));
    return v;
}
#define LDS_WAIT() asm volatile("s_waitcnt lgkmcnt(0)" ::: "memory")

__device__ const unsigned char kBucket[128] = {0, 1, 2, 3, 4, 5, 6, 7, 8, 9, 10, 11, 12, 13, 14, 15, 16, 16, 16, 17, 17, 18, 18, 18, 19, 19, 19, 20, 20, 20, 20, 21, 21, 21, 21, 22, 22, 22, 22, 22, 23, 23, 23, 23, 23, 23, 24, 24, 24, 24, 24, 24, 25, 25, 25, 25, 25, 25, 25, 26, 26, 26, 26, 26, 26, 26, 26, 27, 27, 27, 27, 27, 27, 27, 27, 27, 27, 28, 28, 28, 28, 28, 28, 28, 28, 28, 28, 29, 29, 29, 29, 29, 29, 29, 29, 29, 29, 29, 29, 30, 30, 30, 30, 30, 30, 30, 30, 30, 30, 30, 30, 30, 30, 31, 31, 31, 31, 31, 31, 31, 31, 31, 31, 31, 31, 31, 31, 31};

struct Params {
    const float* in[N_IN];
    float* out;
    unsigned char* ws;
};

template <class F>
__device__ __forceinline__ void transpose_item(const float* W, int ldw, int k0, int n0, int nlim, LAS float* scr, int lane, F dst) {
#pragma unroll 8
    for (int i = 0; i < 32; ++i) { const int kk = 2 * i + (lane >> 5); const int n = n0 + (lane & 31); scr[kk * 33 + (lane & 31)] = n < nlim ? W[(size_t)(k0 + kk) * ldw + n] : 0.f; }
    LDS_WAIT(); asm volatile("" ::: "memory");
    const int c = lane & 7;
#pragma unroll
    for (int j = 0; j < 4; ++j) { const int nn = (lane >> 3) + 8 * j; const int n = n0 + nn; const LAS float* s = scr + (8 * c) * 33 + nn;
        bf16* rowp; float sc;
        if (n < nlim && dst(n, rowp, sc)) {
            v4u o; o.x = pk2(s[0 * 33] * sc, s[1 * 33] * sc); o.y = pk2(s[2 * 33] * sc, s[3 * 33] * sc); o.z = pk2(s[4 * 33] * sc, s[5 * 33] * sc); o.w = pk2(s[6 * 33] * sc, s[7 * 33] * sc);
            *(v4u*)(rowp + 8 * c) = o; } }
    LDS_WAIT(); asm volatile("" ::: "memory");
}
__device__ __forceinline__ int win_row(int n, float& sc) {
    sc = 1.f;
    if (n < 512) { sc = 0.08838834764831845f; return n; }
    if (n < 1024) return n;
    if (n < 2048) return n;
    if (n < 3072) return n;
    if (n < 3088) return 5120 + (n - 3072);
    if (n < 4112) { sc = 0.08838834764831845f; return 3072 + (n - 3088); }
    if (n < 4368) return 4096 + (n - 4112);
    if (n < 4624) return 4352 + (n - 4368);
    if (n < 4880) return 4608 + (n - 4624);
    if (n < 5136) return 5376 + (n - 4880);
    if (n < 5392) return 4864 + (n - 5136);
    if (n < 5648) return 5632 + (n - 5392);
    return 5136 + (n - 5648);
}
constexpr size_t WS_PEVP = WS_W2T;
__device__ __forceinline__ void p0_prologue(const Params& p, LAS unsigned char* lds, int gw, int NGW, int wave, int lane) {
    LAS float* scr = (LAS float*)(lds + wave * 16384);
    bf16* WinT = (bf16*)(p.ws + WS_WINT); bf16* WoT = (bf16*)(p.ws + WS_WOT); bf16* WkcT = (bf16*)(p.ws + WS_WKCT); bf16* WvcT = (bf16*)(p.ws + WS_WVCT);
    bf16* W1T = (bf16*)(p.ws + WS_W1T); bf16* W2T = (bf16*)(p.ws + WS_W2T);
    constexpr int I_IN = 32 * 178, I_O = 32 * 64, I_C = 64 * 4, I_E1 = 32 * 128, I_E2 = 32 * 64;
    constexpr int I_PE = 2 * 64;
    constexpr int NITEMS = I_O + 2 * I_C + I_PE;
    (void)I_IN; (void)WinT;
    for (int it = gw; it < NITEMS; it += NGW) {
        int r = it;
        if (r < I_O) { const int kb = r / 64, nb = r % 64, k0 = kb * 64;
            transpose_item(p.in[I_WOUT], DM, k0, nb * 32, DM, scr, lane, [&](int n, bf16*& rowp, float& sc) { sc = 1.f; rowp = WoT + (size_t)n * DM + k0; return true; }); continue; } r -= I_O;
        if (r >= 2 * I_C) { r -= 2 * I_C; const int which = r >> 6, kq = r & 63; const float* pe = p.in[which ? I_PEV : I_PEK] + kq * 64; const float* w1 = p.in[which ? I_WV1 : I_WK1] + (size_t)kq * 64 * 128 + lane;
            float a0 = 0.f, a1 = 0.f;
#pragma unroll
            for (int k = 0; k < 64; ++k) { const float pv = pe[k]; a0 += pv * w1[k * 128]; a1 += pv * w1[k * 128 + 64]; }
            float* dst = (float*)(p.ws + WS_PEVP) + (size_t)(which * 64 + kq) * 128 + lane; dst[0] = a0; dst[64] = a1; continue; }
        { const int which = r / I_C; r %= I_C; const int kb = r / 4, nb = r % 4, k0 = kb * 64;
            bf16* dstm = which ? WvcT : WkcT;
            transpose_item(p.in[which ? I_WV1 : I_WK1], 128, k0, nb * 32, 128, scr, lane, [&](int n, bf16*& rowp, float& sc) { sc = 1.f; rowp = dstm + (size_t)(n + (k0 >= 2048 ? 128 : 0)) * 2048 + (k0 & 2047); return true; }); }
        (void)I_E1; (void)I_E2; (void)W1T; (void)W2T;
    }
    const float* x = p.in[I_X]; const float* gm = p.in[I_NMIX];
    for (int m = gw; m < T; m += NGW) {
        const f32x4* xr = (const f32x4*)(x + (size_t)m * DM) + lane; f32x4 v[8]; float s = 0.f;
#pragma unroll
        for (int j = 0; j < 8; ++j) { v[j] = xr[64 * j]; s += (v[j].x * v[j].x + v[j].y * v[j].y) + (v[j].z * v[j].z + v[j].w * v[j].w); }
        const float rstd = 1.f / sqrtf(wave_sum(s) * (1.f / DM) + RMS_EPS);
        float mxr = 0.f;
#pragma unroll
        for (int j = 0; j < 8; ++j) { const f32x4 g4 = ((const f32x4*)gm)[lane + 64 * j]; v[j].x *= rstd * g4.x; v[j].y *= rstd * g4.y; v[j].z *= rstd * g4.z; v[j].w *= rstd * g4.w;
            mxr = fmaxf(mxr, fmaxf(fmaxf(fabsf(v[j].x), fabsf(v[j].y)), fmaxf(fabsf(v[j].z), fabsf(v[j].w)))); }
        mxr = wave_max(mxr); const float qs = mxr > 0.f ? mxr * (1.f / 127.f) : 1.f, qi = 1.f / qs;
        unsigned* o4 = (unsigned*)(p.ws + WS_XN + (size_t)m * DM) + lane;
#pragma unroll
        for (int j = 0; j < 8; ++j) { const float M = 12582912.f;
            const unsigned ua = __builtin_bit_cast(unsigned, v[j].x * qi + M), ub = __builtin_bit_cast(unsigned, v[j].y * qi + M), uc = __builtin_bit_cast(unsigned, v[j].z * qi + M), ud = __builtin_bit_cast(unsigned, v[j].w * qi + M);
            o4[64 * j] = __builtin_amdgcn_perm(ub, ua, 0x0c0c0400u) | (__builtin_amdgcn_perm(ud, uc, 0x0c0c0400u) << 16); }
        if (lane == 0) ((float*)(p.ws + WS_XN + (size_t)T * DM))[m] = qs;
    }
}
#define XB_TMO      128
#define XB_XCNT(j)  (256  + 64 * (j))
#define XB_XSUB(j)  (1280 + 64 * (j))
#define XB_XGEN(j)  (2304 + 64 * (j))
#define XB_TOP      3328
#define XB_TOPGEN   3392
#define XCD_BAR_WORDS 3456
#define XB_SPIN_CAP (1u << 18)

__device__ __forceinline__ unsigned xb_ld(unsigned* p)              { return __hip_atomic_load(p, __ATOMIC_RELAXED, __HIP_MEMORY_SCOPE_AGENT); }
__device__ __forceinline__ unsigned xb_add(unsigned* p, unsigned v) { return __hip_atomic_fetch_add(p, v, __ATOMIC_RELAXED, __HIP_MEMORY_SCOPE_AGENT); }
__device__ __forceinline__ unsigned xb_xcc_id() { return (unsigned)__builtin_amdgcn_s_getreg((3 << 11) | 20) & 0xFu; }
#define XB_SPIN(cond, bar) do { unsigned _sp = 0; while (cond) { __builtin_amdgcn_s_sleep(1); \
    if ((++_sp & 255u) == 0u) { if (xb_ld(&(bar)[XB_TMO])) break; if (_sp > XB_SPIN_CAP) { atomicAdd(&(bar)[XB_TMO], 1u); break; } } } } while (0)

struct XcdBarrier {
    unsigned* bar; unsigned x;
    volatile LAS unsigned* st;
};

__device__ __forceinline__ XcdBarrier xcd_barrier_post(unsigned* bar, volatile LAS unsigned* st) {
    XcdBarrier b; b.bar = bar; b.x = xb_xcc_id(); b.st = st;
    if (threadIdx.x == 0) (void)xb_add(&bar[XB_XCNT(b.x)], 1u);
    return b;
}
__device__ __forceinline__ void xcd_barrier_complete(unsigned* bar, unsigned x, unsigned& nloc, unsigned& nx) {
    const unsigned G = gridDim.x * gridDim.y * gridDim.z;
    unsigned sum, cnt, mine, sp = 0u;
    for (;;) {
        sum = 0u; cnt = 0u; mine = 0u;
#pragma unroll
        for (unsigned j = 0; j < 16; ++j) { const unsigned c = xb_ld(&bar[XB_XCNT(j)]); sum += c; cnt += (c > 0u) ? 1u : 0u; mine = (j == x) ? c : mine; }
        if (sum == G) break;
        __builtin_amdgcn_s_sleep(1);
        if ((++sp & 255u) == 0u) { if (xb_ld(&bar[XB_TMO])) break; if (sp > XB_SPIN_CAP) { atomicAdd(&bar[XB_TMO], 1u); break; } }
    }
    nloc = mine > 0u ? mine : 1u; nx = cnt > 0u ? cnt : 1u;
}

__device__ __forceinline__ void xcd_barrier(const XcdBarrier& b) {
    asm volatile("s_waitcnt vmcnt(0)" ::: "memory");
    __syncthreads();
    if (threadIdx.x == 0) {
        unsigned* bar = b.bar;
        __builtin_amdgcn_s_waitcnt(0);
        unsigned nloc = b.st[0], nx = b.st[1];
        if (nloc == 0u) { xcd_barrier_complete(bar, b.x, nloc, nx); b.st[0] = nloc; b.st[1] = nx; }
        const unsigned old = xb_add(&bar[XB_XSUB(b.x)], 1u);
        const unsigned gen = old / nloc;
        if (old + 1u == (gen + 1u) * nloc) {
            __builtin_amdgcn_fence(__ATOMIC_RELEASE, "agent");
            asm volatile("s_waitcnt vmcnt(0)" ::: "memory");
            const unsigned og = xb_add(&bar[XB_TOP], 1u);
            const unsigned tg = og / nx;
            if (og + 1u == (tg + 1u) * nx) xb_add(&bar[XB_TOPGEN], 1u);
            else XB_SPIN(xb_ld(&bar[XB_TOPGEN]) == tg, bar);
            __builtin_amdgcn_fence(__ATOMIC_ACQUIRE, "agent");
            xb_add(&bar[XB_XGEN(b.x)], 1u);
            asm volatile("s_waitcnt vmcnt(0)" ::: "memory");
        } else {
            XB_SPIN(xb_ld(&bar[XB_XGEN(b.x)]) == gen, bar);
            __builtin_amdgcn_fence(__ATOMIC_ACQUIRE, "agent");
            asm volatile("s_waitcnt vmcnt(0)" ::: "memory");
        }
    }
    __syncthreads();
}

struct ProjOrder : pg8::StaticOrder {
    const bf16* xn; const bf16* wt;
    __device__ __forceinline__ bool next(int i, pg8::Unit& u) const { if (!pg8::StaticOrder::next(i, u)) return false; u.kind = (u.pn >= 21) ? 1 : 0; return true; }
    __device__ __forceinline__ const char* pa(const pg8::Gemm& g, const pg8::Unit& u) const { return u.kind ? (const char*)wt + (size_t)u.pn * ((size_t)256 * g.K * 2) : (const char*)xn + (size_t)u.pm * ((size_t)256 * g.K * 2); }
    __device__ __forceinline__ const char* pb(const pg8::Gemm& g, const pg8::Unit& u) const { return u.kind ? (const char*)xn + (size_t)u.pm * ((size_t)256 * g.K * 2) : (const char*)wt + (size_t)u.pn * ((size_t)256 * g.K * 2); }
};
struct EpiRes {
    static constexpr bool PERM = true, AFTER_DRAIN = false;
    const float* x; bf16* h;
    __device__ __forceinline__ void operator()(const pg8::f32x4 (&acc)[2][2][4][2], const pg8::Unit& u, int wr, int wc, int fr, int fq) const {
        const int row0 = u.pm * 256 + wr * 64 + fr, col0 = u.pn * 256 + wc * 32 + 8 * fq;
#pragma unroll
        for (int ai = 0; ai < 2; ++ai)
#pragma unroll
            for (int m = 0; m < 4; ++m) { const size_t off = (size_t)(row0 + ai * 128 + m * 16) * DM + col0;
#pragma unroll
                for (int bj = 0; bj < 2; ++bj) { const pg8::f32x4 x0 = *(const pg8::f32x4*)(x + off + bj * 128), x1 = *(const pg8::f32x4*)(x + off + bj * 128 + 4);
                    const pg8::f32x4 a0 = x0 + acc[ai][bj][m][0], a1 = x1 + acc[ai][bj][m][1]; pg8::u32x4 w;
                    w.x = pg8::cvt_pk_bf16(a0.x, a0.y); w.y = pg8::cvt_pk_bf16(a0.z, a0.w); w.z = pg8::cvt_pk_bf16(a1.x, a1.y); w.w = pg8::cvt_pk_bf16(a1.z, a1.w);
                    *(pg8::u32x4*)(h + off + bj * 128) = w; } }
    }
};
struct MoeOrder {
    int nM, nN, nwg, G, c; const int* tile_exp;
    __device__ __forceinline__ void init(const int* meta, int nN_, int G_, int c_) { nM = meta[0]; nN = nN_; nwg = nM * nN; G = G_; c = c_; tile_exp = meta + 64; }
    __device__ __forceinline__ bool next(int i, pg8::Unit& u) const {
        const long L = (long)i * G + c; if (L >= nwg) return false;
        pg8::tile_of<8>((int)L, nM, nN, u.pm, u.pn); u.kind = tile_exp[u.pm]; return true;
    }
    __device__ __forceinline__ const char* pa(const pg8::Gemm& g, const pg8::Unit& u) const { return (const char*)g.A + (size_t)u.pm * ((size_t)256 * g.K * 2); }
    __device__ __forceinline__ const char* pb(const pg8::Gemm& g, const pg8::Unit& u) const { return (const char*)g.Bt + ((size_t)u.kind * nN + u.pn) * ((size_t)256 * g.K * 2); }
    __device__ __forceinline__ void a_ready(const pg8::Unit&) const {}
    __device__ __forceinline__ void done(const pg8::Unit&) const {}
};

struct MoeOrderG : MoeOrder { const unsigned short* rowtab;
    __device__ __forceinline__ const char* pa(const pg8::Gemm& g, const pg8::Unit&) const { return (const char*)g.A; } };

__device__ __forceinline__ float gelu_tanh(float x) { const float u = 0.7978845608028654f * (x + 0.044715f * x * x * x); const float e = __expf(2.f * u); return 0.5f * x * (1.f + (1.f - 2.f / (e + 1.f))); }
__device__ __forceinline__ void ph_cmp_fin(const Params& p, LAS unsigned char* lds, int bid, int G, int tid, const float* LHall, const float* PEVall) {
    const int grp = tid >> 7, n = tid & 127, ngrp = G * 4, total = 2 * 16 * 255, iters = (total + ngrp - 1) / ngrp;
    LAS float* hid = (LAS float*)lds + grp * 128;
    float pevs[2];
#pragma unroll
    for (int w = 0; w < 2; ++w) { float s = 0.f;
#pragma unroll 8
        for (int q = 0; q < 64; ++q) s += PEVall[(size_t)(w * 64 + q) * 128 + n];
        pevs[w] = s; }
    float wcol[128]; int wh = -1;
    for (int it = 0; it < iters; ++it) { int id = it * ngrp + bid * 4 + grp; if (id >= total) id = total - 1;
        const int which = id / (16 * 255), rem = id % (16 * 255), bg = rem / 255, c = rem % 255;
        if (which != wh) { const float* w2 = p.in[which ? I_WV2 : I_WK2]; wh = which;
#pragma unroll
            for (int mm = 0; mm < 128; ++mm) wcol[mm] = w2[mm * 128 + n]; }
        const float* LH = LHall + ((size_t)which * 4096 + bg * 256) * 256;
        const float a = LH[(size_t)c * 256 + n] + LH[(size_t)(c + 1) * 256 + 128 + n] + (which ? pevs[1] : pevs[0]);
        hid[n] = gelu_tanh(a);
        __syncthreads();
        float o0 = 0.f, o1 = 0.f, o2 = 0.f, o3 = 0.f;
#pragma unroll
        for (int m4 = 0; m4 < 32; ++m4) { const f32x4 hv = *(const LAS f32x4*)(hid + 4 * m4); o0 += hv.x * wcol[4 * m4]; o1 += hv.y * wcol[4 * m4 + 1]; o2 += hv.z * wcol[4 * m4 + 2]; o3 += hv.w * wcol[4 * m4 + 3]; }
        const float o = (o0 + o1) + (o2 + o3);
        if (which == 0) ((bf16*)(p.ws + WS_KCMP))[((size_t)bg * 256 + c) * 128 + n] = (bf16)f2bf(o);
        else ((bf16*)(p.ws + WS_VCMPT))[((size_t)bg * 128 + n) * 256 + c] = (bf16)f2bf(o);
        __syncthreads(); }
}

namespace nsa {
constexpr int KB0 = 0, KB1 = 16384, VB0 = 32768, VB1 = 49152, LUT = 65536;
constexpr int QST = LUT + 4096, IMP = QST + 65536, SELM = IMP + 16384, LDS_END = SELM + 512;
constexpr float LOG2E = 1.4426950408889634f;
typedef float f4 __attribute__((ext_vector_type(4)));

typedef unsigned u2v __attribute__((ext_vector_type(2)));
__device__ __forceinline__ float rmax16(float x) { const unsigned u = __float_as_uint(x); const u2v r = __builtin_amdgcn_permlane16_swap(u, u, false, false); return fmaxf(__uint_as_float(r[0]), __uint_as_float(r[1])); }
__device__ __forceinline__ float rmax32(float x) { const unsigned u = __float_as_uint(x); const u2v r = __builtin_amdgcn_permlane32_swap(u, u, false, false); return fmaxf(__uint_as_float(r[0]), __uint_as_float(r[1])); }
__device__ __forceinline__ float radd16(float x) { const unsigned u = __float_as_uint(x); const u2v r = __builtin_amdgcn_permlane16_swap(u, u, false, false); return __uint_as_float(r[0]) + __uint_as_float(r[1]); }
__device__ __forceinline__ float radd32(float x) { const unsigned u = __float_as_uint(x); const u2v r = __builtin_amdgcn_permlane32_swap(u, u, false, false); return __uint_as_float(r[0]) + __uint_as_float(r[1]); }
__device__ __forceinline__ float raddq(float x) { x += __int_as_float(__builtin_amdgcn_update_dpp(0, __float_as_int(x), 0xB1, 0xF, 0xF, true)); x += __int_as_float(__builtin_amdgcn_update_dpp(0, __float_as_int(x), 0x4E, 0xF, 0xF, true)); return x; }
struct Ctx {
    LAS unsigned char* lds; int tid, lane, wave, c, gq, r;
    int s0, cur;
    const LAS unsigned char* qst;
    int pos0;
    const LAS float* lutrow;
    int koff0, voff0;
    unsigned kdo[2], vdoc[2], vdos[2];
};
__device__ __forceinline__ void dma_k(const Ctx& C, const bf16* kt, LAS unsigned char* kb) {
#pragma unroll
    for (int i = 0; i < 2; ++i) __builtin_amdgcn_global_load_lds((const unsigned*)((const char*)kt + C.kdo[i]), (LAS unsigned*)(kb + (2 * C.wave + i) * 1024), 16, 0, 0); }
__device__ __forceinline__ void dma_v(const Ctx& C, const bf16* vt, const unsigned (&vdo)[2], LAS unsigned char* vb) {
#pragma unroll
    for (int i = 0; i < 2; ++i) __builtin_amdgcn_global_load_lds((const unsigned*)((const char*)vt + vdo[i]), (LAS unsigned*)(vb + (2 * C.wave + i) * 1024), 16, 0, 0); }

__device__ __forceinline__ void compute_st(const Ctx& C, const LAS unsigned char* kb, f4 (&s)[2][4]) {
#pragma unroll
    for (int ks = 0; ks < 4; ++ks) { const bf16x8 q0 = *(const LAS bf16x8*)(C.qst + ks * 1024), q1 = *(const LAS bf16x8*)(C.qst + (4 + ks) * 1024);
#pragma unroll
        for (int kt = 0; kt < 4; ++kt) { const bf16x8 a = *(const LAS bf16x8*)(kb + kt * 4096 + (C.koff0 ^ (ks * 64)));
            s[0][kt] = __builtin_amdgcn_mfma_f32_16x16x32_bf16(a, q0, ks == 0 ? (f4){0.f, 0.f, 0.f, 0.f} : s[0][kt], 0, 0, 0);
            s[1][kt] = __builtin_amdgcn_mfma_f32_16x16x32_bf16(a, q1, ks == 0 ? (f4){0.f, 0.f, 0.f, 0.f} : s[1][kt], 0, 0, 0); }
        asm volatile("" ::: "memory"); }
}
__device__ __forceinline__ void compute_pv(const Ctx& C, const LAS unsigned char* vb, const f4 (&p)[2][4], f4 (&o)[2][8]) {
#pragma unroll
    for (int i = 0; i < 2; ++i) { bf16x8 pb[2];
#pragma unroll
        for (int qt = 0; qt < 2; ++qt) { v4u w; w.x = pg8::cvt_pk_bf16(p[qt][2 * i][0], p[qt][2 * i][1]); w.y = pg8::cvt_pk_bf16(p[qt][2 * i][2], p[qt][2 * i][3]);
            w.z = pg8::cvt_pk_bf16(p[qt][2 * i + 1][0], p[qt][2 * i + 1][1]); w.w = pg8::cvt_pk_bf16(p[qt][2 * i + 1][2], p[qt][2 * i + 1][3]); pb[qt] = __builtin_bit_cast(bf16x8, w); }
#pragma unroll
        for (int dt = 0; dt < 8; ++dt) { const v2u lo = *(const LAS v2u*)(vb + dt * 2048 + (C.voff0 ^ (i * 64))), hi = *(const LAS v2u*)(vb + dt * 2048 + (C.voff0 ^ (i * 64 + 32))); const bf16x8 a = __builtin_bit_cast(bf16x8, (v4u){lo.x, lo.y, hi.x, hi.y});
#pragma unroll
            for (int qt = 0; qt < 2; ++qt) o[qt][dt] = __builtin_amdgcn_mfma_f32_16x16x32_bf16(a, pb[qt], o[qt][dt], 0, 0, 0);
            if (dt & 1) asm volatile("" ::: "memory"); } }
}
enum { M_CMP = 0, M_SEL = 1, M_WIN = 2 };
template <int MODE, bool FAR = false>
__device__ __forceinline__ void mask_bias(const Ctx& C, f4 (&s)[2][4], int kb, int n, const LAS unsigned* selw) {
    const float NEG = -__builtin_inff();
#pragma unroll
    for (int qt = 0; qt < 2; ++qt) {
        bool tokok = true;
        if (MODE == M_SEL) tokok = ((selw[(4 * qt + (C.c >> 2)) * 2 + (n >> 5)] >> (n & 31)) & 1u) != 0u;
        if (FAR) { const float be = tokok ? C.lutrow[127] : NEG;
#pragma unroll
            for (int kt = 0; kt < 4; ++kt)
#pragma unroll
                for (int rg = 0; rg < 4; ++rg) s[qt][kt][rg] = __builtin_fmaf(s[qt][kt][rg], LOG2E, be);
            continue; }
        const int dbase = (MODE == M_CMP) ? (C.pos0 + 4 * qt - 31 - 16 * (kb + 4 * C.gq)) : (C.pos0 + 4 * qt - (kb + 4 * C.gq));
#pragma unroll
        for (int kt = 0; kt < 4; ++kt) {
#pragma unroll
            for (int rg = 0; rg < 4; ++rg) { const int d = (MODE == M_CMP) ? dbase - 16 * (16 * kt + rg) : dbase - (16 * kt + rg);
                int di = d < 0 ? 0 : d; di = di > 127 ? 127 : di; const float bias = C.lutrow[di];
                bool ok = tokok && d >= 0; if (MODE == M_WIN) ok = ok && d < 512;
                s[qt][kt][rg] = ok ? __builtin_fmaf(s[qt][kt][rg], LOG2E, bias) : NEG; }
            asm volatile("" ::: "memory"); }
    }
}
__device__ __forceinline__ void softmax_step(f4 (&s)[2][4], float (&m)[2], float (&l)[2], f4 (&o)[2][8], bool rescale_o) {
#pragma unroll
    for (int qt = 0; qt < 2; ++qt) { float mx = s[qt][0][0];
#pragma unroll
        for (int kt = 0; kt < 4; ++kt)
#pragma unroll
            for (int rg = 0; rg < 4; ++rg) mx = fmaxf(mx, s[qt][kt][rg]);
        mx = rmax32(rmax16(mx));
        const float mn = fmaxf(m[qt], mx), alpha = __builtin_amdgcn_exp2f(m[qt] - mn); m[qt] = mn; float ps = 0.f;
#pragma unroll
        for (int kt = 0; kt < 4; ++kt)
#pragma unroll
            for (int rg = 0; rg < 4; ++rg) { const float e = __builtin_amdgcn_exp2f(s[qt][kt][rg] - mn); s[qt][kt][rg] = e; ps += e; }
        l[qt] = l[qt] * alpha + ps;
        if (rescale_o && __any(alpha != 1.f)) {
#pragma unroll
            for (int dt = 0; dt < 8; ++dt) o[qt][dt] = o[qt][dt] * alpha; }
    }
}
template <int MODE>
__device__ __forceinline__ void softmax_far(const Ctx& C, f4 (&s)[2][4], int n, const LAS unsigned* selw, float (&m)[2], float (&l)[2], f4 (&o)[2][8]) {
    const float b31 = C.lutrow[127];
#pragma unroll
    for (int qt = 0; qt < 2; ++qt) {
        float be = b31;
        if (MODE == M_SEL) { const bool tokok = ((selw[(4 * qt + (C.c >> 2)) * 2 + (n >> 5)] >> (n & 31)) & 1u) != 0u; be = tokok ? b31 : -__builtin_inff(); }
        float mx = fmaxf(fmaxf(s[qt][0][0], s[qt][0][1]), fmaxf(s[qt][0][2], s[qt][0][3]));
#pragma unroll
        for (int kt = 1; kt < 4; ++kt) mx = fmaxf(mx, fmaxf(fmaxf(s[qt][kt][0], s[qt][kt][1]), fmaxf(s[qt][kt][2], s[qt][kt][3])));
        mx = rmax32(rmax16(mx));
        const float mt = __builtin_fmaf(mx, LOG2E, be), mn = fmaxf(m[qt], mt), alpha = __builtin_amdgcn_exp2f(m[qt] - mn), c0 = be - mn; m[qt] = mn; float ps = 0.f;
#pragma unroll
        for (int kt = 0; kt < 4; ++kt)
#pragma unroll
            for (int rg = 0; rg < 4; ++rg) { const float e = __builtin_amdgcn_exp2f(__builtin_fmaf(s[qt][kt][rg], LOG2E, c0)); s[qt][kt][rg] = e; ps += e; }
        l[qt] = l[qt] * alpha + ps;
        if (__any(alpha != 1.f)) {
#pragma unroll
            for (int dt = 0; dt < 8; ++dt) o[qt][dt] = o[qt][dt] * alpha; }
    }
}
}

__device__ __forceinline__ void ph_nsa(const Params& p, LAS unsigned char* lds, int idx0, int idxstride, int tid_in, int wave) {
    using namespace nsa;
    int tid = tid_in; asm volatile("" : "+v"(tid));
    const int lane = tid & 63;
    Ctx C; C.lds = lds; C.tid = tid; C.lane = lane; C.wave = wave; C.c = lane & 15; C.gq = lane >> 4; C.r = lane & 3;
    C.koff0 = C.c * 256 + ((C.gq ^ C.c) * 16);
#pragma unroll
    for (int i = 0; i < 2; ++i) { const int piece = 2 * wave + i;
        { const int row = piece * 4 + (lane >> 4), chunk = (lane & 15) ^ (row & 15); C.kdo[i] = (unsigned)(row * 256 + chunk * 16); }
        { const int row = piece * 8 + (lane >> 3), chunk = (lane & 7) ^ ((row >> 1) & 7); C.vdoc[i] = (unsigned)(row * 256 * 2 + chunk * 16); C.vdos[i] = (unsigned)(row * SEQ * 2 + chunk * 16); } }
    C.voff0 = C.c * 128 + (((C.gq >> 1) ^ ((C.c >> 1) & 7)) * 16) + (C.gq & 1) * 8;
    const bf16* NQ = (const bf16*)(p.ws + WS_NQ); const bf16* SM = (const bf16*)(p.ws + WS_SM); bf16* A2 = (bf16*)(p.ws + WS_A2);
    const float* relb = p.in[I_RELB]; const float* nsag = p.in[I_NSAG];
    LAS float* lut = (LAS float*)(lds + LUT);
    for (int i = tid; i < 8 * 128; i += 512) { const int hh = i >> 7, d = i & 127; lut[i] = relb[(int)kBucket[d] * 8 + hh] * LOG2E; }
    __syncthreads();
    LAS unsigned char* qstw = lds + QST + wave * 8192 + lane * 16; C.qst = qstw;
    LAS float* imp = (LAS float*)(lds + IMP + wave * 2048);
    LAS unsigned long long* selm = (LAS unsigned long long*)(lds + SELM + wave * 64);
#define NSA_SYNC() do { asm volatile("s_waitcnt vmcnt(0)" ::: "memory"); __syncthreads(); } while (0)
    for (int idx = idx0; idx < 512; idx += idxstride) {
        const int rnd = idx >> 8, kq = idx & 255, b = kq & 7, tq = rnd == 0 ? 63 - (kq >> 3) : (kq >> 3);
        C.s0 = tq * 64; C.cur = tq;
        const int tokl0 = 8 * wave + (C.c >> 2);
        C.pos0 = C.s0 + tokl0;
        float ssq[2] = {0.f, 0.f};
        for (int g = 0; g < 2; ++g) {
            const int bg = b * 2 + g, h = g * 4 + C.r;
            C.lutrow = lut + h * 128;
            const bf16* KCMP = (const bf16*)(p.ws + WS_KCMP) + (size_t)bg * 256 * 128; const bf16* VCMPT = (const bf16*)(p.ws + WS_VCMPT) + (size_t)bg * 128 * 256;
#pragma unroll
            for (int qt = 0; qt < 2; ++qt) { const unsigned qo = (unsigned)(((b * SEQ + (C.pos0 + 4 * qt)) * 1024 + h * 128 + 8 * C.gq) * 2);
#pragma unroll
                for (int ks = 0; ks < 4; ++ks) *(LAS bf16x8*)(qstw + (qt * 4 + ks) * 1024) = *(const bf16x8*)((const char*)NQ + qo + ks * 64); }
#pragma unroll
            for (int i = 0; i < 2; ++i) *(LAS f32x4*)((LAS unsigned char*)imp + lane * 16 + i * 1024) = (f32x4){0.f, 0.f, 0.f, 0.f};
#define NSA_OROW(qt) ((char*)A2 + (unsigned)(((b * SEQ + C.pos0 + 4 * (qt)) * DM + 1024 + h * 128 + 4 * C.gq) * 2))
            const int cmaxb = C.s0 + 63 - 31; const int nct = cmaxb >= 0 ? ((cmaxb >> 4) >> 6) + 1 : 0;
            float m[2] = {-1e30f, -1e30f}, l[2] = {0.f, 0.f};
            f4 o[2][8];
            if (nct > 0) {
                dma_k(C, KCMP, lds + KB0); NSA_SYNC();
                for (int ct = 0; ct < nct; ++ct) { const int buf = ct & 1;
                    if (ct + 1 < nct) dma_k(C, KCMP + (ct + 1) * 64 * 128, lds + (buf ? KB0 : KB1));
                    f4 s[2][4]; compute_st(C, lds + (buf ? KB1 : KB0), s); mask_bias<M_CMP>(C, s, 64 * ct, 0, (const LAS unsigned*)selm); softmax_step(s, m, l, o, false);
                    NSA_SYNC(); }
            }
            float inv[2];
#pragma unroll
            for (int qt = 0; qt < 2; ++qt) { const float lt = radd32(radd16(l[qt])); inv[qt] = lt > 0.f ? 1.f / lt : 0.f; }
#pragma unroll
            for (int qt = 0; qt < 2; ++qt)
#pragma unroll
                for (int dt = 0; dt < 8; ++dt) o[qt][dt] = (f4){0.f, 0.f, 0.f, 0.f};
            if (nct > 0) {
                dma_k(C, KCMP, lds + KB0); dma_v(C, VCMPT, C.vdoc, lds + VB0); NSA_SYNC();
                for (int ct = 0; ct < nct; ++ct) { const int buf = ct & 1;
                    if (ct + 1 < nct) { dma_k(C, KCMP + (ct + 1) * 64 * 128, lds + (buf ? KB0 : KB1)); dma_v(C, VCMPT + 64 * (ct + 1), C.vdoc, lds + (buf ? VB0 : VB1)); }
                    f4 s[2][4]; compute_st(C, lds + (buf ? KB1 : KB0), s); mask_bias<M_CMP>(C, s, 64 * ct, 0, (const LAS unsigned*)selm);
#pragma unroll
                    for (int qt = 0; qt < 2; ++qt)
#pragma unroll
                        for (int kt = 0; kt < 4; ++kt) {
#pragma unroll
                            for (int rg = 0; rg < 4; ++rg) s[qt][kt][rg] = __builtin_amdgcn_exp2f(s[qt][kt][rg] - m[qt]) * inv[qt];
                            float po = (s[qt][kt][0] + s[qt][kt][1]) + (s[qt][kt][2] + s[qt][kt][3]), p3 = s[qt][kt][3];
                            po = raddq(po); p3 = raddq(p3);
                            const int nb = 16 * ct + 4 * kt + C.gq, tl = 4 * qt + (C.c >> 2);
                            if (C.r == 0) { __hip_atomic_fetch_add((float*)(imp + tl * 64 + nb), po, __ATOMIC_RELAXED, __HIP_MEMORY_SCOPE_WORKGROUP); if (nb + 1 < 64) __hip_atomic_fetch_add((float*)(imp + tl * 64 + nb + 1), p3, __ATOMIC_RELAXED, __HIP_MEMORY_SCOPE_WORKGROUP); } }
                    compute_pv(C, lds + (buf ? VB1 : VB0), s, o);
                    NSA_SYNC(); }
            }
            LDS_WAIT(); __builtin_amdgcn_wave_barrier();
            for (int tk = 0; tk < 8; ++tk) { const int n = lane; float sc;
                if (n == 0 || n == C.cur || n == C.cur - 1) sc = 1e4f; else if (n <= C.cur) sc = imp[tk * 64 + n]; else sc = -1.f;
                const int key = ((sc < 0.f ? 0 : __float_as_int(sc) + 64) & ~63) | (63 - n);
                int rank = 0;
#pragma unroll
                for (int mm = 0; mm < 64; ++mm) rank += (__builtin_amdgcn_readlane(key, mm) > key) ? 1 : 0;
                const unsigned long long mk = __ballot(rank < 16);
                if (lane == 0) selm[tk] = mk; }
            LDS_WAIT(); __builtin_amdgcn_wave_barrier();
#pragma unroll
            for (int qt = 0; qt < 2; ++qt) { const float gt = 1.f / (1.f + __expf(-bf2f(*(const bf16*)((const char*)SM + (unsigned)(((b * SEQ + (C.pos0 + 4 * qt)) * 64 + 16 + h) * 2)))));
#pragma unroll
                for (int dt = 0; dt < 8; ++dt) { const f4 v = o[qt][dt] * gt; *(v2u*)(NSA_OROW(qt) + 32 * dt) = (v2u){pg8::cvt_pk_bf16(v[0], v[1]), pg8::cvt_pk_bf16(v[2], v[3])}; } }
#pragma unroll
            for (int br = 1; br <= 2; ++br) {
                const bf16* KX = (const bf16*)(p.ws + (br == 1 ? WS_KS : WS_KW)) + bg * SEQ * 128; const bf16* VX = (const bf16*)(p.ws + (br == 1 ? WS_VST : WS_VWT)) + bg * 128 * SEQ;
                const int n0 = br == 1 ? 0 : (C.cur >= 8 ? C.cur - 8 : 0), n1 = C.cur;
                m[0] = m[1] = -1e30f; l[0] = l[1] = 0.f;
#pragma unroll
                for (int qt = 0; qt < 2; ++qt)
#pragma unroll
                    for (int dt = 0; dt < 8; ++dt) o[qt][dt] = (f4){0.f, 0.f, 0.f, 0.f};
                int f0 = n1 + 1, f1 = n0 - 1;
                for (int n = n0; n <= n1; ++n) { const bool fa = (C.s0 - (64 * n + 63) >= 113) && (br == 1 || (C.s0 + 63 - 64 * n) < 512); if (fa) { f0 = n < f0 ? n : f0; f1 = n; } }
                const int cntf = f1 >= f0 ? f1 - f0 + 1 : 0, cnt = n1 - n0 + 1, nlo = cntf ? f0 - n0 : cnt;
#define NSA_TILE(i) ((i) < cntf ? f0 + (i) : (((i) - cntf) < nlo ? n0 + ((i) - cntf) : f1 + 1 + ((i) - cntf - nlo)))
#define NSA_BODY(FARF) { const int n = NSA_TILE(i); const int buf = i & 1; \
                    if (i + 1 < cnt) { const int nn = NSA_TILE(i + 1); dma_k(C, KX + nn * 64 * 128, lds + (buf ? KB0 : KB1)); dma_v(C, VX + 64 * nn, C.vdos, lds + (buf ? VB0 : VB1)); } \
                    bool need = true; \
                    if (br == 1) { const unsigned any = ((const LAS unsigned*)selm)[(lane & 7) * 2 + (n >> 5)] >> (n & 31); need = __any((int)(any & 1u)); } \
                    if (need) { f4 s[2][4]; compute_st(C, lds + (buf ? KB1 : KB0), s); \
                        if (FARF) { if (br == 1) softmax_far<M_SEL>(C, s, n, (const LAS unsigned*)selm, m, l, o); else softmax_far<M_WIN>(C, s, n, (const LAS unsigned*)selm, m, l, o); } \
                        else { if (br == 1) mask_bias<M_SEL, false>(C, s, 64 * n, n, (const LAS unsigned*)selm); else mask_bias<M_WIN, false>(C, s, 64 * n, n, (const LAS unsigned*)selm); \
                            softmax_step(s, m, l, o, true); } \
                        compute_pv(C, lds + (buf ? VB1 : VB0), s, o); } \
                    NSA_SYNC(); }
                { const int nf = NSA_TILE(0); dma_k(C, KX + nf * 64 * 128, lds + KB0); dma_v(C, VX + 64 * nf, C.vdos, lds + VB0); NSA_SYNC(); }
                int i = 0;
                for (; i < cntf; ++i) NSA_BODY(true)
                for (; i < cnt; ++i) NSA_BODY(false)
#undef NSA_BODY
#undef NSA_TILE
                asm volatile("s_waitcnt vmcnt(0)" ::: "memory");
#pragma unroll
                for (int qt = 0; qt < 2; ++qt) { const float lt = radd32(radd16(l[qt]));
                    const int row = b * SEQ + (C.pos0 + 4 * qt);
                    const float sc = (1.f / (1.f + __expf(-bf2f(*(const bf16*)((const char*)SM + (unsigned)((row * 64 + 16 + 8 * br + h) * 2)))))) / lt;
#pragma unroll
                    for (int dt = 0; dt < 8; ++dt) { const f4 v = o[qt][dt] * sc; v2u* sp = (v2u*)(NSA_OROW(qt) + 32 * dt); const v2u pv = *sp;
                        const float a0 = bflo(pv.x) + v[0], a1 = bfhi(pv.x) + v[1], a2 = bflo(pv.y) + v[2], a3 = bfhi(pv.y) + v[3];
                        if (br == 2) ssq[qt] += (a0 * a0 + a1 * a1) + (a2 * a2 + a3 * a3);
                        *sp = (v2u){pg8::cvt_pk_bf16(a0, a1), pg8::cvt_pk_bf16(a2, a3)}; } }
            }
        }
        float rstd[2];
#pragma unroll
        for (int qt = 0; qt < 2; ++qt) { const float t = radd32(radd16(raddq(ssq[qt]))); rstd[qt] = 1.f / sqrtf(t * (1.f / 1024.f) + RMS_EPS); }
        asm volatile("s_waitcnt vmcnt(0)" ::: "memory");
#pragma unroll
        for (int qt = 0; qt < 2; ++qt) { const int sub = C.r * 4 + C.gq; bf16* orow = (bf16*)((char*)A2 + (unsigned)(((b * SEQ + (C.pos0 + 4 * qt)) * DM + 1024) * 2 + sub * 16)); const int subz = 0;
#pragma unroll
            for (int j = 0; j < 8; ++j) { const int col = (j * 16 + subz) * 8; v4u w = *(const v4u*)((const char*)orow + (unsigned)(col * 2)); const f32x4 g0 = *(const f32x4*)((const char*)nsag + (unsigned)(col * 4 + sub * 32)), g1 = *(const f32x4*)((const char*)nsag + (unsigned)(col * 4 + sub * 32 + 16)); const float rs = rstd[qt];
                w.x = pk2(bflo(w.x) * rs * g0.x, bfhi(w.x) * rs * g0.y); w.y = pk2(bflo(w.y) * rs * g0.z, bfhi(w.y) * rs * g0.w); w.z = pk2(bflo(w.z) * rs * g1.x, bfhi(w.z) * rs * g1.y); w.w = pk2(bflo(w.w) * rs * g1.z, bfhi(w.w) * rs * g1.w);
                *(v4u*)((char*)orow + (unsigned)(col * 2)) = w; } }
        NSA_SYNC();
    }
#undef NSA_SYNC
#undef NSA_OROW
}

constexpr size_t WS_ST = WS_LA;
constexpr size_t WS_DEC = WS_ST + (size_t)2048 * 256 * 128 * 2;
static_assert(WS_DEC + (size_t)2048 * 128 * 4 <= WS_KCMP, "gla scratch overlay");
namespace gla {
typedef float f4 __attribute__((ext_vector_type(4)));
constexpr int L_ST = 0, L_KT = 65536, L_QT = 81920, L_VT = 98304, L_GA = 131072, L_GT = L_GA + 4096, L_RED = L_GT + 2048, L_END = L_RED + 512;
struct CumIn { float w[16]; float bb; v4u sm; };
__device__ __forceinline__ CumIn load_cum(const Params& p, int tid, int t0, int h) { CumIn x;
    const bf16* SM = (const bf16*)(p.ws + WS_SM); const float* wa2 = p.in[I_WA2]; const float* ba = p.in[I_BA]; const int dk = tid & 127;
    x.sm = (v4u){0u, 0u, 0u, 0u};
    if (tid < 128) { const int j = tid >> 1, hf = tid & 1; x.sm = *(const v4u*)((const char*)SM + (unsigned)(((t0 + j) * 64 + hf * 8) * 2)); }
#pragma unroll
    for (int r = 0; r < 16; ++r) x.w[r] = wa2[r * 512 + h * 128 + dk];
    x.bb = ba[h * 128 + dk];
    return x; }
__device__ __forceinline__ void chunk_cumsum(const CumIn& in, LAS unsigned char* lds, int tid, float (&P)[16], float& blast) {
    LAS float* ga = (LAS float*)(lds + L_GA); LAS float* gt = (LAS float*)(lds + L_GT);
    if (tid < 128) { const int j = tid >> 1, hf = tid & 1; const v4u w = in.sm;
        LAS float* d = ga + j * 16 + hf * 8; d[0] = bflo(w.x); d[1] = bfhi(w.x); d[2] = bflo(w.y); d[3] = bfhi(w.y); d[4] = bflo(w.z); d[5] = bfhi(w.z); d[6] = bflo(w.w); d[7] = bfhi(w.w); }
    const int dk = tid & 127, jq = tid >> 7;
    const float bb = in.bb;
    __syncthreads();
    float run = 0.f;
#pragma unroll
    for (int jj = 0; jj < 16; ++jj) { const LAS f32x4* gr = (const LAS f32x4*)(ga + (16 * jq + jj) * 16); float z = bb;
#pragma unroll
        for (int r4 = 0; r4 < 4; ++r4) { const f32x4 g4 = gr[r4]; z += g4.x * in.w[4 * r4] + g4.y * in.w[4 * r4 + 1] + g4.z * in.w[4 * r4 + 2] + g4.w * in.w[4 * r4 + 3]; }
        run += (fminf(z, 0.f) - __logf(1.f + __expf(-fabsf(z)))) * (1.f / 16.f);   P[jj] = run; }
    gt[jq * 128 + dk] = run;
    __syncthreads();
    float off = 0.f, tot = 0.f;
#pragma unroll
    for (int q = 0; q < 4; ++q) { const float t = gt[q * 128 + dk]; tot += t; if (q < jq) off += t; }
#pragma unroll
    for (int jj = 0; jj < 16; ++jj) P[jj] += off;
    blast = tot;
}
struct RawK { v4u r[2]; }; struct RawV { v4u r[4]; };
__device__ __forceinline__ RawK load_raw_k(const bf16* src  , int tid, int t0, int h) { RawK x;
#pragma unroll
    for (int q = 0; q < 2; ++q) { const int id = tid + 512 * q, j = id >> 4, c16 = id & 15; x.r[q] = *(const v4u*)((const char*)src + (unsigned)(((t0 + j) * 512 + h * 128 + c16 * 8) * 2)); }
    return x; }
__device__ __forceinline__ void store_raw_k(LAS unsigned char* dst, int tid, const RawK& x) {
#pragma unroll
    for (int q = 0; q < 2; ++q) { const int id = tid + 512 * q, j = id >> 4, c16 = id & 15; *(LAS v4u*)(dst + j * 256 + c16 * 16) = x.r[q]; } }
__device__ __forceinline__ RawV load_raw_v(const Params& p, int tid, int t0, int h) { const bf16* GV = (const bf16*)(p.ws + WS_GV); RawV x;
#pragma unroll
    for (int q = 0; q < 4; ++q) { const int id = tid + 512 * q, j = id >> 5, c = id & 31; x.r[q] = *(const v4u*)((const char*)GV + (unsigned)(((t0 + j) * 1024 + h * 256 + c * 8) * 2)); }
    return x; }
__device__ __forceinline__ void store_raw_v(LAS unsigned char* dst, int tid, const RawV& x) {
#pragma unroll
    for (int q = 0; q < 4; ++q) { const int id = tid + 512 * q, j = id >> 5, c = id & 31; *(LAS v4u*)(dst + j * 512 + c * 16) = x.r[q]; } }
__device__ __forceinline__ void fill_vt(LAS unsigned char* lds, const LAS unsigned char* rv, int tid) {
    const int dv = tid & 255, jh = tid >> 8;
    unsigned short v[32];
#pragma unroll
    for (int jj = 0; jj < 32; ++jj) v[jj] = *(const LAS bf16*)(rv + (32 * jh + jj) * 512 + dv * 2);
    LAS unsigned char* row = lds + L_VT + dv * 128; const int f = (dv >> 1) & 7;
#pragma unroll
    for (int q = 0; q < 4; ++q) { v4u w; w.x = v[8 * q] | ((unsigned)v[8 * q + 1] << 16); w.y = v[8 * q + 2] | ((unsigned)v[8 * q + 3] << 16); w.z = v[8 * q + 4] | ((unsigned)v[8 * q + 5] << 16); w.w = v[8 * q + 6] | ((unsigned)v[8 * q + 7] << 16);
        *(LAS v4u*)(row + (((4 * jh + q) ^ f) * 16)) = w; }
}
}

__device__ __forceinline__ void ph_gla_a(const Params& p, LAS unsigned char* lds, int u0, int ustride, int tid_in, int wave) {
    using namespace gla;
    int tid = tid_in; asm volatile("" : "+v"(tid));
    const int lane = tid & 63, c = lane & 15, gq = lane >> 4;
    const bf16* GK = (const bf16*)(p.ws + WS_GK); bf16* ST = (bf16*)(p.ws + WS_ST); float* DEC = (float*)(p.ws + WS_DEC);
    RawK rk; RawV rv;
    CumIn ci;
    if (u0 < 2048) { const int bh = u0 >> 6, ch = u0 & 63; rk = load_raw_k(GK, tid, (bh >> 2) * SEQ + ch * 64, bh & 3); rv = load_raw_v(p, tid, (bh >> 2) * SEQ + ch * 64, bh & 3); ci = load_cum(p, tid, (bh >> 2) * SEQ + ch * 64, bh & 3); }
    for (int unit = u0; unit < 2048; unit += ustride) {
        const int bh = unit >> 6, ch = unit & 63, b = bh >> 2, h = bh & 3, t0 = b * SEQ + ch * 64;
        store_raw_k(lds + 0, tid, rk); store_raw_v(lds + 16384, tid, rv);
        float P[16], blast; chunk_cumsum(ci, lds, tid, P, blast);
        { const int dk = tid & 127, jq = tid >> 7;
          unsigned short kv[16];
#pragma unroll
          for (int jj = 0; jj < 16; ++jj) kv[jj] = *(const LAS bf16*)(lds + (16 * jq + jj) * 256 + dk * 2);
          unsigned pk[8];
#pragma unroll
          for (int q = 0; q < 8; ++q) pk[q] = pk2(bf2f(kv[2 * q]) * __expf(blast - P[2 * q]), bf2f(kv[2 * q + 1]) * __expf(blast - P[2 * q + 1]));
          LAS unsigned char* row = lds + L_KT + dk * 128; const int f = (dk >> 1) & 7;
          *(LAS v4u*)(row + (((2 * jq) ^ f) * 16)) = (v4u){pk[0], pk[1], pk[2], pk[3]}; *(LAS v4u*)(row + (((2 * jq + 1) ^ f) * 16)) = (v4u){pk[4], pk[5], pk[6], pk[7]};
          if (jq == 0) DEC[unit * 128 + dk] = __expf(blast); }
        fill_vt(lds, lds + 16384, tid);
        __syncthreads();
        { const int un = unit + ustride < 2048 ? unit + ustride : unit, bhn = un >> 6, chn = un & 63; rk = load_raw_k(GK, tid, (bhn >> 2) * SEQ + chn * 64, bhn & 3); rv = load_raw_v(p, tid, (bhn >> 2) * SEQ + chn * 64, bhn & 3); ci = load_cum(p, tid, (bhn >> 2) * SEQ + chn * 64, bhn & 3); }
        f4 acc[16];
        const int f = (c >> 1) & 7;
        bf16x8 aF[2];
#pragma unroll
        for (int ks = 0; ks < 2; ++ks) aF[ks] = *(const LAS bf16x8*)(lds + L_KT + (16 * wave + c) * 128 + (((4 * ks + gq) ^ f) * 16));
#pragma unroll
        for (int nt = 0; nt < 16; ++nt) { acc[nt] = (f4){0.f, 0.f, 0.f, 0.f};
#pragma unroll
            for (int ks = 0; ks < 2; ++ks) { const bf16x8 bF = *(const LAS bf16x8*)(lds + L_VT + (16 * nt + c) * 128 + (((4 * ks + gq) ^ f) * 16)); acc[nt] = __builtin_amdgcn_mfma_f32_16x16x32_bf16(aF[ks], bF, acc[nt], 0, 0, 0); } }
        char* dst = (char*)ST + (size_t)unit * (256 * 128 * 2) + (unsigned)((c * 128 + 16 * wave + 4 * gq) * 2);
#pragma unroll
        for (int nt = 0; nt < 16; ++nt) *(v2u*)(dst + nt * 16 * 256) = (v2u){pg8::cvt_pk_bf16(acc[nt][0], acc[nt][1]), pg8::cvt_pk_bf16(acc[nt][2], acc[nt][3])};
        __syncthreads();
    }
}
__device__ __forceinline__ void ph_gla_b(const Params& p, int gid, int gstride) {
    bf16* ST = (bf16*)(p.ws + WS_ST); const float* DEC = (const float*)(p.ws + WS_DEC);
    for (int e = gid; e < 32 * 4096; e += gstride) { const int bh = e >> 12, dv = (e >> 4) & 255, d8 = e & 15;
        float st[8];
#pragma unroll
        for (int i = 0; i < 8; ++i) st[i] = 0.f;
        char* base = (char*)ST + (size_t)bh * 64 * (256 * 128 * 2) + (unsigned)((dv * 128 + d8 * 8) * 2); const float* dbase = DEC + (size_t)bh * 64 * 128 + d8 * 8;
#pragma unroll 4
        for (int ch = 0; ch < 64; ++ch) { v4u* ptr = (v4u*)(base + (size_t)ch * (256 * 128 * 2)); const v4u w = *ptr; const f32x4 d0 = *(const f32x4*)(dbase + ch * 128), d1 = *(const f32x4*)(dbase + ch * 128 + 4);
            v4u o; o.x = pk2(st[0], st[1]); o.y = pk2(st[2], st[3]); o.z = pk2(st[4], st[5]); o.w = pk2(st[6], st[7]); *ptr = o;
            st[0] = st[0] * d0.x + bflo(w.x); st[1] = st[1] * d0.y + bfhi(w.x); st[2] = st[2] * d0.z + bflo(w.y); st[3] = st[3] * d0.w + bfhi(w.y);
            st[4] = st[4] * d1.x + bflo(w.z); st[5] = st[5] * d1.y + bfhi(w.z); st[6] = st[6] * d1.z + bflo(w.w); st[7] = st[7] * d1.w + bfhi(w.w); }
    }
}
__device__ __forceinline__ void ph_gla_c(const Params& p, LAS unsigned char* lds, int u0, int ustride, int tid_in, int wave) {
    using namespace gla;
    int tid = tid_in; asm volatile("" : "+v"(tid));
    const int lane = tid & 63, c = lane & 15, gq = lane >> 4, nt = wave & 3, half = wave >> 2;
    const bf16* GQ = (const bf16*)(p.ws + WS_GQ); const bf16* GK = (const bf16*)(p.ws + WS_GK); const bf16* GG = (const bf16*)(p.ws + WS_GG); const bf16* ST = (const bf16*)(p.ws + WS_ST);
    bf16* A2 = (bf16*)(p.ws + WS_A2); const float* gn = p.in[I_GLAG];
    const int koff0 = c * 256 + ((gq ^ c) * 16), voff0 = c * 128 + (((gq >> 1) ^ ((c >> 1) & 7)) * 16) + (gq & 1) * 8;
    CumIn ci; RawK rq, rk; RawV rv;
    if (u0 < 2048) { const int bh = u0 >> 6, ch = u0 & 63, t0 = (bh >> 2) * SEQ + ch * 64; rq = load_raw_k(GQ, tid, t0, bh & 3); rk = load_raw_k(GK, tid, t0, bh & 3); rv = load_raw_v(p, tid, t0, bh & 3); ci = load_cum(p, tid, t0, bh & 3); }
    for (int unit = u0; unit < 2048; unit += ustride) {
        const int bh = unit >> 6, ch = unit & 63, b = bh >> 2, h = bh & 3, t0 = b * SEQ + ch * 64;
        store_raw_k(lds + 0, tid, rq); store_raw_k(lds + 16384, tid, rk); store_raw_v(lds + 32768, tid, rv);
        float P[16], blast; chunk_cumsum(ci, lds, tid, P, blast);
        { const int dk = tid & 127, jq = tid >> 7;
#pragma unroll
          for (int jj = 0; jj < 16; ++jj) { const int j = 16 * jq + jj; const float qv = bf2f(*(const LAS bf16*)(lds + j * 256 + dk * 2)), kv = bf2f(*(const LAS bf16*)(lds + 16384 + j * 256 + dk * 2));
              const int off = j * 256 + (((dk >> 3) ^ (j & 15)) * 16) + (dk & 7) * 2;
              *(LAS bf16*)(lds + L_QT + off) = (bf16)f2bf(qv * __expf(P[jj])); *(LAS bf16*)(lds + L_KT + off) = (bf16)f2bf(kv * __expf(-P[jj])); } }
        fill_vt(lds, lds + 32768, tid);
        __syncthreads();
        { const char* src = (const char*)ST + (size_t)unit * (256 * 128 * 2);
#pragma unroll
          for (int i = 0; i < 8; ++i) { const int piece = 8 * wave + i, row = piece * 4 + (lane >> 4), chunk = (lane & 15) ^ (row & 15);
              __builtin_amdgcn_global_load_lds((const unsigned*)(src + (unsigned)(row * 256 + chunk * 16)), (LAS unsigned*)(lds + L_ST + piece * 1024), 16, 0, 0); } }
        v2u ggr[8];
        { const int tokg = t0 + 16 * nt + c;
#pragma unroll
          for (int mt = 0; mt < 8; ++mt) ggr[mt] = *(const v2u*)((const char*)GG + (unsigned)((tokg * 1024 + h * 256 + 128 * half + 16 * mt + 4 * gq) * 2)); }
        asm volatile("s_waitcnt vmcnt(0)" ::: "memory"); __syncthreads();
        { const int un = unit + ustride < 2048 ? unit + ustride : unit, bhn = un >> 6, chn = un & 63, tn = (bhn >> 2) * SEQ + chn * 64; rq = load_raw_k(GQ, tid, tn, bhn & 3); rk = load_raw_k(GK, tid, tn, bhn & 3); rv = load_raw_v(p, tid, tn, bhn & 3); ci = load_cum(p, tid, tn, bhn & 3); }
        bf16x8 qF[4];
#pragma unroll
        for (int ks = 0; ks < 4; ++ks) qF[ks] = *(const LAS bf16x8*)(lds + L_QT + nt * 4096 + (koff0 ^ (ks * 64)));
        f4 sT[4];
#pragma unroll
        for (int jt = 0; jt < 4; ++jt) { sT[jt] = (f4){0.f, 0.f, 0.f, 0.f};
            if (jt <= nt) {
#pragma unroll
                for (int ks = 0; ks < 4; ++ks) { const bf16x8 a = *(const LAS bf16x8*)(lds + L_KT + jt * 4096 + (koff0 ^ (ks * 64))); sT[jt] = __builtin_amdgcn_mfma_f32_16x16x32_bf16(a, qF[ks], sT[jt], 0, 0, 0); }
                if (jt == nt) {
#pragma unroll
                    for (int rg = 0; rg < 4; ++rg) if (4 * gq + rg > c) sT[jt][rg] = 0.f; } } }
        bf16x8 pb[2];
#pragma unroll
        for (int s = 0; s < 2; ++s) { v4u w; w.x = pg8::cvt_pk_bf16(sT[2 * s][0], sT[2 * s][1]); w.y = pg8::cvt_pk_bf16(sT[2 * s][2], sT[2 * s][3]); w.z = pg8::cvt_pk_bf16(sT[2 * s + 1][0], sT[2 * s + 1][1]); w.w = pg8::cvt_pk_bf16(sT[2 * s + 1][2], sT[2 * s + 1][3]); pb[s] = __builtin_bit_cast(bf16x8, w); }
        f4 o[8]; float ss = 0.f;
#pragma unroll
        for (int mt = 0; mt < 8; ++mt) { o[mt] = (f4){0.f, 0.f, 0.f, 0.f}; const int rb = 128 * half + 16 * mt;
#pragma unroll
            for (int ks = 0; ks < 4; ++ks) { const bf16x8 a = *(const LAS bf16x8*)(lds + L_ST + rb * 256 + (koff0 ^ (ks * 64))); o[mt] = __builtin_amdgcn_mfma_f32_16x16x32_bf16(a, qF[ks], o[mt], 0, 0, 0); }
#pragma unroll
            for (int s = 0; s < 2; ++s) if (2 * s <= nt) { const v2u lo = *(const LAS v2u*)(lds + L_VT + rb * 128 + (voff0 ^ (s * 64))), hi = *(const LAS v2u*)(lds + L_VT + rb * 128 + (voff0 ^ (s * 64 + 32)));
                o[mt] = __builtin_amdgcn_mfma_f32_16x16x32_bf16(__builtin_bit_cast(bf16x8, (v4u){lo.x, lo.y, hi.x, hi.y}), pb[s], o[mt], 0, 0, 0); }
            ss += (o[mt][0] * o[mt][0] + o[mt][1] * o[mt][1]) + (o[mt][2] * o[mt][2] + o[mt][3] * o[mt][3]); }
        ss = nsa::radd32(nsa::radd16(ss));
        LAS float* red = (LAS float*)(lds + L_RED);
        if (gq == 0) red[half * 64 + 16 * nt + c] = ss;
        __syncthreads();
        const float rstd = 1.f / sqrtf((red[16 * nt + c] + red[64 + 16 * nt + c]) * (1.f / 256.f) + RMS_EPS);
        const int tok = t0 + 16 * nt + c;
#pragma unroll
        for (int mt = 0; mt < 8; ++mt) { const int dv = 128 * half + 16 * mt + 4 * gq; const f32x4 g4 = *(const f32x4*)((const char*)gn + (unsigned)(dv * 4));
            const v2u gg = ggr[mt];
            const float z0 = bflo(gg.x), z1 = bfhi(gg.x), z2 = bflo(gg.y), z3 = bfhi(gg.y);
            v2u w; w.x = pg8::cvt_pk_bf16(o[mt][0] * rstd * g4.x * (z0 * __builtin_amdgcn_rcpf(1.f + __expf(-z0))), o[mt][1] * rstd * g4.y * (z1 * __builtin_amdgcn_rcpf(1.f + __expf(-z1))));
            w.y = pg8::cvt_pk_bf16(o[mt][2] * rstd * g4.z * (z2 * __builtin_amdgcn_rcpf(1.f + __expf(-z2))), o[mt][3] * rstd * g4.w * (z3 * __builtin_amdgcn_rcpf(1.f + __expf(-z3))));
            *(v2u*)((char*)A2 + (unsigned)((tok * DM + h * 256 + dv) * 2)) = w; }
        __syncthreads();
    }
}

constexpr size_t WS_LH = WS_DEC + (size_t)2048 * 128 * 4;
constexpr size_t WS_PEV = WS_LH + (size_t)2 * 4096 * 256 * 4;
static_assert(WS_PEV + 1024 <= WS_KCMP, "cmp scratch overlay");
struct CmpOrder {
    int c; const bf16 *kc, *vc, *wk, *wv;
    __device__ __forceinline__ bool next(int i, pg8::Unit& u) const { if (i > 0 || c >= 32) return false; u.pm = c & 15; u.pn = 0; u.kind = c >> 4; return true; }
    __device__ __forceinline__ const char* pa(const pg8::Gemm&, const pg8::Unit& u) const { return (const char*)(u.kind ? vc : kc) + (size_t)u.pm * ((size_t)256 * 2048 * 2); }
    __device__ __forceinline__ const char* pb(const pg8::Gemm&, const pg8::Unit& u) const { return (const char*)(u.kind ? wv : wk); }
    __device__ __forceinline__ void a_ready(const pg8::Unit&) const {}
    __device__ __forceinline__ void done(const pg8::Unit&) const {}
};
struct EpiLH {
    static constexpr bool PERM = false, AFTER_DRAIN = false;
    float* LH;
    __device__ __forceinline__ void operator()(const pg8::f32x4 (&acc)[2][2][4][2], const pg8::Unit& u, int wr, int wc, int fr, int fq) const {
        const int row0 = u.kind * 4096 + u.pm * 256 + wr * 64 + fr, col0 = wc * 32 + 4 * fq;
#pragma unroll
        for (int ai = 0; ai < 2; ++ai)
#pragma unroll
            for (int m = 0; m < 4; ++m) { float* rowp = LH + (size_t)(row0 + ai * 128 + m * 16) * 256 + col0;
#pragma unroll
                for (int bj = 0; bj < 2; ++bj)
#pragma unroll
                    for (int n = 0; n < 2; ++n) *(pg8::f32x4*)(rowp + bj * 128 + n * 16) = acc[ai][bj][m][n]; }
    }
};

constexpr size_t PROWS = (size_t)MAXTILES * 256;
constexpr size_t WS_W1Q = WS_W1T;
constexpr size_t WS_W2Q = WS_W1Q + (size_t)NE * 4096 * DM;
constexpr size_t WS_HN8 = WS_W2Q + (size_t)NE * DM * DFF;
constexpr size_t WS_AMAXP = WS_HN8 + (size_t)T * DM;
constexpr size_t WS_WSC1 = WS_AMAXP + PROWS * 64 * 4;
constexpr size_t WS_WSC2 = WS_WSC1 + (size_t)NE * 4096 * 4;
constexpr size_t WS_HSC = WS_WSC2 + (size_t)NE * 2048 * 4;
constexpr size_t WS_ROWSC = WS_HSC + (size_t)T * 4;
constexpr size_t WS_ASC = WS_ROWSC + PROWS * 4;
static_assert(WS_ASC + PROWS * 4 <= WS_XN, "int8 buffers fit in the retired bf16 expert-weight region");
constexpr size_t WS_ROWTOK = WS_CTL + 512 * 1024;
static_assert(PROWS * 2 <= 512 * 1024 && DM == 2048, "row table fits; gathered rows are 2048 bytes");
constexpr size_t WS_H16 = WS_XG;
static_assert((size_t)T * DM * 2 <= PROWS * DM, "h fits below ACT8");
constexpr size_t WS_XG8 = WS_XG;
constexpr size_t WS_ACT8 = WS_XG + PROWS * DM;
constexpr size_t WS_Y = WS_ACT;
static_assert(WS_ACT8 + PROWS * DM <= WS_ACT, "int8 row buffers fit in the retired gathered-row region");

__device__ __forceinline__ unsigned q8x4(float a, float b, float c, float d) {
    const float M = 12582912.f; const unsigned ua = __builtin_bit_cast(unsigned, a + M), ub = __builtin_bit_cast(unsigned, b + M), uc = __builtin_bit_cast(unsigned, c + M), ud = __builtin_bit_cast(unsigned, d + M);
    return __builtin_amdgcn_perm(ub, ua, 0x0c0c0400u) | (__builtin_amdgcn_perm(ud, uc, 0x0c0c0400u) << 16); }
__device__ __forceinline__ float clamp127(float v) { return __builtin_amdgcn_fmed3f(v, -127.f, 127.f); }
__device__ __forceinline__ unsigned q8x4c(float a, float b, float c, float d) { return q8x4(clamp127(a), clamp127(b), clamp127(c), clamp127(d)); }

constexpr size_t WS_WINQ = WS_WINT;
constexpr size_t WS_WISC = WS_WINT + (size_t)NPT * 256 * DM;
constexpr size_t WS_XN8 = WS_XN;
constexpr size_t WS_XSC = WS_XN + (size_t)T * DM;
constexpr size_t WS_PMAX = WS_HN;
constexpr size_t WS_PMAXI = WS_PMAX + (size_t)64 * 8 * 4096 * 4;

constexpr int NSLAB_E = NE * 192, NSLAB = NSLAB_E + 178;
struct SlabSrc { const float* W; int N; bool ok; };
__device__ __forceinline__ SlabSrc slab_src(const Params& p, int sl, int r0, int n4) {
    SlabSrc s;
    if (sl < NSLAB_E) { const int e = sl / 192, r = sl % 192; const bool isw2 = r >= 128; const int nb = isw2 ? r - 128 : r; s.N = isw2 ? 2048 : 4096;
        s.W = (isw2 ? p.in[I_W2] + (size_t)e * DFF * DM : p.in[I_W1] + (size_t)e * DM * 4096) + (size_t)r0 * s.N + nb * 32 + 4 * n4; s.ok = true; }
    else { const int nb = sl - NSLAB_E; s.N = 5672; s.ok = nb * 32 + 4 * n4 < 5672; s.W = p.in[I_WIN] + (size_t)r0 * 5672 + (s.ok ? nb * 32 + 4 * n4 : 0); }
    return s;
}
__device__ __forceinline__ void p0_slab_quant(const Params& p, LAS unsigned char* lds, int bid, int G, int tid) {
    constexpr int RS = 4104;
    LAS unsigned char* TT = lds; LAS float* part = (LAS float*)(lds + 32 * RS); LAS float* inv = part + 64 * 32; LAS int* drow = (LAS int*)(inv + 32);
    signed char* W1Q = (signed char*)(p.ws + WS_W1Q); signed char* W2Q = (signed char*)(p.ws + WS_W2Q); signed char* WIQ = (signed char*)(p.ws + WS_WINQ);
    float* WSC1 = (float*)(p.ws + WS_WSC1); float* WSC2 = (float*)(p.ws + WS_WSC2); float* WISC = (float*)(p.ws + WS_WISC);
    const int n4 = tid & 7, r0 = tid >> 3;
    f32x4 va[8], vb[8];
#define SLAB_ISSUE(dst, sl, j) do { if ((sl) < NSLAB) { const SlabSrc ss_ = slab_src(p, (sl), 2 * r0, n4); _Pragma("unroll") for (int u = 0; u < 8; ++u) dst[u] = __builtin_nontemporal_load((const f32x4*)(ss_.W + (size_t)(128 * (4 * (j) + (u >> 1)) + (u & 1)) * ss_.N)); } } while (0)
#define SLAB_USE(src, j) do { _Pragma("unroll") for (int u2 = 0; u2 < 4; ++u2) { const f32x4 xa = src[2 * u2], xb = src[2 * u2 + 1]; const int k = 2 * r0 + 128 * (4 * (j) + u2);        \
            const unsigned w0 = cvt2bf(xa.x, xb.x), w1 = cvt2bf(xa.y, xb.y), w2 = cvt2bf(xa.z, xb.z), w3 = cvt2bf(xa.w, xb.w);        \
            mx0 = __builtin_elementwise_max(mx0, __builtin_bit_cast(u16x2, w0 & 0x7fff7fffu)); mx1 = __builtin_elementwise_max(mx1, __builtin_bit_cast(u16x2, w1 & 0x7fff7fffu)); \
            mx2 = __builtin_elementwise_max(mx2, __builtin_bit_cast(u16x2, w2 & 0x7fff7fffu)); mx3 = __builtin_elementwise_max(mx3, __builtin_bit_cast(u16x2, w3 & 0x7fff7fffu)); \
            LAS unsigned char* d = TT + (4 * n4) * RS + k * 2; \
            *(LAS unsigned*)d = w0; *(LAS unsigned*)(d + RS) = w1; *(LAS unsigned*)(d + 2 * RS) = w2; *(LAS unsigned*)(d + 3 * RS) = w3; } } while (0)
    SLAB_ISSUE(va, bid, 0); SLAB_ISSUE(vb, bid, 1);
    for (int slab = bid; slab < NSLAB; slab += G) {
        u16x2 mx0 = (u16x2){0, 0}, mx1 = (u16x2){0, 0}, mx2 = (u16x2){0, 0}, mx3 = (u16x2){0, 0};
        SLAB_USE(va, 0); SLAB_ISSUE(va, slab, 2);
        SLAB_USE(vb, 1); SLAB_ISSUE(vb, slab, 3);
        SLAB_USE(va, 2); SLAB_ISSUE(va, slab + G, 0);
        SLAB_USE(vb, 3); SLAB_ISSUE(vb, slab + G, 1);
        { u16x2 t0, t1; { const unsigned m0 = __builtin_bit_cast(unsigned, mx0), m1 = __builtin_bit_cast(unsigned, mx1), m2 = __builtin_bit_cast(unsigned, mx2), m3 = __builtin_bit_cast(unsigned, mx3);
            t0 = __builtin_elementwise_max(__builtin_bit_cast(u16x2, __builtin_amdgcn_perm(m1, m0, 0x05040100u)), __builtin_bit_cast(u16x2, __builtin_amdgcn_perm(m1, m0, 0x07060302u)));
            t1 = __builtin_elementwise_max(__builtin_bit_cast(u16x2, __builtin_amdgcn_perm(m3, m2, 0x05040100u)), __builtin_bit_cast(u16x2, __builtin_amdgcn_perm(m3, m2, 0x07060302u))); }
#pragma unroll
          for (int o = 8; o < 64; o <<= 1) { t0 = __builtin_elementwise_max(t0, __builtin_bit_cast(u16x2, __shfl_xor(__builtin_bit_cast(int, t0), o))); t1 = __builtin_elementwise_max(t1, __builtin_bit_cast(u16x2, __shfl_xor(__builtin_bit_cast(int, t1), o))); }
          const unsigned a0 = __builtin_bit_cast(unsigned, t0), a1 = __builtin_bit_cast(unsigned, t1);
          if ((tid & 63) < 8) *(LAS f32x4*)(part + (tid >> 6) * 32 + 4 * n4) = (f32x4){bflo(a0), bfhi(a0), bflo(a1), bfhi(a1)}; }
        __syncthreads();
        if (tid < 32) { float m = 0.f;
#pragma unroll
            for (int q = 0; q < 8; ++q) m = fmaxf(m, part[q * 32 + tid]);
            const float sc = m > 0.f ? m * (1.f / 127.f) : 1.f; inv[tid] = 1.f / sc;
            if (slab < NSLAB_E) { const int e = slab / 192, r = slab % 192; const bool isw2 = r >= 128; const int n = (isw2 ? r - 128 : r) * 32 + tid;
                if (isw2) { drow[tid] = e * 2048 + n; WSC2[e * 2048 + n] = sc; }
                else { const int j2 = n & 2047, row = (j2 >> 7) * 256 + (n >= 2048 ? 128 : 0) + (j2 & 127); drow[tid] = e * 4096 + row; WSC1[e * 4096 + row] = sc; } }
            else { const int n = (slab - NSLAB_E) * 32 + tid; if (n < 5672) { float qsc; const int row = win_row(n, qsc); drow[tid] = row; WISC[row] = sc * qsc; } else drow[tid] = -1; } }
        __syncthreads();
        { const int kc = tid & 7, n = (tid >> 3) & 31, hf = tid >> 8; const float iv = inv[n]; const int dr = drow[n];
          signed char* dst = (slab < NSLAB_E ? ((slab % 192) >= 128 ? W2Q : W1Q) : WIQ) + (size_t)(dr < 0 ? 0 : dr) * 2048; const LAS unsigned char* src = TT + n * RS;
          if (dr >= 0) {
#pragma unroll
          for (int m8 = 0; m8 < 8; ++m8) { const int k0 = 16 * (kc + 8 * (hf + 2 * m8)); const LAS v2u* sp = (const LAS v2u*)(src + k0 * 2); const v2u a = sp[0], b = sp[1], c = sp[2], d = sp[3]; v4u o;
              o.x = q8x4(bflo(a.x) * iv, bfhi(a.x) * iv, bflo(a.y) * iv, bfhi(a.y) * iv); o.y = q8x4(bflo(b.x) * iv, bfhi(b.x) * iv, bflo(b.y) * iv, bfhi(b.y) * iv);
              o.z = q8x4(bflo(c.x) * iv, bfhi(c.x) * iv, bflo(c.y) * iv, bfhi(c.y) * iv); o.w = q8x4(bflo(d.x) * iv, bfhi(d.x) * iv, bflo(d.y) * iv, bfhi(d.y) * iv);
              *(v4u*)(dst + k0) = o; } } }
        __syncthreads();
    }
#undef SLAB_ISSUE
#undef SLAB_USE
}
struct EpiSwigluI8 {
    static constexpr bool PERM = true, AFTER_DRAIN = false;
    const float* b1; const float* rowsc; const float* wsc1; bf16* act; float* amaxp;
    __device__ __forceinline__ void operator()(const pg8::f32x4 (&acc)[2][2][4][2], const pg8::Unit& u, int wr, int wc, int fr, int fq) const {
        typedef float f2 __attribute__((ext_vector_type(2)));
        const int e = u.kind; const int cin = wc * 32 + 8 * fq; const int col = u.pn * 128 + cin; const int row0 = u.pm * 256 + wr * 64 + fr;
        const float* bg = b1 + (size_t)e * 4096 + col; const float* bl = bg + 2048; const float* sg = wsc1 + (size_t)e * 4096 + u.pn * 256 + cin; const float* sl = sg + 128;
        f2 gb[4], lb[4], gs[4], ls[4];
#pragma unroll
        for (int k = 0; k < 4; ++k) { gb[k] = *(const f2*)(bg + 2 * k); lb[k] = *(const f2*)(bl + 2 * k); gs[k] = *(const f2*)(sg + 2 * k); ls[k] = *(const f2*)(sl + 2 * k); }
#pragma unroll
        for (int ai = 0; ai < 2; ++ai)
#pragma unroll
            for (int m = 0; m < 4; ++m) { const int r = row0 + ai * 128 + m * 16; const float rs = rowsc[r]; const f2 rs2 = (f2){rs, rs}; f2 o[4]; float mx = 0.f;
#pragma unroll
                for (int k = 0; k < 4; ++k) { const int n = k >> 1, j = (k & 1) * 2;
                    const f2 ag = (f2){(float)__float_as_int(acc[ai][0][m][n][j]), (float)__float_as_int(acc[ai][0][m][n][j + 1])}, al = (f2){(float)__float_as_int(acc[ai][1][m][n][j]), (float)__float_as_int(acc[ai][1][m][n][j + 1])};
                    f2 gl = __builtin_elementwise_fma(ag, rs2 * gs[k], gb[k]), li = __builtin_elementwise_fma(al, rs2 * ls[k], lb[k]);
                    gl.x = fminf(gl.x, 7.f); gl.y = fminf(gl.y, 7.f); li.x = __builtin_amdgcn_fmed3f(li.x, -7.f, 7.f); li.y = __builtin_amdgcn_fmed3f(li.y, -7.f, 7.f);
                    const f2 ea = gl * (f2){-2.4554669595930156f, -2.4554669595930156f};
                    const f2 den = (f2){__builtin_amdgcn_exp2f(ea.x), __builtin_amdgcn_exp2f(ea.y)} + (f2){1.f, 1.f};
                    const f2 v = (gl * (f2){__builtin_amdgcn_rcpf(den.x), __builtin_amdgcn_rcpf(den.y)}) * (li + (f2){1.f, 1.f});
                    o[k] = v; mx = fmaxf(mx, fmaxf(fabsf(v.x), fabsf(v.y))); }
                mx = nsa::rmax32(nsa::rmax16(mx));
                if (fq == 0) amaxp[(size_t)r * 64 + u.pn * 4 + wc] = mx;
                pg8::u32x4 w; w.x = pg8::cvt_pk_bf16(o[0].x, o[0].y); w.y = pg8::cvt_pk_bf16(o[1].x, o[1].y); w.z = pg8::cvt_pk_bf16(o[2].x, o[2].y); w.w = pg8::cvt_pk_bf16(o[3].x, o[3].y);
                *(pg8::u32x4*)(act + (size_t)r * DFF + col) = w; }
    }
};
__device__ __forceinline__ void ph_actq(const Params& p, int gw, int NGW, int lane) {
    const int nrows = ((const int*)(p.ws + WS_META))[0] * 256; const float* amaxp = (const float*)(p.ws + WS_AMAXP); const bf16* act = (const bf16*)(p.ws + WS_ACT);
    signed char* A8 = (signed char*)(p.ws + WS_ACT8); float* ASC = (float*)(p.ws + WS_ASC);
    for (int rb = gw; rb < nrows; rb += 2 * NGW) {
        const int r0 = rb, r1 = rb + NGW; const bool h1 = r1 < nrows; const int r1c = h1 ? r1 : r0;
        float m0 = amaxp[(size_t)r0 * 64 + lane], m1 = amaxp[(size_t)r1c * 64 + lane];
        const v4u* s0 = (const v4u*)(act + (size_t)r0 * DFF) + lane * 4; const v4u* s1 = (const v4u*)(act + (size_t)r1c * DFF) + lane * 4; v4u a[2][4];
#pragma unroll
        for (int j = 0; j < 4; ++j) { a[0][j] = s0[j]; a[1][j] = s1[j]; }
        m0 = wave_max(m0); m1 = wave_max(m1);
#pragma unroll
        for (int q = 0; q < 2; ++q) { const int r = q ? r1 : r0; if (q && !h1) break; const float mx = q ? m1 : m0; const float sc = mx > 0.f ? mx * (1.f / 127.f) : 1.f, iv = 1.f / sc; v4u o[2];
#pragma unroll
            for (int h = 0; h < 2; ++h) { const v4u x = a[q][2 * h], y = a[q][2 * h + 1];
                o[h].x = q8x4c(bflo(x.x) * iv, bfhi(x.x) * iv, bflo(x.y) * iv, bfhi(x.y) * iv); o[h].y = q8x4c(bflo(x.z) * iv, bfhi(x.z) * iv, bflo(x.w) * iv, bfhi(x.w) * iv);
                o[h].z = q8x4c(bflo(y.x) * iv, bfhi(y.x) * iv, bflo(y.y) * iv, bfhi(y.y) * iv); o[h].w = q8x4c(bflo(y.z) * iv, bfhi(y.z) * iv, bflo(y.w) * iv, bfhi(y.w) * iv); }
            v4u* dst = (v4u*)(A8 + (size_t)r * DFF) + lane * 2; dst[0] = o[0]; dst[1] = o[1];
            if (lane == 0) ASC[r] = sc; } }
}
struct EpiDownI8 {
    static constexpr bool PERM = true, AFTER_DRAIN = false;
    const float* b2; const float* roww; const float* asc; const float* wsc2; bf16* y;
    __device__ __forceinline__ void operator()(const pg8::f32x4 (&acc)[2][2][4][2], const pg8::Unit& u, int wr, int wc, int fr, int fq) const {
        const int e = u.kind; const int col0 = u.pn * 256 + wc * 32 + 8 * fq; const int row0 = u.pm * 256 + wr * 64 + fr;
        typedef float f2 __attribute__((ext_vector_type(2)));
        f2 bv[2][4], sv[2][4];
#pragma unroll
        for (int bj = 0; bj < 2; ++bj)
#pragma unroll
            for (int k = 0; k < 4; ++k) { bv[bj][k] = *(const f2*)(b2 + (size_t)e * DM + col0 + bj * 128 + 2 * k); sv[bj][k] = *(const f2*)(wsc2 + (size_t)e * DM + col0 + bj * 128 + 2 * k); }
#pragma unroll
        for (int ai = 0; ai < 2; ++ai)
#pragma unroll
            for (int m = 0; m < 4; ++m) { const int r = row0 + ai * 128 + m * 16; const float g = roww[r], as = asc[r]; const f2 g2 = (f2){g, g}, as2 = (f2){as, as};
#pragma unroll
                for (int bj = 0; bj < 2; ++bj) { f2 o[4];
#pragma unroll
                    for (int k = 0; k < 4; ++k) { const int n = k >> 1, j = (k & 1) * 2; const f2 a2 = (f2){(float)__float_as_int(acc[ai][bj][m][n][j]), (float)__float_as_int(acc[ai][bj][m][n][j + 1])};
                        o[k] = __builtin_elementwise_fma(a2, as2 * sv[bj][k], bv[bj][k]) * g2; }
                    pg8::u32x4 w; w.x = pg8::cvt_pk_bf16(o[0].x, o[0].y); w.y = pg8::cvt_pk_bf16(o[1].x, o[1].y); w.z = pg8::cvt_pk_bf16(o[2].x, o[2].y); w.w = pg8::cvt_pk_bf16(o[3].x, o[3].y);
                    *(pg8::u32x4*)(y + (size_t)r * DM + col0 + bj * 128) = w; } }
    }
};

struct EpiProjI8 {
    static constexpr bool PERM = true, AFTER_DRAIN = false;
    unsigned char* ws;
    __device__ __forceinline__ void operator()(const pg8::f32x4 (&acc)[2][2][4][2], const pg8::Unit& u, int wr, int wc, int fr, int fq) const {
        const int cw = wc * 32 + 8 * fq; const float* XSC = (const float*)(ws + WS_XSC); const float* WISC = (const float*)(ws + WS_WISC);
        if (u.kind == 0) {
            const int tn = u.pn; bf16* base; size_t bjs = 128; int ld = 0; bool headmajor = false; bool small = false;
            if (tn < 2) { base = (bf16*)(ws + WS_GQ) + tn * 256; ld = 512; }
            else if (tn < 4) { base = (bf16*)(ws + WS_GK) + (tn - 2) * 256; ld = 512; }
            else if (tn < 8) { base = (bf16*)(ws + WS_GV) + (tn - 4) * 256; ld = 1024; }
            else if (tn < 12) { base = (bf16*)(ws + WS_GG) + (tn - 8) * 256; ld = 1024; }
            else if (tn < 16) { base = (bf16*)(ws + WS_NQ) + (tn - 12) * 256; ld = 1024; }
            else if (tn < 20) { base = (bf16*)(ws + (tn == 16 ? WS_KC : tn == 17 ? WS_VC : tn == 18 ? WS_KS : WS_KW)); headmajor = true; bjs = (size_t)SEQ * 128; }
            else { base = (bf16*)(ws + WS_SM); ld = 64; small = true; }
            if (small && wc >= 2) return;
            typedef float f2 __attribute__((ext_vector_type(2)));
            f2 cs[2][4];
#pragma unroll
            for (int bj = 0; bj < 2; ++bj)
#pragma unroll
                for (int k = 0; k < 4; ++k) cs[bj][k] = *(const f2*)(WISC + tn * 256 + bj * 128 + cw + 2 * k);
#pragma unroll
            for (int ai = 0; ai < 2; ++ai)
#pragma unroll
                for (int m = 0; m < 4; ++m) { const int r = u.pm * 256 + ai * 128 + wr * 64 + m * 16 + fr; const float rs = XSC[r];
                    const size_t rterm = headmajor ? ((size_t)(r >> 12) * 2 * SEQ + (r & (SEQ - 1))) * 128 : (size_t)r * ld;
#pragma unroll
                    for (int bj = 0; bj < 2; ++bj) { if (small && bj) continue; f2 o[4]; const f2 rs2 = (f2){rs, rs};
#pragma unroll
                        for (int k = 0; k < 4; ++k) { const int n = k >> 1, j = (k & 1) * 2; o[k] = (f2){(float)__float_as_int(acc[ai][bj][m][n][j]), (float)__float_as_int(acc[ai][bj][m][n][j + 1])} * (rs2 * cs[bj][k]); }
                        pg8::u32x4 w; w.x = pg8::cvt_pk_bf16(o[0].x, o[0].y); w.y = pg8::cvt_pk_bf16(o[1].x, o[1].y); w.z = pg8::cvt_pk_bf16(o[2].x, o[2].y); w.w = pg8::cvt_pk_bf16(o[3].x, o[3].y);
                        *(pg8::u32x4*)(base + rterm + bj * bjs + cw) = w; } }
        } else {
            bf16* base = (bf16*)(ws + (u.pn == 21 ? WS_VST : WS_VWT));
#pragma unroll
            for (int ai = 0; ai < 2; ++ai)
#pragma unroll
                for (int m = 0; m < 4; ++m) { const int dh = wr * 64 + m * 16 + fr; const float ws_ = WISC[u.pn * 256 + ai * 128 + dh];
#pragma unroll
                    for (int bj = 0; bj < 2; ++bj) { const int tok = u.pm * 256 + bj * 128 + cw; const int b = tok >> 12, s = tok & (SEQ - 1); float o[8];
                        const pg8::f32x4 x0 = *(const pg8::f32x4*)(XSC + tok), x1 = *(const pg8::f32x4*)(XSC + tok + 4);
#pragma unroll
                        for (int j = 0; j < 4; ++j) { o[j] = (float)__float_as_int(acc[ai][bj][m][0][j]) * (ws_ * x0[j]); o[4 + j] = (float)__float_as_int(acc[ai][bj][m][1][j]) * (ws_ * x1[j]); }
                        pg8::u32x4 w; w.x = pg8::cvt_pk_bf16(o[0], o[1]); w.y = pg8::cvt_pk_bf16(o[2], o[3]); w.z = pg8::cvt_pk_bf16(o[4], o[5]); w.w = pg8::cvt_pk_bf16(o[6], o[7]);
                        *(pg8::u32x4*)(base + ((size_t)(b * 2 + ai) * 128 + dh) * SEQ + s) = w; } }
        }
    }
};

__device__ __forceinline__ void r1_router(const Params& p, LAS unsigned char* lds, int vb, int tid, int wave, int lane) {
    LAS float* rowbuf = (LAS float*)lds;
    LAS float* part = (LAS float*)(lds + 65536);
    LAS int* tk = (LAS int*)(lds + 81920 + wave * 1024);
    LAS int* cntw = (LAS int*)(lds + 90112);
    const bf16* h = (const bf16*)(p.ws + WS_H16); const float* gf = p.in[I_NFFN]; const float* rw = p.in[I_RW]; const float* rb = p.in[I_RB];
    signed char* HN8 = (signed char*)(p.ws + WS_HN8);
    const int e = lane & 31, eg = tid & 31, dg = tid >> 5; int mycount = 0;
    float rwr[128];
#pragma unroll
    for (int c4 = 0; c4 < 4; ++c4) { unsigned o = (unsigned)((((dg * 128 + c4 * 32) * 32) + eg) * 4); asm volatile("" : "+v"(o));
#pragma unroll
        for (int i = 0; i < 32; ++i) rwr[c4 * 32 + i] = *(const float*)((const char*)rw + o + i * 128); }
    v4u hw[4];
    { const v4u* xr = (const v4u*)(h + (size_t)(vb * TPV + wave) * DM) + lane;
#pragma unroll
      for (int q = 0; q < 4; ++q) hw[q] = xr[64 * q]; }
    for (int grp = 0; grp < 16; ++grp) { const int t = vb * TPV + grp * 8 + wave;
        { float s = 0.f;
#pragma unroll
          for (int q = 0; q < 4; ++q) { const float a0 = bflo(hw[q].x), a1 = bfhi(hw[q].x), a2 = bflo(hw[q].y), a3 = bfhi(hw[q].y), a4 = bflo(hw[q].z), a5 = bfhi(hw[q].z), a6 = bflo(hw[q].w), a7 = bfhi(hw[q].w);
              s += ((a0 * a0 + a1 * a1) + (a2 * a2 + a3 * a3)) + ((a4 * a4 + a5 * a5) + (a6 * a6 + a7 * a7)); }
          const float rstd = 1.f / sqrtf(wave_sum(s) * (1.f / DM) + RMS_EPS);
          float mxr = 0.f; LAS f32x4* hrow = (LAS f32x4*)(rowbuf + wave * 2048);
#pragma unroll
          for (int j = 0; j < 8; ++j) { const int cj = 2 * lane + 128 * (j >> 1) + (j & 1); const f32x4 g4 = ((const f32x4*)gf)[cj]; const unsigned wa = (j & 1) ? hw[j >> 1].z : hw[j >> 1].x, wb = (j & 1) ? hw[j >> 1].w : hw[j >> 1].y;
              f32x4 y; y.x = bflo(wa) * rstd * g4.x; y.y = bfhi(wa) * rstd * g4.y; y.z = bflo(wb) * rstd * g4.z; y.w = bfhi(wb) * rstd * g4.w;
              hrow[cj] = y; mxr = fmaxf(mxr, fmaxf(fmaxf(fabsf(y.x), fabsf(y.y)), fmaxf(fabsf(y.z), fabsf(y.w)))); }
          mxr = wave_max(mxr); const float qs = mxr > 0.f ? mxr * (1.f / 127.f) : 1.f, qi = 1.f / qs;
          v2u* o8 = (v2u*)(HN8 + (size_t)t * DM) + lane;
#pragma unroll
          for (int q = 0; q < 4; ++q) { const f32x4 ya = hrow[2 * lane + 128 * q], yb = hrow[2 * lane + 128 * q + 1]; v2u o;
              o.x = q8x4(ya.x * qi, ya.y * qi, ya.z * qi, ya.w * qi); o.y = q8x4(yb.x * qi, yb.y * qi, yb.z * qi, yb.w * qi); o8[64 * q] = o; }
          if (lane == 0) ((float*)(p.ws + WS_HSC))[t] = qs; }
        __syncthreads();
        { const int tn = vb * TPV + (grp < 15 ? grp + 1 : grp) * 8 + wave; const v4u* xr = (const v4u*)(h + (size_t)tn * DM) + lane;
#pragma unroll
          for (int q = 0; q < 4; ++q) hw[q] = xr[64 * q]; }
        { float acc[8];
#pragma unroll
          for (int tt = 0; tt < 8; ++tt) acc[tt] = 0.f;
#pragma unroll
          for (int i4 = 0; i4 < 32; ++i4) { f32x4 xv[8];
#pragma unroll
              for (int tt = 0; tt < 8; ++tt) xv[tt] = *(const LAS f32x4*)(rowbuf + tt * 2048 + dg * 128 + 4 * i4);
#pragma unroll
              for (int tt = 0; tt < 8; ++tt) acc[tt] += xv[tt].x * rwr[4 * i4] + xv[tt].y * rwr[4 * i4 + 1] + xv[tt].z * rwr[4 * i4 + 2] + xv[tt].w * rwr[4 * i4 + 3];
              if (i4 & 1) asm volatile("" ::: "memory"); }
#pragma unroll
          for (int tt = 0; tt < 8; ++tt) part[(dg * 8 + tt) * 32 + eg] = acc[tt]; }
        __syncthreads();
        { float a = rb[e];
#pragma unroll
          for (int q = 0; q < 16; ++q) a += part[(q * 8 + wave) * 32 + e];
          int rank = 0;
#pragma unroll
          for (int mm = 0; mm < 32; ++mm) { const float lm = __shfl(a, mm); rank += (lm > a || (lm == a && mm < e)) ? 1 : 0; }
          const float mx = wave_max(a); const bool sel = rank < 4;
          const float ex = (sel && lane < 32) ? __expf(a - mx) : 0.f; const float sum = wave_sum(ex);
          if (sel && lane < 32) { LAS int* q = tk + (grp * 4 + rank) * 4; q[0] = e; q[1] = mycount; q[2] = __builtin_bit_cast(int, ex / sum); ++mycount; } }
        __syncthreads();
    }
    int ln; asm volatile("v_mbcnt_lo_u32_b32 %0, -1, 0\n\tv_mbcnt_hi_u32_b32 %0, -1, %0" : "=v"(ln));
    if (ln < 32) cntw[wave * 32 + ln] = mycount;
    __syncthreads();
    if (wave == 0 && ln < 32) { int tot = 0; for (int w = 0; w < 8; ++w) tot += cntw[w * 32 + ln]; ((int*)(p.ws + WS_CNT))[vb * 32 + ln] = tot; }
    { const int i = ln >> 2, k = ln & 3; const LAS int* q = tk + (i * 4 + k) * 4; const int ee = q[0]; int base = 0; for (int w = 0; w < wave; ++w) base += cntw[w * 32 + ee];
      const int t = vb * TPV + i * 8 + wave;
      ((int*)(p.ws + WS_EIDX))[t * 4 + k] = ee; ((int*)(p.ws + WS_LRNK))[t * 4 + k] = base + q[1]; ((int*)(p.ws + WS_GATE))[t * 4 + k] = q[2]; }
    __syncthreads();
}
__device__ __forceinline__ void r2_gather(const Params& p, LAS unsigned char* lds, int vb, bool write_meta, int tid, int wave, int lane) {
    LAS int* part_tot = (LAS int*)lds;
    LAS int* part_base = part_tot + 512;
    LAS int* pbase = part_base + 512;
    const int* CNT = (const int*)(p.ws + WS_CNT);
    { const int e = tid & 31, part = tid >> 5; int tot = 0, bs = 0;
      for (int v = part * 16; v < part * 16 + 16; ++v) { const int c = CNT[v * 32 + e]; tot += c; if (v < vb) bs += c; }
      part_tot[part * 32 + e] = tot; part_base[part * 32 + e] = bs; }
    __syncthreads();
    if (tid == 0) { int ps = 0; int* meta = (int*)(p.ws + WS_META); int nt = 0;
        for (int e = 0; e < 32; ++e) { int tot = 0, bs = 0; for (int q = 0; q < 16; ++q) { tot += part_tot[q * 32 + e]; bs += part_base[q * 32 + e]; }
            pbase[e] = ps + bs; const int ntile = (tot + 255) >> 8;
            if (write_meta) for (int q = 0; q < ntile; ++q) meta[64 + nt + q] = e;
            nt += ntile; ps += ntile * 256; }
        if (write_meta) meta[0] = nt; }
    __syncthreads();
    const float* HSC = (const float*)(p.ws + WS_HSC); float* ROWSC = (float*)(p.ws + WS_ROWSC);
    const int* EIDX = (const int*)(p.ws + WS_EIDX); const int* LRNK = (const int*)(p.ws + WS_LRNK); const float* GATE = (const float*)(p.ws + WS_GATE);
    int* POS = (int*)(p.ws + WS_POS); float* ROWW = (float*)(p.ws + WS_ROWW);
    unsigned short* RT = (unsigned short*)(p.ws + WS_ROWTOK);
    { const int t = vb * TPV + (tid >> 2), k = tid & 3;
      const int pos = pbase[EIDX[t * 4 + k]] + LRNK[t * 4 + k];
      POS[t * 4 + k] = pos; ROWW[pos] = GATE[t * 4 + k]; ROWSC[pos] = HSC[t]; RT[(pos & ~255) + (pos & 63) * 4 + ((pos >> 6) & 3)] = (unsigned short)t; }
    __syncthreads();
}
__device__ __forceinline__ void pf_final(const Params& p, int gw, int NGW, int lane) {
    const bf16* Y = (const bf16*)(p.ws + WS_Y); const int* POS = (const int*)(p.ws + WS_POS); const float* gfin = p.in[I_NFIN]; const bf16* H = (const bf16*)(p.ws + WS_H16);
    for (int t = gw; t < T; t += NGW) {
        f32x4 v[8]; const v4u* hr = (const v4u*)(H + (size_t)t * DM) + lane;
#pragma unroll
        for (int q = 0; q < 4; ++q) { const v4u w = hr[64 * q]; v[2 * q] = (f32x4){bflo(w.x), bfhi(w.x), bflo(w.y), bfhi(w.y)}; v[2 * q + 1] = (f32x4){bflo(w.z), bfhi(w.z), bflo(w.w), bfhi(w.w)}; }
#pragma unroll
        for (int k = 0; k < 4; ++k) { const int pos = POS[t * 4 + k]; const v4u* yr = (const v4u*)(Y + (size_t)pos * DM) + lane;
#pragma unroll
            for (int q = 0; q < 4; ++q) { const v4u w = yr[64 * q]; v[2 * q].x += bflo(w.x); v[2 * q].y += bfhi(w.x); v[2 * q].z += bflo(w.y); v[2 * q].w += bfhi(w.y);
                v[2 * q + 1].x += bflo(w.z); v[2 * q + 1].y += bfhi(w.z); v[2 * q + 1].z += bflo(w.w); v[2 * q + 1].w += bfhi(w.w); } }
        float s = 0.f;
#pragma unroll
        for (int j = 0; j < 8; ++j) s += (v[j].x * v[j].x + v[j].y * v[j].y) + (v[j].z * v[j].z + v[j].w * v[j].w);
        const float rstd = 1.f / sqrtf(wave_sum(s) * (1.f / DM) + RMS_EPS); f32x4* xr = (f32x4*)(p.out + (size_t)t * DM);
#pragma unroll
        for (int j = 0; j < 8; ++j) { const int cj = 2 * lane + 128 * (j >> 1) + (j & 1); const f32x4 g4 = ((const f32x4*)gfin)[cj]; f32x4 o; o.x = v[j].x * rstd * g4.x; o.y = v[j].y * rstd * g4.y; o.z = v[j].z * rstd * g4.z; o.w = v[j].w * rstd * g4.w; xr[cj] = o; }
    }
}


constexpr int LDS_BYTES = 159744;
constexpr int MISC_OFF = LDS_BYTES - 256;  static_assert(nsa::LDS_END <= MISC_OFF && gla::L_END <= MISC_OFF, "LDS map");
constexpr int CW_BAR = 4096, CW_XL = 16384;
__global__ __launch_bounds__(512, 2) void mega_fwd(Params p) {
    extern __shared__ __attribute__((aligned(16))) unsigned char lds_raw[];
    LAS unsigned char* lds = (LAS unsigned char*)lds_raw;
    const int G = gridDim.x, bid = blockIdx.x, NGW = G * 8;
#define PH_IDS int tid = threadIdx.x; asm volatile("" : "+v"(tid)); const int lane = tid & 63, wave = __builtin_amdgcn_readfirstlane(tid >> 6), gw = bid * 8 + wave; (void)lane; (void)gw;
    for (int u = threadIdx.x; u < 64; u += 512) ((LAS unsigned*)(lds + MISC_OFF))[u] = 0u;
    __syncthreads();
    XcdBarrier bar = xcd_barrier_post((unsigned*)(p.ws + WS_CTL) + CW_BAR, (volatile LAS unsigned*)(lds + MISC_OFF) + 8);
    { PH_IDS; p0_prologue(p, lds, gw, NGW, wave, lane); __syncthreads(); p0_slab_quant(p, lds, bid, G, tid); }
    xcd_barrier(bar);
    { pg8::Gemm g{(const bf16*)(p.ws + WS_XN8), (const bf16*)(p.ws + WS_WINQ), T, NPT * 256, DM / 2};
      ProjOrder S; S.init(T, NPT * 256, G, bid); S.xn = g.A; S.wt = g.Bt; EpiProjI8 E{p.ws};
      pg8::gemm_phase<EpiProjI8, ProjOrder, true, true, true>(lds, g, S, E); }
    xcd_barrier(bar);
    if (bid < 32) {
        pg8::Gemm g{(const bf16*)(p.ws + WS_KC), (const bf16*)(p.ws + WS_WKCT), 4096, 256, 2048};
        CmpOrder S{bid, (const bf16*)(p.ws + WS_KC), (const bf16*)(p.ws + WS_VC), (const bf16*)(p.ws + WS_WKCT), (const bf16*)(p.ws + WS_WVCT)}; EpiLH E{(float*)(p.ws + WS_LH)};
        pg8::gemm_phase<EpiLH, CmpOrder, true, true>(lds, g, S, E);
    } else { PH_IDS; ph_gla_a(p, lds, bid - 32, G - 32, tid, wave); }
    xcd_barrier(bar);
    { PH_IDS; ph_gla_b(p, bid * 512 + tid, G * 512);
      for (int i = bid * 512 + tid; i < 16 * 128; i += G * 512) { const int bgz = i >> 7, dz = i & 127; ((bf16*)(p.ws + WS_KCMP))[((size_t)bgz * 256 + 255) * 128 + dz] = 0; ((bf16*)(p.ws + WS_VCMPT))[((size_t)bgz * 128 + dz) * 256 + 255] = 0; }
      ph_cmp_fin(p, lds, bid, G, tid, (const float*)(p.ws + WS_LH), (const float*)(p.ws + WS_PEVP)); }
    xcd_barrier(bar);
    { PH_IDS; ph_nsa(p, lds, bid, G, tid, wave); }
    { PH_IDS; __syncthreads(); ph_gla_c(p, lds, bid, G, tid, wave); }
    xcd_barrier(bar);
    { pg8::Gemm g{(const bf16*)(p.ws + WS_A2), (const bf16*)(p.ws + WS_WOT), T, DM, DM};
      pg8::StaticOrder S; S.init(T, DM, G, bid); EpiRes E{p.in[I_X], (bf16*)(p.ws + WS_H16)};
      pg8::gemm_phase<EpiRes, pg8::StaticOrder, true, true>(lds, g, S, E); }
    xcd_barrier(bar);
    { PH_IDS; for (int vb = bid; vb < NVB; vb += G) r1_router(p, lds, vb, tid, wave, lane); }
    xcd_barrier(bar);
    { PH_IDS; for (int vb = bid; vb < NVB; vb += G) r2_gather(p, lds, vb, vb == 0, tid, wave, lane); }
    xcd_barrier(bar);
    { pg8::Gemm g{(const bf16*)(p.ws + WS_HN8), (const bf16*)(p.ws + WS_W1Q), MAXTILES * 256, 4096, DM / 2};
      MoeOrderG S; S.init((const int*)(p.ws + WS_META), 16, G, bid); S.rowtab = (const unsigned short*)(p.ws + WS_ROWTOK); EpiSwigluI8 E{p.in[I_B1], (const float*)(p.ws + WS_ROWSC), (const float*)(p.ws + WS_WSC1), (bf16*)(p.ws + WS_ACT), (float*)(p.ws + WS_AMAXP)};
      pg8::gemm_phase<EpiSwigluI8, MoeOrderG, true, true, true, true>(lds, g, S, E); }
    xcd_barrier(bar);
    { PH_IDS; ph_actq(p, gw, NGW, lane); }
    xcd_barrier(bar);
    { pg8::Gemm g{(const bf16*)(p.ws + WS_ACT8), (const bf16*)(p.ws + WS_W2Q), MAXTILES * 256, DM, DFF / 2};
      MoeOrder S; S.init((const int*)(p.ws + WS_META), 8, G, bid); EpiDownI8 E{p.in[I_B2], (const float*)(p.ws + WS_ROWW), (const float*)(p.ws + WS_ASC), (const float*)(p.ws + WS_WSC2), (bf16*)(p.ws + WS_Y)};
      pg8::gemm_phase<EpiDownI8, MoeOrder, true, true, true>(lds, g, S, E); }
    xcd_barrier(bar);
    { PH_IDS; pf_final(p, gw, NGW, lane); }
}

extern "C" void kernel_launch(void* const* d_in, const int* in_sizes, int n_in, void* d_out, int out_size, void* d_ws, size_t ws_size, hipStream_t stream) {
    static int grid = 0;
    if (grid == 0) {
        if (n_in != N_IN || out_size != T * DM || ws_size < WS_END) { fprintf(stderr, "kernel_launch: unexpected shapes (n_in %d out %d ws %zu need %zu)\n", n_in, out_size, ws_size, (size_t)WS_END); grid = -1; return; }
        int dev = 0, cus = 0, per_cu = 0;
        if (hipGetDevice(&dev) != hipSuccess || hipDeviceGetAttribute(&cus, hipDeviceAttributeMultiprocessorCount, dev) != hipSuccess) { grid = -1; return; }
        if (hipFuncSetAttribute((const void*)mega_fwd, hipFuncAttributeMaxDynamicSharedMemorySize, LDS_BYTES) != hipSuccess) { fprintf(stderr, "kernel_launch: hipFuncSetAttribute failed\n"); grid = -1; return; }
        if (hipOccupancyMaxActiveBlocksPerMultiprocessor(&per_cu, (const void*)mega_fwd, 512, LDS_BYTES) != hipSuccess || per_cu < 1) { fprintf(stderr, "kernel_launch: occupancy query says %d blocks per CU\n", per_cu); }
        (void)hipGetLastError();
        grid = cus;
    }
    if (grid < 0) return;
    if (hipMemsetAsync((char*)d_ws + WS_CTL, 0, CTL_BYTES, stream) != hipSuccess) return;
    Params p{};
    for (int i = 0; i < N_IN; ++i) p.in[i] = (const float*)d_in[i];
    p.out = (float*)d_out; p.ws = (unsigned char*)d_ws;
    hipLaunchKernelGGL(mega_fwd, dim3(grid), dim3(512), LDS_BYTES, stream, p);
}
```

```cpp
#include <hip/hip_runtime.h>
#include <cstdio>
#include <cstdint>
namespace pg8 {
#define PG8_LAS __attribute__((address_space(3)))
typedef unsigned short bf16_t;
typedef short bf16x8 __attribute__((ext_vector_type(8)));
typedef float f32x4 __attribute__((ext_vector_type(4)));
typedef unsigned u32x4 __attribute__((ext_vector_type(4)));
typedef unsigned v2u_t __attribute__((ext_vector_type(2)));
constexpr int BM = 256, BK = 64, HALF = 128, HTB = HALF * BK * 2  , STAGE_BYTES = 8 * HTB, NXCD = 8, WGM = 8;

__host__ __device__ __forceinline__ int lds_byte(int r, int c) { const int st = (r >> 4) * 2 + (c >> 5), rr = r & 15, cc = c & 31, ob = rr * 64 + cc * 2; return st * 1024 + (ob ^ (((ob >> 9) & 1) << 5)); }
__host__ __device__ __forceinline__ void stage_rc(int b, int& R, int& C) { const int st = b / 1024, sb = b % 1024, swz = sb ^ (((sb >> 9) & 1) << 5); R = (st >> 1) * 16 + swz / 64; C = (st & 1) * 32 + (swz % 64) / 2; }
__host__ __device__ __forceinline__ int perm32(int rho) { const int n = rho >> 4, i = rho & 15; return 8 * (i >> 2) + 4 * n + (i & 3); }

struct Unit { int pm, pn, kind; };
struct Gemm { const bf16_t* A; const bf16_t* Bt; int M, N, K; };

template <int WG = WGM> __host__ __device__ __forceinline__ void tile_of(int wgid, int nM, int nN, int& pm, int& pn) {
    const int nwg = nM * nN;
    { const int q = nwg / NXCD, r = nwg % NXCD, xcd = wgid % NXCD, off = wgid / NXCD; wgid = (xcd < r ? xcd * (q + 1) : r * (q + 1) + (xcd - r) * q) + off; }
    const int nig = WG * nN, gid = wgid / nig, fm = gid * WG, gsz = (nM - fm) < WG ? (nM - fm) : WG;
    pm = fm + ((wgid % nig) % gsz); pn = (wgid % nig) / gsz;
}
struct StaticOrder {
    int nM, nN, nwg, G, c;
    __host__ __device__ void init(int M, int N, int G_, int c_) { nM = M / BM; nN = N / BM; nwg = nM * nN; G = G_; c = c_; }
    __device__ __forceinline__ bool next(int i, Unit& u) const {
        const long L = (long)i * G + c; if (L >= nwg) return false;
        tile_of((int)L, nM, nN, u.pm, u.pn); u.kind = 0; return true;
    }
    __device__ __forceinline__ const char* pa(const Gemm& g, const Unit& u) const { return (const char*)g.A + (size_t)u.pm * ((size_t)BM * g.K * 2); }
    __device__ __forceinline__ const char* pb(const Gemm& g, const Unit& u) const { return (const char*)g.Bt + (size_t)u.pn * ((size_t)BM * g.K * 2); }
    __device__ __forceinline__ void a_ready(const Unit&) const {}
    __device__ __forceinline__ void done(const Unit&) const {}
};
__device__ __forceinline__ unsigned cvt_pk_bf16(float lo, float hi) { unsigned r; asm volatile("v_cvt_pk_bf16_f32 %0, %1, %2" : "=v"(r) : "v"(lo), "v"(hi)); return r; }
template <bool I8> __device__ __forceinline__ f32x4 mma16(bf16x8 a, bf16x8 b, f32x4 c) {
    if constexpr (I8) { typedef int i32x4 __attribute__((ext_vector_type(4)));
        return __builtin_bit_cast(f32x4, __builtin_amdgcn_mfma_i32_16x16x64_i8(__builtin_bit_cast(i32x4, a), __builtin_bit_cast(i32x4, b), __builtin_bit_cast(i32x4, c), 0, 0, 0)); }
    else return __builtin_amdgcn_mfma_f32_16x16x32_bf16(a, b, c, 0, 0, 0);
}
template <class Epi, class Sched, bool ALIGN_EPI = false, bool SP2 = false, bool I8 = false, bool GATHER = false>
__device__ __forceinline__ void gemm_phase(PG8_LAS unsigned char* lds, const Gemm g, const Sched& S, const Epi& E) {
    int tid_l = threadIdx.x; asm volatile("" : "+v"(tid_l));
    const int tid = tid_l, wid = __builtin_amdgcn_readfirstlane(tid >> 6), lane = tid & 63, wr = wid >> 2, wc = wid & 3, fr = lane & 15, fq = lane >> 4;
    const int K = g.K, nt = K / BK;
    unsigned voffA[2], voffB[2];
#pragma unroll
    for (int i = 0; i < 2; ++i) { int R, C; stage_rc(tid * 16 + i * 8192, R, C); const int Rb = Epi::PERM ? ((R & ~31) + perm32(R & 31)) : R;
        voffA[i] = (unsigned)(R * K + C) * 2u; voffB[i] = (unsigned)(Rb * K + C) * 2u; }
    const size_t kstep = (size_t)(BK * 2);
    const size_t hstep = (size_t)HALF * K * 2;
    const unsigned ldsw = (unsigned)wid * 1024u;
    const int aoff = lds_byte(wr * 64 + fr, fq * 8), boff = lds_byte(wc * 32 + fr, fq * 8);
#define PG8_SA(b, h) (((b) * 2 + (h)) * HTB)
#define PG8_SB(b, h) ((4 + (b) * 2 + (h)) * HTB)
#define PG8_STAGE(bufoff, gbase, voff) do { _Pragma("unroll") for (int _i = 0; _i < 2; ++_i) \
        __builtin_amdgcn_global_load_lds((const unsigned*)((const char*)(gbase) + (voff)[_i]), (PG8_LAS unsigned*)(lds + (bufoff) + ldsw + _i * 8192), 16, 0, 0); } while (0)
#define PG8_STAGE_A(bufoff, ptr, h) do { if constexpr (GATHER) PG8_STAGE(bufoff, ptr, cuo + 2 * (h)); else PG8_STAGE(bufoff, (ptr) + (h) * hstep, voffA); } while (0)
#define PG8_LDA(dst, b, h) do { _Pragma("unroll") for (int m = 0; m < 4; ++m) _Pragma("unroll") for (int k = 0; k < 2; ++k) dst[m][k] = *(const PG8_LAS bf16x8*)(lds + PG8_SA(b, h) + aoff + m * 2048 + k * 1024); } while (0)
#define PG8_LDB(dst, b, h) do { _Pragma("unroll") for (int n = 0; n < 2; ++n) _Pragma("unroll") for (int k = 0; k < 2; ++k) dst[n][k] = *(const PG8_LAS bf16x8*)(lds + PG8_SB(b, h) + boff + n * 2048 + k * 1024); } while (0)
#define PG8_MMA(ai, bj, At, Bt) do { __builtin_amdgcn_s_setprio(1); _Pragma("unroll") for (int m = 0; m < 4; ++m) _Pragma("unroll") for (int n = 0; n < 2; ++n) _Pragma("unroll") for (int k = 0; k < 2; ++k) \
        acc[ai][bj][m][n] = mma16<I8>(Bt[n][k], At[m][k], acc[ai][bj][m][n]); __builtin_amdgcn_s_setprio(0); } while (0)
#define PG8_WAIT_V(n) asm volatile("s_waitcnt vmcnt(" #n ")" ::: "memory")
#define PG8_WAIT_L(n) asm volatile("s_waitcnt lgkmcnt(" #n ")" ::: "memory")
#define PG8_BAR __builtin_amdgcn_s_barrier()
#define PG8_SCHED __builtin_amdgcn_sched_barrier(0)
    Unit cur, nxt; int ui = 0;
    if (!S.next(0, cur)) return;
    unsigned cuo[4] = {0u, 0u, 0u, 0u}, cb0 = 0u; v2u_t raw = {0u, 0u};
    if constexpr (GATHER) { int R0, C0; stage_rc(tid * 16, R0, C0); cb0 = (unsigned)C0 * 2u; unsigned ro = (unsigned)R0 * 8u; asm volatile("" : "+v"(ro));
        Unit u1; const bool h1 = S.next(1, u1); const v2u_t r0 = *(const v2u_t*)((const char*)S.rowtab + (size_t)cur.pm * 512 + ro); raw = *(const v2u_t*)((const char*)S.rowtab + (size_t)(h1 ? u1.pm : cur.pm) * 512 + ro);
        cuo[0] = ((r0.x & 0xffffu) << 11) + cb0; cuo[1] = ((r0.x >> 16) << 11) + cb0; cuo[2] = ((r0.y & 0xffffu) << 11) + cb0; cuo[3] = ((r0.y >> 16) << 11) + cb0; }
    f32x4 acc[2][2][4][2];
#pragma unroll
    for (int a = 0; a < 2; ++a)
#pragma unroll
        for (int b = 0; b < 2; ++b)
#pragma unroll
            for (int m = 0; m < 4; ++m)
#pragma unroll
                for (int n = 0; n < 2; ++n) acc[a][b][m][n] = (f32x4){0.f, 0.f, 0.f, 0.f};
    bf16x8 At[4][2], B0[2][2], B1[2][2];
    const char* cA = S.pa(g, cur); const char* cB = S.pb(g, cur);
    S.a_ready(cur);
    if constexpr (SP2) {
        PG8_STAGE(PG8_SB(0, 0), cB, voffB); PG8_STAGE(PG8_SB(0, 1), cB + hstep, voffB); PG8_STAGE_A(PG8_SA(0, 0), cA, 0); PG8_STAGE_A(PG8_SA(0, 1), cA, 1);
        if (wr == 1) PG8_BAR;
        PG8_WAIT_V(2); PG8_BAR;
        PG8_STAGE(PG8_SB(1, 0), cB + kstep, voffB); PG8_STAGE_A(PG8_SA(1, 0), cA + kstep, 0); PG8_STAGE(PG8_SB(1, 1), cB + hstep + kstep, voffB);
        PG8_WAIT_V(6); PG8_BAR;
    } else {
        PG8_STAGE(PG8_SB(0, 0), cB, voffB); PG8_STAGE(PG8_SA(0, 0), cA, voffA); PG8_STAGE(PG8_SB(0, 1), cB + hstep, voffB); PG8_STAGE(PG8_SA(0, 1), cA + hstep, voffA);
        if (wr == 1) PG8_BAR;
        PG8_WAIT_V(4); PG8_BAR;
        PG8_STAGE(PG8_SB(1, 0), cB + kstep, voffB); PG8_STAGE(PG8_SA(1, 0), cA + kstep, voffA); PG8_STAGE(PG8_SB(1, 1), cB + hstep + kstep, voffB);
        PG8_WAIT_V(6); PG8_BAR;
    }
    for (;;) {
        const bool has_next = S.next(ui + 1, nxt);
        const char* nA = has_next ? S.pa(g, nxt) : cA; const char* nB = has_next ? S.pb(g, nxt) : cB;
        for (int t = 0; t < nt; t += 2) {
            const bool last = (t == nt - 2);
            const char* a1 = cA + (size_t)(t + 1) * kstep;
            const char* a2 = last ? nA : cA + (size_t)(t + 2) * kstep; const char* b2 = last ? nB : cB + (size_t)(t + 2) * kstep;
            const char* a3 = a2 + kstep; const char* b3 = b2 + kstep;
            if (last && has_next) S.a_ready(nxt);
            if constexpr (SP2) {
            PG8_LDB(B0, 0, 0); PG8_LDB(B1, 0, 1); PG8_SCHED; PG8_LDA(At, 0, 0); PG8_STAGE_A(PG8_SA(1, 1), a1, 1);
            if constexpr (GATHER) { unsigned rx = raw.x, ry = raw.y; asm volatile("" : "+v"(rx), "+v"(ry));
                const unsigned n0 = ((rx & 0xffffu) << 11) + cb0, n1 = ((rx >> 16) << 11) + cb0, n2 = ((ry & 0xffffu) << 11) + cb0, n3 = ((ry >> 16) << 11) + cb0;
                cuo[0] = last ? n0 : cuo[0]; cuo[1] = last ? n1 : cuo[1]; cuo[2] = last ? n2 : cuo[2]; cuo[3] = last ? n3 : cuo[3]; }
            PG8_WAIT_V(8); PG8_WAIT_L(0); PG8_BAR; PG8_MMA(0, 0, At, B0); PG8_MMA(0, 1, At, B1); PG8_BAR; PG8_SCHED;
            PG8_LDA(At, 0, 1); PG8_STAGE(PG8_SB(0, 0), b2, voffB); PG8_STAGE(PG8_SB(0, 1), b2 + hstep, voffB); PG8_STAGE_A(PG8_SA(0, 0), a2, 0);
            PG8_WAIT_V(8); PG8_WAIT_L(0); PG8_BAR; PG8_MMA(1, 0, At, B0); PG8_MMA(1, 1, At, B1); PG8_BAR; PG8_SCHED;
            PG8_LDB(B0, 1, 0); PG8_LDB(B1, 1, 1); PG8_SCHED; PG8_LDA(At, 1, 0); PG8_STAGE_A(PG8_SA(0, 1), a2, 1);
            PG8_WAIT_V(8); PG8_WAIT_L(0); PG8_BAR; PG8_MMA(0, 0, At, B0); PG8_MMA(0, 1, At, B1); PG8_BAR; PG8_SCHED;
            PG8_LDA(At, 1, 1); PG8_STAGE(PG8_SB(1, 0), b3, voffB); PG8_STAGE(PG8_SB(1, 1), b3 + hstep, voffB); PG8_STAGE_A(PG8_SA(1, 0), a3, 0);
            PG8_WAIT_V(8); PG8_WAIT_L(0); PG8_BAR; PG8_MMA(1, 0, At, B0); PG8_MMA(1, 1, At, B1); PG8_BAR; PG8_SCHED;
            } else {
            PG8_LDB(B0, 0, 0); PG8_SCHED; PG8_LDA(At, 0, 0); PG8_STAGE(PG8_SA(1, 1), a1 + hstep, voffA);
            PG8_WAIT_L(8); PG8_BAR; PG8_WAIT_L(0); PG8_MMA(0, 0, At, B0); PG8_BAR; PG8_SCHED;
            PG8_LDB(B1, 0, 1); PG8_STAGE(PG8_SB(0, 0), b2, voffB);
            PG8_BAR; PG8_WAIT_L(0); PG8_MMA(0, 1, At, B1); PG8_BAR;
            PG8_LDA(At, 0, 1); PG8_STAGE(PG8_SA(0, 0), a2, voffA);
            PG8_BAR; PG8_WAIT_L(0); PG8_MMA(1, 0, At, B0); PG8_BAR; PG8_SCHED;
            PG8_STAGE(PG8_SB(0, 1), b2 + hstep, voffB);
            PG8_WAIT_V(6); PG8_BAR; PG8_MMA(1, 1, At, B1); PG8_BAR;
            PG8_LDB(B0, 1, 0); PG8_SCHED; PG8_LDA(At, 1, 0); PG8_STAGE(PG8_SA(0, 1), a2 + hstep, voffA);
            PG8_WAIT_L(8); PG8_BAR; PG8_WAIT_L(0); PG8_MMA(0, 0, At, B0); PG8_BAR; PG8_SCHED;
            PG8_LDB(B1, 1, 1); PG8_STAGE(PG8_SB(1, 0), b3, voffB);
            PG8_BAR; PG8_WAIT_L(0); PG8_MMA(0, 1, At, B1); PG8_BAR;
            PG8_LDA(At, 1, 1); PG8_STAGE(PG8_SA(1, 0), a3, voffA);
            PG8_BAR; PG8_WAIT_L(0); PG8_MMA(1, 0, At, B0); PG8_BAR; PG8_SCHED;
            PG8_STAGE(PG8_SB(1, 1), b3 + hstep, voffB);
            PG8_WAIT_V(6); PG8_BAR; PG8_MMA(1, 1, At, B1); PG8_BAR;
            }
        }
        if constexpr (ALIGN_EPI) { if (wr == 0) PG8_BAR; }
        if constexpr (GATHER) { static_assert(SP2 && !Epi::AFTER_DRAIN, "GATHER is written for the SP2 loop"); int R0, C0; stage_rc(tid * 16, R0, C0); Unit u2; const bool h2 = S.next(ui + 2, u2);
            unsigned ro = (unsigned)R0 * 8u; asm volatile("" : "+v"(ro)); raw = *(const v2u_t*)((const char*)S.rowtab + (size_t)(h2 ? u2.pm : cur.pm) * 512 + ro); PG8_SCHED; }
        if constexpr (!Epi::AFTER_DRAIN) { E(acc, cur, wr, wc, fr, fq); S.done(cur); }
        if (!has_next) break;
#pragma unroll
        for (int a = 0; a < 2; ++a)
#pragma unroll
            for (int b = 0; b < 2; ++b)
#pragma unroll
                for (int m = 0; m < 4; ++m)
#pragma unroll
                    for (int n = 0; n < 2; ++n) acc[a][b][m][n] = (f32x4){0.f, 0.f, 0.f, 0.f};
        cur = nxt; cA = nA; cB = nB; ++ui;
        if constexpr (ALIGN_EPI) { if (wr == 1) PG8_BAR; }
    }
    PG8_WAIT_V(0);
    if constexpr (!ALIGN_EPI) { if (wr == 0) PG8_BAR; }
    PG8_BAR;
    if constexpr (Epi::AFTER_DRAIN) { E.fused(acc, cur, wr, wc, fr, fq, lds, wid, lane); S.done(cur); }
#undef PG8_SA
#undef PG8_SB
#undef PG8_STAGE
#undef PG8_STAGE_A
#undef PG8_LDA
#undef PG8_LDB
#undef PG8_MMA
#undef PG8_WAIT_V
#undef PG8_WAIT_L
#undef PG8_BAR
#undef PG8_SCHED
}
}

#define GAS __attribute__((address_space(1)))
#define LAS __attribute__((address_space(3)))
typedef unsigned short bf16;
typedef unsigned v4u __attribute__((ext_vector_type(4)));
typedef unsigned v2u __attribute__((ext_vector_type(2)));
typedef float f32x4 __attribute__((ext_vector_type(4)));
typedef short bf16x8 __attribute__((ext_vector_type(8)));

constexpr int NB = 8, SEQ = 4096, DM = 2048, T = NB * SEQ;
constexpr int NPT = 23;
constexpr int NE = 32, DFF = 2048;
constexpr int MAXTILES = 544;
constexpr float RMS_EPS = 1e-5f;
constexpr int NVB = 256, TPV = T / NVB;

enum { I_X = 0, I_NMIX, I_WIN, I_WA2, I_BA, I_GLAG, I_PEK, I_WK1, I_WK2, I_PEV, I_WV1, I_WV2, I_NSAG, I_RELB, I_WOUT, I_NFFN, I_RW, I_RB, I_W1, I_B1, I_W2, I_B2, I_NFIN, N_IN };

constexpr size_t MiB = 1u << 20;
constexpr size_t al(size_t x) { return (x + 255) & ~(size_t)255; }
constexpr size_t WS_CTL = 0, CTL_BYTES = 1 * MiB;
constexpr size_t WS_CNT = WS_CTL + CTL_BYTES;
constexpr size_t WS_META = WS_CNT + al(NVB * 32 * 4);
constexpr size_t WS_EIDX = WS_META + al((64 + MAXTILES) * 4);
constexpr size_t WS_LRNK = WS_EIDX + al((size_t)T * 4 * 4);
constexpr size_t WS_GATE = WS_LRNK + al((size_t)T * 4 * 4);
constexpr size_t WS_POS = WS_GATE + al((size_t)T * 4 * 4);
constexpr size_t WS_ROWW = WS_POS + al((size_t)T * 4 * 4);
constexpr size_t WS_WINT = al(WS_ROWW + (size_t)MAXTILES * 256 * 4);
constexpr size_t WS_WOT = WS_WINT + (size_t)NPT * 256 * DM * 2;
constexpr size_t WS_WKCT = WS_WOT + (size_t)DM * DM * 2;
constexpr size_t WS_WVCT = WS_WKCT + (size_t)256 * 2048 * 2;
constexpr size_t WS_W1T = WS_WVCT + (size_t)256 * 2048 * 2;
constexpr size_t WS_W2T = WS_W1T + (size_t)NE * 4096 * DM * 2;
constexpr size_t WS_XN = WS_W2T + (size_t)NE * DM * DFF * 2;
constexpr size_t WS_GQ = WS_XN + (size_t)T * DM * 2;
constexpr size_t WS_GK = WS_GQ + (size_t)T * 512 * 2;
constexpr size_t WS_GV = WS_GK + (size_t)T * 512 * 2;
constexpr size_t WS_GG = WS_GV + (size_t)T * 1024 * 2;
constexpr size_t WS_NQ = WS_GG + (size_t)T * 1024 * 2;
constexpr size_t WS_KC = WS_NQ + (size_t)T * 1024 * 2;
constexpr size_t WS_VC = WS_KC + (size_t)T * 256 * 2;
constexpr size_t WS_KS = WS_VC + (size_t)T * 256 * 2;
constexpr size_t WS_KW = WS_KS + (size_t)T * 256 * 2;
constexpr size_t WS_VST = WS_KW + (size_t)T * 256 * 2;
constexpr size_t WS_VWT = WS_VST + (size_t)T * 256 * 2;
constexpr size_t WS_SM = WS_VWT + (size_t)T * 256 * 2;
constexpr size_t WS_LA = WS_SM + (size_t)T * 64 * 2;
constexpr size_t WS_OG = WS_LA + (size_t)T * 512 * 4;
constexpr size_t WS_ON = WS_OG + (size_t)T * 1024 * 4;
constexpr size_t WS_KCMP = WS_ON + (size_t)T * 1024 * 4;
constexpr size_t WS_VCMPT = WS_KCMP + (size_t)16 * 256 * 128 * 2;
constexpr size_t WS_A2 = WS_VCMPT + (size_t)16 * 256 * 128 * 2;
constexpr size_t WS_HN = WS_A2 + (size_t)T * DM * 2;
constexpr size_t WS_XG = WS_HN + (size_t)T * DM * 2;
constexpr size_t WS_ACT = WS_XG + (size_t)MAXTILES * 256 * DM * 2;
constexpr size_t WS_END = WS_ACT + (size_t)MAXTILES * 256 * DFF * 2;

typedef unsigned short u16x2 __attribute__((ext_vector_type(2)));
__device__ __forceinline__ unsigned cvt2bf(float lo, float hi) { unsigned r; asm("v_cvt_pk_bf16_f32 %0, %1, %2" : "=v"(r) : "v"(lo), "v"(hi)); return r; }
__device__ __forceinline__ unsigned f2bf(float f) { return cvt2bf(f, f) & 0xffffu; }
__device__ __forceinline__ unsigned pk2(float lo, float hi) { return cvt2bf(lo, hi); }
__device__ __forceinline__ float bf2f(unsigned short v) { return __builtin_bit_cast(float, (unsigned)v << 16); }
__device__ __forceinline__ float bflo(unsigned w) { return __builtin_bit_cast(float, w << 16); }
__device__ __forceinline__ float bfhi(unsigned w) { return __builtin_bit_cast(float, w & 0xffff0000u); }
__device__ __forceinline__ float wave_sum(float v) {
#pragma unroll
    for (int o = 1; o < 64; o <<= 1) v += __shfl_xor(v, o);
    return v;
}
__device__ __forceinline__ float wave_max(float v) {
#pragma unroll
    for (int o = 1; o < 64; o <<= 1) v = fmaxf(v, __shfl_xor(v, o));
    return v;
}
#define LDS_WAIT() asm volatile("s_waitcnt lgkmcnt(0)" ::: "memory")

__device__ const unsigned char kBucket[128] = {0, 1, 2, 3, 4, 5, 6, 7, 8, 9, 10, 11, 12, 13, 14, 15, 16, 16, 16, 17, 17, 18, 18, 18, 19, 19, 19, 20, 20, 20, 20, 21, 21, 21, 21, 22, 22, 22, 22, 22, 23, 23, 23, 23, 23, 23, 24, 24, 24, 24, 24, 24, 25, 25, 25, 25, 25, 25, 25, 26, 26, 26, 26, 26, 26, 26, 26, 27, 27, 27, 27, 27, 27, 27, 27, 27, 27, 28, 28, 28, 28, 28, 28, 28, 28, 28, 28, 29, 29, 29, 29, 29, 29, 29, 29, 29, 29, 29, 29, 30, 30, 30, 30, 30, 30, 30, 30, 30, 30, 30, 30, 30, 30, 31, 31, 31, 31, 31, 31, 31, 31, 31, 31, 31, 31, 31, 31, 31};

struct Params {
    const float* in[N_IN];
    float* out;
    unsigned char* ws;
};

template <class F>
__device__ __forceinline__ void transpose_item(const float* W, int ldw, int k0, int n0, int nlim, LAS float* scr, int lane, F dst) {
#pragma unroll 8
    for (int i = 0; i < 32; ++i) { const int kk = 2 * i + (lane >> 5); const int n = n0 + (lane & 31); scr[kk * 33 + (lane & 31)] = n < nlim ? W[(size_t)(k0 + kk) * ldw + n] : 0.f; }
    LDS_WAIT(); asm volatile("" ::: "memory");
    const int c = lane & 7;
#pragma unroll
    for (int j = 0; j < 4; ++j) { const int nn = (lane >> 3) + 8 * j; const int n = n0 + nn; const LAS float* s = scr + (8 * c) * 33 + nn;
        bf16* rowp; float sc;
        if (n < nlim && dst(n, rowp, sc)) {
            v4u o; o.x = pk2(s[0 * 33] * sc, s[1 * 33] * sc); o.y = pk2(s[2 * 33] * sc, s[3 * 33] * sc); o.z = pk2(s[4 * 33] * sc, s[5 * 33] * sc); o.w = pk2(s[6 * 33] * sc, s[7 * 33] * sc);
            *(v4u*)(rowp + 8 * c) = o; } }
    LDS_WAIT(); asm volatile("" ::: "memory");
}
__device__ __forceinline__ int win_row(int n, float& sc) {
    sc = 1.f;
    if (n < 512) { sc = 0.08838834764831845f; return n; }
    if (n < 1024) return n;
    if (n < 2048) return n;
    if (n < 3072) return n;
    if (n < 3088) return 5120 + (n - 3072);
    if (n < 4112) { sc = 0.08838834764831845f; return 3072 + (n - 3088); }
    if (n < 4368) return 4096 + (n - 4112);
    if (n < 4624) return 4352 + (n - 4368);
    if (n < 4880) return 4608 + (n - 4624);
    if (n < 5136) return 5376 + (n - 4880);
    if (n < 5392) return 4864 + (n - 5136);
    if (n < 5648) return 5632 + (n - 5392);
    return 5136 + (n - 5648);
}
constexpr size_t WS_PEVP = WS_W2T;
__device__ __forceinline__ void p0_prologue(const Params& p, LAS unsigned char* lds, int gw, int NGW, int wave, int lane) {
    LAS float* scr = (LAS float*)(lds + wave * 16384);
    bf16* WinT = (bf16*)(p.ws + WS_WINT); bf16* WoT = (bf16*)(p.ws + WS_WOT); bf16* WkcT = (bf16*)(p.ws + WS_WKCT); bf16* WvcT = (bf16*)(p.ws + WS_WVCT);
    bf16* W1T = (bf16*)(p.ws + WS_W1T); bf16* W2T = (bf16*)(p.ws + WS_W2T);
    constexpr int I_IN = 32 * 178, I_O = 32 * 64, I_C = 64 * 4, I_E1 = 32 * 128, I_E2 = 32 * 64;
    constexpr int I_PE = 2 * 64;
    constexpr int NITEMS = I_O + 2 * I_C + I_PE;
    (void)I_IN; (void)WinT;
    for (int it = gw; it < NITEMS; it += NGW) {
        int r = it;
        if (r < I_O) { const int kb = r / 64, nb = r % 64, k0 = kb * 64;
            transpose_item(p.in[I_WOUT], DM, k0, nb * 32, DM, scr, lane, [&](int n, bf16*& rowp, float& sc) { sc = 1.f; rowp = WoT + (size_t)n * DM + k0; return true; }); continue; } r -= I_O;
        if (r >= 2 * I_C) { r -= 2 * I_C; const int which = r >> 6, kq = r & 63; const float* pe = p.in[which ? I_PEV : I_PEK] + kq * 64; const float* w1 = p.in[which ? I_WV1 : I_WK1] + (size_t)kq * 64 * 128 + lane;
            float a0 = 0.f, a1 = 0.f;
#pragma unroll
            for (int k = 0; k < 64; ++k) { const float pv = pe[k]; a0 += pv * w1[k * 128]; a1 += pv * w1[k * 128 + 64]; }
            float* dst = (float*)(p.ws + WS_PEVP) + (size_t)(which * 64 + kq) * 128 + lane; dst[0] = a0; dst[64] = a1; continue; }
        { const int which = r / I_C; r %= I_C; const int kb = r / 4, nb = r % 4, k0 = kb * 64;
            bf16* dstm = which ? WvcT : WkcT;
            transpose_item(p.in[which ? I_WV1 : I_WK1], 128, k0, nb * 32, 128, scr, lane, [&](int n, bf16*& rowp, float& sc) { sc = 1.f; rowp = dstm + (size_t)(n + (k0 >= 2048 ? 128 : 0)) * 2048 + (k0 & 2047); return true; }); }
        (void)I_E1; (void)I_E2; (void)W1T; (void)W2T;
    }
    const float* x = p.in[I_X]; const float* gm = p.in[I_NMIX];
    for (int m = gw; m < T; m += NGW) {
        const f32x4* xr = (const f32x4*)(x + (size_t)m * DM) + lane; f32x4 v[8]; float s = 0.f;
#pragma unroll
        for (int j = 0; j < 8; ++j) { v[j] = xr[64 * j]; s += (v[j].x * v[j].x + v[j].y * v[j].y) + (v[j].z * v[j].z + v[j].w * v[j].w); }
        const float rstd = 1.f / sqrtf(wave_sum(s) * (1.f / DM) + RMS_EPS);
        float mxr = 0.f;
#pragma unroll
        for (int j = 0; j < 8; ++j) { const f32x4 g4 = ((const f32x4*)gm)[lane + 64 * j]; v[j].x *= rstd * g4.x; v[j].y *= rstd * g4.y; v[j].z *= rstd * g4.z; v[j].w *= rstd * g4.w;
            mxr = fmaxf(mxr, fmaxf(fmaxf(fabsf(v[j].x), fabsf(v[j].y)), fmaxf(fabsf(v[j].z), fabsf(v[j].w)))); }
        mxr = wave_max(mxr); const float qs = mxr > 0.f ? mxr * (1.f / 127.f) : 1.f, qi = 1.f / qs;
        unsigned* o4 = (unsigned*)(p.ws + WS_XN + (size_t)m * DM) + lane;
#pragma unroll
        for (int j = 0; j < 8; ++j) { const float M = 12582912.f;
            const unsigned ua = __builtin_bit_cast(unsigned, v[j].x * qi + M), ub = __builtin_bit_cast(unsigned, v[j].y * qi + M), uc = __builtin_bit_cast(unsigned, v[j].z * qi + M), ud = __builtin_bit_cast(unsigned, v[j].w * qi + M);
            o4[64 * j] = __builtin_amdgcn_perm(ub, ua, 0x0c0c0400u) | (__builtin_amdgcn_perm(ud, uc, 0x0c0c0400u) << 16); }
        if (lane == 0) ((float*)(p.ws + WS_XN + (size_t)T * DM))[m] = qs;
    }
}
#define XB_TMO      128
#define XB_XCNT(j)  (256  + 64 * (j))
#define XB_XSUB(j)  (1280 + 64 * (j))
#define XB_XGEN(j)  (2304 + 64 * (j))
#define XB_TOP      3328
#define XB_TOPGEN   3392
#define XCD_BAR_WORDS 3456
#define XB_SPIN_CAP (1u << 18)

__device__ __forceinline__ unsigned xb_ld(unsigned* p)              { return __hip_atomic_load(p, __ATOMIC_RELAXED, __HIP_MEMORY_SCOPE_AGENT); }
__device__ __forceinline__ unsigned xb_add(unsigned* p, unsigned v) { return __hip_atomic_fetch_add(p, v, __ATOMIC_RELAXED, __HIP_MEMORY_SCOPE_AGENT); }
__device__ __forceinline__ unsigned xb_xcc_id() { return (unsigned)__builtin_amdgcn_s_getreg((3 << 11) | 20) & 0xFu; }
#define XB_SPIN(cond, bar) do { unsigned _sp = 0; while (cond) { __builtin_amdgcn_s_sleep(1); \
    if ((++_sp & 255u) == 0u) { if (xb_ld(&(bar)[XB_TMO])) break; if (_sp > XB_SPIN_CAP) { atomicAdd(&(bar)[XB_TMO], 1u); break; } } } } while (0)

struct XcdBarrier {
    unsigned* bar; unsigned x;
    volatile LAS unsigned* st;
};

__device__ __forceinline__ XcdBarrier xcd_barrier_post(unsigned* bar, volatile LAS unsigned* st) {
    XcdBarrier b; b.bar = bar; b.x = xb_xcc_id(); b.st = st;
    if (threadIdx.x == 0) (void)xb_add(&bar[XB_XCNT(b.x)], 1u);
    return b;
}
__device__ __forceinline__ void xcd_barrier_complete(unsigned* bar, unsigned x, unsigned& nloc, unsigned& nx) {
    const unsigned G = gridDim.x * gridDim.y * gridDim.z;
    unsigned sum, cnt, mine, sp = 0u;
    for (;;) {
        sum = 0u; cnt = 0u; mine = 0u;
#pragma unroll
        for (unsigned j = 0; j < 16; ++j) { const unsigned c = xb_ld(&bar[XB_XCNT(j)]); sum += c; cnt += (c > 0u) ? 1u : 0u; mine = (j == x) ? c : mine; }
        if (sum == G) break;
        __builtin_amdgcn_s_sleep(1);
        if ((++sp & 255u) == 0u) { if (xb_ld(&bar[XB_TMO])) break; if (sp > XB_SPIN_CAP) { atomicAdd(&bar[XB_TMO], 1u); break; } }
    }
    nloc = mine > 0u ? mine : 1u; nx = cnt > 0u ? cnt : 1u;
}

__device__ __forceinline__ void xcd_barrier(const XcdBarrier& b) {
    asm volatile("s_waitcnt vmcnt(0)" ::: "memory");
    __syncthreads();
    if (threadIdx.x == 0) {
        unsigned* bar = b.bar;
        __builtin_amdgcn_s_waitcnt(0);
        unsigned nloc = b.st[0], nx = b.st[1];
        if (nloc == 0u) { xcd_barrier_complete(bar, b.x, nloc, nx); b.st[0] = nloc; b.st[1] = nx; }
        const unsigned old = xb_add(&bar[XB_XSUB(b.x)], 1u);
        const unsigned gen = old / nloc;
        if (old + 1u == (gen + 1u) * nloc) {
            __builtin_amdgcn_fence(__ATOMIC_RELEASE, "agent");
            asm volatile("s_waitcnt vmcnt(0)" ::: "memory");
            const unsigned og = xb_add(&bar[XB_TOP], 1u);
            const unsigned tg = og / nx;
            if (og + 1u == (tg + 1u) * nx) xb_add(&bar[XB_TOPGEN], 1u);
            else XB_SPIN(xb_ld(&bar[XB_TOPGEN]) == tg, bar);
            __builtin_amdgcn_fence(__ATOMIC_ACQUIRE, "agent");
            xb_add(&bar[XB_XGEN(b.x)], 1u);
            asm volatile("s_waitcnt vmcnt(0)" ::: "memory");
        } else {
            XB_SPIN(xb_ld(&bar[XB_XGEN(b.x)]) == gen, bar);
            __builtin_amdgcn_fence(__ATOMIC_ACQUIRE, "agent");
            asm volatile("s_waitcnt vmcnt(0)" ::: "memory");
        }
    }
    __syncthreads();
}

struct ProjOrder : pg8::StaticOrder {
    const bf16* xn; const bf16* wt;
    __device__ __forceinline__ bool next(int i, pg8::Unit& u) const { if (!pg8::StaticOrder::next(i, u)) return false; u.kind = (u.pn >= 21) ? 1 : 0; return true; }
    __device__ __forceinline__ const char* pa(const pg8::Gemm& g, const pg8::Unit& u) const { return u.kind ? (const char*)wt + (size_t)u.pn * ((size_t)256 * g.K * 2) : (const char*)xn + (size_t)u.pm * ((size_t)256 * g.K * 2); }
    __device__ __forceinline__ const char* pb(const pg8::Gemm& g, const pg8::Unit& u) const { return u.kind ? (const char*)xn + (size_t)u.pm * ((size_t)256 * g.K * 2) : (const char*)wt + (size_t)u.pn * ((size_t)256 * g.K * 2); }
};
struct EpiRes {
    static constexpr bool PERM = true, AFTER_DRAIN = false;
    const float* x; bf16* h;
    __device__ __forceinline__ void operator()(const pg8::f32x4 (&acc)[2][2][4][2], const pg8::Unit& u, int wr, int wc, int fr, int fq) const {
        const int row0 = u.pm * 256 + wr * 64 + fr, col0 = u.pn * 256 + wc * 32 + 8 * fq;
#pragma unroll
        for (int ai = 0; ai < 2; ++ai)
#pragma unroll
            for (int m = 0; m < 4; ++m) { const size_t off = (size_t)(row0 + ai * 128 + m * 16) * DM + col0;
#pragma unroll
                for (int bj = 0; bj < 2; ++bj) { const pg8::f32x4 x0 = *(const pg8::f32x4*)(x + off + bj * 128), x1 = *(const pg8::f32x4*)(x + off + bj * 128 + 4);
                    const pg8::f32x4 a0 = x0 + acc[ai][bj][m][0], a1 = x1 + acc[ai][bj][m][1]; pg8::u32x4 w;
                    w.x = pg8::cvt_pk_bf16(a0.x, a0.y); w.y = pg8::cvt_pk_bf16(a0.z, a0.w); w.z = pg8::cvt_pk_bf16(a1.x, a1.y); w.w = pg8::cvt_pk_bf16(a1.z, a1.w);
                    *(pg8::u32x4*)(h + off + bj * 128) = w; } }
    }
};
struct MoeOrder {
    int nM, nN, nwg, G, c; const int* tile_exp;
    __device__ __forceinline__ void init(const int* meta, int nN_, int G_, int c_) { nM = meta[0]; nN = nN_; nwg = nM * nN; G = G_; c = c_; tile_exp = meta + 64; }
    __device__ __forceinline__ bool next(int i, pg8::Unit& u) const {
        const long L = (long)i * G + c; if (L >= nwg) return false;
        pg8::tile_of<8>((int)L, nM, nN, u.pm, u.pn); u.kind = tile_exp[u.pm]; return true;
    }
    __device__ __forceinline__ const char* pa(const pg8::Gemm& g, const pg8::Unit& u) const { return (const char*)g.A + (size_t)u.pm * ((size_t)256 * g.K * 2); }
    __device__ __forceinline__ const char* pb(const pg8::Gemm& g, const pg8::Unit& u) const { return (const char*)g.Bt + ((size_t)u.kind * nN + u.pn) * ((size_t)256 * g.K * 2); }
    __device__ __forceinline__ void a_ready(const pg8::Unit&) const {}
    __device__ __forceinline__ void done(const pg8::Unit&) const {}
};

struct MoeOrderG : MoeOrder { const unsigned short* rowtab;
    __device__ __forceinline__ const char* pa(const pg8::Gemm& g, const pg8::Unit&) const { return (const char*)g.A; } };

__device__ __forceinline__ float gelu_tanh(float x) { const float u = 0.7978845608028654f * (x + 0.044715f * x * x * x); const float e = __expf(2.f * u); return 0.5f * x * (1.f + (1.f - 2.f / (e + 1.f))); }
__device__ __forceinline__ void ph_cmp_fin(const Params& p, LAS unsigned char* lds, int bid, int G, int tid, const float* LHall, const float* PEVall) {
    const int grp = tid >> 7, n = tid & 127, ngrp = G * 4, total = 2 * 16 * 255, iters = (total + ngrp - 1) / ngrp;
    LAS float* hid = (LAS float*)lds + grp * 128;
    float pevs[2];
#pragma unroll
    for (int w = 0; w < 2; ++w) { float s = 0.f;
#pragma unroll 8
        for (int q = 0; q < 64; ++q) s += PEVall[(size_t)(w * 64 + q) * 128 + n];
        pevs[w] = s; }
    float wcol[128]; int wh = -1;
    for (int it = 0; it < iters; ++it) { int id = it * ngrp + bid * 4 + grp; if (id >= total) id = total - 1;
        const int which = id / (16 * 255), rem = id % (16 * 255), bg = rem / 255, c = rem % 255;
        if (which != wh) { const float* w2 = p.in[which ? I_WV2 : I_WK2]; wh = which;
#pragma unroll
            for (int mm = 0; mm < 128; ++mm) wcol[mm] = w2[mm * 128 + n]; }
        const float* LH = LHall + ((size_t)which * 4096 + bg * 256) * 256;
        const float a = LH[(size_t)c * 256 + n] + LH[(size_t)(c + 1) * 256 + 128 + n] + (which ? pevs[1] : pevs[0]);
        hid[n] = gelu_tanh(a);
        __syncthreads();
        float o0 = 0.f, o1 = 0.f, o2 = 0.f, o3 = 0.f;
#pragma unroll
        for (int m4 = 0; m4 < 32; ++m4) { const f32x4 hv = *(const LAS f32x4*)(hid + 4 * m4); o0 += hv.x * wcol[4 * m4]; o1 += hv.y * wcol[4 * m4 + 1]; o2 += hv.z * wcol[4 * m4 + 2]; o3 += hv.w * wcol[4 * m4 + 3]; }
        const float o = (o0 + o1) + (o2 + o3);
        if (which == 0) ((bf16*)(p.ws + WS_KCMP))[((size_t)bg * 256 + c) * 128 + n] = (bf16)f2bf(o);
        else ((bf16*)(p.ws + WS_VCMPT))[((size_t)bg * 128 + n) * 256 + c] = (bf16)f2bf(o);
        __syncthreads(); }
}

namespace nsa {
constexpr int KB0 = 0, KB1 = 16384, VB0 = 32768, VB1 = 49152, LUT = 65536;
constexpr int QST = LUT + 4096, IMP = QST + 65536, SELM = IMP + 16384, LDS_END = SELM + 512;
constexpr float LOG2E = 1.4426950408889634f;
typedef float f4 __attribute__((ext_vector_type(4)));

typedef unsigned u2v __attribute__((ext_vector_type(2)));
__device__ __forceinline__ float rmax16(float x) { const unsigned u = __float_as_uint(x); const u2v r = __builtin_amdgcn_permlane16_swap(u, u, false, false); return fmaxf(__uint_as_float(r[0]), __uint_as_float(r[1])); }
__device__ __forceinline__ float rmax32(float x) { const unsigned u = __float_as_uint(x); const u2v r = __builtin_amdgcn_permlane32_swap(u, u, false, false); return fmaxf(__uint_as_float(r[0]), __uint_as_float(r[1])); }
__device__ __forceinline__ float radd16(float x) { const unsigned u = __float_as_uint(x); const u2v r = __builtin_amdgcn_permlane16_swap(u, u, false, false); return __uint_as_float(r[0]) + __uint_as_float(r[1]); }
__device__ __forceinline__ float radd32(float x) { const unsigned u = __float_as_uint(x); const u2v r = __builtin_amdgcn_permlane32_swap(u, u, false, false); return __uint_as_float(r[0]) + __uint_as_float(r[1]); }
__device__ __forceinline__ float raddq(float x) { x += __int_as_float(__builtin_amdgcn_update_dpp(0, __float_as_int(x), 0xB1, 0xF, 0xF, true)); x += __int_as_float(__builtin_amdgcn_update_dpp(0, __float_as_int(x), 0x4E, 0xF, 0xF, true)); return x; }
struct Ctx {
    LAS unsigned char* lds; int tid, lane, wave, c, gq, r;
    int s0, cur;
    const LAS unsigned char* qst;
    int pos0;
    const LAS float* lutrow;
    int koff0, voff0;
    unsigned kdo[2], vdoc[2], vdos[2];
};
__device__ __forceinline__ void dma_k(const Ctx& C, const bf16* kt, LAS unsigned char* kb) {
#pragma unroll
    for (int i = 0; i < 2; ++i) __builtin_amdgcn_global_load_lds((const unsigned*)((const char*)kt + C.kdo[i]), (LAS unsigned*)(kb + (2 * C.wave + i) * 1024), 16, 0, 0); }
__device__ __forceinline__ void dma_v(const Ctx& C, const bf16* vt, const unsigned (&vdo)[2], LAS unsigned char* vb) {
#pragma unroll
    for (int i = 0; i < 2; ++i) __builtin_amdgcn_global_load_lds((const unsigned*)((const char*)vt + vdo[i]), (LAS unsigned*)(vb + (2 * C.wave + i) * 1024), 16, 0, 0); }

__device__ __forceinline__ void compute_st(const Ctx& C, const LAS unsigned char* kb, f4 (&s)[2][4]) {
#pragma unroll
    for (int ks = 0; ks < 4; ++ks) { const bf16x8 q0 = *(const LAS bf16x8*)(C.qst + ks * 1024), q1 = *(const LAS bf16x8*)(C.qst + (4 + ks) * 1024);
#pragma unroll
        for (int kt = 0; kt < 4; ++kt) { const bf16x8 a = *(const LAS bf16x8*)(kb + kt * 4096 + (C.koff0 ^ (ks * 64)));
            s[0][kt] = __builtin_amdgcn_mfma_f32_16x16x32_bf16(a, q0, ks == 0 ? (f4){0.f, 0.f, 0.f, 0.f} : s[0][kt], 0, 0, 0);
            s[1][kt] = __builtin_amdgcn_mfma_f32_16x16x32_bf16(a, q1, ks == 0 ? (f4){0.f, 0.f, 0.f, 0.f} : s[1][kt], 0, 0, 0); }
        asm volatile("" ::: "memory"); }
}
__device__ __forceinline__ void compute_pv(const Ctx& C, const LAS unsigned char* vb, const f4 (&p)[2][4], f4 (&o)[2][8]) {
#pragma unroll
    for (int i = 0; i < 2; ++i) { bf16x8 pb[2];
#pragma unroll
        for (int qt = 0; qt < 2; ++qt) { v4u w; w.x = pg8::cvt_pk_bf16(p[qt][2 * i][0], p[qt][2 * i][1]); w.y = pg8::cvt_pk_bf16(p[qt][2 * i][2], p[qt][2 * i][3]);
            w.z = pg8::cvt_pk_bf16(p[qt][2 * i + 1][0], p[qt][2 * i + 1][1]); w.w = pg8::cvt_pk_bf16(p[qt][2 * i + 1][2], p[qt][2 * i + 1][3]); pb[qt] = __builtin_bit_cast(bf16x8, w); }
#pragma unroll
        for (int dt = 0; dt < 8; ++dt) { const v2u lo = *(const LAS v2u*)(vb + dt * 2048 + (C.voff0 ^ (i * 64))), hi = *(const LAS v2u*)(vb + dt * 2048 + (C.voff0 ^ (i * 64 + 32))); const bf16x8 a = __builtin_bit_cast(bf16x8, (v4u){lo.x, lo.y, hi.x, hi.y});
#pragma unroll
            for (int qt = 0; qt < 2; ++qt) o[qt][dt] = __builtin_amdgcn_mfma_f32_16x16x32_bf16(a, pb[qt], o[qt][dt], 0, 0, 0);
            if (dt & 1) asm volatile("" ::: "memory"); } }
}
enum { M_CMP = 0, M_SEL = 1, M_WIN = 2 };
template <int MODE, bool FAR = false>
__device__ __forceinline__ void mask_bias(const Ctx& C, f4 (&s)[2][4], int kb, int n, const LAS unsigned* selw) {
    const float NEG = -__builtin_inff();
#pragma unroll
    for (int qt = 0; qt < 2; ++qt) {
        bool tokok = true;
        if (MODE == M_SEL) tokok = ((selw[(4 * qt + (C.c >> 2)) * 2 + (n >> 5)] >> (n & 31)) & 1u) != 0u;
        if (FAR) { const float be = tokok ? C.lutrow[127] : NEG;
#pragma unroll
            for (int kt = 0; kt < 4; ++kt)
#pragma unroll
                for (int rg = 0; rg < 4; ++rg) s[qt][kt][rg] = __builtin_fmaf(s[qt][kt][rg], LOG2E, be);
            continue; }
        const int dbase = (MODE == M_CMP) ? (C.pos0 + 4 * qt - 31 - 16 * (kb + 4 * C.gq)) : (C.pos0 + 4 * qt - (kb + 4 * C.gq));
#pragma unroll
        for (int kt = 0; kt < 4; ++kt) {
#pragma unroll
            for (int rg = 0; rg < 4; ++rg) { const int d = (MODE == M_CMP) ? dbase - 16 * (16 * kt + rg) : dbase - (16 * kt + rg);
                int di = d < 0 ? 0 : d; di = di > 127 ? 127 : di; const float bias = C.lutrow[di];
                bool ok = tokok && d >= 0; if (MODE == M_WIN) ok = ok && d < 512;
                s[qt][kt][rg] = ok ? __builtin_fmaf(s[qt][kt][rg], LOG2E, bias) : NEG; }
            asm volatile("" ::: "memory"); }
    }
}
__device__ __forceinline__ void softmax_step(f4 (&s)[2][4], float (&m)[2], float (&l)[2], f4 (&o)[2][8], bool rescale_o) {
#pragma unroll
    for (int qt = 0; qt < 2; ++qt) { float mx = s[qt][0][0];
#pragma unroll
        for (int kt = 0; kt < 4; ++kt)
#pragma unroll
            for (int rg = 0; rg < 4; ++rg) mx = fmaxf(mx, s[qt][kt][rg]);
        mx = rmax32(rmax16(mx));
        const float mn = fmaxf(m[qt], mx), alpha = __builtin_amdgcn_exp2f(m[qt] - mn); m[qt] = mn; float ps = 0.f;
#pragma unroll
        for (int kt = 0; kt < 4; ++kt)
#pragma unroll
            for (int rg = 0; rg < 4; ++rg) { const float e = __builtin_amdgcn_exp2f(s[qt][kt][rg] - mn); s[qt][kt][rg] = e; ps += e; }
        l[qt] = l[qt] * alpha + ps;
        if (rescale_o && __any(alpha != 1.f)) {
#pragma unroll
            for (int dt = 0; dt < 8; ++dt) o[qt][dt] = o[qt][dt] * alpha; }
    }
}
template <int MODE>
__device__ __forceinline__ void softmax_far(const Ctx& C, f4 (&s)[2][4], int n, const LAS unsigned* selw, float (&m)[2], float (&l)[2], f4 (&o)[2][8]) {
    const float b31 = C.lutrow[127];
#pragma unroll
    for (int qt = 0; qt < 2; ++qt) {
        float be = b31;
        if (MODE == M_SEL) { const bool tokok = ((selw[(4 * qt + (C.c >> 2)) * 2 + (n >> 5)] >> (n & 31)) & 1u) != 0u; be = tokok ? b31 : -__builtin_inff(); }
        float mx = fmaxf(fmaxf(s[qt][0][0], s[qt][0][1]), fmaxf(s[qt][0][2], s[qt][0][3]));
#pragma unroll
        for (int kt = 1; kt < 4; ++kt) mx = fmaxf(mx, fmaxf(fmaxf(s[qt][kt][0], s[qt][kt][1]), fmaxf(s[qt][kt][2], s[qt][kt][3])));
        mx = rmax32(rmax16(mx));
        const float mt = __builtin_fmaf(mx, LOG2E, be), mn = fmaxf(m[qt], mt), alpha = __builtin_amdgcn_exp2f(m[qt] - mn), c0 = be - mn; m[qt] = mn; float ps = 0.f;
#pragma unroll
        for (int kt = 0; kt < 4; ++kt)
#pragma unroll
            for (int rg = 0; rg < 4; ++rg) { const float e = __builtin_amdgcn_exp2f(__builtin_fmaf(s[qt][kt][rg], LOG2E, c0)); s[qt][kt][rg] = e; ps += e; }
        l[qt] = l[qt] * alpha + ps;
        if (__any(alpha != 1.f)) {
#pragma unroll
            for (int dt = 0; dt < 8; ++dt) o[qt][dt] = o[qt][dt] * alpha; }
    }
}
}

__device__ __forceinline__ void ph_nsa(const Params& p, LAS unsigned char* lds, int idx0, int idxstride, int tid_in, int wave) {
    using namespace nsa;
    int tid = tid_in; asm volatile("" : "+v"(tid));
    const int lane = tid & 63;
    Ctx C; C.lds = lds; C.tid = tid; C.lane = lane; C.wave = wave; C.c = lane & 15; C.gq = lane >> 4; C.r = lane & 3;
    C.koff0 = C.c * 256 + ((C.gq ^ C.c) * 16);
#pragma unroll
    for (int i = 0; i < 2; ++i) { const int piece = 2 * wave + i;
        { const int row = piece * 4 + (lane >> 4), chunk = (lane & 15) ^ (row & 15); C.kdo[i] = (unsigned)(row * 256 + chunk * 16); }
        { const int row = piece * 8 + (lane >> 3), chunk = (lane & 7) ^ ((row >> 1) & 7); C.vdoc[i] = (unsigned)(row * 256 * 2 + chunk * 16); C.vdos[i] = (unsigned)(row * SEQ * 2 + chunk * 16); } }
    C.voff0 = C.c * 128 + (((C.gq >> 1) ^ ((C.c >> 1) & 7)) * 16) + (C.gq & 1) * 8;
    const bf16* NQ = (const bf16*)(p.ws + WS_NQ); const bf16* SM = (const bf16*)(p.ws + WS_SM); bf16* A2 = (bf16*)(p.ws + WS_A2);
    const float* relb = p.in[I_RELB]; const float* nsag = p.in[I_NSAG];
    LAS float* lut = (LAS float*)(lds + LUT);
    for (int i = tid; i < 8 * 128; i += 512) { const int hh = i >> 7, d = i & 127; lut[i] = relb[(int)kBucket[d] * 8 + hh] * LOG2E; }
    __syncthreads();
    LAS unsigned char* qstw = lds + QST + wave * 8192 + lane * 16; C.qst = qstw;
    LAS float* imp = (LAS float*)(lds + IMP + wave * 2048);
    LAS unsigned long long* selm = (LAS unsigned long long*)(lds + SELM + wave * 64);
#define NSA_SYNC() do { asm volatile("s_waitcnt vmcnt(0)" ::: "memory"); __syncthreads(); } while (0)
    for (int idx = idx0; idx < 512; idx += idxstride) {
        const int rnd = idx >> 8, kq = idx & 255, b = kq & 7, tq = rnd == 0 ? 63 - (kq >> 3) : (kq >> 3);
        C.s0 = tq * 64; C.cur = tq;
        const int tokl0 = 8 * wave + (C.c >> 2);
        C.pos0 = C.s0 + tokl0;
        float ssq[2] = {0.f, 0.f};
        for (int g = 0; g < 2; ++g) {
            const int bg = b * 2 + g, h = g * 4 + C.r;
            C.lutrow = lut + h * 128;
            const bf16* KCMP = (const bf16*)(p.ws + WS_KCMP) + (size_t)bg * 256 * 128; const bf16* VCMPT = (const bf16*)(p.ws + WS_VCMPT) + (size_t)bg * 128 * 256;
#pragma unroll
            for (int qt = 0; qt < 2; ++qt) { const unsigned qo = (unsigned)(((b * SEQ + (C.pos0 + 4 * qt)) * 1024 + h * 128 + 8 * C.gq) * 2);
#pragma unroll
                for (int ks = 0; ks < 4; ++ks) *(LAS bf16x8*)(qstw + (qt * 4 + ks) * 1024) = *(const bf16x8*)((const char*)NQ + qo + ks * 64); }
#pragma unroll
            for (int i = 0; i < 2; ++i) *(LAS f32x4*)((LAS unsigned char*)imp + lane * 16 + i * 1024) = (f32x4){0.f, 0.f, 0.f, 0.f};
#define NSA_OROW(qt) ((char*)A2 + (unsigned)(((b * SEQ + C.pos0 + 4 * (qt)) * DM + 1024 + h * 128 + 4 * C.gq) * 2))
            const int cmaxb = C.s0 + 63 - 31; const int nct = cmaxb >= 0 ? ((cmaxb >> 4) >> 6) + 1 : 0;
            float m[2] = {-1e30f, -1e30f}, l[2] = {0.f, 0.f};
            f4 o[2][8];
            if (nct > 0) {
                dma_k(C, KCMP, lds + KB0); NSA_SYNC();
                for (int ct = 0; ct < nct; ++ct) { const int buf = ct & 1;
                    if (ct + 1 < nct) dma_k(C, KCMP + (ct + 1) * 64 * 128, lds + (buf ? KB0 : KB1));
                    f4 s[2][4]; compute_st(C, lds + (buf ? KB1 : KB0), s); mask_bias<M_CMP>(C, s, 64 * ct, 0, (const LAS unsigned*)selm); softmax_step(s, m, l, o, false);
                    NSA_SYNC(); }
            }
            float inv[2];
#pragma unroll
            for (int qt = 0; qt < 2; ++qt) { const float lt = radd32(radd16(l[qt])); inv[qt] = lt > 0.f ? 1.f / lt : 0.f; }
#pragma unroll
            for (int qt = 0; qt < 2; ++qt)
#pragma unroll
                for (int dt = 0; dt < 8; ++dt) o[qt][dt] = (f4){0.f, 0.f, 0.f, 0.f};
            if (nct > 0) {
                dma_k(C, KCMP, lds + KB0); dma_v(C, VCMPT, C.vdoc, lds + VB0); NSA_SYNC();
                for (int ct = 0; ct < nct; ++ct) { const int buf = ct & 1;
                    if (ct + 1 < nct) { dma_k(C, KCMP + (ct + 1) * 64 * 128, lds + (buf ? KB0 : KB1)); dma_v(C, VCMPT + 64 * (ct + 1), C.vdoc, lds + (buf ? VB0 : VB1)); }
                    f4 s[2][4]; compute_st(C, lds + (buf ? KB1 : KB0), s); mask_bias<M_CMP>(C, s, 64 * ct, 0, (const LAS unsigned*)selm);
#pragma unroll
                    for (int qt = 0; qt < 2; ++qt)
#pragma unroll
                        for (int kt = 0; kt < 4; ++kt) {
#pragma unroll
                            for (int rg = 0; rg < 4; ++rg) s[qt][kt][rg] = __builtin_amdgcn_exp2f(s[qt][kt][rg] - m[qt]) * inv[qt];
                            float po = (s[qt][kt][0] + s[qt][kt][1]) + (s[qt][kt][2] + s[qt][kt][3]), p3 = s[qt][kt][3];
                            po = raddq(po); p3 = raddq(p3);
                            const int nb = 16 * ct + 4 * kt + C.gq, tl = 4 * qt + (C.c >> 2);
                            if (C.r == 0) { __hip_atomic_fetch_add((float*)(imp + tl * 64 + nb), po, __ATOMIC_RELAXED, __HIP_MEMORY_SCOPE_WORKGROUP); if (nb + 1 < 64) __hip_atomic_fetch_add((float*)(imp + tl * 64 + nb + 1), p3, __ATOMIC_RELAXED, __HIP_MEMORY_SCOPE_WORKGROUP); } }
                    compute_pv(C, lds + (buf ? VB1 : VB0), s, o);
                    NSA_SYNC(); }
            }
            LDS_WAIT(); __builtin_amdgcn_wave_barrier();
            for (int tk = 0; tk < 8; ++tk) { const int n = lane; float sc;
                if (n == 0 || n == C.cur || n == C.cur - 1) sc = 1e4f; else if (n <= C.cur) sc = imp[tk * 64 + n]; else sc = -1.f;
                const int key = ((sc < 0.f ? 0 : __float_as_int(sc) + 64) & ~63) | (63 - n);
                int rank = 0;
#pragma unroll
                for (int mm = 0; mm < 64; ++mm) rank += (__builtin_amdgcn_readlane(key, mm) > key) ? 1 : 0;
                const unsigned long long mk = __ballot(rank < 16);
                if (lane == 0) selm[tk] = mk; }
            LDS_WAIT(); __builtin_amdgcn_wave_barrier();
#pragma unroll
            for (int qt = 0; qt < 2; ++qt) { const float gt = 1.f / (1.f + __expf(-bf2f(*(const bf16*)((const char*)SM + (unsigned)(((b * SEQ + (C.pos0 + 4 * qt)) * 64 + 16 + h) * 2)))));
#pragma unroll
                for (int dt = 0; dt < 8; ++dt) { const f4 v = o[qt][dt] * gt; *(v2u*)(NSA_OROW(qt) + 32 * dt) = (v2u){pg8::cvt_pk_bf16(v[0], v[1]), pg8::cvt_pk_bf16(v[2], v[3])}; } }
#pragma unroll
            for (int br = 1; br <= 2; ++br) {
                const bf16* KX = (const bf16*)(p.ws + (br == 1 ? WS_KS : WS_KW)) + bg * SEQ * 128; const bf16* VX = (const bf16*)(p.ws + (br == 1 ? WS_VST : WS_VWT)) + bg * 128 * SEQ;
                const int n0 = br == 1 ? 0 : (C.cur >= 8 ? C.cur - 8 : 0), n1 = C.cur;
                m[0] = m[1] = -1e30f; l[0] = l[1] = 0.f;
#pragma unroll
                for (int qt = 0; qt < 2; ++qt)
#pragma unroll
                    for (int dt = 0; dt < 8; ++dt) o[qt][dt] = (f4){0.f, 0.f, 0.f, 0.f};
                int f0 = n1 + 1, f1 = n0 - 1;
                for (int n = n0; n <= n1; ++n) { const bool fa = (C.s0 - (64 * n + 63) >= 113) && (br == 1 || (C.s0 + 63 - 64 * n) < 512); if (fa) { f0 = n < f0 ? n : f0; f1 = n; } }
                const int cntf = f1 >= f0 ? f1 - f0 + 1 : 0, cnt = n1 - n0 + 1, nlo = cntf ? f0 - n0 : cnt;
#define NSA_TILE(i) ((i) < cntf ? f0 + (i) : (((i) - cntf) < nlo ? n0 + ((i) - cntf) : f1 + 1 + ((i) - cntf - nlo)))
#define NSA_BODY(FARF) { const int n = NSA_TILE(i); const int buf = i & 1; \
                    if (i + 1 < cnt) { const int nn = NSA_TILE(i + 1); dma_k(C, KX + nn * 64 * 128, lds + (buf ? KB0 : KB1)); dma_v(C, VX + 64 * nn, C.vdos, lds + (buf ? VB0 : VB1)); } \
                    bool need = true; \
                    if (br == 1) { const unsigned any = ((const LAS unsigned*)selm)[(lane & 7) * 2 + (n >> 5)] >> (n & 31); need = __any((int)(any & 1u)); } \
                    if (need) { f4 s[2][4]; compute_st(C, lds + (buf ? KB1 : KB0), s); \
                        if (FARF) { if (br == 1) softmax_far<M_SEL>(C, s, n, (const LAS unsigned*)selm, m, l, o); else softmax_far<M_WIN>(C, s, n, (const LAS unsigned*)selm, m, l, o); } \
                        else { if (br == 1) mask_bias<M_SEL, false>(C, s, 64 * n, n, (const LAS unsigned*)selm); else mask_bias<M_WIN, false>(C, s, 64 * n, n, (const LAS unsigned*)selm); \
                            softmax_step(s, m, l, o, true); } \
                        compute_pv(C, lds + (buf ? VB1 : VB0), s, o); } \
                    NSA_SYNC(); }
                { const int nf = NSA_TILE(0); dma_k(C, KX + nf * 64 * 128, lds + KB0); dma_v(C, VX + 64 * nf, C.vdos, lds + VB0); NSA_SYNC(); }
                int i = 0;
                for (; i < cntf; ++i) NSA_BODY(true)
                for (; i < cnt; ++i) NSA_BODY(false)
#undef NSA_BODY
#undef NSA_TILE
                asm volatile("s_waitcnt vmcnt(0)" ::: "memory");
#pragma unroll
                for (int qt = 0; qt < 2; ++qt) { const float lt = radd32(radd16(l[qt]));
                    const int row = b * SEQ + (C.pos0 + 4 * qt);
                    const float sc = (1.f / (1.f + __expf(-bf2f(*(const bf16*)((const char*)SM + (unsigned)((row * 64 + 16 + 8 * br + h) * 2)))))) / lt;
#pragma unroll
                    for (int dt = 0; dt < 8; ++dt) { const f4 v = o[qt][dt] * sc; v2u* sp = (v2u*)(NSA_OROW(qt) + 32 * dt); const v2u pv = *sp;
                        const float a0 = bflo(pv.x) + v[0], a1 = bfhi(pv.x) + v[1], a2 = bflo(pv.y) + v[2], a3 = bfhi(pv.y) + v[3];
                        if (br == 2) ssq[qt] += (a0 * a0 + a1 * a1) + (a2 * a2 + a3 * a3);
                        *sp = (v2u){pg8::cvt_pk_bf16(a0, a1), pg8::cvt_pk_bf16(a2, a3)}; } }
            }
        }
        float rstd[2];
#pragma unroll
        for (int qt = 0; qt < 2; ++qt) { const float t = radd32(radd16(raddq(ssq[qt]))); rstd[qt] = 1.f / sqrtf(t * (1.f / 1024.f) + RMS_EPS); }
        asm volatile("s_waitcnt vmcnt(0)" ::: "memory");
#pragma unroll
        for (int qt = 0; qt < 2; ++qt) { const int sub = C.r * 4 + C.gq; bf16* orow = (bf16*)((char*)A2 + (unsigned)(((b * SEQ + (C.pos0 + 4 * qt)) * DM + 1024) * 2 + sub * 16)); const int subz = 0;
#pragma unroll
            for (int j = 0; j < 8; ++j) { const int col = (j * 16 + subz) * 8; v4u w = *(const v4u*)((const char*)orow + (unsigned)(col * 2)); const f32x4 g0 = *(const f32x4*)((const char*)nsag + (unsigned)(col * 4 + sub * 32)), g1 = *(const f32x4*)((const char*)nsag + (unsigned)(col * 4 + sub * 32 + 16)); const float rs = rstd[qt];
                w.x = pk2(bflo(w.x) * rs * g0.x, bfhi(w.x) * rs * g0.y); w.y = pk2(bflo(w.y) * rs * g0.z, bfhi(w.y) * rs * g0.w); w.z = pk2(bflo(w.z) * rs * g1.x, bfhi(w.z) * rs * g1.y); w.w = pk2(bflo(w.w) * rs * g1.z, bfhi(w.w) * rs * g1.w);
                *(v4u*)((char*)orow + (unsigned)(col * 2)) = w; } }
        NSA_SYNC();
    }
#undef NSA_SYNC
#undef NSA_OROW
}

constexpr size_t WS_ST = WS_LA;
constexpr size_t WS_DEC = WS_ST + (size_t)2048 * 256 * 128 * 2;
static_assert(WS_DEC + (size_t)2048 * 128 * 4 <= WS_KCMP, "gla scratch overlay");
namespace gla {
typedef float f4 __attribute__((ext_vector_type(4)));
constexpr int L_ST = 0, L_KT = 65536, L_QT = 81920, L_VT = 98304, L_GA = 131072, L_GT = L_GA + 4096, L_RED = L_GT + 2048, L_END = L_RED + 512;
struct CumIn { float w[16]; float bb; v4u sm; };
__device__ __forceinline__ CumIn load_cum(const Params& p, int tid, int t0, int h) { CumIn x;
    const bf16* SM = (const bf16*)(p.ws + WS_SM); const float* wa2 = p.in[I_WA2]; const float* ba = p.in[I_BA]; const int dk = tid & 127;
    x.sm = (v4u){0u, 0u, 0u, 0u};
    if (tid < 128) { const int j = tid >> 1, hf = tid & 1; x.sm = *(const v4u*)((const char*)SM + (unsigned)(((t0 + j) * 64 + hf * 8) * 2)); }
#pragma unroll
    for (int r = 0; r < 16; ++r) x.w[r] = wa2[r * 512 + h * 128 + dk];
    x.bb = ba[h * 128 + dk];
    return x; }
__device__ __forceinline__ void chunk_cumsum(const CumIn& in, LAS unsigned char* lds, int tid, float (&P)[16], float& blast) {
    LAS float* ga = (LAS float*)(lds + L_GA); LAS float* gt = (LAS float*)(lds + L_GT);
    if (tid < 128) { const int j = tid >> 1, hf = tid & 1; const v4u w = in.sm;
        LAS float* d = ga + j * 16 + hf * 8; d[0] = bflo(w.x); d[1] = bfhi(w.x); d[2] = bflo(w.y); d[3] = bfhi(w.y); d[4] = bflo(w.z); d[5] = bfhi(w.z); d[6] = bflo(w.w); d[7] = bfhi(w.w); }
    const int dk = tid & 127, jq = tid >> 7;
    const float bb = in.bb;
    __syncthreads();
    float run = 0.f;
#pragma unroll
    for (int jj = 0; jj < 16; ++jj) { const LAS f32x4* gr = (const LAS f32x4*)(ga + (16 * jq + jj) * 16); float z = bb;
#pragma unroll
        for (int r4 = 0; r4 < 4; ++r4) { const f32x4 g4 = gr[r4]; z += g4.x * in.w[4 * r4] + g4.y * in.w[4 * r4 + 1] + g4.z * in.w[4 * r4 + 2] + g4.w * in.w[4 * r4 + 3]; }
        run += (fminf(z, 0.f) - __logf(1.f + __expf(-fabsf(z)))) * (1.f / 16.f);   P[jj] = run; }
    gt[jq * 128 + dk] = run;
    __syncthreads();
    float off = 0.f, tot = 0.f;
#pragma unroll
    for (int q = 0; q < 4; ++q) { const float t = gt[q * 128 + dk]; tot += t; if (q < jq) off += t; }
#pragma unroll
    for (int jj = 0; jj < 16; ++jj) P[jj] += off;
    blast = tot;
}
struct RawK { v4u r[2]; }; struct RawV { v4u r[4]; };
__device__ __forceinline__ RawK load_raw_k(const bf16* src  , int tid, int t0, int h) { RawK x;
#pragma unroll
    for (int q = 0; q < 2; ++q) { const int id = tid + 512 * q, j = id >> 4, c16 = id & 15; x.r[q] = *(const v4u*)((const char*)src + (unsigned)(((t0 + j) * 512 + h * 128 + c16 * 8) * 2)); }
    return x; }
__device__ __forceinline__ void store_raw_k(LAS unsigned char* dst, int tid, const RawK& x) {
#pragma unroll
    for (int q = 0; q < 2; ++q) { const int id = tid + 512 * q, j = id >> 4, c16 = id & 15; *(LAS v4u*)(dst + j * 256 + c16 * 16) = x.r[q]; } }
__device__ __forceinline__ RawV load_raw_v(const Params& p, int tid, int t0, int h) { const bf16* GV = (const bf16*)(p.ws + WS_GV); RawV x;
#pragma unroll
    for (int q = 0; q < 4; ++q) { const int id = tid + 512 * q, j = id >> 5, c = id & 31; x.r[q] = *(const v4u*)((const char*)GV + (unsigned)(((t0 + j) * 1024 + h * 256 + c * 8) * 2)); }
    return x; }
__device__ __forceinline__ void store_raw_v(LAS unsigned char* dst, int tid, const RawV& x) {
#pragma unroll
    for (int q = 0; q < 4; ++q) { const int id = tid + 512 * q, j = id >> 5, c = id & 31; *(LAS v4u*)(dst + j * 512 + c * 16) = x.r[q]; } }
__device__ __forceinline__ void fill_vt(LAS unsigned char* lds, const LAS unsigned char* rv, int tid) {
    const int dv = tid & 255, jh = tid >> 8;
    unsigned short v[32];
#pragma unroll
    for (int jj = 0; jj < 32; ++jj) v[jj] = *(const LAS bf16*)(rv + (32 * jh + jj) * 512 + dv * 2);
    LAS unsigned char* row = lds + L_VT + dv * 128; const int f = (dv >> 1) & 7;
#pragma unroll
    for (int q = 0; q < 4; ++q) { v4u w; w.x = v[8 * q] | ((unsigned)v[8 * q + 1] << 16); w.y = v[8 * q + 2] | ((unsigned)v[8 * q + 3] << 16); w.z = v[8 * q + 4] | ((unsigned)v[8 * q + 5] << 16); w.w = v[8 * q + 6] | ((unsigned)v[8 * q + 7] << 16);
        *(LAS v4u*)(row + (((4 * jh + q) ^ f) * 16)) = w; }
}
}

__device__ __forceinline__ void ph_gla_a(const Params& p, LAS unsigned char* lds, int u0, int ustride, int tid_in, int wave) {
    using namespace gla;
    int tid = tid_in; asm volatile("" : "+v"(tid));
    const int lane = tid & 63, c = lane & 15, gq = lane >> 4;
    const bf16* GK = (const bf16*)(p.ws + WS_GK); bf16* ST = (bf16*)(p.ws + WS_ST); float* DEC = (float*)(p.ws + WS_DEC);
    RawK rk; RawV rv;
    CumIn ci;
    if (u0 < 2048) { const int bh = u0 >> 6, ch = u0 & 63; rk = load_raw_k(GK, tid, (bh >> 2) * SEQ + ch * 64, bh & 3); rv = load_raw_v(p, tid, (bh >> 2) * SEQ + ch * 64, bh & 3); ci = load_cum(p, tid, (bh >> 2) * SEQ + ch * 64, bh & 3); }
    for (int unit = u0; unit < 2048; unit += ustride) {
        const int bh = unit >> 6, ch = unit & 63, b = bh >> 2, h = bh & 3, t0 = b * SEQ + ch * 64;
        store_raw_k(lds + 0, tid, rk); store_raw_v(lds + 16384, tid, rv);
        float P[16], blast; chunk_cumsum(ci, lds, tid, P, blast);
        { const int dk = tid & 127, jq = tid >> 7;
          unsigned short kv[16];
#pragma unroll
          for (int jj = 0; jj < 16; ++jj) kv[jj] = *(const LAS bf16*)(lds + (16 * jq + jj) * 256 + dk * 2);
          unsigned pk[8];
#pragma unroll
          for (int q = 0; q < 8; ++q) pk[q] = pk2(bf2f(kv[2 * q]) * __expf(blast - P[2 * q]), bf2f(kv[2 * q + 1]) * __expf(blast - P[2 * q + 1]));
          LAS unsigned char* row = lds + L_KT + dk * 128; const int f = (dk >> 1) & 7;
          *(LAS v4u*)(row + (((2 * jq) ^ f) * 16)) = (v4u){pk[0], pk[1], pk[2], pk[3]}; *(LAS v4u*)(row + (((2 * jq + 1) ^ f) * 16)) = (v4u){pk[4], pk[5], pk[6], pk[7]};
          if (jq == 0) DEC[unit * 128 + dk] = __expf(blast); }
        fill_vt(lds, lds + 16384, tid);
        __syncthreads();
        { const int un = unit + ustride < 2048 ? unit + ustride : unit, bhn = un >> 6, chn = un & 63; rk = load_raw_k(GK, tid, (bhn >> 2) * SEQ + chn * 64, bhn & 3); rv = load_raw_v(p, tid, (bhn >> 2) * SEQ + chn * 64, bhn & 3); ci = load_cum(p, tid, (bhn >> 2) * SEQ + chn * 64, bhn & 3); }
        f4 acc[16];
        const int f = (c >> 1) & 7;
        bf16x8 aF[2];
#pragma unroll
        for (int ks = 0; ks < 2; ++ks) aF[ks] = *(const LAS bf16x8*)(lds + L_KT + (16 * wave + c) * 128 + (((4 * ks + gq) ^ f) * 16));
#pragma unroll
        for (int nt = 0; nt < 16; ++nt) { acc[nt] = (f4){0.f, 0.f, 0.f, 0.f};
#pragma unroll
            for (int ks = 0; ks < 2; ++ks) { const bf16x8 bF = *(const LAS bf16x8*)(lds + L_VT + (16 * nt + c) * 128 + (((4 * ks + gq) ^ f) * 16)); acc[nt] = __builtin_amdgcn_mfma_f32_16x16x32_bf16(aF[ks], bF, acc[nt], 0, 0, 0); } }
        char* dst = (char*)ST + (size_t)unit * (256 * 128 * 2) + (unsigned)((c * 128 + 16 * wave + 4 * gq) * 2);
#pragma unroll
        for (int nt = 0; nt < 16; ++nt) *(v2u*)(dst + nt * 16 * 256) = (v2u){pg8::cvt_pk_bf16(acc[nt][0], acc[nt][1]), pg8::cvt_pk_bf16(acc[nt][2], acc[nt][3])};
        __syncthreads();
    }
}
__device__ __forceinline__ void ph_gla_b(const Params& p, int gid, int gstride) {
    bf16* ST = (bf16*)(p.ws + WS_ST); const float* DEC = (const float*)(p.ws + WS_DEC);
    for (int e = gid; e < 32 * 4096; e += gstride) { const int bh = e >> 12, dv = (e >> 4) & 255, d8 = e & 15;
        float st[8];
#pragma unroll
        for (int i = 0; i < 8; ++i) st[i] = 0.f;
        char* base = (char*)ST + (size_t)bh * 64 * (256 * 128 * 2) + (unsigned)((dv * 128 + d8 * 8) * 2); const float* dbase = DEC + (size_t)bh * 64 * 128 + d8 * 8;
#pragma unroll 4
        for (int ch = 0; ch < 64; ++ch) { v4u* ptr = (v4u*)(base + (size_t)ch * (256 * 128 * 2)); const v4u w = *ptr; const f32x4 d0 = *(const f32x4*)(dbase + ch * 128), d1 = *(const f32x4*)(dbase + ch * 128 + 4);
            v4u o; o.x = pk2(st[0], st[1]); o.y = pk2(st[2], st[3]); o.z = pk2(st[4], st[5]); o.w = pk2(st[6], st[7]); *ptr = o;
            st[0] = st[0] * d0.x + bflo(w.x); st[1] = st[1] * d0.y + bfhi(w.x); st[2] = st[2] * d0.z + bflo(w.y); st[3] = st[3] * d0.w + bfhi(w.y);
            st[4] = st[4] * d1.x + bflo(w.z); st[5] = st[5] * d1.y + bfhi(w.z); st[6] = st[6] * d1.z + bflo(w.w); st[7] = st[7] * d1.w + bfhi(w.w); }
    }
}
__device__ __forceinline__ void ph_gla_c(const Params& p, LAS unsigned char* lds, int u0, int ustride, int tid_in, int wave) {
    using namespace gla;
    int tid = tid_in; asm volatile("" : "+v"(tid));
    const int lane = tid & 63, c = lane & 15, gq = lane >> 4, nt = wave & 3, half = wave >> 2;
    const bf16* GQ = (const bf16*)(p.ws + WS_GQ); const bf16* GK = (const bf16*)(p.ws + WS_GK); const bf16* GG = (const bf16*)(p.ws + WS_GG); const bf16* ST = (const bf16*)(p.ws + WS_ST);
    bf16* A2 = (bf16*)(p.ws + WS_A2); const float* gn = p.in[I_GLAG];
    const int koff0 = c * 256 + ((gq ^ c) * 16), voff0 = c * 128 + (((gq >> 1) ^ ((c >> 1) & 7)) * 16) + (gq & 1) * 8;
    CumIn ci; RawK rq, rk; RawV rv;
    if (u0 < 2048) { const int bh = u0 >> 6, ch = u0 & 63, t0 = (bh >> 2) * SEQ + ch * 64; rq = load_raw_k(GQ, tid, t0, bh & 3); rk = load_raw_k(GK, tid, t0, bh & 3); rv = load_raw_v(p, tid, t0, bh & 3); ci = load_cum(p, tid, t0, bh & 3); }
    for (int unit = u0; unit < 2048; unit += ustride) {
        const int bh = unit >> 6, ch = unit & 63, b = bh >> 2, h = bh & 3, t0 = b * SEQ + ch * 64;
        store_raw_k(lds + 0, tid, rq); store_raw_k(lds + 16384, tid, rk); store_raw_v(lds + 32768, tid, rv);
        float P[16], blast; chunk_cumsum(ci, lds, tid, P, blast);
        { const int dk = tid & 127, jq = tid >> 7;
#pragma unroll
          for (int jj = 0; jj < 16; ++jj) { const int j = 16 * jq + jj; const float qv = bf2f(*(const LAS bf16*)(lds + j * 256 + dk * 2)), kv = bf2f(*(const LAS bf16*)(lds + 16384 + j * 256 + dk * 2));
              const int off = j * 256 + (((dk >> 3) ^ (j & 15)) * 16) + (dk & 7) * 2;
              *(LAS bf16*)(lds + L_QT + off) = (bf16)f2bf(qv * __expf(P[jj])); *(LAS bf16*)(lds + L_KT + off) = (bf16)f2bf(kv * __expf(-P[jj])); } }
        fill_vt(lds, lds + 32768, tid);
        __syncthreads();
        { const char* src = (const char*)ST + (size_t)unit * (256 * 128 * 2);
#pragma unroll
          for (int i = 0; i < 8; ++i) { const int piece = 8 * wave + i, row = piece * 4 + (lane >> 4), chunk = (lane & 15) ^ (row & 15);
              __builtin_amdgcn_global_load_lds((const unsigned*)(src + (unsigned)(row * 256 + chunk * 16)), (LAS unsigned*)(lds + L_ST + piece * 1024), 16, 0, 0); } }
        v2u ggr[8];
        { const int tokg = t0 + 16 * nt + c;
#pragma unroll
          for (int mt = 0; mt < 8; ++mt) ggr[mt] = *(const v2u*)((const char*)GG + (unsigned)((tokg * 1024 + h * 256 + 128 * half + 16 * mt + 4 * gq) * 2)); }
        asm volatile("s_waitcnt vmcnt(0)" ::: "memory"); __syncthreads();
        { const int un = unit + ustride < 2048 ? unit + ustride : unit, bhn = un >> 6, chn = un & 63, tn = (bhn >> 2) * SEQ + chn * 64; rq = load_raw_k(GQ, tid, tn, bhn & 3); rk = load_raw_k(GK, tid, tn, bhn & 3); rv = load_raw_v(p, tid, tn, bhn & 3); ci = load_cum(p, tid, tn, bhn & 3); }
        bf16x8 qF[4];
#pragma unroll
        for (int ks = 0; ks < 4; ++ks) qF[ks] = *(const LAS bf16x8*)(lds + L_QT + nt * 4096 + (koff0 ^ (ks * 64)));
        f4 sT[4];
#pragma unroll
        for (int jt = 0; jt < 4; ++jt) { sT[jt] = (f4){0.f, 0.f, 0.f, 0.f};
            if (jt <= nt) {
#pragma unroll
                for (int ks = 0; ks < 4; ++ks) { const bf16x8 a = *(const LAS bf16x8*)(lds + L_KT + jt * 4096 + (koff0 ^ (ks * 64))); sT[jt] = __builtin_amdgcn_mfma_f32_16x16x32_bf16(a, qF[ks], sT[jt], 0, 0, 0); }
                if (jt == nt) {
#pragma unroll
                    for (int rg = 0; rg < 4; ++rg) if (4 * gq + rg > c) sT[jt][rg] = 0.f; } } }
        bf16x8 pb[2];
#pragma unroll
        for (int s = 0; s < 2; ++s) { v4u w; w.x = pg8::cvt_pk_bf16(sT[2 * s][0], sT[2 * s][1]); w.y = pg8::cvt_pk_bf16(sT[2 * s][2], sT[2 * s][3]); w.z = pg8::cvt_pk_bf16(sT[2 * s + 1][0], sT[2 * s + 1][1]); w.w = pg8::cvt_pk_bf16(sT[2 * s + 1][2], sT[2 * s + 1][3]); pb[s] = __builtin_bit_cast(bf16x8, w); }
        f4 o[8]; float ss = 0.f;
#pragma unroll
        for (int mt = 0; mt < 8; ++mt) { o[mt] = (f4){0.f, 0.f, 0.f, 0.f}; const int rb = 128 * half + 16 * mt;
#pragma unroll
            for (int ks = 0; ks < 4; ++ks) { const bf16x8 a = *(const LAS bf16x8*)(lds + L_ST + rb * 256 + (koff0 ^ (ks * 64))); o[mt] = __builtin_amdgcn_mfma_f32_16x16x32_bf16(a, qF[ks], o[mt], 0, 0, 0); }
#pragma unroll
            for (int s = 0; s < 2; ++s) if (2 * s <= nt) { const v2u lo = *(const LAS v2u*)(lds + L_VT + rb * 128 + (voff0 ^ (s * 64))), hi = *(const LAS v2u*)(lds + L_VT + rb * 128 + (voff0 ^ (s * 64 + 32)));
                o[mt] = __builtin_amdgcn_mfma_f32_16x16x32_bf16(__builtin_bit_cast(bf16x8, (v4u){lo.x, lo.y, hi.x, hi.y}), pb[s], o[mt], 0, 0, 0); }
            ss += (o[mt][0] * o[mt][0] + o[mt][1] * o[mt][1]) + (o[mt][2] * o[mt][2] + o[mt][3] * o[mt][3]); }
        ss = nsa::radd32(nsa::radd16(ss));
        LAS float* red = (LAS float*)(lds + L_RED);
        if (gq == 0) red[half * 64 + 16 * nt + c] = ss;
        __syncthreads();
        const float rstd = 1.f / sqrtf((red[16 * nt + c] + red[64 + 16 * nt + c]) * (1.f / 256.f) + RMS_EPS);
        const int tok = t0 + 16 * nt + c;
#pragma unroll
        for (int mt = 0; mt < 8; ++mt) { const int dv = 128 * half + 16 * mt + 4 * gq; const f32x4 g4 = *(const f32x4*)((const char*)gn + (unsigned)(dv * 4));
            const v2u gg = ggr[mt];
            const float z0 = bflo(gg.x), z1 = bfhi(gg.x), z2 = bflo(gg.y), z3 = bfhi(gg.y);
            v2u w; w.x = pg8::cvt_pk_bf16(o[mt][0] * rstd * g4.x * (z0 * __builtin_amdgcn_rcpf(1.f + __expf(-z0))), o[mt][1] * rstd * g4.y * (z1 * __builtin_amdgcn_rcpf(1.f + __expf(-z1))));
            w.y = pg8::cvt_pk_bf16(o[mt][2] * rstd * g4.z * (z2 * __builtin_amdgcn_rcpf(1.f + __expf(-z2))), o[mt][3] * rstd * g4.w * (z3 * __builtin_amdgcn_rcpf(1.f + __expf(-z3))));
            *(v2u*)((char*)A2 + (unsigned)((tok * DM + h * 256 + dv) * 2)) = w; }
        __syncthreads();
    }
}

constexpr size_t WS_LH = WS_DEC + (size_t)2048 * 128 * 4;
constexpr size_t WS_PEV = WS_LH + (size_t)2 * 4096 * 256 * 4;
static_assert(WS_PEV + 1024 <= WS_KCMP, "cmp scratch overlay");
struct CmpOrder {
    int c; const bf16 *kc, *vc, *wk, *wv;
    __device__ __forceinline__ bool next(int i, pg8::Unit& u) const { if (i > 0 || c >= 32) return false; u.pm = c & 15; u.pn = 0; u.kind = c >> 4; return true; }
    __device__ __forceinline__ const char* pa(const pg8::Gemm&, const pg8::Unit& u) const { return (const char*)(u.kind ? vc : kc) + (size_t)u.pm * ((size_t)256 * 2048 * 2); }
    __device__ __forceinline__ const char* pb(const pg8::Gemm&, const pg8::Unit& u) const { return (const char*)(u.kind ? wv : wk); }
    __device__ __forceinline__ void a_ready(const pg8::Unit&) const {}
    __device__ __forceinline__ void done(const pg8::Unit&) const {}
};
struct EpiLH {
    static constexpr bool PERM = false, AFTER_DRAIN = false;
    float* LH;
    __device__ __forceinline__ void operator()(const pg8::f32x4 (&acc)[2][2][4][2], const pg8::Unit& u, int wr, int wc, int fr, int fq) const {
        const int row0 = u.kind * 4096 + u.pm * 256 + wr * 64 + fr, col0 = wc * 32 + 4 * fq;
#pragma unroll
        for (int ai = 0; ai < 2; ++ai)
#pragma unroll
            for (int m = 0; m < 4; ++m) { float* rowp = LH + (size_t)(row0 + ai * 128 + m * 16) * 256 + col0;
#pragma unroll
                for (int bj = 0; bj < 2; ++bj)
#pragma unroll
                    for (int n = 0; n < 2; ++n) *(pg8::f32x4*)(rowp + bj * 128 + n * 16) = acc[ai][bj][m][n]; }
    }
};

constexpr size_t PROWS = (size_t)MAXTILES * 256;
constexpr size_t WS_W1Q = WS_W1T;
constexpr size_t WS_W2Q = WS_W1Q + (size_t)NE * 4096 * DM;
constexpr size_t WS_HN8 = WS_W2Q + (size_t)NE * DM * DFF;
constexpr size_t WS_AMAXP = WS_HN8 + (size_t)T * DM;
constexpr size_t WS_WSC1 = WS_AMAXP + PROWS * 64 * 4;
constexpr size_t WS_WSC2 = WS_WSC1 + (size_t)NE * 4096 * 4;
constexpr size_t WS_HSC = WS_WSC2 + (size_t)NE * 2048 * 4;
constexpr size_t WS_ROWSC = WS_HSC + (size_t)T * 4;
constexpr size_t WS_ASC = WS_ROWSC + PROWS * 4;
static_assert(WS_ASC + PROWS * 4 <= WS_XN, "int8 buffers fit in the retired bf16 expert-weight region");
constexpr size_t WS_ROWTOK = WS_CTL + 512 * 1024;
static_assert(PROWS * 2 <= 512 * 1024 && DM == 2048, "row table fits; gathered rows are 2048 bytes");
constexpr size_t WS_H16 = WS_XG;
static_assert((size_t)T * DM * 2 <= PROWS * DM, "h fits below ACT8");
constexpr size_t WS_XG8 = WS_XG;
constexpr size_t WS_ACT8 = WS_XG + PROWS * DM;
constexpr size_t WS_Y = WS_ACT;
static_assert(WS_ACT8 + PROWS * DM <= WS_ACT, "int8 row buffers fit in the retired gathered-row region");

__device__ __forceinline__ unsigned q8x4(float a, float b, float c, float d) {
    const float M = 12582912.f; const unsigned ua = __builtin_bit_cast(unsigned, a + M), ub = __builtin_bit_cast(unsigned, b + M), uc = __builtin_bit_cast(unsigned, c + M), ud = __builtin_bit_cast(unsigned, d + M);
    return __builtin_amdgcn_perm(ub, ua, 0x0c0c0400u) | (__builtin_amdgcn_perm(ud, uc, 0x0c0c0400u) << 16); }
__device__ __forceinline__ unsigned rq4(unsigned w, float f) { const int s = (int)w;
    const float b0 = (float)((s << 24) >> 24), b1 = (float)((s << 16) >> 24), b2 = (float)((s << 8) >> 24), b3 = (float)(s >> 24); return q8x4(b0 * f, b1 * f, b2 * f, b3 * f); }
__device__ __forceinline__ float clamp127(float v) { return __builtin_amdgcn_fmed3f(v, -127.f, 127.f); }
__device__ __forceinline__ unsigned q8x4c(float a, float b, float c, float d) { return q8x4(clamp127(a), clamp127(b), clamp127(c), clamp127(d)); }

constexpr size_t WS_WINQ = WS_WINT;
constexpr size_t WS_WISC = WS_WINT + (size_t)NPT * 256 * DM;
constexpr size_t WS_XN8 = WS_XN;
constexpr size_t WS_XSC = WS_XN + (size_t)T * DM;
constexpr size_t WS_PMAX = WS_HN;
constexpr size_t WS_PMAXI = WS_PMAX + (size_t)64 * 8 * 4096 * 4;

constexpr int NSLAB_E = NE * 192, NSLAB = NSLAB_E + 178;
struct SlabSrc { const float* W; int N; bool ok; };
__device__ __forceinline__ SlabSrc slab_src(const Params& p, int sl, int r0, int n4) {
    SlabSrc s;
    if (sl < NSLAB_E) { const int e = sl / 192, r = sl % 192; const bool isw2 = r >= 128; const int nb = isw2 ? r - 128 : r; s.N = isw2 ? 2048 : 4096;
        s.W = (isw2 ? p.in[I_W2] + (size_t)e * DFF * DM : p.in[I_W1] + (size_t)e * DM * 4096) + (size_t)r0 * s.N + nb * 32 + 4 * n4; s.ok = true; }
    else { const int nb = sl - NSLAB_E; s.N = 5672; s.ok = nb * 32 + 4 * n4 < 5672; s.W = p.in[I_WIN] + (size_t)r0 * 5672 + (s.ok ? nb * 32 + 4 * n4 : 0); }
    return s;
}
__device__ __forceinline__ void p0_slab_quant(const Params& p, LAS unsigned char* lds, int bid, int G, int tid) {
    constexpr int RS = 4104;
    LAS unsigned char* TT = lds; LAS float* part = (LAS float*)(lds + 32 * RS); LAS float* inv = part + 64 * 32; LAS int* drow = (LAS int*)(inv + 32);
    signed char* W1Q = (signed char*)(p.ws + WS_W1Q); signed char* W2Q = (signed char*)(p.ws + WS_W2Q); signed char* WIQ = (signed char*)(p.ws + WS_WINQ);
    float* WSC1 = (float*)(p.ws + WS_WSC1); float* WSC2 = (float*)(p.ws + WS_WSC2); float* WISC = (float*)(p.ws + WS_WISC);
    const int n4 = tid & 7, r0 = tid >> 3;
    f32x4 va[8], vb[8];
#define SLAB_ISSUE(dst, sl, j) do { if ((sl) < NSLAB) { const SlabSrc ss_ = slab_src(p, (sl), 2 * r0, n4); _Pragma("unroll") for (int u = 0; u < 8; ++u) dst[u] = __builtin_nontemporal_load((const f32x4*)(ss_.W + (size_t)(128 * (4 * (j) + (u >> 1)) + (u & 1)) * ss_.N)); } } while (0)
#define SLAB_USE(src, j) do { _Pragma("unroll") for (int u2 = 0; u2 < 4; ++u2) { const f32x4 xa = src[2 * u2], xb = src[2 * u2 + 1]; const int k = 2 * r0 + 128 * (4 * (j) + u2);        \
            const unsigned w0 = cvt2bf(xa.x, xb.x), w1 = cvt2bf(xa.y, xb.y), w2 = cvt2bf(xa.z, xb.z), w3 = cvt2bf(xa.w, xb.w);        \
            mx0 = __builtin_elementwise_max(mx0, __builtin_bit_cast(u16x2, w0 & 0x7fff7fffu)); mx1 = __builtin_elementwise_max(mx1, __builtin_bit_cast(u16x2, w1 & 0x7fff7fffu)); \
            mx2 = __builtin_elementwise_max(mx2, __builtin_bit_cast(u16x2, w2 & 0x7fff7fffu)); mx3 = __builtin_elementwise_max(mx3, __builtin_bit_cast(u16x2, w3 & 0x7fff7fffu)); \
            LAS unsigned char* d = TT + (4 * n4) * RS + k * 2; \
            *(LAS unsigned*)d = w0; *(LAS unsigned*)(d + RS) = w1; *(LAS unsigned*)(d + 2 * RS) = w2; *(LAS unsigned*)(d + 3 * RS) = w3; } } while (0)
    SLAB_ISSUE(va, bid, 0); SLAB_ISSUE(vb, bid, 1);
    for (int slab = bid; slab < NSLAB; slab += G) {
        u16x2 mx0 = (u16x2){0, 0}, mx1 = (u16x2){0, 0}, mx2 = (u16x2){0, 0}, mx3 = (u16x2){0, 0};
        SLAB_USE(va, 0); SLAB_ISSUE(va, slab, 2);
        SLAB_USE(vb, 1); SLAB_ISSUE(vb, slab, 3);
        SLAB_USE(va, 2); SLAB_ISSUE(va, slab + G, 0);
        SLAB_USE(vb, 3); SLAB_ISSUE(vb, slab + G, 1);
        { u16x2 t0, t1; { const unsigned m0 = __builtin_bit_cast(unsigned, mx0), m1 = __builtin_bit_cast(unsigned, mx1), m2 = __builtin_bit_cast(unsigned, mx2), m3 = __builtin_bit_cast(unsigned, mx3);
            t0 = __builtin_elementwise_max(__builtin_bit_cast(u16x2, __builtin_amdgcn_perm(m1, m0, 0x05040100u)), __builtin_bit_cast(u16x2, __builtin_amdgcn_perm(m1, m0, 0x07060302u)));
            t1 = __builtin_elementwise_max(__builtin_bit_cast(u16x2, __builtin_amdgcn_perm(m3, m2, 0x05040100u)), __builtin_bit_cast(u16x2, __builtin_amdgcn_perm(m3, m2, 0x07060302u))); }
#pragma unroll
          for (int o = 8; o < 64; o <<= 1) { t0 = __builtin_elementwise_max(t0, __builtin_bit_cast(u16x2, __shfl_xor(__builtin_bit_cast(int, t0), o))); t1 = __builtin_elementwise_max(t1, __builtin_bit_cast(u16x2, __shfl_xor(__builtin_bit_cast(int, t1), o))); }
          const unsigned a0 = __builtin_bit_cast(unsigned, t0), a1 = __builtin_bit_cast(unsigned, t1);
          if ((tid & 63) < 8) *(LAS f32x4*)(part + (tid >> 6) * 32 + 4 * n4) = (f32x4){bflo(a0), bfhi(a0), bflo(a1), bfhi(a1)}; }
        __syncthreads();
        if (tid < 32) { float m = 0.f;
#pragma unroll
            for (int q = 0; q < 8; ++q) m = fmaxf(m, part[q * 32 + tid]);
            const float sc = m > 0.f ? m * (1.f / 127.f) : 1.f; inv[tid] = 1.f / sc;
            if (slab < NSLAB_E) { const int e = slab / 192, r = slab % 192; const bool isw2 = r >= 128; const int n = (isw2 ? r - 128 : r) * 32 + tid;
                if (isw2) { drow[tid] = e * 2048 + n; WSC2[e * 2048 + n] = sc; }
                else { const int j2 = n & 2047, row = (j2 >> 7) * 256 + (n >= 2048 ? 128 : 0) + (j2 & 127); drow[tid] = e * 4096 + row; WSC1[e * 4096 + row] = sc; } }
            else { const int n = (slab - NSLAB_E) * 32 + tid; if (n < 5672) { float qsc; const int row = win_row(n, qsc); drow[tid] = row; WISC[row] = sc * qsc; } else drow[tid] = -1; } }
        __syncthreads();
        { const int kc = tid & 7, n = (tid >> 3) & 31, hf = tid >> 8; const float iv = inv[n]; const int dr = drow[n];
          signed char* dst = (slab < NSLAB_E ? ((slab % 192) >= 128 ? W2Q : W1Q) : WIQ) + (size_t)(dr < 0 ? 0 : dr) * 2048; const LAS unsigned char* src = TT + n * RS;
          if (dr >= 0) {
#pragma unroll
          for (int m8 = 0; m8 < 8; ++m8) { const int k0 = 16 * (kc + 8 * (hf + 2 * m8)); const LAS v2u* sp = (const LAS v2u*)(src + k0 * 2); const v2u a = sp[0], b = sp[1], c = sp[2], d = sp[3]; v4u o;
              o.x = q8x4(bflo(a.x) * iv, bfhi(a.x) * iv, bflo(a.y) * iv, bfhi(a.y) * iv); o.y = q8x4(bflo(b.x) * iv, bfhi(b.x) * iv, bflo(b.y) * iv, bfhi(b.y) * iv);
              o.z = q8x4(bflo(c.x) * iv, bfhi(c.x) * iv, bflo(c.y) * iv, bfhi(c.y) * iv); o.w = q8x4(bflo(d.x) * iv, bfhi(d.x) * iv, bflo(d.y) * iv, bfhi(d.y) * iv);
              *(v4u*)(dst + k0) = o; } } }
        __syncthreads();
    }
#undef SLAB_ISSUE
#undef SLAB_USE
}
struct EpiSwigluI8 {
    static constexpr bool PERM = true, AFTER_DRAIN = false;
    const float* b1; const float* rowsc; const float* wsc1; signed char* act8; float* amaxp;
    __device__ __forceinline__ void operator()(const pg8::f32x4 (&acc)[2][2][4][2], const pg8::Unit& u, int wr, int wc, int fr, int fq) const {
        typedef float f2 __attribute__((ext_vector_type(2)));
        const int e = u.kind; const int cin = wc * 32 + 8 * fq; const int col = u.pn * 128 + cin; const int row0 = u.pm * 256 + wr * 64 + fr;
        const float* bg = b1 + (size_t)e * 4096 + col; const float* bl = bg + 2048; const float* sg = wsc1 + (size_t)e * 4096 + u.pn * 256 + cin; const float* sl = sg + 128;
        f2 gb[4], lb[4], gs[4], ls[4];
#pragma unroll
        for (int k = 0; k < 4; ++k) { gb[k] = *(const f2*)(bg + 2 * k); lb[k] = *(const f2*)(bl + 2 * k); gs[k] = *(const f2*)(sg + 2 * k); ls[k] = *(const f2*)(sl + 2 * k); }
#pragma unroll
        for (int ai = 0; ai < 2; ++ai)
#pragma unroll
            for (int m = 0; m < 4; ++m) { const int r = row0 + ai * 128 + m * 16; const float rs = rowsc[r]; const f2 rs2 = (f2){rs, rs}; f2 o[4]; float mx = 0.f;
#pragma unroll
                for (int k = 0; k < 4; ++k) { const int n = k >> 1, j = (k & 1) * 2;
                    const f2 ag = (f2){(float)__float_as_int(acc[ai][0][m][n][j]), (float)__float_as_int(acc[ai][0][m][n][j + 1])}, al = (f2){(float)__float_as_int(acc[ai][1][m][n][j]), (float)__float_as_int(acc[ai][1][m][n][j + 1])};
                    f2 gl = __builtin_elementwise_fma(ag, rs2 * gs[k], gb[k]), li = __builtin_elementwise_fma(al, rs2 * ls[k], lb[k]);
                    gl.x = fminf(gl.x, 7.f); gl.y = fminf(gl.y, 7.f); li.x = __builtin_amdgcn_fmed3f(li.x, -7.f, 7.f); li.y = __builtin_amdgcn_fmed3f(li.y, -7.f, 7.f);
                    const f2 ea = gl * (f2){-2.4554669595930156f, -2.4554669595930156f};
                    const f2 den = (f2){__builtin_amdgcn_exp2f(ea.x), __builtin_amdgcn_exp2f(ea.y)} + (f2){1.f, 1.f};
                    const f2 v = (gl * (f2){__builtin_amdgcn_rcpf(den.x), __builtin_amdgcn_rcpf(den.y)}) * (li + (f2){1.f, 1.f});
                    o[k] = v; mx = fmaxf(mx, fmaxf(fabsf(v.x), fabsf(v.y))); }
                mx = nsa::rmax32(nsa::rmax16(mx));
                if (fq == 0) amaxp[(size_t)r * 64 + u.pn * 4 + wc] = mx;
                const float iq = mx > 0.f ? 127.f * __builtin_amdgcn_rcpf(mx) : 0.f; const f2 iq2 = (f2){iq, iq}; v2u w;
                { const f2 q0 = o[0] * iq2, q1 = o[1] * iq2, q2 = o[2] * iq2, q3 = o[3] * iq2; w.x = q8x4(q0.x, q0.y, q1.x, q1.y); w.y = q8x4(q2.x, q2.y, q3.x, q3.y); }
                *(v2u*)(act8 + (size_t)r * DFF + col) = w; }
    }
};
__device__ __forceinline__ void ph_actq(const Params& p, int gw, int NGW, int lane) {
    const int nrows = ((const int*)(p.ws + WS_META))[0] * 256; const float* amaxp = (const float*)(p.ws + WS_AMAXP);
    signed char* A8 = (signed char*)(p.ws + WS_ACT8); float* ASC = (float*)(p.ws + WS_ASC);
    for (int rb = gw; rb < nrows; rb += 2 * NGW) {
        const int r0 = rb, r1 = rb + NGW; const bool h1 = r1 < nrows; const int r1c = h1 ? r1 : r0;
        const float g0 = amaxp[(size_t)r0 * 64 + lane], g1 = amaxp[(size_t)r1c * 64 + lane];
        v4u* s0 = (v4u*)(A8 + (size_t)r0 * DFF) + lane * 2; v4u* s1 = (v4u*)(A8 + (size_t)r1c * DFF) + lane * 2;
        const v4u a00 = s0[0], a01 = s0[1], a10 = s1[0], a11 = s1[1];
        const float m0 = wave_max(g0), m1 = wave_max(g1);
        { const float f = m0 > 0.f ? g0 * __builtin_amdgcn_rcpf(m0) : 0.f;
          v4u o0, o1; o0.x = rq4(a00.x, f); o0.y = rq4(a00.y, f); o0.z = rq4(a00.z, f); o0.w = rq4(a00.w, f); o1.x = rq4(a01.x, f); o1.y = rq4(a01.y, f); o1.z = rq4(a01.z, f); o1.w = rq4(a01.w, f);
          s0[0] = o0; s0[1] = o1; if (lane == 0) ASC[r0] = m0 > 0.f ? m0 * (1.f / 127.f) : 1.f; }
        if (h1) { const float f = m1 > 0.f ? g1 * __builtin_amdgcn_rcpf(m1) : 0.f;
          v4u o0, o1; o0.x = rq4(a10.x, f); o0.y = rq4(a10.y, f); o0.z = rq4(a10.z, f); o0.w = rq4(a10.w, f); o1.x = rq4(a11.x, f); o1.y = rq4(a11.y, f); o1.z = rq4(a11.z, f); o1.w = rq4(a11.w, f);
          s1[0] = o0; s1[1] = o1; if (lane == 0) ASC[r1] = m1 > 0.f ? m1 * (1.f / 127.f) : 1.f; } }
}
struct EpiDownI8 {
    static constexpr bool PERM = true, AFTER_DRAIN = false;
    const float* b2; const float* roww; const float* asc; const float* wsc2; bf16* y;
    __device__ __forceinline__ void operator()(const pg8::f32x4 (&acc)[2][2][4][2], const pg8::Unit& u, int wr, int wc, int fr, int fq) const {
        const int e = u.kind; const int col0 = u.pn * 256 + wc * 32 + 8 * fq; const int row0 = u.pm * 256 + wr * 64 + fr;
        typedef float f2 __attribute__((ext_vector_type(2)));
        f2 bv[2][4], sv[2][4];
#pragma unroll
        for (int bj = 0; bj < 2; ++bj)
#pragma unroll
            for (int k = 0; k < 4; ++k) { bv[bj][k] = *(const f2*)(b2 + (size_t)e * DM + col0 + bj * 128 + 2 * k); sv[bj][k] = *(const f2*)(wsc2 + (size_t)e * DM + col0 + bj * 128 + 2 * k); }
#pragma unroll
        for (int ai = 0; ai < 2; ++ai)
#pragma unroll
            for (int m = 0; m < 4; ++m) { const int r = row0 + ai * 128 + m * 16; const float g = roww[r], as = asc[r]; const f2 g2 = (f2){g, g}, as2 = (f2){as, as};
#pragma unroll
                for (int bj = 0; bj < 2; ++bj) { f2 o[4];
#pragma unroll
                    for (int k = 0; k < 4; ++k) { const int n = k >> 1, j = (k & 1) * 2; const f2 a2 = (f2){(float)__float_as_int(acc[ai][bj][m][n][j]), (float)__float_as_int(acc[ai][bj][m][n][j + 1])};
                        o[k] = __builtin_elementwise_fma(a2, as2 * sv[bj][k], bv[bj][k]) * g2; }
                    pg8::u32x4 w; w.x = pg8::cvt_pk_bf16(o[0].x, o[0].y); w.y = pg8::cvt_pk_bf16(o[1].x, o[1].y); w.z = pg8::cvt_pk_bf16(o[2].x, o[2].y); w.w = pg8::cvt_pk_bf16(o[3].x, o[3].y);
                    *(pg8::u32x4*)(y + (size_t)r * DM + col0 + bj * 128) = w; } }
    }
};

struct EpiProjI8 {
    static constexpr bool PERM = true, AFTER_DRAIN = false;
    unsigned char* ws;
    __device__ __forceinline__ void operator()(const pg8::f32x4 (&acc)[2][2][4][2], const pg8::Unit& u, int wr, int wc, int fr, int fq) const {
        const int cw = wc * 32 + 8 * fq; const float* XSC = (const float*)(ws + WS_XSC); const float* WISC = (const float*)(ws + WS_WISC);
        if (u.kind == 0) {
            const int tn = u.pn; bf16* base; size_t bjs = 128; int ld = 0; bool headmajor = false; bool small = false;
            if (tn < 2) { base = (bf16*)(ws + WS_GQ) + tn * 256; ld = 512; }
            else if (tn < 4) { base = (bf16*)(ws + WS_GK) + (tn - 2) * 256; ld = 512; }
            else if (tn < 8) { base = (bf16*)(ws + WS_GV) + (tn - 4) * 256; ld = 1024; }
            else if (tn < 12) { base = (bf16*)(ws + WS_GG) + (tn - 8) * 256; ld = 1024; }
            else if (tn < 16) { base = (bf16*)(ws + WS_NQ) + (tn - 12) * 256; ld = 1024; }
            else if (tn < 20) { base = (bf16*)(ws + (tn == 16 ? WS_KC : tn == 17 ? WS_VC : tn == 18 ? WS_KS : WS_KW)); headmajor = true; bjs = (size_t)SEQ * 128; }
            else { base = (bf16*)(ws + WS_SM); ld = 64; small = true; }
            if (small && wc >= 2) return;
            typedef float f2 __attribute__((ext_vector_type(2)));
            f2 cs[2][4];
#pragma unroll
            for (int bj = 0; bj < 2; ++bj)
#pragma unroll
                for (int k = 0; k < 4; ++k) cs[bj][k] = *(const f2*)(WISC + tn * 256 + bj * 128 + cw + 2 * k);
#pragma unroll
            for (int ai = 0; ai < 2; ++ai)
#pragma unroll
                for (int m = 0; m < 4; ++m) { const int r = u.pm * 256 + ai * 128 + wr * 64 + m * 16 + fr; const float rs = XSC[r];
                    const size_t rterm = headmajor ? ((size_t)(r >> 12) * 2 * SEQ + (r & (SEQ - 1))) * 128 : (size_t)r * ld;
#pragma unroll
                    for (int bj = 0; bj < 2; ++bj) { if (small && bj) continue; f2 o[4]; const f2 rs2 = (f2){rs, rs};
#pragma unroll
                        for (int k = 0; k < 4; ++k) { const int n = k >> 1, j = (k & 1) * 2; o[k] = (f2){(float)__float_as_int(acc[ai][bj][m][n][j]), (float)__float_as_int(acc[ai][bj][m][n][j + 1])} * (rs2 * cs[bj][k]); }
                        pg8::u32x4 w; w.x = pg8::cvt_pk_bf16(o[0].x, o[0].y); w.y = pg8::cvt_pk_bf16(o[1].x, o[1].y); w.z = pg8::cvt_pk_bf16(o[2].x, o[2].y); w.w = pg8::cvt_pk_bf16(o[3].x, o[3].y);
                        *(pg8::u32x4*)(base + rterm + bj * bjs + cw) = w; } }
        } else {
            bf16* base = (bf16*)(ws + (u.pn == 21 ? WS_VST : WS_VWT));
#pragma unroll
            for (int ai = 0; ai < 2; ++ai)
#pragma unroll
                for (int m = 0; m < 4; ++m) { const int dh = wr * 64 + m * 16 + fr; const float ws_ = WISC[u.pn * 256 + ai * 128 + dh];
#pragma unroll
                    for (int bj = 0; bj < 2; ++bj) { const int tok = u.pm * 256 + bj * 128 + cw; const int b = tok >> 12, s = tok & (SEQ - 1); float o[8];
                        const pg8::f32x4 x0 = *(const pg8::f32x4*)(XSC + tok), x1 = *(const pg8::f32x4*)(XSC + tok + 4);
#pragma unroll
                        for (int j = 0; j < 4; ++j) { o[j] = (float)__float_as_int(acc[ai][bj][m][0][j]) * (ws_ * x0[j]); o[4 + j] = (float)__float_as_int(acc[ai][bj][m][1][j]) * (ws_ * x1[j]); }
                        pg8::u32x4 w; w.x = pg8::cvt_pk_bf16(o[0], o[1]); w.y = pg8::cvt_pk_bf16(o[2], o[3]); w.z = pg8::cvt_pk_bf16(o[4], o[5]); w.w = pg8::cvt_pk_bf16(o[6], o[7]);
                        *(pg8::u32x4*)(base + ((size_t)(b * 2 + ai) * 128 + dh) * SEQ + s) = w; } }
        }
    }
};

__device__ __forceinline__ void r1_router(const Params& p, LAS unsigned char* lds, int vb, int tid, int wave, int lane) {
    LAS float* rowbuf = (LAS float*)lds;
    LAS float* part = (LAS float*)(lds + 65536);
    LAS int* tk = (LAS int*)(lds + 81920 + wave * 1024);
    LAS int* cntw = (LAS int*)(lds + 90112);
    const bf16* h = (const bf16*)(p.ws + WS_H16); const float* gf = p.in[I_NFFN]; const float* rw = p.in[I_RW]; const float* rb = p.in[I_RB];
    signed char* HN8 = (signed char*)(p.ws + WS_HN8);
    const int e = lane & 31, eg = tid & 31, dg = tid >> 5; int mycount = 0;
    float rwr[128];
#pragma unroll
    for (int c4 = 0; c4 < 4; ++c4) { unsigned o = (unsigned)((((dg * 128 + c4 * 32) * 32) + eg) * 4); asm volatile("" : "+v"(o));
#pragma unroll
        for (int i = 0; i < 32; ++i) rwr[c4 * 32 + i] = *(const float*)((const char*)rw + o + i * 128); }
    v4u hw[4];
    { const v4u* xr = (const v4u*)(h + (size_t)(vb * TPV + wave) * DM) + lane;
#pragma unroll
      for (int q = 0; q < 4; ++q) hw[q] = xr[64 * q]; }
    for (int grp = 0; grp < 16; ++grp) { const int t = vb * TPV + grp * 8 + wave;
        { float s = 0.f;
#pragma unroll
          for (int q = 0; q < 4; ++q) { const float a0 = bflo(hw[q].x), a1 = bfhi(hw[q].x), a2 = bflo(hw[q].y), a3 = bfhi(hw[q].y), a4 = bflo(hw[q].z), a5 = bfhi(hw[q].z), a6 = bflo(hw[q].w), a7 = bfhi(hw[q].w);
              s += ((a0 * a0 + a1 * a1) + (a2 * a2 + a3 * a3)) + ((a4 * a4 + a5 * a5) + (a6 * a6 + a7 * a7)); }
          const float rstd = 1.f / sqrtf(wave_sum(s) * (1.f / DM) + RMS_EPS);
          float mxr = 0.f; LAS f32x4* hrow = (LAS f32x4*)(rowbuf + wave * 2048);
#pragma unroll
          for (int j = 0; j < 8; ++j) { const int cj = 2 * lane + 128 * (j >> 1) + (j & 1); const f32x4 g4 = ((const f32x4*)gf)[cj]; const unsigned wa = (j & 1) ? hw[j >> 1].z : hw[j >> 1].x, wb = (j & 1) ? hw[j >> 1].w : hw[j >> 1].y;
              f32x4 y; y.x = bflo(wa) * rstd * g4.x; y.y = bfhi(wa) * rstd * g4.y; y.z = bflo(wb) * rstd * g4.z; y.w = bfhi(wb) * rstd * g4.w;
              hrow[cj] = y; mxr = fmaxf(mxr, fmaxf(fmaxf(fabsf(y.x), fabsf(y.y)), fmaxf(fabsf(y.z), fabsf(y.w)))); }
          mxr = wave_max(mxr); const float qs = mxr > 0.f ? mxr * (1.f / 127.f) : 1.f, qi = 1.f / qs;
          v2u* o8 = (v2u*)(HN8 + (size_t)t * DM) + lane;
#pragma unroll
          for (int q = 0; q < 4; ++q) { const f32x4 ya = hrow[2 * lane + 128 * q], yb = hrow[2 * lane + 128 * q + 1]; v2u o;
              o.x = q8x4(ya.x * qi, ya.y * qi, ya.z * qi, ya.w * qi); o.y = q8x4(yb.x * qi, yb.y * qi, yb.z * qi, yb.w * qi); o8[64 * q] = o; }
          if (lane == 0) ((float*)(p.ws + WS_HSC))[t] = qs; }
        __syncthreads();
        { const int tn = vb * TPV + (grp < 15 ? grp + 1 : grp) * 8 + wave; const v4u* xr = (const v4u*)(h + (size_t)tn * DM) + lane;
#pragma unroll
          for (int q = 0; q < 4; ++q) hw[q] = xr[64 * q]; }
        { float acc[8];
#pragma unroll
          for (int tt = 0; tt < 8; ++tt) acc[tt] = 0.f;
#pragma unroll
          for (int i4 = 0; i4 < 32; ++i4) { f32x4 xv[8];
#pragma unroll
              for (int tt = 0; tt < 8; ++tt) xv[tt] = *(const LAS f32x4*)(rowbuf + tt * 2048 + dg * 128 + 4 * i4);
#pragma unroll
              for (int tt = 0; tt < 8; ++tt) acc[tt] += xv[tt].x * rwr[4 * i4] + xv[tt].y * rwr[4 * i4 + 1] + xv[tt].z * rwr[4 * i4 + 2] + xv[tt].w * rwr[4 * i4 + 3];
              if (i4 & 1) asm volatile("" ::: "memory"); }
#pragma unroll
          for (int tt = 0; tt < 8; ++tt) part[(dg * 8 + tt) * 32 + eg] = acc[tt]; }
        __syncthreads();
        { float a = rb[e];
#pragma unroll
          for (int q = 0; q < 16; ++q) a += part[(q * 8 + wave) * 32 + e];
          int rank = 0;
#pragma unroll
          for (int mm = 0; mm < 32; ++mm) { const float lm = __shfl(a, mm); rank += (lm > a || (lm == a && mm < e)) ? 1 : 0; }
          const float mx = wave_max(a); const bool sel = rank < 4;
          const float ex = (sel && lane < 32) ? __expf(a - mx) : 0.f; const float sum = wave_sum(ex);
          if (sel && lane < 32) { LAS int* q = tk + (grp * 4 + rank) * 4; q[0] = e; q[1] = mycount; q[2] = __builtin_bit_cast(int, ex / sum); ++mycount; } }
        __syncthreads();
    }
    int ln; asm volatile("v_mbcnt_lo_u32_b32 %0, -1, 0\n\tv_mbcnt_hi_u32_b32 %0, -1, %0" : "=v"(ln));
    if (ln < 32) cntw[wave * 32 + ln] = mycount;
    __syncthreads();
    if (wave == 0 && ln < 32) { int tot = 0; for (int w = 0; w < 8; ++w) tot += cntw[w * 32 + ln]; ((int*)(p.ws + WS_CNT))[vb * 32 + ln] = tot; }
    { const int i = ln >> 2, k = ln & 3; const LAS int* q = tk + (i * 4 + k) * 4; const int ee = q[0]; int base = 0; for (int w = 0; w < wave; ++w) base += cntw[w * 32 + ee];
      const int t = vb * TPV + i * 8 + wave;
      ((int*)(p.ws + WS_EIDX))[t * 4 + k] = ee; ((int*)(p.ws + WS_LRNK))[t * 4 + k] = base + q[1]; ((int*)(p.ws + WS_GATE))[t * 4 + k] = q[2]; }
    __syncthreads();
}
__device__ __forceinline__ void r2_gather(const Params& p, LAS unsigned char* lds, int vb, bool write_meta, int tid, int wave, int lane) {
    LAS int* part_tot = (LAS int*)lds;
    LAS int* part_base = part_tot + 512;
    LAS int* pbase = part_base + 512;
    const int* CNT = (const int*)(p.ws + WS_CNT);
    { const int e = tid & 31, part = tid >> 5; int tot = 0, bs = 0;
      for (int v = part * 16; v < part * 16 + 16; ++v) { const int c = CNT[v * 32 + e]; tot += c; if (v < vb) bs += c; }
      part_tot[part * 32 + e] = tot; part_base[part * 32 + e] = bs; }
    __syncthreads();
    if (tid == 0) { int ps = 0; int* meta = (int*)(p.ws + WS_META); int nt = 0;
        for (int e = 0; e < 32; ++e) { int tot = 0, bs = 0; for (int q = 0; q < 16; ++q) { tot += part_tot[q * 32 + e]; bs += part_base[q * 32 + e]; }
            pbase[e] = ps + bs; const int ntile = (tot + 255) >> 8;
            if (write_meta) for (int q = 0; q < ntile; ++q) meta[64 + nt + q] = e;
            nt += ntile; ps += ntile * 256; }
        if (write_meta) meta[0] = nt; }
    __syncthreads();
    const float* HSC = (const float*)(p.ws + WS_HSC); float* ROWSC = (float*)(p.ws + WS_ROWSC);
    const int* EIDX = (const int*)(p.ws + WS_EIDX); const int* LRNK = (const int*)(p.ws + WS_LRNK); const float* GATE = (const float*)(p.ws + WS_GATE);
    int* POS = (int*)(p.ws + WS_POS); float* ROWW = (float*)(p.ws + WS_ROWW);
    unsigned short* RT = (unsigned short*)(p.ws + WS_ROWTOK);
    { const int t = vb * TPV + (tid >> 2), k = tid & 3;
      const int pos = pbase[EIDX[t * 4 + k]] + LRNK[t * 4 + k];
      POS[t * 4 + k] = pos; ROWW[pos] = GATE[t * 4 + k]; ROWSC[pos] = HSC[t]; RT[(pos & ~255) + (pos & 63) * 4 + ((pos >> 6) & 3)] = (unsigned short)t; }
    __syncthreads();
}
__device__ __forceinline__ void pf_final(const Params& p, int gw, int NGW, int lane) {
    const bf16* Y = (const bf16*)(p.ws + WS_Y); const int* POS = (const int*)(p.ws + WS_POS); const float* gfin = p.in[I_NFIN]; const bf16* H = (const bf16*)(p.ws + WS_H16);
    for (int t = gw; t < T; t += NGW) {
        f32x4 v[8]; const v4u* hr = (const v4u*)(H + (size_t)t * DM) + lane;
#pragma unroll
        for (int q = 0; q < 4; ++q) { const v4u w = hr[64 * q]; v[2 * q] = (f32x4){bflo(w.x), bfhi(w.x), bflo(w.y), bfhi(w.y)}; v[2 * q + 1] = (f32x4){bflo(w.z), bfhi(w.z), bflo(w.w), bfhi(w.w)}; }
#pragma unroll
        for (int k = 0; k < 4; ++k) { const int pos = POS[t * 4 + k]; const v4u* yr = (const v4u*)(Y + (size_t)pos * DM) + lane;
#pragma unroll
            for (int q = 0; q < 4; ++q) { const v4u w = yr[64 * q]; v[2 * q].x += bflo(w.x); v[2 * q].y += bfhi(w.x); v[2 * q].z += bflo(w.y); v[2 * q].w += bfhi(w.y);
                v[2 * q + 1].x += bflo(w.z); v[2 * q + 1].y += bfhi(w.z); v[2 * q + 1].z += bflo(w.w); v[2 * q + 1].w += bfhi(w.w); } }
        float s = 0.f;
#pragma unroll
        for (int j = 0; j < 8; ++j) s += (v[j].x * v[j].x + v[j].y * v[j].y) + (v[j].z * v[j].z + v[j].w * v[j].w);
        const float rstd = 1.f / sqrtf(wave_sum(s) * (1.f / DM) + RMS_EPS); f32x4* xr = (f32x4*)(p.out + (size_t)t * DM);
#pragma unroll
        for (int j = 0; j < 8; ++j) { const int cj = 2 * lane + 128 * (j >> 1) + (j & 1); const f32x4 g4 = ((const f32x4*)gfin)[cj]; f32x4 o; o.x = v[j].x * rstd * g4.x; o.y = v[j].y * rstd * g4.y; o.z = v[j].z * rstd * g4.z; o.w = v[j].w * rstd * g4.w; xr[cj] = o; }
    }
}


constexpr int LDS_BYTES = 159744;
constexpr int MISC_OFF = LDS_BYTES - 256;  static_assert(nsa::LDS_END <= MISC_OFF && gla::L_END <= MISC_OFF, "LDS map");
constexpr int CW_BAR = 4096, CW_XL = 16384;
__global__ __launch_bounds__(512, 2) void mega_fwd(Params p) {
    extern __shared__ __attribute__((aligned(16))) unsigned char lds_raw[];
    LAS unsigned char* lds = (LAS unsigned char*)lds_raw;
    const int G = gridDim.x, bid = blockIdx.x, NGW = G * 8;
#define PH_IDS int tid = threadIdx.x; asm volatile("" : "+v"(tid)); const int lane = tid & 63, wave = __builtin_amdgcn_readfirstlane(tid >> 6), gw = bid * 8 + wave; (void)lane; (void)gw;
    for (int u = threadIdx.x; u < 64; u += 512) ((LAS unsigned*)(lds + MISC_OFF))[u] = 0u;
    __syncthreads();
    XcdBarrier bar = xcd_barrier_post((unsigned*)(p.ws + WS_CTL) + CW_BAR, (volatile LAS unsigned*)(lds + MISC_OFF) + 8);
    { PH_IDS; p0_prologue(p, lds, gw, NGW, wave, lane); __syncthreads(); p0_slab_quant(p, lds, bid, G, tid); }
    xcd_barrier(bar);
    { pg8::Gemm g{(const bf16*)(p.ws + WS_XN8), (const bf16*)(p.ws + WS_WINQ), T, NPT * 256, DM / 2};
      ProjOrder S; S.init(T, NPT * 256, G, bid); S.xn = g.A; S.wt = g.Bt; EpiProjI8 E{p.ws};
      pg8::gemm_phase<EpiProjI8, ProjOrder, true, true, true>(lds, g, S, E); }
    xcd_barrier(bar);
    if (bid < 32) {
        pg8::Gemm g{(const bf16*)(p.ws + WS_KC), (const bf16*)(p.ws + WS_WKCT), 4096, 256, 2048};
        CmpOrder S{bid, (const bf16*)(p.ws + WS_KC), (const bf16*)(p.ws + WS_VC), (const bf16*)(p.ws + WS_WKCT), (const bf16*)(p.ws + WS_WVCT)}; EpiLH E{(float*)(p.ws + WS_LH)};
        pg8::gemm_phase<EpiLH, CmpOrder, true, true>(lds, g, S, E);
    } else { PH_IDS; ph_gla_a(p, lds, bid - 32, G - 32, tid, wave); }
    xcd_barrier(bar);
    { PH_IDS; ph_gla_b(p, bid * 512 + tid, G * 512);
      for (int i = bid * 512 + tid; i < 16 * 128; i += G * 512) { const int bgz = i >> 7, dz = i & 127; ((bf16*)(p.ws + WS_KCMP))[((size_t)bgz * 256 + 255) * 128 + dz] = 0; ((bf16*)(p.ws + WS_VCMPT))[((size_t)bgz * 128 + dz) * 256 + 255] = 0; }
      ph_cmp_fin(p, lds, bid, G, tid, (const float*)(p.ws + WS_LH), (const float*)(p.ws + WS_PEVP)); }
    xcd_barrier(bar);
    { PH_IDS; ph_nsa(p, lds, bid, G, tid, wave); }
    { PH_IDS; __syncthreads(); ph_gla_c(p, lds, bid, G, tid, wave); }
    xcd_barrier(bar);
    { pg8::Gemm g{(const bf16*)(p.ws + WS_A2), (const bf16*)(p.ws + WS_WOT), T, DM, DM};
      pg8::StaticOrder S; S.init(T, DM, G, bid); EpiRes E{p.in[I_X], (bf16*)(p.ws + WS_H16)};
      pg8::gemm_phase<EpiRes, pg8::StaticOrder, true, true>(lds, g, S, E); }
    xcd_barrier(bar);
    { PH_IDS; for (int vb = bid; vb < NVB; vb += G) r1_router(p, lds, vb, tid, wave, lane); }
    xcd_barrier(bar);
    { PH_IDS; for (int vb = bid; vb < NVB; vb += G) r2_gather(p, lds, vb, vb == 0, tid, wave, lane); }
    xcd_barrier(bar);
    { pg8::Gemm g{(const bf16*)(p.ws + WS_HN8), (const bf16*)(p.ws + WS_W1Q), MAXTILES * 256, 4096, DM / 2};
      MoeOrderG S; S.init((const int*)(p.ws + WS_META), 16, G, bid); S.rowtab = (const unsigned short*)(p.ws + WS_ROWTOK); EpiSwigluI8 E{p.in[I_B1], (const float*)(p.ws + WS_ROWSC), (const float*)(p.ws + WS_WSC1), (signed char*)(p.ws + WS_ACT8), (float*)(p.ws + WS_AMAXP)};
      pg8::gemm_phase<EpiSwigluI8, MoeOrderG, true, true, true, true>(lds, g, S, E); }
    xcd_barrier(bar);
    { PH_IDS; ph_actq(p, gw, NGW, lane); }
    xcd_barrier(bar);
    { pg8::Gemm g{(const bf16*)(p.ws + WS_ACT8), (const bf16*)(p.ws + WS_W2Q), MAXTILES * 256, DM, DFF / 2};
      MoeOrder S; S.init((const int*)(p.ws + WS_META), 8, G, bid); EpiDownI8 E{p.in[I_B2], (const float*)(p.ws + WS_ROWW), (const float*)(p.ws + WS_ASC), (const float*)(p.ws + WS_WSC2), (bf16*)(p.ws + WS_Y)};
      pg8::gemm_phase<EpiDownI8, MoeOrder, true, true, true>(lds, g, S, E); }
    xcd_barrier(bar);
    { PH_IDS; pf_final(p, gw, NGW, lane); }
}

extern "C" void kernel_launch(void* const* d_in, const int* in_sizes, int n_in, void* d_out, int out_size, void* d_ws, size_t ws_size, hipStream_t stream) {
    static int grid = 0;
    if (grid == 0) {
        if (n_in != N_IN || out_size != T * DM || ws_size < WS_END) { fprintf(stderr, "kernel_launch: unexpected shapes (n_in %d out %d ws %zu need %zu)\n", n_in, out_size, ws_size, (size_t)WS_END); grid = -1; return; }
        int dev = 0, cus = 0, per_cu = 0;
        if (hipGetDevice(&dev) != hipSuccess || hipDeviceGetAttribute(&cus, hipDeviceAttributeMultiprocessorCount, dev) != hipSuccess) { grid = -1; return; }
        if (hipFuncSetAttribute((const void*)mega_fwd, hipFuncAttributeMaxDynamicSharedMemorySize, LDS_BYTES) != hipSuccess) { fprintf(stderr, "kernel_launch: hipFuncSetAttribute failed\n"); grid = -1; return; }
        if (hipOccupancyMaxActiveBlocksPerMultiprocessor(&per_cu, (const void*)mega_fwd, 512, LDS_BYTES) != hipSuccess || per_cu < 1) { fprintf(stderr, "kernel_launch: occupancy query says %d blocks per CU\n", per_cu); }
        (void)hipGetLastError();
        grid = cus;
    }
    if (grid < 0) return;
    if (hipMemsetAsync((char*)d_ws + WS_CTL, 0, CTL_BYTES, stream) != hipSuccess) return;
    Params p{};
    for (int i = 0; i < N_IN; ++i) p.in[i] = (const float*)d_in[i];
    p.out = (float*)d_out; p.ws = (unsigned char*)d_ws;
    hipLaunchKernelGGL(mega_fwd, dim3(grid), dim3(512), LDS_BYTES, stream, p);
}
```

```cpp
#include <hip/hip_runtime.h>
#include <cstdio>
#include <cstdint>
namespace pg8 {
#define PG8_LAS __attribute__((address_space(3)))
typedef unsigned short bf16_t;
typedef short bf16x8 __attribute__((ext_vector_type(8)));
typedef float f32x4 __attribute__((ext_vector_type(4)));
typedef unsigned u32x4 __attribute__((ext_vector_type(4)));
typedef unsigned v2u_t __attribute__((ext_vector_type(2)));
constexpr int BM = 256, BK = 64, HALF = 128, HTB = HALF * BK * 2  , STAGE_BYTES = 8 * HTB, NXCD = 8, WGM = 8;

__host__ __device__ __forceinline__ int lds_byte(int r, int c) { const int st = (r >> 4) * 2 + (c >> 5), rr = r & 15, cc = c & 31, ob = rr * 64 + cc * 2; return st * 1024 + (ob ^ (((ob >> 9) & 1) << 5)); }
__host__ __device__ __forceinline__ void stage_rc(int b, int& R, int& C) { const int st = b / 1024, sb = b % 1024, swz = sb ^ (((sb >> 9) & 1) << 5); R = (st >> 1) * 16 + swz / 64; C = (st & 1) * 32 + (swz % 64) / 2; }
__host__ __device__ __forceinline__ int perm32(int rho) { const int n = rho >> 4, i = rho & 15; return 8 * (i >> 2) + 4 * n + (i & 3); }

struct Unit { int pm, pn, kind; };
struct Gemm { const bf16_t* A; const bf16_t* Bt; int M, N, K; };

template <int WG = WGM> __host__ __device__ __forceinline__ void tile_of(int wgid, int nM, int nN, int& pm, int& pn) {
    const int nwg = nM * nN;
    { const int q = nwg / NXCD, r = nwg % NXCD, xcd = wgid % NXCD, off = wgid / NXCD; wgid = (xcd < r ? xcd * (q + 1) : r * (q + 1) + (xcd - r) * q) + off; }
    const int nig = WG * nN, gid = wgid / nig, fm = gid * WG, gsz = (nM - fm) < WG ? (nM - fm) : WG;
    pm = fm + ((wgid % nig) % gsz); pn = (wgid % nig) / gsz;
}
struct StaticOrder {
    int nM, nN, nwg, G, c;
    __host__ __device__ void init(int M, int N, int G_, int c_) { nM = M / BM; nN = N / BM; nwg = nM * nN; G = G_; c = c_; }
    __device__ __forceinline__ bool next(int i, Unit& u) const {
        const long L = (long)i * G + c; if (L >= nwg) return false;
        tile_of((int)L, nM, nN, u.pm, u.pn); u.kind = 0; return true;
    }
    __device__ __forceinline__ const char* pa(const Gemm& g, const Unit& u) const { return (const char*)g.A + (size_t)u.pm * ((size_t)BM * g.K * 2); }
    __device__ __forceinline__ const char* pb(const Gemm& g, const Unit& u) const { return (const char*)g.Bt + (size_t)u.pn * ((size_t)BM * g.K * 2); }
    __device__ __forceinline__ void a_ready(const Unit&) const {}
    __device__ __forceinline__ void done(const Unit&) const {}
};
__device__ __forceinline__ unsigned cvt_pk_bf16(float lo, float hi) { unsigned r; asm volatile("v_cvt_pk_bf16_f32 %0, %1, %2" : "=v"(r) : "v"(lo), "v"(hi)); return r; }
template <bool I8> __device__ __forceinline__ f32x4 mma16(bf16x8 a, bf16x8 b, f32x4 c) {
    if constexpr (I8) { typedef int i32x4 __attribute__((ext_vector_type(4)));
        return __builtin_bit_cast(f32x4, __builtin_amdgcn_mfma_i32_16x16x64_i8(__builtin_bit_cast(i32x4, a), __builtin_bit_cast(i32x4, b), __builtin_bit_cast(i32x4, c), 0, 0, 0)); }
    else return __builtin_amdgcn_mfma_f32_16x16x32_bf16(a, b, c, 0, 0, 0);
}
template <class Epi, class Sched, bool ALIGN_EPI = false, bool SP2 = false, bool I8 = false, bool GATHER = false>
__device__ __forceinline__ void gemm_phase(PG8_LAS unsigned char* lds, const Gemm g, const Sched& S, const Epi& E) {
    int tid_l = threadIdx.x; asm volatile("" : "+v"(tid_l));
    const int tid = tid_l, wid = __builtin_amdgcn_readfirstlane(tid >> 6), lane = tid & 63, wr = wid >> 2, wc = wid & 3, fr = lane & 15, fq = lane >> 4;
    const int K = g.K, nt = K / BK;
    unsigned voffA[2], voffB[2];
#pragma unroll
    for (int i = 0; i < 2; ++i) { int R, C; stage_rc(tid * 16 + i * 8192, R, C); const int Rb = Epi::PERM ? ((R & ~31) + perm32(R & 31)) : R;
        voffA[i] = (unsigned)(R * K + C) * 2u; voffB[i] = (unsigned)(Rb * K + C) * 2u; }
    const size_t kstep = (size_t)(BK * 2);
    const size_t hstep = (size_t)HALF * K * 2;
    const unsigned ldsw = (unsigned)wid * 1024u;
    const int aoff = lds_byte(wr * 64 + fr, fq * 8), boff = lds_byte(wc * 32 + fr, fq * 8);
#define PG8_SA(b, h) (((b) * 2 + (h)) * HTB)
#define PG8_SB(b, h) ((4 + (b) * 2 + (h)) * HTB)
#define PG8_STAGE(bufoff, gbase, voff) do { _Pragma("unroll") for (int _i = 0; _i < 2; ++_i) \
        __builtin_amdgcn_global_load_lds((const unsigned*)((const char*)(gbase) + (voff)[_i]), (PG8_LAS unsigned*)(lds + (bufoff) + ldsw + _i * 8192), 16, 0, 0); } while (0)
#define PG8_STAGE_A(bufoff, ptr, h) do { if constexpr (GATHER) PG8_STAGE(bufoff, ptr, cuo + 2 * (h)); else PG8_STAGE(bufoff, (ptr) + (h) * hstep, voffA); } while (0)
#define PG8_LDA(dst, b, h) do { _Pragma("unroll") for (int m = 0; m < 4; ++m) _Pragma("unroll") for (int k = 0; k < 2; ++k) dst[m][k] = *(const PG8_LAS bf16x8*)(lds + PG8_SA(b, h) + aoff + m * 2048 + k * 1024); } while (0)
#define PG8_LDB(dst, b, h) do { _Pragma("unroll") for (int n = 0; n < 2; ++n) _Pragma("unroll") for (int k = 0; k < 2; ++k) dst[n][k] = *(const PG8_LAS bf16x8*)(lds + PG8_SB(b, h) + boff + n * 2048 + k * 1024); } while (0)
#define PG8_MMA(ai, bj, At, Bt) do { __builtin_amdgcn_s_setprio(1); _Pragma("unroll") for (int m = 0; m < 4; ++m) _Pragma("unroll") for (int n = 0; n < 2; ++n) _Pragma("unroll") for (int k = 0; k < 2; ++k) \
        acc[ai][bj][m][n] = mma16<I8>(Bt[n][k], At[m][k], acc[ai][bj][m][n]); __builtin_amdgcn_s_setprio(0); } while (0)
#define PG8_WAIT_V(n) asm volatile("s_waitcnt vmcnt(" #n ")" ::: "memory")
#define PG8_WAIT_L(n) asm volatile("s_waitcnt lgkmcnt(" #n ")" ::: "memory")
#define PG8_BAR __builtin_amdgcn_s_barrier()
#define PG8_SCHED __builtin_amdgcn_sched_barrier(0)
    Unit cur, nxt; int ui = 0;
    if (!S.next(0, cur)) return;
    unsigned cuo[4] = {0u, 0u, 0u, 0u}, cb0 = 0u; v2u_t raw = {0u, 0u};
    if constexpr (GATHER) { int R0, C0; stage_rc(tid * 16, R0, C0); cb0 = (unsigned)C0 * 2u; unsigned ro = (unsigned)R0 * 8u; asm volatile("" : "+v"(ro));
        Unit u1; const bool h1 = S.next(1, u1); const v2u_t r0 = *(const v2u_t*)((const char*)S.rowtab + (size_t)cur.pm * 512 + ro); raw = *(const v2u_t*)((const char*)S.rowtab + (size_t)(h1 ? u1.pm : cur.pm) * 512 + ro);
        cuo[0] = ((r0.x & 0xffffu) << 11) + cb0; cuo[1] = ((r0.x >> 16) << 11) + cb0; cuo[2] = ((r0.y & 0xffffu) << 11) + cb0; cuo[3] = ((r0.y >> 16) << 11) + cb0; }
    f32x4 acc[2][2][4][2];
#pragma unroll
    for (int a = 0; a < 2; ++a)
#pragma unroll
        for (int b = 0; b < 2; ++b)
#pragma unroll
            for (int m = 0; m < 4; ++m)
#pragma unroll
                for (int n = 0; n < 2; ++n) acc[a][b][m][n] = (f32x4){0.f, 0.f, 0.f, 0.f};
    bf16x8 At[4][2], B0[2][2], B1[2][2];
    const char* cA = S.pa(g, cur); const char* cB = S.pb(g, cur);
    S.a_ready(cur);
    if constexpr (SP2) {
        PG8_STAGE(PG8_SB(0, 0), cB, voffB); PG8_STAGE(PG8_SB(0, 1), cB + hstep, voffB); PG8_STAGE_A(PG8_SA(0, 0), cA, 0); PG8_STAGE_A(PG8_SA(0, 1), cA, 1);
        if (wr == 1) PG8_BAR;
        PG8_WAIT_V(2); PG8_BAR;
        PG8_STAGE(PG8_SB(1, 0), cB + kstep, voffB); PG8_STAGE_A(PG8_SA(1, 0), cA + kstep, 0); PG8_STAGE(PG8_SB(1, 1), cB + hstep + kstep, voffB);
        PG8_WAIT_V(6); PG8_BAR;
    } else {
        PG8_STAGE(PG8_SB(0, 0), cB, voffB); PG8_STAGE(PG8_SA(0, 0), cA, voffA); PG8_STAGE(PG8_SB(0, 1), cB + hstep, voffB); PG8_STAGE(PG8_SA(0, 1), cA + hstep, voffA);
        if (wr == 1) PG8_BAR;
        PG8_WAIT_V(4); PG8_BAR;
        PG8_STAGE(PG8_SB(1, 0), cB + kstep, voffB); PG8_STAGE(PG8_SA(1, 0), cA + kstep, voffA); PG8_STAGE(PG8_SB(1, 1), cB + hstep + kstep, voffB);
        PG8_WAIT_V(6); PG8_BAR;
    }
    for (;;) {
        const bool has_next = S.next(ui + 1, nxt);
        const char* nA = has_next ? S.pa(g, nxt) : cA; const char* nB = has_next ? S.pb(g, nxt) : cB;
        for (int t = 0; t < nt; t += 2) {
            const bool last = (t == nt - 2);
            const char* a1 = cA + (size_t)(t + 1) * kstep;
            const char* a2 = last ? nA : cA + (size_t)(t + 2) * kstep; const char* b2 = last ? nB : cB + (size_t)(t + 2) * kstep;
            const char* a3 = a2 + kstep; const char* b3 = b2 + kstep;
            if (last && has_next) S.a_ready(nxt);
            if constexpr (SP2) {
            PG8_LDB(B0, 0, 0); PG8_LDB(B1, 0, 1); PG8_SCHED; PG8_LDA(At, 0, 0); PG8_STAGE_A(PG8_SA(1, 1), a1, 1);
            if constexpr (GATHER) { unsigned rx = raw.x, ry = raw.y; asm volatile("" : "+v"(rx), "+v"(ry));
                const unsigned n0 = ((rx & 0xffffu) << 11) + cb0, n1 = ((rx >> 16) << 11) + cb0, n2 = ((ry & 0xffffu) << 11) + cb0, n3 = ((ry >> 16) << 11) + cb0;
                cuo[0] = last ? n0 : cuo[0]; cuo[1] = last ? n1 : cuo[1]; cuo[2] = last ? n2 : cuo[2]; cuo[3] = last ? n3 : cuo[3]; }
            PG8_WAIT_V(8); PG8_WAIT_L(0); PG8_BAR; PG8_MMA(0, 0, At, B0); PG8_MMA(0, 1, At, B1); PG8_BAR; PG8_SCHED;
            PG8_LDA(At, 0, 1); PG8_STAGE(PG8_SB(0, 0), b2, voffB); PG8_STAGE(PG8_SB(0, 1), b2 + hstep, voffB); PG8_STAGE_A(PG8_SA(0, 0), a2, 0);
            PG8_WAIT_V(8); PG8_WAIT_L(0); PG8_BAR; PG8_MMA(1, 0, At, B0); PG8_MMA(1, 1, At, B1); PG8_BAR; PG8_SCHED;
            PG8_LDB(B0, 1, 0); PG8_LDB(B1, 1, 1); PG8_SCHED; PG8_LDA(At, 1, 0); PG8_STAGE_A(PG8_SA(0, 1), a2, 1);
            PG8_WAIT_V(8); PG8_WAIT_L(0); PG8_BAR; PG8_MMA(0, 0, At, B0); PG8_MMA(0, 1, At, B1); PG8_BAR; PG8_SCHED;
            PG8_LDA(At, 1, 1); PG8_STAGE(PG8_SB(1, 0), b3, voffB); PG8_STAGE(PG8_SB(1, 1), b3 + hstep, voffB); PG8_STAGE_A(PG8_SA(1, 0), a3, 0);
            PG8_WAIT_V(8); PG8_WAIT_L(0); PG8_BAR; PG8_MMA(1, 0, At, B0); PG8_MMA(1, 1, At, B1); PG8_BAR; PG8_SCHED;
            } else {
            PG8_LDB(B0, 0, 0); PG8_SCHED; PG8_LDA(At, 0, 0); PG8_STAGE(PG8_SA(1, 1), a1 + hstep, voffA);
            PG8_WAIT_L(8); PG8_BAR; PG8_WAIT_L(0); PG8_MMA(0, 0, At, B0); PG8_BAR; PG8_SCHED;
            PG8_LDB(B1, 0, 1); PG8_STAGE(PG8_SB(0, 0), b2, voffB);
            PG8_BAR; PG8_WAIT_L(0); PG8_MMA(0, 1, At, B1); PG8_BAR;
            PG8_LDA(At, 0, 1); PG8_STAGE(PG8_SA(0, 0), a2, voffA);
            PG8_BAR; PG8_WAIT_L(0); PG8_MMA(1, 0, At, B0); PG8_BAR; PG8_SCHED;
            PG8_STAGE(PG8_SB(0, 1), b2 + hstep, voffB);
            PG8_WAIT_V(6); PG8_BAR; PG8_MMA(1, 1, At, B1); PG8_BAR;
            PG8_LDB(B0, 1, 0); PG8_SCHED; PG8_LDA(At, 1, 0); PG8_STAGE(PG8_SA(0, 1), a2 + hstep, voffA);
            PG8_WAIT_L(8); PG8_BAR; PG8_WAIT_L(0); PG8_MMA(0, 0, At, B0); PG8_BAR; PG8_SCHED;
            PG8_LDB(B1, 1, 1); PG8_STAGE(PG8_SB(1, 0), b3, voffB);
            PG8_BAR; PG8_WAIT_L(0); PG8_MMA(0, 1, At, B1); PG8_BAR;
            PG8_LDA(At, 1, 1); PG8_STAGE(PG8_SA(1, 0), a3, voffA);
            PG8_BAR; PG8_WAIT_L(0); PG8_MMA(1, 0, At, B0); PG8_BAR; PG8_SCHED;
            PG8_STAGE(PG8_SB(1, 1), b3 + hstep, voffB);
            PG8_WAIT_V(6); PG8_BAR; PG8_MMA(1, 1, At, B1); PG8_BAR;
            }
        }
        if constexpr (ALIGN_EPI) { if (wr == 0) PG8_BAR; }
        if constexpr (GATHER) { static_assert(SP2 && !Epi::AFTER_DRAIN, "GATHER is written for the SP2 loop"); int R0, C0; stage_rc(tid * 16, R0, C0); Unit u2; const bool h2 = S.next(ui + 2, u2);
            unsigned ro = (unsigned)R0 * 8u; asm volatile("" : "+v"(ro)); raw = *(const v2u_t*)((const char*)S.rowtab + (size_t)(h2 ? u2.pm : cur.pm) * 512 + ro); PG8_SCHED; }
        if constexpr (!Epi::AFTER_DRAIN) { E(acc, cur, wr, wc, fr, fq); S.done(cur); }
        if (!has_next) break;
#pragma unroll
        for (int a = 0; a < 2; ++a)
#pragma unroll
            for (int b = 0; b < 2; ++b)
#pragma unroll
                for (int m = 0; m < 4; ++m)
#pragma unroll
                    for (int n = 0; n < 2; ++n) acc[a][b][m][n] = (f32x4){0.f, 0.f, 0.f, 0.f};
        cur = nxt; cA = nA; cB = nB; ++ui;
        if constexpr (ALIGN_EPI) { if (wr == 1) PG8_BAR; }
    }
    PG8_WAIT_V(0);
    if constexpr (!ALIGN_EPI) { if (wr == 0) PG8_BAR; }
    PG8_BAR;
    if constexpr (Epi::AFTER_DRAIN) { E.fused(acc, cur, wr, wc, fr, fq, lds, wid, lane); S.done(cur); }
#undef PG8_SA
#undef PG8_SB
#undef PG8_STAGE
#undef PG8_STAGE_A
#undef PG8_LDA
#undef PG8_LDB
#undef PG8_MMA
#undef PG8_WAIT_V
#undef PG8_WAIT_L
#undef PG8_BAR
#undef PG8_SCHED
}
}

#define GAS __attribute__((address_space(1)))
#define LAS __attribute__((address_space(3)))
typedef unsigned short bf16;
typedef unsigned v4u __attribute__((ext_vector_type(4)));
typedef unsigned v2u __attribute__((ext_vector_type(2)));
typedef float f32x4 __attribute__((ext_vector_type(4)));
typedef short bf16x8 __attribute__((ext_vector_type(8)));

constexpr int NB = 8, SEQ = 4096, DM = 2048, T = NB * SEQ;
constexpr int NPT = 23;
constexpr int NE = 32, DFF = 2048;
constexpr int MAXTILES = 544;
constexpr float RMS_EPS = 1e-5f;
constexpr int NVB = 256, TPV = T / NVB;

enum { I_X = 0, I_NMIX, I_WIN, I_WA2, I_BA, I_GLAG, I_PEK, I_WK1, I_WK2, I_PEV, I_WV1, I_WV2, I_NSAG, I_RELB, I_WOUT, I_NFFN, I_RW, I_RB, I_W1, I_B1, I_W2, I_B2, I_NFIN, N_IN };

constexpr size_t MiB = 1u << 20;
constexpr size_t al(size_t x) { return (x + 255) & ~(size_t)255; }
constexpr size_t WS_CTL = 0, CTL_BYTES = 1 * MiB;
constexpr size_t WS_CNT = WS_CTL + CTL_BYTES;
constexpr size_t WS_META = WS_CNT + al(NVB * 32 * 4);
constexpr size_t WS_EIDX = WS_META + al((64 + MAXTILES) * 4);
constexpr size_t WS_LRNK = WS_EIDX + al((size_t)T * 4 * 4);
constexpr size_t WS_GATE = WS_LRNK + al((size_t)T * 4 * 4);
constexpr size_t WS_POS = WS_GATE + al((size_t)T * 4 * 4);
constexpr size_t WS_ROWW = WS_POS + al((size_t)T * 4 * 4);
constexpr size_t WS_WINT = al(WS_ROWW + (size_t)MAXTILES * 256 * 4);
constexpr size_t WS_WOT = WS_WINT + (size_t)NPT * 256 * DM * 2;
constexpr size_t WS_WKCT = WS_WOT + (size_t)DM * DM * 2;
constexpr size_t WS_WVCT = WS_WKCT + (size_t)256 * 2048 * 2;
constexpr size_t WS_W1T = WS_WVCT + (size_t)256 * 2048 * 2;
constexpr size_t WS_W2T = WS_W1T + (size_t)NE * 4096 * DM * 2;
constexpr size_t WS_XN = WS_W2T + (size_t)NE * DM * DFF * 2;
constexpr size_t WS_GQ = WS_XN + (size_t)T * DM * 2;
constexpr size_t WS_GK = WS_GQ + (size_t)T * 512 * 2;
constexpr size_t WS_GV = WS_GK + (size_t)T * 512 * 2;
constexpr size_t WS_GG = WS_GV + (size_t)T * 1024 * 2;
constexpr size_t WS_NQ = WS_GG + (size_t)T * 1024 * 2;
constexpr size_t WS_KC = WS_NQ + (size_t)T * 1024 * 2;
constexpr size_t WS_VC = WS_KC + (size_t)T * 256 * 2;
constexpr size_t WS_KS = WS_VC + (size_t)T * 256 * 2;
constexpr size_t WS_KW = WS_KS + (size_t)T * 256 * 2;
constexpr size_t WS_VST = WS_KW + (size_t)T * 256 * 2;
constexpr size_t WS_VWT = WS_VST + (size_t)T * 256 * 2;
constexpr size_t WS_SM = WS_VWT + (size_t)T * 256 * 2;
constexpr size_t WS_LA = WS_SM + (size_t)T * 64 * 2;
constexpr size_t WS_OG = WS_LA + (size_t)T * 512 * 4;
constexpr size_t WS_ON = WS_OG + (size_t)T * 1024 * 4;
constexpr size_t WS_KCMP = WS_ON + (size_t)T * 1024 * 4;
constexpr size_t WS_VCMPT = WS_KCMP + (size_t)16 * 256 * 128 * 2;
constexpr size_t WS_A2 = WS_VCMPT + (size_t)16 * 256 * 128 * 2;
constexpr size_t WS_HN = WS_A2 + (size_t)T * DM * 2;
constexpr size_t WS_XG = WS_HN + (size_t)T * DM * 2;
constexpr size_t WS_ACT = WS_XG + (size_t)MAXTILES * 256 * DM * 2;
constexpr size_t WS_END = WS_ACT + (size_t)MAXTILES * 256 * DFF * 2;

typedef unsigned short u16x2 __attribute__((ext_vector_type(2)));
__device__ __forceinline__ unsigned cvt2bf(float lo, float hi) { unsigned r; asm("v_cvt_pk_bf16_f32 %0, %1, %2" : "=v"(r) : "v"(lo), "v"(hi)); return r; }
__device__ __forceinline__ unsigned f2bf(float f) { return cvt2bf(f, f) & 0xffffu; }
__device__ __forceinline__ unsigned pk2(float lo, float hi) { return cvt2bf(lo, hi); }
__device__ __forceinline__ float bf2f(unsigned short v) { return __builtin_bit_cast(float, (unsigned)v << 16); }
__device__ __forceinline__ float bflo(unsigned w) { return __builtin_bit_cast(float, w << 16); }
__device__ __forceinline__ float bfhi(unsigned w) { return __builtin_bit_cast(float, w & 0xffff0000u); }
__device__ __forceinline__ float wave_sum(float v) {
#pragma unroll
    for (int o = 1; o < 64; o <<= 1) v += __shfl_xor(v, o);
    return v;
}
__device__ __forceinline__ float wave_max(float v) {
#pragma unroll
    for (int o = 1; o < 64; o <<= 1) v = fmaxf(v, __shfl_xor(v, o));
    return v;
}
#define LDS_WAIT() asm volatile("s_waitcnt lgkmcnt(0)" ::: "memory")

__device__ const unsigned char kBucket[128] = {0, 1, 2, 3, 4, 5, 6, 7, 8, 9, 10, 11, 12, 13, 14, 15, 16, 16, 16, 17, 17, 18, 18, 18, 19, 19, 19, 20, 20, 20, 20, 21, 21, 21, 21, 22, 22, 22, 22, 22, 23, 23, 23, 23, 23, 23, 24, 24, 24, 24, 24, 24, 25, 25, 25, 25, 25, 25, 25, 26, 26, 26, 26, 26, 26, 26, 26, 27, 27, 27, 27, 27, 27, 27, 27, 27, 27, 28, 28, 28, 28, 28, 28, 28, 28, 28, 28, 29, 29, 29, 29, 29, 29, 29, 29, 29, 29, 29, 29, 30, 30, 30, 30, 30, 30, 30, 30, 30, 30, 30, 30, 30, 30, 31, 31, 31, 31, 31, 31, 31, 31, 31, 31, 31, 31, 31, 31, 31};

struct Params {
    const float* in[N_IN];
    float* out;
    unsigned char* ws;
};

template <class F>
__device__ __forceinline__ void transpose_item(const float* W, int ldw, int k0, int n0, int nlim, LAS float* scr, int lane, F dst) {
#pragma unroll 8
    for (int i = 0; i < 32; ++i) { const int kk = 2 * i + (lane >> 5); const int n = n0 + (lane & 31); scr[kk * 33 + (lane & 31)] = n < nlim ? W[(size_t)(k0 + kk) * ldw + n] : 0.f; }
    LDS_WAIT(); asm volatile("" ::: "memory");
    const int c = lane & 7;
#pragma unroll
    for (int j = 0; j < 4; ++j) { const int nn = (lane >> 3) + 8 * j; const int n = n0 + nn; const LAS float* s = scr + (8 * c) * 33 + nn;
        bf16* rowp; float sc;
        if (n < nlim && dst(n, rowp, sc)) {
            v4u o; o.x = pk2(s[0 * 33] * sc, s[1 * 33] * sc); o.y = pk2(s[2 * 33] * sc, s[3 * 33] * sc); o.z = pk2(s[4 * 33] * sc, s[5 * 33] * sc); o.w = pk2(s[6 * 33] * sc, s[7 * 33] * sc);
            *(v4u*)(rowp + 8 * c) = o; } }
    LDS_WAIT(); asm volatile("" ::: "memory");
}
__device__ __forceinline__ int win_row(int n, float& sc) {
    sc = 1.f;
    if (n < 512) { sc = 0.08838834764831845f; return n; }
    if (n < 1024) return n;
    if (n < 2048) return n;
    if (n < 3072) return n;
    if (n < 3088) return 5120 + (n - 3072);
    if (n < 4112) { sc = 0.08838834764831845f; return 3072 + (n - 3088); }
    if (n < 4368) return 4096 + (n - 4112);
    if (n < 4624) return 4352 + (n - 4368);
    if (n < 4880) return 4608 + (n - 4624);
    if (n < 5136) return 5376 + (n - 4880);
    if (n < 5392) return 4864 + (n - 5136);
    if (n < 5648) return 5632 + (n - 5392);
    return 5136 + (n - 5648);
}
constexpr size_t WS_PEVP = WS_W2T;
__device__ __forceinline__ void p0_prologue(const Params& p, LAS unsigned char* lds, int gw, int NGW, int wave, int lane) {
    LAS float* scr = (LAS float*)(lds + wave * 16384);
    bf16* WinT = (bf16*)(p.ws + WS_WINT); bf16* WoT = (bf16*)(p.ws + WS_WOT); bf16* WkcT = (bf16*)(p.ws + WS_WKCT); bf16* WvcT = (bf16*)(p.ws + WS_WVCT);
    bf16* W1T = (bf16*)(p.ws + WS_W1T); bf16* W2T = (bf16*)(p.ws + WS_W2T);
    constexpr int I_IN = 32 * 178, I_O = 0  , I_C = 64 * 4, I_E1 = 32 * 128, I_E2 = 32 * 64;
    constexpr int I_PE = 2 * 64;
    constexpr int NITEMS = I_O + 2 * I_C + I_PE;
    (void)I_IN; (void)WinT;
    for (int it = gw; it < NITEMS; it += NGW) {
        int r = it;
        if (r < I_O) { const int kb = r / 64, nb = r % 64, k0 = kb * 64;
            transpose_item(p.in[I_WOUT], DM, k0, nb * 32, DM, scr, lane, [&](int n, bf16*& rowp, float& sc) { sc = 1.f; rowp = WoT + (size_t)n * DM + k0; return true; }); continue; } r -= I_O;
        if (r >= 2 * I_C) { r -= 2 * I_C; const int which = r >> 6, kq = r & 63; const float* pe = p.in[which ? I_PEV : I_PEK] + kq * 64; const float* w1 = p.in[which ? I_WV1 : I_WK1] + (size_t)kq * 64 * 128 + lane;
            float a0 = 0.f, a1 = 0.f;
#pragma unroll
            for (int k = 0; k < 64; ++k) { const float pv = pe[k]; a0 += pv * w1[k * 128]; a1 += pv * w1[k * 128 + 64]; }
            float* dst = (float*)(p.ws + WS_PEVP) + (size_t)(which * 64 + kq) * 128 + lane; dst[0] = a0; dst[64] = a1; continue; }
        { const int which = r / I_C; r %= I_C; const int kb = r / 4, nb = r % 4, k0 = kb * 64;
            bf16* dstm = which ? WvcT : WkcT;
            transpose_item(p.in[which ? I_WV1 : I_WK1], 128, k0, nb * 32, 128, scr, lane, [&](int n, bf16*& rowp, float& sc) { sc = 1.f; rowp = dstm + (size_t)(n + (k0 >= 2048 ? 128 : 0)) * 2048 + (k0 & 2047); return true; }); }
        (void)I_E1; (void)I_E2; (void)W1T; (void)W2T;
    }
    const float* x = p.in[I_X]; const float* gm = p.in[I_NMIX];
    for (int m = gw; m < T; m += NGW) {
        const f32x4* xr = (const f32x4*)(x + (size_t)m * DM) + lane; f32x4 v[8]; float s = 0.f;
#pragma unroll
        for (int j = 0; j < 8; ++j) { v[j] = xr[64 * j]; s += (v[j].x * v[j].x + v[j].y * v[j].y) + (v[j].z * v[j].z + v[j].w * v[j].w); }
        const float rstd = 1.f / sqrtf(wave_sum(s) * (1.f / DM) + RMS_EPS);
        float mxr = 0.f;
#pragma unroll
        for (int j = 0; j < 8; ++j) { const f32x4 g4 = ((const f32x4*)gm)[lane + 64 * j]; v[j].x *= rstd * g4.x; v[j].y *= rstd * g4.y; v[j].z *= rstd * g4.z; v[j].w *= rstd * g4.w;
            mxr = fmaxf(mxr, fmaxf(fmaxf(fabsf(v[j].x), fabsf(v[j].y)), fmaxf(fabsf(v[j].z), fabsf(v[j].w)))); }
        mxr = wave_max(mxr); const float qs = mxr > 0.f ? mxr * (1.f / 127.f) : 1.f, qi = 1.f / qs;
        unsigned* o4 = (unsigned*)(p.ws + WS_XN + (size_t)m * DM) + lane;
#pragma unroll
        for (int j = 0; j < 8; ++j) { const float M = 12582912.f;
            const unsigned ua = __builtin_bit_cast(unsigned, v[j].x * qi + M), ub = __builtin_bit_cast(unsigned, v[j].y * qi + M), uc = __builtin_bit_cast(unsigned, v[j].z * qi + M), ud = __builtin_bit_cast(unsigned, v[j].w * qi + M);
            o4[64 * j] = __builtin_amdgcn_perm(ub, ua, 0x0c0c0400u) | (__builtin_amdgcn_perm(ud, uc, 0x0c0c0400u) << 16); }
        if (lane == 0) ((float*)(p.ws + WS_XN + (size_t)T * DM))[m] = qs;
    }
}
#define XB_TMO      128
#define XB_XCNT(j)  (256  + 64 * (j))
#define XB_XSUB(j)  (1280 + 64 * (j))
#define XB_XGEN(j)  (2304 + 64 * (j))
#define XB_TOP      3328
#define XB_TOPGEN   3392
#define XCD_BAR_WORDS 3456
#define XB_SPIN_CAP (1u << 18)

__device__ __forceinline__ unsigned xb_ld(unsigned* p)              { return __hip_atomic_load(p, __ATOMIC_RELAXED, __HIP_MEMORY_SCOPE_AGENT); }
__device__ __forceinline__ unsigned xb_add(unsigned* p, unsigned v) { return __hip_atomic_fetch_add(p, v, __ATOMIC_RELAXED, __HIP_MEMORY_SCOPE_AGENT); }
__device__ __forceinline__ unsigned xb_xcc_id() { return (unsigned)__builtin_amdgcn_s_getreg((3 << 11) | 20) & 0xFu; }
#define XB_SPIN(cond, bar) do { unsigned _sp = 0; while (cond) { __builtin_amdgcn_s_sleep(1); \
    if ((++_sp & 255u) == 0u) { if (xb_ld(&(bar)[XB_TMO])) break; if (_sp > XB_SPIN_CAP) { atomicAdd(&(bar)[XB_TMO], 1u); break; } } } } while (0)

struct XcdBarrier {
    unsigned* bar; unsigned x;
    volatile LAS unsigned* st;
};

__device__ __forceinline__ XcdBarrier xcd_barrier_post(unsigned* bar, volatile LAS unsigned* st) {
    XcdBarrier b; b.bar = bar; b.x = xb_xcc_id(); b.st = st;
    if (threadIdx.x == 0) (void)xb_add(&bar[XB_XCNT(b.x)], 1u);
    return b;
}
__device__ __forceinline__ void xcd_barrier_complete(unsigned* bar, unsigned x, unsigned& nloc, unsigned& nx) {
    const unsigned G = gridDim.x * gridDim.y * gridDim.z;
    unsigned sum, cnt, mine, sp = 0u;
    for (;;) {
        sum = 0u; cnt = 0u; mine = 0u;
#pragma unroll
        for (unsigned j = 0; j < 16; ++j) { const unsigned c = xb_ld(&bar[XB_XCNT(j)]); sum += c; cnt += (c > 0u) ? 1u : 0u; mine = (j == x) ? c : mine; }
        if (sum == G) break;
        __builtin_amdgcn_s_sleep(1);
        if ((++sp & 255u) == 0u) { if (xb_ld(&bar[XB_TMO])) break; if (sp > XB_SPIN_CAP) { atomicAdd(&bar[XB_TMO], 1u); break; } }
    }
    nloc = mine > 0u ? mine : 1u; nx = cnt > 0u ? cnt : 1u;
}

__device__ __forceinline__ void xcd_barrier(const XcdBarrier& b) {
    asm volatile("s_waitcnt vmcnt(0)" ::: "memory");
    __syncthreads();
    if (threadIdx.x == 0) {
        unsigned* bar = b.bar;
        __builtin_amdgcn_s_waitcnt(0);
        unsigned nloc = b.st[0], nx = b.st[1];
        if (nloc == 0u) { xcd_barrier_complete(bar, b.x, nloc, nx); b.st[0] = nloc; b.st[1] = nx; }
        const unsigned old = xb_add(&bar[XB_XSUB(b.x)], 1u);
        const unsigned gen = old / nloc;
        if (old + 1u == (gen + 1u) * nloc) {
            __builtin_amdgcn_fence(__ATOMIC_RELEASE, "agent");
            asm volatile("s_waitcnt vmcnt(0)" ::: "memory");
            const unsigned og = xb_add(&bar[XB_TOP], 1u);
            const unsigned tg = og / nx;
            if (og + 1u == (tg + 1u) * nx) xb_add(&bar[XB_TOPGEN], 1u);
            else XB_SPIN(xb_ld(&bar[XB_TOPGEN]) == tg, bar);
            __builtin_amdgcn_fence(__ATOMIC_ACQUIRE, "agent");
            xb_add(&bar[XB_XGEN(b.x)], 1u);
            asm volatile("s_waitcnt vmcnt(0)" ::: "memory");
        } else {
            XB_SPIN(xb_ld(&bar[XB_XGEN(b.x)]) == gen, bar);
            __builtin_amdgcn_fence(__ATOMIC_ACQUIRE, "agent");
            asm volatile("s_waitcnt vmcnt(0)" ::: "memory");
        }
    }
    __syncthreads();
}

struct ProjOrder : pg8::StaticOrder {
    const bf16* xn; const bf16* wt;
    __device__ __forceinline__ bool next(int i, pg8::Unit& u) const { if (!pg8::StaticOrder::next(i, u)) return false; u.kind = (u.pn >= 21) ? 1 : 0; return true; }
    __device__ __forceinline__ const char* pa(const pg8::Gemm& g, const pg8::Unit& u) const { return u.kind ? (const char*)wt + (size_t)u.pn * ((size_t)256 * g.K * 2) : (const char*)xn + (size_t)u.pm * ((size_t)256 * g.K * 2); }
    __device__ __forceinline__ const char* pb(const pg8::Gemm& g, const pg8::Unit& u) const { return u.kind ? (const char*)xn + (size_t)u.pm * ((size_t)256 * g.K * 2) : (const char*)wt + (size_t)u.pn * ((size_t)256 * g.K * 2); }
};
struct EpiRes {
    static constexpr bool PERM = true, AFTER_DRAIN = false;
    const float* x; bf16* h;
    __device__ __forceinline__ void operator()(const pg8::f32x4 (&acc)[2][2][4][2], const pg8::Unit& u, int wr, int wc, int fr, int fq) const {
        const int row0 = u.pm * 256 + wr * 64 + fr, col0 = u.pn * 256 + wc * 32 + 8 * fq;
#pragma unroll
        for (int ai = 0; ai < 2; ++ai)
#pragma unroll
            for (int m = 0; m < 4; ++m) { const size_t off = (size_t)(row0 + ai * 128 + m * 16) * DM + col0;
#pragma unroll
                for (int bj = 0; bj < 2; ++bj) { const pg8::f32x4 x0 = *(const pg8::f32x4*)(x + off + bj * 128), x1 = *(const pg8::f32x4*)(x + off + bj * 128 + 4);
                    const pg8::f32x4 a0 = x0 + acc[ai][bj][m][0], a1 = x1 + acc[ai][bj][m][1]; pg8::u32x4 w;
                    w.x = pg8::cvt_pk_bf16(a0.x, a0.y); w.y = pg8::cvt_pk_bf16(a0.z, a0.w); w.z = pg8::cvt_pk_bf16(a1.x, a1.y); w.w = pg8::cvt_pk_bf16(a1.z, a1.w);
                    *(pg8::u32x4*)(h + off + bj * 128) = w; } }
    }
};
struct MoeOrder {
    int nM, nN, nwg, G, c; const int* tile_exp;
    __device__ __forceinline__ void init(const int* meta, int nN_, int G_, int c_) { nM = meta[0]; nN = nN_; nwg = nM * nN; G = G_; c = c_; tile_exp = meta + 64; }
    __device__ __forceinline__ bool next(int i, pg8::Unit& u) const {
        const long L = (long)i * G + c; if (L >= nwg) return false;
        pg8::tile_of<8>((int)L, nM, nN, u.pm, u.pn); u.kind = tile_exp[u.pm]; return true;
    }
    __device__ __forceinline__ const char* pa(const pg8::Gemm& g, const pg8::Unit& u) const { return (const char*)g.A + (size_t)u.pm * ((size_t)256 * g.K * 2); }
    __device__ __forceinline__ const char* pb(const pg8::Gemm& g, const pg8::Unit& u) const { return (const char*)g.Bt + ((size_t)u.kind * nN + u.pn) * ((size_t)256 * g.K * 2); }
    __device__ __forceinline__ void a_ready(const pg8::Unit&) const {}
    __device__ __forceinline__ void done(const pg8::Unit&) const {}
};

struct MoeOrderG : MoeOrder { const unsigned short* rowtab;
    __device__ __forceinline__ const char* pa(const pg8::Gemm& g, const pg8::Unit&) const { return (const char*)g.A; } };

__device__ __forceinline__ float gelu_tanh(float x) { const float u = 0.7978845608028654f * (x + 0.044715f * x * x * x); const float e = __expf(2.f * u); return 0.5f * x * (1.f + (1.f - 2.f / (e + 1.f))); }
__device__ __forceinline__ void ph_cmp_fin(const Params& p, LAS unsigned char* lds, int bid, int G, int tid, const float* LHall, const float* PEVall) {
    const int grp = tid >> 7, n = tid & 127, ngrp = G * 4, total = 2 * 16 * 255, iters = (total + ngrp - 1) / ngrp;
    LAS float* hid = (LAS float*)lds + grp * 128;
    float pevs[2];
#pragma unroll
    for (int w = 0; w < 2; ++w) { float s = 0.f;
#pragma unroll 8
        for (int q = 0; q < 64; ++q) s += PEVall[(size_t)(w * 64 + q) * 128 + n];
        pevs[w] = s; }
    float wcol[128]; int wh = -1;
    for (int it = 0; it < iters; ++it) { int id = it * ngrp + bid * 4 + grp; if (id >= total) id = total - 1;
        const int which = id / (16 * 255), rem = id % (16 * 255), bg = rem / 255, c = rem % 255;
        if (which != wh) { const float* w2 = p.in[which ? I_WV2 : I_WK2]; wh = which;
#pragma unroll
            for (int mm = 0; mm < 128; ++mm) wcol[mm] = w2[mm * 128 + n]; }
        const float* LH = LHall + ((size_t)which * 4096 + bg * 256) * 256;
        const float a = LH[(size_t)c * 256 + n] + LH[(size_t)(c + 1) * 256 + 128 + n] + (which ? pevs[1] : pevs[0]);
        hid[n] = gelu_tanh(a);
        __syncthreads();
        float o0 = 0.f, o1 = 0.f, o2 = 0.f, o3 = 0.f;
#pragma unroll
        for (int m4 = 0; m4 < 32; ++m4) { const f32x4 hv = *(const LAS f32x4*)(hid + 4 * m4); o0 += hv.x * wcol[4 * m4]; o1 += hv.y * wcol[4 * m4 + 1]; o2 += hv.z * wcol[4 * m4 + 2]; o3 += hv.w * wcol[4 * m4 + 3]; }
        const float o = (o0 + o1) + (o2 + o3);
        if (which == 0) ((bf16*)(p.ws + WS_KCMP))[((size_t)bg * 256 + c) * 128 + n] = (bf16)f2bf(o);
        else ((bf16*)(p.ws + WS_VCMPT))[((size_t)bg * 128 + n) * 256 + c] = (bf16)f2bf(o);
        __syncthreads(); }
}

namespace nsa {
constexpr int KB0 = 0, KB1 = 16384, VB0 = 32768, VB1 = 49152, LUT = 65536;
constexpr int QST = LUT + 4096, IMP = QST + 65536, SELM = IMP + 16384, LDS_END = SELM + 512;
constexpr float LOG2E = 1.4426950408889634f;
typedef float f4 __attribute__((ext_vector_type(4)));

typedef unsigned u2v __attribute__((ext_vector_type(2)));
__device__ __forceinline__ float rmax16(float x) { const unsigned u = __float_as_uint(x); const u2v r = __builtin_amdgcn_permlane16_swap(u, u, false, false); return fmaxf(__uint_as_float(r[0]), __uint_as_float(r[1])); }
__device__ __forceinline__ float rmax32(float x) { const unsigned u = __float_as_uint(x); const u2v r = __builtin_amdgcn_permlane32_swap(u, u, false, false); return fmaxf(__uint_as_float(r[0]), __uint_as_float(r[1])); }
__device__ __forceinline__ float radd16(float x) { const unsigned u = __float_as_uint(x); const u2v r = __builtin_amdgcn_permlane16_swap(u, u, false, false); return __uint_as_float(r[0]) + __uint_as_float(r[1]); }
__device__ __forceinline__ float radd32(float x) { const unsigned u = __float_as_uint(x); const u2v r = __builtin_amdgcn_permlane32_swap(u, u, false, false); return __uint_as_float(r[0]) + __uint_as_float(r[1]); }
__device__ __forceinline__ float raddq(float x) { x += __int_as_float(__builtin_amdgcn_update_dpp(0, __float_as_int(x), 0xB1, 0xF, 0xF, true)); x += __int_as_float(__builtin_amdgcn_update_dpp(0, __float_as_int(x), 0x4E, 0xF, 0xF, true)); return x; }
struct Ctx {
    LAS unsigned char* lds; int tid, lane, wave, c, gq, r;
    int s0, cur;
    const LAS unsigned char* qst;
    int pos0;
    const LAS float* lutrow;
    int koff0, voff0;
    unsigned kdo[2], vdoc[2], vdos[2];
};
__device__ __forceinline__ void dma_k(const Ctx& C, const bf16* kt, LAS unsigned char* kb) {
#pragma unroll
    for (int i = 0; i < 2; ++i) __builtin_amdgcn_global_load_lds((const unsigned*)((const char*)kt + C.kdo[i]), (LAS unsigned*)(kb + (2 * C.wave + i) * 1024), 16, 0, 0); }
__device__ __forceinline__ void dma_v(const Ctx& C, const bf16* vt, const unsigned (&vdo)[2], LAS unsigned char* vb) {
#pragma unroll
    for (int i = 0; i < 2; ++i) __builtin_amdgcn_global_load_lds((const unsigned*)((const char*)vt + vdo[i]), (LAS unsigned*)(vb + (2 * C.wave + i) * 1024), 16, 0, 0); }

__device__ __forceinline__ void compute_st(const Ctx& C, const LAS unsigned char* kb, f4 (&s)[2][4]) {
#pragma unroll
    for (int ks = 0; ks < 4; ++ks) { const bf16x8 q0 = *(const LAS bf16x8*)(C.qst + ks * 1024), q1 = *(const LAS bf16x8*)(C.qst + (4 + ks) * 1024);
#pragma unroll
        for (int kt = 0; kt < 4; ++kt) { const bf16x8 a = *(const LAS bf16x8*)(kb + kt * 4096 + (C.koff0 ^ (ks * 64)));
            s[0][kt] = __builtin_amdgcn_mfma_f32_16x16x32_bf16(a, q0, ks == 0 ? (f4){0.f, 0.f, 0.f, 0.f} : s[0][kt], 0, 0, 0);
            s[1][kt] = __builtin_amdgcn_mfma_f32_16x16x32_bf16(a, q1, ks == 0 ? (f4){0.f, 0.f, 0.f, 0.f} : s[1][kt], 0, 0, 0); }
        asm volatile("" ::: "memory"); }
}
__device__ __forceinline__ void compute_pv(const Ctx& C, const LAS unsigned char* vb, const f4 (&p)[2][4], f4 (&o)[2][8]) {
#pragma unroll
    for (int i = 0; i < 2; ++i) { bf16x8 pb[2];
#pragma unroll
        for (int qt = 0; qt < 2; ++qt) { v4u w; w.x = pg8::cvt_pk_bf16(p[qt][2 * i][0], p[qt][2 * i][1]); w.y = pg8::cvt_pk_bf16(p[qt][2 * i][2], p[qt][2 * i][3]);
            w.z = pg8::cvt_pk_bf16(p[qt][2 * i + 1][0], p[qt][2 * i + 1][1]); w.w = pg8::cvt_pk_bf16(p[qt][2 * i + 1][2], p[qt][2 * i + 1][3]); pb[qt] = __builtin_bit_cast(bf16x8, w); }
#pragma unroll
        for (int dt = 0; dt < 8; ++dt) { const v2u lo = *(const LAS v2u*)(vb + dt * 2048 + (C.voff0 ^ (i * 64))), hi = *(const LAS v2u*)(vb + dt * 2048 + (C.voff0 ^ (i * 64 + 32))); const bf16x8 a = __builtin_bit_cast(bf16x8, (v4u){lo.x, lo.y, hi.x, hi.y});
#pragma unroll
            for (int qt = 0; qt < 2; ++qt) o[qt][dt] = __builtin_amdgcn_mfma_f32_16x16x32_bf16(a, pb[qt], o[qt][dt], 0, 0, 0);
            if (dt & 1) asm volatile("" ::: "memory"); } }
}
enum { M_CMP = 0, M_SEL = 1, M_WIN = 2 };
template <int MODE, bool FAR = false>
__device__ __forceinline__ void mask_bias(const Ctx& C, f4 (&s)[2][4], int kb, int n, const LAS unsigned* selw) {
    const float NEG = -__builtin_inff();
#pragma unroll
    for (int qt = 0; qt < 2; ++qt) {
        bool tokok = true;
        if (MODE == M_SEL) tokok = ((selw[(4 * qt + (C.c >> 2)) * 2 + (n >> 5)] >> (n & 31)) & 1u) != 0u;
        if (FAR) { const float be = tokok ? C.lutrow[127] : NEG;
#pragma unroll
            for (int kt = 0; kt < 4; ++kt)
#pragma unroll
                for (int rg = 0; rg < 4; ++rg) s[qt][kt][rg] = __builtin_fmaf(s[qt][kt][rg], LOG2E, be);
            continue; }
        const int dbase = (MODE == M_CMP) ? (C.pos0 + 4 * qt - 31 - 16 * (kb + 4 * C.gq)) : (C.pos0 + 4 * qt - (kb + 4 * C.gq));
#pragma unroll
        for (int kt = 0; kt < 4; ++kt) {
#pragma unroll
            for (int rg = 0; rg < 4; ++rg) { const int d = (MODE == M_CMP) ? dbase - 16 * (16 * kt + rg) : dbase - (16 * kt + rg);
                int di = d < 0 ? 0 : d; di = di > 127 ? 127 : di; const float bias = C.lutrow[di];
                bool ok = tokok && d >= 0; if (MODE == M_WIN) ok = ok && d < 512;
                s[qt][kt][rg] = ok ? __builtin_fmaf(s[qt][kt][rg], LOG2E, bias) : NEG; }
            asm volatile("" ::: "memory"); }
    }
}
__device__ __forceinline__ void softmax_step(f4 (&s)[2][4], float (&m)[2], float (&l)[2], f4 (&o)[2][8], bool rescale_o) {
#pragma unroll
    for (int qt = 0; qt < 2; ++qt) { float mx = s[qt][0][0];
#pragma unroll
        for (int kt = 0; kt < 4; ++kt)
#pragma unroll
            for (int rg = 0; rg < 4; ++rg) mx = fmaxf(mx, s[qt][kt][rg]);
        mx = rmax32(rmax16(mx));
        const float mn = fmaxf(m[qt], mx), alpha = __builtin_amdgcn_exp2f(m[qt] - mn); m[qt] = mn; float ps = 0.f;
#pragma unroll
        for (int kt = 0; kt < 4; ++kt)
#pragma unroll
            for (int rg = 0; rg < 4; ++rg) { const float e = __builtin_amdgcn_exp2f(s[qt][kt][rg] - mn); s[qt][kt][rg] = e; ps += e; }
        l[qt] = l[qt] * alpha + ps;
        if (rescale_o && __any(alpha != 1.f)) {
#pragma unroll
            for (int dt = 0; dt < 8; ++dt) o[qt][dt] = o[qt][dt] * alpha; }
    }
}
template <int MODE>
__device__ __forceinline__ void softmax_far(const Ctx& C, f4 (&s)[2][4], int n, const LAS unsigned* selw, float (&m)[2], float (&l)[2], f4 (&o)[2][8]) {
    const float b31 = C.lutrow[127];
#pragma unroll
    for (int qt = 0; qt < 2; ++qt) {
        float be = b31;
        if (MODE == M_SEL) { const bool tokok = ((selw[(4 * qt + (C.c >> 2)) * 2 + (n >> 5)] >> (n & 31)) & 1u) != 0u; be = tokok ? b31 : -__builtin_inff(); }
        float mx = fmaxf(fmaxf(s[qt][0][0], s[qt][0][1]), fmaxf(s[qt][0][2], s[qt][0][3]));
#pragma unroll
        for (int kt = 1; kt < 4; ++kt) mx = fmaxf(mx, fmaxf(fmaxf(s[qt][kt][0], s[qt][kt][1]), fmaxf(s[qt][kt][2], s[qt][kt][3])));
        mx = rmax32(rmax16(mx));
        const float mt = __builtin_fmaf(mx, LOG2E, be), mn = fmaxf(m[qt], mt), alpha = __builtin_amdgcn_exp2f(m[qt] - mn), c0 = be - mn; m[qt] = mn; float ps = 0.f;
#pragma unroll
        for (int kt = 0; kt < 4; ++kt)
#pragma unroll
            for (int rg = 0; rg < 4; ++rg) { const float e = __builtin_amdgcn_exp2f(__builtin_fmaf(s[qt][kt][rg], LOG2E, c0)); s[qt][kt][rg] = e; ps += e; }
        l[qt] = l[qt] * alpha + ps;
        if (__any(alpha != 1.f)) {
#pragma unroll
            for (int dt = 0; dt < 8; ++dt) o[qt][dt] = o[qt][dt] * alpha; }
    }
}
}

__device__ __forceinline__ void ph_nsa(const Params& p, LAS unsigned char* lds, int idx0, int idxstride, int tid_in, int wave) {
    using namespace nsa;
    int tid = tid_in; asm volatile("" : "+v"(tid));
    const int lane = tid & 63;
    Ctx C; C.lds = lds; C.tid = tid; C.lane = lane; C.wave = wave; C.c = lane & 15; C.gq = lane >> 4; C.r = lane & 3;
    C.koff0 = C.c * 256 + ((C.gq ^ C.c) * 16);
#pragma unroll
    for (int i = 0; i < 2; ++i) { const int piece = 2 * wave + i;
        { const int row = piece * 4 + (lane >> 4), chunk = (lane & 15) ^ (row & 15); C.kdo[i] = (unsigned)(row * 256 + chunk * 16); }
        { const int row = piece * 8 + (lane >> 3), chunk = (lane & 7) ^ ((row >> 1) & 7); C.vdoc[i] = (unsigned)(row * 256 * 2 + chunk * 16); C.vdos[i] = (unsigned)(row * SEQ * 2 + chunk * 16); } }
    C.voff0 = C.c * 128 + (((C.gq >> 1) ^ ((C.c >> 1) & 7)) * 16) + (C.gq & 1) * 8;
    const bf16* NQ = (const bf16*)(p.ws + WS_NQ); const bf16* SM = (const bf16*)(p.ws + WS_SM); bf16* A2 = (bf16*)(p.ws + WS_A2);
    const float* relb = p.in[I_RELB]; const float* nsag = p.in[I_NSAG];
    LAS float* lut = (LAS float*)(lds + LUT);
    for (int i = tid; i < 8 * 128; i += 512) { const int hh = i >> 7, d = i & 127; lut[i] = relb[(int)kBucket[d] * 8 + hh] * LOG2E; }
    __syncthreads();
    LAS unsigned char* qstw = lds + QST + wave * 8192 + lane * 16; C.qst = qstw;
    LAS float* imp = (LAS float*)(lds + IMP + wave * 2048);
    LAS unsigned long long* selm = (LAS unsigned long long*)(lds + SELM + wave * 64);
#define NSA_SYNC() do { asm volatile("s_waitcnt vmcnt(0)" ::: "memory"); __syncthreads(); } while (0)
    for (int idx = idx0; idx < 512; idx += idxstride) {
        const int rnd = idx >> 8, kq = idx & 255, b = kq & 7, tq = rnd == 0 ? 63 - (kq >> 3) : (kq >> 3);
        C.s0 = tq * 64; C.cur = tq;
        const int tokl0 = 8 * wave + (C.c >> 2);
        C.pos0 = C.s0 + tokl0;
        float ssq[2] = {0.f, 0.f};
        for (int g = 0; g < 2; ++g) {
            const int bg = b * 2 + g, h = g * 4 + C.r;
            C.lutrow = lut + h * 128;
            const bf16* KCMP = (const bf16*)(p.ws + WS_KCMP) + (size_t)bg * 256 * 128; const bf16* VCMPT = (const bf16*)(p.ws + WS_VCMPT) + (size_t)bg * 128 * 256;
#pragma unroll
            for (int qt = 0; qt < 2; ++qt) { const unsigned qo = (unsigned)(((b * SEQ + (C.pos0 + 4 * qt)) * 1024 + h * 128 + 8 * C.gq) * 2);
#pragma unroll
                for (int ks = 0; ks < 4; ++ks) *(LAS bf16x8*)(qstw + (qt * 4 + ks) * 1024) = *(const bf16x8*)((const char*)NQ + qo + ks * 64); }
#pragma unroll
            for (int i = 0; i < 2; ++i) *(LAS f32x4*)((LAS unsigned char*)imp + lane * 16 + i * 1024) = (f32x4){0.f, 0.f, 0.f, 0.f};
#define NSA_OROW(qt) ((char*)A2 + (unsigned)(((b * SEQ + C.pos0 + 4 * (qt)) * DM + 1024 + h * 128 + 4 * C.gq) * 2))
            const int cmaxb = C.s0 + 63 - 31; const int nct = cmaxb >= 0 ? ((cmaxb >> 4) >> 6) + 1 : 0;
            float m[2] = {-1e30f, -1e30f}, l[2] = {0.f, 0.f};
            f4 o[2][8];
            if (nct > 0) {
                dma_k(C, KCMP, lds + KB0); NSA_SYNC();
                for (int ct = 0; ct < nct; ++ct) { const int buf = ct & 1;
                    if (ct + 1 < nct) dma_k(C, KCMP + (ct + 1) * 64 * 128, lds + (buf ? KB0 : KB1));
                    f4 s[2][4]; compute_st(C, lds + (buf ? KB1 : KB0), s); mask_bias<M_CMP>(C, s, 64 * ct, 0, (const LAS unsigned*)selm); softmax_step(s, m, l, o, false);
                    NSA_SYNC(); }
            }
            float inv[2];
#pragma unroll
            for (int qt = 0; qt < 2; ++qt) { const float lt = radd32(radd16(l[qt])); inv[qt] = lt > 0.f ? 1.f / lt : 0.f; }
#pragma unroll
            for (int qt = 0; qt < 2; ++qt)
#pragma unroll
                for (int dt = 0; dt < 8; ++dt) o[qt][dt] = (f4){0.f, 0.f, 0.f, 0.f};
            if (nct > 0) {
                dma_k(C, KCMP, lds + KB0); dma_v(C, VCMPT, C.vdoc, lds + VB0); NSA_SYNC();
                for (int ct = 0; ct < nct; ++ct) { const int buf = ct & 1;
                    if (ct + 1 < nct) { dma_k(C, KCMP + (ct + 1) * 64 * 128, lds + (buf ? KB0 : KB1)); dma_v(C, VCMPT + 64 * (ct + 1), C.vdoc, lds + (buf ? VB0 : VB1)); }
                    f4 s[2][4]; compute_st(C, lds + (buf ? KB1 : KB0), s); mask_bias<M_CMP>(C, s, 64 * ct, 0, (const LAS unsigned*)selm);
#pragma unroll
                    for (int qt = 0; qt < 2; ++qt)
#pragma unroll
                        for (int kt = 0; kt < 4; ++kt) {
#pragma unroll
                            for (int rg = 0; rg < 4; ++rg) s[qt][kt][rg] = __builtin_amdgcn_exp2f(s[qt][kt][rg] - m[qt]) * inv[qt];
                            float po = (s[qt][kt][0] + s[qt][kt][1]) + (s[qt][kt][2] + s[qt][kt][3]), p3 = s[qt][kt][3];
                            po = raddq(po); p3 = raddq(p3);
                            const int nb = 16 * ct + 4 * kt + C.gq, tl = 4 * qt + (C.c >> 2);
                            if (C.r == 0) { __hip_atomic_fetch_add((float*)(imp + tl * 64 + nb), po, __ATOMIC_RELAXED, __HIP_MEMORY_SCOPE_WORKGROUP); if (nb + 1 < 64) __hip_atomic_fetch_add((float*)(imp + tl * 64 + nb + 1), p3, __ATOMIC_RELAXED, __HIP_MEMORY_SCOPE_WORKGROUP); } }
                    compute_pv(C, lds + (buf ? VB1 : VB0), s, o);
                    NSA_SYNC(); }
            }
            LDS_WAIT(); __builtin_amdgcn_wave_barrier();
            for (int tk = 0; tk < 8; ++tk) { const int n = lane; float sc;
                if (n == 0 || n == C.cur || n == C.cur - 1) sc = 1e4f; else if (n <= C.cur) sc = imp[tk * 64 + n]; else sc = -1.f;
                const int key = ((sc < 0.f ? 0 : __float_as_int(sc) + 64) & ~63) | (63 - n);
                int rank = 0;
#pragma unroll
                for (int mm = 0; mm < 64; ++mm) rank += (__builtin_amdgcn_readlane(key, mm) > key) ? 1 : 0;
                const unsigned long long mk = __ballot(rank < 16);
                if (lane == 0) selm[tk] = mk; }
            LDS_WAIT(); __builtin_amdgcn_wave_barrier();
#pragma unroll
            for (int qt = 0; qt < 2; ++qt) { const float gt = 1.f / (1.f + __expf(-bf2f(*(const bf16*)((const char*)SM + (unsigned)(((b * SEQ + (C.pos0 + 4 * qt)) * 64 + 16 + h) * 2)))));
#pragma unroll
                for (int dt = 0; dt < 8; ++dt) { const f4 v = o[qt][dt] * gt; *(v2u*)(NSA_OROW(qt) + 32 * dt) = (v2u){pg8::cvt_pk_bf16(v[0], v[1]), pg8::cvt_pk_bf16(v[2], v[3])}; } }
#pragma unroll
            for (int br = 1; br <= 2; ++br) {
                const bf16* KX = (const bf16*)(p.ws + (br == 1 ? WS_KS : WS_KW)) + bg * SEQ * 128; const bf16* VX = (const bf16*)(p.ws + (br == 1 ? WS_VST : WS_VWT)) + bg * 128 * SEQ;
                const int n0 = br == 1 ? 0 : (C.cur >= 8 ? C.cur - 8 : 0), n1 = C.cur;
                m[0] = m[1] = -1e30f; l[0] = l[1] = 0.f;
#pragma unroll
                for (int qt = 0; qt < 2; ++qt)
#pragma unroll
                    for (int dt = 0; dt < 8; ++dt) o[qt][dt] = (f4){0.f, 0.f, 0.f, 0.f};
                int f0 = n1 + 1, f1 = n0 - 1;
                for (int n = n0; n <= n1; ++n) { const bool fa = (C.s0 - (64 * n + 63) >= 113) && (br == 1 || (C.s0 + 63 - 64 * n) < 512); if (fa) { f0 = n < f0 ? n : f0; f1 = n; } }
                const int cntf = f1 >= f0 ? f1 - f0 + 1 : 0, cnt = n1 - n0 + 1, nlo = cntf ? f0 - n0 : cnt;
#define NSA_TILE(i) ((i) < cntf ? f0 + (i) : (((i) - cntf) < nlo ? n0 + ((i) - cntf) : f1 + 1 + ((i) - cntf - nlo)))
#define NSA_BODY(FARF) { const int n = NSA_TILE(i); const int buf = i & 1; \
                    if (i + 1 < cnt) { const int nn = NSA_TILE(i + 1); dma_k(C, KX + nn * 64 * 128, lds + (buf ? KB0 : KB1)); dma_v(C, VX + 64 * nn, C.vdos, lds + (buf ? VB0 : VB1)); } \
                    bool need = true; \
                    if (br == 1) { const unsigned any = ((const LAS unsigned*)selm)[(lane & 7) * 2 + (n >> 5)] >> (n & 31); need = __any((int)(any & 1u)); } \
                    if (need) { f4 s[2][4]; compute_st(C, lds + (buf ? KB1 : KB0), s); \
                        if (FARF) { if (br == 1) softmax_far<M_SEL>(C, s, n, (const LAS unsigned*)selm, m, l, o); else softmax_far<M_WIN>(C, s, n, (const LAS unsigned*)selm, m, l, o); } \
                        else { if (br == 1) mask_bias<M_SEL, false>(C, s, 64 * n, n, (const LAS unsigned*)selm); else mask_bias<M_WIN, false>(C, s, 64 * n, n, (const LAS unsigned*)selm); \
                            softmax_step(s, m, l, o, true); } \
                        compute_pv(C, lds + (buf ? VB1 : VB0), s, o); } \
                    NSA_SYNC(); }
                { const int nf = NSA_TILE(0); dma_k(C, KX + nf * 64 * 128, lds + KB0); dma_v(C, VX + 64 * nf, C.vdos, lds + VB0); NSA_SYNC(); }
                int i = 0;
                for (; i < cntf; ++i) NSA_BODY(true)
                for (; i < cnt; ++i) NSA_BODY(false)
#undef NSA_BODY
#undef NSA_TILE
                asm volatile("s_waitcnt vmcnt(0)" ::: "memory");
#pragma unroll
                for (int qt = 0; qt < 2; ++qt) { const float lt = radd32(radd16(l[qt]));
                    const int row = b * SEQ + (C.pos0 + 4 * qt);
                    const float sc = (1.f / (1.f + __expf(-bf2f(*(const bf16*)((const char*)SM + (unsigned)((row * 64 + 16 + 8 * br + h) * 2)))))) / lt;
#pragma unroll
                    for (int dt = 0; dt < 8; ++dt) { const f4 v = o[qt][dt] * sc; v2u* sp = (v2u*)(NSA_OROW(qt) + 32 * dt); const v2u pv = *sp;
                        const float a0 = bflo(pv.x) + v[0], a1 = bfhi(pv.x) + v[1], a2 = bflo(pv.y) + v[2], a3 = bfhi(pv.y) + v[3];
                        if (br == 2) ssq[qt] += (a0 * a0 + a1 * a1) + (a2 * a2 + a3 * a3);
                        *sp = (v2u){pg8::cvt_pk_bf16(a0, a1), pg8::cvt_pk_bf16(a2, a3)}; } }
            }
        }
        float rstd[2];
#pragma unroll
        for (int qt = 0; qt < 2; ++qt) { const float t = radd32(radd16(raddq(ssq[qt]))); rstd[qt] = 1.f / sqrtf(t * (1.f / 1024.f) + RMS_EPS); }
        asm volatile("s_waitcnt vmcnt(0)" ::: "memory");
#pragma unroll
        for (int qt = 0; qt < 2; ++qt) { const int sub = C.r * 4 + C.gq; bf16* orow = (bf16*)((char*)A2 + (unsigned)(((b * SEQ + (C.pos0 + 4 * qt)) * DM + 1024) * 2 + sub * 16)); const int subz = 0;
#pragma unroll
            for (int j = 0; j < 8; ++j) { const int col = (j * 16 + subz) * 8; v4u w = *(const v4u*)((const char*)orow + (unsigned)(col * 2)); const f32x4 g0 = *(const f32x4*)((const char*)nsag + (unsigned)(col * 4 + sub * 32)), g1 = *(const f32x4*)((const char*)nsag + (unsigned)(col * 4 + sub * 32 + 16)); const float rs = rstd[qt];
                w.x = pk2(bflo(w.x) * rs * g0.x, bfhi(w.x) * rs * g0.y); w.y = pk2(bflo(w.y) * rs * g0.z, bfhi(w.y) * rs * g0.w); w.z = pk2(bflo(w.z) * rs * g1.x, bfhi(w.z) * rs * g1.y); w.w = pk2(bflo(w.w) * rs * g1.z, bfhi(w.w) * rs * g1.w);
                *(v4u*)((char*)orow + (unsigned)(col * 2)) = w; } }
        NSA_SYNC();
    }
#undef NSA_SYNC
#undef NSA_OROW
}

constexpr size_t WS_ST = WS_LA;
constexpr size_t WS_DEC = WS_ST + (size_t)2048 * 256 * 128 * 2;
static_assert(WS_DEC + (size_t)2048 * 128 * 4 <= WS_KCMP, "gla scratch overlay");
namespace gla {
typedef float f4 __attribute__((ext_vector_type(4)));
constexpr int L_ST = 0, L_KT = 65536, L_QT = 81920, L_VT = 98304, L_GA = 131072, L_GT = L_GA + 4096, L_RED = L_GT + 2048, L_END = L_RED + 512;
struct CumIn { float w[16]; float bb; v4u sm; };
__device__ __forceinline__ CumIn load_cum(const Params& p, int tid, int t0, int h) { CumIn x;
    const bf16* SM = (const bf16*)(p.ws + WS_SM); const float* wa2 = p.in[I_WA2]; const float* ba = p.in[I_BA]; const int dk = tid & 127;
    x.sm = (v4u){0u, 0u, 0u, 0u};
    if (tid < 128) { const int j = tid >> 1, hf = tid & 1; x.sm = *(const v4u*)((const char*)SM + (unsigned)(((t0 + j) * 64 + hf * 8) * 2)); }
#pragma unroll
    for (int r = 0; r < 16; ++r) x.w[r] = wa2[r * 512 + h * 128 + dk];
    x.bb = ba[h * 128 + dk];
    return x; }
__device__ __forceinline__ void chunk_cumsum(const CumIn& in, LAS unsigned char* lds, int tid, float (&P)[16], float& blast) {
    LAS float* ga = (LAS float*)(lds + L_GA); LAS float* gt = (LAS float*)(lds + L_GT);
    if (tid < 128) { const int j = tid >> 1, hf = tid & 1; const v4u w = in.sm;
        LAS float* d = ga + j * 16 + hf * 8; d[0] = bflo(w.x); d[1] = bfhi(w.x); d[2] = bflo(w.y); d[3] = bfhi(w.y); d[4] = bflo(w.z); d[5] = bfhi(w.z); d[6] = bflo(w.w); d[7] = bfhi(w.w); }
    const int dk = tid & 127, jq = tid >> 7;
    const float bb = in.bb;
    __syncthreads();
    float run = 0.f;
#pragma unroll
    for (int jj = 0; jj < 16; ++jj) { const LAS f32x4* gr = (const LAS f32x4*)(ga + (16 * jq + jj) * 16); float z = bb;
#pragma unroll
        for (int r4 = 0; r4 < 4; ++r4) { const f32x4 g4 = gr[r4]; z += g4.x * in.w[4 * r4] + g4.y * in.w[4 * r4 + 1] + g4.z * in.w[4 * r4 + 2] + g4.w * in.w[4 * r4 + 3]; }
        run += (fminf(z, 0.f) - __logf(1.f + __expf(-fabsf(z)))) * (1.f / 16.f);   P[jj] = run; }
    gt[jq * 128 + dk] = run;
    __syncthreads();
    float off = 0.f, tot = 0.f;
#pragma unroll
    for (int q = 0; q < 4; ++q) { const float t = gt[q * 128 + dk]; tot += t; if (q < jq) off += t; }
#pragma unroll
    for (int jj = 0; jj < 16; ++jj) P[jj] += off;
    blast = tot;
}
struct RawK { v4u r[2]; }; struct RawV { v4u r[4]; };
__device__ __forceinline__ RawK load_raw_k(const bf16* src  , int tid, int t0, int h) { RawK x;
#pragma unroll
    for (int q = 0; q < 2; ++q) { const int id = tid + 512 * q, j = id >> 4, c16 = id & 15; x.r[q] = *(const v4u*)((const char*)src + (unsigned)(((t0 + j) * 512 + h * 128 + c16 * 8) * 2)); }
    return x; }
__device__ __forceinline__ void store_raw_k(LAS unsigned char* dst, int tid, const RawK& x) {
#pragma unroll
    for (int q = 0; q < 2; ++q) { const int id = tid + 512 * q, j = id >> 4, c16 = id & 15; *(LAS v4u*)(dst + j * 256 + c16 * 16) = x.r[q]; } }
__device__ __forceinline__ RawV load_raw_v(const Params& p, int tid, int t0, int h) { const bf16* GV = (const bf16*)(p.ws + WS_GV); RawV x;
#pragma unroll
    for (int q = 0; q < 4; ++q) { const int id = tid + 512 * q, j = id >> 5, c = id & 31; x.r[q] = *(const v4u*)((const char*)GV + (unsigned)(((t0 + j) * 1024 + h * 256 + c * 8) * 2)); }
    return x; }
__device__ __forceinline__ void store_raw_v(LAS unsigned char* dst, int tid, const RawV& x) {
#pragma unroll
    for (int q = 0; q < 4; ++q) { const int id = tid + 512 * q, j = id >> 5, c = id & 31; *(LAS v4u*)(dst + j * 512 + c * 16) = x.r[q]; } }
__device__ __forceinline__ void fill_vt(LAS unsigned char* lds, const LAS unsigned char* rv, int tid) {
    const int dv = tid & 255, jh = tid >> 8;
    unsigned short v[32];
#pragma unroll
    for (int jj = 0; jj < 32; ++jj) v[jj] = *(const LAS bf16*)(rv + (32 * jh + jj) * 512 + dv * 2);
    LAS unsigned char* row = lds + L_VT + dv * 128; const int f = (dv >> 1) & 7;
#pragma unroll
    for (int q = 0; q < 4; ++q) { v4u w; w.x = v[8 * q] | ((unsigned)v[8 * q + 1] << 16); w.y = v[8 * q + 2] | ((unsigned)v[8 * q + 3] << 16); w.z = v[8 * q + 4] | ((unsigned)v[8 * q + 5] << 16); w.w = v[8 * q + 6] | ((unsigned)v[8 * q + 7] << 16);
        *(LAS v4u*)(row + (((4 * jh + q) ^ f) * 16)) = w; }
}
}

__device__ __forceinline__ void ph_gla_a(const Params& p, LAS unsigned char* lds, int u0, int ustride, int tid_in, int wave) {
    using namespace gla;
    int tid = tid_in; asm volatile("" : "+v"(tid));
    const int lane = tid & 63, c = lane & 15, gq = lane >> 4;
    const bf16* GK = (const bf16*)(p.ws + WS_GK); bf16* ST = (bf16*)(p.ws + WS_ST); float* DEC = (float*)(p.ws + WS_DEC);
    RawK rk; RawV rv;
    CumIn ci;
    if (u0 < 2048) { const int bh = u0 >> 6, ch = u0 & 63; rk = load_raw_k(GK, tid, (bh >> 2) * SEQ + ch * 64, bh & 3); rv = load_raw_v(p, tid, (bh >> 2) * SEQ + ch * 64, bh & 3); ci = load_cum(p, tid, (bh >> 2) * SEQ + ch * 64, bh & 3); }
    for (int unit = u0; unit < 2048; unit += ustride) {
        const int bh = unit >> 6, ch = unit & 63, b = bh >> 2, h = bh & 3, t0 = b * SEQ + ch * 64;
        store_raw_k(lds + 0, tid, rk); store_raw_v(lds + 16384, tid, rv);
        float P[16], blast; chunk_cumsum(ci, lds, tid, P, blast);
        { const int dk = tid & 127, jq = tid >> 7;
          unsigned short kv[16];
#pragma unroll
          for (int jj = 0; jj < 16; ++jj) kv[jj] = *(const LAS bf16*)(lds + (16 * jq + jj) * 256 + dk * 2);
          unsigned pk[8];
#pragma unroll
          for (int q = 0; q < 8; ++q) pk[q] = pk2(bf2f(kv[2 * q]) * __expf(blast - P[2 * q]), bf2f(kv[2 * q + 1]) * __expf(blast - P[2 * q + 1]));
          LAS unsigned char* row = lds + L_KT + dk * 128; const int f = (dk >> 1) & 7;
          *(LAS v4u*)(row + (((2 * jq) ^ f) * 16)) = (v4u){pk[0], pk[1], pk[2], pk[3]}; *(LAS v4u*)(row + (((2 * jq + 1) ^ f) * 16)) = (v4u){pk[4], pk[5], pk[6], pk[7]};
          if (jq == 0) DEC[unit * 128 + dk] = __expf(blast); }
        fill_vt(lds, lds + 16384, tid);
        __syncthreads();
        { const int un = unit + ustride < 2048 ? unit + ustride : unit, bhn = un >> 6, chn = un & 63; rk = load_raw_k(GK, tid, (bhn >> 2) * SEQ + chn * 64, bhn & 3); rv = load_raw_v(p, tid, (bhn >> 2) * SEQ + chn * 64, bhn & 3); ci = load_cum(p, tid, (bhn >> 2) * SEQ + chn * 64, bhn & 3); }
        f4 acc[16];
        const int f = (c >> 1) & 7;
        bf16x8 aF[2];
#pragma unroll
        for (int ks = 0; ks < 2; ++ks) aF[ks] = *(const LAS bf16x8*)(lds + L_KT + (16 * wave + c) * 128 + (((4 * ks + gq) ^ f) * 16));
#pragma unroll
        for (int nt = 0; nt < 16; ++nt) { acc[nt] = (f4){0.f, 0.f, 0.f, 0.f};
#pragma unroll
            for (int ks = 0; ks < 2; ++ks) { const bf16x8 bF = *(const LAS bf16x8*)(lds + L_VT + (16 * nt + c) * 128 + (((4 * ks + gq) ^ f) * 16)); acc[nt] = __builtin_amdgcn_mfma_f32_16x16x32_bf16(aF[ks], bF, acc[nt], 0, 0, 0); } }
        char* dst = (char*)ST + (size_t)unit * (256 * 128 * 2) + (unsigned)((c * 128 + 16 * wave + 4 * gq) * 2);
#pragma unroll
        for (int nt = 0; nt < 16; ++nt) *(v2u*)(dst + nt * 16 * 256) = (v2u){pg8::cvt_pk_bf16(acc[nt][0], acc[nt][1]), pg8::cvt_pk_bf16(acc[nt][2], acc[nt][3])};
        __syncthreads();
    }
}
__device__ __forceinline__ void ph_gla_b(const Params& p, int gid, int gstride) {
    bf16* ST = (bf16*)(p.ws + WS_ST); const float* DEC = (const float*)(p.ws + WS_DEC);
    for (int e = gid; e < 32 * 4096; e += gstride) { const int bh = e >> 12, dv = (e >> 4) & 255, d8 = e & 15;
        float st[8];
#pragma unroll
        for (int i = 0; i < 8; ++i) st[i] = 0.f;
        char* base = (char*)ST + (size_t)bh * 64 * (256 * 128 * 2) + (unsigned)((dv * 128 + d8 * 8) * 2); const float* dbase = DEC + (size_t)bh * 64 * 128 + d8 * 8;
#pragma unroll 4
        for (int ch = 0; ch < 64; ++ch) { v4u* ptr = (v4u*)(base + (size_t)ch * (256 * 128 * 2)); const v4u w = *ptr; const f32x4 d0 = *(const f32x4*)(dbase + ch * 128), d1 = *(const f32x4*)(dbase + ch * 128 + 4);
            v4u o; o.x = pk2(st[0], st[1]); o.y = pk2(st[2], st[3]); o.z = pk2(st[4], st[5]); o.w = pk2(st[6], st[7]); *ptr = o;
            st[0] = st[0] * d0.x + bflo(w.x); st[1] = st[1] * d0.y + bfhi(w.x); st[2] = st[2] * d0.z + bflo(w.y); st[3] = st[3] * d0.w + bfhi(w.y);
            st[4] = st[4] * d1.x + bflo(w.z); st[5] = st[5] * d1.y + bfhi(w.z); st[6] = st[6] * d1.z + bflo(w.w); st[7] = st[7] * d1.w + bfhi(w.w); }
    }
}
__device__ __forceinline__ void ph_gla_c(const Params& p, LAS unsigned char* lds, int u0, int ustride, int tid_in, int wave) {
    using namespace gla;
    int tid = tid_in; asm volatile("" : "+v"(tid));
    const int lane = tid & 63, c = lane & 15, gq = lane >> 4, nt = wave & 3, half = wave >> 2;
    const bf16* GQ = (const bf16*)(p.ws + WS_GQ); const bf16* GK = (const bf16*)(p.ws + WS_GK); const bf16* GG = (const bf16*)(p.ws + WS_GG); const bf16* ST = (const bf16*)(p.ws + WS_ST);
    bf16* A2 = (bf16*)(p.ws + WS_A2); const float* gn = p.in[I_GLAG];
    const int koff0 = c * 256 + ((gq ^ c) * 16), voff0 = c * 128 + (((gq >> 1) ^ ((c >> 1) & 7)) * 16) + (gq & 1) * 8;
    CumIn ci; RawK rq, rk; RawV rv;
    if (u0 < 2048) { const int bh = u0 >> 6, ch = u0 & 63, t0 = (bh >> 2) * SEQ + ch * 64; rq = load_raw_k(GQ, tid, t0, bh & 3); rk = load_raw_k(GK, tid, t0, bh & 3); rv = load_raw_v(p, tid, t0, bh & 3); ci = load_cum(p, tid, t0, bh & 3); }
    for (int unit = u0; unit < 2048; unit += ustride) {
        const int bh = unit >> 6, ch = unit & 63, b = bh >> 2, h = bh & 3, t0 = b * SEQ + ch * 64;
        store_raw_k(lds + 0, tid, rq); store_raw_k(lds + 16384, tid, rk); store_raw_v(lds + 32768, tid, rv);
        float P[16], blast; chunk_cumsum(ci, lds, tid, P, blast);
        { const int dk = tid & 127, jq = tid >> 7;
#pragma unroll
          for (int jj = 0; jj < 16; ++jj) { const int j = 16 * jq + jj; const float qv = bf2f(*(const LAS bf16*)(lds + j * 256 + dk * 2)), kv = bf2f(*(const LAS bf16*)(lds + 16384 + j * 256 + dk * 2));
              const int off = j * 256 + (((dk >> 3) ^ (j & 15)) * 16) + (dk & 7) * 2;
              *(LAS bf16*)(lds + L_QT + off) = (bf16)f2bf(qv * __expf(P[jj])); *(LAS bf16*)(lds + L_KT + off) = (bf16)f2bf(kv * __expf(-P[jj])); } }
        fill_vt(lds, lds + 32768, tid);
        __syncthreads();
        { const char* src = (const char*)ST + (size_t)unit * (256 * 128 * 2);
#pragma unroll
          for (int i = 0; i < 8; ++i) { const int piece = 8 * wave + i, row = piece * 4 + (lane >> 4), chunk = (lane & 15) ^ (row & 15);
              __builtin_amdgcn_global_load_lds((const unsigned*)(src + (unsigned)(row * 256 + chunk * 16)), (LAS unsigned*)(lds + L_ST + piece * 1024), 16, 0, 0); } }
        v2u ggr[8];
        { const int tokg = t0 + 16 * nt + c;
#pragma unroll
          for (int mt = 0; mt < 8; ++mt) ggr[mt] = *(const v2u*)((const char*)GG + (unsigned)((tokg * 1024 + h * 256 + 128 * half + 16 * mt + 4 * gq) * 2)); }
        asm volatile("s_waitcnt vmcnt(0)" ::: "memory"); __syncthreads();
        { const int un = unit + ustride < 2048 ? unit + ustride : unit, bhn = un >> 6, chn = un & 63, tn = (bhn >> 2) * SEQ + chn * 64; rq = load_raw_k(GQ, tid, tn, bhn & 3); rk = load_raw_k(GK, tid, tn, bhn & 3); rv = load_raw_v(p, tid, tn, bhn & 3); ci = load_cum(p, tid, tn, bhn & 3); }
        bf16x8 qF[4];
#pragma unroll
        for (int ks = 0; ks < 4; ++ks) qF[ks] = *(const LAS bf16x8*)(lds + L_QT + nt * 4096 + (koff0 ^ (ks * 64)));
        f4 sT[4];
#pragma unroll
        for (int jt = 0; jt < 4; ++jt) { sT[jt] = (f4){0.f, 0.f, 0.f, 0.f};
            if (jt <= nt) {
#pragma unroll
                for (int ks = 0; ks < 4; ++ks) { const bf16x8 a = *(const LAS bf16x8*)(lds + L_KT + jt * 4096 + (koff0 ^ (ks * 64))); sT[jt] = __builtin_amdgcn_mfma_f32_16x16x32_bf16(a, qF[ks], sT[jt], 0, 0, 0); }
                if (jt == nt) {
#pragma unroll
                    for (int rg = 0; rg < 4; ++rg) if (4 * gq + rg > c) sT[jt][rg] = 0.f; } } }
        bf16x8 pb[2];
#pragma unroll
        for (int s = 0; s < 2; ++s) { v4u w; w.x = pg8::cvt_pk_bf16(sT[2 * s][0], sT[2 * s][1]); w.y = pg8::cvt_pk_bf16(sT[2 * s][2], sT[2 * s][3]); w.z = pg8::cvt_pk_bf16(sT[2 * s + 1][0], sT[2 * s + 1][1]); w.w = pg8::cvt_pk_bf16(sT[2 * s + 1][2], sT[2 * s + 1][3]); pb[s] = __builtin_bit_cast(bf16x8, w); }
        f4 o[8]; float ss = 0.f;
#pragma unroll
        for (int mt = 0; mt < 8; ++mt) { o[mt] = (f4){0.f, 0.f, 0.f, 0.f}; const int rb = 128 * half + 16 * mt;
#pragma unroll
            for (int ks = 0; ks < 4; ++ks) { const bf16x8 a = *(const LAS bf16x8*)(lds + L_ST + rb * 256 + (koff0 ^ (ks * 64))); o[mt] = __builtin_amdgcn_mfma_f32_16x16x32_bf16(a, qF[ks], o[mt], 0, 0, 0); }
#pragma unroll
            for (int s = 0; s < 2; ++s) if (2 * s <= nt) { const v2u lo = *(const LAS v2u*)(lds + L_VT + rb * 128 + (voff0 ^ (s * 64))), hi = *(const LAS v2u*)(lds + L_VT + rb * 128 + (voff0 ^ (s * 64 + 32)));
                o[mt] = __builtin_amdgcn_mfma_f32_16x16x32_bf16(__builtin_bit_cast(bf16x8, (v4u){lo.x, lo.y, hi.x, hi.y}), pb[s], o[mt], 0, 0, 0); }
            ss += (o[mt][0] * o[mt][0] + o[mt][1] * o[mt][1]) + (o[mt][2] * o[mt][2] + o[mt][3] * o[mt][3]); }
        ss = nsa::radd32(nsa::radd16(ss));
        LAS float* red = (LAS float*)(lds + L_RED);
        if (gq == 0) red[half * 64 + 16 * nt + c] = ss;
        __syncthreads();
        const float rstd = 1.f / sqrtf((red[16 * nt + c] + red[64 + 16 * nt + c]) * (1.f / 256.f) + RMS_EPS);
        const int tok = t0 + 16 * nt + c;
#pragma unroll
        for (int mt = 0; mt < 8; ++mt) { const int dv = 128 * half + 16 * mt + 4 * gq; const f32x4 g4 = *(const f32x4*)((const char*)gn + (unsigned)(dv * 4));
            const v2u gg = ggr[mt];
            const float z0 = bflo(gg.x), z1 = bfhi(gg.x), z2 = bflo(gg.y), z3 = bfhi(gg.y);
            v2u w; w.x = pg8::cvt_pk_bf16(o[mt][0] * rstd * g4.x * (z0 * __builtin_amdgcn_rcpf(1.f + __expf(-z0))), o[mt][1] * rstd * g4.y * (z1 * __builtin_amdgcn_rcpf(1.f + __expf(-z1))));
            w.y = pg8::cvt_pk_bf16(o[mt][2] * rstd * g4.z * (z2 * __builtin_amdgcn_rcpf(1.f + __expf(-z2))), o[mt][3] * rstd * g4.w * (z3 * __builtin_amdgcn_rcpf(1.f + __expf(-z3))));
            *(v2u*)((char*)A2 + (unsigned)((tok * DM + h * 256 + dv) * 2)) = w; }
        __syncthreads();
    }
}

constexpr size_t WS_LH = WS_DEC + (size_t)2048 * 128 * 4;
constexpr size_t WS_PEV = WS_LH + (size_t)2 * 4096 * 256 * 4;
static_assert(WS_PEV + 1024 <= WS_KCMP, "cmp scratch overlay");
struct CmpOrder {
    int c; const bf16 *kc, *vc, *wk, *wv;
    __device__ __forceinline__ bool next(int i, pg8::Unit& u) const { if (i > 0 || c >= 32) return false; u.pm = c & 15; u.pn = 0; u.kind = c >> 4; return true; }
    __device__ __forceinline__ const char* pa(const pg8::Gemm&, const pg8::Unit& u) const { return (const char*)(u.kind ? vc : kc) + (size_t)u.pm * ((size_t)256 * 2048 * 2); }
    __device__ __forceinline__ const char* pb(const pg8::Gemm&, const pg8::Unit& u) const { return (const char*)(u.kind ? wv : wk); }
    __device__ __forceinline__ void a_ready(const pg8::Unit&) const {}
    __device__ __forceinline__ void done(const pg8::Unit&) const {}
};
struct EpiLH {
    static constexpr bool PERM = false, AFTER_DRAIN = false;
    float* LH;
    __device__ __forceinline__ void operator()(const pg8::f32x4 (&acc)[2][2][4][2], const pg8::Unit& u, int wr, int wc, int fr, int fq) const {
        const int row0 = u.kind * 4096 + u.pm * 256 + wr * 64 + fr, col0 = wc * 32 + 4 * fq;
#pragma unroll
        for (int ai = 0; ai < 2; ++ai)
#pragma unroll
            for (int m = 0; m < 4; ++m) { float* rowp = LH + (size_t)(row0 + ai * 128 + m * 16) * 256 + col0;
#pragma unroll
                for (int bj = 0; bj < 2; ++bj)
#pragma unroll
                    for (int n = 0; n < 2; ++n) *(pg8::f32x4*)(rowp + bj * 128 + n * 16) = acc[ai][bj][m][n]; }
    }
};

constexpr size_t PROWS = (size_t)MAXTILES * 256;
constexpr size_t WS_W1Q = WS_W1T;
constexpr size_t WS_W2Q = WS_W1Q + (size_t)NE * 4096 * DM;
constexpr size_t WS_HN8 = WS_W2Q + (size_t)NE * DM * DFF;
constexpr size_t WS_AMAXP = WS_HN8 + (size_t)T * DM;
constexpr size_t WS_WSC1 = WS_AMAXP + PROWS * 64 * 4;
constexpr size_t WS_WSC2 = WS_WSC1 + (size_t)NE * 4096 * 4;
constexpr size_t WS_HSC = WS_WSC2 + (size_t)NE * 2048 * 4;
constexpr size_t WS_ROWSC = WS_HSC + (size_t)T * 4;
constexpr size_t WS_ASC = WS_ROWSC + PROWS * 4;
static_assert(WS_ASC + PROWS * 4 <= WS_XN, "int8 buffers fit in the retired bf16 expert-weight region");
constexpr size_t WS_ROWTOK = WS_CTL + 512 * 1024;
static_assert(PROWS * 2 <= 512 * 1024 && DM == 2048, "row table fits; gathered rows are 2048 bytes");
constexpr size_t WS_H16 = WS_XG;
static_assert((size_t)T * DM * 2 <= PROWS * DM, "h fits below ACT8");
constexpr size_t WS_XG8 = WS_XG;
constexpr size_t WS_ACT8 = WS_XG + PROWS * DM;
constexpr size_t WS_Y = WS_ACT;
static_assert(WS_ACT8 + PROWS * DM <= WS_ACT, "int8 row buffers fit in the retired gathered-row region");

__device__ __forceinline__ unsigned q8x4(float a, float b, float c, float d) {
    const float M = 12582912.f; const unsigned ua = __builtin_bit_cast(unsigned, a + M), ub = __builtin_bit_cast(unsigned, b + M), uc = __builtin_bit_cast(unsigned, c + M), ud = __builtin_bit_cast(unsigned, d + M);
    return __builtin_amdgcn_perm(ub, ua, 0x0c0c0400u) | (__builtin_amdgcn_perm(ud, uc, 0x0c0c0400u) << 16); }
__device__ __forceinline__ unsigned rq4(unsigned w, float f) { const int s = (int)w;
    const float b0 = (float)((s << 24) >> 24), b1 = (float)((s << 16) >> 24), b2 = (float)((s << 8) >> 24), b3 = (float)(s >> 24); return q8x4(b0 * f, b1 * f, b2 * f, b3 * f); }
__device__ __forceinline__ float clamp127(float v) { return __builtin_amdgcn_fmed3f(v, -127.f, 127.f); }
__device__ __forceinline__ unsigned q8x4c(float a, float b, float c, float d) { return q8x4(clamp127(a), clamp127(b), clamp127(c), clamp127(d)); }

constexpr size_t WS_WINQ = WS_WINT;
constexpr size_t WS_WISC = WS_WINT + (size_t)NPT * 256 * DM;
constexpr size_t WS_XN8 = WS_XN;
constexpr size_t WS_XSC = WS_XN + (size_t)T * DM;
constexpr size_t WS_PMAX = WS_HN;
constexpr size_t WS_PMAXI = WS_PMAX + (size_t)64 * 8 * 4096 * 4;

constexpr size_t WS_WOQ = WS_WOT;
constexpr size_t WS_WOSC = WS_WOT + (size_t)DM * DM;
constexpr size_t WS_A2Q = WS_HN;
constexpr size_t WS_A2SC = WS_HN + (size_t)T * DM;
constexpr int NSLAB_E = NE * 192, NSLAB_I = NSLAB_E + 178, NSLAB = NSLAB_I + 64;
struct SlabSrc { const float* W; int N; bool ok; };
__device__ __forceinline__ SlabSrc slab_src(const Params& p, int sl, int r0, int n4) {
    SlabSrc s;
    if (sl < NSLAB_E) { const int e = sl / 192, r = sl % 192; const bool isw2 = r >= 128; const int nb = isw2 ? r - 128 : r; s.N = isw2 ? 2048 : 4096;
        s.W = (isw2 ? p.in[I_W2] + (size_t)e * DFF * DM : p.in[I_W1] + (size_t)e * DM * 4096) + (size_t)r0 * s.N + nb * 32 + 4 * n4; s.ok = true; }
    else if (sl < NSLAB_I) { const int nb = sl - NSLAB_E; s.N = 5672; s.ok = nb * 32 + 4 * n4 < 5672; s.W = p.in[I_WIN] + (size_t)r0 * 5672 + (s.ok ? nb * 32 + 4 * n4 : 0); }
    else { const int nb = sl - NSLAB_I; s.N = DM; s.ok = true; s.W = p.in[I_WOUT] + (size_t)r0 * DM + nb * 32 + 4 * n4; }
    return s;
}
__device__ __forceinline__ void p0_slab_quant(const Params& p, LAS unsigned char* lds, int bid, int G, int tid) {
    constexpr int RS = 4104;
    LAS unsigned char* TT = lds; LAS float* part = (LAS float*)(lds + 32 * RS); LAS float* inv = part + 64 * 32; LAS int* drow = (LAS int*)(inv + 32);
    signed char* W1Q = (signed char*)(p.ws + WS_W1Q); signed char* W2Q = (signed char*)(p.ws + WS_W2Q); signed char* WIQ = (signed char*)(p.ws + WS_WINQ);
    float* WSC1 = (float*)(p.ws + WS_WSC1); float* WSC2 = (float*)(p.ws + WS_WSC2); float* WISC = (float*)(p.ws + WS_WISC);
    const int n4 = tid & 7, r0 = tid >> 3;
    f32x4 va[8], vb[8];
#define SLAB_ISSUE(dst, sl, j) do { if ((sl) < NSLAB) { const SlabSrc ss_ = slab_src(p, (sl), 2 * r0, n4); _Pragma("unroll") for (int u = 0; u < 8; ++u) dst[u] = __builtin_nontemporal_load((const f32x4*)(ss_.W + (size_t)(128 * (4 * (j) + (u >> 1)) + (u & 1)) * ss_.N)); } } while (0)
#define SLAB_USE(src, j) do { _Pragma("unroll") for (int u2 = 0; u2 < 4; ++u2) { const f32x4 xa = src[2 * u2], xb = src[2 * u2 + 1]; const int k = 2 * r0 + 128 * (4 * (j) + u2);        \
            const unsigned w0 = cvt2bf(xa.x, xb.x), w1 = cvt2bf(xa.y, xb.y), w2 = cvt2bf(xa.z, xb.z), w3 = cvt2bf(xa.w, xb.w);        \
            mx0 = __builtin_elementwise_max(mx0, __builtin_bit_cast(u16x2, w0 & 0x7fff7fffu)); mx1 = __builtin_elementwise_max(mx1, __builtin_bit_cast(u16x2, w1 & 0x7fff7fffu)); \
            mx2 = __builtin_elementwise_max(mx2, __builtin_bit_cast(u16x2, w2 & 0x7fff7fffu)); mx3 = __builtin_elementwise_max(mx3, __builtin_bit_cast(u16x2, w3 & 0x7fff7fffu)); \
            LAS unsigned char* d = TT + (4 * n4) * RS + k * 2; \
            *(LAS unsigned*)d = w0; *(LAS unsigned*)(d + RS) = w1; *(LAS unsigned*)(d + 2 * RS) = w2; *(LAS unsigned*)(d + 3 * RS) = w3; } } while (0)
    SLAB_ISSUE(va, bid, 0); SLAB_ISSUE(vb, bid, 1);
    for (int slab = bid; slab < NSLAB; slab += G) {
        u16x2 mx0 = (u16x2){0, 0}, mx1 = (u16x2){0, 0}, mx2 = (u16x2){0, 0}, mx3 = (u16x2){0, 0};
        SLAB_USE(va, 0); SLAB_ISSUE(va, slab, 2);
        SLAB_USE(vb, 1); SLAB_ISSUE(vb, slab, 3);
        SLAB_USE(va, 2); SLAB_ISSUE(va, slab + G, 0);
        SLAB_USE(vb, 3); SLAB_ISSUE(vb, slab + G, 1);
        { u16x2 t0, t1; { const unsigned m0 = __builtin_bit_cast(unsigned, mx0), m1 = __builtin_bit_cast(unsigned, mx1), m2 = __builtin_bit_cast(unsigned, mx2), m3 = __builtin_bit_cast(unsigned, mx3);
            t0 = __builtin_elementwise_max(__builtin_bit_cast(u16x2, __builtin_amdgcn_perm(m1, m0, 0x05040100u)), __builtin_bit_cast(u16x2, __builtin_amdgcn_perm(m1, m0, 0x07060302u)));
            t1 = __builtin_elementwise_max(__builtin_bit_cast(u16x2, __builtin_amdgcn_perm(m3, m2, 0x05040100u)), __builtin_bit_cast(u16x2, __builtin_amdgcn_perm(m3, m2, 0x07060302u))); }
#pragma unroll
          for (int o = 8; o < 64; o <<= 1) { t0 = __builtin_elementwise_max(t0, __builtin_bit_cast(u16x2, __shfl_xor(__builtin_bit_cast(int, t0), o))); t1 = __builtin_elementwise_max(t1, __builtin_bit_cast(u16x2, __shfl_xor(__builtin_bit_cast(int, t1), o))); }
          const unsigned a0 = __builtin_bit_cast(unsigned, t0), a1 = __builtin_bit_cast(unsigned, t1);
          if ((tid & 63) < 8) *(LAS f32x4*)(part + (tid >> 6) * 32 + 4 * n4) = (f32x4){bflo(a0), bfhi(a0), bflo(a1), bfhi(a1)}; }
        __syncthreads();
        if (tid < 32) { float m = 0.f;
#pragma unroll
            for (int q = 0; q < 8; ++q) m = fmaxf(m, part[q * 32 + tid]);
            const float sc = m > 0.f ? m * (1.f / 127.f) : 1.f; inv[tid] = 1.f / sc;
            if (slab < NSLAB_E) { const int e = slab / 192, r = slab % 192; const bool isw2 = r >= 128; const int n = (isw2 ? r - 128 : r) * 32 + tid;
                if (isw2) { drow[tid] = e * 2048 + n; WSC2[e * 2048 + n] = sc; }
                else { const int j2 = n & 2047, row = (j2 >> 7) * 256 + (n >= 2048 ? 128 : 0) + (j2 & 127); drow[tid] = e * 4096 + row; WSC1[e * 4096 + row] = sc; } }
            else if (slab < NSLAB_I) { const int n = (slab - NSLAB_E) * 32 + tid; if (n < 5672) { float qsc; const int row = win_row(n, qsc); drow[tid] = row; WISC[row] = sc * qsc; } else drow[tid] = -1; }
            else { const int n = (slab - NSLAB_I) * 32 + tid; drow[tid] = n; ((float*)(p.ws + WS_WOSC))[n] = sc; } }
        __syncthreads();
        { const int kc = tid & 7, n = (tid >> 3) & 31, hf = tid >> 8; const float iv = inv[n]; const int dr = drow[n];
          signed char* dst = (slab < NSLAB_E ? ((slab % 192) >= 128 ? W2Q : W1Q) : slab < NSLAB_I ? WIQ : (signed char*)(p.ws + WS_WOQ)) + (size_t)(dr < 0 ? 0 : dr) * 2048; const LAS unsigned char* src = TT + n * RS;
          if (dr >= 0) {
#pragma unroll
          for (int m8 = 0; m8 < 8; ++m8) { const int k0 = 16 * (kc + 8 * (hf + 2 * m8)); const LAS v2u* sp = (const LAS v2u*)(src + k0 * 2); const v2u a = sp[0], b = sp[1], c = sp[2], d = sp[3]; v4u o;
              o.x = q8x4(bflo(a.x) * iv, bfhi(a.x) * iv, bflo(a.y) * iv, bfhi(a.y) * iv); o.y = q8x4(bflo(b.x) * iv, bfhi(b.x) * iv, bflo(b.y) * iv, bfhi(b.y) * iv);
              o.z = q8x4(bflo(c.x) * iv, bfhi(c.x) * iv, bflo(c.y) * iv, bfhi(c.y) * iv); o.w = q8x4(bflo(d.x) * iv, bfhi(d.x) * iv, bflo(d.y) * iv, bfhi(d.y) * iv);
              *(v4u*)(dst + k0) = o; } } }
        __syncthreads();
    }
#undef SLAB_ISSUE
#undef SLAB_USE
}
struct EpiSwigluI8 {
    static constexpr bool PERM = true, AFTER_DRAIN = false;
    const float* b1; const float* rowsc; const float* wsc1; signed char* act8; float* amaxp;
    __device__ __forceinline__ void operator()(const pg8::f32x4 (&acc)[2][2][4][2], const pg8::Unit& u, int wr, int wc, int fr, int fq) const {
        typedef float f2 __attribute__((ext_vector_type(2)));
        const int e = u.kind; const int cin = wc * 32 + 8 * fq; const int col = u.pn * 128 + cin; const int row0 = u.pm * 256 + wr * 64 + fr;
        const float* bg = b1 + (size_t)e * 4096 + col; const float* bl = bg + 2048; const float* sg = wsc1 + (size_t)e * 4096 + u.pn * 256 + cin; const float* sl = sg + 128;
        f2 gb[4], lb[4], gs[4], ls[4];
#pragma unroll
        for (int k = 0; k < 4; ++k) { gb[k] = *(const f2*)(bg + 2 * k); lb[k] = *(const f2*)(bl + 2 * k); gs[k] = *(const f2*)(sg + 2 * k); ls[k] = *(const f2*)(sl + 2 * k); }
#pragma unroll
        for (int ai = 0; ai < 2; ++ai)
#pragma unroll
            for (int m = 0; m < 4; ++m) { const int r = row0 + ai * 128 + m * 16; const float rs = rowsc[r]; const f2 rs2 = (f2){rs, rs}; f2 o[4]; float mx = 0.f;
#pragma unroll
                for (int k = 0; k < 4; ++k) { const int n = k >> 1, j = (k & 1) * 2;
                    const f2 ag = (f2){(float)__float_as_int(acc[ai][0][m][n][j]), (float)__float_as_int(acc[ai][0][m][n][j + 1])}, al = (f2){(float)__float_as_int(acc[ai][1][m][n][j]), (float)__float_as_int(acc[ai][1][m][n][j + 1])};
                    f2 gl = __builtin_elementwise_fma(ag, rs2 * gs[k], gb[k]), li = __builtin_elementwise_fma(al, rs2 * ls[k], lb[k]);
                    gl.x = fminf(gl.x, 7.f); gl.y = fminf(gl.y, 7.f); li.x = __builtin_amdgcn_fmed3f(li.x, -7.f, 7.f); li.y = __builtin_amdgcn_fmed3f(li.y, -7.f, 7.f);
                    const f2 ea = gl * (f2){-2.4554669595930156f, -2.4554669595930156f};
                    const f2 den = (f2){__builtin_amdgcn_exp2f(ea.x), __builtin_amdgcn_exp2f(ea.y)} + (f2){1.f, 1.f};
                    const f2 v = (gl * (f2){__builtin_amdgcn_rcpf(den.x), __builtin_amdgcn_rcpf(den.y)}) * (li + (f2){1.f, 1.f});
                    o[k] = v; mx = fmaxf(mx, fmaxf(fabsf(v.x), fabsf(v.y))); }
                mx = nsa::rmax32(nsa::rmax16(mx));
                if (fq == 0) amaxp[(size_t)r * 64 + u.pn * 4 + wc] = mx;
                const float iq = mx > 0.f ? 127.f * __builtin_amdgcn_rcpf(mx) : 0.f; const f2 iq2 = (f2){iq, iq}; v2u w;
                { const f2 q0 = o[0] * iq2, q1 = o[1] * iq2, q2 = o[2] * iq2, q3 = o[3] * iq2; w.x = q8x4(q0.x, q0.y, q1.x, q1.y); w.y = q8x4(q2.x, q2.y, q3.x, q3.y); }
                *(v2u*)(act8 + (size_t)r * DFF + col) = w; }
    }
};
__device__ __forceinline__ void ph_a2q(const Params& p, int gw, int NGW, int lane) {
    const bf16* A2 = (const bf16*)(p.ws + WS_A2); signed char* Q = (signed char*)(p.ws + WS_A2Q); float* SC = (float*)(p.ws + WS_A2SC);
    for (int rb = gw; rb < T; rb += 2 * NGW) { const int r0 = rb, r1 = rb + NGW < T ? rb + NGW : rb;
        const v4u* s0 = (const v4u*)(A2 + (size_t)r0 * DM) + lane; const v4u* s1 = (const v4u*)(A2 + (size_t)r1 * DM) + lane; v4u a[2][4];
#pragma unroll
        for (int q = 0; q < 4; ++q) { a[0][q] = s0[64 * q]; a[1][q] = s1[64 * q]; }
#pragma unroll
        for (int rr = 0; rr < 2; ++rr) { const int r = rr ? r1 : r0; float mx = 0.f;
#pragma unroll
            for (int q = 0; q < 4; ++q) { const v4u x = a[rr][q]; mx = fmaxf(mx, fmaxf(fmaxf(fmaxf(fabsf(bflo(x.x)), fabsf(bfhi(x.x))), fmaxf(fabsf(bflo(x.y)), fabsf(bfhi(x.y)))), fmaxf(fmaxf(fabsf(bflo(x.z)), fabsf(bfhi(x.z))), fmaxf(fabsf(bflo(x.w)), fabsf(bfhi(x.w)))))); }
            mx = wave_max(mx); const float sc = mx > 0.f ? mx * (1.f / 127.f) : 1.f, iv = mx > 0.f ? 127.f * __builtin_amdgcn_rcpf(mx) : 0.f;
            v2u* dst = (v2u*)(Q + (size_t)r * DM) + lane;
#pragma unroll
            for (int q = 0; q < 4; ++q) { const v4u x = a[rr][q]; v2u o; o.x = q8x4(bflo(x.x) * iv, bfhi(x.x) * iv, bflo(x.y) * iv, bfhi(x.y) * iv); o.y = q8x4(bflo(x.z) * iv, bfhi(x.z) * iv, bflo(x.w) * iv, bfhi(x.w) * iv); dst[64 * q] = o; }
            if (lane == 0) SC[r] = sc; } }
}
struct EpiResI8 {
    static constexpr bool PERM = true, AFTER_DRAIN = false;
    const float* x; bf16* h; const float* rsc; const float* csc;
    __device__ __forceinline__ void operator()(const pg8::f32x4 (&acc)[2][2][4][2], const pg8::Unit& u, int wr, int wc, int fr, int fq) const {
        typedef float f2 __attribute__((ext_vector_type(2)));
        const int row0 = u.pm * 256 + wr * 64 + fr, col0 = u.pn * 256 + wc * 32 + 8 * fq;
        f2 cs[2][4];
#pragma unroll
        for (int bj = 0; bj < 2; ++bj)
#pragma unroll
            for (int k = 0; k < 4; ++k) cs[bj][k] = *(const f2*)(csc + col0 + bj * 128 + 2 * k);
#pragma unroll
        for (int ai = 0; ai < 2; ++ai)
#pragma unroll
            for (int m = 0; m < 4; ++m) { const int r = row0 + ai * 128 + m * 16; const size_t off = (size_t)r * DM + col0; const float rs = rsc[r]; const f2 rs2 = (f2){rs, rs};
#pragma unroll
                for (int bj = 0; bj < 2; ++bj) { const pg8::f32x4 x0 = *(const pg8::f32x4*)(x + off + bj * 128), x1 = *(const pg8::f32x4*)(x + off + bj * 128 + 4); f2 o[4];
#pragma unroll
                    for (int k = 0; k < 4; ++k) { const int n = k >> 1, j = (k & 1) * 2; const f2 xv = n ? (f2){x1[j], x1[j + 1]} : (f2){x0[j], x0[j + 1]};
                        o[k] = __builtin_elementwise_fma((f2){(float)__float_as_int(acc[ai][bj][m][n][j]), (float)__float_as_int(acc[ai][bj][m][n][j + 1])}, rs2 * cs[bj][k], xv); }
                    pg8::u32x4 w; w.x = pg8::cvt_pk_bf16(o[0].x, o[0].y); w.y = pg8::cvt_pk_bf16(o[1].x, o[1].y); w.z = pg8::cvt_pk_bf16(o[2].x, o[2].y); w.w = pg8::cvt_pk_bf16(o[3].x, o[3].y);
                    *(pg8::u32x4*)(h + off + bj * 128) = w; } }
    }
};
__device__ __forceinline__ void ph_actq(const Params& p, int gw, int NGW, int lane) {
    const int nrows = ((const int*)(p.ws + WS_META))[0] * 256; const float* amaxp = (const float*)(p.ws + WS_AMAXP);
    signed char* A8 = (signed char*)(p.ws + WS_ACT8); float* ASC = (float*)(p.ws + WS_ASC);
    for (int rb = gw; rb < nrows; rb += 2 * NGW) {
        const int r0 = rb, r1 = rb + NGW; const bool h1 = r1 < nrows; const int r1c = h1 ? r1 : r0;
        const float g0 = amaxp[(size_t)r0 * 64 + lane], g1 = amaxp[(size_t)r1c * 64 + lane];
        v4u* s0 = (v4u*)(A8 + (size_t)r0 * DFF) + lane * 2; v4u* s1 = (v4u*)(A8 + (size_t)r1c * DFF) + lane * 2;
        const v4u a00 = s0[0], a01 = s0[1], a10 = s1[0], a11 = s1[1];
        const float m0 = wave_max(g0), m1 = wave_max(g1);
        { const float f = m0 > 0.f ? g0 * __builtin_amdgcn_rcpf(m0) : 0.f;
          v4u o0, o1; o0.x = rq4(a00.x, f); o0.y = rq4(a00.y, f); o0.z = rq4(a00.z, f); o0.w = rq4(a00.w, f); o1.x = rq4(a01.x, f); o1.y = rq4(a01.y, f); o1.z = rq4(a01.z, f); o1.w = rq4(a01.w, f);
          s0[0] = o0; s0[1] = o1; if (lane == 0) ASC[r0] = m0 > 0.f ? m0 * (1.f / 127.f) : 1.f; }
        if (h1) { const float f = m1 > 0.f ? g1 * __builtin_amdgcn_rcpf(m1) : 0.f;
          v4u o0, o1; o0.x = rq4(a10.x, f); o0.y = rq4(a10.y, f); o0.z = rq4(a10.z, f); o0.w = rq4(a10.w, f); o1.x = rq4(a11.x, f); o1.y = rq4(a11.y, f); o1.z = rq4(a11.z, f); o1.w = rq4(a11.w, f);
          s1[0] = o0; s1[1] = o1; if (lane == 0) ASC[r1] = m1 > 0.f ? m1 * (1.f / 127.f) : 1.f; } }
}
struct EpiDownI8 {
    static constexpr bool PERM = true, AFTER_DRAIN = false;
    const float* b2; const float* roww; const float* asc; const float* wsc2; bf16* y;
    __device__ __forceinline__ void operator()(const pg8::f32x4 (&acc)[2][2][4][2], const pg8::Unit& u, int wr, int wc, int fr, int fq) const {
        const int e = u.kind; const int col0 = u.pn * 256 + wc * 32 + 8 * fq; const int row0 = u.pm * 256 + wr * 64 + fr;
        typedef float f2 __attribute__((ext_vector_type(2)));
        f2 bv[2][4], sv[2][4];
#pragma unroll
        for (int bj = 0; bj < 2; ++bj)
#pragma unroll
            for (int k = 0; k < 4; ++k) { bv[bj][k] = *(const f2*)(b2 + (size_t)e * DM + col0 + bj * 128 + 2 * k); sv[bj][k] = *(const f2*)(wsc2 + (size_t)e * DM + col0 + bj * 128 + 2 * k); }
#pragma unroll
        for (int ai = 0; ai < 2; ++ai)
#pragma unroll
            for (int m = 0; m < 4; ++m) { const int r = row0 + ai * 128 + m * 16; const float g = roww[r], as = asc[r]; const f2 g2 = (f2){g, g}, as2 = (f2){as, as};
#pragma unroll
                for (int bj = 0; bj < 2; ++bj) { f2 o[4];
#pragma unroll
                    for (int k = 0; k < 4; ++k) { const int n = k >> 1, j = (k & 1) * 2; const f2 a2 = (f2){(float)__float_as_int(acc[ai][bj][m][n][j]), (float)__float_as_int(acc[ai][bj][m][n][j + 1])};
                        o[k] = __builtin_elementwise_fma(a2, as2 * sv[bj][k], bv[bj][k]) * g2; }
                    pg8::u32x4 w; w.x = pg8::cvt_pk_bf16(o[0].x, o[0].y); w.y = pg8::cvt_pk_bf16(o[1].x, o[1].y); w.z = pg8::cvt_pk_bf16(o[2].x, o[2].y); w.w = pg8::cvt_pk_bf16(o[3].x, o[3].y);
                    *(pg8::u32x4*)(y + (size_t)r * DM + col0 + bj * 128) = w; } }
    }
};

struct EpiProjI8 {
    static constexpr bool PERM = true, AFTER_DRAIN = false;
    unsigned char* ws;
    __device__ __forceinline__ void operator()(const pg8::f32x4 (&acc)[2][2][4][2], const pg8::Unit& u, int wr, int wc, int fr, int fq) const {
        const int cw = wc * 32 + 8 * fq; const float* XSC = (const float*)(ws + WS_XSC); const float* WISC = (const float*)(ws + WS_WISC);
        if (u.kind == 0) {
            const int tn = u.pn; bf16* base; size_t bjs = 128; int ld = 0; bool headmajor = false; bool small = false;
            if (tn < 2) { base = (bf16*)(ws + WS_GQ) + tn * 256; ld = 512; }
            else if (tn < 4) { base = (bf16*)(ws + WS_GK) + (tn - 2) * 256; ld = 512; }
            else if (tn < 8) { base = (bf16*)(ws + WS_GV) + (tn - 4) * 256; ld = 1024; }
            else if (tn < 12) { base = (bf16*)(ws + WS_GG) + (tn - 8) * 256; ld = 1024; }
            else if (tn < 16) { base = (bf16*)(ws + WS_NQ) + (tn - 12) * 256; ld = 1024; }
            else if (tn < 20) { base = (bf16*)(ws + (tn == 16 ? WS_KC : tn == 17 ? WS_VC : tn == 18 ? WS_KS : WS_KW)); headmajor = true; bjs = (size_t)SEQ * 128; }
            else { base = (bf16*)(ws + WS_SM); ld = 64; small = true; }
            if (small && wc >= 2) return;
            typedef float f2 __attribute__((ext_vector_type(2)));
            f2 cs[2][4];
#pragma unroll
            for (int bj = 0; bj < 2; ++bj)
#pragma unroll
                for (int k = 0; k < 4; ++k) cs[bj][k] = *(const f2*)(WISC + tn * 256 + bj * 128 + cw + 2 * k);
#pragma unroll
            for (int ai = 0; ai < 2; ++ai)
#pragma unroll
                for (int m = 0; m < 4; ++m) { const int r = u.pm * 256 + ai * 128 + wr * 64 + m * 16 + fr; const float rs = XSC[r];
                    const size_t rterm = headmajor ? ((size_t)(r >> 12) * 2 * SEQ + (r & (SEQ - 1))) * 128 : (size_t)r * ld;
#pragma unroll
                    for (int bj = 0; bj < 2; ++bj) { if (small && bj) continue; f2 o[4]; const f2 rs2 = (f2){rs, rs};
#pragma unroll
                        for (int k = 0; k < 4; ++k) { const int n = k >> 1, j = (k & 1) * 2; o[k] = (f2){(float)__float_as_int(acc[ai][bj][m][n][j]), (float)__float_as_int(acc[ai][bj][m][n][j + 1])} * (rs2 * cs[bj][k]); }
                        pg8::u32x4 w; w.x = pg8::cvt_pk_bf16(o[0].x, o[0].y); w.y = pg8::cvt_pk_bf16(o[1].x, o[1].y); w.z = pg8::cvt_pk_bf16(o[2].x, o[2].y); w.w = pg8::cvt_pk_bf16(o[3].x, o[3].y);
                        *(pg8::u32x4*)(base + rterm + bj * bjs + cw) = w; } }
        } else {
            bf16* base = (bf16*)(ws + (u.pn == 21 ? WS_VST : WS_VWT));
#pragma unroll
            for (int ai = 0; ai < 2; ++ai)
#pragma unroll
                for (int m = 0; m < 4; ++m) { const int dh = wr * 64 + m * 16 + fr; const float ws_ = WISC[u.pn * 256 + ai * 128 + dh];
#pragma unroll
                    for (int bj = 0; bj < 2; ++bj) { const int tok = u.pm * 256 + bj * 128 + cw; const int b = tok >> 12, s = tok & (SEQ - 1); float o[8];
                        const pg8::f32x4 x0 = *(const pg8::f32x4*)(XSC + tok), x1 = *(const pg8::f32x4*)(XSC + tok + 4);
#pragma unroll
                        for (int j = 0; j < 4; ++j) { o[j] = (float)__float_as_int(acc[ai][bj][m][0][j]) * (ws_ * x0[j]); o[4 + j] = (float)__float_as_int(acc[ai][bj][m][1][j]) * (ws_ * x1[j]); }
                        pg8::u32x4 w; w.x = pg8::cvt_pk_bf16(o[0], o[1]); w.y = pg8::cvt_pk_bf16(o[2], o[3]); w.z = pg8::cvt_pk_bf16(o[4], o[5]); w.w = pg8::cvt_pk_bf16(o[6], o[7]);
                        *(pg8::u32x4*)(base + ((size_t)(b * 2 + ai) * 128 + dh) * SEQ + s) = w; } }
        }
    }
};

__device__ __forceinline__ void r1_router(const Params& p, LAS unsigned char* lds, int vb, int tid, int wave, int lane) {
    LAS float* rowbuf = (LAS float*)lds;
    LAS float* part = (LAS float*)(lds + 65536);
    LAS int* tk = (LAS int*)(lds + 81920 + wave * 1024);
    LAS int* cntw = (LAS int*)(lds + 90112);
    const bf16* h = (const bf16*)(p.ws + WS_H16); const float* gf = p.in[I_NFFN]; const float* rw = p.in[I_RW]; const float* rb = p.in[I_RB];
    signed char* HN8 = (signed char*)(p.ws + WS_HN8);
    const int e = lane & 31, eg = tid & 31, dg = tid >> 5; int mycount = 0;
    float rwr[128];
#pragma unroll
    for (int c4 = 0; c4 < 4; ++c4) { unsigned o = (unsigned)((((dg * 128 + c4 * 32) * 32) + eg) * 4); asm volatile("" : "+v"(o));
#pragma unroll
        for (int i = 0; i < 32; ++i) rwr[c4 * 32 + i] = *(const float*)((const char*)rw + o + i * 128); }
    v4u hw[4];
    { const v4u* xr = (const v4u*)(h + (size_t)(vb * TPV + wave) * DM) + lane;
#pragma unroll
      for (int q = 0; q < 4; ++q) hw[q] = xr[64 * q]; }
    for (int grp = 0; grp < 16; ++grp) { const int t = vb * TPV + grp * 8 + wave;
        { float s = 0.f;
#pragma unroll
          for (int q = 0; q < 4; ++q) { const float a0 = bflo(hw[q].x), a1 = bfhi(hw[q].x), a2 = bflo(hw[q].y), a3 = bfhi(hw[q].y), a4 = bflo(hw[q].z), a5 = bfhi(hw[q].z), a6 = bflo(hw[q].w), a7 = bfhi(hw[q].w);
              s += ((a0 * a0 + a1 * a1) + (a2 * a2 + a3 * a3)) + ((a4 * a4 + a5 * a5) + (a6 * a6 + a7 * a7)); }
          const float rstd = 1.f / sqrtf(wave_sum(s) * (1.f / DM) + RMS_EPS);
          float mxr = 0.f; LAS f32x4* hrow = (LAS f32x4*)(rowbuf + wave * 2048);
#pragma unroll
          for (int j = 0; j < 8; ++j) { const int cj = 2 * lane + 128 * (j >> 1) + (j & 1); const f32x4 g4 = ((const f32x4*)gf)[cj]; const unsigned wa = (j & 1) ? hw[j >> 1].z : hw[j >> 1].x, wb = (j & 1) ? hw[j >> 1].w : hw[j >> 1].y;
              f32x4 y; y.x = bflo(wa) * rstd * g4.x; y.y = bfhi(wa) * rstd * g4.y; y.z = bflo(wb) * rstd * g4.z; y.w = bfhi(wb) * rstd * g4.w;
              hrow[cj] = y; mxr = fmaxf(mxr, fmaxf(fmaxf(fabsf(y.x), fabsf(y.y)), fmaxf(fabsf(y.z), fabsf(y.w)))); }
          mxr = wave_max(mxr); const float qs = mxr > 0.f ? mxr * (1.f / 127.f) : 1.f, qi = 1.f / qs;
          v2u* o8 = (v2u*)(HN8 + (size_t)t * DM) + lane;
#pragma unroll
          for (int q = 0; q < 4; ++q) { const f32x4 ya = hrow[2 * lane + 128 * q], yb = hrow[2 * lane + 128 * q + 1]; v2u o;
              o.x = q8x4(ya.x * qi, ya.y * qi, ya.z * qi, ya.w * qi); o.y = q8x4(yb.x * qi, yb.y * qi, yb.z * qi, yb.w * qi); o8[64 * q] = o; }
          if (lane == 0) ((float*)(p.ws + WS_HSC))[t] = qs; }
        __syncthreads();
        { const int tn = vb * TPV + (grp < 15 ? grp + 1 : grp) * 8 + wave; const v4u* xr = (const v4u*)(h + (size_t)tn * DM) + lane;
#pragma unroll
          for (int q = 0; q < 4; ++q) hw[q] = xr[64 * q]; }
        { float acc[8];
#pragma unroll
          for (int tt = 0; tt < 8; ++tt) acc[tt] = 0.f;
#pragma unroll
          for (int i4 = 0; i4 < 32; ++i4) { f32x4 xv[8];
#pragma unroll
              for (int tt = 0; tt < 8; ++tt) xv[tt] = *(const LAS f32x4*)(rowbuf + tt * 2048 + dg * 128 + 4 * i4);
#pragma unroll
              for (int tt = 0; tt < 8; ++tt) acc[tt] += xv[tt].x * rwr[4 * i4] + xv[tt].y * rwr[4 * i4 + 1] + xv[tt].z * rwr[4 * i4 + 2] + xv[tt].w * rwr[4 * i4 + 3];
              if (i4 & 1) asm volatile("" ::: "memory"); }
#pragma unroll
          for (int tt = 0; tt < 8; ++tt) part[(dg * 8 + tt) * 32 + eg] = acc[tt]; }
        __syncthreads();
        { float a = rb[e];
#pragma unroll
          for (int q = 0; q < 16; ++q) a += part[(q * 8 + wave) * 32 + e];
          int rank = 0;
#pragma unroll
          for (int mm = 0; mm < 32; ++mm) { const float lm = __shfl(a, mm); rank += (lm > a || (lm == a && mm < e)) ? 1 : 0; }
          const float mx = wave_max(a); const bool sel = rank < 4;
          const float ex = (sel && lane < 32) ? __expf(a - mx) : 0.f; const float sum = wave_sum(ex);
          if (sel && lane < 32) { LAS int* q = tk + (grp * 4 + rank) * 4; q[0] = e; q[1] = mycount; q[2] = __builtin_bit_cast(int, ex / sum); ++mycount; } }
        __syncthreads();
    }
    int ln; asm volatile("v_mbcnt_lo_u32_b32 %0, -1, 0\n\tv_mbcnt_hi_u32_b32 %0, -1, %0" : "=v"(ln));
    if (ln < 32) cntw[wave * 32 + ln] = mycount;
    __syncthreads();
    if (wave == 0 && ln < 32) { int tot = 0; for (int w = 0; w < 8; ++w) tot += cntw[w * 32 + ln]; ((int*)(p.ws + WS_CNT))[vb * 32 + ln] = tot; }
    { const int i = ln >> 2, k = ln & 3; const LAS int* q = tk + (i * 4 + k) * 4; const int ee = q[0]; int base = 0; for (int w = 0; w < wave; ++w) base += cntw[w * 32 + ee];
      const int t = vb * TPV + i * 8 + wave;
      ((int*)(p.ws + WS_EIDX))[t * 4 + k] = ee; ((int*)(p.ws + WS_LRNK))[t * 4 + k] = base + q[1]; ((int*)(p.ws + WS_GATE))[t * 4 + k] = q[2]; }
    __syncthreads();
}
__device__ __forceinline__ void r2_gather(const Params& p, LAS unsigned char* lds, int vb, bool write_meta, int tid, int wave, int lane) {
    LAS int* part_tot = (LAS int*)lds;
    LAS int* part_base = part_tot + 512;
    LAS int* pbase = part_base + 512;
    const int* CNT = (const int*)(p.ws + WS_CNT);
    { const int e = tid & 31, part = tid >> 5; int tot = 0, bs = 0;
      for (int v = part * 16; v < part * 16 + 16; ++v) { const int c = CNT[v * 32 + e]; tot += c; if (v < vb) bs += c; }
      part_tot[part * 32 + e] = tot; part_base[part * 32 + e] = bs; }
    __syncthreads();
    if (tid == 0) { int ps = 0; int* meta = (int*)(p.ws + WS_META); int nt = 0;
        for (int e = 0; e < 32; ++e) { int tot = 0, bs = 0; for (int q = 0; q < 16; ++q) { tot += part_tot[q * 32 + e]; bs += part_base[q * 32 + e]; }
            pbase[e] = ps + bs; const int ntile = (tot + 255) >> 8;
            if (write_meta) for (int q = 0; q < ntile; ++q) meta[64 + nt + q] = e;
            nt += ntile; ps += ntile * 256; }
        if (write_meta) meta[0] = nt; }
    __syncthreads();
    const float* HSC = (const float*)(p.ws + WS_HSC); float* ROWSC = (float*)(p.ws + WS_ROWSC);
    const int* EIDX = (const int*)(p.ws + WS_EIDX); const int* LRNK = (const int*)(p.ws + WS_LRNK); const float* GATE = (const float*)(p.ws + WS_GATE);
    int* POS = (int*)(p.ws + WS_POS); float* ROWW = (float*)(p.ws + WS_ROWW);
    unsigned short* RT = (unsigned short*)(p.ws + WS_ROWTOK);
    { const int t = vb * TPV + (tid >> 2), k = tid & 3;
      const int pos = pbase[EIDX[t * 4 + k]] + LRNK[t * 4 + k];
      POS[t * 4 + k] = pos; ROWW[pos] = GATE[t * 4 + k]; ROWSC[pos] = HSC[t]; RT[(pos & ~255) + (pos & 63) * 4 + ((pos >> 6) & 3)] = (unsigned short)t; }
    __syncthreads();
}
__device__ __forceinline__ void pf_final(const Params& p, int gw, int NGW, int lane) {
    const bf16* Y = (const bf16*)(p.ws + WS_Y); const int* POS = (const int*)(p.ws + WS_POS); const float* gfin = p.in[I_NFIN]; const bf16* H = (const bf16*)(p.ws + WS_H16);
    for (int t = gw; t < T; t += NGW) {
        f32x4 v[8]; const v4u* hr = (const v4u*)(H + (size_t)t * DM) + lane;
#pragma unroll
        for (int q = 0; q < 4; ++q) { const v4u w = hr[64 * q]; v[2 * q] = (f32x4){bflo(w.x), bfhi(w.x), bflo(w.y), bfhi(w.y)}; v[2 * q + 1] = (f32x4){bflo(w.z), bfhi(w.z), bflo(w.w), bfhi(w.w)}; }
#pragma unroll
        for (int k = 0; k < 4; ++k) { const int pos = POS[t * 4 + k]; const v4u* yr = (const v4u*)(Y + (size_t)pos * DM) + lane;
#pragma unroll
            for (int q = 0; q < 4; ++q) { const v4u w = yr[64 * q]; v[2 * q].x += bflo(w.x); v[2 * q].y += bfhi(w.x); v[2 * q].z += bflo(w.y); v[2 * q].w += bfhi(w.y);
                v[2 * q + 1].x += bflo(w.z); v[2 * q + 1].y += bfhi(w.z); v[2 * q + 1].z += bflo(w.w); v[2 * q + 1].w += bfhi(w.w); } }
        float s = 0.f;
#pragma unroll
        for (int j = 0; j < 8; ++j) s += (v[j].x * v[j].x + v[j].y * v[j].y) + (v[j].z * v[j].z + v[j].w * v[j].w);
        const float rstd = 1.f / sqrtf(wave_sum(s) * (1.f / DM) + RMS_EPS); f32x4* xr = (f32x4*)(p.out + (size_t)t * DM);
#pragma unroll
        for (int j = 0; j < 8; ++j) { const int cj = 2 * lane + 128 * (j >> 1) + (j & 1); const f32x4 g4 = ((const f32x4*)gfin)[cj]; f32x4 o; o.x = v[j].x * rstd * g4.x; o.y = v[j].y * rstd * g4.y; o.z = v[j].z * rstd * g4.z; o.w = v[j].w * rstd * g4.w; xr[cj] = o; }
    }
}


constexpr int LDS_BYTES = 159744;
constexpr int MISC_OFF = LDS_BYTES - 256;  static_assert(nsa::LDS_END <= MISC_OFF && gla::L_END <= MISC_OFF, "LDS map");
constexpr int CW_BAR = 4096, CW_XL = 16384;
__global__ __launch_bounds__(512, 2) void mega_fwd(Params p) {
    extern __shared__ __attribute__((aligned(16))) unsigned char lds_raw[];
    LAS unsigned char* lds = (LAS unsigned char*)lds_raw;
    const int G = gridDim.x, bid = blockIdx.x, NGW = G * 8;
#define PH_IDS int tid = threadIdx.x; asm volatile("" : "+v"(tid)); const int lane = tid & 63, wave = __builtin_amdgcn_readfirstlane(tid >> 6), gw = bid * 8 + wave; (void)lane; (void)gw;
    for (int u = threadIdx.x; u < 64; u += 512) ((LAS unsigned*)(lds + MISC_OFF))[u] = 0u;
    __syncthreads();
    XcdBarrier bar = xcd_barrier_post((unsigned*)(p.ws + WS_CTL) + CW_BAR, (volatile LAS unsigned*)(lds + MISC_OFF) + 8);
    { PH_IDS; p0_prologue(p, lds, gw, NGW, wave, lane); __syncthreads(); p0_slab_quant(p, lds, bid, G, tid); }
    xcd_barrier(bar);
    { pg8::Gemm g{(const bf16*)(p.ws + WS_XN8), (const bf16*)(p.ws + WS_WINQ), T, NPT * 256, DM / 2};
      ProjOrder S; S.init(T, NPT * 256, G, bid); S.xn = g.A; S.wt = g.Bt; EpiProjI8 E{p.ws};
      pg8::gemm_phase<EpiProjI8, ProjOrder, true, true, true>(lds, g, S, E); }
    xcd_barrier(bar);
    if (bid < 32) {
        pg8::Gemm g{(const bf16*)(p.ws + WS_KC), (const bf16*)(p.ws + WS_WKCT), 4096, 256, 2048};
        CmpOrder S{bid, (const bf16*)(p.ws + WS_KC), (const bf16*)(p.ws + WS_VC), (const bf16*)(p.ws + WS_WKCT), (const bf16*)(p.ws + WS_WVCT)}; EpiLH E{(float*)(p.ws + WS_LH)};
        pg8::gemm_phase<EpiLH, CmpOrder, true, true>(lds, g, S, E);
    } else { PH_IDS; ph_gla_a(p, lds, bid - 32, G - 32, tid, wave); }
    xcd_barrier(bar);
    { PH_IDS; ph_gla_b(p, bid * 512 + tid, G * 512);
      for (int i = bid * 512 + tid; i < 16 * 128; i += G * 512) { const int bgz = i >> 7, dz = i & 127; ((bf16*)(p.ws + WS_KCMP))[((size_t)bgz * 256 + 255) * 128 + dz] = 0; ((bf16*)(p.ws + WS_VCMPT))[((size_t)bgz * 128 + dz) * 256 + 255] = 0; }
      ph_cmp_fin(p, lds, bid, G, tid, (const float*)(p.ws + WS_LH), (const float*)(p.ws + WS_PEVP)); }
    xcd_barrier(bar);
    { PH_IDS; ph_nsa(p, lds, bid, G, tid, wave); }
    { PH_IDS; __syncthreads(); ph_gla_c(p, lds, bid, G, tid, wave); }
    xcd_barrier(bar);
    { PH_IDS; ph_a2q(p, gw, NGW, lane); }
    xcd_barrier(bar);
    { pg8::Gemm g{(const bf16*)(p.ws + WS_A2Q), (const bf16*)(p.ws + WS_WOQ), T, DM, DM / 2};
      pg8::StaticOrder S; S.init(T, DM, G, bid); EpiResI8 E{p.in[I_X], (bf16*)(p.ws + WS_H16), (const float*)(p.ws + WS_A2SC), (const float*)(p.ws + WS_WOSC)};
      pg8::gemm_phase<EpiResI8, pg8::StaticOrder, true, true, true>(lds, g, S, E); }
    xcd_barrier(bar);
    { PH_IDS; for (int vb = bid; vb < NVB; vb += G) r1_router(p, lds, vb, tid, wave, lane); }
    xcd_barrier(bar);
    { PH_IDS; for (int vb = bid; vb < NVB; vb += G) r2_gather(p, lds, vb, vb == 0, tid, wave, lane); }
    xcd_barrier(bar);
    { pg8::Gemm g{(const bf16*)(p.ws + WS_HN8), (const bf16*)(p.ws + WS_W1Q), MAXTILES * 256, 4096, DM / 2};
      MoeOrderG S; S.init((const int*)(p.ws + WS_META), 16, G, bid); S.rowtab = (const unsigned short*)(p.ws + WS_ROWTOK); EpiSwigluI8 E{p.in[I_B1], (const float*)(p.ws + WS_ROWSC), (const float*)(p.ws + WS_WSC1), (signed char*)(p.ws + WS_ACT8), (float*)(p.ws + WS_AMAXP)};
      pg8::gemm_phase<EpiSwigluI8, MoeOrderG, true, true, true, true>(lds, g, S, E); }
    xcd_barrier(bar);
    { PH_IDS; ph_actq(p, gw, NGW, lane); }
    xcd_barrier(bar);
    { pg8::Gemm g{(const bf16*)(p.ws + WS_ACT8), (const bf16*)(p.ws + WS_W2Q), MAXTILES * 256, DM, DFF / 2};
      MoeOrder S; S.init((const int*)(p.ws + WS_META), 8, G, bid); EpiDownI8 E{p.in[I_B2], (const float*)(p.ws + WS_ROWW), (const float*)(p.ws + WS_ASC), (const float*)(p.ws + WS_WSC2), (bf16*)(p.ws + WS_Y)};
      pg8::gemm_phase<EpiDownI8, MoeOrder, true, true, true>(lds, g, S, E); }
    xcd_barrier(bar);
    { PH_IDS; pf_final(p, gw, NGW, lane); }
}

extern "C" void kernel_launch(void* const* d_in, const int* in_sizes, int n_in, void* d_out, int out_size, void* d_ws, size_t ws_size, hipStream_t stream) {
    static int grid = 0;
    if (grid == 0) {
        if (n_in != N_IN || out_size != T * DM || ws_size < WS_END) { fprintf(stderr, "kernel_launch: unexpected shapes (n_in %d out %d ws %zu need %zu)\n", n_in, out_size, ws_size, (size_t)WS_END); grid = -1; return; }
        int dev = 0, cus = 0, per_cu = 0;
        if (hipGetDevice(&dev) != hipSuccess || hipDeviceGetAttribute(&cus, hipDeviceAttributeMultiprocessorCount, dev) != hipSuccess) { grid = -1; return; }
        if (hipFuncSetAttribute((const void*)mega_fwd, hipFuncAttributeMaxDynamicSharedMemorySize, LDS_BYTES) != hipSuccess) { fprintf(stderr, "kernel_launch: hipFuncSetAttribute failed\n"); grid = -1; return; }
        if (hipOccupancyMaxActiveBlocksPerMultiprocessor(&per_cu, (const void*)mega_fwd, 512, LDS_BYTES) != hipSuccess || per_cu < 1) { fprintf(stderr, "kernel_launch: occupancy query says %d blocks per CU\n", per_cu); }
        (void)hipGetLastError();
        grid = cus;
    }
    if (grid < 0) return;
    if (hipMemsetAsync((char*)d_ws + WS_CTL, 0, CTL_BYTES, stream) != hipSuccess) return;
    Params p{};
    for (int i = 0; i < N_IN; ++i) p.in[i] = (const float*)d_in[i];
    p.out = (float*)d_out; p.ws = (unsigned char*)d_ws;
    hipLaunchKernelGGL(mega_fwd, dim3(grid), dim3(512), LDS_BYTES, stream, p);
}
```

```cpp
#include <hip/hip_runtime.h>
#include <cstdio>
#include <cstdint>
namespace pg8 {
#define PG8_LAS __attribute__((address_space(3)))
typedef unsigned short bf16_t;
typedef short bf16x8 __attribute__((ext_vector_type(8)));
typedef float f32x4 __attribute__((ext_vector_type(4)));
typedef unsigned u32x4 __attribute__((ext_vector_type(4)));
typedef unsigned v2u_t __attribute__((ext_vector_type(2)));
constexpr int BM = 256, BK = 64, HALF = 128, HTB = HALF * BK * 2  , STAGE_BYTES = 8 * HTB, NXCD = 8, WGM = 8;

__host__ __device__ __forceinline__ int lds_byte(int r, int c) { const int st = (r >> 4) * 2 + (c >> 5), rr = r & 15, cc = c & 31, ob = rr * 64 + cc * 2; return st * 1024 + (ob ^ (((ob >> 9) & 1) << 5)); }
__host__ __device__ __forceinline__ void stage_rc(int b, int& R, int& C) { const int st = b / 1024, sb = b % 1024, swz = sb ^ (((sb >> 9) & 1) << 5); R = (st >> 1) * 16 + swz / 64; C = (st & 1) * 32 + (swz % 64) / 2; }
__host__ __device__ __forceinline__ int perm32(int rho) { const int n = rho >> 4, i = rho & 15; return 8 * (i >> 2) + 4 * n + (i & 3); }

struct Unit { int pm, pn, kind; };
struct Gemm { const bf16_t* A; const bf16_t* Bt; int M, N, K; };

template <int WG = WGM> __host__ __device__ __forceinline__ void tile_of(int wgid, int nM, int nN, int& pm, int& pn) {
    const int nwg = nM * nN;
    { const int q = nwg / NXCD, r = nwg % NXCD, xcd = wgid % NXCD, off = wgid / NXCD; wgid = (xcd < r ? xcd * (q + 1) : r * (q + 1) + (xcd - r) * q) + off; }
    const int nig = WG * nN, gid = wgid / nig, fm = gid * WG, gsz = (nM - fm) < WG ? (nM - fm) : WG;
    pm = fm + ((wgid % nig) % gsz); pn = (wgid % nig) / gsz;
}
struct StaticOrder {
    int nM, nN, nwg, G, c;
    __host__ __device__ void init(int M, int N, int G_, int c_) { nM = M / BM; nN = N / BM; nwg = nM * nN; G = G_; c = c_; }
    __device__ __forceinline__ bool next(int i, Unit& u) const {
        const long L = (long)i * G + c; if (L >= nwg) return false;
        tile_of((int)L, nM, nN, u.pm, u.pn); u.kind = 0; return true;
    }
    __device__ __forceinline__ const char* pa(const Gemm& g, const Unit& u) const { return (const char*)g.A + (size_t)u.pm * ((size_t)BM * g.K * 2); }
    __device__ __forceinline__ const char* pb(const Gemm& g, const Unit& u) const { return (const char*)g.Bt + (size_t)u.pn * ((size_t)BM * g.K * 2); }
    __device__ __forceinline__ void a_ready(const Unit&) const {}
    __device__ __forceinline__ void done(const Unit&) const {}
};
__device__ __forceinline__ unsigned cvt_pk_bf16(float lo, float hi) { unsigned r; asm volatile("v_cvt_pk_bf16_f32 %0, %1, %2" : "=v"(r) : "v"(lo), "v"(hi)); return r; }
template <bool I8> __device__ __forceinline__ f32x4 mma16(bf16x8 a, bf16x8 b, f32x4 c) {
    if constexpr (I8) { typedef int i32x4 __attribute__((ext_vector_type(4)));
        return __builtin_bit_cast(f32x4, __builtin_amdgcn_mfma_i32_16x16x64_i8(__builtin_bit_cast(i32x4, a), __builtin_bit_cast(i32x4, b), __builtin_bit_cast(i32x4, c), 0, 0, 0)); }
    else return __builtin_amdgcn_mfma_f32_16x16x32_bf16(a, b, c, 0, 0, 0);
}
template <class Epi, class Sched, bool ALIGN_EPI = false, bool SP2 = false, bool I8 = false, bool GATHER = false>
__device__ __forceinline__ void gemm_phase(PG8_LAS unsigned char* lds, const Gemm g, const Sched& S, const Epi& E) {
    int tid_l = threadIdx.x; asm volatile("" : "+v"(tid_l));
    const int tid = tid_l, wid = __builtin_amdgcn_readfirstlane(tid >> 6), lane = tid & 63, wr = wid >> 2, wc = wid & 3, fr = lane & 15, fq = lane >> 4;
    const int K = g.K, nt = K / BK;
    unsigned voffA[2], voffB[2];
#pragma unroll
    for (int i = 0; i < 2; ++i) { int R, C; stage_rc(tid * 16 + i * 8192, R, C); const int Rb = Epi::PERM ? ((R & ~31) + perm32(R & 31)) : R;
        voffA[i] = (unsigned)(R * K + C) * 2u; voffB[i] = (unsigned)(Rb * K + C) * 2u; }
    const size_t kstep = (size_t)(BK * 2);
    const size_t hstep = (size_t)HALF * K * 2;
    const unsigned ldsw = (unsigned)wid * 1024u;
    const int aoff = lds_byte(wr * 64 + fr, fq * 8), boff = lds_byte(wc * 32 + fr, fq * 8);
#define PG8_SA(b, h) (((b) * 2 + (h)) * HTB)
#define PG8_SB(b, h) ((4 + (b) * 2 + (h)) * HTB)
#define PG8_STAGE(bufoff, gbase, voff) do { _Pragma("unroll") for (int _i = 0; _i < 2; ++_i) \
        __builtin_amdgcn_global_load_lds((const unsigned*)((const char*)(gbase) + (voff)[_i]), (PG8_LAS unsigned*)(lds + (bufoff) + ldsw + _i * 8192), 16, 0, 0); } while (0)
#define PG8_STAGE_A(bufoff, ptr, h) do { if constexpr (GATHER) PG8_STAGE(bufoff, ptr, cuo + 2 * (h)); else PG8_STAGE(bufoff, (ptr) + (h) * hstep, voffA); } while (0)
#define PG8_LDA(dst, b, h) do { _Pragma("unroll") for (int m = 0; m < 4; ++m) _Pragma("unroll") for (int k = 0; k < 2; ++k) dst[m][k] = *(const PG8_LAS bf16x8*)(lds + PG8_SA(b, h) + aoff + m * 2048 + k * 1024); } while (0)
#define PG8_LDB(dst, b, h) do { _Pragma("unroll") for (int n = 0; n < 2; ++n) _Pragma("unroll") for (int k = 0; k < 2; ++k) dst[n][k] = *(const PG8_LAS bf16x8*)(lds + PG8_SB(b, h) + boff + n * 2048 + k * 1024); } while (0)
#define PG8_MMA(ai, bj, At, Bt) do { __builtin_amdgcn_s_setprio(1); _Pragma("unroll") for (int m = 0; m < 4; ++m) _Pragma("unroll") for (int n = 0; n < 2; ++n) _Pragma("unroll") for (int k = 0; k < 2; ++k) \
        acc[ai][bj][m][n] = mma16<I8>(Bt[n][k], At[m][k], acc[ai][bj][m][n]); __builtin_amdgcn_s_setprio(0); } while (0)
#define PG8_WAIT_V(n) asm volatile("s_waitcnt vmcnt(" #n ")" ::: "memory")
#define PG8_WAIT_L(n) asm volatile("s_waitcnt lgkmcnt(" #n ")" ::: "memory")
#define PG8_BAR __builtin_amdgcn_s_barrier()
#define PG8_SCHED __builtin_amdgcn_sched_barrier(0)
    Unit cur, nxt; int ui = 0;
    if (!S.next(0, cur)) return;
    unsigned cuo[4] = {0u, 0u, 0u, 0u}, cb0 = 0u; v2u_t raw = {0u, 0u};
    if constexpr (GATHER) { int R0, C0; stage_rc(tid * 16, R0, C0); cb0 = (unsigned)C0 * 2u; unsigned ro = (unsigned)R0 * 8u; asm volatile("" : "+v"(ro));
        Unit u1; const bool h1 = S.next(1, u1); const v2u_t r0 = *(const v2u_t*)((const char*)S.rowtab + (size_t)cur.pm * 512 + ro); raw = *(const v2u_t*)((const char*)S.rowtab + (size_t)(h1 ? u1.pm : cur.pm) * 512 + ro);
        cuo[0] = ((r0.x & 0xffffu) << 11) + cb0; cuo[1] = ((r0.x >> 16) << 11) + cb0; cuo[2] = ((r0.y & 0xffffu) << 11) + cb0; cuo[3] = ((r0.y >> 16) << 11) + cb0; }
    f32x4 acc[2][2][4][2];
#pragma unroll
    for (int a = 0; a < 2; ++a)
#pragma unroll
        for (int b = 0; b < 2; ++b)
#pragma unroll
            for (int m = 0; m < 4; ++m)
#pragma unroll
                for (int n = 0; n < 2; ++n) acc[a][b][m][n] = (f32x4){0.f, 0.f, 0.f, 0.f};
    bf16x8 At[4][2], B0[2][2], B1[2][2];
    const char* cA = S.pa(g, cur); const char* cB = S.pb(g, cur);
    S.a_ready(cur);
    if constexpr (SP2) {
        PG8_STAGE(PG8_SB(0, 0), cB, voffB); PG8_STAGE(PG8_SB(0, 1), cB + hstep, voffB); PG8_STAGE_A(PG8_SA(0, 0), cA, 0); PG8_STAGE_A(PG8_SA(0, 1), cA, 1);
        if (wr == 1) PG8_BAR;
        PG8_WAIT_V(2); PG8_BAR;
        PG8_STAGE(PG8_SB(1, 0), cB + kstep, voffB); PG8_STAGE_A(PG8_SA(1, 0), cA + kstep, 0); PG8_STAGE(PG8_SB(1, 1), cB + hstep + kstep, voffB);
        PG8_WAIT_V(6); PG8_BAR;
    } else {
        PG8_STAGE(PG8_SB(0, 0), cB, voffB); PG8_STAGE(PG8_SA(0, 0), cA, voffA); PG8_STAGE(PG8_SB(0, 1), cB + hstep, voffB); PG8_STAGE(PG8_SA(0, 1), cA + hstep, voffA);
        if (wr == 1) PG8_BAR;
        PG8_WAIT_V(4); PG8_BAR;
        PG8_STAGE(PG8_SB(1, 0), cB + kstep, voffB); PG8_STAGE(PG8_SA(1, 0), cA + kstep, voffA); PG8_STAGE(PG8_SB(1, 1), cB + hstep + kstep, voffB);
        PG8_WAIT_V(6); PG8_BAR;
    }
    for (;;) {
        const bool has_next = S.next(ui + 1, nxt);
        const char* nA = has_next ? S.pa(g, nxt) : cA; const char* nB = has_next ? S.pb(g, nxt) : cB;
        for (int t = 0; t < nt; t += 2) {
            const bool last = (t == nt - 2);
            const char* a1 = cA + (size_t)(t + 1) * kstep;
            const char* a2 = last ? nA : cA + (size_t)(t + 2) * kstep; const char* b2 = last ? nB : cB + (size_t)(t + 2) * kstep;
            const char* a3 = a2 + kstep; const char* b3 = b2 + kstep;
            if (last && has_next) S.a_ready(nxt);
            if constexpr (SP2) {
            PG8_LDB(B0, 0, 0); PG8_LDB(B1, 0, 1); PG8_SCHED; PG8_LDA(At, 0, 0); PG8_STAGE_A(PG8_SA(1, 1), a1, 1);
            if constexpr (GATHER) { unsigned rx = raw.x, ry = raw.y; asm volatile("" : "+v"(rx), "+v"(ry));
                const unsigned n0 = ((rx & 0xffffu) << 11) + cb0, n1 = ((rx >> 16) << 11) + cb0, n2 = ((ry & 0xffffu) << 11) + cb0, n3 = ((ry >> 16) << 11) + cb0;
                cuo[0] = last ? n0 : cuo[0]; cuo[1] = last ? n1 : cuo[1]; cuo[2] = last ? n2 : cuo[2]; cuo[3] = last ? n3 : cuo[3]; }
            PG8_WAIT_V(8); PG8_WAIT_L(0); PG8_BAR; PG8_MMA(0, 0, At, B0); PG8_MMA(0, 1, At, B1); PG8_BAR; PG8_SCHED;
            PG8_LDA(At, 0, 1); PG8_STAGE(PG8_SB(0, 0), b2, voffB); PG8_STAGE(PG8_SB(0, 1), b2 + hstep, voffB); PG8_STAGE_A(PG8_SA(0, 0), a2, 0);
            PG8_WAIT_V(8); PG8_WAIT_L(0); PG8_BAR; PG8_MMA(1, 0, At, B0); PG8_MMA(1, 1, At, B1); PG8_BAR; PG8_SCHED;
            PG8_LDB(B0, 1, 0); PG8_LDB(B1, 1, 1); PG8_SCHED; PG8_LDA(At, 1, 0); PG8_STAGE_A(PG8_SA(0, 1), a2, 1);
            PG8_WAIT_V(8); PG8_WAIT_L(0); PG8_BAR; PG8_MMA(0, 0, At, B0); PG8_MMA(0, 1, At, B1); PG8_BAR; PG8_SCHED;
            PG8_LDA(At, 1, 1); PG8_STAGE(PG8_SB(1, 0), b3, voffB); PG8_STAGE(PG8_SB(1, 1), b3 + hstep, voffB); PG8_STAGE_A(PG8_SA(1, 0), a3, 0);
            PG8_WAIT_V(8); PG8_WAIT_L(0); PG8_BAR; PG8_MMA(1, 0, At, B0); PG8_MMA(1, 1, At, B1); PG8_BAR; PG8_SCHED;
            } else {
            PG8_LDB(B0, 0, 0); PG8_SCHED; PG8_LDA(At, 0, 0); PG8_STAGE(PG8_SA(1, 1), a1 + hstep, voffA);
            PG8_WAIT_L(8); PG8_BAR; PG8_WAIT_L(0); PG8_MMA(0, 0, At, B0); PG8_BAR; PG8_SCHED;
            PG8_LDB(B1, 0, 1); PG8_STAGE(PG8_SB(0, 0), b2, voffB);
            PG8_BAR; PG8_WAIT_L(0); PG8_MMA(0, 1, At, B1); PG8_BAR;
            PG8_LDA(At, 0, 1); PG8_STAGE(PG8_SA(0, 0), a2, voffA);
            PG8_BAR; PG8_WAIT_L(0); PG8_MMA(1, 0, At, B0); PG8_BAR; PG8_SCHED;
            PG8_STAGE(PG8_SB(0, 1), b2 + hstep, voffB);
            PG8_WAIT_V(6); PG8_BAR; PG8_MMA(1, 1, At, B1); PG8_BAR;
            PG8_LDB(B0, 1, 0); PG8_SCHED; PG8_LDA(At, 1, 0); PG8_STAGE(PG8_SA(0, 1), a2 + hstep, voffA);
            PG8_WAIT_L(8); PG8_BAR; PG8_WAIT_L(0); PG8_MMA(0, 0, At, B0); PG8_BAR; PG8_SCHED;
            PG8_LDB(B1, 1, 1); PG8_STAGE(PG8_SB(1, 0), b3, voffB);
            PG8_BAR; PG8_WAIT_L(0); PG8_MMA(0, 1, At, B1); PG8_BAR;
            PG8_LDA(At, 1, 1); PG8_STAGE(PG8_SA(1, 0), a3, voffA);
            PG8_BAR; PG8_WAIT_L(0); PG8_MMA(1, 0, At, B0); PG8_BAR; PG8_SCHED;
            PG8_STAGE(PG8_SB(1, 1), b3 + hstep, voffB);
            PG8_WAIT_V(6); PG8_BAR; PG8_MMA(1, 1, At, B1); PG8_BAR;
            }
        }
        if constexpr (ALIGN_EPI) { if (wr == 0) PG8_BAR; }
        if constexpr (GATHER) { static_assert(SP2 && !Epi::AFTER_DRAIN, "GATHER is written for the SP2 loop"); int R0, C0; stage_rc(tid * 16, R0, C0); Unit u2; const bool h2 = S.next(ui + 2, u2);
            unsigned ro = (unsigned)R0 * 8u; asm volatile("" : "+v"(ro)); raw = *(const v2u_t*)((const char*)S.rowtab + (size_t)(h2 ? u2.pm : cur.pm) * 512 + ro); PG8_SCHED; }
        if constexpr (!Epi::AFTER_DRAIN) { E(acc, cur, wr, wc, fr, fq); S.done(cur); }
        if (!has_next) break;
#pragma unroll
        for (int a = 0; a < 2; ++a)
#pragma unroll
            for (int b = 0; b < 2; ++b)
#pragma unroll
                for (int m = 0; m < 4; ++m)
#pragma unroll
                    for (int n = 0; n < 2; ++n) acc[a][b][m][n] = (f32x4){0.f, 0.f, 0.f, 0.f};
        cur = nxt; cA = nA; cB = nB; ++ui;
        if constexpr (ALIGN_EPI) { if (wr == 1) PG8_BAR; }
    }
    PG8_WAIT_V(0);
    if constexpr (!ALIGN_EPI) { if (wr == 0) PG8_BAR; }
    PG8_BAR;
    if constexpr (Epi::AFTER_DRAIN) { E.fused(acc, cur, wr, wc, fr, fq, lds, wid, lane); S.done(cur); }
#undef PG8_SA
#undef PG8_SB
#undef PG8_STAGE
#undef PG8_STAGE_A
#undef PG8_LDA
#undef PG8_LDB
#undef PG8_MMA
#undef PG8_WAIT_V
#undef PG8_WAIT_L
#undef PG8_BAR
#undef PG8_SCHED
}
}

#define GAS __attribute__((address_space(1)))
#define LAS __attribute__((address_space(3)))
typedef unsigned short bf16;
typedef unsigned v4u __attribute__((ext_vector_type(4)));
typedef unsigned v2u __attribute__((ext_vector_type(2)));
typedef float f32x4 __attribute__((ext_vector_type(4)));
typedef short bf16x8 __attribute__((ext_vector_type(8)));

constexpr int NB = 8, SEQ = 4096, DM = 2048, T = NB * SEQ;
constexpr int NPT = 23;
constexpr int NE = 32, DFF = 2048;
constexpr int MAXTILES = 544;
constexpr float RMS_EPS = 1e-5f;
constexpr int NVB = 256, TPV = T / NVB;

enum { I_X = 0, I_NMIX, I_WIN, I_WA2, I_BA, I_GLAG, I_PEK, I_WK1, I_WK2, I_PEV, I_WV1, I_WV2, I_NSAG, I_RELB, I_WOUT, I_NFFN, I_RW, I_RB, I_W1, I_B1, I_W2, I_B2, I_NFIN, N_IN };

constexpr size_t MiB = 1u << 20;
constexpr size_t al(size_t x) { return (x + 255) & ~(size_t)255; }
constexpr size_t WS_CTL = 0, CTL_BYTES = 1 * MiB;
constexpr size_t WS_CNT = WS_CTL + CTL_BYTES;
constexpr size_t WS_META = WS_CNT + al(NVB * 32 * 4);
constexpr size_t WS_EIDX = WS_META + al((64 + MAXTILES) * 4);
constexpr size_t WS_LRNK = WS_EIDX + al((size_t)T * 4 * 4);
constexpr size_t WS_GATE = WS_LRNK + al((size_t)T * 4 * 4);
constexpr size_t WS_POS = WS_GATE + al((size_t)T * 4 * 4);
constexpr size_t WS_ROWW = WS_POS + al((size_t)T * 4 * 4);
constexpr size_t WS_WINT = al(WS_ROWW + (size_t)MAXTILES * 256 * 4);
constexpr size_t WS_WOT = WS_WINT + (size_t)NPT * 256 * DM * 2;
constexpr size_t WS_WKCT = WS_WOT + (size_t)DM * DM * 2;
constexpr size_t WS_WVCT = WS_WKCT + (size_t)256 * 2048 * 2;
constexpr size_t WS_W1T = WS_WVCT + (size_t)256 * 2048 * 2;
constexpr size_t WS_W2T = WS_W1T + (size_t)NE * 4096 * DM * 2;
constexpr size_t WS_XN = WS_W2T + (size_t)NE * DM * DFF * 2;
constexpr size_t WS_GQ = WS_XN + (size_t)T * DM * 2;
constexpr size_t WS_GK = WS_GQ + (size_t)T * 512 * 2;
constexpr size_t WS_GV = WS_GK + (size_t)T * 512 * 2;
constexpr size_t WS_GG = WS_GV + (size_t)T * 1024 * 2;
constexpr size_t WS_NQ = WS_GG + (size_t)T * 1024 * 2;
constexpr size_t WS_KC = WS_NQ + (size_t)T * 1024 * 2;
constexpr size_t WS_VC = WS_KC + (size_t)T * 256 * 2;
constexpr size_t WS_KS = WS_VC + (size_t)T * 256 * 2;
constexpr size_t WS_KW = WS_KS + (size_t)T * 256 * 2;
constexpr size_t WS_VST = WS_KW + (size_t)T * 256 * 2;
constexpr size_t WS_VWT = WS_VST + (size_t)T * 256 * 2;
constexpr size_t WS_SM = WS_VWT + (size_t)T * 256 * 2;
constexpr size_t WS_LA = WS_SM + (size_t)T * 64 * 2;
constexpr size_t WS_OG = WS_LA + (size_t)T * 512 * 4;
constexpr size_t WS_ON = WS_OG + (size_t)T * 1024 * 4;
constexpr size_t WS_KCMP = WS_ON + (size_t)T * 1024 * 4;
constexpr size_t WS_VCMPT = WS_KCMP + (size_t)16 * 256 * 128 * 2;
constexpr size_t WS_A2 = WS_VCMPT + (size_t)16 * 256 * 128 * 2;
constexpr size_t WS_HN = WS_A2 + (size_t)T * DM * 2;
constexpr size_t WS_XG = WS_HN + (size_t)T * DM * 2;
constexpr size_t WS_ACT = WS_XG + (size_t)MAXTILES * 256 * DM * 2;
constexpr size_t WS_END = WS_ACT + (size_t)MAXTILES * 256 * DFF * 2;

typedef unsigned short u16x2 __attribute__((ext_vector_type(2)));
__device__ __forceinline__ unsigned cvt2bf(float lo, float hi) { unsigned r; asm("v_cvt_pk_bf16_f32 %0, %1, %2" : "=v"(r) : "v"(lo), "v"(hi)); return r; }
__device__ __forceinline__ unsigned f2bf(float f) { return cvt2bf(f, f) & 0xffffu; }
__device__ __forceinline__ unsigned pk2(float lo, float hi) { return cvt2bf(lo, hi); }
__device__ __forceinline__ float bf2f(unsigned short v) { return __builtin_bit_cast(float, (unsigned)v << 16); }
__device__ __forceinline__ float bflo(unsigned w) { return __builtin_bit_cast(float, w << 16); }
__device__ __forceinline__ float bfhi(unsigned w) { return __builtin_bit_cast(float, w & 0xffff0000u); }
__device__ __forceinline__ float wave_sum(float v) {
#pragma unroll
    for (int o = 1; o < 64; o <<= 1) v += __shfl_xor(v, o);
    return v;
}
__device__ __forceinline__ float wave_max(float v) {
#pragma unroll
    for (int o = 1; o < 64; o <<= 1) v = fmaxf(v, __shfl_xor(v, o));
    return v;
}
__device__ __forceinline__ int vt_pos(int k) { return (k & ~63) | ((k & 32) + ((k >> 2) & 3) * 8 + ((k >> 4) & 1) * 4 + (k & 3)); }
#define LDS_WAIT() asm volatile("s_waitcnt lgkmcnt(0)" ::: "memory")

__device__ const unsigned char kBucket[128] = {0, 1, 2, 3, 4, 5, 6, 7, 8, 9, 10, 11, 12, 13, 14, 15, 16, 16, 16, 17, 17, 18, 18, 18, 19, 19, 19, 20, 20, 20, 20, 21, 21, 21, 21, 22, 22, 22, 22, 22, 23, 23, 23, 23, 23, 23, 24, 24, 24, 24, 24, 24, 25, 25, 25, 25, 25, 25, 25, 26, 26, 26, 26, 26, 26, 26, 26, 27, 27, 27, 27, 27, 27, 27, 27, 27, 27, 28, 28, 28, 28, 28, 28, 28, 28, 28, 28, 29, 29, 29, 29, 29, 29, 29, 29, 29, 29, 29, 29, 30, 30, 30, 30, 30, 30, 30, 30, 30, 30, 30, 30, 30, 30, 31, 31, 31, 31, 31, 31, 31, 31, 31, 31, 31, 31, 31, 31, 31};

struct Params {
    const float* in[N_IN];
    float* out;
    unsigned char* ws;
};

template <class F>
__device__ __forceinline__ void transpose_item(const float* W, int ldw, int k0, int n0, int nlim, LAS float* scr, int lane, F dst) {
#pragma unroll 8
    for (int i = 0; i < 32; ++i) { const int kk = 2 * i + (lane >> 5); const int n = n0 + (lane & 31); scr[kk * 33 + (lane & 31)] = n < nlim ? W[(size_t)(k0 + kk) * ldw + n] : 0.f; }
    LDS_WAIT(); asm volatile("" ::: "memory");
    const int c = lane & 7;
#pragma unroll
    for (int j = 0; j < 4; ++j) { const int nn = (lane >> 3) + 8 * j; const int n = n0 + nn; const LAS float* s = scr + (8 * c) * 33 + nn;
        bf16* rowp; float sc;
        if (n < nlim && dst(n, rowp, sc)) {
            v4u o; o.x = pk2(s[0 * 33] * sc, s[1 * 33] * sc); o.y = pk2(s[2 * 33] * sc, s[3 * 33] * sc); o.z = pk2(s[4 * 33] * sc, s[5 * 33] * sc); o.w = pk2(s[6 * 33] * sc, s[7 * 33] * sc);
            *(v4u*)(rowp + 8 * c) = o; } }
    LDS_WAIT(); asm volatile("" ::: "memory");
}
__device__ __forceinline__ int win_row(int n, float& sc) {
    sc = 1.f;
    if (n < 512) { sc = 0.08838834764831845f; return n; }
    if (n < 1024) return n;
    if (n < 2048) return n;
    if (n < 3072) return n;
    if (n < 3088) return 5120 + (n - 3072);
    if (n < 4112) { sc = 0.08838834764831845f; return 3072 + (n - 3088); }
    if (n < 4368) return 4096 + (n - 4112);
    if (n < 4624) return 4352 + (n - 4368);
    if (n < 4880) return 4608 + (n - 4624);
    if (n < 5136) return 5376 + (n - 4880);
    if (n < 5392) return 4864 + (n - 5136);
    if (n < 5648) return 5632 + (n - 5392);
    return 5136 + (n - 5648);
}
constexpr size_t WS_WRH = WS_HN, WS_WRL = WS_HN + (size_t)32 * 2048 * 2;
constexpr size_t WS_PEVP = WS_W2T;
template <bool ITEMS, bool XN>
__device__ __forceinline__ void p0_prologue(const Params& p, LAS unsigned char* lds, int gw, int NGW, int wave, int lane) {
    LAS float* scr = (LAS float*)(lds + wave * 16384);
    bf16* WinT = (bf16*)(p.ws + WS_WINT); bf16* WoT = (bf16*)(p.ws + WS_WOT); bf16* WkcT = (bf16*)(p.ws + WS_WKCT); bf16* WvcT = (bf16*)(p.ws + WS_WVCT);
    bf16* W1T = (bf16*)(p.ws + WS_W1T); bf16* W2T = (bf16*)(p.ws + WS_W2T);
    constexpr int I_IN = 32 * 178, I_O = 32 * 64, I_C = 64 * 4, I_E1 = 32 * 128, I_E2 = 32 * 64;
    constexpr int I_PE = 2 * 64;
    constexpr int I_RW2 = 64;
    constexpr int NITEMS = I_O + 2 * I_C + I_PE + I_RW2;
    (void)I_IN; (void)WinT;
    if constexpr (ITEMS) for (int it = gw; it < NITEMS; it += NGW) {
        int r = it;
        if (r < I_O) { const int kb = r / 64, nb = r % 64, k0 = kb * 64;
            transpose_item(p.in[I_WOUT], DM, k0, nb * 32, DM, scr, lane, [&](int n, bf16*& rowp, float& sc) { sc = 1.f; rowp = WoT + (size_t)n * DM + k0; return true; }); continue; } r -= I_O;
        if (r >= 2 * I_C + I_PE) { r -= 2 * I_C + I_PE; const float* rw = p.in[I_RW]; bf16* WRH = (bf16*)(p.ws + WS_WRH); bf16* WRL = (bf16*)(p.ws + WS_WRL); const int e = lane & 31;
#pragma unroll 4
            for (int kk = 0; kk < 16; ++kk) { const int k = r * 32 + 2 * kk + (lane >> 5); const float w = rw[k * 32 + e]; const unsigned hi = f2bf(w); WRH[e * 2048 + k] = (bf16)hi; WRL[e * 2048 + k] = (bf16)f2bf(w - bf2f((unsigned short)hi)); }
            continue; }
        if (r >= 2 * I_C) { r -= 2 * I_C; const int which = r >> 6, kq = r & 63; const float* pe = p.in[which ? I_PEV : I_PEK] + kq * 64; const float* w1 = p.in[which ? I_WV1 : I_WK1] + (size_t)kq * 64 * 128 + lane;
            float a0 = 0.f, a1 = 0.f;
#pragma unroll
            for (int k = 0; k < 64; ++k) { const float pv = pe[k]; a0 += pv * w1[k * 128]; a1 += pv * w1[k * 128 + 64]; }
            float* dst = (float*)(p.ws + WS_PEVP) + (size_t)(which * 64 + kq) * 128 + lane; dst[0] = a0; dst[64] = a1; continue; }
        { const int which = r / I_C; r %= I_C; const int kb = r / 4, nb = r % 4, k0 = kb * 64;
            bf16* dstm = which ? WvcT : WkcT;
            transpose_item(p.in[which ? I_WV1 : I_WK1], 128, k0, nb * 32, 128, scr, lane, [&](int n, bf16*& rowp, float& sc) { sc = 1.f; rowp = dstm + (size_t)(n + (k0 >= 2048 ? 128 : 0)) * 2048 + (k0 & 2047); return true; }); }
        (void)I_E1; (void)I_E2; (void)W1T; (void)W2T;
    }
    const float* x = p.in[I_X]; const float* gm = p.in[I_NMIX];
    if constexpr (XN) for (int m = gw; m < T; m += NGW) {
        const f32x4* xr = (const f32x4*)(x + (size_t)m * DM) + lane; f32x4 v[8]; float s = 0.f;
#pragma unroll
        for (int j = 0; j < 8; ++j) { v[j] = xr[64 * j]; s += (v[j].x * v[j].x + v[j].y * v[j].y) + (v[j].z * v[j].z + v[j].w * v[j].w); }
        const float rstd = 1.f / sqrtf(wave_sum(s) * (1.f / DM) + RMS_EPS);
        float mxr = 0.f;
#pragma unroll
        for (int j = 0; j < 8; ++j) { const f32x4 g4 = ((const f32x4*)gm)[lane + 64 * j]; v[j].x *= rstd * g4.x; v[j].y *= rstd * g4.y; v[j].z *= rstd * g4.z; v[j].w *= rstd * g4.w;
            mxr = fmaxf(mxr, fmaxf(fmaxf(fabsf(v[j].x), fabsf(v[j].y)), fmaxf(fabsf(v[j].z), fabsf(v[j].w)))); }
        mxr = wave_max(mxr); const float qs = mxr > 0.f ? mxr * (1.f / 127.f) : 1.f, qi = 1.f / qs;
        unsigned* o4 = (unsigned*)(p.ws + WS_XN + (size_t)m * DM) + lane;
#pragma unroll
        for (int j = 0; j < 8; ++j) { const float M = 12582912.f;
            const unsigned ua = __builtin_bit_cast(unsigned, v[j].x * qi + M), ub = __builtin_bit_cast(unsigned, v[j].y * qi + M), uc = __builtin_bit_cast(unsigned, v[j].z * qi + M), ud = __builtin_bit_cast(unsigned, v[j].w * qi + M);
            o4[64 * j] = __builtin_amdgcn_perm(ub, ua, 0x0c0c0400u) | (__builtin_amdgcn_perm(ud, uc, 0x0c0c0400u) << 16); }
        if (lane == 0) ((float*)(p.ws + WS_XN + (size_t)T * DM))[m] = qs;
    }
}
#define XB_TMO      128
#define XB_XCNT(j)  (256  + 64 * (j))
#define XB_XSUB(j)  (1280 + 64 * (j))
#define XB_XGEN(j)  (2304 + 64 * (j))
#define XB_TOP      3328
#define XB_TOPGEN   3392
#define XCD_BAR_WORDS 3456
#define XB_SPIN_CAP (1u << 18)

__device__ __forceinline__ unsigned xb_ld(unsigned* p)              { return __hip_atomic_load(p, __ATOMIC_RELAXED, __HIP_MEMORY_SCOPE_AGENT); }
__device__ __forceinline__ unsigned xb_add(unsigned* p, unsigned v) { return __hip_atomic_fetch_add(p, v, __ATOMIC_RELAXED, __HIP_MEMORY_SCOPE_AGENT); }
__device__ __forceinline__ unsigned xb_xcc_id() { return (unsigned)__builtin_amdgcn_s_getreg((3 << 11) | 20) & 0xFu; }
#define XB_SPIN(cond, bar) do { unsigned _sp = 0; while (cond) { __builtin_amdgcn_s_sleep(1); \
    if ((++_sp & 255u) == 0u) { if (xb_ld(&(bar)[XB_TMO])) break; if (_sp > XB_SPIN_CAP) { atomicAdd(&(bar)[XB_TMO], 1u); break; } } } } while (0)

struct XcdBarrier {
    unsigned* bar; unsigned x;
    volatile LAS unsigned* st;
};

__device__ __forceinline__ XcdBarrier xcd_barrier_post(unsigned* bar, volatile LAS unsigned* st) {
    XcdBarrier b; b.bar = bar; b.x = xb_xcc_id(); b.st = st;
    if (threadIdx.x == 0) (void)xb_add(&bar[XB_XCNT(b.x)], 1u);
    return b;
}
__device__ __forceinline__ void xcd_barrier_complete(unsigned* bar, unsigned x, unsigned& nloc, unsigned& nx) {
    const unsigned G = gridDim.x * gridDim.y * gridDim.z;
    unsigned sum, cnt, mine, sp = 0u;
    for (;;) {
        sum = 0u; cnt = 0u; mine = 0u;
#pragma unroll
        for (unsigned j = 0; j < 16; ++j) { const unsigned c = xb_ld(&bar[XB_XCNT(j)]); sum += c; cnt += (c > 0u) ? 1u : 0u; mine = (j == x) ? c : mine; }
        if (sum == G) break;
        __builtin_amdgcn_s_sleep(1);
        if ((++sp & 255u) == 0u) { if (xb_ld(&bar[XB_TMO])) break; if (sp > XB_SPIN_CAP) { atomicAdd(&bar[XB_TMO], 1u); break; } }
    }
    nloc = mine > 0u ? mine : 1u; nx = cnt > 0u ? cnt : 1u;
}

__device__ __forceinline__ void xcd_barrier(const XcdBarrier& b) {
    asm volatile("s_waitcnt vmcnt(0)" ::: "memory");
    __syncthreads();
    if (threadIdx.x == 0) {
        unsigned* bar = b.bar;
        __builtin_amdgcn_s_waitcnt(0);
        unsigned nloc = b.st[0], nx = b.st[1];
        if (nloc == 0u) { xcd_barrier_complete(bar, b.x, nloc, nx); b.st[0] = nloc; b.st[1] = nx; }
        const unsigned old = xb_add(&bar[XB_XSUB(b.x)], 1u);
        const unsigned gen = old / nloc;
        if (old + 1u == (gen + 1u) * nloc) {
            __builtin_amdgcn_fence(__ATOMIC_RELEASE, "agent");
            asm volatile("s_waitcnt vmcnt(0)" ::: "memory");
            const unsigned og = xb_add(&bar[XB_TOP], 1u);
            const unsigned tg = og / nx;
            if (og + 1u == (tg + 1u) * nx) xb_add(&bar[XB_TOPGEN], 1u);
            else XB_SPIN(xb_ld(&bar[XB_TOPGEN]) == tg, bar);
            __builtin_amdgcn_fence(__ATOMIC_ACQUIRE, "agent");
            xb_add(&bar[XB_XGEN(b.x)], 1u);
            asm volatile("s_waitcnt vmcnt(0)" ::: "memory");
        } else {
            XB_SPIN(xb_ld(&bar[XB_XGEN(b.x)]) == gen, bar);
            __builtin_amdgcn_fence(__ATOMIC_ACQUIRE, "agent");
            asm volatile("s_waitcnt vmcnt(0)" ::: "memory");
        }
    }
    __syncthreads();
}

struct ProjOrder : pg8::StaticOrder {
    const bf16* xn; const bf16* wt;
    __device__ __forceinline__ bool next(int i, pg8::Unit& u) const { if (!pg8::StaticOrder::next(i, u)) return false; u.kind = (u.pn >= 21) ? 1 : 0; return true; }
    __device__ __forceinline__ const char* pa(const pg8::Gemm& g, const pg8::Unit& u) const { return u.kind ? (const char*)wt + (size_t)u.pn * ((size_t)256 * g.K * 2) : (const char*)xn + (size_t)u.pm * ((size_t)256 * g.K * 2); }
    __device__ __forceinline__ const char* pb(const pg8::Gemm& g, const pg8::Unit& u) const { return u.kind ? (const char*)xn + (size_t)u.pm * ((size_t)256 * g.K * 2) : (const char*)wt + (size_t)u.pn * ((size_t)256 * g.K * 2); }
};
struct EpiRes {
    static constexpr bool PERM = true, AFTER_DRAIN = false;
    const float* x; bf16* h;
    __device__ __forceinline__ void operator()(const pg8::f32x4 (&acc)[2][2][4][2], const pg8::Unit& u, int wr, int wc, int fr, int fq) const {
        const int row0 = u.pm * 256 + wr * 64 + fr, col0 = u.pn * 256 + wc * 32 + 8 * fq;
#pragma unroll
        for (int ai = 0; ai < 2; ++ai)
#pragma unroll
            for (int m = 0; m < 4; ++m) { const size_t off = (size_t)(row0 + ai * 128 + m * 16) * DM + col0;
#pragma unroll
                for (int bj = 0; bj < 2; ++bj) { const pg8::f32x4 x0 = *(const pg8::f32x4*)(x + off + bj * 128), x1 = *(const pg8::f32x4*)(x + off + bj * 128 + 4);
                    const pg8::f32x4 a0 = x0 + acc[ai][bj][m][0], a1 = x1 + acc[ai][bj][m][1]; pg8::u32x4 w;
                    w.x = pg8::cvt_pk_bf16(a0.x, a0.y); w.y = pg8::cvt_pk_bf16(a0.z, a0.w); w.z = pg8::cvt_pk_bf16(a1.x, a1.y); w.w = pg8::cvt_pk_bf16(a1.z, a1.w);
                    *(pg8::u32x4*)(h + off + bj * 128) = w; } }
    }
};
struct MoeOrder {
    int nM, nN, nwg, G, c; const int* tile_exp;
    __device__ __forceinline__ void init(const int* meta, int nN_, int G_, int c_) { nM = meta[0]; nN = nN_; nwg = nM * nN; G = G_; c = c_; tile_exp = meta + 64; }
    __device__ __forceinline__ bool next(int i, pg8::Unit& u) const {
        const long L = (long)i * G + c; if (L >= nwg) return false;
        pg8::tile_of<8>((int)L, nM, nN, u.pm, u.pn); u.kind = tile_exp[u.pm]; return true;
    }
    __device__ __forceinline__ const char* pa(const pg8::Gemm& g, const pg8::Unit& u) const { return (const char*)g.A + (size_t)u.pm * ((size_t)256 * g.K * 2); }
    __device__ __forceinline__ const char* pb(const pg8::Gemm& g, const pg8::Unit& u) const { return (const char*)g.Bt + ((size_t)u.kind * nN + u.pn) * ((size_t)256 * g.K * 2); }
    __device__ __forceinline__ void a_ready(const pg8::Unit&) const {}
    __device__ __forceinline__ void done(const pg8::Unit&) const {}
};

struct MoeOrderG : MoeOrder { const unsigned short* rowtab;
    __device__ __forceinline__ const char* pa(const pg8::Gemm& g, const pg8::Unit&) const { return (const char*)g.A; } };

__device__ __forceinline__ float gelu_tanh(float x) { const float u = 0.7978845608028654f * (x + 0.044715f * x * x * x); const float e = __expf(2.f * u); return 0.5f * x * (1.f + (1.f - 2.f / (e + 1.f))); }
__device__ __forceinline__ void ph_cmp_fin(const Params& p, LAS unsigned char* lds, int bid, int G, int tid, const float* LHall, const float* PEVall) {
    const int grp = tid >> 7, n = tid & 127, ngrp = G * 4, total = 2 * 16 * 255, iters = (total + ngrp - 1) / ngrp;
    LAS float* hid = (LAS float*)lds + grp * 128;
    float pevs[2];
#pragma unroll
    for (int w = 0; w < 2; ++w) { float s = 0.f;
#pragma unroll 8
        for (int q = 0; q < 64; ++q) s += PEVall[(size_t)(w * 64 + q) * 128 + n];
        pevs[w] = s; }
    float wcol[128]; int wh = -1;
    for (int it = 0; it < iters; ++it) { int id = it * ngrp + bid * 4 + grp; if (id >= total) id = total - 1;
        const int which = id / (16 * 255), rem = id % (16 * 255), bg = rem / 255, c = rem % 255;
        if (which != wh) { const float* w2 = p.in[which ? I_WV2 : I_WK2]; wh = which;
#pragma unroll
            for (int mm = 0; mm < 128; ++mm) wcol[mm] = w2[mm * 128 + n]; }
        const float* LH = LHall + ((size_t)which * 4096 + bg * 256) * 256;
        const float a = LH[(size_t)c * 256 + n] + LH[(size_t)(c + 1) * 256 + 128 + n] + (which ? pevs[1] : pevs[0]);
        hid[n] = gelu_tanh(a);
        __syncthreads();
        float o0 = 0.f, o1 = 0.f, o2 = 0.f, o3 = 0.f;
#pragma unroll
        for (int m4 = 0; m4 < 32; ++m4) { const f32x4 hv = *(const LAS f32x4*)(hid + 4 * m4); o0 += hv.x * wcol[4 * m4]; o1 += hv.y * wcol[4 * m4 + 1]; o2 += hv.z * wcol[4 * m4 + 2]; o3 += hv.w * wcol[4 * m4 + 3]; }
        const float o = (o0 + o1) + (o2 + o3);
        if (which == 0) ((bf16*)(p.ws + WS_KCMP))[((size_t)bg * 256 + c) * 128 + n] = (bf16)f2bf(o);
        else ((bf16*)(p.ws + WS_VCMPT))[((size_t)bg * 128 + n) * 256 + vt_pos(c)] = (bf16)f2bf(o);
        __syncthreads(); }
}

namespace nsa {
constexpr int KB0 = 0, KB1 = 16384, VB0 = 32768, VB1 = 49152, LUT = 65536;
constexpr int QST = LUT + 4096, IMP = QST + 65536, SELM = IMP + 16384, LDS_END = SELM + 512;
constexpr float LOG2E = 1.4426950408889634f;
typedef float f4 __attribute__((ext_vector_type(4)));

typedef unsigned u2v __attribute__((ext_vector_type(2)));
__device__ __forceinline__ float rmax16(float x) { const unsigned u = __float_as_uint(x); const u2v r = __builtin_amdgcn_permlane16_swap(u, u, false, false); return fmaxf(__uint_as_float(r[0]), __uint_as_float(r[1])); }
__device__ __forceinline__ float rmax32(float x) { const unsigned u = __float_as_uint(x); const u2v r = __builtin_amdgcn_permlane32_swap(u, u, false, false); return fmaxf(__uint_as_float(r[0]), __uint_as_float(r[1])); }
__device__ __forceinline__ float radd16(float x) { const unsigned u = __float_as_uint(x); const u2v r = __builtin_amdgcn_permlane16_swap(u, u, false, false); return __uint_as_float(r[0]) + __uint_as_float(r[1]); }
__device__ __forceinline__ float radd32(float x) { const unsigned u = __float_as_uint(x); const u2v r = __builtin_amdgcn_permlane32_swap(u, u, false, false); return __uint_as_float(r[0]) + __uint_as_float(r[1]); }
__device__ __forceinline__ float raddq(float x) { x += __int_as_float(__builtin_amdgcn_update_dpp(0, __float_as_int(x), 0xB1, 0xF, 0xF, true)); x += __int_as_float(__builtin_amdgcn_update_dpp(0, __float_as_int(x), 0x4E, 0xF, 0xF, true)); return x; }
struct Ctx {
    LAS unsigned char* lds; int tid, lane, wave, c, gq, r;
    int s0, cur;
    const LAS unsigned char* qst;
    int pos0;
    const LAS float* lutrow;
    int koff0, voff0;
    unsigned kdo[2], vdoc[2], vdos[2];
};
__device__ __forceinline__ void dma_k(const Ctx& C, const bf16* kt, LAS unsigned char* kb) {
#pragma unroll
    for (int i = 0; i < 2; ++i) __builtin_amdgcn_global_load_lds((const unsigned*)((const char*)kt + C.kdo[i]), (LAS unsigned*)(kb + (2 * C.wave + i) * 1024), 16, 0, 0); }
__device__ __forceinline__ void dma_v(const Ctx& C, const bf16* vt, const unsigned (&vdo)[2], LAS unsigned char* vb) {
#pragma unroll
    for (int i = 0; i < 2; ++i) __builtin_amdgcn_global_load_lds((const unsigned*)((const char*)vt + vdo[i]), (LAS unsigned*)(vb + (2 * C.wave + i) * 1024), 16, 0, 0); }

__device__ __forceinline__ void compute_st(const Ctx& C, const LAS unsigned char* kb, f4 (&s)[2][4]) {
    bf16x8 an = *(const LAS bf16x8*)(kb + C.koff0), an2 = *(const LAS bf16x8*)(kb + 4096 + C.koff0);
    bf16x8 qn0 = *(const LAS bf16x8*)(C.qst), qn1 = *(const LAS bf16x8*)(C.qst + 4 * 1024);
#pragma unroll
    for (int ks = 0; ks < 4; ++ks) { const bf16x8 q0 = qn0, q1 = qn1;
#pragma unroll
        for (int kt = 0; kt < 4; ++kt) { const bf16x8 a = an; const int jn = ks * 4 + kt + 2; an = an2;
            if (jn < 16) an2 = *(const LAS bf16x8*)(kb + (jn & 3) * 4096 + (C.koff0 ^ ((jn >> 2) * 64)));
            if (kt == 2 && ks < 3) { qn0 = *(const LAS bf16x8*)(C.qst + (ks + 1) * 1024); qn1 = *(const LAS bf16x8*)(C.qst + (4 + ks + 1) * 1024); }
            __builtin_amdgcn_sched_barrier(0);
            s[0][kt] = __builtin_amdgcn_mfma_f32_16x16x32_bf16(a, q0, ks == 0 ? (f4){0.f, 0.f, 0.f, 0.f} : s[0][kt], 0, 0, 0);
            s[1][kt] = __builtin_amdgcn_mfma_f32_16x16x32_bf16(a, q1, ks == 0 ? (f4){0.f, 0.f, 0.f, 0.f} : s[1][kt], 0, 0, 0); } }
}
__device__ __forceinline__ void compute_pv(const Ctx& C, const LAS unsigned char* vb, const f4 (&p)[2][4], f4 (&o)[2][8]) {
    bf16x8 an = *(const LAS bf16x8*)(vb + C.voff0), an2 = *(const LAS bf16x8*)(vb + 2048 + C.voff0);
#pragma unroll
    for (int i = 0; i < 2; ++i) { bf16x8 pb[2];
#pragma unroll
        for (int qt = 0; qt < 2; ++qt) { v4u w; w.x = pg8::cvt_pk_bf16(p[qt][2 * i][0], p[qt][2 * i][1]); w.y = pg8::cvt_pk_bf16(p[qt][2 * i][2], p[qt][2 * i][3]);
            w.z = pg8::cvt_pk_bf16(p[qt][2 * i + 1][0], p[qt][2 * i + 1][1]); w.w = pg8::cvt_pk_bf16(p[qt][2 * i + 1][2], p[qt][2 * i + 1][3]); pb[qt] = __builtin_bit_cast(bf16x8, w); }
#pragma unroll
        for (int dt = 0; dt < 8; ++dt) { const bf16x8 a = an; const int jn = i * 8 + dt + 2; an = an2;
            if (jn < 16) an2 = *(const LAS bf16x8*)(vb + (jn & 7) * 2048 + (C.voff0 ^ ((jn >> 3) * 64)));
            __builtin_amdgcn_sched_barrier(0);
#pragma unroll
            for (int qt = 0; qt < 2; ++qt) o[qt][dt] = __builtin_amdgcn_mfma_f32_16x16x32_bf16(a, pb[qt], o[qt][dt], 0, 0, 0); } }
}
enum { M_CMP = 0, M_SEL = 1, M_WIN = 2 };
template <int MODE, bool FAR = false>
__device__ __forceinline__ void mask_bias(const Ctx& C, f4 (&s)[2][4], int kb, int n, const LAS unsigned* selw) {
    const float NEG = -__builtin_inff();
#pragma unroll
    for (int qt = 0; qt < 2; ++qt) {
        bool tokok = true;
        if (MODE == M_SEL) tokok = ((selw[(4 * qt + (C.c >> 2)) * 2 + (n >> 5)] >> (n & 31)) & 1u) != 0u;
        if (FAR) { const float be = tokok ? C.lutrow[127] : NEG;
#pragma unroll
            for (int kt = 0; kt < 4; ++kt)
#pragma unroll
                for (int rg = 0; rg < 4; ++rg) s[qt][kt][rg] = __builtin_fmaf(s[qt][kt][rg], LOG2E, be);
            continue; }
        const int dbase = (MODE == M_CMP) ? (C.pos0 + 4 * qt - 31 - 16 * (kb + 4 * C.gq)) : (C.pos0 + 4 * qt - (kb + 4 * C.gq));
#pragma unroll
        for (int kt = 0; kt < 4; ++kt) {
#pragma unroll
            for (int rg = 0; rg < 4; ++rg) { const int d = (MODE == M_CMP) ? dbase - 16 * (16 * kt + rg) : dbase - (16 * kt + rg);
                int di = d < 0 ? 0 : d; di = di > 127 ? 127 : di; const float bias = C.lutrow[di];
                bool ok = tokok && d >= 0; if (MODE == M_WIN) ok = ok && d < 512;
                s[qt][kt][rg] = ok ? __builtin_fmaf(s[qt][kt][rg], LOG2E, bias) : NEG; }
            asm volatile("" ::: "memory"); }
    }
}
__device__ __forceinline__ void softmax_step(f4 (&s)[2][4], float (&m)[2], float (&l)[2], f4 (&o)[2][8], bool rescale_o) {
#pragma unroll
    for (int qt = 0; qt < 2; ++qt) { float mx = s[qt][0][0];
#pragma unroll
        for (int kt = 0; kt < 4; ++kt)
#pragma unroll
            for (int rg = 0; rg < 4; ++rg) mx = fmaxf(mx, s[qt][kt][rg]);
        mx = rmax32(rmax16(mx));
        const float mn = fmaxf(m[qt], mx), alpha = __builtin_amdgcn_exp2f(m[qt] - mn); m[qt] = mn; float ps = 0.f;
#pragma unroll
        for (int kt = 0; kt < 4; ++kt)
#pragma unroll
            for (int rg = 0; rg < 4; ++rg) { const float e = __builtin_amdgcn_exp2f(s[qt][kt][rg] - mn); s[qt][kt][rg] = e; ps += e; }
        l[qt] = l[qt] * alpha + ps;
        if (rescale_o && __any(alpha != 1.f)) {
#pragma unroll
            for (int dt = 0; dt < 8; ++dt) o[qt][dt] = o[qt][dt] * alpha; }
    }
}
template <int MODE>
__device__ __forceinline__ void softmax_far(const Ctx& C, f4 (&s)[2][4], int n, const LAS unsigned* selw, float (&m)[2], float (&l)[2], f4 (&o)[2][8]) {
    const float b31 = C.lutrow[127];
#pragma unroll
    for (int qt = 0; qt < 2; ++qt) {
        float be = b31;
        if (MODE == M_SEL) { const bool tokok = ((selw[(4 * qt + (C.c >> 2)) * 2 + (n >> 5)] >> (n & 31)) & 1u) != 0u; be = tokok ? b31 : -__builtin_inff(); }
        float mx = fmaxf(fmaxf(s[qt][0][0], s[qt][0][1]), fmaxf(s[qt][0][2], s[qt][0][3]));
#pragma unroll
        for (int kt = 1; kt < 4; ++kt) mx = fmaxf(mx, fmaxf(fmaxf(s[qt][kt][0], s[qt][kt][1]), fmaxf(s[qt][kt][2], s[qt][kt][3])));
        mx = rmax32(rmax16(mx));
        const float mt = __builtin_fmaf(mx, LOG2E, be), mn = fmaxf(m[qt], mt), alpha = __builtin_amdgcn_exp2f(m[qt] - mn), c0 = be - mn; m[qt] = mn; float ps = 0.f;
#pragma unroll
        for (int kt = 0; kt < 4; ++kt)
#pragma unroll
            for (int rg = 0; rg < 4; ++rg) { const float e = __builtin_amdgcn_exp2f(__builtin_fmaf(s[qt][kt][rg], LOG2E, c0)); s[qt][kt][rg] = e; ps += e; }
        l[qt] = l[qt] * alpha + ps;
        if (__any(alpha != 1.f)) {
#pragma unroll
            for (int dt = 0; dt < 8; ++dt) o[qt][dt] = o[qt][dt] * alpha; }
    }
}
}

__device__ __forceinline__ void ph_nsa(const Params& p, LAS unsigned char* lds, int idx0, int idxstride, int tid_in, int wave) {
    using namespace nsa;
    int tid = tid_in; asm volatile("" : "+v"(tid));
    const int lane = tid & 63;
    Ctx C; C.lds = lds; C.tid = tid; C.lane = lane; C.wave = wave; C.c = lane & 15; C.gq = lane >> 4; C.r = lane & 3;
    C.koff0 = C.c * 256 + ((C.gq ^ C.c) * 16);
#pragma unroll
    for (int i = 0; i < 2; ++i) { const int piece = 2 * wave + i;
        { const int row = piece * 4 + (lane >> 4), chunk = (lane & 15) ^ (row & 15); C.kdo[i] = (unsigned)(row * 256 + chunk * 16); }
        { const int row = piece * 8 + (lane >> 3), chunk = (lane & 7) ^ ((row >> 1) & 7); C.vdoc[i] = (unsigned)(row * 256 * 2 + chunk * 16); C.vdos[i] = (unsigned)(row * SEQ * 2 + chunk * 16); } }
    C.voff0 = C.c * 128 + ((C.gq ^ ((C.c >> 1) & 7)) * 16);
    const bf16* NQ = (const bf16*)(p.ws + WS_NQ); const bf16* SM = (const bf16*)(p.ws + WS_SM); bf16* A2 = (bf16*)(p.ws + WS_A2);
    const float* relb = p.in[I_RELB]; const float* nsag = p.in[I_NSAG];
    LAS float* lut = (LAS float*)(lds + LUT);
    for (int i = tid; i < 8 * 128; i += 512) { const int hh = i >> 7, d = i & 127; lut[i] = relb[(int)kBucket[d] * 8 + hh] * LOG2E; }
    __syncthreads();
    LAS unsigned char* qstw = lds + QST + wave * 8192 + lane * 16; C.qst = qstw;
    LAS float* imp = (LAS float*)(lds + IMP + wave * 2048);
    LAS unsigned long long* selm = (LAS unsigned long long*)(lds + SELM + wave * 64);
#define NSA_SYNC() do { asm volatile("s_waitcnt vmcnt(0)" ::: "memory"); __syncthreads(); } while (0)
    for (int idx = idx0; idx < 512; idx += idxstride) {
        const int rnd = idx >> 8, kq = idx & 255, b = kq & 7, tq = rnd == 0 ? 63 - (kq >> 3) : (kq >> 3);
        C.s0 = tq * 64; C.cur = tq;
        const int tokl0 = 8 * wave + (C.c >> 2);
        C.pos0 = C.s0 + tokl0;
        float ssq[2] = {0.f, 0.f};
        for (int g = 0; g < 2; ++g) {
            const int bg = b * 2 + g, h = g * 4 + C.r;
            C.lutrow = lut + h * 128;
            const bf16* KCMP = (const bf16*)(p.ws + WS_KCMP) + (size_t)bg * 256 * 128; const bf16* VCMPT = (const bf16*)(p.ws + WS_VCMPT) + (size_t)bg * 128 * 256;
#pragma unroll
            for (int qt = 0; qt < 2; ++qt) { const unsigned qo = (unsigned)(((b * SEQ + (C.pos0 + 4 * qt)) * 1024 + h * 128 + 8 * C.gq) * 2);
#pragma unroll
                for (int ks = 0; ks < 4; ++ks) *(LAS bf16x8*)(qstw + (qt * 4 + ks) * 1024) = *(const bf16x8*)((const char*)NQ + qo + ks * 64); }
#pragma unroll
            for (int i = 0; i < 2; ++i) *(LAS f32x4*)((LAS unsigned char*)imp + lane * 16 + i * 1024) = (f32x4){0.f, 0.f, 0.f, 0.f};
#define NSA_OROW(qt) ((char*)A2 + (unsigned)(((b * SEQ + C.pos0 + 4 * (qt)) * DM + 1024 + h * 128 + 4 * C.gq) * 2))
            const int cmaxb = C.s0 + 63 - 31; const int nct = cmaxb >= 0 ? ((cmaxb >> 4) >> 6) + 1 : 0;
            float m[2] = {-1e30f, -1e30f}, l[2] = {0.f, 0.f};
            f4 o[2][8];
            if (nct > 0) {
                dma_k(C, KCMP, lds + KB0); NSA_SYNC();
                for (int ct = 0; ct < nct; ++ct) { const int buf = ct & 1;
                    if (ct + 1 < nct) dma_k(C, KCMP + (ct + 1) * 64 * 128, lds + (buf ? KB0 : KB1));
                    f4 s[2][4]; compute_st(C, lds + (buf ? KB1 : KB0), s); mask_bias<M_CMP>(C, s, 64 * ct, 0, (const LAS unsigned*)selm); softmax_step(s, m, l, o, false);
                    NSA_SYNC(); }
            }
            float inv[2];
#pragma unroll
            for (int qt = 0; qt < 2; ++qt) { const float lt = radd32(radd16(l[qt])); inv[qt] = lt > 0.f ? 1.f / lt : 0.f; }
#pragma unroll
            for (int qt = 0; qt < 2; ++qt)
#pragma unroll
                for (int dt = 0; dt < 8; ++dt) o[qt][dt] = (f4){0.f, 0.f, 0.f, 0.f};
            if (nct > 0) {
                dma_k(C, KCMP, lds + KB0); dma_v(C, VCMPT, C.vdoc, lds + VB0); NSA_SYNC();
                for (int ct = 0; ct < nct; ++ct) { const int buf = ct & 1;
                    if (ct + 1 < nct) { dma_k(C, KCMP + (ct + 1) * 64 * 128, lds + (buf ? KB0 : KB1)); dma_v(C, VCMPT + 64 * (ct + 1), C.vdoc, lds + (buf ? VB0 : VB1)); }
                    f4 s[2][4]; compute_st(C, lds + (buf ? KB1 : KB0), s); mask_bias<M_CMP>(C, s, 64 * ct, 0, (const LAS unsigned*)selm);
#pragma unroll
                    for (int qt = 0; qt < 2; ++qt)
#pragma unroll
                        for (int kt = 0; kt < 4; ++kt) {
#pragma unroll
                            for (int rg = 0; rg < 4; ++rg) s[qt][kt][rg] = __builtin_amdgcn_exp2f(s[qt][kt][rg] - m[qt]) * inv[qt];
                            float po = (s[qt][kt][0] + s[qt][kt][1]) + (s[qt][kt][2] + s[qt][kt][3]), p3 = s[qt][kt][3];
                            po = raddq(po); p3 = raddq(p3);
                            const int nb = 16 * ct + 4 * kt + C.gq, tl = 4 * qt + (C.c >> 2);
                            if (C.r == 0) { __hip_atomic_fetch_add((float*)(imp + tl * 64 + nb), po, __ATOMIC_RELAXED, __HIP_MEMORY_SCOPE_WORKGROUP); if (nb + 1 < 64) __hip_atomic_fetch_add((float*)(imp + tl * 64 + nb + 1), p3, __ATOMIC_RELAXED, __HIP_MEMORY_SCOPE_WORKGROUP); } }
                    compute_pv(C, lds + (buf ? VB1 : VB0), s, o);
                    NSA_SYNC(); }
            }
            LDS_WAIT(); __builtin_amdgcn_wave_barrier();
            for (int tk = 0; tk < 8; ++tk) { const int n = lane; float sc;
                if (n == 0 || n == C.cur || n == C.cur - 1) sc = 1e4f; else if (n <= C.cur) sc = imp[tk * 64 + n]; else sc = -1.f;
                const int key = ((sc < 0.f ? 0 : __float_as_int(sc) + 64) & ~63) | (63 - n);
                int rank = 0;
#pragma unroll
                for (int mm = 0; mm < 64; ++mm) rank += (__builtin_amdgcn_readlane(key, mm) > key) ? 1 : 0;
                const unsigned long long mk = __ballot(rank < 16);
                if (lane == 0) selm[tk] = mk; }
            LDS_WAIT(); __builtin_amdgcn_wave_barrier();
#pragma unroll
            for (int qt = 0; qt < 2; ++qt) { const float gt = 1.f / (1.f + __expf(-bf2f(*(const bf16*)((const char*)SM + (unsigned)(((b * SEQ + (C.pos0 + 4 * qt)) * 64 + 16 + h) * 2)))));
#pragma unroll
                for (int dt = 0; dt < 8; ++dt) { const f4 v = o[qt][dt] * gt; *(v2u*)(NSA_OROW(qt) + 32 * dt) = (v2u){pg8::cvt_pk_bf16(v[0], v[1]), pg8::cvt_pk_bf16(v[2], v[3])}; } }
#pragma unroll
            for (int br = 1; br <= 2; ++br) {
                const bf16* KX = (const bf16*)(p.ws + (br == 1 ? WS_KS : WS_KW)) + bg * SEQ * 128; const bf16* VX = (const bf16*)(p.ws + (br == 1 ? WS_VST : WS_VWT)) + bg * 128 * SEQ;
                const int n0 = br == 1 ? 0 : (C.cur >= 8 ? C.cur - 8 : 0), n1 = C.cur;
                m[0] = m[1] = -1e30f; l[0] = l[1] = 0.f;
#pragma unroll
                for (int qt = 0; qt < 2; ++qt)
#pragma unroll
                    for (int dt = 0; dt < 8; ++dt) o[qt][dt] = (f4){0.f, 0.f, 0.f, 0.f};
                int f0 = n1 + 1, f1 = n0 - 1;
                for (int n = n0; n <= n1; ++n) { const bool fa = (C.s0 - (64 * n + 63) >= 113) && (br == 1 || (C.s0 + 63 - 64 * n) < 512); if (fa) { f0 = n < f0 ? n : f0; f1 = n; } }
                const int cntf = f1 >= f0 ? f1 - f0 + 1 : 0, cnt = n1 - n0 + 1, nlo = cntf ? f0 - n0 : cnt;
#define NSA_TILE(i) ((i) < cntf ? f0 + (i) : (((i) - cntf) < nlo ? n0 + ((i) - cntf) : f1 + 1 + ((i) - cntf - nlo)))
#define NSA_BODY(FARF) { const int n = NSA_TILE(i); const int buf = i & 1; \
                    if (i + 1 < cnt) { const int nn = NSA_TILE(i + 1); dma_k(C, KX + nn * 64 * 128, lds + (buf ? KB0 : KB1)); dma_v(C, VX + 64 * nn, C.vdos, lds + (buf ? VB0 : VB1)); } \
                    bool need = true; \
                    if (br == 1) { const unsigned any = ((const LAS unsigned*)selm)[(lane & 7) * 2 + (n >> 5)] >> (n & 31); need = __any((int)(any & 1u)); } \
                    if (need) { f4 s[2][4]; compute_st(C, lds + (buf ? KB1 : KB0), s); \
                        if (FARF) { if (br == 1) softmax_far<M_SEL>(C, s, n, (const LAS unsigned*)selm, m, l, o); else softmax_far<M_WIN>(C, s, n, (const LAS unsigned*)selm, m, l, o); } \
                        else { if (br == 1) mask_bias<M_SEL, false>(C, s, 64 * n, n, (const LAS unsigned*)selm); else mask_bias<M_WIN, false>(C, s, 64 * n, n, (const LAS unsigned*)selm); \
                            softmax_step(s, m, l, o, true); } \
                        compute_pv(C, lds + (buf ? VB1 : VB0), s, o); } \
                    NSA_SYNC(); }
                { const int nf = NSA_TILE(0); dma_k(C, KX + nf * 64 * 128, lds + KB0); dma_v(C, VX + 64 * nf, C.vdos, lds + VB0); NSA_SYNC(); }
                int i = 0;
                for (; i < cntf; ++i) NSA_BODY(true)
                for (; i < cnt; ++i) NSA_BODY(false)
#undef NSA_BODY
#undef NSA_TILE
                asm volatile("s_waitcnt vmcnt(0)" ::: "memory");
#pragma unroll
                for (int qt = 0; qt < 2; ++qt) { const float lt = radd32(radd16(l[qt]));
                    const int row = b * SEQ + (C.pos0 + 4 * qt);
                    const float sc = (1.f / (1.f + __expf(-bf2f(*(const bf16*)((const char*)SM + (unsigned)((row * 64 + 16 + 8 * br + h) * 2)))))) / lt;
#pragma unroll
                    for (int dt = 0; dt < 8; ++dt) { const f4 v = o[qt][dt] * sc; v2u* sp = (v2u*)(NSA_OROW(qt) + 32 * dt); const v2u pv = *sp;
                        const float a0 = bflo(pv.x) + v[0], a1 = bfhi(pv.x) + v[1], a2 = bflo(pv.y) + v[2], a3 = bfhi(pv.y) + v[3];
                        if (br == 2) ssq[qt] += (a0 * a0 + a1 * a1) + (a2 * a2 + a3 * a3);
                        *sp = (v2u){pg8::cvt_pk_bf16(a0, a1), pg8::cvt_pk_bf16(a2, a3)}; } }
            }
        }
        float rstd[2];
#pragma unroll
        for (int qt = 0; qt < 2; ++qt) { const float t = radd32(radd16(raddq(ssq[qt]))); rstd[qt] = 1.f / sqrtf(t * (1.f / 1024.f) + RMS_EPS); }
        asm volatile("s_waitcnt vmcnt(0)" ::: "memory");
#pragma unroll
        for (int qt = 0; qt < 2; ++qt) { const int sub = C.r * 4 + C.gq; bf16* orow = (bf16*)((char*)A2 + (unsigned)(((b * SEQ + (C.pos0 + 4 * qt)) * DM + 1024) * 2 + sub * 16)); const int subz = 0;
#pragma unroll
            for (int j = 0; j < 8; ++j) { const int col = (j * 16 + subz) * 8; v4u w = *(const v4u*)((const char*)orow + (unsigned)(col * 2)); const f32x4 g0 = *(const f32x4*)((const char*)nsag + (unsigned)(col * 4 + sub * 32)), g1 = *(const f32x4*)((const char*)nsag + (unsigned)(col * 4 + sub * 32 + 16)); const float rs = rstd[qt];
                w.x = pk2(bflo(w.x) * rs * g0.x, bfhi(w.x) * rs * g0.y); w.y = pk2(bflo(w.y) * rs * g0.z, bfhi(w.y) * rs * g0.w); w.z = pk2(bflo(w.z) * rs * g1.x, bfhi(w.z) * rs * g1.y); w.w = pk2(bflo(w.w) * rs * g1.z, bfhi(w.w) * rs * g1.w);
                *(v4u*)((char*)orow + (unsigned)(col * 2)) = w; } }
        NSA_SYNC();
    }
#undef NSA_SYNC
#undef NSA_OROW
}

constexpr size_t WS_ST = WS_LA;
constexpr size_t WS_DEC = WS_ST + (size_t)2048 * 256 * 128 * 2;
static_assert(WS_DEC + (size_t)2048 * 128 * 4 <= WS_KCMP, "gla scratch overlay");
namespace gla {
typedef float f4 __attribute__((ext_vector_type(4)));
constexpr int L_ST = 0, L_KT = 65536, L_QT = 81920, L_VT = 98304, L_GA = 131072, L_GT = L_GA + 4096, L_RED = L_GT + 2048, L_END = L_RED + 512;
struct CumIn { float w[16]; float bb; v4u sm; };
__device__ __forceinline__ CumIn load_cum(const Params& p, int tid, int t0, int h) { CumIn x;
    const bf16* SM = (const bf16*)(p.ws + WS_SM); const float* wa2 = p.in[I_WA2]; const float* ba = p.in[I_BA]; const int dk = tid & 127;
    x.sm = (v4u){0u, 0u, 0u, 0u};
    if (tid < 128) { const int j = tid >> 1, hf = tid & 1; x.sm = *(const v4u*)((const char*)SM + (unsigned)(((t0 + j) * 64 + hf * 8) * 2)); }
#pragma unroll
    for (int r = 0; r < 16; ++r) x.w[r] = wa2[r * 512 + h * 128 + dk];
    x.bb = ba[h * 128 + dk];
    return x; }
__device__ __forceinline__ void chunk_cumsum(const CumIn& in, LAS unsigned char* lds, int tid, float (&P)[16], float& blast) {
    LAS float* ga = (LAS float*)(lds + L_GA); LAS float* gt = (LAS float*)(lds + L_GT);
    if (tid < 128) { const int j = tid >> 1, hf = tid & 1; const v4u w = in.sm;
        LAS float* d = ga + j * 16 + hf * 8; d[0] = bflo(w.x); d[1] = bfhi(w.x); d[2] = bflo(w.y); d[3] = bfhi(w.y); d[4] = bflo(w.z); d[5] = bfhi(w.z); d[6] = bflo(w.w); d[7] = bfhi(w.w); }
    const int dk = tid & 127, jq = tid >> 7;
    const float bb = in.bb;
    __syncthreads();
    float run = 0.f;
#pragma unroll
    for (int jj = 0; jj < 16; ++jj) { const LAS f32x4* gr = (const LAS f32x4*)(ga + (16 * jq + jj) * 16); float z = bb;
#pragma unroll
        for (int r4 = 0; r4 < 4; ++r4) { const f32x4 g4 = gr[r4]; z += g4.x * in.w[4 * r4] + g4.y * in.w[4 * r4 + 1] + g4.z * in.w[4 * r4 + 2] + g4.w * in.w[4 * r4 + 3]; }
        run += (fminf(z, 0.f) - __logf(1.f + __expf(-fabsf(z)))) * (1.f / 16.f);   P[jj] = run; }
    gt[jq * 128 + dk] = run;
    __syncthreads();
    float off = 0.f, tot = 0.f;
#pragma unroll
    for (int q = 0; q < 4; ++q) { const float t = gt[q * 128 + dk]; tot += t; if (q < jq) off += t; }
#pragma unroll
    for (int jj = 0; jj < 16; ++jj) P[jj] += off;
    blast = tot;
}
struct RawK { v4u r[2]; }; struct RawV { v4u r[4]; };
__device__ __forceinline__ RawK load_raw_k(const bf16* src  , int tid, int t0, int h) { RawK x;
#pragma unroll
    for (int q = 0; q < 2; ++q) { const int id = tid + 512 * q, j = id >> 4, c16 = id & 15; x.r[q] = *(const v4u*)((const char*)src + (unsigned)(((t0 + j) * 512 + h * 128 + c16 * 8) * 2)); }
    return x; }
__device__ __forceinline__ void store_raw_k(LAS unsigned char* dst, int tid, const RawK& x) {
#pragma unroll
    for (int q = 0; q < 2; ++q) { const int id = tid + 512 * q, j = id >> 4, c16 = id & 15; *(LAS v4u*)(dst + j * 256 + c16 * 16) = x.r[q]; } }
__device__ __forceinline__ RawV load_raw_v(const Params& p, int tid, int t0, int h) { const bf16* GV = (const bf16*)(p.ws + WS_GV); RawV x;
#pragma unroll
    for (int q = 0; q < 4; ++q) { const int id = tid + 512 * q, j = id >> 5, c = id & 31; x.r[q] = *(const v4u*)((const char*)GV + (unsigned)(((t0 + j) * 1024 + h * 256 + c * 8) * 2)); }
    return x; }
__device__ __forceinline__ void store_raw_v(LAS unsigned char* dst, int tid, const RawV& x) {
#pragma unroll
    for (int q = 0; q < 4; ++q) { const int id = tid + 512 * q, j = id >> 5, c = id & 31; *(LAS v4u*)(dst + j * 512 + c * 16) = x.r[q]; } }
__device__ __forceinline__ void fill_vt(LAS unsigned char* lds, const LAS unsigned char* rv, int tid) {
    const int dv = tid & 255, jh = tid >> 8;
    unsigned short v[32];
#pragma unroll
    for (int jj = 0; jj < 32; ++jj) v[jj] = *(const LAS bf16*)(rv + (32 * jh + jj) * 512 + dv * 2);
    LAS unsigned char* row = lds + L_VT + dv * 128; const int f = (dv >> 1) & 7;
#pragma unroll
    for (int q = 0; q < 4; ++q) { v4u w; w.x = v[8 * q] | ((unsigned)v[8 * q + 1] << 16); w.y = v[8 * q + 2] | ((unsigned)v[8 * q + 3] << 16); w.z = v[8 * q + 4] | ((unsigned)v[8 * q + 5] << 16); w.w = v[8 * q + 6] | ((unsigned)v[8 * q + 7] << 16);
        *(LAS v4u*)(row + (((4 * jh + q) ^ f) * 16)) = w; }
}
}

__device__ __forceinline__ void ph_gla_a(const Params& p, LAS unsigned char* lds, int u0, int ustride, int tid_in, int wave) {
    using namespace gla;
    int tid = tid_in; asm volatile("" : "+v"(tid));
    const int lane = tid & 63, c = lane & 15, gq = lane >> 4;
    const bf16* GK = (const bf16*)(p.ws + WS_GK); bf16* ST = (bf16*)(p.ws + WS_ST); float* DEC = (float*)(p.ws + WS_DEC);
    RawK rk; RawV rv;
    CumIn ci;
    if (u0 < 2048) { const int bh = u0 >> 6, ch = u0 & 63; rk = load_raw_k(GK, tid, (bh >> 2) * SEQ + ch * 64, bh & 3); rv = load_raw_v(p, tid, (bh >> 2) * SEQ + ch * 64, bh & 3); ci = load_cum(p, tid, (bh >> 2) * SEQ + ch * 64, bh & 3); }
    for (int unit = u0; unit < 2048; unit += ustride) {
        const int bh = unit >> 6, ch = unit & 63, b = bh >> 2, h = bh & 3, t0 = b * SEQ + ch * 64;
        store_raw_k(lds + 0, tid, rk); store_raw_v(lds + 16384, tid, rv);
        float P[16], blast; chunk_cumsum(ci, lds, tid, P, blast);
        { const int dk = tid & 127, jq = tid >> 7;
          unsigned short kv[16];
#pragma unroll
          for (int jj = 0; jj < 16; ++jj) kv[jj] = *(const LAS bf16*)(lds + (16 * jq + jj) * 256 + dk * 2);
          unsigned pk[8];
#pragma unroll
          for (int q = 0; q < 8; ++q) pk[q] = pk2(bf2f(kv[2 * q]) * __expf(blast - P[2 * q]), bf2f(kv[2 * q + 1]) * __expf(blast - P[2 * q + 1]));
          LAS unsigned char* row = lds + L_KT + dk * 128; const int f = (dk >> 1) & 7;
          *(LAS v4u*)(row + (((2 * jq) ^ f) * 16)) = (v4u){pk[0], pk[1], pk[2], pk[3]}; *(LAS v4u*)(row + (((2 * jq + 1) ^ f) * 16)) = (v4u){pk[4], pk[5], pk[6], pk[7]};
          if (jq == 0) DEC[unit * 128 + dk] = __expf(blast); }
        fill_vt(lds, lds + 16384, tid);
        __syncthreads();
        { const int un = unit + ustride < 2048 ? unit + ustride : unit, bhn = un >> 6, chn = un & 63; rk = load_raw_k(GK, tid, (bhn >> 2) * SEQ + chn * 64, bhn & 3); rv = load_raw_v(p, tid, (bhn >> 2) * SEQ + chn * 64, bhn & 3); ci = load_cum(p, tid, (bhn >> 2) * SEQ + chn * 64, bhn & 3); }
        f4 acc[16];
        const int f = (c >> 1) & 7;
        bf16x8 aF[2];
#pragma unroll
        for (int ks = 0; ks < 2; ++ks) aF[ks] = *(const LAS bf16x8*)(lds + L_KT + (16 * wave + c) * 128 + (((4 * ks + gq) ^ f) * 16));
#pragma unroll
        for (int nt = 0; nt < 16; ++nt) { acc[nt] = (f4){0.f, 0.f, 0.f, 0.f};
#pragma unroll
            for (int ks = 0; ks < 2; ++ks) { const bf16x8 bF = *(const LAS bf16x8*)(lds + L_VT + (16 * nt + c) * 128 + (((4 * ks + gq) ^ f) * 16)); acc[nt] = __builtin_amdgcn_mfma_f32_16x16x32_bf16(aF[ks], bF, acc[nt], 0, 0, 0); } }
        char* dst = (char*)ST + (size_t)unit * (256 * 128 * 2) + (unsigned)((c * 128 + 16 * wave + 4 * gq) * 2);
#pragma unroll
        for (int nt = 0; nt < 16; ++nt) *(v2u*)(dst + nt * 16 * 256) = (v2u){pg8::cvt_pk_bf16(acc[nt][0], acc[nt][1]), pg8::cvt_pk_bf16(acc[nt][2], acc[nt][3])};
        __syncthreads();
    }
}
__device__ __forceinline__ void ph_gla_b(const Params& p, int gid, int gstride) {
    bf16* ST = (bf16*)(p.ws + WS_ST); const float* DEC = (const float*)(p.ws + WS_DEC);
    for (int e = gid; e < 32 * 4096; e += gstride) { const int bh = e >> 12, dv = (e >> 4) & 255, d8 = e & 15;
        float st[8];
#pragma unroll
        for (int i = 0; i < 8; ++i) st[i] = 0.f;
        char* base = (char*)ST + (size_t)bh * 64 * (256 * 128 * 2) + (unsigned)((dv * 128 + d8 * 8) * 2); const float* dbase = DEC + (size_t)bh * 64 * 128 + d8 * 8;
#pragma unroll 4
        for (int ch = 0; ch < 64; ++ch) { v4u* ptr = (v4u*)(base + (size_t)ch * (256 * 128 * 2)); const v4u w = *ptr; const f32x4 d0 = *(const f32x4*)(dbase + ch * 128), d1 = *(const f32x4*)(dbase + ch * 128 + 4);
            v4u o; o.x = pk2(st[0], st[1]); o.y = pk2(st[2], st[3]); o.z = pk2(st[4], st[5]); o.w = pk2(st[6], st[7]); *ptr = o;
            st[0] = st[0] * d0.x + bflo(w.x); st[1] = st[1] * d0.y + bfhi(w.x); st[2] = st[2] * d0.z + bflo(w.y); st[3] = st[3] * d0.w + bfhi(w.y);
            st[4] = st[4] * d1.x + bflo(w.z); st[5] = st[5] * d1.y + bfhi(w.z); st[6] = st[6] * d1.z + bflo(w.w); st[7] = st[7] * d1.w + bfhi(w.w); }
    }
}
__device__ __forceinline__ void ph_gla_c(const Params& p, LAS unsigned char* lds, int u0, int ustride, int tid_in, int wave) {
    using namespace gla;
    int tid = tid_in; asm volatile("" : "+v"(tid));
    const int lane = tid & 63, c = lane & 15, gq = lane >> 4, nt = wave & 3, half = wave >> 2;
    const bf16* GQ = (const bf16*)(p.ws + WS_GQ); const bf16* GK = (const bf16*)(p.ws + WS_GK); const bf16* GG = (const bf16*)(p.ws + WS_GG); const bf16* ST = (const bf16*)(p.ws + WS_ST);
    bf16* A2 = (bf16*)(p.ws + WS_A2); const float* gn = p.in[I_GLAG];
    const int koff0 = c * 256 + ((gq ^ c) * 16), voff0 = c * 128 + (((gq >> 1) ^ ((c >> 1) & 7)) * 16) + (gq & 1) * 8;
    CumIn ci; RawK rq, rk; RawV rv;
    if (u0 < 2048) { const int bh = u0 >> 6, ch = u0 & 63, t0 = (bh >> 2) * SEQ + ch * 64; rq = load_raw_k(GQ, tid, t0, bh & 3); rk = load_raw_k(GK, tid, t0, bh & 3); rv = load_raw_v(p, tid, t0, bh & 3); ci = load_cum(p, tid, t0, bh & 3); }
    for (int unit = u0; unit < 2048; unit += ustride) {
        const int bh = unit >> 6, ch = unit & 63, b = bh >> 2, h = bh & 3, t0 = b * SEQ + ch * 64;
        store_raw_k(lds + 0, tid, rq); store_raw_k(lds + 16384, tid, rk); store_raw_v(lds + 32768, tid, rv);
        float P[16], blast; chunk_cumsum(ci, lds, tid, P, blast);
        { const int dk = tid & 127, jq = tid >> 7;
#pragma unroll
          for (int jj = 0; jj < 16; ++jj) { const int j = 16 * jq + jj; const float qv = bf2f(*(const LAS bf16*)(lds + j * 256 + dk * 2)), kv = bf2f(*(const LAS bf16*)(lds + 16384 + j * 256 + dk * 2));
              const int off = j * 256 + (((dk >> 3) ^ (j & 15)) * 16) + (dk & 7) * 2;
              *(LAS bf16*)(lds + L_QT + off) = (bf16)f2bf(qv * __expf(P[jj])); *(LAS bf16*)(lds + L_KT + off) = (bf16)f2bf(kv * __expf(-P[jj])); } }
        fill_vt(lds, lds + 32768, tid);
        __syncthreads();
        { const char* src = (const char*)ST + (size_t)unit * (256 * 128 * 2);
#pragma unroll
          for (int i = 0; i < 8; ++i) { const int piece = 8 * wave + i, row = piece * 4 + (lane >> 4), chunk = (lane & 15) ^ (row & 15);
              __builtin_amdgcn_global_load_lds((const unsigned*)(src + (unsigned)(row * 256 + chunk * 16)), (LAS unsigned*)(lds + L_ST + piece * 1024), 16, 0, 0); } }
        v2u ggr[8];
        { const int tokg = t0 + 16 * nt + c;
#pragma unroll
          for (int mt = 0; mt < 8; ++mt) ggr[mt] = *(const v2u*)((const char*)GG + (unsigned)((tokg * 1024 + h * 256 + 128 * half + 16 * mt + 4 * gq) * 2)); }
        asm volatile("s_waitcnt vmcnt(0)" ::: "memory"); __syncthreads();
        { const int un = unit + ustride < 2048 ? unit + ustride : unit, bhn = un >> 6, chn = un & 63, tn = (bhn >> 2) * SEQ + chn * 64; rq = load_raw_k(GQ, tid, tn, bhn & 3); rk = load_raw_k(GK, tid, tn, bhn & 3); rv = load_raw_v(p, tid, tn, bhn & 3); ci = load_cum(p, tid, tn, bhn & 3); }
        bf16x8 qF[4];
#pragma unroll
        for (int ks = 0; ks < 4; ++ks) qF[ks] = *(const LAS bf16x8*)(lds + L_QT + nt * 4096 + (koff0 ^ (ks * 64)));
        f4 sT[4];
#pragma unroll
        for (int jt = 0; jt < 4; ++jt) { sT[jt] = (f4){0.f, 0.f, 0.f, 0.f};
            if (jt <= nt) {
#pragma unroll
                for (int ks = 0; ks < 4; ++ks) { const bf16x8 a = *(const LAS bf16x8*)(lds + L_KT + jt * 4096 + (koff0 ^ (ks * 64))); sT[jt] = __builtin_amdgcn_mfma_f32_16x16x32_bf16(a, qF[ks], sT[jt], 0, 0, 0); }
                if (jt == nt) {
#pragma unroll
                    for (int rg = 0; rg < 4; ++rg) if (4 * gq + rg > c) sT[jt][rg] = 0.f; } } }
        bf16x8 pb[2];
#pragma unroll
        for (int s = 0; s < 2; ++s) { v4u w; w.x = pg8::cvt_pk_bf16(sT[2 * s][0], sT[2 * s][1]); w.y = pg8::cvt_pk_bf16(sT[2 * s][2], sT[2 * s][3]); w.z = pg8::cvt_pk_bf16(sT[2 * s + 1][0], sT[2 * s + 1][1]); w.w = pg8::cvt_pk_bf16(sT[2 * s + 1][2], sT[2 * s + 1][3]); pb[s] = __builtin_bit_cast(bf16x8, w); }
        f4 o[8]; float ss = 0.f;
#pragma unroll
        for (int mt = 0; mt < 8; ++mt) { o[mt] = (f4){0.f, 0.f, 0.f, 0.f}; const int rb = 128 * half + 16 * mt;
#pragma unroll
            for (int ks = 0; ks < 4; ++ks) { const bf16x8 a = *(const LAS bf16x8*)(lds + L_ST + rb * 256 + (koff0 ^ (ks * 64))); o[mt] = __builtin_amdgcn_mfma_f32_16x16x32_bf16(a, qF[ks], o[mt], 0, 0, 0); }
#pragma unroll
            for (int s = 0; s < 2; ++s) if (2 * s <= nt) { const v2u lo = *(const LAS v2u*)(lds + L_VT + rb * 128 + (voff0 ^ (s * 64))), hi = *(const LAS v2u*)(lds + L_VT + rb * 128 + (voff0 ^ (s * 64 + 32)));
                o[mt] = __builtin_amdgcn_mfma_f32_16x16x32_bf16(__builtin_bit_cast(bf16x8, (v4u){lo.x, lo.y, hi.x, hi.y}), pb[s], o[mt], 0, 0, 0); }
            ss += (o[mt][0] * o[mt][0] + o[mt][1] * o[mt][1]) + (o[mt][2] * o[mt][2] + o[mt][3] * o[mt][3]); }
        ss = nsa::radd32(nsa::radd16(ss));
        LAS float* red = (LAS float*)(lds + L_RED);
        if (gq == 0) red[half * 64 + 16 * nt + c] = ss;
        __syncthreads();
        const float rstd = 1.f / sqrtf((red[16 * nt + c] + red[64 + 16 * nt + c]) * (1.f / 256.f) + RMS_EPS);
        const int tok = t0 + 16 * nt + c;
#pragma unroll
        for (int mt = 0; mt < 8; ++mt) { const int dv = 128 * half + 16 * mt + 4 * gq; const f32x4 g4 = *(const f32x4*)((const char*)gn + (unsigned)(dv * 4));
            const v2u gg = ggr[mt];
            const float z0 = bflo(gg.x), z1 = bfhi(gg.x), z2 = bflo(gg.y), z3 = bfhi(gg.y);
            v2u w; w.x = pg8::cvt_pk_bf16(o[mt][0] * rstd * g4.x * (z0 * __builtin_amdgcn_rcpf(1.f + __expf(-z0))), o[mt][1] * rstd * g4.y * (z1 * __builtin_amdgcn_rcpf(1.f + __expf(-z1))));
            w.y = pg8::cvt_pk_bf16(o[mt][2] * rstd * g4.z * (z2 * __builtin_amdgcn_rcpf(1.f + __expf(-z2))), o[mt][3] * rstd * g4.w * (z3 * __builtin_amdgcn_rcpf(1.f + __expf(-z3))));
            *(v2u*)((char*)A2 + (unsigned)((tok * DM + h * 256 + dv) * 2)) = w; }
        __syncthreads();
    }
}

constexpr size_t WS_LH = WS_DEC + (size_t)2048 * 128 * 4;
constexpr size_t WS_PEV = WS_LH + (size_t)2 * 4096 * 256 * 4;
static_assert(WS_PEV + 1024 <= WS_KCMP, "cmp scratch overlay");
struct CmpOrder {
    int c; const bf16 *kc, *vc, *wk, *wv;
    __device__ __forceinline__ bool next(int i, pg8::Unit& u) const { if (i > 0 || c >= 32) return false; u.pm = c & 15; u.pn = 0; u.kind = c >> 4; return true; }
    __device__ __forceinline__ const char* pa(const pg8::Gemm&, const pg8::Unit& u) const { return (const char*)(u.kind ? vc : kc) + (size_t)u.pm * ((size_t)256 * 2048 * 2); }
    __device__ __forceinline__ const char* pb(const pg8::Gemm&, const pg8::Unit& u) const { return (const char*)(u.kind ? wv : wk); }
    __device__ __forceinline__ void a_ready(const pg8::Unit&) const {}
    __device__ __forceinline__ void done(const pg8::Unit&) const {}
};
struct EpiLH {
    static constexpr bool PERM = false, AFTER_DRAIN = false;
    float* LH;
    __device__ __forceinline__ void operator()(const pg8::f32x4 (&acc)[2][2][4][2], const pg8::Unit& u, int wr, int wc, int fr, int fq) const {
        const int row0 = u.kind * 4096 + u.pm * 256 + wr * 64 + fr, col0 = wc * 32 + 4 * fq;
#pragma unroll
        for (int ai = 0; ai < 2; ++ai)
#pragma unroll
            for (int m = 0; m < 4; ++m) { float* rowp = LH + (size_t)(row0 + ai * 128 + m * 16) * 256 + col0;
#pragma unroll
                for (int bj = 0; bj < 2; ++bj)
#pragma unroll
                    for (int n = 0; n < 2; ++n) *(pg8::f32x4*)(rowp + bj * 128 + n * 16) = acc[ai][bj][m][n]; }
    }
};

constexpr size_t PROWS = (size_t)MAXTILES * 256;
constexpr size_t WS_W1Q = WS_W1T;
constexpr size_t WS_W2Q = WS_W1Q + (size_t)NE * 4096 * DM;
constexpr size_t WS_HN8 = WS_W2Q + (size_t)NE * DM * DFF;
constexpr size_t WS_AMAXP = WS_HN8 + (size_t)T * DM;
constexpr size_t WS_WSC1 = WS_AMAXP + PROWS * 64 * 4;
constexpr size_t WS_WSC2 = WS_WSC1 + (size_t)NE * 4096 * 4;
constexpr size_t WS_HSC = WS_WSC2 + (size_t)NE * 2048 * 4;
constexpr size_t WS_ROWSC = WS_HSC + (size_t)T * 4;
constexpr size_t WS_ASC = WS_ROWSC + PROWS * 4;
static_assert(WS_ASC + PROWS * 4 <= WS_XN, "int8 buffers fit in the retired bf16 expert-weight region");
constexpr size_t WS_ROWTOK = WS_CTL + 512 * 1024;
static_assert(PROWS * 2 <= 512 * 1024 && DM == 2048, "row table fits; gathered rows are 2048 bytes");
constexpr size_t WS_H16 = WS_XG;
static_assert((size_t)T * DM * 2 <= PROWS * DM, "h fits below ACT8");
constexpr size_t WS_XG8 = WS_XG;
constexpr size_t WS_ACT8 = WS_XG + PROWS * DM;
constexpr int AREC = 40, AROW = 64 * AREC;
constexpr size_t WS_APROV = WS_ACT;
static_assert(PROWS * (size_t)AROW <= (size_t)MAXTILES * 256 * DFF * 2, "provisional activation records fit in the retired bf16 act region");
constexpr size_t WS_Y = WS_ACT;
constexpr size_t WS_YSC = WS_ACT + PROWS * DM;
static_assert(WS_YSC + PROWS * 64 * 4 <= WS_END, "expert output buffers fit");
static_assert(WS_ACT8 + PROWS * DM <= WS_ACT, "int8 row buffers fit in the retired gathered-row region");

__device__ __forceinline__ unsigned q8x4(float a, float b, float c, float d) {
    const float M = 12582912.f; const unsigned ua = __builtin_bit_cast(unsigned, a + M), ub = __builtin_bit_cast(unsigned, b + M), uc = __builtin_bit_cast(unsigned, c + M), ud = __builtin_bit_cast(unsigned, d + M);
    return __builtin_amdgcn_perm(ub, ua, 0x0c0c0400u) | (__builtin_amdgcn_perm(ud, uc, 0x0c0c0400u) << 16); }
__device__ __forceinline__ unsigned rq4(unsigned w, float f) { const int s = (int)w;
    const float b0 = (float)((s << 24) >> 24), b1 = (float)((s << 16) >> 24), b2 = (float)((s << 8) >> 24), b3 = (float)(s >> 24); return q8x4(b0 * f, b1 * f, b2 * f, b3 * f); }
__device__ __forceinline__ float clamp127(float v) { return __builtin_amdgcn_fmed3f(v, -127.f, 127.f); }
__device__ __forceinline__ unsigned q8x4c(float a, float b, float c, float d) { return q8x4(clamp127(a), clamp127(b), clamp127(c), clamp127(d)); }

constexpr size_t WS_WINQ = WS_WINT;
constexpr size_t WS_WISC = WS_WINT + (size_t)NPT * 256 * DM;
constexpr size_t WS_XN8 = WS_XN;
constexpr size_t WS_XSC = WS_XN + (size_t)T * DM;
constexpr size_t WS_PMAX = WS_HN;
constexpr size_t WS_PMAXI = WS_PMAX + (size_t)64 * 8 * 4096 * 4;

constexpr int NSLAB_E = NE * 192, NSLAB = NSLAB_E + 178;
struct SlabSrc { const float* W; int N; bool ok; };
__device__ __forceinline__ SlabSrc slab_src(const Params& p, int sl, int r0, int n4) {
    SlabSrc s;
    if (sl < NSLAB_E) { const int e = sl / 192, r = sl % 192; const bool isw2 = r >= 128; const int nb = isw2 ? r - 128 : r; s.N = isw2 ? 2048 : 4096;
        s.W = (isw2 ? p.in[I_W2] + (size_t)e * DFF * DM : p.in[I_W1] + (size_t)e * DM * 4096) + (size_t)r0 * s.N + nb * 32 + 4 * n4; s.ok = true; }
    else { const int nb = sl - NSLAB_E; s.N = 5672; s.ok = nb * 32 + 4 * n4 < 5672; s.W = p.in[I_WIN] + (size_t)r0 * 5672 + (s.ok ? nb * 32 + 4 * n4 : 0); }
    return s;
}
__device__ __forceinline__ void p0_slab_quant(const Params& p, LAS unsigned char* lds, int bid, int G, int tid) {
    constexpr int RS = 4104;
    LAS unsigned char* TT = lds; LAS float* part = (LAS float*)(lds + 32 * RS); LAS float* inv = part + 64 * 32; LAS int* drow = (LAS int*)(inv + 32);
    signed char* W1Q = (signed char*)(p.ws + WS_W1Q); signed char* W2Q = (signed char*)(p.ws + WS_W2Q); signed char* WIQ = (signed char*)(p.ws + WS_WINQ);
    float* WSC1 = (float*)(p.ws + WS_WSC1); float* WSC2 = (float*)(p.ws + WS_WSC2); float* WISC = (float*)(p.ws + WS_WISC);
    const int n4 = tid & 7, r0 = tid >> 3;
    f32x4 va[8], vb[8];
#define SLAB_ISSUE(dst, sl, j) do { if ((sl) < NSLAB) { const SlabSrc ss_ = slab_src(p, (sl), 2 * r0, n4); _Pragma("unroll") for (int u = 0; u < 8; ++u) dst[u] = __builtin_nontemporal_load((const f32x4*)(ss_.W + (size_t)(128 * (4 * (j) + (u >> 1)) + (u & 1)) * ss_.N)); } } while (0)
#define SLAB_USE(src, j) do { _Pragma("unroll") for (int u2 = 0; u2 < 4; ++u2) { const f32x4 xa = src[2 * u2], xb = src[2 * u2 + 1]; const int k = 2 * r0 + 128 * (4 * (j) + u2);        \
            const unsigned w0 = cvt2bf(xa.x, xb.x), w1 = cvt2bf(xa.y, xb.y), w2 = cvt2bf(xa.z, xb.z), w3 = cvt2bf(xa.w, xb.w);        \
            mx0 = __builtin_elementwise_max(mx0, __builtin_bit_cast(u16x2, w0 & 0x7fff7fffu)); mx1 = __builtin_elementwise_max(mx1, __builtin_bit_cast(u16x2, w1 & 0x7fff7fffu)); \
            mx2 = __builtin_elementwise_max(mx2, __builtin_bit_cast(u16x2, w2 & 0x7fff7fffu)); mx3 = __builtin_elementwise_max(mx3, __builtin_bit_cast(u16x2, w3 & 0x7fff7fffu)); \
            LAS unsigned char* d = TT + (4 * n4) * RS + k * 2; \
            *(LAS unsigned*)d = w0; *(LAS unsigned*)(d + RS) = w1; *(LAS unsigned*)(d + 2 * RS) = w2; *(LAS unsigned*)(d + 3 * RS) = w3; } } while (0)
    SLAB_ISSUE(va, bid, 0); SLAB_ISSUE(vb, bid, 1);
    for (int slab = bid; slab < NSLAB; slab += G) {
        u16x2 mx0 = (u16x2){0, 0}, mx1 = (u16x2){0, 0}, mx2 = (u16x2){0, 0}, mx3 = (u16x2){0, 0};
        SLAB_USE(va, 0); SLAB_ISSUE(va, slab, 2);
        SLAB_USE(vb, 1); SLAB_ISSUE(vb, slab, 3);
        SLAB_USE(va, 2); SLAB_ISSUE(va, slab + G, 0);
        SLAB_USE(vb, 3); SLAB_ISSUE(vb, slab + G, 1);
        { u16x2 t0, t1; { const unsigned m0 = __builtin_bit_cast(unsigned, mx0), m1 = __builtin_bit_cast(unsigned, mx1), m2 = __builtin_bit_cast(unsigned, mx2), m3 = __builtin_bit_cast(unsigned, mx3);
            t0 = __builtin_elementwise_max(__builtin_bit_cast(u16x2, __builtin_amdgcn_perm(m1, m0, 0x05040100u)), __builtin_bit_cast(u16x2, __builtin_amdgcn_perm(m1, m0, 0x07060302u)));
            t1 = __builtin_elementwise_max(__builtin_bit_cast(u16x2, __builtin_amdgcn_perm(m3, m2, 0x05040100u)), __builtin_bit_cast(u16x2, __builtin_amdgcn_perm(m3, m2, 0x07060302u))); }
#pragma unroll
          for (int o = 8; o < 64; o <<= 1) { t0 = __builtin_elementwise_max(t0, __builtin_bit_cast(u16x2, __shfl_xor(__builtin_bit_cast(int, t0), o))); t1 = __builtin_elementwise_max(t1, __builtin_bit_cast(u16x2, __shfl_xor(__builtin_bit_cast(int, t1), o))); }
          const unsigned a0 = __builtin_bit_cast(unsigned, t0), a1 = __builtin_bit_cast(unsigned, t1);
          if ((tid & 63) < 8) *(LAS f32x4*)(part + (tid >> 6) * 32 + 4 * n4) = (f32x4){bflo(a0), bfhi(a0), bflo(a1), bfhi(a1)}; }
        __syncthreads();
        if (tid < 32) { float m = 0.f;
#pragma unroll
            for (int q = 0; q < 8; ++q) m = fmaxf(m, part[q * 32 + tid]);
            const float sc = m > 0.f ? m * (1.f / 127.f) : 1.f; inv[tid] = 1.f / sc;
            if (slab < NSLAB_E) { const int e = slab / 192, r = slab % 192; const bool isw2 = r >= 128; const int n = (isw2 ? r - 128 : r) * 32 + tid;
                if (isw2) { drow[tid] = e * 2048 + n; WSC2[e * 2048 + n] = sc; }
                else { const int j2 = n & 2047, row = (j2 >> 7) * 256 + (n >= 2048 ? 128 : 0) + (j2 & 127); drow[tid] = e * 4096 + row; WSC1[e * 4096 + row] = sc; } }
            else { const int n = (slab - NSLAB_E) * 32 + tid; if (n < 5672) { float qsc; const int row = win_row(n, qsc); drow[tid] = row; WISC[row] = sc * qsc; } else drow[tid] = -1; } }
        __syncthreads();
        { const int kc = tid & 7, n = (tid >> 3) & 31, hf = tid >> 8; const float iv = inv[n]; const int dr = drow[n];
          signed char* dst = (slab < NSLAB_E ? ((slab % 192) >= 128 ? W2Q : W1Q) : WIQ) + (size_t)(dr < 0 ? 0 : dr) * 2048; const LAS unsigned char* src = TT + n * RS;
          if (dr >= 0) {
#pragma unroll
          for (int m8 = 0; m8 < 8; ++m8) { const int k0 = 16 * (kc + 8 * (hf + 2 * m8)); const LAS v2u* sp = (const LAS v2u*)(src + k0 * 2); const v2u a = sp[0], b = sp[1], c = sp[2], d = sp[3]; v4u o;
              o.x = q8x4(bflo(a.x) * iv, bfhi(a.x) * iv, bflo(a.y) * iv, bfhi(a.y) * iv); o.y = q8x4(bflo(b.x) * iv, bfhi(b.x) * iv, bflo(b.y) * iv, bfhi(b.y) * iv);
              o.z = q8x4(bflo(c.x) * iv, bfhi(c.x) * iv, bflo(c.y) * iv, bfhi(c.y) * iv); o.w = q8x4(bflo(d.x) * iv, bfhi(d.x) * iv, bflo(d.y) * iv, bfhi(d.y) * iv);
              *(v4u*)(dst + k0) = o; } } }
        __syncthreads();
    }
#undef SLAB_ISSUE
#undef SLAB_USE
}
struct EpiSwigluI8 {
    static constexpr bool PERM = true, AFTER_DRAIN = false;
    const float* b1; const float* rowsc; const float* wsc1; unsigned char* aprov;
    __device__ __forceinline__ void operator()(const pg8::f32x4 (&acc)[2][2][4][2], const pg8::Unit& u, int wr, int wc, int fr, int fq) const {
        typedef float f2 __attribute__((ext_vector_type(2)));
        const int e = u.kind; const int cin = wc * 32 + 8 * fq; const int col = u.pn * 128 + cin; const int row0 = u.pm * 256 + wr * 64 + fr;
        const float* bg = b1 + (size_t)e * 4096 + col; const float* bl = bg + 2048; const float* sg = wsc1 + (size_t)e * 4096 + u.pn * 256 + cin; const float* sl = sg + 128;
        f2 gb[4], lb[4], gs[4], ls[4];
#pragma unroll
        for (int k = 0; k < 4; ++k) { gb[k] = *(const f2*)(bg + 2 * k); lb[k] = *(const f2*)(bl + 2 * k); gs[k] = *(const f2*)(sg + 2 * k); ls[k] = *(const f2*)(sl + 2 * k); }
#pragma unroll
        for (int ai = 0; ai < 2; ++ai)
#pragma unroll
            for (int m = 0; m < 4; ++m) { const int r = row0 + ai * 128 + m * 16; const float rs = rowsc[r]; const f2 rs2 = (f2){rs, rs}; f2 o[4]; float mx = 0.f;
#pragma unroll
                for (int k = 0; k < 4; ++k) { const int n = k >> 1, j = (k & 1) * 2;
                    const f2 ag = (f2){(float)__float_as_int(acc[ai][0][m][n][j]), (float)__float_as_int(acc[ai][0][m][n][j + 1])}, al = (f2){(float)__float_as_int(acc[ai][1][m][n][j]), (float)__float_as_int(acc[ai][1][m][n][j + 1])};
                    f2 gl = __builtin_elementwise_fma(ag, rs2 * gs[k], gb[k]), li = __builtin_elementwise_fma(al, rs2 * ls[k], lb[k]);
                    gl.x = fminf(gl.x, 7.f); gl.y = fminf(gl.y, 7.f); li.x = __builtin_amdgcn_fmed3f(li.x, -7.f, 7.f); li.y = __builtin_amdgcn_fmed3f(li.y, -7.f, 7.f);
                    const f2 ea = gl * (f2){-2.4554669595930156f, -2.4554669595930156f};
                    const f2 den = (f2){__builtin_amdgcn_exp2f(ea.x), __builtin_amdgcn_exp2f(ea.y)} + (f2){1.f, 1.f};
                    const f2 v = (gl * (f2){__builtin_amdgcn_rcpf(den.x), __builtin_amdgcn_rcpf(den.y)}) * (li + (f2){1.f, 1.f});
                    o[k] = v; mx = fmaxf(mx, fmaxf(fabsf(v.x), fabsf(v.y))); }
                mx = nsa::rmax32(nsa::rmax16(mx));
                unsigned char* rec = aprov + (size_t)r * AROW + (u.pn * 4 + wc) * AREC;
                if (fq == 0) *(float*)rec = mx;
                const float iq = mx > 0.f ? 127.f * __builtin_amdgcn_rcpf(mx) : 0.f; const f2 iq2 = (f2){iq, iq}; v2u w;
                { const f2 q0 = o[0] * iq2, q1 = o[1] * iq2, q2 = o[2] * iq2, q3 = o[3] * iq2; w.x = q8x4(q0.x, q0.y, q1.x, q1.y); w.y = q8x4(q2.x, q2.y, q3.x, q3.y); }
                *(v2u*)(rec + 8 + 8 * fq) = w; }
    }
};
__device__ __forceinline__ void ph_actq(const Params& p, int gw, int NGW, int lane) {
    const int nrows = ((const int*)(p.ws + WS_META))[0] * 256; const unsigned char* AP = p.ws + WS_APROV;
    signed char* A8 = (signed char*)(p.ws + WS_ACT8); float* ASC = (float*)(p.ws + WS_ASC);
    for (int rb = gw; rb < nrows; rb += 2 * NGW) {
        const int r0 = rb, r1 = rb + NGW; const bool h1 = r1 < nrows; const int r1c = h1 ? r1 : r0;
        const unsigned char* s0 = AP + (size_t)r0 * AROW + lane * AREC; const unsigned char* s1 = AP + (size_t)r1c * AROW + lane * AREC;
        const float g0 = *(const float*)s0, g1 = *(const float*)s1;
        const v2u a00 = *(const v2u*)(s0 + 8), a01 = *(const v2u*)(s0 + 16), a02 = *(const v2u*)(s0 + 24), a03 = *(const v2u*)(s0 + 32);
        const v2u a10 = *(const v2u*)(s1 + 8), a11 = *(const v2u*)(s1 + 16), a12 = *(const v2u*)(s1 + 24), a13 = *(const v2u*)(s1 + 32);
        const float m0 = wave_max(g0), m1 = wave_max(g1);
        { const float f = m0 > 0.f ? g0 * __builtin_amdgcn_rcpf(m0) : 0.f;
          v4u o0, o1; o0.x = rq4(a00.x, f); o0.y = rq4(a00.y, f); o0.z = rq4(a01.x, f); o0.w = rq4(a01.y, f); o1.x = rq4(a02.x, f); o1.y = rq4(a02.y, f); o1.z = rq4(a03.x, f); o1.w = rq4(a03.y, f);
          v4u* d = (v4u*)(A8 + (size_t)r0 * DFF) + lane * 2; d[0] = o0; d[1] = o1; if (lane == 0) ASC[r0] = m0 > 0.f ? m0 * (1.f / 127.f) : 1.f; }
        if (h1) { const float f = m1 > 0.f ? g1 * __builtin_amdgcn_rcpf(m1) : 0.f;
          v4u o0, o1; o0.x = rq4(a10.x, f); o0.y = rq4(a10.y, f); o0.z = rq4(a11.x, f); o0.w = rq4(a11.y, f); o1.x = rq4(a12.x, f); o1.y = rq4(a12.y, f); o1.z = rq4(a13.x, f); o1.w = rq4(a13.y, f);
          v4u* d = (v4u*)(A8 + (size_t)r1 * DFF) + lane * 2; d[0] = o0; d[1] = o1; if (lane == 0) ASC[r1] = m1 > 0.f ? m1 * (1.f / 127.f) : 1.f; } }
}
struct EpiDownI8 {
    static constexpr bool PERM = true, AFTER_DRAIN = false;
    const float* b2; const float* roww; const float* asc; const float* wsc2; signed char* y; float* ysc;
    __device__ __forceinline__ void operator()(const pg8::f32x4 (&acc)[2][2][4][2], const pg8::Unit& u, int wr, int wc, int fr, int fq) const {
        const int e = u.kind; const int col0 = u.pn * 256 + wc * 32 + 8 * fq; const int row0 = u.pm * 256 + wr * 64 + fr;
        typedef float f2 __attribute__((ext_vector_type(2)));
        f2 bv[2][4], sv[2][4];
#pragma unroll
        for (int bj = 0; bj < 2; ++bj)
#pragma unroll
            for (int k = 0; k < 4; ++k) { bv[bj][k] = *(const f2*)(b2 + (size_t)e * DM + col0 + bj * 128 + 2 * k); sv[bj][k] = *(const f2*)(wsc2 + (size_t)e * DM + col0 + bj * 128 + 2 * k); }
#pragma unroll
        for (int ai = 0; ai < 2; ++ai)
#pragma unroll
            for (int m = 0; m < 4; ++m) { const int r = row0 + ai * 128 + m * 16; const float g = roww[r], as = asc[r]; const f2 g2 = (f2){g, g}, as2 = (f2){as, as};
#pragma unroll
                for (int bj = 0; bj < 2; ++bj) { f2 o[4];
#pragma unroll
                    for (int k = 0; k < 4; ++k) { const int n = k >> 1, j = (k & 1) * 2; const f2 a2 = (f2){(float)__float_as_int(acc[ai][bj][m][n][j]), (float)__float_as_int(acc[ai][bj][m][n][j + 1])};
                        o[k] = __builtin_elementwise_fma(a2, as2 * sv[bj][k], bv[bj][k]) * g2; }
                    float mx = fmaxf(fmaxf(fmaxf(fabsf(o[0].x), fabsf(o[0].y)), fmaxf(fabsf(o[1].x), fabsf(o[1].y))), fmaxf(fmaxf(fabsf(o[2].x), fabsf(o[2].y)), fmaxf(fabsf(o[3].x), fabsf(o[3].y))));
                    mx = nsa::rmax32(nsa::rmax16(mx));
                    if (fq == 0) ysc[(size_t)r * 64 + u.pn * 8 + bj * 4 + wc] = mx * (1.f / 127.f);
                    const float iq = mx > 0.f ? 127.f * __builtin_amdgcn_rcpf(mx) : 0.f; const f2 iq2 = (f2){iq, iq}; v2u w;
                    { const f2 q0 = o[0] * iq2, q1 = o[1] * iq2, q2 = o[2] * iq2, q3 = o[3] * iq2; w.x = q8x4(q0.x, q0.y, q1.x, q1.y); w.y = q8x4(q2.x, q2.y, q3.x, q3.y); }
                    *(v2u*)(y + (size_t)r * DM + col0 + bj * 128) = w; } }
    }
};

struct EpiProjI8 {
    static constexpr bool PERM = true, AFTER_DRAIN = false;
    unsigned char* ws;
    __device__ __forceinline__ void operator()(const pg8::f32x4 (&acc)[2][2][4][2], const pg8::Unit& u, int wr, int wc, int fr, int fq) const {
        const int cw = wc * 32 + 8 * fq; const float* XSC = (const float*)(ws + WS_XSC); const float* WISC = (const float*)(ws + WS_WISC);
        if (u.kind == 0) {
            const int tn = u.pn; bf16* base; size_t bjs = 128; int ld = 0; bool headmajor = false; bool small = false;
            if (tn < 2) { base = (bf16*)(ws + WS_GQ) + tn * 256; ld = 512; }
            else if (tn < 4) { base = (bf16*)(ws + WS_GK) + (tn - 2) * 256; ld = 512; }
            else if (tn < 8) { base = (bf16*)(ws + WS_GV) + (tn - 4) * 256; ld = 1024; }
            else if (tn < 12) { base = (bf16*)(ws + WS_GG) + (tn - 8) * 256; ld = 1024; }
            else if (tn < 16) { base = (bf16*)(ws + WS_NQ) + (tn - 12) * 256; ld = 1024; }
            else if (tn < 20) { base = (bf16*)(ws + (tn == 16 ? WS_KC : tn == 17 ? WS_VC : tn == 18 ? WS_KS : WS_KW)); headmajor = true; bjs = (size_t)SEQ * 128; }
            else { base = (bf16*)(ws + WS_SM); ld = 64; small = true; }
            if (small && wc >= 2) return;
            typedef float f2 __attribute__((ext_vector_type(2)));
            f2 cs[2][4];
#pragma unroll
            for (int bj = 0; bj < 2; ++bj)
#pragma unroll
                for (int k = 0; k < 4; ++k) cs[bj][k] = *(const f2*)(WISC + tn * 256 + bj * 128 + cw + 2 * k);
#pragma unroll
            for (int ai = 0; ai < 2; ++ai)
#pragma unroll
                for (int m = 0; m < 4; ++m) { const int r = u.pm * 256 + ai * 128 + wr * 64 + m * 16 + fr; const float rs = XSC[r];
                    const size_t rterm = headmajor ? ((size_t)(r >> 12) * 2 * SEQ + (r & (SEQ - 1))) * 128 : (size_t)r * ld;
#pragma unroll
                    for (int bj = 0; bj < 2; ++bj) { if (small && bj) continue; f2 o[4]; const f2 rs2 = (f2){rs, rs};
#pragma unroll
                        for (int k = 0; k < 4; ++k) { const int n = k >> 1, j = (k & 1) * 2; o[k] = (f2){(float)__float_as_int(acc[ai][bj][m][n][j]), (float)__float_as_int(acc[ai][bj][m][n][j + 1])} * (rs2 * cs[bj][k]); }
                        pg8::u32x4 w; w.x = pg8::cvt_pk_bf16(o[0].x, o[0].y); w.y = pg8::cvt_pk_bf16(o[1].x, o[1].y); w.z = pg8::cvt_pk_bf16(o[2].x, o[2].y); w.w = pg8::cvt_pk_bf16(o[3].x, o[3].y);
                        *(pg8::u32x4*)(base + rterm + bj * bjs + cw) = w; } }
        } else {
            bf16* base = (bf16*)(ws + (u.pn == 21 ? WS_VST : WS_VWT));
#pragma unroll
            for (int ai = 0; ai < 2; ++ai)
#pragma unroll
                for (int m = 0; m < 4; ++m) { const int dh = wr * 64 + m * 16 + fr; const float ws_ = WISC[u.pn * 256 + ai * 128 + dh];
#pragma unroll
                    for (int bj = 0; bj < 2; ++bj) { const int tok = u.pm * 256 + bj * 128 + cw; const int b = tok >> 12, s = tok & (SEQ - 1); float o[8];
                        const pg8::f32x4 x0 = *(const pg8::f32x4*)(XSC + tok), x1 = *(const pg8::f32x4*)(XSC + tok + 4);
#pragma unroll
                        for (int j = 0; j < 4; ++j) { o[j] = (float)__float_as_int(acc[ai][bj][m][0][j]) * (ws_ * x0[j]); o[4 + j] = (float)__float_as_int(acc[ai][bj][m][1][j]) * (ws_ * x1[j]); }
                        pg8::u32x4 w; w.x = pg8::cvt_pk_bf16(o[0], o[1]); w.y = pg8::cvt_pk_bf16(o[2], o[3]); w.z = pg8::cvt_pk_bf16(o[4], o[5]); w.w = pg8::cvt_pk_bf16(o[6], o[7]);
                        bf16* vrow = base + ((size_t)(b * 2 + ai) * 128 + dh) * SEQ; const int p0 = vt_pos(s);
                        *(v2u*)(vrow + p0) = (v2u){w.x, w.y}; *(v2u*)(vrow + p0 + 8) = (v2u){w.z, w.w}; } }
        }
    }
};

__device__ __forceinline__ void r1_router(const Params& p, LAS unsigned char* lds, int vb, int tid, int wave, int lane_in) {
    int lane; asm volatile("v_mbcnt_lo_u32_b32 %0, -1, 0\n\tv_mbcnt_hi_u32_b32 %0, -1, %0" : "=v"(lane)); (void)lane_in; (void)tid;
    constexpr int RP = 2052;
    LAS float* rowbuf = (LAS float*)lds;
    LAS float* part = (LAS float*)(lds + 131328);
    LAS int* tk = (LAS int*)(lds + 147712 + wave * 1024);
    LAS int* cntw = (LAS int*)(lds + 155904);
    const bf16* h = (const bf16*)(p.ws + WS_H16); const float* gf = p.in[I_NFFN]; const float* rb = p.in[I_RB];
    signed char* HN8 = (signed char*)(p.ws + WS_HN8);
    const int c = lane & 15, gq = lane >> 4, e = lane & 31, hf = lane >> 5; int mycount = 0;
    bf16x8 bh[2][8], bl[2][8];
    { unsigned o = (unsigned)((c * 2048 + 256 * wave + 8 * gq) * 2); asm volatile("" : "+v"(o));
#pragma unroll
      for (int nt = 0; nt < 2; ++nt)
#pragma unroll
        for (int s = 0; s < 8; ++s) { bh[nt][s] = *(const bf16x8*)((const char*)(p.ws + WS_WRH) + o + (nt * 16 * 2048 + 32 * s) * 2); bl[nt][s] = *(const bf16x8*)((const char*)(p.ws + WS_WRL) + o + (nt * 16 * 2048 + 32 * s) * 2); } }
    v4u hw[2][4];
#pragma unroll
    for (int r = 0; r < 2; ++r) { const v4u* xr = (const v4u*)(h + (size_t)(vb * TPV + 2 * wave + r) * DM) + lane;
#pragma unroll
      for (int q = 0; q < 4; ++q) hw[r][q] = xr[64 * q]; }
    for (int grp = 0; grp < 8; ++grp) {
#pragma unroll
        for (int r = 0; r < 2; ++r) { const int t = vb * TPV + grp * 16 + 2 * wave + r; float s = 0.f;
#pragma unroll
          for (int q = 0; q < 4; ++q) { const float a0 = bflo(hw[r][q].x), a1 = bfhi(hw[r][q].x), a2 = bflo(hw[r][q].y), a3 = bfhi(hw[r][q].y), a4 = bflo(hw[r][q].z), a5 = bfhi(hw[r][q].z), a6 = bflo(hw[r][q].w), a7 = bfhi(hw[r][q].w);
              s += ((a0 * a0 + a1 * a1) + (a2 * a2 + a3 * a3)) + ((a4 * a4 + a5 * a5) + (a6 * a6 + a7 * a7)); }
          const float rstd = 1.f / sqrtf(wave_sum(s) * (1.f / DM) + RMS_EPS);
          float mxr = 0.f; LAS f32x4* hrow = (LAS f32x4*)(rowbuf + (2 * wave + r) * RP);
#pragma unroll
          for (int j = 0; j < 8; ++j) { const int cj = 2 * lane + 128 * (j >> 1) + (j & 1); const f32x4 g4 = ((const f32x4*)gf)[cj]; const unsigned wa = (j & 1) ? hw[r][j >> 1].z : hw[r][j >> 1].x, wb = (j & 1) ? hw[r][j >> 1].w : hw[r][j >> 1].y;
              f32x4 y; y.x = bflo(wa) * rstd * g4.x; y.y = bfhi(wa) * rstd * g4.y; y.z = bflo(wb) * rstd * g4.z; y.w = bfhi(wb) * rstd * g4.w;
              hrow[cj] = y; mxr = fmaxf(mxr, fmaxf(fmaxf(fabsf(y.x), fabsf(y.y)), fmaxf(fabsf(y.z), fabsf(y.w)))); }
          mxr = wave_max(mxr); const float qs = mxr > 0.f ? mxr * (1.f / 127.f) : 1.f, qi = 1.f / qs;
          v2u* o8 = (v2u*)(HN8 + (size_t)t * DM) + lane;
#pragma unroll
          for (int q = 0; q < 4; ++q) { const f32x4 ya = hrow[2 * lane + 128 * q], yb = hrow[2 * lane + 128 * q + 1]; v2u o;
              o.x = q8x4(ya.x * qi, ya.y * qi, ya.z * qi, ya.w * qi); o.y = q8x4(yb.x * qi, yb.y * qi, yb.z * qi, yb.w * qi); o8[64 * q] = o; }
          if (lane == 0) ((float*)(p.ws + WS_HSC))[t] = qs; }
        __syncthreads();
#pragma unroll
        for (int r = 0; r < 2; ++r) { const int tn = vb * TPV + (grp < 7 ? grp + 1 : grp) * 16 + 2 * wave + r; const v4u* xr = (const v4u*)(h + (size_t)tn * DM) + lane;
#pragma unroll
          for (int q = 0; q < 4; ++q) hw[r][q] = xr[64 * q]; }
        { nsa::f4 acc[2] = {(nsa::f4){0.f, 0.f, 0.f, 0.f}, (nsa::f4){0.f, 0.f, 0.f, 0.f}};
          const LAS float* ap = rowbuf + c * RP + 256 * wave + 8 * gq;
#pragma unroll
          for (int s = 0; s < 8; ++s) { const f32x4 y0 = *(const LAS f32x4*)(ap + 32 * s), y1 = *(const LAS f32x4*)(ap + 32 * s + 4);
              v4u ah; ah.x = cvt2bf(y0.x, y0.y); ah.y = cvt2bf(y0.z, y0.w); ah.z = cvt2bf(y1.x, y1.y); ah.w = cvt2bf(y1.z, y1.w);
              v4u al; al.x = cvt2bf(y0.x - bflo(ah.x), y0.y - bfhi(ah.x)); al.y = cvt2bf(y0.z - bflo(ah.y), y0.w - bfhi(ah.y)); al.z = cvt2bf(y1.x - bflo(ah.z), y1.y - bfhi(ah.z)); al.w = cvt2bf(y1.z - bflo(ah.w), y1.w - bfhi(ah.w));
              const bf16x8 Ah = __builtin_bit_cast(bf16x8, ah), Al = __builtin_bit_cast(bf16x8, al);
#pragma unroll
              for (int nt = 0; nt < 2; ++nt) { acc[nt] = __builtin_amdgcn_mfma_f32_16x16x32_bf16(Ah, bh[nt][s], acc[nt], 0, 0, 0); acc[nt] = __builtin_amdgcn_mfma_f32_16x16x32_bf16(Ah, bl[nt][s], acc[nt], 0, 0, 0);
                  acc[nt] = __builtin_amdgcn_mfma_f32_16x16x32_bf16(Al, bh[nt][s], acc[nt], 0, 0, 0); } }
#pragma unroll
          for (int nt = 0; nt < 2; ++nt) { part[(wave * 16 + 4 * gq + 0) * 32 + 16 * nt + c] = acc[nt].x; part[(wave * 16 + 4 * gq + 1) * 32 + 16 * nt + c] = acc[nt].y;
              part[(wave * 16 + 4 * gq + 2) * 32 + 16 * nt + c] = acc[nt].z; part[(wave * 16 + 4 * gq + 3) * 32 + 16 * nt + c] = acc[nt].w; } }
        __syncthreads();
        { const int tl = 2 * wave + hf; float a = rb[e];
#pragma unroll
          for (int q = 0; q < 8; ++q) a += part[(q * 16 + tl) * 32 + e];
          int rank = 0;
#pragma unroll
          for (int mm = 0; mm < 32; ++mm) { const float lm = __shfl(a, (lane & 32) + mm); rank += (lm > a || (lm == a && mm < e)) ? 1 : 0; }
          float mx = a;
#pragma unroll
          for (int o = 1; o < 32; o <<= 1) mx = fmaxf(mx, __shfl_xor(mx, o));
          const bool sel = rank < 4; const float ex = sel ? __expf(a - mx) : 0.f; float sum = ex;
#pragma unroll
          for (int o = 1; o < 32; o <<= 1) sum += __shfl_xor(sum, o);
          const int seli = sel ? 1 : 0, selo = __shfl_xor(seli, 32);
          if (sel) { LAS int* q = tk + ((grp * 2 + hf) * 4 + rank) * 4; q[0] = e; q[1] = mycount + (hf ? selo : 0); q[2] = __builtin_bit_cast(int, ex / sum); }
          mycount += seli + selo; }
        __syncthreads();
    }
    int ln; asm volatile("v_mbcnt_lo_u32_b32 %0, -1, 0\n\tv_mbcnt_hi_u32_b32 %0, -1, %0" : "=v"(ln));
    if (ln < 32) cntw[wave * 32 + ln] = mycount;
    __syncthreads();
    if (wave == 0 && ln < 32) { int tot = 0; for (int w = 0; w < 8; ++w) tot += cntw[w * 32 + ln]; ((int*)(p.ws + WS_CNT))[vb * 32 + ln] = tot; }
    { const int i = ln >> 2, k = ln & 3; const LAS int* q = tk + (i * 4 + k) * 4; const int ee = q[0]; int base = 0; for (int w = 0; w < wave; ++w) base += cntw[w * 32 + ee];
      const int t = vb * TPV + (i >> 1) * 16 + 2 * wave + (i & 1);
      ((int*)(p.ws + WS_EIDX))[t * 4 + k] = ee; ((int*)(p.ws + WS_LRNK))[t * 4 + k] = base + q[1]; ((int*)(p.ws + WS_GATE))[t * 4 + k] = q[2]; }
    __syncthreads();
}
__device__ __forceinline__ void r2_gather(const Params& p, LAS unsigned char* lds, int vb, bool write_meta, int tid, int wave, int lane) {
    LAS int* part_tot = (LAS int*)lds;
    LAS int* part_base = part_tot + 512;
    LAS int* pbase = part_base + 512;
    const int* CNT = (const int*)(p.ws + WS_CNT);
    { const int e = tid & 31, part = tid >> 5; int tot = 0, bs = 0;
      for (int v = part * 16; v < part * 16 + 16; ++v) { const int c = CNT[v * 32 + e]; tot += c; if (v < vb) bs += c; }
      part_tot[part * 32 + e] = tot; part_base[part * 32 + e] = bs; }
    __syncthreads();
    if (tid == 0) { int ps = 0; int* meta = (int*)(p.ws + WS_META); int nt = 0;
        for (int e = 0; e < 32; ++e) { int tot = 0, bs = 0; for (int q = 0; q < 16; ++q) { tot += part_tot[q * 32 + e]; bs += part_base[q * 32 + e]; }
            pbase[e] = ps + bs; const int ntile = (tot + 255) >> 8;
            if (write_meta) for (int q = 0; q < ntile; ++q) meta[64 + nt + q] = e;
            nt += ntile; ps += ntile * 256; }
        if (write_meta) meta[0] = nt; }
    __syncthreads();
    const float* HSC = (const float*)(p.ws + WS_HSC); float* ROWSC = (float*)(p.ws + WS_ROWSC);
    const int* EIDX = (const int*)(p.ws + WS_EIDX); const int* LRNK = (const int*)(p.ws + WS_LRNK); const float* GATE = (const float*)(p.ws + WS_GATE);
    int* POS = (int*)(p.ws + WS_POS); float* ROWW = (float*)(p.ws + WS_ROWW);
    unsigned short* RT = (unsigned short*)(p.ws + WS_ROWTOK);
    { const int t = vb * TPV + (tid >> 2), k = tid & 3;
      const int pos = pbase[EIDX[t * 4 + k]] + LRNK[t * 4 + k];
      POS[t * 4 + k] = pos; ROWW[pos] = GATE[t * 4 + k]; ROWSC[pos] = HSC[t]; RT[(pos & ~255) + (pos & 63) * 4 + ((pos >> 6) & 3)] = (unsigned short)t; }
    __syncthreads();
}
__device__ __forceinline__ void pf_final(const Params& p, int gw, int NGW, int lane) {
    const signed char* Y = (const signed char*)(p.ws + WS_Y); const float* YSC = (const float*)(p.ws + WS_YSC); const int* POS = (const int*)(p.ws + WS_POS); const float* gfin = p.in[I_NFIN]; const bf16* H = (const bf16*)(p.ws + WS_H16);
    for (int t = gw; t < T; t += NGW) {
        f32x4 v[8]; const v4u* hr = (const v4u*)(H + (size_t)t * DM) + lane;
#pragma unroll
        for (int q = 0; q < 4; ++q) { const v4u w = hr[64 * q]; v[2 * q] = (f32x4){bflo(w.x), bfhi(w.x), bflo(w.y), bfhi(w.y)}; v[2 * q + 1] = (f32x4){bflo(w.z), bfhi(w.z), bflo(w.w), bfhi(w.w)}; }
#pragma unroll
        for (int k = 0; k < 4; ++k) { const int pos = POS[t * 4 + k]; const v2u* yr = (const v2u*)(Y + (size_t)pos * DM) + lane; const float* sr = YSC + (size_t)pos * 64 + (lane >> 2);
#pragma unroll
            for (int q = 0; q < 4; ++q) { const v2u w = yr[64 * q]; const float sc = sr[16 * q]; const int a = (int)w.x, b = (int)w.y;
                v[2 * q].x += (float)((a << 24) >> 24) * sc; v[2 * q].y += (float)((a << 16) >> 24) * sc; v[2 * q].z += (float)((a << 8) >> 24) * sc; v[2 * q].w += (float)(a >> 24) * sc;
                v[2 * q + 1].x += (float)((b << 24) >> 24) * sc; v[2 * q + 1].y += (float)((b << 16) >> 24) * sc; v[2 * q + 1].z += (float)((b << 8) >> 24) * sc; v[2 * q + 1].w += (float)(b >> 24) * sc; } }
        float s = 0.f;
#pragma unroll
        for (int j = 0; j < 8; ++j) s += (v[j].x * v[j].x + v[j].y * v[j].y) + (v[j].z * v[j].z + v[j].w * v[j].w);
        const float rstd = 1.f / sqrtf(wave_sum(s) * (1.f / DM) + RMS_EPS); f32x4* xr = (f32x4*)(p.out + (size_t)t * DM);
#pragma unroll
        for (int j = 0; j < 8; ++j) { const int cj = 2 * lane + 128 * (j >> 1) + (j & 1); const f32x4 g4 = ((const f32x4*)gfin)[cj]; f32x4 o; o.x = v[j].x * rstd * g4.x; o.y = v[j].y * rstd * g4.y; o.z = v[j].z * rstd * g4.z; o.w = v[j].w * rstd * g4.w; xr[cj] = o; }
    }
}


constexpr int LDS_BYTES = 159744;
constexpr int MISC_OFF = LDS_BYTES - 256;  static_assert(nsa::LDS_END <= MISC_OFF && gla::L_END <= MISC_OFF, "LDS map");
constexpr int CW_BAR = 4096, CW_XL = 16384;
__global__ __launch_bounds__(512, 2) void mega_fwd(Params p) {
    extern __shared__ __attribute__((aligned(16))) unsigned char lds_raw[];
    LAS unsigned char* lds = (LAS unsigned char*)lds_raw;
    const int G = gridDim.x, bid = blockIdx.x, NGW = G * 8;
#define PH_IDS int tid = threadIdx.x; asm volatile("" : "+v"(tid)); const int lane = tid & 63, wave = __builtin_amdgcn_readfirstlane(tid >> 6), gw = bid * 8 + wave; (void)lane; (void)gw;
    for (int u = threadIdx.x; u < 64; u += 512) ((LAS unsigned*)(lds + MISC_OFF))[u] = 0u;
    __syncthreads();
    XcdBarrier bar = xcd_barrier_post((unsigned*)(p.ws + WS_CTL) + CW_BAR, (volatile LAS unsigned*)(lds + MISC_OFF) + 8);
    { PH_IDS; p0_prologue<false, true>(p, lds, gw, NGW, wave, lane); __syncthreads(); p0_slab_quant(p, lds, bid, G, tid); }
    xcd_barrier(bar);
    { pg8::Gemm g{(const bf16*)(p.ws + WS_XN8), (const bf16*)(p.ws + WS_WINQ), T, NPT * 256, DM / 2};
      ProjOrder S; S.init(T, NPT * 256, G, bid); S.xn = g.A; S.wt = g.Bt; EpiProjI8 E{p.ws};
      pg8::gemm_phase<EpiProjI8, ProjOrder, true, true, true>(lds, g, S, E); }
    { const int ntile = (T / 256) * NPT, busy = ntile % G;
      PH_IDS; if (busy == 0) p0_prologue<true, false>(p, lds, gw, NGW, wave, lane); else if (bid >= busy) p0_prologue<true, false>(p, lds, (bid - busy) * 8 + wave, (G - busy) * 8, wave, lane); }
    xcd_barrier(bar);
    if (bid < 32) {
        pg8::Gemm g{(const bf16*)(p.ws + WS_KC), (const bf16*)(p.ws + WS_WKCT), 4096, 256, 2048};
        CmpOrder S{bid, (const bf16*)(p.ws + WS_KC), (const bf16*)(p.ws + WS_VC), (const bf16*)(p.ws + WS_WKCT), (const bf16*)(p.ws + WS_WVCT)}; EpiLH E{(float*)(p.ws + WS_LH)};
        pg8::gemm_phase<EpiLH, CmpOrder, true, true>(lds, g, S, E);
    } else { PH_IDS; ph_gla_a(p, lds, bid - 32, G - 32, tid, wave); }
    xcd_barrier(bar);
    { PH_IDS; ph_gla_b(p, bid * 512 + tid, G * 512);
      for (int i = bid * 512 + tid; i < 16 * 128; i += G * 512) { const int bgz = i >> 7, dz = i & 127; ((bf16*)(p.ws + WS_KCMP))[((size_t)bgz * 256 + 255) * 128 + dz] = 0; ((bf16*)(p.ws + WS_VCMPT))[((size_t)bgz * 128 + dz) * 256 + vt_pos(255)] = 0; }
      ph_cmp_fin(p, lds, bid, G, tid, (const float*)(p.ws + WS_LH), (const float*)(p.ws + WS_PEVP)); }
    xcd_barrier(bar);
    { PH_IDS; ph_nsa(p, lds, bid, G, tid, wave); }
    { PH_IDS; __syncthreads(); ph_gla_c(p, lds, bid, G, tid, wave); }
    xcd_barrier(bar);
    { pg8::Gemm g{(const bf16*)(p.ws + WS_A2), (const bf16*)(p.ws + WS_WOT), T, DM, DM};
      pg8::StaticOrder S; S.init(T, DM, G, bid); EpiRes E{p.in[I_X], (bf16*)(p.ws + WS_H16)};
      pg8::gemm_phase<EpiRes, pg8::StaticOrder, true, true>(lds, g, S, E); }
    xcd_barrier(bar);
    { PH_IDS; for (int vb = bid; vb < NVB; vb += G) r1_router(p, lds, vb, tid, wave, lane); }
    xcd_barrier(bar);
    { PH_IDS; for (int vb = bid; vb < NVB; vb += G) r2_gather(p, lds, vb, vb == 0, tid, wave, lane); }
    xcd_barrier(bar);
    { pg8::Gemm g{(const bf16*)(p.ws + WS_HN8), (const bf16*)(p.ws + WS_W1Q), MAXTILES * 256, 4096, DM / 2};
      MoeOrderG S; S.init((const int*)(p.ws + WS_META), 16, G, bid); S.rowtab = (const unsigned short*)(p.ws + WS_ROWTOK); EpiSwigluI8 E{p.in[I_B1], (const float*)(p.ws + WS_ROWSC), (const float*)(p.ws + WS_WSC1), p.ws + WS_APROV};
      pg8::gemm_phase<EpiSwigluI8, MoeOrderG, true, true, true, true>(lds, g, S, E); }
    xcd_barrier(bar);
    { PH_IDS; ph_actq(p, gw, NGW, lane); }
    xcd_barrier(bar);
    { pg8::Gemm g{(const bf16*)(p.ws + WS_ACT8), (const bf16*)(p.ws + WS_W2Q), MAXTILES * 256, DM, DFF / 2};
      MoeOrder S; S.init((const int*)(p.ws + WS_META), 8, G, bid); EpiDownI8 E{p.in[I_B2], (const float*)(p.ws + WS_ROWW), (const float*)(p.ws + WS_ASC), (const float*)(p.ws + WS_WSC2), (signed char*)(p.ws + WS_Y), (float*)(p.ws + WS_YSC)};
      pg8::gemm_phase<EpiDownI8, MoeOrder, true, true, true>(lds, g, S, E); }
    xcd_barrier(bar);
    { PH_IDS; pf_final(p, gw, NGW, lane); }
}

extern "C" void kernel_launch(void* const* d_in, const int* in_sizes, int n_in, void* d_out, int out_size, void* d_ws, size_t ws_size, hipStream_t stream) {
    static int grid = 0;
    if (grid == 0) {
        if (n_in != N_IN || out_size != T * DM || ws_size < WS_END) { fprintf(stderr, "kernel_launch: unexpected shapes (n_in %d out %d ws %zu need %zu)\n", n_in, out_size, ws_size, (size_t)WS_END); grid = -1; return; }
        int dev = 0, cus = 0, per_cu = 0;
        if (hipGetDevice(&dev) != hipSuccess || hipDeviceGetAttribute(&cus, hipDeviceAttributeMultiprocessorCount, dev) != hipSuccess) { grid = -1; return; }
        if (hipFuncSetAttribute((const void*)mega_fwd, hipFuncAttributeMaxDynamicSharedMemorySize, LDS_BYTES) != hipSuccess) { fprintf(stderr, "kernel_launch: hipFuncSetAttribute failed\n"); grid = -1; return; }
        if (hipOccupancyMaxActiveBlocksPerMultiprocessor(&per_cu, (const void*)mega_fwd, 512, LDS_BYTES) != hipSuccess || per_cu < 1) { fprintf(stderr, "kernel_launch: occupancy query says %d blocks per CU\n", per_cu); }
        (void)hipGetLastError();
        grid = cus;
    }
    if (grid < 0) return;
    if (hipMemsetAsync((char*)d_ws + WS_CTL, 0, CTL_BYTES, stream) != hipSuccess) return;
    Params p{};
    for (int i = 0; i < N_IN; ++i) p.in[i] = (const float*)d_in[i];
    p.out = (float*)d_out; p.ws = (unsigned char*)d_ws;
    hipLaunchKernelGGL(mega_fwd, dim3(grid), dim3(512), LDS_BYTES, stream, p);
}
```

```cpp
#include <hip/hip_runtime.h>
#include <cstdio>
#include <cstdint>
namespace pg8 {
#define PG8_LAS __attribute__((address_space(3)))
typedef unsigned short bf16_t;
typedef short bf16x8 __attribute__((ext_vector_type(8)));
typedef float f32x4 __attribute__((ext_vector_type(4)));
typedef unsigned u32x4 __attribute__((ext_vector_type(4)));
typedef unsigned v2u_t __attribute__((ext_vector_type(2)));
constexpr int BM = 256, BK = 64, HALF = 128, HTB = HALF * BK * 2  , STAGE_BYTES = 8 * HTB, NXCD = 8, WGM = 8;

__host__ __device__ __forceinline__ int lds_byte(int r, int c) { const int st = (r >> 4) * 2 + (c >> 5), rr = r & 15, cc = c & 31, ob = rr * 64 + cc * 2; return st * 1024 + (ob ^ (((ob >> 9) & 1) << 5)); }
__host__ __device__ __forceinline__ void stage_rc(int b, int& R, int& C) { const int st = b / 1024, sb = b % 1024, swz = sb ^ (((sb >> 9) & 1) << 5); R = (st >> 1) * 16 + swz / 64; C = (st & 1) * 32 + (swz % 64) / 2; }
__host__ __device__ __forceinline__ int perm32(int rho) { const int n = rho >> 4, i = rho & 15; return 8 * (i >> 2) + 4 * n + (i & 3); }

struct Unit { int pm, pn, kind; };
struct Gemm { const bf16_t* A; const bf16_t* Bt; int M, N, K; };

template <int WG = WGM> __host__ __device__ __forceinline__ void tile_of(int wgid, int nM, int nN, int& pm, int& pn) {
    const int nwg = nM * nN;
    { const int q = nwg / NXCD, r = nwg % NXCD, xcd = wgid % NXCD, off = wgid / NXCD; wgid = (xcd < r ? xcd * (q + 1) : r * (q + 1) + (xcd - r) * q) + off; }
    const int nig = WG * nN, gid = wgid / nig, fm = gid * WG, gsz = (nM - fm) < WG ? (nM - fm) : WG;
    pm = fm + ((wgid % nig) % gsz); pn = (wgid % nig) / gsz;
}
struct StaticOrder {
    int nM, nN, nwg, G, c;
    __host__ __device__ void init(int M, int N, int G_, int c_) { nM = M / BM; nN = N / BM; nwg = nM * nN; G = G_; c = c_; }
    __device__ __forceinline__ bool next(int i, Unit& u) const {
        const long L = (long)i * G + c; if (L >= nwg) return false;
        tile_of((int)L, nM, nN, u.pm, u.pn); u.kind = 0; return true;
    }
    __device__ __forceinline__ const char* pa(const Gemm& g, const Unit& u) const { return (const char*)g.A + (size_t)u.pm * ((size_t)BM * g.K * 2); }
    __device__ __forceinline__ const char* pb(const Gemm& g, const Unit& u) const { return (const char*)g.Bt + (size_t)u.pn * ((size_t)BM * g.K * 2); }
    __device__ __forceinline__ void a_ready(const Unit&) const {}
    __device__ __forceinline__ void done(const Unit&) const {}
};
__device__ __forceinline__ unsigned cvt_pk_bf16(float lo, float hi) { unsigned r; asm volatile("v_cvt_pk_bf16_f32 %0, %1, %2" : "=v"(r) : "v"(lo), "v"(hi)); return r; }
template <bool I8> __device__ __forceinline__ f32x4 mma16(bf16x8 a, bf16x8 b, f32x4 c) {
    if constexpr (I8) { typedef int i32x4 __attribute__((ext_vector_type(4)));
        return __builtin_bit_cast(f32x4, __builtin_amdgcn_mfma_i32_16x16x64_i8(__builtin_bit_cast(i32x4, a), __builtin_bit_cast(i32x4, b), __builtin_bit_cast(i32x4, c), 0, 0, 0)); }
    else return __builtin_amdgcn_mfma_f32_16x16x32_bf16(a, b, c, 0, 0, 0);
}
template <class Epi, class Sched, bool ALIGN_EPI = false, bool SP2 = false, bool I8 = false, bool GATHER = false>
__device__ __forceinline__ void gemm_phase(PG8_LAS unsigned char* lds, const Gemm g, const Sched& S, const Epi& E) {
    int tid_l = threadIdx.x; asm volatile("" : "+v"(tid_l));
    const int tid = tid_l, wid = __builtin_amdgcn_readfirstlane(tid >> 6), lane = tid & 63, wr = wid >> 2, wc = wid & 3, fr = lane & 15, fq = lane >> 4;
    const int K = g.K, nt = K / BK;
    unsigned voffA[2], voffB[2];
#pragma unroll
    for (int i = 0; i < 2; ++i) { int R, C; stage_rc(tid * 16 + i * 8192, R, C); const int Rb = Epi::PERM ? ((R & ~31) + perm32(R & 31)) : R;
        voffA[i] = (unsigned)(R * K + C) * 2u; voffB[i] = (unsigned)(Rb * K + C) * 2u; }
    const size_t kstep = (size_t)(BK * 2);
    const size_t hstep = (size_t)HALF * K * 2;
    const unsigned ldsw = (unsigned)wid * 1024u;
    const int aoff = lds_byte(wr * 64 + fr, fq * 8), boff = lds_byte(wc * 32 + fr, fq * 8);
#define PG8_SA(b, h) (((b) * 2 + (h)) * HTB)
#define PG8_SB(b, h) ((4 + (b) * 2 + (h)) * HTB)
#define PG8_STAGE(bufoff, gbase, voff) do { _Pragma("unroll") for (int _i = 0; _i < 2; ++_i) \
        __builtin_amdgcn_global_load_lds((const unsigned*)((const char*)(gbase) + (voff)[_i]), (PG8_LAS unsigned*)(lds + (bufoff) + ldsw + _i * 8192), 16, 0, 0); } while (0)
#define PG8_STAGE_A(bufoff, ptr, h) do { if constexpr (GATHER) PG8_STAGE(bufoff, ptr, cuo + 2 * (h)); else PG8_STAGE(bufoff, (ptr) + (h) * hstep, voffA); } while (0)
#define PG8_LDA(dst, b, h) do { _Pragma("unroll") for (int m = 0; m < 4; ++m) _Pragma("unroll") for (int k = 0; k < 2; ++k) dst[m][k] = *(const PG8_LAS bf16x8*)(lds + PG8_SA(b, h) + aoff + m * 2048 + k * 1024); } while (0)
#define PG8_LDB(dst, b, h) do { _Pragma("unroll") for (int n = 0; n < 2; ++n) _Pragma("unroll") for (int k = 0; k < 2; ++k) dst[n][k] = *(const PG8_LAS bf16x8*)(lds + PG8_SB(b, h) + boff + n * 2048 + k * 1024); } while (0)
#define PG8_MMA(ai, bj, At, Bt) do { __builtin_amdgcn_s_setprio(1); _Pragma("unroll") for (int m = 0; m < 4; ++m) _Pragma("unroll") for (int n = 0; n < 2; ++n) _Pragma("unroll") for (int k = 0; k < 2; ++k) \
        acc[ai][bj][m][n] = mma16<I8>(Bt[n][k], At[m][k], acc[ai][bj][m][n]); __builtin_amdgcn_s_setprio(0); } while (0)
#define PG8_WAIT_V(n) asm volatile("s_waitcnt vmcnt(" #n ")" ::: "memory")
#define PG8_WAIT_L(n) asm volatile("s_waitcnt lgkmcnt(" #n ")" ::: "memory")
#define PG8_BAR __builtin_amdgcn_s_barrier()
#define PG8_SCHED __builtin_amdgcn_sched_barrier(0)
    Unit cur, nxt; int ui = 0;
    if (!S.next(0, cur)) return;
    unsigned cuo[4] = {0u, 0u, 0u, 0u}, cb0 = 0u; v2u_t raw = {0u, 0u};
    if constexpr (GATHER) { int R0, C0; stage_rc(tid * 16, R0, C0); cb0 = (unsigned)C0 * 2u; unsigned ro = (unsigned)R0 * 8u; asm volatile("" : "+v"(ro));
        Unit u1; const bool h1 = S.next(1, u1); const v2u_t r0 = *(const v2u_t*)((const char*)S.rowtab + (size_t)cur.pm * 512 + ro); raw = *(const v2u_t*)((const char*)S.rowtab + (size_t)(h1 ? u1.pm : cur.pm) * 512 + ro);
        cuo[0] = ((r0.x & 0xffffu) << 11) + cb0; cuo[1] = ((r0.x >> 16) << 11) + cb0; cuo[2] = ((r0.y & 0xffffu) << 11) + cb0; cuo[3] = ((r0.y >> 16) << 11) + cb0; }
    f32x4 acc[2][2][4][2];
#pragma unroll
    for (int a = 0; a < 2; ++a)
#pragma unroll
        for (int b = 0; b < 2; ++b)
#pragma unroll
            for (int m = 0; m < 4; ++m)
#pragma unroll
                for (int n = 0; n < 2; ++n) acc[a][b][m][n] = (f32x4){0.f, 0.f, 0.f, 0.f};
    bf16x8 At[4][2], B0[2][2], B1[2][2];
    const char* cA = S.pa(g, cur); const char* cB = S.pb(g, cur);
    S.a_ready(cur);
    if constexpr (SP2) {
        PG8_STAGE(PG8_SB(0, 0), cB, voffB); PG8_STAGE(PG8_SB(0, 1), cB + hstep, voffB); PG8_STAGE_A(PG8_SA(0, 0), cA, 0); PG8_STAGE_A(PG8_SA(0, 1), cA, 1);
        if (wr == 1) PG8_BAR;
        PG8_WAIT_V(2); PG8_BAR;
        PG8_STAGE(PG8_SB(1, 0), cB + kstep, voffB); PG8_STAGE_A(PG8_SA(1, 0), cA + kstep, 0); PG8_STAGE(PG8_SB(1, 1), cB + hstep + kstep, voffB);
        PG8_WAIT_V(6); PG8_BAR;
    } else {
        PG8_STAGE(PG8_SB(0, 0), cB, voffB); PG8_STAGE(PG8_SA(0, 0), cA, voffA); PG8_STAGE(PG8_SB(0, 1), cB + hstep, voffB); PG8_STAGE(PG8_SA(0, 1), cA + hstep, voffA);
        if (wr == 1) PG8_BAR;
        PG8_WAIT_V(4); PG8_BAR;
        PG8_STAGE(PG8_SB(1, 0), cB + kstep, voffB); PG8_STAGE(PG8_SA(1, 0), cA + kstep, voffA); PG8_STAGE(PG8_SB(1, 1), cB + hstep + kstep, voffB);
        PG8_WAIT_V(6); PG8_BAR;
    }
    for (;;) {
        const bool has_next = S.next(ui + 1, nxt);
        const char* nA = has_next ? S.pa(g, nxt) : cA; const char* nB = has_next ? S.pb(g, nxt) : cB;
        for (int t = 0; t < nt; t += 2) {
            const bool last = (t == nt - 2);
            const char* a1 = cA + (size_t)(t + 1) * kstep;
            const char* a2 = last ? nA : cA + (size_t)(t + 2) * kstep; const char* b2 = last ? nB : cB + (size_t)(t + 2) * kstep;
            const char* a3 = a2 + kstep; const char* b3 = b2 + kstep;
            if (last && has_next) S.a_ready(nxt);
            if constexpr (SP2) {
            PG8_LDB(B0, 0, 0); PG8_LDB(B1, 0, 1); PG8_SCHED; PG8_LDA(At, 0, 0); PG8_STAGE_A(PG8_SA(1, 1), a1, 1);
            if constexpr (GATHER) { unsigned rx = raw.x, ry = raw.y; asm volatile("" : "+v"(rx), "+v"(ry));
                const unsigned n0 = ((rx & 0xffffu) << 11) + cb0, n1 = ((rx >> 16) << 11) + cb0, n2 = ((ry & 0xffffu) << 11) + cb0, n3 = ((ry >> 16) << 11) + cb0;
                cuo[0] = last ? n0 : cuo[0]; cuo[1] = last ? n1 : cuo[1]; cuo[2] = last ? n2 : cuo[2]; cuo[3] = last ? n3 : cuo[3]; }
            PG8_WAIT_V(8); PG8_WAIT_L(0); PG8_BAR; PG8_MMA(0, 0, At, B0); PG8_MMA(0, 1, At, B1); PG8_BAR; PG8_SCHED;
            PG8_LDA(At, 0, 1); PG8_STAGE(PG8_SB(0, 0), b2, voffB); PG8_STAGE(PG8_SB(0, 1), b2 + hstep, voffB); PG8_STAGE_A(PG8_SA(0, 0), a2, 0);
            PG8_WAIT_V(8); PG8_WAIT_L(0); PG8_BAR; PG8_MMA(1, 0, At, B0); PG8_MMA(1, 1, At, B1); PG8_BAR; PG8_SCHED;
            PG8_LDB(B0, 1, 0); PG8_LDB(B1, 1, 1); PG8_SCHED; PG8_LDA(At, 1, 0); PG8_STAGE_A(PG8_SA(0, 1), a2, 1);
            PG8_WAIT_V(8); PG8_WAIT_L(0); PG8_BAR; PG8_MMA(0, 0, At, B0); PG8_MMA(0, 1, At, B1); PG8_BAR; PG8_SCHED;
            PG8_LDA(At, 1, 1); PG8_STAGE(PG8_SB(1, 0), b3, voffB); PG8_STAGE(PG8_SB(1, 1), b3 + hstep, voffB); PG8_STAGE_A(PG8_SA(1, 0), a3, 0);
            PG8_WAIT_V(8); PG8_WAIT_L(0); PG8_BAR; PG8_MMA(1, 0, At, B0); PG8_MMA(1, 1, At, B1); PG8_BAR; PG8_SCHED;
            } else {
            PG8_LDB(B0, 0, 0); PG8_SCHED; PG8_LDA(At, 0, 0); PG8_STAGE(PG8_SA(1, 1), a1 + hstep, voffA);
            PG8_WAIT_L(8); PG8_BAR; PG8_WAIT_L(0); PG8_MMA(0, 0, At, B0); PG8_BAR; PG8_SCHED;
            PG8_LDB(B1, 0, 1); PG8_STAGE(PG8_SB(0, 0), b2, voffB);
            PG8_BAR; PG8_WAIT_L(0); PG8_MMA(0, 1, At, B1); PG8_BAR;
            PG8_LDA(At, 0, 1); PG8_STAGE(PG8_SA(0, 0), a2, voffA);
            PG8_BAR; PG8_WAIT_L(0); PG8_MMA(1, 0, At, B0); PG8_BAR; PG8_SCHED;
            PG8_STAGE(PG8_SB(0, 1), b2 + hstep, voffB);
            PG8_WAIT_V(6); PG8_BAR; PG8_MMA(1, 1, At, B1); PG8_BAR;
            PG8_LDB(B0, 1, 0); PG8_SCHED; PG8_LDA(At, 1, 0); PG8_STAGE(PG8_SA(0, 1), a2 + hstep, voffA);
            PG8_WAIT_L(8); PG8_BAR; PG8_WAIT_L(0); PG8_MMA(0, 0, At, B0); PG8_BAR; PG8_SCHED;
            PG8_LDB(B1, 1, 1); PG8_STAGE(PG8_SB(1, 0), b3, voffB);
            PG8_BAR; PG8_WAIT_L(0); PG8_MMA(0, 1, At, B1); PG8_BAR;
            PG8_LDA(At, 1, 1); PG8_STAGE(PG8_SA(1, 0), a3, voffA);
            PG8_BAR; PG8_WAIT_L(0); PG8_MMA(1, 0, At, B0); PG8_BAR; PG8_SCHED;
            PG8_STAGE(PG8_SB(1, 1), b3 + hstep, voffB);
            PG8_WAIT_V(6); PG8_BAR; PG8_MMA(1, 1, At, B1); PG8_BAR;
            }
        }
        if constexpr (ALIGN_EPI) { if (wr == 0) PG8_BAR; }
        if constexpr (GATHER) { static_assert(SP2 && !Epi::AFTER_DRAIN, "GATHER is written for the SP2 loop"); int R0, C0; stage_rc(tid * 16, R0, C0); Unit u2; const bool h2 = S.next(ui + 2, u2);
            unsigned ro = (unsigned)R0 * 8u; asm volatile("" : "+v"(ro)); raw = *(const v2u_t*)((const char*)S.rowtab + (size_t)(h2 ? u2.pm : cur.pm) * 512 + ro); PG8_SCHED; }
        if constexpr (!Epi::AFTER_DRAIN) { E(acc, cur, wr, wc, fr, fq); S.done(cur); }
        if (!has_next) break;
#pragma unroll
        for (int a = 0; a < 2; ++a)
#pragma unroll
            for (int b = 0; b < 2; ++b)
#pragma unroll
                for (int m = 0; m < 4; ++m)
#pragma unroll
                    for (int n = 0; n < 2; ++n) acc[a][b][m][n] = (f32x4){0.f, 0.f, 0.f, 0.f};
        cur = nxt; cA = nA; cB = nB; ++ui;
        if constexpr (ALIGN_EPI) { if (wr == 1) PG8_BAR; }
    }
    PG8_WAIT_V(0);
    if constexpr (!ALIGN_EPI) { if (wr == 0) PG8_BAR; }
    PG8_BAR;
    if constexpr (Epi::AFTER_DRAIN) { E.fused(acc, cur, wr, wc, fr, fq, lds, wid, lane); S.done(cur); }
#undef PG8_SA
#undef PG8_SB
#undef PG8_STAGE
#undef PG8_STAGE_A
#undef PG8_LDA
#undef PG8_LDB
#undef PG8_MMA
#undef PG8_WAIT_V
#undef PG8_WAIT_L
#undef PG8_BAR
#undef PG8_SCHED
}
}

#define GAS __attribute__((address_space(1)))
#define LAS __attribute__((address_space(3)))
typedef unsigned short bf16;
typedef unsigned v4u __attribute__((ext_vector_type(4)));
typedef unsigned v2u __attribute__((ext_vector_type(2)));
typedef float f32x4 __attribute__((ext_vector_type(4)));
typedef short bf16x8 __attribute__((ext_vector_type(8)));

constexpr int NB = 8, SEQ = 4096, DM = 2048, T = NB * SEQ;
constexpr int NPT = 23;
constexpr int NE = 32, DFF = 2048;
constexpr int MAXTILES = 544;
constexpr float RMS_EPS = 1e-5f;
constexpr int NVB = 256, TPV = T / NVB;

enum { I_X = 0, I_NMIX, I_WIN, I_WA2, I_BA, I_GLAG, I_PEK, I_WK1, I_WK2, I_PEV, I_WV1, I_WV2, I_NSAG, I_RELB, I_WOUT, I_NFFN, I_RW, I_RB, I_W1, I_B1, I_W2, I_B2, I_NFIN, N_IN };

constexpr size_t MiB = 1u << 20;
constexpr size_t al(size_t x) { return (x + 255) & ~(size_t)255; }
constexpr size_t WS_CTL = 0, CTL_BYTES = 1 * MiB;
constexpr size_t WS_CNT = WS_CTL + CTL_BYTES;
constexpr size_t WS_META = WS_CNT + al(NVB * 32 * 4);
constexpr size_t WS_EIDX = WS_META + al((64 + MAXTILES) * 4);
constexpr size_t WS_LRNK = WS_EIDX + al((size_t)T * 4 * 4);
constexpr size_t WS_GATE = WS_LRNK + al((size_t)T * 4 * 4);
constexpr size_t WS_POS = WS_GATE + al((size_t)T * 4 * 4);
constexpr size_t WS_ROWW = WS_POS + al((size_t)T * 4 * 4);
constexpr size_t WS_WINT = al(WS_ROWW + (size_t)MAXTILES * 256 * 4);
constexpr size_t WS_WOT = WS_WINT + (size_t)NPT * 256 * DM * 2;
constexpr size_t WS_WKCT = WS_WOT + (size_t)DM * DM * 2;
constexpr size_t WS_WVCT = WS_WKCT + (size_t)256 * 2048 * 2;
constexpr size_t WS_W1T = WS_WVCT + (size_t)256 * 2048 * 2;
constexpr size_t WS_W2T = WS_W1T + (size_t)NE * 4096 * DM * 2;
constexpr size_t WS_XN = WS_W2T + (size_t)NE * DM * DFF * 2;
constexpr size_t WS_GQ = WS_XN + (size_t)T * DM * 2;
constexpr size_t WS_GK = WS_GQ + (size_t)T * 512 * 2;
constexpr size_t WS_GV = WS_GK + (size_t)T * 512 * 2;
constexpr size_t WS_GG = WS_GV + (size_t)T * 1024 * 2;
constexpr size_t WS_NQ = WS_GG + (size_t)T * 1024 * 2;
constexpr size_t WS_KC = WS_NQ + (size_t)T * 1024 * 2;
constexpr size_t WS_VC = WS_KC + (size_t)T * 256 * 2;
constexpr size_t WS_KS = WS_VC + (size_t)T * 256 * 2;
constexpr size_t WS_KW = WS_KS + (size_t)T * 256 * 2;
constexpr size_t WS_VST = WS_KW + (size_t)T * 256 * 2;
constexpr size_t WS_VWT = WS_VST + (size_t)T * 256 * 2;
constexpr size_t WS_SM = WS_VWT + (size_t)T * 256 * 2;
constexpr size_t WS_LA = WS_SM + (size_t)T * 64 * 2;
constexpr size_t WS_OG = WS_LA + (size_t)T * 512 * 4;
constexpr size_t WS_ON = WS_OG + (size_t)T * 1024 * 4;
constexpr size_t WS_KCMP = WS_ON + (size_t)T * 1024 * 4;
constexpr size_t WS_VCMPT = WS_KCMP + (size_t)16 * 256 * 128 * 2;
constexpr size_t WS_A2 = WS_VCMPT + (size_t)16 * 256 * 128 * 2;
constexpr size_t WS_HN = WS_A2 + (size_t)T * DM * 2;
constexpr size_t WS_XG = WS_HN + (size_t)T * DM * 2;
constexpr size_t WS_ACT = WS_XG + (size_t)MAXTILES * 256 * DM * 2;
constexpr size_t WS_END = WS_ACT + (size_t)MAXTILES * 256 * DFF * 2;

typedef unsigned short u16x2 __attribute__((ext_vector_type(2)));
__device__ __forceinline__ unsigned cvt2bf(float lo, float hi) { unsigned r; asm("v_cvt_pk_bf16_f32 %0, %1, %2" : "=v"(r) : "v"(lo), "v"(hi)); return r; }
__device__ __forceinline__ unsigned f2bf(float f) { return cvt2bf(f, f) & 0xffffu; }
__device__ __forceinline__ unsigned pk2(float lo, float hi) { return cvt2bf(lo, hi); }
__device__ __forceinline__ float bf2f(unsigned short v) { return __builtin_bit_cast(float, (unsigned)v << 16); }
__device__ __forceinline__ float bflo(unsigned w) { return __builtin_bit_cast(float, w << 16); }
__device__ __forceinline__ float bfhi(unsigned w) { return __builtin_bit_cast(float, w & 0xffff0000u); }
__device__ __forceinline__ float wave_sum(float v) {
#pragma unroll
    for (int o = 1; o < 64; o <<= 1) v += __shfl_xor(v, o);
    return v;
}
__device__ __forceinline__ float wave_max(float v) {
#pragma unroll
    for (int o = 1; o < 64; o <<= 1) v = fmaxf(v, __shfl_xor(v, o));
    return v;
}
__device__ __forceinline__ int vt_pos(int k) { return (k & ~63) | ((k & 32) + ((k >> 2) & 3) * 8 + ((k >> 4) & 1) * 4 + (k & 3)); }
#define LDS_WAIT() asm volatile("s_waitcnt lgkmcnt(0)" ::: "memory")

__device__ const unsigned char kBucket[128] = {0, 1, 2, 3, 4, 5, 6, 7, 8, 9, 10, 11, 12, 13, 14, 15, 16, 16, 16, 17, 17, 18, 18, 18, 19, 19, 19, 20, 20, 20, 20, 21, 21, 21, 21, 22, 22, 22, 22, 22, 23, 23, 23, 23, 23, 23, 24, 24, 24, 24, 24, 24, 25, 25, 25, 25, 25, 25, 25, 26, 26, 26, 26, 26, 26, 26, 26, 27, 27, 27, 27, 27, 27, 27, 27, 27, 27, 28, 28, 28, 28, 28, 28, 28, 28, 28, 28, 29, 29, 29, 29, 29, 29, 29, 29, 29, 29, 29, 29, 30, 30, 30, 30, 30, 30, 30, 30, 30, 30, 30, 30, 30, 30, 31, 31, 31, 31, 31, 31, 31, 31, 31, 31, 31, 31, 31, 31, 31};

struct Params {
    const float* in[N_IN];
    float* out;
    unsigned char* ws;
};

template <class F>
__device__ __forceinline__ void transpose_item(const float* W, int ldw, int k0, int n0, int nlim, LAS float* scr, int lane, F dst) {
#pragma unroll 8
    for (int i = 0; i < 32; ++i) { const int kk = 2 * i + (lane >> 5); const int n = n0 + (lane & 31); scr[kk * 33 + (lane & 31)] = n < nlim ? W[(size_t)(k0 + kk) * ldw + n] : 0.f; }
    LDS_WAIT(); asm volatile("" ::: "memory");
    const int c = lane & 7;
#pragma unroll
    for (int j = 0; j < 4; ++j) { const int nn = (lane >> 3) + 8 * j; const int n = n0 + nn; const LAS float* s = scr + (8 * c) * 33 + nn;
        bf16* rowp; float sc;
        if (n < nlim && dst(n, rowp, sc)) {
            v4u o; o.x = pk2(s[0 * 33] * sc, s[1 * 33] * sc); o.y = pk2(s[2 * 33] * sc, s[3 * 33] * sc); o.z = pk2(s[4 * 33] * sc, s[5 * 33] * sc); o.w = pk2(s[6 * 33] * sc, s[7 * 33] * sc);
            *(v4u*)(rowp + 8 * c) = o; } }
    LDS_WAIT(); asm volatile("" ::: "memory");
}
__device__ __forceinline__ int win_row(int n, float& sc) {
    sc = 1.f;
    if (n < 512) { sc = 0.08838834764831845f; return n; }
    if (n < 1024) return n;
    if (n < 2048) return n;
    if (n < 3072) return n;
    if (n < 3088) return 5120 + (n - 3072);
    if (n < 4112) { sc = 0.08838834764831845f; return 3072 + (n - 3088); }
    if (n < 4368) return 4096 + (n - 4112);
    if (n < 4624) return 4352 + (n - 4368);
    if (n < 4880) return 4608 + (n - 4624);
    if (n < 5136) return 5376 + (n - 4880);
    if (n < 5392) return 4864 + (n - 5136);
    if (n < 5648) return 5632 + (n - 5392);
    return 5136 + (n - 5648);
}
constexpr size_t WS_WRH = WS_HN, WS_WRL = WS_HN + (size_t)32 * 2048 * 2;
constexpr size_t WS_PEVP = WS_W2T;
template <bool ITEMS, bool XN>
__device__ __forceinline__ void p0_prologue(const Params& p, LAS unsigned char* lds, int gw, int NGW, int wave, int lane) {
    LAS float* scr = (LAS float*)(lds + wave * 16384);
    bf16* WinT = (bf16*)(p.ws + WS_WINT); bf16* WoT = (bf16*)(p.ws + WS_WOT); bf16* WkcT = (bf16*)(p.ws + WS_WKCT); bf16* WvcT = (bf16*)(p.ws + WS_WVCT);
    bf16* W1T = (bf16*)(p.ws + WS_W1T); bf16* W2T = (bf16*)(p.ws + WS_W2T);
    constexpr int I_IN = 32 * 178, I_O = 32 * 64, I_C = 64 * 4, I_E1 = 32 * 128, I_E2 = 32 * 64;
    constexpr int I_PE = 2 * 64;
    constexpr int I_RW2 = 64;
    constexpr int NITEMS = I_O + 2 * I_C + I_PE + I_RW2;
    (void)I_IN; (void)WinT;
    if constexpr (ITEMS) for (int it = gw; it < NITEMS; it += NGW) {
        int r = it;
        if (r < I_O) { const int kb = r / 64, nb = r % 64, k0 = kb * 64;
            transpose_item(p.in[I_WOUT], DM, k0, nb * 32, DM, scr, lane, [&](int n, bf16*& rowp, float& sc) { sc = 1.f; rowp = WoT + (size_t)n * DM + k0; return true; }); continue; } r -= I_O;
        if (r >= 2 * I_C + I_PE) { r -= 2 * I_C + I_PE; const float* rw = p.in[I_RW]; bf16* WRH = (bf16*)(p.ws + WS_WRH); bf16* WRL = (bf16*)(p.ws + WS_WRL); const int e = lane & 31;
#pragma unroll 4
            for (int kk = 0; kk < 16; ++kk) { const int k = r * 32 + 2 * kk + (lane >> 5); const float w = rw[k * 32 + e]; const unsigned hi = f2bf(w); WRH[e * 2048 + k] = (bf16)hi; WRL[e * 2048 + k] = (bf16)f2bf(w - bf2f((unsigned short)hi)); }
            continue; }
        if (r >= 2 * I_C) { r -= 2 * I_C; const int which = r >> 6, kq = r & 63; const float* pe = p.in[which ? I_PEV : I_PEK] + kq * 64; const float* w1 = p.in[which ? I_WV1 : I_WK1] + (size_t)kq * 64 * 128 + lane;
            float a0 = 0.f, a1 = 0.f;
#pragma unroll
            for (int k = 0; k < 64; ++k) { const float pv = pe[k]; a0 += pv * w1[k * 128]; a1 += pv * w1[k * 128 + 64]; }
            float* dst = (float*)(p.ws + WS_PEVP) + (size_t)(which * 64 + kq) * 128 + lane; dst[0] = a0; dst[64] = a1; continue; }
        { const int which = r / I_C; r %= I_C; const int kb = r / 4, nb = r % 4, k0 = kb * 64;
            bf16* dstm = which ? WvcT : WkcT;
            transpose_item(p.in[which ? I_WV1 : I_WK1], 128, k0, nb * 32, 128, scr, lane, [&](int n, bf16*& rowp, float& sc) { sc = 1.f; rowp = dstm + (size_t)(n + (k0 >= 2048 ? 128 : 0)) * 2048 + (k0 & 2047); return true; }); }
        (void)I_E1; (void)I_E2; (void)W1T; (void)W2T;
    }
    const float* x = p.in[I_X]; const float* gm = p.in[I_NMIX];
    if constexpr (XN) for (int m = gw; m < T; m += NGW) {
        const f32x4* xr = (const f32x4*)(x + (size_t)m * DM) + lane; f32x4 v[8]; float s = 0.f;
#pragma unroll
        for (int j = 0; j < 8; ++j) { v[j] = xr[64 * j]; s += (v[j].x * v[j].x + v[j].y * v[j].y) + (v[j].z * v[j].z + v[j].w * v[j].w); }
        const float rstd = 1.f / sqrtf(wave_sum(s) * (1.f / DM) + RMS_EPS);
        float mxr = 0.f;
#pragma unroll
        for (int j = 0; j < 8; ++j) { const f32x4 g4 = ((const f32x4*)gm)[lane + 64 * j]; v[j].x *= rstd * g4.x; v[j].y *= rstd * g4.y; v[j].z *= rstd * g4.z; v[j].w *= rstd * g4.w;
            mxr = fmaxf(mxr, fmaxf(fmaxf(fabsf(v[j].x), fabsf(v[j].y)), fmaxf(fabsf(v[j].z), fabsf(v[j].w)))); }
        mxr = wave_max(mxr); const float qs = mxr > 0.f ? mxr * (1.f / 127.f) : 1.f, qi = 1.f / qs;
        unsigned* o4 = (unsigned*)(p.ws + WS_XN + (size_t)m * DM) + lane;
#pragma unroll
        for (int j = 0; j < 8; ++j) { const float M = 12582912.f;
            const unsigned ua = __builtin_bit_cast(unsigned, v[j].x * qi + M), ub = __builtin_bit_cast(unsigned, v[j].y * qi + M), uc = __builtin_bit_cast(unsigned, v[j].z * qi + M), ud = __builtin_bit_cast(unsigned, v[j].w * qi + M);
            o4[64 * j] = __builtin_amdgcn_perm(ub, ua, 0x0c0c0400u) | (__builtin_amdgcn_perm(ud, uc, 0x0c0c0400u) << 16); }
        if (lane == 0) ((float*)(p.ws + WS_XN + (size_t)T * DM))[m] = qs;
    }
}
#define XB_TMO      128
#define XB_XCNT(j)  (256  + 64 * (j))
#define XB_XSUB(j)  (1280 + 64 * (j))
#define XB_XGEN(j)  (2304 + 64 * (j))
#define XB_TOP      3328
#define XB_TOPGEN   3392
#define XCD_BAR_WORDS 3456
#define XB_SPIN_CAP (1u << 18)

__device__ __forceinline__ unsigned xb_ld(unsigned* p)              { return __hip_atomic_load(p, __ATOMIC_RELAXED, __HIP_MEMORY_SCOPE_AGENT); }
__device__ __forceinline__ unsigned xb_add(unsigned* p, unsigned v) { return __hip_atomic_fetch_add(p, v, __ATOMIC_RELAXED, __HIP_MEMORY_SCOPE_AGENT); }
__device__ __forceinline__ unsigned xb_xcc_id() { return (unsigned)__builtin_amdgcn_s_getreg((3 << 11) | 20) & 0xFu; }
#define XB_SPIN(cond, bar) do { unsigned _sp = 0; while (cond) { __builtin_amdgcn_s_sleep(1); \
    if ((++_sp & 255u) == 0u) { if (xb_ld(&(bar)[XB_TMO])) break; if (_sp > XB_SPIN_CAP) { atomicAdd(&(bar)[XB_TMO], 1u); break; } } } } while (0)

struct XcdBarrier {
    unsigned* bar; unsigned x;
    volatile LAS unsigned* st;
};

__device__ __forceinline__ XcdBarrier xcd_barrier_post(unsigned* bar, volatile LAS unsigned* st) {
    XcdBarrier b; b.bar = bar; b.x = xb_xcc_id(); b.st = st;
    if (threadIdx.x == 0) (void)xb_add(&bar[XB_XCNT(b.x)], 1u);
    return b;
}
__device__ __forceinline__ void xcd_barrier_complete(unsigned* bar, unsigned x, unsigned& nloc, unsigned& nx) {
    const unsigned G = gridDim.x * gridDim.y * gridDim.z;
    unsigned sum, cnt, mine, sp = 0u;
    for (;;) {
        sum = 0u; cnt = 0u; mine = 0u;
#pragma unroll
        for (unsigned j = 0; j < 16; ++j) { const unsigned c = xb_ld(&bar[XB_XCNT(j)]); sum += c; cnt += (c > 0u) ? 1u : 0u; mine = (j == x) ? c : mine; }
        if (sum == G) break;
        __builtin_amdgcn_s_sleep(1);
        if ((++sp & 255u) == 0u) { if (xb_ld(&bar[XB_TMO])) break; if (sp > XB_SPIN_CAP) { atomicAdd(&bar[XB_TMO], 1u); break; } }
    }
    nloc = mine > 0u ? mine : 1u; nx = cnt > 0u ? cnt : 1u;
}

__device__ __forceinline__ void xcd_barrier(const XcdBarrier& b) {
    asm volatile("s_waitcnt vmcnt(0)" ::: "memory");
    __syncthreads();
    if (threadIdx.x == 0) {
        unsigned* bar = b.bar;
        __builtin_amdgcn_s_waitcnt(0);
        unsigned nloc = b.st[0], nx = b.st[1];
        if (nloc == 0u) { xcd_barrier_complete(bar, b.x, nloc, nx); b.st[0] = nloc; b.st[1] = nx; }
        const unsigned old = xb_add(&bar[XB_XSUB(b.x)], 1u);
        const unsigned gen = old / nloc;
        if (old + 1u == (gen + 1u) * nloc) {
            __builtin_amdgcn_fence(__ATOMIC_RELEASE, "agent");
            asm volatile("s_waitcnt vmcnt(0)" ::: "memory");
            const unsigned og = xb_add(&bar[XB_TOP], 1u);
            const unsigned tg = og / nx;
            if (og + 1u == (tg + 1u) * nx) xb_add(&bar[XB_TOPGEN], 1u);
            else XB_SPIN(xb_ld(&bar[XB_TOPGEN]) == tg, bar);
            __builtin_amdgcn_fence(__ATOMIC_ACQUIRE, "agent");
            xb_add(&bar[XB_XGEN(b.x)], 1u);
            asm volatile("s_waitcnt vmcnt(0)" ::: "memory");
        } else {
            XB_SPIN(xb_ld(&bar[XB_XGEN(b.x)]) == gen, bar);
            __builtin_amdgcn_fence(__ATOMIC_ACQUIRE, "agent");
            asm volatile("s_waitcnt vmcnt(0)" ::: "memory");
        }
    }
    __syncthreads();
}

struct ProjOrder : pg8::StaticOrder {
    const bf16* xn; const bf16* wt;
    __device__ __forceinline__ bool next(int i, pg8::Unit& u) const { if (!pg8::StaticOrder::next(i, u)) return false; u.kind = (u.pn >= 21) ? 1 : 0; return true; }
    __device__ __forceinline__ const char* pa(const pg8::Gemm& g, const pg8::Unit& u) const { return u.kind ? (const char*)wt + (size_t)u.pn * ((size_t)256 * g.K * 2) : (const char*)xn + (size_t)u.pm * ((size_t)256 * g.K * 2); }
    __device__ __forceinline__ const char* pb(const pg8::Gemm& g, const pg8::Unit& u) const { return u.kind ? (const char*)xn + (size_t)u.pm * ((size_t)256 * g.K * 2) : (const char*)wt + (size_t)u.pn * ((size_t)256 * g.K * 2); }
};
struct EpiRes {
    static constexpr bool PERM = true, AFTER_DRAIN = false;
    const float* x; bf16* h;
    __device__ __forceinline__ void operator()(const pg8::f32x4 (&acc)[2][2][4][2], const pg8::Unit& u, int wr, int wc, int fr, int fq) const {
        const int row0 = u.pm * 256 + wr * 64 + fr, col0 = u.pn * 256 + wc * 32 + 8 * fq;
#pragma unroll
        for (int ai = 0; ai < 2; ++ai) { pg8::f32x4 xv[4][2][2];
#pragma unroll
            for (int m = 0; m < 4; ++m)
#pragma unroll
                for (int bj = 0; bj < 2; ++bj) { const float* xp = x + (size_t)(row0 + ai * 128 + m * 16) * DM + col0 + bj * 128; xv[m][bj][0] = *(const pg8::f32x4*)xp; xv[m][bj][1] = *(const pg8::f32x4*)(xp + 4); }
#pragma unroll
            for (int m = 0; m < 4; ++m) { const size_t off = (size_t)(row0 + ai * 128 + m * 16) * DM + col0;
#pragma unroll
                for (int bj = 0; bj < 2; ++bj) { const pg8::f32x4 x0 = xv[m][bj][0], x1 = xv[m][bj][1];
                    const pg8::f32x4 a0 = x0 + acc[ai][bj][m][0], a1 = x1 + acc[ai][bj][m][1]; pg8::u32x4 w;
                    w.x = pg8::cvt_pk_bf16(a0.x, a0.y); w.y = pg8::cvt_pk_bf16(a0.z, a0.w); w.z = pg8::cvt_pk_bf16(a1.x, a1.y); w.w = pg8::cvt_pk_bf16(a1.z, a1.w);
                    *(pg8::u32x4*)(h + off + bj * 128) = w; } } }
    }
};
struct MoeOrder {
    int nM, nN, nwg, G, c; const int* tile_exp;
    __device__ __forceinline__ void init(const int* meta, int nN_, int G_, int c_) { nM = meta[0]; nN = nN_; nwg = nM * nN; G = G_; c = c_; tile_exp = meta + 64; }
    __device__ __forceinline__ bool next(int i, pg8::Unit& u) const {
        const long L = (long)i * G + c; if (L >= nwg) return false;
        pg8::tile_of<8>((int)L, nM, nN, u.pm, u.pn); u.kind = tile_exp[u.pm]; return true;
    }
    __device__ __forceinline__ const char* pa(const pg8::Gemm& g, const pg8::Unit& u) const { return (const char*)g.A + (size_t)u.pm * ((size_t)256 * g.K * 2); }
    __device__ __forceinline__ const char* pb(const pg8::Gemm& g, const pg8::Unit& u) const { return (const char*)g.Bt + ((size_t)u.kind * nN + u.pn) * ((size_t)256 * g.K * 2); }
    __device__ __forceinline__ void a_ready(const pg8::Unit&) const {}
    __device__ __forceinline__ void done(const pg8::Unit&) const {}
};

struct MoeOrderG : MoeOrder { const unsigned short* rowtab;
    __device__ __forceinline__ const char* pa(const pg8::Gemm& g, const pg8::Unit&) const { return (const char*)g.A; } };

__device__ __forceinline__ float gelu_tanh(float x) { const float u = 0.7978845608028654f * (x + 0.044715f * x * x * x); const float e = __expf(2.f * u); return 0.5f * x * (1.f + (1.f - 2.f / (e + 1.f))); }
__device__ __forceinline__ void ph_cmp_fin(const Params& p, LAS unsigned char* lds, int bid, int G, int tid, const float* LHall, const float* PEVall) {
    const int grp = tid >> 7, n = tid & 127, ngrp = G * 4, total = 2 * 16 * 255, iters = (total + ngrp - 1) / ngrp;
    LAS float* hid = (LAS float*)lds + grp * 128;
    float pevs[2];
#pragma unroll
    for (int w = 0; w < 2; ++w) { float s = 0.f;
#pragma unroll 8
        for (int q = 0; q < 64; ++q) s += PEVall[(size_t)(w * 64 + q) * 128 + n];
        pevs[w] = s; }
    float wcol[128]; int wh = -1;
    for (int it = 0; it < iters; ++it) { int id = it * ngrp + bid * 4 + grp; if (id >= total) id = total - 1;
        const int which = id / (16 * 255), rem = id % (16 * 255), bg = rem / 255, c = rem % 255;
        if (which != wh) { const float* w2 = p.in[which ? I_WV2 : I_WK2]; wh = which;
#pragma unroll
            for (int mm = 0; mm < 128; ++mm) wcol[mm] = w2[mm * 128 + n]; }
        const float* LH = LHall + ((size_t)which * 4096 + bg * 256) * 256;
        const float a = LH[(size_t)c * 256 + n] + LH[(size_t)(c + 1) * 256 + 128 + n] + (which ? pevs[1] : pevs[0]);
        hid[n] = gelu_tanh(a);
        __syncthreads();
        float o0 = 0.f, o1 = 0.f, o2 = 0.f, o3 = 0.f;
#pragma unroll
        for (int m4 = 0; m4 < 32; ++m4) { const f32x4 hv = *(const LAS f32x4*)(hid + 4 * m4); o0 += hv.x * wcol[4 * m4]; o1 += hv.y * wcol[4 * m4 + 1]; o2 += hv.z * wcol[4 * m4 + 2]; o3 += hv.w * wcol[4 * m4 + 3]; }
        const float o = (o0 + o1) + (o2 + o3);
        if (which == 0) ((bf16*)(p.ws + WS_KCMP))[((size_t)bg * 256 + c) * 128 + n] = (bf16)f2bf(o);
        else ((bf16*)(p.ws + WS_VCMPT))[((size_t)bg * 128 + n) * 256 + vt_pos(c)] = (bf16)f2bf(o);
        __syncthreads(); }
}

namespace nsa {
constexpr int KB0 = 0, KB1 = 16384, VB0 = 32768, VB1 = 49152, LUT = 65536;
constexpr int QST = LUT + 4096, IMP = QST + 65536, SELM = IMP + 16384, LDS_END = SELM + 512;
constexpr float LOG2E = 1.4426950408889634f;
typedef float f4 __attribute__((ext_vector_type(4)));

typedef unsigned u2v __attribute__((ext_vector_type(2)));
__device__ __forceinline__ float rmax16(float x) { const unsigned u = __float_as_uint(x); const u2v r = __builtin_amdgcn_permlane16_swap(u, u, false, false); return fmaxf(__uint_as_float(r[0]), __uint_as_float(r[1])); }
__device__ __forceinline__ float rmax32(float x) { const unsigned u = __float_as_uint(x); const u2v r = __builtin_amdgcn_permlane32_swap(u, u, false, false); return fmaxf(__uint_as_float(r[0]), __uint_as_float(r[1])); }
__device__ __forceinline__ float radd16(float x) { const unsigned u = __float_as_uint(x); const u2v r = __builtin_amdgcn_permlane16_swap(u, u, false, false); return __uint_as_float(r[0]) + __uint_as_float(r[1]); }
__device__ __forceinline__ float radd32(float x) { const unsigned u = __float_as_uint(x); const u2v r = __builtin_amdgcn_permlane32_swap(u, u, false, false); return __uint_as_float(r[0]) + __uint_as_float(r[1]); }
__device__ __forceinline__ float raddq(float x) { x += __int_as_float(__builtin_amdgcn_update_dpp(0, __float_as_int(x), 0xB1, 0xF, 0xF, true)); x += __int_as_float(__builtin_amdgcn_update_dpp(0, __float_as_int(x), 0x4E, 0xF, 0xF, true)); return x; }
struct Ctx {
    LAS unsigned char* lds; int tid, lane, wave, c, gq, r;
    int s0, cur;
    const LAS unsigned char* qst;
    int pos0;
    const LAS float* lutrow;
    int koff0, voff0;
    unsigned kdo[2], vdoc[2], vdos[2];
};
__device__ __forceinline__ void dma_k(const Ctx& C, const bf16* kt, LAS unsigned char* kb) {
#pragma unroll
    for (int i = 0; i < 2; ++i) __builtin_amdgcn_global_load_lds((const unsigned*)((const char*)kt + C.kdo[i]), (LAS unsigned*)(kb + (2 * C.wave + i) * 1024), 16, 0, 0); }
__device__ __forceinline__ void dma_v(const Ctx& C, const bf16* vt, const unsigned (&vdo)[2], LAS unsigned char* vb) {
#pragma unroll
    for (int i = 0; i < 2; ++i) __builtin_amdgcn_global_load_lds((const unsigned*)((const char*)vt + vdo[i]), (LAS unsigned*)(vb + (2 * C.wave + i) * 1024), 16, 0, 0); }

__device__ __forceinline__ void compute_st(const Ctx& C, const LAS unsigned char* kb, f4 (&s)[2][4]) {
    bf16x8 an = *(const LAS bf16x8*)(kb + C.koff0), an2 = *(const LAS bf16x8*)(kb + 4096 + C.koff0);
    bf16x8 qn0 = *(const LAS bf16x8*)(C.qst), qn1 = *(const LAS bf16x8*)(C.qst + 4 * 1024);
#pragma unroll
    for (int ks = 0; ks < 4; ++ks) { const bf16x8 q0 = qn0, q1 = qn1;
#pragma unroll
        for (int kt = 0; kt < 4; ++kt) { const bf16x8 a = an; const int jn = ks * 4 + kt + 2; an = an2;
            if (jn < 16) an2 = *(const LAS bf16x8*)(kb + (jn & 3) * 4096 + (C.koff0 ^ ((jn >> 2) * 64)));
            if (kt == 2 && ks < 3) { qn0 = *(const LAS bf16x8*)(C.qst + (ks + 1) * 1024); qn1 = *(const LAS bf16x8*)(C.qst + (4 + ks + 1) * 1024); }
            __builtin_amdgcn_sched_barrier(0);
            s[0][kt] = __builtin_amdgcn_mfma_f32_16x16x32_bf16(a, q0, ks == 0 ? (f4){0.f, 0.f, 0.f, 0.f} : s[0][kt], 0, 0, 0);
            s[1][kt] = __builtin_amdgcn_mfma_f32_16x16x32_bf16(a, q1, ks == 0 ? (f4){0.f, 0.f, 0.f, 0.f} : s[1][kt], 0, 0, 0); } }
}
__device__ __forceinline__ void compute_pv(const Ctx& C, const LAS unsigned char* vb, const f4 (&p)[2][4], f4 (&o)[2][8]) {
    bf16x8 an = *(const LAS bf16x8*)(vb + C.voff0), an2 = *(const LAS bf16x8*)(vb + 2048 + C.voff0);
#pragma unroll
    for (int i = 0; i < 2; ++i) { bf16x8 pb[2];
#pragma unroll
        for (int qt = 0; qt < 2; ++qt) { v4u w; w.x = pg8::cvt_pk_bf16(p[qt][2 * i][0], p[qt][2 * i][1]); w.y = pg8::cvt_pk_bf16(p[qt][2 * i][2], p[qt][2 * i][3]);
            w.z = pg8::cvt_pk_bf16(p[qt][2 * i + 1][0], p[qt][2 * i + 1][1]); w.w = pg8::cvt_pk_bf16(p[qt][2 * i + 1][2], p[qt][2 * i + 1][3]); pb[qt] = __builtin_bit_cast(bf16x8, w); }
#pragma unroll
        for (int dt = 0; dt < 8; ++dt) { const bf16x8 a = an; const int jn = i * 8 + dt + 2; an = an2;
            if (jn < 16) an2 = *(const LAS bf16x8*)(vb + (jn & 7) * 2048 + (C.voff0 ^ ((jn >> 3) * 64)));
            __builtin_amdgcn_sched_barrier(0);
#pragma unroll
            for (int qt = 0; qt < 2; ++qt) o[qt][dt] = __builtin_amdgcn_mfma_f32_16x16x32_bf16(a, pb[qt], o[qt][dt], 0, 0, 0); } }
}
enum { M_CMP = 0, M_SEL = 1, M_WIN = 2 };
template <int MODE, bool FAR = false>
__device__ __forceinline__ void mask_bias(const Ctx& C, f4 (&s)[2][4], int kb, int n, const LAS unsigned* selw) {
    const float NEG = -__builtin_inff();
#pragma unroll
    for (int qt = 0; qt < 2; ++qt) {
        bool tokok = true;
        if (MODE == M_SEL) tokok = ((selw[(4 * qt + (C.c >> 2)) * 2 + (n >> 5)] >> (n & 31)) & 1u) != 0u;
        if (FAR) { const float be = tokok ? C.lutrow[127] : NEG;
#pragma unroll
            for (int kt = 0; kt < 4; ++kt)
#pragma unroll
                for (int rg = 0; rg < 4; ++rg) s[qt][kt][rg] = __builtin_fmaf(s[qt][kt][rg], LOG2E, be);
            continue; }
        const int dbase = (MODE == M_CMP) ? (C.pos0 + 4 * qt - 31 - 16 * (kb + 4 * C.gq)) : (C.pos0 + 4 * qt - (kb + 4 * C.gq));
#pragma unroll
        for (int kt = 0; kt < 4; ++kt) {
#pragma unroll
            for (int rg = 0; rg < 4; ++rg) { const int d = (MODE == M_CMP) ? dbase - 16 * (16 * kt + rg) : dbase - (16 * kt + rg);
                int di = d < 0 ? 0 : d; di = di > 127 ? 127 : di; const float bias = C.lutrow[di];
                bool ok = tokok && d >= 0; if (MODE == M_WIN) ok = ok && d < 512;
                s[qt][kt][rg] = ok ? __builtin_fmaf(s[qt][kt][rg], LOG2E, bias) : NEG; }
            asm volatile("" ::: "memory"); }
    }
}
__device__ __forceinline__ void softmax_step(f4 (&s)[2][4], float (&m)[2], float (&l)[2], f4 (&o)[2][8], bool rescale_o) {
#pragma unroll
    for (int qt = 0; qt < 2; ++qt) { float mx = s[qt][0][0];
#pragma unroll
        for (int kt = 0; kt < 4; ++kt)
#pragma unroll
            for (int rg = 0; rg < 4; ++rg) mx = fmaxf(mx, s[qt][kt][rg]);
        mx = rmax32(rmax16(mx));
        const float mn = fmaxf(m[qt], mx), alpha = __builtin_amdgcn_exp2f(m[qt] - mn); m[qt] = mn; float ps = 0.f;
#pragma unroll
        for (int kt = 0; kt < 4; ++kt)
#pragma unroll
            for (int rg = 0; rg < 4; ++rg) { const float e = __builtin_amdgcn_exp2f(s[qt][kt][rg] - mn); s[qt][kt][rg] = e; ps += e; }
        l[qt] = l[qt] * alpha + ps;
        if (rescale_o && __any(alpha != 1.f)) {
#pragma unroll
            for (int dt = 0; dt < 8; ++dt) o[qt][dt] = o[qt][dt] * alpha; }
    }
}
template <int MODE>
__device__ __forceinline__ void softmax_far(const Ctx& C, f4 (&s)[2][4], int n, const LAS unsigned* selw, float (&m)[2], float (&l)[2], f4 (&o)[2][8]) {
    const float b31 = C.lutrow[127];
#pragma unroll
    for (int qt = 0; qt < 2; ++qt) {
        float be = b31;
        if (MODE == M_SEL) { const bool tokok = ((selw[(4 * qt + (C.c >> 2)) * 2 + (n >> 5)] >> (n & 31)) & 1u) != 0u; be = tokok ? b31 : -__builtin_inff(); }
        float mx = fmaxf(fmaxf(s[qt][0][0], s[qt][0][1]), fmaxf(s[qt][0][2], s[qt][0][3]));
#pragma unroll
        for (int kt = 1; kt < 4; ++kt) mx = fmaxf(mx, fmaxf(fmaxf(s[qt][kt][0], s[qt][kt][1]), fmaxf(s[qt][kt][2], s[qt][kt][3])));
        mx = rmax32(rmax16(mx));
        const float mt = __builtin_fmaf(mx, LOG2E, be), mn = fmaxf(m[qt], mt), alpha = __builtin_amdgcn_exp2f(m[qt] - mn), c0 = be - mn; m[qt] = mn; float ps = 0.f;
#pragma unroll
        for (int kt = 0; kt < 4; ++kt)
#pragma unroll
            for (int rg = 0; rg < 4; ++rg) { const float e = __builtin_amdgcn_exp2f(__builtin_fmaf(s[qt][kt][rg], LOG2E, c0)); s[qt][kt][rg] = e; ps += e; }
        l[qt] = l[qt] * alpha + ps;
        if (__any(alpha != 1.f)) {
#pragma unroll
            for (int dt = 0; dt < 8; ++dt) o[qt][dt] = o[qt][dt] * alpha; }
    }
}
}

__device__ __forceinline__ void ph_nsa(const Params& p, LAS unsigned char* lds, int idx0, int idxstride, int tid_in, int wave) {
    using namespace nsa;
    int tid = tid_in; asm volatile("" : "+v"(tid));
    const int lane = tid & 63;
    Ctx C; C.lds = lds; C.tid = tid; C.lane = lane; C.wave = wave; C.c = lane & 15; C.gq = lane >> 4; C.r = lane & 3;
    C.koff0 = C.c * 256 + ((C.gq ^ C.c) * 16);
#pragma unroll
    for (int i = 0; i < 2; ++i) { const int piece = 2 * wave + i;
        { const int row = piece * 4 + (lane >> 4), chunk = (lane & 15) ^ (row & 15); C.kdo[i] = (unsigned)(row * 256 + chunk * 16); }
        { const int row = piece * 8 + (lane >> 3), chunk = (lane & 7) ^ ((row >> 1) & 7); C.vdoc[i] = (unsigned)(row * 256 * 2 + chunk * 16); C.vdos[i] = (unsigned)(row * SEQ * 2 + chunk * 16); } }
    C.voff0 = C.c * 128 + ((C.gq ^ ((C.c >> 1) & 7)) * 16);
    const bf16* NQ = (const bf16*)(p.ws + WS_NQ); const bf16* SM = (const bf16*)(p.ws + WS_SM); bf16* A2 = (bf16*)(p.ws + WS_A2);
    const float* relb = p.in[I_RELB]; const float* nsag = p.in[I_NSAG];
    LAS float* lut = (LAS float*)(lds + LUT);
    for (int i = tid; i < 8 * 128; i += 512) { const int hh = i >> 7, d = i & 127; lut[i] = relb[(int)kBucket[d] * 8 + hh] * LOG2E; }
    __syncthreads();
    LAS unsigned char* qstw = lds + QST + wave * 8192 + lane * 16; C.qst = qstw;
    LAS float* imp = (LAS float*)(lds + IMP + wave * 2048);
    LAS unsigned long long* selm = (LAS unsigned long long*)(lds + SELM + wave * 64);
#define NSA_SYNC() do { asm volatile("s_waitcnt vmcnt(0)" ::: "memory"); __syncthreads(); } while (0)
    for (int idx = idx0; idx < 512; idx += idxstride) {
        const int rnd = idx >> 8, kq = idx & 255, b = kq & 7, tq = rnd == 0 ? 63 - (kq >> 3) : (kq >> 3);
        C.s0 = tq * 64; C.cur = tq;
        const int tokl0 = 8 * wave + (C.c >> 2);
        C.pos0 = C.s0 + tokl0;
        float ssq[2] = {0.f, 0.f};
        for (int g = 0; g < 2; ++g) {
            const int bg = b * 2 + g, h = g * 4 + C.r;
            C.lutrow = lut + h * 128;
            const bf16* KCMP = (const bf16*)(p.ws + WS_KCMP) + (size_t)bg * 256 * 128; const bf16* VCMPT = (const bf16*)(p.ws + WS_VCMPT) + (size_t)bg * 128 * 256;
#pragma unroll
            for (int qt = 0; qt < 2; ++qt) { const unsigned qo = (unsigned)(((b * SEQ + (C.pos0 + 4 * qt)) * 1024 + h * 128 + 8 * C.gq) * 2);
#pragma unroll
                for (int ks = 0; ks < 4; ++ks) *(LAS bf16x8*)(qstw + (qt * 4 + ks) * 1024) = *(const bf16x8*)((const char*)NQ + qo + ks * 64); }
#pragma unroll
            for (int i = 0; i < 2; ++i) *(LAS f32x4*)((LAS unsigned char*)imp + lane * 16 + i * 1024) = (f32x4){0.f, 0.f, 0.f, 0.f};
#define NSA_OROW(qt) ((char*)A2 + (unsigned)(((b * SEQ + C.pos0 + 4 * (qt)) * DM + 1024 + h * 128 + 4 * C.gq) * 2))
            const int cmaxb = C.s0 + 63 - 31; const int nct = cmaxb >= 0 ? ((cmaxb >> 4) >> 6) + 1 : 0;
            float m[2] = {-1e30f, -1e30f}, l[2] = {0.f, 0.f};
            f4 o[2][8];
            if (nct > 0) {
                dma_k(C, KCMP, lds + KB0); NSA_SYNC();
                for (int ct = 0; ct < nct; ++ct) { const int buf = ct & 1;
                    if (ct + 1 < nct) dma_k(C, KCMP + (ct + 1) * 64 * 128, lds + (buf ? KB0 : KB1));
                    f4 s[2][4]; compute_st(C, lds + (buf ? KB1 : KB0), s); mask_bias<M_CMP>(C, s, 64 * ct, 0, (const LAS unsigned*)selm); softmax_step(s, m, l, o, false);
                    NSA_SYNC(); }
            }
            float inv[2];
#pragma unroll
            for (int qt = 0; qt < 2; ++qt) { const float lt = radd32(radd16(l[qt])); inv[qt] = lt > 0.f ? 1.f / lt : 0.f; }
#pragma unroll
            for (int qt = 0; qt < 2; ++qt)
#pragma unroll
                for (int dt = 0; dt < 8; ++dt) o[qt][dt] = (f4){0.f, 0.f, 0.f, 0.f};
            if (nct > 0) {
                dma_k(C, KCMP, lds + KB0); dma_v(C, VCMPT, C.vdoc, lds + VB0); NSA_SYNC();
                for (int ct = 0; ct < nct; ++ct) { const int buf = ct & 1;
                    if (ct + 1 < nct) { dma_k(C, KCMP + (ct + 1) * 64 * 128, lds + (buf ? KB0 : KB1)); dma_v(C, VCMPT + 64 * (ct + 1), C.vdoc, lds + (buf ? VB0 : VB1)); }
                    f4 s[2][4]; compute_st(C, lds + (buf ? KB1 : KB0), s); mask_bias<M_CMP>(C, s, 64 * ct, 0, (const LAS unsigned*)selm);
#pragma unroll
                    for (int qt = 0; qt < 2; ++qt)
#pragma unroll
                        for (int kt = 0; kt < 4; ++kt) {
#pragma unroll
                            for (int rg = 0; rg < 4; ++rg) s[qt][kt][rg] = __builtin_amdgcn_exp2f(s[qt][kt][rg] - m[qt]) * inv[qt];
                            float po = (s[qt][kt][0] + s[qt][kt][1]) + (s[qt][kt][2] + s[qt][kt][3]), p3 = s[qt][kt][3];
                            po = raddq(po); p3 = raddq(p3);
                            const int nb = 16 * ct + 4 * kt + C.gq, tl = 4 * qt + (C.c >> 2);
                            if (C.r == 0) { __hip_atomic_fetch_add((float*)(imp + tl * 64 + nb), po, __ATOMIC_RELAXED, __HIP_MEMORY_SCOPE_WORKGROUP); if (nb + 1 < 64) __hip_atomic_fetch_add((float*)(imp + tl * 64 + nb + 1), p3, __ATOMIC_RELAXED, __HIP_MEMORY_SCOPE_WORKGROUP); } }
                    compute_pv(C, lds + (buf ? VB1 : VB0), s, o);
                    NSA_SYNC(); }
            }
            LDS_WAIT(); __builtin_amdgcn_wave_barrier();
            for (int tk = 0; tk < 8; ++tk) { const int n = lane; float sc;
                if (n == 0 || n == C.cur || n == C.cur - 1) sc = 1e4f; else if (n <= C.cur) sc = imp[tk * 64 + n]; else sc = -1.f;
                const int key = ((sc < 0.f ? 0 : __float_as_int(sc) + 64) & ~63) | (63 - n);
                int rank = 0;
#pragma unroll
                for (int mm = 0; mm < 64; ++mm) rank += (__builtin_amdgcn_readlane(key, mm) > key) ? 1 : 0;
                const unsigned long long mk = __ballot(rank < 16);
                if (lane == 0) selm[tk] = mk; }
            LDS_WAIT(); __builtin_amdgcn_wave_barrier();
#pragma unroll
            for (int qt = 0; qt < 2; ++qt) { const float gt = 1.f / (1.f + __expf(-bf2f(*(const bf16*)((const char*)SM + (unsigned)(((b * SEQ + (C.pos0 + 4 * qt)) * 64 + 16 + h) * 2)))));
#pragma unroll
                for (int dt = 0; dt < 8; ++dt) { const f4 v = o[qt][dt] * gt; *(v2u*)(NSA_OROW(qt) + 32 * dt) = (v2u){pg8::cvt_pk_bf16(v[0], v[1]), pg8::cvt_pk_bf16(v[2], v[3])}; } }
#pragma unroll
            for (int br = 1; br <= 2; ++br) {
                const bf16* KX = (const bf16*)(p.ws + (br == 1 ? WS_KS : WS_KW)) + bg * SEQ * 128; const bf16* VX = (const bf16*)(p.ws + (br == 1 ? WS_VST : WS_VWT)) + bg * 128 * SEQ;
                const int n0 = br == 1 ? 0 : (C.cur >= 8 ? C.cur - 8 : 0), n1 = C.cur;
                m[0] = m[1] = -1e30f; l[0] = l[1] = 0.f;
#pragma unroll
                for (int qt = 0; qt < 2; ++qt)
#pragma unroll
                    for (int dt = 0; dt < 8; ++dt) o[qt][dt] = (f4){0.f, 0.f, 0.f, 0.f};
                int f0 = n1 + 1, f1 = n0 - 1;
                for (int n = n0; n <= n1; ++n) { const bool fa = (C.s0 - (64 * n + 63) >= 113) && (br == 1 || (C.s0 + 63 - 64 * n) < 512); if (fa) { f0 = n < f0 ? n : f0; f1 = n; } }
                const int cntf = f1 >= f0 ? f1 - f0 + 1 : 0, cnt = n1 - n0 + 1, nlo = cntf ? f0 - n0 : cnt;
#define NSA_TILE(i) ((i) < cntf ? f0 + (i) : (((i) - cntf) < nlo ? n0 + ((i) - cntf) : f1 + 1 + ((i) - cntf - nlo)))
#define NSA_BODY(FARF) { const int n = NSA_TILE(i); const int buf = i & 1; \
                    if (i + 1 < cnt) { const int nn = NSA_TILE(i + 1); dma_k(C, KX + nn * 64 * 128, lds + (buf ? KB0 : KB1)); dma_v(C, VX + 64 * nn, C.vdos, lds + (buf ? VB0 : VB1)); } \
                    { f4 s[2][4]; compute_st(C, lds + (buf ? KB1 : KB0), s);        \
                        if (FARF) { if (br == 1) softmax_far<M_SEL>(C, s, n, (const LAS unsigned*)selm, m, l, o); else softmax_far<M_WIN>(C, s, n, (const LAS unsigned*)selm, m, l, o); } \
                        else { if (br == 1) mask_bias<M_SEL, false>(C, s, 64 * n, n, (const LAS unsigned*)selm); else mask_bias<M_WIN, false>(C, s, 64 * n, n, (const LAS unsigned*)selm); \
                            softmax_step(s, m, l, o, true); } \
                        compute_pv(C, lds + (buf ? VB1 : VB0), s, o); } \
                    NSA_SYNC(); }
                { const int nf = NSA_TILE(0); dma_k(C, KX + nf * 64 * 128, lds + KB0); dma_v(C, VX + 64 * nf, C.vdos, lds + VB0); NSA_SYNC(); }
                int i = 0;
                for (; i < cntf; ++i) NSA_BODY(true)
                for (; i < cnt; ++i) NSA_BODY(false)
#undef NSA_BODY
#undef NSA_TILE
                asm volatile("s_waitcnt vmcnt(0)" ::: "memory");
#pragma unroll
                for (int qt = 0; qt < 2; ++qt) { const float lt = radd32(radd16(l[qt]));
                    const int row = b * SEQ + (C.pos0 + 4 * qt);
                    const float sc = (1.f / (1.f + __expf(-bf2f(*(const bf16*)((const char*)SM + (unsigned)((row * 64 + 16 + 8 * br + h) * 2)))))) / lt;
#pragma unroll
                    for (int dt = 0; dt < 8; ++dt) { const f4 v = o[qt][dt] * sc; v2u* sp = (v2u*)(NSA_OROW(qt) + 32 * dt); const v2u pv = *sp;
                        const float a0 = bflo(pv.x) + v[0], a1 = bfhi(pv.x) + v[1], a2 = bflo(pv.y) + v[2], a3 = bfhi(pv.y) + v[3];
                        if (br == 2) ssq[qt] += (a0 * a0 + a1 * a1) + (a2 * a2 + a3 * a3);
                        *sp = (v2u){pg8::cvt_pk_bf16(a0, a1), pg8::cvt_pk_bf16(a2, a3)}; } }
            }
        }
        float rstd[2];
#pragma unroll
        for (int qt = 0; qt < 2; ++qt) { const float t = radd32(radd16(raddq(ssq[qt]))); rstd[qt] = 1.f / sqrtf(t * (1.f / 1024.f) + RMS_EPS); }
        asm volatile("s_waitcnt vmcnt(0)" ::: "memory");
#pragma unroll
        for (int qt = 0; qt < 2; ++qt) { const int sub = C.r * 4 + C.gq; bf16* orow = (bf16*)((char*)A2 + (unsigned)(((b * SEQ + (C.pos0 + 4 * qt)) * DM + 1024) * 2 + sub * 16)); const int subz = 0;
#pragma unroll
            for (int j = 0; j < 8; ++j) { const int col = (j * 16 + subz) * 8; v4u w = *(const v4u*)((const char*)orow + (unsigned)(col * 2)); const f32x4 g0 = *(const f32x4*)((const char*)nsag + (unsigned)(col * 4 + sub * 32)), g1 = *(const f32x4*)((const char*)nsag + (unsigned)(col * 4 + sub * 32 + 16)); const float rs = rstd[qt];
                w.x = pk2(bflo(w.x) * rs * g0.x, bfhi(w.x) * rs * g0.y); w.y = pk2(bflo(w.y) * rs * g0.z, bfhi(w.y) * rs * g0.w); w.z = pk2(bflo(w.z) * rs * g1.x, bfhi(w.z) * rs * g1.y); w.w = pk2(bflo(w.w) * rs * g1.z, bfhi(w.w) * rs * g1.w);
                *(v4u*)((char*)orow + (unsigned)(col * 2)) = w; } }
        NSA_SYNC();
    }
#undef NSA_SYNC
#undef NSA_OROW
}
constexpr size_t WS_ST = WS_LA;
constexpr size_t WS_DEC = WS_ST + (size_t)2048 * 256 * 128 * 2;
static_assert(WS_DEC + (size_t)2048 * 128 * 4 <= WS_KCMP, "gla scratch overlay");
namespace gla {
typedef float f4 __attribute__((ext_vector_type(4)));
constexpr int L_ST = 0, L_KT = 65536, L_QT = 81920, L_VT = 98304, L_GA = 131072, L_GT = L_GA + 4096, L_RED = L_GT + 2048, L_END = L_RED + 512;
struct CumIn { float w[16]; float bb; v4u sm; };
__device__ __forceinline__ CumIn load_cum(const Params& p, int tid, int t0, int h) { CumIn x;
    const bf16* SM = (const bf16*)(p.ws + WS_SM); const float* wa2 = p.in[I_WA2]; const float* ba = p.in[I_BA]; const int dk = tid & 127;
    x.sm = (v4u){0u, 0u, 0u, 0u};
    if (tid < 128) { const int j = tid >> 1, hf = tid & 1; x.sm = *(const v4u*)((const char*)SM + (unsigned)(((t0 + j) * 64 + hf * 8) * 2)); }
#pragma unroll
    for (int r = 0; r < 16; ++r) x.w[r] = wa2[r * 512 + h * 128 + dk];
    x.bb = ba[h * 128 + dk];
    return x; }
__device__ __forceinline__ void chunk_cumsum(const CumIn& in, LAS unsigned char* lds, int tid, float (&P)[16], float& blast) {
    LAS float* ga = (LAS float*)(lds + L_GA); LAS float* gt = (LAS float*)(lds + L_GT);
    if (tid < 128) { const int j = tid >> 1, hf = tid & 1; const v4u w = in.sm;
        LAS float* d = ga + j * 16 + hf * 8; d[0] = bflo(w.x); d[1] = bfhi(w.x); d[2] = bflo(w.y); d[3] = bfhi(w.y); d[4] = bflo(w.z); d[5] = bfhi(w.z); d[6] = bflo(w.w); d[7] = bfhi(w.w); }
    const int dk = tid & 127, jq = tid >> 7;
    const float bb = in.bb;
    __syncthreads();
    float run = 0.f;
#pragma unroll
    for (int jj = 0; jj < 16; ++jj) { const LAS f32x4* gr = (const LAS f32x4*)(ga + (16 * jq + jj) * 16); float z = bb;
#pragma unroll
        for (int r4 = 0; r4 < 4; ++r4) { const f32x4 g4 = gr[r4]; z += g4.x * in.w[4 * r4] + g4.y * in.w[4 * r4 + 1] + g4.z * in.w[4 * r4 + 2] + g4.w * in.w[4 * r4 + 3]; }
        run += (fminf(z, 0.f) - __logf(1.f + __expf(-fabsf(z)))) * (1.f / 16.f);   P[jj] = run; }
    gt[jq * 128 + dk] = run;
    __syncthreads();
    float off = 0.f, tot = 0.f;
#pragma unroll
    for (int q = 0; q < 4; ++q) { const float t = gt[q * 128 + dk]; tot += t; if (q < jq) off += t; }
#pragma unroll
    for (int jj = 0; jj < 16; ++jj) P[jj] += off;
    blast = tot;
}
struct RawK { v4u r[2]; }; struct RawV { v4u r[4]; };
__device__ __forceinline__ RawK load_raw_k(const bf16* src  , int tid, int t0, int h) { RawK x;
#pragma unroll
    for (int q = 0; q < 2; ++q) { const int id = tid + 512 * q, j = id >> 4, c16 = id & 15; x.r[q] = *(const v4u*)((const char*)src + (unsigned)(((t0 + j) * 512 + h * 128 + c16 * 8) * 2)); }
    return x; }
__device__ __forceinline__ void store_raw_k(LAS unsigned char* dst, int tid, const RawK& x) {
#pragma unroll
    for (int q = 0; q < 2; ++q) { const int id = tid + 512 * q, j = id >> 4, c16 = id & 15; *(LAS v4u*)(dst + j * 256 + c16 * 16) = x.r[q]; } }
__device__ __forceinline__ RawV load_raw_v(const Params& p, int tid, int t0, int h) { const bf16* GV = (const bf16*)(p.ws + WS_GV); RawV x;
#pragma unroll
    for (int q = 0; q < 4; ++q) { const int id = tid + 512 * q, j = id >> 5, c = id & 31; x.r[q] = *(const v4u*)((const char*)GV + (unsigned)(((t0 + j) * 1024 + h * 256 + c * 8) * 2)); }
    return x; }
__device__ __forceinline__ void store_raw_v(LAS unsigned char* dst, int tid, const RawV& x) {
#pragma unroll
    for (int q = 0; q < 4; ++q) { const int id = tid + 512 * q, j = id >> 5, c = id & 31; *(LAS v4u*)(dst + j * 512 + c * 16) = x.r[q]; } }
__device__ __forceinline__ void fill_vt(LAS unsigned char* lds, const LAS unsigned char* rv, int tid) {
    const int dv = tid & 255, jh = tid >> 8;
    unsigned short v[32];
#pragma unroll
    for (int jj = 0; jj < 32; ++jj) v[jj] = *(const LAS bf16*)(rv + (32 * jh + jj) * 512 + dv * 2);
    LAS unsigned char* row = lds + L_VT + dv * 128; const int f = (dv >> 1) & 7;
#pragma unroll
    for (int q = 0; q < 4; ++q) { v4u w; w.x = v[8 * q] | ((unsigned)v[8 * q + 1] << 16); w.y = v[8 * q + 2] | ((unsigned)v[8 * q + 3] << 16); w.z = v[8 * q + 4] | ((unsigned)v[8 * q + 5] << 16); w.w = v[8 * q + 6] | ((unsigned)v[8 * q + 7] << 16);
        *(LAS v4u*)(row + (((4 * jh + q) ^ f) * 16)) = w; }
}
}

__device__ __forceinline__ void ph_gla_a(const Params& p, LAS unsigned char* lds, int u0, int ustride, int tid_in, int wave) {
    using namespace gla;
    int tid = tid_in; asm volatile("" : "+v"(tid));
    const int lane = tid & 63, c = lane & 15, gq = lane >> 4;
    const bf16* GK = (const bf16*)(p.ws + WS_GK); bf16* ST = (bf16*)(p.ws + WS_ST); float* DEC = (float*)(p.ws + WS_DEC);
    RawK rk; RawV rv;
    CumIn ci;
    if (u0 < 2048) { const int bh = u0 >> 6, ch = u0 & 63; rk = load_raw_k(GK, tid, (bh >> 2) * SEQ + ch * 64, bh & 3); rv = load_raw_v(p, tid, (bh >> 2) * SEQ + ch * 64, bh & 3); ci = load_cum(p, tid, (bh >> 2) * SEQ + ch * 64, bh & 3); }
    for (int unit = u0; unit < 2048; unit += ustride) {
        const int bh = unit >> 6, ch = unit & 63, b = bh >> 2, h = bh & 3, t0 = b * SEQ + ch * 64;
        store_raw_k(lds + 0, tid, rk); store_raw_v(lds + 16384, tid, rv);
        float P[16], blast; chunk_cumsum(ci, lds, tid, P, blast);
        { const int dk = tid & 127, jq = tid >> 7;
          unsigned short kv[16];
#pragma unroll
          for (int jj = 0; jj < 16; ++jj) kv[jj] = *(const LAS bf16*)(lds + (16 * jq + jj) * 256 + dk * 2);
          unsigned pk[8];
#pragma unroll
          for (int q = 0; q < 8; ++q) pk[q] = pk2(bf2f(kv[2 * q]) * __expf(blast - P[2 * q]), bf2f(kv[2 * q + 1]) * __expf(blast - P[2 * q + 1]));
          LAS unsigned char* row = lds + L_KT + dk * 128; const int f = (dk >> 1) & 7;
          *(LAS v4u*)(row + (((2 * jq) ^ f) * 16)) = (v4u){pk[0], pk[1], pk[2], pk[3]}; *(LAS v4u*)(row + (((2 * jq + 1) ^ f) * 16)) = (v4u){pk[4], pk[5], pk[6], pk[7]};
          if (jq == 0) DEC[unit * 128 + dk] = __expf(blast); }
        fill_vt(lds, lds + 16384, tid);
        __syncthreads();
        { const int un = unit + ustride < 2048 ? unit + ustride : unit, bhn = un >> 6, chn = un & 63; rk = load_raw_k(GK, tid, (bhn >> 2) * SEQ + chn * 64, bhn & 3); rv = load_raw_v(p, tid, (bhn >> 2) * SEQ + chn * 64, bhn & 3); ci = load_cum(p, tid, (bhn >> 2) * SEQ + chn * 64, bhn & 3); }
        f4 acc[16];
        const int f = (c >> 1) & 7;
        bf16x8 aF[2];
#pragma unroll
        for (int ks = 0; ks < 2; ++ks) aF[ks] = *(const LAS bf16x8*)(lds + L_KT + (16 * wave + c) * 128 + (((4 * ks + gq) ^ f) * 16));
#pragma unroll
        for (int nt = 0; nt < 16; ++nt) { acc[nt] = (f4){0.f, 0.f, 0.f, 0.f};
#pragma unroll
            for (int ks = 0; ks < 2; ++ks) { const bf16x8 bF = *(const LAS bf16x8*)(lds + L_VT + (16 * nt + c) * 128 + (((4 * ks + gq) ^ f) * 16)); acc[nt] = __builtin_amdgcn_mfma_f32_16x16x32_bf16(aF[ks], bF, acc[nt], 0, 0, 0); } }
        char* dst = (char*)ST + (size_t)unit * (256 * 128 * 2) + (unsigned)((c * 128 + 16 * wave + 4 * gq) * 2);
#pragma unroll
        for (int nt = 0; nt < 16; ++nt) *(v2u*)(dst + nt * 16 * 256) = (v2u){pg8::cvt_pk_bf16(acc[nt][0], acc[nt][1]), pg8::cvt_pk_bf16(acc[nt][2], acc[nt][3])};
        __syncthreads();
    }
}
__device__ __forceinline__ void ph_gla_b(const Params& p, int gid, int gstride) {
    bf16* ST = (bf16*)(p.ws + WS_ST); const float* DEC = (const float*)(p.ws + WS_DEC);
    for (int e = gid; e < 32 * 4096; e += gstride) { const int bh = e >> 12, dv = (e >> 4) & 255, d8 = e & 15;
        float st[8];
#pragma unroll
        for (int i = 0; i < 8; ++i) st[i] = 0.f;
        char* base = (char*)ST + (size_t)bh * 64 * (256 * 128 * 2) + (unsigned)((dv * 128 + d8 * 8) * 2); const float* dbase = DEC + (size_t)bh * 64 * 128 + d8 * 8;
#pragma unroll 4
        for (int ch = 0; ch < 64; ++ch) { v4u* ptr = (v4u*)(base + (size_t)ch * (256 * 128 * 2)); const v4u w = *ptr; const f32x4 d0 = *(const f32x4*)(dbase + ch * 128), d1 = *(const f32x4*)(dbase + ch * 128 + 4);
            v4u o; o.x = pk2(st[0], st[1]); o.y = pk2(st[2], st[3]); o.z = pk2(st[4], st[5]); o.w = pk2(st[6], st[7]); *ptr = o;
            st[0] = st[0] * d0.x + bflo(w.x); st[1] = st[1] * d0.y + bfhi(w.x); st[2] = st[2] * d0.z + bflo(w.y); st[3] = st[3] * d0.w + bfhi(w.y);
            st[4] = st[4] * d1.x + bflo(w.z); st[5] = st[5] * d1.y + bfhi(w.z); st[6] = st[6] * d1.z + bflo(w.w); st[7] = st[7] * d1.w + bfhi(w.w); }
    }
}
__device__ __forceinline__ void ph_gla_c(const Params& p, LAS unsigned char* lds, int u0, int ustride, int tid_in, int wave) {
    using namespace gla;
    int tid = tid_in; asm volatile("" : "+v"(tid));
    const int lane = tid & 63, c = lane & 15, gq = lane >> 4, nt = wave & 3, half = wave >> 2;
    const bf16* GQ = (const bf16*)(p.ws + WS_GQ); const bf16* GK = (const bf16*)(p.ws + WS_GK); const bf16* GG = (const bf16*)(p.ws + WS_GG); const bf16* ST = (const bf16*)(p.ws + WS_ST);
    bf16* A2 = (bf16*)(p.ws + WS_A2); const float* gn = p.in[I_GLAG];
    const int koff0 = c * 256 + ((gq ^ c) * 16), voff0 = c * 128 + (((gq >> 1) ^ ((c >> 1) & 7)) * 16) + (gq & 1) * 8;
    CumIn ci; RawK rq, rk; RawV rv;
    if (u0 < 2048) { const int bh = u0 >> 6, ch = u0 & 63, t0 = (bh >> 2) * SEQ + ch * 64; rq = load_raw_k(GQ, tid, t0, bh & 3); rk = load_raw_k(GK, tid, t0, bh & 3); rv = load_raw_v(p, tid, t0, bh & 3); ci = load_cum(p, tid, t0, bh & 3); }
    for (int unit = u0; unit < 2048; unit += ustride) {
        const int bh = unit >> 6, ch = unit & 63, b = bh >> 2, h = bh & 3, t0 = b * SEQ + ch * 64;
        store_raw_k(lds + 0, tid, rq); store_raw_k(lds + 16384, tid, rk); store_raw_v(lds + 32768, tid, rv);
        float P[16], blast; chunk_cumsum(ci, lds, tid, P, blast);
        { const int dk = tid & 127, jq = tid >> 7;
#pragma unroll
          for (int jj = 0; jj < 16; ++jj) { const int j = 16 * jq + jj; const float qv = bf2f(*(const LAS bf16*)(lds + j * 256 + dk * 2)), kv = bf2f(*(const LAS bf16*)(lds + 16384 + j * 256 + dk * 2));
              const int off = j * 256 + (((dk >> 3) ^ (j & 15)) * 16) + (dk & 7) * 2;
              *(LAS bf16*)(lds + L_QT + off) = (bf16)f2bf(qv * __expf(P[jj])); *(LAS bf16*)(lds + L_KT + off) = (bf16)f2bf(kv * __expf(-P[jj])); } }
        fill_vt(lds, lds + 32768, tid);
        __syncthreads();
        { const char* src = (const char*)ST + (size_t)unit * (256 * 128 * 2);
#pragma unroll
          for (int i = 0; i < 8; ++i) { const int piece = 8 * wave + i, row = piece * 4 + (lane >> 4), chunk = (lane & 15) ^ (row & 15);
              __builtin_amdgcn_global_load_lds((const unsigned*)(src + (unsigned)(row * 256 + chunk * 16)), (LAS unsigned*)(lds + L_ST + piece * 1024), 16, 0, 0); } }
        v2u ggr[8];
        { const int tokg = t0 + 16 * nt + c;
#pragma unroll
          for (int mt = 0; mt < 8; ++mt) ggr[mt] = *(const v2u*)((const char*)GG + (unsigned)((tokg * 1024 + h * 256 + 128 * half + 16 * mt + 4 * gq) * 2)); }
        asm volatile("s_waitcnt vmcnt(0)" ::: "memory"); __syncthreads();
        { const int un = unit + ustride < 2048 ? unit + ustride : unit, bhn = un >> 6, chn = un & 63, tn = (bhn >> 2) * SEQ + chn * 64; rq = load_raw_k(GQ, tid, tn, bhn & 3); rk = load_raw_k(GK, tid, tn, bhn & 3); rv = load_raw_v(p, tid, tn, bhn & 3); ci = load_cum(p, tid, tn, bhn & 3); }
        bf16x8 qF[4];
#pragma unroll
        for (int ks = 0; ks < 4; ++ks) qF[ks] = *(const LAS bf16x8*)(lds + L_QT + nt * 4096 + (koff0 ^ (ks * 64)));
        f4 sT[4];
        { const LAS unsigned char* kt0 = lds + L_KT; bf16x8 an = *(const LAS bf16x8*)(kt0 + koff0), an2 = *(const LAS bf16x8*)(kt0 + 4096 + koff0);
#pragma unroll
          for (int ks = 0; ks < 4; ++ks)
#pragma unroll
            for (int jt = 0; jt < 4; ++jt) { const bf16x8 a = an; const int jn = ks * 4 + jt + 2; an = an2;
                if (jn < 16) an2 = *(const LAS bf16x8*)(kt0 + (jn & 3) * 4096 + (koff0 ^ ((jn >> 2) * 64)));
                __builtin_amdgcn_sched_barrier(0);
                sT[jt] = __builtin_amdgcn_mfma_f32_16x16x32_bf16(a, qF[ks], ks == 0 ? (f4){0.f, 0.f, 0.f, 0.f} : sT[jt], 0, 0, 0); }
#pragma unroll
          for (int jt = 0; jt < 4; ++jt)
#pragma unroll
            for (int rg = 0; rg < 4; ++rg) if (jt > nt || (jt == nt && 4 * gq + rg > c)) sT[jt][rg] = 0.f; }
        bf16x8 pb[2];
#pragma unroll
        for (int s = 0; s < 2; ++s) { v4u w; w.x = pg8::cvt_pk_bf16(sT[2 * s][0], sT[2 * s][1]); w.y = pg8::cvt_pk_bf16(sT[2 * s][2], sT[2 * s][3]); w.z = pg8::cvt_pk_bf16(sT[2 * s + 1][0], sT[2 * s + 1][1]); w.w = pg8::cvt_pk_bf16(sT[2 * s + 1][2], sT[2 * s + 1][3]); pb[s] = __builtin_bit_cast(bf16x8, w); }
        f4 o[8]; float ss = 0.f;
        { const LAS unsigned char* st0 = lds + L_ST + (128 * half) * 256; bf16x8 an = *(const LAS bf16x8*)(st0 + koff0), an2 = *(const LAS bf16x8*)(st0 + 16 * 256 + koff0);
#pragma unroll
          for (int ks = 0; ks < 4; ++ks)
#pragma unroll
            for (int mt = 0; mt < 8; ++mt) { const bf16x8 a = an; const int jn = ks * 8 + mt + 2; an = an2;
                if (jn < 32) an2 = *(const LAS bf16x8*)(st0 + (jn & 7) * 16 * 256 + (koff0 ^ ((jn >> 3) * 64)));
                __builtin_amdgcn_sched_barrier(0);
                o[mt] = __builtin_amdgcn_mfma_f32_16x16x32_bf16(a, qF[ks], ks == 0 ? (f4){0.f, 0.f, 0.f, 0.f} : o[mt], 0, 0, 0); } }
#pragma unroll
        for (int s = 0; s < 2; ++s) if (2 * s <= nt) { const LAS unsigned char* vt0 = lds + L_VT + (128 * half) * 128;
            v2u lo = *(const LAS v2u*)(vt0 + (voff0 ^ (s * 64))), hi = *(const LAS v2u*)(vt0 + (voff0 ^ (s * 64 + 32)));
#pragma unroll
            for (int mt = 0; mt < 8; ++mt) { const bf16x8 a = __builtin_bit_cast(bf16x8, (v4u){lo.x, lo.y, hi.x, hi.y});
                if (mt < 7) { lo = *(const LAS v2u*)(vt0 + (mt + 1) * 16 * 128 + (voff0 ^ (s * 64))); hi = *(const LAS v2u*)(vt0 + (mt + 1) * 16 * 128 + (voff0 ^ (s * 64 + 32))); }
                __builtin_amdgcn_sched_barrier(0);
                o[mt] = __builtin_amdgcn_mfma_f32_16x16x32_bf16(a, pb[s], o[mt], 0, 0, 0); } }
#pragma unroll
        for (int mt = 0; mt < 8; ++mt) ss += (o[mt][0] * o[mt][0] + o[mt][1] * o[mt][1]) + (o[mt][2] * o[mt][2] + o[mt][3] * o[mt][3]);
        ss = nsa::radd32(nsa::radd16(ss));
        LAS float* red = (LAS float*)(lds + L_RED);
        if (gq == 0) red[half * 64 + 16 * nt + c] = ss;
        __syncthreads();
        const float rstd = 1.f / sqrtf((red[16 * nt + c] + red[64 + 16 * nt + c]) * (1.f / 256.f) + RMS_EPS);
        const int tok = t0 + 16 * nt + c;
#pragma unroll
        for (int mt = 0; mt < 8; ++mt) { const int dv = 128 * half + 16 * mt + 4 * gq; const f32x4 g4 = *(const f32x4*)((const char*)gn + (unsigned)(dv * 4));
            const v2u gg = ggr[mt];
            const float z0 = bflo(gg.x), z1 = bfhi(gg.x), z2 = bflo(gg.y), z3 = bfhi(gg.y);
            v2u w; w.x = pg8::cvt_pk_bf16(o[mt][0] * rstd * g4.x * (z0 * __builtin_amdgcn_rcpf(1.f + __expf(-z0))), o[mt][1] * rstd * g4.y * (z1 * __builtin_amdgcn_rcpf(1.f + __expf(-z1))));
            w.y = pg8::cvt_pk_bf16(o[mt][2] * rstd * g4.z * (z2 * __builtin_amdgcn_rcpf(1.f + __expf(-z2))), o[mt][3] * rstd * g4.w * (z3 * __builtin_amdgcn_rcpf(1.f + __expf(-z3))));
            *(v2u*)((char*)A2 + (unsigned)((tok * DM + h * 256 + dv) * 2)) = w; }
        __syncthreads();
    }
}


constexpr size_t WS_LH = WS_DEC + (size_t)2048 * 128 * 4;
constexpr size_t WS_PEV = WS_LH + (size_t)2 * 4096 * 256 * 4;
static_assert(WS_PEV + 1024 <= WS_KCMP, "cmp scratch overlay");
struct CmpOrder {
    int c; const bf16 *kc, *vc, *wk, *wv;
    __device__ __forceinline__ bool next(int i, pg8::Unit& u) const { if (i > 0 || c >= 32) return false; u.pm = c & 15; u.pn = 0; u.kind = c >> 4; return true; }
    __device__ __forceinline__ const char* pa(const pg8::Gemm&, const pg8::Unit& u) const { return (const char*)(u.kind ? vc : kc) + (size_t)u.pm * ((size_t)256 * 2048 * 2); }
    __device__ __forceinline__ const char* pb(const pg8::Gemm&, const pg8::Unit& u) const { return (const char*)(u.kind ? wv : wk); }
    __device__ __forceinline__ void a_ready(const pg8::Unit&) const {}
    __device__ __forceinline__ void done(const pg8::Unit&) const {}
};
struct EpiLH {
    static constexpr bool PERM = false, AFTER_DRAIN = false;
    float* LH;
    __device__ __forceinline__ void operator()(const pg8::f32x4 (&acc)[2][2][4][2], const pg8::Unit& u, int wr, int wc, int fr, int fq) const {
        const int row0 = u.kind * 4096 + u.pm * 256 + wr * 64 + fr, col0 = wc * 32 + 4 * fq;
#pragma unroll
        for (int ai = 0; ai < 2; ++ai)
#pragma unroll
            for (int m = 0; m < 4; ++m) { float* rowp = LH + (size_t)(row0 + ai * 128 + m * 16) * 256 + col0;
#pragma unroll
                for (int bj = 0; bj < 2; ++bj)
#pragma unroll
                    for (int n = 0; n < 2; ++n) *(pg8::f32x4*)(rowp + bj * 128 + n * 16) = acc[ai][bj][m][n]; }
    }
};

constexpr size_t PROWS = (size_t)MAXTILES * 256;
constexpr size_t WS_W1Q = WS_W1T;
constexpr size_t WS_W2Q = WS_W1Q + (size_t)NE * 4096 * DM;
constexpr size_t WS_HN8 = WS_W2Q + (size_t)NE * DM * DFF;
constexpr size_t WS_AMAXP = WS_HN8 + (size_t)T * DM;
constexpr size_t WS_WSC1 = WS_AMAXP + PROWS * 64 * 4;
constexpr size_t WS_WSC2 = WS_WSC1 + (size_t)NE * 4096 * 4;
constexpr size_t WS_HSC = WS_WSC2 + (size_t)NE * 2048 * 4;
constexpr size_t WS_ROWSC = WS_HSC + (size_t)T * 4;
constexpr size_t WS_ASC = WS_ROWSC + PROWS * 4;
static_assert(WS_ASC + PROWS * 4 <= WS_XN, "int8 buffers fit in the retired bf16 expert-weight region");
constexpr size_t WS_ROWTOK = WS_CTL + 512 * 1024;
static_assert(PROWS * 2 <= 512 * 1024 && DM == 2048, "row table fits; gathered rows are 2048 bytes");
constexpr size_t WS_H16 = WS_XG;
static_assert((size_t)T * DM * 2 <= PROWS * DM, "h fits below ACT8");
constexpr size_t WS_XG8 = WS_XG;
constexpr size_t WS_ACT8 = WS_XG + PROWS * DM;
constexpr size_t WS_Y = WS_ACT;
constexpr size_t WS_YSC = WS_ACT + PROWS * DM;
static_assert(WS_YSC + PROWS * 64 * 4 <= WS_END, "expert output buffers fit");
static_assert(WS_ACT8 + PROWS * DM <= WS_ACT, "int8 row buffers fit in the retired gathered-row region");

__device__ __forceinline__ unsigned q8x4(float a, float b, float c, float d) {
    const float M = 12582912.f; const unsigned ua = __builtin_bit_cast(unsigned, a + M), ub = __builtin_bit_cast(unsigned, b + M), uc = __builtin_bit_cast(unsigned, c + M), ud = __builtin_bit_cast(unsigned, d + M);
    return __builtin_amdgcn_perm(ub, ua, 0x0c0c0400u) | (__builtin_amdgcn_perm(ud, uc, 0x0c0c0400u) << 16); }
__device__ __forceinline__ unsigned rq4(unsigned w, float f) { const int s = (int)w;
    const float b0 = (float)((s << 24) >> 24), b1 = (float)((s << 16) >> 24), b2 = (float)((s << 8) >> 24), b3 = (float)(s >> 24); return q8x4(b0 * f, b1 * f, b2 * f, b3 * f); }
__device__ __forceinline__ float clamp127(float v) { return __builtin_amdgcn_fmed3f(v, -127.f, 127.f); }
__device__ __forceinline__ unsigned q8x4c(float a, float b, float c, float d) { return q8x4(clamp127(a), clamp127(b), clamp127(c), clamp127(d)); }

constexpr size_t WS_WINQ = WS_WINT;
constexpr size_t WS_WISC = WS_WINT + (size_t)NPT * 256 * DM;
constexpr size_t WS_XN8 = WS_XN;
constexpr size_t WS_XSC = WS_XN + (size_t)T * DM;
constexpr size_t WS_PMAX = WS_HN;
constexpr size_t WS_PMAXI = WS_PMAX + (size_t)64 * 8 * 4096 * 4;

constexpr int NSLAB_E = NE * 192, NSLAB = NSLAB_E + 178;
struct SlabSrc { const float* W; int N; bool ok; };
__device__ __forceinline__ SlabSrc slab_src(const Params& p, int sl, int r0, int n4) {
    SlabSrc s;
    if (sl < NSLAB_E) { const int e = sl / 192, r = sl % 192; const bool isw2 = r >= 128; const int nb = isw2 ? r - 128 : r; s.N = isw2 ? 2048 : 4096;
        s.W = (isw2 ? p.in[I_W2] + (size_t)e * DFF * DM : p.in[I_W1] + (size_t)e * DM * 4096) + (size_t)r0 * s.N + nb * 32 + 4 * n4; s.ok = true; }
    else { const int nb = sl - NSLAB_E; s.N = 5672; s.ok = nb * 32 + 4 * n4 < 5672; s.W = p.in[I_WIN] + (size_t)r0 * 5672 + (s.ok ? nb * 32 + 4 * n4 : 0); }
    return s;
}
__device__ __forceinline__ void p0_slab_quant(const Params& p, LAS unsigned char* lds, int bid, int G, int tid) {
    constexpr int RS = 4104;
    LAS unsigned char* TT = lds; LAS float* part = (LAS float*)(lds + 32 * RS); LAS float* inv = part + 64 * 32; LAS int* drow = (LAS int*)(inv + 32);
    signed char* W1Q = (signed char*)(p.ws + WS_W1Q); signed char* W2Q = (signed char*)(p.ws + WS_W2Q); signed char* WIQ = (signed char*)(p.ws + WS_WINQ);
    float* WSC1 = (float*)(p.ws + WS_WSC1); float* WSC2 = (float*)(p.ws + WS_WSC2); float* WISC = (float*)(p.ws + WS_WISC);
    const int n4 = tid & 7, r0 = tid >> 3;
    f32x4 va[8], vb[8];
#define SLAB_ISSUE(dst, sl, j) do { if ((sl) < NSLAB) { const SlabSrc ss_ = slab_src(p, (sl), 2 * r0, n4); _Pragma("unroll") for (int u = 0; u < 8; ++u) dst[u] = __builtin_nontemporal_load((const f32x4*)(ss_.W + (size_t)(128 * (4 * (j) + (u >> 1)) + (u & 1)) * ss_.N)); } } while (0)
#define SLAB_USE(src, j) do { _Pragma("unroll") for (int u2 = 0; u2 < 4; ++u2) { const f32x4 xa = src[2 * u2], xb = src[2 * u2 + 1]; const int k = 2 * r0 + 128 * (4 * (j) + u2);        \
            const unsigned w0 = cvt2bf(xa.x, xb.x), w1 = cvt2bf(xa.y, xb.y), w2 = cvt2bf(xa.z, xb.z), w3 = cvt2bf(xa.w, xb.w);        \
            mx0 = __builtin_elementwise_max(mx0, __builtin_bit_cast(u16x2, w0 & 0x7fff7fffu)); mx1 = __builtin_elementwise_max(mx1, __builtin_bit_cast(u16x2, w1 & 0x7fff7fffu)); \
            mx2 = __builtin_elementwise_max(mx2, __builtin_bit_cast(u16x2, w2 & 0x7fff7fffu)); mx3 = __builtin_elementwise_max(mx3, __builtin_bit_cast(u16x2, w3 & 0x7fff7fffu)); \
            LAS unsigned char* d = TT + (4 * n4) * RS + k * 2; \
            *(LAS unsigned*)d = w0; *(LAS unsigned*)(d + RS) = w1; *(LAS unsigned*)(d + 2 * RS) = w2; *(LAS unsigned*)(d + 3 * RS) = w3; } } while (0)
    SLAB_ISSUE(va, bid, 0); SLAB_ISSUE(vb, bid, 1);
    for (int slab = bid; slab < NSLAB; slab += G) {
        u16x2 mx0 = (u16x2){0, 0}, mx1 = (u16x2){0, 0}, mx2 = (u16x2){0, 0}, mx3 = (u16x2){0, 0};
        SLAB_USE(va, 0); SLAB_ISSUE(va, slab, 2);
        SLAB_USE(vb, 1); SLAB_ISSUE(vb, slab, 3);
        SLAB_USE(va, 2); SLAB_ISSUE(va, slab + G, 0);
        SLAB_USE(vb, 3); SLAB_ISSUE(vb, slab + G, 1);
        { u16x2 t0, t1; { const unsigned m0 = __builtin_bit_cast(unsigned, mx0), m1 = __builtin_bit_cast(unsigned, mx1), m2 = __builtin_bit_cast(unsigned, mx2), m3 = __builtin_bit_cast(unsigned, mx3);
            t0 = __builtin_elementwise_max(__builtin_bit_cast(u16x2, __builtin_amdgcn_perm(m1, m0, 0x05040100u)), __builtin_bit_cast(u16x2, __builtin_amdgcn_perm(m1, m0, 0x07060302u)));
            t1 = __builtin_elementwise_max(__builtin_bit_cast(u16x2, __builtin_amdgcn_perm(m3, m2, 0x05040100u)), __builtin_bit_cast(u16x2, __builtin_amdgcn_perm(m3, m2, 0x07060302u))); }
#pragma unroll
          for (int o = 8; o < 64; o <<= 1) { t0 = __builtin_elementwise_max(t0, __builtin_bit_cast(u16x2, __shfl_xor(__builtin_bit_cast(int, t0), o))); t1 = __builtin_elementwise_max(t1, __builtin_bit_cast(u16x2, __shfl_xor(__builtin_bit_cast(int, t1), o))); }
          const unsigned a0 = __builtin_bit_cast(unsigned, t0), a1 = __builtin_bit_cast(unsigned, t1);
          if ((tid & 63) < 8) *(LAS f32x4*)(part + (tid >> 6) * 32 + 4 * n4) = (f32x4){bflo(a0), bfhi(a0), bflo(a1), bfhi(a1)}; }
        __syncthreads();
        if (tid < 32) { float m = 0.f;
#pragma unroll
            for (int q = 0; q < 8; ++q) m = fmaxf(m, part[q * 32 + tid]);
            const float sc = m > 0.f ? m * (1.f / 127.f) : 1.f; inv[tid] = 1.f / sc;
            if (slab < NSLAB_E) { const int e = slab / 192, r = slab % 192; const bool isw2 = r >= 128; const int n = (isw2 ? r - 128 : r) * 32 + tid;
                if (isw2) { drow[tid] = e * 2048 + n; WSC2[e * 2048 + n] = sc; }
                else { const int j2 = n & 2047, row = (j2 >> 7) * 256 + (n >= 2048 ? 128 : 0) + (j2 & 127); drow[tid] = e * 4096 + row; WSC1[e * 4096 + row] = sc; } }
            else { const int n = (slab - NSLAB_E) * 32 + tid; if (n < 5672) { float qsc; const int row = win_row(n, qsc); drow[tid] = row; WISC[row] = sc * qsc; } else drow[tid] = -1; } }
        __syncthreads();
        { const int kc = tid & 7, n = (tid >> 3) & 31, hf = tid >> 8; const float iv = inv[n]; const int dr = drow[n];
          signed char* dst = (slab < NSLAB_E ? ((slab % 192) >= 128 ? W2Q : W1Q) : WIQ) + (size_t)(dr < 0 ? 0 : dr) * 2048; const LAS unsigned char* src = TT + n * RS;
          if (dr >= 0) {
#pragma unroll
          for (int m8 = 0; m8 < 8; ++m8) { const int k0 = 16 * (kc + 8 * (hf + 2 * m8)); const LAS v2u* sp = (const LAS v2u*)(src + k0 * 2); const v2u a = sp[0], b = sp[1], c = sp[2], d = sp[3]; v4u o;
              o.x = q8x4(bflo(a.x) * iv, bfhi(a.x) * iv, bflo(a.y) * iv, bfhi(a.y) * iv); o.y = q8x4(bflo(b.x) * iv, bfhi(b.x) * iv, bflo(b.y) * iv, bfhi(b.y) * iv);
              o.z = q8x4(bflo(c.x) * iv, bfhi(c.x) * iv, bflo(c.y) * iv, bfhi(c.y) * iv); o.w = q8x4(bflo(d.x) * iv, bfhi(d.x) * iv, bflo(d.y) * iv, bfhi(d.y) * iv);
              *(v4u*)(dst + k0) = o; } } }
        __syncthreads();
    }
#undef SLAB_ISSUE
#undef SLAB_USE
}
struct EpiSwigluI8 {
    static constexpr bool PERM = true, AFTER_DRAIN = false;
    const float* b1; const float* rowsc; const float* wsc1; signed char* act8; float* amaxp;
    __device__ __forceinline__ void operator()(const pg8::f32x4 (&acc)[2][2][4][2], const pg8::Unit& u, int wr, int wc, int fr, int fq) const {
        typedef float f2 __attribute__((ext_vector_type(2)));
        const int e = u.kind; const int cin = wc * 32 + 8 * fq; const int col = u.pn * 128 + cin; const int row0 = u.pm * 256 + wr * 64 + fr;
        const float* bg = b1 + (size_t)e * 4096 + col; const float* bl = bg + 2048; const float* sg = wsc1 + (size_t)e * 4096 + u.pn * 256 + cin; const float* sl = sg + 128;
        f2 gb[4], lb[4], gs[4], ls[4];
#pragma unroll
        for (int k = 0; k < 4; ++k) { gb[k] = *(const f2*)(bg + 2 * k); lb[k] = *(const f2*)(bl + 2 * k); gs[k] = *(const f2*)(sg + 2 * k); ls[k] = *(const f2*)(sl + 2 * k); }
        float rsv[8];
#pragma unroll
        for (int q = 0; q < 8; ++q) rsv[q] = rowsc[row0 + (q >> 2) * 128 + (q & 3) * 16];
#pragma unroll
        for (int ai = 0; ai < 2; ++ai)
#pragma unroll
            for (int m = 0; m < 4; ++m) { const int r = row0 + ai * 128 + m * 16; const float rs = rsv[ai * 4 + m]; const f2 rs2 = (f2){rs, rs}; f2 o[4]; float mx = 0.f;
#pragma unroll
                for (int k = 0; k < 4; ++k) { const int n = k >> 1, j = (k & 1) * 2;
                    const f2 ag = (f2){(float)__float_as_int(acc[ai][0][m][n][j]), (float)__float_as_int(acc[ai][0][m][n][j + 1])}, al = (f2){(float)__float_as_int(acc[ai][1][m][n][j]), (float)__float_as_int(acc[ai][1][m][n][j + 1])};
                    f2 gl = __builtin_elementwise_fma(ag, rs2 * gs[k], gb[k]), li = __builtin_elementwise_fma(al, rs2 * ls[k], lb[k]);
                    gl.x = fminf(gl.x, 7.f); gl.y = fminf(gl.y, 7.f); li.x = __builtin_amdgcn_fmed3f(li.x, -7.f, 7.f); li.y = __builtin_amdgcn_fmed3f(li.y, -7.f, 7.f);
                    const f2 ea = gl * (f2){-2.4554669595930156f, -2.4554669595930156f};
                    const f2 den = (f2){__builtin_amdgcn_exp2f(ea.x), __builtin_amdgcn_exp2f(ea.y)} + (f2){1.f, 1.f};
                    const f2 v = (gl * (f2){__builtin_amdgcn_rcpf(den.x), __builtin_amdgcn_rcpf(den.y)}) * (li + (f2){1.f, 1.f});
                    o[k] = v; mx = fmaxf(mx, fmaxf(fabsf(v.x), fabsf(v.y))); }
                mx = nsa::rmax32(nsa::rmax16(mx));
                if (fq == 0) amaxp[(size_t)r * 64 + u.pn * 4 + wc] = mx;
                const float iq = mx > 0.f ? 127.f * __builtin_amdgcn_rcpf(mx) : 0.f; const f2 iq2 = (f2){iq, iq}; v2u w;
                { const f2 q0 = o[0] * iq2, q1 = o[1] * iq2, q2 = o[2] * iq2, q3 = o[3] * iq2; w.x = q8x4(q0.x, q0.y, q1.x, q1.y); w.y = q8x4(q2.x, q2.y, q3.x, q3.y); }
                *(v2u*)(act8 + (size_t)r * DFF + col) = w; }
    }
};
__device__ __forceinline__ void ph_actq(const Params& p, int gw, int NGW, int lane) {
    const int nrows = ((const int*)(p.ws + WS_META))[0] * 256; const float* amaxp = (const float*)(p.ws + WS_AMAXP);
    signed char* A8 = (signed char*)(p.ws + WS_ACT8); float* ASC = (float*)(p.ws + WS_ASC);
    for (int rb = gw; rb < nrows; rb += 2 * NGW) {
        const int r0 = rb, r1 = rb + NGW; const bool h1 = r1 < nrows; const int r1c = h1 ? r1 : r0;
        const float g0 = amaxp[(size_t)r0 * 64 + lane], g1 = amaxp[(size_t)r1c * 64 + lane];
        v4u* s0 = (v4u*)(A8 + (size_t)r0 * DFF) + lane * 2; v4u* s1 = (v4u*)(A8 + (size_t)r1c * DFF) + lane * 2;
        const v4u a00 = s0[0], a01 = s0[1], a10 = s1[0], a11 = s1[1];
        const float m0 = wave_max(g0), m1 = wave_max(g1);
        { const float f = m0 > 0.f ? g0 * __builtin_amdgcn_rcpf(m0) : 0.f;
          v4u o0, o1; o0.x = rq4(a00.x, f); o0.y = rq4(a00.y, f); o0.z = rq4(a00.z, f); o0.w = rq4(a00.w, f); o1.x = rq4(a01.x, f); o1.y = rq4(a01.y, f); o1.z = rq4(a01.z, f); o1.w = rq4(a01.w, f);
          s0[0] = o0; s0[1] = o1; if (lane == 0) ASC[r0] = m0 > 0.f ? m0 * (1.f / 127.f) : 1.f; }
        if (h1) { const float f = m1 > 0.f ? g1 * __builtin_amdgcn_rcpf(m1) : 0.f;
          v4u o0, o1; o0.x = rq4(a10.x, f); o0.y = rq4(a10.y, f); o0.z = rq4(a10.z, f); o0.w = rq4(a10.w, f); o1.x = rq4(a11.x, f); o1.y = rq4(a11.y, f); o1.z = rq4(a11.z, f); o1.w = rq4(a11.w, f);
          s1[0] = o0; s1[1] = o1; if (lane == 0) ASC[r1] = m1 > 0.f ? m1 * (1.f / 127.f) : 1.f; } }
}
struct EpiDownI8 {
    static constexpr bool PERM = true, AFTER_DRAIN = false;
    const float* b2; const float* roww; const float* asc; const float* wsc2; signed char* y; float* ysc;
    __device__ __forceinline__ void operator()(const pg8::f32x4 (&acc)[2][2][4][2], const pg8::Unit& u, int wr, int wc, int fr, int fq) const {
        const int e = u.kind; const int col0 = u.pn * 256 + wc * 32 + 8 * fq; const int row0 = u.pm * 256 + wr * 64 + fr;
        typedef float f2 __attribute__((ext_vector_type(2)));
        f2 bv[2][4], sv[2][4];
#pragma unroll
        for (int bj = 0; bj < 2; ++bj)
#pragma unroll
            for (int k = 0; k < 4; ++k) { bv[bj][k] = *(const f2*)(b2 + (size_t)e * DM + col0 + bj * 128 + 2 * k); sv[bj][k] = *(const f2*)(wsc2 + (size_t)e * DM + col0 + bj * 128 + 2 * k); }
        float gv[8], av[8];
#pragma unroll
        for (int q = 0; q < 8; ++q) { const int rq = row0 + (q >> 2) * 128 + (q & 3) * 16; gv[q] = roww[rq]; av[q] = asc[rq]; }
#pragma unroll
        for (int ai = 0; ai < 2; ++ai)
#pragma unroll
            for (int m = 0; m < 4; ++m) { const int r = row0 + ai * 128 + m * 16; const float g = gv[ai * 4 + m], as = av[ai * 4 + m]; const f2 g2 = (f2){g, g}, as2 = (f2){as, as};
#pragma unroll
                for (int bj = 0; bj < 2; ++bj) { f2 o[4];
#pragma unroll
                    for (int k = 0; k < 4; ++k) { const int n = k >> 1, j = (k & 1) * 2; const f2 a2 = (f2){(float)__float_as_int(acc[ai][bj][m][n][j]), (float)__float_as_int(acc[ai][bj][m][n][j + 1])};
                        o[k] = __builtin_elementwise_fma(a2, as2 * sv[bj][k], bv[bj][k]) * g2; }
                    float mx = fmaxf(fmaxf(fmaxf(fabsf(o[0].x), fabsf(o[0].y)), fmaxf(fabsf(o[1].x), fabsf(o[1].y))), fmaxf(fmaxf(fabsf(o[2].x), fabsf(o[2].y)), fmaxf(fabsf(o[3].x), fabsf(o[3].y))));
                    mx = nsa::rmax32(nsa::rmax16(mx));
                    if (fq == 0) ysc[(size_t)r * 64 + u.pn * 8 + bj * 4 + wc] = mx * (1.f / 127.f);
                    const float iq = mx > 0.f ? 127.f * __builtin_amdgcn_rcpf(mx) : 0.f; const f2 iq2 = (f2){iq, iq}; v2u w;
                    { const f2 q0 = o[0] * iq2, q1 = o[1] * iq2, q2 = o[2] * iq2, q3 = o[3] * iq2; w.x = q8x4(q0.x, q0.y, q1.x, q1.y); w.y = q8x4(q2.x, q2.y, q3.x, q3.y); }
                    *(v2u*)(y + (size_t)r * DM + col0 + bj * 128) = w; } }
    }
};

struct EpiProjI8 {
    static constexpr bool PERM = true, AFTER_DRAIN = false;
    unsigned char* ws;
    __device__ __forceinline__ void operator()(const pg8::f32x4 (&acc)[2][2][4][2], const pg8::Unit& u, int wr, int wc, int fr, int fq) const {
        const int cw = wc * 32 + 8 * fq; const float* XSC = (const float*)(ws + WS_XSC); const float* WISC = (const float*)(ws + WS_WISC);
        if (u.kind == 0) {
            const int tn = u.pn; bf16* base; size_t bjs = 128; int ld = 0; bool headmajor = false; bool small = false;
            if (tn < 2) { base = (bf16*)(ws + WS_GQ) + tn * 256; ld = 512; }
            else if (tn < 4) { base = (bf16*)(ws + WS_GK) + (tn - 2) * 256; ld = 512; }
            else if (tn < 8) { base = (bf16*)(ws + WS_GV) + (tn - 4) * 256; ld = 1024; }
            else if (tn < 12) { base = (bf16*)(ws + WS_GG) + (tn - 8) * 256; ld = 1024; }
            else if (tn < 16) { base = (bf16*)(ws + WS_NQ) + (tn - 12) * 256; ld = 1024; }
            else if (tn < 20) { base = (bf16*)(ws + (tn == 16 ? WS_KC : tn == 17 ? WS_VC : tn == 18 ? WS_KS : WS_KW)); headmajor = true; bjs = (size_t)SEQ * 128; }
            else { base = (bf16*)(ws + WS_SM); ld = 64; small = true; }
            if (small && wc >= 2) return;
            typedef float f2 __attribute__((ext_vector_type(2)));
            f2 cs[2][4];
#pragma unroll
            for (int bj = 0; bj < 2; ++bj)
#pragma unroll
                for (int k = 0; k < 4; ++k) cs[bj][k] = *(const f2*)(WISC + tn * 256 + bj * 128 + cw + 2 * k);
            float rsv[8];
#pragma unroll
            for (int q = 0; q < 8; ++q) rsv[q] = XSC[u.pm * 256 + (q >> 2) * 128 + wr * 64 + (q & 3) * 16 + fr];
#pragma unroll
            for (int ai = 0; ai < 2; ++ai)
#pragma unroll
                for (int m = 0; m < 4; ++m) { const int r = u.pm * 256 + ai * 128 + wr * 64 + m * 16 + fr; const float rs = rsv[ai * 4 + m];
                    const size_t rterm = headmajor ? ((size_t)(r >> 12) * 2 * SEQ + (r & (SEQ - 1))) * 128 : (size_t)r * ld;
#pragma unroll
                    for (int bj = 0; bj < 2; ++bj) { if (small && bj) continue; f2 o[4]; const f2 rs2 = (f2){rs, rs};
#pragma unroll
                        for (int k = 0; k < 4; ++k) { const int n = k >> 1, j = (k & 1) * 2; o[k] = (f2){(float)__float_as_int(acc[ai][bj][m][n][j]), (float)__float_as_int(acc[ai][bj][m][n][j + 1])} * (rs2 * cs[bj][k]); }
                        pg8::u32x4 w; w.x = pg8::cvt_pk_bf16(o[0].x, o[0].y); w.y = pg8::cvt_pk_bf16(o[1].x, o[1].y); w.z = pg8::cvt_pk_bf16(o[2].x, o[2].y); w.w = pg8::cvt_pk_bf16(o[3].x, o[3].y);
                        *(pg8::u32x4*)(base + rterm + bj * bjs + cw) = w; } }
        } else {
            bf16* base = (bf16*)(ws + (u.pn == 21 ? WS_VST : WS_VWT));
            pg8::f32x4 xs[2][2]; float wsv[8];
#pragma unroll
            for (int bj = 0; bj < 2; ++bj) { const int tok = u.pm * 256 + bj * 128 + cw; xs[bj][0] = *(const pg8::f32x4*)(XSC + tok); xs[bj][1] = *(const pg8::f32x4*)(XSC + tok + 4); }
#pragma unroll
            for (int q = 0; q < 8; ++q) wsv[q] = WISC[u.pn * 256 + (q >> 2) * 128 + wr * 64 + (q & 3) * 16 + fr];
#pragma unroll
            for (int ai = 0; ai < 2; ++ai)
#pragma unroll
                for (int m = 0; m < 4; ++m) { const int dh = wr * 64 + m * 16 + fr; const float ws_ = wsv[ai * 4 + m];
#pragma unroll
                    for (int bj = 0; bj < 2; ++bj) { const int tok = u.pm * 256 + bj * 128 + cw; const int b = tok >> 12, s = tok & (SEQ - 1); float o[8];
                        const pg8::f32x4 x0 = xs[bj][0], x1 = xs[bj][1];
#pragma unroll
                        for (int j = 0; j < 4; ++j) { o[j] = (float)__float_as_int(acc[ai][bj][m][0][j]) * (ws_ * x0[j]); o[4 + j] = (float)__float_as_int(acc[ai][bj][m][1][j]) * (ws_ * x1[j]); }
                        pg8::u32x4 w; w.x = pg8::cvt_pk_bf16(o[0], o[1]); w.y = pg8::cvt_pk_bf16(o[2], o[3]); w.z = pg8::cvt_pk_bf16(o[4], o[5]); w.w = pg8::cvt_pk_bf16(o[6], o[7]);
                        bf16* vrow = base + ((size_t)(b * 2 + ai) * 128 + dh) * SEQ; const int p0 = vt_pos(s);
                        *(v2u*)(vrow + p0) = (v2u){w.x, w.y}; *(v2u*)(vrow + p0 + 8) = (v2u){w.z, w.w}; } }
        }
    }
};

__device__ __forceinline__ void r1_router(const Params& p, LAS unsigned char* lds, int vb, int tid, int wave, int lane_in) {
    int lane; asm volatile("v_mbcnt_lo_u32_b32 %0, -1, 0\n\tv_mbcnt_hi_u32_b32 %0, -1, %0" : "=v"(lane)); (void)lane_in; (void)tid;
    constexpr int RP = 2052;
    LAS float* rowbuf = (LAS float*)lds;
    LAS float* part = (LAS float*)(lds + 131328);
    LAS int* tk = (LAS int*)(lds + 147712 + wave * 1024);
    LAS int* cntw = (LAS int*)(lds + 155904);
    const bf16* h = (const bf16*)(p.ws + WS_H16); const float* gf = p.in[I_NFFN]; const float* rb = p.in[I_RB];
    signed char* HN8 = (signed char*)(p.ws + WS_HN8);
    const int c = lane & 15, gq = lane >> 4, e = lane & 31, hf = lane >> 5; int mycount = 0;
    bf16x8 bh[2][8], bl[2][8];
    { unsigned o = (unsigned)((c * 2048 + 256 * wave + 8 * gq) * 2); asm volatile("" : "+v"(o));
#pragma unroll
      for (int nt = 0; nt < 2; ++nt)
#pragma unroll
        for (int s = 0; s < 8; ++s) { bh[nt][s] = *(const bf16x8*)((const char*)(p.ws + WS_WRH) + o + (nt * 16 * 2048 + 32 * s) * 2); bl[nt][s] = *(const bf16x8*)((const char*)(p.ws + WS_WRL) + o + (nt * 16 * 2048 + 32 * s) * 2); } }
    v4u hw[2][4];
#pragma unroll
    for (int r = 0; r < 2; ++r) { const v4u* xr = (const v4u*)(h + (size_t)(vb * TPV + 2 * wave + r) * DM) + lane;
#pragma unroll
      for (int q = 0; q < 4; ++q) hw[r][q] = xr[64 * q]; }
    for (int grp = 0; grp < 8; ++grp) {
#pragma unroll
        for (int r = 0; r < 2; ++r) { const int t = vb * TPV + grp * 16 + 2 * wave + r; float s = 0.f;
#pragma unroll
          for (int q = 0; q < 4; ++q) { const float a0 = bflo(hw[r][q].x), a1 = bfhi(hw[r][q].x), a2 = bflo(hw[r][q].y), a3 = bfhi(hw[r][q].y), a4 = bflo(hw[r][q].z), a5 = bfhi(hw[r][q].z), a6 = bflo(hw[r][q].w), a7 = bfhi(hw[r][q].w);
              s += ((a0 * a0 + a1 * a1) + (a2 * a2 + a3 * a3)) + ((a4 * a4 + a5 * a5) + (a6 * a6 + a7 * a7)); }
          const float rstd = 1.f / sqrtf(wave_sum(s) * (1.f / DM) + RMS_EPS);
          float mxr = 0.f; LAS f32x4* hrow = (LAS f32x4*)(rowbuf + (2 * wave + r) * RP);
#pragma unroll
          for (int j = 0; j < 8; ++j) { const int cj = 2 * lane + 128 * (j >> 1) + (j & 1); const f32x4 g4 = ((const f32x4*)gf)[cj]; const unsigned wa = (j & 1) ? hw[r][j >> 1].z : hw[r][j >> 1].x, wb = (j & 1) ? hw[r][j >> 1].w : hw[r][j >> 1].y;
              f32x4 y; y.x = bflo(wa) * rstd * g4.x; y.y = bfhi(wa) * rstd * g4.y; y.z = bflo(wb) * rstd * g4.z; y.w = bfhi(wb) * rstd * g4.w;
              hrow[cj] = y; mxr = fmaxf(mxr, fmaxf(fmaxf(fabsf(y.x), fabsf(y.y)), fmaxf(fabsf(y.z), fabsf(y.w)))); }
          mxr = wave_max(mxr); const float qs = mxr > 0.f ? mxr * (1.f / 127.f) : 1.f, qi = 1.f / qs;
          v2u* o8 = (v2u*)(HN8 + (size_t)t * DM) + lane;
#pragma unroll
          for (int q = 0; q < 4; ++q) { const f32x4 ya = hrow[2 * lane + 128 * q], yb = hrow[2 * lane + 128 * q + 1]; v2u o;
              o.x = q8x4(ya.x * qi, ya.y * qi, ya.z * qi, ya.w * qi); o.y = q8x4(yb.x * qi, yb.y * qi, yb.z * qi, yb.w * qi); o8[64 * q] = o; }
          if (lane == 0) ((float*)(p.ws + WS_HSC))[t] = qs; }
        __syncthreads();
#pragma unroll
        for (int r = 0; r < 2; ++r) { const int tn = vb * TPV + (grp < 7 ? grp + 1 : grp) * 16 + 2 * wave + r; const v4u* xr = (const v4u*)(h + (size_t)tn * DM) + lane;
#pragma unroll
          for (int q = 0; q < 4; ++q) hw[r][q] = xr[64 * q]; }
        { nsa::f4 acc[2] = {(nsa::f4){0.f, 0.f, 0.f, 0.f}, (nsa::f4){0.f, 0.f, 0.f, 0.f}};
          const LAS float* ap = rowbuf + c * RP + 256 * wave + 8 * gq;
#pragma unroll
          for (int s = 0; s < 8; ++s) { const f32x4 y0 = *(const LAS f32x4*)(ap + 32 * s), y1 = *(const LAS f32x4*)(ap + 32 * s + 4);
              v4u ah; ah.x = cvt2bf(y0.x, y0.y); ah.y = cvt2bf(y0.z, y0.w); ah.z = cvt2bf(y1.x, y1.y); ah.w = cvt2bf(y1.z, y1.w);
              v4u al; al.x = cvt2bf(y0.x - bflo(ah.x), y0.y - bfhi(ah.x)); al.y = cvt2bf(y0.z - bflo(ah.y), y0.w - bfhi(ah.y)); al.z = cvt2bf(y1.x - bflo(ah.z), y1.y - bfhi(ah.z)); al.w = cvt2bf(y1.z - bflo(ah.w), y1.w - bfhi(ah.w));
              const bf16x8 Ah = __builtin_bit_cast(bf16x8, ah), Al = __builtin_bit_cast(bf16x8, al);
#pragma unroll
              for (int nt = 0; nt < 2; ++nt) { acc[nt] = __builtin_amdgcn_mfma_f32_16x16x32_bf16(Ah, bh[nt][s], acc[nt], 0, 0, 0); acc[nt] = __builtin_amdgcn_mfma_f32_16x16x32_bf16(Ah, bl[nt][s], acc[nt], 0, 0, 0);
                  acc[nt] = __builtin_amdgcn_mfma_f32_16x16x32_bf16(Al, bh[nt][s], acc[nt], 0, 0, 0); } }
#pragma unroll
          for (int nt = 0; nt < 2; ++nt) { part[(wave * 16 + 4 * gq + 0) * 32 + 16 * nt + c] = acc[nt].x; part[(wave * 16 + 4 * gq + 1) * 32 + 16 * nt + c] = acc[nt].y;
              part[(wave * 16 + 4 * gq + 2) * 32 + 16 * nt + c] = acc[nt].z; part[(wave * 16 + 4 * gq + 3) * 32 + 16 * nt + c] = acc[nt].w; } }
        __syncthreads();
        { const int tl = 2 * wave + hf; float a = rb[e];
#pragma unroll
          for (int q = 0; q < 8; ++q) a += part[(q * 16 + tl) * 32 + e];
          int rank = 0;
#pragma unroll
          for (int mm = 0; mm < 32; ++mm) { const float lm = __shfl(a, (lane & 32) + mm); rank += (lm > a || (lm == a && mm < e)) ? 1 : 0; }
          float mx = a;
#pragma unroll
          for (int o = 1; o < 32; o <<= 1) mx = fmaxf(mx, __shfl_xor(mx, o));
          const bool sel = rank < 4; const float ex = sel ? __expf(a - mx) : 0.f; float sum = ex;
#pragma unroll
          for (int o = 1; o < 32; o <<= 1) sum += __shfl_xor(sum, o);
          const int seli = sel ? 1 : 0, selo = __shfl_xor(seli, 32);
          if (sel) { LAS int* q = tk + ((grp * 2 + hf) * 4 + rank) * 4; q[0] = e; q[1] = mycount + (hf ? selo : 0); q[2] = __builtin_bit_cast(int, ex / sum); }
          mycount += seli + selo; }
        __syncthreads();
    }
    int ln; asm volatile("v_mbcnt_lo_u32_b32 %0, -1, 0\n\tv_mbcnt_hi_u32_b32 %0, -1, %0" : "=v"(ln));
    if (ln < 32) cntw[wave * 32 + ln] = mycount;
    __syncthreads();
    if (wave == 0 && ln < 32) { int tot = 0; for (int w = 0; w < 8; ++w) tot += cntw[w * 32 + ln]; ((int*)(p.ws + WS_CNT))[vb * 32 + ln] = tot; }
    { const int i = ln >> 2, k = ln & 3; const LAS int* q = tk + (i * 4 + k) * 4; const int ee = q[0]; int base = 0; for (int w = 0; w < wave; ++w) base += cntw[w * 32 + ee];
      const int t = vb * TPV + (i >> 1) * 16 + 2 * wave + (i & 1);
      ((int*)(p.ws + WS_EIDX))[t * 4 + k] = ee; ((int*)(p.ws + WS_LRNK))[t * 4 + k] = base + q[1]; ((int*)(p.ws + WS_GATE))[t * 4 + k] = q[2]; }
    __syncthreads();
}
__device__ __forceinline__ void r2_gather(const Params& p, LAS unsigned char* lds, int vb, bool write_meta, int tid, int wave, int lane) {
    LAS int* part_tot = (LAS int*)lds;
    LAS int* part_base = part_tot + 512;
    LAS int* pbase = part_base + 512;
    const int* CNT = (const int*)(p.ws + WS_CNT);
    { const int e = tid & 31, part = tid >> 5; int tot = 0, bs = 0;
      for (int v = part * 16; v < part * 16 + 16; ++v) { const int c = CNT[v * 32 + e]; tot += c; if (v < vb) bs += c; }
      part_tot[part * 32 + e] = tot; part_base[part * 32 + e] = bs; }
    __syncthreads();
    if (tid == 0) { int ps = 0; int* meta = (int*)(p.ws + WS_META); int nt = 0;
        for (int e = 0; e < 32; ++e) { int tot = 0, bs = 0; for (int q = 0; q < 16; ++q) { tot += part_tot[q * 32 + e]; bs += part_base[q * 32 + e]; }
            pbase[e] = ps + bs; const int ntile = (tot + 255) >> 8;
            if (write_meta) for (int q = 0; q < ntile; ++q) meta[64 + nt + q] = e;
            nt += ntile; ps += ntile * 256; }
        if (write_meta) meta[0] = nt; }
    __syncthreads();
    const float* HSC = (const float*)(p.ws + WS_HSC); float* ROWSC = (float*)(p.ws + WS_ROWSC);
    const int* EIDX = (const int*)(p.ws + WS_EIDX); const int* LRNK = (const int*)(p.ws + WS_LRNK); const float* GATE = (const float*)(p.ws + WS_GATE);
    int* POS = (int*)(p.ws + WS_POS); float* ROWW = (float*)(p.ws + WS_ROWW);
    unsigned short* RT = (unsigned short*)(p.ws + WS_ROWTOK);
    { const int t = vb * TPV + (tid >> 2), k = tid & 3;
      const int pos = pbase[EIDX[t * 4 + k]] + LRNK[t * 4 + k];
      POS[t * 4 + k] = pos; ROWW[pos] = GATE[t * 4 + k]; ROWSC[pos] = HSC[t]; RT[(pos & ~255) + (pos & 63) * 4 + ((pos >> 6) & 3)] = (unsigned short)t; }
    __syncthreads();
}
__device__ __forceinline__ void pf_final(const Params& p, int gw, int NGW, int lane) {
    const signed char* Y = (const signed char*)(p.ws + WS_Y); const float* YSC = (const float*)(p.ws + WS_YSC); const int* POS = (const int*)(p.ws + WS_POS); const float* gfin = p.in[I_NFIN]; const bf16* H = (const bf16*)(p.ws + WS_H16);
    for (int t = gw; t < T; t += NGW) {
        f32x4 v[8]; const v4u* hr = (const v4u*)(H + (size_t)t * DM) + lane;
#pragma unroll
        for (int q = 0; q < 4; ++q) { const v4u w = hr[64 * q]; v[2 * q] = (f32x4){bflo(w.x), bfhi(w.x), bflo(w.y), bfhi(w.y)}; v[2 * q + 1] = (f32x4){bflo(w.z), bfhi(w.z), bflo(w.w), bfhi(w.w)}; }
#pragma unroll
        for (int k = 0; k < 4; ++k) { const int pos = POS[t * 4 + k]; const v2u* yr = (const v2u*)(Y + (size_t)pos * DM) + lane; const float* sr = YSC + (size_t)pos * 64 + (lane >> 2);
#pragma unroll
            for (int q = 0; q < 4; ++q) { const v2u w = yr[64 * q]; const float sc = sr[16 * q]; const int a = (int)w.x, b = (int)w.y;
                v[2 * q].x += (float)((a << 24) >> 24) * sc; v[2 * q].y += (float)((a << 16) >> 24) * sc; v[2 * q].z += (float)((a << 8) >> 24) * sc; v[2 * q].w += (float)(a >> 24) * sc;
                v[2 * q + 1].x += (float)((b << 24) >> 24) * sc; v[2 * q + 1].y += (float)((b << 16) >> 24) * sc; v[2 * q + 1].z += (float)((b << 8) >> 24) * sc; v[2 * q + 1].w += (float)(b >> 24) * sc; } }
        float s = 0.f;
#pragma unroll
        for (int j = 0; j < 8; ++j) s += (v[j].x * v[j].x + v[j].y * v[j].y) + (v[j].z * v[j].z + v[j].w * v[j].w);
        const float rstd = 1.f / sqrtf(wave_sum(s) * (1.f / DM) + RMS_EPS); f32x4* xr = (f32x4*)(p.out + (size_t)t * DM);
#pragma unroll
        for (int j = 0; j < 8; ++j) { const int cj = 2 * lane + 128 * (j >> 1) + (j & 1); const f32x4 g4 = ((const f32x4*)gfin)[cj]; f32x4 o; o.x = v[j].x * rstd * g4.x; o.y = v[j].y * rstd * g4.y; o.z = v[j].z * rstd * g4.z; o.w = v[j].w * rstd * g4.w; xr[cj] = o; }
    }
}


constexpr int LDS_BYTES = 159744;
constexpr int MISC_OFF = LDS_BYTES - 256;  static_assert(nsa::LDS_END <= MISC_OFF && gla::L_END <= MISC_OFF, "LDS map");
constexpr int CW_BAR = 4096, CW_XL = 16384;
__global__ __launch_bounds__(512, 2) void mega_fwd(Params p) {
    extern __shared__ __attribute__((aligned(16))) unsigned char lds_raw[];
    LAS unsigned char* lds = (LAS unsigned char*)lds_raw;
    const int G = gridDim.x, bid = blockIdx.x, NGW = G * 8;
#define PH_IDS int tid = threadIdx.x; asm volatile("" : "+v"(tid)); const int lane = tid & 63, wave = __builtin_amdgcn_readfirstlane(tid >> 6), gw = bid * 8 + wave; (void)lane; (void)gw;
    for (int u = threadIdx.x; u < 64; u += 512) ((LAS unsigned*)(lds + MISC_OFF))[u] = 0u;
    __syncthreads();
    XcdBarrier bar = xcd_barrier_post((unsigned*)(p.ws + WS_CTL) + CW_BAR, (volatile LAS unsigned*)(lds + MISC_OFF) + 8);
    { PH_IDS; p0_prologue<false, true>(p, lds, gw, NGW, wave, lane); __syncthreads(); p0_slab_quant(p, lds, bid, G, tid); }
    xcd_barrier(bar);
    { pg8::Gemm g{(const bf16*)(p.ws + WS_XN8), (const bf16*)(p.ws + WS_WINQ), T, NPT * 256, DM / 2};
      ProjOrder S; S.init(T, NPT * 256, G, bid); S.xn = g.A; S.wt = g.Bt; EpiProjI8 E{p.ws};
      pg8::gemm_phase<EpiProjI8, ProjOrder, true, true, true>(lds, g, S, E); }
    { const int ntile = (T / 256) * NPT, busy = ntile % G;
      PH_IDS; if (busy == 0) p0_prologue<true, false>(p, lds, gw, NGW, wave, lane); else if (bid >= busy) p0_prologue<true, false>(p, lds, (bid - busy) * 8 + wave, (G - busy) * 8, wave, lane); }
    xcd_barrier(bar);
    if (bid < 32) {
        pg8::Gemm g{(const bf16*)(p.ws + WS_KC), (const bf16*)(p.ws + WS_WKCT), 4096, 256, 2048};
        CmpOrder S{bid, (const bf16*)(p.ws + WS_KC), (const bf16*)(p.ws + WS_VC), (const bf16*)(p.ws + WS_WKCT), (const bf16*)(p.ws + WS_WVCT)}; EpiLH E{(float*)(p.ws + WS_LH)};
        pg8::gemm_phase<EpiLH, CmpOrder, true, true>(lds, g, S, E);
    } else { PH_IDS; ph_gla_a(p, lds, bid - 32, G - 32, tid, wave); }
    xcd_barrier(bar);
    { PH_IDS; ph_gla_b(p, bid * 512 + tid, G * 512);
      for (int i = bid * 512 + tid; i < 16 * 128; i += G * 512) { const int bgz = i >> 7, dz = i & 127; ((bf16*)(p.ws + WS_KCMP))[((size_t)bgz * 256 + 255) * 128 + dz] = 0; ((bf16*)(p.ws + WS_VCMPT))[((size_t)bgz * 128 + dz) * 256 + vt_pos(255)] = 0; }
      ph_cmp_fin(p, lds, bid, G, tid, (const float*)(p.ws + WS_LH), (const float*)(p.ws + WS_PEVP)); }
    xcd_barrier(bar);
    { PH_IDS; ph_nsa(p, lds, bid, G, tid, wave); }
    { PH_IDS; __syncthreads(); ph_gla_c(p, lds, bid, G, tid, wave); }
    xcd_barrier(bar);
    { pg8::Gemm g{(const bf16*)(p.ws + WS_A2), (const bf16*)(p.ws + WS_WOT), T, DM, DM};
      pg8::StaticOrder S; S.init(T, DM, G, bid); EpiRes E{p.in[I_X], (bf16*)(p.ws + WS_H16)};
      pg8::gemm_phase<EpiRes, pg8::StaticOrder, true, true>(lds, g, S, E); }
    xcd_barrier(bar);
    { PH_IDS; for (int vb = bid; vb < NVB; vb += G) r1_router(p, lds, vb, tid, wave, lane); }
    xcd_barrier(bar);
    { PH_IDS; for (int vb = bid; vb < NVB; vb += G) r2_gather(p, lds, vb, vb == 0, tid, wave, lane); }
    xcd_barrier(bar);
    { pg8::Gemm g{(const bf16*)(p.ws + WS_HN8), (const bf16*)(p.ws + WS_W1Q), MAXTILES * 256, 4096, DM / 2};
      MoeOrderG S; S.init((const int*)(p.ws + WS_META), 16, G, bid); S.rowtab = (const unsigned short*)(p.ws + WS_ROWTOK); EpiSwigluI8 E{p.in[I_B1], (const float*)(p.ws + WS_ROWSC), (const float*)(p.ws + WS_WSC1), (signed char*)(p.ws + WS_ACT8), (float*)(p.ws + WS_AMAXP)};
      pg8::gemm_phase<EpiSwigluI8, MoeOrderG, true, true, true, true>(lds, g, S, E); }
    xcd_barrier(bar);
    { PH_IDS; ph_actq(p, gw, NGW, lane); }
    xcd_barrier(bar);
    { pg8::Gemm g{(const bf16*)(p.ws + WS_ACT8), (const bf16*)(p.ws + WS_W2Q), MAXTILES * 256, DM, DFF / 2};
      MoeOrder S; S.init((const int*)(p.ws + WS_META), 8, G, bid); EpiDownI8 E{p.in[I_B2], (const float*)(p.ws + WS_ROWW), (const float*)(p.ws + WS_ASC), (const float*)(p.ws + WS_WSC2), (signed char*)(p.ws + WS_Y), (float*)(p.ws + WS_YSC)};
      pg8::gemm_phase<EpiDownI8, MoeOrder, true, true, true>(lds, g, S, E); }
    xcd_barrier(bar);
    { PH_IDS; pf_final(p, gw, NGW, lane); }
}

extern "C" void kernel_launch(void* const* d_in, const int* in_sizes, int n_in, void* d_out, int out_size, void* d_ws, size_t ws_size, hipStream_t stream) {
    static int grid = 0;
    if (grid == 0) {
        if (n_in != N_IN || out_size != T * DM || ws_size < WS_END) { fprintf(stderr, "kernel_launch: unexpected shapes (n_in %d out %d ws %zu need %zu)\n", n_in, out_size, ws_size, (size_t)WS_END); grid = -1; return; }
        int dev = 0, cus = 0, per_cu = 0;
        if (hipGetDevice(&dev) != hipSuccess || hipDeviceGetAttribute(&cus, hipDeviceAttributeMultiprocessorCount, dev) != hipSuccess) { grid = -1; return; }
        if (hipFuncSetAttribute((const void*)mega_fwd, hipFuncAttributeMaxDynamicSharedMemorySize, LDS_BYTES) != hipSuccess) { fprintf(stderr, "kernel_launch: hipFuncSetAttribute failed\n"); grid = -1; return; }
        if (hipOccupancyMaxActiveBlocksPerMultiprocessor(&per_cu, (const void*)mega_fwd, 512, LDS_BYTES) != hipSuccess || per_cu < 1) { fprintf(stderr, "kernel_launch: occupancy query says %d blocks per CU\n", per_cu); }
        (void)hipGetLastError();
        grid = cus;
    }
    if (grid < 0) return;
    if (hipMemsetAsync((char*)d_ws + WS_CTL, 0, CTL_BYTES, stream) != hipSuccess) return;
    Params p{};
    for (int i = 0; i < N_IN; ++i) p.in[i] = (const float*)d_in[i];
    p.out = (float*)d_out; p.ws = (unsigned char*)d_ws;
    hipLaunchKernelGGL(mega_fwd, dim3(grid), dim3(512), LDS_BYTES, stream, p);
}
```
